# Optimizing an MI355X kernel written in HIP

```python
import jax, jax.numpy as jnp
from jax import lax
import numpy as np

D_MODEL = 1024
BATCH = 8
SEQ = 2048
DEPTH = 2

D_RNN = 512
N_RNN_BLOCKS = 8
RNN_BLOCK = D_RNN // N_RNN_BLOCKS
CONV_WIDTH = 4
LRU_C = 8.0
N_HEADS = 8
HEAD_DIM = 64
D_ATTN = N_HEADS * HEAD_DIM
N_IDX_HEADS = 8
IDX_DIM = 64
MAX_TOPK = 256
Q_BLOCK = 128
D_MIX = D_RNN + D_ATTN
SPLITS = (D_RNN, D_RNN, D_ATTN, HEAD_DIM, HEAD_DIM, D_ATTN, N_IDX_HEADS * IDX_DIM, IDX_DIM, N_IDX_HEADS)
D_IN = sum(SPLITS)
EPS = 1e-6

kernel_name = "hymba_rglru_dsa_adaln_block"


def rmsnorm(x, g):
    xf = x.astype(jnp.float32)
    y = xf * lax.rsqrt(jnp.mean(xf * xf, axis=-1, keepdims=True) + EPS)
    return (y * g.astype(jnp.float32)).astype(x.dtype)


def causal_depthwise_conv(x, w, b):
    C = x.shape[-1]
    y = lax.conv_general_dilated(
        x, w[:, None, :].astype(x.dtype), window_strides=(1,), padding=[(CONV_WIDTH - 1, 0)],
        dimension_numbers=("NWC", "WIO", "NWC"), feature_group_count=C)
    return y + b


def rg_lru(x, w_x, b_x, w_a, b_a, a_param):
    B, S, D = x.shape
    xb = x.reshape(B, S, N_RNN_BLOCKS, RNN_BLOCK)
    gate_x = jax.nn.sigmoid((jnp.einsum("bsnc,ncd->bsnd", xb, w_x).reshape(B, S, D) + b_x).astype(jnp.float32))
    gate_a = jax.nn.sigmoid((jnp.einsum("bsnc,ncd->bsnd", xb, w_a).reshape(B, S, D) + b_a).astype(jnp.float32))
    log_a = -LRU_C * gate_a * jax.nn.softplus(-a_param.astype(jnp.float32))
    a = jnp.exp(log_a)
    mult = jnp.sqrt(-jnp.expm1(2.0 * log_a))
    u = mult * gate_x * x.astype(jnp.float32)

    def combine(left, right):
        a1, b1 = left
        a2, b2 = right
        return a1 * a2, a2 * b1 + b2

    _, h = lax.associative_scan(combine, (a, u), axis=1)
    return h.astype(x.dtype)


def dsa_attention(q, k, v, qi, ki, wi):
    B, S, H, Dh = q.shape
    topk = min(MAX_TOPK, S // 4)
    n_blocks = S // Q_BLOCK
    key_pos = jnp.arange(S)
    kif = ki.astype(jnp.float32)

    def block(i):
        start = i * Q_BLOCK
        qb = lax.dynamic_slice_in_dim(q, start, Q_BLOCK, axis=1)
        qib = lax.dynamic_slice_in_dim(qi, start, Q_BLOCK, axis=1).astype(jnp.float32)
        wib = lax.dynamic_slice_in_dim(wi, start, Q_BLOCK, axis=1).astype(jnp.float32)
        q_pos = start + jnp.arange(Q_BLOCK)
        logits = jnp.einsum("bthd,bsd->bths", qib, kif) * (IDX_DIM ** -0.5)
        score = jnp.einsum("bths,bth->bts", jax.nn.relu(logits), wib * (N_IDX_HEADS ** -0.5))
        causal = key_pos[None, :] <= q_pos[:, None]
        score = jnp.where(causal[None], score, -jnp.inf)
        _, idx = lax.top_k(score, topk)
        valid = idx <= q_pos[None, :, None]
        kg = jax.vmap(lambda kk, ii: kk[ii])(k, idx)
        vg = jax.vmap(lambda vv, ii: vv[ii])(v, idx)
        s = jnp.einsum("bthd,btkd->bthk", qb, kg).astype(jnp.float32) * (Dh ** -0.5)
        s = jnp.where(valid[:, :, None, :], s, -jnp.inf)
        p = jax.nn.softmax(s, axis=-1).astype(vg.dtype)
        return jnp.einsum("bthk,btkd->bthd", p, vg)

    out = lax.map(block, jnp.arange(n_blocks))
    return out.transpose(1, 0, 2, 3, 4).reshape(B, S, H * Dh)


def setup_inputs(seed: int = 0) -> dict:
    key = jax.random.key(seed)
    ks = jax.random.split(key, 16)
    f32 = jnp.float32
    x = jax.random.normal(ks[0], (BATCH, SEQ, D_MODEL), f32)
    c = jax.random.normal(ks[1], (BATCH, D_MODEL), f32)
    norm_g = 1.0 + 0.02 * jax.random.normal(ks[2], (DEPTH, D_MODEL), f32)
    ada_w = jax.random.normal(ks[3], (DEPTH, D_MODEL, 3 * D_MODEL), f32) * (0.5 * D_MODEL ** -0.5)
    ada_b = 0.02 * jax.random.normal(ks[4], (DEPTH, 3 * D_MODEL), f32)
    w_in = jax.random.normal(ks[5], (DEPTH, D_MODEL, D_IN), f32) * (D_MODEL ** -0.5)
    conv_w = jax.random.normal(ks[6], (DEPTH, CONV_WIDTH, D_RNN), f32) * (CONV_WIDTH ** -0.5)
    conv_b = 0.02 * jax.random.normal(ks[7], (DEPTH, D_RNN), f32)
    lru_wx = jax.random.normal(ks[8], (DEPTH, N_RNN_BLOCKS, RNN_BLOCK, RNN_BLOCK), f32) * (RNN_BLOCK ** -0.5)
    lru_bx = 0.02 * jax.random.normal(ks[9], (DEPTH, D_RNN), f32)
    lru_wa = jax.random.normal(ks[10], (DEPTH, N_RNN_BLOCKS, RNN_BLOCK, RNN_BLOCK), f32) * (RNN_BLOCK ** -0.5)
    lru_ba = 0.02 * jax.random.normal(ks[11], (DEPTH, D_RNN), f32)
    a_c = jax.random.uniform(ks[12], (DEPTH, D_RNN), f32, 0.9, 0.999)
    a0 = a_c ** (1.0 / LRU_C)
    lru_a = jnp.log(a0) - jnp.log1p(-a0)
    w_out = jax.random.normal(ks[13], (DEPTH, D_MIX, D_MODEL), f32) * (D_MIX ** -0.5)
    final_g = 1.0 + 0.02 * jax.random.normal(ks[14], (D_MODEL,), f32)
    return {"x": x, "c": c, "norm_g": norm_g, "ada_w": ada_w, "ada_b": ada_b, "w_in": w_in,
            "conv_w": conv_w, "conv_b": conv_b, "lru_wx": lru_wx, "lru_bx": lru_bx,
            "lru_wa": lru_wa, "lru_ba": lru_ba, "lru_a": lru_a, "w_out": w_out, "final_g": final_g}


def reference(x, c, norm_g, ada_w, ada_b, w_in, conv_w, conv_b, lru_wx, lru_bx, lru_wa, lru_ba, lru_a, w_out, final_g):
    B, S, _ = x.shape
    split_points = np.cumsum(SPLITS)[:-1].tolist()
    c_act = jax.nn.silu(c)
    for l in range(DEPTH):
        mod = c_act @ ada_w[l] + ada_b[l]
        shift, scale, gate = jnp.split(mod, 3, axis=-1)
        h = rmsnorm(x, norm_g[l]) * (1.0 + scale[:, None, :]) + shift[:, None, :]
        z = h @ w_in[l]
        xr, gr, q, k, v, ga, qi, ki, wi = jnp.split(z, split_points, axis=-1)
        xr = causal_depthwise_conv(xr, conv_w[l], conv_b[l])
        y_r = rg_lru(xr, lru_wx[l], lru_bx[l], lru_wa[l], lru_ba[l], lru_a[l]) * jax.nn.silu(gr)
        y_a = dsa_attention(q.reshape(B, S, N_HEADS, HEAD_DIM), k, v,
                            qi.reshape(B, S, N_IDX_HEADS, IDX_DIM), ki, wi) * jax.nn.silu(ga)
        y = jnp.concatenate([y_r, y_a], axis=-1) @ w_out[l]
        x = x + gate[:, None, :] * y
    return rmsnorm(x, final_g)
```

```cpp
#include <hip/hip_runtime.h>
#include <hip/hip_cooperative_groups.h>
#include <cstdio>
#include <cstdint>
#include <cmath>
namespace cg = cooperative_groups;
namespace pg8 {
#define PG8_LAS __attribute__((address_space(3)))
typedef unsigned short bf16_t;
typedef short bf16x8 __attribute__((ext_vector_type(8)));
typedef float f32x4 __attribute__((ext_vector_type(4)));
typedef unsigned u32x4 __attribute__((ext_vector_type(4)));
constexpr int BM = 256, BK = 64, HALF = 128, HTB = HALF * BK * 2  , STAGE_BYTES = 8 * HTB, NXCD = 8, WGM = 8;

__host__ __device__ __forceinline__ int lds_byte(int r, int c) { const int st = (r >> 4) * 2 + (c >> 5), rr = r & 15, cc = c & 31, ob = rr * 64 + cc * 2; return st * 1024 + (ob ^ (((ob >> 9) & 1) << 5)); }
__host__ __device__ __forceinline__ void stage_rc(int b, int& R, int& C) { const int st = b / 1024, sb = b % 1024, swz = sb ^ (((sb >> 9) & 1) << 5); R = (st >> 1) * 16 + swz / 64; C = (st & 1) * 32 + (swz % 64) / 2; }
__host__ __device__ __forceinline__ int perm32(int rho) { const int n = rho >> 4, i = rho & 15; return 8 * (i >> 2) + 4 * n + (i & 3); }

struct Unit { int pm, pn; };
struct Gemm { const bf16_t* A; const bf16_t* Bt; int M, N, K; };

struct StaticOrder {
    int nM, nN, nwg, G, c;
    __host__ __device__ void init(int M, int N, int G_, int c_) { nM = M / BM; nN = N / BM; nwg = nM * nN; G = G_; c = c_; }
    __host__ __device__ bool next(int i, Unit& u) const {
        const long L = (long)i * G + c; if (L >= nwg) return false;
        int wgid = (int)L; { const int q = nwg / NXCD, r = nwg % NXCD, xcd = wgid % NXCD, off = wgid / NXCD; wgid = (xcd < r ? xcd * (q + 1) : r * (q + 1) + (xcd - r) * q) + off; }
        const int nig = WGM * nN, gid = wgid / nig, fm = gid * WGM, gsz = (nM - fm) < WGM ? (nM - fm) : WGM;
        u.pm = fm + ((wgid % nig) % gsz); u.pn = (wgid % nig) / gsz; return true;
    }
    __device__ __forceinline__ void a_ready(const Unit&) const {}
    __device__ __forceinline__ void done(const Unit&) const {}
};

__device__ __forceinline__ unsigned cvt_pk_bf16(float lo, float hi) { unsigned r; asm volatile("v_cvt_pk_bf16_f32 %0, %1, %2" : "=v"(r) : "v"(lo), "v"(hi)); return r; }
typedef float f32x2 __attribute__((ext_vector_type(2)));
template <class Epi, class Sched, bool ALIGN_EPI = false, bool SP2 = false>
__device__ __forceinline__ void gemm_phase(PG8_LAS unsigned char* lds, const Gemm g, const Sched& S, const Epi& E) {
    const int tid = threadIdx.x, wid = __builtin_amdgcn_readfirstlane(tid >> 6), lane = tid & 63, wr = wid >> 2, wc = wid & 3, fr = lane & 15, fq = lane >> 4;
    const int K = g.K, nt = K / BK;
    unsigned voffA[2], voffB[2];
#pragma unroll
    for (int i = 0; i < 2; ++i) { int R, C; stage_rc(tid * 16 + i * 8192, R, C); const int Rb = Epi::PERM ? ((R & ~31) + perm32(R & 31)) : R;
        voffA[i] = (unsigned)(R * K + C) * 2u; voffB[i] = (unsigned)(Rb * K + C) * 2u; }
    const size_t kstep = (size_t)(BK * 2);
    const size_t hstep = (size_t)HALF * K * 2;
    const size_t tstep = 2 * hstep;
    const unsigned ldsw = (unsigned)wid * 1024u;
    const int aoff = lds_byte(wr * 64 + fr, fq * 8), boff = lds_byte(wc * 32 + fr, fq * 8);
#define PG8_SA(b, h) (((b) * 2 + (h)) * HTB)
#define PG8_SB(b, h) ((4 + (b) * 2 + (h)) * HTB)
#define PG8_STAGE(bufoff, gbase, voff) do { _Pragma("unroll") for (int _i = 0; _i < 2; ++_i) \
        __builtin_amdgcn_global_load_lds((const unsigned*)((const char*)(gbase) + (voff)[_i]), (PG8_LAS unsigned*)(lds + (bufoff) + ldsw + _i * 8192), 16, 0, 0); } while (0)
#define PG8_LDA(dst, b, h) do { _Pragma("unroll") for (int m = 0; m < 4; ++m) _Pragma("unroll") for (int k = 0; k < 2; ++k) dst[m][k] = *(const PG8_LAS bf16x8*)(lds + PG8_SA(b, h) + aoff + m * 2048 + k * 1024); } while (0)
#define PG8_LDB(dst, b, h) do { _Pragma("unroll") for (int n = 0; n < 2; ++n) _Pragma("unroll") for (int k = 0; k < 2; ++k) dst[n][k] = *(const PG8_LAS bf16x8*)(lds + PG8_SB(b, h) + boff + n * 2048 + k * 1024); } while (0)
#define PG8_MMA(ai, bj, At, Bt) do { __builtin_amdgcn_s_setprio(1); _Pragma("unroll") for (int m = 0; m < 4; ++m) _Pragma("unroll") for (int n = 0; n < 2; ++n) _Pragma("unroll") for (int k = 0; k < 2; ++k) \
        acc[ai][bj][m][n] = __builtin_amdgcn_mfma_f32_16x16x32_bf16(Bt[n][k], At[m][k], acc[ai][bj][m][n], 0, 0, 0); __builtin_amdgcn_s_setprio(0); } while (0)
#define PG8_WAIT_V(n) asm volatile("s_waitcnt vmcnt(" #n ")" ::: "memory")
#define PG8_WAIT_L(n) asm volatile("s_waitcnt lgkmcnt(" #n ")" ::: "memory")
#define PG8_BAR __builtin_amdgcn_s_barrier()
#define PG8_SCHED __builtin_amdgcn_sched_barrier(0)
    Unit cur, nxt; int ui = 0;
    if (!S.next(0, cur)) return;
    f32x4 acc[2][2][4][2];
#pragma unroll
    for (int a = 0; a < 2; ++a)
#pragma unroll
        for (int b = 0; b < 2; ++b)
#pragma unroll
            for (int m = 0; m < 4; ++m)
#pragma unroll
                for (int n = 0; n < 2; ++n) acc[a][b][m][n] = (f32x4){0.f, 0.f, 0.f, 0.f};
    bf16x8 At[4][2], B0[2][2], B1[2][2];
    const char* cA = (const char*)g.A + (size_t)cur.pm * tstep; const char* cB = (const char*)g.Bt + (size_t)cur.pn * tstep;
    S.a_ready(cur);
    if constexpr (SP2) {
        PG8_STAGE(PG8_SB(0, 0), cB, voffB); PG8_STAGE(PG8_SB(0, 1), cB + hstep, voffB); PG8_STAGE(PG8_SA(0, 0), cA, voffA); PG8_STAGE(PG8_SA(0, 1), cA + hstep, voffA);
        if (wr == 1) PG8_BAR;
        PG8_WAIT_V(2); PG8_BAR;
        PG8_STAGE(PG8_SB(1, 0), cB + kstep, voffB); PG8_STAGE(PG8_SA(1, 0), cA + kstep, voffA); PG8_STAGE(PG8_SB(1, 1), cB + hstep + kstep, voffB);
        PG8_WAIT_V(6); PG8_BAR;
    } else {
        PG8_STAGE(PG8_SB(0, 0), cB, voffB); PG8_STAGE(PG8_SA(0, 0), cA, voffA); PG8_STAGE(PG8_SB(0, 1), cB + hstep, voffB); PG8_STAGE(PG8_SA(0, 1), cA + hstep, voffA);
        if (wr == 1) PG8_BAR;
        PG8_WAIT_V(4); PG8_BAR;
        PG8_STAGE(PG8_SB(1, 0), cB + kstep, voffB); PG8_STAGE(PG8_SA(1, 0), cA + kstep, voffA); PG8_STAGE(PG8_SB(1, 1), cB + hstep + kstep, voffB);
        PG8_WAIT_V(6); PG8_BAR;
    }
    for (;;) {
        const bool has_next = S.next(ui + 1, nxt);
        const char* nA = has_next ? (const char*)g.A + (size_t)nxt.pm * tstep : cA; const char* nB = has_next ? (const char*)g.Bt + (size_t)nxt.pn * tstep : cB;
        for (int t = 0; t < nt; t += 2) {
            const bool last = (t == nt - 2);
            const char* a1 = cA + (size_t)(t + 1) * kstep;
            const char* a2 = last ? nA : cA + (size_t)(t + 2) * kstep; const char* b2 = last ? nB : cB + (size_t)(t + 2) * kstep;
            const char* a3 = a2 + kstep; const char* b3 = b2 + kstep;
            if (last && has_next) S.a_ready(nxt);
            if constexpr (SP2) {
            PG8_LDB(B0, 0, 0); PG8_LDB(B1, 0, 1); PG8_SCHED; PG8_LDA(At, 0, 0); PG8_STAGE(PG8_SA(1, 1), a1 + hstep, voffA);
            PG8_WAIT_V(8); PG8_WAIT_L(0); PG8_BAR; PG8_MMA(0, 0, At, B0); PG8_MMA(0, 1, At, B1); PG8_BAR; PG8_SCHED;
            PG8_LDA(At, 0, 1); PG8_STAGE(PG8_SB(0, 0), b2, voffB); PG8_STAGE(PG8_SB(0, 1), b2 + hstep, voffB); PG8_STAGE(PG8_SA(0, 0), a2, voffA);
            PG8_WAIT_V(8); PG8_WAIT_L(0); PG8_BAR; PG8_MMA(1, 0, At, B0); PG8_MMA(1, 1, At, B1); PG8_BAR; PG8_SCHED;
            PG8_LDB(B0, 1, 0); PG8_LDB(B1, 1, 1); PG8_SCHED; PG8_LDA(At, 1, 0); PG8_STAGE(PG8_SA(0, 1), a2 + hstep, voffA);
            PG8_WAIT_V(8); PG8_WAIT_L(0); PG8_BAR; PG8_MMA(0, 0, At, B0); PG8_MMA(0, 1, At, B1); PG8_BAR; PG8_SCHED;
            PG8_LDA(At, 1, 1); PG8_STAGE(PG8_SB(1, 0), b3, voffB); PG8_STAGE(PG8_SB(1, 1), b3 + hstep, voffB); PG8_STAGE(PG8_SA(1, 0), a3, voffA);
            PG8_WAIT_V(8); PG8_WAIT_L(0); PG8_BAR; PG8_MMA(1, 0, At, B0); PG8_MMA(1, 1, At, B1); PG8_BAR; PG8_SCHED;
            } else {
            PG8_LDB(B0, 0, 0); PG8_SCHED; PG8_LDA(At, 0, 0); PG8_STAGE(PG8_SA(1, 1), a1 + hstep, voffA);
            PG8_WAIT_L(8); PG8_BAR; PG8_WAIT_L(0); PG8_MMA(0, 0, At, B0); PG8_BAR; PG8_SCHED;
            PG8_LDB(B1, 0, 1); PG8_STAGE(PG8_SB(0, 0), b2, voffB);
            PG8_BAR; PG8_WAIT_L(0); PG8_MMA(0, 1, At, B1); PG8_BAR;
            PG8_LDA(At, 0, 1); PG8_STAGE(PG8_SA(0, 0), a2, voffA);
            PG8_BAR; PG8_WAIT_L(0); PG8_MMA(1, 0, At, B0); PG8_BAR; PG8_SCHED;
            PG8_STAGE(PG8_SB(0, 1), b2 + hstep, voffB);
            PG8_WAIT_V(6); PG8_BAR; PG8_MMA(1, 1, At, B1); PG8_BAR;
            PG8_LDB(B0, 1, 0); PG8_SCHED; PG8_LDA(At, 1, 0); PG8_STAGE(PG8_SA(0, 1), a2 + hstep, voffA);
            PG8_WAIT_L(8); PG8_BAR; PG8_WAIT_L(0); PG8_MMA(0, 0, At, B0); PG8_BAR; PG8_SCHED;
            PG8_LDB(B1, 1, 1); PG8_STAGE(PG8_SB(1, 0), b3, voffB);
            PG8_BAR; PG8_WAIT_L(0); PG8_MMA(0, 1, At, B1); PG8_BAR;
            PG8_LDA(At, 1, 1); PG8_STAGE(PG8_SA(1, 0), a3, voffA);
            PG8_BAR; PG8_WAIT_L(0); PG8_MMA(1, 0, At, B0); PG8_BAR; PG8_SCHED;
            PG8_STAGE(PG8_SB(1, 1), b3 + hstep, voffB);
            PG8_WAIT_V(6); PG8_BAR; PG8_MMA(1, 1, At, B1); PG8_BAR;
            }
        }
        if constexpr (ALIGN_EPI) { if (wr == 0) PG8_BAR; }
        if constexpr (!Epi::AFTER_DRAIN) { E(acc, cur, wr, wc, fr, fq); S.done(cur); }
        if (!has_next) break;
#pragma unroll
        for (int a = 0; a < 2; ++a)
#pragma unroll
            for (int b = 0; b < 2; ++b)
#pragma unroll
                for (int m = 0; m < 4; ++m)
#pragma unroll
                    for (int n = 0; n < 2; ++n) acc[a][b][m][n] = (f32x4){0.f, 0.f, 0.f, 0.f};
        cur = nxt; cA = nA; cB = nB; ++ui;
        if constexpr (ALIGN_EPI) { if (wr == 1) PG8_BAR; }
    }
    PG8_WAIT_V(0);
    if constexpr (!ALIGN_EPI) { if (wr == 0) PG8_BAR; }
    PG8_BAR;
    if constexpr (Epi::AFTER_DRAIN) { E.fused(acc, cur, wr, wc, fr, fq, lds, wid, lane); S.done(cur); }
#undef PG8_SA
#undef PG8_SB
#undef PG8_STAGE
#undef PG8_LDA
#undef PG8_LDB
#undef PG8_MMA
#undef PG8_WAIT_V
#undef PG8_WAIT_L
#undef PG8_BAR
#undef PG8_SCHED
}
}

#ifndef PG8_SP2
#define PG8_SP2 true
#endif
#ifndef PG8_ALIGN
#define PG8_ALIGN true
#endif
constexpr int BATCH = 8, SEQ = 2048, DM = 1024, MROWS = BATCH * SEQ, DEPTH = 2;
constexpr int D_RNN = 512, NHEAD = 8, HDIM = 64, D_INR = 2760, ZP = 2816, TOPK = 256;
constexpr int C_XR = 0, C_GR = 512, C_Q = 1024, C_K = 1536, C_V = 1600, C_GA = 1664, C_QI = 2176, C_KI = 2688, C_WI = 2752;
constexpr float EPS = 1e-6f;
constexpr size_t MiB = 1u << 20;
constexpr size_t WS_CTL = 0, CTL_ZERO_BYTES = 1 * MiB;
constexpr size_t WS_MOD = 1 * MiB;
constexpr size_t WS_BIAS = 1 * MiB + 256 * 1024;
constexpr size_t WS_SSQ = 2 * MiB;
constexpr size_t WS_WTIN = 3 * MiB;
constexpr size_t WS_WTOUT = 14 * MiB;
constexpr size_t WS_A = 32 * MiB;
constexpr size_t WS_Z = 64 * MiB;
constexpr size_t WS_Y = 152 * MiB;
constexpr size_t WS_END = 184 * MiB;
constexpr int LDS_BYTES = 147456;
constexpr int MISC_OFF = 131072 + 8192;
constexpr int NPHASE = 9;

#define LAS __attribute__((address_space(3)))
typedef unsigned short bf16;
typedef float f32x4 __attribute__((ext_vector_type(4)));
typedef unsigned u32x4 __attribute__((ext_vector_type(4)));
typedef unsigned u32x2 __attribute__((ext_vector_type(2)));
__device__ __forceinline__ float bf2f(bf16 v) { return __uint_as_float(((unsigned)v) << 16); }
__device__ __forceinline__ unsigned f2bf(float f) { unsigned u = __float_as_uint(f); return (u + 0x7fffu + ((u >> 16) & 1u)) >> 16; }
__device__ __forceinline__ unsigned pk2(float lo, float hi) { return f2bf(lo) | (f2bf(hi) << 16); }
__device__ __forceinline__ float wave_sum(float v) {
#pragma unroll
    for (int o = 1; o < 64; o <<= 1) v += __shfl_xor(v, o);
    return v;
}
__device__ __forceinline__ float wave_max(float v) {
#pragma unroll
    for (int o = 1; o < 64; o <<= 1) v = fmaxf(v, __shfl_xor(v, o));
    return v;
}
__device__ __forceinline__ int wave_sum_i(int v) {
#pragma unroll
    for (int o = 1; o < 64; o <<= 1) v += __shfl_xor(v, o);
    return v;
}
__device__ __forceinline__ float siluf(float v) { return v / (1.f + expf(-v)); }
__device__ __forceinline__ float sigmf(float v) { return 1.f / (1.f + expf(-v)); }

struct P {
    const float *x, *c, *norm_g, *ada_w, *ada_b, *w_in, *conv_w, *conv_b, *lru_wx, *lru_bx, *lru_wa, *lru_ba, *lru_a, *w_out, *final_g;
    float* out;
    float *mod, *bias, *ssq;
    bf16 *wt_in, *wt_out, *A, *Z, *Y;
    unsigned* ctl;
};

struct EpiZ {
    static constexpr bool PERM = true, AFTER_DRAIN = false;
    bf16* Zp; const float* ssq; const float* bias;
    __device__ __forceinline__ void operator()(const pg8::f32x4 (&acc)[2][2][4][2], const pg8::Unit& u, int wr, int wc, int fr, int fq) const {
        const int row0 = u.pm * 256 + wr * 64 + fr, col0 = u.pn * 256 + wc * 32 + 8 * fq, b = u.pm >> 3;
        f32x4 bv[2][2];
#pragma unroll
        for (int bj = 0; bj < 2; ++bj)
#pragma unroll
            for (int n = 0; n < 2; ++n) bv[bj][n] = *(const f32x4*)(bias + b * ZP + col0 + bj * 128 + 4 * n);
#pragma unroll
        for (int ai = 0; ai < 2; ++ai)
#pragma unroll
            for (int m = 0; m < 4; ++m) {
                const int r = row0 + ai * 128 + m * 16;
                const f32x4 q = *(const f32x4*)(ssq + (size_t)r * 4);
                const float rstd = 1.0f / sqrtf(((q.x + q.y) + (q.z + q.w)) * (1.0f / 1024.0f) + EPS);
                bf16* rowp = Zp + (size_t)r * ZP + col0;
#pragma unroll
                for (int bj = 0; bj < 2; ++bj) {
                    const f32x4 v0 = acc[ai][bj][m][0] * rstd + bv[bj][0], v1 = acc[ai][bj][m][1] * rstd + bv[bj][1];
                    u32x4 w; w.x = pk2(v0[0], v0[1]); w.y = pk2(v0[2], v0[3]); w.z = pk2(v1[0], v1[1]); w.w = pk2(v1[2], v1[3]);
                    *(u32x4*)(rowp + bj * 128) = w;
                }
            }
    }
};
struct EpiX {
    static constexpr bool PERM = true, AFTER_DRAIN = true;
    const float* xres; float* xout; bf16* Anext; const float* gate; const float* ng; const float* nscale; float* ssq;
    __device__ __forceinline__ void fused(pg8::f32x4 (&acc)[2][2][4][2], const pg8::Unit& u, int wr, int wc, int fr, int fq, LAS unsigned char* lds, int wid, int lane) const {
        const int b = u.pm >> 3, col0 = u.pn * 256 + wc * 32 + 8 * fq;
        LAS float* Pp = (LAS float*)lds;
        f32x4 gv[2][2], gs[2][2];
#pragma unroll
        for (int bj = 0; bj < 2; ++bj)
#pragma unroll
            for (int n = 0; n < 2; ++n) {
                gv[bj][n] = *(const f32x4*)(gate + b * 3072 + col0 + bj * 128 + 4 * n);
                if (Anext) { const f32x4 g = *(const f32x4*)(ng + col0 + bj * 128 + 4 * n), s = *(const f32x4*)(nscale + b * 3072 + col0 + bj * 128 + 4 * n); gs[bj][n] = g * (s + 1.0f); }
                else gs[bj][n] = (f32x4){0.f, 0.f, 0.f, 0.f};
            }
#pragma unroll
        for (int ai = 0; ai < 2; ++ai)
#pragma unroll
            for (int m = 0; m < 4; ++m) {
                const int rl = ai * 128 + wr * 64 + m * 16 + fr; const size_t r = (size_t)u.pm * 256 + rl;
                float s = 0.f;
#pragma unroll
                for (int bj = 0; bj < 2; ++bj) {
                    f32x4 x1[2];
#pragma unroll
                    for (int n = 0; n < 2; ++n) {
                        const f32x4 xr = *(const f32x4*)(xres + r * DM + col0 + bj * 128 + 4 * n);
                        x1[n] = xr + gv[bj][n] * acc[ai][bj][m][n];
                        *(f32x4*)(xout + r * DM + col0 + bj * 128 + 4 * n) = x1[n];
                        s += (x1[n][0] * x1[n][0] + x1[n][1] * x1[n][1]) + (x1[n][2] * x1[n][2] + x1[n][3] * x1[n][3]);
                    }
                    if (Anext) { const f32x4 a0 = x1[0] * gs[bj][0], a1 = x1[1] * gs[bj][1];
                        u32x4 w; w.x = pk2(a0[0], a0[1]); w.y = pk2(a0[2], a0[3]); w.z = pk2(a1[0], a1[1]); w.w = pk2(a1[2], a1[3]);
                        *(u32x4*)(Anext + r * DM + col0 + bj * 128) = w; }
                }
                s += __shfl_xor(s, 16); s += __shfl_xor(s, 32);
                if (fq == 0) Pp[rl * 4 + wc] = s;
            }
        __syncthreads();
        const int tid = wid * 64 + lane;
        if (tid < 256) ssq[((size_t)u.pm * 256 + tid) * 4 + u.pn] = (Pp[tid * 4 + 0] + Pp[tid * 4 + 1]) + (Pp[tid * 4 + 2] + Pp[tid * 4 + 3]);
        __syncthreads();
    }
};

__device__ __forceinline__ void ph0_prologue(const P& p, LAS unsigned char* lds) {
    const int tid = threadIdx.x, lane = tid & 63, wave = tid >> 6, G = gridDim.x, wg = blockIdx.x;
    LAS float* fl = (LAS float*)lds;
    for (int u = wg; u < 96; u += G) {
        const int l = u / 48, j = (u % 48) * 64 + lane;
        for (int i = tid; i < 8192; i += 512) fl[i] = siluf(p.c[i]);
        __syncthreads();
        float acc[8];
#pragma unroll
        for (int b = 0; b < 8; ++b) acc[b] = 0.f;
        const float* w = p.ada_w + ((size_t)l * 1024 + wave * 128) * 3072 + j;
        for (int k = 0; k < 128; ++k) { const float wv = w[(size_t)k * 3072];
#pragma unroll
            for (int b = 0; b < 8; ++b) acc[b] += fl[b * 1024 + wave * 128 + k] * wv; }
#pragma unroll
        for (int b = 0; b < 8; ++b) fl[8192 + (wave * 8 + b) * 64 + lane] = acc[b];
        __syncthreads();
        { const int b = wave; float s = p.ada_b[l * 3072 + j];
#pragma unroll
          for (int w8 = 0; w8 < 8; ++w8) s += fl[8192 + (w8 * 8 + b) * 64 + lane];
          p.mod[(l * 8 + b) * 3072 + j] = s; }
        __syncthreads();
    }
    for (int u = wg; u < 1920; u += G) {
        const float* W; bf16* WT; int N, kt, nt;
        if (u < 1408) { const int l = u / 704, r = u % 704; kt = r / 44; nt = r % 44; W = p.w_in + (size_t)l * 1024 * D_INR; N = D_INR; WT = p.wt_in + (size_t)l * ZP * 1024; }
        else { int r = u - 1408; const int l = r / 256; r %= 256; kt = r / 16; nt = r % 16; W = p.w_out + (size_t)l * 1024 * 1024; N = 1024; WT = p.wt_out + (size_t)l * 1024 * 1024; }
#pragma unroll
        for (int i = 0; i < 8; ++i) { const int kk = wave + 8 * i, n = nt * 64 + lane; fl[kk * 65 + lane] = (n < N) ? W[(size_t)(kt * 64 + kk) * N + n] : 0.f; }
        __syncthreads();
        { const int n = tid >> 3, ks = tid & 7; u32x4 o;
          o.x = pk2(fl[(ks * 8 + 0) * 65 + n], fl[(ks * 8 + 1) * 65 + n]); o.y = pk2(fl[(ks * 8 + 2) * 65 + n], fl[(ks * 8 + 3) * 65 + n]);
          o.z = pk2(fl[(ks * 8 + 4) * 65 + n], fl[(ks * 8 + 5) * 65 + n]); o.w = pk2(fl[(ks * 8 + 6) * 65 + n], fl[(ks * 8 + 7) * 65 + n]);
          *(u32x4*)(WT + (size_t)(nt * 64 + n) * 1024 + kt * 64 + ks * 8) = o; }
        __syncthreads();
    }
    for (int r = wg * 8 + wave; r < MROWS; r += G * 8) {
        const f32x4* xr = (const f32x4*)(p.x + (size_t)r * DM) + lane; float s = 0.f;
#pragma unroll
        for (int j = 0; j < 4; ++j) { const f32x4 v = xr[64 * j]; s += (v[0] * v[0] + v[1] * v[1]) + (v[2] * v[2] + v[3] * v[3]); }
        s = wave_sum(s);
        if (lane == 0) *(f32x4*)(p.ssq + (size_t)r * 4) = (f32x4){s, 0.f, 0.f, 0.f};
    }
}
__device__ __forceinline__ void ph1_prologue(const P& p, LAS unsigned char* lds) {
    const int tid = threadIdx.x, lane = tid & 63, wave = tid >> 6, G = gridDim.x, wg = blockIdx.x;
    LAS float* fl = (LAS float*)lds;
    for (int u = wg; u < 88; u += G) {
        const int l = u / 44, n = (u % 44) * 64 + lane;
        for (int i = tid; i < 8192; i += 512) fl[i] = p.mod[(l * 8 + (i >> 10)) * 3072 + (i & 1023)];
        __syncthreads();
        float acc[8];
#pragma unroll
        for (int b = 0; b < 8; ++b) acc[b] = 0.f;
        if (n < D_INR) { const float* w = p.w_in + ((size_t)l * 1024 + wave * 128) * D_INR + n;
            for (int k = 0; k < 128; ++k) { const float wv = w[(size_t)k * D_INR];
#pragma unroll
                for (int b = 0; b < 8; ++b) acc[b] += fl[b * 1024 + wave * 128 + k] * wv; } }
#pragma unroll
        for (int b = 0; b < 8; ++b) fl[8192 + (wave * 8 + b) * 64 + lane] = acc[b];
        __syncthreads();
        { const int b = wave; float s = 0.f;
#pragma unroll
          for (int w8 = 0; w8 < 8; ++w8) s += fl[8192 + (w8 * 8 + b) * 64 + lane];
          p.bias[(l * 8 + b) * ZP + n] = s; }
        __syncthreads();
    }
    for (int r = wg * 8 + wave; r < MROWS; r += G * 8) {
        const int b = r >> 11;
#pragma unroll
        for (int j = 0; j < 4; ++j) { const int k = (lane + 64 * j) * 4;
            const f32x4 v = *(const f32x4*)(p.x + (size_t)r * DM + k), g = *(const f32x4*)(p.norm_g + k), sc = *(const f32x4*)(p.mod + (size_t)b * 3072 + 1024 + k);
            const f32x4 o = v * g * (sc + 1.0f); u32x2 w; w.x = pk2(o[0], o[1]); w.y = pk2(o[2], o[3]);
            *(u32x2*)(p.A + (size_t)r * DM + k) = w; }
    }
}
__device__ __forceinline__ void ph_final(const P& p) {
    const int tid = threadIdx.x, lane = tid & 63, wave = tid >> 6, G = gridDim.x, wg = blockIdx.x;
    for (int r = wg * 8 + wave; r < MROWS; r += G * 8) {
        const f32x4 q = *(const f32x4*)(p.ssq + (size_t)r * 4);
        const float rstd = 1.0f / sqrtf(((q.x + q.y) + (q.z + q.w)) * (1.0f / 1024.0f) + EPS);
#pragma unroll
        for (int j = 0; j < 4; ++j) { const int k = (lane + 64 * j) * 4;
            const f32x4 v = *(const f32x4*)(p.out + (size_t)r * DM + k), g = *(const f32x4*)(p.final_g + k);
            *(f32x4*)(p.out + (size_t)r * DM + k) = v * rstd * g; }
    }
}
__device__ __forceinline__ unsigned score_ukey(float s) { const unsigned u = __float_as_uint(s + 0.0f); return (u & 0x80000000u) ? ~u : (u | 0x80000000u); }
__device__ __forceinline__ void topk_threshold(const unsigned (&k)[32], unsigned& thr, unsigned& need) {
    unsigned prefix = 0u; bool exact = false;
    for (int bit = 31; bit >= 0; --bit) {
        const unsigned cand = prefix | (1u << bit);
        int c = 0;
#pragma unroll
        for (int i = 0; i < 32; ++i) c += (k[i] >= cand) ? 1 : 0;
        c = wave_sum_i(c);
        if (c >= TOPK) prefix = cand;
        if (c == TOPK) { exact = true; break; }
    }
    thr = prefix;
    if (exact) { need = 0xffffffffu; }
    else { int c = 0;
#pragma unroll
        for (int i = 0; i < 32; ++i) c += (k[i] > prefix) ? 1 : 0;
        c = wave_sum_i(c); need = (unsigned)(TOPK - c); }
}
__device__ __forceinline__ void lru_naive(const P& p, int l, LAS unsigned char* lds) {
    const int tid = threadIdx.x, lane = tid & 63, wave = tid >> 6, G = gridDim.x, wg = blockIdx.x;
    LAS float* wxl = (LAS float*)lds; LAS float* wal = wxl + 4096; LAS float* sm = wal + 4096;
    for (int u = wg; u < 64; u += G) {
        const int b = u >> 3, blk = u & 7, dg = blk * 64 + lane;
        for (int i = tid; i < 4096; i += 512) { wxl[i] = p.lru_wx[((size_t)l * 8 + blk) * 4096 + i]; wal[i] = p.lru_wa[((size_t)l * 8 + blk) * 4096 + i]; }
        __syncthreads();
        const float cw0 = p.conv_w[(l * 4 + 0) * 512 + dg], cw1 = p.conv_w[(l * 4 + 1) * 512 + dg], cw2 = p.conv_w[(l * 4 + 2) * 512 + dg], cw3 = p.conv_w[(l * 4 + 3) * 512 + dg];
        const float cb = p.conv_b[l * 512 + dg], bx = p.lru_bx[l * 512 + dg], ba = p.lru_ba[l * 512 + dg];
        const float sp = log1pf(expf(-p.lru_a[l * 512 + dg]));
        const int t0 = wave * 256; const bf16* zb = p.Z + (size_t)b * SEQ * ZP;
        float carry = 0.f;
        for (int pass = 0; pass < 2; ++pass) {
            float h = carry, Pc = 1.f;
            float xm3 = 0.f, xm2 = 0.f, xm1 = 0.f;
            if (t0 > 0) { xm3 = bf2f(zb[(size_t)(t0 - 3) * ZP + C_XR + dg]); xm2 = bf2f(zb[(size_t)(t0 - 2) * ZP + C_XR + dg]); xm1 = bf2f(zb[(size_t)(t0 - 1) * ZP + C_XR + dg]); }
            for (int t = t0; t < t0 + 256; ++t) {
                const float x0 = bf2f(zb[(size_t)t * ZP + C_XR + dg]);
                const float xc = cb + cw0 * xm3 + cw1 * xm2 + cw2 * xm1 + cw3 * x0;
                xm3 = xm2; xm2 = xm1; xm1 = x0;
                float gx = bx, ga = ba;
#pragma unroll 8
                for (int c = 0; c < 64; ++c) { const float xcc = __shfl(xc, c); gx += xcc * wxl[c * 64 + lane]; ga += xcc * wal[c * 64 + lane]; }
                const float la = -8.0f * sigmf(ga) * sp, a = expf(la), mult = sqrtf(-expm1f(2.0f * la));
                h = a * h + mult * sigmf(gx) * xc; Pc *= a;
                if (pass == 1) { const float gr = bf2f(zb[(size_t)t * ZP + C_GR + dg]); p.Y[((size_t)b * SEQ + t) * DM + dg] = (bf16)f2bf(h * siluf(gr)); }
            }
            if (pass == 0) {
                sm[(wave * 64 + lane) * 2 + 0] = Pc; sm[(wave * 64 + lane) * 2 + 1] = h;
                __syncthreads();
                float hc = 0.f;
                for (int w2 = 0; w2 < wave; ++w2) hc = sm[(w2 * 64 + lane) * 2 + 0] * hc + sm[(w2 * 64 + lane) * 2 + 1];
                carry = hc;
            }
        }
        __syncthreads();
    }
}
__device__ __forceinline__ void dsa_naive(const P& p, LAS unsigned char* lds) {
    const int tid = threadIdx.x, lane = tid & 63, wave = tid >> 6, G = gridDim.x, wg = blockIdx.x;
    LAS float* QI = (LAS float*)lds; LAS float* QV = QI + 512; LAS float* WIv = QV + 512; LAS float* INV = WIv + 8;
    LAS float* SC = INV + 8;
    LAS float* LG = SC + 2048;
    LAS unsigned short* SEL = (LAS unsigned short*)(LG + 2048);
    for (int r = wg; r < MROWS; r += G) {
        const int b = r >> 11, t = r & 2047; const bf16* zr = p.Z + (size_t)r * ZP; const bf16* zb = p.Z + (size_t)b * SEQ * ZP;
        QI[tid] = bf2f(zr[C_QI + tid]); QV[tid] = bf2f(zr[C_Q + tid]);
        if (tid < 8) WIv[tid] = bf2f(zr[C_WI + tid]) * 0.35355339059327373f;
        __syncthreads();
        int nsel;
        if (t < TOPK) { if (tid <= t) SEL[tid] = (unsigned short)tid; nsel = t + 1; }
        else {
            for (int s = tid; s <= t; s += 512) {
                const u32x4* kr = (const u32x4*)(zb + (size_t)s * ZP + C_KI); float kv[64];
#pragma unroll
                for (int i = 0; i < 8; ++i) { const u32x4 w = kr[i];
                    kv[8 * i + 0] = __uint_as_float(w.x << 16); kv[8 * i + 1] = __uint_as_float(w.x & 0xffff0000u); kv[8 * i + 2] = __uint_as_float(w.y << 16); kv[8 * i + 3] = __uint_as_float(w.y & 0xffff0000u);
                    kv[8 * i + 4] = __uint_as_float(w.z << 16); kv[8 * i + 5] = __uint_as_float(w.z & 0xffff0000u); kv[8 * i + 6] = __uint_as_float(w.w << 16); kv[8 * i + 7] = __uint_as_float(w.w & 0xffff0000u); }
                float sc = 0.f;
                for (int h = 0; h < 8; ++h) { float dot = 0.f;
#pragma unroll
                    for (int d = 0; d < 64; ++d) dot += QI[h * 64 + d] * kv[d];
                    sc += fmaxf(dot * 0.125f, 0.f) * WIv[h]; }
                SC[s] = sc;
            }
            __syncthreads();
            if (wave == 0) {
                unsigned k[32];
#pragma unroll
                for (int i = 0; i < 32; ++i) { const int key = lane + 64 * i; k[i] = (key <= t) ? score_ukey(SC[key]) : 0u; }
                unsigned thr, need; topk_threshold(k, thr, need);
                unsigned base = 0u, eqbase = 0u;
#pragma unroll
                for (int i = 0; i < 32; ++i) {
                    const bool eq = (k[i] == thr);
                    const unsigned long long em = __ballot(eq);
                    const unsigned erank = eqbase + __builtin_amdgcn_mbcnt_hi((unsigned)(em >> 32), __builtin_amdgcn_mbcnt_lo((unsigned)em, 0u));
                    const bool sel = (k[i] > thr) || (eq && erank < need);
                    const unsigned long long smk = __ballot(sel);
                    const unsigned pos = base + __builtin_amdgcn_mbcnt_hi((unsigned)(smk >> 32), __builtin_amdgcn_mbcnt_lo((unsigned)smk, 0u));
                    if (sel && pos < TOPK) SEL[pos] = (unsigned short)(lane + 64 * i);
                    base += (unsigned)__popcll(smk); eqbase += (unsigned)__popcll(em);
                }
            }
            nsel = TOPK;
        }
        __syncthreads();
        if (tid < nsel) {
            const int key = SEL[tid]; const u32x4* kr = (const u32x4*)(zb + (size_t)key * ZP + C_K); float kv[64];
#pragma unroll
            for (int i = 0; i < 8; ++i) { const u32x4 w = kr[i];
                kv[8 * i + 0] = __uint_as_float(w.x << 16); kv[8 * i + 1] = __uint_as_float(w.x & 0xffff0000u); kv[8 * i + 2] = __uint_as_float(w.y << 16); kv[8 * i + 3] = __uint_as_float(w.y & 0xffff0000u);
                kv[8 * i + 4] = __uint_as_float(w.z << 16); kv[8 * i + 5] = __uint_as_float(w.z & 0xffff0000u); kv[8 * i + 6] = __uint_as_float(w.w << 16); kv[8 * i + 7] = __uint_as_float(w.w & 0xffff0000u); }
            for (int h = 0; h < 8; ++h) { float dot = 0.f;
#pragma unroll
                for (int d = 0; d < 64; ++d) dot += QV[h * 64 + d] * kv[d];
                LG[h * 256 + tid] = dot * 0.125f; }
        }
        __syncthreads();
        { const int h = wave; float mx = -INFINITY;
          for (int j = lane; j < nsel; j += 64) mx = fmaxf(mx, LG[h * 256 + j]);
          mx = wave_max(mx); float sum = 0.f;
          for (int j = lane; j < nsel; j += 64) { const float e = expf(LG[h * 256 + j] - mx); LG[h * 256 + j] = e; sum += e; }
          sum = wave_sum(sum); if (lane == 0) INV[h] = 1.0f / sum; }
        __syncthreads();
        { const int h = wave; float o = 0.f;
          for (int j = 0; j < nsel; ++j) { const int key = SEL[j]; o += LG[h * 256 + j] * bf2f(zb[(size_t)key * ZP + C_V + lane]); }
          o *= INV[h]; const float ga = bf2f(zr[C_GA + h * 64 + lane]);
          p.Y[(size_t)r * DM + 512 + h * 64 + lane] = (bf16)f2bf(o * siluf(ga)); }
        __syncthreads();
    }
}
struct Args { const float* in[15]; float* out; unsigned char* ws; int ph_lo, ph_hi; };
__global__ void __launch_bounds__(512, 2) mega(Args a) {
    extern __shared__ __attribute__((aligned(16))) unsigned char lds_raw[];
    LAS unsigned char* lds = (LAS unsigned char*)lds_raw;
    P p;
    p.x = a.in[0]; p.c = a.in[1]; p.norm_g = a.in[2]; p.ada_w = a.in[3]; p.ada_b = a.in[4]; p.w_in = a.in[5]; p.conv_w = a.in[6]; p.conv_b = a.in[7];
    p.lru_wx = a.in[8]; p.lru_bx = a.in[9]; p.lru_wa = a.in[10]; p.lru_ba = a.in[11]; p.lru_a = a.in[12]; p.w_out = a.in[13]; p.final_g = a.in[14];
    p.out = a.out; unsigned char* ws = a.ws;
    p.ctl = (unsigned*)(ws + WS_CTL); p.mod = (float*)(ws + WS_MOD); p.bias = (float*)(ws + WS_BIAS); p.ssq = (float*)(ws + WS_SSQ);
    p.wt_in = (bf16*)(ws + WS_WTIN); p.wt_out = (bf16*)(ws + WS_WTOUT); p.A = (bf16*)(ws + WS_A); p.Z = (bf16*)(ws + WS_Z); p.Y = (bf16*)(ws + WS_Y);
    const int lo = a.ph_lo, hi = a.ph_hi;
#define IN(k) (lo <= (k) && (k) < hi)
#define SEAM(k) do { if (IN(k) && IN((k) + 1)) { cg::this_grid().sync(); } } while (0)
    if (IN(0)) ph0_prologue(p, lds);
    SEAM(0);
    if (IN(1)) ph1_prologue(p, lds);
    SEAM(1);
#define LAYER(l, base) \
    if (IN(base)) { \
        pg8::Gemm g{p.A, p.wt_in + (size_t)(l) * ZP * 1024, MROWS, ZP, DM}; pg8::StaticOrder S; S.init(MROWS, ZP, (int)gridDim.x, (int)blockIdx.x); \
        EpiZ E{p.Z, p.ssq, p.bias + (size_t)(l) * 8 * ZP}; \
        pg8::gemm_phase<EpiZ, pg8::StaticOrder, PG8_ALIGN, PG8_SP2>(lds, g, S, E); \
    } \
    SEAM(base); \
    if (IN((base) + 1)) { lru_naive(p, (l), lds); __syncthreads(); dsa_naive(p, lds); } \
    SEAM((base) + 1); \
    if (IN((base) + 2)) { \
        pg8::Gemm g{p.Y, p.wt_out + (size_t)(l) * 1024 * 1024, MROWS, DM, DM}; pg8::StaticOrder S; S.init(MROWS, DM, (int)gridDim.x, (int)blockIdx.x); \
        constexpr bool last = ((l) == DEPTH - 1); \
        EpiX E{(l) == 0 ? p.x : p.out, p.out, last ? nullptr : p.A, p.mod + (size_t)(l) * 8 * 3072 + 2048, \
               last ? nullptr : p.norm_g + (size_t)((l) + 1) * 1024, last ? nullptr : p.mod + (size_t)((l) + 1) * 8 * 3072 + 1024, p.ssq}; \
        pg8::gemm_phase<EpiX, pg8::StaticOrder, false, PG8_SP2>(lds, g, S, E); \
    } \
    SEAM((base) + 2);
    LAYER(0, 2)
    LAYER(1, 5)
    if (IN(8)) ph_final(p);
}
#ifndef MK_N_LAUNCHES
#define MK_N_LAUNCHES 9
#endif
extern "C" void kernel_launch(void* const* d_in, const int* in_sizes, int n_in, void* d_out, int out_size, void* d_ws, size_t ws_size, hipStream_t stream) {
    static int grid = 0;
    if (grid == 0) {
        if (n_in != 15 || out_size != MROWS * DM || ws_size < WS_END) { fprintf(stderr, "kernel_launch: unexpected problem (n_in %d out %d ws %zu)\n", n_in, out_size, ws_size); grid = -1; return; }
        int dev = 0, cus = 0, per_cu = 0;
        hipGetDevice(&dev); hipDeviceGetAttribute(&cus, hipDeviceAttributeMultiprocessorCount, dev);
        if (hipFuncSetAttribute((const void*)mega, hipFuncAttributeMaxDynamicSharedMemorySize, LDS_BYTES) != hipSuccess) { fprintf(stderr, "kernel_launch: hipFuncSetAttribute failed\n"); grid = -1; return; }
        if (hipOccupancyMaxActiveBlocksPerMultiprocessor(&per_cu, (const void*)mega, 512, LDS_BYTES) != hipSuccess || per_cu < 1) { fprintf(stderr, "kernel_launch: occupancy query failed (%d)\n", per_cu); per_cu = 1; }
        (void)hipGetLastError();
        grid = cus * per_cu;
        if (grid != 256) fprintf(stderr, "kernel_launch: grid %d (cus %d x %d) != 256: the fused out-projection epilogue needs exactly 256 workgroups\n", grid, cus, per_cu);
    }
    if (grid < 0) return;
    hipMemsetAsync((char*)d_ws + WS_CTL, 0, CTL_ZERO_BYTES, stream);
    Args a{};
    for (int i = 0; i < 15; ++i) a.in[i] = (const float*)d_in[i];
    a.out = (float*)d_out; a.ws = (unsigned char*)d_ws;
#if MK_N_LAUNCHES == 1
    a.ph_lo = 0; a.ph_hi = NPHASE;
    void* args[] = {&a};
    hipError_t e = hipLaunchCooperativeKernel((const void*)mega, dim3(grid), dim3(512), args, LDS_BYTES, stream);
    if (e != hipSuccess) fprintf(stderr, "cooperative launch failed: %s (grid %d)\n", hipGetErrorString(e), grid);
#else
    for (int ph = 0; ph < NPHASE; ++ph) { a.ph_lo = ph; a.ph_hi = ph + 1; hipLaunchKernelGGL(mega, dim3(grid), dim3(512), LDS_BYTES, stream, a); }
#endif
}
```

```cpp
#include <hip/hip_runtime.h>
#include <hip/hip_cooperative_groups.h>
#include <cstdio>
#include <cstdint>
#include <cmath>
namespace cg = cooperative_groups;

namespace pg8 {
#define PG8_LAS __attribute__((address_space(3)))
typedef unsigned short bf16_t;
typedef short bf16x8 __attribute__((ext_vector_type(8)));
typedef float f32x4 __attribute__((ext_vector_type(4)));
typedef unsigned u32x4 __attribute__((ext_vector_type(4)));
constexpr int BM = 256, BK = 64, HALF = 128, HTB = HALF * BK * 2  , STAGE_BYTES = 8 * HTB, NXCD = 8, WGM = 8;

__host__ __device__ __forceinline__ int lds_byte(int r, int c) { const int st = (r >> 4) * 2 + (c >> 5), rr = r & 15, cc = c & 31, ob = rr * 64 + cc * 2; return st * 1024 + (ob ^ (((ob >> 9) & 1) << 5)); }
__host__ __device__ __forceinline__ void stage_rc(int b, int& R, int& C) { const int st = b / 1024, sb = b % 1024, swz = sb ^ (((sb >> 9) & 1) << 5); R = (st >> 1) * 16 + swz / 64; C = (st & 1) * 32 + (swz % 64) / 2; }
__host__ __device__ __forceinline__ int perm32(int rho) { const int n = rho >> 4, i = rho & 15; return 8 * (i >> 2) + 4 * n + (i & 3); }

struct Unit { int pm, pn; };
struct Gemm { const bf16_t* A; const bf16_t* Bt; int M, N, K; };

struct StaticOrder {
    int nM, nN, nwg, G, c;
    __host__ __device__ void init(int M, int N, int G_, int c_) { nM = M / BM; nN = N / BM; nwg = nM * nN; G = G_; c = c_; }
    __host__ __device__ bool next(int i, Unit& u) const {
        const long L = (long)i * G + c; if (L >= nwg) return false;
        int wgid = (int)L; { const int q = nwg / NXCD, r = nwg % NXCD, xcd = wgid % NXCD, off = wgid / NXCD; wgid = (xcd < r ? xcd * (q + 1) : r * (q + 1) + (xcd - r) * q) + off; }
        const int nig = WGM * nN, gid = wgid / nig, fm = gid * WGM, gsz = (nM - fm) < WGM ? (nM - fm) : WGM;
        u.pm = fm + ((wgid % nig) % gsz); u.pn = (wgid % nig) / gsz; return true;
    }
    __device__ __forceinline__ void a_ready(const Unit&) const {}
    __device__ __forceinline__ void done(const Unit&) const {}
};

__device__ __forceinline__ unsigned cvt_pk_bf16(float lo, float hi) { unsigned r; asm volatile("v_cvt_pk_bf16_f32 %0, %1, %2" : "=v"(r) : "v"(lo), "v"(hi)); return r; }
typedef float f32x2 __attribute__((ext_vector_type(2)));
template <class Epi, class Sched, bool ALIGN_EPI = false, bool SP2 = false>
__device__ __forceinline__ void gemm_phase(PG8_LAS unsigned char* lds, const Gemm g, const Sched& S, const Epi& E) {
    const int tid = threadIdx.x, wid = __builtin_amdgcn_readfirstlane(tid >> 6), lane = tid & 63, wr = wid >> 2, wc = wid & 3, fr = lane & 15, fq = lane >> 4;
    const int K = g.K, nt = K / BK;
    unsigned voffA[2], voffB[2];
#pragma unroll
    for (int i = 0; i < 2; ++i) { int R, C; stage_rc(tid * 16 + i * 8192, R, C); const int Rb = Epi::PERM ? ((R & ~31) + perm32(R & 31)) : R;
        voffA[i] = (unsigned)(R * K + C) * 2u; voffB[i] = (unsigned)(Rb * K + C) * 2u; }
    const size_t kstep = (size_t)(BK * 2);
    const size_t hstep = (size_t)HALF * K * 2;
    const size_t tstep = 2 * hstep;
    const unsigned ldsw = (unsigned)wid * 1024u;
    const int aoff = lds_byte(wr * 64 + fr, fq * 8), boff = lds_byte(wc * 32 + fr, fq * 8);
#define PG8_SA(b, h) (((b) * 2 + (h)) * HTB)
#define PG8_SB(b, h) ((4 + (b) * 2 + (h)) * HTB)
#define PG8_STAGE(bufoff, gbase, voff) do { _Pragma("unroll") for (int _i = 0; _i < 2; ++_i) \
        __builtin_amdgcn_global_load_lds((const unsigned*)((const char*)(gbase) + (voff)[_i]), (PG8_LAS unsigned*)(lds + (bufoff) + ldsw + _i * 8192), 16, 0, 0); } while (0)
#define PG8_LDA(dst, b, h) do { _Pragma("unroll") for (int m = 0; m < 4; ++m) _Pragma("unroll") for (int k = 0; k < 2; ++k) dst[m][k] = *(const PG8_LAS bf16x8*)(lds + PG8_SA(b, h) + aoff + m * 2048 + k * 1024); } while (0)
#define PG8_LDB(dst, b, h) do { _Pragma("unroll") for (int n = 0; n < 2; ++n) _Pragma("unroll") for (int k = 0; k < 2; ++k) dst[n][k] = *(const PG8_LAS bf16x8*)(lds + PG8_SB(b, h) + boff + n * 2048 + k * 1024); } while (0)
#define PG8_MMA(ai, bj, At, Bt) do { __builtin_amdgcn_s_setprio(1); _Pragma("unroll") for (int m = 0; m < 4; ++m) _Pragma("unroll") for (int n = 0; n < 2; ++n) _Pragma("unroll") for (int k = 0; k < 2; ++k) \
        acc[ai][bj][m][n] = __builtin_amdgcn_mfma_f32_16x16x32_bf16(Bt[n][k], At[m][k], acc[ai][bj][m][n], 0, 0, 0); __builtin_amdgcn_s_setprio(0); } while (0)
#define PG8_WAIT_V(n) asm volatile("s_waitcnt vmcnt(" #n ")" ::: "memory")
#define PG8_WAIT_L(n) asm volatile("s_waitcnt lgkmcnt(" #n ")" ::: "memory")
#define PG8_BAR __builtin_amdgcn_s_barrier()
#define PG8_SCHED __builtin_amdgcn_sched_barrier(0)
    Unit cur, nxt; int ui = 0;
    if (!S.next(0, cur)) return;
    f32x4 acc[2][2][4][2];
#pragma unroll
    for (int a = 0; a < 2; ++a)
#pragma unroll
        for (int b = 0; b < 2; ++b)
#pragma unroll
            for (int m = 0; m < 4; ++m)
#pragma unroll
                for (int n = 0; n < 2; ++n) acc[a][b][m][n] = (f32x4){0.f, 0.f, 0.f, 0.f};
    bf16x8 At[4][2], B0[2][2], B1[2][2];
    const char* cA = (const char*)g.A + (size_t)cur.pm * tstep; const char* cB = (const char*)g.Bt + (size_t)cur.pn * tstep;
    S.a_ready(cur);
    if constexpr (SP2) {
        PG8_STAGE(PG8_SB(0, 0), cB, voffB); PG8_STAGE(PG8_SB(0, 1), cB + hstep, voffB); PG8_STAGE(PG8_SA(0, 0), cA, voffA); PG8_STAGE(PG8_SA(0, 1), cA + hstep, voffA);
        if (wr == 1) PG8_BAR;
        PG8_WAIT_V(2); PG8_BAR;
        PG8_STAGE(PG8_SB(1, 0), cB + kstep, voffB); PG8_STAGE(PG8_SA(1, 0), cA + kstep, voffA); PG8_STAGE(PG8_SB(1, 1), cB + hstep + kstep, voffB);
        PG8_WAIT_V(6); PG8_BAR;
    } else {
        PG8_STAGE(PG8_SB(0, 0), cB, voffB); PG8_STAGE(PG8_SA(0, 0), cA, voffA); PG8_STAGE(PG8_SB(0, 1), cB + hstep, voffB); PG8_STAGE(PG8_SA(0, 1), cA + hstep, voffA);
        if (wr == 1) PG8_BAR;
        PG8_WAIT_V(4); PG8_BAR;
        PG8_STAGE(PG8_SB(1, 0), cB + kstep, voffB); PG8_STAGE(PG8_SA(1, 0), cA + kstep, voffA); PG8_STAGE(PG8_SB(1, 1), cB + hstep + kstep, voffB);
        PG8_WAIT_V(6); PG8_BAR;
    }
    for (;;) {
        const bool has_next = S.next(ui + 1, nxt);
        const char* nA = has_next ? (const char*)g.A + (size_t)nxt.pm * tstep : cA; const char* nB = has_next ? (const char*)g.Bt + (size_t)nxt.pn * tstep : cB;
        for (int t = 0; t < nt; t += 2) {
            const bool last = (t == nt - 2);
            const char* a1 = cA + (size_t)(t + 1) * kstep;
            const char* a2 = last ? nA : cA + (size_t)(t + 2) * kstep; const char* b2 = last ? nB : cB + (size_t)(t + 2) * kstep;
            const char* a3 = a2 + kstep; const char* b3 = b2 + kstep;
            if (last && has_next) S.a_ready(nxt);
            if constexpr (SP2) {
            PG8_LDB(B0, 0, 0); PG8_LDB(B1, 0, 1); PG8_SCHED; PG8_LDA(At, 0, 0); PG8_STAGE(PG8_SA(1, 1), a1 + hstep, voffA);
            PG8_WAIT_V(8); PG8_WAIT_L(0); PG8_BAR; PG8_MMA(0, 0, At, B0); PG8_MMA(0, 1, At, B1); PG8_BAR; PG8_SCHED;
            PG8_LDA(At, 0, 1); PG8_STAGE(PG8_SB(0, 0), b2, voffB); PG8_STAGE(PG8_SB(0, 1), b2 + hstep, voffB); PG8_STAGE(PG8_SA(0, 0), a2, voffA);
            PG8_WAIT_V(8); PG8_WAIT_L(0); PG8_BAR; PG8_MMA(1, 0, At, B0); PG8_MMA(1, 1, At, B1); PG8_BAR; PG8_SCHED;
            PG8_LDB(B0, 1, 0); PG8_LDB(B1, 1, 1); PG8_SCHED; PG8_LDA(At, 1, 0); PG8_STAGE(PG8_SA(0, 1), a2 + hstep, voffA);
            PG8_WAIT_V(8); PG8_WAIT_L(0); PG8_BAR; PG8_MMA(0, 0, At, B0); PG8_MMA(0, 1, At, B1); PG8_BAR; PG8_SCHED;
            PG8_LDA(At, 1, 1); PG8_STAGE(PG8_SB(1, 0), b3, voffB); PG8_STAGE(PG8_SB(1, 1), b3 + hstep, voffB); PG8_STAGE(PG8_SA(1, 0), a3, voffA);
            PG8_WAIT_V(8); PG8_WAIT_L(0); PG8_BAR; PG8_MMA(1, 0, At, B0); PG8_MMA(1, 1, At, B1); PG8_BAR; PG8_SCHED;
            } else {
            PG8_LDB(B0, 0, 0); PG8_SCHED; PG8_LDA(At, 0, 0); PG8_STAGE(PG8_SA(1, 1), a1 + hstep, voffA);
            PG8_WAIT_L(8); PG8_BAR; PG8_WAIT_L(0); PG8_MMA(0, 0, At, B0); PG8_BAR; PG8_SCHED;
            PG8_LDB(B1, 0, 1); PG8_STAGE(PG8_SB(0, 0), b2, voffB);
            PG8_BAR; PG8_WAIT_L(0); PG8_MMA(0, 1, At, B1); PG8_BAR;
            PG8_LDA(At, 0, 1); PG8_STAGE(PG8_SA(0, 0), a2, voffA);
            PG8_BAR; PG8_WAIT_L(0); PG8_MMA(1, 0, At, B0); PG8_BAR; PG8_SCHED;
            PG8_STAGE(PG8_SB(0, 1), b2 + hstep, voffB);
            PG8_WAIT_V(6); PG8_BAR; PG8_MMA(1, 1, At, B1); PG8_BAR;
            PG8_LDB(B0, 1, 0); PG8_SCHED; PG8_LDA(At, 1, 0); PG8_STAGE(PG8_SA(0, 1), a2 + hstep, voffA);
            PG8_WAIT_L(8); PG8_BAR; PG8_WAIT_L(0); PG8_MMA(0, 0, At, B0); PG8_BAR; PG8_SCHED;
            PG8_LDB(B1, 1, 1); PG8_STAGE(PG8_SB(1, 0), b3, voffB);
            PG8_BAR; PG8_WAIT_L(0); PG8_MMA(0, 1, At, B1); PG8_BAR;
            PG8_LDA(At, 1, 1); PG8_STAGE(PG8_SA(1, 0), a3, voffA);
            PG8_BAR; PG8_WAIT_L(0); PG8_MMA(1, 0, At, B0); PG8_BAR; PG8_SCHED;
            PG8_STAGE(PG8_SB(1, 1), b3 + hstep, voffB);
            PG8_WAIT_V(6); PG8_BAR; PG8_MMA(1, 1, At, B1); PG8_BAR;
            }
        }
        if constexpr (ALIGN_EPI) { if (wr == 0) PG8_BAR; }
        if constexpr (!Epi::AFTER_DRAIN) { E(acc, cur, wr, wc, fr, fq); S.done(cur); }
        if (!has_next) break;
#pragma unroll
        for (int a = 0; a < 2; ++a)
#pragma unroll
            for (int b = 0; b < 2; ++b)
#pragma unroll
                for (int m = 0; m < 4; ++m)
#pragma unroll
                    for (int n = 0; n < 2; ++n) acc[a][b][m][n] = (f32x4){0.f, 0.f, 0.f, 0.f};
        cur = nxt; cA = nA; cB = nB; ++ui;
        if constexpr (ALIGN_EPI) { if (wr == 1) PG8_BAR; }
    }
    PG8_WAIT_V(0);
    if constexpr (!ALIGN_EPI) { if (wr == 0) PG8_BAR; }
    PG8_BAR;
    if constexpr (Epi::AFTER_DRAIN) { E.fused(acc, cur, wr, wc, fr, fq, lds, wid, lane); S.done(cur); }
#undef PG8_SA
#undef PG8_SB
#undef PG8_STAGE
#undef PG8_LDA
#undef PG8_LDB
#undef PG8_MMA
#undef PG8_WAIT_V
#undef PG8_WAIT_L
#undef PG8_BAR
#undef PG8_SCHED
}
}

#ifndef PG8_SP2
#define PG8_SP2 true
#endif
#ifndef PG8_ALIGN
#define PG8_ALIGN true
#endif
constexpr int BATCH = 8, SEQ = 2048, DM = 1024, MROWS = BATCH * SEQ, DEPTH = 2;
constexpr int D_RNN = 512, NHEAD = 8, HDIM = 64, D_INR = 2760, ZP = 2816, TOPK = 256;
constexpr int C_XR = 0, C_GR = 512, C_Q = 1024, C_K = 1536, C_V = 1600, C_GA = 1664, C_QI = 2176, C_KI = 2688, C_WI = 2752;
constexpr float EPS = 1e-6f;
constexpr float QSCALE = 0.125f * 1.4426950408889634f;
constexpr size_t MiB = 1u << 20;
constexpr size_t WS_CTL = 0, CTL_ZERO_BYTES = 1 * MiB;
constexpr size_t WS_MOD = 1 * MiB;
constexpr size_t WS_BIAS = 1 * MiB + 256 * 1024;
constexpr size_t WS_SSQ = 2 * MiB;
constexpr size_t WS_WTIN = 3 * MiB;
constexpr size_t WS_WTOUT = 14 * MiB;
constexpr size_t WS_A = 32 * MiB;
constexpr size_t WS_Z = 64 * MiB;
constexpr size_t WS_Y = 152 * MiB;
constexpr size_t WS_END = 184 * MiB;
constexpr int LDS_BYTES = 163840;
constexpr int MISC_OFF = 131072 + 8192;
constexpr int NPHASE = 8;
constexpr int CW_BAR = 4096, CW_PANEL = 16384;

#define LAS __attribute__((address_space(3)))
typedef unsigned short bf16;
typedef float f32x4 __attribute__((ext_vector_type(4)));
typedef unsigned u32x4 __attribute__((ext_vector_type(4)));
typedef unsigned u32x2 __attribute__((ext_vector_type(2)));
__device__ __forceinline__ float bf2f(bf16 v) { return __uint_as_float(((unsigned)v) << 16); }
__device__ __forceinline__ unsigned f2bf(float f) { unsigned u = __float_as_uint(f); return (u + 0x7fffu + ((u >> 16) & 1u)) >> 16; }
__device__ __forceinline__ unsigned pk2(float lo, float hi) { return f2bf(lo) | (f2bf(hi) << 16); }
__device__ __forceinline__ float wave_sum(float v) {
#pragma unroll
    for (int o = 1; o < 64; o <<= 1) v += __shfl_xor(v, o);
    return v;
}
__device__ __forceinline__ float wave_max(float v) {
#pragma unroll
    for (int o = 1; o < 64; o <<= 1) v = fmaxf(v, __shfl_xor(v, o));
    return v;
}
__device__ __forceinline__ int wave_sum_i(int v) {
#pragma unroll
    for (int o = 1; o < 64; o <<= 1) v += __shfl_xor(v, o);
    return v;
}
__device__ __forceinline__ float siluf(float v) { return v / (1.f + expf(-v)); }
__device__ __forceinline__ float sigmf(float v) { return 1.f / (1.f + expf(-v)); }

struct P {
    const float *x, *c, *norm_g, *ada_w, *ada_b, *w_in, *conv_w, *conv_b, *lru_wx, *lru_bx, *lru_wa, *lru_ba, *lru_a, *w_out, *final_g;
    float* out;
    float *mod, *bias, *ssq;
    bf16 *wt_in, *wt_out, *A, *Z, *Y;
    unsigned* ctl;
};

struct EpiZ {
    static constexpr bool PERM = true, AFTER_DRAIN = false;
    bf16* Zp; const float* ssq; const float* bias;
    __device__ __forceinline__ void operator()(const pg8::f32x4 (&acc)[2][2][4][2], const pg8::Unit& u, int wr, int wc, int fr, int fq) const {
        const int row0 = u.pm * 256 + wr * 64 + fr, col0 = u.pn * 256 + wc * 32 + 8 * fq, b = u.pm >> 3;
        const float cs = (u.pn == 4 || u.pn == 5) ? QSCALE : 1.0f;
        f32x4 bv[2][2];
#pragma unroll
        for (int bj = 0; bj < 2; ++bj)
#pragma unroll
            for (int n = 0; n < 2; ++n) bv[bj][n] = *(const f32x4*)(bias + b * ZP + col0 + bj * 128 + 4 * n);
#pragma unroll
        for (int ai = 0; ai < 2; ++ai)
#pragma unroll
            for (int m = 0; m < 4; ++m) {
                const int r = row0 + ai * 128 + m * 16;
                const f32x4 q = *(const f32x4*)(ssq + (size_t)r * 4);
                const float rstd = 1.0f / sqrtf(((q.x + q.y) + (q.z + q.w)) * (1.0f / 1024.0f) + EPS);
                bf16* rowp = Zp + (size_t)r * ZP + col0;
#pragma unroll
                for (int bj = 0; bj < 2; ++bj) {
                    const f32x4 v0 = (acc[ai][bj][m][0] * rstd + bv[bj][0]) * cs, v1 = (acc[ai][bj][m][1] * rstd + bv[bj][1]) * cs;
                    u32x4 w; w.x = pk2(v0[0], v0[1]); w.y = pk2(v0[2], v0[3]); w.z = pk2(v1[0], v1[1]); w.w = pk2(v1[2], v1[3]);
                    *(u32x4*)(rowp + bj * 128) = w;
                }
            }
    }
};
struct EpiX {
    static constexpr bool PERM = true, AFTER_DRAIN = true;
    const float* xres; float* xout; bf16* Anext; const float* gate; const float* ng; const float* nscale; float* ssq;
    __device__ __forceinline__ void fused(pg8::f32x4 (&acc)[2][2][4][2], const pg8::Unit& u, int wr, int wc, int fr, int fq, LAS unsigned char* lds, int wid, int lane) const {
        const int b = u.pm >> 3, col0 = u.pn * 256 + wc * 32 + 8 * fq;
        LAS float* Pp = (LAS float*)lds;
        f32x4 gv[2][2], gs[2][2];
#pragma unroll
        for (int bj = 0; bj < 2; ++bj)
#pragma unroll
            for (int n = 0; n < 2; ++n) {
                gv[bj][n] = *(const f32x4*)(gate + b * 3072 + col0 + bj * 128 + 4 * n);
                if (Anext) { const f32x4 g = *(const f32x4*)(ng + col0 + bj * 128 + 4 * n), s = *(const f32x4*)(nscale + b * 3072 + col0 + bj * 128 + 4 * n); gs[bj][n] = g * (s + 1.0f); }
                else gs[bj][n] = (f32x4){0.f, 0.f, 0.f, 0.f};
            }
#pragma unroll
        for (int ai = 0; ai < 2; ++ai)
#pragma unroll
            for (int m = 0; m < 4; ++m) {
                const int rl = ai * 128 + wr * 64 + m * 16 + fr; const size_t r = (size_t)u.pm * 256 + rl;
                float s = 0.f;
#pragma unroll
                for (int bj = 0; bj < 2; ++bj) {
                    f32x4 x1[2];
#pragma unroll
                    for (int n = 0; n < 2; ++n) {
                        const f32x4 xr = *(const f32x4*)(xres + r * DM + col0 + bj * 128 + 4 * n);
                        x1[n] = xr + gv[bj][n] * acc[ai][bj][m][n];
                        *(f32x4*)(xout + r * DM + col0 + bj * 128 + 4 * n) = x1[n];
                        s += (x1[n][0] * x1[n][0] + x1[n][1] * x1[n][1]) + (x1[n][2] * x1[n][2] + x1[n][3] * x1[n][3]);
                    }
                    if (Anext) { const f32x4 a0 = x1[0] * gs[bj][0], a1 = x1[1] * gs[bj][1];
                        u32x4 w; w.x = pk2(a0[0], a0[1]); w.y = pk2(a0[2], a0[3]); w.z = pk2(a1[0], a1[1]); w.w = pk2(a1[2], a1[3]);
                        *(u32x4*)(Anext + r * DM + col0 + bj * 128) = w; }
                }
                s += __shfl_xor(s, 16); s += __shfl_xor(s, 32);
                if (fq == 0) Pp[rl * 4 + wc] = s;
            }
        __syncthreads();
        const int tid = wid * 64 + lane;
        if (tid < 256) ssq[((size_t)u.pm * 256 + tid) * 4 + u.pn] = (Pp[tid * 4 + 0] + Pp[tid * 4 + 1]) + (Pp[tid * 4 + 2] + Pp[tid * 4 + 3]);
        __syncthreads();
    }
};

struct EpiXF {
    static constexpr bool PERM = true, AFTER_DRAIN = true;
    const float* xres; float* out; const float* gate; const float* fg; float* ssq; unsigned* cnt;
    __device__ __forceinline__ void fused(pg8::f32x4 (&acc)[2][2][4][2], const pg8::Unit& u, int wr, int wc, int fr, int fq, LAS unsigned char* lds, int wid, int lane) const {
        const int b = u.pm >> 3, col0 = u.pn * 256 + wc * 32 + 8 * fq, tid = wid * 64 + lane;
        LAS float* Pp = (LAS float*)lds;
        LAS float* Sr = (LAS float*)(lds + 4096);
        {
            f32x4 gv[2][2];
#pragma unroll
            for (int bj = 0; bj < 2; ++bj)
#pragma unroll
                for (int n = 0; n < 2; ++n) gv[bj][n] = *(const f32x4*)(gate + b * 3072 + col0 + bj * 128 + 4 * n);
#pragma unroll
            for (int ai = 0; ai < 2; ++ai)
#pragma unroll
                for (int m = 0; m < 4; ++m) {
                    const int rl = ai * 128 + wr * 64 + m * 16 + fr; const size_t r = (size_t)u.pm * 256 + rl;
                    float s = 0.f;
#pragma unroll
                    for (int bj = 0; bj < 2; ++bj)
#pragma unroll
                        for (int n = 0; n < 2; ++n) {
                            const f32x4 xr = *(const f32x4*)(xres + r * DM + col0 + bj * 128 + 4 * n);
                            const f32x4 x1 = xr + gv[bj][n] * acc[ai][bj][m][n];
                            acc[ai][bj][m][n] = x1;
                            s += (x1[0] * x1[0] + x1[1] * x1[1]) + (x1[2] * x1[2] + x1[3] * x1[3]);
                        }
                    s += __shfl_xor(s, 16); s += __shfl_xor(s, 32);
                    if (fq == 0) Pp[rl * 4 + wc] = s;
                }
        }
        __syncthreads();
        if (tid < 256) { const float tot = (Pp[tid * 4 + 0] + Pp[tid * 4 + 1]) + (Pp[tid * 4 + 2] + Pp[tid * 4 + 3]);
            __hip_atomic_store(ssq + ((size_t)u.pm * 256 + tid) * 4 + u.pn, tot, __ATOMIC_RELAXED, __HIP_MEMORY_SCOPE_AGENT); }
        asm volatile("s_waitcnt vmcnt(0)" ::: "memory");
        __syncthreads();
        if (tid == 0) {
            unsigned* c = cnt + 64 * u.pm;
            __hip_atomic_fetch_add(c, 1u, __ATOMIC_RELAXED, __HIP_MEMORY_SCOPE_AGENT);
            unsigned spins = 0u;
            while (__hip_atomic_load(c, __ATOMIC_RELAXED, __HIP_MEMORY_SCOPE_AGENT) < 4u) { __builtin_amdgcn_s_sleep(2); if (++spins > (1u << 22)) break; }
            __builtin_amdgcn_fence(__ATOMIC_ACQUIRE, "agent");
            asm volatile("s_waitcnt vmcnt(0)" ::: "memory");
        }
        __syncthreads();
        if (tid < 256) { const float* sp = ssq + ((size_t)u.pm * 256 + tid) * 4;
            const float q0 = __hip_atomic_load(sp + 0, __ATOMIC_RELAXED, __HIP_MEMORY_SCOPE_AGENT), q1 = __hip_atomic_load(sp + 1, __ATOMIC_RELAXED, __HIP_MEMORY_SCOPE_AGENT);
            const float q2 = __hip_atomic_load(sp + 2, __ATOMIC_RELAXED, __HIP_MEMORY_SCOPE_AGENT), q3 = __hip_atomic_load(sp + 3, __ATOMIC_RELAXED, __HIP_MEMORY_SCOPE_AGENT);
            Sr[tid] = 1.0f / sqrtf(((q0 + q1) + (q2 + q3)) * (1.0f / 1024.0f) + EPS); }
        __syncthreads();
        f32x4 fgv[2][2];
#pragma unroll
        for (int bj = 0; bj < 2; ++bj)
#pragma unroll
            for (int n = 0; n < 2; ++n) fgv[bj][n] = *(const f32x4*)(fg + col0 + bj * 128 + 4 * n);
#pragma unroll
        for (int ai = 0; ai < 2; ++ai)
#pragma unroll
            for (int m = 0; m < 4; ++m) {
                const int rl = ai * 128 + wr * 64 + m * 16 + fr; const size_t r = (size_t)u.pm * 256 + rl; const float rstd = Sr[rl];
#pragma unroll
                for (int bj = 0; bj < 2; ++bj)
#pragma unroll
                    for (int n = 0; n < 2; ++n) *(f32x4*)(out + r * DM + col0 + bj * 128 + 4 * n) = acc[ai][bj][m][n] * rstd * fgv[bj][n];
            }
        __syncthreads();
    }
};

__device__ __forceinline__ void ph0_prologue(const P& p, LAS unsigned char* lds) {
    const int tid = threadIdx.x, lane = tid & 63, wave = tid >> 6, G = gridDim.x, wg = blockIdx.x;
    LAS float* fl = (LAS float*)lds;
    for (int u = wg; u < 96; u += G) {
        const int l = u / 48, j = (u % 48) * 64 + lane;
        for (int i = tid; i < 8192; i += 512) fl[i] = siluf(p.c[i]);
        __syncthreads();
        float acc[8];
#pragma unroll
        for (int b = 0; b < 8; ++b) acc[b] = 0.f;
        const float* w = p.ada_w + ((size_t)l * 1024 + wave * 128) * 3072 + j;
        for (int k = 0; k < 128; ++k) { const float wv = w[(size_t)k * 3072];
#pragma unroll
            for (int b = 0; b < 8; ++b) acc[b] += fl[b * 1024 + wave * 128 + k] * wv; }
#pragma unroll
        for (int b = 0; b < 8; ++b) fl[8192 + (wave * 8 + b) * 64 + lane] = acc[b];
        __syncthreads();
        { const int b = wave; float s = p.ada_b[l * 3072 + j];
#pragma unroll
          for (int w8 = 0; w8 < 8; ++w8) s += fl[8192 + (w8 * 8 + b) * 64 + lane];
          p.mod[(l * 8 + b) * 3072 + j] = s; }
        __syncthreads();
    }
#pragma unroll 1
    for (int u0 = wg; u0 < 1920; u0 += 2 * G) {
        float v[2][8]; bf16* dst[2]; bool act[2];
#pragma unroll
        for (int q = 0; q < 2; ++q) {
            const int u = u0 + q * G; act[q] = u < 1920; dst[q] = nullptr;
#pragma unroll
            for (int j = 0; j < 8; ++j) v[q][j] = 0.f;
            if (act[q]) {
                const float* W; bf16* WT; int N, kt, nt;
                if (u < 1408) { const int l = u / 704, r = u % 704; kt = r / 44; nt = r % 44; W = p.w_in + (size_t)l * 1024 * D_INR; N = D_INR; WT = p.wt_in + (size_t)l * ZP * 1024; }
                else { int r = u - 1408; const int l = r / 256; r %= 256; kt = r / 16; nt = r % 16; W = p.w_out + (size_t)l * 1024 * 1024; N = 1024; WT = p.wt_out + (size_t)l * 1024 * 1024; }
                const int n = nt * 64 + lane, k0 = kt * 64 + wave * 8;
                if (n < N) {
#pragma unroll
                    for (int j = 0; j < 8; ++j) v[q][j] = W[(size_t)(k0 + j) * N + n];
                }
                dst[q] = WT + (size_t)n * 1024 + k0;
            }
        }
#pragma unroll
        for (int q = 0; q < 2; ++q) if (act[q]) { u32x4 o; o.x = pk2(v[q][0], v[q][1]); o.y = pk2(v[q][2], v[q][3]); o.z = pk2(v[q][4], v[q][5]); o.w = pk2(v[q][6], v[q][7]); *(u32x4*)dst[q] = o; }
    }
}
__device__ __forceinline__ void ph1_prologue(const P& p, LAS unsigned char* lds) {
    const int tid = threadIdx.x, lane = tid & 63, wave = tid >> 6, G = gridDim.x, wg = blockIdx.x;
    LAS float* fl = (LAS float*)lds;
    for (int u = wg; u < 88; u += G) {
        const int l = u / 44, n = (u % 44) * 64 + lane;
        for (int i = tid; i < 8192; i += 512) fl[i] = p.mod[(l * 8 + (i >> 10)) * 3072 + (i & 1023)];
        __syncthreads();
        float acc[8];
#pragma unroll
        for (int b = 0; b < 8; ++b) acc[b] = 0.f;
        if (n < D_INR) { const float* w = p.w_in + ((size_t)l * 1024 + wave * 128) * D_INR + n;
            for (int k = 0; k < 128; ++k) { const float wv = w[(size_t)k * D_INR];
#pragma unroll
                for (int b = 0; b < 8; ++b) acc[b] += fl[b * 1024 + wave * 128 + k] * wv; } }
#pragma unroll
        for (int b = 0; b < 8; ++b) fl[8192 + (wave * 8 + b) * 64 + lane] = acc[b];
        __syncthreads();
        { const int b = wave; float s = 0.f;
#pragma unroll
          for (int w8 = 0; w8 < 8; ++w8) s += fl[8192 + (w8 * 8 + b) * 64 + lane];
          p.bias[(l * 8 + b) * ZP + n] = s; }
        __syncthreads();
    }
#pragma unroll 1
    for (int r = wg * 8 + wave; r < MROWS; r += G * 16) {
        const int r2 = (r + G * 8 < MROWS) ? r + G * 8 : r; const int b1 = r >> 11, b2 = r2 >> 11;
        f32x4 va[4], vb[4];
#pragma unroll
        for (int j = 0; j < 4; ++j) { const int k = (lane + 64 * j) * 4; va[j] = *(const f32x4*)(p.x + (size_t)r * DM + k); vb[j] = *(const f32x4*)(p.x + (size_t)r2 * DM + k); }
        float s1 = 0.f, s2 = 0.f;
#pragma unroll
        for (int j = 0; j < 4; ++j) { const int k = (lane + 64 * j) * 4;
            const f32x4 g = *(const f32x4*)(p.norm_g + k), sc1 = *(const f32x4*)(p.mod + (size_t)b1 * 3072 + 1024 + k), sc2 = *(const f32x4*)(p.mod + (size_t)b2 * 3072 + 1024 + k);
            s1 += (va[j][0] * va[j][0] + va[j][1] * va[j][1]) + (va[j][2] * va[j][2] + va[j][3] * va[j][3]);
            s2 += (vb[j][0] * vb[j][0] + vb[j][1] * vb[j][1]) + (vb[j][2] * vb[j][2] + vb[j][3] * vb[j][3]);
            const f32x4 o1 = va[j] * g * (sc1 + 1.0f), o2 = vb[j] * g * (sc2 + 1.0f);
            u32x2 w1, w2; w1.x = pk2(o1[0], o1[1]); w1.y = pk2(o1[2], o1[3]); w2.x = pk2(o2[0], o2[1]); w2.y = pk2(o2[2], o2[3]);
            *(u32x2*)(p.A + (size_t)r * DM + k) = w1; if (r2 != r) *(u32x2*)(p.A + (size_t)r2 * DM + k) = w2; }
        s1 = wave_sum(s1); s2 = wave_sum(s2);
        if (lane == 0) { *(f32x4*)(p.ssq + (size_t)r * 4) = (f32x4){s1, 0.f, 0.f, 0.f}; if (r2 != r) *(f32x4*)(p.ssq + (size_t)r2 * 4) = (f32x4){s2, 0.f, 0.f, 0.f}; }
    }
}
__device__ __forceinline__ void ph_final(const P& p) {
    const int tid = threadIdx.x, lane = tid & 63, wave = tid >> 6, G = gridDim.x, wg = blockIdx.x;
    for (int r = wg * 8 + wave; r < MROWS; r += G * 8) {
        const f32x4 q = *(const f32x4*)(p.ssq + (size_t)r * 4);
        const float rstd = 1.0f / sqrtf(((q.x + q.y) + (q.z + q.w)) * (1.0f / 1024.0f) + EPS);
#pragma unroll
        for (int j = 0; j < 4; ++j) { const int k = (lane + 64 * j) * 4;
            const f32x4 v = *(const f32x4*)(p.out + (size_t)r * DM + k), g = *(const f32x4*)(p.final_g + k);
            *(f32x4*)(p.out + (size_t)r * DM + k) = v * rstd * g; }
    }
}
#define XB_TMO      128
#define XB_XCNT(j)  (256  + 64 * (j))
#define XB_XSUB(j)  (1280 + 64 * (j))
#define XB_XGEN(j)  (2304 + 64 * (j))
#define XB_TOP      3328
#define XB_TOPGEN   3392
#define XCD_BAR_WORDS 3456
#define XB_SPIN_CAP (1u << 18)

__device__ __forceinline__ unsigned xb_ld(unsigned* p)              { return __hip_atomic_load(p, __ATOMIC_RELAXED, __HIP_MEMORY_SCOPE_AGENT); }
__device__ __forceinline__ unsigned xb_add(unsigned* p, unsigned v) { return __hip_atomic_fetch_add(p, v, __ATOMIC_RELAXED, __HIP_MEMORY_SCOPE_AGENT); }
__device__ __forceinline__ unsigned xb_xcc_id() { return (unsigned)__builtin_amdgcn_s_getreg((3 << 11) | 20) & 0xFu; }
#define XB_SPIN(cond, bar) do { unsigned _sp = 0; while (cond) { __builtin_amdgcn_s_sleep(1); \
    if ((++_sp & 255u) == 0u) { if (xb_ld(&(bar)[XB_TMO])) break; if (_sp > XB_SPIN_CAP) { atomicAdd(&(bar)[XB_TMO], 1u); break; } } } } while (0)

struct XcdBarrier {
    unsigned* bar; unsigned x;
    volatile LAS unsigned* st;
};

__device__ __forceinline__ XcdBarrier xcd_barrier_post(unsigned* bar, volatile LAS unsigned* st) {
    XcdBarrier b; b.bar = bar; b.x = xb_xcc_id(); b.st = st;
    if (threadIdx.x == 0) (void)xb_add(&bar[XB_XCNT(b.x)], 1u);
    return b;
}
__device__ __forceinline__ void xcd_barrier_complete(unsigned* bar, unsigned x, unsigned& nloc, unsigned& nx) {
    const unsigned G = gridDim.x * gridDim.y * gridDim.z;
    unsigned sum, cnt, mine, sp = 0u;
    for (;;) {
        sum = 0u; cnt = 0u; mine = 0u;
#pragma unroll
        for (unsigned j = 0; j < 16; ++j) { const unsigned c = xb_ld(&bar[XB_XCNT(j)]); sum += c; cnt += (c > 0u) ? 1u : 0u; mine = (j == x) ? c : mine; }
        if (sum == G) break;
        __builtin_amdgcn_s_sleep(1);
        if ((++sp & 255u) == 0u) { if (xb_ld(&bar[XB_TMO])) break; if (sp > XB_SPIN_CAP) { atomicAdd(&bar[XB_TMO], 1u); break; } }
    }
    nloc = mine > 0u ? mine : 1u; nx = cnt > 0u ? cnt : 1u;
}

__device__ __forceinline__ void xcd_barrier(const XcdBarrier& b) {
    asm volatile("s_waitcnt vmcnt(0)" ::: "memory");
    __syncthreads();
    if (threadIdx.x == 0) {
        unsigned* bar = b.bar;
        __builtin_amdgcn_s_waitcnt(0);
        unsigned nloc = b.st[0], nx = b.st[1];
        if (nloc == 0u) { xcd_barrier_complete(bar, b.x, nloc, nx); b.st[0] = nloc; b.st[1] = nx; }
        const unsigned old = xb_add(&bar[XB_XSUB(b.x)], 1u);
        const unsigned gen = old / nloc;
        if (old + 1u == (gen + 1u) * nloc) {
            __builtin_amdgcn_fence(__ATOMIC_RELEASE, "agent");
            asm volatile("s_waitcnt vmcnt(0)" ::: "memory");
            const unsigned og = xb_add(&bar[XB_TOP], 1u);
            const unsigned tg = og / nx;
            if (og + 1u == (tg + 1u) * nx) xb_add(&bar[XB_TOPGEN], 1u);
            else XB_SPIN(xb_ld(&bar[XB_TOPGEN]) == tg, bar);
            __builtin_amdgcn_fence(__ATOMIC_ACQUIRE, "agent");
            xb_add(&bar[XB_XGEN(b.x)], 1u);
            asm volatile("s_waitcnt vmcnt(0)" ::: "memory");
        } else {
            XB_SPIN(xb_ld(&bar[XB_XGEN(b.x)]) == gen, bar);
            __builtin_amdgcn_fence(__ATOMIC_ACQUIRE, "agent");
            asm volatile("s_waitcnt vmcnt(0)" ::: "memory");
        }
    }
    __syncthreads();
}
__device__ __forceinline__ unsigned score_ukey(float s) { const unsigned u = __float_as_uint(s + 0.0f); return (u & 0x80000000u) ? ~u : (u | 0x80000000u); }
__device__ __forceinline__ void topk_threshold(const unsigned (&k)[32], unsigned& thr, unsigned& need) {
    unsigned prefix = 0u; bool exact = false;
    for (int bit = 31; bit >= 0; --bit) {
        const unsigned cand = prefix | (1u << bit);
        int c = 0;
#pragma unroll
        for (int i = 0; i < 32; ++i) c += (k[i] >= cand) ? 1 : 0;
        c = wave_sum_i(c);
        if (c >= TOPK) prefix = cand;
        if (c == TOPK) { exact = true; break; }
    }
    thr = prefix;
    if (exact) { need = 0xffffffffu; }
    else { int c = 0;
#pragma unroll
        for (int i = 0; i < 32; ++i) c += (k[i] > prefix) ? 1 : 0;
        c = wave_sum_i(c); need = (unsigned)(TOPK - c); }
}
#ifndef PROBE_VALU
#define PROBE_VALU 0
#endif
#ifndef RP_T3
#define RP_T3 1
#endif
#ifndef RP_T1
#define RP_T1 1
#endif
#ifndef RP_T2
#define RP_T2 1
#endif
#ifndef RP_I
#define RP_I 1
#endif
#ifndef RP_T
#define RP_T 1
#endif
#ifndef RP_V
#define RP_V 1
#endif
typedef short bf16x8v __attribute__((ext_vector_type(8)));
typedef short s16x4v __attribute__((ext_vector_type(4)));
constexpr int BMS = 65;
constexpr int SCP = 2052;
constexpr int DSA_BM_OFF = 16 * SCP * 4;
constexpr int DSA_RING_OFF = 0;
constexpr int DSA_QIB_OFF = 147456;
constexpr int DSA_WIB_OFF = 135680;
constexpr int DSA_MLUT_OFF = 143616;
__device__ __forceinline__ void glds16(const void* gsrc, unsigned lds_dst) { unsigned keep;
    asm volatile("s_mov_b32 %0, m0\n\ts_mov_b32 m0, %2\n\ts_nop 0\n\tglobal_load_lds_dwordx4 %1, off\n\ts_mov_b32 m0, %0" : "=&s"(keep) : "v"(gsrc), "s"(lds_dst) : "memory"); }
template <int I> __device__ __forceinline__ unsigned mbit_t(int mw) { unsigned r; asm("v_bfe_i32 %0, %1, %2, 1" : "=v"(r) : "v"(mw), "i"(I)); return r; }
#define mbit(mw, i) mbit_t<(i)>(mw)
__device__ __forceinline__ float relu_i(float x) { return __int_as_float(max(__float_as_int(x), 0)); }
__device__ __forceinline__ int imax3(float a, float b, float c) { return max(max(__float_as_int(a), __float_as_int(b)), __float_as_int(c)); }
__device__ __forceinline__ s16x4v lds_tr16(LAS const unsigned char* p) { return __builtin_bit_cast(s16x4v, __builtin_amdgcn_ds_read_tr16_b64_v4i16((LAS s16x4v*)p)); }
__device__ __forceinline__ unsigned cvtpk(float lo, float hi) { typedef float f2 __attribute__((ext_vector_type(2))); typedef __bf16 b2 __attribute__((ext_vector_type(2))); f2 v = {lo, hi}; b2 r = __builtin_convertvector(v, b2); return __builtin_bit_cast(unsigned, r); }


template <int L> __device__ __forceinline__ void wr2lanes(int& w, unsigned lo, unsigned hi) {
    asm volatile("s_nop 1\n\tv_writelane_b32 %0, %1, %3\n\tv_writelane_b32 %0, %2, %4" : "+v"(w) : "s"(lo), "s"(hi), "i"(L), "i"(L + 1));
}
__device__ __forceinline__ int wave_sum_dpp(int v) {
    v += __builtin_amdgcn_update_dpp(0, v, 0xB1, 0xf, 0xf, true);
    v += __builtin_amdgcn_update_dpp(0, v, 0x4E, 0xf, 0xf, true);
    v += __builtin_amdgcn_update_dpp(0, v, 0x141, 0xf, 0xf, true);
    v += __builtin_amdgcn_update_dpp(0, v, 0x140, 0xf, 0xf, true);
    return __builtin_amdgcn_readlane(v, 0) + __builtin_amdgcn_readlane(v, 16) + __builtin_amdgcn_readlane(v, 32) + __builtin_amdgcn_readlane(v, 48);
}
__device__ __forceinline__ unsigned wave_max_dpp(unsigned v) {
    v = max(v, (unsigned)__builtin_amdgcn_update_dpp(0, (int)v, 0xB1, 0xf, 0xf, true));
    v = max(v, (unsigned)__builtin_amdgcn_update_dpp(0, (int)v, 0x4E, 0xf, 0xf, true));
    v = max(v, (unsigned)__builtin_amdgcn_update_dpp(0, (int)v, 0x141, 0xf, 0xf, true));
    v = max(v, (unsigned)__builtin_amdgcn_update_dpp(0, (int)v, 0x140, 0xf, 0xf, true));
    return max(max((unsigned)__builtin_amdgcn_readlane((int)v, 0), (unsigned)__builtin_amdgcn_readlane((int)v, 16)), max((unsigned)__builtin_amdgcn_readlane((int)v, 32), (unsigned)__builtin_amdgcn_readlane((int)v, 48)));
}
__device__ __forceinline__ int cnt8(int acc, unsigned cand, unsigned k0, unsigned k1, unsigned k2, unsigned k3, unsigned k4, unsigned k5, unsigned k6, unsigned k7) {
    unsigned long long m0, m1, m2, m3, m4, m5, m6, m7;
    asm volatile("v_cmp_le_u32_e64 %1, %9, %10\n\tv_cmp_le_u32_e64 %2, %9, %11\n\tv_cmp_le_u32_e64 %3, %9, %12\n\tv_cmp_le_u32_e64 %4, %9, %13\n\t"
                 "v_cmp_le_u32_e64 %5, %9, %14\n\tv_cmp_le_u32_e64 %6, %9, %15\n\tv_cmp_le_u32_e64 %7, %9, %16\n\tv_cmp_le_u32_e64 %8, %9, %17\n\t"
                 "v_addc_co_u32_e64 %0, %1, 0, %0, %1\n\tv_addc_co_u32_e64 %0, %2, 0, %0, %2\n\tv_addc_co_u32_e64 %0, %3, 0, %0, %3\n\tv_addc_co_u32_e64 %0, %4, 0, %0, %4\n\t"
                 "v_addc_co_u32_e64 %0, %5, 0, %0, %5\n\tv_addc_co_u32_e64 %0, %6, 0, %0, %6\n\tv_addc_co_u32_e64 %0, %7, 0, %0, %7\n\tv_addc_co_u32_e64 %0, %8, 0, %0, %8"
                 : "+v"(acc), "=&s"(m0), "=&s"(m1), "=&s"(m2), "=&s"(m3), "=&s"(m4), "=&s"(m5), "=&s"(m6), "=&s"(m7)
                 : "s"(cand), "v"(k0), "v"(k1), "v"(k2), "v"(k3), "v"(k4), "v"(k5), "v"(k6), "v"(k7));
    return acc;
}
__device__ __forceinline__ int count_ge(const unsigned (&k)[32], unsigned cand_, int nb) {
    const unsigned cand = (unsigned)__builtin_amdgcn_readfirstlane((int)cand_);
    int c = 0;
    c = cnt8(c, cand, k[0], k[1], k[2], k[3], k[4], k[5], k[6], k[7]);
    if (nb > 1) c = cnt8(c, cand, k[8], k[9], k[10], k[11], k[12], k[13], k[14], k[15]);
    if (nb > 2) c = cnt8(c, cand, k[16], k[17], k[18], k[19], k[20], k[21], k[22], k[23]);
    if (nb > 3) c = cnt8(c, cand, k[24], k[25], k[26], k[27], k[28], k[29], k[30], k[31]);
    return wave_sum_dpp(c);
}
struct TopkState { unsigned prefix; int bit; bool done; unsigned need; int nb; };
__device__ __forceinline__ void topk_init(const unsigned (&k)[32], TopkState& st) {
    unsigned mx = 0u;
#pragma unroll
    for (int i = 0; i < 32; ++i) mx = max(mx, k[i]);
    mx = wave_max_dpp(mx);
    st.prefix = 0u; st.bit = 31; st.done = false; st.need = 0u;
    unsigned E = mx >> 23;
#pragma unroll 1
    for (int j = 0; j < 4; ++j) {
        if (E < (unsigned)j + 1u) break;
        const unsigned T = (E - (unsigned)j) << 23;
        const int c = count_ge(k, T, st.nb);
        if (c >= TOPK) { st.prefix = T; st.bit = 22; if (c == TOPK) { st.done = true; st.need = 0xffffffffu; } break; }
    }
}
__device__ __forceinline__ void topk_step(const unsigned (&k)[32], TopkState& st) {
    if (st.done) return;
    if (st.bit < 0) { int c = 0;
#pragma unroll
        for (int i = 0; i < 32; ++i) c += (k[i] > st.prefix) ? 1 : 0;
        c = wave_sum_dpp(c); st.need = (unsigned)(TOPK - c); st.done = true; return; }
    const unsigned cand = st.prefix | (1u << st.bit);
    const int c = count_ge(k, cand, st.nb);
    if (c >= TOPK) st.prefix = cand;
    if (c == TOPK) { st.done = true; st.need = 0xffffffffu; }
    --st.bit;
}

__device__ __forceinline__ void dsa_prefetch_qi(const bf16* zb, int qt, LAS unsigned char* lds, int wave, int lane) {
    const unsigned lds_base = (unsigned)(uintptr_t)lds;
#pragma unroll
    for (int i = 0; i < 2; ++i) { const int row = 2 * wave + i;
        glds16(zb + (size_t)(qt * 16 + row) * ZP + C_QI + ((lane ^ row) * 8), (unsigned)__builtin_amdgcn_readfirstlane(lds_base + DSA_QIB_OFF + row * 1024)); }
    if (wave == 0) glds16(zb + (size_t)(qt * 16 + (lane & 15)) * ZP + C_WI, (unsigned)__builtin_amdgcn_readfirstlane(lds_base + DSA_WIB_OFF));
}

__device__ __forceinline__ void dsa_prefetch_ki(const bf16* zb, int qt, bf16x8v (&pk)[4], int wave, int lane) {
    const int r16 = lane & 15, g = lane >> 4;
    if (wave <= qt) { const bf16* krow = zb + (size_t)(wave * 16 + r16) * ZP + C_KI; pk[0] = *(const bf16x8v*)(krow + 8 * g); pk[1] = *(const bf16x8v*)(krow + 32 + 8 * g); }
    if (wave + 8 <= qt) { const bf16* krow = zb + (size_t)((wave + 8) * 16 + r16) * ZP + C_KI; pk[2] = *(const bf16x8v*)(krow + 8 * g); pk[3] = *(const bf16x8v*)(krow + 32 + 8 * g); }
}

__device__ __forceinline__ void dsa_unit(const P& p, int b, int qt, int qt_next, bf16x8v (&pk)[4], LAS unsigned char* lds) {
    const int tid = threadIdx.x, lane = tid & 63, wave = __builtin_amdgcn_readfirstlane(tid >> 6), r16 = lane & 15, g = lane >> 4;
    const int q0 = qt * 16; const bf16* zb = p.Z + (size_t)b * SEQ * ZP;
    LAS float* SC = (LAS float*)lds; LAS unsigned* BM = (LAS unsigned*)(lds + DSA_BM_OFF);
    const bool dense_all = (qt < TOPK / 16);
    const bf16* qrow = zb + (size_t)(q0 + r16) * ZP;
    const bf16x8v bq0 = *(const bf16x8v*)(qrow + C_Q + wave * 64 + 8 * g), bq1 = *(const bf16x8v*)(qrow + C_Q + wave * 64 + 32 + 8 * g);
    u32x2 gwv[4];
#pragma unroll
    for (int dt = 0; dt < 4; ++dt) gwv[dt] = *(const u32x2*)(qrow + C_GA + wave * 64 + dt * 16 + 4 * g);
    const int nsteps = (((q0 + 16 + 31) >> 5) + 1) & ~1, nmega = (nsteps + 7) >> 3;
    const int kkey = lane >> 3, vkey = lane >> 1, vhalf = lane & 1;
    const unsigned lds_base = (unsigned)(uintptr_t)lds;
#define DSA_STAGE(mm) do { const int st_ = (mm) * 8 + wave; if (st_ < nsteps) { \
        const bf16* kb_ = zb + (size_t)st_ * 32 * ZP; const unsigned ldsb_ = lds_base + (unsigned)(((mm) & 1) * 65536 + wave * 4096); \
        _Pragma("unroll") for (int c_ = 0; c_ < 4; ++c_) { const int key_ = 8 * c_ + kkey, ch_ = (lane & 7) ^ ((key_ & 15) >> 1); \
            glds16(kb_ + (size_t)key_ * ZP + C_K + ch_ * 8, (unsigned)__builtin_amdgcn_readfirstlane(ldsb_ + c_ * 1024)); } \
        _Pragma("unroll") for (int c_ = 0; c_ < 4; ++c_) \
            glds16(kb_ + (size_t)vkey * ZP + C_V + c_ * 16 + vhalf * 8, (unsigned)__builtin_amdgcn_readfirstlane(ldsb_ + 32768 + c_ * 1024)); } } while (0)
    if (!dense_all) {
        for (int rpI = 0; rpI < RP_I; ++rpI) {
        bf16x8v bq[8][2]; float wv[8];
#pragma unroll
        for (int h = 0; h < 8; ++h) { bq[h][0] = *(LAS const bf16x8v*)(lds + DSA_QIB_OFF + r16 * 1024 + (((8 * h + g) ^ r16) * 16)); bq[h][1] = *(LAS const bf16x8v*)(lds + DSA_QIB_OFF + r16 * 1024 + (((8 * h + 4 + g) ^ r16) * 16));
            wv[h] = bf2f(*(LAS const bf16*)(lds + DSA_WIB_OFF + r16 * 16 + h * 2)) * 0.35355339059327373f * 0.125f; }
        bf16x8v a0n = pk[0], a1n = pk[1], a0m = pk[2], a1m = pk[3];
#pragma unroll 1
        for (int kt = wave; kt <= qt; kt += 8) {
            const bf16x8v a0 = a0n, a1 = a1n; a0n = a0m; a1n = a1m;
            if (kt + 16 <= qt) { const bf16* krow = zb + (size_t)((kt + 16) * 16 + r16) * ZP + C_KI; a0m = *(const bf16x8v*)(krow + 8 * g); a1m = *(const bf16x8v*)(krow + 32 + 8 * g); }
            f32x4 sc = {0.f, 0.f, 0.f, 0.f};
#pragma unroll
            for (int h = 0; h < 8; ++h) {
                f32x4 acc = {0.f, 0.f, 0.f, 0.f};
                acc = __builtin_amdgcn_mfma_f32_16x16x32_bf16(a0, bq[h][0], acc, 0, 0, 0);
                acc = __builtin_amdgcn_mfma_f32_16x16x32_bf16(a1, bq[h][1], acc, 0, 0, 0);
#pragma unroll
                for (int i = 0; i < 4; ++i) sc[i] += relu_i(acc[i]) * wv[h];
            }
            if (__builtin_amdgcn_readfirstlane(kt) == qt) {
#pragma unroll
                for (int i = 0; i < 4; ++i) sc[i] = (4 * g + i > r16) ? -INFINITY : sc[i];
            }
            *(LAS f32x4*)(SC + r16 * SCP + kt * 16 + 4 * g) = sc;
        }
        __syncthreads();
        }
#pragma unroll 1
        for (int rpT = 0; rpT < RP_T; ++rpT) {
            const int ra = 2 * wave, rb = 2 * wave + 1, ta = q0 + ra, tb = q0 + rb;
            unsigned ka[32], kb[32];
#pragma unroll
            for (int i = 0; i < 32; ++i) { const int key = lane + 64 * i; ka[i] = (key <= ta) ? score_ukey(SC[ra * SCP + key]) : 0u; kb[i] = (key <= tb) ? score_ukey(SC[rb * SCP + key]) : 0u; }
#if RP_T1 > 1
            asm volatile("" :: "v"(ka[0]), "v"(kb[31]) : "memory");
#pragma unroll
            for (int i = 0; i < 32; ++i) { const int key = lane + 64 * i; ka[i] = (key <= ta) ? score_ukey(SC[ra * SCP + key]) : 0u; kb[i] = (key <= tb) ? score_ukey(SC[rb * SCP + key]) : 0u; }
            asm volatile("" ::: "memory");
#endif
            asm volatile("s_waitcnt lgkmcnt(0)" ::: "memory");
            __syncthreads();
            DSA_STAGE(0);
            TopkState sa, sb; sa.nb = (ta >> 9) + 1; sb.nb = (tb >> 9) + 1; topk_init(ka, sa); topk_init(kb, sb);
#pragma unroll 1
            while (!(sa.done && sb.done)) { topk_step(ka, sa); topk_step(kb, sb); }
#if RP_T2 > 1
            asm volatile("" :: "v"(sa.prefix), "v"(sb.prefix));
            topk_init(ka, sa); topk_init(kb, sb);
#pragma unroll 1
            while (!(sa.done && sb.done)) { topk_step(ka, sa); topk_step(kb, sb); }
#endif
            if (sa.need == 0xffffffffu && sb.need == 0xffffffffu) {
                const unsigned ta_ = (unsigned)__builtin_amdgcn_readfirstlane((int)sa.prefix), tb_ = (unsigned)__builtin_amdgcn_readfirstlane((int)sb.prefix);
                int wa = 0, wb = 0;
#define WR2(i) { const unsigned long long ma = __ballot(ka[i] >= ta_), mb = __ballot(kb[i] >= tb_); wr2lanes<2 * (i)>(wa, (unsigned)ma, (unsigned)(ma >> 32)); wr2lanes<2 * (i)>(wb, (unsigned)mb, (unsigned)(mb >> 32)); }
                WR2(0) WR2(1) WR2(2) WR2(3) WR2(4) WR2(5) WR2(6) WR2(7) WR2(8) WR2(9) WR2(10) WR2(11) WR2(12) WR2(13) WR2(14) WR2(15)
                WR2(16) WR2(17) WR2(18) WR2(19) WR2(20) WR2(21) WR2(22) WR2(23) WR2(24) WR2(25) WR2(26) WR2(27) WR2(28) WR2(29) WR2(30) WR2(31)
#undef WR2
                BM[ra * BMS + lane] = (unsigned)wa; BM[rb * BMS + lane] = (unsigned)wb;
#if RP_T3 > 1
                asm volatile("" : "+v"(wa), "+v"(wb) :: "memory");
#define WR2(i) { const unsigned long long ma = __ballot(ka[i] >= ta_), mb = __ballot(kb[i] >= tb_); wr2lanes<2 * (i)>(wa, (unsigned)ma, (unsigned)(ma >> 32)); wr2lanes<2 * (i)>(wb, (unsigned)mb, (unsigned)(mb >> 32)); }
                WR2(0) WR2(1) WR2(2) WR2(3) WR2(4) WR2(5) WR2(6) WR2(7) WR2(8) WR2(9) WR2(10) WR2(11) WR2(12) WR2(13) WR2(14) WR2(15)
                WR2(16) WR2(17) WR2(18) WR2(19) WR2(20) WR2(21) WR2(22) WR2(23) WR2(24) WR2(25) WR2(26) WR2(27) WR2(28) WR2(29) WR2(30) WR2(31)
#undef WR2
                BM[ra * BMS + lane] = (unsigned)wa; BM[rb * BMS + lane] = (unsigned)wb;
#endif
            } else {
            unsigned eqa = 0u, eqb = 0u;
#pragma unroll 1
            for (int i = 0; i < 32; ++i) {
                unsigned kai = ka[0], kbi = kb[0];
#pragma unroll
                for (int j = 1; j < 32; ++j) { kai = (i == j) ? ka[j] : kai; kbi = (i == j) ? kb[j] : kbi; }
                { const bool eq = (kai == sa.prefix); const unsigned long long em = __ballot(eq);
                  const unsigned erank = eqa + __builtin_amdgcn_mbcnt_hi((unsigned)(em >> 32), __builtin_amdgcn_mbcnt_lo((unsigned)em, 0u));
                  const unsigned long long smk = __ballot((kai > sa.prefix) || (eq && erank < sa.need));
                  if (lane == 0) { BM[ra * BMS + 2 * i] = (unsigned)smk; BM[ra * BMS + 2 * i + 1] = (unsigned)(smk >> 32); }
                  eqa += (unsigned)__popcll(em); }
                { const bool eq = (kbi == sb.prefix); const unsigned long long em = __ballot(eq);
                  const unsigned erank = eqb + __builtin_amdgcn_mbcnt_hi((unsigned)(em >> 32), __builtin_amdgcn_mbcnt_lo((unsigned)em, 0u));
                  const unsigned long long smk = __ballot((kbi > sb.prefix) || (eq && erank < sb.need));
                  if (lane == 0) { BM[rb * BMS + 2 * i] = (unsigned)smk; BM[rb * BMS + 2 * i + 1] = (unsigned)(smk >> 32); }
                  eqb += (unsigned)__popcll(em); }
            }
            }
        }
    } else {
        for (int i = tid; i < 1024; i += 512) { const int row = i >> 6, w = i & 63, t = q0 + row, lo = 32 * w;
            BM[row * BMS + w] = (t >= lo + 31) ? 0xffffffffu : ((t < lo) ? 0u : ((2u << (t - lo)) - 1u)); }
        DSA_STAGE(0);
    }
    __syncthreads();
    const int h = wave;
#pragma unroll 1
    for (int rpV = 0; rpV < RP_V; ++rpV) {
    asm volatile("s_waitcnt vmcnt(0)" ::: "memory");
    asm volatile("" :: "v"(bq0), "v"(bq1), "v"(gwv[0]), "v"(gwv[1]), "v"(gwv[2]), "v"(gwv[3]));
    __syncthreads();
    if (qt_next >= TOPK / 16) { dsa_prefetch_qi(zb, qt_next, lds, wave, lane); dsa_prefetch_ki(zb, qt_next, pk, wave, lane); }
    f32x4 o[4], lacc = {0.f, 0.f, 0.f, 0.f}, negm = {0.f, 0.f, 0.f, 0.f};
#pragma unroll
    for (int dt = 0; dt < 4; ++dt) o[dt] = (f32x4){0.f, 0.f, 0.f, 0.f};
    float m_run = 0.f;
    const int kofs0 = r16 * 128 + ((g ^ (r16 >> 1)) & 7) * 16, kofs1 = r16 * 128 + (((4 + g) ^ (r16 >> 1)) & 7) * 16;
    const int vofs = 32768 + (4 * g + ((lane & 15) >> 2)) * 32 + (lane & 3) * 8;
    bf16x8v ones = {0x3f80, 0x3f80, 0x3f80, 0x3f80, 0x3f80, 0x3f80, 0x3f80, 0x3f80};
    asm volatile("" : "+v"(ones));
    LAS const unsigned char* mlut = lds + DSA_MLUT_OFF;
    constexpr float THR = 8.0f;
    bool first = true;
#pragma unroll 1
    for (int mm = 0; mm < nmega; ++mm) {
        if (mm + 1 < nmega) DSA_STAGE(mm + 1);
        LAS unsigned char* slotb = lds + (mm & 1) * 65536;
        const int nsub = (nsteps - mm * 8) < 8 ? (nsteps - mm * 8) : 8;
#pragma unroll 1
        for (int u = 0; u < nsub; u += 2) {
            LAS unsigned char* slot = slotb + u * 4096;
            const int mwA = (int)(BM[r16 * BMS + mm * 8 + u] >> (4 * g)), mwB = (int)(BM[r16 * BMS + mm * 8 + u + 1] >> (4 * g));
            f32x4 s0, s1, s2, s3;
            { const bf16x8v ka0 = *(LAS const bf16x8v*)(slot + kofs0), ka1 = *(LAS const bf16x8v*)(slot + kofs1);
              const bf16x8v kb0 = *(LAS const bf16x8v*)(slot + 2048 + kofs0), kb1 = *(LAS const bf16x8v*)(slot + 2048 + kofs1);
              const bf16x8v kc0 = *(LAS const bf16x8v*)(slot + 4096 + kofs0), kc1 = *(LAS const bf16x8v*)(slot + 4096 + kofs1);
              const bf16x8v kd0 = *(LAS const bf16x8v*)(slot + 6144 + kofs0), kd1 = *(LAS const bf16x8v*)(slot + 6144 + kofs1);
              s0 = __builtin_amdgcn_mfma_f32_16x16x32_bf16(ka0, bq0, negm, 0, 0, 0); s1 = __builtin_amdgcn_mfma_f32_16x16x32_bf16(kb0, bq0, negm, 0, 0, 0);
              s2 = __builtin_amdgcn_mfma_f32_16x16x32_bf16(kc0, bq0, negm, 0, 0, 0); s3 = __builtin_amdgcn_mfma_f32_16x16x32_bf16(kd0, bq0, negm, 0, 0, 0);
              s0 = __builtin_amdgcn_mfma_f32_16x16x32_bf16(ka1, bq1, s0, 0, 0, 0); s1 = __builtin_amdgcn_mfma_f32_16x16x32_bf16(kb1, bq1, s1, 0, 0, 0);
              s2 = __builtin_amdgcn_mfma_f32_16x16x32_bf16(kc1, bq1, s2, 0, 0, 0); s3 = __builtin_amdgcn_mfma_f32_16x16x32_bf16(kd1, bq1, s3, 0, 0, 0); }
            const int lmi = max(max(max(imax3(s0[0], s0[1], s0[2]), imax3(s0[3], s1[0], s1[1])), max(imax3(s1[2], s1[3], s2[0]), imax3(s2[1], s2[2], s2[3]))), max(imax3(s3[0], s3[1], s3[2]), __float_as_int(s3[3])));
            if (first || __any(lmi > 0x41000000)) {
                float lmx = fmaxf(fmaxf(fmaxf(fmaxf(s0[0], s0[1]), fmaxf(s0[2], s0[3])), fmaxf(fmaxf(s1[0], s1[1]), fmaxf(s1[2], s1[3]))), fmaxf(fmaxf(fmaxf(s2[0], s2[1]), fmaxf(s2[2], s2[3])), fmaxf(fmaxf(s3[0], s3[1]), fmaxf(s3[2], s3[3]))));
                { const auto r1 = __builtin_amdgcn_permlane16_swap(__float_as_uint(lmx), __float_as_uint(lmx), false, false); lmx = fmaxf(__uint_as_float(r1[0]), __uint_as_float(r1[1])); }
                { const auto r2 = __builtin_amdgcn_permlane32_swap(__float_as_uint(lmx), __float_as_uint(lmx), false, false); lmx = fmaxf(__uint_as_float(r2[0]), __uint_as_float(r2[1])); }
                const float dl = first ? lmx : fmaxf(lmx, 0.f);
                m_run += dl; const float f = first ? 1.0f : __builtin_amdgcn_exp2f(-dl);
#pragma unroll
                for (int i = 0; i < 4; ++i) { s0[i] -= dl; s1[i] -= dl; s2[i] -= dl; s3[i] -= dl; negm[i] = -m_run; }
                lacc = lacc * f;
#pragma unroll
                for (int dt = 0; dt < 4; ++dt) o[dt] = o[dt] * f;
                first = false;
            }
            const u32x2 mk0 = *(LAS const u32x2*)(mlut + ((mwA & 15) << 3)), mk1 = *(LAS const u32x2*)(mlut + (((mwA >> 16) & 15) << 3));
            const u32x2 mk2 = *(LAS const u32x2*)(mlut + ((mwB & 15) << 3)), mk3 = *(LAS const u32x2*)(mlut + (((mwB >> 16) & 15) << 3));
            u32x4 pwA, pwB;
            pwA.x = cvtpk(__builtin_amdgcn_exp2f(s0[0]), __builtin_amdgcn_exp2f(s0[1])) & mk0.x; pwA.y = cvtpk(__builtin_amdgcn_exp2f(s0[2]), __builtin_amdgcn_exp2f(s0[3])) & mk0.y;
            pwA.z = cvtpk(__builtin_amdgcn_exp2f(s1[0]), __builtin_amdgcn_exp2f(s1[1])) & mk1.x; pwA.w = cvtpk(__builtin_amdgcn_exp2f(s1[2]), __builtin_amdgcn_exp2f(s1[3])) & mk1.y;
            pwB.x = cvtpk(__builtin_amdgcn_exp2f(s2[0]), __builtin_amdgcn_exp2f(s2[1])) & mk2.x; pwB.y = cvtpk(__builtin_amdgcn_exp2f(s2[2]), __builtin_amdgcn_exp2f(s2[3])) & mk2.y;
            pwB.z = cvtpk(__builtin_amdgcn_exp2f(s3[0]), __builtin_amdgcn_exp2f(s3[1])) & mk3.x; pwB.w = cvtpk(__builtin_amdgcn_exp2f(s3[2]), __builtin_amdgcn_exp2f(s3[3])) & mk3.y;
            const bf16x8v pfA = __builtin_bit_cast(bf16x8v, pwA), pfB = __builtin_bit_cast(bf16x8v, pwB);
            lacc = __builtin_amdgcn_mfma_f32_16x16x32_bf16(ones, pfA, lacc, 0, 0, 0);
            lacc = __builtin_amdgcn_mfma_f32_16x16x32_bf16(ones, pfB, lacc, 0, 0, 0);
#pragma unroll
            for (int dt = 0; dt < 4; ++dt) {
                const s16x4v lo = lds_tr16(slot + vofs + dt * 1024), hi = lds_tr16(slot + vofs + dt * 1024 + 512);
                const s16x4v lo2 = lds_tr16(slot + 4096 + vofs + dt * 1024), hi2 = lds_tr16(slot + 4096 + vofs + dt * 1024 + 512);
                const bf16x8v vf = {lo[0], lo[1], lo[2], lo[3], hi[0], hi[1], hi[2], hi[3]};
                const bf16x8v vf2 = {lo2[0], lo2[1], lo2[2], lo2[3], hi2[0], hi2[1], hi2[2], hi2[3]};
                o[dt] = __builtin_amdgcn_mfma_f32_16x16x32_bf16(vf, pfA, o[dt], 0, 0, 0);
                o[dt] = __builtin_amdgcn_mfma_f32_16x16x32_bf16(vf2, pfB, o[dt], 0, 0, 0);
            }
        }
        asm volatile("s_waitcnt vmcnt(0) lgkmcnt(0)" ::: "memory");
        __syncthreads();
    }
#undef DSA_STAGE
    const float inv = 1.0f / lacc[0];
    bf16* yrow = p.Y + ((size_t)b * SEQ + q0 + r16) * DM + 512 + h * 64;
#pragma unroll
    for (int dt = 0; dt < 4; ++dt) {
        const u32x2 gw = gwv[dt];
        const float g0 = __uint_as_float(gw.x << 16), g1 = __uint_as_float(gw.x & 0xffff0000u), g2 = __uint_as_float(gw.y << 16), g3 = __uint_as_float(gw.y & 0xffff0000u);
        u32x2 w; w.x = pk2(o[dt][0] * inv * siluf(g0), o[dt][1] * inv * siluf(g1)); w.y = pk2(o[dt][2] * inv * siluf(g2), o[dt][3] * inv * siluf(g3));
        *(u32x2*)(yrow + dt * 16 + 4 * g) = w;
    }
    __syncthreads();
    }
}
__device__ __forceinline__ int dsa_qt_of(int j, int i) { return (i == 0) ? 127 - j : (i == 1) ? 64 + j : (i == 2) ? 63 - j : j; }
__device__ __forceinline__ void dsa_phase_pre(const P& p, LAS unsigned char* lds) {
    const int G = gridDim.x, wg = blockIdx.x, lane = threadIdx.x & 63, wave = __builtin_amdgcn_readfirstlane(threadIdx.x >> 6);
    const int b = (G == 256) ? (wg & 7) : (wg >> 7), qt = (G == 256) ? dsa_qt_of(wg >> 3, 0) : 127 - (wg & 127);
    if (wg < 1024 && qt >= TOPK / 16) dsa_prefetch_qi(p.Z + (size_t)b * SEQ * ZP, qt, lds, wave, lane);
}
__device__ __forceinline__ void dsa_phase(const P& p, LAS unsigned char* lds) {
    const int G = gridDim.x, wg = blockIdx.x;
    if (G == 256) {
        const int b = wg & 7, j = wg >> 3, lane = threadIdx.x & 63, wave = __builtin_amdgcn_readfirstlane(threadIdx.x >> 6);
        bf16x8v pk[4] = {{0, 0, 0, 0, 0, 0, 0, 0}, {0, 0, 0, 0, 0, 0, 0, 0}, {0, 0, 0, 0, 0, 0, 0, 0}, {0, 0, 0, 0, 0, 0, 0, 0}};
        if (dsa_qt_of(j, 0) >= TOPK / 16) dsa_prefetch_ki(p.Z + (size_t)b * SEQ * ZP, dsa_qt_of(j, 0), pk, wave, lane);
#pragma unroll 1
        for (int i = 0; i < 4; ++i) dsa_unit(p, b, dsa_qt_of(j, i), (i < 3) ? dsa_qt_of(j, i + 1) : -1, pk, lds);
    }
}
constexpr int LRU_WS_OFF = 139264;
constexpr int LRU_XB = 264 * 128;
constexpr int LRU_GB = 256 * 32;
constexpr int LRU_BUF = LRU_XB + LRU_GB;
__device__ __forceinline__ float fast_sigm(float x) { return __builtin_amdgcn_rcpf(1.0f + __expf(-x)); }
__device__ __forceinline__ void lru_unit(const P& p, int l, int b, int blk, int q4, LAS unsigned char* lds) {
    const int tid = threadIdx.x, lane = tid & 63, wave = __builtin_amdgcn_readfirstlane(tid >> 6), r16 = lane & 15, g = lane >> 4;
    const bf16* zb = p.Z + (size_t)b * SEQ * ZP;
    const int cA = blk * 64, dloc = q4 * 16 + r16, dg = blk * 64 + dloc;
    const unsigned lds_base = (unsigned)(uintptr_t)lds;
#define LRU_STAGE(r) do { const unsigned bb_ = lds_base + (unsigned)(((r) & 1) * LRU_BUF); \
        _Pragma("unroll") for (int i_ = 0; i_ < 5; ++i_) { const int pc_ = wave + 8 * i_; if (pc_ < 33) { const int rho_ = pc_ * 8 + (lane >> 3); int t_ = (r) * 256 - 3 + rho_; t_ = t_ < 0 ? 0 : (t_ > SEQ - 1 ? SEQ - 1 : t_); \
            const int ch_ = (lane & 7) ^ ((rho_ >> 1) & 7); glds16(zb + (size_t)t_ * ZP + C_XR + cA + ch_ * 8, (unsigned)__builtin_amdgcn_readfirstlane(bb_ + pc_ * 1024)); } } \
        { const int row_ = wave * 32 + (lane >> 1); glds16(zb + (size_t)((r) * 256 + row_) * ZP + C_GR + dg - r16 + (lane & 1) * 8, (unsigned)__builtin_amdgcn_readfirstlane(bb_ + LRU_XB + wave * 1024)); } } while (0)
    LRU_STAGE(0);
    float cwA[2][4][8], cbA[2][8];
#pragma unroll
    for (int s = 0; s < 2; ++s)
#pragma unroll
        for (int j = 0; j < 8; ++j) { const int c = cA + 32 * s + 8 * g + j; cbA[s][j] = p.conv_b[l * 512 + c];
#pragma unroll
            for (int k = 0; k < 4; ++k) cwA[s][k][j] = p.conv_w[(l * 4 + k) * 512 + c]; }
    bf16x8v bxf[2], baf[2];
#pragma unroll
    for (int s = 0; s < 2; ++s) { u32x4 wx, wa; unsigned tx[8], ta[8];
#pragma unroll
        for (int j = 0; j < 8; ++j) { const size_t idx = (((size_t)l * 8 + blk) * 64 + 32 * s + 8 * g + j) * 64 + dloc; tx[j] = f2bf(p.lru_wx[idx]); ta[j] = f2bf(p.lru_wa[idx]); }
        wx.x = tx[0] | (tx[1] << 16); wx.y = tx[2] | (tx[3] << 16); wx.z = tx[4] | (tx[5] << 16); wx.w = tx[6] | (tx[7] << 16);
        wa.x = ta[0] | (ta[1] << 16); wa.y = ta[2] | (ta[3] << 16); wa.z = ta[4] | (ta[5] << 16); wa.w = ta[6] | (ta[7] << 16);
        bxf[s] = __builtin_bit_cast(bf16x8v, wx); baf[s] = __builtin_bit_cast(bf16x8v, wa); }
    const float cw0 = p.conv_w[(l * 4 + 0) * 512 + dg], cw1 = p.conv_w[(l * 4 + 1) * 512 + dg], cw2 = p.conv_w[(l * 4 + 2) * 512 + dg], cw3 = p.conv_w[(l * 4 + 3) * 512 + dg];
    const float cb = p.conv_b[l * 512 + dg], bxv = p.lru_bx[l * 512 + dg], bav = p.lru_ba[l * 512 + dg];
    const float sp8 = -8.0f * log1pf(expf(-p.lru_a[l * 512 + dg]));
    asm volatile("" :: "v"(cwA[0][0][0]), "v"(cwA[1][3][7]), "v"(cbA[1][7]), "v"(bxf[0]), "v"(bxf[1]), "v"(baf[0]), "v"(baf[1]), "v"(cw0), "v"(cw1), "v"(cw2), "v"(cw3), "v"(cb), "v"(bxv), "v"(bav), "v"(sp8));
    LAS float* WS = (LAS float*)(lds + LRU_WS_OFF);
    float hrun = 0.f;
#pragma unroll 1
    for (int round = 0; round < 8; ++round) {
        asm volatile("s_waitcnt vmcnt(0)" ::: "memory");
        __syncthreads();
        if (round + 1 < 8) LRU_STAGE(round + 1);
        LAS const unsigned char* xb = lds + (round & 1) * LRU_BUF; LAS const unsigned char* gb = xb + LRU_XB;
        const int tw = round * 256 + wave * 32;
        float hl[2][4], pl[2][4], gr4[2][4], PT[2], HT[2], PE[2], HE[2];
#pragma unroll
        for (int tau = 0; tau < 2; ++tau) {
            const int t0 = tw + 16 * tau, rho0 = wave * 32 + 16 * tau;
            bf16x8v af[2];
#pragma unroll
            for (int s = 0; s < 2; ++s) {
                float xc[8];
#pragma unroll
                for (int j = 0; j < 8; ++j) xc[j] = cbA[s][j];
#pragma unroll
                for (int k = 0; k < 4; ++k) { const int rho = rho0 + r16 + k; u32x4 w = *(LAS const u32x4*)(xb + rho * 128 + (((4 * s + g) ^ (rho >> 1)) & 7) * 16);
                    if (t0 + r16 - 3 + k < 0) w = (u32x4){0u, 0u, 0u, 0u};
                    xc[0] += cwA[s][k][0] * __uint_as_float(w.x << 16); xc[1] += cwA[s][k][1] * __uint_as_float(w.x & 0xffff0000u);
                    xc[2] += cwA[s][k][2] * __uint_as_float(w.y << 16); xc[3] += cwA[s][k][3] * __uint_as_float(w.y & 0xffff0000u);
                    xc[4] += cwA[s][k][4] * __uint_as_float(w.z << 16); xc[5] += cwA[s][k][5] * __uint_as_float(w.z & 0xffff0000u);
                    xc[6] += cwA[s][k][6] * __uint_as_float(w.w << 16); xc[7] += cwA[s][k][7] * __uint_as_float(w.w & 0xffff0000u); }
                u32x4 pw; pw.x = cvtpk(xc[0], xc[1]); pw.y = cvtpk(xc[2], xc[3]); pw.z = cvtpk(xc[4], xc[5]); pw.w = cvtpk(xc[6], xc[7]);
                af[s] = __builtin_bit_cast(bf16x8v, pw);
            }
            f32x4 gx = {0.f, 0.f, 0.f, 0.f}, ga = {0.f, 0.f, 0.f, 0.f};
            gx = __builtin_amdgcn_mfma_f32_16x16x32_bf16(af[0], bxf[0], gx, 0, 0, 0); gx = __builtin_amdgcn_mfma_f32_16x16x32_bf16(af[1], bxf[1], gx, 0, 0, 0);
            ga = __builtin_amdgcn_mfma_f32_16x16x32_bf16(af[0], baf[0], ga, 0, 0, 0); ga = __builtin_amdgcn_mfma_f32_16x16x32_bf16(af[1], baf[1], ga, 0, 0, 0);
            float xo[7];
#pragma unroll
            for (int m = 0; m < 7; ++m) { const int rho = rho0 + 4 * g + m;
                const unsigned short v = *(LAS const unsigned short*)(xb + rho * 128 + (((dloc >> 3) ^ (rho >> 1)) & 7) * 16 + (dloc & 7) * 2);
                xo[m] = (t0 + 4 * g - 3 + m >= 0) ? bf2f(v) : 0.f; }
            float Pr = 1.f, Hr = 0.f;
#pragma unroll
            for (int i = 0; i < 4; ++i) {
                const float xcv = cb + cw0 * xo[i] + cw1 * xo[i + 1] + cw2 * xo[i + 2] + cw3 * xo[i + 3];
                const float sx = fast_sigm(gx[i] + bxv), sa = fast_sigm(ga[i] + bav);
                const float la = sp8 * sa, a = __expf(la), y2 = 2.0f * la;
                const float ser = -y2 * (1.0f + y2 * (0.5f + y2 * (0.16666667f + y2 * (0.041666668f + y2 * (0.0083333338f + y2 * 0.0013888889f)))));
                const float em = (y2 > -0.25f) ? ser : (1.0f - __expf(y2));
                const float u = __builtin_amdgcn_sqrtf(em) * sx * xcv;
                Hr = a * Hr + u; Pr *= a; hl[tau][i] = Hr; pl[tau][i] = Pr;
                gr4[tau][i] = bf2f(*(LAS const unsigned short*)(gb + (rho0 + 4 * g + i) * 32 + r16 * 2));
            }
            float Pi = Pr, Hi = Hr;
            { const float Pl = __shfl_up(Pi, 16), Hl = __shfl_up(Hi, 16); if (g >= 1) { Hi = Pi * Hl + Hi; Pi = Pl * Pi; } }
            { const float Pl = __shfl_up(Pi, 32), Hl = __shfl_up(Hi, 32); if (g >= 2) { Hi = Pi * Hl + Hi; Pi = Pl * Pi; } }
            float Pe = __shfl_up(Pi, 16), He = __shfl_up(Hi, 16); if (g == 0) { Pe = 1.f; He = 0.f; }
            PT[tau] = __shfl(Pi, 48 + r16); HT[tau] = __shfl(Hi, 48 + r16); PE[tau] = Pe; HE[tau] = He;
        }
        HE[1] = PE[1] * HT[0] + HE[1]; PE[1] = PT[0] * PE[1];
        const float Pw = PT[0] * PT[1], Hw = PT[1] * HT[0] + HT[1];
        LAS float* wsr = WS + (round & 1) * 256;
        if (g == 0) { wsr[(wave * 16 + r16) * 2 + 0] = Pw; wsr[(wave * 16 + r16) * 2 + 1] = Hw; }
        asm volatile("s_waitcnt lgkmcnt(0)" ::: "memory");
        __builtin_amdgcn_s_barrier();
        asm volatile("" ::: "memory");
        float hc = hrun, hall = hrun;
#pragma unroll
        for (int w2 = 0; w2 < 8; ++w2) { if (w2 == wave) hc = hall; hall = wsr[(w2 * 16 + r16) * 2 + 0] * hall + wsr[(w2 * 16 + r16) * 2 + 1]; }
        hrun = hall;
#pragma unroll
        for (int tau = 0; tau < 2; ++tau) {
            const float hin = PE[tau] * hc + HE[tau];
            bf16* yp = p.Y + ((size_t)b * SEQ + tw + 16 * tau + 4 * g) * DM + dg;
#pragma unroll
            for (int i = 0; i < 4; ++i) { const float h = hl[tau][i] + pl[tau][i] * hin, gr = gr4[tau][i]; yp[(size_t)i * DM] = (bf16)f2bf(h * gr * fast_sigm(gr)); }
        }
    }
#undef LRU_STAGE
    asm volatile("s_waitcnt vmcnt(0)" ::: "memory");
    __syncthreads();
}
__device__ __forceinline__ void lru_phase(const P& p, int l, LAS unsigned char* lds) {
    const int G = gridDim.x, wg = blockIdx.x;
#pragma unroll 1
    for (int u = wg; u < 256; u += G) lru_unit(p, l, (u >> 3) & 7, u & 7, u >> 6, lds);
}
#ifndef DSA_PHASE
#define DSA_PHASE dsa_phase
#endif
#ifndef LRU_PHASE
#define LRU_PHASE lru_phase
#endif
#ifndef RP_A
#define RP_A 1
#endif
#ifndef RP_L
#define RP_L 1
#endif
#ifndef RP_D
#define RP_D 1
#endif
#ifndef RP_C
#define RP_C 1
#endif
#ifndef RP_0
#define RP_0 1
#endif
struct Args { const float* in[15]; float* out; unsigned char* ws; int ph_lo, ph_hi; };
__global__ void __launch_bounds__(512, 2) mega(Args a) {
    extern __shared__ __attribute__((aligned(16))) unsigned char lds_raw[];
    LAS unsigned char* lds = (LAS unsigned char*)lds_raw;
    P p;
    p.x = a.in[0]; p.c = a.in[1]; p.norm_g = a.in[2]; p.ada_w = a.in[3]; p.ada_b = a.in[4]; p.w_in = a.in[5]; p.conv_w = a.in[6]; p.conv_b = a.in[7];
    p.lru_wx = a.in[8]; p.lru_bx = a.in[9]; p.lru_wa = a.in[10]; p.lru_ba = a.in[11]; p.lru_a = a.in[12]; p.w_out = a.in[13]; p.final_g = a.in[14];
    p.out = a.out; unsigned char* ws = a.ws;
    p.ctl = (unsigned*)(ws + WS_CTL); p.mod = (float*)(ws + WS_MOD); p.bias = (float*)(ws + WS_BIAS); p.ssq = (float*)(ws + WS_SSQ);
    p.wt_in = (bf16*)(ws + WS_WTIN); p.wt_out = (bf16*)(ws + WS_WTOUT); p.A = (bf16*)(ws + WS_A); p.Z = (bf16*)(ws + WS_Z); p.Y = (bf16*)(ws + WS_Y);
    const int lo = a.ph_lo, hi = a.ph_hi;
    volatile LAS unsigned* MISC = (volatile LAS unsigned*)(lds + MISC_OFF + 4096);
    if (threadIdx.x < 4) MISC[threadIdx.x] = 0u;
    if (threadIdx.x < 16) { const unsigned t = threadIdx.x; u32x2 m; m.x = ((t & 1u) ? 0xffffu : 0u) | ((t & 2u) ? 0xffff0000u : 0u); m.y = ((t & 4u) ? 0xffffu : 0u) | ((t & 8u) ? 0xffff0000u : 0u);
        *(LAS u32x2*)(lds + DSA_MLUT_OFF + t * 8) = m; }
    __syncthreads();
    XcdBarrier bar; bar.bar = p.ctl + CW_BAR; bar.x = 0; bar.st = MISC;
    if (hi - lo > 1) bar = xcd_barrier_post(p.ctl + CW_BAR, MISC);
#define IN(k) (lo <= (k) && (k) < hi)
#ifndef N_CG_SEAMS
#define N_CG_SEAMS 0
#endif
#define SEAM(k) do { if (IN(k) && IN((k) + 1)) { if ((k) < N_CG_SEAMS) cg::this_grid().sync(); else xcd_barrier(bar); } } while (0)
    if (IN(0)) { ph0_prologue(p, lds); if (RP_0 > 1) { __syncthreads(); ph0_prologue(p, lds); } }
    SEAM(0);
    if (IN(1)) { ph1_prologue(p, lds); if (RP_0 > 1) { __syncthreads(); ph1_prologue(p, lds); } }
    SEAM(1);
#define LAYER(l, base) \
    if (IN(base)) { \
        pg8::Gemm g{p.A, p.wt_in + (size_t)(l) * ZP * 1024, MROWS, ZP, DM}; pg8::StaticOrder S; S.init(MROWS, ZP, (int)gridDim.x, (int)blockIdx.x); \
        EpiZ E{p.Z, p.ssq, p.bias + (size_t)(l) * 8 * ZP}; \
        pg8::gemm_phase<EpiZ, pg8::StaticOrder, PG8_ALIGN, PG8_SP2>(lds, g, S, E); if (RP_A > 1) { __syncthreads(); pg8::gemm_phase<EpiZ, pg8::StaticOrder, PG8_ALIGN, PG8_SP2>(lds, g, S, E); } \
    } \
    SEAM(base); \
    if (IN((base) + 1)) { dsa_phase_pre(p, lds); LRU_PHASE(p, (l), lds); __syncthreads(); if (RP_L > 1) { LRU_PHASE(p, (l), lds); __syncthreads(); } DSA_PHASE(p, lds); if (RP_D > 1) { __syncthreads(); DSA_PHASE(p, lds); } } \
    SEAM((base) + 1); \
    if (IN((base) + 2)) { \
        pg8::Gemm g{p.Y, p.wt_out + (size_t)(l) * 1024 * 1024, MROWS, DM, DM}; pg8::StaticOrder S; S.init(MROWS, DM, (int)gridDim.x, (int)blockIdx.x); \
        if constexpr ((l) == DEPTH - 1) { \
            EpiXF E{p.out, p.out, p.mod + (size_t)(l) * 8 * 3072 + 2048, p.final_g, p.ssq, p.ctl + CW_PANEL}; \
            pg8::gemm_phase<EpiXF, pg8::StaticOrder, false, PG8_SP2>(lds, g, S, E); \
        } else { \
            EpiX E{(l) == 0 ? p.x : p.out, p.out, p.A, p.mod + (size_t)(l) * 8 * 3072 + 2048, p.norm_g + (size_t)((l) + 1) * 1024, p.mod + (size_t)((l) + 1) * 8 * 3072 + 1024, p.ssq}; \
            pg8::gemm_phase<EpiX, pg8::StaticOrder, false, PG8_SP2>(lds, g, S, E); if (RP_C > 1 && (l) == 0) { __syncthreads(); pg8::gemm_phase<EpiX, pg8::StaticOrder, false, PG8_SP2>(lds, g, S, E); } \
        } \
    } \
    if ((base) + 3 < NPHASE) SEAM((base) + 2);
    LAYER(0, 2)
    LAYER(1, 5)
}
#ifndef MK_N_LAUNCHES
#define MK_N_LAUNCHES 1
#endif
extern "C" void kernel_launch(void* const* d_in, const int* in_sizes, int n_in, void* d_out, int out_size, void* d_ws, size_t ws_size, hipStream_t stream) {
    static int grid = 0;
    if (grid == 0) {
        if (n_in != 15 || out_size != MROWS * DM || ws_size < WS_END) { fprintf(stderr, "kernel_launch: unexpected problem (n_in %d out %d ws %zu)\n", n_in, out_size, ws_size); grid = -1; return; }
        int dev = 0, cus = 0, per_cu = 0;
        hipGetDevice(&dev); hipDeviceGetAttribute(&cus, hipDeviceAttributeMultiprocessorCount, dev);
        if (hipFuncSetAttribute((const void*)mega, hipFuncAttributeMaxDynamicSharedMemorySize, LDS_BYTES) != hipSuccess) { fprintf(stderr, "kernel_launch: hipFuncSetAttribute failed\n"); grid = -1; return; }
        if (hipOccupancyMaxActiveBlocksPerMultiprocessor(&per_cu, (const void*)mega, 512, LDS_BYTES) != hipSuccess || per_cu < 1) { fprintf(stderr, "kernel_launch: occupancy query failed (%d)\n", per_cu); per_cu = 1; }
        (void)hipGetLastError();
        grid = cus * per_cu;
        if (grid != 256) fprintf(stderr, "kernel_launch: grid %d (cus %d x %d) != 256: the fused out-projection epilogue needs exactly 256 workgroups\n", grid, cus, per_cu);
    }
    if (grid < 0) return;
    hipMemsetAsync((char*)d_ws + WS_CTL, 0, CTL_ZERO_BYTES, stream);
    Args a{};
    for (int i = 0; i < 15; ++i) a.in[i] = (const float*)d_in[i];
    a.out = (float*)d_out; a.ws = (unsigned char*)d_ws;
#if MK_N_LAUNCHES == 1
    a.ph_lo = 0; a.ph_hi = NPHASE;
    void* args[] = {&a};
    hipError_t e = hipLaunchCooperativeKernel((const void*)mega, dim3(grid), dim3(512), args, LDS_BYTES, stream);
    if (e != hipSuccess) fprintf(stderr, "cooperative launch failed: %s (grid %d)\n", hipGetErrorString(e), grid);
#else
    for (int ph = 0; ph < NPHASE; ++ph) { a.ph_lo = ph; a.ph_hi = ph + 1; hipLaunchKernelGGL(mega, dim3(grid), dim3(512), LDS_BYTES, stream, a); }
#endif
}
```

```cpp
#include <hip/hip_runtime.h>
#include <hip/hip_cooperative_groups.h>
#include <cstdio>
#include <cstdint>
#include <cmath>
namespace cg = cooperative_groups;

namespace pg8 {
#define PG8_LAS __attribute__((address_space(3)))
typedef unsigned short bf16_t;
typedef short bf16x8 __attribute__((ext_vector_type(8)));
typedef float f32x4 __attribute__((ext_vector_type(4)));
typedef unsigned u32x4 __attribute__((ext_vector_type(4)));
constexpr int BM = 256, BK = 64, HALF = 128, HTB = HALF * BK * 2  , STAGE_BYTES = 8 * HTB, NXCD = 8, WGM = 8;

__host__ __device__ __forceinline__ int lds_byte(int r, int c) { const int st = (r >> 4) * 2 + (c >> 5), rr = r & 15, cc = c & 31, ob = rr * 64 + cc * 2; return st * 1024 + (ob ^ (((ob >> 9) & 1) << 5)); }
__host__ __device__ __forceinline__ void stage_rc(int b, int& R, int& C) { const int st = b / 1024, sb = b % 1024, swz = sb ^ (((sb >> 9) & 1) << 5); R = (st >> 1) * 16 + swz / 64; C = (st & 1) * 32 + (swz % 64) / 2; }
__host__ __device__ __forceinline__ int perm32(int rho) { const int n = rho >> 4, i = rho & 15; return 8 * (i >> 2) + 4 * n + (i & 3); }

struct Unit { int pm, pn; };
struct Gemm { const bf16_t* A; const bf16_t* Bt; int M, N, K; };

struct StaticOrder {
    int nM, nN, nwg, G, c;
    __host__ __device__ void init(int M, int N, int G_, int c_) { nM = M / BM; nN = N / BM; nwg = nM * nN; G = G_; c = c_; }
    __host__ __device__ bool next(int i, Unit& u) const {
        const long L = (long)i * G + c; if (L >= nwg) return false;
        int wgid = (int)L; { const int q = nwg / NXCD, r = nwg % NXCD, xcd = wgid % NXCD, off = wgid / NXCD; wgid = (xcd < r ? xcd * (q + 1) : r * (q + 1) + (xcd - r) * q) + off; }
        const int nig = WGM * nN, gid = wgid / nig, fm = gid * WGM, gsz = (nM - fm) < WGM ? (nM - fm) : WGM;
        u.pm = fm + ((wgid % nig) % gsz); u.pn = (wgid % nig) / gsz; return true;
    }
    __device__ __forceinline__ void a_ready(const Unit&) const {}
    __device__ __forceinline__ void done(const Unit&) const {}
};

__device__ __forceinline__ unsigned cvt_pk_bf16(float lo, float hi) { unsigned r; asm volatile("v_cvt_pk_bf16_f32 %0, %1, %2" : "=v"(r) : "v"(lo), "v"(hi)); return r; }
typedef float f32x2 __attribute__((ext_vector_type(2)));
template <class Epi, class Sched, bool ALIGN_EPI = false, bool SP2 = false>
__device__ __forceinline__ void gemm_phase(PG8_LAS unsigned char* lds, const Gemm g, const Sched& S, const Epi& E) {
    const int tid = threadIdx.x, wid = __builtin_amdgcn_readfirstlane(tid >> 6), lane = tid & 63, wr = wid >> 2, wc = wid & 3, fr = lane & 15, fq = lane >> 4;
    const int K = g.K, nt = K / BK;
    unsigned voffA[2], voffB[2];
#pragma unroll
    for (int i = 0; i < 2; ++i) { int R, C; stage_rc(tid * 16 + i * 8192, R, C); const int Rb = Epi::PERM ? ((R & ~31) + perm32(R & 31)) : R;
        voffA[i] = (unsigned)(R * K + C) * 2u; voffB[i] = (unsigned)(Rb * K + C) * 2u; }
    const size_t kstep = (size_t)(BK * 2);
    const size_t hstep = (size_t)HALF * K * 2;
    const size_t tstep = 2 * hstep;
    const unsigned ldsw = (unsigned)wid * 1024u;
    const int aoff = lds_byte(wr * 64 + fr, fq * 8), boff = lds_byte(wc * 32 + fr, fq * 8);
#define PG8_SA(b, h) (((b) * 2 + (h)) * HTB)
#define PG8_SB(b, h) ((4 + (b) * 2 + (h)) * HTB)
#define PG8_STAGE(bufoff, gbase, voff) do { _Pragma("unroll") for (int _i = 0; _i < 2; ++_i) \
        __builtin_amdgcn_global_load_lds((const unsigned*)((const char*)(gbase) + (voff)[_i]), (PG8_LAS unsigned*)(lds + (bufoff) + ldsw + _i * 8192), 16, 0, 0); } while (0)
#define PG8_LDA(dst, b, h) do { _Pragma("unroll") for (int m = 0; m < 4; ++m) _Pragma("unroll") for (int k = 0; k < 2; ++k) dst[m][k] = *(const PG8_LAS bf16x8*)(lds + PG8_SA(b, h) + aoff + m * 2048 + k * 1024); } while (0)
#define PG8_LDB(dst, b, h) do { _Pragma("unroll") for (int n = 0; n < 2; ++n) _Pragma("unroll") for (int k = 0; k < 2; ++k) dst[n][k] = *(const PG8_LAS bf16x8*)(lds + PG8_SB(b, h) + boff + n * 2048 + k * 1024); } while (0)
#define PG8_MMA(ai, bj, At, Bt) do { __builtin_amdgcn_s_setprio(1); _Pragma("unroll") for (int m = 0; m < 4; ++m) _Pragma("unroll") for (int n = 0; n < 2; ++n) _Pragma("unroll") for (int k = 0; k < 2; ++k) \
        acc[ai][bj][m][n] = __builtin_amdgcn_mfma_f32_16x16x32_bf16(Bt[n][k], At[m][k], acc[ai][bj][m][n], 0, 0, 0); __builtin_amdgcn_s_setprio(0); } while (0)
#define PG8_WAIT_V(n) asm volatile("s_waitcnt vmcnt(" #n ")" ::: "memory")
#define PG8_WAIT_L(n) asm volatile("s_waitcnt lgkmcnt(" #n ")" ::: "memory")
#define PG8_BAR __builtin_amdgcn_s_barrier()
#define PG8_SCHED __builtin_amdgcn_sched_barrier(0)
    Unit cur, nxt; int ui = 0;
    if (!S.next(0, cur)) return;
    f32x4 acc[2][2][4][2];
#pragma unroll
    for (int a = 0; a < 2; ++a)
#pragma unroll
        for (int b = 0; b < 2; ++b)
#pragma unroll
            for (int m = 0; m < 4; ++m)
#pragma unroll
                for (int n = 0; n < 2; ++n) acc[a][b][m][n] = (f32x4){0.f, 0.f, 0.f, 0.f};
    bf16x8 At[4][2], B0[2][2], B1[2][2];
    const char* cA = (const char*)g.A + (size_t)cur.pm * tstep; const char* cB = (const char*)g.Bt + (size_t)cur.pn * tstep;
    S.a_ready(cur);
    if constexpr (SP2) {
        PG8_STAGE(PG8_SB(0, 0), cB, voffB); PG8_STAGE(PG8_SB(0, 1), cB + hstep, voffB); PG8_STAGE(PG8_SA(0, 0), cA, voffA); PG8_STAGE(PG8_SA(0, 1), cA + hstep, voffA);
        if (wr == 1) PG8_BAR;
        PG8_WAIT_V(2); PG8_BAR;
        PG8_STAGE(PG8_SB(1, 0), cB + kstep, voffB); PG8_STAGE(PG8_SA(1, 0), cA + kstep, voffA); PG8_STAGE(PG8_SB(1, 1), cB + hstep + kstep, voffB);
        PG8_WAIT_V(6); PG8_BAR;
    } else {
        PG8_STAGE(PG8_SB(0, 0), cB, voffB); PG8_STAGE(PG8_SA(0, 0), cA, voffA); PG8_STAGE(PG8_SB(0, 1), cB + hstep, voffB); PG8_STAGE(PG8_SA(0, 1), cA + hstep, voffA);
        if (wr == 1) PG8_BAR;
        PG8_WAIT_V(4); PG8_BAR;
        PG8_STAGE(PG8_SB(1, 0), cB + kstep, voffB); PG8_STAGE(PG8_SA(1, 0), cA + kstep, voffA); PG8_STAGE(PG8_SB(1, 1), cB + hstep + kstep, voffB);
        PG8_WAIT_V(6); PG8_BAR;
    }
    for (;;) {
        const bool has_next = S.next(ui + 1, nxt);
        const char* nA = has_next ? (const char*)g.A + (size_t)nxt.pm * tstep : cA; const char* nB = has_next ? (const char*)g.Bt + (size_t)nxt.pn * tstep : cB;
        for (int t = 0; t < nt; t += 2) {
            const bool last = (t == nt - 2);
            const char* a1 = cA + (size_t)(t + 1) * kstep;
            const char* a2 = last ? nA : cA + (size_t)(t + 2) * kstep; const char* b2 = last ? nB : cB + (size_t)(t + 2) * kstep;
            const char* a3 = a2 + kstep; const char* b3 = b2 + kstep;
            if (last && has_next) S.a_ready(nxt);
            if constexpr (SP2) {
            PG8_LDB(B0, 0, 0); PG8_LDB(B1, 0, 1); PG8_SCHED; PG8_LDA(At, 0, 0); PG8_STAGE(PG8_SA(1, 1), a1 + hstep, voffA);
            PG8_WAIT_V(8); PG8_WAIT_L(0); PG8_BAR; PG8_MMA(0, 0, At, B0); PG8_MMA(0, 1, At, B1); PG8_BAR; PG8_SCHED;
            PG8_LDA(At, 0, 1); PG8_STAGE(PG8_SB(0, 0), b2, voffB); PG8_STAGE(PG8_SB(0, 1), b2 + hstep, voffB); PG8_STAGE(PG8_SA(0, 0), a2, voffA);
            PG8_WAIT_V(8); PG8_WAIT_L(0); PG8_BAR; PG8_MMA(1, 0, At, B0); PG8_MMA(1, 1, At, B1); PG8_BAR; PG8_SCHED;
            PG8_LDB(B0, 1, 0); PG8_LDB(B1, 1, 1); PG8_SCHED; PG8_LDA(At, 1, 0); PG8_STAGE(PG8_SA(0, 1), a2 + hstep, voffA);
            PG8_WAIT_V(8); PG8_WAIT_L(0); PG8_BAR; PG8_MMA(0, 0, At, B0); PG8_MMA(0, 1, At, B1); PG8_BAR; PG8_SCHED;
            PG8_LDA(At, 1, 1); PG8_STAGE(PG8_SB(1, 0), b3, voffB); PG8_STAGE(PG8_SB(1, 1), b3 + hstep, voffB); PG8_STAGE(PG8_SA(1, 0), a3, voffA);
            PG8_WAIT_V(8); PG8_WAIT_L(0); PG8_BAR; PG8_MMA(1, 0, At, B0); PG8_MMA(1, 1, At, B1); PG8_BAR; PG8_SCHED;
            } else {
            PG8_LDB(B0, 0, 0); PG8_SCHED; PG8_LDA(At, 0, 0); PG8_STAGE(PG8_SA(1, 1), a1 + hstep, voffA);
            PG8_WAIT_L(8); PG8_BAR; PG8_WAIT_L(0); PG8_MMA(0, 0, At, B0); PG8_BAR; PG8_SCHED;
            PG8_LDB(B1, 0, 1); PG8_STAGE(PG8_SB(0, 0), b2, voffB);
            PG8_BAR; PG8_WAIT_L(0); PG8_MMA(0, 1, At, B1); PG8_BAR;
            PG8_LDA(At, 0, 1); PG8_STAGE(PG8_SA(0, 0), a2, voffA);
            PG8_BAR; PG8_WAIT_L(0); PG8_MMA(1, 0, At, B0); PG8_BAR; PG8_SCHED;
            PG8_STAGE(PG8_SB(0, 1), b2 + hstep, voffB);
            PG8_WAIT_V(6); PG8_BAR; PG8_MMA(1, 1, At, B1); PG8_BAR;
            PG8_LDB(B0, 1, 0); PG8_SCHED; PG8_LDA(At, 1, 0); PG8_STAGE(PG8_SA(0, 1), a2 + hstep, voffA);
            PG8_WAIT_L(8); PG8_BAR; PG8_WAIT_L(0); PG8_MMA(0, 0, At, B0); PG8_BAR; PG8_SCHED;
            PG8_LDB(B1, 1, 1); PG8_STAGE(PG8_SB(1, 0), b3, voffB);
            PG8_BAR; PG8_WAIT_L(0); PG8_MMA(0, 1, At, B1); PG8_BAR;
            PG8_LDA(At, 1, 1); PG8_STAGE(PG8_SA(1, 0), a3, voffA);
            PG8_BAR; PG8_WAIT_L(0); PG8_MMA(1, 0, At, B0); PG8_BAR; PG8_SCHED;
            PG8_STAGE(PG8_SB(1, 1), b3 + hstep, voffB);
            PG8_WAIT_V(6); PG8_BAR; PG8_MMA(1, 1, At, B1); PG8_BAR;
            }
        }
        if constexpr (ALIGN_EPI) { if (wr == 0) PG8_BAR; }
        if constexpr (!Epi::AFTER_DRAIN) { E(acc, cur, wr, wc, fr, fq); S.done(cur); }
        if (!has_next) break;
#pragma unroll
        for (int a = 0; a < 2; ++a)
#pragma unroll
            for (int b = 0; b < 2; ++b)
#pragma unroll
                for (int m = 0; m < 4; ++m)
#pragma unroll
                    for (int n = 0; n < 2; ++n) acc[a][b][m][n] = (f32x4){0.f, 0.f, 0.f, 0.f};
        cur = nxt; cA = nA; cB = nB; ++ui;
        if constexpr (ALIGN_EPI) { if (wr == 1) PG8_BAR; }
    }
    PG8_WAIT_V(0);
    if constexpr (!ALIGN_EPI) { if (wr == 0) PG8_BAR; }
    PG8_BAR;
    if constexpr (Epi::AFTER_DRAIN) { E.fused(acc, cur, wr, wc, fr, fq, lds, wid, lane); S.done(cur); }
#undef PG8_SA
#undef PG8_SB
#undef PG8_STAGE
#undef PG8_LDA
#undef PG8_LDB
#undef PG8_MMA
#undef PG8_WAIT_V
#undef PG8_WAIT_L
#undef PG8_BAR
#undef PG8_SCHED
}
}

#ifndef PG8_SP2
#define PG8_SP2 true
#endif
#ifndef PG8_ALIGN
#define PG8_ALIGN true
#endif
constexpr int BATCH = 8, SEQ = 2048, DM = 1024, MROWS = BATCH * SEQ, DEPTH = 2;
constexpr int D_RNN = 512, NHEAD = 8, HDIM = 64, D_INR = 2760, ZP = 2816, TOPK = 256;
constexpr int C_XR = 0, C_GR = 512, C_Q = 1024, C_K = 1536, C_V = 1600, C_GA = 1664, C_QI = 2176, C_KI = 2688, C_WI = 2752;
constexpr float EPS = 1e-6f;
constexpr float QSCALE = 0.125f * 1.4426950408889634f;
constexpr size_t MiB = 1u << 20;
constexpr size_t WS_CTL = 0, CTL_ZERO_BYTES = 1 * MiB;
constexpr size_t WS_MOD = 1 * MiB;
constexpr size_t WS_BIAS = 1 * MiB + 256 * 1024;
constexpr size_t WS_SSQ = 2 * MiB;
constexpr size_t WS_WTIN = 3 * MiB;
constexpr size_t WS_WTOUT = 14 * MiB;
constexpr size_t WS_A = 32 * MiB;
constexpr size_t WS_Z = 64 * MiB;
constexpr size_t WS_Y = 152 * MiB;
constexpr size_t WS_END = 184 * MiB;
constexpr int LDS_BYTES = 163840;
constexpr int MISC_OFF = 131072 + 8192;
constexpr int NPHASE = 8;
constexpr int CW_BAR = 4096, CW_PANEL = 16384;

#define LAS __attribute__((address_space(3)))
typedef unsigned short bf16;
typedef float f32x4 __attribute__((ext_vector_type(4)));
typedef unsigned u32x4 __attribute__((ext_vector_type(4)));
typedef unsigned u32x2 __attribute__((ext_vector_type(2)));
__device__ __forceinline__ float bf2f(bf16 v) { return __uint_as_float(((unsigned)v) << 16); }
__device__ __forceinline__ unsigned f2bf(float f) { unsigned u = __float_as_uint(f); return (u + 0x7fffu + ((u >> 16) & 1u)) >> 16; }
__device__ __forceinline__ unsigned pk2(float lo, float hi) { return f2bf(lo) | (f2bf(hi) << 16); }
__device__ __forceinline__ float wave_sum(float v) {
#pragma unroll
    for (int o = 1; o < 64; o <<= 1) v += __shfl_xor(v, o);
    return v;
}
__device__ __forceinline__ float wave_max(float v) {
#pragma unroll
    for (int o = 1; o < 64; o <<= 1) v = fmaxf(v, __shfl_xor(v, o));
    return v;
}
__device__ __forceinline__ int wave_sum_i(int v) {
#pragma unroll
    for (int o = 1; o < 64; o <<= 1) v += __shfl_xor(v, o);
    return v;
}
__device__ __forceinline__ float siluf(float v) { return v / (1.f + expf(-v)); }
__device__ __forceinline__ float sigmf(float v) { return 1.f / (1.f + expf(-v)); }

struct P {
    const float *x, *c, *norm_g, *ada_w, *ada_b, *w_in, *conv_w, *conv_b, *lru_wx, *lru_bx, *lru_wa, *lru_ba, *lru_a, *w_out, *final_g;
    float* out;
    float *mod, *bias, *ssq;
    bf16 *wt_in, *wt_out, *A, *Z, *Y;
    unsigned* ctl;
};

struct EpiZ {
    static constexpr bool PERM = true, AFTER_DRAIN = false;
    bf16* Zp; const float* ssq; const float* bias;
    __device__ __forceinline__ void operator()(const pg8::f32x4 (&acc)[2][2][4][2], const pg8::Unit& u, int wr, int wc, int fr, int fq) const {
        const int row0 = u.pm * 256 + wr * 64 + fr, col0 = u.pn * 256 + wc * 32 + 8 * fq, b = u.pm >> 3;
        const float cs = (u.pn == 4 || u.pn == 5) ? QSCALE : 1.0f;
        f32x4 bv[2][2];
#pragma unroll
        for (int bj = 0; bj < 2; ++bj)
#pragma unroll
            for (int n = 0; n < 2; ++n) bv[bj][n] = *(const f32x4*)(bias + b * ZP + col0 + bj * 128 + 4 * n);
#pragma unroll
        for (int ai = 0; ai < 2; ++ai)
#pragma unroll
            for (int m = 0; m < 4; ++m) {
                const int r = row0 + ai * 128 + m * 16;
                const f32x4 q = *(const f32x4*)(ssq + (size_t)r * 4);
                const float rstd = 1.0f / sqrtf(((q.x + q.y) + (q.z + q.w)) * (1.0f / 1024.0f) + EPS);
                bf16* rowp = Zp + (size_t)r * ZP + col0;
#pragma unroll
                for (int bj = 0; bj < 2; ++bj) {
                    const f32x4 v0 = (acc[ai][bj][m][0] * rstd + bv[bj][0]) * cs, v1 = (acc[ai][bj][m][1] * rstd + bv[bj][1]) * cs;
                    u32x4 w; w.x = pk2(v0[0], v0[1]); w.y = pk2(v0[2], v0[3]); w.z = pk2(v1[0], v1[1]); w.w = pk2(v1[2], v1[3]);
                    *(u32x4*)(rowp + bj * 128) = w;
                }
            }
    }
};
struct EpiX {
    static constexpr bool PERM = true, AFTER_DRAIN = true;
    const float* xres; float* xout; bf16* Anext; const float* gate; const float* ng; const float* nscale; float* ssq;
    __device__ __forceinline__ void fused(pg8::f32x4 (&acc)[2][2][4][2], const pg8::Unit& u, int wr, int wc, int fr, int fq, LAS unsigned char* lds, int wid, int lane) const {
        const int b = u.pm >> 3, col0 = u.pn * 256 + wc * 32 + 8 * fq;
        LAS float* Pp = (LAS float*)lds;
        f32x4 gv[2][2], gs[2][2];
#pragma unroll
        for (int bj = 0; bj < 2; ++bj)
#pragma unroll
            for (int n = 0; n < 2; ++n) {
                gv[bj][n] = *(const f32x4*)(gate + b * 3072 + col0 + bj * 128 + 4 * n);
                if (Anext) { const f32x4 g = *(const f32x4*)(ng + col0 + bj * 128 + 4 * n), s = *(const f32x4*)(nscale + b * 3072 + col0 + bj * 128 + 4 * n); gs[bj][n] = g * (s + 1.0f); }
                else gs[bj][n] = (f32x4){0.f, 0.f, 0.f, 0.f};
            }
#pragma unroll
        for (int ai = 0; ai < 2; ++ai)
#pragma unroll
            for (int m = 0; m < 4; ++m) {
                const int rl = ai * 128 + wr * 64 + m * 16 + fr; const size_t r = (size_t)u.pm * 256 + rl;
                float s = 0.f;
#pragma unroll
                for (int bj = 0; bj < 2; ++bj) {
                    f32x4 x1[2];
#pragma unroll
                    for (int n = 0; n < 2; ++n) {
                        const f32x4 xr = *(const f32x4*)(xres + r * DM + col0 + bj * 128 + 4 * n);
                        x1[n] = xr + gv[bj][n] * acc[ai][bj][m][n];
                        *(f32x4*)(xout + r * DM + col0 + bj * 128 + 4 * n) = x1[n];
                        s += (x1[n][0] * x1[n][0] + x1[n][1] * x1[n][1]) + (x1[n][2] * x1[n][2] + x1[n][3] * x1[n][3]);
                    }
                    if (Anext) { const f32x4 a0 = x1[0] * gs[bj][0], a1 = x1[1] * gs[bj][1];
                        u32x4 w; w.x = pk2(a0[0], a0[1]); w.y = pk2(a0[2], a0[3]); w.z = pk2(a1[0], a1[1]); w.w = pk2(a1[2], a1[3]);
                        *(u32x4*)(Anext + r * DM + col0 + bj * 128) = w; }
                }
                s += __shfl_xor(s, 16); s += __shfl_xor(s, 32);
                if (fq == 0) Pp[rl * 4 + wc] = s;
            }
        __syncthreads();
        const int tid = wid * 64 + lane;
        if (tid < 256) ssq[((size_t)u.pm * 256 + tid) * 4 + u.pn] = (Pp[tid * 4 + 0] + Pp[tid * 4 + 1]) + (Pp[tid * 4 + 2] + Pp[tid * 4 + 3]);
        __syncthreads();
    }
};

struct EpiXF {
    static constexpr bool PERM = true, AFTER_DRAIN = true;
    const float* xres; float* out; const float* gate; const float* fg; float* ssq; unsigned* cnt;
    __device__ __forceinline__ void fused(pg8::f32x4 (&acc)[2][2][4][2], const pg8::Unit& u, int wr, int wc, int fr, int fq, LAS unsigned char* lds, int wid, int lane) const {
        const int b = u.pm >> 3, col0 = u.pn * 256 + wc * 32 + 8 * fq, tid = wid * 64 + lane;
        LAS float* Pp = (LAS float*)lds;
        LAS float* Sr = (LAS float*)(lds + 4096);
        {
            f32x4 gv[2][2];
#pragma unroll
            for (int bj = 0; bj < 2; ++bj)
#pragma unroll
                for (int n = 0; n < 2; ++n) gv[bj][n] = *(const f32x4*)(gate + b * 3072 + col0 + bj * 128 + 4 * n);
#pragma unroll
            for (int ai = 0; ai < 2; ++ai)
#pragma unroll
                for (int m = 0; m < 4; ++m) {
                    const int rl = ai * 128 + wr * 64 + m * 16 + fr; const size_t r = (size_t)u.pm * 256 + rl;
                    float s = 0.f;
#pragma unroll
                    for (int bj = 0; bj < 2; ++bj)
#pragma unroll
                        for (int n = 0; n < 2; ++n) {
                            const f32x4 xr = *(const f32x4*)(xres + r * DM + col0 + bj * 128 + 4 * n);
                            const f32x4 x1 = xr + gv[bj][n] * acc[ai][bj][m][n];
                            acc[ai][bj][m][n] = x1;
                            s += (x1[0] * x1[0] + x1[1] * x1[1]) + (x1[2] * x1[2] + x1[3] * x1[3]);
                        }
                    s += __shfl_xor(s, 16); s += __shfl_xor(s, 32);
                    if (fq == 0) Pp[rl * 4 + wc] = s;
                }
        }
        __syncthreads();
        if (tid < 256) { const float tot = (Pp[tid * 4 + 0] + Pp[tid * 4 + 1]) + (Pp[tid * 4 + 2] + Pp[tid * 4 + 3]);
            __hip_atomic_store(ssq + ((size_t)u.pm * 256 + tid) * 4 + u.pn, tot, __ATOMIC_RELAXED, __HIP_MEMORY_SCOPE_AGENT); }
        asm volatile("s_waitcnt vmcnt(0)" ::: "memory");
        __syncthreads();
        if (tid == 0) {
            unsigned* c = cnt + 64 * u.pm;
            __hip_atomic_fetch_add(c, 1u, __ATOMIC_RELAXED, __HIP_MEMORY_SCOPE_AGENT);
            unsigned spins = 0u;
            while (__hip_atomic_load(c, __ATOMIC_RELAXED, __HIP_MEMORY_SCOPE_AGENT) < 4u) { __builtin_amdgcn_s_sleep(2); if (++spins > (1u << 22)) break; }
            __builtin_amdgcn_fence(__ATOMIC_ACQUIRE, "agent");
            asm volatile("s_waitcnt vmcnt(0)" ::: "memory");
        }
        __syncthreads();
        if (tid < 256) { const float* sp = ssq + ((size_t)u.pm * 256 + tid) * 4;
            const float q0 = __hip_atomic_load(sp + 0, __ATOMIC_RELAXED, __HIP_MEMORY_SCOPE_AGENT), q1 = __hip_atomic_load(sp + 1, __ATOMIC_RELAXED, __HIP_MEMORY_SCOPE_AGENT);
            const float q2 = __hip_atomic_load(sp + 2, __ATOMIC_RELAXED, __HIP_MEMORY_SCOPE_AGENT), q3 = __hip_atomic_load(sp + 3, __ATOMIC_RELAXED, __HIP_MEMORY_SCOPE_AGENT);
            Sr[tid] = 1.0f / sqrtf(((q0 + q1) + (q2 + q3)) * (1.0f / 1024.0f) + EPS); }
        __syncthreads();
        f32x4 fgv[2][2];
#pragma unroll
        for (int bj = 0; bj < 2; ++bj)
#pragma unroll
            for (int n = 0; n < 2; ++n) fgv[bj][n] = *(const f32x4*)(fg + col0 + bj * 128 + 4 * n);
#pragma unroll
        for (int ai = 0; ai < 2; ++ai)
#pragma unroll
            for (int m = 0; m < 4; ++m) {
                const int rl = ai * 128 + wr * 64 + m * 16 + fr; const size_t r = (size_t)u.pm * 256 + rl; const float rstd = Sr[rl];
#pragma unroll
                for (int bj = 0; bj < 2; ++bj)
#pragma unroll
                    for (int n = 0; n < 2; ++n) *(f32x4*)(out + r * DM + col0 + bj * 128 + 4 * n) = acc[ai][bj][m][n] * rstd * fgv[bj][n];
            }
        __syncthreads();
    }
};

__device__ __forceinline__ void ph0_prologue(const P& p, LAS unsigned char* lds) {
    const int tid = threadIdx.x, lane = tid & 63, wave = tid >> 6, G = gridDim.x, wg = blockIdx.x;
    LAS float* fl = (LAS float*)lds;
    for (int u = wg; u < 96; u += G) {
        const int l = u / 48, j = (u % 48) * 64 + lane;
        for (int i = tid; i < 8192; i += 512) fl[i] = siluf(p.c[i]);
        __syncthreads();
        float acc[8];
#pragma unroll
        for (int b = 0; b < 8; ++b) acc[b] = 0.f;
        const float* w = p.ada_w + ((size_t)l * 1024 + wave * 128) * 3072 + j;
        for (int k = 0; k < 128; ++k) { const float wv = w[(size_t)k * 3072];
#pragma unroll
            for (int b = 0; b < 8; ++b) acc[b] += fl[b * 1024 + wave * 128 + k] * wv; }
#pragma unroll
        for (int b = 0; b < 8; ++b) fl[8192 + (wave * 8 + b) * 64 + lane] = acc[b];
        __syncthreads();
        { const int b = wave; float s = p.ada_b[l * 3072 + j];
#pragma unroll
          for (int w8 = 0; w8 < 8; ++w8) s += fl[8192 + (w8 * 8 + b) * 64 + lane];
          p.mod[(l * 8 + b) * 3072 + j] = s; }
        __syncthreads();
    }
#pragma unroll 1
    for (int u0 = wg; u0 < 1920; u0 += 2 * G) {
        float v[2][8]; bf16* dst[2]; bool act[2];
#pragma unroll
        for (int q = 0; q < 2; ++q) {
            const int u = u0 + q * G; act[q] = u < 1920; dst[q] = nullptr;
#pragma unroll
            for (int j = 0; j < 8; ++j) v[q][j] = 0.f;
            if (act[q]) {
                const float* W; bf16* WT; int N, kt, nt;
                if (u < 1408) { const int l = u / 704, r = u % 704; kt = r / 44; nt = r % 44; W = p.w_in + (size_t)l * 1024 * D_INR; N = D_INR; WT = p.wt_in + (size_t)l * ZP * 1024; }
                else { int r = u - 1408; const int l = r / 256; r %= 256; kt = r / 16; nt = r % 16; W = p.w_out + (size_t)l * 1024 * 1024; N = 1024; WT = p.wt_out + (size_t)l * 1024 * 1024; }
                const int n = nt * 64 + lane, k0 = kt * 64 + wave * 8;
                if (n < N) {
#pragma unroll
                    for (int j = 0; j < 8; ++j) v[q][j] = W[(size_t)(k0 + j) * N + n];
                }
                dst[q] = WT + (size_t)n * 1024 + k0;
            }
        }
#pragma unroll
        for (int q = 0; q < 2; ++q) if (act[q]) { u32x4 o; o.x = pk2(v[q][0], v[q][1]); o.y = pk2(v[q][2], v[q][3]); o.z = pk2(v[q][4], v[q][5]); o.w = pk2(v[q][6], v[q][7]); *(u32x4*)dst[q] = o; }
    }
}
__device__ __forceinline__ void ph1_prologue(const P& p, LAS unsigned char* lds) {
    const int tid = threadIdx.x, lane = tid & 63, wave = tid >> 6, G = gridDim.x, wg = blockIdx.x;
    LAS float* fl = (LAS float*)lds;
    for (int u = wg; u < 88; u += G) {
        const int l = u / 44, n = (u % 44) * 64 + lane;
        for (int i = tid; i < 8192; i += 512) fl[i] = p.mod[(l * 8 + (i >> 10)) * 3072 + (i & 1023)];
        __syncthreads();
        float acc[8];
#pragma unroll
        for (int b = 0; b < 8; ++b) acc[b] = 0.f;
        if (n < D_INR) { const float* w = p.w_in + ((size_t)l * 1024 + wave * 128) * D_INR + n;
            for (int k = 0; k < 128; ++k) { const float wv = w[(size_t)k * D_INR];
#pragma unroll
                for (int b = 0; b < 8; ++b) acc[b] += fl[b * 1024 + wave * 128 + k] * wv; } }
#pragma unroll
        for (int b = 0; b < 8; ++b) fl[8192 + (wave * 8 + b) * 64 + lane] = acc[b];
        __syncthreads();
        { const int b = wave; float s = 0.f;
#pragma unroll
          for (int w8 = 0; w8 < 8; ++w8) s += fl[8192 + (w8 * 8 + b) * 64 + lane];
          p.bias[(l * 8 + b) * ZP + n] = s; }
        __syncthreads();
    }
#pragma unroll 1
    for (int r = wg * 8 + wave; r < MROWS; r += G * 16) {
        const int r2 = (r + G * 8 < MROWS) ? r + G * 8 : r; const int b1 = r >> 11, b2 = r2 >> 11;
        f32x4 va[4], vb[4];
#pragma unroll
        for (int j = 0; j < 4; ++j) { const int k = (lane + 64 * j) * 4; va[j] = *(const f32x4*)(p.x + (size_t)r * DM + k); vb[j] = *(const f32x4*)(p.x + (size_t)r2 * DM + k); }
        float s1 = 0.f, s2 = 0.f;
#pragma unroll
        for (int j = 0; j < 4; ++j) { const int k = (lane + 64 * j) * 4;
            const f32x4 g = *(const f32x4*)(p.norm_g + k), sc1 = *(const f32x4*)(p.mod + (size_t)b1 * 3072 + 1024 + k), sc2 = *(const f32x4*)(p.mod + (size_t)b2 * 3072 + 1024 + k);
            s1 += (va[j][0] * va[j][0] + va[j][1] * va[j][1]) + (va[j][2] * va[j][2] + va[j][3] * va[j][3]);
            s2 += (vb[j][0] * vb[j][0] + vb[j][1] * vb[j][1]) + (vb[j][2] * vb[j][2] + vb[j][3] * vb[j][3]);
            const f32x4 o1 = va[j] * g * (sc1 + 1.0f), o2 = vb[j] * g * (sc2 + 1.0f);
            u32x2 w1, w2; w1.x = pk2(o1[0], o1[1]); w1.y = pk2(o1[2], o1[3]); w2.x = pk2(o2[0], o2[1]); w2.y = pk2(o2[2], o2[3]);
            *(u32x2*)(p.A + (size_t)r * DM + k) = w1; if (r2 != r) *(u32x2*)(p.A + (size_t)r2 * DM + k) = w2; }
        s1 = wave_sum(s1); s2 = wave_sum(s2);
        if (lane == 0) { *(f32x4*)(p.ssq + (size_t)r * 4) = (f32x4){s1, 0.f, 0.f, 0.f}; if (r2 != r) *(f32x4*)(p.ssq + (size_t)r2 * 4) = (f32x4){s2, 0.f, 0.f, 0.f}; }
    }
}
__device__ __forceinline__ void ph_final(const P& p) {
    const int tid = threadIdx.x, lane = tid & 63, wave = tid >> 6, G = gridDim.x, wg = blockIdx.x;
    for (int r = wg * 8 + wave; r < MROWS; r += G * 8) {
        const f32x4 q = *(const f32x4*)(p.ssq + (size_t)r * 4);
        const float rstd = 1.0f / sqrtf(((q.x + q.y) + (q.z + q.w)) * (1.0f / 1024.0f) + EPS);
#pragma unroll
        for (int j = 0; j < 4; ++j) { const int k = (lane + 64 * j) * 4;
            const f32x4 v = *(const f32x4*)(p.out + (size_t)r * DM + k), g = *(const f32x4*)(p.final_g + k);
            *(f32x4*)(p.out + (size_t)r * DM + k) = v * rstd * g; }
    }
}
#define XB_TMO      128
#define XB_XCNT(j)  (256  + 64 * (j))
#define XB_XSUB(j)  (1280 + 64 * (j))
#define XB_XGEN(j)  (2304 + 64 * (j))
#define XB_TOP      3328
#define XB_TOPGEN   3392
#define XCD_BAR_WORDS 3456
#define XB_SPIN_CAP (1u << 18)

__device__ __forceinline__ unsigned xb_ld(unsigned* p)              { return __hip_atomic_load(p, __ATOMIC_RELAXED, __HIP_MEMORY_SCOPE_AGENT); }
__device__ __forceinline__ unsigned xb_add(unsigned* p, unsigned v) { return __hip_atomic_fetch_add(p, v, __ATOMIC_RELAXED, __HIP_MEMORY_SCOPE_AGENT); }
__device__ __forceinline__ unsigned xb_xcc_id() { return (unsigned)__builtin_amdgcn_s_getreg((3 << 11) | 20) & 0xFu; }
#define XB_SPIN(cond, bar) do { unsigned _sp = 0; while (cond) { __builtin_amdgcn_s_sleep(1); \
    if ((++_sp & 255u) == 0u) { if (xb_ld(&(bar)[XB_TMO])) break; if (_sp > XB_SPIN_CAP) { atomicAdd(&(bar)[XB_TMO], 1u); break; } } } } while (0)

struct XcdBarrier {
    unsigned* bar; unsigned x;
    volatile LAS unsigned* st;
};

__device__ __forceinline__ XcdBarrier xcd_barrier_post(unsigned* bar, volatile LAS unsigned* st) {
    XcdBarrier b; b.bar = bar; b.x = xb_xcc_id(); b.st = st;
    if (threadIdx.x == 0) (void)xb_add(&bar[XB_XCNT(b.x)], 1u);
    return b;
}
__device__ __forceinline__ void xcd_barrier_complete(unsigned* bar, unsigned x, unsigned& nloc, unsigned& nx) {
    const unsigned G = gridDim.x * gridDim.y * gridDim.z;
    unsigned sum, cnt, mine, sp = 0u;
    for (;;) {
        sum = 0u; cnt = 0u; mine = 0u;
#pragma unroll
        for (unsigned j = 0; j < 16; ++j) { const unsigned c = xb_ld(&bar[XB_XCNT(j)]); sum += c; cnt += (c > 0u) ? 1u : 0u; mine = (j == x) ? c : mine; }
        if (sum == G) break;
        __builtin_amdgcn_s_sleep(1);
        if ((++sp & 255u) == 0u) { if (xb_ld(&bar[XB_TMO])) break; if (sp > XB_SPIN_CAP) { atomicAdd(&bar[XB_TMO], 1u); break; } }
    }
    nloc = mine > 0u ? mine : 1u; nx = cnt > 0u ? cnt : 1u;
}

__device__ __forceinline__ void xcd_barrier(const XcdBarrier& b) {
    asm volatile("s_waitcnt vmcnt(0)" ::: "memory");
    __syncthreads();
    if (threadIdx.x == 0) {
        unsigned* bar = b.bar;
        __builtin_amdgcn_s_waitcnt(0);
        unsigned nloc = b.st[0], nx = b.st[1];
        if (nloc == 0u) { xcd_barrier_complete(bar, b.x, nloc, nx); b.st[0] = nloc; b.st[1] = nx; }
        const unsigned old = xb_add(&bar[XB_XSUB(b.x)], 1u);
        const unsigned gen = old / nloc;
        if (old + 1u == (gen + 1u) * nloc) {
            __builtin_amdgcn_fence(__ATOMIC_RELEASE, "agent");
            asm volatile("s_waitcnt vmcnt(0)" ::: "memory");
            const unsigned og = xb_add(&bar[XB_TOP], 1u);
            const unsigned tg = og / nx;
            if (og + 1u == (tg + 1u) * nx) xb_add(&bar[XB_TOPGEN], 1u);
            else XB_SPIN(xb_ld(&bar[XB_TOPGEN]) == tg, bar);
            __builtin_amdgcn_fence(__ATOMIC_ACQUIRE, "agent");
            xb_add(&bar[XB_XGEN(b.x)], 1u);
            asm volatile("s_waitcnt vmcnt(0)" ::: "memory");
        } else {
            XB_SPIN(xb_ld(&bar[XB_XGEN(b.x)]) == gen, bar);
            __builtin_amdgcn_fence(__ATOMIC_ACQUIRE, "agent");
            asm volatile("s_waitcnt vmcnt(0)" ::: "memory");
        }
    }
    __syncthreads();
}
__device__ __forceinline__ unsigned score_ukey(float s) { const unsigned u = __float_as_uint(s + 0.0f); return (u & 0x80000000u) ? ~u : (u | 0x80000000u); }
__device__ __forceinline__ void topk_threshold(const unsigned (&k)[32], unsigned& thr, unsigned& need) {
    unsigned prefix = 0u; bool exact = false;
    for (int bit = 31; bit >= 0; --bit) {
        const unsigned cand = prefix | (1u << bit);
        int c = 0;
#pragma unroll
        for (int i = 0; i < 32; ++i) c += (k[i] >= cand) ? 1 : 0;
        c = wave_sum_i(c);
        if (c >= TOPK) prefix = cand;
        if (c == TOPK) { exact = true; break; }
    }
    thr = prefix;
    if (exact) { need = 0xffffffffu; }
    else { int c = 0;
#pragma unroll
        for (int i = 0; i < 32; ++i) c += (k[i] > prefix) ? 1 : 0;
        c = wave_sum_i(c); need = (unsigned)(TOPK - c); }
}
#ifndef PROBE_VALU
#define PROBE_VALU 0
#endif
#ifndef RP_T3
#define RP_T3 1
#endif
#ifndef RP_T1
#define RP_T1 1
#endif
#ifndef RP_T2
#define RP_T2 1
#endif
#ifndef RP_I
#define RP_I 1
#endif
#ifndef RP_T
#define RP_T 1
#endif
#ifndef RP_V
#define RP_V 1
#endif
typedef short bf16x8v __attribute__((ext_vector_type(8)));
typedef short s16x4v __attribute__((ext_vector_type(4)));
constexpr int BMS = 65;
constexpr int SCP = 2052;
constexpr int DSA_BM_OFF = 16 * SCP * 4;
constexpr int DSA_RING_OFF = 0;
constexpr int DSA_QIB_OFF = 147456;
constexpr int DSA_WIB_OFF = 135680;
constexpr int DSA_MLUT_OFF = 143616;
__device__ __forceinline__ void glds16(const void* gsrc, unsigned lds_dst) { unsigned keep;
    asm volatile("s_mov_b32 %0, m0\n\ts_mov_b32 m0, %2\n\ts_nop 0\n\tglobal_load_lds_dwordx4 %1, off\n\ts_mov_b32 m0, %0" : "=&s"(keep) : "v"(gsrc), "s"(lds_dst) : "memory"); }
template <int I> __device__ __forceinline__ unsigned mbit_t(int mw) { unsigned r; asm("v_bfe_i32 %0, %1, %2, 1" : "=v"(r) : "v"(mw), "i"(I)); return r; }
#define mbit(mw, i) mbit_t<(i)>(mw)
__device__ __forceinline__ float relu_i(float x) { return __int_as_float(max(__float_as_int(x), 0)); }
__device__ __forceinline__ int imax3(float a, float b, float c) { return max(max(__float_as_int(a), __float_as_int(b)), __float_as_int(c)); }
__device__ __forceinline__ s16x4v lds_tr16(LAS const unsigned char* p) { return __builtin_bit_cast(s16x4v, __builtin_amdgcn_ds_read_tr16_b64_v4i16((LAS s16x4v*)p)); }
__device__ __forceinline__ unsigned cvtpk(float lo, float hi) { typedef float f2 __attribute__((ext_vector_type(2))); typedef __bf16 b2 __attribute__((ext_vector_type(2))); f2 v = {lo, hi}; b2 r = __builtin_convertvector(v, b2); return __builtin_bit_cast(unsigned, r); }


template <int L> __device__ __forceinline__ void wr2lanes(int& w, unsigned lo, unsigned hi) {
    asm volatile("s_nop 1\n\tv_writelane_b32 %0, %1, %3\n\tv_writelane_b32 %0, %2, %4" : "+v"(w) : "s"(lo), "s"(hi), "i"(L), "i"(L + 1));
}
__device__ __forceinline__ int wave_sum_dpp(int v) {
    v += __builtin_amdgcn_update_dpp(0, v, 0xB1, 0xf, 0xf, true);
    v += __builtin_amdgcn_update_dpp(0, v, 0x4E, 0xf, 0xf, true);
    v += __builtin_amdgcn_update_dpp(0, v, 0x141, 0xf, 0xf, true);
    v += __builtin_amdgcn_update_dpp(0, v, 0x140, 0xf, 0xf, true);
    return __builtin_amdgcn_readlane(v, 0) + __builtin_amdgcn_readlane(v, 16) + __builtin_amdgcn_readlane(v, 32) + __builtin_amdgcn_readlane(v, 48);
}
__device__ __forceinline__ unsigned wave_max_dpp(unsigned v) {
    v = max(v, (unsigned)__builtin_amdgcn_update_dpp(0, (int)v, 0xB1, 0xf, 0xf, true));
    v = max(v, (unsigned)__builtin_amdgcn_update_dpp(0, (int)v, 0x4E, 0xf, 0xf, true));
    v = max(v, (unsigned)__builtin_amdgcn_update_dpp(0, (int)v, 0x141, 0xf, 0xf, true));
    v = max(v, (unsigned)__builtin_amdgcn_update_dpp(0, (int)v, 0x140, 0xf, 0xf, true));
    return max(max((unsigned)__builtin_amdgcn_readlane((int)v, 0), (unsigned)__builtin_amdgcn_readlane((int)v, 16)), max((unsigned)__builtin_amdgcn_readlane((int)v, 32), (unsigned)__builtin_amdgcn_readlane((int)v, 48)));
}
__device__ __forceinline__ int cnt8(int acc, unsigned cand, unsigned k0, unsigned k1, unsigned k2, unsigned k3, unsigned k4, unsigned k5, unsigned k6, unsigned k7) {
    unsigned long long m0, m1, m2, m3, m4, m5, m6, m7;
    asm volatile("v_cmp_le_u32_e64 %1, %9, %10\n\tv_cmp_le_u32_e64 %2, %9, %11\n\tv_cmp_le_u32_e64 %3, %9, %12\n\tv_cmp_le_u32_e64 %4, %9, %13\n\t"
                 "v_cmp_le_u32_e64 %5, %9, %14\n\tv_cmp_le_u32_e64 %6, %9, %15\n\tv_cmp_le_u32_e64 %7, %9, %16\n\tv_cmp_le_u32_e64 %8, %9, %17\n\t"
                 "v_addc_co_u32_e64 %0, %1, 0, %0, %1\n\tv_addc_co_u32_e64 %0, %2, 0, %0, %2\n\tv_addc_co_u32_e64 %0, %3, 0, %0, %3\n\tv_addc_co_u32_e64 %0, %4, 0, %0, %4\n\t"
                 "v_addc_co_u32_e64 %0, %5, 0, %0, %5\n\tv_addc_co_u32_e64 %0, %6, 0, %0, %6\n\tv_addc_co_u32_e64 %0, %7, 0, %0, %7\n\tv_addc_co_u32_e64 %0, %8, 0, %0, %8"
                 : "+v"(acc), "=&s"(m0), "=&s"(m1), "=&s"(m2), "=&s"(m3), "=&s"(m4), "=&s"(m5), "=&s"(m6), "=&s"(m7)
                 : "s"(cand), "v"(k0), "v"(k1), "v"(k2), "v"(k3), "v"(k4), "v"(k5), "v"(k6), "v"(k7));
    return acc;
}
__device__ __forceinline__ int count_ge(const unsigned (&k)[32], unsigned cand_, int nb) {
    const unsigned cand = (unsigned)__builtin_amdgcn_readfirstlane((int)cand_);
    int c = 0;
    c = cnt8(c, cand, k[0], k[1], k[2], k[3], k[4], k[5], k[6], k[7]);
    if (nb > 1) c = cnt8(c, cand, k[8], k[9], k[10], k[11], k[12], k[13], k[14], k[15]);
    if (nb > 2) c = cnt8(c, cand, k[16], k[17], k[18], k[19], k[20], k[21], k[22], k[23]);
    if (nb > 3) c = cnt8(c, cand, k[24], k[25], k[26], k[27], k[28], k[29], k[30], k[31]);
    return wave_sum_dpp(c);
}
struct TopkState { unsigned prefix; int bit; bool done; unsigned need; int nb; };
__device__ __forceinline__ void topk_init(const unsigned (&k)[32], TopkState& st) {
    unsigned mx = 0u;
#pragma unroll
    for (int i = 0; i < 32; ++i) mx = max(mx, k[i]);
    mx = wave_max_dpp(mx);
    st.prefix = 0u; st.bit = 31; st.done = false; st.need = 0u;
    unsigned E = mx >> 23;
#pragma unroll 1
    for (int j = 0; j < 4; ++j) {
        if (E < (unsigned)j + 1u) break;
        const unsigned T = (E - (unsigned)j) << 23;
        const int c = count_ge(k, T, st.nb);
        if (c >= TOPK) { st.prefix = T; st.bit = 22; if (c == TOPK) { st.done = true; st.need = 0xffffffffu; } break; }
    }
}
__device__ __forceinline__ void topk_step(const unsigned (&k)[32], TopkState& st) {
    if (st.done) return;
    if (st.bit < 0) { int c = 0;
#pragma unroll
        for (int i = 0; i < 32; ++i) c += (k[i] > st.prefix) ? 1 : 0;
        c = wave_sum_dpp(c); st.need = (unsigned)(TOPK - c); st.done = true; return; }
    const unsigned cand = st.prefix | (1u << st.bit);
    const int c = count_ge(k, cand, st.nb);
    if (c >= TOPK) st.prefix = cand;
    if (c == TOPK) { st.done = true; st.need = 0xffffffffu; }
    --st.bit;
}

__device__ __forceinline__ void dsa_prefetch_qi(const bf16* zb, int qt, LAS unsigned char* lds, int wave, int lane) {
    const unsigned lds_base = (unsigned)(uintptr_t)lds;
#pragma unroll
    for (int i = 0; i < 2; ++i) { const int row = 2 * wave + i;
        glds16(zb + (size_t)(qt * 16 + row) * ZP + C_QI + ((lane ^ row) * 8), (unsigned)__builtin_amdgcn_readfirstlane(lds_base + DSA_QIB_OFF + row * 1024)); }
    if (wave == 0) glds16(zb + (size_t)(qt * 16 + (lane & 15)) * ZP + C_WI, (unsigned)__builtin_amdgcn_readfirstlane(lds_base + DSA_WIB_OFF));
}

__device__ __forceinline__ void dsa_prefetch_ki(const bf16* zb, int qt, bf16x8v (&pk)[4], int wave, int lane) {
    const int r16 = lane & 15, g = lane >> 4;
    if (wave <= qt) { const bf16* krow = zb + (size_t)(wave * 16 + r16) * ZP + C_KI; pk[0] = *(const bf16x8v*)(krow + 8 * g); pk[1] = *(const bf16x8v*)(krow + 32 + 8 * g); }
    if (wave + 8 <= qt) { const bf16* krow = zb + (size_t)((wave + 8) * 16 + r16) * ZP + C_KI; pk[2] = *(const bf16x8v*)(krow + 8 * g); pk[3] = *(const bf16x8v*)(krow + 32 + 8 * g); }
}

__device__ __forceinline__ void dsa_unit(const P& p, int b, int qt, int qt_next, bf16x8v (&pk)[4], LAS unsigned char* lds) {
    const int tid = threadIdx.x, lane = tid & 63, wave = __builtin_amdgcn_readfirstlane(tid >> 6), r16 = lane & 15, g = lane >> 4;
    const int q0 = qt * 16; const bf16* zb = p.Z + (size_t)b * SEQ * ZP;
    LAS float* SC = (LAS float*)lds; LAS unsigned* BM = (LAS unsigned*)(lds + DSA_BM_OFF);
    const bool dense_all = (qt < TOPK / 16);
    const bf16* qrow = zb + (size_t)(q0 + r16) * ZP;
    const bf16x8v bq0 = *(const bf16x8v*)(qrow + C_Q + wave * 64 + 8 * g), bq1 = *(const bf16x8v*)(qrow + C_Q + wave * 64 + 32 + 8 * g);
    u32x2 gwv[4];
#pragma unroll
    for (int dt = 0; dt < 4; ++dt) gwv[dt] = *(const u32x2*)(qrow + C_GA + wave * 64 + dt * 16 + 4 * g);
    const int nsteps = (((q0 + 16 + 31) >> 5) + 1) & ~1, nmega = (nsteps + 7) >> 3;
    const int kkey = lane >> 3, vkey = lane >> 1, vhalf = lane & 1;
    const unsigned lds_base = (unsigned)(uintptr_t)lds;
#define DSA_STAGE(mm) do { const int st_ = (mm) * 8 + wave; if (st_ < nsteps) { \
        const bf16* kb_ = zb + (size_t)st_ * 32 * ZP; const unsigned ldsb_ = lds_base + (unsigned)(((mm) & 1) * 65536 + wave * 4096); \
        _Pragma("unroll") for (int c_ = 0; c_ < 4; ++c_) { const int key_ = 8 * c_ + kkey, ch_ = (lane & 7) ^ ((key_ & 15) >> 1); \
            glds16(kb_ + (size_t)key_ * ZP + C_K + ch_ * 8, (unsigned)__builtin_amdgcn_readfirstlane(ldsb_ + c_ * 1024)); } \
        _Pragma("unroll") for (int c_ = 0; c_ < 4; ++c_) \
            glds16(kb_ + (size_t)vkey * ZP + C_V + c_ * 16 + vhalf * 8, (unsigned)__builtin_amdgcn_readfirstlane(ldsb_ + 32768 + c_ * 1024)); } } while (0)
    if (!dense_all) {
        for (int rpI = 0; rpI < RP_I; ++rpI) {
        bf16x8v bq[8][2]; float wv[8];
#pragma unroll
        for (int h = 0; h < 8; ++h) { bq[h][0] = *(LAS const bf16x8v*)(lds + DSA_QIB_OFF + r16 * 1024 + (((8 * h + g) ^ r16) * 16)); bq[h][1] = *(LAS const bf16x8v*)(lds + DSA_QIB_OFF + r16 * 1024 + (((8 * h + 4 + g) ^ r16) * 16));
            wv[h] = bf2f(*(LAS const bf16*)(lds + DSA_WIB_OFF + r16 * 16 + h * 2)) * 0.35355339059327373f * 0.125f; }
        bf16x8v ra0 = pk[0], ra1 = pk[1], rb0 = pk[2], rb1 = pk[3], rc0 = pk[0], rc1 = pk[1];
#define IDX_LOAD(d0, d1, ktl) do { const int ktl_ = (ktl) <= qt ? (ktl) : qt;        \
            const bf16* krow_ = zb + (size_t)(ktl_ * 16 + r16) * ZP + C_KI; d0 = *(const bf16x8v*)(krow_ + 8 * g); d1 = *(const bf16x8v*)(krow_ + 32 + 8 * g); } while (0)
#define IDX_STEP(c0, c1) do { \
            f32x4 sc = {0.f, 0.f, 0.f, 0.f}; \
            _Pragma("unroll") for (int h = 0; h < 8; ++h) { \
                f32x4 acc = {0.f, 0.f, 0.f, 0.f}; \
                acc = __builtin_amdgcn_mfma_f32_16x16x32_bf16(c0, bq[h][0], acc, 0, 0, 0); \
                acc = __builtin_amdgcn_mfma_f32_16x16x32_bf16(c1, bq[h][1], acc, 0, 0, 0); \
                _Pragma("unroll") for (int i = 0; i < 4; ++i) sc[i] += relu_i(acc[i]) * wv[h]; \
            } \
            if (__builtin_amdgcn_readfirstlane(kt) == qt) {                  \
                _Pragma("unroll") for (int i = 0; i < 4; ++i) sc[i] = (4 * g + i > r16) ? -INFINITY : sc[i]; \
            } \
            *(LAS f32x4*)(SC + r16 * SCP + kt * 16 + 4 * g) = sc; } while (0)
        int kt = wave;
        const int nst = (qt - wave + 8) >> 3;
        const int ntrip = (nst * 11) >> 5, rem = nst - 3 * ntrip;
#pragma unroll 1
        for (int it = ntrip; it > 0; --it) {
            IDX_LOAD(rc0, rc1, kt + 16); __builtin_amdgcn_sched_barrier(0); IDX_STEP(ra0, ra1); __builtin_amdgcn_sched_barrier(0); kt += 8;
            IDX_LOAD(ra0, ra1, kt + 16); __builtin_amdgcn_sched_barrier(0); IDX_STEP(rb0, rb1); __builtin_amdgcn_sched_barrier(0); kt += 8;
            IDX_LOAD(rb0, rb1, kt + 16); __builtin_amdgcn_sched_barrier(0); IDX_STEP(rc0, rc1); __builtin_amdgcn_sched_barrier(0); kt += 8;
        }
        if (rem >= 1) { IDX_STEP(ra0, ra1); kt += 8; if (rem >= 2) { IDX_STEP(rb0, rb1); } }
#undef IDX_LOAD
#undef IDX_STEP
        __syncthreads();
        }
#pragma unroll 1
        for (int rpT = 0; rpT < RP_T; ++rpT) {
            const int ra = 2 * wave, rb = 2 * wave + 1, ta = q0 + ra, tb = q0 + rb;
            unsigned ka[32], kb[32];
#pragma unroll
            for (int i = 0; i < 32; ++i) { const int key = lane + 64 * i; ka[i] = (key <= ta) ? score_ukey(SC[ra * SCP + key]) : 0u; kb[i] = (key <= tb) ? score_ukey(SC[rb * SCP + key]) : 0u; }
#if RP_T1 > 1
            asm volatile("" :: "v"(ka[0]), "v"(kb[31]) : "memory");
#pragma unroll
            for (int i = 0; i < 32; ++i) { const int key = lane + 64 * i; ka[i] = (key <= ta) ? score_ukey(SC[ra * SCP + key]) : 0u; kb[i] = (key <= tb) ? score_ukey(SC[rb * SCP + key]) : 0u; }
            asm volatile("" ::: "memory");
#endif
            asm volatile("s_waitcnt lgkmcnt(0)" ::: "memory");
            __syncthreads();
            DSA_STAGE(0);
            TopkState sa, sb; sa.nb = (ta >> 9) + 1; sb.nb = (tb >> 9) + 1; topk_init(ka, sa); topk_init(kb, sb);
#pragma unroll 1
            while (!(sa.done && sb.done)) { topk_step(ka, sa); topk_step(kb, sb); }
#if RP_T2 > 1
            asm volatile("" :: "v"(sa.prefix), "v"(sb.prefix));
            topk_init(ka, sa); topk_init(kb, sb);
#pragma unroll 1
            while (!(sa.done && sb.done)) { topk_step(ka, sa); topk_step(kb, sb); }
#endif
            if (sa.need == 0xffffffffu && sb.need == 0xffffffffu) {
                const unsigned ta_ = (unsigned)__builtin_amdgcn_readfirstlane((int)sa.prefix), tb_ = (unsigned)__builtin_amdgcn_readfirstlane((int)sb.prefix);
                int wa = 0, wb = 0;
#define WR2(i) { const unsigned long long ma = __ballot(ka[i] >= ta_), mb = __ballot(kb[i] >= tb_); wr2lanes<2 * (i)>(wa, (unsigned)ma, (unsigned)(ma >> 32)); wr2lanes<2 * (i)>(wb, (unsigned)mb, (unsigned)(mb >> 32)); }
                WR2(0) WR2(1) WR2(2) WR2(3) WR2(4) WR2(5) WR2(6) WR2(7) WR2(8) WR2(9) WR2(10) WR2(11) WR2(12) WR2(13) WR2(14) WR2(15)
                WR2(16) WR2(17) WR2(18) WR2(19) WR2(20) WR2(21) WR2(22) WR2(23) WR2(24) WR2(25) WR2(26) WR2(27) WR2(28) WR2(29) WR2(30) WR2(31)
#undef WR2
                BM[ra * BMS + lane] = (unsigned)wa; BM[rb * BMS + lane] = (unsigned)wb;
#if RP_T3 > 1
                asm volatile("" : "+v"(wa), "+v"(wb) :: "memory");
#define WR2(i) { const unsigned long long ma = __ballot(ka[i] >= ta_), mb = __ballot(kb[i] >= tb_); wr2lanes<2 * (i)>(wa, (unsigned)ma, (unsigned)(ma >> 32)); wr2lanes<2 * (i)>(wb, (unsigned)mb, (unsigned)(mb >> 32)); }
                WR2(0) WR2(1) WR2(2) WR2(3) WR2(4) WR2(5) WR2(6) WR2(7) WR2(8) WR2(9) WR2(10) WR2(11) WR2(12) WR2(13) WR2(14) WR2(15)
                WR2(16) WR2(17) WR2(18) WR2(19) WR2(20) WR2(21) WR2(22) WR2(23) WR2(24) WR2(25) WR2(26) WR2(27) WR2(28) WR2(29) WR2(30) WR2(31)
#undef WR2
                BM[ra * BMS + lane] = (unsigned)wa; BM[rb * BMS + lane] = (unsigned)wb;
#endif
            } else {
            unsigned eqa = 0u, eqb = 0u;
#pragma unroll 1
            for (int i = 0; i < 32; ++i) {
                unsigned kai = ka[0], kbi = kb[0];
#pragma unroll
                for (int j = 1; j < 32; ++j) { kai = (i == j) ? ka[j] : kai; kbi = (i == j) ? kb[j] : kbi; }
                { const bool eq = (kai == sa.prefix); const unsigned long long em = __ballot(eq);
                  const unsigned erank = eqa + __builtin_amdgcn_mbcnt_hi((unsigned)(em >> 32), __builtin_amdgcn_mbcnt_lo((unsigned)em, 0u));
                  const unsigned long long smk = __ballot((kai > sa.prefix) || (eq && erank < sa.need));
                  if (lane == 0) { BM[ra * BMS + 2 * i] = (unsigned)smk; BM[ra * BMS + 2 * i + 1] = (unsigned)(smk >> 32); }
                  eqa += (unsigned)__popcll(em); }
                { const bool eq = (kbi == sb.prefix); const unsigned long long em = __ballot(eq);
                  const unsigned erank = eqb + __builtin_amdgcn_mbcnt_hi((unsigned)(em >> 32), __builtin_amdgcn_mbcnt_lo((unsigned)em, 0u));
                  const unsigned long long smk = __ballot((kbi > sb.prefix) || (eq && erank < sb.need));
                  if (lane == 0) { BM[rb * BMS + 2 * i] = (unsigned)smk; BM[rb * BMS + 2 * i + 1] = (unsigned)(smk >> 32); }
                  eqb += (unsigned)__popcll(em); }
            }
            }
        }
    } else {
        for (int i = tid; i < 1024; i += 512) { const int row = i >> 6, w = i & 63, t = q0 + row, lo = 32 * w;
            BM[row * BMS + w] = (t >= lo + 31) ? 0xffffffffu : ((t < lo) ? 0u : ((2u << (t - lo)) - 1u)); }
        DSA_STAGE(0);
    }
    __syncthreads();
    const int h = wave;
#pragma unroll 1
    for (int rpV = 0; rpV < RP_V; ++rpV) {
    asm volatile("s_waitcnt vmcnt(0)" ::: "memory");
    asm volatile("" :: "v"(bq0), "v"(bq1), "v"(gwv[0]), "v"(gwv[1]), "v"(gwv[2]), "v"(gwv[3]));
    __syncthreads();
    if (qt_next >= TOPK / 16) { dsa_prefetch_qi(zb, qt_next, lds, wave, lane); dsa_prefetch_ki(zb, qt_next, pk, wave, lane); }
    f32x4 o[4], lacc = {0.f, 0.f, 0.f, 0.f}, negm = {0.f, 0.f, 0.f, 0.f};
#pragma unroll
    for (int dt = 0; dt < 4; ++dt) o[dt] = (f32x4){0.f, 0.f, 0.f, 0.f};
    float m_run = 0.f;
    const int kofs0 = r16 * 128 + ((g ^ (r16 >> 1)) & 7) * 16, kofs1 = r16 * 128 + (((4 + g) ^ (r16 >> 1)) & 7) * 16;
    const int vofs = 32768 + (4 * g + ((lane & 15) >> 2)) * 32 + (lane & 3) * 8;
    bf16x8v ones = {0x3f80, 0x3f80, 0x3f80, 0x3f80, 0x3f80, 0x3f80, 0x3f80, 0x3f80};
    asm volatile("" : "+v"(ones));
    LAS const unsigned char* mlut = lds + DSA_MLUT_OFF;
    constexpr float THR = 8.0f;
    bool first = true;
#pragma unroll 1
    for (int mm = 0; mm < nmega; ++mm) {
        if (mm + 1 < nmega) DSA_STAGE(mm + 1);
        LAS unsigned char* slotb = lds + (mm & 1) * 65536;
        const int nsub = (nsteps - mm * 8) < 8 ? (nsteps - mm * 8) : 8;
#pragma unroll 1
        for (int u = 0; u < nsub; u += 2) {
            LAS unsigned char* slot = slotb + u * 4096;
            const int mwA = (int)(BM[r16 * BMS + mm * 8 + u] >> (4 * g)), mwB = (int)(BM[r16 * BMS + mm * 8 + u + 1] >> (4 * g));
            f32x4 s0, s1, s2, s3;
            { const bf16x8v ka0 = *(LAS const bf16x8v*)(slot + kofs0), ka1 = *(LAS const bf16x8v*)(slot + kofs1);
              const bf16x8v kb0 = *(LAS const bf16x8v*)(slot + 2048 + kofs0), kb1 = *(LAS const bf16x8v*)(slot + 2048 + kofs1);
              const bf16x8v kc0 = *(LAS const bf16x8v*)(slot + 4096 + kofs0), kc1 = *(LAS const bf16x8v*)(slot + 4096 + kofs1);
              const bf16x8v kd0 = *(LAS const bf16x8v*)(slot + 6144 + kofs0), kd1 = *(LAS const bf16x8v*)(slot + 6144 + kofs1);
              s0 = __builtin_amdgcn_mfma_f32_16x16x32_bf16(ka0, bq0, negm, 0, 0, 0); s1 = __builtin_amdgcn_mfma_f32_16x16x32_bf16(kb0, bq0, negm, 0, 0, 0);
              s2 = __builtin_amdgcn_mfma_f32_16x16x32_bf16(kc0, bq0, negm, 0, 0, 0); s3 = __builtin_amdgcn_mfma_f32_16x16x32_bf16(kd0, bq0, negm, 0, 0, 0);
              s0 = __builtin_amdgcn_mfma_f32_16x16x32_bf16(ka1, bq1, s0, 0, 0, 0); s1 = __builtin_amdgcn_mfma_f32_16x16x32_bf16(kb1, bq1, s1, 0, 0, 0);
              s2 = __builtin_amdgcn_mfma_f32_16x16x32_bf16(kc1, bq1, s2, 0, 0, 0); s3 = __builtin_amdgcn_mfma_f32_16x16x32_bf16(kd1, bq1, s3, 0, 0, 0); }
            const int lmi = max(max(max(imax3(s0[0], s0[1], s0[2]), imax3(s0[3], s1[0], s1[1])), max(imax3(s1[2], s1[3], s2[0]), imax3(s2[1], s2[2], s2[3]))), max(imax3(s3[0], s3[1], s3[2]), __float_as_int(s3[3])));
            if (first || __any(lmi > 0x41000000)) {
                float lmx = fmaxf(fmaxf(fmaxf(fmaxf(s0[0], s0[1]), fmaxf(s0[2], s0[3])), fmaxf(fmaxf(s1[0], s1[1]), fmaxf(s1[2], s1[3]))), fmaxf(fmaxf(fmaxf(s2[0], s2[1]), fmaxf(s2[2], s2[3])), fmaxf(fmaxf(s3[0], s3[1]), fmaxf(s3[2], s3[3]))));
                { const auto r1 = __builtin_amdgcn_permlane16_swap(__float_as_uint(lmx), __float_as_uint(lmx), false, false); lmx = fmaxf(__uint_as_float(r1[0]), __uint_as_float(r1[1])); }
                { const auto r2 = __builtin_amdgcn_permlane32_swap(__float_as_uint(lmx), __float_as_uint(lmx), false, false); lmx = fmaxf(__uint_as_float(r2[0]), __uint_as_float(r2[1])); }
                const float dl = first ? lmx : fmaxf(lmx, 0.f);
                m_run += dl; const float f = first ? 1.0f : __builtin_amdgcn_exp2f(-dl);
#pragma unroll
                for (int i = 0; i < 4; ++i) { s0[i] -= dl; s1[i] -= dl; s2[i] -= dl; s3[i] -= dl; negm[i] = -m_run; }
                lacc = lacc * f;
#pragma unroll
                for (int dt = 0; dt < 4; ++dt) o[dt] = o[dt] * f;
                first = false;
            }
            const u32x2 mk0 = *(LAS const u32x2*)(mlut + ((mwA & 15) << 3)), mk1 = *(LAS const u32x2*)(mlut + (((mwA >> 16) & 15) << 3));
            const u32x2 mk2 = *(LAS const u32x2*)(mlut + ((mwB & 15) << 3)), mk3 = *(LAS const u32x2*)(mlut + (((mwB >> 16) & 15) << 3));
            u32x4 pwA, pwB;
            pwA.x = cvtpk(__builtin_amdgcn_exp2f(s0[0]), __builtin_amdgcn_exp2f(s0[1])) & mk0.x; pwA.y = cvtpk(__builtin_amdgcn_exp2f(s0[2]), __builtin_amdgcn_exp2f(s0[3])) & mk0.y;
            pwA.z = cvtpk(__builtin_amdgcn_exp2f(s1[0]), __builtin_amdgcn_exp2f(s1[1])) & mk1.x; pwA.w = cvtpk(__builtin_amdgcn_exp2f(s1[2]), __builtin_amdgcn_exp2f(s1[3])) & mk1.y;
            pwB.x = cvtpk(__builtin_amdgcn_exp2f(s2[0]), __builtin_amdgcn_exp2f(s2[1])) & mk2.x; pwB.y = cvtpk(__builtin_amdgcn_exp2f(s2[2]), __builtin_amdgcn_exp2f(s2[3])) & mk2.y;
            pwB.z = cvtpk(__builtin_amdgcn_exp2f(s3[0]), __builtin_amdgcn_exp2f(s3[1])) & mk3.x; pwB.w = cvtpk(__builtin_amdgcn_exp2f(s3[2]), __builtin_amdgcn_exp2f(s3[3])) & mk3.y;
            const bf16x8v pfA = __builtin_bit_cast(bf16x8v, pwA), pfB = __builtin_bit_cast(bf16x8v, pwB);
            lacc = __builtin_amdgcn_mfma_f32_16x16x32_bf16(ones, pfA, lacc, 0, 0, 0);
            lacc = __builtin_amdgcn_mfma_f32_16x16x32_bf16(ones, pfB, lacc, 0, 0, 0);
#pragma unroll
            for (int dt = 0; dt < 4; ++dt) {
                const s16x4v lo = lds_tr16(slot + vofs + dt * 1024), hi = lds_tr16(slot + vofs + dt * 1024 + 512);
                const s16x4v lo2 = lds_tr16(slot + 4096 + vofs + dt * 1024), hi2 = lds_tr16(slot + 4096 + vofs + dt * 1024 + 512);
                const bf16x8v vf = {lo[0], lo[1], lo[2], lo[3], hi[0], hi[1], hi[2], hi[3]};
                const bf16x8v vf2 = {lo2[0], lo2[1], lo2[2], lo2[3], hi2[0], hi2[1], hi2[2], hi2[3]};
                o[dt] = __builtin_amdgcn_mfma_f32_16x16x32_bf16(vf, pfA, o[dt], 0, 0, 0);
                o[dt] = __builtin_amdgcn_mfma_f32_16x16x32_bf16(vf2, pfB, o[dt], 0, 0, 0);
            }
        }
        asm volatile("s_waitcnt vmcnt(0) lgkmcnt(0)" ::: "memory");
        __syncthreads();
    }
#undef DSA_STAGE
    const float inv = 1.0f / lacc[0];
    bf16* yrow = p.Y + ((size_t)b * SEQ + q0 + r16) * DM + 512 + h * 64;
#pragma unroll
    for (int dt = 0; dt < 4; ++dt) {
        const u32x2 gw = gwv[dt];
        const float g0 = __uint_as_float(gw.x << 16), g1 = __uint_as_float(gw.x & 0xffff0000u), g2 = __uint_as_float(gw.y << 16), g3 = __uint_as_float(gw.y & 0xffff0000u);
        u32x2 w; w.x = pk2(o[dt][0] * inv * siluf(g0), o[dt][1] * inv * siluf(g1)); w.y = pk2(o[dt][2] * inv * siluf(g2), o[dt][3] * inv * siluf(g3));
        *(u32x2*)(yrow + dt * 16 + 4 * g) = w;
    }
    __syncthreads();
    }
}
__device__ __forceinline__ int dsa_qt_of(int j, int i) { return (i == 0) ? 127 - j : (i == 1) ? 64 + j : (i == 2) ? 63 - j : j; }
__device__ __forceinline__ void dsa_phase_pre(const P& p, LAS unsigned char* lds) {
    const int G = gridDim.x, wg = blockIdx.x, lane = threadIdx.x & 63, wave = __builtin_amdgcn_readfirstlane(threadIdx.x >> 6);
    const int b = (G == 256) ? (wg & 7) : (wg >> 7), qt = (G == 256) ? dsa_qt_of(wg >> 3, 0) : 127 - (wg & 127);
    if (wg < 1024 && qt >= TOPK / 16) dsa_prefetch_qi(p.Z + (size_t)b * SEQ * ZP, qt, lds, wave, lane);
}
__device__ __forceinline__ void dsa_phase(const P& p, LAS unsigned char* lds) {
    const int G = gridDim.x, wg = blockIdx.x;
    if (G == 256) {
        const int b = wg & 7, j = wg >> 3, lane = threadIdx.x & 63, wave = __builtin_amdgcn_readfirstlane(threadIdx.x >> 6);
        bf16x8v pk[4] = {{0, 0, 0, 0, 0, 0, 0, 0}, {0, 0, 0, 0, 0, 0, 0, 0}, {0, 0, 0, 0, 0, 0, 0, 0}, {0, 0, 0, 0, 0, 0, 0, 0}};
        if (dsa_qt_of(j, 0) >= TOPK / 16) dsa_prefetch_ki(p.Z + (size_t)b * SEQ * ZP, dsa_qt_of(j, 0), pk, wave, lane);
#pragma unroll 1
        for (int i = 0; i < 4; ++i) dsa_unit(p, b, dsa_qt_of(j, i), (i < 3) ? dsa_qt_of(j, i + 1) : -1, pk, lds);
    }
}
constexpr int LRU_WS_OFF = 139264;
constexpr int LRU_XB = 264 * 128;
constexpr int LRU_GB = 256 * 32;
constexpr int LRU_BUF = LRU_XB + LRU_GB;
__device__ __forceinline__ float fast_sigm(float x) { return __builtin_amdgcn_rcpf(1.0f + __expf(-x)); }
__device__ __forceinline__ void lru_unit(const P& p, int l, int b, int blk, int q4, LAS unsigned char* lds) {
    const int tid = threadIdx.x, lane = tid & 63, wave = __builtin_amdgcn_readfirstlane(tid >> 6), r16 = lane & 15, g = lane >> 4;
    const bf16* zb = p.Z + (size_t)b * SEQ * ZP;
    const int cA = blk * 64, dloc = q4 * 16 + r16, dg = blk * 64 + dloc;
    const unsigned lds_base = (unsigned)(uintptr_t)lds;
#define LRU_STAGE(r) do { const unsigned bb_ = lds_base + (unsigned)(((r) & 1) * LRU_BUF); \
        _Pragma("unroll") for (int i_ = 0; i_ < 5; ++i_) { const int pc_ = wave + 8 * i_; if (pc_ < 33) { const int rho_ = pc_ * 8 + (lane >> 3); int t_ = (r) * 256 - 3 + rho_; t_ = t_ < 0 ? 0 : (t_ > SEQ - 1 ? SEQ - 1 : t_); \
            const int ch_ = (lane & 7) ^ ((rho_ >> 1) & 7); glds16(zb + (size_t)t_ * ZP + C_XR + cA + ch_ * 8, (unsigned)__builtin_amdgcn_readfirstlane(bb_ + pc_ * 1024)); } } \
        { const int row_ = wave * 32 + (lane >> 1); glds16(zb + (size_t)((r) * 256 + row_) * ZP + C_GR + dg - r16 + (lane & 1) * 8, (unsigned)__builtin_amdgcn_readfirstlane(bb_ + LRU_XB + wave * 1024)); } } while (0)
    LRU_STAGE(0);
    float cwA[2][4][8], cbA[2][8];
#pragma unroll
    for (int s = 0; s < 2; ++s)
#pragma unroll
        for (int j = 0; j < 8; ++j) { const int c = cA + 32 * s + 8 * g + j; cbA[s][j] = p.conv_b[l * 512 + c];
#pragma unroll
            for (int k = 0; k < 4; ++k) cwA[s][k][j] = p.conv_w[(l * 4 + k) * 512 + c]; }
    bf16x8v bxf[2], baf[2];
#pragma unroll
    for (int s = 0; s < 2; ++s) { u32x4 wx, wa; unsigned tx[8], ta[8];
#pragma unroll
        for (int j = 0; j < 8; ++j) { const size_t idx = (((size_t)l * 8 + blk) * 64 + 32 * s + 8 * g + j) * 64 + dloc; tx[j] = f2bf(p.lru_wx[idx]); ta[j] = f2bf(p.lru_wa[idx]); }
        wx.x = tx[0] | (tx[1] << 16); wx.y = tx[2] | (tx[3] << 16); wx.z = tx[4] | (tx[5] << 16); wx.w = tx[6] | (tx[7] << 16);
        wa.x = ta[0] | (ta[1] << 16); wa.y = ta[2] | (ta[3] << 16); wa.z = ta[4] | (ta[5] << 16); wa.w = ta[6] | (ta[7] << 16);
        bxf[s] = __builtin_bit_cast(bf16x8v, wx); baf[s] = __builtin_bit_cast(bf16x8v, wa); }
    const float cw0 = p.conv_w[(l * 4 + 0) * 512 + dg], cw1 = p.conv_w[(l * 4 + 1) * 512 + dg], cw2 = p.conv_w[(l * 4 + 2) * 512 + dg], cw3 = p.conv_w[(l * 4 + 3) * 512 + dg];
    const float cb = p.conv_b[l * 512 + dg], bxv = p.lru_bx[l * 512 + dg], bav = p.lru_ba[l * 512 + dg];
    const float sp8 = -8.0f * log1pf(expf(-p.lru_a[l * 512 + dg]));
    asm volatile("" :: "v"(cwA[0][0][0]), "v"(cwA[1][3][7]), "v"(cbA[1][7]), "v"(bxf[0]), "v"(bxf[1]), "v"(baf[0]), "v"(baf[1]), "v"(cw0), "v"(cw1), "v"(cw2), "v"(cw3), "v"(cb), "v"(bxv), "v"(bav), "v"(sp8));
    LAS float* WS = (LAS float*)(lds + LRU_WS_OFF);
    float hrun = 0.f;
#pragma unroll 1
    for (int round = 0; round < 8; ++round) {
        asm volatile("s_waitcnt vmcnt(0)" ::: "memory");
        __syncthreads();
        if (round + 1 < 8) LRU_STAGE(round + 1);
        LAS const unsigned char* xb = lds + (round & 1) * LRU_BUF; LAS const unsigned char* gb = xb + LRU_XB;
        const int tw = round * 256 + wave * 32;
        float hl[2][4], pl[2][4], gr4[2][4], PT[2], HT[2], PE[2], HE[2];
#pragma unroll
        for (int tau = 0; tau < 2; ++tau) {
            const int t0 = tw + 16 * tau, rho0 = wave * 32 + 16 * tau;
            bf16x8v af[2];
#pragma unroll
            for (int s = 0; s < 2; ++s) {
                float xc[8];
#pragma unroll
                for (int j = 0; j < 8; ++j) xc[j] = cbA[s][j];
#pragma unroll
                for (int k = 0; k < 4; ++k) { const int rho = rho0 + r16 + k; u32x4 w = *(LAS const u32x4*)(xb + rho * 128 + (((4 * s + g) ^ (rho >> 1)) & 7) * 16);
                    if (t0 + r16 - 3 + k < 0) w = (u32x4){0u, 0u, 0u, 0u};
                    xc[0] += cwA[s][k][0] * __uint_as_float(w.x << 16); xc[1] += cwA[s][k][1] * __uint_as_float(w.x & 0xffff0000u);
                    xc[2] += cwA[s][k][2] * __uint_as_float(w.y << 16); xc[3] += cwA[s][k][3] * __uint_as_float(w.y & 0xffff0000u);
                    xc[4] += cwA[s][k][4] * __uint_as_float(w.z << 16); xc[5] += cwA[s][k][5] * __uint_as_float(w.z & 0xffff0000u);
                    xc[6] += cwA[s][k][6] * __uint_as_float(w.w << 16); xc[7] += cwA[s][k][7] * __uint_as_float(w.w & 0xffff0000u); }
                u32x4 pw; pw.x = cvtpk(xc[0], xc[1]); pw.y = cvtpk(xc[2], xc[3]); pw.z = cvtpk(xc[4], xc[5]); pw.w = cvtpk(xc[6], xc[7]);
                af[s] = __builtin_bit_cast(bf16x8v, pw);
            }
            f32x4 gx = {0.f, 0.f, 0.f, 0.f}, ga = {0.f, 0.f, 0.f, 0.f};
            gx = __builtin_amdgcn_mfma_f32_16x16x32_bf16(af[0], bxf[0], gx, 0, 0, 0); gx = __builtin_amdgcn_mfma_f32_16x16x32_bf16(af[1], bxf[1], gx, 0, 0, 0);
            ga = __builtin_amdgcn_mfma_f32_16x16x32_bf16(af[0], baf[0], ga, 0, 0, 0); ga = __builtin_amdgcn_mfma_f32_16x16x32_bf16(af[1], baf[1], ga, 0, 0, 0);
            float xo[7];
#pragma unroll
            for (int m = 0; m < 7; ++m) { const int rho = rho0 + 4 * g + m;
                const unsigned short v = *(LAS const unsigned short*)(xb + rho * 128 + (((dloc >> 3) ^ (rho >> 1)) & 7) * 16 + (dloc & 7) * 2);
                xo[m] = (t0 + 4 * g - 3 + m >= 0) ? bf2f(v) : 0.f; }
            float Pr = 1.f, Hr = 0.f;
#pragma unroll
            for (int i = 0; i < 4; ++i) {
                const float xcv = cb + cw0 * xo[i] + cw1 * xo[i + 1] + cw2 * xo[i + 2] + cw3 * xo[i + 3];
                const float sx = fast_sigm(gx[i] + bxv), sa = fast_sigm(ga[i] + bav);
                const float la = sp8 * sa, a = __expf(la), y2 = 2.0f * la;
                const float ser = -y2 * (1.0f + y2 * (0.5f + y2 * (0.16666667f + y2 * (0.041666668f + y2 * (0.0083333338f + y2 * 0.0013888889f)))));
                const float em = (y2 > -0.25f) ? ser : (1.0f - __expf(y2));
                const float u = __builtin_amdgcn_sqrtf(em) * sx * xcv;
                Hr = a * Hr + u; Pr *= a; hl[tau][i] = Hr; pl[tau][i] = Pr;
                gr4[tau][i] = bf2f(*(LAS const unsigned short*)(gb + (rho0 + 4 * g + i) * 32 + r16 * 2));
            }
            float Pi = Pr, Hi = Hr;
            { const float Pl = __shfl_up(Pi, 16), Hl = __shfl_up(Hi, 16); if (g >= 1) { Hi = Pi * Hl + Hi; Pi = Pl * Pi; } }
            { const float Pl = __shfl_up(Pi, 32), Hl = __shfl_up(Hi, 32); if (g >= 2) { Hi = Pi * Hl + Hi; Pi = Pl * Pi; } }
            float Pe = __shfl_up(Pi, 16), He = __shfl_up(Hi, 16); if (g == 0) { Pe = 1.f; He = 0.f; }
            PT[tau] = __shfl(Pi, 48 + r16); HT[tau] = __shfl(Hi, 48 + r16); PE[tau] = Pe; HE[tau] = He;
        }
        HE[1] = PE[1] * HT[0] + HE[1]; PE[1] = PT[0] * PE[1];
        const float Pw = PT[0] * PT[1], Hw = PT[1] * HT[0] + HT[1];
        LAS float* wsr = WS + (round & 1) * 256;
        if (g == 0) { wsr[(wave * 16 + r16) * 2 + 0] = Pw; wsr[(wave * 16 + r16) * 2 + 1] = Hw; }
        asm volatile("s_waitcnt lgkmcnt(0)" ::: "memory");
        __builtin_amdgcn_s_barrier();
        asm volatile("" ::: "memory");
        float hc = hrun, hall = hrun;
#pragma unroll
        for (int w2 = 0; w2 < 8; ++w2) { if (w2 == wave) hc = hall; hall = wsr[(w2 * 16 + r16) * 2 + 0] * hall + wsr[(w2 * 16 + r16) * 2 + 1]; }
        hrun = hall;
#pragma unroll
        for (int tau = 0; tau < 2; ++tau) {
            const float hin = PE[tau] * hc + HE[tau];
            bf16* yp = p.Y + ((size_t)b * SEQ + tw + 16 * tau + 4 * g) * DM + dg;
#pragma unroll
            for (int i = 0; i < 4; ++i) { const float h = hl[tau][i] + pl[tau][i] * hin, gr = gr4[tau][i]; yp[(size_t)i * DM] = (bf16)f2bf(h * gr * fast_sigm(gr)); }
        }
    }
#undef LRU_STAGE
    asm volatile("s_waitcnt vmcnt(0)" ::: "memory");
    __syncthreads();
}
__device__ __forceinline__ void lru_phase(const P& p, int l, LAS unsigned char* lds) {
    const int G = gridDim.x, wg = blockIdx.x;
#pragma unroll 1
    for (int u = wg; u < 256; u += G) lru_unit(p, l, (u >> 3) & 7, u & 7, u >> 6, lds);
}
#ifndef DSA_PHASE
#define DSA_PHASE dsa_phase
#endif
#ifndef LRU_PHASE
#define LRU_PHASE lru_phase
#endif
#ifndef RP_A
#define RP_A 1
#endif
#ifndef RP_L
#define RP_L 1
#endif
#ifndef RP_D
#define RP_D 1
#endif
#ifndef RP_C
#define RP_C 1
#endif
#ifndef RP_0
#define RP_0 1
#endif
struct Args { const float* in[15]; float* out; unsigned char* ws; int ph_lo, ph_hi; };
__global__ void __launch_bounds__(512, 2) mega(Args a) {
    extern __shared__ __attribute__((aligned(16))) unsigned char lds_raw[];
    LAS unsigned char* lds = (LAS unsigned char*)lds_raw;
    P p;
    p.x = a.in[0]; p.c = a.in[1]; p.norm_g = a.in[2]; p.ada_w = a.in[3]; p.ada_b = a.in[4]; p.w_in = a.in[5]; p.conv_w = a.in[6]; p.conv_b = a.in[7];
    p.lru_wx = a.in[8]; p.lru_bx = a.in[9]; p.lru_wa = a.in[10]; p.lru_ba = a.in[11]; p.lru_a = a.in[12]; p.w_out = a.in[13]; p.final_g = a.in[14];
    p.out = a.out; unsigned char* ws = a.ws;
    p.ctl = (unsigned*)(ws + WS_CTL); p.mod = (float*)(ws + WS_MOD); p.bias = (float*)(ws + WS_BIAS); p.ssq = (float*)(ws + WS_SSQ);
    p.wt_in = (bf16*)(ws + WS_WTIN); p.wt_out = (bf16*)(ws + WS_WTOUT); p.A = (bf16*)(ws + WS_A); p.Z = (bf16*)(ws + WS_Z); p.Y = (bf16*)(ws + WS_Y);
    const int lo = a.ph_lo, hi = a.ph_hi;
    volatile LAS unsigned* MISC = (volatile LAS unsigned*)(lds + MISC_OFF + 4096);
    if (threadIdx.x < 4) MISC[threadIdx.x] = 0u;
    if (threadIdx.x < 16) { const unsigned t = threadIdx.x; u32x2 m; m.x = ((t & 1u) ? 0xffffu : 0u) | ((t & 2u) ? 0xffff0000u : 0u); m.y = ((t & 4u) ? 0xffffu : 0u) | ((t & 8u) ? 0xffff0000u : 0u);
        *(LAS u32x2*)(lds + DSA_MLUT_OFF + t * 8) = m; }
    __syncthreads();
    XcdBarrier bar; bar.bar = p.ctl + CW_BAR; bar.x = 0; bar.st = MISC;
    if (hi - lo > 1) bar = xcd_barrier_post(p.ctl + CW_BAR, MISC);
#define IN(k) (lo <= (k) && (k) < hi)
#ifndef N_CG_SEAMS
#define N_CG_SEAMS 0
#endif
#define SEAM(k) do { if (IN(k) && IN((k) + 1)) { if ((k) < N_CG_SEAMS) cg::this_grid().sync(); else xcd_barrier(bar); } } while (0)
    if (IN(0)) { ph0_prologue(p, lds); if (RP_0 > 1) { __syncthreads(); ph0_prologue(p, lds); } }
    SEAM(0);
    if (IN(1)) { ph1_prologue(p, lds); if (RP_0 > 1) { __syncthreads(); ph1_prologue(p, lds); } }
    SEAM(1);
#define LAYER(l, base) \
    if (IN(base)) { \
        pg8::Gemm g{p.A, p.wt_in + (size_t)(l) * ZP * 1024, MROWS, ZP, DM}; pg8::StaticOrder S; S.init(MROWS, ZP, (int)gridDim.x, (int)blockIdx.x); \
        EpiZ E{p.Z, p.ssq, p.bias + (size_t)(l) * 8 * ZP}; \
        pg8::gemm_phase<EpiZ, pg8::StaticOrder, PG8_ALIGN, PG8_SP2>(lds, g, S, E); if (RP_A > 1) { __syncthreads(); pg8::gemm_phase<EpiZ, pg8::StaticOrder, PG8_ALIGN, PG8_SP2>(lds, g, S, E); } \
    } \
    SEAM(base); \
    if (IN((base) + 1)) { dsa_phase_pre(p, lds); LRU_PHASE(p, (l), lds); __syncthreads(); if (RP_L > 1) { LRU_PHASE(p, (l), lds); __syncthreads(); } DSA_PHASE(p, lds); if (RP_D > 1) { __syncthreads(); DSA_PHASE(p, lds); } } \
    SEAM((base) + 1); \
    if (IN((base) + 2)) { \
        pg8::Gemm g{p.Y, p.wt_out + (size_t)(l) * 1024 * 1024, MROWS, DM, DM}; pg8::StaticOrder S; S.init(MROWS, DM, (int)gridDim.x, (int)blockIdx.x); \
        if constexpr ((l) == DEPTH - 1) { \
            EpiXF E{p.out, p.out, p.mod + (size_t)(l) * 8 * 3072 + 2048, p.final_g, p.ssq, p.ctl + CW_PANEL}; \
            pg8::gemm_phase<EpiXF, pg8::StaticOrder, false, PG8_SP2>(lds, g, S, E); \
        } else { \
            EpiX E{(l) == 0 ? p.x : p.out, p.out, p.A, p.mod + (size_t)(l) * 8 * 3072 + 2048, p.norm_g + (size_t)((l) + 1) * 1024, p.mod + (size_t)((l) + 1) * 8 * 3072 + 1024, p.ssq}; \
            pg8::gemm_phase<EpiX, pg8::StaticOrder, false, PG8_SP2>(lds, g, S, E); if (RP_C > 1 && (l) == 0) { __syncthreads(); pg8::gemm_phase<EpiX, pg8::StaticOrder, false, PG8_SP2>(lds, g, S, E); } \
        } \
    } \
    if ((base) + 3 < NPHASE) SEAM((base) + 2);
    LAYER(0, 2)
    LAYER(1, 5)
}
#ifndef MK_N_LAUNCHES
#define MK_N_LAUNCHES 1
#endif
extern "C" void kernel_launch(void* const* d_in, const int* in_sizes, int n_in, void* d_out, int out_size, void* d_ws, size_t ws_size, hipStream_t stream) {
    static int grid = 0;
    if (grid == 0) {
        if (n_in != 15 || out_size != MROWS * DM || ws_size < WS_END) { fprintf(stderr, "kernel_launch: unexpected problem (n_in %d out %d ws %zu)\n", n_in, out_size, ws_size); grid = -1; return; }
        int dev = 0, cus = 0, per_cu = 0;
        hipGetDevice(&dev); hipDeviceGetAttribute(&cus, hipDeviceAttributeMultiprocessorCount, dev);
        if (hipFuncSetAttribute((const void*)mega, hipFuncAttributeMaxDynamicSharedMemorySize, LDS_BYTES) != hipSuccess) { fprintf(stderr, "kernel_launch: hipFuncSetAttribute failed\n"); grid = -1; return; }
        if (hipOccupancyMaxActiveBlocksPerMultiprocessor(&per_cu, (const void*)mega, 512, LDS_BYTES) != hipSuccess || per_cu < 1) { fprintf(stderr, "kernel_launch: occupancy query failed (%d)\n", per_cu); per_cu = 1; }
        (void)hipGetLastError();
        grid = cus * per_cu;
        if (grid != 256) fprintf(stderr, "kernel_launch: grid %d (cus %d x %d) != 256: the fused out-projection epilogue needs exactly 256 workgroups\n", grid, cus, per_cu);
    }
    if (grid < 0) return;
    hipMemsetAsync((char*)d_ws + WS_CTL, 0, CTL_ZERO_BYTES, stream);
    Args a{};
    for (int i = 0; i < 15; ++i) a.in[i] = (const float*)d_in[i];
    a.out = (float*)d_out; a.ws = (unsigned char*)d_ws;
#if MK_N_LAUNCHES == 1
    a.ph_lo = 0; a.ph_hi = NPHASE;
    void* args[] = {&a};
    hipError_t e = hipLaunchCooperativeKernel((const void*)mega, dim3(grid), dim3(512), args, LDS_BYTES, stream);
    if (e != hipSuccess) fprintf(stderr, "cooperative launch failed: %s (grid %d)\n", hipGetErrorString(e), grid);
#else
    for (int ph = 0; ph < NPHASE; ++ph) { a.ph_lo = ph; a.ph_hi = ph + 1; hipLaunchKernelGGL(mega, dim3(grid), dim3(512), LDS_BYTES, stream, a); }
#endif
}
```

```cpp
#include <hip/hip_runtime.h>
#include <hip/hip_cooperative_groups.h>
#include <cstdio>
#include <cstdint>
#include <cmath>
namespace cg = cooperative_groups;
#define EPI_XD 3
#define EPI_ZD 8
namespace pg8 {
#define PG8_LAS __attribute__((address_space(3)))
typedef unsigned short bf16_t;
typedef short bf16x8 __attribute__((ext_vector_type(8)));
typedef float f32x4 __attribute__((ext_vector_type(4)));
typedef unsigned u32x4 __attribute__((ext_vector_type(4)));
constexpr int BM = 256, BK = 64, HALF = 128, HTB = HALF * BK * 2  , STAGE_BYTES = 8 * HTB, NXCD = 8, WGM = 8;

__host__ __device__ __forceinline__ int lds_byte(int r, int c) { const int st = (r >> 4) * 2 + (c >> 5), rr = r & 15, cc = c & 31, ob = rr * 64 + cc * 2; return st * 1024 + (ob ^ (((ob >> 9) & 1) << 5)); }
__host__ __device__ __forceinline__ void stage_rc(int b, int& R, int& C) { const int st = b / 1024, sb = b % 1024, swz = sb ^ (((sb >> 9) & 1) << 5); R = (st >> 1) * 16 + swz / 64; C = (st & 1) * 32 + (swz % 64) / 2; }
__host__ __device__ __forceinline__ int perm32(int rho) { const int n = rho >> 4, i = rho & 15; return 8 * (i >> 2) + 4 * n + (i & 3); }

struct Unit { int pm, pn; };
struct Gemm { const bf16_t* A; const bf16_t* Bt; int M, N, K; };

struct StaticOrder {
    int nM, nN, nwg, G, c;
    __host__ __device__ void init(int M, int N, int G_, int c_) { nM = M / BM; nN = N / BM; nwg = nM * nN; G = G_; c = c_; }
    __host__ __device__ bool next(int i, Unit& u) const {
        const long L = (long)i * G + c; if (L >= nwg) return false;
        int wgid = (int)L; { const int q = nwg / NXCD, r = nwg % NXCD, xcd = wgid % NXCD, off = wgid / NXCD; wgid = (xcd < r ? xcd * (q + 1) : r * (q + 1) + (xcd - r) * q) + off; }
        const int nig = WGM * nN, gid = wgid / nig, fm = gid * WGM, gsz = (nM - fm) < WGM ? (nM - fm) : WGM;
        u.pm = fm + ((wgid % nig) % gsz); u.pn = (wgid % nig) / gsz; return true;
    }
    __device__ __forceinline__ void a_ready(const Unit&) const {}
    __device__ __forceinline__ void done(const Unit&) const {}
};

__device__ __forceinline__ unsigned cvt_pk_bf16(float lo, float hi) { unsigned r; asm volatile("v_cvt_pk_bf16_f32 %0, %1, %2" : "=v"(r) : "v"(lo), "v"(hi)); return r; }
typedef float f32x2 __attribute__((ext_vector_type(2)));
template <class Epi, class Sched, bool ALIGN_EPI = false, bool SP2 = false>
__device__ __forceinline__ void gemm_phase(PG8_LAS unsigned char* lds, const Gemm g, const Sched& S, const Epi& E) {
    const int tid = threadIdx.x, wid = __builtin_amdgcn_readfirstlane(tid >> 6), lane = tid & 63, wr = wid >> 2, wc = wid & 3, fr = lane & 15, fq = lane >> 4;
    const int K = g.K, nt = K / BK;
    unsigned voffA[2], voffB[2];
#pragma unroll
    for (int i = 0; i < 2; ++i) { int R, C; stage_rc(tid * 16 + i * 8192, R, C); const int Rb = Epi::PERM ? ((R & ~31) + perm32(R & 31)) : R;
        voffA[i] = (unsigned)(R * K + C) * 2u; voffB[i] = (unsigned)(Rb * K + C) * 2u; }
    const size_t kstep = (size_t)(BK * 2);
    const size_t hstep = (size_t)HALF * K * 2;
    const size_t tstep = 2 * hstep;
    const unsigned ldsw = (unsigned)wid * 1024u;
    const int aoff = lds_byte(wr * 64 + fr, fq * 8), boff = lds_byte(wc * 32 + fr, fq * 8);
#define PG8_SA(b, h) (((b) * 2 + (h)) * HTB)
#define PG8_SB(b, h) ((4 + (b) * 2 + (h)) * HTB)
#define PG8_STAGE(bufoff, gbase, voff) do { _Pragma("unroll") for (int _i = 0; _i < 2; ++_i) \
        __builtin_amdgcn_global_load_lds((const unsigned*)((const char*)(gbase) + (voff)[_i]), (PG8_LAS unsigned*)(lds + (bufoff) + ldsw + _i * 8192), 16, 0, 0); } while (0)
#define PG8_LDA(dst, b, h) do { _Pragma("unroll") for (int m = 0; m < 4; ++m) _Pragma("unroll") for (int k = 0; k < 2; ++k) dst[m][k] = *(const PG8_LAS bf16x8*)(lds + PG8_SA(b, h) + aoff + m * 2048 + k * 1024); } while (0)
#define PG8_LDB(dst, b, h) do { _Pragma("unroll") for (int n = 0; n < 2; ++n) _Pragma("unroll") for (int k = 0; k < 2; ++k) dst[n][k] = *(const PG8_LAS bf16x8*)(lds + PG8_SB(b, h) + boff + n * 2048 + k * 1024); } while (0)
#define PG8_MMA(ai, bj, At, Bt) do { __builtin_amdgcn_s_setprio(1); _Pragma("unroll") for (int m = 0; m < 4; ++m) _Pragma("unroll") for (int n = 0; n < 2; ++n) _Pragma("unroll") for (int k = 0; k < 2; ++k) \
        acc[ai][bj][m][n] = __builtin_amdgcn_mfma_f32_16x16x32_bf16(Bt[n][k], At[m][k], acc[ai][bj][m][n], 0, 0, 0); __builtin_amdgcn_s_setprio(0); } while (0)
#define PG8_WAIT_V(n) asm volatile("s_waitcnt vmcnt(" #n ")" ::: "memory")
#define PG8_WAIT_L(n) asm volatile("s_waitcnt lgkmcnt(" #n ")" ::: "memory")
#define PG8_BAR __builtin_amdgcn_s_barrier()
#define PG8_SCHED __builtin_amdgcn_sched_barrier(0)
    Unit cur, nxt; int ui = 0;
    if (!S.next(0, cur)) return;
    f32x4 acc[2][2][4][2];
#pragma unroll
    for (int a = 0; a < 2; ++a)
#pragma unroll
        for (int b = 0; b < 2; ++b)
#pragma unroll
            for (int m = 0; m < 4; ++m)
#pragma unroll
                for (int n = 0; n < 2; ++n) acc[a][b][m][n] = (f32x4){0.f, 0.f, 0.f, 0.f};
    bf16x8 At[4][2], B0[2][2], B1[2][2];
    const char* cA = (const char*)g.A + (size_t)cur.pm * tstep; const char* cB = (const char*)g.Bt + (size_t)cur.pn * tstep;
    S.a_ready(cur);
    if constexpr (SP2) {
        PG8_STAGE(PG8_SB(0, 0), cB, voffB); PG8_STAGE(PG8_SB(0, 1), cB + hstep, voffB); PG8_STAGE(PG8_SA(0, 0), cA, voffA); PG8_STAGE(PG8_SA(0, 1), cA + hstep, voffA);
        if (wr == 1) PG8_BAR;
        PG8_WAIT_V(2); PG8_BAR;
        PG8_STAGE(PG8_SB(1, 0), cB + kstep, voffB); PG8_STAGE(PG8_SA(1, 0), cA + kstep, voffA); PG8_STAGE(PG8_SB(1, 1), cB + hstep + kstep, voffB);
        PG8_WAIT_V(6); PG8_BAR;
    } else {
        PG8_STAGE(PG8_SB(0, 0), cB, voffB); PG8_STAGE(PG8_SA(0, 0), cA, voffA); PG8_STAGE(PG8_SB(0, 1), cB + hstep, voffB); PG8_STAGE(PG8_SA(0, 1), cA + hstep, voffA);
        if (wr == 1) PG8_BAR;
        PG8_WAIT_V(4); PG8_BAR;
        PG8_STAGE(PG8_SB(1, 0), cB + kstep, voffB); PG8_STAGE(PG8_SA(1, 0), cA + kstep, voffA); PG8_STAGE(PG8_SB(1, 1), cB + hstep + kstep, voffB);
        PG8_WAIT_V(6); PG8_BAR;
    }
    for (;;) {
        const bool has_next = S.next(ui + 1, nxt);
        const char* nA = has_next ? (const char*)g.A + (size_t)nxt.pm * tstep : cA; const char* nB = has_next ? (const char*)g.Bt + (size_t)nxt.pn * tstep : cB;
        for (int t = 0; t < nt; t += 2) {
            const bool last = (t == nt - 2);
            const char* a1 = cA + (size_t)(t + 1) * kstep;
            const char* a2 = last ? nA : cA + (size_t)(t + 2) * kstep; const char* b2 = last ? nB : cB + (size_t)(t + 2) * kstep;
            const char* a3 = a2 + kstep; const char* b3 = b2 + kstep;
            if (last && has_next) S.a_ready(nxt);
            if constexpr (SP2) {
            PG8_LDB(B0, 0, 0); PG8_LDB(B1, 0, 1); PG8_SCHED; PG8_LDA(At, 0, 0); PG8_STAGE(PG8_SA(1, 1), a1 + hstep, voffA);
            PG8_WAIT_V(8); PG8_WAIT_L(0); PG8_BAR; PG8_MMA(0, 0, At, B0); PG8_MMA(0, 1, At, B1); PG8_BAR; PG8_SCHED;
            PG8_LDA(At, 0, 1); PG8_STAGE(PG8_SB(0, 0), b2, voffB); PG8_STAGE(PG8_SB(0, 1), b2 + hstep, voffB); PG8_STAGE(PG8_SA(0, 0), a2, voffA);
            PG8_WAIT_V(8); PG8_WAIT_L(0); PG8_BAR; PG8_MMA(1, 0, At, B0); PG8_MMA(1, 1, At, B1); PG8_BAR; PG8_SCHED;
            PG8_LDB(B0, 1, 0); PG8_LDB(B1, 1, 1); PG8_SCHED; PG8_LDA(At, 1, 0); PG8_STAGE(PG8_SA(0, 1), a2 + hstep, voffA);
            PG8_WAIT_V(8); PG8_WAIT_L(0); PG8_BAR; PG8_MMA(0, 0, At, B0); PG8_MMA(0, 1, At, B1); PG8_BAR; PG8_SCHED;
            PG8_LDA(At, 1, 1); PG8_STAGE(PG8_SB(1, 0), b3, voffB); PG8_STAGE(PG8_SB(1, 1), b3 + hstep, voffB); PG8_STAGE(PG8_SA(1, 0), a3, voffA);
            PG8_WAIT_V(8); PG8_WAIT_L(0); PG8_BAR; PG8_MMA(1, 0, At, B0); PG8_MMA(1, 1, At, B1); PG8_BAR; PG8_SCHED;
            } else {
            PG8_LDB(B0, 0, 0); PG8_SCHED; PG8_LDA(At, 0, 0); PG8_STAGE(PG8_SA(1, 1), a1 + hstep, voffA);
            PG8_WAIT_L(8); PG8_BAR; PG8_WAIT_L(0); PG8_MMA(0, 0, At, B0); PG8_BAR; PG8_SCHED;
            PG8_LDB(B1, 0, 1); PG8_STAGE(PG8_SB(0, 0), b2, voffB);
            PG8_BAR; PG8_WAIT_L(0); PG8_MMA(0, 1, At, B1); PG8_BAR;
            PG8_LDA(At, 0, 1); PG8_STAGE(PG8_SA(0, 0), a2, voffA);
            PG8_BAR; PG8_WAIT_L(0); PG8_MMA(1, 0, At, B0); PG8_BAR; PG8_SCHED;
            PG8_STAGE(PG8_SB(0, 1), b2 + hstep, voffB);
            PG8_WAIT_V(6); PG8_BAR; PG8_MMA(1, 1, At, B1); PG8_BAR;
            PG8_LDB(B0, 1, 0); PG8_SCHED; PG8_LDA(At, 1, 0); PG8_STAGE(PG8_SA(0, 1), a2 + hstep, voffA);
            PG8_WAIT_L(8); PG8_BAR; PG8_WAIT_L(0); PG8_MMA(0, 0, At, B0); PG8_BAR; PG8_SCHED;
            PG8_LDB(B1, 1, 1); PG8_STAGE(PG8_SB(1, 0), b3, voffB);
            PG8_BAR; PG8_WAIT_L(0); PG8_MMA(0, 1, At, B1); PG8_BAR;
            PG8_LDA(At, 1, 1); PG8_STAGE(PG8_SA(1, 0), a3, voffA);
            PG8_BAR; PG8_WAIT_L(0); PG8_MMA(1, 0, At, B0); PG8_BAR; PG8_SCHED;
            PG8_STAGE(PG8_SB(1, 1), b3 + hstep, voffB);
            PG8_WAIT_V(6); PG8_BAR; PG8_MMA(1, 1, At, B1); PG8_BAR;
            }
        }
        if constexpr (ALIGN_EPI) { if (wr == 0) PG8_BAR; }
        if constexpr (!Epi::AFTER_DRAIN) { E(acc, cur, wr, wc, fr, fq); S.done(cur); }
        if (!has_next) break;
#pragma unroll
        for (int a = 0; a < 2; ++a)
#pragma unroll
            for (int b = 0; b < 2; ++b)
#pragma unroll
                for (int m = 0; m < 4; ++m)
#pragma unroll
                    for (int n = 0; n < 2; ++n) acc[a][b][m][n] = (f32x4){0.f, 0.f, 0.f, 0.f};
        cur = nxt; cA = nA; cB = nB; ++ui;
        if constexpr (ALIGN_EPI) { if (wr == 1) PG8_BAR; }
    }
    PG8_WAIT_V(0);
    if constexpr (!ALIGN_EPI) { if (wr == 0) PG8_BAR; }
    PG8_BAR;
    if constexpr (Epi::AFTER_DRAIN) { E.fused(acc, cur, wr, wc, fr, fq, lds, wid, lane); S.done(cur); }
#undef PG8_SA
#undef PG8_SB
#undef PG8_STAGE
#undef PG8_LDA
#undef PG8_LDB
#undef PG8_MMA
#undef PG8_WAIT_V
#undef PG8_WAIT_L
#undef PG8_BAR
#undef PG8_SCHED
}
}

#ifndef PG8_SP2
#define PG8_SP2 true
#endif
#ifndef PG8_ALIGN
#define PG8_ALIGN true
#endif
constexpr int BATCH = 8, SEQ = 2048, DM = 1024, MROWS = BATCH * SEQ, DEPTH = 2;
constexpr int D_RNN = 512, NHEAD = 8, HDIM = 64, D_INR = 2760, ZP = 2816, TOPK = 256;
constexpr int C_XR = 0, C_GR = 512, C_Q = 1024, C_K = 1536, C_V = 1600, C_GA = 1664, C_QI = 2176, C_KI = 2688, C_WI = 2752;
constexpr float EPS = 1e-6f;
constexpr float QSCALE = 0.125f * 1.4426950408889634f;
constexpr size_t MiB = 1u << 20;
constexpr size_t WS_CTL = 0, CTL_ZERO_BYTES = 1 * MiB;
constexpr size_t WS_MOD = 1 * MiB;
constexpr size_t WS_BIAS = 1 * MiB + 256 * 1024;
constexpr size_t WS_SSQ = 2 * MiB;
constexpr size_t WS_WTIN = 3 * MiB;
constexpr size_t WS_WTOUT = 14 * MiB;
constexpr size_t WS_A = 32 * MiB;
constexpr size_t WS_Z = 64 * MiB;
constexpr size_t WS_Y = 152 * MiB;
constexpr size_t WS_END = 184 * MiB;
constexpr int LDS_BYTES = 163840;
constexpr int MISC_OFF = 131072 + 8192;
constexpr int NPHASE = 8;
constexpr int CW_BAR = 4096, CW_PANEL = 16384;

#define LAS __attribute__((address_space(3)))
typedef unsigned short bf16;
typedef float f32x4 __attribute__((ext_vector_type(4)));
typedef unsigned u32x4 __attribute__((ext_vector_type(4)));
typedef unsigned u32x2 __attribute__((ext_vector_type(2)));
__device__ __forceinline__ float bf2f(bf16 v) { return __uint_as_float(((unsigned)v) << 16); }
__device__ __forceinline__ unsigned f2bf(float f) { unsigned u = __float_as_uint(f); return (u + 0x7fffu + ((u >> 16) & 1u)) >> 16; }
__device__ __forceinline__ unsigned pk2(float lo, float hi) { return f2bf(lo) | (f2bf(hi) << 16); }
__device__ __forceinline__ float wave_sum(float v) {
#pragma unroll
    for (int o = 1; o < 64; o <<= 1) v += __shfl_xor(v, o);
    return v;
}
__device__ __forceinline__ float wave_max(float v) {
#pragma unroll
    for (int o = 1; o < 64; o <<= 1) v = fmaxf(v, __shfl_xor(v, o));
    return v;
}
__device__ __forceinline__ int wave_sum_i(int v) {
#pragma unroll
    for (int o = 1; o < 64; o <<= 1) v += __shfl_xor(v, o);
    return v;
}
__device__ __forceinline__ float siluf(float v) { return v / (1.f + expf(-v)); }
__device__ __forceinline__ float sigmf(float v) { return 1.f / (1.f + expf(-v)); }

struct P {
    const float *x, *c, *norm_g, *ada_w, *ada_b, *w_in, *conv_w, *conv_b, *lru_wx, *lru_bx, *lru_wa, *lru_ba, *lru_a, *w_out, *final_g;
    float* out;
    float *mod, *bias, *ssq;
    bf16 *wt_in, *wt_out, *A, *Z, *Y;
    unsigned* ctl;
};

#ifndef EPI_ZD
#define EPI_ZD 2
#endif
struct EpiZ {
    static constexpr bool PERM = true, AFTER_DRAIN = false;
    bf16* Zp; const float* ssq; const float* bias;
    __device__ __forceinline__ void operator()(const pg8::f32x4 (&acc)[2][2][4][2], const pg8::Unit& u, int wr, int wc, int fr, int fq) const {
        const int row0 = u.pm * 256 + wr * 64 + fr, col0 = u.pn * 256 + wc * 32 + 8 * fq, b = u.pm >> 3;
        const float cs = (u.pn == 4 || u.pn == 5) ? QSCALE : 1.0f;
        f32x4 bv[2][2];
#pragma unroll
        for (int bj = 0; bj < 2; ++bj)
#pragma unroll
            for (int n = 0; n < 2; ++n) bv[bj][n] = *(const f32x4*)(bias + b * ZP + col0 + bj * 128 + 4 * n);
        f32x4 qq[EPI_ZD];
#pragma unroll
        for (int gi = 0; gi < EPI_ZD; ++gi) qq[gi] = *(const f32x4*)(ssq + (size_t)(row0 + (gi >> 2) * 128 + (gi & 3) * 16) * 4);
#pragma unroll
        for (int ai = 0; ai < 2; ++ai)
#pragma unroll
            for (int m = 0; m < 4; ++m) {
                const int r = row0 + ai * 128 + m * 16, gi = ai * 4 + m;
                const f32x4 q = qq[gi % EPI_ZD];
                if (gi + EPI_ZD < 8) qq[gi % EPI_ZD] = *(const f32x4*)(ssq + (size_t)(row0 + ((gi + EPI_ZD) >> 2) * 128 + ((gi + EPI_ZD) & 3) * 16) * 4);
                const float rstd = 1.0f / sqrtf(((q.x + q.y) + (q.z + q.w)) * (1.0f / 1024.0f) + EPS);
                bf16* rowp = Zp + (size_t)r * ZP + col0;
#pragma unroll
                for (int bj = 0; bj < 2; ++bj) {
                    const f32x4 v0 = (acc[ai][bj][m][0] * rstd + bv[bj][0]) * cs, v1 = (acc[ai][bj][m][1] * rstd + bv[bj][1]) * cs;
                    u32x4 w; w.x = pk2(v0[0], v0[1]); w.y = pk2(v0[2], v0[3]); w.z = pk2(v1[0], v1[1]); w.w = pk2(v1[2], v1[3]);
                    *(u32x4*)(rowp + bj * 128) = w;
                }
            }
    }
};
#ifndef EPI_XD
#define EPI_XD 4
#endif
struct EpiX {
    static constexpr bool PERM = true, AFTER_DRAIN = true;
    const float* xres; float* xout; bf16* Anext; const float* gate; const float* ng; const float* nscale; float* ssq;
    __device__ __forceinline__ void fused(pg8::f32x4 (&acc)[2][2][4][2], const pg8::Unit& u, int wr, int wc, int fr, int fq, LAS unsigned char* lds, int wid, int lane) const {
        const int b = u.pm >> 3, col0 = u.pn * 256 + wc * 32 + 8 * fq;
        LAS float* Pp = (LAS float*)lds;
        f32x4 gv[2][2], gs[2][2];
#pragma unroll
        for (int bj = 0; bj < 2; ++bj)
#pragma unroll
            for (int n = 0; n < 2; ++n) {
                gv[bj][n] = *(const f32x4*)(gate + b * 3072 + col0 + bj * 128 + 4 * n);
                if (Anext) { const f32x4 g = *(const f32x4*)(ng + col0 + bj * 128 + 4 * n), s = *(const f32x4*)(nscale + b * 3072 + col0 + bj * 128 + 4 * n); gs[bj][n] = g * (s + 1.0f); }
                else gs[bj][n] = (f32x4){0.f, 0.f, 0.f, 0.f};
            }
        f32x4 xq[EPI_XD][2][2];
#define EPIX_LOAD(gi) do { const size_t r_ = (size_t)u.pm * 256 + ((gi) >> 2) * 128 + wr * 64 + ((gi) & 3) * 16 + fr; \
        _Pragma("unroll") for (int bj = 0; bj < 2; ++bj) _Pragma("unroll") for (int n = 0; n < 2; ++n) xq[(gi) % EPI_XD][bj][n] = *(const f32x4*)(xres + r_ * DM + col0 + bj * 128 + 4 * n); } while (0)
#pragma unroll
        for (int gi = 0; gi < EPI_XD; ++gi) EPIX_LOAD(gi);
#pragma unroll
        for (int ai = 0; ai < 2; ++ai)
#pragma unroll
            for (int m = 0; m < 4; ++m) {
                const int rl = ai * 128 + wr * 64 + m * 16 + fr; const size_t r = (size_t)u.pm * 256 + rl;
                float s = 0.f;
                f32x4 xc[2][2];
#pragma unroll
                for (int bj = 0; bj < 2; ++bj)
#pragma unroll
                    for (int n = 0; n < 2; ++n) xc[bj][n] = xq[(ai * 4 + m) % EPI_XD][bj][n];
                if (ai * 4 + m + EPI_XD < 8) EPIX_LOAD(ai * 4 + m + EPI_XD);
#pragma unroll
                for (int bj = 0; bj < 2; ++bj) {
                    f32x4 x1[2];
#pragma unroll
                    for (int n = 0; n < 2; ++n) {
                        const f32x4 xr = xc[bj][n];
                        x1[n] = xr + gv[bj][n] * acc[ai][bj][m][n];
                        *(f32x4*)(xout + r * DM + col0 + bj * 128 + 4 * n) = x1[n];
                        s += (x1[n][0] * x1[n][0] + x1[n][1] * x1[n][1]) + (x1[n][2] * x1[n][2] + x1[n][3] * x1[n][3]);
                    }
                    if (Anext) { const f32x4 a0 = x1[0] * gs[bj][0], a1 = x1[1] * gs[bj][1];
                        u32x4 w; w.x = pk2(a0[0], a0[1]); w.y = pk2(a0[2], a0[3]); w.z = pk2(a1[0], a1[1]); w.w = pk2(a1[2], a1[3]);
                        *(u32x4*)(Anext + r * DM + col0 + bj * 128) = w; }
                }
                s += __shfl_xor(s, 16); s += __shfl_xor(s, 32);
                if (fq == 0) Pp[rl * 4 + wc] = s;
            }
        __syncthreads();
        const int tid = wid * 64 + lane;
        if (tid < 256) ssq[((size_t)u.pm * 256 + tid) * 4 + u.pn] = (Pp[tid * 4 + 0] + Pp[tid * 4 + 1]) + (Pp[tid * 4 + 2] + Pp[tid * 4 + 3]);
        __syncthreads();
    }
};

struct EpiXF {
    static constexpr bool PERM = true, AFTER_DRAIN = true;
    const float* xres; float* out; const float* gate; const float* fg; float* ssq; unsigned* cnt;
    __device__ __forceinline__ void fused(pg8::f32x4 (&acc)[2][2][4][2], const pg8::Unit& u, int wr, int wc, int fr, int fq, LAS unsigned char* lds, int wid, int lane) const {
        const int b = u.pm >> 3, col0 = u.pn * 256 + wc * 32 + 8 * fq, tid = wid * 64 + lane;
        LAS float* Pp = (LAS float*)lds;
        LAS float* Sr = (LAS float*)(lds + 4096);
        {
            f32x4 gv[2][2];
#pragma unroll
            for (int bj = 0; bj < 2; ++bj)
#pragma unroll
                for (int n = 0; n < 2; ++n) gv[bj][n] = *(const f32x4*)(gate + b * 3072 + col0 + bj * 128 + 4 * n);
#pragma unroll
            for (int ai = 0; ai < 2; ++ai)
#pragma unroll
                for (int m = 0; m < 4; ++m) {
                    const int rl = ai * 128 + wr * 64 + m * 16 + fr; const size_t r = (size_t)u.pm * 256 + rl;
                    float s = 0.f;
#pragma unroll
                    for (int bj = 0; bj < 2; ++bj)
#pragma unroll
                        for (int n = 0; n < 2; ++n) {
                            const f32x4 xr = *(const f32x4*)(xres + r * DM + col0 + bj * 128 + 4 * n);
                            const f32x4 x1 = xr + gv[bj][n] * acc[ai][bj][m][n];
                            acc[ai][bj][m][n] = x1;
                            s += (x1[0] * x1[0] + x1[1] * x1[1]) + (x1[2] * x1[2] + x1[3] * x1[3]);
                        }
                    s += __shfl_xor(s, 16); s += __shfl_xor(s, 32);
                    if (fq == 0) Pp[rl * 4 + wc] = s;
                }
        }
        __syncthreads();
        if (tid < 256) { const float tot = (Pp[tid * 4 + 0] + Pp[tid * 4 + 1]) + (Pp[tid * 4 + 2] + Pp[tid * 4 + 3]);
            __hip_atomic_store(ssq + ((size_t)u.pm * 256 + tid) * 4 + u.pn, tot, __ATOMIC_RELAXED, __HIP_MEMORY_SCOPE_AGENT); }
        asm volatile("s_waitcnt vmcnt(0)" ::: "memory");
        __syncthreads();
        if (tid == 0) {
            unsigned* c = cnt + 64 * u.pm;
            __hip_atomic_fetch_add(c, 1u, __ATOMIC_RELAXED, __HIP_MEMORY_SCOPE_AGENT);
            unsigned spins = 0u;
            while (__hip_atomic_load(c, __ATOMIC_RELAXED, __HIP_MEMORY_SCOPE_AGENT) < 4u) { __builtin_amdgcn_s_sleep(2); if (++spins > (1u << 22)) break; }
            __builtin_amdgcn_fence(__ATOMIC_ACQUIRE, "agent");
            asm volatile("s_waitcnt vmcnt(0)" ::: "memory");
        }
        __syncthreads();
        if (tid < 256) { const float* sp = ssq + ((size_t)u.pm * 256 + tid) * 4;
            const float q0 = __hip_atomic_load(sp + 0, __ATOMIC_RELAXED, __HIP_MEMORY_SCOPE_AGENT), q1 = __hip_atomic_load(sp + 1, __ATOMIC_RELAXED, __HIP_MEMORY_SCOPE_AGENT);
            const float q2 = __hip_atomic_load(sp + 2, __ATOMIC_RELAXED, __HIP_MEMORY_SCOPE_AGENT), q3 = __hip_atomic_load(sp + 3, __ATOMIC_RELAXED, __HIP_MEMORY_SCOPE_AGENT);
            Sr[tid] = 1.0f / sqrtf(((q0 + q1) + (q2 + q3)) * (1.0f / 1024.0f) + EPS); }
        __syncthreads();
        f32x4 fgv[2][2];
#pragma unroll
        for (int bj = 0; bj < 2; ++bj)
#pragma unroll
            for (int n = 0; n < 2; ++n) fgv[bj][n] = *(const f32x4*)(fg + col0 + bj * 128 + 4 * n);
#pragma unroll
        for (int ai = 0; ai < 2; ++ai)
#pragma unroll
            for (int m = 0; m < 4; ++m) {
                const int rl = ai * 128 + wr * 64 + m * 16 + fr; const size_t r = (size_t)u.pm * 256 + rl; const float rstd = Sr[rl];
#pragma unroll
                for (int bj = 0; bj < 2; ++bj)
#pragma unroll
                    for (int n = 0; n < 2; ++n) *(f32x4*)(out + r * DM + col0 + bj * 128 + 4 * n) = acc[ai][bj][m][n] * rstd * fgv[bj][n];
            }
        __syncthreads();
    }
};

__device__ __forceinline__ void ph0_prologue(const P& p, LAS unsigned char* lds) {
    const int tid = threadIdx.x, lane = tid & 63, wave = tid >> 6, G = gridDim.x, wg = blockIdx.x;
    LAS float* fl = (LAS float*)lds;
    for (int u = wg; u < 96; u += G) {
        const int l = u / 48, j = (u % 48) * 64 + lane;
        for (int i = tid; i < 8192; i += 512) fl[i] = siluf(p.c[i]);
        __syncthreads();
        float acc[8];
#pragma unroll
        for (int b = 0; b < 8; ++b) acc[b] = 0.f;
        const float* w = p.ada_w + ((size_t)l * 1024 + wave * 128) * 3072 + j;
        for (int k = 0; k < 128; ++k) { const float wv = w[(size_t)k * 3072];
#pragma unroll
            for (int b = 0; b < 8; ++b) acc[b] += fl[b * 1024 + wave * 128 + k] * wv; }
#pragma unroll
        for (int b = 0; b < 8; ++b) fl[8192 + (wave * 8 + b) * 64 + lane] = acc[b];
        __syncthreads();
        { const int b = wave; float s = p.ada_b[l * 3072 + j];
#pragma unroll
          for (int w8 = 0; w8 < 8; ++w8) s += fl[8192 + (w8 * 8 + b) * 64 + lane];
          p.mod[(l * 8 + b) * 3072 + j] = s; }
        __syncthreads();
    }
#pragma unroll 1
    for (int u0 = wg; u0 < 1920; u0 += 2 * G) {
        float v[2][8]; bf16* dst[2]; bool act[2];
#pragma unroll
        for (int q = 0; q < 2; ++q) {
            const int u = u0 + q * G; act[q] = u < 1920; dst[q] = nullptr;
#pragma unroll
            for (int j = 0; j < 8; ++j) v[q][j] = 0.f;
            if (act[q]) {
                const float* W; bf16* WT; int N, kt, nt;
                if (u < 1408) { const int l = u / 704, r = u % 704; kt = r / 44; nt = r % 44; W = p.w_in + (size_t)l * 1024 * D_INR; N = D_INR; WT = p.wt_in + (size_t)l * ZP * 1024; }
                else { int r = u - 1408; const int l = r / 256; r %= 256; kt = r / 16; nt = r % 16; W = p.w_out + (size_t)l * 1024 * 1024; N = 1024; WT = p.wt_out + (size_t)l * 1024 * 1024; }
                const int n = nt * 64 + lane, k0 = kt * 64 + wave * 8;
                if (n < N) {
#pragma unroll
                    for (int j = 0; j < 8; ++j) v[q][j] = W[(size_t)(k0 + j) * N + n];
                }
                dst[q] = WT + (size_t)n * 1024 + k0;
            }
        }
#pragma unroll
        for (int q = 0; q < 2; ++q) if (act[q]) { u32x4 o; o.x = pk2(v[q][0], v[q][1]); o.y = pk2(v[q][2], v[q][3]); o.z = pk2(v[q][4], v[q][5]); o.w = pk2(v[q][6], v[q][7]); *(u32x4*)dst[q] = o; }
    }
}
__device__ __forceinline__ void ph1_prologue(const P& p, LAS unsigned char* lds) {
    const int tid = threadIdx.x, lane = tid & 63, wave = tid >> 6, G = gridDim.x, wg = blockIdx.x;
    LAS float* fl = (LAS float*)lds;
    for (int u = wg; u < 88; u += G) {
        const int l = u / 44, n = (u % 44) * 64 + lane;
        for (int i = tid; i < 8192; i += 512) fl[i] = p.mod[(l * 8 + (i >> 10)) * 3072 + (i & 1023)];
        __syncthreads();
        float acc[8];
#pragma unroll
        for (int b = 0; b < 8; ++b) acc[b] = 0.f;
        if (n < D_INR) { const float* w = p.w_in + ((size_t)l * 1024 + wave * 128) * D_INR + n;
            for (int k = 0; k < 128; ++k) { const float wv = w[(size_t)k * D_INR];
#pragma unroll
                for (int b = 0; b < 8; ++b) acc[b] += fl[b * 1024 + wave * 128 + k] * wv; } }
#pragma unroll
        for (int b = 0; b < 8; ++b) fl[8192 + (wave * 8 + b) * 64 + lane] = acc[b];
        __syncthreads();
        { const int b = wave; float s = 0.f;
#pragma unroll
          for (int w8 = 0; w8 < 8; ++w8) s += fl[8192 + (w8 * 8 + b) * 64 + lane];
          p.bias[(l * 8 + b) * ZP + n] = s; }
        __syncthreads();
    }
#pragma unroll 1
    for (int r = wg * 8 + wave; r < MROWS; r += G * 16) {
        const int r2 = (r + G * 8 < MROWS) ? r + G * 8 : r; const int b1 = r >> 11, b2 = r2 >> 11;
        f32x4 va[4], vb[4];
#pragma unroll
        for (int j = 0; j < 4; ++j) { const int k = (lane + 64 * j) * 4; va[j] = *(const f32x4*)(p.x + (size_t)r * DM + k); vb[j] = *(const f32x4*)(p.x + (size_t)r2 * DM + k); }
        float s1 = 0.f, s2 = 0.f;
#pragma unroll
        for (int j = 0; j < 4; ++j) { const int k = (lane + 64 * j) * 4;
            const f32x4 g = *(const f32x4*)(p.norm_g + k), sc1 = *(const f32x4*)(p.mod + (size_t)b1 * 3072 + 1024 + k), sc2 = *(const f32x4*)(p.mod + (size_t)b2 * 3072 + 1024 + k);
            s1 += (va[j][0] * va[j][0] + va[j][1] * va[j][1]) + (va[j][2] * va[j][2] + va[j][3] * va[j][3]);
            s2 += (vb[j][0] * vb[j][0] + vb[j][1] * vb[j][1]) + (vb[j][2] * vb[j][2] + vb[j][3] * vb[j][3]);
            const f32x4 o1 = va[j] * g * (sc1 + 1.0f), o2 = vb[j] * g * (sc2 + 1.0f);
            u32x2 w1, w2; w1.x = pk2(o1[0], o1[1]); w1.y = pk2(o1[2], o1[3]); w2.x = pk2(o2[0], o2[1]); w2.y = pk2(o2[2], o2[3]);
            *(u32x2*)(p.A + (size_t)r * DM + k) = w1; if (r2 != r) *(u32x2*)(p.A + (size_t)r2 * DM + k) = w2; }
        s1 = wave_sum(s1); s2 = wave_sum(s2);
        if (lane == 0) { *(f32x4*)(p.ssq + (size_t)r * 4) = (f32x4){s1, 0.f, 0.f, 0.f}; if (r2 != r) *(f32x4*)(p.ssq + (size_t)r2 * 4) = (f32x4){s2, 0.f, 0.f, 0.f}; }
    }
}
__device__ __forceinline__ void ph_final(const P& p) {
    const int tid = threadIdx.x, lane = tid & 63, wave = tid >> 6, G = gridDim.x, wg = blockIdx.x;
    for (int r = wg * 8 + wave; r < MROWS; r += G * 8) {
        const f32x4 q = *(const f32x4*)(p.ssq + (size_t)r * 4);
        const float rstd = 1.0f / sqrtf(((q.x + q.y) + (q.z + q.w)) * (1.0f / 1024.0f) + EPS);
#pragma unroll
        for (int j = 0; j < 4; ++j) { const int k = (lane + 64 * j) * 4;
            const f32x4 v = *(const f32x4*)(p.out + (size_t)r * DM + k), g = *(const f32x4*)(p.final_g + k);
            *(f32x4*)(p.out + (size_t)r * DM + k) = v * rstd * g; }
    }
}
#define XB_TMO      128
#define XB_XCNT(j)  (256  + 64 * (j))
#define XB_XSUB(j)  (1280 + 64 * (j))
#define XB_XGEN(j)  (2304 + 64 * (j))
#define XB_TOP      3328
#define XB_TOPGEN   3392
#define XCD_BAR_WORDS 3456
#define XB_SPIN_CAP (1u << 18)

__device__ __forceinline__ unsigned xb_ld(unsigned* p)              { return __hip_atomic_load(p, __ATOMIC_RELAXED, __HIP_MEMORY_SCOPE_AGENT); }
__device__ __forceinline__ unsigned xb_add(unsigned* p, unsigned v) { return __hip_atomic_fetch_add(p, v, __ATOMIC_RELAXED, __HIP_MEMORY_SCOPE_AGENT); }
__device__ __forceinline__ unsigned xb_xcc_id() { return (unsigned)__builtin_amdgcn_s_getreg((3 << 11) | 20) & 0xFu; }
#define XB_SPIN(cond, bar) do { unsigned _sp = 0; while (cond) { __builtin_amdgcn_s_sleep(1); \
    if ((++_sp & 255u) == 0u) { if (xb_ld(&(bar)[XB_TMO])) break; if (_sp > XB_SPIN_CAP) { atomicAdd(&(bar)[XB_TMO], 1u); break; } } } } while (0)

struct XcdBarrier {
    unsigned* bar; unsigned x;
    volatile LAS unsigned* st;
};

__device__ __forceinline__ XcdBarrier xcd_barrier_post(unsigned* bar, volatile LAS unsigned* st) {
    XcdBarrier b; b.bar = bar; b.x = xb_xcc_id(); b.st = st;
    if (threadIdx.x == 0) (void)xb_add(&bar[XB_XCNT(b.x)], 1u);
    return b;
}
__device__ __forceinline__ void xcd_barrier_complete(unsigned* bar, unsigned x, unsigned& nloc, unsigned& nx) {
    const unsigned G = gridDim.x * gridDim.y * gridDim.z;
    unsigned sum, cnt, mine, sp = 0u;
    for (;;) {
        sum = 0u; cnt = 0u; mine = 0u;
#pragma unroll
        for (unsigned j = 0; j < 16; ++j) { const unsigned c = xb_ld(&bar[XB_XCNT(j)]); sum += c; cnt += (c > 0u) ? 1u : 0u; mine = (j == x) ? c : mine; }
        if (sum == G) break;
        __builtin_amdgcn_s_sleep(1);
        if ((++sp & 255u) == 0u) { if (xb_ld(&bar[XB_TMO])) break; if (sp > XB_SPIN_CAP) { atomicAdd(&bar[XB_TMO], 1u); break; } }
    }
    nloc = mine > 0u ? mine : 1u; nx = cnt > 0u ? cnt : 1u;
}

__device__ __forceinline__ void xcd_barrier(const XcdBarrier& b) {
    asm volatile("s_waitcnt vmcnt(0)" ::: "memory");
    __syncthreads();
    if (threadIdx.x == 0) {
        unsigned* bar = b.bar;
        __builtin_amdgcn_s_waitcnt(0);
        unsigned nloc = b.st[0], nx = b.st[1];
        if (nloc == 0u) { xcd_barrier_complete(bar, b.x, nloc, nx); b.st[0] = nloc; b.st[1] = nx; }
        const unsigned old = xb_add(&bar[XB_XSUB(b.x)], 1u);
        const unsigned gen = old / nloc;
        if (old + 1u == (gen + 1u) * nloc) {
            __builtin_amdgcn_fence(__ATOMIC_RELEASE, "agent");
            asm volatile("s_waitcnt vmcnt(0)" ::: "memory");
            const unsigned og = xb_add(&bar[XB_TOP], 1u);
            const unsigned tg = og / nx;
            if (og + 1u == (tg + 1u) * nx) xb_add(&bar[XB_TOPGEN], 1u);
            else XB_SPIN(xb_ld(&bar[XB_TOPGEN]) == tg, bar);
            __builtin_amdgcn_fence(__ATOMIC_ACQUIRE, "agent");
            xb_add(&bar[XB_XGEN(b.x)], 1u);
            asm volatile("s_waitcnt vmcnt(0)" ::: "memory");
        } else {
            XB_SPIN(xb_ld(&bar[XB_XGEN(b.x)]) == gen, bar);
            __builtin_amdgcn_fence(__ATOMIC_ACQUIRE, "agent");
            asm volatile("s_waitcnt vmcnt(0)" ::: "memory");
        }
    }
    __syncthreads();
}
__device__ __forceinline__ unsigned score_ukey(float s) { const unsigned u = __float_as_uint(s + 0.0f); return (u & 0x80000000u) ? ~u : (u | 0x80000000u); }
__device__ __forceinline__ void topk_threshold(const unsigned (&k)[32], unsigned& thr, unsigned& need) {
    unsigned prefix = 0u; bool exact = false;
    for (int bit = 31; bit >= 0; --bit) {
        const unsigned cand = prefix | (1u << bit);
        int c = 0;
#pragma unroll
        for (int i = 0; i < 32; ++i) c += (k[i] >= cand) ? 1 : 0;
        c = wave_sum_i(c);
        if (c >= TOPK) prefix = cand;
        if (c == TOPK) { exact = true; break; }
    }
    thr = prefix;
    if (exact) { need = 0xffffffffu; }
    else { int c = 0;
#pragma unroll
        for (int i = 0; i < 32; ++i) c += (k[i] > prefix) ? 1 : 0;
        c = wave_sum_i(c); need = (unsigned)(TOPK - c); }
}
#ifndef PROBE_VALU
#define PROBE_VALU 0
#endif
#ifndef RP_T3
#define RP_T3 1
#endif
#ifndef RP_T1
#define RP_T1 1
#endif
#ifndef RP_T2
#define RP_T2 1
#endif
#ifndef RP_I
#define RP_I 1
#endif
#ifndef RP_T
#define RP_T 1
#endif
#ifndef RP_V
#define RP_V 1
#endif
typedef short bf16x8v __attribute__((ext_vector_type(8)));
typedef short s16x4v __attribute__((ext_vector_type(4)));
constexpr int BMS = 65;
constexpr int SCP = 2052;
constexpr int DSA_BM_OFF = 16 * SCP * 4;
constexpr int DSA_RING_OFF = 0;
constexpr int DSA_QIB_OFF = 147456;
constexpr int DSA_WIB_OFF = 135680;
constexpr int DSA_MLUT_OFF = 143616;
__device__ __forceinline__ void glds16(const void* gsrc, unsigned lds_dst) { unsigned keep;
    asm volatile("s_mov_b32 %0, m0\n\ts_mov_b32 m0, %2\n\ts_nop 0\n\tglobal_load_lds_dwordx4 %1, off\n\ts_mov_b32 m0, %0" : "=&s"(keep) : "v"(gsrc), "s"(lds_dst) : "memory"); }
template <int I> __device__ __forceinline__ unsigned mbit_t(int mw) { unsigned r; asm("v_bfe_i32 %0, %1, %2, 1" : "=v"(r) : "v"(mw), "i"(I)); return r; }
#define mbit(mw, i) mbit_t<(i)>(mw)
__device__ __forceinline__ float relu_i(float x) { return __int_as_float(max(__float_as_int(x), 0)); }
__device__ __forceinline__ int imax3(float a, float b, float c) { return max(max(__float_as_int(a), __float_as_int(b)), __float_as_int(c)); }
__device__ __forceinline__ s16x4v lds_tr16(LAS const unsigned char* p) { return __builtin_bit_cast(s16x4v, __builtin_amdgcn_ds_read_tr16_b64_v4i16((LAS s16x4v*)p)); }
__device__ __forceinline__ unsigned cvtpk(float lo, float hi) { typedef float f2 __attribute__((ext_vector_type(2))); typedef __bf16 b2 __attribute__((ext_vector_type(2))); f2 v = {lo, hi}; b2 r = __builtin_convertvector(v, b2); return __builtin_bit_cast(unsigned, r); }


template <int L> __device__ __forceinline__ void wr2lanes(int& w, unsigned lo, unsigned hi) {
    asm volatile("s_nop 1\n\tv_writelane_b32 %0, %1, %3\n\tv_writelane_b32 %0, %2, %4" : "+v"(w) : "s"(lo), "s"(hi), "i"(L), "i"(L + 1));
}
__device__ __forceinline__ int wave_sum_dpp(int v) {
    v += __builtin_amdgcn_update_dpp(0, v, 0xB1, 0xf, 0xf, true);
    v += __builtin_amdgcn_update_dpp(0, v, 0x4E, 0xf, 0xf, true);
    v += __builtin_amdgcn_update_dpp(0, v, 0x141, 0xf, 0xf, true);
    v += __builtin_amdgcn_update_dpp(0, v, 0x140, 0xf, 0xf, true);
    return __builtin_amdgcn_readlane(v, 0) + __builtin_amdgcn_readlane(v, 16) + __builtin_amdgcn_readlane(v, 32) + __builtin_amdgcn_readlane(v, 48);
}
__device__ __forceinline__ unsigned wave_max_dpp(unsigned v) {
    v = max(v, (unsigned)__builtin_amdgcn_update_dpp(0, (int)v, 0xB1, 0xf, 0xf, true));
    v = max(v, (unsigned)__builtin_amdgcn_update_dpp(0, (int)v, 0x4E, 0xf, 0xf, true));
    v = max(v, (unsigned)__builtin_amdgcn_update_dpp(0, (int)v, 0x141, 0xf, 0xf, true));
    v = max(v, (unsigned)__builtin_amdgcn_update_dpp(0, (int)v, 0x140, 0xf, 0xf, true));
    return max(max((unsigned)__builtin_amdgcn_readlane((int)v, 0), (unsigned)__builtin_amdgcn_readlane((int)v, 16)), max((unsigned)__builtin_amdgcn_readlane((int)v, 32), (unsigned)__builtin_amdgcn_readlane((int)v, 48)));
}
__device__ __forceinline__ int cnt8(int acc, unsigned cand, unsigned k0, unsigned k1, unsigned k2, unsigned k3, unsigned k4, unsigned k5, unsigned k6, unsigned k7) {
    unsigned long long m0, m1, m2, m3, m4, m5, m6, m7;
    asm volatile("v_cmp_le_u32_e64 %1, %9, %10\n\tv_cmp_le_u32_e64 %2, %9, %11\n\tv_cmp_le_u32_e64 %3, %9, %12\n\tv_cmp_le_u32_e64 %4, %9, %13\n\t"
                 "v_cmp_le_u32_e64 %5, %9, %14\n\tv_cmp_le_u32_e64 %6, %9, %15\n\tv_cmp_le_u32_e64 %7, %9, %16\n\tv_cmp_le_u32_e64 %8, %9, %17\n\t"
                 "v_addc_co_u32_e64 %0, %1, 0, %0, %1\n\tv_addc_co_u32_e64 %0, %2, 0, %0, %2\n\tv_addc_co_u32_e64 %0, %3, 0, %0, %3\n\tv_addc_co_u32_e64 %0, %4, 0, %0, %4\n\t"
                 "v_addc_co_u32_e64 %0, %5, 0, %0, %5\n\tv_addc_co_u32_e64 %0, %6, 0, %0, %6\n\tv_addc_co_u32_e64 %0, %7, 0, %0, %7\n\tv_addc_co_u32_e64 %0, %8, 0, %0, %8"
                 : "+v"(acc), "=&s"(m0), "=&s"(m1), "=&s"(m2), "=&s"(m3), "=&s"(m4), "=&s"(m5), "=&s"(m6), "=&s"(m7)
                 : "s"(cand), "v"(k0), "v"(k1), "v"(k2), "v"(k3), "v"(k4), "v"(k5), "v"(k6), "v"(k7));
    return acc;
}
__device__ __forceinline__ int count_ge(const unsigned (&k)[32], unsigned cand_, int nb) {
    const unsigned cand = (unsigned)__builtin_amdgcn_readfirstlane((int)cand_);
    int c = 0;
    c = cnt8(c, cand, k[0], k[1], k[2], k[3], k[4], k[5], k[6], k[7]);
    if (nb > 1) c = cnt8(c, cand, k[8], k[9], k[10], k[11], k[12], k[13], k[14], k[15]);
    if (nb > 2) c = cnt8(c, cand, k[16], k[17], k[18], k[19], k[20], k[21], k[22], k[23]);
    if (nb > 3) c = cnt8(c, cand, k[24], k[25], k[26], k[27], k[28], k[29], k[30], k[31]);
    return wave_sum_dpp(c);
}
struct TopkState { unsigned prefix; int bit; bool done; unsigned need; int nb; };
__device__ __forceinline__ void topk_init(const unsigned (&k)[32], TopkState& st) {
    unsigned mx = 0u;
#pragma unroll
    for (int i = 0; i < 32; ++i) mx = max(mx, k[i]);
    mx = wave_max_dpp(mx);
    st.prefix = 0u; st.bit = 31; st.done = false; st.need = 0u;
    unsigned E = mx >> 23;
#pragma unroll 1
    for (int j = 0; j < 4; ++j) {
        if (E < (unsigned)j + 1u) break;
        const unsigned T = (E - (unsigned)j) << 23;
        const int c = count_ge(k, T, st.nb);
        if (c >= TOPK) { st.prefix = T; st.bit = 22; if (c == TOPK) { st.done = true; st.need = 0xffffffffu; } break; }
    }
}
__device__ __forceinline__ void topk_step(const unsigned (&k)[32], TopkState& st) {
    if (st.done) return;
    if (st.bit < 0) { int c = 0;
#pragma unroll
        for (int i = 0; i < 32; ++i) c += (k[i] > st.prefix) ? 1 : 0;
        c = wave_sum_dpp(c); st.need = (unsigned)(TOPK - c); st.done = true; return; }
    const unsigned cand = st.prefix | (1u << st.bit);
    const int c = count_ge(k, cand, st.nb);
    if (c >= TOPK) st.prefix = cand;
    if (c == TOPK) { st.done = true; st.need = 0xffffffffu; }
    --st.bit;
}

__device__ __forceinline__ void dsa_prefetch_qi(const bf16* zb, int qt, LAS unsigned char* lds, int wave, int lane) {
    const unsigned lds_base = (unsigned)(uintptr_t)lds;
#pragma unroll
    for (int i = 0; i < 2; ++i) { const int row = 2 * wave + i;
        glds16(zb + (size_t)(qt * 16 + row) * ZP + C_QI + ((lane ^ row) * 8), (unsigned)__builtin_amdgcn_readfirstlane(lds_base + DSA_QIB_OFF + row * 1024)); }
    if (wave == 0) glds16(zb + (size_t)(qt * 16 + (lane & 15)) * ZP + C_WI, (unsigned)__builtin_amdgcn_readfirstlane(lds_base + DSA_WIB_OFF));
}

__device__ __forceinline__ void dsa_prefetch_ki(const bf16* zb, int qt, bf16x8v (&pk)[4], int wave, int lane) {
    const int r16 = lane & 15, g = lane >> 4;
    if (wave <= qt) { const bf16* krow = zb + (size_t)(wave * 16 + r16) * ZP + C_KI; pk[0] = *(const bf16x8v*)(krow + 8 * g); pk[1] = *(const bf16x8v*)(krow + 32 + 8 * g); }
    if (wave + 8 <= qt) { const bf16* krow = zb + (size_t)((wave + 8) * 16 + r16) * ZP + C_KI; pk[2] = *(const bf16x8v*)(krow + 8 * g); pk[3] = *(const bf16x8v*)(krow + 32 + 8 * g); }
}

__device__ __forceinline__ void dsa_unit(const P& p, int b, int qt, int qt_next, bf16x8v (&pk)[4], LAS unsigned char* lds) {
    const int tid = threadIdx.x, lane = tid & 63, wave = __builtin_amdgcn_readfirstlane(tid >> 6), r16 = lane & 15, g = lane >> 4;
    const int q0 = qt * 16; const bf16* zb = p.Z + (size_t)b * SEQ * ZP;
    LAS float* SC = (LAS float*)lds; LAS unsigned* BM = (LAS unsigned*)(lds + DSA_BM_OFF);
    const bool dense_all = (qt < TOPK / 16);
    const bf16* qrow = zb + (size_t)(q0 + r16) * ZP;
    const bf16x8v bq0 = *(const bf16x8v*)(qrow + C_Q + wave * 64 + 8 * g), bq1 = *(const bf16x8v*)(qrow + C_Q + wave * 64 + 32 + 8 * g);
    u32x2 gwv[4];
#pragma unroll
    for (int dt = 0; dt < 4; ++dt) gwv[dt] = *(const u32x2*)(qrow + C_GA + wave * 64 + dt * 16 + 4 * g);
    const int nsteps = (((q0 + 16 + 31) >> 5) + 1) & ~1, nmega = (nsteps + 7) >> 3;
    const int kkey = lane >> 3, vkey = lane >> 1, vhalf = lane & 1;
    const unsigned lds_base = (unsigned)(uintptr_t)lds;
#define DSA_STAGE(mm) do { const int st_ = (mm) * 8 + wave; if (st_ < nsteps) { \
        const bf16* kb_ = zb + (size_t)st_ * 32 * ZP; const unsigned ldsb_ = lds_base + (unsigned)(((mm) & 1) * 65536 + wave * 4096); \
        _Pragma("unroll") for (int c_ = 0; c_ < 4; ++c_) { const int key_ = 8 * c_ + kkey, ch_ = (lane & 7) ^ ((key_ & 15) >> 1); \
            glds16(kb_ + (size_t)key_ * ZP + C_K + ch_ * 8, (unsigned)__builtin_amdgcn_readfirstlane(ldsb_ + c_ * 1024)); } \
        _Pragma("unroll") for (int c_ = 0; c_ < 4; ++c_) \
            glds16(kb_ + (size_t)vkey * ZP + C_V + c_ * 16 + vhalf * 8, (unsigned)__builtin_amdgcn_readfirstlane(ldsb_ + 32768 + c_ * 1024)); } } while (0)
    if (!dense_all) {
        for (int rpI = 0; rpI < RP_I; ++rpI) {
        bf16x8v bq[8][2]; float wv[8];
#pragma unroll
        for (int h = 0; h < 8; ++h) { bq[h][0] = *(LAS const bf16x8v*)(lds + DSA_QIB_OFF + r16 * 1024 + (((8 * h + g) ^ r16) * 16)); bq[h][1] = *(LAS const bf16x8v*)(lds + DSA_QIB_OFF + r16 * 1024 + (((8 * h + 4 + g) ^ r16) * 16));
            wv[h] = bf2f(*(LAS const bf16*)(lds + DSA_WIB_OFF + r16 * 16 + h * 2)) * 0.35355339059327373f * 0.125f; }
        bf16x8v ra0 = pk[0], ra1 = pk[1], rb0 = pk[2], rb1 = pk[3], rc0 = pk[0], rc1 = pk[1];
#define IDX_LOAD(d0, d1, ktl) do { const int ktl_ = (ktl) <= qt ? (ktl) : qt;        \
            const bf16* krow_ = zb + (size_t)(ktl_ * 16 + r16) * ZP + C_KI; d0 = *(const bf16x8v*)(krow_ + 8 * g); d1 = *(const bf16x8v*)(krow_ + 32 + 8 * g); } while (0)
#define IDX_STEP(c0, c1) do { \
            f32x4 sc = {0.f, 0.f, 0.f, 0.f}; \
            _Pragma("unroll") for (int h = 0; h < 8; ++h) { \
                f32x4 acc = {0.f, 0.f, 0.f, 0.f}; \
                acc = __builtin_amdgcn_mfma_f32_16x16x32_bf16(c0, bq[h][0], acc, 0, 0, 0); \
                acc = __builtin_amdgcn_mfma_f32_16x16x32_bf16(c1, bq[h][1], acc, 0, 0, 0); \
                _Pragma("unroll") for (int i = 0; i < 4; ++i) sc[i] += relu_i(acc[i]) * wv[h]; \
            } \
            if (__builtin_amdgcn_readfirstlane(kt) == qt) {                  \
                _Pragma("unroll") for (int i = 0; i < 4; ++i) sc[i] = (4 * g + i > r16) ? -INFINITY : sc[i]; \
            } \
            *(LAS f32x4*)(SC + r16 * SCP + kt * 16 + 4 * g) = sc; } while (0)
        int kt = wave;
        const int nst = (qt - wave + 8) >> 3;
        const int ntrip = (nst * 11) >> 5, rem = nst - 3 * ntrip;
#pragma unroll 1
        for (int it = ntrip; it > 0; --it) {
            IDX_LOAD(rc0, rc1, kt + 16); __builtin_amdgcn_sched_barrier(0); IDX_STEP(ra0, ra1); __builtin_amdgcn_sched_barrier(0); kt += 8;
            IDX_LOAD(ra0, ra1, kt + 16); __builtin_amdgcn_sched_barrier(0); IDX_STEP(rb0, rb1); __builtin_amdgcn_sched_barrier(0); kt += 8;
            IDX_LOAD(rb0, rb1, kt + 16); __builtin_amdgcn_sched_barrier(0); IDX_STEP(rc0, rc1); __builtin_amdgcn_sched_barrier(0); kt += 8;
        }
        if (rem >= 1) { IDX_STEP(ra0, ra1); kt += 8; if (rem >= 2) { IDX_STEP(rb0, rb1); } }
#undef IDX_LOAD
#undef IDX_STEP
        __syncthreads();
        }
#pragma unroll 1
        for (int rpT = 0; rpT < RP_T; ++rpT) {
            const int ra = 2 * wave, rb = 2 * wave + 1, ta = q0 + ra, tb = q0 + rb;
            unsigned ka[32], kb[32];
#pragma unroll
            for (int i = 0; i < 32; ++i) { const int key = lane + 64 * i; ka[i] = (key <= ta) ? score_ukey(SC[ra * SCP + key]) : 0u; kb[i] = (key <= tb) ? score_ukey(SC[rb * SCP + key]) : 0u; }
#if RP_T1 > 1
            asm volatile("" :: "v"(ka[0]), "v"(kb[31]) : "memory");
#pragma unroll
            for (int i = 0; i < 32; ++i) { const int key = lane + 64 * i; ka[i] = (key <= ta) ? score_ukey(SC[ra * SCP + key]) : 0u; kb[i] = (key <= tb) ? score_ukey(SC[rb * SCP + key]) : 0u; }
            asm volatile("" ::: "memory");
#endif
            asm volatile("s_waitcnt lgkmcnt(0)" ::: "memory");
            __syncthreads();
            DSA_STAGE(0);
            TopkState sa, sb; sa.nb = (ta >> 9) + 1; sb.nb = (tb >> 9) + 1; topk_init(ka, sa); topk_init(kb, sb);
#pragma unroll 1
            while (!(sa.done && sb.done)) { topk_step(ka, sa); topk_step(kb, sb); }
#if RP_T2 > 1
            asm volatile("" :: "v"(sa.prefix), "v"(sb.prefix));
            topk_init(ka, sa); topk_init(kb, sb);
#pragma unroll 1
            while (!(sa.done && sb.done)) { topk_step(ka, sa); topk_step(kb, sb); }
#endif
            if (sa.need == 0xffffffffu && sb.need == 0xffffffffu) {
                const unsigned ta_ = (unsigned)__builtin_amdgcn_readfirstlane((int)sa.prefix), tb_ = (unsigned)__builtin_amdgcn_readfirstlane((int)sb.prefix);
                int wa = 0, wb = 0;
#define WR2(i) { const unsigned long long ma = __ballot(ka[i] >= ta_), mb = __ballot(kb[i] >= tb_); wr2lanes<2 * (i)>(wa, (unsigned)ma, (unsigned)(ma >> 32)); wr2lanes<2 * (i)>(wb, (unsigned)mb, (unsigned)(mb >> 32)); }
                WR2(0) WR2(1) WR2(2) WR2(3) WR2(4) WR2(5) WR2(6) WR2(7) WR2(8) WR2(9) WR2(10) WR2(11) WR2(12) WR2(13) WR2(14) WR2(15)
                WR2(16) WR2(17) WR2(18) WR2(19) WR2(20) WR2(21) WR2(22) WR2(23) WR2(24) WR2(25) WR2(26) WR2(27) WR2(28) WR2(29) WR2(30) WR2(31)
#undef WR2
                BM[ra * BMS + lane] = (unsigned)wa; BM[rb * BMS + lane] = (unsigned)wb;
#if RP_T3 > 1
                asm volatile("" : "+v"(wa), "+v"(wb) :: "memory");
#define WR2(i) { const unsigned long long ma = __ballot(ka[i] >= ta_), mb = __ballot(kb[i] >= tb_); wr2lanes<2 * (i)>(wa, (unsigned)ma, (unsigned)(ma >> 32)); wr2lanes<2 * (i)>(wb, (unsigned)mb, (unsigned)(mb >> 32)); }
                WR2(0) WR2(1) WR2(2) WR2(3) WR2(4) WR2(5) WR2(6) WR2(7) WR2(8) WR2(9) WR2(10) WR2(11) WR2(12) WR2(13) WR2(14) WR2(15)
                WR2(16) WR2(17) WR2(18) WR2(19) WR2(20) WR2(21) WR2(22) WR2(23) WR2(24) WR2(25) WR2(26) WR2(27) WR2(28) WR2(29) WR2(30) WR2(31)
#undef WR2
                BM[ra * BMS + lane] = (unsigned)wa; BM[rb * BMS + lane] = (unsigned)wb;
#endif
            } else {
            unsigned eqa = 0u, eqb = 0u;
#pragma unroll 1
            for (int i = 0; i < 32; ++i) {
                unsigned kai = ka[0], kbi = kb[0];
#pragma unroll
                for (int j = 1; j < 32; ++j) { kai = (i == j) ? ka[j] : kai; kbi = (i == j) ? kb[j] : kbi; }
                { const bool eq = (kai == sa.prefix); const unsigned long long em = __ballot(eq);
                  const unsigned erank = eqa + __builtin_amdgcn_mbcnt_hi((unsigned)(em >> 32), __builtin_amdgcn_mbcnt_lo((unsigned)em, 0u));
                  const unsigned long long smk = __ballot((kai > sa.prefix) || (eq && erank < sa.need));
                  if (lane == 0) { BM[ra * BMS + 2 * i] = (unsigned)smk; BM[ra * BMS + 2 * i + 1] = (unsigned)(smk >> 32); }
                  eqa += (unsigned)__popcll(em); }
                { const bool eq = (kbi == sb.prefix); const unsigned long long em = __ballot(eq);
                  const unsigned erank = eqb + __builtin_amdgcn_mbcnt_hi((unsigned)(em >> 32), __builtin_amdgcn_mbcnt_lo((unsigned)em, 0u));
                  const unsigned long long smk = __ballot((kbi > sb.prefix) || (eq && erank < sb.need));
                  if (lane == 0) { BM[rb * BMS + 2 * i] = (unsigned)smk; BM[rb * BMS + 2 * i + 1] = (unsigned)(smk >> 32); }
                  eqb += (unsigned)__popcll(em); }
            }
            }
        }
    } else {
        for (int i = tid; i < 1024; i += 512) { const int row = i >> 6, w = i & 63, t = q0 + row, lo = 32 * w;
            BM[row * BMS + w] = (t >= lo + 31) ? 0xffffffffu : ((t < lo) ? 0u : ((2u << (t - lo)) - 1u)); }
        DSA_STAGE(0);
    }
    __syncthreads();
    const int h = wave;
#pragma unroll 1
    for (int rpV = 0; rpV < RP_V; ++rpV) {
    asm volatile("s_waitcnt vmcnt(0)" ::: "memory");
    asm volatile("" :: "v"(bq0), "v"(bq1), "v"(gwv[0]), "v"(gwv[1]), "v"(gwv[2]), "v"(gwv[3]));
    __syncthreads();
    if (qt_next >= TOPK / 16) { dsa_prefetch_qi(zb, qt_next, lds, wave, lane); dsa_prefetch_ki(zb, qt_next, pk, wave, lane); }
    f32x4 o[4], lacc = {0.f, 0.f, 0.f, 0.f}, negm = {0.f, 0.f, 0.f, 0.f};
#pragma unroll
    for (int dt = 0; dt < 4; ++dt) o[dt] = (f32x4){0.f, 0.f, 0.f, 0.f};
    float m_run = 0.f;
    const int kofs0 = r16 * 128 + ((g ^ (r16 >> 1)) & 7) * 16, kofs1 = r16 * 128 + (((4 + g) ^ (r16 >> 1)) & 7) * 16;
    const int vofs = 32768 + (4 * g + ((lane & 15) >> 2)) * 32 + (lane & 3) * 8;
    bf16x8v ones = {0x3f80, 0x3f80, 0x3f80, 0x3f80, 0x3f80, 0x3f80, 0x3f80, 0x3f80};
    asm volatile("" : "+v"(ones));
    LAS const unsigned char* mlut = lds + DSA_MLUT_OFF;
    constexpr float THR = 8.0f;
    bool first = true;
#pragma unroll 1
    for (int mm = 0; mm < nmega; ++mm) {
        if (mm + 1 < nmega) DSA_STAGE(mm + 1);
        LAS unsigned char* slotb = lds + (mm & 1) * 65536;
        const int nsub = (nsteps - mm * 8) < 8 ? (nsteps - mm * 8) : 8;
#pragma unroll 1
        for (int u = 0; u < nsub; u += 2) {
            LAS unsigned char* slot = slotb + u * 4096;
            const int mwA = (int)(BM[r16 * BMS + mm * 8 + u] >> (4 * g)), mwB = (int)(BM[r16 * BMS + mm * 8 + u + 1] >> (4 * g));
            f32x4 s0, s1, s2, s3;
            { const bf16x8v ka0 = *(LAS const bf16x8v*)(slot + kofs0), ka1 = *(LAS const bf16x8v*)(slot + kofs1);
              const bf16x8v kb0 = *(LAS const bf16x8v*)(slot + 2048 + kofs0), kb1 = *(LAS const bf16x8v*)(slot + 2048 + kofs1);
              const bf16x8v kc0 = *(LAS const bf16x8v*)(slot + 4096 + kofs0), kc1 = *(LAS const bf16x8v*)(slot + 4096 + kofs1);
              const bf16x8v kd0 = *(LAS const bf16x8v*)(slot + 6144 + kofs0), kd1 = *(LAS const bf16x8v*)(slot + 6144 + kofs1);
              s0 = __builtin_amdgcn_mfma_f32_16x16x32_bf16(ka0, bq0, negm, 0, 0, 0); s1 = __builtin_amdgcn_mfma_f32_16x16x32_bf16(kb0, bq0, negm, 0, 0, 0);
              s2 = __builtin_amdgcn_mfma_f32_16x16x32_bf16(kc0, bq0, negm, 0, 0, 0); s3 = __builtin_amdgcn_mfma_f32_16x16x32_bf16(kd0, bq0, negm, 0, 0, 0);
              s0 = __builtin_amdgcn_mfma_f32_16x16x32_bf16(ka1, bq1, s0, 0, 0, 0); s1 = __builtin_amdgcn_mfma_f32_16x16x32_bf16(kb1, bq1, s1, 0, 0, 0);
              s2 = __builtin_amdgcn_mfma_f32_16x16x32_bf16(kc1, bq1, s2, 0, 0, 0); s3 = __builtin_amdgcn_mfma_f32_16x16x32_bf16(kd1, bq1, s3, 0, 0, 0); }
            const int lmi = max(max(max(imax3(s0[0], s0[1], s0[2]), imax3(s0[3], s1[0], s1[1])), max(imax3(s1[2], s1[3], s2[0]), imax3(s2[1], s2[2], s2[3]))), max(imax3(s3[0], s3[1], s3[2]), __float_as_int(s3[3])));
            if (first || __any(lmi > 0x41000000)) {
                float lmx = fmaxf(fmaxf(fmaxf(fmaxf(s0[0], s0[1]), fmaxf(s0[2], s0[3])), fmaxf(fmaxf(s1[0], s1[1]), fmaxf(s1[2], s1[3]))), fmaxf(fmaxf(fmaxf(s2[0], s2[1]), fmaxf(s2[2], s2[3])), fmaxf(fmaxf(s3[0], s3[1]), fmaxf(s3[2], s3[3]))));
                { const auto r1 = __builtin_amdgcn_permlane16_swap(__float_as_uint(lmx), __float_as_uint(lmx), false, false); lmx = fmaxf(__uint_as_float(r1[0]), __uint_as_float(r1[1])); }
                { const auto r2 = __builtin_amdgcn_permlane32_swap(__float_as_uint(lmx), __float_as_uint(lmx), false, false); lmx = fmaxf(__uint_as_float(r2[0]), __uint_as_float(r2[1])); }
                const float dl = first ? lmx : fmaxf(lmx, 0.f);
                m_run += dl; const float f = first ? 1.0f : __builtin_amdgcn_exp2f(-dl);
#pragma unroll
                for (int i = 0; i < 4; ++i) { s0[i] -= dl; s1[i] -= dl; s2[i] -= dl; s3[i] -= dl; negm[i] = -m_run; }
                lacc = lacc * f;
#pragma unroll
                for (int dt = 0; dt < 4; ++dt) o[dt] = o[dt] * f;
                first = false;
            }
            const u32x2 mk0 = *(LAS const u32x2*)(mlut + ((mwA & 15) << 3)), mk1 = *(LAS const u32x2*)(mlut + (((mwA >> 16) & 15) << 3));
            const u32x2 mk2 = *(LAS const u32x2*)(mlut + ((mwB & 15) << 3)), mk3 = *(LAS const u32x2*)(mlut + (((mwB >> 16) & 15) << 3));
            u32x4 pwA, pwB;
            pwA.x = cvtpk(__builtin_amdgcn_exp2f(s0[0]), __builtin_amdgcn_exp2f(s0[1])) & mk0.x; pwA.y = cvtpk(__builtin_amdgcn_exp2f(s0[2]), __builtin_amdgcn_exp2f(s0[3])) & mk0.y;
            pwA.z = cvtpk(__builtin_amdgcn_exp2f(s1[0]), __builtin_amdgcn_exp2f(s1[1])) & mk1.x; pwA.w = cvtpk(__builtin_amdgcn_exp2f(s1[2]), __builtin_amdgcn_exp2f(s1[3])) & mk1.y;
            pwB.x = cvtpk(__builtin_amdgcn_exp2f(s2[0]), __builtin_amdgcn_exp2f(s2[1])) & mk2.x; pwB.y = cvtpk(__builtin_amdgcn_exp2f(s2[2]), __builtin_amdgcn_exp2f(s2[3])) & mk2.y;
            pwB.z = cvtpk(__builtin_amdgcn_exp2f(s3[0]), __builtin_amdgcn_exp2f(s3[1])) & mk3.x; pwB.w = cvtpk(__builtin_amdgcn_exp2f(s3[2]), __builtin_amdgcn_exp2f(s3[3])) & mk3.y;
            const bf16x8v pfA = __builtin_bit_cast(bf16x8v, pwA), pfB = __builtin_bit_cast(bf16x8v, pwB);
            lacc = __builtin_amdgcn_mfma_f32_16x16x32_bf16(ones, pfA, lacc, 0, 0, 0);
            lacc = __builtin_amdgcn_mfma_f32_16x16x32_bf16(ones, pfB, lacc, 0, 0, 0);
#pragma unroll
            for (int dt = 0; dt < 4; ++dt) {
                const s16x4v lo = lds_tr16(slot + vofs + dt * 1024), hi = lds_tr16(slot + vofs + dt * 1024 + 512);
                const s16x4v lo2 = lds_tr16(slot + 4096 + vofs + dt * 1024), hi2 = lds_tr16(slot + 4096 + vofs + dt * 1024 + 512);
                const bf16x8v vf = {lo[0], lo[1], lo[2], lo[3], hi[0], hi[1], hi[2], hi[3]};
                const bf16x8v vf2 = {lo2[0], lo2[1], lo2[2], lo2[3], hi2[0], hi2[1], hi2[2], hi2[3]};
                o[dt] = __builtin_amdgcn_mfma_f32_16x16x32_bf16(vf, pfA, o[dt], 0, 0, 0);
                o[dt] = __builtin_amdgcn_mfma_f32_16x16x32_bf16(vf2, pfB, o[dt], 0, 0, 0);
            }
        }
        asm volatile("s_waitcnt vmcnt(0) lgkmcnt(0)" ::: "memory");
        __syncthreads();
    }
#undef DSA_STAGE
    const float inv = 1.0f / lacc[0];
    bf16* yrow = p.Y + ((size_t)b * SEQ + q0 + r16) * DM + 512 + h * 64;
#pragma unroll
    for (int dt = 0; dt < 4; ++dt) {
        const u32x2 gw = gwv[dt];
        const float g0 = __uint_as_float(gw.x << 16), g1 = __uint_as_float(gw.x & 0xffff0000u), g2 = __uint_as_float(gw.y << 16), g3 = __uint_as_float(gw.y & 0xffff0000u);
        u32x2 w; w.x = pk2(o[dt][0] * inv * siluf(g0), o[dt][1] * inv * siluf(g1)); w.y = pk2(o[dt][2] * inv * siluf(g2), o[dt][3] * inv * siluf(g3));
        *(u32x2*)(yrow + dt * 16 + 4 * g) = w;
    }
    __syncthreads();
    }
}
__device__ __forceinline__ int dsa_qt_of(int j, int i) { return (i == 0) ? 127 - j : (i == 1) ? 64 + j : (i == 2) ? 63 - j : j; }
__device__ __forceinline__ void dsa_phase_pre(const P& p, LAS unsigned char* lds) {
    const int G = gridDim.x, wg = blockIdx.x, lane = threadIdx.x & 63, wave = __builtin_amdgcn_readfirstlane(threadIdx.x >> 6);
    const int b = (G == 256) ? (wg & 7) : (wg >> 7), qt = (G == 256) ? dsa_qt_of(wg >> 3, 0) : 127 - (wg & 127);
    if (wg < 1024 && qt >= TOPK / 16) dsa_prefetch_qi(p.Z + (size_t)b * SEQ * ZP, qt, lds, wave, lane);
}
__device__ __forceinline__ void dsa_phase(const P& p, LAS unsigned char* lds) {
    const int G = gridDim.x, wg = blockIdx.x;
    if (G == 256) {
        const int b = wg & 7, j = wg >> 3, lane = threadIdx.x & 63, wave = __builtin_amdgcn_readfirstlane(threadIdx.x >> 6);
        bf16x8v pk[4] = {{0, 0, 0, 0, 0, 0, 0, 0}, {0, 0, 0, 0, 0, 0, 0, 0}, {0, 0, 0, 0, 0, 0, 0, 0}, {0, 0, 0, 0, 0, 0, 0, 0}};
        if (dsa_qt_of(j, 0) >= TOPK / 16) dsa_prefetch_ki(p.Z + (size_t)b * SEQ * ZP, dsa_qt_of(j, 0), pk, wave, lane);
#pragma unroll 1
        for (int i = 0; i < 4; ++i) dsa_unit(p, b, dsa_qt_of(j, i), (i < 3) ? dsa_qt_of(j, i + 1) : -1, pk, lds);
    }
}
constexpr int LRU_WS_OFF = 139264;
constexpr int LRU_XB = 264 * 128;
constexpr int LRU_GB = 256 * 32;
constexpr int LRU_BUF = LRU_XB + LRU_GB;
__device__ __forceinline__ float fast_sigm(float x) { return __builtin_amdgcn_rcpf(1.0f + __expf(-x)); }
__device__ __forceinline__ void lru_unit(const P& p, int l, int b, int blk, int q4, LAS unsigned char* lds) {
    const int tid = threadIdx.x, lane = tid & 63, wave = __builtin_amdgcn_readfirstlane(tid >> 6), r16 = lane & 15, g = lane >> 4;
    const bf16* zb = p.Z + (size_t)b * SEQ * ZP;
    const int cA = blk * 64, dloc = q4 * 16 + r16, dg = blk * 64 + dloc;
    const unsigned lds_base = (unsigned)(uintptr_t)lds;
#define LRU_STAGE(r) do { const unsigned bb_ = lds_base + (unsigned)(((r) & 1) * LRU_BUF); \
        _Pragma("unroll") for (int i_ = 0; i_ < 5; ++i_) { const int pc_ = wave + 8 * i_; if (pc_ < 33) { const int rho_ = pc_ * 8 + (lane >> 3); int t_ = (r) * 256 - 3 + rho_; t_ = t_ < 0 ? 0 : (t_ > SEQ - 1 ? SEQ - 1 : t_); \
            const int ch_ = (lane & 7) ^ ((rho_ >> 1) & 7); glds16(zb + (size_t)t_ * ZP + C_XR + cA + ch_ * 8, (unsigned)__builtin_amdgcn_readfirstlane(bb_ + pc_ * 1024)); } } \
        { const int row_ = wave * 32 + (lane >> 1); glds16(zb + (size_t)((r) * 256 + row_) * ZP + C_GR + dg - r16 + (lane & 1) * 8, (unsigned)__builtin_amdgcn_readfirstlane(bb_ + LRU_XB + wave * 1024)); } } while (0)
    LRU_STAGE(0);
    float cwA[2][4][8], cbA[2][8];
#pragma unroll
    for (int s = 0; s < 2; ++s)
#pragma unroll
        for (int j = 0; j < 8; ++j) { const int c = cA + 32 * s + 8 * g + j; cbA[s][j] = p.conv_b[l * 512 + c];
#pragma unroll
            for (int k = 0; k < 4; ++k) cwA[s][k][j] = p.conv_w[(l * 4 + k) * 512 + c]; }
    bf16x8v bxf[2], baf[2];
#pragma unroll
    for (int s = 0; s < 2; ++s) { u32x4 wx, wa; unsigned tx[8], ta[8];
#pragma unroll
        for (int j = 0; j < 8; ++j) { const size_t idx = (((size_t)l * 8 + blk) * 64 + 32 * s + 8 * g + j) * 64 + dloc; tx[j] = f2bf(p.lru_wx[idx]); ta[j] = f2bf(p.lru_wa[idx]); }
        wx.x = tx[0] | (tx[1] << 16); wx.y = tx[2] | (tx[3] << 16); wx.z = tx[4] | (tx[5] << 16); wx.w = tx[6] | (tx[7] << 16);
        wa.x = ta[0] | (ta[1] << 16); wa.y = ta[2] | (ta[3] << 16); wa.z = ta[4] | (ta[5] << 16); wa.w = ta[6] | (ta[7] << 16);
        bxf[s] = __builtin_bit_cast(bf16x8v, wx); baf[s] = __builtin_bit_cast(bf16x8v, wa); }
    const float cw0 = p.conv_w[(l * 4 + 0) * 512 + dg], cw1 = p.conv_w[(l * 4 + 1) * 512 + dg], cw2 = p.conv_w[(l * 4 + 2) * 512 + dg], cw3 = p.conv_w[(l * 4 + 3) * 512 + dg];
    const float cb = p.conv_b[l * 512 + dg], bxv = p.lru_bx[l * 512 + dg], bav = p.lru_ba[l * 512 + dg];
    const float sp8 = -8.0f * log1pf(expf(-p.lru_a[l * 512 + dg]));
    asm volatile("" :: "v"(cwA[0][0][0]), "v"(cwA[1][3][7]), "v"(cbA[1][7]), "v"(bxf[0]), "v"(bxf[1]), "v"(baf[0]), "v"(baf[1]), "v"(cw0), "v"(cw1), "v"(cw2), "v"(cw3), "v"(cb), "v"(bxv), "v"(bav), "v"(sp8));
    LAS float* WS = (LAS float*)(lds + LRU_WS_OFF);
    float hrun = 0.f;
#pragma unroll 1
    for (int round = 0; round < 8; ++round) {
        asm volatile("s_waitcnt vmcnt(0)" ::: "memory");
        __syncthreads();
        if (round + 1 < 8) LRU_STAGE(round + 1);
        LAS const unsigned char* xb = lds + (round & 1) * LRU_BUF; LAS const unsigned char* gb = xb + LRU_XB;
        const int tw = round * 256 + wave * 32;
        float hl[2][4], pl[2][4], gr4[2][4], PT[2], HT[2], PE[2], HE[2];
#pragma unroll
        for (int tau = 0; tau < 2; ++tau) {
            const int t0 = tw + 16 * tau, rho0 = wave * 32 + 16 * tau;
            bf16x8v af[2];
#pragma unroll
            for (int s = 0; s < 2; ++s) {
                float xc[8];
#pragma unroll
                for (int j = 0; j < 8; ++j) xc[j] = cbA[s][j];
#pragma unroll
                for (int k = 0; k < 4; ++k) { const int rho = rho0 + r16 + k; u32x4 w = *(LAS const u32x4*)(xb + rho * 128 + (((4 * s + g) ^ (rho >> 1)) & 7) * 16);
                    if (t0 + r16 - 3 + k < 0) w = (u32x4){0u, 0u, 0u, 0u};
                    xc[0] += cwA[s][k][0] * __uint_as_float(w.x << 16); xc[1] += cwA[s][k][1] * __uint_as_float(w.x & 0xffff0000u);
                    xc[2] += cwA[s][k][2] * __uint_as_float(w.y << 16); xc[3] += cwA[s][k][3] * __uint_as_float(w.y & 0xffff0000u);
                    xc[4] += cwA[s][k][4] * __uint_as_float(w.z << 16); xc[5] += cwA[s][k][5] * __uint_as_float(w.z & 0xffff0000u);
                    xc[6] += cwA[s][k][6] * __uint_as_float(w.w << 16); xc[7] += cwA[s][k][7] * __uint_as_float(w.w & 0xffff0000u); }
                u32x4 pw; pw.x = cvtpk(xc[0], xc[1]); pw.y = cvtpk(xc[2], xc[3]); pw.z = cvtpk(xc[4], xc[5]); pw.w = cvtpk(xc[6], xc[7]);
                af[s] = __builtin_bit_cast(bf16x8v, pw);
            }
            f32x4 gx = {0.f, 0.f, 0.f, 0.f}, ga = {0.f, 0.f, 0.f, 0.f};
            gx = __builtin_amdgcn_mfma_f32_16x16x32_bf16(af[0], bxf[0], gx, 0, 0, 0); gx = __builtin_amdgcn_mfma_f32_16x16x32_bf16(af[1], bxf[1], gx, 0, 0, 0);
            ga = __builtin_amdgcn_mfma_f32_16x16x32_bf16(af[0], baf[0], ga, 0, 0, 0); ga = __builtin_amdgcn_mfma_f32_16x16x32_bf16(af[1], baf[1], ga, 0, 0, 0);
            float xo[7];
#pragma unroll
            for (int m = 0; m < 7; ++m) { const int rho = rho0 + 4 * g + m;
                const unsigned short v = *(LAS const unsigned short*)(xb + rho * 128 + (((dloc >> 3) ^ (rho >> 1)) & 7) * 16 + (dloc & 7) * 2);
                xo[m] = (t0 + 4 * g - 3 + m >= 0) ? bf2f(v) : 0.f; }
            float Pr = 1.f, Hr = 0.f;
#pragma unroll
            for (int i = 0; i < 4; ++i) {
                const float xcv = cb + cw0 * xo[i] + cw1 * xo[i + 1] + cw2 * xo[i + 2] + cw3 * xo[i + 3];
                const float sx = fast_sigm(gx[i] + bxv), sa = fast_sigm(ga[i] + bav);
                const float la = sp8 * sa, a = __expf(la), y2 = 2.0f * la;
                const float ser = -y2 * (1.0f + y2 * (0.5f + y2 * (0.16666667f + y2 * (0.041666668f + y2 * (0.0083333338f + y2 * 0.0013888889f)))));
                const float em = (y2 > -0.25f) ? ser : (1.0f - __expf(y2));
                const float u = __builtin_amdgcn_sqrtf(em) * sx * xcv;
                Hr = a * Hr + u; Pr *= a; hl[tau][i] = Hr; pl[tau][i] = Pr;
                gr4[tau][i] = bf2f(*(LAS const unsigned short*)(gb + (rho0 + 4 * g + i) * 32 + r16 * 2));
            }
            float Pi = Pr, Hi = Hr;
            { const float Pl = __shfl_up(Pi, 16), Hl = __shfl_up(Hi, 16); if (g >= 1) { Hi = Pi * Hl + Hi; Pi = Pl * Pi; } }
            { const float Pl = __shfl_up(Pi, 32), Hl = __shfl_up(Hi, 32); if (g >= 2) { Hi = Pi * Hl + Hi; Pi = Pl * Pi; } }
            float Pe = __shfl_up(Pi, 16), He = __shfl_up(Hi, 16); if (g == 0) { Pe = 1.f; He = 0.f; }
            PT[tau] = __shfl(Pi, 48 + r16); HT[tau] = __shfl(Hi, 48 + r16); PE[tau] = Pe; HE[tau] = He;
        }
        HE[1] = PE[1] * HT[0] + HE[1]; PE[1] = PT[0] * PE[1];
        const float Pw = PT[0] * PT[1], Hw = PT[1] * HT[0] + HT[1];
        LAS float* wsr = WS + (round & 1) * 256;
        if (g == 0) { wsr[(wave * 16 + r16) * 2 + 0] = Pw; wsr[(wave * 16 + r16) * 2 + 1] = Hw; }
        asm volatile("s_waitcnt lgkmcnt(0)" ::: "memory");
        __builtin_amdgcn_s_barrier();
        asm volatile("" ::: "memory");
        float hc = hrun, hall = hrun;
#pragma unroll
        for (int w2 = 0; w2 < 8; ++w2) { if (w2 == wave) hc = hall; hall = wsr[(w2 * 16 + r16) * 2 + 0] * hall + wsr[(w2 * 16 + r16) * 2 + 1]; }
        hrun = hall;
#pragma unroll
        for (int tau = 0; tau < 2; ++tau) {
            const float hin = PE[tau] * hc + HE[tau];
            bf16* yp = p.Y + ((size_t)b * SEQ + tw + 16 * tau + 4 * g) * DM + dg;
#pragma unroll
            for (int i = 0; i < 4; ++i) { const float h = hl[tau][i] + pl[tau][i] * hin, gr = gr4[tau][i]; yp[(size_t)i * DM] = (bf16)f2bf(h * gr * fast_sigm(gr)); }
        }
    }
#undef LRU_STAGE
    asm volatile("s_waitcnt vmcnt(0)" ::: "memory");
    __syncthreads();
}
__device__ __forceinline__ void lru_phase(const P& p, int l, LAS unsigned char* lds) {
    const int G = gridDim.x, wg = blockIdx.x;
#pragma unroll 1
    for (int u = wg; u < 256; u += G) lru_unit(p, l, (u >> 3) & 7, u & 7, u >> 6, lds);
}
#ifndef DSA_PHASE
#define DSA_PHASE dsa_phase
#endif
#ifndef LRU_PHASE
#define LRU_PHASE lru_phase
#endif
#ifndef RP_A
#define RP_A 1
#endif
#ifndef RP_L
#define RP_L 1
#endif
#ifndef RP_D
#define RP_D 1
#endif
#ifndef RP_C
#define RP_C 1
#endif
#ifndef RP_0
#define RP_0 1
#endif
template <int OFF> __device__ __forceinline__ unsigned long long karg_u64() {
    unsigned long long v; const unsigned long long kp = (unsigned long long)__builtin_amdgcn_kernarg_segment_ptr();
    asm volatile("s_load_dwordx2 %0, %1, %2\n\ts_waitcnt lgkmcnt(0)" : "=s"(v) : "s"(kp), "i"(OFF) : "memory");
    return v;
}
struct Args { const float* in[15]; float* out; unsigned char* ws; int ph_lo, ph_hi; };
__global__ void __launch_bounds__(512, 2) mega(Args a) {
    extern __shared__ __attribute__((aligned(16))) unsigned char lds_raw[];
    LAS unsigned char* lds = (LAS unsigned char*)lds_raw;
#define KARG(T, off) ((T)(__attribute__((address_space(1))) void*)karg_u64<(off)>())
#define LOADP() P p; { unsigned char* ws_ = KARG(unsigned char*, 128); \
        p.x = KARG(const float*, 0); p.c = KARG(const float*, 8); p.norm_g = KARG(const float*, 16); p.ada_w = KARG(const float*, 24); p.ada_b = KARG(const float*, 32); p.w_in = KARG(const float*, 40); \
        p.conv_w = KARG(const float*, 48); p.conv_b = KARG(const float*, 56); p.lru_wx = KARG(const float*, 64); p.lru_bx = KARG(const float*, 72); p.lru_wa = KARG(const float*, 80); p.lru_ba = KARG(const float*, 88); \
        p.lru_a = KARG(const float*, 96); p.w_out = KARG(const float*, 104); p.final_g = KARG(const float*, 112); p.out = KARG(float*, 120); \
        p.ctl = (unsigned*)(ws_ + WS_CTL); p.mod = (float*)(ws_ + WS_MOD); p.bias = (float*)(ws_ + WS_BIAS); p.ssq = (float*)(ws_ + WS_SSQ); \
        p.wt_in = (bf16*)(ws_ + WS_WTIN); p.wt_out = (bf16*)(ws_ + WS_WTOUT); p.A = (bf16*)(ws_ + WS_A); p.Z = (bf16*)(ws_ + WS_Z); p.Y = (bf16*)(ws_ + WS_Y); }
    unsigned* const ctl0 = (unsigned*)((unsigned char*)a.ws + WS_CTL);
    const int lo = a.ph_lo, hi = a.ph_hi;
    volatile LAS unsigned* MISC = (volatile LAS unsigned*)(lds + MISC_OFF + 4096);
    if (threadIdx.x < 4) MISC[threadIdx.x] = 0u;
    if (threadIdx.x < 16) { const unsigned t = threadIdx.x; u32x2 m; m.x = ((t & 1u) ? 0xffffu : 0u) | ((t & 2u) ? 0xffff0000u : 0u); m.y = ((t & 4u) ? 0xffffu : 0u) | ((t & 8u) ? 0xffff0000u : 0u);
        *(LAS u32x2*)(lds + DSA_MLUT_OFF + t * 8) = m; }
    __syncthreads();
    XcdBarrier bar; bar.bar = ctl0 + CW_BAR; bar.x = 0; bar.st = MISC;
    if (hi - lo > 1) bar = xcd_barrier_post(ctl0 + CW_BAR, MISC);
#define IN(k) (lo <= (k) && (k) < hi)
#ifndef N_CG_SEAMS
#define N_CG_SEAMS 0
#endif
#define SEAM(k) do { if (IN(k) && IN((k) + 1)) { if ((k) < N_CG_SEAMS) cg::this_grid().sync(); else xcd_barrier(bar); } } while (0)
    if (IN(0)) { LOADP(); ph0_prologue(p, lds); if (RP_0 > 1) { __syncthreads(); ph0_prologue(p, lds); } }
    SEAM(0);
    if (IN(1)) { LOADP(); ph1_prologue(p, lds); if (RP_0 > 1) { __syncthreads(); ph1_prologue(p, lds); } }
    SEAM(1);
#define LAYER(l, base) \
    if (IN(base)) { LOADP(); \
        pg8::Gemm g{p.A, p.wt_in + (size_t)(l) * ZP * 1024, MROWS, ZP, DM}; pg8::StaticOrder S; S.init(MROWS, ZP, (int)gridDim.x, (int)blockIdx.x); \
        EpiZ E{p.Z, p.ssq, p.bias + (size_t)(l) * 8 * ZP}; \
        pg8::gemm_phase<EpiZ, pg8::StaticOrder, PG8_ALIGN, PG8_SP2>(lds, g, S, E); if (RP_A > 1) { __syncthreads(); pg8::gemm_phase<EpiZ, pg8::StaticOrder, PG8_ALIGN, PG8_SP2>(lds, g, S, E); } \
    } \
    SEAM(base); \
    if (IN((base) + 1)) { LOADP(); dsa_phase_pre(p, lds); LRU_PHASE(p, (l), lds); __syncthreads(); if (RP_L > 1) { LRU_PHASE(p, (l), lds); __syncthreads(); } DSA_PHASE(p, lds); if (RP_D > 1) { __syncthreads(); DSA_PHASE(p, lds); } } \
    SEAM((base) + 1); \
    if (IN((base) + 2)) { LOADP(); \
        pg8::Gemm g{p.Y, p.wt_out + (size_t)(l) * 1024 * 1024, MROWS, DM, DM}; pg8::StaticOrder S; S.init(MROWS, DM, (int)gridDim.x, (int)blockIdx.x); \
        if constexpr ((l) == DEPTH - 1) { \
            EpiXF E{p.out, p.out, p.mod + (size_t)(l) * 8 * 3072 + 2048, p.final_g, p.ssq, p.ctl + CW_PANEL}; \
            pg8::gemm_phase<EpiXF, pg8::StaticOrder, false, PG8_SP2>(lds, g, S, E); \
        } else { \
            EpiX E{(l) == 0 ? p.x : p.out, p.out, p.A, p.mod + (size_t)(l) * 8 * 3072 + 2048, p.norm_g + (size_t)((l) + 1) * 1024, p.mod + (size_t)((l) + 1) * 8 * 3072 + 1024, p.ssq}; \
            pg8::gemm_phase<EpiX, pg8::StaticOrder, false, PG8_SP2>(lds, g, S, E); if (RP_C > 1 && (l) == 0) { __syncthreads(); pg8::gemm_phase<EpiX, pg8::StaticOrder, false, PG8_SP2>(lds, g, S, E); } \
        } \
    } \
    if ((base) + 3 < NPHASE) SEAM((base) + 2);
    LAYER(0, 2)
    LAYER(1, 5)
}
#ifndef MK_N_LAUNCHES
#define MK_N_LAUNCHES 1
#endif
extern "C" void kernel_launch(void* const* d_in, const int* in_sizes, int n_in, void* d_out, int out_size, void* d_ws, size_t ws_size, hipStream_t stream) {
    static int grid = 0;
    if (grid == 0) {
        if (n_in != 15 || out_size != MROWS * DM || ws_size < WS_END) { fprintf(stderr, "kernel_launch: unexpected problem (n_in %d out %d ws %zu)\n", n_in, out_size, ws_size); grid = -1; return; }
        int dev = 0, cus = 0, per_cu = 0;
        hipGetDevice(&dev); hipDeviceGetAttribute(&cus, hipDeviceAttributeMultiprocessorCount, dev);
        if (hipFuncSetAttribute((const void*)mega, hipFuncAttributeMaxDynamicSharedMemorySize, LDS_BYTES) != hipSuccess) { fprintf(stderr, "kernel_launch: hipFuncSetAttribute failed\n"); grid = -1; return; }
        if (hipOccupancyMaxActiveBlocksPerMultiprocessor(&per_cu, (const void*)mega, 512, LDS_BYTES) != hipSuccess || per_cu < 1) { fprintf(stderr, "kernel_launch: occupancy query failed (%d)\n", per_cu); per_cu = 1; }
        (void)hipGetLastError();
        grid = cus * per_cu;
        if (grid != 256) fprintf(stderr, "kernel_launch: grid %d (cus %d x %d) != 256: the fused out-projection epilogue needs exactly 256 workgroups\n", grid, cus, per_cu);
    }
    if (grid < 0) return;
    hipMemsetAsync((char*)d_ws + WS_CTL, 0, CTL_ZERO_BYTES, stream);
    Args a{};
    for (int i = 0; i < 15; ++i) a.in[i] = (const float*)d_in[i];
    a.out = (float*)d_out; a.ws = (unsigned char*)d_ws;
#if MK_N_LAUNCHES == 1
    a.ph_lo = 0; a.ph_hi = NPHASE;
    void* args[] = {&a};
    hipError_t e = hipLaunchCooperativeKernel((const void*)mega, dim3(grid), dim3(512), args, LDS_BYTES, stream);
    if (e != hipSuccess) fprintf(stderr, "cooperative launch failed: %s (grid %d)\n", hipGetErrorString(e), grid);
#else
    for (int ph = 0; ph < NPHASE; ++ph) { a.ph_lo = ph; a.ph_hi = ph + 1; hipLaunchKernelGGL(mega, dim3(grid), dim3(512), LDS_BYTES, stream, a); }
#endif
}
```

```cpp
#include <hip/hip_runtime.h>
#include <hip/hip_cooperative_groups.h>
#include <cstdio>
#include <cstdint>
#include <cmath>
namespace cg = cooperative_groups;
#define EPI_XD 3
#define EPI_ZD 8
namespace pg8 {
#define PG8_LAS __attribute__((address_space(3)))
typedef unsigned short bf16_t;
typedef short bf16x8 __attribute__((ext_vector_type(8)));
typedef float f32x4 __attribute__((ext_vector_type(4)));
typedef unsigned u32x4 __attribute__((ext_vector_type(4)));
constexpr int BM = 256, BK = 64, HALF = 128, HTB = HALF * BK * 2  , STAGE_BYTES = 8 * HTB, NXCD = 8, WGM = 8;

__host__ __device__ __forceinline__ int lds_byte(int r, int c) { const int st = (r >> 4) * 2 + (c >> 5), rr = r & 15, cc = c & 31, ob = rr * 64 + cc * 2; return st * 1024 + (ob ^ (((ob >> 9) & 1) << 5)); }
__host__ __device__ __forceinline__ void stage_rc(int b, int& R, int& C) { const int st = b / 1024, sb = b % 1024, swz = sb ^ (((sb >> 9) & 1) << 5); R = (st >> 1) * 16 + swz / 64; C = (st & 1) * 32 + (swz % 64) / 2; }
__host__ __device__ __forceinline__ int perm32(int rho) { const int n = rho >> 4, i = rho & 15; return 8 * (i >> 2) + 4 * n + (i & 3); }

struct Unit { int pm, pn; };
struct Gemm { const bf16_t* A; const bf16_t* Bt; int M, N, K; };

struct StaticOrder {
    int nM, nN, nwg, G, c;
    __host__ __device__ void init(int M, int N, int G_, int c_) { nM = M / BM; nN = N / BM; nwg = nM * nN; G = G_; c = c_; }
    __host__ __device__ bool next(int i, Unit& u) const {
        const long L = (long)i * G + c; if (L >= nwg) return false;
        int wgid = (int)L; { const int q = nwg / NXCD, r = nwg % NXCD, xcd = wgid % NXCD, off = wgid / NXCD; wgid = (xcd < r ? xcd * (q + 1) : r * (q + 1) + (xcd - r) * q) + off; }
        const int nig = WGM * nN, gid = wgid / nig, fm = gid * WGM, gsz = (nM - fm) < WGM ? (nM - fm) : WGM;
        u.pm = fm + ((wgid % nig) % gsz); u.pn = (wgid % nig) / gsz; return true;
    }
    __device__ __forceinline__ void a_ready(const Unit&) const {}
    __device__ __forceinline__ void done(const Unit&) const {}
};

__device__ __forceinline__ unsigned cvt_pk_bf16(float lo, float hi) { unsigned r; asm volatile("v_cvt_pk_bf16_f32 %0, %1, %2" : "=v"(r) : "v"(lo), "v"(hi)); return r; }
typedef float f32x2 __attribute__((ext_vector_type(2)));
template <class Epi, class Sched, bool ALIGN_EPI = false, bool SP2 = false>
__device__ __forceinline__ void gemm_phase(PG8_LAS unsigned char* lds, const Gemm g, const Sched& S, const Epi& E) {
    const int tid = threadIdx.x, wid = __builtin_amdgcn_readfirstlane(tid >> 6), lane = tid & 63, wr = wid >> 2, wc = wid & 3, fr = lane & 15, fq = lane >> 4;
    const int K = g.K, nt = K / BK;
    unsigned voffA[2], voffB[2];
#pragma unroll
    for (int i = 0; i < 2; ++i) { int R, C; stage_rc(tid * 16 + i * 8192, R, C); const int Rb = Epi::PERM ? ((R & ~31) + perm32(R & 31)) : R;
        voffA[i] = (unsigned)(R * K + C) * 2u; voffB[i] = (unsigned)(Rb * K + C) * 2u; }
    const size_t kstep = (size_t)(BK * 2);
    const size_t hstep = (size_t)HALF * K * 2;
    const size_t tstep = 2 * hstep;
    const unsigned ldsw = (unsigned)wid * 1024u;
    const int aoff = lds_byte(wr * 64 + fr, fq * 8), boff = lds_byte(wc * 32 + fr, fq * 8);
#define PG8_SA(b, h) (((b) * 2 + (h)) * HTB)
#define PG8_SB(b, h) ((4 + (b) * 2 + (h)) * HTB)
#define PG8_STAGE(bufoff, gbase, voff) do { _Pragma("unroll") for (int _i = 0; _i < 2; ++_i) \
        __builtin_amdgcn_global_load_lds((const unsigned*)((const char*)(gbase) + (voff)[_i]), (PG8_LAS unsigned*)(lds + (bufoff) + ldsw + _i * 8192), 16, 0, 0); } while (0)
#define PG8_LDA(dst, b, h) do { _Pragma("unroll") for (int m = 0; m < 4; ++m) _Pragma("unroll") for (int k = 0; k < 2; ++k) dst[m][k] = *(const PG8_LAS bf16x8*)(lds + PG8_SA(b, h) + aoff + m * 2048 + k * 1024); } while (0)
#define PG8_LDB(dst, b, h) do { _Pragma("unroll") for (int n = 0; n < 2; ++n) _Pragma("unroll") for (int k = 0; k < 2; ++k) dst[n][k] = *(const PG8_LAS bf16x8*)(lds + PG8_SB(b, h) + boff + n * 2048 + k * 1024); } while (0)
#define PG8_MMA(ai, bj, At, Bt) do { __builtin_amdgcn_s_setprio(1); _Pragma("unroll") for (int m = 0; m < 4; ++m) _Pragma("unroll") for (int n = 0; n < 2; ++n) _Pragma("unroll") for (int k = 0; k < 2; ++k) \
        acc[ai][bj][m][n] = __builtin_amdgcn_mfma_f32_16x16x32_bf16(Bt[n][k], At[m][k], acc[ai][bj][m][n], 0, 0, 0); __builtin_amdgcn_s_setprio(0); } while (0)
#define PG8_WAIT_V(n) asm volatile("s_waitcnt vmcnt(" #n ")" ::: "memory")
#define PG8_WAIT_L(n) asm volatile("s_waitcnt lgkmcnt(" #n ")" ::: "memory")
#define PG8_BAR __builtin_amdgcn_s_barrier()
#define PG8_SCHED __builtin_amdgcn_sched_barrier(0)
    Unit cur, nxt; int ui = 0;
    if (!S.next(0, cur)) return;
    f32x4 acc[2][2][4][2];
#pragma unroll
    for (int a = 0; a < 2; ++a)
#pragma unroll
        for (int b = 0; b < 2; ++b)
#pragma unroll
            for (int m = 0; m < 4; ++m)
#pragma unroll
                for (int n = 0; n < 2; ++n) acc[a][b][m][n] = (f32x4){0.f, 0.f, 0.f, 0.f};
    bf16x8 At[4][2], B0[2][2], B1[2][2];
    const char* cA = (const char*)g.A + (size_t)cur.pm * tstep; const char* cB = (const char*)g.Bt + (size_t)cur.pn * tstep;
    S.a_ready(cur);
    if constexpr (SP2) {
        PG8_STAGE(PG8_SB(0, 0), cB, voffB); PG8_STAGE(PG8_SB(0, 1), cB + hstep, voffB); PG8_STAGE(PG8_SA(0, 0), cA, voffA); PG8_STAGE(PG8_SA(0, 1), cA + hstep, voffA);
        if (wr == 1) PG8_BAR;
        PG8_WAIT_V(2); PG8_BAR;
        PG8_STAGE(PG8_SB(1, 0), cB + kstep, voffB); PG8_STAGE(PG8_SA(1, 0), cA + kstep, voffA); PG8_STAGE(PG8_SB(1, 1), cB + hstep + kstep, voffB);
        PG8_WAIT_V(6); PG8_BAR;
    } else {
        PG8_STAGE(PG8_SB(0, 0), cB, voffB); PG8_STAGE(PG8_SA(0, 0), cA, voffA); PG8_STAGE(PG8_SB(0, 1), cB + hstep, voffB); PG8_STAGE(PG8_SA(0, 1), cA + hstep, voffA);
        if (wr == 1) PG8_BAR;
        PG8_WAIT_V(4); PG8_BAR;
        PG8_STAGE(PG8_SB(1, 0), cB + kstep, voffB); PG8_STAGE(PG8_SA(1, 0), cA + kstep, voffA); PG8_STAGE(PG8_SB(1, 1), cB + hstep + kstep, voffB);
        PG8_WAIT_V(6); PG8_BAR;
    }
    for (;;) {
        const bool has_next = S.next(ui + 1, nxt);
        const char* nA = has_next ? (const char*)g.A + (size_t)nxt.pm * tstep : cA; const char* nB = has_next ? (const char*)g.Bt + (size_t)nxt.pn * tstep : cB;
        for (int t = 0; t < nt; t += 2) {
            const bool last = (t == nt - 2);
            const char* a1 = cA + (size_t)(t + 1) * kstep;
            const char* a2 = last ? nA : cA + (size_t)(t + 2) * kstep; const char* b2 = last ? nB : cB + (size_t)(t + 2) * kstep;
            const char* a3 = a2 + kstep; const char* b3 = b2 + kstep;
            if (last && has_next) S.a_ready(nxt);
            if constexpr (SP2) {
            PG8_LDB(B0, 0, 0); PG8_LDB(B1, 0, 1); PG8_SCHED; PG8_LDA(At, 0, 0); PG8_STAGE(PG8_SA(1, 1), a1 + hstep, voffA);
            PG8_WAIT_V(8); PG8_WAIT_L(0); PG8_BAR; PG8_MMA(0, 0, At, B0); PG8_MMA(0, 1, At, B1); PG8_BAR; PG8_SCHED;
            PG8_LDA(At, 0, 1); PG8_STAGE(PG8_SB(0, 0), b2, voffB); PG8_STAGE(PG8_SB(0, 1), b2 + hstep, voffB); PG8_STAGE(PG8_SA(0, 0), a2, voffA);
            PG8_WAIT_V(8); PG8_WAIT_L(0); PG8_BAR; PG8_MMA(1, 0, At, B0); PG8_MMA(1, 1, At, B1); PG8_BAR; PG8_SCHED;
            PG8_LDB(B0, 1, 0); PG8_LDB(B1, 1, 1); PG8_SCHED; PG8_LDA(At, 1, 0); PG8_STAGE(PG8_SA(0, 1), a2 + hstep, voffA);
            PG8_WAIT_V(8); PG8_WAIT_L(0); PG8_BAR; PG8_MMA(0, 0, At, B0); PG8_MMA(0, 1, At, B1); PG8_BAR; PG8_SCHED;
            PG8_LDA(At, 1, 1); PG8_STAGE(PG8_SB(1, 0), b3, voffB); PG8_STAGE(PG8_SB(1, 1), b3 + hstep, voffB); PG8_STAGE(PG8_SA(1, 0), a3, voffA);
            PG8_WAIT_V(8); PG8_WAIT_L(0); PG8_BAR; PG8_MMA(1, 0, At, B0); PG8_MMA(1, 1, At, B1); PG8_BAR; PG8_SCHED;
            } else {
            PG8_LDB(B0, 0, 0); PG8_SCHED; PG8_LDA(At, 0, 0); PG8_STAGE(PG8_SA(1, 1), a1 + hstep, voffA);
            PG8_WAIT_L(8); PG8_BAR; PG8_WAIT_L(0); PG8_MMA(0, 0, At, B0); PG8_BAR; PG8_SCHED;
            PG8_LDB(B1, 0, 1); PG8_STAGE(PG8_SB(0, 0), b2, voffB);
            PG8_BAR; PG8_WAIT_L(0); PG8_MMA(0, 1, At, B1); PG8_BAR;
            PG8_LDA(At, 0, 1); PG8_STAGE(PG8_SA(0, 0), a2, voffA);
            PG8_BAR; PG8_WAIT_L(0); PG8_MMA(1, 0, At, B0); PG8_BAR; PG8_SCHED;
            PG8_STAGE(PG8_SB(0, 1), b2 + hstep, voffB);
            PG8_WAIT_V(6); PG8_BAR; PG8_MMA(1, 1, At, B1); PG8_BAR;
            PG8_LDB(B0, 1, 0); PG8_SCHED; PG8_LDA(At, 1, 0); PG8_STAGE(PG8_SA(0, 1), a2 + hstep, voffA);
            PG8_WAIT_L(8); PG8_BAR; PG8_WAIT_L(0); PG8_MMA(0, 0, At, B0); PG8_BAR; PG8_SCHED;
            PG8_LDB(B1, 1, 1); PG8_STAGE(PG8_SB(1, 0), b3, voffB);
            PG8_BAR; PG8_WAIT_L(0); PG8_MMA(0, 1, At, B1); PG8_BAR;
            PG8_LDA(At, 1, 1); PG8_STAGE(PG8_SA(1, 0), a3, voffA);
            PG8_BAR; PG8_WAIT_L(0); PG8_MMA(1, 0, At, B0); PG8_BAR; PG8_SCHED;
            PG8_STAGE(PG8_SB(1, 1), b3 + hstep, voffB);
            PG8_WAIT_V(6); PG8_BAR; PG8_MMA(1, 1, At, B1); PG8_BAR;
            }
        }
        if constexpr (ALIGN_EPI) { if (wr == 0) PG8_BAR; }
        if constexpr (!Epi::AFTER_DRAIN) { E(acc, cur, wr, wc, fr, fq); S.done(cur); }
        if (!has_next) break;
#pragma unroll
        for (int a = 0; a < 2; ++a)
#pragma unroll
            for (int b = 0; b < 2; ++b)
#pragma unroll
                for (int m = 0; m < 4; ++m)
#pragma unroll
                    for (int n = 0; n < 2; ++n) acc[a][b][m][n] = (f32x4){0.f, 0.f, 0.f, 0.f};
        cur = nxt; cA = nA; cB = nB; ++ui;
        if constexpr (ALIGN_EPI) { if (wr == 1) PG8_BAR; }
    }
    PG8_WAIT_V(0);
    if constexpr (!ALIGN_EPI) { if (wr == 0) PG8_BAR; }
    PG8_BAR;
    if constexpr (Epi::AFTER_DRAIN) { E.fused(acc, cur, wr, wc, fr, fq, lds, wid, lane); S.done(cur); }
#undef PG8_SA
#undef PG8_SB
#undef PG8_STAGE
#undef PG8_LDA
#undef PG8_LDB
#undef PG8_MMA
#undef PG8_WAIT_V
#undef PG8_WAIT_L
#undef PG8_BAR
#undef PG8_SCHED
}
}

#ifndef PG8_SP2
#define PG8_SP2 true
#endif
#ifndef PG8_ALIGN
#define PG8_ALIGN true
#endif
constexpr int BATCH = 8, SEQ = 2048, DM = 1024, MROWS = BATCH * SEQ, DEPTH = 2;
constexpr int D_RNN = 512, NHEAD = 8, HDIM = 64, D_INR = 2760, ZP = 2816, TOPK = 256;
constexpr int C_XR = 0, C_GR = 512, C_Q = 1024, C_K = 1536, C_V = 1600, C_GA = 1664, C_QI = 2176, C_KI = 2688, C_WI = 2752;
constexpr float EPS = 1e-6f;
constexpr float QSCALE = 0.125f * 1.4426950408889634f;
constexpr size_t MiB = 1u << 20;
constexpr size_t WS_CTL = 0, CTL_ZERO_BYTES = 1 * MiB;
constexpr size_t WS_MOD = 1 * MiB;
constexpr size_t WS_BIAS = 1 * MiB + 256 * 1024;
constexpr size_t WS_SSQ = 2 * MiB;
constexpr size_t WS_WTIN = 3 * MiB;
constexpr size_t WS_WTOUT = 14 * MiB;
constexpr size_t WS_A = 32 * MiB;
constexpr size_t WS_Z = 64 * MiB;
constexpr size_t WS_Y = 152 * MiB;
constexpr size_t WS_END = 184 * MiB;
constexpr int LDS_BYTES = 163840;
constexpr int MISC_OFF = 131072 + 8192;
constexpr int NPHASE = 8;
constexpr int CW_BAR = 4096, CW_PANEL = 16384;

#define LAS __attribute__((address_space(3)))
typedef unsigned short bf16;
typedef float f32x4 __attribute__((ext_vector_type(4)));
typedef unsigned u32x4 __attribute__((ext_vector_type(4)));
typedef unsigned u32x2 __attribute__((ext_vector_type(2)));
__device__ __forceinline__ float bf2f(bf16 v) { return __uint_as_float(((unsigned)v) << 16); }
__device__ __forceinline__ unsigned f2bf(float f) { unsigned u = __float_as_uint(f); return (u + 0x7fffu + ((u >> 16) & 1u)) >> 16; }
__device__ __forceinline__ unsigned pk2(float lo, float hi) { return f2bf(lo) | (f2bf(hi) << 16); }
__device__ __forceinline__ float wave_sum(float v) {
#pragma unroll
    for (int o = 1; o < 64; o <<= 1) v += __shfl_xor(v, o);
    return v;
}
__device__ __forceinline__ float wave_max(float v) {
#pragma unroll
    for (int o = 1; o < 64; o <<= 1) v = fmaxf(v, __shfl_xor(v, o));
    return v;
}
__device__ __forceinline__ int wave_sum_i(int v) {
#pragma unroll
    for (int o = 1; o < 64; o <<= 1) v += __shfl_xor(v, o);
    return v;
}
__device__ __forceinline__ float siluf(float v) { return v / (1.f + expf(-v)); }
__device__ __forceinline__ float sigmf(float v) { return 1.f / (1.f + expf(-v)); }

struct P {
    const float *x, *c, *norm_g, *ada_w, *ada_b, *w_in, *conv_w, *conv_b, *lru_wx, *lru_bx, *lru_wa, *lru_ba, *lru_a, *w_out, *final_g;
    float* out;
    float *mod, *bias, *ssq;
    bf16 *wt_in, *wt_out, *A, *Z, *Y;
    unsigned* ctl;
};

#ifndef EPI_ZD
#define EPI_ZD 2
#endif
struct EpiZ {
    static constexpr bool PERM = true, AFTER_DRAIN = false;
    bf16* Zp; const float* ssq; const float* bias;
    __device__ __forceinline__ void operator()(const pg8::f32x4 (&acc)[2][2][4][2], const pg8::Unit& u, int wr, int wc, int fr, int fq) const {
        const int row0 = u.pm * 256 + wr * 64 + fr, col0 = u.pn * 256 + wc * 32 + 8 * fq, b = u.pm >> 3;
        const float cs = (u.pn == 4 || u.pn == 5) ? QSCALE : 1.0f;
        f32x4 bv[2][2];
#pragma unroll
        for (int bj = 0; bj < 2; ++bj)
#pragma unroll
            for (int n = 0; n < 2; ++n) bv[bj][n] = *(const f32x4*)(bias + b * ZP + col0 + bj * 128 + 4 * n);
        f32x4 qq[EPI_ZD];
#pragma unroll
        for (int gi = 0; gi < EPI_ZD; ++gi) qq[gi] = *(const f32x4*)(ssq + (size_t)(row0 + (gi >> 2) * 128 + (gi & 3) * 16) * 4);
#pragma unroll
        for (int ai = 0; ai < 2; ++ai)
#pragma unroll
            for (int m = 0; m < 4; ++m) {
                const int r = row0 + ai * 128 + m * 16, gi = ai * 4 + m;
                const f32x4 q = qq[gi % EPI_ZD];
                if (gi + EPI_ZD < 8) qq[gi % EPI_ZD] = *(const f32x4*)(ssq + (size_t)(row0 + ((gi + EPI_ZD) >> 2) * 128 + ((gi + EPI_ZD) & 3) * 16) * 4);
                const float rstd = 1.0f / sqrtf(((q.x + q.y) + (q.z + q.w)) * (1.0f / 1024.0f) + EPS);
                bf16* rowp = Zp + (size_t)r * ZP + col0;
#pragma unroll
                for (int bj = 0; bj < 2; ++bj) {
                    const f32x4 v0 = (acc[ai][bj][m][0] * rstd + bv[bj][0]) * cs, v1 = (acc[ai][bj][m][1] * rstd + bv[bj][1]) * cs;
                    u32x4 w; w.x = pk2(v0[0], v0[1]); w.y = pk2(v0[2], v0[3]); w.z = pk2(v1[0], v1[1]); w.w = pk2(v1[2], v1[3]);
                    *(u32x4*)(rowp + bj * 128) = w;
                }
            }
    }
};
#ifndef EPI_XD
#define EPI_XD 4
#endif
struct EpiX {
    static constexpr bool PERM = true, AFTER_DRAIN = true;
    const float* xres; float* xout; bf16* Anext; const float* gate; const float* ng; const float* nscale; float* ssq;
    __device__ __forceinline__ void fused(pg8::f32x4 (&acc)[2][2][4][2], const pg8::Unit& u, int wr, int wc, int fr, int fq, LAS unsigned char* lds, int wid, int lane) const {
        const int b = u.pm >> 3, col0 = u.pn * 256 + wc * 32 + 8 * fq;
        LAS float* Pp = (LAS float*)lds;
        f32x4 gv[2][2], gs[2][2];
#pragma unroll
        for (int bj = 0; bj < 2; ++bj)
#pragma unroll
            for (int n = 0; n < 2; ++n) {
                gv[bj][n] = *(const f32x4*)(gate + b * 3072 + col0 + bj * 128 + 4 * n);
                if (Anext) { const f32x4 g = *(const f32x4*)(ng + col0 + bj * 128 + 4 * n), s = *(const f32x4*)(nscale + b * 3072 + col0 + bj * 128 + 4 * n); gs[bj][n] = g * (s + 1.0f); }
                else gs[bj][n] = (f32x4){0.f, 0.f, 0.f, 0.f};
            }
        f32x4 xq[EPI_XD][2][2];
#define EPIX_LOAD(gi) do { const size_t r_ = (size_t)u.pm * 256 + ((gi) >> 2) * 128 + wr * 64 + ((gi) & 3) * 16 + fr; \
        _Pragma("unroll") for (int bj = 0; bj < 2; ++bj) _Pragma("unroll") for (int n = 0; n < 2; ++n) xq[(gi) % EPI_XD][bj][n] = *(const f32x4*)(xres + r_ * DM + col0 + bj * 128 + 4 * n); } while (0)
#pragma unroll
        for (int gi = 0; gi < EPI_XD; ++gi) EPIX_LOAD(gi);
#pragma unroll
        for (int ai = 0; ai < 2; ++ai)
#pragma unroll
            for (int m = 0; m < 4; ++m) {
                const int rl = ai * 128 + wr * 64 + m * 16 + fr; const size_t r = (size_t)u.pm * 256 + rl;
                float s = 0.f;
                f32x4 xc[2][2];
#pragma unroll
                for (int bj = 0; bj < 2; ++bj)
#pragma unroll
                    for (int n = 0; n < 2; ++n) xc[bj][n] = xq[(ai * 4 + m) % EPI_XD][bj][n];
                if (ai * 4 + m + EPI_XD < 8) EPIX_LOAD(ai * 4 + m + EPI_XD);
#pragma unroll
                for (int bj = 0; bj < 2; ++bj) {
                    f32x4 x1[2];
#pragma unroll
                    for (int n = 0; n < 2; ++n) {
                        const f32x4 xr = xc[bj][n];
                        x1[n] = xr + gv[bj][n] * acc[ai][bj][m][n];
                        *(f32x4*)(xout + r * DM + col0 + bj * 128 + 4 * n) = x1[n];
                        s += (x1[n][0] * x1[n][0] + x1[n][1] * x1[n][1]) + (x1[n][2] * x1[n][2] + x1[n][3] * x1[n][3]);
                    }
                    if (Anext) { const f32x4 a0 = x1[0] * gs[bj][0], a1 = x1[1] * gs[bj][1];
                        u32x4 w; w.x = pk2(a0[0], a0[1]); w.y = pk2(a0[2], a0[3]); w.z = pk2(a1[0], a1[1]); w.w = pk2(a1[2], a1[3]);
                        *(u32x4*)(Anext + r * DM + col0 + bj * 128) = w; }
                }
                s += __shfl_xor(s, 16); s += __shfl_xor(s, 32);
                if (fq == 0) Pp[rl * 4 + wc] = s;
            }
        __syncthreads();
        const int tid = wid * 64 + lane;
        if (tid < 256) ssq[((size_t)u.pm * 256 + tid) * 4 + u.pn] = (Pp[tid * 4 + 0] + Pp[tid * 4 + 1]) + (Pp[tid * 4 + 2] + Pp[tid * 4 + 3]);
        __syncthreads();
    }
};

struct EpiXF {
    static constexpr bool PERM = true, AFTER_DRAIN = true;
    const float* xres; float* out; const float* gate; const float* fg; float* ssq; unsigned* cnt;
    __device__ __forceinline__ void fused(pg8::f32x4 (&acc)[2][2][4][2], const pg8::Unit& u, int wr, int wc, int fr, int fq, LAS unsigned char* lds, int wid, int lane) const {
        const int b = u.pm >> 3, col0 = u.pn * 256 + wc * 32 + 8 * fq, tid = wid * 64 + lane;
        LAS float* Pp = (LAS float*)lds;
        LAS float* Sr = (LAS float*)(lds + 4096);
        {
            f32x4 gv[2][2];
#pragma unroll
            for (int bj = 0; bj < 2; ++bj)
#pragma unroll
                for (int n = 0; n < 2; ++n) gv[bj][n] = *(const f32x4*)(gate + b * 3072 + col0 + bj * 128 + 4 * n);
#pragma unroll
            for (int ai = 0; ai < 2; ++ai)
#pragma unroll
                for (int m = 0; m < 4; ++m) {
                    const int rl = ai * 128 + wr * 64 + m * 16 + fr; const size_t r = (size_t)u.pm * 256 + rl;
                    float s = 0.f;
#pragma unroll
                    for (int bj = 0; bj < 2; ++bj)
#pragma unroll
                        for (int n = 0; n < 2; ++n) {
                            const f32x4 xr = *(const f32x4*)(xres + r * DM + col0 + bj * 128 + 4 * n);
                            const f32x4 x1 = xr + gv[bj][n] * acc[ai][bj][m][n];
                            acc[ai][bj][m][n] = x1;
                            s += (x1[0] * x1[0] + x1[1] * x1[1]) + (x1[2] * x1[2] + x1[3] * x1[3]);
                        }
                    s += __shfl_xor(s, 16); s += __shfl_xor(s, 32);
                    if (fq == 0) Pp[rl * 4 + wc] = s;
                }
        }
        __syncthreads();
        if (tid < 256) { const float tot = (Pp[tid * 4 + 0] + Pp[tid * 4 + 1]) + (Pp[tid * 4 + 2] + Pp[tid * 4 + 3]);
            __hip_atomic_store(ssq + ((size_t)u.pm * 256 + tid) * 4 + u.pn, tot, __ATOMIC_RELAXED, __HIP_MEMORY_SCOPE_AGENT); }
        asm volatile("s_waitcnt vmcnt(0)" ::: "memory");
        __syncthreads();
        if (tid == 0) {
            unsigned* c = cnt + 64 * u.pm;
            __hip_atomic_fetch_add(c, 1u, __ATOMIC_RELAXED, __HIP_MEMORY_SCOPE_AGENT);
            unsigned spins = 0u;
            while (__hip_atomic_load(c, __ATOMIC_RELAXED, __HIP_MEMORY_SCOPE_AGENT) < 4u) { __builtin_amdgcn_s_sleep(2); if (++spins > (1u << 22)) break; }
            __builtin_amdgcn_fence(__ATOMIC_ACQUIRE, "agent");
            asm volatile("s_waitcnt vmcnt(0)" ::: "memory");
        }
        __syncthreads();
        if (tid < 256) { const float* sp = ssq + ((size_t)u.pm * 256 + tid) * 4;
            const float q0 = __hip_atomic_load(sp + 0, __ATOMIC_RELAXED, __HIP_MEMORY_SCOPE_AGENT), q1 = __hip_atomic_load(sp + 1, __ATOMIC_RELAXED, __HIP_MEMORY_SCOPE_AGENT);
            const float q2 = __hip_atomic_load(sp + 2, __ATOMIC_RELAXED, __HIP_MEMORY_SCOPE_AGENT), q3 = __hip_atomic_load(sp + 3, __ATOMIC_RELAXED, __HIP_MEMORY_SCOPE_AGENT);
            Sr[tid] = 1.0f / sqrtf(((q0 + q1) + (q2 + q3)) * (1.0f / 1024.0f) + EPS); }
        __syncthreads();
        f32x4 fgv[2][2];
#pragma unroll
        for (int bj = 0; bj < 2; ++bj)
#pragma unroll
            for (int n = 0; n < 2; ++n) fgv[bj][n] = *(const f32x4*)(fg + col0 + bj * 128 + 4 * n);
#pragma unroll
        for (int ai = 0; ai < 2; ++ai)
#pragma unroll
            for (int m = 0; m < 4; ++m) {
                const int rl = ai * 128 + wr * 64 + m * 16 + fr; const size_t r = (size_t)u.pm * 256 + rl; const float rstd = Sr[rl];
#pragma unroll
                for (int bj = 0; bj < 2; ++bj)
#pragma unroll
                    for (int n = 0; n < 2; ++n) *(f32x4*)(out + r * DM + col0 + bj * 128 + 4 * n) = acc[ai][bj][m][n] * rstd * fgv[bj][n];
            }
        __syncthreads();
    }
};

#ifndef TRQ
#define TRQ 4
#endif
__device__ __forceinline__ void ph0_prologue(const P& p, LAS unsigned char* lds) {
    const int tid = threadIdx.x, lane = tid & 63, wave = tid >> 6, G = gridDim.x, wg = blockIdx.x;
    LAS float* fl = (LAS float*)lds;
    for (int u = wg; u < 96; u += G) {
        const int l = u / 48, j = (u % 48) * 64 + lane;
        for (int i = tid; i < 8192; i += 512) fl[i] = siluf(p.c[i]);
        __syncthreads();
        float acc[8];
#pragma unroll
        for (int b = 0; b < 8; ++b) acc[b] = 0.f;
        const float* w = p.ada_w + ((size_t)l * 1024 + wave * 128) * 3072 + j;
        for (int k = 0; k < 128; ++k) { const float wv = w[(size_t)k * 3072];
#pragma unroll
            for (int b = 0; b < 8; ++b) acc[b] += fl[b * 1024 + wave * 128 + k] * wv; }
#pragma unroll
        for (int b = 0; b < 8; ++b) fl[8192 + (wave * 8 + b) * 64 + lane] = acc[b];
        __syncthreads();
        { const int b = wave; float s = p.ada_b[l * 3072 + j];
#pragma unroll
          for (int w8 = 0; w8 < 8; ++w8) s += fl[8192 + (w8 * 8 + b) * 64 + lane];
          p.mod[(l * 8 + b) * 3072 + j] = s; }
        __syncthreads();
    }
#pragma unroll 1
    for (int u0 = wg; u0 < 1920; u0 += TRQ * G) {
        float v[TRQ][8]; bf16* dst[TRQ]; bool act[TRQ];
#pragma unroll
        for (int q = 0; q < TRQ; ++q) {
            const int u = u0 + q * G; act[q] = u < 1920; dst[q] = nullptr;
#pragma unroll
            for (int j = 0; j < 8; ++j) v[q][j] = 0.f;
            if (act[q]) {
                const float* W; bf16* WT; int N, kt, nt;
                if (u < 1408) { const int l = u / 704, r = u % 704; kt = r / 44; nt = r % 44; W = p.w_in + (size_t)l * 1024 * D_INR; N = D_INR; WT = p.wt_in + (size_t)l * ZP * 1024; }
                else { int r = u - 1408; const int l = r / 256; r %= 256; kt = r / 16; nt = r % 16; W = p.w_out + (size_t)l * 1024 * 1024; N = 1024; WT = p.wt_out + (size_t)l * 1024 * 1024; }
                const int n = nt * 64 + lane, k0 = kt * 64 + wave * 8;
                if (n < N) {
#pragma unroll
                    for (int j = 0; j < 8; ++j) v[q][j] = W[(size_t)(k0 + j) * N + n];
                }
                dst[q] = WT + (size_t)n * 1024 + k0;
            }
        }
#pragma unroll
        for (int q = 0; q < TRQ; ++q) if (act[q]) { u32x4 o; o.x = pk2(v[q][0], v[q][1]); o.y = pk2(v[q][2], v[q][3]); o.z = pk2(v[q][4], v[q][5]); o.w = pk2(v[q][6], v[q][7]); *(u32x4*)dst[q] = o; }
    }
}
__device__ __forceinline__ void ph1_prologue(const P& p, LAS unsigned char* lds) {
    const int tid = threadIdx.x, lane = tid & 63, wave = tid >> 6, G = gridDim.x, wg = blockIdx.x;
    LAS float* fl = (LAS float*)lds;
    for (int u = wg; u < 88; u += G) {
        const int l = u / 44, n = (u % 44) * 64 + lane;
        for (int i = tid; i < 8192; i += 512) fl[i] = p.mod[(l * 8 + (i >> 10)) * 3072 + (i & 1023)];
        __syncthreads();
        float acc[8];
#pragma unroll
        for (int b = 0; b < 8; ++b) acc[b] = 0.f;
        if (n < D_INR) { const float* w = p.w_in + ((size_t)l * 1024 + wave * 128) * D_INR + n;
            for (int k = 0; k < 128; ++k) { const float wv = w[(size_t)k * D_INR];
#pragma unroll
                for (int b = 0; b < 8; ++b) acc[b] += fl[b * 1024 + wave * 128 + k] * wv; } }
#pragma unroll
        for (int b = 0; b < 8; ++b) fl[8192 + (wave * 8 + b) * 64 + lane] = acc[b];
        __syncthreads();
        { const int b = wave; float s = 0.f;
#pragma unroll
          for (int w8 = 0; w8 < 8; ++w8) s += fl[8192 + (w8 * 8 + b) * 64 + lane];
          p.bias[(l * 8 + b) * ZP + n] = s; }
        __syncthreads();
    }
    {
        const int r0 = wg * 8 + wave, rstep = G * 8;
        f32x4 gq[4], xv[2][2][4], sv[2][2][4];
#pragma unroll
        for (int j = 0; j < 4; ++j) gq[j] = *(const f32x4*)(p.norm_g + (lane + 64 * j) * 4);
#define A0_LOAD(slot, pr) do { _Pragma("unroll") for (int h_ = 0; h_ < 2; ++h_) _Pragma("unroll") for (int j = 0; j < 4; ++j) { const int k_ = (lane + 64 * j) * 4, r_ = r0 + rstep * (2 * (pr) + h_); \
            xv[slot][h_][j] = *(const f32x4*)(p.x + (size_t)r_ * DM + k_); sv[slot][h_][j] = *(const f32x4*)(p.mod + (size_t)(r_ >> 11) * 3072 + 1024 + k_); } } while (0)
        A0_LOAD(0, 0);
#pragma unroll
        for (int pr = 0; pr < 4; ++pr) {
            if (pr + 1 < 4) A0_LOAD((pr + 1) & 1, pr + 1);
#pragma unroll
            for (int h = 0; h < 2; ++h) {
                const int r = r0 + rstep * (2 * pr + h); float s1 = 0.f;
#pragma unroll
                for (int j = 0; j < 4; ++j) { const int k = (lane + 64 * j) * 4; const f32x4 v = xv[pr & 1][h][j];
                    s1 += (v[0] * v[0] + v[1] * v[1]) + (v[2] * v[2] + v[3] * v[3]);
                    const f32x4 o1 = v * gq[j] * (sv[pr & 1][h][j] + 1.0f);
                    u32x2 w1; w1.x = pk2(o1[0], o1[1]); w1.y = pk2(o1[2], o1[3]);
                    *(u32x2*)(p.A + (size_t)r * DM + k) = w1; }
                s1 = wave_sum(s1);
                if (lane == 0) *(f32x4*)(p.ssq + (size_t)r * 4) = (f32x4){s1, 0.f, 0.f, 0.f};
            }
        }
#undef A0_LOAD
    }
}
__device__ __forceinline__ void ph_final(const P& p) {
    const int tid = threadIdx.x, lane = tid & 63, wave = tid >> 6, G = gridDim.x, wg = blockIdx.x;
    for (int r = wg * 8 + wave; r < MROWS; r += G * 8) {
        const f32x4 q = *(const f32x4*)(p.ssq + (size_t)r * 4);
        const float rstd = 1.0f / sqrtf(((q.x + q.y) + (q.z + q.w)) * (1.0f / 1024.0f) + EPS);
#pragma unroll
        for (int j = 0; j < 4; ++j) { const int k = (lane + 64 * j) * 4;
            const f32x4 v = *(const f32x4*)(p.out + (size_t)r * DM + k), g = *(const f32x4*)(p.final_g + k);
            *(f32x4*)(p.out + (size_t)r * DM + k) = v * rstd * g; }
    }
}
#define XB_TMO      128
#define XB_XCNT(j)  (256  + 64 * (j))
#define XB_XSUB(j)  (1280 + 64 * (j))
#define XB_XGEN(j)  (2304 + 64 * (j))
#define XB_TOP      3328
#define XB_TOPGEN   3392
#define XCD_BAR_WORDS 3456
#define XB_SPIN_CAP (1u << 18)

__device__ __forceinline__ unsigned xb_ld(unsigned* p)              { return __hip_atomic_load(p, __ATOMIC_RELAXED, __HIP_MEMORY_SCOPE_AGENT); }
__device__ __forceinline__ unsigned xb_add(unsigned* p, unsigned v) { return __hip_atomic_fetch_add(p, v, __ATOMIC_RELAXED, __HIP_MEMORY_SCOPE_AGENT); }
__device__ __forceinline__ unsigned xb_xcc_id() { return (unsigned)__builtin_amdgcn_s_getreg((3 << 11) | 20) & 0xFu; }
#define XB_SPIN(cond, bar) do { unsigned _sp = 0; while (cond) { __builtin_amdgcn_s_sleep(1); \
    if ((++_sp & 255u) == 0u) { if (xb_ld(&(bar)[XB_TMO])) break; if (_sp > XB_SPIN_CAP) { atomicAdd(&(bar)[XB_TMO], 1u); break; } } } } while (0)

struct XcdBarrier {
    unsigned* bar; unsigned x;
    volatile LAS unsigned* st;
};

__device__ __forceinline__ XcdBarrier xcd_barrier_post(unsigned* bar, volatile LAS unsigned* st) {
    XcdBarrier b; b.bar = bar; b.x = xb_xcc_id(); b.st = st;
    if (threadIdx.x == 0) (void)xb_add(&bar[XB_XCNT(b.x)], 1u);
    return b;
}
__device__ __forceinline__ void xcd_barrier_complete(unsigned* bar, unsigned x, unsigned& nloc, unsigned& nx) {
    const unsigned G = gridDim.x * gridDim.y * gridDim.z;
    unsigned sum, cnt, mine, sp = 0u;
    for (;;) {
        sum = 0u; cnt = 0u; mine = 0u;
#pragma unroll
        for (unsigned j = 0; j < 16; ++j) { const unsigned c = xb_ld(&bar[XB_XCNT(j)]); sum += c; cnt += (c > 0u) ? 1u : 0u; mine = (j == x) ? c : mine; }
        if (sum == G) break;
        __builtin_amdgcn_s_sleep(1);
        if ((++sp & 255u) == 0u) { if (xb_ld(&bar[XB_TMO])) break; if (sp > XB_SPIN_CAP) { atomicAdd(&bar[XB_TMO], 1u); break; } }
    }
    nloc = mine > 0u ? mine : 1u; nx = cnt > 0u ? cnt : 1u;
}

__device__ __forceinline__ void xcd_barrier(const XcdBarrier& b) {
    asm volatile("s_waitcnt vmcnt(0)" ::: "memory");
    __syncthreads();
    if (threadIdx.x == 0) {
        unsigned* bar = b.bar;
        __builtin_amdgcn_s_waitcnt(0);
        unsigned nloc = b.st[0], nx = b.st[1];
        if (nloc == 0u) { xcd_barrier_complete(bar, b.x, nloc, nx); b.st[0] = nloc; b.st[1] = nx; }
        const unsigned old = xb_add(&bar[XB_XSUB(b.x)], 1u);
        const unsigned gen = old / nloc;
        if (old + 1u == (gen + 1u) * nloc) {
            __builtin_amdgcn_fence(__ATOMIC_RELEASE, "agent");
            asm volatile("s_waitcnt vmcnt(0)" ::: "memory");
            const unsigned og = xb_add(&bar[XB_TOP], 1u);
            const unsigned tg = og / nx;
            if (og + 1u == (tg + 1u) * nx) xb_add(&bar[XB_TOPGEN], 1u);
            else XB_SPIN(xb_ld(&bar[XB_TOPGEN]) == tg, bar);
            __builtin_amdgcn_fence(__ATOMIC_ACQUIRE, "agent");
            xb_add(&bar[XB_XGEN(b.x)], 1u);
            asm volatile("s_waitcnt vmcnt(0)" ::: "memory");
        } else {
            XB_SPIN(xb_ld(&bar[XB_XGEN(b.x)]) == gen, bar);
            __builtin_amdgcn_fence(__ATOMIC_ACQUIRE, "agent");
            asm volatile("s_waitcnt vmcnt(0)" ::: "memory");
        }
    }
    __syncthreads();
}
__device__ __forceinline__ unsigned score_ukey(float s) { const unsigned u = __float_as_uint(s + 0.0f); return (u & 0x80000000u) ? ~u : (u | 0x80000000u); }
__device__ __forceinline__ void topk_threshold(const unsigned (&k)[32], unsigned& thr, unsigned& need) {
    unsigned prefix = 0u; bool exact = false;
    for (int bit = 31; bit >= 0; --bit) {
        const unsigned cand = prefix | (1u << bit);
        int c = 0;
#pragma unroll
        for (int i = 0; i < 32; ++i) c += (k[i] >= cand) ? 1 : 0;
        c = wave_sum_i(c);
        if (c >= TOPK) prefix = cand;
        if (c == TOPK) { exact = true; break; }
    }
    thr = prefix;
    if (exact) { need = 0xffffffffu; }
    else { int c = 0;
#pragma unroll
        for (int i = 0; i < 32; ++i) c += (k[i] > prefix) ? 1 : 0;
        c = wave_sum_i(c); need = (unsigned)(TOPK - c); }
}
#ifndef PROBE_VALU
#define PROBE_VALU 0
#endif
#ifndef RP_T3
#define RP_T3 1
#endif
#ifndef RP_T1
#define RP_T1 1
#endif
#ifndef RP_T2
#define RP_T2 1
#endif
#ifndef RP_I
#define RP_I 1
#endif
#ifndef RP_T
#define RP_T 1
#endif
#ifndef RP_V
#define RP_V 1
#endif
typedef short bf16x8v __attribute__((ext_vector_type(8)));
typedef short s16x4v __attribute__((ext_vector_type(4)));
constexpr int BMS = 65;
constexpr int SCP = 2052;
constexpr int DSA_BM_OFF = 16 * SCP * 4;
constexpr int DSA_RING_OFF = 0;
constexpr int DSA_QIB_OFF = 147456;
constexpr int DSA_WIB_OFF = 135680;
constexpr int DSA_MLUT_OFF = 143616;
__device__ __forceinline__ void glds16(const void* gsrc, unsigned lds_dst) { unsigned keep;
    asm volatile("s_mov_b32 %0, m0\n\ts_mov_b32 m0, %2\n\ts_nop 0\n\tglobal_load_lds_dwordx4 %1, off\n\ts_mov_b32 m0, %0" : "=&s"(keep) : "v"(gsrc), "s"(lds_dst) : "memory"); }
template <int I> __device__ __forceinline__ unsigned mbit_t(int mw) { unsigned r; asm("v_bfe_i32 %0, %1, %2, 1" : "=v"(r) : "v"(mw), "i"(I)); return r; }
#define mbit(mw, i) mbit_t<(i)>(mw)
__device__ __forceinline__ float relu_i(float x) { return __int_as_float(max(__float_as_int(x), 0)); }
__device__ __forceinline__ int imax3(float a, float b, float c) { return max(max(__float_as_int(a), __float_as_int(b)), __float_as_int(c)); }
__device__ __forceinline__ s16x4v lds_tr16(LAS const unsigned char* p) { return __builtin_bit_cast(s16x4v, __builtin_amdgcn_ds_read_tr16_b64_v4i16((LAS s16x4v*)p)); }
__device__ __forceinline__ unsigned cvtpk(float lo, float hi) { typedef float f2 __attribute__((ext_vector_type(2))); typedef __bf16 b2 __attribute__((ext_vector_type(2))); f2 v = {lo, hi}; b2 r = __builtin_convertvector(v, b2); return __builtin_bit_cast(unsigned, r); }


template <int L> __device__ __forceinline__ void wr2lanes(int& w, unsigned lo, unsigned hi) {
    asm volatile("s_nop 1\n\tv_writelane_b32 %0, %1, %3\n\tv_writelane_b32 %0, %2, %4" : "+v"(w) : "s"(lo), "s"(hi), "i"(L), "i"(L + 1));
}
__device__ __forceinline__ int wave_sum_dpp(int v) {
    v += __builtin_amdgcn_update_dpp(0, v, 0xB1, 0xf, 0xf, true);
    v += __builtin_amdgcn_update_dpp(0, v, 0x4E, 0xf, 0xf, true);
    v += __builtin_amdgcn_update_dpp(0, v, 0x141, 0xf, 0xf, true);
    v += __builtin_amdgcn_update_dpp(0, v, 0x140, 0xf, 0xf, true);
    return __builtin_amdgcn_readlane(v, 0) + __builtin_amdgcn_readlane(v, 16) + __builtin_amdgcn_readlane(v, 32) + __builtin_amdgcn_readlane(v, 48);
}
__device__ __forceinline__ unsigned wave_max_dpp(unsigned v) {
    v = max(v, (unsigned)__builtin_amdgcn_update_dpp(0, (int)v, 0xB1, 0xf, 0xf, true));
    v = max(v, (unsigned)__builtin_amdgcn_update_dpp(0, (int)v, 0x4E, 0xf, 0xf, true));
    v = max(v, (unsigned)__builtin_amdgcn_update_dpp(0, (int)v, 0x141, 0xf, 0xf, true));
    v = max(v, (unsigned)__builtin_amdgcn_update_dpp(0, (int)v, 0x140, 0xf, 0xf, true));
    return max(max((unsigned)__builtin_amdgcn_readlane((int)v, 0), (unsigned)__builtin_amdgcn_readlane((int)v, 16)), max((unsigned)__builtin_amdgcn_readlane((int)v, 32), (unsigned)__builtin_amdgcn_readlane((int)v, 48)));
}
__device__ __forceinline__ int cnt8(int acc, unsigned cand, unsigned k0, unsigned k1, unsigned k2, unsigned k3, unsigned k4, unsigned k5, unsigned k6, unsigned k7) {
    unsigned long long m0, m1, m2, m3, m4, m5, m6, m7;
    asm volatile("v_cmp_le_u32_e64 %1, %9, %10\n\tv_cmp_le_u32_e64 %2, %9, %11\n\tv_cmp_le_u32_e64 %3, %9, %12\n\tv_cmp_le_u32_e64 %4, %9, %13\n\t"
                 "v_cmp_le_u32_e64 %5, %9, %14\n\tv_cmp_le_u32_e64 %6, %9, %15\n\tv_cmp_le_u32_e64 %7, %9, %16\n\tv_cmp_le_u32_e64 %8, %9, %17\n\t"
                 "v_addc_co_u32_e64 %0, %1, 0, %0, %1\n\tv_addc_co_u32_e64 %0, %2, 0, %0, %2\n\tv_addc_co_u32_e64 %0, %3, 0, %0, %3\n\tv_addc_co_u32_e64 %0, %4, 0, %0, %4\n\t"
                 "v_addc_co_u32_e64 %0, %5, 0, %0, %5\n\tv_addc_co_u32_e64 %0, %6, 0, %0, %6\n\tv_addc_co_u32_e64 %0, %7, 0, %0, %7\n\tv_addc_co_u32_e64 %0, %8, 0, %0, %8"
                 : "+v"(acc), "=&s"(m0), "=&s"(m1), "=&s"(m2), "=&s"(m3), "=&s"(m4), "=&s"(m5), "=&s"(m6), "=&s"(m7)
                 : "s"(cand), "v"(k0), "v"(k1), "v"(k2), "v"(k3), "v"(k4), "v"(k5), "v"(k6), "v"(k7));
    return acc;
}
__device__ __forceinline__ int count_ge(const unsigned (&k)[32], unsigned cand_, int nb) {
    const unsigned cand = (unsigned)__builtin_amdgcn_readfirstlane((int)cand_);
    int c = 0;
    c = cnt8(c, cand, k[0], k[1], k[2], k[3], k[4], k[5], k[6], k[7]);
    if (nb > 1) c = cnt8(c, cand, k[8], k[9], k[10], k[11], k[12], k[13], k[14], k[15]);
    if (nb > 2) c = cnt8(c, cand, k[16], k[17], k[18], k[19], k[20], k[21], k[22], k[23]);
    if (nb > 3) c = cnt8(c, cand, k[24], k[25], k[26], k[27], k[28], k[29], k[30], k[31]);
    return wave_sum_dpp(c);
}
struct TopkState { unsigned prefix; int bit; bool done; unsigned need; int nb; };
__device__ __forceinline__ void topk_init(const unsigned (&k)[32], TopkState& st) {
    unsigned mx = 0u;
#pragma unroll
    for (int i = 0; i < 32; ++i) mx = max(mx, k[i]);
    mx = wave_max_dpp(mx);
    st.prefix = 0u; st.bit = 31; st.done = false; st.need = 0u;
    unsigned E = mx >> 23;
#pragma unroll 1
    for (int j = 0; j < 4; ++j) {
        if (E < (unsigned)j + 1u) break;
        const unsigned T = (E - (unsigned)j) << 23;
        const int c = count_ge(k, T, st.nb);
        if (c >= TOPK) { st.prefix = T; st.bit = 22; if (c == TOPK) { st.done = true; st.need = 0xffffffffu; } break; }
    }
}
__device__ __forceinline__ void topk_step(const unsigned (&k)[32], TopkState& st) {
    if (st.done) return;
    if (st.bit < 0) { int c = 0;
#pragma unroll
        for (int i = 0; i < 32; ++i) c += (k[i] > st.prefix) ? 1 : 0;
        c = wave_sum_dpp(c); st.need = (unsigned)(TOPK - c); st.done = true; return; }
    const unsigned cand = st.prefix | (1u << st.bit);
    const int c = count_ge(k, cand, st.nb);
    if (c >= TOPK) st.prefix = cand;
    if (c == TOPK) { st.done = true; st.need = 0xffffffffu; }
    --st.bit;
}

__device__ __forceinline__ void dsa_prefetch_qi(const bf16* zb, int qt, LAS unsigned char* lds, int wave, int lane) {
    const unsigned lds_base = (unsigned)(uintptr_t)lds;
#pragma unroll
    for (int i = 0; i < 2; ++i) { const int row = 2 * wave + i;
        glds16(zb + (size_t)(qt * 16 + row) * ZP + C_QI + ((lane ^ row) * 8), (unsigned)__builtin_amdgcn_readfirstlane(lds_base + DSA_QIB_OFF + row * 1024)); }
    if (wave == 0) glds16(zb + (size_t)(qt * 16 + (lane & 15)) * ZP + C_WI, (unsigned)__builtin_amdgcn_readfirstlane(lds_base + DSA_WIB_OFF));
}

__device__ __forceinline__ void dsa_prefetch_ki(const bf16* zb, int qt, bf16x8v (&pk)[4], int wave, int lane) {
    const int r16 = lane & 15, g = lane >> 4;
    if (wave <= qt) { const bf16* krow = zb + (size_t)(wave * 16 + r16) * ZP + C_KI; pk[0] = *(const bf16x8v*)(krow + 8 * g); pk[1] = *(const bf16x8v*)(krow + 32 + 8 * g); }
    if (wave + 8 <= qt) { const bf16* krow = zb + (size_t)((wave + 8) * 16 + r16) * ZP + C_KI; pk[2] = *(const bf16x8v*)(krow + 8 * g); pk[3] = *(const bf16x8v*)(krow + 32 + 8 * g); }
}

__device__ __forceinline__ void dsa_unit(const P& p, int b, int qt, int qt_next, bf16x8v (&pk)[4], LAS unsigned char* lds) {
    const int tid = threadIdx.x, lane = tid & 63, wave = __builtin_amdgcn_readfirstlane(tid >> 6), r16 = lane & 15, g = lane >> 4;
    const int q0 = qt * 16; const bf16* zb = p.Z + (size_t)b * SEQ * ZP;
    LAS float* SC = (LAS float*)lds; LAS unsigned* BM = (LAS unsigned*)(lds + DSA_BM_OFF);
    const bool dense_all = (qt < TOPK / 16);
    const bf16* qrow = zb + (size_t)(q0 + r16) * ZP;
    const bf16x8v bq0 = *(const bf16x8v*)(qrow + C_Q + wave * 64 + 8 * g), bq1 = *(const bf16x8v*)(qrow + C_Q + wave * 64 + 32 + 8 * g);
    u32x2 gwv[4];
#pragma unroll
    for (int dt = 0; dt < 4; ++dt) gwv[dt] = *(const u32x2*)(qrow + C_GA + wave * 64 + dt * 16 + 4 * g);
    const int nsteps = (((q0 + 16 + 31) >> 5) + 1) & ~1, nmega = (nsteps + 7) >> 3;
    const int kkey = lane >> 3, vkey = lane >> 1, vhalf = lane & 1;
    const unsigned lds_base = (unsigned)(uintptr_t)lds;
#define DSA_STAGE(mm) do { const int st_ = (mm) * 8 + wave; if (st_ < nsteps) { \
        const bf16* kb_ = zb + (size_t)st_ * 32 * ZP; const unsigned ldsb_ = lds_base + (unsigned)(((mm) & 1) * 65536 + wave * 4096); \
        _Pragma("unroll") for (int c_ = 0; c_ < 4; ++c_) { const int key_ = 8 * c_ + kkey, ch_ = (lane & 7) ^ ((key_ & 15) >> 1); \
            glds16(kb_ + (size_t)key_ * ZP + C_K + ch_ * 8, (unsigned)__builtin_amdgcn_readfirstlane(ldsb_ + c_ * 1024)); } \
        _Pragma("unroll") for (int c_ = 0; c_ < 4; ++c_) \
            glds16(kb_ + (size_t)vkey * ZP + C_V + c_ * 16 + vhalf * 8, (unsigned)__builtin_amdgcn_readfirstlane(ldsb_ + 32768 + c_ * 1024)); } } while (0)
    if (!dense_all) {
        for (int rpI = 0; rpI < RP_I; ++rpI) {
        bf16x8v bq[8][2]; float wv[8];
#pragma unroll
        for (int h = 0; h < 8; ++h) { bq[h][0] = *(LAS const bf16x8v*)(lds + DSA_QIB_OFF + r16 * 1024 + (((8 * h + g) ^ r16) * 16)); bq[h][1] = *(LAS const bf16x8v*)(lds + DSA_QIB_OFF + r16 * 1024 + (((8 * h + 4 + g) ^ r16) * 16));
            wv[h] = bf2f(*(LAS const bf16*)(lds + DSA_WIB_OFF + r16 * 16 + h * 2)) * 0.35355339059327373f * 0.125f; }
        bf16x8v ra0 = pk[0], ra1 = pk[1], rb0 = pk[2], rb1 = pk[3], rc0 = pk[0], rc1 = pk[1];
#define IDX_LOAD(d0, d1, ktl) do { const int ktl_ = (ktl) <= qt ? (ktl) : qt;        \
            const bf16* krow_ = zb + (size_t)(ktl_ * 16 + r16) * ZP + C_KI; d0 = *(const bf16x8v*)(krow_ + 8 * g); d1 = *(const bf16x8v*)(krow_ + 32 + 8 * g); } while (0)
#define IDX_STEP(c0, c1) do { \
            f32x4 sc = {0.f, 0.f, 0.f, 0.f}; \
            _Pragma("unroll") for (int h = 0; h < 8; ++h) { \
                f32x4 acc = {0.f, 0.f, 0.f, 0.f}; \
                acc = __builtin_amdgcn_mfma_f32_16x16x32_bf16(c0, bq[h][0], acc, 0, 0, 0); \
                acc = __builtin_amdgcn_mfma_f32_16x16x32_bf16(c1, bq[h][1], acc, 0, 0, 0); \
                _Pragma("unroll") for (int i = 0; i < 4; ++i) sc[i] += relu_i(acc[i]) * wv[h]; \
            } \
            if (__builtin_amdgcn_readfirstlane(kt) == qt) {                  \
                _Pragma("unroll") for (int i = 0; i < 4; ++i) sc[i] = (4 * g + i > r16) ? -INFINITY : sc[i]; \
            } \
            *(LAS f32x4*)(SC + r16 * SCP + kt * 16 + 4 * g) = sc; } while (0)
        int kt = wave;
        const int nst = (qt - wave + 8) >> 3;
        const int ntrip = (nst * 11) >> 5, rem = nst - 3 * ntrip;
#pragma unroll 1
        for (int it = ntrip; it > 0; --it) {
            IDX_LOAD(rc0, rc1, kt + 16); __builtin_amdgcn_sched_barrier(0); IDX_STEP(ra0, ra1); __builtin_amdgcn_sched_barrier(0); kt += 8;
            IDX_LOAD(ra0, ra1, kt + 16); __builtin_amdgcn_sched_barrier(0); IDX_STEP(rb0, rb1); __builtin_amdgcn_sched_barrier(0); kt += 8;
            IDX_LOAD(rb0, rb1, kt + 16); __builtin_amdgcn_sched_barrier(0); IDX_STEP(rc0, rc1); __builtin_amdgcn_sched_barrier(0); kt += 8;
        }
        if (rem >= 1) { IDX_STEP(ra0, ra1); kt += 8; if (rem >= 2) { IDX_STEP(rb0, rb1); } }
#undef IDX_LOAD
#undef IDX_STEP
        __syncthreads();
        }
#pragma unroll 1
        for (int rpT = 0; rpT < RP_T; ++rpT) {
            const int ra = 2 * wave, rb = 2 * wave + 1, ta = q0 + ra, tb = q0 + rb;
            unsigned ka[32], kb[32];
#pragma unroll
            for (int i = 0; i < 32; ++i) { const int key = lane + 64 * i; ka[i] = (key <= ta) ? score_ukey(SC[ra * SCP + key]) : 0u; kb[i] = (key <= tb) ? score_ukey(SC[rb * SCP + key]) : 0u; }
#if RP_T1 > 1
            asm volatile("" :: "v"(ka[0]), "v"(kb[31]) : "memory");
#pragma unroll
            for (int i = 0; i < 32; ++i) { const int key = lane + 64 * i; ka[i] = (key <= ta) ? score_ukey(SC[ra * SCP + key]) : 0u; kb[i] = (key <= tb) ? score_ukey(SC[rb * SCP + key]) : 0u; }
            asm volatile("" ::: "memory");
#endif
            asm volatile("s_waitcnt lgkmcnt(0)" ::: "memory");
            __syncthreads();
            DSA_STAGE(0);
            TopkState sa, sb; sa.nb = (ta >> 9) + 1; sb.nb = (tb >> 9) + 1; topk_init(ka, sa); topk_init(kb, sb);
#pragma unroll 1
            while (!(sa.done && sb.done)) { topk_step(ka, sa); topk_step(kb, sb); }
#if RP_T2 > 1
            asm volatile("" :: "v"(sa.prefix), "v"(sb.prefix));
            topk_init(ka, sa); topk_init(kb, sb);
#pragma unroll 1
            while (!(sa.done && sb.done)) { topk_step(ka, sa); topk_step(kb, sb); }
#endif
            if (sa.need == 0xffffffffu && sb.need == 0xffffffffu) {
                const unsigned ta_ = (unsigned)__builtin_amdgcn_readfirstlane((int)sa.prefix), tb_ = (unsigned)__builtin_amdgcn_readfirstlane((int)sb.prefix);
                int wa = 0, wb = 0;
#define WR2(i) { const unsigned long long ma = __ballot(ka[i] >= ta_), mb = __ballot(kb[i] >= tb_); wr2lanes<2 * (i)>(wa, (unsigned)ma, (unsigned)(ma >> 32)); wr2lanes<2 * (i)>(wb, (unsigned)mb, (unsigned)(mb >> 32)); }
                WR2(0) WR2(1) WR2(2) WR2(3) WR2(4) WR2(5) WR2(6) WR2(7) WR2(8) WR2(9) WR2(10) WR2(11) WR2(12) WR2(13) WR2(14) WR2(15)
                WR2(16) WR2(17) WR2(18) WR2(19) WR2(20) WR2(21) WR2(22) WR2(23) WR2(24) WR2(25) WR2(26) WR2(27) WR2(28) WR2(29) WR2(30) WR2(31)
#undef WR2
                BM[ra * BMS + lane] = (unsigned)wa; BM[rb * BMS + lane] = (unsigned)wb;
#if RP_T3 > 1
                asm volatile("" : "+v"(wa), "+v"(wb) :: "memory");
#define WR2(i) { const unsigned long long ma = __ballot(ka[i] >= ta_), mb = __ballot(kb[i] >= tb_); wr2lanes<2 * (i)>(wa, (unsigned)ma, (unsigned)(ma >> 32)); wr2lanes<2 * (i)>(wb, (unsigned)mb, (unsigned)(mb >> 32)); }
                WR2(0) WR2(1) WR2(2) WR2(3) WR2(4) WR2(5) WR2(6) WR2(7) WR2(8) WR2(9) WR2(10) WR2(11) WR2(12) WR2(13) WR2(14) WR2(15)
                WR2(16) WR2(17) WR2(18) WR2(19) WR2(20) WR2(21) WR2(22) WR2(23) WR2(24) WR2(25) WR2(26) WR2(27) WR2(28) WR2(29) WR2(30) WR2(31)
#undef WR2
                BM[ra * BMS + lane] = (unsigned)wa; BM[rb * BMS + lane] = (unsigned)wb;
#endif
            } else {
            unsigned eqa = 0u, eqb = 0u;
#pragma unroll 1
            for (int i = 0; i < 32; ++i) {
                unsigned kai = ka[0], kbi = kb[0];
#pragma unroll
                for (int j = 1; j < 32; ++j) { kai = (i == j) ? ka[j] : kai; kbi = (i == j) ? kb[j] : kbi; }
                { const bool eq = (kai == sa.prefix); const unsigned long long em = __ballot(eq);
                  const unsigned erank = eqa + __builtin_amdgcn_mbcnt_hi((unsigned)(em >> 32), __builtin_amdgcn_mbcnt_lo((unsigned)em, 0u));
                  const unsigned long long smk = __ballot((kai > sa.prefix) || (eq && erank < sa.need));
                  if (lane == 0) { BM[ra * BMS + 2 * i] = (unsigned)smk; BM[ra * BMS + 2 * i + 1] = (unsigned)(smk >> 32); }
                  eqa += (unsigned)__popcll(em); }
                { const bool eq = (kbi == sb.prefix); const unsigned long long em = __ballot(eq);
                  const unsigned erank = eqb + __builtin_amdgcn_mbcnt_hi((unsigned)(em >> 32), __builtin_amdgcn_mbcnt_lo((unsigned)em, 0u));
                  const unsigned long long smk = __ballot((kbi > sb.prefix) || (eq && erank < sb.need));
                  if (lane == 0) { BM[rb * BMS + 2 * i] = (unsigned)smk; BM[rb * BMS + 2 * i + 1] = (unsigned)(smk >> 32); }
                  eqb += (unsigned)__popcll(em); }
            }
            }
        }
    } else {
        for (int i = tid; i < 1024; i += 512) { const int row = i >> 6, w = i & 63, t = q0 + row, lo = 32 * w;
            BM[row * BMS + w] = (t >= lo + 31) ? 0xffffffffu : ((t < lo) ? 0u : ((2u << (t - lo)) - 1u)); }
        DSA_STAGE(0);
    }
    __syncthreads();
    const int h = wave;
#pragma unroll 1
    for (int rpV = 0; rpV < RP_V; ++rpV) {
    asm volatile("s_waitcnt vmcnt(0)" ::: "memory");
    asm volatile("" :: "v"(bq0), "v"(bq1), "v"(gwv[0]), "v"(gwv[1]), "v"(gwv[2]), "v"(gwv[3]));
    __syncthreads();
    if (qt_next >= TOPK / 16) { dsa_prefetch_qi(zb, qt_next, lds, wave, lane); dsa_prefetch_ki(zb, qt_next, pk, wave, lane); }
    f32x4 o[4], lacc = {0.f, 0.f, 0.f, 0.f}, negm = {0.f, 0.f, 0.f, 0.f};
#pragma unroll
    for (int dt = 0; dt < 4; ++dt) o[dt] = (f32x4){0.f, 0.f, 0.f, 0.f};
    float m_run = 0.f;
    const int kofs0 = r16 * 128 + ((g ^ (r16 >> 1)) & 7) * 16, kofs1 = r16 * 128 + (((4 + g) ^ (r16 >> 1)) & 7) * 16;
    const int vofs = 32768 + (4 * g + ((lane & 15) >> 2)) * 32 + (lane & 3) * 8;
    bf16x8v ones = {0x3f80, 0x3f80, 0x3f80, 0x3f80, 0x3f80, 0x3f80, 0x3f80, 0x3f80};
    asm volatile("" : "+v"(ones));
    LAS const unsigned char* mlut = lds + DSA_MLUT_OFF;
    constexpr float THR = 8.0f;
    bool first = true;
#pragma unroll 1
    for (int mm = 0; mm < nmega; ++mm) {
        if (mm + 1 < nmega) DSA_STAGE(mm + 1);
        LAS unsigned char* slotb = lds + (mm & 1) * 65536;
        const int nsub = (nsteps - mm * 8) < 8 ? (nsteps - mm * 8) : 8;
#pragma unroll 1
        for (int u = 0; u < nsub; u += 2) {
            LAS unsigned char* slot = slotb + u * 4096;
            const int mwA = (int)(BM[r16 * BMS + mm * 8 + u] >> (4 * g)), mwB = (int)(BM[r16 * BMS + mm * 8 + u + 1] >> (4 * g));
            f32x4 s0, s1, s2, s3;
            { const bf16x8v ka0 = *(LAS const bf16x8v*)(slot + kofs0), ka1 = *(LAS const bf16x8v*)(slot + kofs1);
              const bf16x8v kb0 = *(LAS const bf16x8v*)(slot + 2048 + kofs0), kb1 = *(LAS const bf16x8v*)(slot + 2048 + kofs1);
              const bf16x8v kc0 = *(LAS const bf16x8v*)(slot + 4096 + kofs0), kc1 = *(LAS const bf16x8v*)(slot + 4096 + kofs1);
              const bf16x8v kd0 = *(LAS const bf16x8v*)(slot + 6144 + kofs0), kd1 = *(LAS const bf16x8v*)(slot + 6144 + kofs1);
              s0 = __builtin_amdgcn_mfma_f32_16x16x32_bf16(ka0, bq0, negm, 0, 0, 0); s1 = __builtin_amdgcn_mfma_f32_16x16x32_bf16(kb0, bq0, negm, 0, 0, 0);
              s2 = __builtin_amdgcn_mfma_f32_16x16x32_bf16(kc0, bq0, negm, 0, 0, 0); s3 = __builtin_amdgcn_mfma_f32_16x16x32_bf16(kd0, bq0, negm, 0, 0, 0);
              s0 = __builtin_amdgcn_mfma_f32_16x16x32_bf16(ka1, bq1, s0, 0, 0, 0); s1 = __builtin_amdgcn_mfma_f32_16x16x32_bf16(kb1, bq1, s1, 0, 0, 0);
              s2 = __builtin_amdgcn_mfma_f32_16x16x32_bf16(kc1, bq1, s2, 0, 0, 0); s3 = __builtin_amdgcn_mfma_f32_16x16x32_bf16(kd1, bq1, s3, 0, 0, 0); }
            const int lmi = max(max(max(imax3(s0[0], s0[1], s0[2]), imax3(s0[3], s1[0], s1[1])), max(imax3(s1[2], s1[3], s2[0]), imax3(s2[1], s2[2], s2[3]))), max(imax3(s3[0], s3[1], s3[2]), __float_as_int(s3[3])));
            if (first || __any(lmi > 0x41000000)) {
                float lmx = fmaxf(fmaxf(fmaxf(fmaxf(s0[0], s0[1]), fmaxf(s0[2], s0[3])), fmaxf(fmaxf(s1[0], s1[1]), fmaxf(s1[2], s1[3]))), fmaxf(fmaxf(fmaxf(s2[0], s2[1]), fmaxf(s2[2], s2[3])), fmaxf(fmaxf(s3[0], s3[1]), fmaxf(s3[2], s3[3]))));
                { const auto r1 = __builtin_amdgcn_permlane16_swap(__float_as_uint(lmx), __float_as_uint(lmx), false, false); lmx = fmaxf(__uint_as_float(r1[0]), __uint_as_float(r1[1])); }
                { const auto r2 = __builtin_amdgcn_permlane32_swap(__float_as_uint(lmx), __float_as_uint(lmx), false, false); lmx = fmaxf(__uint_as_float(r2[0]), __uint_as_float(r2[1])); }
                const float dl = first ? lmx : fmaxf(lmx, 0.f);
                m_run += dl; const float f = first ? 1.0f : __builtin_amdgcn_exp2f(-dl);
#pragma unroll
                for (int i = 0; i < 4; ++i) { s0[i] -= dl; s1[i] -= dl; s2[i] -= dl; s3[i] -= dl; negm[i] = -m_run; }
                lacc = lacc * f;
#pragma unroll
                for (int dt = 0; dt < 4; ++dt) o[dt] = o[dt] * f;
                first = false;
            }
            const u32x2 mk0 = *(LAS const u32x2*)(mlut + ((mwA & 15) << 3)), mk1 = *(LAS const u32x2*)(mlut + (((mwA >> 16) & 15) << 3));
            const u32x2 mk2 = *(LAS const u32x2*)(mlut + ((mwB & 15) << 3)), mk3 = *(LAS const u32x2*)(mlut + (((mwB >> 16) & 15) << 3));
            u32x4 pwA, pwB;
            pwA.x = cvtpk(__builtin_amdgcn_exp2f(s0[0]), __builtin_amdgcn_exp2f(s0[1])) & mk0.x; pwA.y = cvtpk(__builtin_amdgcn_exp2f(s0[2]), __builtin_amdgcn_exp2f(s0[3])) & mk0.y;
            pwA.z = cvtpk(__builtin_amdgcn_exp2f(s1[0]), __builtin_amdgcn_exp2f(s1[1])) & mk1.x; pwA.w = cvtpk(__builtin_amdgcn_exp2f(s1[2]), __builtin_amdgcn_exp2f(s1[3])) & mk1.y;
            pwB.x = cvtpk(__builtin_amdgcn_exp2f(s2[0]), __builtin_amdgcn_exp2f(s2[1])) & mk2.x; pwB.y = cvtpk(__builtin_amdgcn_exp2f(s2[2]), __builtin_amdgcn_exp2f(s2[3])) & mk2.y;
            pwB.z = cvtpk(__builtin_amdgcn_exp2f(s3[0]), __builtin_amdgcn_exp2f(s3[1])) & mk3.x; pwB.w = cvtpk(__builtin_amdgcn_exp2f(s3[2]), __builtin_amdgcn_exp2f(s3[3])) & mk3.y;
            const bf16x8v pfA = __builtin_bit_cast(bf16x8v, pwA), pfB = __builtin_bit_cast(bf16x8v, pwB);
            lacc = __builtin_amdgcn_mfma_f32_16x16x32_bf16(ones, pfA, lacc, 0, 0, 0);
            lacc = __builtin_amdgcn_mfma_f32_16x16x32_bf16(ones, pfB, lacc, 0, 0, 0);
#pragma unroll
            for (int dt = 0; dt < 4; ++dt) {
                const s16x4v lo = lds_tr16(slot + vofs + dt * 1024), hi = lds_tr16(slot + vofs + dt * 1024 + 512);
                const s16x4v lo2 = lds_tr16(slot + 4096 + vofs + dt * 1024), hi2 = lds_tr16(slot + 4096 + vofs + dt * 1024 + 512);
                const bf16x8v vf = {lo[0], lo[1], lo[2], lo[3], hi[0], hi[1], hi[2], hi[3]};
                const bf16x8v vf2 = {lo2[0], lo2[1], lo2[2], lo2[3], hi2[0], hi2[1], hi2[2], hi2[3]};
                o[dt] = __builtin_amdgcn_mfma_f32_16x16x32_bf16(vf, pfA, o[dt], 0, 0, 0);
                o[dt] = __builtin_amdgcn_mfma_f32_16x16x32_bf16(vf2, pfB, o[dt], 0, 0, 0);
            }
        }
        asm volatile("s_waitcnt vmcnt(0) lgkmcnt(0)" ::: "memory");
        __syncthreads();
    }
#undef DSA_STAGE
    const float inv = 1.0f / lacc[0];
    bf16* yrow = p.Y + ((size_t)b * SEQ + q0 + r16) * DM + 512 + h * 64;
#pragma unroll
    for (int dt = 0; dt < 4; ++dt) {
        const u32x2 gw = gwv[dt];
        const float g0 = __uint_as_float(gw.x << 16), g1 = __uint_as_float(gw.x & 0xffff0000u), g2 = __uint_as_float(gw.y << 16), g3 = __uint_as_float(gw.y & 0xffff0000u);
        u32x2 w; w.x = pk2(o[dt][0] * inv * siluf(g0), o[dt][1] * inv * siluf(g1)); w.y = pk2(o[dt][2] * inv * siluf(g2), o[dt][3] * inv * siluf(g3));
        *(u32x2*)(yrow + dt * 16 + 4 * g) = w;
    }
    __syncthreads();
    }
}
__device__ __forceinline__ int dsa_qt_of(int j, int i) { return (i == 0) ? 127 - j : (i == 1) ? 64 + j : (i == 2) ? 63 - j : j; }
__device__ __forceinline__ void dsa_phase_pre(const P& p, LAS unsigned char* lds) {
    const int G = gridDim.x, wg = blockIdx.x, lane = threadIdx.x & 63, wave = __builtin_amdgcn_readfirstlane(threadIdx.x >> 6);
    const int b = (G == 256) ? (wg & 7) : (wg >> 7), qt = (G == 256) ? dsa_qt_of(wg >> 3, 0) : 127 - (wg & 127);
    if (wg < 1024 && qt >= TOPK / 16) dsa_prefetch_qi(p.Z + (size_t)b * SEQ * ZP, qt, lds, wave, lane);
}
__device__ __forceinline__ void dsa_phase(const P& p, LAS unsigned char* lds) {
    const int G = gridDim.x, wg = blockIdx.x;
    if (G == 256) {
        const int b = wg & 7, j = wg >> 3, lane = threadIdx.x & 63, wave = __builtin_amdgcn_readfirstlane(threadIdx.x >> 6);
        bf16x8v pk[4] = {{0, 0, 0, 0, 0, 0, 0, 0}, {0, 0, 0, 0, 0, 0, 0, 0}, {0, 0, 0, 0, 0, 0, 0, 0}, {0, 0, 0, 0, 0, 0, 0, 0}};
        if (dsa_qt_of(j, 0) >= TOPK / 16) dsa_prefetch_ki(p.Z + (size_t)b * SEQ * ZP, dsa_qt_of(j, 0), pk, wave, lane);
#pragma unroll 1
        for (int i = 0; i < 4; ++i) dsa_unit(p, b, dsa_qt_of(j, i), (i < 3) ? dsa_qt_of(j, i + 1) : -1, pk, lds);
    }
}
constexpr int LRU_WS_OFF = 139264;
constexpr int LRU_XB = 264 * 128;
constexpr int LRU_GB = 256 * 32;
constexpr int LRU_BUF = LRU_XB + LRU_GB;
__device__ __forceinline__ float fast_sigm(float x) { return __builtin_amdgcn_rcpf(1.0f + __expf(-x)); }
__device__ __forceinline__ void lru_unit(const P& p, int l, int b, int blk, int q4, LAS unsigned char* lds) {
    const int tid = threadIdx.x, lane = tid & 63, wave = __builtin_amdgcn_readfirstlane(tid >> 6), r16 = lane & 15, g = lane >> 4;
    const bf16* zb = p.Z + (size_t)b * SEQ * ZP;
    const int cA = blk * 64, dloc = q4 * 16 + r16, dg = blk * 64 + dloc;
    const unsigned lds_base = (unsigned)(uintptr_t)lds;
#define LRU_STAGE(r) do { const unsigned bb_ = lds_base + (unsigned)(((r) & 1) * LRU_BUF); \
        _Pragma("unroll") for (int i_ = 0; i_ < 5; ++i_) { const int pc_ = wave + 8 * i_; if (pc_ < 33) { const int rho_ = pc_ * 8 + (lane >> 3); int t_ = (r) * 256 - 3 + rho_; t_ = t_ < 0 ? 0 : (t_ > SEQ - 1 ? SEQ - 1 : t_); \
            const int ch_ = (lane & 7) ^ ((rho_ >> 1) & 7); glds16(zb + (size_t)t_ * ZP + C_XR + cA + ch_ * 8, (unsigned)__builtin_amdgcn_readfirstlane(bb_ + pc_ * 1024)); } } \
        { const int row_ = wave * 32 + (lane >> 1); glds16(zb + (size_t)((r) * 256 + row_) * ZP + C_GR + dg - r16 + (lane & 1) * 8, (unsigned)__builtin_amdgcn_readfirstlane(bb_ + LRU_XB + wave * 1024)); } } while (0)
    LRU_STAGE(0);
    float cwA[2][4][8], cbA[2][8];
#pragma unroll
    for (int s = 0; s < 2; ++s)
#pragma unroll
        for (int j = 0; j < 8; ++j) { const int c = cA + 32 * s + 8 * g + j; cbA[s][j] = p.conv_b[l * 512 + c];
#pragma unroll
            for (int k = 0; k < 4; ++k) cwA[s][k][j] = p.conv_w[(l * 4 + k) * 512 + c]; }
    bf16x8v bxf[2], baf[2];
#pragma unroll
    for (int s = 0; s < 2; ++s) { u32x4 wx, wa; unsigned tx[8], ta[8];
#pragma unroll
        for (int j = 0; j < 8; ++j) { const size_t idx = (((size_t)l * 8 + blk) * 64 + 32 * s + 8 * g + j) * 64 + dloc; tx[j] = f2bf(p.lru_wx[idx]); ta[j] = f2bf(p.lru_wa[idx]); }
        wx.x = tx[0] | (tx[1] << 16); wx.y = tx[2] | (tx[3] << 16); wx.z = tx[4] | (tx[5] << 16); wx.w = tx[6] | (tx[7] << 16);
        wa.x = ta[0] | (ta[1] << 16); wa.y = ta[2] | (ta[3] << 16); wa.z = ta[4] | (ta[5] << 16); wa.w = ta[6] | (ta[7] << 16);
        bxf[s] = __builtin_bit_cast(bf16x8v, wx); baf[s] = __builtin_bit_cast(bf16x8v, wa); }
    const float cw0 = p.conv_w[(l * 4 + 0) * 512 + dg], cw1 = p.conv_w[(l * 4 + 1) * 512 + dg], cw2 = p.conv_w[(l * 4 + 2) * 512 + dg], cw3 = p.conv_w[(l * 4 + 3) * 512 + dg];
    const float cb = p.conv_b[l * 512 + dg], bxv = p.lru_bx[l * 512 + dg], bav = p.lru_ba[l * 512 + dg];
    const float sp8 = -8.0f * log1pf(expf(-p.lru_a[l * 512 + dg]));
    asm volatile("" :: "v"(cwA[0][0][0]), "v"(cwA[1][3][7]), "v"(cbA[1][7]), "v"(bxf[0]), "v"(bxf[1]), "v"(baf[0]), "v"(baf[1]), "v"(cw0), "v"(cw1), "v"(cw2), "v"(cw3), "v"(cb), "v"(bxv), "v"(bav), "v"(sp8));
    LAS float* WS = (LAS float*)(lds + LRU_WS_OFF);
    float hrun = 0.f;
    asm volatile("s_waitcnt vmcnt(0)" ::: "memory");
#pragma unroll 1
    for (int round = 0; round < 8; ++round) {
        asm volatile("s_waitcnt vmcnt(8)" ::: "memory");
        __syncthreads();
        if (round + 1 < 8) LRU_STAGE(round + 1);
        LAS const unsigned char* xb = lds + (round & 1) * LRU_BUF; LAS const unsigned char* gb = xb + LRU_XB;
        const int tw = round * 256 + wave * 32;
        float hl[2][4], pl[2][4], gr4[2][4], PT[2], HT[2], PE[2], HE[2];
#pragma unroll
        for (int tau = 0; tau < 2; ++tau) {
            const int t0 = tw + 16 * tau, rho0 = wave * 32 + 16 * tau;
            bf16x8v af[2];
#pragma unroll
            for (int s = 0; s < 2; ++s) {
                float xc[8];
#pragma unroll
                for (int j = 0; j < 8; ++j) xc[j] = cbA[s][j];
#pragma unroll
                for (int k = 0; k < 4; ++k) { const int rho = rho0 + r16 + k; u32x4 w = *(LAS const u32x4*)(xb + rho * 128 + (((4 * s + g) ^ (rho >> 1)) & 7) * 16);
                    if (t0 + r16 - 3 + k < 0) w = (u32x4){0u, 0u, 0u, 0u};
                    xc[0] += cwA[s][k][0] * __uint_as_float(w.x << 16); xc[1] += cwA[s][k][1] * __uint_as_float(w.x & 0xffff0000u);
                    xc[2] += cwA[s][k][2] * __uint_as_float(w.y << 16); xc[3] += cwA[s][k][3] * __uint_as_float(w.y & 0xffff0000u);
                    xc[4] += cwA[s][k][4] * __uint_as_float(w.z << 16); xc[5] += cwA[s][k][5] * __uint_as_float(w.z & 0xffff0000u);
                    xc[6] += cwA[s][k][6] * __uint_as_float(w.w << 16); xc[7] += cwA[s][k][7] * __uint_as_float(w.w & 0xffff0000u); }
                u32x4 pw; pw.x = cvtpk(xc[0], xc[1]); pw.y = cvtpk(xc[2], xc[3]); pw.z = cvtpk(xc[4], xc[5]); pw.w = cvtpk(xc[6], xc[7]);
                af[s] = __builtin_bit_cast(bf16x8v, pw);
            }
            f32x4 gx = {0.f, 0.f, 0.f, 0.f}, ga = {0.f, 0.f, 0.f, 0.f};
            gx = __builtin_amdgcn_mfma_f32_16x16x32_bf16(af[0], bxf[0], gx, 0, 0, 0); gx = __builtin_amdgcn_mfma_f32_16x16x32_bf16(af[1], bxf[1], gx, 0, 0, 0);
            ga = __builtin_amdgcn_mfma_f32_16x16x32_bf16(af[0], baf[0], ga, 0, 0, 0); ga = __builtin_amdgcn_mfma_f32_16x16x32_bf16(af[1], baf[1], ga, 0, 0, 0);
            float xo[7];
#pragma unroll
            for (int m = 0; m < 7; ++m) { const int rho = rho0 + 4 * g + m;
                const unsigned short v = *(LAS const unsigned short*)(xb + rho * 128 + (((dloc >> 3) ^ (rho >> 1)) & 7) * 16 + (dloc & 7) * 2);
                xo[m] = (t0 + 4 * g - 3 + m >= 0) ? bf2f(v) : 0.f; }
            float Pr = 1.f, Hr = 0.f;
#pragma unroll
            for (int i = 0; i < 4; ++i) {
                const float xcv = cb + cw0 * xo[i] + cw1 * xo[i + 1] + cw2 * xo[i + 2] + cw3 * xo[i + 3];
                const float sx = fast_sigm(gx[i] + bxv), sa = fast_sigm(ga[i] + bav);
                const float la = sp8 * sa, a = __expf(la), y2 = 2.0f * la;
                const float ser = -y2 * (1.0f + y2 * (0.5f + y2 * (0.16666667f + y2 * (0.041666668f + y2 * (0.0083333338f + y2 * 0.0013888889f)))));
                const float em = (y2 > -0.25f) ? ser : (1.0f - __expf(y2));
                const float u = __builtin_amdgcn_sqrtf(em) * sx * xcv;
                Hr = a * Hr + u; Pr *= a; hl[tau][i] = Hr; pl[tau][i] = Pr;
                gr4[tau][i] = bf2f(*(LAS const unsigned short*)(gb + (rho0 + 4 * g + i) * 32 + r16 * 2));
            }
            float Pi = Pr, Hi = Hr;
            { const float Pl = __shfl_up(Pi, 16), Hl = __shfl_up(Hi, 16); if (g >= 1) { Hi = Pi * Hl + Hi; Pi = Pl * Pi; } }
            { const float Pl = __shfl_up(Pi, 32), Hl = __shfl_up(Hi, 32); if (g >= 2) { Hi = Pi * Hl + Hi; Pi = Pl * Pi; } }
            float Pe = __shfl_up(Pi, 16), He = __shfl_up(Hi, 16); if (g == 0) { Pe = 1.f; He = 0.f; }
            PT[tau] = __shfl(Pi, 48 + r16); HT[tau] = __shfl(Hi, 48 + r16); PE[tau] = Pe; HE[tau] = He;
        }
        HE[1] = PE[1] * HT[0] + HE[1]; PE[1] = PT[0] * PE[1];
        const float Pw = PT[0] * PT[1], Hw = PT[1] * HT[0] + HT[1];
        LAS float* wsr = WS + (round & 1) * 256;
        if (g == 0) { wsr[(wave * 16 + r16) * 2 + 0] = Pw; wsr[(wave * 16 + r16) * 2 + 1] = Hw; }
        asm volatile("s_waitcnt lgkmcnt(0)" ::: "memory");
        __builtin_amdgcn_s_barrier();
        asm volatile("" ::: "memory");
        float hc = hrun, hall = hrun;
#pragma unroll
        for (int w2 = 0; w2 < 8; ++w2) { if (w2 == wave) hc = hall; hall = wsr[(w2 * 16 + r16) * 2 + 0] * hall + wsr[(w2 * 16 + r16) * 2 + 1]; }
        hrun = hall;
#pragma unroll
        for (int tau = 0; tau < 2; ++tau) {
            const float hin = PE[tau] * hc + HE[tau];
            bf16* yp = p.Y + ((size_t)b * SEQ + tw + 16 * tau + 4 * g) * DM + dg;
#pragma unroll
            for (int i = 0; i < 4; ++i) { const float h = hl[tau][i] + pl[tau][i] * hin, gr = gr4[tau][i]; yp[(size_t)i * DM] = (bf16)f2bf(h * gr * fast_sigm(gr)); }
        }
    }
#undef LRU_STAGE
    __syncthreads();
}
__device__ __forceinline__ void lru_phase(const P& p, int l, LAS unsigned char* lds) {
    const int G = gridDim.x, wg = blockIdx.x;
#pragma unroll 1
    for (int u = wg; u < 256; u += G) lru_unit(p, l, (u >> 3) & 7, u & 7, u >> 6, lds);
}
#ifndef DSA_PHASE
#define DSA_PHASE dsa_phase
#endif
#ifndef LRU_PHASE
#define LRU_PHASE lru_phase
#endif
#ifndef RP_A
#define RP_A 1
#endif
#ifndef RP_L
#define RP_L 1
#endif
#ifndef RP_D
#define RP_D 1
#endif
#ifndef RP_C
#define RP_C 1
#endif
#ifndef RP_0
#define RP_0 1
#endif
template <int OFF> __device__ __forceinline__ unsigned long long karg_u64() {
    unsigned long long v; const unsigned long long kp = (unsigned long long)__builtin_amdgcn_kernarg_segment_ptr();
    asm volatile("s_load_dwordx2 %0, %1, %2\n\ts_waitcnt lgkmcnt(0)" : "=s"(v) : "s"(kp), "i"(OFF) : "memory");
    return v;
}
struct Args { const float* in[15]; float* out; unsigned char* ws; int ph_lo, ph_hi; };
__global__ void __launch_bounds__(512, 2) mega(Args a) {
    extern __shared__ __attribute__((aligned(16))) unsigned char lds_raw[];
    LAS unsigned char* lds = (LAS unsigned char*)lds_raw;
#define KARG(T, off) ((T)(__attribute__((address_space(1))) void*)karg_u64<(off)>())
#define LOADP() P p; { unsigned char* ws_ = KARG(unsigned char*, 128); \
        p.x = KARG(const float*, 0); p.c = KARG(const float*, 8); p.norm_g = KARG(const float*, 16); p.ada_w = KARG(const float*, 24); p.ada_b = KARG(const float*, 32); p.w_in = KARG(const float*, 40); \
        p.conv_w = KARG(const float*, 48); p.conv_b = KARG(const float*, 56); p.lru_wx = KARG(const float*, 64); p.lru_bx = KARG(const float*, 72); p.lru_wa = KARG(const float*, 80); p.lru_ba = KARG(const float*, 88); \
        p.lru_a = KARG(const float*, 96); p.w_out = KARG(const float*, 104); p.final_g = KARG(const float*, 112); p.out = KARG(float*, 120); \
        p.ctl = (unsigned*)(ws_ + WS_CTL); p.mod = (float*)(ws_ + WS_MOD); p.bias = (float*)(ws_ + WS_BIAS); p.ssq = (float*)(ws_ + WS_SSQ); \
        p.wt_in = (bf16*)(ws_ + WS_WTIN); p.wt_out = (bf16*)(ws_ + WS_WTOUT); p.A = (bf16*)(ws_ + WS_A); p.Z = (bf16*)(ws_ + WS_Z); p.Y = (bf16*)(ws_ + WS_Y); }
    unsigned* const ctl0 = (unsigned*)((unsigned char*)a.ws + WS_CTL);
    const int lo = a.ph_lo, hi = a.ph_hi;
    volatile LAS unsigned* MISC = (volatile LAS unsigned*)(lds + MISC_OFF + 4096);
    if (threadIdx.x < 4) MISC[threadIdx.x] = 0u;
    if (threadIdx.x < 16) { const unsigned t = threadIdx.x; u32x2 m; m.x = ((t & 1u) ? 0xffffu : 0u) | ((t & 2u) ? 0xffff0000u : 0u); m.y = ((t & 4u) ? 0xffffu : 0u) | ((t & 8u) ? 0xffff0000u : 0u);
        *(LAS u32x2*)(lds + DSA_MLUT_OFF + t * 8) = m; }
    __syncthreads();
    XcdBarrier bar; bar.bar = ctl0 + CW_BAR; bar.x = 0; bar.st = MISC;
    if (hi - lo > 1) bar = xcd_barrier_post(ctl0 + CW_BAR, MISC);
#define IN(k) (lo <= (k) && (k) < hi)
#ifndef N_CG_SEAMS
#define N_CG_SEAMS 0
#endif
#define SEAM(k) do { if (IN(k) && IN((k) + 1)) { if ((k) < N_CG_SEAMS) cg::this_grid().sync(); else xcd_barrier(bar); } } while (0)
    if (IN(0)) { LOADP(); ph0_prologue(p, lds); if (RP_0 > 1) { __syncthreads(); ph0_prologue(p, lds); } }
    SEAM(0);
    if (IN(1)) { LOADP(); ph1_prologue(p, lds); if (RP_0 > 1) { __syncthreads(); ph1_prologue(p, lds); } }
    SEAM(1);
#define LAYER(l, base) \
    if (IN(base)) { LOADP(); \
        pg8::Gemm g{p.A, p.wt_in + (size_t)(l) * ZP * 1024, MROWS, ZP, DM}; pg8::StaticOrder S; S.init(MROWS, ZP, (int)gridDim.x, (int)blockIdx.x); \
        EpiZ E{p.Z, p.ssq, p.bias + (size_t)(l) * 8 * ZP}; \
        pg8::gemm_phase<EpiZ, pg8::StaticOrder, PG8_ALIGN, PG8_SP2>(lds, g, S, E); if (RP_A > 1) { __syncthreads(); pg8::gemm_phase<EpiZ, pg8::StaticOrder, PG8_ALIGN, PG8_SP2>(lds, g, S, E); } \
    } \
    SEAM(base); \
    if (IN((base) + 1)) { LOADP(); dsa_phase_pre(p, lds); LRU_PHASE(p, (l), lds); __syncthreads(); if (RP_L > 1) { LRU_PHASE(p, (l), lds); __syncthreads(); } DSA_PHASE(p, lds); if (RP_D > 1) { __syncthreads(); DSA_PHASE(p, lds); } } \
    SEAM((base) + 1); \
    if (IN((base) + 2)) { LOADP(); \
        pg8::Gemm g{p.Y, p.wt_out + (size_t)(l) * 1024 * 1024, MROWS, DM, DM}; pg8::StaticOrder S; S.init(MROWS, DM, (int)gridDim.x, (int)blockIdx.x); \
        if constexpr ((l) == DEPTH - 1) { \
            EpiXF E{p.out, p.out, p.mod + (size_t)(l) * 8 * 3072 + 2048, p.final_g, p.ssq, p.ctl + CW_PANEL}; \
            pg8::gemm_phase<EpiXF, pg8::StaticOrder, false, PG8_SP2>(lds, g, S, E); \
        } else { \
            EpiX E{(l) == 0 ? p.x : p.out, p.out, p.A, p.mod + (size_t)(l) * 8 * 3072 + 2048, p.norm_g + (size_t)((l) + 1) * 1024, p.mod + (size_t)((l) + 1) * 8 * 3072 + 1024, p.ssq}; \
            pg8::gemm_phase<EpiX, pg8::StaticOrder, false, PG8_SP2>(lds, g, S, E); if (RP_C > 1 && (l) == 0) { __syncthreads(); pg8::gemm_phase<EpiX, pg8::StaticOrder, false, PG8_SP2>(lds, g, S, E); } \
        } \
    } \
    if ((base) + 3 < NPHASE) SEAM((base) + 2);
    LAYER(0, 2)
    LAYER(1, 5)
}
#ifndef MK_N_LAUNCHES
#define MK_N_LAUNCHES 1
#endif
extern "C" void kernel_launch(void* const* d_in, const int* in_sizes, int n_in, void* d_out, int out_size, void* d_ws, size_t ws_size, hipStream_t stream) {
    static int grid = 0;
    if (grid == 0) {
        if (n_in != 15 || out_size != MROWS * DM || ws_size < WS_END) { fprintf(stderr, "kernel_launch: unexpected problem (n_in %d out %d ws %zu)\n", n_in, out_size, ws_size); grid = -1; return; }
        int dev = 0, cus = 0, per_cu = 0;
        hipGetDevice(&dev); hipDeviceGetAttribute(&cus, hipDeviceAttributeMultiprocessorCount, dev);
        if (hipFuncSetAttribute((const void*)mega, hipFuncAttributeMaxDynamicSharedMemorySize, LDS_BYTES) != hipSuccess) { fprintf(stderr, "kernel_launch: hipFuncSetAttribute failed\n"); grid = -1; return; }
        if (hipOccupancyMaxActiveBlocksPerMultiprocessor(&per_cu, (const void*)mega, 512, LDS_BYTES) != hipSuccess || per_cu < 1) { fprintf(stderr, "kernel_launch: occupancy query failed (%d)\n", per_cu); per_cu = 1; }
        (void)hipGetLastError();
        grid = cus * per_cu;
        if (grid != 256) fprintf(stderr, "kernel_launch: grid %d (cus %d x %d) != 256: the fused out-projection epilogue needs exactly 256 workgroups\n", grid, cus, per_cu);
    }
    if (grid < 0) return;
    hipMemsetAsync((char*)d_ws + WS_CTL, 0, CTL_ZERO_BYTES, stream);
    Args a{};
    for (int i = 0; i < 15; ++i) a.in[i] = (const float*)d_in[i];
    a.out = (float*)d_out; a.ws = (unsigned char*)d_ws;
#if MK_N_LAUNCHES == 1
    a.ph_lo = 0; a.ph_hi = NPHASE;
    void* args[] = {&a};
    hipError_t e = hipLaunchCooperativeKernel((const void*)mega, dim3(grid), dim3(512), args, LDS_BYTES, stream);
    if (e != hipSuccess) fprintf(stderr, "cooperative launch failed: %s (grid %d)\n", hipGetErrorString(e), grid);
#else
    for (int ph = 0; ph < NPHASE; ++ph) { a.ph_lo = ph; a.ph_hi = ph + 1; hipLaunchKernelGGL(mega, dim3(grid), dim3(512), LDS_BYTES, stream, a); }
#endif
}
```

```cpp
#include <hip/hip_runtime.h>
#include <hip/hip_cooperative_groups.h>
#include <cstdio>
#include <cstdint>
#include <cmath>
namespace cg = cooperative_groups;
#define EPI_XD 3
#define EPI_ZD 8
#define HIST_WAVES 8
namespace pg8 {
#define PG8_LAS __attribute__((address_space(3)))
typedef unsigned short bf16_t;
typedef short bf16x8 __attribute__((ext_vector_type(8)));
typedef float f32x4 __attribute__((ext_vector_type(4)));
typedef unsigned u32x4 __attribute__((ext_vector_type(4)));
constexpr int BM = 256, BK = 64, HALF = 128, HTB = HALF * BK * 2  , STAGE_BYTES = 8 * HTB, NXCD = 8, WGM = 8;

__host__ __device__ __forceinline__ int lds_byte(int r, int c) { const int st = (r >> 4) * 2 + (c >> 5), rr = r & 15, cc = c & 31, ob = rr * 64 + cc * 2; return st * 1024 + (ob ^ (((ob >> 9) & 1) << 5)); }
__host__ __device__ __forceinline__ void stage_rc(int b, int& R, int& C) { const int st = b / 1024, sb = b % 1024, swz = sb ^ (((sb >> 9) & 1) << 5); R = (st >> 1) * 16 + swz / 64; C = (st & 1) * 32 + (swz % 64) / 2; }
__host__ __device__ __forceinline__ int perm32(int rho) { const int n = rho >> 4, i = rho & 15; return 8 * (i >> 2) + 4 * n + (i & 3); }

struct Unit { int pm, pn; };
struct Gemm { const bf16_t* A; const bf16_t* Bt; int M, N, K; };

struct StaticOrder {
    int nM, nN, nwg, G, c;
    __host__ __device__ void init(int M, int N, int G_, int c_) { nM = M / BM; nN = N / BM; nwg = nM * nN; G = G_; c = c_; }
    __host__ __device__ bool next(int i, Unit& u) const {
        const long L = (long)i * G + c; if (L >= nwg) return false;
        int wgid = (int)L; { const int q = nwg / NXCD, r = nwg % NXCD, xcd = wgid % NXCD, off = wgid / NXCD; wgid = (xcd < r ? xcd * (q + 1) : r * (q + 1) + (xcd - r) * q) + off; }
        const int nig = WGM * nN, gid = wgid / nig, fm = gid * WGM, gsz = (nM - fm) < WGM ? (nM - fm) : WGM;
        u.pm = fm + ((wgid % nig) % gsz); u.pn = (wgid % nig) / gsz; return true;
    }
    __device__ __forceinline__ void a_ready(const Unit&) const {}
    __device__ __forceinline__ void done(const Unit&) const {}
};

__device__ __forceinline__ unsigned cvt_pk_bf16(float lo, float hi) { unsigned r; asm volatile("v_cvt_pk_bf16_f32 %0, %1, %2" : "=v"(r) : "v"(lo), "v"(hi)); return r; }
typedef float f32x2 __attribute__((ext_vector_type(2)));
template <class Epi, class Sched, bool ALIGN_EPI = false, bool SP2 = false>
__device__ __forceinline__ void gemm_phase(PG8_LAS unsigned char* lds, const Gemm g, const Sched& S, const Epi& E) {
    const int tid = threadIdx.x, wid = __builtin_amdgcn_readfirstlane(tid >> 6), lane = tid & 63, wr = wid >> 2, wc = wid & 3, fr = lane & 15, fq = lane >> 4;
    const int K = g.K, nt = K / BK;
    unsigned voffA[2], voffB[2];
#pragma unroll
    for (int i = 0; i < 2; ++i) { int R, C; stage_rc(tid * 16 + i * 8192, R, C); const int Rb = Epi::PERM ? ((R & ~31) + perm32(R & 31)) : R;
        voffA[i] = (unsigned)(R * K + C) * 2u; voffB[i] = (unsigned)(Rb * K + C) * 2u; }
    const size_t kstep = (size_t)(BK * 2);
    const size_t hstep = (size_t)HALF * K * 2;
    const size_t tstep = 2 * hstep;
    const unsigned ldsw = (unsigned)wid * 1024u;
    const int aoff = lds_byte(wr * 64 + fr, fq * 8), boff = lds_byte(wc * 32 + fr, fq * 8);
#define PG8_SA(b, h) (((b) * 2 + (h)) * HTB)
#define PG8_SB(b, h) ((4 + (b) * 2 + (h)) * HTB)
#define PG8_STAGE(bufoff, gbase, voff) do { _Pragma("unroll") for (int _i = 0; _i < 2; ++_i) \
        __builtin_amdgcn_global_load_lds((const unsigned*)((const char*)(gbase) + (voff)[_i]), (PG8_LAS unsigned*)(lds + (bufoff) + ldsw + _i * 8192), 16, 0, 0); } while (0)
#define PG8_LDA(dst, b, h) do { _Pragma("unroll") for (int m = 0; m < 4; ++m) _Pragma("unroll") for (int k = 0; k < 2; ++k) dst[m][k] = *(const PG8_LAS bf16x8*)(lds + PG8_SA(b, h) + aoff + m * 2048 + k * 1024); } while (0)
#define PG8_LDB(dst, b, h) do { _Pragma("unroll") for (int n = 0; n < 2; ++n) _Pragma("unroll") for (int k = 0; k < 2; ++k) dst[n][k] = *(const PG8_LAS bf16x8*)(lds + PG8_SB(b, h) + boff + n * 2048 + k * 1024); } while (0)
#define PG8_MMA(ai, bj, At, Bt) do { __builtin_amdgcn_s_setprio(1); _Pragma("unroll") for (int m = 0; m < 4; ++m) _Pragma("unroll") for (int n = 0; n < 2; ++n) _Pragma("unroll") for (int k = 0; k < 2; ++k) \
        acc[ai][bj][m][n] = __builtin_amdgcn_mfma_f32_16x16x32_bf16(Bt[n][k], At[m][k], acc[ai][bj][m][n], 0, 0, 0); __builtin_amdgcn_s_setprio(0); } while (0)
#define PG8_WAIT_V(n) asm volatile("s_waitcnt vmcnt(" #n ")" ::: "memory")
#define PG8_WAIT_L(n) asm volatile("s_waitcnt lgkmcnt(" #n ")" ::: "memory")
#define PG8_BAR __builtin_amdgcn_s_barrier()
#define PG8_SCHED __builtin_amdgcn_sched_barrier(0)
    Unit cur, nxt; int ui = 0;
    if (!S.next(0, cur)) return;
    f32x4 acc[2][2][4][2];
#pragma unroll
    for (int a = 0; a < 2; ++a)
#pragma unroll
        for (int b = 0; b < 2; ++b)
#pragma unroll
            for (int m = 0; m < 4; ++m)
#pragma unroll
                for (int n = 0; n < 2; ++n) acc[a][b][m][n] = (f32x4){0.f, 0.f, 0.f, 0.f};
    bf16x8 At[4][2], B0[2][2], B1[2][2];
    const char* cA = (const char*)g.A + (size_t)cur.pm * tstep; const char* cB = (const char*)g.Bt + (size_t)cur.pn * tstep;
    S.a_ready(cur);
    if constexpr (SP2) {
        PG8_STAGE(PG8_SB(0, 0), cB, voffB); PG8_STAGE(PG8_SB(0, 1), cB + hstep, voffB); PG8_STAGE(PG8_SA(0, 0), cA, voffA); PG8_STAGE(PG8_SA(0, 1), cA + hstep, voffA);
        if (wr == 1) PG8_BAR;
        PG8_WAIT_V(2); PG8_BAR;
        PG8_STAGE(PG8_SB(1, 0), cB + kstep, voffB); PG8_STAGE(PG8_SA(1, 0), cA + kstep, voffA); PG8_STAGE(PG8_SB(1, 1), cB + hstep + kstep, voffB);
        PG8_WAIT_V(6); PG8_BAR;
    } else {
        PG8_STAGE(PG8_SB(0, 0), cB, voffB); PG8_STAGE(PG8_SA(0, 0), cA, voffA); PG8_STAGE(PG8_SB(0, 1), cB + hstep, voffB); PG8_STAGE(PG8_SA(0, 1), cA + hstep, voffA);
        if (wr == 1) PG8_BAR;
        PG8_WAIT_V(4); PG8_BAR;
        PG8_STAGE(PG8_SB(1, 0), cB + kstep, voffB); PG8_STAGE(PG8_SA(1, 0), cA + kstep, voffA); PG8_STAGE(PG8_SB(1, 1), cB + hstep + kstep, voffB);
        PG8_WAIT_V(6); PG8_BAR;
    }
    for (;;) {
        const bool has_next = S.next(ui + 1, nxt);
        const char* nA = has_next ? (const char*)g.A + (size_t)nxt.pm * tstep : cA; const char* nB = has_next ? (const char*)g.Bt + (size_t)nxt.pn * tstep : cB;
        for (int t = 0; t < nt; t += 2) {
            const bool last = (t == nt - 2);
            const char* a1 = cA + (size_t)(t + 1) * kstep;
            const char* a2 = last ? nA : cA + (size_t)(t + 2) * kstep; const char* b2 = last ? nB : cB + (size_t)(t + 2) * kstep;
            const char* a3 = a2 + kstep; const char* b3 = b2 + kstep;
            if (last && has_next) S.a_ready(nxt);
            if constexpr (SP2) {
            PG8_LDB(B0, 0, 0); PG8_LDB(B1, 0, 1); PG8_SCHED; PG8_LDA(At, 0, 0); PG8_STAGE(PG8_SA(1, 1), a1 + hstep, voffA);
            PG8_WAIT_V(8); PG8_WAIT_L(0); PG8_BAR; PG8_MMA(0, 0, At, B0); PG8_MMA(0, 1, At, B1); PG8_BAR; PG8_SCHED;
            PG8_LDA(At, 0, 1); PG8_STAGE(PG8_SB(0, 0), b2, voffB); PG8_STAGE(PG8_SB(0, 1), b2 + hstep, voffB); PG8_STAGE(PG8_SA(0, 0), a2, voffA);
            PG8_WAIT_V(8); PG8_WAIT_L(0); PG8_BAR; PG8_MMA(1, 0, At, B0); PG8_MMA(1, 1, At, B1); PG8_BAR; PG8_SCHED;
            PG8_LDB(B0, 1, 0); PG8_LDB(B1, 1, 1); PG8_SCHED; PG8_LDA(At, 1, 0); PG8_STAGE(PG8_SA(0, 1), a2 + hstep, voffA);
            PG8_WAIT_V(8); PG8_WAIT_L(0); PG8_BAR; PG8_MMA(0, 0, At, B0); PG8_MMA(0, 1, At, B1); PG8_BAR; PG8_SCHED;
            PG8_LDA(At, 1, 1); PG8_STAGE(PG8_SB(1, 0), b3, voffB); PG8_STAGE(PG8_SB(1, 1), b3 + hstep, voffB); PG8_STAGE(PG8_SA(1, 0), a3, voffA);
            PG8_WAIT_V(8); PG8_WAIT_L(0); PG8_BAR; PG8_MMA(1, 0, At, B0); PG8_MMA(1, 1, At, B1); PG8_BAR; PG8_SCHED;
            } else {
            PG8_LDB(B0, 0, 0); PG8_SCHED; PG8_LDA(At, 0, 0); PG8_STAGE(PG8_SA(1, 1), a1 + hstep, voffA);
            PG8_WAIT_L(8); PG8_BAR; PG8_WAIT_L(0); PG8_MMA(0, 0, At, B0); PG8_BAR; PG8_SCHED;
            PG8_LDB(B1, 0, 1); PG8_STAGE(PG8_SB(0, 0), b2, voffB);
            PG8_BAR; PG8_WAIT_L(0); PG8_MMA(0, 1, At, B1); PG8_BAR;
            PG8_LDA(At, 0, 1); PG8_STAGE(PG8_SA(0, 0), a2, voffA);
            PG8_BAR; PG8_WAIT_L(0); PG8_MMA(1, 0, At, B0); PG8_BAR; PG8_SCHED;
            PG8_STAGE(PG8_SB(0, 1), b2 + hstep, voffB);
            PG8_WAIT_V(6); PG8_BAR; PG8_MMA(1, 1, At, B1); PG8_BAR;
            PG8_LDB(B0, 1, 0); PG8_SCHED; PG8_LDA(At, 1, 0); PG8_STAGE(PG8_SA(0, 1), a2 + hstep, voffA);
            PG8_WAIT_L(8); PG8_BAR; PG8_WAIT_L(0); PG8_MMA(0, 0, At, B0); PG8_BAR; PG8_SCHED;
            PG8_LDB(B1, 1, 1); PG8_STAGE(PG8_SB(1, 0), b3, voffB);
            PG8_BAR; PG8_WAIT_L(0); PG8_MMA(0, 1, At, B1); PG8_BAR;
            PG8_LDA(At, 1, 1); PG8_STAGE(PG8_SA(1, 0), a3, voffA);
            PG8_BAR; PG8_WAIT_L(0); PG8_MMA(1, 0, At, B0); PG8_BAR; PG8_SCHED;
            PG8_STAGE(PG8_SB(1, 1), b3 + hstep, voffB);
            PG8_WAIT_V(6); PG8_BAR; PG8_MMA(1, 1, At, B1); PG8_BAR;
            }
        }
        if constexpr (ALIGN_EPI) { if (wr == 0) PG8_BAR; }
        if constexpr (!Epi::AFTER_DRAIN) { E(acc, cur, wr, wc, fr, fq); S.done(cur); }
        if (!has_next) break;
#pragma unroll
        for (int a = 0; a < 2; ++a)
#pragma unroll
            for (int b = 0; b < 2; ++b)
#pragma unroll
                for (int m = 0; m < 4; ++m)
#pragma unroll
                    for (int n = 0; n < 2; ++n) acc[a][b][m][n] = (f32x4){0.f, 0.f, 0.f, 0.f};
        cur = nxt; cA = nA; cB = nB; ++ui;
        if constexpr (ALIGN_EPI) { if (wr == 1) PG8_BAR; }
    }
    PG8_WAIT_V(0);
    if constexpr (!ALIGN_EPI) { if (wr == 0) PG8_BAR; }
    PG8_BAR;
    if constexpr (Epi::AFTER_DRAIN) { E.fused(acc, cur, wr, wc, fr, fq, lds, wid, lane); S.done(cur); }
#undef PG8_SA
#undef PG8_SB
#undef PG8_STAGE
#undef PG8_LDA
#undef PG8_LDB
#undef PG8_MMA
#undef PG8_WAIT_V
#undef PG8_WAIT_L
#undef PG8_BAR
#undef PG8_SCHED
}
}

#ifndef PG8_SP2
#define PG8_SP2 true
#endif
#ifndef PG8_ALIGN
#define PG8_ALIGN true
#endif
constexpr int BATCH = 8, SEQ = 2048, DM = 1024, MROWS = BATCH * SEQ, DEPTH = 2;
constexpr int D_RNN = 512, NHEAD = 8, HDIM = 64, D_INR = 2760, ZP = 2816, TOPK = 256;
constexpr int C_XR = 0, C_GR = 512, C_Q = 1024, C_K = 1536, C_V = 1600, C_GA = 1664, C_QI = 2176, C_KI = 2688, C_WI = 2752;
constexpr float EPS = 1e-6f;
constexpr float QSCALE = 0.125f * 1.4426950408889634f;
constexpr size_t MiB = 1u << 20;
constexpr size_t WS_CTL = 0, CTL_ZERO_BYTES = 1 * MiB;
constexpr size_t WS_MOD = 1 * MiB;
constexpr size_t WS_BIAS = 1 * MiB + 256 * 1024;
constexpr size_t WS_SSQ = 2 * MiB;
constexpr size_t WS_WTIN = 3 * MiB;
constexpr size_t WS_WTOUT = 14 * MiB;
constexpr size_t WS_A = 32 * MiB;
constexpr size_t WS_Z = 64 * MiB;
constexpr size_t WS_Y = 152 * MiB;
constexpr size_t WS_END = 184 * MiB;
constexpr int LDS_BYTES = 163840;
constexpr int MISC_OFF = 131072 + 8192;
constexpr int NPHASE = 8;
constexpr int CW_BAR = 4096, CW_PANEL = 16384;

#define LAS __attribute__((address_space(3)))
typedef unsigned short bf16;
typedef float f32x4 __attribute__((ext_vector_type(4)));
typedef unsigned u32x4 __attribute__((ext_vector_type(4)));
typedef unsigned u32x2 __attribute__((ext_vector_type(2)));
__device__ __forceinline__ float bf2f(bf16 v) { return __uint_as_float(((unsigned)v) << 16); }
__device__ __forceinline__ unsigned f2bf(float f) { unsigned u = __float_as_uint(f); return (u + 0x7fffu + ((u >> 16) & 1u)) >> 16; }
__device__ __forceinline__ unsigned pk2(float lo, float hi) { return f2bf(lo) | (f2bf(hi) << 16); }
__device__ __forceinline__ float wave_sum(float v) {
#pragma unroll
    for (int o = 1; o < 64; o <<= 1) v += __shfl_xor(v, o);
    return v;
}
__device__ __forceinline__ float wave_max(float v) {
#pragma unroll
    for (int o = 1; o < 64; o <<= 1) v = fmaxf(v, __shfl_xor(v, o));
    return v;
}
__device__ __forceinline__ int wave_sum_i(int v) {
#pragma unroll
    for (int o = 1; o < 64; o <<= 1) v += __shfl_xor(v, o);
    return v;
}
__device__ __forceinline__ float siluf(float v) { return v / (1.f + expf(-v)); }
__device__ __forceinline__ float sigmf(float v) { return 1.f / (1.f + expf(-v)); }

struct P {
    const float *x, *c, *norm_g, *ada_w, *ada_b, *w_in, *conv_w, *conv_b, *lru_wx, *lru_bx, *lru_wa, *lru_ba, *lru_a, *w_out, *final_g;
    float* out;
    float *mod, *bias, *ssq;
    bf16 *wt_in, *wt_out, *A, *Z, *Y;
    unsigned* ctl;
};

#ifndef EPI_ZD
#define EPI_ZD 2
#endif
struct EpiZ {
    static constexpr bool PERM = true, AFTER_DRAIN = false;
    bf16* Zp; const float* ssq; const float* bias;
    __device__ __forceinline__ void operator()(const pg8::f32x4 (&acc)[2][2][4][2], const pg8::Unit& u, int wr, int wc, int fr, int fq) const {
        const int row0 = u.pm * 256 + wr * 64 + fr, col0 = u.pn * 256 + wc * 32 + 8 * fq, b = u.pm >> 3;
        const float cs = (u.pn == 4 || u.pn == 5) ? QSCALE : 1.0f;
        f32x4 bv[2][2];
#pragma unroll
        for (int bj = 0; bj < 2; ++bj)
#pragma unroll
            for (int n = 0; n < 2; ++n) bv[bj][n] = *(const f32x4*)(bias + b * ZP + col0 + bj * 128 + 4 * n);
        f32x4 qq[EPI_ZD];
#pragma unroll
        for (int gi = 0; gi < EPI_ZD; ++gi) qq[gi] = *(const f32x4*)(ssq + (size_t)(row0 + (gi >> 2) * 128 + (gi & 3) * 16) * 4);
#pragma unroll
        for (int ai = 0; ai < 2; ++ai)
#pragma unroll
            for (int m = 0; m < 4; ++m) {
                const int r = row0 + ai * 128 + m * 16, gi = ai * 4 + m;
                const f32x4 q = qq[gi % EPI_ZD];
                if (gi + EPI_ZD < 8) qq[gi % EPI_ZD] = *(const f32x4*)(ssq + (size_t)(row0 + ((gi + EPI_ZD) >> 2) * 128 + ((gi + EPI_ZD) & 3) * 16) * 4);
                const float rstd = 1.0f / sqrtf(((q.x + q.y) + (q.z + q.w)) * (1.0f / 1024.0f) + EPS);
                bf16* rowp = Zp + (size_t)r * ZP + col0;
#pragma unroll
                for (int bj = 0; bj < 2; ++bj) {
                    const f32x4 v0 = (acc[ai][bj][m][0] * rstd + bv[bj][0]) * cs, v1 = (acc[ai][bj][m][1] * rstd + bv[bj][1]) * cs;
                    u32x4 w; w.x = pk2(v0[0], v0[1]); w.y = pk2(v0[2], v0[3]); w.z = pk2(v1[0], v1[1]); w.w = pk2(v1[2], v1[3]);
                    *(u32x4*)(rowp + bj * 128) = w;
                }
            }
    }
};
#ifndef EPI_XD
#define EPI_XD 4
#endif
struct EpiX {
    static constexpr bool PERM = true, AFTER_DRAIN = true;
    const float* xres; float* xout; bf16* Anext; const float* gate; const float* ng; const float* nscale; float* ssq;
    __device__ __forceinline__ void fused(pg8::f32x4 (&acc)[2][2][4][2], const pg8::Unit& u, int wr, int wc, int fr, int fq, LAS unsigned char* lds, int wid, int lane) const {
        const int b = u.pm >> 3, col0 = u.pn * 256 + wc * 32 + 8 * fq;
        LAS float* Pp = (LAS float*)lds;
        f32x4 gv[2][2], gs[2][2];
#pragma unroll
        for (int bj = 0; bj < 2; ++bj)
#pragma unroll
            for (int n = 0; n < 2; ++n) {
                gv[bj][n] = *(const f32x4*)(gate + b * 3072 + col0 + bj * 128 + 4 * n);
                if (Anext) { const f32x4 g = *(const f32x4*)(ng + col0 + bj * 128 + 4 * n), s = *(const f32x4*)(nscale + b * 3072 + col0 + bj * 128 + 4 * n); gs[bj][n] = g * (s + 1.0f); }
                else gs[bj][n] = (f32x4){0.f, 0.f, 0.f, 0.f};
            }
        f32x4 xq[EPI_XD][2][2];
#define EPIX_LOAD(gi) do { const size_t r_ = (size_t)u.pm * 256 + ((gi) >> 2) * 128 + wr * 64 + ((gi) & 3) * 16 + fr; \
        _Pragma("unroll") for (int bj = 0; bj < 2; ++bj) _Pragma("unroll") for (int n = 0; n < 2; ++n) xq[(gi) % EPI_XD][bj][n] = *(const f32x4*)(xres + r_ * DM + col0 + bj * 128 + 4 * n); } while (0)
#pragma unroll
        for (int gi = 0; gi < EPI_XD; ++gi) EPIX_LOAD(gi);
#pragma unroll
        for (int ai = 0; ai < 2; ++ai)
#pragma unroll
            for (int m = 0; m < 4; ++m) {
                const int rl = ai * 128 + wr * 64 + m * 16 + fr; const size_t r = (size_t)u.pm * 256 + rl;
                float s = 0.f;
                f32x4 xc[2][2];
#pragma unroll
                for (int bj = 0; bj < 2; ++bj)
#pragma unroll
                    for (int n = 0; n < 2; ++n) xc[bj][n] = xq[(ai * 4 + m) % EPI_XD][bj][n];
                if (ai * 4 + m + EPI_XD < 8) EPIX_LOAD(ai * 4 + m + EPI_XD);
#pragma unroll
                for (int bj = 0; bj < 2; ++bj) {
                    f32x4 x1[2];
#pragma unroll
                    for (int n = 0; n < 2; ++n) {
                        const f32x4 xr = xc[bj][n];
                        x1[n] = xr + gv[bj][n] * acc[ai][bj][m][n];
                        *(f32x4*)(xout + r * DM + col0 + bj * 128 + 4 * n) = x1[n];
                        s += (x1[n][0] * x1[n][0] + x1[n][1] * x1[n][1]) + (x1[n][2] * x1[n][2] + x1[n][3] * x1[n][3]);
                    }
                    if (Anext) { const f32x4 a0 = x1[0] * gs[bj][0], a1 = x1[1] * gs[bj][1];
                        u32x4 w; w.x = pk2(a0[0], a0[1]); w.y = pk2(a0[2], a0[3]); w.z = pk2(a1[0], a1[1]); w.w = pk2(a1[2], a1[3]);
                        *(u32x4*)(Anext + r * DM + col0 + bj * 128) = w; }
                }
                s += __shfl_xor(s, 16); s += __shfl_xor(s, 32);
                if (fq == 0) Pp[rl * 4 + wc] = s;
            }
        __syncthreads();
        const int tid = wid * 64 + lane;
        if (tid < 256) ssq[((size_t)u.pm * 256 + tid) * 4 + u.pn] = (Pp[tid * 4 + 0] + Pp[tid * 4 + 1]) + (Pp[tid * 4 + 2] + Pp[tid * 4 + 3]);
        __syncthreads();
    }
};

struct EpiXF {
    static constexpr bool PERM = true, AFTER_DRAIN = true;
    const float* xres; float* out; const float* gate; const float* fg; float* ssq; unsigned* cnt;
    __device__ __forceinline__ void fused(pg8::f32x4 (&acc)[2][2][4][2], const pg8::Unit& u, int wr, int wc, int fr, int fq, LAS unsigned char* lds, int wid, int lane) const {
        const int b = u.pm >> 3, col0 = u.pn * 256 + wc * 32 + 8 * fq, tid = wid * 64 + lane;
        LAS float* Pp = (LAS float*)lds;
        LAS float* Sr = (LAS float*)(lds + 4096);
        {
            f32x4 gv[2][2];
#pragma unroll
            for (int bj = 0; bj < 2; ++bj)
#pragma unroll
                for (int n = 0; n < 2; ++n) gv[bj][n] = *(const f32x4*)(gate + b * 3072 + col0 + bj * 128 + 4 * n);
#pragma unroll
            for (int ai = 0; ai < 2; ++ai)
#pragma unroll
                for (int m = 0; m < 4; ++m) {
                    const int rl = ai * 128 + wr * 64 + m * 16 + fr; const size_t r = (size_t)u.pm * 256 + rl;
                    float s = 0.f;
#pragma unroll
                    for (int bj = 0; bj < 2; ++bj)
#pragma unroll
                        for (int n = 0; n < 2; ++n) {
                            const f32x4 xr = *(const f32x4*)(xres + r * DM + col0 + bj * 128 + 4 * n);
                            const f32x4 x1 = xr + gv[bj][n] * acc[ai][bj][m][n];
                            acc[ai][bj][m][n] = x1;
                            s += (x1[0] * x1[0] + x1[1] * x1[1]) + (x1[2] * x1[2] + x1[3] * x1[3]);
                        }
                    s += __shfl_xor(s, 16); s += __shfl_xor(s, 32);
                    if (fq == 0) Pp[rl * 4 + wc] = s;
                }
        }
        __syncthreads();
        if (tid < 256) { const float tot = (Pp[tid * 4 + 0] + Pp[tid * 4 + 1]) + (Pp[tid * 4 + 2] + Pp[tid * 4 + 3]);
            __hip_atomic_store(ssq + ((size_t)u.pm * 256 + tid) * 4 + u.pn, tot, __ATOMIC_RELAXED, __HIP_MEMORY_SCOPE_AGENT); }
        asm volatile("s_waitcnt vmcnt(0)" ::: "memory");
        __syncthreads();
        if (tid == 0) {
            unsigned* c = cnt + 64 * u.pm;
            __hip_atomic_fetch_add(c, 1u, __ATOMIC_RELAXED, __HIP_MEMORY_SCOPE_AGENT);
            unsigned spins = 0u;
            while (__hip_atomic_load(c, __ATOMIC_RELAXED, __HIP_MEMORY_SCOPE_AGENT) < 4u) { __builtin_amdgcn_s_sleep(2); if (++spins > (1u << 22)) break; }
            __builtin_amdgcn_fence(__ATOMIC_ACQUIRE, "agent");
            asm volatile("s_waitcnt vmcnt(0)" ::: "memory");
        }
        __syncthreads();
        if (tid < 256) { const float* sp = ssq + ((size_t)u.pm * 256 + tid) * 4;
            const float q0 = __hip_atomic_load(sp + 0, __ATOMIC_RELAXED, __HIP_MEMORY_SCOPE_AGENT), q1 = __hip_atomic_load(sp + 1, __ATOMIC_RELAXED, __HIP_MEMORY_SCOPE_AGENT);
            const float q2 = __hip_atomic_load(sp + 2, __ATOMIC_RELAXED, __HIP_MEMORY_SCOPE_AGENT), q3 = __hip_atomic_load(sp + 3, __ATOMIC_RELAXED, __HIP_MEMORY_SCOPE_AGENT);
            Sr[tid] = 1.0f / sqrtf(((q0 + q1) + (q2 + q3)) * (1.0f / 1024.0f) + EPS); }
        __syncthreads();
        f32x4 fgv[2][2];
#pragma unroll
        for (int bj = 0; bj < 2; ++bj)
#pragma unroll
            for (int n = 0; n < 2; ++n) fgv[bj][n] = *(const f32x4*)(fg + col0 + bj * 128 + 4 * n);
#pragma unroll
        for (int ai = 0; ai < 2; ++ai)
#pragma unroll
            for (int m = 0; m < 4; ++m) {
                const int rl = ai * 128 + wr * 64 + m * 16 + fr; const size_t r = (size_t)u.pm * 256 + rl; const float rstd = Sr[rl];
#pragma unroll
                for (int bj = 0; bj < 2; ++bj)
#pragma unroll
                    for (int n = 0; n < 2; ++n) *(f32x4*)(out + r * DM + col0 + bj * 128 + 4 * n) = acc[ai][bj][m][n] * rstd * fgv[bj][n];
            }
        __syncthreads();
    }
};

#ifndef TRQ
#define TRQ 4
#endif
__device__ __forceinline__ void ph0_prologue(const P& p, LAS unsigned char* lds) {
    const int tid = threadIdx.x, lane = tid & 63, wave = tid >> 6, G = gridDim.x, wg = blockIdx.x;
    LAS float* fl = (LAS float*)lds;
    for (int u = wg; u < 96; u += G) {
        const int l = u / 48, j = (u % 48) * 64 + lane;
        for (int i = tid; i < 8192; i += 512) fl[i] = siluf(p.c[i]);
        __syncthreads();
        float acc[8];
#pragma unroll
        for (int b = 0; b < 8; ++b) acc[b] = 0.f;
        const float* w = p.ada_w + ((size_t)l * 1024 + wave * 128) * 3072 + j;
        for (int k = 0; k < 128; ++k) { const float wv = w[(size_t)k * 3072];
#pragma unroll
            for (int b = 0; b < 8; ++b) acc[b] += fl[b * 1024 + wave * 128 + k] * wv; }
#pragma unroll
        for (int b = 0; b < 8; ++b) fl[8192 + (wave * 8 + b) * 64 + lane] = acc[b];
        __syncthreads();
        { const int b = wave; float s = p.ada_b[l * 3072 + j];
#pragma unroll
          for (int w8 = 0; w8 < 8; ++w8) s += fl[8192 + (w8 * 8 + b) * 64 + lane];
          p.mod[(l * 8 + b) * 3072 + j] = s; }
        __syncthreads();
    }
#pragma unroll 1
    for (int u0 = wg; u0 < 1920; u0 += TRQ * G) {
        float v[TRQ][8]; bf16* dst[TRQ]; bool act[TRQ];
#pragma unroll
        for (int q = 0; q < TRQ; ++q) {
            const int u = u0 + q * G; act[q] = u < 1920; dst[q] = nullptr;
#pragma unroll
            for (int j = 0; j < 8; ++j) v[q][j] = 0.f;
            if (act[q]) {
                const float* W; bf16* WT; int N, kt, nt;
                if (u < 1408) { const int l = u / 704, r = u % 704; kt = r / 44; nt = r % 44; W = p.w_in + (size_t)l * 1024 * D_INR; N = D_INR; WT = p.wt_in + (size_t)l * ZP * 1024; }
                else { int r = u - 1408; const int l = r / 256; r %= 256; kt = r / 16; nt = r % 16; W = p.w_out + (size_t)l * 1024 * 1024; N = 1024; WT = p.wt_out + (size_t)l * 1024 * 1024; }
                const int n = nt * 64 + lane, k0 = kt * 64 + wave * 8;
                if (n < N) {
#pragma unroll
                    for (int j = 0; j < 8; ++j) v[q][j] = W[(size_t)(k0 + j) * N + n];
                }
                dst[q] = WT + (size_t)n * 1024 + k0;
            }
        }
#pragma unroll
        for (int q = 0; q < TRQ; ++q) if (act[q]) { u32x4 o; o.x = pk2(v[q][0], v[q][1]); o.y = pk2(v[q][2], v[q][3]); o.z = pk2(v[q][4], v[q][5]); o.w = pk2(v[q][6], v[q][7]); *(u32x4*)dst[q] = o; }
    }
}
__device__ __forceinline__ void ph1_prologue(const P& p, LAS unsigned char* lds) {
    const int tid = threadIdx.x, lane = tid & 63, wave = tid >> 6, G = gridDim.x, wg = blockIdx.x;
    LAS float* fl = (LAS float*)lds;
    for (int u = wg; u < 88; u += G) {
        const int l = u / 44, n = (u % 44) * 64 + lane;
        for (int i = tid; i < 8192; i += 512) fl[i] = p.mod[(l * 8 + (i >> 10)) * 3072 + (i & 1023)];
        __syncthreads();
        float acc[8];
#pragma unroll
        for (int b = 0; b < 8; ++b) acc[b] = 0.f;
        if (n < D_INR) { const float* w = p.w_in + ((size_t)l * 1024 + wave * 128) * D_INR + n;
            for (int k = 0; k < 128; ++k) { const float wv = w[(size_t)k * D_INR];
#pragma unroll
                for (int b = 0; b < 8; ++b) acc[b] += fl[b * 1024 + wave * 128 + k] * wv; } }
#pragma unroll
        for (int b = 0; b < 8; ++b) fl[8192 + (wave * 8 + b) * 64 + lane] = acc[b];
        __syncthreads();
        { const int b = wave; float s = 0.f;
#pragma unroll
          for (int w8 = 0; w8 < 8; ++w8) s += fl[8192 + (w8 * 8 + b) * 64 + lane];
          p.bias[(l * 8 + b) * ZP + n] = s; }
        __syncthreads();
    }
    {
        const int r0 = wg * 8 + wave, rstep = G * 8;
        f32x4 gq[4], xv[2][2][4], sv[2][2][4];
#pragma unroll
        for (int j = 0; j < 4; ++j) gq[j] = *(const f32x4*)(p.norm_g + (lane + 64 * j) * 4);
#define A0_LOAD(slot, pr) do { _Pragma("unroll") for (int h_ = 0; h_ < 2; ++h_) _Pragma("unroll") for (int j = 0; j < 4; ++j) { const int k_ = (lane + 64 * j) * 4, r_ = r0 + rstep * (2 * (pr) + h_); \
            xv[slot][h_][j] = *(const f32x4*)(p.x + (size_t)r_ * DM + k_); sv[slot][h_][j] = *(const f32x4*)(p.mod + (size_t)(r_ >> 11) * 3072 + 1024 + k_); } } while (0)
        A0_LOAD(0, 0);
#pragma unroll
        for (int pr = 0; pr < 4; ++pr) {
            if (pr + 1 < 4) A0_LOAD((pr + 1) & 1, pr + 1);
#pragma unroll
            for (int h = 0; h < 2; ++h) {
                const int r = r0 + rstep * (2 * pr + h); float s1 = 0.f;
#pragma unroll
                for (int j = 0; j < 4; ++j) { const int k = (lane + 64 * j) * 4; const f32x4 v = xv[pr & 1][h][j];
                    s1 += (v[0] * v[0] + v[1] * v[1]) + (v[2] * v[2] + v[3] * v[3]);
                    const f32x4 o1 = v * gq[j] * (sv[pr & 1][h][j] + 1.0f);
                    u32x2 w1; w1.x = pk2(o1[0], o1[1]); w1.y = pk2(o1[2], o1[3]);
                    *(u32x2*)(p.A + (size_t)r * DM + k) = w1; }
                s1 = wave_sum(s1);
                if (lane == 0) *(f32x4*)(p.ssq + (size_t)r * 4) = (f32x4){s1, 0.f, 0.f, 0.f};
            }
        }
#undef A0_LOAD
    }
}
__device__ __forceinline__ void ph_final(const P& p) {
    const int tid = threadIdx.x, lane = tid & 63, wave = tid >> 6, G = gridDim.x, wg = blockIdx.x;
    for (int r = wg * 8 + wave; r < MROWS; r += G * 8) {
        const f32x4 q = *(const f32x4*)(p.ssq + (size_t)r * 4);
        const float rstd = 1.0f / sqrtf(((q.x + q.y) + (q.z + q.w)) * (1.0f / 1024.0f) + EPS);
#pragma unroll
        for (int j = 0; j < 4; ++j) { const int k = (lane + 64 * j) * 4;
            const f32x4 v = *(const f32x4*)(p.out + (size_t)r * DM + k), g = *(const f32x4*)(p.final_g + k);
            *(f32x4*)(p.out + (size_t)r * DM + k) = v * rstd * g; }
    }
}
#define XB_TMO      128
#define XB_XCNT(j)  (256  + 64 * (j))
#define XB_XSUB(j)  (1280 + 64 * (j))
#define XB_XGEN(j)  (2304 + 64 * (j))
#define XB_TOP      3328
#define XB_TOPGEN   3392
#define XCD_BAR_WORDS 3456
#define XB_SPIN_CAP (1u << 18)

__device__ __forceinline__ unsigned xb_ld(unsigned* p)              { return __hip_atomic_load(p, __ATOMIC_RELAXED, __HIP_MEMORY_SCOPE_AGENT); }
__device__ __forceinline__ unsigned xb_add(unsigned* p, unsigned v) { return __hip_atomic_fetch_add(p, v, __ATOMIC_RELAXED, __HIP_MEMORY_SCOPE_AGENT); }
__device__ __forceinline__ unsigned xb_xcc_id() { return (unsigned)__builtin_amdgcn_s_getreg((3 << 11) | 20) & 0xFu; }
#define XB_SPIN(cond, bar) do { unsigned _sp = 0; while (cond) { __builtin_amdgcn_s_sleep(1); \
    if ((++_sp & 255u) == 0u) { if (xb_ld(&(bar)[XB_TMO])) break; if (_sp > XB_SPIN_CAP) { atomicAdd(&(bar)[XB_TMO], 1u); break; } } } } while (0)

struct XcdBarrier {
    unsigned* bar; unsigned x;
    volatile LAS unsigned* st;
};

__device__ __forceinline__ XcdBarrier xcd_barrier_post(unsigned* bar, volatile LAS unsigned* st) {
    XcdBarrier b; b.bar = bar; b.x = xb_xcc_id(); b.st = st;
    if (threadIdx.x == 0) (void)xb_add(&bar[XB_XCNT(b.x)], 1u);
    return b;
}
__device__ __forceinline__ void xcd_barrier_complete(unsigned* bar, unsigned x, unsigned& nloc, unsigned& nx) {
    const unsigned G = gridDim.x * gridDim.y * gridDim.z;
    unsigned sum, cnt, mine, sp = 0u;
    for (;;) {
        sum = 0u; cnt = 0u; mine = 0u;
#pragma unroll
        for (unsigned j = 0; j < 16; ++j) { const unsigned c = xb_ld(&bar[XB_XCNT(j)]); sum += c; cnt += (c > 0u) ? 1u : 0u; mine = (j == x) ? c : mine; }
        if (sum == G) break;
        __builtin_amdgcn_s_sleep(1);
        if ((++sp & 255u) == 0u) { if (xb_ld(&bar[XB_TMO])) break; if (sp > XB_SPIN_CAP) { atomicAdd(&bar[XB_TMO], 1u); break; } }
    }
    nloc = mine > 0u ? mine : 1u; nx = cnt > 0u ? cnt : 1u;
}

__device__ __forceinline__ void xcd_barrier(const XcdBarrier& b) {
    asm volatile("s_waitcnt vmcnt(0)" ::: "memory");
    __syncthreads();
    if (threadIdx.x == 0) {
        unsigned* bar = b.bar;
        __builtin_amdgcn_s_waitcnt(0);
        unsigned nloc = b.st[0], nx = b.st[1];
        if (nloc == 0u) { xcd_barrier_complete(bar, b.x, nloc, nx); b.st[0] = nloc; b.st[1] = nx; }
        const unsigned old = xb_add(&bar[XB_XSUB(b.x)], 1u);
        const unsigned gen = old / nloc;
        if (old + 1u == (gen + 1u) * nloc) {
            __builtin_amdgcn_fence(__ATOMIC_RELEASE, "agent");
            asm volatile("s_waitcnt vmcnt(0)" ::: "memory");
            const unsigned og = xb_add(&bar[XB_TOP], 1u);
            const unsigned tg = og / nx;
            if (og + 1u == (tg + 1u) * nx) xb_add(&bar[XB_TOPGEN], 1u);
            else XB_SPIN(xb_ld(&bar[XB_TOPGEN]) == tg, bar);
            __builtin_amdgcn_fence(__ATOMIC_ACQUIRE, "agent");
            xb_add(&bar[XB_XGEN(b.x)], 1u);
            asm volatile("s_waitcnt vmcnt(0)" ::: "memory");
        } else {
            XB_SPIN(xb_ld(&bar[XB_XGEN(b.x)]) == gen, bar);
            __builtin_amdgcn_fence(__ATOMIC_ACQUIRE, "agent");
            asm volatile("s_waitcnt vmcnt(0)" ::: "memory");
        }
    }
    __syncthreads();
}
__device__ __forceinline__ unsigned score_ukey(float s) { const unsigned u = __float_as_uint(s + 0.0f); return (u & 0x80000000u) ? ~u : (u | 0x80000000u); }
__device__ __forceinline__ void topk_threshold(const unsigned (&k)[32], unsigned& thr, unsigned& need) {
    unsigned prefix = 0u; bool exact = false;
    for (int bit = 31; bit >= 0; --bit) {
        const unsigned cand = prefix | (1u << bit);
        int c = 0;
#pragma unroll
        for (int i = 0; i < 32; ++i) c += (k[i] >= cand) ? 1 : 0;
        c = wave_sum_i(c);
        if (c >= TOPK) prefix = cand;
        if (c == TOPK) { exact = true; break; }
    }
    thr = prefix;
    if (exact) { need = 0xffffffffu; }
    else { int c = 0;
#pragma unroll
        for (int i = 0; i < 32; ++i) c += (k[i] > prefix) ? 1 : 0;
        c = wave_sum_i(c); need = (unsigned)(TOPK - c); }
}
#ifndef PROBE_VALU
#define PROBE_VALU 0
#endif
#ifndef RP_T3
#define RP_T3 1
#endif
#ifndef RP_T1
#define RP_T1 1
#endif
#ifndef RP_T2
#define RP_T2 1
#endif
#ifndef RP_I
#define RP_I 1
#endif
#ifndef RP_T
#define RP_T 1
#endif
#ifndef RP_V
#define RP_V 1
#endif
typedef short bf16x8v __attribute__((ext_vector_type(8)));
typedef short s16x4v __attribute__((ext_vector_type(4)));
constexpr int BMS = 65;
constexpr int SCP = 2052;
constexpr int DSA_BM_OFF = 16 * SCP * 4;
constexpr int DSA_RING_OFF = 0;
constexpr int DSA_QIB_OFF = 147456;
constexpr int DSA_WIB_OFF = 135680;
constexpr int DSA_MLUT_OFF = 143616;
__device__ __forceinline__ void glds16(const void* gsrc, unsigned lds_dst) { unsigned keep;
    asm volatile("s_mov_b32 %0, m0\n\ts_mov_b32 m0, %2\n\ts_nop 0\n\tglobal_load_lds_dwordx4 %1, off\n\ts_mov_b32 m0, %0" : "=&s"(keep) : "v"(gsrc), "s"(lds_dst) : "memory"); }
template <int I> __device__ __forceinline__ unsigned mbit_t(int mw) { unsigned r; asm("v_bfe_i32 %0, %1, %2, 1" : "=v"(r) : "v"(mw), "i"(I)); return r; }
#define mbit(mw, i) mbit_t<(i)>(mw)
__device__ __forceinline__ float relu_i(float x) { return __int_as_float(max(__float_as_int(x), 0)); }
__device__ __forceinline__ int imax3(float a, float b, float c) { return max(max(__float_as_int(a), __float_as_int(b)), __float_as_int(c)); }
__device__ __forceinline__ s16x4v lds_tr16(LAS const unsigned char* p) { return __builtin_bit_cast(s16x4v, __builtin_amdgcn_ds_read_tr16_b64_v4i16((LAS s16x4v*)p)); }
__device__ __forceinline__ unsigned cvtpk(float lo, float hi) { typedef float f2 __attribute__((ext_vector_type(2))); typedef __bf16 b2 __attribute__((ext_vector_type(2))); f2 v = {lo, hi}; b2 r = __builtin_convertvector(v, b2); return __builtin_bit_cast(unsigned, r); }


template <int L> __device__ __forceinline__ void wr2lanes(int& w, unsigned lo, unsigned hi) {
    asm volatile("s_nop 1\n\tv_writelane_b32 %0, %1, %3\n\tv_writelane_b32 %0, %2, %4" : "+v"(w) : "s"(lo), "s"(hi), "i"(L), "i"(L + 1));
}
__device__ __forceinline__ int wave_sum_dpp(int v) {
    v += __builtin_amdgcn_update_dpp(0, v, 0xB1, 0xf, 0xf, true);
    v += __builtin_amdgcn_update_dpp(0, v, 0x4E, 0xf, 0xf, true);
    v += __builtin_amdgcn_update_dpp(0, v, 0x141, 0xf, 0xf, true);
    v += __builtin_amdgcn_update_dpp(0, v, 0x140, 0xf, 0xf, true);
    return __builtin_amdgcn_readlane(v, 0) + __builtin_amdgcn_readlane(v, 16) + __builtin_amdgcn_readlane(v, 32) + __builtin_amdgcn_readlane(v, 48);
}
__device__ __forceinline__ unsigned wave_max_dpp(unsigned v) {
    v = max(v, (unsigned)__builtin_amdgcn_update_dpp(0, (int)v, 0xB1, 0xf, 0xf, true));
    v = max(v, (unsigned)__builtin_amdgcn_update_dpp(0, (int)v, 0x4E, 0xf, 0xf, true));
    v = max(v, (unsigned)__builtin_amdgcn_update_dpp(0, (int)v, 0x141, 0xf, 0xf, true));
    v = max(v, (unsigned)__builtin_amdgcn_update_dpp(0, (int)v, 0x140, 0xf, 0xf, true));
    return max(max((unsigned)__builtin_amdgcn_readlane((int)v, 0), (unsigned)__builtin_amdgcn_readlane((int)v, 16)), max((unsigned)__builtin_amdgcn_readlane((int)v, 32), (unsigned)__builtin_amdgcn_readlane((int)v, 48)));
}
__device__ __forceinline__ int cnt8(int acc, unsigned cand, unsigned k0, unsigned k1, unsigned k2, unsigned k3, unsigned k4, unsigned k5, unsigned k6, unsigned k7) {
    unsigned long long m0, m1, m2, m3, m4, m5, m6, m7;
    asm volatile("v_cmp_le_u32_e64 %1, %9, %10\n\tv_cmp_le_u32_e64 %2, %9, %11\n\tv_cmp_le_u32_e64 %3, %9, %12\n\tv_cmp_le_u32_e64 %4, %9, %13\n\t"
                 "v_cmp_le_u32_e64 %5, %9, %14\n\tv_cmp_le_u32_e64 %6, %9, %15\n\tv_cmp_le_u32_e64 %7, %9, %16\n\tv_cmp_le_u32_e64 %8, %9, %17\n\t"
                 "v_addc_co_u32_e64 %0, %1, 0, %0, %1\n\tv_addc_co_u32_e64 %0, %2, 0, %0, %2\n\tv_addc_co_u32_e64 %0, %3, 0, %0, %3\n\tv_addc_co_u32_e64 %0, %4, 0, %0, %4\n\t"
                 "v_addc_co_u32_e64 %0, %5, 0, %0, %5\n\tv_addc_co_u32_e64 %0, %6, 0, %0, %6\n\tv_addc_co_u32_e64 %0, %7, 0, %0, %7\n\tv_addc_co_u32_e64 %0, %8, 0, %0, %8"
                 : "+v"(acc), "=&s"(m0), "=&s"(m1), "=&s"(m2), "=&s"(m3), "=&s"(m4), "=&s"(m5), "=&s"(m6), "=&s"(m7)
                 : "s"(cand), "v"(k0), "v"(k1), "v"(k2), "v"(k3), "v"(k4), "v"(k5), "v"(k6), "v"(k7));
    return acc;
}
__device__ __forceinline__ int count_ge(const unsigned (&k)[32], unsigned cand_, int nb) {
    const unsigned cand = (unsigned)__builtin_amdgcn_readfirstlane((int)cand_);
    int c = 0;
    c = cnt8(c, cand, k[0], k[1], k[2], k[3], k[4], k[5], k[6], k[7]);
    if (nb > 1) c = cnt8(c, cand, k[8], k[9], k[10], k[11], k[12], k[13], k[14], k[15]);
    if (nb > 2) c = cnt8(c, cand, k[16], k[17], k[18], k[19], k[20], k[21], k[22], k[23]);
    if (nb > 3) c = cnt8(c, cand, k[24], k[25], k[26], k[27], k[28], k[29], k[30], k[31]);
    return wave_sum_dpp(c);
}
__device__ __forceinline__ int wave_scan_dpp(int v) {
    v += __builtin_amdgcn_update_dpp(0, v, 0x111, 0xf, 0xf, false);
    v += __builtin_amdgcn_update_dpp(0, v, 0x112, 0xf, 0xf, false);
    v += __builtin_amdgcn_update_dpp(0, v, 0x114, 0xf, 0xf, false);
    v += __builtin_amdgcn_update_dpp(0, v, 0x118, 0xf, 0xf, false);
    v += __builtin_amdgcn_update_dpp(0, v, 0x142, 0xa, 0xf, false);
    v += __builtin_amdgcn_update_dpp(0, v, 0x143, 0xc, 0xf, false);
    return v;
}
#ifndef HIST_WAVES
#define HIST_WAVES 4
#endif
struct TopkState { unsigned prefix; int bit; bool done; unsigned need; int nb; LAS unsigned* hist; int crej; };
__device__ __forceinline__ void topk_hist(const unsigned (&k)[32], TopkState& st, int c_above) {
    const int lane = threadIdx.x & 63;
    const unsigned T = (unsigned)__builtin_amdgcn_readfirstlane((int)st.prefix);
    LAS unsigned* hist = st.hist;
    *(LAS u32x4*)(hist + 4 * lane) = (u32x4){0u, 0u, 0u, 0u};
    asm volatile("" ::: "memory");
    const unsigned hb_ = (unsigned)(uintptr_t)hist; const unsigned one = 1u;
#define HF8(i0) { unsigned t0_; unsigned long long ex_; \
        asm volatile("s_mov_b64 %1, exec\n\t" \
            "v_subrev_u32_e32 %0, %2, %5\n\tv_lshrrev_b32_e32 %0, 15, %0\n\tv_cmpx_gt_u32_e32 vcc, 0x100, %0\n\tv_lshl_add_u32 %0, %0, 2, %3\n\tds_add_u32 %0, %4\n\ts_mov_b64 exec, %1\n\t" \
            "v_subrev_u32_e32 %0, %2, %6\n\tv_lshrrev_b32_e32 %0, 15, %0\n\tv_cmpx_gt_u32_e32 vcc, 0x100, %0\n\tv_lshl_add_u32 %0, %0, 2, %3\n\tds_add_u32 %0, %4\n\ts_mov_b64 exec, %1\n\t" \
            "v_subrev_u32_e32 %0, %2, %7\n\tv_lshrrev_b32_e32 %0, 15, %0\n\tv_cmpx_gt_u32_e32 vcc, 0x100, %0\n\tv_lshl_add_u32 %0, %0, 2, %3\n\tds_add_u32 %0, %4\n\ts_mov_b64 exec, %1\n\t" \
            "v_subrev_u32_e32 %0, %2, %8\n\tv_lshrrev_b32_e32 %0, 15, %0\n\tv_cmpx_gt_u32_e32 vcc, 0x100, %0\n\tv_lshl_add_u32 %0, %0, 2, %3\n\tds_add_u32 %0, %4\n\ts_mov_b64 exec, %1\n\t" \
            "v_subrev_u32_e32 %0, %2, %9\n\tv_lshrrev_b32_e32 %0, 15, %0\n\tv_cmpx_gt_u32_e32 vcc, 0x100, %0\n\tv_lshl_add_u32 %0, %0, 2, %3\n\tds_add_u32 %0, %4\n\ts_mov_b64 exec, %1\n\t" \
            "v_subrev_u32_e32 %0, %2, %10\n\tv_lshrrev_b32_e32 %0, 15, %0\n\tv_cmpx_gt_u32_e32 vcc, 0x100, %0\n\tv_lshl_add_u32 %0, %0, 2, %3\n\tds_add_u32 %0, %4\n\ts_mov_b64 exec, %1\n\t" \
            "v_subrev_u32_e32 %0, %2, %11\n\tv_lshrrev_b32_e32 %0, 15, %0\n\tv_cmpx_gt_u32_e32 vcc, 0x100, %0\n\tv_lshl_add_u32 %0, %0, 2, %3\n\tds_add_u32 %0, %4\n\ts_mov_b64 exec, %1\n\t" \
            "v_subrev_u32_e32 %0, %2, %12\n\tv_lshrrev_b32_e32 %0, 15, %0\n\tv_cmpx_gt_u32_e32 vcc, 0x100, %0\n\tv_lshl_add_u32 %0, %0, 2, %3\n\tds_add_u32 %0, %4\n\ts_mov_b64 exec, %1" \
            : "=&v"(t0_), "=&s"(ex_) : "s"(T), "s"(hb_), "v"(one), "v"(k[i0]), "v"(k[i0 + 1]), "v"(k[i0 + 2]), "v"(k[i0 + 3]), "v"(k[i0 + 4]), "v"(k[i0 + 5]), "v"(k[i0 + 6]), "v"(k[i0 + 7]) : "vcc", "memory"); }
    HF8(0)
    if (st.nb > 1) HF8(8)
    if (st.nb > 2) HF8(16)
    if (st.nb > 3) HF8(24)
#undef HF8
    asm volatile("" ::: "memory");
    const u32x4 w = *(LAS const u32x4*)(hist + 4 * (63 - lane));
    const int t = (int)((w.x + w.y) + (w.z + w.w));
    const int P = wave_scan_dpp(t);
    const int k1 = TOPK - c_above;
    const unsigned long long bal = __ballot(P >= k1);
    const int Ls = __builtin_ctzll(bal);
    int c = __builtin_amdgcn_readlane(P, Ls) - __builtin_amdgcn_readlane(t, Ls);
    const int h3 = __builtin_amdgcn_readlane((int)w.w, Ls), h2 = __builtin_amdgcn_readlane((int)w.z, Ls), h1 = __builtin_amdgcn_readlane((int)w.y, Ls), h0 = __builtin_amdgcn_readlane((int)w.x, Ls);
    int bsel = 3, hb = h3;
    if (c + h3 < k1) { c += h3; bsel = 2; hb = h2; if (c + h2 < k1) { c += h2; bsel = 1; hb = h1; if (c + h1 < k1) { c += h1; bsel = 0; hb = h0; } } }
    const unsigned bin = (unsigned)(4 * (63 - Ls) + bsel);
    st.prefix = T | (bin << 15); st.bit = 14;
    if (c + hb == k1) { st.done = true; st.need = 0xffffffffu; }
}
__device__ __forceinline__ void topk_init(const unsigned (&k)[32], TopkState& st) {
    unsigned mx = 0u;
#pragma unroll
    for (int i = 0; i < 32; ++i) mx = max(mx, k[i]);
    mx = wave_max_dpp(mx);
    st.prefix = 0u; st.bit = 31; st.done = false; st.need = 0u; st.crej = 0;
    unsigned E = mx >> 23;
    int cprev = 0;
#pragma unroll 1
    for (int j = 0; j < 4; ++j) {
        if (E < (unsigned)j + 1u) break;
        const unsigned T = (E - (unsigned)j) << 23;
        const int c = count_ge(k, T, st.nb);
        if (c >= TOPK) { st.prefix = T; st.bit = 22; if (c == TOPK) { st.done = true; st.need = 0xffffffffu; }
#ifndef NO_TOPK_HIST
#ifdef PROBE_HIST2
            else if (st.hist) { TopkState sv = st; topk_hist(k, st, cprev); asm volatile("" :: "s"(st.prefix) : "memory"); st = sv; topk_hist(k, st, cprev); }
#else
            else if (st.hist) topk_hist(k, st, cprev);
#endif
#endif
            break; }
        cprev = c;
    }
}
__device__ __forceinline__ void topk_step(const unsigned (&k)[32], TopkState& st) {
    if (st.done) return;
    if (st.bit < 0) { int c = 0;
#pragma unroll
        for (int i = 0; i < 32; ++i) c += (k[i] > st.prefix) ? 1 : 0;
        c = wave_sum_dpp(c); st.need = (unsigned)(TOPK - c); st.done = true; return; }
    const unsigned cand = st.prefix | (1u << st.bit);
    const int c = count_ge(k, cand, st.nb);
    if (c >= TOPK) st.prefix = cand; else st.crej = c;
    if (c == TOPK) { st.done = true; st.need = 0xffffffffu; }
    --st.bit;
#ifndef NO_TOPK_HIST
    if (st.bit == 22 && !st.done && st.hist) topk_hist(k, st, st.crej);
#endif
}

__device__ __forceinline__ void dsa_prefetch_qi(const bf16* zb, int qt, LAS unsigned char* lds, int wave, int lane) {
    const unsigned lds_base = (unsigned)(uintptr_t)lds;
#pragma unroll
    for (int i = 0; i < 2; ++i) { const int row = 2 * wave + i;
        glds16(zb + (size_t)(qt * 16 + row) * ZP + C_QI + ((lane ^ row) * 8), (unsigned)__builtin_amdgcn_readfirstlane(lds_base + DSA_QIB_OFF + row * 1024)); }
    if (wave == 0) glds16(zb + (size_t)(qt * 16 + (lane & 15)) * ZP + C_WI, (unsigned)__builtin_amdgcn_readfirstlane(lds_base + DSA_WIB_OFF));
}

__device__ __forceinline__ void dsa_prefetch_ki(const bf16* zb, int qt, bf16x8v (&pk)[4], int wave, int lane) {
    const int r16 = lane & 15, g = lane >> 4;
    if (wave <= qt) { const bf16* krow = zb + (size_t)(wave * 16 + r16) * ZP + C_KI; pk[0] = *(const bf16x8v*)(krow + 8 * g); pk[1] = *(const bf16x8v*)(krow + 32 + 8 * g); }
    if (wave + 8 <= qt) { const bf16* krow = zb + (size_t)((wave + 8) * 16 + r16) * ZP + C_KI; pk[2] = *(const bf16x8v*)(krow + 8 * g); pk[3] = *(const bf16x8v*)(krow + 32 + 8 * g); }
}

__device__ __forceinline__ void dsa_unit(const P& p, int b, int qt, int qt_next, bf16x8v (&pk)[4], LAS unsigned char* lds) {
    const int tid = threadIdx.x, lane = tid & 63, wave = __builtin_amdgcn_readfirstlane(tid >> 6), r16 = lane & 15, g = lane >> 4;
    const int q0 = qt * 16; const bf16* zb = p.Z + (size_t)b * SEQ * ZP;
    LAS float* SC = (LAS float*)lds; LAS unsigned* BM = (LAS unsigned*)(lds + DSA_BM_OFF);
    const bool dense_all = (qt < TOPK / 16);
    const bf16* qrow = zb + (size_t)(q0 + r16) * ZP;
    const bf16x8v bq0 = *(const bf16x8v*)(qrow + C_Q + wave * 64 + 8 * g), bq1 = *(const bf16x8v*)(qrow + C_Q + wave * 64 + 32 + 8 * g);
    u32x2 gwv[4];
#pragma unroll
    for (int dt = 0; dt < 4; ++dt) gwv[dt] = *(const u32x2*)(qrow + C_GA + wave * 64 + dt * 16 + 4 * g);
    const int nsteps = (((q0 + 16 + 31) >> 5) + 1) & ~1, nmega = (nsteps + 7) >> 3;
    const int kkey = lane >> 3, vkey = lane >> 1, vhalf = lane & 1;
    const unsigned lds_base = (unsigned)(uintptr_t)lds;
#define DSA_STAGE(mm) do { const int st_ = (mm) * 8 + wave; if (st_ < nsteps) { \
        const bf16* kb_ = zb + (size_t)st_ * 32 * ZP; const unsigned ldsb_ = lds_base + (unsigned)(((mm) & 1) * 65536 + wave * 4096); \
        _Pragma("unroll") for (int c_ = 0; c_ < 4; ++c_) { const int key_ = 8 * c_ + kkey, ch_ = (lane & 7) ^ ((key_ & 15) >> 1); \
            glds16(kb_ + (size_t)key_ * ZP + C_K + ch_ * 8, (unsigned)__builtin_amdgcn_readfirstlane(ldsb_ + c_ * 1024)); } \
        _Pragma("unroll") for (int c_ = 0; c_ < 4; ++c_) \
            glds16(kb_ + (size_t)vkey * ZP + C_V + c_ * 16 + vhalf * 8, (unsigned)__builtin_amdgcn_readfirstlane(ldsb_ + 32768 + c_ * 1024)); } } while (0)
    if (!dense_all) {
        for (int rpI = 0; rpI < RP_I; ++rpI) {
        bf16x8v bq[8][2]; float wv[8];
#pragma unroll
        for (int h = 0; h < 8; ++h) { bq[h][0] = *(LAS const bf16x8v*)(lds + DSA_QIB_OFF + r16 * 1024 + (((8 * h + g) ^ r16) * 16)); bq[h][1] = *(LAS const bf16x8v*)(lds + DSA_QIB_OFF + r16 * 1024 + (((8 * h + 4 + g) ^ r16) * 16));
            wv[h] = bf2f(*(LAS const bf16*)(lds + DSA_WIB_OFF + r16 * 16 + h * 2)) * 0.35355339059327373f * 0.125f; }
        bf16x8v ra0 = pk[0], ra1 = pk[1], rb0 = pk[2], rb1 = pk[3], rc0 = pk[0], rc1 = pk[1];
#define IDX_LOAD(d0, d1, ktl) do { const int ktl_ = (ktl) <= qt ? (ktl) : qt;        \
            const bf16* krow_ = zb + (size_t)(ktl_ * 16 + r16) * ZP + C_KI; d0 = *(const bf16x8v*)(krow_ + 8 * g); d1 = *(const bf16x8v*)(krow_ + 32 + 8 * g); } while (0)
#define IDX_STEP(c0, c1) do { \
            f32x4 sc = {0.f, 0.f, 0.f, 0.f}; \
            _Pragma("unroll") for (int h = 0; h < 8; ++h) { \
                f32x4 acc = {0.f, 0.f, 0.f, 0.f}; \
                acc = __builtin_amdgcn_mfma_f32_16x16x32_bf16(c0, bq[h][0], acc, 0, 0, 0); \
                acc = __builtin_amdgcn_mfma_f32_16x16x32_bf16(c1, bq[h][1], acc, 0, 0, 0); \
                _Pragma("unroll") for (int i = 0; i < 4; ++i) sc[i] += relu_i(acc[i]) * wv[h]; \
            } \
            if (__builtin_amdgcn_readfirstlane(kt) == qt) {                  \
                _Pragma("unroll") for (int i = 0; i < 4; ++i) sc[i] = (4 * g + i > r16) ? -INFINITY : sc[i]; \
            } \
            *(LAS f32x4*)(SC + r16 * SCP + kt * 16 + 4 * g) = sc; } while (0)
        int kt = wave;
        const int nst = (qt - wave + 8) >> 3;
        const int ntrip = (nst * 11) >> 5, rem = nst - 3 * ntrip;
#pragma unroll 1
        for (int it = ntrip; it > 0; --it) {
            IDX_LOAD(rc0, rc1, kt + 16); __builtin_amdgcn_sched_barrier(0); IDX_STEP(ra0, ra1); __builtin_amdgcn_sched_barrier(0); kt += 8;
            IDX_LOAD(ra0, ra1, kt + 16); __builtin_amdgcn_sched_barrier(0); IDX_STEP(rb0, rb1); __builtin_amdgcn_sched_barrier(0); kt += 8;
            IDX_LOAD(rb0, rb1, kt + 16); __builtin_amdgcn_sched_barrier(0); IDX_STEP(rc0, rc1); __builtin_amdgcn_sched_barrier(0); kt += 8;
        }
        if (rem >= 1) { IDX_STEP(ra0, ra1); kt += 8; if (rem >= 2) { IDX_STEP(rb0, rb1); } }
#undef IDX_LOAD
#undef IDX_STEP
        __syncthreads();
        }
#pragma unroll 1
        for (int rpT = 0; rpT < RP_T; ++rpT) {
            const int ra = 2 * wave, rb = 2 * wave + 1, ta = q0 + ra, tb = q0 + rb;
            unsigned ka[32], kb[32];
#pragma unroll
            for (int i = 0; i < 32; ++i) { const int key = lane + 64 * i; ka[i] = (key <= ta) ? score_ukey(SC[ra * SCP + key]) : 0u; kb[i] = (key <= tb) ? score_ukey(SC[rb * SCP + key]) : 0u; }
#if RP_T1 > 1
            asm volatile("" :: "v"(ka[0]), "v"(kb[31]) : "memory");
#pragma unroll
            for (int i = 0; i < 32; ++i) { const int key = lane + 64 * i; ka[i] = (key <= ta) ? score_ukey(SC[ra * SCP + key]) : 0u; kb[i] = (key <= tb) ? score_ukey(SC[rb * SCP + key]) : 0u; }
            asm volatile("" ::: "memory");
#endif
            asm volatile("s_waitcnt lgkmcnt(0)" ::: "memory");
            __syncthreads();
            DSA_STAGE(0);
            TopkState sa, sb; sa.nb = (ta >> 9) + 1; sb.nb = (tb >> 9) + 1;
            sa.hist = (wave < HIST_WAVES) ? (LAS unsigned*)(lds + 65536 + ra * 1280) : (LAS unsigned*)nullptr; sb.hist = (wave < HIST_WAVES) ? (LAS unsigned*)(lds + 65536 + rb * 1280) : (LAS unsigned*)nullptr;
            topk_init(ka, sa); topk_init(kb, sb);
#pragma unroll 1
            while (!(sa.done && sb.done)) { topk_step(ka, sa); topk_step(kb, sb); }
#if RP_T2 > 1
            asm volatile("" :: "v"(sa.prefix), "v"(sb.prefix));
            topk_init(ka, sa); topk_init(kb, sb);
#pragma unroll 1
            while (!(sa.done && sb.done)) { topk_step(ka, sa); topk_step(kb, sb); }
#endif
            if (sa.need == 0xffffffffu && sb.need == 0xffffffffu) {
                const unsigned ta_ = (unsigned)__builtin_amdgcn_readfirstlane((int)sa.prefix), tb_ = (unsigned)__builtin_amdgcn_readfirstlane((int)sb.prefix);
                int wa = 0, wb = 0;
#define WR2(i) { const unsigned long long ma = __ballot(ka[i] >= ta_), mb = __ballot(kb[i] >= tb_); wr2lanes<2 * (i)>(wa, (unsigned)ma, (unsigned)(ma >> 32)); wr2lanes<2 * (i)>(wb, (unsigned)mb, (unsigned)(mb >> 32)); }
                WR2(0) WR2(1) WR2(2) WR2(3) WR2(4) WR2(5) WR2(6) WR2(7) WR2(8) WR2(9) WR2(10) WR2(11) WR2(12) WR2(13) WR2(14) WR2(15)
                WR2(16) WR2(17) WR2(18) WR2(19) WR2(20) WR2(21) WR2(22) WR2(23) WR2(24) WR2(25) WR2(26) WR2(27) WR2(28) WR2(29) WR2(30) WR2(31)
#undef WR2
                BM[ra * BMS + lane] = (unsigned)wa; BM[rb * BMS + lane] = (unsigned)wb;
#if RP_T3 > 1
                asm volatile("" : "+v"(wa), "+v"(wb) :: "memory");
#define WR2(i) { const unsigned long long ma = __ballot(ka[i] >= ta_), mb = __ballot(kb[i] >= tb_); wr2lanes<2 * (i)>(wa, (unsigned)ma, (unsigned)(ma >> 32)); wr2lanes<2 * (i)>(wb, (unsigned)mb, (unsigned)(mb >> 32)); }
                WR2(0) WR2(1) WR2(2) WR2(3) WR2(4) WR2(5) WR2(6) WR2(7) WR2(8) WR2(9) WR2(10) WR2(11) WR2(12) WR2(13) WR2(14) WR2(15)
                WR2(16) WR2(17) WR2(18) WR2(19) WR2(20) WR2(21) WR2(22) WR2(23) WR2(24) WR2(25) WR2(26) WR2(27) WR2(28) WR2(29) WR2(30) WR2(31)
#undef WR2
                BM[ra * BMS + lane] = (unsigned)wa; BM[rb * BMS + lane] = (unsigned)wb;
#endif
            } else {
            unsigned eqa = 0u, eqb = 0u;
#pragma unroll 1
            for (int i = 0; i < 32; ++i) {
                unsigned kai = ka[0], kbi = kb[0];
#pragma unroll
                for (int j = 1; j < 32; ++j) { kai = (i == j) ? ka[j] : kai; kbi = (i == j) ? kb[j] : kbi; }
                { const bool eq = (kai == sa.prefix); const unsigned long long em = __ballot(eq);
                  const unsigned erank = eqa + __builtin_amdgcn_mbcnt_hi((unsigned)(em >> 32), __builtin_amdgcn_mbcnt_lo((unsigned)em, 0u));
                  const unsigned long long smk = __ballot((kai > sa.prefix) || (eq && erank < sa.need));
                  if (lane == 0) { BM[ra * BMS + 2 * i] = (unsigned)smk; BM[ra * BMS + 2 * i + 1] = (unsigned)(smk >> 32); }
                  eqa += (unsigned)__popcll(em); }
                { const bool eq = (kbi == sb.prefix); const unsigned long long em = __ballot(eq);
                  const unsigned erank = eqb + __builtin_amdgcn_mbcnt_hi((unsigned)(em >> 32), __builtin_amdgcn_mbcnt_lo((unsigned)em, 0u));
                  const unsigned long long smk = __ballot((kbi > sb.prefix) || (eq && erank < sb.need));
                  if (lane == 0) { BM[rb * BMS + 2 * i] = (unsigned)smk; BM[rb * BMS + 2 * i + 1] = (unsigned)(smk >> 32); }
                  eqb += (unsigned)__popcll(em); }
            }
            }
        }
    } else {
        for (int i = tid; i < 1024; i += 512) { const int row = i >> 6, w = i & 63, t = q0 + row, lo = 32 * w;
            BM[row * BMS + w] = (t >= lo + 31) ? 0xffffffffu : ((t < lo) ? 0u : ((2u << (t - lo)) - 1u)); }
        DSA_STAGE(0);
    }
    __syncthreads();
    const int h = wave;
#pragma unroll 1
    for (int rpV = 0; rpV < RP_V; ++rpV) {
    asm volatile("s_waitcnt vmcnt(0)" ::: "memory");
    asm volatile("" :: "v"(bq0), "v"(bq1), "v"(gwv[0]), "v"(gwv[1]), "v"(gwv[2]), "v"(gwv[3]));
    __syncthreads();
    if (qt_next >= TOPK / 16) { dsa_prefetch_qi(zb, qt_next, lds, wave, lane); dsa_prefetch_ki(zb, qt_next, pk, wave, lane); }
    f32x4 o[4], lacc = {0.f, 0.f, 0.f, 0.f}, negm = {0.f, 0.f, 0.f, 0.f};
#pragma unroll
    for (int dt = 0; dt < 4; ++dt) o[dt] = (f32x4){0.f, 0.f, 0.f, 0.f};
    float m_run = 0.f;
    const int kofs0 = r16 * 128 + ((g ^ (r16 >> 1)) & 7) * 16, kofs1 = r16 * 128 + (((4 + g) ^ (r16 >> 1)) & 7) * 16;
    const int vofs = 32768 + (4 * g + ((lane & 15) >> 2)) * 32 + (lane & 3) * 8;
    bf16x8v ones = {0x3f80, 0x3f80, 0x3f80, 0x3f80, 0x3f80, 0x3f80, 0x3f80, 0x3f80};
    asm volatile("" : "+v"(ones));
    LAS const unsigned char* mlut = lds + DSA_MLUT_OFF;
    constexpr float THR = 8.0f;
    bool first = true;
#pragma unroll 1
    for (int mm = 0; mm < nmega; ++mm) {
        if (mm + 1 < nmega) DSA_STAGE(mm + 1);
        LAS unsigned char* slotb = lds + (mm & 1) * 65536;
        const int nsub = (nsteps - mm * 8) < 8 ? (nsteps - mm * 8) : 8;
#pragma unroll 1
        for (int u = 0; u < nsub; u += 2) {
            LAS unsigned char* slot = slotb + u * 4096;
            const int mwA = (int)(BM[r16 * BMS + mm * 8 + u] >> (4 * g)), mwB = (int)(BM[r16 * BMS + mm * 8 + u + 1] >> (4 * g));
            f32x4 s0, s1, s2, s3;
            { const bf16x8v ka0 = *(LAS const bf16x8v*)(slot + kofs0), ka1 = *(LAS const bf16x8v*)(slot + kofs1);
              const bf16x8v kb0 = *(LAS const bf16x8v*)(slot + 2048 + kofs0), kb1 = *(LAS const bf16x8v*)(slot + 2048 + kofs1);
              const bf16x8v kc0 = *(LAS const bf16x8v*)(slot + 4096 + kofs0), kc1 = *(LAS const bf16x8v*)(slot + 4096 + kofs1);
              const bf16x8v kd0 = *(LAS const bf16x8v*)(slot + 6144 + kofs0), kd1 = *(LAS const bf16x8v*)(slot + 6144 + kofs1);
              s0 = __builtin_amdgcn_mfma_f32_16x16x32_bf16(ka0, bq0, negm, 0, 0, 0); s1 = __builtin_amdgcn_mfma_f32_16x16x32_bf16(kb0, bq0, negm, 0, 0, 0);
              s2 = __builtin_amdgcn_mfma_f32_16x16x32_bf16(kc0, bq0, negm, 0, 0, 0); s3 = __builtin_amdgcn_mfma_f32_16x16x32_bf16(kd0, bq0, negm, 0, 0, 0);
              s0 = __builtin_amdgcn_mfma_f32_16x16x32_bf16(ka1, bq1, s0, 0, 0, 0); s1 = __builtin_amdgcn_mfma_f32_16x16x32_bf16(kb1, bq1, s1, 0, 0, 0);
              s2 = __builtin_amdgcn_mfma_f32_16x16x32_bf16(kc1, bq1, s2, 0, 0, 0); s3 = __builtin_amdgcn_mfma_f32_16x16x32_bf16(kd1, bq1, s3, 0, 0, 0); }
            const int lmi = max(max(max(imax3(s0[0], s0[1], s0[2]), imax3(s0[3], s1[0], s1[1])), max(imax3(s1[2], s1[3], s2[0]), imax3(s2[1], s2[2], s2[3]))), max(imax3(s3[0], s3[1], s3[2]), __float_as_int(s3[3])));
            if (first || __any(lmi > 0x41000000)) {
                float lmx = fmaxf(fmaxf(fmaxf(fmaxf(s0[0], s0[1]), fmaxf(s0[2], s0[3])), fmaxf(fmaxf(s1[0], s1[1]), fmaxf(s1[2], s1[3]))), fmaxf(fmaxf(fmaxf(s2[0], s2[1]), fmaxf(s2[2], s2[3])), fmaxf(fmaxf(s3[0], s3[1]), fmaxf(s3[2], s3[3]))));
                { const auto r1 = __builtin_amdgcn_permlane16_swap(__float_as_uint(lmx), __float_as_uint(lmx), false, false); lmx = fmaxf(__uint_as_float(r1[0]), __uint_as_float(r1[1])); }
                { const auto r2 = __builtin_amdgcn_permlane32_swap(__float_as_uint(lmx), __float_as_uint(lmx), false, false); lmx = fmaxf(__uint_as_float(r2[0]), __uint_as_float(r2[1])); }
                const float dl = first ? lmx : fmaxf(lmx, 0.f);
                m_run += dl; const float f = first ? 1.0f : __builtin_amdgcn_exp2f(-dl);
#pragma unroll
                for (int i = 0; i < 4; ++i) { s0[i] -= dl; s1[i] -= dl; s2[i] -= dl; s3[i] -= dl; negm[i] = -m_run; }
                lacc = lacc * f;
#pragma unroll
                for (int dt = 0; dt < 4; ++dt) o[dt] = o[dt] * f;
                first = false;
            }
            const u32x2 mk0 = *(LAS const u32x2*)(mlut + ((mwA & 15) << 3)), mk1 = *(LAS const u32x2*)(mlut + (((mwA >> 16) & 15) << 3));
            const u32x2 mk2 = *(LAS const u32x2*)(mlut + ((mwB & 15) << 3)), mk3 = *(LAS const u32x2*)(mlut + (((mwB >> 16) & 15) << 3));
            u32x4 pwA, pwB;
            pwA.x = cvtpk(__builtin_amdgcn_exp2f(s0[0]), __builtin_amdgcn_exp2f(s0[1])) & mk0.x; pwA.y = cvtpk(__builtin_amdgcn_exp2f(s0[2]), __builtin_amdgcn_exp2f(s0[3])) & mk0.y;
            pwA.z = cvtpk(__builtin_amdgcn_exp2f(s1[0]), __builtin_amdgcn_exp2f(s1[1])) & mk1.x; pwA.w = cvtpk(__builtin_amdgcn_exp2f(s1[2]), __builtin_amdgcn_exp2f(s1[3])) & mk1.y;
            pwB.x = cvtpk(__builtin_amdgcn_exp2f(s2[0]), __builtin_amdgcn_exp2f(s2[1])) & mk2.x; pwB.y = cvtpk(__builtin_amdgcn_exp2f(s2[2]), __builtin_amdgcn_exp2f(s2[3])) & mk2.y;
            pwB.z = cvtpk(__builtin_amdgcn_exp2f(s3[0]), __builtin_amdgcn_exp2f(s3[1])) & mk3.x; pwB.w = cvtpk(__builtin_amdgcn_exp2f(s3[2]), __builtin_amdgcn_exp2f(s3[3])) & mk3.y;
            const bf16x8v pfA = __builtin_bit_cast(bf16x8v, pwA), pfB = __builtin_bit_cast(bf16x8v, pwB);
            lacc = __builtin_amdgcn_mfma_f32_16x16x32_bf16(ones, pfA, lacc, 0, 0, 0);
            lacc = __builtin_amdgcn_mfma_f32_16x16x32_bf16(ones, pfB, lacc, 0, 0, 0);
#pragma unroll
            for (int dt = 0; dt < 4; ++dt) {
                const s16x4v lo = lds_tr16(slot + vofs + dt * 1024), hi = lds_tr16(slot + vofs + dt * 1024 + 512);
                const s16x4v lo2 = lds_tr16(slot + 4096 + vofs + dt * 1024), hi2 = lds_tr16(slot + 4096 + vofs + dt * 1024 + 512);
                const bf16x8v vf = {lo[0], lo[1], lo[2], lo[3], hi[0], hi[1], hi[2], hi[3]};
                const bf16x8v vf2 = {lo2[0], lo2[1], lo2[2], lo2[3], hi2[0], hi2[1], hi2[2], hi2[3]};
                o[dt] = __builtin_amdgcn_mfma_f32_16x16x32_bf16(vf, pfA, o[dt], 0, 0, 0);
                o[dt] = __builtin_amdgcn_mfma_f32_16x16x32_bf16(vf2, pfB, o[dt], 0, 0, 0);
            }
        }
        asm volatile("s_waitcnt vmcnt(0) lgkmcnt(0)" ::: "memory");
        __syncthreads();
    }
#undef DSA_STAGE
    const float inv = 1.0f / lacc[0];
    bf16* yrow = p.Y + ((size_t)b * SEQ + q0 + r16) * DM + 512 + h * 64;
#pragma unroll
    for (int dt = 0; dt < 4; ++dt) {
        const u32x2 gw = gwv[dt];
        const float g0 = __uint_as_float(gw.x << 16), g1 = __uint_as_float(gw.x & 0xffff0000u), g2 = __uint_as_float(gw.y << 16), g3 = __uint_as_float(gw.y & 0xffff0000u);
        u32x2 w; w.x = pk2(o[dt][0] * inv * siluf(g0), o[dt][1] * inv * siluf(g1)); w.y = pk2(o[dt][2] * inv * siluf(g2), o[dt][3] * inv * siluf(g3));
        *(u32x2*)(yrow + dt * 16 + 4 * g) = w;
    }
    __syncthreads();
    }
}
__device__ __forceinline__ int dsa_qt_of(int j, int i) { return (i == 0) ? 127 - j : (i == 1) ? 64 + j : (i == 2) ? 63 - j : j; }
__device__ __forceinline__ void dsa_phase_pre(const P& p, LAS unsigned char* lds) {
    const int G = gridDim.x, wg = blockIdx.x, lane = threadIdx.x & 63, wave = __builtin_amdgcn_readfirstlane(threadIdx.x >> 6);
    const int b = (G == 256) ? (wg & 7) : (wg >> 7), qt = (G == 256) ? dsa_qt_of(wg >> 3, 0) : 127 - (wg & 127);
    if (wg < 1024 && qt >= TOPK / 16) dsa_prefetch_qi(p.Z + (size_t)b * SEQ * ZP, qt, lds, wave, lane);
}
__device__ __forceinline__ void dsa_phase(const P& p, LAS unsigned char* lds) {
    const int G = gridDim.x, wg = blockIdx.x;
    if (G == 256) {
        const int b = wg & 7, j = wg >> 3, lane = threadIdx.x & 63, wave = __builtin_amdgcn_readfirstlane(threadIdx.x >> 6);
        bf16x8v pk[4] = {{0, 0, 0, 0, 0, 0, 0, 0}, {0, 0, 0, 0, 0, 0, 0, 0}, {0, 0, 0, 0, 0, 0, 0, 0}, {0, 0, 0, 0, 0, 0, 0, 0}};
        if (dsa_qt_of(j, 0) >= TOPK / 16) dsa_prefetch_ki(p.Z + (size_t)b * SEQ * ZP, dsa_qt_of(j, 0), pk, wave, lane);
#pragma unroll 1
        for (int i = 0; i < 4; ++i) dsa_unit(p, b, dsa_qt_of(j, i), (i < 3) ? dsa_qt_of(j, i + 1) : -1, pk, lds);
    }
}
constexpr int LRU_WS_OFF = 139264;
constexpr int LRU_XB = 264 * 128;
constexpr int LRU_GB = 256 * 32;
constexpr int LRU_BUF = LRU_XB + LRU_GB;
__device__ __forceinline__ float fast_sigm(float x) { return __builtin_amdgcn_rcpf(1.0f + __expf(-x)); }
__device__ __forceinline__ void lru_unit(const P& p, int l, int b, int blk, int q4, LAS unsigned char* lds) {
    const int tid = threadIdx.x, lane = tid & 63, wave = __builtin_amdgcn_readfirstlane(tid >> 6), r16 = lane & 15, g = lane >> 4;
    const bf16* zb = p.Z + (size_t)b * SEQ * ZP;
    const int cA = blk * 64, dloc = q4 * 16 + r16, dg = blk * 64 + dloc;
    const unsigned lds_base = (unsigned)(uintptr_t)lds;
#define LRU_STAGE(r) do { const unsigned bb_ = lds_base + (unsigned)(((r) & 1) * LRU_BUF); \
        _Pragma("unroll") for (int i_ = 0; i_ < 5; ++i_) { const int pc_ = wave + 8 * i_; if (pc_ < 33) { const int rho_ = pc_ * 8 + (lane >> 3); int t_ = (r) * 256 - 3 + rho_; t_ = t_ < 0 ? 0 : (t_ > SEQ - 1 ? SEQ - 1 : t_); \
            const int ch_ = (lane & 7) ^ ((rho_ >> 1) & 7); glds16(zb + (size_t)t_ * ZP + C_XR + cA + ch_ * 8, (unsigned)__builtin_amdgcn_readfirstlane(bb_ + pc_ * 1024)); } } \
        { const int row_ = wave * 32 + (lane >> 1); glds16(zb + (size_t)((r) * 256 + row_) * ZP + C_GR + dg - r16 + (lane & 1) * 8, (unsigned)__builtin_amdgcn_readfirstlane(bb_ + LRU_XB + wave * 1024)); } } while (0)
    LRU_STAGE(0);
    float cwA[2][4][8], cbA[2][8];
#pragma unroll
    for (int s = 0; s < 2; ++s)
#pragma unroll
        for (int j = 0; j < 8; ++j) { const int c = cA + 32 * s + 8 * g + j; cbA[s][j] = p.conv_b[l * 512 + c];
#pragma unroll
            for (int k = 0; k < 4; ++k) cwA[s][k][j] = p.conv_w[(l * 4 + k) * 512 + c]; }
    bf16x8v bxf[2], baf[2];
#pragma unroll
    for (int s = 0; s < 2; ++s) { u32x4 wx, wa; unsigned tx[8], ta[8];
#pragma unroll
        for (int j = 0; j < 8; ++j) { const size_t idx = (((size_t)l * 8 + blk) * 64 + 32 * s + 8 * g + j) * 64 + dloc; tx[j] = f2bf(p.lru_wx[idx]); ta[j] = f2bf(p.lru_wa[idx]); }
        wx.x = tx[0] | (tx[1] << 16); wx.y = tx[2] | (tx[3] << 16); wx.z = tx[4] | (tx[5] << 16); wx.w = tx[6] | (tx[7] << 16);
        wa.x = ta[0] | (ta[1] << 16); wa.y = ta[2] | (ta[3] << 16); wa.z = ta[4] | (ta[5] << 16); wa.w = ta[6] | (ta[7] << 16);
        bxf[s] = __builtin_bit_cast(bf16x8v, wx); baf[s] = __builtin_bit_cast(bf16x8v, wa); }
    const float cw0 = p.conv_w[(l * 4 + 0) * 512 + dg], cw1 = p.conv_w[(l * 4 + 1) * 512 + dg], cw2 = p.conv_w[(l * 4 + 2) * 512 + dg], cw3 = p.conv_w[(l * 4 + 3) * 512 + dg];
    const float cb = p.conv_b[l * 512 + dg], bxv = p.lru_bx[l * 512 + dg], bav = p.lru_ba[l * 512 + dg];
    const float sp8 = -8.0f * log1pf(expf(-p.lru_a[l * 512 + dg]));
    asm volatile("" :: "v"(cwA[0][0][0]), "v"(cwA[1][3][7]), "v"(cbA[1][7]), "v"(bxf[0]), "v"(bxf[1]), "v"(baf[0]), "v"(baf[1]), "v"(cw0), "v"(cw1), "v"(cw2), "v"(cw3), "v"(cb), "v"(bxv), "v"(bav), "v"(sp8));
    LAS float* WS = (LAS float*)(lds + LRU_WS_OFF);
    float hrun = 0.f;
    asm volatile("s_waitcnt vmcnt(0)" ::: "memory");
#pragma unroll 1
    for (int round = 0; round < 8; ++round) {
        asm volatile("s_waitcnt vmcnt(8)" ::: "memory");
        __syncthreads();
        if (round + 1 < 8) LRU_STAGE(round + 1);
        LAS const unsigned char* xb = lds + (round & 1) * LRU_BUF; LAS const unsigned char* gb = xb + LRU_XB;
        const int tw = round * 256 + wave * 32;
        float hl[2][4], pl[2][4], gr4[2][4], PT[2], HT[2], PE[2], HE[2];
#pragma unroll
        for (int tau = 0; tau < 2; ++tau) {
            const int t0 = tw + 16 * tau, rho0 = wave * 32 + 16 * tau;
            bf16x8v af[2];
#pragma unroll
            for (int s = 0; s < 2; ++s) {
                float xc[8];
#pragma unroll
                for (int j = 0; j < 8; ++j) xc[j] = cbA[s][j];
#pragma unroll
                for (int k = 0; k < 4; ++k) { const int rho = rho0 + r16 + k; u32x4 w = *(LAS const u32x4*)(xb + rho * 128 + (((4 * s + g) ^ (rho >> 1)) & 7) * 16);
                    if (t0 + r16 - 3 + k < 0) w = (u32x4){0u, 0u, 0u, 0u};
                    xc[0] += cwA[s][k][0] * __uint_as_float(w.x << 16); xc[1] += cwA[s][k][1] * __uint_as_float(w.x & 0xffff0000u);
                    xc[2] += cwA[s][k][2] * __uint_as_float(w.y << 16); xc[3] += cwA[s][k][3] * __uint_as_float(w.y & 0xffff0000u);
                    xc[4] += cwA[s][k][4] * __uint_as_float(w.z << 16); xc[5] += cwA[s][k][5] * __uint_as_float(w.z & 0xffff0000u);
                    xc[6] += cwA[s][k][6] * __uint_as_float(w.w << 16); xc[7] += cwA[s][k][7] * __uint_as_float(w.w & 0xffff0000u); }
                u32x4 pw; pw.x = cvtpk(xc[0], xc[1]); pw.y = cvtpk(xc[2], xc[3]); pw.z = cvtpk(xc[4], xc[5]); pw.w = cvtpk(xc[6], xc[7]);
                af[s] = __builtin_bit_cast(bf16x8v, pw);
            }
            f32x4 gx = {0.f, 0.f, 0.f, 0.f}, ga = {0.f, 0.f, 0.f, 0.f};
            gx = __builtin_amdgcn_mfma_f32_16x16x32_bf16(af[0], bxf[0], gx, 0, 0, 0); gx = __builtin_amdgcn_mfma_f32_16x16x32_bf16(af[1], bxf[1], gx, 0, 0, 0);
            ga = __builtin_amdgcn_mfma_f32_16x16x32_bf16(af[0], baf[0], ga, 0, 0, 0); ga = __builtin_amdgcn_mfma_f32_16x16x32_bf16(af[1], baf[1], ga, 0, 0, 0);
            float xo[7];
#pragma unroll
            for (int m = 0; m < 7; ++m) { const int rho = rho0 + 4 * g + m;
                const unsigned short v = *(LAS const unsigned short*)(xb + rho * 128 + (((dloc >> 3) ^ (rho >> 1)) & 7) * 16 + (dloc & 7) * 2);
                xo[m] = (t0 + 4 * g - 3 + m >= 0) ? bf2f(v) : 0.f; }
            float Pr = 1.f, Hr = 0.f;
#pragma unroll
            for (int i = 0; i < 4; ++i) {
                const float xcv = cb + cw0 * xo[i] + cw1 * xo[i + 1] + cw2 * xo[i + 2] + cw3 * xo[i + 3];
                const float sx = fast_sigm(gx[i] + bxv), sa = fast_sigm(ga[i] + bav);
                const float la = sp8 * sa, a = __expf(la), y2 = 2.0f * la;
                const float ser = -y2 * (1.0f + y2 * (0.5f + y2 * (0.16666667f + y2 * (0.041666668f + y2 * (0.0083333338f + y2 * 0.0013888889f)))));
                const float em = (y2 > -0.25f) ? ser : (1.0f - __expf(y2));
                const float u = __builtin_amdgcn_sqrtf(em) * sx * xcv;
                Hr = a * Hr + u; Pr *= a; hl[tau][i] = Hr; pl[tau][i] = Pr;
                gr4[tau][i] = bf2f(*(LAS const unsigned short*)(gb + (rho0 + 4 * g + i) * 32 + r16 * 2));
            }
            float Pi = Pr, Hi = Hr;
            { const float Pl = __shfl_up(Pi, 16), Hl = __shfl_up(Hi, 16); if (g >= 1) { Hi = Pi * Hl + Hi; Pi = Pl * Pi; } }
            { const float Pl = __shfl_up(Pi, 32), Hl = __shfl_up(Hi, 32); if (g >= 2) { Hi = Pi * Hl + Hi; Pi = Pl * Pi; } }
            float Pe = __shfl_up(Pi, 16), He = __shfl_up(Hi, 16); if (g == 0) { Pe = 1.f; He = 0.f; }
            PT[tau] = __shfl(Pi, 48 + r16); HT[tau] = __shfl(Hi, 48 + r16); PE[tau] = Pe; HE[tau] = He;
        }
        HE[1] = PE[1] * HT[0] + HE[1]; PE[1] = PT[0] * PE[1];
        const float Pw = PT[0] * PT[1], Hw = PT[1] * HT[0] + HT[1];
        LAS float* wsr = WS + (round & 1) * 256;
        if (g == 0) { wsr[(wave * 16 + r16) * 2 + 0] = Pw; wsr[(wave * 16 + r16) * 2 + 1] = Hw; }
        asm volatile("s_waitcnt lgkmcnt(0)" ::: "memory");
        __builtin_amdgcn_s_barrier();
        asm volatile("" ::: "memory");
        float hc = hrun, hall = hrun;
#pragma unroll
        for (int w2 = 0; w2 < 8; ++w2) { if (w2 == wave) hc = hall; hall = wsr[(w2 * 16 + r16) * 2 + 0] * hall + wsr[(w2 * 16 + r16) * 2 + 1]; }
        hrun = hall;
#pragma unroll
        for (int tau = 0; tau < 2; ++tau) {
            const float hin = PE[tau] * hc + HE[tau];
            bf16* yp = p.Y + ((size_t)b * SEQ + tw + 16 * tau + 4 * g) * DM + dg;
#pragma unroll
            for (int i = 0; i < 4; ++i) { const float h = hl[tau][i] + pl[tau][i] * hin, gr = gr4[tau][i]; yp[(size_t)i * DM] = (bf16)f2bf(h * gr * fast_sigm(gr)); }
        }
    }
#undef LRU_STAGE
    __syncthreads();
}
__device__ __forceinline__ void lru_phase(const P& p, int l, LAS unsigned char* lds) {
    const int G = gridDim.x, wg = blockIdx.x;
#pragma unroll 1
    for (int u = wg; u < 256; u += G) lru_unit(p, l, (u >> 3) & 7, u & 7, u >> 6, lds);
}
#ifndef DSA_PHASE
#define DSA_PHASE dsa_phase
#endif
#ifndef LRU_PHASE
#define LRU_PHASE lru_phase
#endif
#ifndef RP_A
#define RP_A 1
#endif
#ifndef RP_L
#define RP_L 1
#endif
#ifndef RP_D
#define RP_D 1
#endif
#ifndef RP_C
#define RP_C 1
#endif
#ifndef RP_0
#define RP_0 1
#endif
template <int OFF> __device__ __forceinline__ unsigned long long karg_u64() {
    unsigned long long v; const unsigned long long kp = (unsigned long long)__builtin_amdgcn_kernarg_segment_ptr();
    asm volatile("s_load_dwordx2 %0, %1, %2\n\ts_waitcnt lgkmcnt(0)" : "=s"(v) : "s"(kp), "i"(OFF) : "memory");
    return v;
}
struct Args { const float* in[15]; float* out; unsigned char* ws; int ph_lo, ph_hi; };
__global__ void __launch_bounds__(512, 2) mega(Args a) {
    extern __shared__ __attribute__((aligned(16))) unsigned char lds_raw[];
    LAS unsigned char* lds = (LAS unsigned char*)lds_raw;
#define KARG(T, off) ((T)(__attribute__((address_space(1))) void*)karg_u64<(off)>())
#define LOADP() P p; { unsigned char* ws_ = KARG(unsigned char*, 128); \
        p.x = KARG(const float*, 0); p.c = KARG(const float*, 8); p.norm_g = KARG(const float*, 16); p.ada_w = KARG(const float*, 24); p.ada_b = KARG(const float*, 32); p.w_in = KARG(const float*, 40); \
        p.conv_w = KARG(const float*, 48); p.conv_b = KARG(const float*, 56); p.lru_wx = KARG(const float*, 64); p.lru_bx = KARG(const float*, 72); p.lru_wa = KARG(const float*, 80); p.lru_ba = KARG(const float*, 88); \
        p.lru_a = KARG(const float*, 96); p.w_out = KARG(const float*, 104); p.final_g = KARG(const float*, 112); p.out = KARG(float*, 120); \
        p.ctl = (unsigned*)(ws_ + WS_CTL); p.mod = (float*)(ws_ + WS_MOD); p.bias = (float*)(ws_ + WS_BIAS); p.ssq = (float*)(ws_ + WS_SSQ); \
        p.wt_in = (bf16*)(ws_ + WS_WTIN); p.wt_out = (bf16*)(ws_ + WS_WTOUT); p.A = (bf16*)(ws_ + WS_A); p.Z = (bf16*)(ws_ + WS_Z); p.Y = (bf16*)(ws_ + WS_Y); }
    unsigned* const ctl0 = (unsigned*)((unsigned char*)a.ws + WS_CTL);
    const int lo = a.ph_lo, hi = a.ph_hi;
    volatile LAS unsigned* MISC = (volatile LAS unsigned*)(lds + MISC_OFF + 4096);
    if (threadIdx.x < 4) MISC[threadIdx.x] = 0u;
    if (threadIdx.x < 16) { const unsigned t = threadIdx.x; u32x2 m; m.x = ((t & 1u) ? 0xffffu : 0u) | ((t & 2u) ? 0xffff0000u : 0u); m.y = ((t & 4u) ? 0xffffu : 0u) | ((t & 8u) ? 0xffff0000u : 0u);
        *(LAS u32x2*)(lds + DSA_MLUT_OFF + t * 8) = m; }
    __syncthreads();
    XcdBarrier bar; bar.bar = ctl0 + CW_BAR; bar.x = 0; bar.st = MISC;
    if (hi - lo > 1) bar = xcd_barrier_post(ctl0 + CW_BAR, MISC);
#define IN(k) (lo <= (k) && (k) < hi)
#ifndef N_CG_SEAMS
#define N_CG_SEAMS 0
#endif
#define SEAM(k) do { if (IN(k) && IN((k) + 1)) { if ((k) < N_CG_SEAMS) cg::this_grid().sync(); else xcd_barrier(bar); } } while (0)
    if (IN(0)) { LOADP(); ph0_prologue(p, lds); if (RP_0 > 1) { __syncthreads(); ph0_prologue(p, lds); } }
    SEAM(0);
    if (IN(1)) { LOADP(); ph1_prologue(p, lds); if (RP_0 > 1) { __syncthreads(); ph1_prologue(p, lds); } }
    SEAM(1);
#define LAYER(l, base) \
    if (IN(base)) { LOADP(); \
        pg8::Gemm g{p.A, p.wt_in + (size_t)(l) * ZP * 1024, MROWS, ZP, DM}; pg8::StaticOrder S; S.init(MROWS, ZP, (int)gridDim.x, (int)blockIdx.x); \
        EpiZ E{p.Z, p.ssq, p.bias + (size_t)(l) * 8 * ZP}; \
        pg8::gemm_phase<EpiZ, pg8::StaticOrder, PG8_ALIGN, PG8_SP2>(lds, g, S, E); if (RP_A > 1) { __syncthreads(); pg8::gemm_phase<EpiZ, pg8::StaticOrder, PG8_ALIGN, PG8_SP2>(lds, g, S, E); } \
    } \
    SEAM(base); \
    if (IN((base) + 1)) { LOADP(); dsa_phase_pre(p, lds); LRU_PHASE(p, (l), lds); __syncthreads(); if (RP_L > 1) { LRU_PHASE(p, (l), lds); __syncthreads(); } DSA_PHASE(p, lds); if (RP_D > 1) { __syncthreads(); DSA_PHASE(p, lds); } } \
    SEAM((base) + 1); \
    if (IN((base) + 2)) { LOADP(); \
        pg8::Gemm g{p.Y, p.wt_out + (size_t)(l) * 1024 * 1024, MROWS, DM, DM}; pg8::StaticOrder S; S.init(MROWS, DM, (int)gridDim.x, (int)blockIdx.x); \
        if constexpr ((l) == DEPTH - 1) { \
            EpiXF E{p.out, p.out, p.mod + (size_t)(l) * 8 * 3072 + 2048, p.final_g, p.ssq, p.ctl + CW_PANEL}; \
            pg8::gemm_phase<EpiXF, pg8::StaticOrder, false, PG8_SP2>(lds, g, S, E); \
        } else { \
            EpiX E{(l) == 0 ? p.x : p.out, p.out, p.A, p.mod + (size_t)(l) * 8 * 3072 + 2048, p.norm_g + (size_t)((l) + 1) * 1024, p.mod + (size_t)((l) + 1) * 8 * 3072 + 1024, p.ssq}; \
            pg8::gemm_phase<EpiX, pg8::StaticOrder, false, PG8_SP2>(lds, g, S, E); if (RP_C > 1 && (l) == 0) { __syncthreads(); pg8::gemm_phase<EpiX, pg8::StaticOrder, false, PG8_SP2>(lds, g, S, E); } \
        } \
    } \
    if ((base) + 3 < NPHASE) SEAM((base) + 2);
    LAYER(0, 2)
    LAYER(1, 5)
}
#ifndef MK_N_LAUNCHES
#define MK_N_LAUNCHES 1
#endif
extern "C" void kernel_launch(void* const* d_in, const int* in_sizes, int n_in, void* d_out, int out_size, void* d_ws, size_t ws_size, hipStream_t stream) {
    static int grid = 0;
    if (grid == 0) {
        if (n_in != 15 || out_size != MROWS * DM || ws_size < WS_END) { fprintf(stderr, "kernel_launch: unexpected problem (n_in %d out %d ws %zu)\n", n_in, out_size, ws_size); grid = -1; return; }
        int dev = 0, cus = 0, per_cu = 0;
        hipGetDevice(&dev); hipDeviceGetAttribute(&cus, hipDeviceAttributeMultiprocessorCount, dev);
        if (hipFuncSetAttribute((const void*)mega, hipFuncAttributeMaxDynamicSharedMemorySize, LDS_BYTES) != hipSuccess) { fprintf(stderr, "kernel_launch: hipFuncSetAttribute failed\n"); grid = -1; return; }
        if (hipOccupancyMaxActiveBlocksPerMultiprocessor(&per_cu, (const void*)mega, 512, LDS_BYTES) != hipSuccess || per_cu < 1) { fprintf(stderr, "kernel_launch: occupancy query failed (%d)\n", per_cu); per_cu = 1; }
        (void)hipGetLastError();
        grid = cus * per_cu;
        if (grid != 256) fprintf(stderr, "kernel_launch: grid %d (cus %d x %d) != 256: the fused out-projection epilogue needs exactly 256 workgroups\n", grid, cus, per_cu);
    }
    if (grid < 0) return;
    hipMemsetAsync((char*)d_ws + WS_CTL, 0, CTL_ZERO_BYTES, stream);
    Args a{};
    for (int i = 0; i < 15; ++i) a.in[i] = (const float*)d_in[i];
    a.out = (float*)d_out; a.ws = (unsigned char*)d_ws;
#if MK_N_LAUNCHES == 1
    a.ph_lo = 0; a.ph_hi = NPHASE;
    void* args[] = {&a};
    hipError_t e = hipLaunchCooperativeKernel((const void*)mega, dim3(grid), dim3(512), args, LDS_BYTES, stream);
    if (e != hipSuccess) fprintf(stderr, "cooperative launch failed: %s (grid %d)\n", hipGetErrorString(e), grid);
#else
    for (int ph = 0; ph < NPHASE; ++ph) { a.ph_lo = ph; a.ph_hi = ph + 1; hipLaunchKernelGGL(mega, dim3(grid), dim3(512), LDS_BYTES, stream, a); }
#endif
}
```

```cpp
#include <hip/hip_runtime.h>
#include <hip/hip_cooperative_groups.h>
#include <cstdio>
#include <cstdint>
#include <cmath>
namespace cg = cooperative_groups;
#define EPI_XD 3
#define EPI_ZD 8
#define HIST_WAVES 8
#define PRO_KC 64
namespace pg8 {
#define PG8_LAS __attribute__((address_space(3)))
typedef unsigned short bf16_t;
typedef short bf16x8 __attribute__((ext_vector_type(8)));
typedef float f32x4 __attribute__((ext_vector_type(4)));
typedef unsigned u32x4 __attribute__((ext_vector_type(4)));
constexpr int BM = 256, BK = 64, HALF = 128, HTB = HALF * BK * 2  , STAGE_BYTES = 8 * HTB, NXCD = 8, WGM = 8;

__host__ __device__ __forceinline__ int lds_byte(int r, int c) { const int st = (r >> 4) * 2 + (c >> 5), rr = r & 15, cc = c & 31, ob = rr * 64 + cc * 2; return st * 1024 + (ob ^ (((ob >> 9) & 1) << 5)); }
__host__ __device__ __forceinline__ void stage_rc(int b, int& R, int& C) { const int st = b / 1024, sb = b % 1024, swz = sb ^ (((sb >> 9) & 1) << 5); R = (st >> 1) * 16 + swz / 64; C = (st & 1) * 32 + (swz % 64) / 2; }
__host__ __device__ __forceinline__ int perm32(int rho) { const int n = rho >> 4, i = rho & 15; return 8 * (i >> 2) + 4 * n + (i & 3); }

struct Unit { int pm, pn; };
struct Gemm { const bf16_t* A; const bf16_t* Bt; int M, N, K; };

struct StaticOrder {
    int nM, nN, nwg, G, c;
    __host__ __device__ void init(int M, int N, int G_, int c_) { nM = M / BM; nN = N / BM; nwg = nM * nN; G = G_; c = c_; }
    __host__ __device__ bool next(int i, Unit& u) const {
        const long L = (long)i * G + c; if (L >= nwg) return false;
        int wgid = (int)L; { const int q = nwg / NXCD, r = nwg % NXCD, xcd = wgid % NXCD, off = wgid / NXCD; wgid = (xcd < r ? xcd * (q + 1) : r * (q + 1) + (xcd - r) * q) + off; }
        const int nig = WGM * nN, gid = wgid / nig, fm = gid * WGM, gsz = (nM - fm) < WGM ? (nM - fm) : WGM;
        u.pm = fm + ((wgid % nig) % gsz); u.pn = (wgid % nig) / gsz; return true;
    }
    __device__ __forceinline__ void a_ready(const Unit&) const {}
    __device__ __forceinline__ void done(const Unit&) const {}
};

__device__ __forceinline__ unsigned cvt_pk_bf16(float lo, float hi) { unsigned r; asm volatile("v_cvt_pk_bf16_f32 %0, %1, %2" : "=v"(r) : "v"(lo), "v"(hi)); return r; }
typedef float f32x2 __attribute__((ext_vector_type(2)));
template <class Epi, class Sched, bool ALIGN_EPI = false, bool SP2 = false>
__device__ __forceinline__ void gemm_phase(PG8_LAS unsigned char* lds, const Gemm g, const Sched& S, const Epi& E) {
    const int tid = threadIdx.x, wid = __builtin_amdgcn_readfirstlane(tid >> 6), lane = tid & 63, wr = wid >> 2, wc = wid & 3, fr = lane & 15, fq = lane >> 4;
    const int K = g.K, nt = K / BK;
    unsigned voffA[2], voffB[2];
#pragma unroll
    for (int i = 0; i < 2; ++i) { int R, C; stage_rc(tid * 16 + i * 8192, R, C); const int Rb = Epi::PERM ? ((R & ~31) + perm32(R & 31)) : R;
        voffA[i] = (unsigned)(R * K + C) * 2u; voffB[i] = (unsigned)(Rb * K + C) * 2u; }
    const size_t kstep = (size_t)(BK * 2);
    const size_t hstep = (size_t)HALF * K * 2;
    const size_t tstep = 2 * hstep;
    const unsigned ldsw = (unsigned)wid * 1024u;
    const int aoff = lds_byte(wr * 64 + fr, fq * 8), boff = lds_byte(wc * 32 + fr, fq * 8);
#define PG8_SA(b, h) (((b) * 2 + (h)) * HTB)
#define PG8_SB(b, h) ((4 + (b) * 2 + (h)) * HTB)
#define PG8_STAGE(bufoff, gbase, voff) do { _Pragma("unroll") for (int _i = 0; _i < 2; ++_i) \
        __builtin_amdgcn_global_load_lds((const unsigned*)((const char*)(gbase) + (voff)[_i]), (PG8_LAS unsigned*)(lds + (bufoff) + ldsw + _i * 8192), 16, 0, 0); } while (0)
#define PG8_LDA(dst, b, h) do { _Pragma("unroll") for (int m = 0; m < 4; ++m) _Pragma("unroll") for (int k = 0; k < 2; ++k) dst[m][k] = *(const PG8_LAS bf16x8*)(lds + PG8_SA(b, h) + aoff + m * 2048 + k * 1024); } while (0)
#define PG8_LDB(dst, b, h) do { _Pragma("unroll") for (int n = 0; n < 2; ++n) _Pragma("unroll") for (int k = 0; k < 2; ++k) dst[n][k] = *(const PG8_LAS bf16x8*)(lds + PG8_SB(b, h) + boff + n * 2048 + k * 1024); } while (0)
#define PG8_MMA(ai, bj, At, Bt) do { __builtin_amdgcn_s_setprio(1); _Pragma("unroll") for (int m = 0; m < 4; ++m) _Pragma("unroll") for (int n = 0; n < 2; ++n) _Pragma("unroll") for (int k = 0; k < 2; ++k) \
        acc[ai][bj][m][n] = __builtin_amdgcn_mfma_f32_16x16x32_bf16(Bt[n][k], At[m][k], acc[ai][bj][m][n], 0, 0, 0); __builtin_amdgcn_s_setprio(0); } while (0)
#define PG8_WAIT_V(n) asm volatile("s_waitcnt vmcnt(" #n ")" ::: "memory")
#define PG8_WAIT_L(n) asm volatile("s_waitcnt lgkmcnt(" #n ")" ::: "memory")
#define PG8_BAR __builtin_amdgcn_s_barrier()
#define PG8_SCHED __builtin_amdgcn_sched_barrier(0)
    Unit cur, nxt; int ui = 0;
    if (!S.next(0, cur)) return;
    f32x4 acc[2][2][4][2];
#pragma unroll
    for (int a = 0; a < 2; ++a)
#pragma unroll
        for (int b = 0; b < 2; ++b)
#pragma unroll
            for (int m = 0; m < 4; ++m)
#pragma unroll
                for (int n = 0; n < 2; ++n) acc[a][b][m][n] = (f32x4){0.f, 0.f, 0.f, 0.f};
    bf16x8 At[4][2], B0[2][2], B1[2][2];
    const char* cA = (const char*)g.A + (size_t)cur.pm * tstep; const char* cB = (const char*)g.Bt + (size_t)cur.pn * tstep;
    S.a_ready(cur);
    if constexpr (SP2) {
        PG8_STAGE(PG8_SB(0, 0), cB, voffB); PG8_STAGE(PG8_SB(0, 1), cB + hstep, voffB); PG8_STAGE(PG8_SA(0, 0), cA, voffA); PG8_STAGE(PG8_SA(0, 1), cA + hstep, voffA);
        if (wr == 1) PG8_BAR;
        PG8_WAIT_V(2); PG8_BAR;
        PG8_STAGE(PG8_SB(1, 0), cB + kstep, voffB); PG8_STAGE(PG8_SA(1, 0), cA + kstep, voffA); PG8_STAGE(PG8_SB(1, 1), cB + hstep + kstep, voffB);
        PG8_WAIT_V(6); PG8_BAR;
    } else {
        PG8_STAGE(PG8_SB(0, 0), cB, voffB); PG8_STAGE(PG8_SA(0, 0), cA, voffA); PG8_STAGE(PG8_SB(0, 1), cB + hstep, voffB); PG8_STAGE(PG8_SA(0, 1), cA + hstep, voffA);
        if (wr == 1) PG8_BAR;
        PG8_WAIT_V(4); PG8_BAR;
        PG8_STAGE(PG8_SB(1, 0), cB + kstep, voffB); PG8_STAGE(PG8_SA(1, 0), cA + kstep, voffA); PG8_STAGE(PG8_SB(1, 1), cB + hstep + kstep, voffB);
        PG8_WAIT_V(6); PG8_BAR;
    }
    for (;;) {
        const bool has_next = S.next(ui + 1, nxt);
        const char* nA = has_next ? (const char*)g.A + (size_t)nxt.pm * tstep : cA; const char* nB = has_next ? (const char*)g.Bt + (size_t)nxt.pn * tstep : cB;
        for (int t = 0; t < nt; t += 2) {
            const bool last = (t == nt - 2);
            const char* a1 = cA + (size_t)(t + 1) * kstep;
            const char* a2 = last ? nA : cA + (size_t)(t + 2) * kstep; const char* b2 = last ? nB : cB + (size_t)(t + 2) * kstep;
            const char* a3 = a2 + kstep; const char* b3 = b2 + kstep;
            if (last && has_next) S.a_ready(nxt);
            if constexpr (SP2) {
            PG8_LDB(B0, 0, 0); PG8_LDB(B1, 0, 1); PG8_SCHED; PG8_LDA(At, 0, 0); PG8_STAGE(PG8_SA(1, 1), a1 + hstep, voffA);
            PG8_WAIT_V(8); PG8_WAIT_L(0); PG8_BAR; PG8_MMA(0, 0, At, B0); PG8_MMA(0, 1, At, B1); PG8_BAR; PG8_SCHED;
            PG8_LDA(At, 0, 1); PG8_STAGE(PG8_SB(0, 0), b2, voffB); PG8_STAGE(PG8_SB(0, 1), b2 + hstep, voffB); PG8_STAGE(PG8_SA(0, 0), a2, voffA);
            PG8_WAIT_V(8); PG8_WAIT_L(0); PG8_BAR; PG8_MMA(1, 0, At, B0); PG8_MMA(1, 1, At, B1); PG8_BAR; PG8_SCHED;
            PG8_LDB(B0, 1, 0); PG8_LDB(B1, 1, 1); PG8_SCHED; PG8_LDA(At, 1, 0); PG8_STAGE(PG8_SA(0, 1), a2 + hstep, voffA);
            PG8_WAIT_V(8); PG8_WAIT_L(0); PG8_BAR; PG8_MMA(0, 0, At, B0); PG8_MMA(0, 1, At, B1); PG8_BAR; PG8_SCHED;
            PG8_LDA(At, 1, 1); PG8_STAGE(PG8_SB(1, 0), b3, voffB); PG8_STAGE(PG8_SB(1, 1), b3 + hstep, voffB); PG8_STAGE(PG8_SA(1, 0), a3, voffA);
            PG8_WAIT_V(8); PG8_WAIT_L(0); PG8_BAR; PG8_MMA(1, 0, At, B0); PG8_MMA(1, 1, At, B1); PG8_BAR; PG8_SCHED;
            } else {
            PG8_LDB(B0, 0, 0); PG8_SCHED; PG8_LDA(At, 0, 0); PG8_STAGE(PG8_SA(1, 1), a1 + hstep, voffA);
            PG8_WAIT_L(8); PG8_BAR; PG8_WAIT_L(0); PG8_MMA(0, 0, At, B0); PG8_BAR; PG8_SCHED;
            PG8_LDB(B1, 0, 1); PG8_STAGE(PG8_SB(0, 0), b2, voffB);
            PG8_BAR; PG8_WAIT_L(0); PG8_MMA(0, 1, At, B1); PG8_BAR;
            PG8_LDA(At, 0, 1); PG8_STAGE(PG8_SA(0, 0), a2, voffA);
            PG8_BAR; PG8_WAIT_L(0); PG8_MMA(1, 0, At, B0); PG8_BAR; PG8_SCHED;
            PG8_STAGE(PG8_SB(0, 1), b2 + hstep, voffB);
            PG8_WAIT_V(6); PG8_BAR; PG8_MMA(1, 1, At, B1); PG8_BAR;
            PG8_LDB(B0, 1, 0); PG8_SCHED; PG8_LDA(At, 1, 0); PG8_STAGE(PG8_SA(0, 1), a2 + hstep, voffA);
            PG8_WAIT_L(8); PG8_BAR; PG8_WAIT_L(0); PG8_MMA(0, 0, At, B0); PG8_BAR; PG8_SCHED;
            PG8_LDB(B1, 1, 1); PG8_STAGE(PG8_SB(1, 0), b3, voffB);
            PG8_BAR; PG8_WAIT_L(0); PG8_MMA(0, 1, At, B1); PG8_BAR;
            PG8_LDA(At, 1, 1); PG8_STAGE(PG8_SA(1, 0), a3, voffA);
            PG8_BAR; PG8_WAIT_L(0); PG8_MMA(1, 0, At, B0); PG8_BAR; PG8_SCHED;
            PG8_STAGE(PG8_SB(1, 1), b3 + hstep, voffB);
            PG8_WAIT_V(6); PG8_BAR; PG8_MMA(1, 1, At, B1); PG8_BAR;
            }
        }
        if constexpr (ALIGN_EPI) { if (wr == 0) PG8_BAR; }
        if constexpr (!Epi::AFTER_DRAIN) { E(acc, cur, wr, wc, fr, fq); S.done(cur); }
        if (!has_next) break;
#pragma unroll
        for (int a = 0; a < 2; ++a)
#pragma unroll
            for (int b = 0; b < 2; ++b)
#pragma unroll
                for (int m = 0; m < 4; ++m)
#pragma unroll
                    for (int n = 0; n < 2; ++n) acc[a][b][m][n] = (f32x4){0.f, 0.f, 0.f, 0.f};
        cur = nxt; cA = nA; cB = nB; ++ui;
        if constexpr (ALIGN_EPI) { if (wr == 1) PG8_BAR; }
    }
    PG8_WAIT_V(0);
    if constexpr (!ALIGN_EPI) { if (wr == 0) PG8_BAR; }
    PG8_BAR;
    if constexpr (Epi::AFTER_DRAIN) { E.fused(acc, cur, wr, wc, fr, fq, lds, wid, lane); S.done(cur); }
#undef PG8_SA
#undef PG8_SB
#undef PG8_STAGE
#undef PG8_LDA
#undef PG8_LDB
#undef PG8_MMA
#undef PG8_WAIT_V
#undef PG8_WAIT_L
#undef PG8_BAR
#undef PG8_SCHED
}
}

#ifndef PG8_SP2
#define PG8_SP2 true
#endif
#ifndef PG8_ALIGN
#define PG8_ALIGN true
#endif
constexpr int BATCH = 8, SEQ = 2048, DM = 1024, MROWS = BATCH * SEQ, DEPTH = 2;
constexpr int D_RNN = 512, NHEAD = 8, HDIM = 64, D_INR = 2760, ZP = 2816, TOPK = 256;
constexpr int C_XR = 0, C_GR = 512, C_Q = 1024, C_K = 1536, C_V = 1600, C_GA = 1664, C_QI = 2176, C_KI = 2688, C_WI = 2752;
constexpr float EPS = 1e-6f;
constexpr float QSCALE = 0.125f * 1.4426950408889634f;
constexpr size_t MiB = 1u << 20;
constexpr size_t WS_CTL = 0, CTL_ZERO_BYTES = 1 * MiB;
constexpr size_t WS_MOD = 1 * MiB;
constexpr size_t WS_BIAS = 1 * MiB + 256 * 1024;
constexpr size_t WS_SSQ = 2 * MiB;
constexpr size_t WS_WTIN = 3 * MiB;
constexpr size_t WS_WTOUT = 14 * MiB;
constexpr size_t WS_A = 32 * MiB;
constexpr size_t WS_Z = 64 * MiB;
constexpr size_t WS_Y = 152 * MiB;
constexpr size_t WS_X1 = 184 * MiB;
constexpr size_t WS_END = 216 * MiB;
constexpr int LDS_BYTES = 163840;
constexpr int MISC_OFF = 131072 + 8192;
constexpr int NPHASE = 8;
constexpr int CW_BAR = 4096, CW_PANEL = 16384;

#define LAS __attribute__((address_space(3)))
typedef unsigned short bf16;
typedef float f32x4 __attribute__((ext_vector_type(4)));
typedef unsigned u32x4 __attribute__((ext_vector_type(4)));
typedef unsigned u32x2 __attribute__((ext_vector_type(2)));
__device__ __forceinline__ float bf2f(bf16 v) { return __uint_as_float(((unsigned)v) << 16); }
__device__ __forceinline__ unsigned f2bf(float f) { unsigned u = __float_as_uint(f); return (u + 0x7fffu + ((u >> 16) & 1u)) >> 16; }
__device__ __forceinline__ unsigned pk2(float lo, float hi) { return f2bf(lo) | (f2bf(hi) << 16); }
__device__ __forceinline__ float wave_sum(float v) {
#pragma unroll
    for (int o = 1; o < 64; o <<= 1) v += __shfl_xor(v, o);
    return v;
}
__device__ __forceinline__ float wave_max(float v) {
#pragma unroll
    for (int o = 1; o < 64; o <<= 1) v = fmaxf(v, __shfl_xor(v, o));
    return v;
}
__device__ __forceinline__ int wave_sum_i(int v) {
#pragma unroll
    for (int o = 1; o < 64; o <<= 1) v += __shfl_xor(v, o);
    return v;
}
__device__ __forceinline__ float siluf(float v) { return v / (1.f + expf(-v)); }
__device__ __forceinline__ float sigmf(float v) { return 1.f / (1.f + expf(-v)); }

struct P {
    const float *x, *c, *norm_g, *ada_w, *ada_b, *w_in, *conv_w, *conv_b, *lru_wx, *lru_bx, *lru_wa, *lru_ba, *lru_a, *w_out, *final_g;
    float* out;
    float *mod, *bias, *ssq;
    bf16 *wt_in, *wt_out, *A, *Z, *Y, *X1;
    unsigned* ctl;
};

#ifndef EPI_ZD
#define EPI_ZD 2
#endif
struct EpiZ {
    static constexpr bool PERM = true, AFTER_DRAIN = false;
    bf16* Zp; const float* ssq; const float* bias;
    __device__ __forceinline__ void operator()(const pg8::f32x4 (&acc)[2][2][4][2], const pg8::Unit& u, int wr, int wc, int fr, int fq) const {
        const int row0 = u.pm * 256 + wr * 64 + fr, col0 = u.pn * 256 + wc * 32 + 8 * fq, b = u.pm >> 3;
        const float cs = (u.pn == 4 || u.pn == 5) ? QSCALE : 1.0f;
        f32x4 bv[2][2];
#pragma unroll
        for (int bj = 0; bj < 2; ++bj)
#pragma unroll
            for (int n = 0; n < 2; ++n) bv[bj][n] = *(const f32x4*)(bias + b * ZP + col0 + bj * 128 + 4 * n);
        f32x4 qq[EPI_ZD];
#pragma unroll
        for (int gi = 0; gi < EPI_ZD; ++gi) qq[gi] = *(const f32x4*)(ssq + (size_t)(row0 + (gi >> 2) * 128 + (gi & 3) * 16) * 4);
#pragma unroll
        for (int ai = 0; ai < 2; ++ai)
#pragma unroll
            for (int m = 0; m < 4; ++m) {
                const int r = row0 + ai * 128 + m * 16, gi = ai * 4 + m;
                const f32x4 q = qq[gi % EPI_ZD];
                if (gi + EPI_ZD < 8) qq[gi % EPI_ZD] = *(const f32x4*)(ssq + (size_t)(row0 + ((gi + EPI_ZD) >> 2) * 128 + ((gi + EPI_ZD) & 3) * 16) * 4);
                const float rstd = 1.0f / sqrtf(((q.x + q.y) + (q.z + q.w)) * (1.0f / 1024.0f) + EPS);
                bf16* rowp = Zp + (size_t)r * ZP + col0;
#pragma unroll
                for (int bj = 0; bj < 2; ++bj) {
                    const f32x4 v0 = (acc[ai][bj][m][0] * rstd + bv[bj][0]) * cs, v1 = (acc[ai][bj][m][1] * rstd + bv[bj][1]) * cs;
                    u32x4 w; w.x = pk2(v0[0], v0[1]); w.y = pk2(v0[2], v0[3]); w.z = pk2(v1[0], v1[1]); w.w = pk2(v1[2], v1[3]);
                    *(u32x4*)(rowp + bj * 128) = w;
                }
            }
    }
};
#ifndef EPI_XD
#define EPI_XD 4
#endif
struct EpiX {
    static constexpr bool PERM = true, AFTER_DRAIN = true;
    const float* xres; bf16* xout; bf16* Anext; const float* gate; const float* ng; const float* nscale; float* ssq;
    __device__ __forceinline__ void fused(pg8::f32x4 (&acc)[2][2][4][2], const pg8::Unit& u, int wr, int wc, int fr, int fq, LAS unsigned char* lds, int wid, int lane) const {
        const int b = u.pm >> 3, col0 = u.pn * 256 + wc * 32 + 8 * fq;
        LAS float* Pp = (LAS float*)lds;
        f32x4 gv[2][2], gs[2][2];
#pragma unroll
        for (int bj = 0; bj < 2; ++bj)
#pragma unroll
            for (int n = 0; n < 2; ++n) {
                gv[bj][n] = *(const f32x4*)(gate + b * 3072 + col0 + bj * 128 + 4 * n);
                if (Anext) { const f32x4 g = *(const f32x4*)(ng + col0 + bj * 128 + 4 * n), s = *(const f32x4*)(nscale + b * 3072 + col0 + bj * 128 + 4 * n); gs[bj][n] = g * (s + 1.0f); }
                else gs[bj][n] = (f32x4){0.f, 0.f, 0.f, 0.f};
            }
        f32x4 xq[EPI_XD][2][2];
#define EPIX_LOAD(gi) do { const size_t r_ = (size_t)u.pm * 256 + ((gi) >> 2) * 128 + wr * 64 + ((gi) & 3) * 16 + fr; \
        _Pragma("unroll") for (int bj = 0; bj < 2; ++bj) _Pragma("unroll") for (int n = 0; n < 2; ++n) xq[(gi) % EPI_XD][bj][n] = *(const f32x4*)(xres + r_ * DM + col0 + bj * 128 + 4 * n); } while (0)
#pragma unroll
        for (int gi = 0; gi < EPI_XD; ++gi) EPIX_LOAD(gi);
#pragma unroll
        for (int ai = 0; ai < 2; ++ai)
#pragma unroll
            for (int m = 0; m < 4; ++m) {
                const int rl = ai * 128 + wr * 64 + m * 16 + fr; const size_t r = (size_t)u.pm * 256 + rl;
                float s = 0.f;
                f32x4 xc[2][2];
#pragma unroll
                for (int bj = 0; bj < 2; ++bj)
#pragma unroll
                    for (int n = 0; n < 2; ++n) xc[bj][n] = xq[(ai * 4 + m) % EPI_XD][bj][n];
                if (ai * 4 + m + EPI_XD < 8) EPIX_LOAD(ai * 4 + m + EPI_XD);
#pragma unroll
                for (int bj = 0; bj < 2; ++bj) {
                    f32x4 x1[2];
#pragma unroll
                    for (int n = 0; n < 2; ++n) {
                        const f32x4 xr = xc[bj][n];
                        x1[n] = xr + gv[bj][n] * acc[ai][bj][m][n];
                        s += (x1[n][0] * x1[n][0] + x1[n][1] * x1[n][1]) + (x1[n][2] * x1[n][2] + x1[n][3] * x1[n][3]);
                    }
                    { u32x4 xw; xw.x = pk2(x1[0][0], x1[0][1]); xw.y = pk2(x1[0][2], x1[0][3]); xw.z = pk2(x1[1][0], x1[1][1]); xw.w = pk2(x1[1][2], x1[1][3]);
                      *(u32x4*)(xout + r * DM + col0 + bj * 128) = xw; }
                    if (Anext) { const f32x4 a0 = x1[0] * gs[bj][0], a1 = x1[1] * gs[bj][1];
                        u32x4 w; w.x = pk2(a0[0], a0[1]); w.y = pk2(a0[2], a0[3]); w.z = pk2(a1[0], a1[1]); w.w = pk2(a1[2], a1[3]);
                        *(u32x4*)(Anext + r * DM + col0 + bj * 128) = w; }
                }
                s += __shfl_xor(s, 16); s += __shfl_xor(s, 32);
                if (fq == 0) Pp[rl * 4 + wc] = s;
            }
        __syncthreads();
        const int tid = wid * 64 + lane;
        if (tid < 256) ssq[((size_t)u.pm * 256 + tid) * 4 + u.pn] = (Pp[tid * 4 + 0] + Pp[tid * 4 + 1]) + (Pp[tid * 4 + 2] + Pp[tid * 4 + 3]);
        __syncthreads();
    }
};

struct EpiXF {
    static constexpr bool PERM = true, AFTER_DRAIN = true;
    const bf16* xres; float* out; const float* gate; const float* fg; float* ssq; unsigned* cnt;
    __device__ __forceinline__ void fused(pg8::f32x4 (&acc)[2][2][4][2], const pg8::Unit& u, int wr, int wc, int fr, int fq, LAS unsigned char* lds, int wid, int lane) const {
        const int b = u.pm >> 3, col0 = u.pn * 256 + wc * 32 + 8 * fq, tid = wid * 64 + lane;
        LAS float* Pp = (LAS float*)lds;
        LAS float* Sr = (LAS float*)(lds + 4096);
        {
            f32x4 gv[2][2];
#pragma unroll
            for (int bj = 0; bj < 2; ++bj)
#pragma unroll
                for (int n = 0; n < 2; ++n) gv[bj][n] = *(const f32x4*)(gate + b * 3072 + col0 + bj * 128 + 4 * n);
#pragma unroll
            for (int ai = 0; ai < 2; ++ai)
#pragma unroll
                for (int m = 0; m < 4; ++m) {
                    const int rl = ai * 128 + wr * 64 + m * 16 + fr; const size_t r = (size_t)u.pm * 256 + rl;
                    float s = 0.f;
#pragma unroll
                    for (int bj = 0; bj < 2; ++bj) {
                        const u32x4 xw = *(const u32x4*)(xres + r * DM + col0 + bj * 128);
#pragma unroll
                        for (int n = 0; n < 2; ++n) {
                            const unsigned w0 = n ? xw.z : xw.x, w1 = n ? xw.w : xw.y;
                            const f32x4 xr = {__uint_as_float(w0 << 16), __uint_as_float(w0 & 0xffff0000u), __uint_as_float(w1 << 16), __uint_as_float(w1 & 0xffff0000u)};
                            const f32x4 x1 = xr + gv[bj][n] * acc[ai][bj][m][n];
                            acc[ai][bj][m][n] = x1;
                            s += (x1[0] * x1[0] + x1[1] * x1[1]) + (x1[2] * x1[2] + x1[3] * x1[3]);
                        }
                    }
                    s += __shfl_xor(s, 16); s += __shfl_xor(s, 32);
                    if (fq == 0) Pp[rl * 4 + wc] = s;
                }
        }
        __syncthreads();
        if (tid < 256) { const float tot = (Pp[tid * 4 + 0] + Pp[tid * 4 + 1]) + (Pp[tid * 4 + 2] + Pp[tid * 4 + 3]);
            __hip_atomic_store(ssq + ((size_t)u.pm * 256 + tid) * 4 + u.pn, tot, __ATOMIC_RELAXED, __HIP_MEMORY_SCOPE_AGENT); }
        asm volatile("s_waitcnt vmcnt(0)" ::: "memory");
        __syncthreads();
        if (tid == 0) {
            unsigned* c = cnt + 64 * u.pm;
            __hip_atomic_fetch_add(c, 1u, __ATOMIC_RELAXED, __HIP_MEMORY_SCOPE_AGENT);
            unsigned spins = 0u;
            while (__hip_atomic_load(c, __ATOMIC_RELAXED, __HIP_MEMORY_SCOPE_AGENT) < 4u) { __builtin_amdgcn_s_sleep(2); if (++spins > (1u << 22)) break; }
            __builtin_amdgcn_fence(__ATOMIC_ACQUIRE, "agent");
            asm volatile("s_waitcnt vmcnt(0)" ::: "memory");
        }
        __syncthreads();
        if (tid < 256) { const float* sp = ssq + ((size_t)u.pm * 256 + tid) * 4;
            const float q0 = __hip_atomic_load(sp + 0, __ATOMIC_RELAXED, __HIP_MEMORY_SCOPE_AGENT), q1 = __hip_atomic_load(sp + 1, __ATOMIC_RELAXED, __HIP_MEMORY_SCOPE_AGENT);
            const float q2 = __hip_atomic_load(sp + 2, __ATOMIC_RELAXED, __HIP_MEMORY_SCOPE_AGENT), q3 = __hip_atomic_load(sp + 3, __ATOMIC_RELAXED, __HIP_MEMORY_SCOPE_AGENT);
            Sr[tid] = 1.0f / sqrtf(((q0 + q1) + (q2 + q3)) * (1.0f / 1024.0f) + EPS); }
        __syncthreads();
        f32x4 fgv[2][2];
#pragma unroll
        for (int bj = 0; bj < 2; ++bj)
#pragma unroll
            for (int n = 0; n < 2; ++n) fgv[bj][n] = *(const f32x4*)(fg + col0 + bj * 128 + 4 * n);
#pragma unroll
        for (int ai = 0; ai < 2; ++ai)
#pragma unroll
            for (int m = 0; m < 4; ++m) {
                const int rl = ai * 128 + wr * 64 + m * 16 + fr; const size_t r = (size_t)u.pm * 256 + rl; const float rstd = Sr[rl];
#pragma unroll
                for (int bj = 0; bj < 2; ++bj)
#pragma unroll
                    for (int n = 0; n < 2; ++n) *(f32x4*)(out + r * DM + col0 + bj * 128 + 4 * n) = acc[ai][bj][m][n] * rstd * fgv[bj][n];
            }
        __syncthreads();
    }
};

#ifndef PRO_KC
#define PRO_KC 64
#endif
#ifndef TRQ
#define TRQ 4
#endif
__device__ __forceinline__ void ph0_prologue(const P& p, LAS unsigned char* lds) {
    const int tid = threadIdx.x, lane = tid & 63, wave = tid >> 6, G = gridDim.x, wg = blockIdx.x;
    LAS float* fl = (LAS float*)lds;
    for (int u = wg; u < 96; u += G) {
        const int l = u / 48, j = (u % 48) * 64 + lane;
        for (int i = tid; i < 8192; i += 512) fl[i] = siluf(p.c[i]);
        __syncthreads();
        float acc[8];
#pragma unroll
        for (int b = 0; b < 8; ++b) acc[b] = 0.f;
        const float* w = p.ada_w + ((size_t)l * 1024 + wave * 128) * 3072 + j;
#pragma unroll 1
        for (int k0 = 0; k0 < 128; k0 += PRO_KC) { float wv[PRO_KC];
#pragma unroll
          for (int k = 0; k < PRO_KC; ++k) wv[k] = w[(size_t)(k0 + k) * 3072];
#pragma unroll
          for (int k = 0; k < PRO_KC; ++k) {
#pragma unroll
            for (int b = 0; b < 8; ++b) acc[b] += fl[b * 1024 + wave * 128 + k0 + k] * wv[k]; } }
#pragma unroll
        for (int b = 0; b < 8; ++b) fl[8192 + (wave * 8 + b) * 64 + lane] = acc[b];
        __syncthreads();
        { const int b = wave; float s = p.ada_b[l * 3072 + j];
#pragma unroll
          for (int w8 = 0; w8 < 8; ++w8) s += fl[8192 + (w8 * 8 + b) * 64 + lane];
          p.mod[(l * 8 + b) * 3072 + j] = s; }
        __syncthreads();
    }
#pragma unroll 1
    for (int u0 = wg; u0 < 1920; u0 += TRQ * G) {
        float v[TRQ][8]; bf16* dst[TRQ]; bool act[TRQ];
#pragma unroll
        for (int q = 0; q < TRQ; ++q) {
            const int u = u0 + q * G; act[q] = u < 1920; dst[q] = nullptr;
#pragma unroll
            for (int j = 0; j < 8; ++j) v[q][j] = 0.f;
            if (act[q]) {
                const float* W; bf16* WT; int N, kt, nt;
                if (u < 1408) { const int l = u / 704, r = u % 704; kt = r / 44; nt = r % 44; W = p.w_in + (size_t)l * 1024 * D_INR; N = D_INR; WT = p.wt_in + (size_t)l * ZP * 1024; }
                else { int r = u - 1408; const int l = r / 256; r %= 256; kt = r / 16; nt = r % 16; W = p.w_out + (size_t)l * 1024 * 1024; N = 1024; WT = p.wt_out + (size_t)l * 1024 * 1024; }
                const int n = nt * 64 + lane, k0 = kt * 64 + wave * 8;
                if (n < N) {
#pragma unroll
                    for (int j = 0; j < 8; ++j) v[q][j] = W[(size_t)(k0 + j) * N + n];
                }
                dst[q] = WT + (size_t)n * 1024 + k0;
            }
        }
#pragma unroll
        for (int q = 0; q < TRQ; ++q) if (act[q]) { u32x4 o; o.x = pk2(v[q][0], v[q][1]); o.y = pk2(v[q][2], v[q][3]); o.z = pk2(v[q][4], v[q][5]); o.w = pk2(v[q][6], v[q][7]); *(u32x4*)dst[q] = o; }
    }
}
__device__ __forceinline__ void ph1_prologue(const P& p, LAS unsigned char* lds) {
    const int tid = threadIdx.x, lane = tid & 63, wave = tid >> 6, G = gridDim.x, wg = blockIdx.x;
    LAS float* fl = (LAS float*)lds;
    for (int u = wg; u < 88; u += G) {
        const int l = u / 44, n = (u % 44) * 64 + lane;
        for (int i = tid; i < 8192; i += 512) fl[i] = p.mod[(l * 8 + (i >> 10)) * 3072 + (i & 1023)];
        __syncthreads();
        float acc[8];
#pragma unroll
        for (int b = 0; b < 8; ++b) acc[b] = 0.f;
        if (n < D_INR) { const float* w = p.w_in + ((size_t)l * 1024 + wave * 128) * D_INR + n;
#pragma unroll 1
            for (int k0 = 0; k0 < 128; k0 += PRO_KC) { float wv[PRO_KC];
#pragma unroll
              for (int k = 0; k < PRO_KC; ++k) wv[k] = w[(size_t)(k0 + k) * D_INR];
#pragma unroll
              for (int k = 0; k < PRO_KC; ++k) {
#pragma unroll
                for (int b = 0; b < 8; ++b) acc[b] += fl[b * 1024 + wave * 128 + k0 + k] * wv[k]; } } }
#pragma unroll
        for (int b = 0; b < 8; ++b) fl[8192 + (wave * 8 + b) * 64 + lane] = acc[b];
        __syncthreads();
        { const int b = wave; float s = 0.f;
#pragma unroll
          for (int w8 = 0; w8 < 8; ++w8) s += fl[8192 + (w8 * 8 + b) * 64 + lane];
          p.bias[(l * 8 + b) * ZP + n] = s; }
        __syncthreads();
    }
    {
        const int r0 = wg * 8 + wave, rstep = G * 8;
        f32x4 gq[4], xv[2][2][4], sv[2][2][4];
#pragma unroll
        for (int j = 0; j < 4; ++j) gq[j] = *(const f32x4*)(p.norm_g + (lane + 64 * j) * 4);
#define A0_LOAD(slot, pr) do { _Pragma("unroll") for (int h_ = 0; h_ < 2; ++h_) _Pragma("unroll") for (int j = 0; j < 4; ++j) { const int k_ = (lane + 64 * j) * 4, r_ = r0 + rstep * (2 * (pr) + h_); \
            xv[slot][h_][j] = *(const f32x4*)(p.x + (size_t)r_ * DM + k_); sv[slot][h_][j] = *(const f32x4*)(p.mod + (size_t)(r_ >> 11) * 3072 + 1024 + k_); } } while (0)
        A0_LOAD(0, 0);
#pragma unroll
        for (int pr = 0; pr < 4; ++pr) {
            if (pr + 1 < 4) A0_LOAD((pr + 1) & 1, pr + 1);
#pragma unroll
            for (int h = 0; h < 2; ++h) {
                const int r = r0 + rstep * (2 * pr + h); float s1 = 0.f;
#pragma unroll
                for (int j = 0; j < 4; ++j) { const int k = (lane + 64 * j) * 4; const f32x4 v = xv[pr & 1][h][j];
                    s1 += (v[0] * v[0] + v[1] * v[1]) + (v[2] * v[2] + v[3] * v[3]);
                    const f32x4 o1 = v * gq[j] * (sv[pr & 1][h][j] + 1.0f);
                    u32x2 w1; w1.x = pk2(o1[0], o1[1]); w1.y = pk2(o1[2], o1[3]);
                    *(u32x2*)(p.A + (size_t)r * DM + k) = w1; }
                s1 = wave_sum(s1);
                if (lane == 0) *(f32x4*)(p.ssq + (size_t)r * 4) = (f32x4){s1, 0.f, 0.f, 0.f};
            }
        }
#undef A0_LOAD
    }
}
__device__ __forceinline__ void ph_final(const P& p) {
    const int tid = threadIdx.x, lane = tid & 63, wave = tid >> 6, G = gridDim.x, wg = blockIdx.x;
    for (int r = wg * 8 + wave; r < MROWS; r += G * 8) {
        const f32x4 q = *(const f32x4*)(p.ssq + (size_t)r * 4);
        const float rstd = 1.0f / sqrtf(((q.x + q.y) + (q.z + q.w)) * (1.0f / 1024.0f) + EPS);
#pragma unroll
        for (int j = 0; j < 4; ++j) { const int k = (lane + 64 * j) * 4;
            const f32x4 v = *(const f32x4*)(p.out + (size_t)r * DM + k), g = *(const f32x4*)(p.final_g + k);
            *(f32x4*)(p.out + (size_t)r * DM + k) = v * rstd * g; }
    }
}
#define XB_TMO      128
#define XB_XCNT(j)  (256  + 64 * (j))
#define XB_XSUB(j)  (1280 + 64 * (j))
#define XB_XGEN(j)  (2304 + 64 * (j))
#define XB_TOP      3328
#define XB_TOPGEN   3392
#define XCD_BAR_WORDS 3456
#define XB_SPIN_CAP (1u << 18)

__device__ __forceinline__ unsigned xb_ld(unsigned* p)              { return __hip_atomic_load(p, __ATOMIC_RELAXED, __HIP_MEMORY_SCOPE_AGENT); }
__device__ __forceinline__ unsigned xb_add(unsigned* p, unsigned v) { return __hip_atomic_fetch_add(p, v, __ATOMIC_RELAXED, __HIP_MEMORY_SCOPE_AGENT); }
__device__ __forceinline__ unsigned xb_xcc_id() { return (unsigned)__builtin_amdgcn_s_getreg((3 << 11) | 20) & 0xFu; }
#define XB_SPIN(cond, bar) do { unsigned _sp = 0; while (cond) { __builtin_amdgcn_s_sleep(1); \
    if ((++_sp & 255u) == 0u) { if (xb_ld(&(bar)[XB_TMO])) break; if (_sp > XB_SPIN_CAP) { atomicAdd(&(bar)[XB_TMO], 1u); break; } } } } while (0)

struct XcdBarrier {
    unsigned* bar; unsigned x;
    volatile LAS unsigned* st;
};

__device__ __forceinline__ XcdBarrier xcd_barrier_post(unsigned* bar, volatile LAS unsigned* st) {
    XcdBarrier b; b.bar = bar; b.x = xb_xcc_id(); b.st = st;
    if (threadIdx.x == 0) (void)xb_add(&bar[XB_XCNT(b.x)], 1u);
    return b;
}
__device__ __forceinline__ void xcd_barrier_complete(unsigned* bar, unsigned x, unsigned& nloc, unsigned& nx) {
    const unsigned G = gridDim.x * gridDim.y * gridDim.z;
    unsigned sum, cnt, mine, sp = 0u;
    for (;;) {
        sum = 0u; cnt = 0u; mine = 0u;
#pragma unroll
        for (unsigned j = 0; j < 16; ++j) { const unsigned c = xb_ld(&bar[XB_XCNT(j)]); sum += c; cnt += (c > 0u) ? 1u : 0u; mine = (j == x) ? c : mine; }
        if (sum == G) break;
        __builtin_amdgcn_s_sleep(1);
        if ((++sp & 255u) == 0u) { if (xb_ld(&bar[XB_TMO])) break; if (sp > XB_SPIN_CAP) { atomicAdd(&bar[XB_TMO], 1u); break; } }
    }
    nloc = mine > 0u ? mine : 1u; nx = cnt > 0u ? cnt : 1u;
}

__device__ __forceinline__ void xcd_barrier(const XcdBarrier& b) {
    asm volatile("s_waitcnt vmcnt(0)" ::: "memory");
    __syncthreads();
    if (threadIdx.x == 0) {
        unsigned* bar = b.bar;
        __builtin_amdgcn_s_waitcnt(0);
        unsigned nloc = b.st[0], nx = b.st[1];
        if (nloc == 0u) { xcd_barrier_complete(bar, b.x, nloc, nx); b.st[0] = nloc; b.st[1] = nx; }
        const unsigned old = xb_add(&bar[XB_XSUB(b.x)], 1u);
        const unsigned gen = old / nloc;
        if (old + 1u == (gen + 1u) * nloc) {
            __builtin_amdgcn_fence(__ATOMIC_RELEASE, "agent");
            asm volatile("s_waitcnt vmcnt(0)" ::: "memory");
            const unsigned og = xb_add(&bar[XB_TOP], 1u);
            const unsigned tg = og / nx;
            if (og + 1u == (tg + 1u) * nx) xb_add(&bar[XB_TOPGEN], 1u);
            else XB_SPIN(xb_ld(&bar[XB_TOPGEN]) == tg, bar);
            __builtin_amdgcn_fence(__ATOMIC_ACQUIRE, "agent");
            xb_add(&bar[XB_XGEN(b.x)], 1u);
            asm volatile("s_waitcnt vmcnt(0)" ::: "memory");
        } else {
            XB_SPIN(xb_ld(&bar[XB_XGEN(b.x)]) == gen, bar);
            __builtin_amdgcn_fence(__ATOMIC_ACQUIRE, "agent");
            asm volatile("s_waitcnt vmcnt(0)" ::: "memory");
        }
    }
    __syncthreads();
}
__device__ __forceinline__ unsigned score_ukey(float s) { const unsigned u = __float_as_uint(s + 0.0f); return (u & 0x80000000u) ? ~u : (u | 0x80000000u); }
__device__ __forceinline__ void topk_threshold(const unsigned (&k)[32], unsigned& thr, unsigned& need) {
    unsigned prefix = 0u; bool exact = false;
    for (int bit = 31; bit >= 0; --bit) {
        const unsigned cand = prefix | (1u << bit);
        int c = 0;
#pragma unroll
        for (int i = 0; i < 32; ++i) c += (k[i] >= cand) ? 1 : 0;
        c = wave_sum_i(c);
        if (c >= TOPK) prefix = cand;
        if (c == TOPK) { exact = true; break; }
    }
    thr = prefix;
    if (exact) { need = 0xffffffffu; }
    else { int c = 0;
#pragma unroll
        for (int i = 0; i < 32; ++i) c += (k[i] > prefix) ? 1 : 0;
        c = wave_sum_i(c); need = (unsigned)(TOPK - c); }
}
#ifndef PROBE_VALU
#define PROBE_VALU 0
#endif
#ifndef RP_T3
#define RP_T3 1
#endif
#ifndef RP_T1
#define RP_T1 1
#endif
#ifndef RP_T2
#define RP_T2 1
#endif
#ifndef RP_I
#define RP_I 1
#endif
#ifndef RP_T
#define RP_T 1
#endif
#ifndef RP_V
#define RP_V 1
#endif
typedef short bf16x8v __attribute__((ext_vector_type(8)));
typedef short s16x4v __attribute__((ext_vector_type(4)));
constexpr int BMS = 65;
constexpr int SCP = 2052;
constexpr int DSA_BM_OFF = 16 * SCP * 4;
constexpr int DSA_RING_OFF = 0;
constexpr int DSA_QIB_OFF = 147456;
constexpr int DSA_WIB_OFF = 135680;
constexpr int DSA_MLUT_OFF = 143616;
__device__ __forceinline__ void glds16(const void* gsrc, unsigned lds_dst) { unsigned keep;
    asm volatile("s_mov_b32 %0, m0\n\ts_mov_b32 m0, %2\n\ts_nop 0\n\tglobal_load_lds_dwordx4 %1, off\n\ts_mov_b32 m0, %0" : "=&s"(keep) : "v"(gsrc), "s"(lds_dst) : "memory"); }
template <int I> __device__ __forceinline__ unsigned mbit_t(int mw) { unsigned r; asm("v_bfe_i32 %0, %1, %2, 1" : "=v"(r) : "v"(mw), "i"(I)); return r; }
#define mbit(mw, i) mbit_t<(i)>(mw)
__device__ __forceinline__ float relu_i(float x) { return __int_as_float(max(__float_as_int(x), 0)); }
__device__ __forceinline__ int imax3(float a, float b, float c) { return max(max(__float_as_int(a), __float_as_int(b)), __float_as_int(c)); }
__device__ __forceinline__ s16x4v lds_tr16(LAS const unsigned char* p) { return __builtin_bit_cast(s16x4v, __builtin_amdgcn_ds_read_tr16_b64_v4i16((LAS s16x4v*)p)); }
__device__ __forceinline__ unsigned cvtpk(float lo, float hi) { typedef float f2 __attribute__((ext_vector_type(2))); typedef __bf16 b2 __attribute__((ext_vector_type(2))); f2 v = {lo, hi}; b2 r = __builtin_convertvector(v, b2); return __builtin_bit_cast(unsigned, r); }


template <int L> __device__ __forceinline__ void wr2lanes(int& w, unsigned lo, unsigned hi) {
    asm volatile("s_nop 1\n\tv_writelane_b32 %0, %1, %3\n\tv_writelane_b32 %0, %2, %4" : "+v"(w) : "s"(lo), "s"(hi), "i"(L), "i"(L + 1));
}
__device__ __forceinline__ int wave_sum_dpp(int v) {
    v += __builtin_amdgcn_update_dpp(0, v, 0xB1, 0xf, 0xf, true);
    v += __builtin_amdgcn_update_dpp(0, v, 0x4E, 0xf, 0xf, true);
    v += __builtin_amdgcn_update_dpp(0, v, 0x141, 0xf, 0xf, true);
    v += __builtin_amdgcn_update_dpp(0, v, 0x140, 0xf, 0xf, true);
    return __builtin_amdgcn_readlane(v, 0) + __builtin_amdgcn_readlane(v, 16) + __builtin_amdgcn_readlane(v, 32) + __builtin_amdgcn_readlane(v, 48);
}
__device__ __forceinline__ unsigned wave_max_dpp(unsigned v) {
    v = max(v, (unsigned)__builtin_amdgcn_update_dpp(0, (int)v, 0xB1, 0xf, 0xf, true));
    v = max(v, (unsigned)__builtin_amdgcn_update_dpp(0, (int)v, 0x4E, 0xf, 0xf, true));
    v = max(v, (unsigned)__builtin_amdgcn_update_dpp(0, (int)v, 0x141, 0xf, 0xf, true));
    v = max(v, (unsigned)__builtin_amdgcn_update_dpp(0, (int)v, 0x140, 0xf, 0xf, true));
    return max(max((unsigned)__builtin_amdgcn_readlane((int)v, 0), (unsigned)__builtin_amdgcn_readlane((int)v, 16)), max((unsigned)__builtin_amdgcn_readlane((int)v, 32), (unsigned)__builtin_amdgcn_readlane((int)v, 48)));
}
__device__ __forceinline__ int cnt8(int acc, unsigned cand, unsigned k0, unsigned k1, unsigned k2, unsigned k3, unsigned k4, unsigned k5, unsigned k6, unsigned k7) {
    unsigned long long m0, m1, m2, m3, m4, m5, m6, m7;
    asm volatile("v_cmp_le_u32_e64 %1, %9, %10\n\tv_cmp_le_u32_e64 %2, %9, %11\n\tv_cmp_le_u32_e64 %3, %9, %12\n\tv_cmp_le_u32_e64 %4, %9, %13\n\t"
                 "v_cmp_le_u32_e64 %5, %9, %14\n\tv_cmp_le_u32_e64 %6, %9, %15\n\tv_cmp_le_u32_e64 %7, %9, %16\n\tv_cmp_le_u32_e64 %8, %9, %17\n\t"
                 "v_addc_co_u32_e64 %0, %1, 0, %0, %1\n\tv_addc_co_u32_e64 %0, %2, 0, %0, %2\n\tv_addc_co_u32_e64 %0, %3, 0, %0, %3\n\tv_addc_co_u32_e64 %0, %4, 0, %0, %4\n\t"
                 "v_addc_co_u32_e64 %0, %5, 0, %0, %5\n\tv_addc_co_u32_e64 %0, %6, 0, %0, %6\n\tv_addc_co_u32_e64 %0, %7, 0, %0, %7\n\tv_addc_co_u32_e64 %0, %8, 0, %0, %8"
                 : "+v"(acc), "=&s"(m0), "=&s"(m1), "=&s"(m2), "=&s"(m3), "=&s"(m4), "=&s"(m5), "=&s"(m6), "=&s"(m7)
                 : "s"(cand), "v"(k0), "v"(k1), "v"(k2), "v"(k3), "v"(k4), "v"(k5), "v"(k6), "v"(k7));
    return acc;
}
__device__ __forceinline__ int count_ge(const unsigned (&k)[32], unsigned cand_, int nb) {
    const unsigned cand = (unsigned)__builtin_amdgcn_readfirstlane((int)cand_);
    int c = 0;
    c = cnt8(c, cand, k[0], k[1], k[2], k[3], k[4], k[5], k[6], k[7]);
    if (nb > 1) c = cnt8(c, cand, k[8], k[9], k[10], k[11], k[12], k[13], k[14], k[15]);
    if (nb > 2) c = cnt8(c, cand, k[16], k[17], k[18], k[19], k[20], k[21], k[22], k[23]);
    if (nb > 3) c = cnt8(c, cand, k[24], k[25], k[26], k[27], k[28], k[29], k[30], k[31]);
    return wave_sum_dpp(c);
}
__device__ __forceinline__ int wave_scan_dpp(int v) {
    v += __builtin_amdgcn_update_dpp(0, v, 0x111, 0xf, 0xf, false);
    v += __builtin_amdgcn_update_dpp(0, v, 0x112, 0xf, 0xf, false);
    v += __builtin_amdgcn_update_dpp(0, v, 0x114, 0xf, 0xf, false);
    v += __builtin_amdgcn_update_dpp(0, v, 0x118, 0xf, 0xf, false);
    v += __builtin_amdgcn_update_dpp(0, v, 0x142, 0xa, 0xf, false);
    v += __builtin_amdgcn_update_dpp(0, v, 0x143, 0xc, 0xf, false);
    return v;
}
#ifndef HIST_WAVES
#define HIST_WAVES 4
#endif
struct TopkState { unsigned prefix; int bit; bool done; unsigned need; int nb; LAS unsigned* hist; int crej; };
__device__ __forceinline__ void topk_hist(const unsigned (&k)[32], TopkState& st, int c_above) {
    const int lane = threadIdx.x & 63;
    const unsigned T = (unsigned)__builtin_amdgcn_readfirstlane((int)st.prefix);
    LAS unsigned* hist = st.hist;
    *(LAS u32x4*)(hist + 4 * lane) = (u32x4){0u, 0u, 0u, 0u};
    asm volatile("" ::: "memory");
    const unsigned hb_ = (unsigned)(uintptr_t)hist; const unsigned one = 1u;
#define HF8(i0) { unsigned t0_; unsigned long long ex_; \
        asm volatile("s_mov_b64 %1, exec\n\t" \
            "v_subrev_u32_e32 %0, %2, %5\n\tv_lshrrev_b32_e32 %0, 15, %0\n\tv_cmpx_gt_u32_e32 vcc, 0x100, %0\n\tv_lshl_add_u32 %0, %0, 2, %3\n\tds_add_u32 %0, %4\n\ts_mov_b64 exec, %1\n\t" \
            "v_subrev_u32_e32 %0, %2, %6\n\tv_lshrrev_b32_e32 %0, 15, %0\n\tv_cmpx_gt_u32_e32 vcc, 0x100, %0\n\tv_lshl_add_u32 %0, %0, 2, %3\n\tds_add_u32 %0, %4\n\ts_mov_b64 exec, %1\n\t" \
            "v_subrev_u32_e32 %0, %2, %7\n\tv_lshrrev_b32_e32 %0, 15, %0\n\tv_cmpx_gt_u32_e32 vcc, 0x100, %0\n\tv_lshl_add_u32 %0, %0, 2, %3\n\tds_add_u32 %0, %4\n\ts_mov_b64 exec, %1\n\t" \
            "v_subrev_u32_e32 %0, %2, %8\n\tv_lshrrev_b32_e32 %0, 15, %0\n\tv_cmpx_gt_u32_e32 vcc, 0x100, %0\n\tv_lshl_add_u32 %0, %0, 2, %3\n\tds_add_u32 %0, %4\n\ts_mov_b64 exec, %1\n\t" \
            "v_subrev_u32_e32 %0, %2, %9\n\tv_lshrrev_b32_e32 %0, 15, %0\n\tv_cmpx_gt_u32_e32 vcc, 0x100, %0\n\tv_lshl_add_u32 %0, %0, 2, %3\n\tds_add_u32 %0, %4\n\ts_mov_b64 exec, %1\n\t" \
            "v_subrev_u32_e32 %0, %2, %10\n\tv_lshrrev_b32_e32 %0, 15, %0\n\tv_cmpx_gt_u32_e32 vcc, 0x100, %0\n\tv_lshl_add_u32 %0, %0, 2, %3\n\tds_add_u32 %0, %4\n\ts_mov_b64 exec, %1\n\t" \
            "v_subrev_u32_e32 %0, %2, %11\n\tv_lshrrev_b32_e32 %0, 15, %0\n\tv_cmpx_gt_u32_e32 vcc, 0x100, %0\n\tv_lshl_add_u32 %0, %0, 2, %3\n\tds_add_u32 %0, %4\n\ts_mov_b64 exec, %1\n\t" \
            "v_subrev_u32_e32 %0, %2, %12\n\tv_lshrrev_b32_e32 %0, 15, %0\n\tv_cmpx_gt_u32_e32 vcc, 0x100, %0\n\tv_lshl_add_u32 %0, %0, 2, %3\n\tds_add_u32 %0, %4\n\ts_mov_b64 exec, %1" \
            : "=&v"(t0_), "=&s"(ex_) : "s"(T), "s"(hb_), "v"(one), "v"(k[i0]), "v"(k[i0 + 1]), "v"(k[i0 + 2]), "v"(k[i0 + 3]), "v"(k[i0 + 4]), "v"(k[i0 + 5]), "v"(k[i0 + 6]), "v"(k[i0 + 7]) : "vcc", "memory"); }
    HF8(0)
    if (st.nb > 1) HF8(8)
    if (st.nb > 2) HF8(16)
    if (st.nb > 3) HF8(24)
#undef HF8
    asm volatile("" ::: "memory");
    const u32x4 w = *(LAS const u32x4*)(hist + 4 * (63 - lane));
    const int t = (int)((w.x + w.y) + (w.z + w.w));
    const int P = wave_scan_dpp(t);
    const int k1 = TOPK - c_above;
    const unsigned long long bal = __ballot(P >= k1);
    const int Ls = __builtin_ctzll(bal);
    int c = __builtin_amdgcn_readlane(P, Ls) - __builtin_amdgcn_readlane(t, Ls);
    const int h3 = __builtin_amdgcn_readlane((int)w.w, Ls), h2 = __builtin_amdgcn_readlane((int)w.z, Ls), h1 = __builtin_amdgcn_readlane((int)w.y, Ls), h0 = __builtin_amdgcn_readlane((int)w.x, Ls);
    int bsel = 3, hb = h3;
    if (c + h3 < k1) { c += h3; bsel = 2; hb = h2; if (c + h2 < k1) { c += h2; bsel = 1; hb = h1; if (c + h1 < k1) { c += h1; bsel = 0; hb = h0; } } }
    const unsigned bin = (unsigned)(4 * (63 - Ls) + bsel);
    st.prefix = T | (bin << 15); st.bit = 14;
    if (c + hb == k1) { st.done = true; st.need = 0xffffffffu; }
}
__device__ __forceinline__ void topk_init(const unsigned (&k)[32], TopkState& st) {
    unsigned mx = 0u;
#pragma unroll
    for (int i = 0; i < 32; ++i) mx = max(mx, k[i]);
    mx = wave_max_dpp(mx);
    st.prefix = 0u; st.bit = 31; st.done = false; st.need = 0u; st.crej = 0;
    unsigned E = mx >> 23;
    int cprev = 0;
#pragma unroll 1
    for (int j = 0; j < 4; ++j) {
        if (E < (unsigned)j + 1u) break;
        const unsigned T = (E - (unsigned)j) << 23;
        const int c = count_ge(k, T, st.nb);
        if (c >= TOPK) { st.prefix = T; st.bit = 22; if (c == TOPK) { st.done = true; st.need = 0xffffffffu; }
#ifndef NO_TOPK_HIST
#ifdef PROBE_HIST2
            else if (st.hist) { TopkState sv = st; topk_hist(k, st, cprev); asm volatile("" :: "s"(st.prefix) : "memory"); st = sv; topk_hist(k, st, cprev); }
#else
            else if (st.hist) topk_hist(k, st, cprev);
#endif
#endif
            break; }
        cprev = c;
    }
}
__device__ __forceinline__ void topk_step(const unsigned (&k)[32], TopkState& st) {
    if (st.done) return;
    if (st.bit < 0) { int c = 0;
#pragma unroll
        for (int i = 0; i < 32; ++i) c += (k[i] > st.prefix) ? 1 : 0;
        c = wave_sum_dpp(c); st.need = (unsigned)(TOPK - c); st.done = true; return; }
    const unsigned cand = st.prefix | (1u << st.bit);
    const int c = count_ge(k, cand, st.nb);
    if (c >= TOPK) st.prefix = cand; else st.crej = c;
    if (c == TOPK) { st.done = true; st.need = 0xffffffffu; }
    --st.bit;
#ifndef NO_TOPK_HIST
    if (st.bit == 22 && !st.done && st.hist) topk_hist(k, st, st.crej);
#endif
}

__device__ __forceinline__ void dsa_prefetch_qi(const bf16* zb, int qt, LAS unsigned char* lds, int wave, int lane) {
    const unsigned lds_base = (unsigned)(uintptr_t)lds;
#pragma unroll
    for (int i = 0; i < 2; ++i) { const int row = 2 * wave + i;
        glds16(zb + (size_t)(qt * 16 + row) * ZP + C_QI + ((lane ^ row) * 8), (unsigned)__builtin_amdgcn_readfirstlane(lds_base + DSA_QIB_OFF + row * 1024)); }
    if (wave == 0) glds16(zb + (size_t)(qt * 16 + (lane & 15)) * ZP + C_WI, (unsigned)__builtin_amdgcn_readfirstlane(lds_base + DSA_WIB_OFF));
}

__device__ __forceinline__ void dsa_prefetch_ki(const bf16* zb, int qt, bf16x8v (&pk)[4], int wave, int lane) {
    const int r16 = lane & 15, g = lane >> 4;
    if (wave <= qt) { const bf16* krow = zb + (size_t)(wave * 16 + r16) * ZP + C_KI; pk[0] = *(const bf16x8v*)(krow + 8 * g); pk[1] = *(const bf16x8v*)(krow + 32 + 8 * g); }
    if (wave + 8 <= qt) { const bf16* krow = zb + (size_t)((wave + 8) * 16 + r16) * ZP + C_KI; pk[2] = *(const bf16x8v*)(krow + 8 * g); pk[3] = *(const bf16x8v*)(krow + 32 + 8 * g); }
}

__device__ __forceinline__ void dsa_unit(const P& p, int b, int qt, int qt_next, bf16x8v (&pk)[4], LAS unsigned char* lds) {
    const int tid = threadIdx.x, lane = tid & 63, wave = __builtin_amdgcn_readfirstlane(tid >> 6), r16 = lane & 15, g = lane >> 4;
    const int q0 = qt * 16; const bf16* zb = p.Z + (size_t)b * SEQ * ZP;
    LAS float* SC = (LAS float*)lds; LAS unsigned* BM = (LAS unsigned*)(lds + DSA_BM_OFF);
    const bool dense_all = (qt < TOPK / 16);
    const bf16* qrow = zb + (size_t)(q0 + r16) * ZP;
    const bf16x8v bq0 = *(const bf16x8v*)(qrow + C_Q + wave * 64 + 8 * g), bq1 = *(const bf16x8v*)(qrow + C_Q + wave * 64 + 32 + 8 * g);
    u32x2 gwv[4];
#pragma unroll
    for (int dt = 0; dt < 4; ++dt) gwv[dt] = *(const u32x2*)(qrow + C_GA + wave * 64 + dt * 16 + 4 * g);
    const int nsteps = (((q0 + 16 + 31) >> 5) + 1) & ~1, nmega = (nsteps + 7) >> 3;
    const int kkey = lane >> 3, vkey = lane >> 1, vhalf = lane & 1;
    const unsigned lds_base = (unsigned)(uintptr_t)lds;
#define DSA_STAGE(mm) do { const int st_ = (mm) * 8 + wave; if (st_ < nsteps) { \
        const bf16* kb_ = zb + (size_t)st_ * 32 * ZP; const unsigned ldsb_ = lds_base + (unsigned)(((mm) & 1) * 65536 + wave * 4096); \
        _Pragma("unroll") for (int c_ = 0; c_ < 4; ++c_) { const int key_ = 8 * c_ + kkey, ch_ = (lane & 7) ^ ((key_ & 15) >> 1); \
            glds16(kb_ + (size_t)key_ * ZP + C_K + ch_ * 8, (unsigned)__builtin_amdgcn_readfirstlane(ldsb_ + c_ * 1024)); } \
        _Pragma("unroll") for (int c_ = 0; c_ < 4; ++c_) \
            glds16(kb_ + (size_t)vkey * ZP + C_V + c_ * 16 + vhalf * 8, (unsigned)__builtin_amdgcn_readfirstlane(ldsb_ + 32768 + c_ * 1024)); } } while (0)
    if (!dense_all) {
        for (int rpI = 0; rpI < RP_I; ++rpI) {
        bf16x8v bq[8][2]; float wv[8];
#pragma unroll
        for (int h = 0; h < 8; ++h) { bq[h][0] = *(LAS const bf16x8v*)(lds + DSA_QIB_OFF + r16 * 1024 + (((8 * h + g) ^ r16) * 16)); bq[h][1] = *(LAS const bf16x8v*)(lds + DSA_QIB_OFF + r16 * 1024 + (((8 * h + 4 + g) ^ r16) * 16));
            wv[h] = bf2f(*(LAS const bf16*)(lds + DSA_WIB_OFF + r16 * 16 + h * 2)) * 0.35355339059327373f * 0.125f; }
        bf16x8v ra0 = pk[0], ra1 = pk[1], rb0 = pk[2], rb1 = pk[3], rc0 = pk[0], rc1 = pk[1];
#define IDX_LOAD(d0, d1, ktl) do { const int ktl_ = (ktl) <= qt ? (ktl) : qt;        \
            const bf16* krow_ = zb + (size_t)(ktl_ * 16 + r16) * ZP + C_KI; d0 = *(const bf16x8v*)(krow_ + 8 * g); d1 = *(const bf16x8v*)(krow_ + 32 + 8 * g); } while (0)
#define IDX_STEP(c0, c1) do { \
            f32x4 sc = {0.f, 0.f, 0.f, 0.f}; \
            _Pragma("unroll") for (int h = 0; h < 8; ++h) { \
                f32x4 acc = {0.f, 0.f, 0.f, 0.f}; \
                acc = __builtin_amdgcn_mfma_f32_16x16x32_bf16(c0, bq[h][0], acc, 0, 0, 0); \
                acc = __builtin_amdgcn_mfma_f32_16x16x32_bf16(c1, bq[h][1], acc, 0, 0, 0); \
                _Pragma("unroll") for (int i = 0; i < 4; ++i) sc[i] += relu_i(acc[i]) * wv[h]; \
            } \
            if (__builtin_amdgcn_readfirstlane(kt) == qt) {                  \
                _Pragma("unroll") for (int i = 0; i < 4; ++i) sc[i] = (4 * g + i > r16) ? -INFINITY : sc[i]; \
            } \
            *(LAS f32x4*)(SC + r16 * SCP + kt * 16 + 4 * g) = sc; } while (0)
        int kt = wave;
        const int nst = (qt - wave + 8) >> 3;
        const int ntrip = (nst * 11) >> 5, rem = nst - 3 * ntrip;
#pragma unroll 1
        for (int it = ntrip; it > 0; --it) {
            IDX_LOAD(rc0, rc1, kt + 16); __builtin_amdgcn_sched_barrier(0); IDX_STEP(ra0, ra1); __builtin_amdgcn_sched_barrier(0); kt += 8;
            IDX_LOAD(ra0, ra1, kt + 16); __builtin_amdgcn_sched_barrier(0); IDX_STEP(rb0, rb1); __builtin_amdgcn_sched_barrier(0); kt += 8;
            IDX_LOAD(rb0, rb1, kt + 16); __builtin_amdgcn_sched_barrier(0); IDX_STEP(rc0, rc1); __builtin_amdgcn_sched_barrier(0); kt += 8;
        }
        if (rem >= 1) { IDX_STEP(ra0, ra1); kt += 8; if (rem >= 2) { IDX_STEP(rb0, rb1); } }
#undef IDX_LOAD
#undef IDX_STEP
        __syncthreads();
        }
#pragma unroll 1
        for (int rpT = 0; rpT < RP_T; ++rpT) {
            const int ra = 2 * wave, rb = 2 * wave + 1, ta = q0 + ra, tb = q0 + rb;
            unsigned ka[32], kb[32];
#pragma unroll
            for (int i = 0; i < 32; ++i) { const int key = lane + 64 * i; ka[i] = (key <= ta) ? score_ukey(SC[ra * SCP + key]) : 0u; kb[i] = (key <= tb) ? score_ukey(SC[rb * SCP + key]) : 0u; }
#if RP_T1 > 1
            asm volatile("" :: "v"(ka[0]), "v"(kb[31]) : "memory");
#pragma unroll
            for (int i = 0; i < 32; ++i) { const int key = lane + 64 * i; ka[i] = (key <= ta) ? score_ukey(SC[ra * SCP + key]) : 0u; kb[i] = (key <= tb) ? score_ukey(SC[rb * SCP + key]) : 0u; }
            asm volatile("" ::: "memory");
#endif
            asm volatile("s_waitcnt lgkmcnt(0)" ::: "memory");
            __syncthreads();
            DSA_STAGE(0);
            TopkState sa, sb; sa.nb = (ta >> 9) + 1; sb.nb = (tb >> 9) + 1;
            sa.hist = (wave < HIST_WAVES) ? (LAS unsigned*)(lds + 65536 + ra * 1280) : (LAS unsigned*)nullptr; sb.hist = (wave < HIST_WAVES) ? (LAS unsigned*)(lds + 65536 + rb * 1280) : (LAS unsigned*)nullptr;
            topk_init(ka, sa); topk_init(kb, sb);
#pragma unroll 1
            while (!(sa.done && sb.done)) { topk_step(ka, sa); topk_step(kb, sb); }
#if RP_T2 > 1
            asm volatile("" :: "v"(sa.prefix), "v"(sb.prefix));
            topk_init(ka, sa); topk_init(kb, sb);
#pragma unroll 1
            while (!(sa.done && sb.done)) { topk_step(ka, sa); topk_step(kb, sb); }
#endif
            if (sa.need == 0xffffffffu && sb.need == 0xffffffffu) {
                const unsigned ta_ = (unsigned)__builtin_amdgcn_readfirstlane((int)sa.prefix), tb_ = (unsigned)__builtin_amdgcn_readfirstlane((int)sb.prefix);
                int wa = 0, wb = 0;
#define WR2(i) { const unsigned long long ma = __ballot(ka[i] >= ta_), mb = __ballot(kb[i] >= tb_); wr2lanes<2 * (i)>(wa, (unsigned)ma, (unsigned)(ma >> 32)); wr2lanes<2 * (i)>(wb, (unsigned)mb, (unsigned)(mb >> 32)); }
                WR2(0) WR2(1) WR2(2) WR2(3) WR2(4) WR2(5) WR2(6) WR2(7) WR2(8) WR2(9) WR2(10) WR2(11) WR2(12) WR2(13) WR2(14) WR2(15)
                WR2(16) WR2(17) WR2(18) WR2(19) WR2(20) WR2(21) WR2(22) WR2(23) WR2(24) WR2(25) WR2(26) WR2(27) WR2(28) WR2(29) WR2(30) WR2(31)
#undef WR2
                BM[ra * BMS + lane] = (unsigned)wa; BM[rb * BMS + lane] = (unsigned)wb;
#if RP_T3 > 1
                asm volatile("" : "+v"(wa), "+v"(wb) :: "memory");
#define WR2(i) { const unsigned long long ma = __ballot(ka[i] >= ta_), mb = __ballot(kb[i] >= tb_); wr2lanes<2 * (i)>(wa, (unsigned)ma, (unsigned)(ma >> 32)); wr2lanes<2 * (i)>(wb, (unsigned)mb, (unsigned)(mb >> 32)); }
                WR2(0) WR2(1) WR2(2) WR2(3) WR2(4) WR2(5) WR2(6) WR2(7) WR2(8) WR2(9) WR2(10) WR2(11) WR2(12) WR2(13) WR2(14) WR2(15)
                WR2(16) WR2(17) WR2(18) WR2(19) WR2(20) WR2(21) WR2(22) WR2(23) WR2(24) WR2(25) WR2(26) WR2(27) WR2(28) WR2(29) WR2(30) WR2(31)
#undef WR2
                BM[ra * BMS + lane] = (unsigned)wa; BM[rb * BMS + lane] = (unsigned)wb;
#endif
            } else {
            unsigned eqa = 0u, eqb = 0u;
#pragma unroll 1
            for (int i = 0; i < 32; ++i) {
                unsigned kai = ka[0], kbi = kb[0];
#pragma unroll
                for (int j = 1; j < 32; ++j) { kai = (i == j) ? ka[j] : kai; kbi = (i == j) ? kb[j] : kbi; }
                { const bool eq = (kai == sa.prefix); const unsigned long long em = __ballot(eq);
                  const unsigned erank = eqa + __builtin_amdgcn_mbcnt_hi((unsigned)(em >> 32), __builtin_amdgcn_mbcnt_lo((unsigned)em, 0u));
                  const unsigned long long smk = __ballot((kai > sa.prefix) || (eq && erank < sa.need));
                  if (lane == 0) { BM[ra * BMS + 2 * i] = (unsigned)smk; BM[ra * BMS + 2 * i + 1] = (unsigned)(smk >> 32); }
                  eqa += (unsigned)__popcll(em); }
                { const bool eq = (kbi == sb.prefix); const unsigned long long em = __ballot(eq);
                  const unsigned erank = eqb + __builtin_amdgcn_mbcnt_hi((unsigned)(em >> 32), __builtin_amdgcn_mbcnt_lo((unsigned)em, 0u));
                  const unsigned long long smk = __ballot((kbi > sb.prefix) || (eq && erank < sb.need));
                  if (lane == 0) { BM[rb * BMS + 2 * i] = (unsigned)smk; BM[rb * BMS + 2 * i + 1] = (unsigned)(smk >> 32); }
                  eqb += (unsigned)__popcll(em); }
            }
            }
        }
    } else {
        for (int i = tid; i < 1024; i += 512) { const int row = i >> 6, w = i & 63, t = q0 + row, lo = 32 * w;
            BM[row * BMS + w] = (t >= lo + 31) ? 0xffffffffu : ((t < lo) ? 0u : ((2u << (t - lo)) - 1u)); }
        DSA_STAGE(0);
    }
    __syncthreads();
    const int h = wave;
#pragma unroll 1
    for (int rpV = 0; rpV < RP_V; ++rpV) {
    asm volatile("s_waitcnt vmcnt(0)" ::: "memory");
    asm volatile("" :: "v"(bq0), "v"(bq1), "v"(gwv[0]), "v"(gwv[1]), "v"(gwv[2]), "v"(gwv[3]));
    __syncthreads();
    if (qt_next >= TOPK / 16) { dsa_prefetch_qi(zb, qt_next, lds, wave, lane); dsa_prefetch_ki(zb, qt_next, pk, wave, lane); }
    f32x4 o[4], lacc = {0.f, 0.f, 0.f, 0.f}, negm = {0.f, 0.f, 0.f, 0.f};
#pragma unroll
    for (int dt = 0; dt < 4; ++dt) o[dt] = (f32x4){0.f, 0.f, 0.f, 0.f};
    float m_run = 0.f;
    const int kofs0 = r16 * 128 + ((g ^ (r16 >> 1)) & 7) * 16, kofs1 = r16 * 128 + (((4 + g) ^ (r16 >> 1)) & 7) * 16;
    const int vofs = 32768 + (4 * g + ((lane & 15) >> 2)) * 32 + (lane & 3) * 8;
    bf16x8v ones = {0x3f80, 0x3f80, 0x3f80, 0x3f80, 0x3f80, 0x3f80, 0x3f80, 0x3f80};
    asm volatile("" : "+v"(ones));
    LAS const unsigned char* mlut = lds + DSA_MLUT_OFF;
    constexpr float THR = 8.0f;
    bool first = true;
#pragma unroll 1
    for (int mm = 0; mm < nmega; ++mm) {
        if (mm + 1 < nmega) DSA_STAGE(mm + 1);
        LAS unsigned char* slotb = lds + (mm & 1) * 65536;
        const int nsub = (nsteps - mm * 8) < 8 ? (nsteps - mm * 8) : 8;
#pragma unroll 1
        for (int u = 0; u < nsub; u += 2) {
            LAS unsigned char* slot = slotb + u * 4096;
            const int mwA = (int)(BM[r16 * BMS + mm * 8 + u] >> (4 * g)), mwB = (int)(BM[r16 * BMS + mm * 8 + u + 1] >> (4 * g));
            f32x4 s0, s1, s2, s3;
            { const bf16x8v ka0 = *(LAS const bf16x8v*)(slot + kofs0), ka1 = *(LAS const bf16x8v*)(slot + kofs1);
              const bf16x8v kb0 = *(LAS const bf16x8v*)(slot + 2048 + kofs0), kb1 = *(LAS const bf16x8v*)(slot + 2048 + kofs1);
              const bf16x8v kc0 = *(LAS const bf16x8v*)(slot + 4096 + kofs0), kc1 = *(LAS const bf16x8v*)(slot + 4096 + kofs1);
              const bf16x8v kd0 = *(LAS const bf16x8v*)(slot + 6144 + kofs0), kd1 = *(LAS const bf16x8v*)(slot + 6144 + kofs1);
              s0 = __builtin_amdgcn_mfma_f32_16x16x32_bf16(ka0, bq0, negm, 0, 0, 0); s1 = __builtin_amdgcn_mfma_f32_16x16x32_bf16(kb0, bq0, negm, 0, 0, 0);
              s2 = __builtin_amdgcn_mfma_f32_16x16x32_bf16(kc0, bq0, negm, 0, 0, 0); s3 = __builtin_amdgcn_mfma_f32_16x16x32_bf16(kd0, bq0, negm, 0, 0, 0);
              s0 = __builtin_amdgcn_mfma_f32_16x16x32_bf16(ka1, bq1, s0, 0, 0, 0); s1 = __builtin_amdgcn_mfma_f32_16x16x32_bf16(kb1, bq1, s1, 0, 0, 0);
              s2 = __builtin_amdgcn_mfma_f32_16x16x32_bf16(kc1, bq1, s2, 0, 0, 0); s3 = __builtin_amdgcn_mfma_f32_16x16x32_bf16(kd1, bq1, s3, 0, 0, 0); }
            const int lmi = max(max(max(imax3(s0[0], s0[1], s0[2]), imax3(s0[3], s1[0], s1[1])), max(imax3(s1[2], s1[3], s2[0]), imax3(s2[1], s2[2], s2[3]))), max(imax3(s3[0], s3[1], s3[2]), __float_as_int(s3[3])));
            if (first || __any(lmi > 0x41000000)) {
                float lmx = fmaxf(fmaxf(fmaxf(fmaxf(s0[0], s0[1]), fmaxf(s0[2], s0[3])), fmaxf(fmaxf(s1[0], s1[1]), fmaxf(s1[2], s1[3]))), fmaxf(fmaxf(fmaxf(s2[0], s2[1]), fmaxf(s2[2], s2[3])), fmaxf(fmaxf(s3[0], s3[1]), fmaxf(s3[2], s3[3]))));
                { const auto r1 = __builtin_amdgcn_permlane16_swap(__float_as_uint(lmx), __float_as_uint(lmx), false, false); lmx = fmaxf(__uint_as_float(r1[0]), __uint_as_float(r1[1])); }
                { const auto r2 = __builtin_amdgcn_permlane32_swap(__float_as_uint(lmx), __float_as_uint(lmx), false, false); lmx = fmaxf(__uint_as_float(r2[0]), __uint_as_float(r2[1])); }
                const float dl = first ? lmx : fmaxf(lmx, 0.f);
                m_run += dl; const float f = first ? 1.0f : __builtin_amdgcn_exp2f(-dl);
#pragma unroll
                for (int i = 0; i < 4; ++i) { s0[i] -= dl; s1[i] -= dl; s2[i] -= dl; s3[i] -= dl; negm[i] = -m_run; }
                lacc = lacc * f;
#pragma unroll
                for (int dt = 0; dt < 4; ++dt) o[dt] = o[dt] * f;
                first = false;
            }
            const u32x2 mk0 = *(LAS const u32x2*)(mlut + ((mwA & 15) << 3)), mk1 = *(LAS const u32x2*)(mlut + (((mwA >> 16) & 15) << 3));
            const u32x2 mk2 = *(LAS const u32x2*)(mlut + ((mwB & 15) << 3)), mk3 = *(LAS const u32x2*)(mlut + (((mwB >> 16) & 15) << 3));
            u32x4 pwA, pwB;
            pwA.x = cvtpk(__builtin_amdgcn_exp2f(s0[0]), __builtin_amdgcn_exp2f(s0[1])) & mk0.x; pwA.y = cvtpk(__builtin_amdgcn_exp2f(s0[2]), __builtin_amdgcn_exp2f(s0[3])) & mk0.y;
            pwA.z = cvtpk(__builtin_amdgcn_exp2f(s1[0]), __builtin_amdgcn_exp2f(s1[1])) & mk1.x; pwA.w = cvtpk(__builtin_amdgcn_exp2f(s1[2]), __builtin_amdgcn_exp2f(s1[3])) & mk1.y;
            pwB.x = cvtpk(__builtin_amdgcn_exp2f(s2[0]), __builtin_amdgcn_exp2f(s2[1])) & mk2.x; pwB.y = cvtpk(__builtin_amdgcn_exp2f(s2[2]), __builtin_amdgcn_exp2f(s2[3])) & mk2.y;
            pwB.z = cvtpk(__builtin_amdgcn_exp2f(s3[0]), __builtin_amdgcn_exp2f(s3[1])) & mk3.x; pwB.w = cvtpk(__builtin_amdgcn_exp2f(s3[2]), __builtin_amdgcn_exp2f(s3[3])) & mk3.y;
            const bf16x8v pfA = __builtin_bit_cast(bf16x8v, pwA), pfB = __builtin_bit_cast(bf16x8v, pwB);
            lacc = __builtin_amdgcn_mfma_f32_16x16x32_bf16(ones, pfA, lacc, 0, 0, 0);
            lacc = __builtin_amdgcn_mfma_f32_16x16x32_bf16(ones, pfB, lacc, 0, 0, 0);
#pragma unroll
            for (int dt = 0; dt < 4; ++dt) {
                const s16x4v lo = lds_tr16(slot + vofs + dt * 1024), hi = lds_tr16(slot + vofs + dt * 1024 + 512);
                const s16x4v lo2 = lds_tr16(slot + 4096 + vofs + dt * 1024), hi2 = lds_tr16(slot + 4096 + vofs + dt * 1024 + 512);
                const bf16x8v vf = {lo[0], lo[1], lo[2], lo[3], hi[0], hi[1], hi[2], hi[3]};
                const bf16x8v vf2 = {lo2[0], lo2[1], lo2[2], lo2[3], hi2[0], hi2[1], hi2[2], hi2[3]};
                o[dt] = __builtin_amdgcn_mfma_f32_16x16x32_bf16(vf, pfA, o[dt], 0, 0, 0);
                o[dt] = __builtin_amdgcn_mfma_f32_16x16x32_bf16(vf2, pfB, o[dt], 0, 0, 0);
            }
        }
        asm volatile("s_waitcnt vmcnt(0) lgkmcnt(0)" ::: "memory");
        __syncthreads();
    }
#undef DSA_STAGE
    const float inv = 1.0f / lacc[0];
    bf16* yrow = p.Y + ((size_t)b * SEQ + q0 + r16) * DM + 512 + h * 64;
#pragma unroll
    for (int dt = 0; dt < 4; ++dt) {
        const u32x2 gw = gwv[dt];
        const float g0 = __uint_as_float(gw.x << 16), g1 = __uint_as_float(gw.x & 0xffff0000u), g2 = __uint_as_float(gw.y << 16), g3 = __uint_as_float(gw.y & 0xffff0000u);
        u32x2 w; w.x = pk2(o[dt][0] * inv * siluf(g0), o[dt][1] * inv * siluf(g1)); w.y = pk2(o[dt][2] * inv * siluf(g2), o[dt][3] * inv * siluf(g3));
        *(u32x2*)(yrow + dt * 16 + 4 * g) = w;
    }
    __syncthreads();
    }
}
__device__ __forceinline__ int dsa_qt_of(int j, int i) { return (i == 0) ? 127 - j : (i == 1) ? 64 + j : (i == 2) ? 63 - j : j; }
__device__ __forceinline__ void dsa_phase_pre(const P& p, LAS unsigned char* lds) {
    const int G = gridDim.x, wg = blockIdx.x, lane = threadIdx.x & 63, wave = __builtin_amdgcn_readfirstlane(threadIdx.x >> 6);
    const int b = (G == 256) ? (wg & 7) : (wg >> 7), qt = (G == 256) ? dsa_qt_of(wg >> 3, 0) : 127 - (wg & 127);
    if (wg < 1024 && qt >= TOPK / 16) dsa_prefetch_qi(p.Z + (size_t)b * SEQ * ZP, qt, lds, wave, lane);
}
__device__ __forceinline__ void dsa_phase(const P& p, LAS unsigned char* lds) {
    const int G = gridDim.x, wg = blockIdx.x;
    if (G == 256) {
        const int b = wg & 7, j = wg >> 3, lane = threadIdx.x & 63, wave = __builtin_amdgcn_readfirstlane(threadIdx.x >> 6);
        bf16x8v pk[4] = {{0, 0, 0, 0, 0, 0, 0, 0}, {0, 0, 0, 0, 0, 0, 0, 0}, {0, 0, 0, 0, 0, 0, 0, 0}, {0, 0, 0, 0, 0, 0, 0, 0}};
        if (dsa_qt_of(j, 0) >= TOPK / 16) dsa_prefetch_ki(p.Z + (size_t)b * SEQ * ZP, dsa_qt_of(j, 0), pk, wave, lane);
#pragma unroll 1
        for (int i = 0; i < 4; ++i) dsa_unit(p, b, dsa_qt_of(j, i), (i < 3) ? dsa_qt_of(j, i + 1) : -1, pk, lds);
    }
}
constexpr int LRU_WS_OFF = 139264;
constexpr int LRU_XB = 264 * 128;
constexpr int LRU_GB = 256 * 32;
constexpr int LRU_BUF = LRU_XB + LRU_GB;
__device__ __forceinline__ float fast_sigm(float x) { return __builtin_amdgcn_rcpf(1.0f + __expf(-x)); }
__device__ __forceinline__ void lru_unit(const P& p, int l, int b, int blk, int q4, LAS unsigned char* lds) {
    const int tid = threadIdx.x, lane = tid & 63, wave = __builtin_amdgcn_readfirstlane(tid >> 6), r16 = lane & 15, g = lane >> 4;
    const bf16* zb = p.Z + (size_t)b * SEQ * ZP;
    const int cA = blk * 64, dloc = q4 * 16 + r16, dg = blk * 64 + dloc;
    const unsigned lds_base = (unsigned)(uintptr_t)lds;
#define LRU_STAGE(r) do { const unsigned bb_ = lds_base + (unsigned)(((r) & 1) * LRU_BUF); \
        _Pragma("unroll") for (int i_ = 0; i_ < 5; ++i_) { const int pc_ = wave + 8 * i_; if (pc_ < 33) { const int rho_ = pc_ * 8 + (lane >> 3); int t_ = (r) * 256 - 3 + rho_; t_ = t_ < 0 ? 0 : (t_ > SEQ - 1 ? SEQ - 1 : t_); \
            const int ch_ = (lane & 7) ^ ((rho_ >> 1) & 7); glds16(zb + (size_t)t_ * ZP + C_XR + cA + ch_ * 8, (unsigned)__builtin_amdgcn_readfirstlane(bb_ + pc_ * 1024)); } } \
        { const int row_ = wave * 32 + (lane >> 1); glds16(zb + (size_t)((r) * 256 + row_) * ZP + C_GR + dg - r16 + (lane & 1) * 8, (unsigned)__builtin_amdgcn_readfirstlane(bb_ + LRU_XB + wave * 1024)); } } while (0)
    LRU_STAGE(0);
    float cwA[2][4][8], cbA[2][8];
#pragma unroll
    for (int s = 0; s < 2; ++s)
#pragma unroll
        for (int j = 0; j < 8; ++j) { const int c = cA + 32 * s + 8 * g + j; cbA[s][j] = p.conv_b[l * 512 + c];
#pragma unroll
            for (int k = 0; k < 4; ++k) cwA[s][k][j] = p.conv_w[(l * 4 + k) * 512 + c]; }
    bf16x8v bxf[2], baf[2];
#pragma unroll
    for (int s = 0; s < 2; ++s) { u32x4 wx, wa; unsigned tx[8], ta[8];
#pragma unroll
        for (int j = 0; j < 8; ++j) { const size_t idx = (((size_t)l * 8 + blk) * 64 + 32 * s + 8 * g + j) * 64 + dloc; tx[j] = f2bf(p.lru_wx[idx]); ta[j] = f2bf(p.lru_wa[idx]); }
        wx.x = tx[0] | (tx[1] << 16); wx.y = tx[2] | (tx[3] << 16); wx.z = tx[4] | (tx[5] << 16); wx.w = tx[6] | (tx[7] << 16);
        wa.x = ta[0] | (ta[1] << 16); wa.y = ta[2] | (ta[3] << 16); wa.z = ta[4] | (ta[5] << 16); wa.w = ta[6] | (ta[7] << 16);
        bxf[s] = __builtin_bit_cast(bf16x8v, wx); baf[s] = __builtin_bit_cast(bf16x8v, wa); }
    const float cw0 = p.conv_w[(l * 4 + 0) * 512 + dg], cw1 = p.conv_w[(l * 4 + 1) * 512 + dg], cw2 = p.conv_w[(l * 4 + 2) * 512 + dg], cw3 = p.conv_w[(l * 4 + 3) * 512 + dg];
    const float cb = p.conv_b[l * 512 + dg], bxv = p.lru_bx[l * 512 + dg], bav = p.lru_ba[l * 512 + dg];
    const float sp8 = -8.0f * log1pf(expf(-p.lru_a[l * 512 + dg]));
    asm volatile("" :: "v"(cwA[0][0][0]), "v"(cwA[1][3][7]), "v"(cbA[1][7]), "v"(bxf[0]), "v"(bxf[1]), "v"(baf[0]), "v"(baf[1]), "v"(cw0), "v"(cw1), "v"(cw2), "v"(cw3), "v"(cb), "v"(bxv), "v"(bav), "v"(sp8));
    LAS float* WS = (LAS float*)(lds + LRU_WS_OFF);
    float hrun = 0.f;
    asm volatile("s_waitcnt vmcnt(0)" ::: "memory");
#pragma unroll 1
    for (int round = 0; round < 8; ++round) {
        asm volatile("s_waitcnt vmcnt(8)" ::: "memory");
        __syncthreads();
        if (round + 1 < 8) LRU_STAGE(round + 1);
        LAS const unsigned char* xb = lds + (round & 1) * LRU_BUF; LAS const unsigned char* gb = xb + LRU_XB;
        const int tw = round * 256 + wave * 32;
        float hl[2][4], pl[2][4], gr4[2][4], PT[2], HT[2], PE[2], HE[2];
#pragma unroll
        for (int tau = 0; tau < 2; ++tau) {
            const int t0 = tw + 16 * tau, rho0 = wave * 32 + 16 * tau;
            bf16x8v af[2];
#pragma unroll
            for (int s = 0; s < 2; ++s) {
                float xc[8];
#pragma unroll
                for (int j = 0; j < 8; ++j) xc[j] = cbA[s][j];
#pragma unroll
                for (int k = 0; k < 4; ++k) { const int rho = rho0 + r16 + k; u32x4 w = *(LAS const u32x4*)(xb + rho * 128 + (((4 * s + g) ^ (rho >> 1)) & 7) * 16);
                    if (t0 + r16 - 3 + k < 0) w = (u32x4){0u, 0u, 0u, 0u};
                    xc[0] += cwA[s][k][0] * __uint_as_float(w.x << 16); xc[1] += cwA[s][k][1] * __uint_as_float(w.x & 0xffff0000u);
                    xc[2] += cwA[s][k][2] * __uint_as_float(w.y << 16); xc[3] += cwA[s][k][3] * __uint_as_float(w.y & 0xffff0000u);
                    xc[4] += cwA[s][k][4] * __uint_as_float(w.z << 16); xc[5] += cwA[s][k][5] * __uint_as_float(w.z & 0xffff0000u);
                    xc[6] += cwA[s][k][6] * __uint_as_float(w.w << 16); xc[7] += cwA[s][k][7] * __uint_as_float(w.w & 0xffff0000u); }
                u32x4 pw; pw.x = cvtpk(xc[0], xc[1]); pw.y = cvtpk(xc[2], xc[3]); pw.z = cvtpk(xc[4], xc[5]); pw.w = cvtpk(xc[6], xc[7]);
                af[s] = __builtin_bit_cast(bf16x8v, pw);
            }
            f32x4 gx = {0.f, 0.f, 0.f, 0.f}, ga = {0.f, 0.f, 0.f, 0.f};
            gx = __builtin_amdgcn_mfma_f32_16x16x32_bf16(af[0], bxf[0], gx, 0, 0, 0); gx = __builtin_amdgcn_mfma_f32_16x16x32_bf16(af[1], bxf[1], gx, 0, 0, 0);
            ga = __builtin_amdgcn_mfma_f32_16x16x32_bf16(af[0], baf[0], ga, 0, 0, 0); ga = __builtin_amdgcn_mfma_f32_16x16x32_bf16(af[1], baf[1], ga, 0, 0, 0);
            float xo[7];
#pragma unroll
            for (int m = 0; m < 7; ++m) { const int rho = rho0 + 4 * g + m;
                const unsigned short v = *(LAS const unsigned short*)(xb + rho * 128 + (((dloc >> 3) ^ (rho >> 1)) & 7) * 16 + (dloc & 7) * 2);
                xo[m] = (t0 + 4 * g - 3 + m >= 0) ? bf2f(v) : 0.f; }
            float Pr = 1.f, Hr = 0.f;
#pragma unroll
            for (int i = 0; i < 4; ++i) {
                const float xcv = cb + cw0 * xo[i] + cw1 * xo[i + 1] + cw2 * xo[i + 2] + cw3 * xo[i + 3];
                const float sx = fast_sigm(gx[i] + bxv), sa = fast_sigm(ga[i] + bav);
                const float la = sp8 * sa, a = __expf(la), y2 = 2.0f * la;
                const float ser = -y2 * (1.0f + y2 * (0.5f + y2 * (0.16666667f + y2 * (0.041666668f + y2 * (0.0083333338f + y2 * 0.0013888889f)))));
                const float em = (y2 > -0.25f) ? ser : (1.0f - __expf(y2));
                const float u = __builtin_amdgcn_sqrtf(em) * sx * xcv;
                Hr = a * Hr + u; Pr *= a; hl[tau][i] = Hr; pl[tau][i] = Pr;
                gr4[tau][i] = bf2f(*(LAS const unsigned short*)(gb + (rho0 + 4 * g + i) * 32 + r16 * 2));
            }
            float Pi = Pr, Hi = Hr;
            { const float Pl = __shfl_up(Pi, 16), Hl = __shfl_up(Hi, 16); if (g >= 1) { Hi = Pi * Hl + Hi; Pi = Pl * Pi; } }
            { const float Pl = __shfl_up(Pi, 32), Hl = __shfl_up(Hi, 32); if (g >= 2) { Hi = Pi * Hl + Hi; Pi = Pl * Pi; } }
            float Pe = __shfl_up(Pi, 16), He = __shfl_up(Hi, 16); if (g == 0) { Pe = 1.f; He = 0.f; }
            PT[tau] = __shfl(Pi, 48 + r16); HT[tau] = __shfl(Hi, 48 + r16); PE[tau] = Pe; HE[tau] = He;
        }
        HE[1] = PE[1] * HT[0] + HE[1]; PE[1] = PT[0] * PE[1];
        const float Pw = PT[0] * PT[1], Hw = PT[1] * HT[0] + HT[1];
        LAS float* wsr = WS + (round & 1) * 256;
        if (g == 0) { wsr[(wave * 16 + r16) * 2 + 0] = Pw; wsr[(wave * 16 + r16) * 2 + 1] = Hw; }
        asm volatile("s_waitcnt lgkmcnt(0)" ::: "memory");
        __builtin_amdgcn_s_barrier();
        asm volatile("" ::: "memory");
        float hc = hrun, hall = hrun;
#pragma unroll
        for (int w2 = 0; w2 < 8; ++w2) { if (w2 == wave) hc = hall; hall = wsr[(w2 * 16 + r16) * 2 + 0] * hall + wsr[(w2 * 16 + r16) * 2 + 1]; }
        hrun = hall;
#pragma unroll
        for (int tau = 0; tau < 2; ++tau) {
            const float hin = PE[tau] * hc + HE[tau];
            bf16* yp = p.Y + ((size_t)b * SEQ + tw + 16 * tau + 4 * g) * DM + dg;
#pragma unroll
            for (int i = 0; i < 4; ++i) { const float h = hl[tau][i] + pl[tau][i] * hin, gr = gr4[tau][i]; yp[(size_t)i * DM] = (bf16)f2bf(h * gr * fast_sigm(gr)); }
        }
    }
#undef LRU_STAGE
    __syncthreads();
}
__device__ __forceinline__ void lru_phase(const P& p, int l, LAS unsigned char* lds) {
    const int G = gridDim.x, wg = blockIdx.x;
#pragma unroll 1
    for (int u = wg; u < 256; u += G) lru_unit(p, l, (u >> 3) & 7, u & 7, u >> 6, lds);
}
#ifndef DSA_PHASE
#define DSA_PHASE dsa_phase
#endif
#ifndef LRU_PHASE
#define LRU_PHASE lru_phase
#endif
#ifndef RP_A
#define RP_A 1
#endif
#ifndef RP_L
#define RP_L 1
#endif
#ifndef RP_D
#define RP_D 1
#endif
#ifndef RP_C
#define RP_C 1
#endif
#ifndef RP_0
#define RP_0 1
#endif
template <int OFF> __device__ __forceinline__ unsigned long long karg_u64() {
    unsigned long long v; const unsigned long long kp = (unsigned long long)__builtin_amdgcn_kernarg_segment_ptr();
    asm volatile("s_load_dwordx2 %0, %1, %2\n\ts_waitcnt lgkmcnt(0)" : "=s"(v) : "s"(kp), "i"(OFF) : "memory");
    return v;
}
struct Args { const float* in[15]; float* out; unsigned char* ws; int ph_lo, ph_hi; };
__global__ void __launch_bounds__(512, 2) mega(Args a) {
    extern __shared__ __attribute__((aligned(16))) unsigned char lds_raw[];
    LAS unsigned char* lds = (LAS unsigned char*)lds_raw;
#define KARG(T, off) ((T)(__attribute__((address_space(1))) void*)karg_u64<(off)>())
#define LOADP() P p; { unsigned char* ws_ = KARG(unsigned char*, 128); \
        p.x = KARG(const float*, 0); p.c = KARG(const float*, 8); p.norm_g = KARG(const float*, 16); p.ada_w = KARG(const float*, 24); p.ada_b = KARG(const float*, 32); p.w_in = KARG(const float*, 40); \
        p.conv_w = KARG(const float*, 48); p.conv_b = KARG(const float*, 56); p.lru_wx = KARG(const float*, 64); p.lru_bx = KARG(const float*, 72); p.lru_wa = KARG(const float*, 80); p.lru_ba = KARG(const float*, 88); \
        p.lru_a = KARG(const float*, 96); p.w_out = KARG(const float*, 104); p.final_g = KARG(const float*, 112); p.out = KARG(float*, 120); \
        p.ctl = (unsigned*)(ws_ + WS_CTL); p.mod = (float*)(ws_ + WS_MOD); p.bias = (float*)(ws_ + WS_BIAS); p.ssq = (float*)(ws_ + WS_SSQ); \
        p.wt_in = (bf16*)(ws_ + WS_WTIN); p.wt_out = (bf16*)(ws_ + WS_WTOUT); p.A = (bf16*)(ws_ + WS_A); p.Z = (bf16*)(ws_ + WS_Z); p.Y = (bf16*)(ws_ + WS_Y); p.X1 = (bf16*)(ws_ + WS_X1); }
    unsigned* const ctl0 = (unsigned*)((unsigned char*)a.ws + WS_CTL);
    const int lo = a.ph_lo, hi = a.ph_hi;
    volatile LAS unsigned* MISC = (volatile LAS unsigned*)(lds + MISC_OFF + 4096);
    if (threadIdx.x < 4) MISC[threadIdx.x] = 0u;
    if (threadIdx.x < 16) { const unsigned t = threadIdx.x; u32x2 m; m.x = ((t & 1u) ? 0xffffu : 0u) | ((t & 2u) ? 0xffff0000u : 0u); m.y = ((t & 4u) ? 0xffffu : 0u) | ((t & 8u) ? 0xffff0000u : 0u);
        *(LAS u32x2*)(lds + DSA_MLUT_OFF + t * 8) = m; }
    __syncthreads();
    XcdBarrier bar; bar.bar = ctl0 + CW_BAR; bar.x = 0; bar.st = MISC;
    if (hi - lo > 1) bar = xcd_barrier_post(ctl0 + CW_BAR, MISC);
#define IN(k) (lo <= (k) && (k) < hi)
#ifndef N_CG_SEAMS
#define N_CG_SEAMS 0
#endif
#define SEAM(k) do { if (IN(k) && IN((k) + 1)) { if ((k) < N_CG_SEAMS) cg::this_grid().sync(); else xcd_barrier(bar); } } while (0)
    if (IN(0)) { LOADP(); ph0_prologue(p, lds); if (RP_0 > 1) { __syncthreads(); ph0_prologue(p, lds); } }
    SEAM(0);
    if (IN(1)) { LOADP(); ph1_prologue(p, lds); if (RP_0 > 1) { __syncthreads(); ph1_prologue(p, lds); } }
    SEAM(1);
#define LAYER(l, base) \
    if (IN(base)) { LOADP(); \
        pg8::Gemm g{p.A, p.wt_in + (size_t)(l) * ZP * 1024, MROWS, ZP, DM}; pg8::StaticOrder S; S.init(MROWS, ZP, (int)gridDim.x, (int)blockIdx.x); \
        EpiZ E{p.Z, p.ssq, p.bias + (size_t)(l) * 8 * ZP}; \
        pg8::gemm_phase<EpiZ, pg8::StaticOrder, PG8_ALIGN, PG8_SP2>(lds, g, S, E); if (RP_A > 1) { __syncthreads(); pg8::gemm_phase<EpiZ, pg8::StaticOrder, PG8_ALIGN, PG8_SP2>(lds, g, S, E); } \
    } \
    SEAM(base); \
    if (IN((base) + 1)) { LOADP(); dsa_phase_pre(p, lds); LRU_PHASE(p, (l), lds); __syncthreads(); if (RP_L > 1) { LRU_PHASE(p, (l), lds); __syncthreads(); } DSA_PHASE(p, lds); if (RP_D > 1) { __syncthreads(); DSA_PHASE(p, lds); } } \
    SEAM((base) + 1); \
    if (IN((base) + 2)) { LOADP(); \
        pg8::Gemm g{p.Y, p.wt_out + (size_t)(l) * 1024 * 1024, MROWS, DM, DM}; pg8::StaticOrder S; S.init(MROWS, DM, (int)gridDim.x, (int)blockIdx.x); \
        if constexpr ((l) == DEPTH - 1) { \
            EpiXF E{p.X1, p.out, p.mod + (size_t)(l) * 8 * 3072 + 2048, p.final_g, p.ssq, p.ctl + CW_PANEL}; \
            pg8::gemm_phase<EpiXF, pg8::StaticOrder, false, PG8_SP2>(lds, g, S, E); \
        } else { \
            EpiX E{p.x, p.X1, p.A, p.mod + (size_t)(l) * 8 * 3072 + 2048, p.norm_g + (size_t)((l) + 1) * 1024, p.mod + (size_t)((l) + 1) * 8 * 3072 + 1024, p.ssq}; \
            pg8::gemm_phase<EpiX, pg8::StaticOrder, false, PG8_SP2>(lds, g, S, E); if (RP_C > 1 && (l) == 0) { __syncthreads(); pg8::gemm_phase<EpiX, pg8::StaticOrder, false, PG8_SP2>(lds, g, S, E); } \
        } \
    } \
    if ((base) + 3 < NPHASE) SEAM((base) + 2);
    LAYER(0, 2)
    LAYER(1, 5)
}
#ifndef MK_N_LAUNCHES
#define MK_N_LAUNCHES 1
#endif
extern "C" void kernel_launch(void* const* d_in, const int* in_sizes, int n_in, void* d_out, int out_size, void* d_ws, size_t ws_size, hipStream_t stream) {
    static int grid = 0;
    if (grid == 0) {
        if (n_in != 15 || out_size != MROWS * DM || ws_size < WS_END) { fprintf(stderr, "kernel_launch: unexpected problem (n_in %d out %d ws %zu)\n", n_in, out_size, ws_size); grid = -1; return; }
        int dev = 0, cus = 0, per_cu = 0;
        hipGetDevice(&dev); hipDeviceGetAttribute(&cus, hipDeviceAttributeMultiprocessorCount, dev);
        if (hipFuncSetAttribute((const void*)mega, hipFuncAttributeMaxDynamicSharedMemorySize, LDS_BYTES) != hipSuccess) { fprintf(stderr, "kernel_launch: hipFuncSetAttribute failed\n"); grid = -1; return; }
        if (hipOccupancyMaxActiveBlocksPerMultiprocessor(&per_cu, (const void*)mega, 512, LDS_BYTES) != hipSuccess || per_cu < 1) { fprintf(stderr, "kernel_launch: occupancy query failed (%d)\n", per_cu); per_cu = 1; }
        (void)hipGetLastError();
        grid = cus * per_cu;
        if (grid != 256) fprintf(stderr, "kernel_launch: grid %d (cus %d x %d) != 256: the fused out-projection epilogue needs exactly 256 workgroups\n", grid, cus, per_cu);
    }
    if (grid < 0) return;
    hipMemsetAsync((char*)d_ws + WS_CTL, 0, CTL_ZERO_BYTES, stream);
    Args a{};
    for (int i = 0; i < 15; ++i) a.in[i] = (const float*)d_in[i];
    a.out = (float*)d_out; a.ws = (unsigned char*)d_ws;
#if MK_N_LAUNCHES == 1
    a.ph_lo = 0; a.ph_hi = NPHASE;
    void* args[] = {&a};
    hipError_t e = hipLaunchCooperativeKernel((const void*)mega, dim3(grid), dim3(512), args, LDS_BYTES, stream);
    if (e != hipSuccess) fprintf(stderr, "cooperative launch failed: %s (grid %d)\n", hipGetErrorString(e), grid);
#else
    for (int ph = 0; ph < NPHASE; ++ph) { a.ph_lo = ph; a.ph_hi = ph + 1; hipLaunchKernelGGL(mega, dim3(grid), dim3(512), LDS_BYTES, stream, a); }
#endif
}
```

```cpp
#include <hip/hip_runtime.h>
#include <hip/hip_cooperative_groups.h>
#include <cstdio>
#include <cstdint>
#include <cmath>
namespace cg = cooperative_groups;
#define EPI_XD 3
#define EPI_ZD 8
#define HIST_WAVES 8
#define PRO_KC 64
namespace pg8 {
#define PG8_LAS __attribute__((address_space(3)))
typedef unsigned short bf16_t;
typedef short bf16x8 __attribute__((ext_vector_type(8)));
typedef float f32x4 __attribute__((ext_vector_type(4)));
typedef unsigned u32x4 __attribute__((ext_vector_type(4)));
constexpr int BM = 256, BK = 64, HALF = 128, HTB = HALF * BK * 2  , STAGE_BYTES = 8 * HTB, NXCD = 8, WGM = 8;

__host__ __device__ __forceinline__ int lds_byte(int r, int c) { const int st = (r >> 4) * 2 + (c >> 5), rr = r & 15, cc = c & 31, ob = rr * 64 + cc * 2; return st * 1024 + (ob ^ (((ob >> 9) & 1) << 5)); }
__host__ __device__ __forceinline__ void stage_rc(int b, int& R, int& C) { const int st = b / 1024, sb = b % 1024, swz = sb ^ (((sb >> 9) & 1) << 5); R = (st >> 1) * 16 + swz / 64; C = (st & 1) * 32 + (swz % 64) / 2; }
__host__ __device__ __forceinline__ int perm32(int rho) { const int n = rho >> 4, i = rho & 15; return 8 * (i >> 2) + 4 * n + (i & 3); }

struct Unit { int pm, pn; };
struct Gemm { const bf16_t* A; const bf16_t* Bt; int M, N, K; };

struct StaticOrder {
    int nM, nN, nwg, G, c;
    __host__ __device__ void init(int M, int N, int G_, int c_) { nM = M / BM; nN = N / BM; nwg = nM * nN; G = G_; c = c_; }
    __host__ __device__ bool next(int i, Unit& u) const {
        const long L = (long)i * G + c; if (L >= nwg) return false;
        int wgid = (int)L; { const int q = nwg / NXCD, r = nwg % NXCD, xcd = wgid % NXCD, off = wgid / NXCD; wgid = (xcd < r ? xcd * (q + 1) : r * (q + 1) + (xcd - r) * q) + off; }
        const int nig = WGM * nN, gid = wgid / nig, fm = gid * WGM, gsz = (nM - fm) < WGM ? (nM - fm) : WGM;
        u.pm = fm + ((wgid % nig) % gsz); u.pn = (wgid % nig) / gsz; return true;
    }
    __device__ __forceinline__ void a_ready(const Unit&) const {}
    __device__ __forceinline__ void done(const Unit&) const {}
};

__device__ __forceinline__ unsigned cvt_pk_bf16(float lo, float hi) { unsigned r; asm volatile("v_cvt_pk_bf16_f32 %0, %1, %2" : "=v"(r) : "v"(lo), "v"(hi)); return r; }
typedef float f32x2 __attribute__((ext_vector_type(2)));
template <class Epi, class Sched, bool ALIGN_EPI = false, bool SP2 = false>
__device__ __forceinline__ void gemm_phase(PG8_LAS unsigned char* lds, const Gemm g, const Sched& S, const Epi& E) {
    const int tid = threadIdx.x, wid = __builtin_amdgcn_readfirstlane(tid >> 6), lane = tid & 63, wr = wid >> 2, wc = wid & 3, fr = lane & 15, fq = lane >> 4;
    const int K = g.K, nt = K / BK;
    unsigned voffA[2], voffB[2];
#pragma unroll
    for (int i = 0; i < 2; ++i) { int R, C; stage_rc(tid * 16 + i * 8192, R, C); const int Rb = Epi::PERM ? ((R & ~31) + perm32(R & 31)) : R;
        voffA[i] = (unsigned)(R * K + C) * 2u; voffB[i] = (unsigned)(Rb * K + C) * 2u; }
    const size_t kstep = (size_t)(BK * 2);
    const size_t hstep = (size_t)HALF * K * 2;
    const size_t tstep = 2 * hstep;
    const unsigned ldsw = (unsigned)wid * 1024u;
    const int aoff = lds_byte(wr * 64 + fr, fq * 8), boff = lds_byte(wc * 32 + fr, fq * 8);
#define PG8_SA(b, h) (((b) * 2 + (h)) * HTB)
#define PG8_SB(b, h) ((4 + (b) * 2 + (h)) * HTB)
#define PG8_STAGE(bufoff, gbase, voff) do { _Pragma("unroll") for (int _i = 0; _i < 2; ++_i) \
        __builtin_amdgcn_global_load_lds((const unsigned*)((const char*)(gbase) + (voff)[_i]), (PG8_LAS unsigned*)(lds + (bufoff) + ldsw + _i * 8192), 16, 0, 0); } while (0)
#define PG8_LDA(dst, b, h) do { _Pragma("unroll") for (int m = 0; m < 4; ++m) _Pragma("unroll") for (int k = 0; k < 2; ++k) dst[m][k] = *(const PG8_LAS bf16x8*)(lds + PG8_SA(b, h) + aoff + m * 2048 + k * 1024); } while (0)
#define PG8_LDB(dst, b, h) do { _Pragma("unroll") for (int n = 0; n < 2; ++n) _Pragma("unroll") for (int k = 0; k < 2; ++k) dst[n][k] = *(const PG8_LAS bf16x8*)(lds + PG8_SB(b, h) + boff + n * 2048 + k * 1024); } while (0)
#define PG8_MMA(ai, bj, At, Bt) do { __builtin_amdgcn_s_setprio(1); _Pragma("unroll") for (int m = 0; m < 4; ++m) _Pragma("unroll") for (int n = 0; n < 2; ++n) _Pragma("unroll") for (int k = 0; k < 2; ++k) \
        acc[ai][bj][m][n] = __builtin_amdgcn_mfma_f32_16x16x32_bf16(Bt[n][k], At[m][k], acc[ai][bj][m][n], 0, 0, 0); __builtin_amdgcn_s_setprio(0); } while (0)
#define PG8_WAIT_V(n) asm volatile("s_waitcnt vmcnt(" #n ")" ::: "memory")
#define PG8_WAIT_L(n) asm volatile("s_waitcnt lgkmcnt(" #n ")" ::: "memory")
#define PG8_BAR __builtin_amdgcn_s_barrier()
#define PG8_SCHED __builtin_amdgcn_sched_barrier(0)
    Unit cur, nxt; int ui = 0;
    if (!S.next(0, cur)) return;
    f32x4 acc[2][2][4][2];
#pragma unroll
    for (int a = 0; a < 2; ++a)
#pragma unroll
        for (int b = 0; b < 2; ++b)
#pragma unroll
            for (int m = 0; m < 4; ++m)
#pragma unroll
                for (int n = 0; n < 2; ++n) acc[a][b][m][n] = (f32x4){0.f, 0.f, 0.f, 0.f};
    bf16x8 At[4][2], B0[2][2], B1[2][2];
    const char* cA = (const char*)g.A + (size_t)cur.pm * tstep; const char* cB = (const char*)g.Bt + (size_t)cur.pn * tstep;
    S.a_ready(cur);
    if constexpr (SP2) {
        PG8_STAGE(PG8_SB(0, 0), cB, voffB); PG8_STAGE(PG8_SB(0, 1), cB + hstep, voffB); PG8_STAGE(PG8_SA(0, 0), cA, voffA); PG8_STAGE(PG8_SA(0, 1), cA + hstep, voffA);
        if (wr == 1) PG8_BAR;
        PG8_WAIT_V(2); PG8_BAR;
        PG8_STAGE(PG8_SB(1, 0), cB + kstep, voffB); PG8_STAGE(PG8_SA(1, 0), cA + kstep, voffA); PG8_STAGE(PG8_SB(1, 1), cB + hstep + kstep, voffB);
        PG8_WAIT_V(6); PG8_BAR;
    } else {
        PG8_STAGE(PG8_SB(0, 0), cB, voffB); PG8_STAGE(PG8_SA(0, 0), cA, voffA); PG8_STAGE(PG8_SB(0, 1), cB + hstep, voffB); PG8_STAGE(PG8_SA(0, 1), cA + hstep, voffA);
        if (wr == 1) PG8_BAR;
        PG8_WAIT_V(4); PG8_BAR;
        PG8_STAGE(PG8_SB(1, 0), cB + kstep, voffB); PG8_STAGE(PG8_SA(1, 0), cA + kstep, voffA); PG8_STAGE(PG8_SB(1, 1), cB + hstep + kstep, voffB);
        PG8_WAIT_V(6); PG8_BAR;
    }
    for (;;) {
        const bool has_next = S.next(ui + 1, nxt);
        const char* nA = has_next ? (const char*)g.A + (size_t)nxt.pm * tstep : cA; const char* nB = has_next ? (const char*)g.Bt + (size_t)nxt.pn * tstep : cB;
        for (int t = 0; t < nt; t += 2) {
            const bool last = (t == nt - 2);
            const char* a1 = cA + (size_t)(t + 1) * kstep;
            const char* a2 = last ? nA : cA + (size_t)(t + 2) * kstep; const char* b2 = last ? nB : cB + (size_t)(t + 2) * kstep;
            const char* a3 = a2 + kstep; const char* b3 = b2 + kstep;
            if (last && has_next) S.a_ready(nxt);
            if constexpr (SP2) {
            PG8_LDB(B0, 0, 0); PG8_LDB(B1, 0, 1); PG8_SCHED; PG8_LDA(At, 0, 0); PG8_STAGE(PG8_SA(1, 1), a1 + hstep, voffA);
            PG8_WAIT_V(8); PG8_WAIT_L(0); PG8_BAR; PG8_MMA(0, 0, At, B0); PG8_MMA(0, 1, At, B1); PG8_BAR; PG8_SCHED;
            PG8_LDA(At, 0, 1); PG8_STAGE(PG8_SB(0, 0), b2, voffB); PG8_STAGE(PG8_SB(0, 1), b2 + hstep, voffB); PG8_STAGE(PG8_SA(0, 0), a2, voffA);
            PG8_WAIT_V(8); PG8_WAIT_L(0); PG8_BAR; PG8_MMA(1, 0, At, B0); PG8_MMA(1, 1, At, B1); PG8_BAR; PG8_SCHED;
            PG8_LDB(B0, 1, 0); PG8_LDB(B1, 1, 1); PG8_SCHED; PG8_LDA(At, 1, 0); PG8_STAGE(PG8_SA(0, 1), a2 + hstep, voffA);
            PG8_WAIT_V(8); PG8_WAIT_L(0); PG8_BAR; PG8_MMA(0, 0, At, B0); PG8_MMA(0, 1, At, B1); PG8_BAR; PG8_SCHED;
            PG8_LDA(At, 1, 1); PG8_STAGE(PG8_SB(1, 0), b3, voffB); PG8_STAGE(PG8_SB(1, 1), b3 + hstep, voffB); PG8_STAGE(PG8_SA(1, 0), a3, voffA);
            PG8_WAIT_V(8); PG8_WAIT_L(0); PG8_BAR; PG8_MMA(1, 0, At, B0); PG8_MMA(1, 1, At, B1); PG8_BAR; PG8_SCHED;
            } else {
            PG8_LDB(B0, 0, 0); PG8_SCHED; PG8_LDA(At, 0, 0); PG8_STAGE(PG8_SA(1, 1), a1 + hstep, voffA);
            PG8_WAIT_L(8); PG8_BAR; PG8_WAIT_L(0); PG8_MMA(0, 0, At, B0); PG8_BAR; PG8_SCHED;
            PG8_LDB(B1, 0, 1); PG8_STAGE(PG8_SB(0, 0), b2, voffB);
            PG8_BAR; PG8_WAIT_L(0); PG8_MMA(0, 1, At, B1); PG8_BAR;
            PG8_LDA(At, 0, 1); PG8_STAGE(PG8_SA(0, 0), a2, voffA);
            PG8_BAR; PG8_WAIT_L(0); PG8_MMA(1, 0, At, B0); PG8_BAR; PG8_SCHED;
            PG8_STAGE(PG8_SB(0, 1), b2 + hstep, voffB);
            PG8_WAIT_V(6); PG8_BAR; PG8_MMA(1, 1, At, B1); PG8_BAR;
            PG8_LDB(B0, 1, 0); PG8_SCHED; PG8_LDA(At, 1, 0); PG8_STAGE(PG8_SA(0, 1), a2 + hstep, voffA);
            PG8_WAIT_L(8); PG8_BAR; PG8_WAIT_L(0); PG8_MMA(0, 0, At, B0); PG8_BAR; PG8_SCHED;
            PG8_LDB(B1, 1, 1); PG8_STAGE(PG8_SB(1, 0), b3, voffB);
            PG8_BAR; PG8_WAIT_L(0); PG8_MMA(0, 1, At, B1); PG8_BAR;
            PG8_LDA(At, 1, 1); PG8_STAGE(PG8_SA(1, 0), a3, voffA);
            PG8_BAR; PG8_WAIT_L(0); PG8_MMA(1, 0, At, B0); PG8_BAR; PG8_SCHED;
            PG8_STAGE(PG8_SB(1, 1), b3 + hstep, voffB);
            PG8_WAIT_V(6); PG8_BAR; PG8_MMA(1, 1, At, B1); PG8_BAR;
            }
        }
        if constexpr (ALIGN_EPI) { if (wr == 0) PG8_BAR; }
        if constexpr (!Epi::AFTER_DRAIN) { E(acc, cur, wr, wc, fr, fq); S.done(cur); }
        if (!has_next) break;
#pragma unroll
        for (int a = 0; a < 2; ++a)
#pragma unroll
            for (int b = 0; b < 2; ++b)
#pragma unroll
                for (int m = 0; m < 4; ++m)
#pragma unroll
                    for (int n = 0; n < 2; ++n) acc[a][b][m][n] = (f32x4){0.f, 0.f, 0.f, 0.f};
        cur = nxt; cA = nA; cB = nB; ++ui;
        if constexpr (ALIGN_EPI) { if (wr == 1) PG8_BAR; }
    }
    PG8_WAIT_V(0);
    if constexpr (!ALIGN_EPI) { if (wr == 0) PG8_BAR; }
    PG8_BAR;
    if constexpr (Epi::AFTER_DRAIN) { E.fused(acc, cur, wr, wc, fr, fq, lds, wid, lane); S.done(cur); }
#undef PG8_SA
#undef PG8_SB
#undef PG8_STAGE
#undef PG8_LDA
#undef PG8_LDB
#undef PG8_MMA
#undef PG8_WAIT_V
#undef PG8_WAIT_L
#undef PG8_BAR
#undef PG8_SCHED
}
}

#ifndef PG8_SP2
#define PG8_SP2 true
#endif
#ifndef PG8_ALIGN
#define PG8_ALIGN true
#endif
constexpr int BATCH = 8, SEQ = 2048, DM = 1024, MROWS = BATCH * SEQ, DEPTH = 2;
constexpr int D_RNN = 512, NHEAD = 8, HDIM = 64, D_INR = 2760, ZP = 2816, TOPK = 256;
constexpr int C_XR = 0, C_GR = 512, C_Q = 1024, C_K = 1536, C_V = 1600, C_GA = 1664, C_QI = 2176, C_KI = 2688, C_WI = 2752;
constexpr float EPS = 1e-6f;
constexpr float QSCALE = 0.125f * 1.4426950408889634f;
constexpr size_t MiB = 1u << 20;
constexpr size_t WS_CTL = 0, CTL_ZERO_BYTES = 1 * MiB;
constexpr size_t WS_MOD = 1 * MiB;
constexpr size_t WS_BIAS = 1 * MiB + 256 * 1024;
constexpr size_t WS_SSQ = 2 * MiB;
constexpr size_t WS_WTIN = 3 * MiB;
constexpr size_t WS_WTOUT = 14 * MiB;
constexpr size_t WS_A = 32 * MiB;
constexpr size_t WS_Z = 64 * MiB;
constexpr size_t WS_Y = 152 * MiB;
constexpr size_t WS_X1 = 184 * MiB;
constexpr size_t WS_END = 216 * MiB;
constexpr int LDS_BYTES = 163840;
constexpr int MISC_OFF = 131072 + 8192;
constexpr int NPHASE = 8;
constexpr int CW_BAR = 4096, CW_PANEL = 16384;

#define LAS __attribute__((address_space(3)))
typedef unsigned short bf16;
typedef float f32x4 __attribute__((ext_vector_type(4)));
typedef unsigned u32x4 __attribute__((ext_vector_type(4)));
typedef unsigned u32x2 __attribute__((ext_vector_type(2)));
__device__ __forceinline__ float bf2f(bf16 v) { return __uint_as_float(((unsigned)v) << 16); }
__device__ __forceinline__ unsigned f2bf(float f) { unsigned u = __float_as_uint(f); return (u + 0x7fffu + ((u >> 16) & 1u)) >> 16; }
__device__ __forceinline__ unsigned pk2(float lo, float hi) { return f2bf(lo) | (f2bf(hi) << 16); }
__device__ __forceinline__ float wave_sum(float v) {
#pragma unroll
    for (int o = 1; o < 64; o <<= 1) v += __shfl_xor(v, o);
    return v;
}
__device__ __forceinline__ float wave_max(float v) {
#pragma unroll
    for (int o = 1; o < 64; o <<= 1) v = fmaxf(v, __shfl_xor(v, o));
    return v;
}
__device__ __forceinline__ int wave_sum_i(int v) {
#pragma unroll
    for (int o = 1; o < 64; o <<= 1) v += __shfl_xor(v, o);
    return v;
}
__device__ __forceinline__ float siluf(float v) { return v / (1.f + expf(-v)); }
__device__ __forceinline__ float sigmf(float v) { return 1.f / (1.f + expf(-v)); }

struct P {
    const float *x, *c, *norm_g, *ada_w, *ada_b, *w_in, *conv_w, *conv_b, *lru_wx, *lru_bx, *lru_wa, *lru_ba, *lru_a, *w_out, *final_g;
    float* out;
    float *mod, *bias, *ssq;
    bf16 *wt_in, *wt_out, *A, *Z, *Y, *X1;
    unsigned* ctl;
};

#ifndef EPI_ZD
#define EPI_ZD 2
#endif
struct EpiZ {
    static constexpr bool PERM = true, AFTER_DRAIN = false;
    bf16* Zp; const float* ssq; const float* bias;
    __device__ __forceinline__ void operator()(const pg8::f32x4 (&acc)[2][2][4][2], const pg8::Unit& u, int wr, int wc, int fr, int fq) const {
        const int row0 = u.pm * 256 + wr * 64 + fr, col0 = u.pn * 256 + wc * 32 + 8 * fq, b = u.pm >> 3;
        const float cs = (u.pn == 4 || u.pn == 5) ? QSCALE : 1.0f;
        f32x4 bv[2][2];
#pragma unroll
        for (int bj = 0; bj < 2; ++bj)
#pragma unroll
            for (int n = 0; n < 2; ++n) bv[bj][n] = *(const f32x4*)(bias + b * ZP + col0 + bj * 128 + 4 * n);
        f32x4 qq[EPI_ZD];
#pragma unroll
        for (int gi = 0; gi < EPI_ZD; ++gi) qq[gi] = *(const f32x4*)(ssq + (size_t)(row0 + (gi >> 2) * 128 + (gi & 3) * 16) * 4);
#pragma unroll
        for (int ai = 0; ai < 2; ++ai)
#pragma unroll
            for (int m = 0; m < 4; ++m) {
                const int r = row0 + ai * 128 + m * 16, gi = ai * 4 + m;
                const f32x4 q = qq[gi % EPI_ZD];
                if (gi + EPI_ZD < 8) qq[gi % EPI_ZD] = *(const f32x4*)(ssq + (size_t)(row0 + ((gi + EPI_ZD) >> 2) * 128 + ((gi + EPI_ZD) & 3) * 16) * 4);
                const float rstd = 1.0f / sqrtf(((q.x + q.y) + (q.z + q.w)) * (1.0f / 1024.0f) + EPS);
                bf16* rowp = Zp + (size_t)r * ZP + col0;
#pragma unroll
                for (int bj = 0; bj < 2; ++bj) {
                    const f32x4 v0 = (acc[ai][bj][m][0] * rstd + bv[bj][0]) * cs, v1 = (acc[ai][bj][m][1] * rstd + bv[bj][1]) * cs;
                    u32x4 w; w.x = pk2(v0[0], v0[1]); w.y = pk2(v0[2], v0[3]); w.z = pk2(v1[0], v1[1]); w.w = pk2(v1[2], v1[3]);
                    *(u32x4*)(rowp + bj * 128) = w;
                }
            }
    }
};
#ifndef EPI_XD
#define EPI_XD 4
#endif
struct EpiX {
    static constexpr bool PERM = true, AFTER_DRAIN = true;
    const float* xres; bf16* xout; bf16* Anext; const float* gate; const float* ng; const float* nscale; float* ssq;
    __device__ __forceinline__ void fused(pg8::f32x4 (&acc)[2][2][4][2], const pg8::Unit& u, int wr, int wc, int fr, int fq, LAS unsigned char* lds, int wid, int lane) const {
        const int b = u.pm >> 3, col0 = u.pn * 256 + wc * 32 + 8 * fq;
        LAS float* Pp = (LAS float*)lds;
        f32x4 gv[2][2], gs[2][2];
#pragma unroll
        for (int bj = 0; bj < 2; ++bj)
#pragma unroll
            for (int n = 0; n < 2; ++n) {
                gv[bj][n] = *(const f32x4*)(gate + b * 3072 + col0 + bj * 128 + 4 * n);
                if (Anext) { const f32x4 g = *(const f32x4*)(ng + col0 + bj * 128 + 4 * n), s = *(const f32x4*)(nscale + b * 3072 + col0 + bj * 128 + 4 * n); gs[bj][n] = g * (s + 1.0f); }
                else gs[bj][n] = (f32x4){0.f, 0.f, 0.f, 0.f};
            }
        f32x4 xq[EPI_XD][2][2];
#define EPIX_LOAD(gi) do { const size_t r_ = (size_t)u.pm * 256 + ((gi) >> 2) * 128 + wr * 64 + ((gi) & 3) * 16 + fr; \
        _Pragma("unroll") for (int bj = 0; bj < 2; ++bj) _Pragma("unroll") for (int n = 0; n < 2; ++n) xq[(gi) % EPI_XD][bj][n] = *(const f32x4*)(xres + r_ * DM + col0 + bj * 128 + 4 * n); } while (0)
#pragma unroll
        for (int gi = 0; gi < EPI_XD; ++gi) EPIX_LOAD(gi);
#pragma unroll
        for (int ai = 0; ai < 2; ++ai)
#pragma unroll
            for (int m = 0; m < 4; ++m) {
                const int rl = ai * 128 + wr * 64 + m * 16 + fr; const size_t r = (size_t)u.pm * 256 + rl;
                float s = 0.f;
                f32x4 xc[2][2];
#pragma unroll
                for (int bj = 0; bj < 2; ++bj)
#pragma unroll
                    for (int n = 0; n < 2; ++n) xc[bj][n] = xq[(ai * 4 + m) % EPI_XD][bj][n];
                if (ai * 4 + m + EPI_XD < 8) EPIX_LOAD(ai * 4 + m + EPI_XD);
#pragma unroll
                for (int bj = 0; bj < 2; ++bj) {
                    f32x4 x1[2];
#pragma unroll
                    for (int n = 0; n < 2; ++n) {
                        const f32x4 xr = xc[bj][n];
                        x1[n] = xr + gv[bj][n] * acc[ai][bj][m][n];
                        s += (x1[n][0] * x1[n][0] + x1[n][1] * x1[n][1]) + (x1[n][2] * x1[n][2] + x1[n][3] * x1[n][3]);
                    }
                    { u32x4 xw; xw.x = pk2(x1[0][0], x1[0][1]); xw.y = pk2(x1[0][2], x1[0][3]); xw.z = pk2(x1[1][0], x1[1][1]); xw.w = pk2(x1[1][2], x1[1][3]);
                      *(u32x4*)(xout + r * DM + col0 + bj * 128) = xw; }
                    if (Anext) { const f32x4 a0 = x1[0] * gs[bj][0], a1 = x1[1] * gs[bj][1];
                        u32x4 w; w.x = pk2(a0[0], a0[1]); w.y = pk2(a0[2], a0[3]); w.z = pk2(a1[0], a1[1]); w.w = pk2(a1[2], a1[3]);
                        *(u32x4*)(Anext + r * DM + col0 + bj * 128) = w; }
                }
                s += __shfl_xor(s, 16); s += __shfl_xor(s, 32);
                if (fq == 0) Pp[rl * 4 + wc] = s;
            }
        __syncthreads();
        const int tid = wid * 64 + lane;
        if (tid < 256) ssq[((size_t)u.pm * 256 + tid) * 4 + u.pn] = (Pp[tid * 4 + 0] + Pp[tid * 4 + 1]) + (Pp[tid * 4 + 2] + Pp[tid * 4 + 3]);
        __syncthreads();
    }
};

struct EpiXF {
    static constexpr bool PERM = true, AFTER_DRAIN = true;
    const bf16* xres; float* out; const float* gate; const float* fg; float* ssq; unsigned* cnt;
    __device__ __forceinline__ void fused(pg8::f32x4 (&acc)[2][2][4][2], const pg8::Unit& u, int wr, int wc, int fr, int fq, LAS unsigned char* lds, int wid, int lane) const {
        const int b = u.pm >> 3, col0 = u.pn * 256 + wc * 32 + 8 * fq, tid = wid * 64 + lane;
        LAS float* Pp = (LAS float*)lds;
        LAS float* Sr = (LAS float*)(lds + 4096);
        {
            f32x4 gv[2][2];
#pragma unroll
            for (int bj = 0; bj < 2; ++bj)
#pragma unroll
                for (int n = 0; n < 2; ++n) gv[bj][n] = *(const f32x4*)(gate + b * 3072 + col0 + bj * 128 + 4 * n);
#pragma unroll
            for (int ai = 0; ai < 2; ++ai)
#pragma unroll
                for (int m = 0; m < 4; ++m) {
                    const int rl = ai * 128 + wr * 64 + m * 16 + fr; const size_t r = (size_t)u.pm * 256 + rl;
                    float s = 0.f;
#pragma unroll
                    for (int bj = 0; bj < 2; ++bj) {
                        const u32x4 xw = *(const u32x4*)(xres + r * DM + col0 + bj * 128);
#pragma unroll
                        for (int n = 0; n < 2; ++n) {
                            const unsigned w0 = n ? xw.z : xw.x, w1 = n ? xw.w : xw.y;
                            const f32x4 xr = {__uint_as_float(w0 << 16), __uint_as_float(w0 & 0xffff0000u), __uint_as_float(w1 << 16), __uint_as_float(w1 & 0xffff0000u)};
                            const f32x4 x1 = xr + gv[bj][n] * acc[ai][bj][m][n];
                            acc[ai][bj][m][n] = x1;
                            s += (x1[0] * x1[0] + x1[1] * x1[1]) + (x1[2] * x1[2] + x1[3] * x1[3]);
                        }
                    }
                    s += __shfl_xor(s, 16); s += __shfl_xor(s, 32);
                    if (fq == 0) Pp[rl * 4 + wc] = s;
                }
        }
        __syncthreads();
        if (tid < 256) { const float tot = (Pp[tid * 4 + 0] + Pp[tid * 4 + 1]) + (Pp[tid * 4 + 2] + Pp[tid * 4 + 3]);
            __hip_atomic_store(ssq + ((size_t)u.pm * 256 + tid) * 4 + u.pn, tot, __ATOMIC_RELAXED, __HIP_MEMORY_SCOPE_AGENT); }
        asm volatile("s_waitcnt vmcnt(0)" ::: "memory");
        __syncthreads();
        if (tid == 0) {
            unsigned* c = cnt + 64 * u.pm;
            __hip_atomic_fetch_add(c, 1u, __ATOMIC_RELAXED, __HIP_MEMORY_SCOPE_AGENT);
            unsigned spins = 0u;
            while (__hip_atomic_load(c, __ATOMIC_RELAXED, __HIP_MEMORY_SCOPE_AGENT) < 4u) { __builtin_amdgcn_s_sleep(2); if (++spins > (1u << 22)) break; }
            __builtin_amdgcn_fence(__ATOMIC_ACQUIRE, "agent");
            asm volatile("s_waitcnt vmcnt(0)" ::: "memory");
        }
        __syncthreads();
        if (tid < 256) { const float* sp = ssq + ((size_t)u.pm * 256 + tid) * 4;
            const float q0 = __hip_atomic_load(sp + 0, __ATOMIC_RELAXED, __HIP_MEMORY_SCOPE_AGENT), q1 = __hip_atomic_load(sp + 1, __ATOMIC_RELAXED, __HIP_MEMORY_SCOPE_AGENT);
            const float q2 = __hip_atomic_load(sp + 2, __ATOMIC_RELAXED, __HIP_MEMORY_SCOPE_AGENT), q3 = __hip_atomic_load(sp + 3, __ATOMIC_RELAXED, __HIP_MEMORY_SCOPE_AGENT);
            Sr[tid] = 1.0f / sqrtf(((q0 + q1) + (q2 + q3)) * (1.0f / 1024.0f) + EPS); }
        __syncthreads();
        f32x4 fgv[2][2];
#pragma unroll
        for (int bj = 0; bj < 2; ++bj)
#pragma unroll
            for (int n = 0; n < 2; ++n) fgv[bj][n] = *(const f32x4*)(fg + col0 + bj * 128 + 4 * n);
#pragma unroll
        for (int ai = 0; ai < 2; ++ai)
#pragma unroll
            for (int m = 0; m < 4; ++m) {
                const int rl = ai * 128 + wr * 64 + m * 16 + fr; const size_t r = (size_t)u.pm * 256 + rl; const float rstd = Sr[rl];
#pragma unroll
                for (int bj = 0; bj < 2; ++bj)
#pragma unroll
                    for (int n = 0; n < 2; ++n) *(f32x4*)(out + r * DM + col0 + bj * 128 + 4 * n) = acc[ai][bj][m][n] * rstd * fgv[bj][n];
            }
        __syncthreads();
    }
};

#ifndef PRO_KC
#define PRO_KC 64
#endif
#ifndef TRQ
#define TRQ 4
#endif
__device__ __forceinline__ void ph0_prologue(const P& p, LAS unsigned char* lds) {
    const int tid = threadIdx.x, lane = tid & 63, wave = tid >> 6, G = gridDim.x, wg = blockIdx.x;
    LAS float* fl = (LAS float*)lds;
    for (int u = wg; u < 96; u += G) {
        const int l = u / 48, j = (u % 48) * 64 + lane;
        { float cv[16];
#pragma unroll
          for (int i = 0; i < 16; ++i) cv[i] = p.c[tid + 512 * i];
#pragma unroll
          for (int i = 0; i < 16; ++i) fl[tid + 512 * i] = siluf(cv[i]); }
        __syncthreads();
        float acc[8];
#pragma unroll
        for (int b = 0; b < 8; ++b) acc[b] = 0.f;
        const float* w = p.ada_w + ((size_t)l * 1024 + wave * 128) * 3072 + j;
#pragma unroll 1
        for (int k0 = 0; k0 < 128; k0 += PRO_KC) { float wv[PRO_KC];
#pragma unroll
          for (int k = 0; k < PRO_KC; ++k) wv[k] = w[(size_t)(k0 + k) * 3072];
#pragma unroll
          for (int k = 0; k < PRO_KC; ++k) {
#pragma unroll
            for (int b = 0; b < 8; ++b) acc[b] += fl[b * 1024 + wave * 128 + k0 + k] * wv[k]; } }
#pragma unroll
        for (int b = 0; b < 8; ++b) fl[8192 + (wave * 8 + b) * 64 + lane] = acc[b];
        __syncthreads();
        { const int b = wave; float s = p.ada_b[l * 3072 + j];
#pragma unroll
          for (int w8 = 0; w8 < 8; ++w8) s += fl[8192 + (w8 * 8 + b) * 64 + lane];
          p.mod[(l * 8 + b) * 3072 + j] = s; }
        __syncthreads();
    }
    const int GT = (G > 96) ? G - 96 : G, wt = (G > 96) ? wg - 96 : wg;
    if (wt >= 0)
#pragma unroll 1
    for (int u0 = wt; u0 < 1920; u0 += TRQ * GT) {
        float v[TRQ][8]; bf16* dst[TRQ]; bool act[TRQ];
#pragma unroll
        for (int q = 0; q < TRQ; ++q) {
            const int u = u0 + q * GT; act[q] = u < 1920; dst[q] = nullptr;
#pragma unroll
            for (int j = 0; j < 8; ++j) v[q][j] = 0.f;
            if (act[q]) {
                const float* W; bf16* WT; int N, kt, nt;
                if (u < 1408) { const int l = u / 704, r = u % 704; kt = r / 44; nt = r % 44; W = p.w_in + (size_t)l * 1024 * D_INR; N = D_INR; WT = p.wt_in + (size_t)l * ZP * 1024; }
                else { int r = u - 1408; const int l = r / 256; r %= 256; kt = r / 16; nt = r % 16; W = p.w_out + (size_t)l * 1024 * 1024; N = 1024; WT = p.wt_out + (size_t)l * 1024 * 1024; }
                const int n = nt * 64 + lane, k0 = kt * 64 + wave * 8;
                if (n < N) {
#pragma unroll
                    for (int j = 0; j < 8; ++j) v[q][j] = W[(size_t)(k0 + j) * N + n];
                }
                dst[q] = WT + (size_t)n * 1024 + k0;
            }
        }
#pragma unroll
        for (int q = 0; q < TRQ; ++q) if (act[q]) { u32x4 o; o.x = pk2(v[q][0], v[q][1]); o.y = pk2(v[q][2], v[q][3]); o.z = pk2(v[q][4], v[q][5]); o.w = pk2(v[q][6], v[q][7]); *(u32x4*)dst[q] = o; }
    }
}
__device__ __forceinline__ void ph1_prologue(const P& p, LAS unsigned char* lds) {
    const int tid = threadIdx.x, lane = tid & 63, wave = tid >> 6, G = gridDim.x, wg = blockIdx.x;
    LAS float* fl = (LAS float*)lds;
    for (int u = wg; u < 88; u += G) {
        const int l = u / 44, n = (u % 44) * 64 + lane;
        { float mv[16];
#pragma unroll
          for (int i = 0; i < 16; ++i) { const int e = tid + 512 * i; mv[i] = p.mod[(l * 8 + (e >> 10)) * 3072 + (e & 1023)]; }
#pragma unroll
          for (int i = 0; i < 16; ++i) fl[tid + 512 * i] = mv[i]; }
        __syncthreads();
        float acc[8];
#pragma unroll
        for (int b = 0; b < 8; ++b) acc[b] = 0.f;
        if (n < D_INR) { const float* w = p.w_in + ((size_t)l * 1024 + wave * 128) * D_INR + n;
#pragma unroll 1
            for (int k0 = 0; k0 < 128; k0 += PRO_KC) { float wv[PRO_KC];
#pragma unroll
              for (int k = 0; k < PRO_KC; ++k) wv[k] = w[(size_t)(k0 + k) * D_INR];
#pragma unroll
              for (int k = 0; k < PRO_KC; ++k) {
#pragma unroll
                for (int b = 0; b < 8; ++b) acc[b] += fl[b * 1024 + wave * 128 + k0 + k] * wv[k]; } } }
#pragma unroll
        for (int b = 0; b < 8; ++b) fl[8192 + (wave * 8 + b) * 64 + lane] = acc[b];
        __syncthreads();
        { const int b = wave; float s = 0.f;
#pragma unroll
          for (int w8 = 0; w8 < 8; ++w8) s += fl[8192 + (w8 * 8 + b) * 64 + lane];
          p.bias[(l * 8 + b) * ZP + n] = s; }
        __syncthreads();
    }
    {
        const int r0 = wg * 8 + wave, rstep = G * 8;
        f32x4 gq[4], xv[2][2][4], sv[2][2][4];
#pragma unroll
        for (int j = 0; j < 4; ++j) gq[j] = *(const f32x4*)(p.norm_g + (lane + 64 * j) * 4);
#define A0_LOAD(slot, pr) do { _Pragma("unroll") for (int h_ = 0; h_ < 2; ++h_) _Pragma("unroll") for (int j = 0; j < 4; ++j) { const int k_ = (lane + 64 * j) * 4, r_ = r0 + rstep * (2 * (pr) + h_); \
            xv[slot][h_][j] = *(const f32x4*)(p.x + (size_t)r_ * DM + k_); sv[slot][h_][j] = *(const f32x4*)(p.mod + (size_t)(r_ >> 11) * 3072 + 1024 + k_); } } while (0)
        A0_LOAD(0, 0);
#pragma unroll
        for (int pr = 0; pr < 4; ++pr) {
            if (pr + 1 < 4) A0_LOAD((pr + 1) & 1, pr + 1);
#pragma unroll
            for (int h = 0; h < 2; ++h) {
                const int r = r0 + rstep * (2 * pr + h); float s1 = 0.f;
#pragma unroll
                for (int j = 0; j < 4; ++j) { const int k = (lane + 64 * j) * 4; const f32x4 v = xv[pr & 1][h][j];
                    s1 += (v[0] * v[0] + v[1] * v[1]) + (v[2] * v[2] + v[3] * v[3]);
                    const f32x4 o1 = v * gq[j] * (sv[pr & 1][h][j] + 1.0f);
                    u32x2 w1; w1.x = pk2(o1[0], o1[1]); w1.y = pk2(o1[2], o1[3]);
                    *(u32x2*)(p.A + (size_t)r * DM + k) = w1; }
                s1 = wave_sum(s1);
                if (lane == 0) *(f32x4*)(p.ssq + (size_t)r * 4) = (f32x4){s1, 0.f, 0.f, 0.f};
            }
        }
#undef A0_LOAD
    }
}
__device__ __forceinline__ void ph_final(const P& p) {
    const int tid = threadIdx.x, lane = tid & 63, wave = tid >> 6, G = gridDim.x, wg = blockIdx.x;
    for (int r = wg * 8 + wave; r < MROWS; r += G * 8) {
        const f32x4 q = *(const f32x4*)(p.ssq + (size_t)r * 4);
        const float rstd = 1.0f / sqrtf(((q.x + q.y) + (q.z + q.w)) * (1.0f / 1024.0f) + EPS);
#pragma unroll
        for (int j = 0; j < 4; ++j) { const int k = (lane + 64 * j) * 4;
            const f32x4 v = *(const f32x4*)(p.out + (size_t)r * DM + k), g = *(const f32x4*)(p.final_g + k);
            *(f32x4*)(p.out + (size_t)r * DM + k) = v * rstd * g; }
    }
}
#define XB_TMO      128
#define XB_XCNT(j)  (256  + 64 * (j))
#define XB_XSUB(j)  (1280 + 64 * (j))
#define XB_XGEN(j)  (2304 + 64 * (j))
#define XB_TOP      3328
#define XB_TOPGEN   3392
#define XCD_BAR_WORDS 3456
#define XB_SPIN_CAP (1u << 18)

__device__ __forceinline__ unsigned xb_ld(unsigned* p)              { return __hip_atomic_load(p, __ATOMIC_RELAXED, __HIP_MEMORY_SCOPE_AGENT); }
__device__ __forceinline__ unsigned xb_add(unsigned* p, unsigned v) { return __hip_atomic_fetch_add(p, v, __ATOMIC_RELAXED, __HIP_MEMORY_SCOPE_AGENT); }
__device__ __forceinline__ unsigned xb_xcc_id() { return (unsigned)__builtin_amdgcn_s_getreg((3 << 11) | 20) & 0xFu; }
#define XB_SPIN(cond, bar) do { unsigned _sp = 0; while (cond) { __builtin_amdgcn_s_sleep(1); \
    if ((++_sp & 255u) == 0u) { if (xb_ld(&(bar)[XB_TMO])) break; if (_sp > XB_SPIN_CAP) { atomicAdd(&(bar)[XB_TMO], 1u); break; } } } } while (0)

struct XcdBarrier {
    unsigned* bar; unsigned x;
    volatile LAS unsigned* st;
};

__device__ __forceinline__ XcdBarrier xcd_barrier_post(unsigned* bar, volatile LAS unsigned* st) {
    XcdBarrier b; b.bar = bar; b.x = xb_xcc_id(); b.st = st;
    if (threadIdx.x == 0) (void)xb_add(&bar[XB_XCNT(b.x)], 1u);
    return b;
}
__device__ __forceinline__ void xcd_barrier_complete(unsigned* bar, unsigned x, unsigned& nloc, unsigned& nx) {
    const unsigned G = gridDim.x * gridDim.y * gridDim.z;
    unsigned sum, cnt, mine, sp = 0u;
    for (;;) {
        sum = 0u; cnt = 0u; mine = 0u;
#pragma unroll
        for (unsigned j = 0; j < 16; ++j) { const unsigned c = xb_ld(&bar[XB_XCNT(j)]); sum += c; cnt += (c > 0u) ? 1u : 0u; mine = (j == x) ? c : mine; }
        if (sum == G) break;
        __builtin_amdgcn_s_sleep(1);
        if ((++sp & 255u) == 0u) { if (xb_ld(&bar[XB_TMO])) break; if (sp > XB_SPIN_CAP) { atomicAdd(&bar[XB_TMO], 1u); break; } }
    }
    nloc = mine > 0u ? mine : 1u; nx = cnt > 0u ? cnt : 1u;
}

__device__ __forceinline__ void xcd_barrier(const XcdBarrier& b) {
    asm volatile("s_waitcnt vmcnt(0)" ::: "memory");
    __syncthreads();
    if (threadIdx.x == 0) {
        unsigned* bar = b.bar;
        __builtin_amdgcn_s_waitcnt(0);
        unsigned nloc = b.st[0], nx = b.st[1];
        if (nloc == 0u) { xcd_barrier_complete(bar, b.x, nloc, nx); b.st[0] = nloc; b.st[1] = nx; }
        const unsigned old = xb_add(&bar[XB_XSUB(b.x)], 1u);
        const unsigned gen = old / nloc;
        if (old + 1u == (gen + 1u) * nloc) {
            __builtin_amdgcn_fence(__ATOMIC_RELEASE, "agent");
            asm volatile("s_waitcnt vmcnt(0)" ::: "memory");
            const unsigned og = xb_add(&bar[XB_TOP], 1u);
            const unsigned tg = og / nx;
            if (og + 1u == (tg + 1u) * nx) xb_add(&bar[XB_TOPGEN], 1u);
            else XB_SPIN(xb_ld(&bar[XB_TOPGEN]) == tg, bar);
            __builtin_amdgcn_fence(__ATOMIC_ACQUIRE, "agent");
            xb_add(&bar[XB_XGEN(b.x)], 1u);
            asm volatile("s_waitcnt vmcnt(0)" ::: "memory");
        } else {
            XB_SPIN(xb_ld(&bar[XB_XGEN(b.x)]) == gen, bar);
            __builtin_amdgcn_fence(__ATOMIC_ACQUIRE, "agent");
            asm volatile("s_waitcnt vmcnt(0)" ::: "memory");
        }
    }
    __syncthreads();
}
__device__ __forceinline__ unsigned score_ukey(float s) { const unsigned u = __float_as_uint(s + 0.0f); return (u & 0x80000000u) ? ~u : (u | 0x80000000u); }
__device__ __forceinline__ void topk_threshold(const unsigned (&k)[32], unsigned& thr, unsigned& need) {
    unsigned prefix = 0u; bool exact = false;
    for (int bit = 31; bit >= 0; --bit) {
        const unsigned cand = prefix | (1u << bit);
        int c = 0;
#pragma unroll
        for (int i = 0; i < 32; ++i) c += (k[i] >= cand) ? 1 : 0;
        c = wave_sum_i(c);
        if (c >= TOPK) prefix = cand;
        if (c == TOPK) { exact = true; break; }
    }
    thr = prefix;
    if (exact) { need = 0xffffffffu; }
    else { int c = 0;
#pragma unroll
        for (int i = 0; i < 32; ++i) c += (k[i] > prefix) ? 1 : 0;
        c = wave_sum_i(c); need = (unsigned)(TOPK - c); }
}
#ifndef PROBE_VALU
#define PROBE_VALU 0
#endif
#ifndef RP_T3
#define RP_T3 1
#endif
#ifndef RP_T1
#define RP_T1 1
#endif
#ifndef RP_T2
#define RP_T2 1
#endif
#ifndef RP_I
#define RP_I 1
#endif
#ifndef RP_T
#define RP_T 1
#endif
#ifndef RP_V
#define RP_V 1
#endif
typedef short bf16x8v __attribute__((ext_vector_type(8)));
typedef short s16x4v __attribute__((ext_vector_type(4)));
constexpr int BMS = 65;
constexpr int SCP = 2052;
constexpr int DSA_BM_OFF = 16 * SCP * 4;
constexpr int DSA_RING_OFF = 0;
constexpr int DSA_QIB_OFF = 147456;
constexpr int DSA_WIB_OFF = 135680;
constexpr int DSA_MLUT_OFF = 143616;
__device__ __forceinline__ void glds16(const void* gsrc, unsigned lds_dst) { unsigned keep;
    asm volatile("s_mov_b32 %0, m0\n\ts_mov_b32 m0, %2\n\ts_nop 0\n\tglobal_load_lds_dwordx4 %1, off\n\ts_mov_b32 m0, %0" : "=&s"(keep) : "v"(gsrc), "s"(lds_dst) : "memory"); }
template <int I> __device__ __forceinline__ unsigned mbit_t(int mw) { unsigned r; asm("v_bfe_i32 %0, %1, %2, 1" : "=v"(r) : "v"(mw), "i"(I)); return r; }
#define mbit(mw, i) mbit_t<(i)>(mw)
__device__ __forceinline__ float relu_i(float x) { return __int_as_float(max(__float_as_int(x), 0)); }
__device__ __forceinline__ int imax3(float a, float b, float c) { return max(max(__float_as_int(a), __float_as_int(b)), __float_as_int(c)); }
__device__ __forceinline__ s16x4v lds_tr16(LAS const unsigned char* p) { return __builtin_bit_cast(s16x4v, __builtin_amdgcn_ds_read_tr16_b64_v4i16((LAS s16x4v*)p)); }
__device__ __forceinline__ unsigned cvtpk(float lo, float hi) { typedef float f2 __attribute__((ext_vector_type(2))); typedef __bf16 b2 __attribute__((ext_vector_type(2))); f2 v = {lo, hi}; b2 r = __builtin_convertvector(v, b2); return __builtin_bit_cast(unsigned, r); }


template <int L> __device__ __forceinline__ void wr2lanes(int& w, unsigned lo, unsigned hi) {
    asm volatile("s_nop 1\n\tv_writelane_b32 %0, %1, %3\n\tv_writelane_b32 %0, %2, %4" : "+v"(w) : "s"(lo), "s"(hi), "i"(L), "i"(L + 1));
}
__device__ __forceinline__ int wave_sum_dpp(int v) {
    v += __builtin_amdgcn_update_dpp(0, v, 0xB1, 0xf, 0xf, true);
    v += __builtin_amdgcn_update_dpp(0, v, 0x4E, 0xf, 0xf, true);
    v += __builtin_amdgcn_update_dpp(0, v, 0x141, 0xf, 0xf, true);
    v += __builtin_amdgcn_update_dpp(0, v, 0x140, 0xf, 0xf, true);
    return __builtin_amdgcn_readlane(v, 0) + __builtin_amdgcn_readlane(v, 16) + __builtin_amdgcn_readlane(v, 32) + __builtin_amdgcn_readlane(v, 48);
}
__device__ __forceinline__ unsigned wave_max_dpp(unsigned v) {
    v = max(v, (unsigned)__builtin_amdgcn_update_dpp(0, (int)v, 0xB1, 0xf, 0xf, true));
    v = max(v, (unsigned)__builtin_amdgcn_update_dpp(0, (int)v, 0x4E, 0xf, 0xf, true));
    v = max(v, (unsigned)__builtin_amdgcn_update_dpp(0, (int)v, 0x141, 0xf, 0xf, true));
    v = max(v, (unsigned)__builtin_amdgcn_update_dpp(0, (int)v, 0x140, 0xf, 0xf, true));
    return max(max((unsigned)__builtin_amdgcn_readlane((int)v, 0), (unsigned)__builtin_amdgcn_readlane((int)v, 16)), max((unsigned)__builtin_amdgcn_readlane((int)v, 32), (unsigned)__builtin_amdgcn_readlane((int)v, 48)));
}
__device__ __forceinline__ int cnt8(int acc, unsigned cand, unsigned k0, unsigned k1, unsigned k2, unsigned k3, unsigned k4, unsigned k5, unsigned k6, unsigned k7) {
    unsigned long long m0, m1, m2, m3, m4, m5, m6, m7;
    asm volatile("v_cmp_le_u32_e64 %1, %9, %10\n\tv_cmp_le_u32_e64 %2, %9, %11\n\tv_cmp_le_u32_e64 %3, %9, %12\n\tv_cmp_le_u32_e64 %4, %9, %13\n\t"
                 "v_cmp_le_u32_e64 %5, %9, %14\n\tv_cmp_le_u32_e64 %6, %9, %15\n\tv_cmp_le_u32_e64 %7, %9, %16\n\tv_cmp_le_u32_e64 %8, %9, %17\n\t"
                 "v_addc_co_u32_e64 %0, %1, 0, %0, %1\n\tv_addc_co_u32_e64 %0, %2, 0, %0, %2\n\tv_addc_co_u32_e64 %0, %3, 0, %0, %3\n\tv_addc_co_u32_e64 %0, %4, 0, %0, %4\n\t"
                 "v_addc_co_u32_e64 %0, %5, 0, %0, %5\n\tv_addc_co_u32_e64 %0, %6, 0, %0, %6\n\tv_addc_co_u32_e64 %0, %7, 0, %0, %7\n\tv_addc_co_u32_e64 %0, %8, 0, %0, %8"
                 : "+v"(acc), "=&s"(m0), "=&s"(m1), "=&s"(m2), "=&s"(m3), "=&s"(m4), "=&s"(m5), "=&s"(m6), "=&s"(m7)
                 : "s"(cand), "v"(k0), "v"(k1), "v"(k2), "v"(k3), "v"(k4), "v"(k5), "v"(k6), "v"(k7));
    return acc;
}
__device__ __forceinline__ int count_ge(const unsigned (&k)[32], unsigned cand_, int nb) {
    const unsigned cand = (unsigned)__builtin_amdgcn_readfirstlane((int)cand_);
    int c = 0;
    c = cnt8(c, cand, k[0], k[1], k[2], k[3], k[4], k[5], k[6], k[7]);
    if (nb > 1) c = cnt8(c, cand, k[8], k[9], k[10], k[11], k[12], k[13], k[14], k[15]);
    if (nb > 2) c = cnt8(c, cand, k[16], k[17], k[18], k[19], k[20], k[21], k[22], k[23]);
    if (nb > 3) c = cnt8(c, cand, k[24], k[25], k[26], k[27], k[28], k[29], k[30], k[31]);
    return wave_sum_dpp(c);
}
__device__ __forceinline__ int wave_scan_dpp(int v) {
    v += __builtin_amdgcn_update_dpp(0, v, 0x111, 0xf, 0xf, false);
    v += __builtin_amdgcn_update_dpp(0, v, 0x112, 0xf, 0xf, false);
    v += __builtin_amdgcn_update_dpp(0, v, 0x114, 0xf, 0xf, false);
    v += __builtin_amdgcn_update_dpp(0, v, 0x118, 0xf, 0xf, false);
    v += __builtin_amdgcn_update_dpp(0, v, 0x142, 0xa, 0xf, false);
    v += __builtin_amdgcn_update_dpp(0, v, 0x143, 0xc, 0xf, false);
    return v;
}
#ifndef HIST_WAVES
#define HIST_WAVES 4
#endif
struct TopkState { unsigned prefix; int bit; bool done; unsigned need; int nb; LAS unsigned* hist; int crej; };
__device__ __forceinline__ void topk_hist(const unsigned (&k)[32], TopkState& st, int c_above) {
    const int lane = threadIdx.x & 63;
    const unsigned T = (unsigned)__builtin_amdgcn_readfirstlane((int)st.prefix);
    LAS unsigned* hist = st.hist;
    *(LAS u32x4*)(hist + 4 * lane) = (u32x4){0u, 0u, 0u, 0u};
    asm volatile("" ::: "memory");
    const unsigned hb_ = (unsigned)(uintptr_t)hist; const unsigned one = 1u;
#define HF8(i0) { unsigned t0_; unsigned long long ex_; \
        asm volatile("s_mov_b64 %1, exec\n\t" \
            "v_subrev_u32_e32 %0, %2, %5\n\tv_lshrrev_b32_e32 %0, 15, %0\n\tv_cmpx_gt_u32_e32 vcc, 0x100, %0\n\tv_lshl_add_u32 %0, %0, 2, %3\n\tds_add_u32 %0, %4\n\ts_mov_b64 exec, %1\n\t" \
            "v_subrev_u32_e32 %0, %2, %6\n\tv_lshrrev_b32_e32 %0, 15, %0\n\tv_cmpx_gt_u32_e32 vcc, 0x100, %0\n\tv_lshl_add_u32 %0, %0, 2, %3\n\tds_add_u32 %0, %4\n\ts_mov_b64 exec, %1\n\t" \
            "v_subrev_u32_e32 %0, %2, %7\n\tv_lshrrev_b32_e32 %0, 15, %0\n\tv_cmpx_gt_u32_e32 vcc, 0x100, %0\n\tv_lshl_add_u32 %0, %0, 2, %3\n\tds_add_u32 %0, %4\n\ts_mov_b64 exec, %1\n\t" \
            "v_subrev_u32_e32 %0, %2, %8\n\tv_lshrrev_b32_e32 %0, 15, %0\n\tv_cmpx_gt_u32_e32 vcc, 0x100, %0\n\tv_lshl_add_u32 %0, %0, 2, %3\n\tds_add_u32 %0, %4\n\ts_mov_b64 exec, %1\n\t" \
            "v_subrev_u32_e32 %0, %2, %9\n\tv_lshrrev_b32_e32 %0, 15, %0\n\tv_cmpx_gt_u32_e32 vcc, 0x100, %0\n\tv_lshl_add_u32 %0, %0, 2, %3\n\tds_add_u32 %0, %4\n\ts_mov_b64 exec, %1\n\t" \
            "v_subrev_u32_e32 %0, %2, %10\n\tv_lshrrev_b32_e32 %0, 15, %0\n\tv_cmpx_gt_u32_e32 vcc, 0x100, %0\n\tv_lshl_add_u32 %0, %0, 2, %3\n\tds_add_u32 %0, %4\n\ts_mov_b64 exec, %1\n\t" \
            "v_subrev_u32_e32 %0, %2, %11\n\tv_lshrrev_b32_e32 %0, 15, %0\n\tv_cmpx_gt_u32_e32 vcc, 0x100, %0\n\tv_lshl_add_u32 %0, %0, 2, %3\n\tds_add_u32 %0, %4\n\ts_mov_b64 exec, %1\n\t" \
            "v_subrev_u32_e32 %0, %2, %12\n\tv_lshrrev_b32_e32 %0, 15, %0\n\tv_cmpx_gt_u32_e32 vcc, 0x100, %0\n\tv_lshl_add_u32 %0, %0, 2, %3\n\tds_add_u32 %0, %4\n\ts_mov_b64 exec, %1" \
            : "=&v"(t0_), "=&s"(ex_) : "s"(T), "s"(hb_), "v"(one), "v"(k[i0]), "v"(k[i0 + 1]), "v"(k[i0 + 2]), "v"(k[i0 + 3]), "v"(k[i0 + 4]), "v"(k[i0 + 5]), "v"(k[i0 + 6]), "v"(k[i0 + 7]) : "vcc", "memory"); }
    HF8(0)
    if (st.nb > 1) HF8(8)
    if (st.nb > 2) HF8(16)
    if (st.nb > 3) HF8(24)
#undef HF8
    asm volatile("" ::: "memory");
    const u32x4 w = *(LAS const u32x4*)(hist + 4 * (63 - lane));
    const int t = (int)((w.x + w.y) + (w.z + w.w));
    const int P = wave_scan_dpp(t);
    const int k1 = TOPK - c_above;
    const unsigned long long bal = __ballot(P >= k1);
    const int Ls = __builtin_ctzll(bal);
    int c = __builtin_amdgcn_readlane(P, Ls) - __builtin_amdgcn_readlane(t, Ls);
    const int h3 = __builtin_amdgcn_readlane((int)w.w, Ls), h2 = __builtin_amdgcn_readlane((int)w.z, Ls), h1 = __builtin_amdgcn_readlane((int)w.y, Ls), h0 = __builtin_amdgcn_readlane((int)w.x, Ls);
    int bsel = 3, hb = h3;
    if (c + h3 < k1) { c += h3; bsel = 2; hb = h2; if (c + h2 < k1) { c += h2; bsel = 1; hb = h1; if (c + h1 < k1) { c += h1; bsel = 0; hb = h0; } } }
    const unsigned bin = (unsigned)(4 * (63 - Ls) + bsel);
    st.prefix = T | (bin << 15); st.bit = 14;
    if (c + hb == k1) { st.done = true; st.need = 0xffffffffu; }
}
__device__ __forceinline__ void topk_init(const unsigned (&k)[32], TopkState& st) {
    unsigned mx = 0u;
#pragma unroll
    for (int i = 0; i < 32; ++i) mx = max(mx, k[i]);
    mx = wave_max_dpp(mx);
    st.prefix = 0u; st.bit = 31; st.done = false; st.need = 0u; st.crej = 0;
    unsigned E = mx >> 23;
    int cprev = 0;
#pragma unroll 1
    for (int j = 0; j < 4; ++j) {
        if (E < (unsigned)j + 1u) break;
        const unsigned T = (E - (unsigned)j) << 23;
        const int c = count_ge(k, T, st.nb);
        if (c >= TOPK) { st.prefix = T; st.bit = 22; if (c == TOPK) { st.done = true; st.need = 0xffffffffu; }
#ifndef NO_TOPK_HIST
#ifdef PROBE_HIST2
            else if (st.hist) { TopkState sv = st; topk_hist(k, st, cprev); asm volatile("" :: "s"(st.prefix) : "memory"); st = sv; topk_hist(k, st, cprev); }
#else
            else if (st.hist) topk_hist(k, st, cprev);
#endif
#endif
            break; }
        cprev = c;
    }
}
__device__ __forceinline__ void topk_step(const unsigned (&k)[32], TopkState& st) {
    if (st.done) return;
    if (st.bit < 0) { int c = 0;
#pragma unroll
        for (int i = 0; i < 32; ++i) c += (k[i] > st.prefix) ? 1 : 0;
        c = wave_sum_dpp(c); st.need = (unsigned)(TOPK - c); st.done = true; return; }
    const unsigned cand = st.prefix | (1u << st.bit);
    const int c = count_ge(k, cand, st.nb);
    if (c >= TOPK) st.prefix = cand; else st.crej = c;
    if (c == TOPK) { st.done = true; st.need = 0xffffffffu; }
    --st.bit;
#ifndef NO_TOPK_HIST
    if (st.bit == 22 && !st.done && st.hist) topk_hist(k, st, st.crej);
#endif
}

__device__ __forceinline__ void dsa_prefetch_qi(const bf16* zb, int qt, LAS unsigned char* lds, int wave, int lane) {
    const unsigned lds_base = (unsigned)(uintptr_t)lds;
#pragma unroll
    for (int i = 0; i < 2; ++i) { const int row = 2 * wave + i;
        glds16(zb + (size_t)(qt * 16 + row) * ZP + C_QI + ((lane ^ row) * 8), (unsigned)__builtin_amdgcn_readfirstlane(lds_base + DSA_QIB_OFF + row * 1024)); }
    if (wave == 0) glds16(zb + (size_t)(qt * 16 + (lane & 15)) * ZP + C_WI, (unsigned)__builtin_amdgcn_readfirstlane(lds_base + DSA_WIB_OFF));
}

__device__ __forceinline__ void dsa_prefetch_ki(const bf16* zb, int qt, bf16x8v (&pk)[4], int wave, int lane) {
    const int r16 = lane & 15, g = lane >> 4;
    if (wave <= qt) { const bf16* krow = zb + (size_t)(wave * 16 + r16) * ZP + C_KI; pk[0] = *(const bf16x8v*)(krow + 8 * g); pk[1] = *(const bf16x8v*)(krow + 32 + 8 * g); }
    if (wave + 8 <= qt) { const bf16* krow = zb + (size_t)((wave + 8) * 16 + r16) * ZP + C_KI; pk[2] = *(const bf16x8v*)(krow + 8 * g); pk[3] = *(const bf16x8v*)(krow + 32 + 8 * g); }
}

__device__ __forceinline__ void dsa_unit(const P& p, int b, int qt, int qt_next, bf16x8v (&pk)[4], LAS unsigned char* lds) {
    const int tid = threadIdx.x, lane = tid & 63, wave = __builtin_amdgcn_readfirstlane(tid >> 6), r16 = lane & 15, g = lane >> 4;
    const int q0 = qt * 16; const bf16* zb = p.Z + (size_t)b * SEQ * ZP;
    LAS float* SC = (LAS float*)lds; LAS unsigned* BM = (LAS unsigned*)(lds + DSA_BM_OFF);
    const bool dense_all = (qt < TOPK / 16);
    const bf16* qrow = zb + (size_t)(q0 + r16) * ZP;
    const bf16x8v bq0 = *(const bf16x8v*)(qrow + C_Q + wave * 64 + 8 * g), bq1 = *(const bf16x8v*)(qrow + C_Q + wave * 64 + 32 + 8 * g);
    u32x2 gwv[4];
#pragma unroll
    for (int dt = 0; dt < 4; ++dt) gwv[dt] = *(const u32x2*)(qrow + C_GA + wave * 64 + dt * 16 + 4 * g);
    const int nsteps = (((q0 + 16 + 31) >> 5) + 1) & ~1, nmega = (nsteps + 7) >> 3;
    const int kkey = lane >> 3, vkey = lane >> 1, vhalf = lane & 1;
    const unsigned lds_base = (unsigned)(uintptr_t)lds;
#define DSA_STAGE(mm) do { const int st_ = (mm) * 8 + wave; if (st_ < nsteps) { \
        const bf16* kb_ = zb + (size_t)st_ * 32 * ZP; const unsigned ldsb_ = lds_base + (unsigned)(((mm) & 1) * 65536 + wave * 4096); \
        _Pragma("unroll") for (int c_ = 0; c_ < 4; ++c_) { const int key_ = 8 * c_ + kkey, ch_ = (lane & 7) ^ ((key_ & 15) >> 1); \
            glds16(kb_ + (size_t)key_ * ZP + C_K + ch_ * 8, (unsigned)__builtin_amdgcn_readfirstlane(ldsb_ + c_ * 1024)); } \
        _Pragma("unroll") for (int c_ = 0; c_ < 4; ++c_) \
            glds16(kb_ + (size_t)vkey * ZP + C_V + c_ * 16 + vhalf * 8, (unsigned)__builtin_amdgcn_readfirstlane(ldsb_ + 32768 + c_ * 1024)); } } while (0)
    if (!dense_all) {
        for (int rpI = 0; rpI < RP_I; ++rpI) {
        bf16x8v bq[8][2]; float wv[8];
#pragma unroll
        for (int h = 0; h < 8; ++h) { bq[h][0] = *(LAS const bf16x8v*)(lds + DSA_QIB_OFF + r16 * 1024 + (((8 * h + g) ^ r16) * 16)); bq[h][1] = *(LAS const bf16x8v*)(lds + DSA_QIB_OFF + r16 * 1024 + (((8 * h + 4 + g) ^ r16) * 16));
            wv[h] = bf2f(*(LAS const bf16*)(lds + DSA_WIB_OFF + r16 * 16 + h * 2)) * 0.35355339059327373f * 0.125f; }
        bf16x8v ra0 = pk[0], ra1 = pk[1], rb0 = pk[2], rb1 = pk[3], rc0 = pk[0], rc1 = pk[1];
#define IDX_LOAD(d0, d1, ktl) do { const int ktl_ = (ktl) <= qt ? (ktl) : qt;        \
            const bf16* krow_ = zb + (size_t)(ktl_ * 16 + r16) * ZP + C_KI; d0 = *(const bf16x8v*)(krow_ + 8 * g); d1 = *(const bf16x8v*)(krow_ + 32 + 8 * g); } while (0)
#define IDX_STEP(c0, c1) do { \
            f32x4 sc = {0.f, 0.f, 0.f, 0.f}; \
            _Pragma("unroll") for (int h = 0; h < 8; ++h) { \
                f32x4 acc = {0.f, 0.f, 0.f, 0.f}; \
                acc = __builtin_amdgcn_mfma_f32_16x16x32_bf16(c0, bq[h][0], acc, 0, 0, 0); \
                acc = __builtin_amdgcn_mfma_f32_16x16x32_bf16(c1, bq[h][1], acc, 0, 0, 0); \
                _Pragma("unroll") for (int i = 0; i < 4; ++i) sc[i] += relu_i(acc[i]) * wv[h]; \
            } \
            if (__builtin_amdgcn_readfirstlane(kt) == qt) {                  \
                _Pragma("unroll") for (int i = 0; i < 4; ++i) sc[i] = (4 * g + i > r16) ? -INFINITY : sc[i]; \
            } \
            *(LAS f32x4*)(SC + r16 * SCP + kt * 16 + 4 * g) = sc; } while (0)
        int kt = wave;
        const int nst = (qt - wave + 8) >> 3;
        const int ntrip = (nst * 11) >> 5, rem = nst - 3 * ntrip;
#pragma unroll 1
        for (int it = ntrip; it > 0; --it) {
            IDX_LOAD(rc0, rc1, kt + 16); __builtin_amdgcn_sched_barrier(0); IDX_STEP(ra0, ra1); __builtin_amdgcn_sched_barrier(0); kt += 8;
            IDX_LOAD(ra0, ra1, kt + 16); __builtin_amdgcn_sched_barrier(0); IDX_STEP(rb0, rb1); __builtin_amdgcn_sched_barrier(0); kt += 8;
            IDX_LOAD(rb0, rb1, kt + 16); __builtin_amdgcn_sched_barrier(0); IDX_STEP(rc0, rc1); __builtin_amdgcn_sched_barrier(0); kt += 8;
        }
        if (rem >= 1) { IDX_STEP(ra0, ra1); kt += 8; if (rem >= 2) { IDX_STEP(rb0, rb1); } }
#undef IDX_LOAD
#undef IDX_STEP
        __syncthreads();
        }
#pragma unroll 1
        for (int rpT = 0; rpT < RP_T; ++rpT) {
            const int ra = 2 * wave, rb = 2 * wave + 1, ta = q0 + ra, tb = q0 + rb;
            unsigned ka[32], kb[32];
#pragma unroll
            for (int i = 0; i < 32; ++i) { const int key = lane + 64 * i; ka[i] = (key <= ta) ? score_ukey(SC[ra * SCP + key]) : 0u; kb[i] = (key <= tb) ? score_ukey(SC[rb * SCP + key]) : 0u; }
#if RP_T1 > 1
            asm volatile("" :: "v"(ka[0]), "v"(kb[31]) : "memory");
#pragma unroll
            for (int i = 0; i < 32; ++i) { const int key = lane + 64 * i; ka[i] = (key <= ta) ? score_ukey(SC[ra * SCP + key]) : 0u; kb[i] = (key <= tb) ? score_ukey(SC[rb * SCP + key]) : 0u; }
            asm volatile("" ::: "memory");
#endif
            asm volatile("s_waitcnt lgkmcnt(0)" ::: "memory");
            __syncthreads();
            DSA_STAGE(0);
            TopkState sa, sb; sa.nb = (ta >> 9) + 1; sb.nb = (tb >> 9) + 1;
            sa.hist = (wave < HIST_WAVES) ? (LAS unsigned*)(lds + 65536 + ra * 1280) : (LAS unsigned*)nullptr; sb.hist = (wave < HIST_WAVES) ? (LAS unsigned*)(lds + 65536 + rb * 1280) : (LAS unsigned*)nullptr;
            topk_init(ka, sa); topk_init(kb, sb);
#pragma unroll 1
            while (!(sa.done && sb.done)) { topk_step(ka, sa); topk_step(kb, sb); }
#if RP_T2 > 1
            asm volatile("" :: "v"(sa.prefix), "v"(sb.prefix));
            topk_init(ka, sa); topk_init(kb, sb);
#pragma unroll 1
            while (!(sa.done && sb.done)) { topk_step(ka, sa); topk_step(kb, sb); }
#endif
            if (sa.need == 0xffffffffu && sb.need == 0xffffffffu) {
                const unsigned ta_ = (unsigned)__builtin_amdgcn_readfirstlane((int)sa.prefix), tb_ = (unsigned)__builtin_amdgcn_readfirstlane((int)sb.prefix);
                int wa = 0, wb = 0;
#define WR2(i) { const unsigned long long ma = __ballot(ka[i] >= ta_), mb = __ballot(kb[i] >= tb_); wr2lanes<2 * (i)>(wa, (unsigned)ma, (unsigned)(ma >> 32)); wr2lanes<2 * (i)>(wb, (unsigned)mb, (unsigned)(mb >> 32)); }
                WR2(0) WR2(1) WR2(2) WR2(3) WR2(4) WR2(5) WR2(6) WR2(7) WR2(8) WR2(9) WR2(10) WR2(11) WR2(12) WR2(13) WR2(14) WR2(15)
                WR2(16) WR2(17) WR2(18) WR2(19) WR2(20) WR2(21) WR2(22) WR2(23) WR2(24) WR2(25) WR2(26) WR2(27) WR2(28) WR2(29) WR2(30) WR2(31)
#undef WR2
                BM[ra * BMS + lane] = (unsigned)wa; BM[rb * BMS + lane] = (unsigned)wb;
#if RP_T3 > 1
                asm volatile("" : "+v"(wa), "+v"(wb) :: "memory");
#define WR2(i) { const unsigned long long ma = __ballot(ka[i] >= ta_), mb = __ballot(kb[i] >= tb_); wr2lanes<2 * (i)>(wa, (unsigned)ma, (unsigned)(ma >> 32)); wr2lanes<2 * (i)>(wb, (unsigned)mb, (unsigned)(mb >> 32)); }
                WR2(0) WR2(1) WR2(2) WR2(3) WR2(4) WR2(5) WR2(6) WR2(7) WR2(8) WR2(9) WR2(10) WR2(11) WR2(12) WR2(13) WR2(14) WR2(15)
                WR2(16) WR2(17) WR2(18) WR2(19) WR2(20) WR2(21) WR2(22) WR2(23) WR2(24) WR2(25) WR2(26) WR2(27) WR2(28) WR2(29) WR2(30) WR2(31)
#undef WR2
                BM[ra * BMS + lane] = (unsigned)wa; BM[rb * BMS + lane] = (unsigned)wb;
#endif
            } else {
            unsigned eqa = 0u, eqb = 0u;
#pragma unroll 1
            for (int i = 0; i < 32; ++i) {
                unsigned kai = ka[0], kbi = kb[0];
#pragma unroll
                for (int j = 1; j < 32; ++j) { kai = (i == j) ? ka[j] : kai; kbi = (i == j) ? kb[j] : kbi; }
                { const bool eq = (kai == sa.prefix); const unsigned long long em = __ballot(eq);
                  const unsigned erank = eqa + __builtin_amdgcn_mbcnt_hi((unsigned)(em >> 32), __builtin_amdgcn_mbcnt_lo((unsigned)em, 0u));
                  const unsigned long long smk = __ballot((kai > sa.prefix) || (eq && erank < sa.need));
                  if (lane == 0) { BM[ra * BMS + 2 * i] = (unsigned)smk; BM[ra * BMS + 2 * i + 1] = (unsigned)(smk >> 32); }
                  eqa += (unsigned)__popcll(em); }
                { const bool eq = (kbi == sb.prefix); const unsigned long long em = __ballot(eq);
                  const unsigned erank = eqb + __builtin_amdgcn_mbcnt_hi((unsigned)(em >> 32), __builtin_amdgcn_mbcnt_lo((unsigned)em, 0u));
                  const unsigned long long smk = __ballot((kbi > sb.prefix) || (eq && erank < sb.need));
                  if (lane == 0) { BM[rb * BMS + 2 * i] = (unsigned)smk; BM[rb * BMS + 2 * i + 1] = (unsigned)(smk >> 32); }
                  eqb += (unsigned)__popcll(em); }
            }
            }
        }
    } else {
        for (int i = tid; i < 1024; i += 512) { const int row = i >> 6, w = i & 63, t = q0 + row, lo = 32 * w;
            BM[row * BMS + w] = (t >= lo + 31) ? 0xffffffffu : ((t < lo) ? 0u : ((2u << (t - lo)) - 1u)); }
        DSA_STAGE(0);
    }
    __syncthreads();
    const int h = wave;
#pragma unroll 1
    for (int rpV = 0; rpV < RP_V; ++rpV) {
    asm volatile("s_waitcnt vmcnt(0)" ::: "memory");
    asm volatile("" :: "v"(bq0), "v"(bq1), "v"(gwv[0]), "v"(gwv[1]), "v"(gwv[2]), "v"(gwv[3]));
    __syncthreads();
    if (qt_next >= TOPK / 16) { dsa_prefetch_qi(zb, qt_next, lds, wave, lane); dsa_prefetch_ki(zb, qt_next, pk, wave, lane); }
    f32x4 o[4], lacc = {0.f, 0.f, 0.f, 0.f}, negm = {0.f, 0.f, 0.f, 0.f};
#pragma unroll
    for (int dt = 0; dt < 4; ++dt) o[dt] = (f32x4){0.f, 0.f, 0.f, 0.f};
    float m_run = 0.f;
    const int kofs0 = r16 * 128 + ((g ^ (r16 >> 1)) & 7) * 16, kofs1 = r16 * 128 + (((4 + g) ^ (r16 >> 1)) & 7) * 16;
    const int vofs = 32768 + (4 * g + ((lane & 15) >> 2)) * 32 + (lane & 3) * 8;
    bf16x8v ones = {0x3f80, 0x3f80, 0x3f80, 0x3f80, 0x3f80, 0x3f80, 0x3f80, 0x3f80};
    asm volatile("" : "+v"(ones));
    LAS const unsigned char* mlut = lds + DSA_MLUT_OFF;
    constexpr float THR = 8.0f;
    bool first = true;
#pragma unroll 1
    for (int mm = 0; mm < nmega; ++mm) {
        if (mm + 1 < nmega) DSA_STAGE(mm + 1);
        LAS unsigned char* slotb = lds + (mm & 1) * 65536;
        const int nsub = (nsteps - mm * 8) < 8 ? (nsteps - mm * 8) : 8;
#pragma unroll 1
        for (int u = 0; u < nsub; u += 2) {
            LAS unsigned char* slot = slotb + u * 4096;
            const int mwA = (int)(BM[r16 * BMS + mm * 8 + u] >> (4 * g)), mwB = (int)(BM[r16 * BMS + mm * 8 + u + 1] >> (4 * g));
            f32x4 s0, s1, s2, s3;
            { const bf16x8v ka0 = *(LAS const bf16x8v*)(slot + kofs0), ka1 = *(LAS const bf16x8v*)(slot + kofs1);
              const bf16x8v kb0 = *(LAS const bf16x8v*)(slot + 2048 + kofs0), kb1 = *(LAS const bf16x8v*)(slot + 2048 + kofs1);
              const bf16x8v kc0 = *(LAS const bf16x8v*)(slot + 4096 + kofs0), kc1 = *(LAS const bf16x8v*)(slot + 4096 + kofs1);
              const bf16x8v kd0 = *(LAS const bf16x8v*)(slot + 6144 + kofs0), kd1 = *(LAS const bf16x8v*)(slot + 6144 + kofs1);
              s0 = __builtin_amdgcn_mfma_f32_16x16x32_bf16(ka0, bq0, negm, 0, 0, 0); s1 = __builtin_amdgcn_mfma_f32_16x16x32_bf16(kb0, bq0, negm, 0, 0, 0);
              s2 = __builtin_amdgcn_mfma_f32_16x16x32_bf16(kc0, bq0, negm, 0, 0, 0); s3 = __builtin_amdgcn_mfma_f32_16x16x32_bf16(kd0, bq0, negm, 0, 0, 0);
              s0 = __builtin_amdgcn_mfma_f32_16x16x32_bf16(ka1, bq1, s0, 0, 0, 0); s1 = __builtin_amdgcn_mfma_f32_16x16x32_bf16(kb1, bq1, s1, 0, 0, 0);
              s2 = __builtin_amdgcn_mfma_f32_16x16x32_bf16(kc1, bq1, s2, 0, 0, 0); s3 = __builtin_amdgcn_mfma_f32_16x16x32_bf16(kd1, bq1, s3, 0, 0, 0); }
            const int lmi = max(max(max(imax3(s0[0], s0[1], s0[2]), imax3(s0[3], s1[0], s1[1])), max(imax3(s1[2], s1[3], s2[0]), imax3(s2[1], s2[2], s2[3]))), max(imax3(s3[0], s3[1], s3[2]), __float_as_int(s3[3])));
            if (first || __any(lmi > 0x41000000)) {
                float lmx = fmaxf(fmaxf(fmaxf(fmaxf(s0[0], s0[1]), fmaxf(s0[2], s0[3])), fmaxf(fmaxf(s1[0], s1[1]), fmaxf(s1[2], s1[3]))), fmaxf(fmaxf(fmaxf(s2[0], s2[1]), fmaxf(s2[2], s2[3])), fmaxf(fmaxf(s3[0], s3[1]), fmaxf(s3[2], s3[3]))));
                { const auto r1 = __builtin_amdgcn_permlane16_swap(__float_as_uint(lmx), __float_as_uint(lmx), false, false); lmx = fmaxf(__uint_as_float(r1[0]), __uint_as_float(r1[1])); }
                { const auto r2 = __builtin_amdgcn_permlane32_swap(__float_as_uint(lmx), __float_as_uint(lmx), false, false); lmx = fmaxf(__uint_as_float(r2[0]), __uint_as_float(r2[1])); }
                const float dl = first ? lmx : fmaxf(lmx, 0.f);
                m_run += dl; const float f = first ? 1.0f : __builtin_amdgcn_exp2f(-dl);
#pragma unroll
                for (int i = 0; i < 4; ++i) { s0[i] -= dl; s1[i] -= dl; s2[i] -= dl; s3[i] -= dl; negm[i] = -m_run; }
                lacc = lacc * f;
#pragma unroll
                for (int dt = 0; dt < 4; ++dt) o[dt] = o[dt] * f;
                first = false;
            }
            const u32x2 mk0 = *(LAS const u32x2*)(mlut + ((mwA & 15) << 3)), mk1 = *(LAS const u32x2*)(mlut + (((mwA >> 16) & 15) << 3));
            const u32x2 mk2 = *(LAS const u32x2*)(mlut + ((mwB & 15) << 3)), mk3 = *(LAS const u32x2*)(mlut + (((mwB >> 16) & 15) << 3));
            u32x4 pwA, pwB;
            pwA.x = cvtpk(__builtin_amdgcn_exp2f(s0[0]), __builtin_amdgcn_exp2f(s0[1])) & mk0.x; pwA.y = cvtpk(__builtin_amdgcn_exp2f(s0[2]), __builtin_amdgcn_exp2f(s0[3])) & mk0.y;
            pwA.z = cvtpk(__builtin_amdgcn_exp2f(s1[0]), __builtin_amdgcn_exp2f(s1[1])) & mk1.x; pwA.w = cvtpk(__builtin_amdgcn_exp2f(s1[2]), __builtin_amdgcn_exp2f(s1[3])) & mk1.y;
            pwB.x = cvtpk(__builtin_amdgcn_exp2f(s2[0]), __builtin_amdgcn_exp2f(s2[1])) & mk2.x; pwB.y = cvtpk(__builtin_amdgcn_exp2f(s2[2]), __builtin_amdgcn_exp2f(s2[3])) & mk2.y;
            pwB.z = cvtpk(__builtin_amdgcn_exp2f(s3[0]), __builtin_amdgcn_exp2f(s3[1])) & mk3.x; pwB.w = cvtpk(__builtin_amdgcn_exp2f(s3[2]), __builtin_amdgcn_exp2f(s3[3])) & mk3.y;
            const bf16x8v pfA = __builtin_bit_cast(bf16x8v, pwA), pfB = __builtin_bit_cast(bf16x8v, pwB);
            lacc = __builtin_amdgcn_mfma_f32_16x16x32_bf16(ones, pfA, lacc, 0, 0, 0);
            lacc = __builtin_amdgcn_mfma_f32_16x16x32_bf16(ones, pfB, lacc, 0, 0, 0);
#pragma unroll
            for (int dt = 0; dt < 4; ++dt) {
                const s16x4v lo = lds_tr16(slot + vofs + dt * 1024), hi = lds_tr16(slot + vofs + dt * 1024 + 512);
                const s16x4v lo2 = lds_tr16(slot + 4096 + vofs + dt * 1024), hi2 = lds_tr16(slot + 4096 + vofs + dt * 1024 + 512);
                const bf16x8v vf = {lo[0], lo[1], lo[2], lo[3], hi[0], hi[1], hi[2], hi[3]};
                const bf16x8v vf2 = {lo2[0], lo2[1], lo2[2], lo2[3], hi2[0], hi2[1], hi2[2], hi2[3]};
                o[dt] = __builtin_amdgcn_mfma_f32_16x16x32_bf16(vf, pfA, o[dt], 0, 0, 0);
                o[dt] = __builtin_amdgcn_mfma_f32_16x16x32_bf16(vf2, pfB, o[dt], 0, 0, 0);
            }
        }
        asm volatile("s_waitcnt vmcnt(0) lgkmcnt(0)" ::: "memory");
        __syncthreads();
    }
#undef DSA_STAGE
    const float inv = 1.0f / lacc[0];
    bf16* yrow = p.Y + ((size_t)b * SEQ + q0 + r16) * DM + 512 + h * 64;
#pragma unroll
    for (int dt = 0; dt < 4; ++dt) {
        const u32x2 gw = gwv[dt];
        const float g0 = __uint_as_float(gw.x << 16), g1 = __uint_as_float(gw.x & 0xffff0000u), g2 = __uint_as_float(gw.y << 16), g3 = __uint_as_float(gw.y & 0xffff0000u);
        u32x2 w; w.x = pk2(o[dt][0] * inv * siluf(g0), o[dt][1] * inv * siluf(g1)); w.y = pk2(o[dt][2] * inv * siluf(g2), o[dt][3] * inv * siluf(g3));
        *(u32x2*)(yrow + dt * 16 + 4 * g) = w;
    }
    __syncthreads();
    }
}
__device__ __forceinline__ int dsa_qt_of(int j, int i) { return (i == 0) ? 127 - j : (i == 1) ? 64 + j : (i == 2) ? 63 - j : j; }
__device__ __forceinline__ void dsa_phase_pre(const P& p, LAS unsigned char* lds) {
    const int G = gridDim.x, wg = blockIdx.x, lane = threadIdx.x & 63, wave = __builtin_amdgcn_readfirstlane(threadIdx.x >> 6);
    const int b = (G == 256) ? (wg & 7) : (wg >> 7), qt = (G == 256) ? dsa_qt_of(wg >> 3, 0) : 127 - (wg & 127);
    if (wg < 1024 && qt >= TOPK / 16) dsa_prefetch_qi(p.Z + (size_t)b * SEQ * ZP, qt, lds, wave, lane);
}
__device__ __forceinline__ void dsa_phase(const P& p, LAS unsigned char* lds) {
    const int G = gridDim.x, wg = blockIdx.x;
    if (G == 256) {
        const int b = wg & 7, j = wg >> 3, lane = threadIdx.x & 63, wave = __builtin_amdgcn_readfirstlane(threadIdx.x >> 6);
        bf16x8v pk[4] = {{0, 0, 0, 0, 0, 0, 0, 0}, {0, 0, 0, 0, 0, 0, 0, 0}, {0, 0, 0, 0, 0, 0, 0, 0}, {0, 0, 0, 0, 0, 0, 0, 0}};
        if (dsa_qt_of(j, 0) >= TOPK / 16) dsa_prefetch_ki(p.Z + (size_t)b * SEQ * ZP, dsa_qt_of(j, 0), pk, wave, lane);
#pragma unroll 1
        for (int i = 0; i < 4; ++i) dsa_unit(p, b, dsa_qt_of(j, i), (i < 3) ? dsa_qt_of(j, i + 1) : -1, pk, lds);
    }
}
constexpr int LRU_WS_OFF = 139264;
constexpr int LRU_XB = 264 * 128;
constexpr int LRU_GB = 256 * 32;
constexpr int LRU_BUF = LRU_XB + LRU_GB;
__device__ __forceinline__ float fast_sigm(float x) { return __builtin_amdgcn_rcpf(1.0f + __expf(-x)); }
__device__ __forceinline__ void lru_unit(const P& p, int l, int b, int blk, int q4, LAS unsigned char* lds) {
    const int tid = threadIdx.x, lane = tid & 63, wave = __builtin_amdgcn_readfirstlane(tid >> 6), r16 = lane & 15, g = lane >> 4;
    const bf16* zb = p.Z + (size_t)b * SEQ * ZP;
    const int cA = blk * 64, dloc = q4 * 16 + r16, dg = blk * 64 + dloc;
    const unsigned lds_base = (unsigned)(uintptr_t)lds;
#define LRU_STAGE(r) do { const unsigned bb_ = lds_base + (unsigned)(((r) & 1) * LRU_BUF); \
        _Pragma("unroll") for (int i_ = 0; i_ < 5; ++i_) { const int pc_ = wave + 8 * i_; if (pc_ < 33) { const int rho_ = pc_ * 8 + (lane >> 3); int t_ = (r) * 256 - 3 + rho_; t_ = t_ < 0 ? 0 : (t_ > SEQ - 1 ? SEQ - 1 : t_); \
            const int ch_ = (lane & 7) ^ ((rho_ >> 1) & 7); glds16(zb + (size_t)t_ * ZP + C_XR + cA + ch_ * 8, (unsigned)__builtin_amdgcn_readfirstlane(bb_ + pc_ * 1024)); } } \
        { const int row_ = wave * 32 + (lane >> 1); glds16(zb + (size_t)((r) * 256 + row_) * ZP + C_GR + dg - r16 + (lane & 1) * 8, (unsigned)__builtin_amdgcn_readfirstlane(bb_ + LRU_XB + wave * 1024)); } } while (0)
    LRU_STAGE(0);
    float cwA[2][4][8], cbA[2][8];
#pragma unroll
    for (int s = 0; s < 2; ++s)
#pragma unroll
        for (int j = 0; j < 8; ++j) { const int c = cA + 32 * s + 8 * g + j; cbA[s][j] = p.conv_b[l * 512 + c];
#pragma unroll
            for (int k = 0; k < 4; ++k) cwA[s][k][j] = p.conv_w[(l * 4 + k) * 512 + c]; }
    bf16x8v bxf[2], baf[2];
#pragma unroll
    for (int s = 0; s < 2; ++s) { u32x4 wx, wa; unsigned tx[8], ta[8];
#pragma unroll
        for (int j = 0; j < 8; ++j) { const size_t idx = (((size_t)l * 8 + blk) * 64 + 32 * s + 8 * g + j) * 64 + dloc; tx[j] = f2bf(p.lru_wx[idx]); ta[j] = f2bf(p.lru_wa[idx]); }
        wx.x = tx[0] | (tx[1] << 16); wx.y = tx[2] | (tx[3] << 16); wx.z = tx[4] | (tx[5] << 16); wx.w = tx[6] | (tx[7] << 16);
        wa.x = ta[0] | (ta[1] << 16); wa.y = ta[2] | (ta[3] << 16); wa.z = ta[4] | (ta[5] << 16); wa.w = ta[6] | (ta[7] << 16);
        bxf[s] = __builtin_bit_cast(bf16x8v, wx); baf[s] = __builtin_bit_cast(bf16x8v, wa); }
    const float cw0 = p.conv_w[(l * 4 + 0) * 512 + dg], cw1 = p.conv_w[(l * 4 + 1) * 512 + dg], cw2 = p.conv_w[(l * 4 + 2) * 512 + dg], cw3 = p.conv_w[(l * 4 + 3) * 512 + dg];
    const float cb = p.conv_b[l * 512 + dg], bxv = p.lru_bx[l * 512 + dg], bav = p.lru_ba[l * 512 + dg];
    const float sp8 = -8.0f * log1pf(expf(-p.lru_a[l * 512 + dg]));
    asm volatile("" :: "v"(cwA[0][0][0]), "v"(cwA[1][3][7]), "v"(cbA[1][7]), "v"(bxf[0]), "v"(bxf[1]), "v"(baf[0]), "v"(baf[1]), "v"(cw0), "v"(cw1), "v"(cw2), "v"(cw3), "v"(cb), "v"(bxv), "v"(bav), "v"(sp8));
    LAS float* WS = (LAS float*)(lds + LRU_WS_OFF);
    float hrun = 0.f;
    asm volatile("s_waitcnt vmcnt(0)" ::: "memory");
#pragma unroll 1
    for (int round = 0; round < 8; ++round) {
        asm volatile("s_waitcnt vmcnt(8)" ::: "memory");
        __syncthreads();
        if (round + 1 < 8) LRU_STAGE(round + 1);
        LAS const unsigned char* xb = lds + (round & 1) * LRU_BUF; LAS const unsigned char* gb = xb + LRU_XB;
        const int tw = round * 256 + wave * 32;
        float hl[2][4], pl[2][4], gr4[2][4], PT[2], HT[2], PE[2], HE[2];
#pragma unroll
        for (int tau = 0; tau < 2; ++tau) {
            const int t0 = tw + 16 * tau, rho0 = wave * 32 + 16 * tau;
            bf16x8v af[2];
#pragma unroll
            for (int s = 0; s < 2; ++s) {
                float xc[8];
#pragma unroll
                for (int j = 0; j < 8; ++j) xc[j] = cbA[s][j];
#pragma unroll
                for (int k = 0; k < 4; ++k) { const int rho = rho0 + r16 + k; u32x4 w = *(LAS const u32x4*)(xb + rho * 128 + (((4 * s + g) ^ (rho >> 1)) & 7) * 16);
                    if (t0 + r16 - 3 + k < 0) w = (u32x4){0u, 0u, 0u, 0u};
                    xc[0] += cwA[s][k][0] * __uint_as_float(w.x << 16); xc[1] += cwA[s][k][1] * __uint_as_float(w.x & 0xffff0000u);
                    xc[2] += cwA[s][k][2] * __uint_as_float(w.y << 16); xc[3] += cwA[s][k][3] * __uint_as_float(w.y & 0xffff0000u);
                    xc[4] += cwA[s][k][4] * __uint_as_float(w.z << 16); xc[5] += cwA[s][k][5] * __uint_as_float(w.z & 0xffff0000u);
                    xc[6] += cwA[s][k][6] * __uint_as_float(w.w << 16); xc[7] += cwA[s][k][7] * __uint_as_float(w.w & 0xffff0000u); }
                u32x4 pw; pw.x = cvtpk(xc[0], xc[1]); pw.y = cvtpk(xc[2], xc[3]); pw.z = cvtpk(xc[4], xc[5]); pw.w = cvtpk(xc[6], xc[7]);
                af[s] = __builtin_bit_cast(bf16x8v, pw);
            }
            f32x4 gx = {0.f, 0.f, 0.f, 0.f}, ga = {0.f, 0.f, 0.f, 0.f};
            gx = __builtin_amdgcn_mfma_f32_16x16x32_bf16(af[0], bxf[0], gx, 0, 0, 0); gx = __builtin_amdgcn_mfma_f32_16x16x32_bf16(af[1], bxf[1], gx, 0, 0, 0);
            ga = __builtin_amdgcn_mfma_f32_16x16x32_bf16(af[0], baf[0], ga, 0, 0, 0); ga = __builtin_amdgcn_mfma_f32_16x16x32_bf16(af[1], baf[1], ga, 0, 0, 0);
            float xo[7];
#pragma unroll
            for (int m = 0; m < 7; ++m) { const int rho = rho0 + 4 * g + m;
                const unsigned short v = *(LAS const unsigned short*)(xb + rho * 128 + (((dloc >> 3) ^ (rho >> 1)) & 7) * 16 + (dloc & 7) * 2);
                xo[m] = (t0 + 4 * g - 3 + m >= 0) ? bf2f(v) : 0.f; }
            float Pr = 1.f, Hr = 0.f;
#pragma unroll
            for (int i = 0; i < 4; ++i) {
                const float xcv = cb + cw0 * xo[i] + cw1 * xo[i + 1] + cw2 * xo[i + 2] + cw3 * xo[i + 3];
                const float sx = fast_sigm(gx[i] + bxv), sa = fast_sigm(ga[i] + bav);
                const float la = sp8 * sa, a = __expf(la), y2 = 2.0f * la;
                const float ser = -y2 * (1.0f + y2 * (0.5f + y2 * (0.16666667f + y2 * (0.041666668f + y2 * (0.0083333338f + y2 * 0.0013888889f)))));
                const float em = (y2 > -0.25f) ? ser : (1.0f - __expf(y2));
                const float u = __builtin_amdgcn_sqrtf(em) * sx * xcv;
                Hr = a * Hr + u; Pr *= a; hl[tau][i] = Hr; pl[tau][i] = Pr;
                gr4[tau][i] = bf2f(*(LAS const unsigned short*)(gb + (rho0 + 4 * g + i) * 32 + r16 * 2));
            }
            float Pi = Pr, Hi = Hr;
            { const float Pl = __shfl_up(Pi, 16), Hl = __shfl_up(Hi, 16); if (g >= 1) { Hi = Pi * Hl + Hi; Pi = Pl * Pi; } }
            { const float Pl = __shfl_up(Pi, 32), Hl = __shfl_up(Hi, 32); if (g >= 2) { Hi = Pi * Hl + Hi; Pi = Pl * Pi; } }
            float Pe = __shfl_up(Pi, 16), He = __shfl_up(Hi, 16); if (g == 0) { Pe = 1.f; He = 0.f; }
            PT[tau] = __shfl(Pi, 48 + r16); HT[tau] = __shfl(Hi, 48 + r16); PE[tau] = Pe; HE[tau] = He;
        }
        HE[1] = PE[1] * HT[0] + HE[1]; PE[1] = PT[0] * PE[1];
        const float Pw = PT[0] * PT[1], Hw = PT[1] * HT[0] + HT[1];
        LAS float* wsr = WS + (round & 1) * 256;
        if (g == 0) { wsr[(wave * 16 + r16) * 2 + 0] = Pw; wsr[(wave * 16 + r16) * 2 + 1] = Hw; }
        asm volatile("s_waitcnt lgkmcnt(0)" ::: "memory");
        __builtin_amdgcn_s_barrier();
        asm volatile("" ::: "memory");
        float hc = hrun, hall = hrun;
#pragma unroll
        for (int w2 = 0; w2 < 8; ++w2) { if (w2 == wave) hc = hall; hall = wsr[(w2 * 16 + r16) * 2 + 0] * hall + wsr[(w2 * 16 + r16) * 2 + 1]; }
        hrun = hall;
#pragma unroll
        for (int tau = 0; tau < 2; ++tau) {
            const float hin = PE[tau] * hc + HE[tau];
            bf16* yp = p.Y + ((size_t)b * SEQ + tw + 16 * tau + 4 * g) * DM + dg;
#pragma unroll
            for (int i = 0; i < 4; ++i) { const float h = hl[tau][i] + pl[tau][i] * hin, gr = gr4[tau][i]; yp[(size_t)i * DM] = (bf16)f2bf(h * gr * fast_sigm(gr)); }
        }
    }
#undef LRU_STAGE
    __syncthreads();
}
__device__ __forceinline__ void lru_phase(const P& p, int l, LAS unsigned char* lds) {
    const int G = gridDim.x, wg = blockIdx.x;
#pragma unroll 1
    for (int u = wg; u < 256; u += G) lru_unit(p, l, (u >> 3) & 7, u & 7, u >> 6, lds);
}
#ifndef DSA_PHASE
#define DSA_PHASE dsa_phase
#endif
#ifndef LRU_PHASE
#define LRU_PHASE lru_phase
#endif
#ifndef RP_A
#define RP_A 1
#endif
#ifndef RP_L
#define RP_L 1
#endif
#ifndef RP_D
#define RP_D 1
#endif
#ifndef RP_C
#define RP_C 1
#endif
#ifndef RP_0
#define RP_0 1
#endif
template <int OFF> __device__ __forceinline__ unsigned long long karg_u64() {
    unsigned long long v; const unsigned long long kp = (unsigned long long)__builtin_amdgcn_kernarg_segment_ptr();
    asm volatile("s_load_dwordx2 %0, %1, %2\n\ts_waitcnt lgkmcnt(0)" : "=s"(v) : "s"(kp), "i"(OFF) : "memory");
    return v;
}
struct Args { const float* in[15]; float* out; unsigned char* ws; int ph_lo, ph_hi; };
__global__ void __launch_bounds__(512, 2) mega(Args a) {
    extern __shared__ __attribute__((aligned(16))) unsigned char lds_raw[];
    LAS unsigned char* lds = (LAS unsigned char*)lds_raw;
#define KARG(T, off) ((T)(__attribute__((address_space(1))) void*)karg_u64<(off)>())
#define LOADP() P p; { unsigned char* ws_ = KARG(unsigned char*, 128); \
        p.x = KARG(const float*, 0); p.c = KARG(const float*, 8); p.norm_g = KARG(const float*, 16); p.ada_w = KARG(const float*, 24); p.ada_b = KARG(const float*, 32); p.w_in = KARG(const float*, 40); \
        p.conv_w = KARG(const float*, 48); p.conv_b = KARG(const float*, 56); p.lru_wx = KARG(const float*, 64); p.lru_bx = KARG(const float*, 72); p.lru_wa = KARG(const float*, 80); p.lru_ba = KARG(const float*, 88); \
        p.lru_a = KARG(const float*, 96); p.w_out = KARG(const float*, 104); p.final_g = KARG(const float*, 112); p.out = KARG(float*, 120); \
        p.ctl = (unsigned*)(ws_ + WS_CTL); p.mod = (float*)(ws_ + WS_MOD); p.bias = (float*)(ws_ + WS_BIAS); p.ssq = (float*)(ws_ + WS_SSQ); \
        p.wt_in = (bf16*)(ws_ + WS_WTIN); p.wt_out = (bf16*)(ws_ + WS_WTOUT); p.A = (bf16*)(ws_ + WS_A); p.Z = (bf16*)(ws_ + WS_Z); p.Y = (bf16*)(ws_ + WS_Y); p.X1 = (bf16*)(ws_ + WS_X1); }
    unsigned* const ctl0 = (unsigned*)((unsigned char*)a.ws + WS_CTL);
    const int lo = a.ph_lo, hi = a.ph_hi;
    volatile LAS unsigned* MISC = (volatile LAS unsigned*)(lds + MISC_OFF + 4096);
    if (threadIdx.x < 4) MISC[threadIdx.x] = 0u;
    if (threadIdx.x < 16) { const unsigned t = threadIdx.x; u32x2 m; m.x = ((t & 1u) ? 0xffffu : 0u) | ((t & 2u) ? 0xffff0000u : 0u); m.y = ((t & 4u) ? 0xffffu : 0u) | ((t & 8u) ? 0xffff0000u : 0u);
        *(LAS u32x2*)(lds + DSA_MLUT_OFF + t * 8) = m; }
    __syncthreads();
    XcdBarrier bar; bar.bar = ctl0 + CW_BAR; bar.x = 0; bar.st = MISC;
    if (hi - lo > 1) bar = xcd_barrier_post(ctl0 + CW_BAR, MISC);
#define IN(k) (lo <= (k) && (k) < hi)
#ifndef N_CG_SEAMS
#define N_CG_SEAMS 0
#endif
#define SEAM(k) do { if (IN(k) && IN((k) + 1)) { if ((k) < N_CG_SEAMS) cg::this_grid().sync(); else xcd_barrier(bar); } } while (0)
    if (IN(0)) { LOADP(); ph0_prologue(p, lds); if (RP_0 > 1) { __syncthreads(); ph0_prologue(p, lds); } }
    SEAM(0);
    if (IN(1)) { LOADP(); ph1_prologue(p, lds); if (RP_0 > 1) { __syncthreads(); ph1_prologue(p, lds); } }
    SEAM(1);
#define LAYER(l, base) \
    if (IN(base)) { LOADP(); \
        pg8::Gemm g{p.A, p.wt_in + (size_t)(l) * ZP * 1024, MROWS, ZP, DM}; pg8::StaticOrder S; S.init(MROWS, ZP, (int)gridDim.x, (int)blockIdx.x); \
        EpiZ E{p.Z, p.ssq, p.bias + (size_t)(l) * 8 * ZP}; \
        pg8::gemm_phase<EpiZ, pg8::StaticOrder, PG8_ALIGN, PG8_SP2>(lds, g, S, E); if (RP_A > 1) { __syncthreads(); pg8::gemm_phase<EpiZ, pg8::StaticOrder, PG8_ALIGN, PG8_SP2>(lds, g, S, E); } \
    } \
    SEAM(base); \
    if (IN((base) + 1)) { LOADP(); dsa_phase_pre(p, lds); LRU_PHASE(p, (l), lds); __syncthreads(); if (RP_L > 1) { LRU_PHASE(p, (l), lds); __syncthreads(); } DSA_PHASE(p, lds); if (RP_D > 1) { __syncthreads(); DSA_PHASE(p, lds); } } \
    SEAM((base) + 1); \
    if (IN((base) + 2)) { LOADP(); \
        pg8::Gemm g{p.Y, p.wt_out + (size_t)(l) * 1024 * 1024, MROWS, DM, DM}; pg8::StaticOrder S; S.init(MROWS, DM, (int)gridDim.x, (int)blockIdx.x); \
        if constexpr ((l) == DEPTH - 1) { \
            EpiXF E{p.X1, p.out, p.mod + (size_t)(l) * 8 * 3072 + 2048, p.final_g, p.ssq, p.ctl + CW_PANEL}; \
            pg8::gemm_phase<EpiXF, pg8::StaticOrder, false, PG8_SP2>(lds, g, S, E); \
        } else { \
            EpiX E{p.x, p.X1, p.A, p.mod + (size_t)(l) * 8 * 3072 + 2048, p.norm_g + (size_t)((l) + 1) * 1024, p.mod + (size_t)((l) + 1) * 8 * 3072 + 1024, p.ssq}; \
            pg8::gemm_phase<EpiX, pg8::StaticOrder, false, PG8_SP2>(lds, g, S, E); if (RP_C > 1 && (l) == 0) { __syncthreads(); pg8::gemm_phase<EpiX, pg8::StaticOrder, false, PG8_SP2>(lds, g, S, E); } \
        } \
    } \
    if ((base) + 3 < NPHASE) SEAM((base) + 2);
    LAYER(0, 2)
    LAYER(1, 5)
}
#ifndef MK_N_LAUNCHES
#define MK_N_LAUNCHES 1
#endif
extern "C" void kernel_launch(void* const* d_in, const int* in_sizes, int n_in, void* d_out, int out_size, void* d_ws, size_t ws_size, hipStream_t stream) {
    static int grid = 0;
    if (grid == 0) {
        if (n_in != 15 || out_size != MROWS * DM || ws_size < WS_END) { fprintf(stderr, "kernel_launch: unexpected problem (n_in %d out %d ws %zu)\n", n_in, out_size, ws_size); grid = -1; return; }
        int dev = 0, cus = 0, per_cu = 0;
        hipGetDevice(&dev); hipDeviceGetAttribute(&cus, hipDeviceAttributeMultiprocessorCount, dev);
        if (hipFuncSetAttribute((const void*)mega, hipFuncAttributeMaxDynamicSharedMemorySize, LDS_BYTES) != hipSuccess) { fprintf(stderr, "kernel_launch: hipFuncSetAttribute failed\n"); grid = -1; return; }
        if (hipOccupancyMaxActiveBlocksPerMultiprocessor(&per_cu, (const void*)mega, 512, LDS_BYTES) != hipSuccess || per_cu < 1) { fprintf(stderr, "kernel_launch: occupancy query failed (%d)\n", per_cu); per_cu = 1; }
        (void)hipGetLastError();
        grid = cus * per_cu;
        if (grid != 256) fprintf(stderr, "kernel_launch: grid %d (cus %d x %d) != 256: the fused out-projection epilogue needs exactly 256 workgroups\n", grid, cus, per_cu);
    }
    if (grid < 0) return;
    hipMemsetAsync((char*)d_ws + WS_CTL, 0, CTL_ZERO_BYTES, stream);
    Args a{};
    for (int i = 0; i < 15; ++i) a.in[i] = (const float*)d_in[i];
    a.out = (float*)d_out; a.ws = (unsigned char*)d_ws;
#if MK_N_LAUNCHES == 1
    a.ph_lo = 0; a.ph_hi = NPHASE;
    void* args[] = {&a};
    hipError_t e = hipLaunchCooperativeKernel((const void*)mega, dim3(grid), dim3(512), args, LDS_BYTES, stream);
    if (e != hipSuccess) fprintf(stderr, "cooperative launch failed: %s (grid %d)\n", hipGetErrorString(e), grid);
#else
    for (int ph = 0; ph < NPHASE; ++ph) { a.ph_lo = ph; a.ph_hi = ph + 1; hipLaunchKernelGGL(mega, dim3(grid), dim3(512), LDS_BYTES, stream, a); }
#endif
}
```

```cpp
#include <hip/hip_runtime.h>
#include <hip/hip_cooperative_groups.h>
#include <cstdio>
#include <cstdint>
#include <cmath>
namespace cg = cooperative_groups;
#define EPI_XD 3
#define EPI_ZD 8
#define HIST_WAVES 8
#define PRO_KC 64
namespace pg8 {
#define PG8_LAS __attribute__((address_space(3)))
typedef unsigned short bf16_t;
typedef short bf16x8 __attribute__((ext_vector_type(8)));
typedef float f32x4 __attribute__((ext_vector_type(4)));
typedef unsigned u32x4 __attribute__((ext_vector_type(4)));
constexpr int BM = 256, BK = 64, HALF = 128, HTB = HALF * BK * 2  , STAGE_BYTES = 8 * HTB, NXCD = 8, WGM = 8;

__host__ __device__ __forceinline__ int lds_byte(int r, int c) { const int st = (r >> 4) * 2 + (c >> 5), rr = r & 15, cc = c & 31, ob = rr * 64 + cc * 2; return st * 1024 + (ob ^ (((ob >> 9) & 1) << 5)); }
__host__ __device__ __forceinline__ void stage_rc(int b, int& R, int& C) { const int st = b / 1024, sb = b % 1024, swz = sb ^ (((sb >> 9) & 1) << 5); R = (st >> 1) * 16 + swz / 64; C = (st & 1) * 32 + (swz % 64) / 2; }
__host__ __device__ __forceinline__ int perm32(int rho) { const int n = rho >> 4, i = rho & 15; return 8 * (i >> 2) + 4 * n + (i & 3); }

struct Unit { int pm, pn; };
struct Gemm { const bf16_t* A; const bf16_t* Bt; int M, N, K; };

struct StaticOrder {
    int nM, nN, nwg, G, c;
    __host__ __device__ void init(int M, int N, int G_, int c_) { nM = M / BM; nN = N / BM; nwg = nM * nN; G = G_; c = c_; }
    __host__ __device__ bool next(int i, Unit& u) const {
        const long L = (long)i * G + c; if (L >= nwg) return false;
        int wgid = (int)L; { const int q = nwg / NXCD, r = nwg % NXCD, xcd = wgid % NXCD, off = wgid / NXCD; wgid = (xcd < r ? xcd * (q + 1) : r * (q + 1) + (xcd - r) * q) + off; }
        const int nig = WGM * nN, gid = wgid / nig, fm = gid * WGM, gsz = (nM - fm) < WGM ? (nM - fm) : WGM;
        u.pm = fm + ((wgid % nig) % gsz); u.pn = (wgid % nig) / gsz; return true;
    }
    __device__ __forceinline__ void a_ready(const Unit&) const {}
    __device__ __forceinline__ void done(const Unit&) const {}
};

__device__ __forceinline__ unsigned cvt_pk_bf16(float lo, float hi) { unsigned r; asm volatile("v_cvt_pk_bf16_f32 %0, %1, %2" : "=v"(r) : "v"(lo), "v"(hi)); return r; }
typedef float f32x2 __attribute__((ext_vector_type(2)));
template <class Epi, class Sched, bool ALIGN_EPI = false, bool SP2 = false>
__device__ __forceinline__ void gemm_phase(PG8_LAS unsigned char* lds, const Gemm g, const Sched& S, const Epi& E) {
    const int tid = threadIdx.x, wid = __builtin_amdgcn_readfirstlane(tid >> 6), lane = tid & 63, wr = wid >> 2, wc = wid & 3, fr = lane & 15, fq = lane >> 4;
    const int K = g.K, nt = K / BK;
    unsigned voffA[2], voffB[2];
#pragma unroll
    for (int i = 0; i < 2; ++i) { int R, C; stage_rc(tid * 16 + i * 8192, R, C); const int Rb = Epi::PERM ? ((R & ~31) + perm32(R & 31)) : R;
        voffA[i] = (unsigned)(R * K + C) * 2u; voffB[i] = (unsigned)(Rb * K + C) * 2u; }
    const size_t kstep = (size_t)(BK * 2);
    const size_t hstep = (size_t)HALF * K * 2;
    const size_t tstep = 2 * hstep;
    const unsigned ldsw = (unsigned)wid * 1024u;
    const int aoff = lds_byte(wr * 64 + fr, fq * 8), boff = lds_byte(wc * 32 + fr, fq * 8);
#define PG8_SA(b, h) (((b) * 2 + (h)) * HTB)
#define PG8_SB(b, h) ((4 + (b) * 2 + (h)) * HTB)
#define PG8_STAGE(bufoff, gbase, voff) do { _Pragma("unroll") for (int _i = 0; _i < 2; ++_i) \
        __builtin_amdgcn_global_load_lds((const unsigned*)((const char*)(gbase) + (voff)[_i]), (PG8_LAS unsigned*)(lds + (bufoff) + ldsw + _i * 8192), 16, 0, 0); } while (0)
#define PG8_LDA(dst, b, h) do { _Pragma("unroll") for (int m = 0; m < 4; ++m) _Pragma("unroll") for (int k = 0; k < 2; ++k) dst[m][k] = *(const PG8_LAS bf16x8*)(lds + PG8_SA(b, h) + aoff + m * 2048 + k * 1024); } while (0)
#define PG8_LDB(dst, b, h) do { _Pragma("unroll") for (int n = 0; n < 2; ++n) _Pragma("unroll") for (int k = 0; k < 2; ++k) dst[n][k] = *(const PG8_LAS bf16x8*)(lds + PG8_SB(b, h) + boff + n * 2048 + k * 1024); } while (0)
#define PG8_MMA(ai, bj, At, Bt) do { __builtin_amdgcn_s_setprio(1); _Pragma("unroll") for (int m = 0; m < 4; ++m) _Pragma("unroll") for (int n = 0; n < 2; ++n) _Pragma("unroll") for (int k = 0; k < 2; ++k) \
        acc[ai][bj][m][n] = __builtin_amdgcn_mfma_f32_16x16x32_bf16(Bt[n][k], At[m][k], acc[ai][bj][m][n], 0, 0, 0); __builtin_amdgcn_s_setprio(0); } while (0)
#define PG8_WAIT_V(n) asm volatile("s_waitcnt vmcnt(" #n ")" ::: "memory")
#define PG8_WAIT_L(n) asm volatile("s_waitcnt lgkmcnt(" #n ")" ::: "memory")
#define PG8_BAR __builtin_amdgcn_s_barrier()
#define PG8_SCHED __builtin_amdgcn_sched_barrier(0)
    Unit cur, nxt; int ui = 0;
    if (!S.next(0, cur)) return;
    f32x4 acc[2][2][4][2];
#pragma unroll
    for (int a = 0; a < 2; ++a)
#pragma unroll
        for (int b = 0; b < 2; ++b)
#pragma unroll
            for (int m = 0; m < 4; ++m)
#pragma unroll
                for (int n = 0; n < 2; ++n) acc[a][b][m][n] = (f32x4){0.f, 0.f, 0.f, 0.f};
    bf16x8 At[4][2], B0[2][2], B1[2][2];
    const char* cA = (const char*)g.A + (size_t)cur.pm * tstep; const char* cB = (const char*)g.Bt + (size_t)cur.pn * tstep;
    S.a_ready(cur);
    if constexpr (SP2) {
        PG8_STAGE(PG8_SB(0, 0), cB, voffB); PG8_STAGE(PG8_SB(0, 1), cB + hstep, voffB); PG8_STAGE(PG8_SA(0, 0), cA, voffA); PG8_STAGE(PG8_SA(0, 1), cA + hstep, voffA);
        if (wr == 1) PG8_BAR;
        PG8_WAIT_V(2); PG8_BAR;
        PG8_STAGE(PG8_SB(1, 0), cB + kstep, voffB); PG8_STAGE(PG8_SA(1, 0), cA + kstep, voffA); PG8_STAGE(PG8_SB(1, 1), cB + hstep + kstep, voffB);
        PG8_WAIT_V(6); PG8_BAR;
    } else {
        PG8_STAGE(PG8_SB(0, 0), cB, voffB); PG8_STAGE(PG8_SA(0, 0), cA, voffA); PG8_STAGE(PG8_SB(0, 1), cB + hstep, voffB); PG8_STAGE(PG8_SA(0, 1), cA + hstep, voffA);
        if (wr == 1) PG8_BAR;
        PG8_WAIT_V(4); PG8_BAR;
        PG8_STAGE(PG8_SB(1, 0), cB + kstep, voffB); PG8_STAGE(PG8_SA(1, 0), cA + kstep, voffA); PG8_STAGE(PG8_SB(1, 1), cB + hstep + kstep, voffB);
        PG8_WAIT_V(6); PG8_BAR;
    }
    for (;;) {
        const bool has_next = S.next(ui + 1, nxt);
        const char* nA = has_next ? (const char*)g.A + (size_t)nxt.pm * tstep : cA; const char* nB = has_next ? (const char*)g.Bt + (size_t)nxt.pn * tstep : cB;
        for (int t = 0; t < nt; t += 2) {
            const bool last = (t == nt - 2);
            const char* a1 = cA + (size_t)(t + 1) * kstep;
            const char* a2 = last ? nA : cA + (size_t)(t + 2) * kstep; const char* b2 = last ? nB : cB + (size_t)(t + 2) * kstep;
            const char* a3 = a2 + kstep; const char* b3 = b2 + kstep;
            if (last && has_next) S.a_ready(nxt);
            if constexpr (SP2) {
            PG8_LDB(B0, 0, 0); PG8_LDB(B1, 0, 1); PG8_SCHED; PG8_LDA(At, 0, 0); PG8_STAGE(PG8_SA(1, 1), a1 + hstep, voffA);
            PG8_WAIT_V(8); PG8_WAIT_L(0); PG8_BAR; PG8_MMA(0, 0, At, B0); PG8_MMA(0, 1, At, B1); PG8_BAR; PG8_SCHED;
            PG8_LDA(At, 0, 1); PG8_STAGE(PG8_SB(0, 0), b2, voffB); PG8_STAGE(PG8_SB(0, 1), b2 + hstep, voffB); PG8_STAGE(PG8_SA(0, 0), a2, voffA);
            PG8_WAIT_V(8); PG8_WAIT_L(0); PG8_BAR; PG8_MMA(1, 0, At, B0); PG8_MMA(1, 1, At, B1); PG8_BAR; PG8_SCHED;
            PG8_LDB(B0, 1, 0); PG8_LDB(B1, 1, 1); PG8_SCHED; PG8_LDA(At, 1, 0); PG8_STAGE(PG8_SA(0, 1), a2 + hstep, voffA);
            PG8_WAIT_V(8); PG8_WAIT_L(0); PG8_BAR; PG8_MMA(0, 0, At, B0); PG8_MMA(0, 1, At, B1); PG8_BAR; PG8_SCHED;
            PG8_LDA(At, 1, 1); PG8_STAGE(PG8_SB(1, 0), b3, voffB); PG8_STAGE(PG8_SB(1, 1), b3 + hstep, voffB); PG8_STAGE(PG8_SA(1, 0), a3, voffA);
            PG8_WAIT_V(8); PG8_WAIT_L(0); PG8_BAR; PG8_MMA(1, 0, At, B0); PG8_MMA(1, 1, At, B1); PG8_BAR; PG8_SCHED;
            } else {
            PG8_LDB(B0, 0, 0); PG8_SCHED; PG8_LDA(At, 0, 0); PG8_STAGE(PG8_SA(1, 1), a1 + hstep, voffA);
            PG8_WAIT_L(8); PG8_BAR; PG8_WAIT_L(0); PG8_MMA(0, 0, At, B0); PG8_BAR; PG8_SCHED;
            PG8_LDB(B1, 0, 1); PG8_STAGE(PG8_SB(0, 0), b2, voffB);
            PG8_BAR; PG8_WAIT_L(0); PG8_MMA(0, 1, At, B1); PG8_BAR;
            PG8_LDA(At, 0, 1); PG8_STAGE(PG8_SA(0, 0), a2, voffA);
            PG8_BAR; PG8_WAIT_L(0); PG8_MMA(1, 0, At, B0); PG8_BAR; PG8_SCHED;
            PG8_STAGE(PG8_SB(0, 1), b2 + hstep, voffB);
            PG8_WAIT_V(6); PG8_BAR; PG8_MMA(1, 1, At, B1); PG8_BAR;
            PG8_LDB(B0, 1, 0); PG8_SCHED; PG8_LDA(At, 1, 0); PG8_STAGE(PG8_SA(0, 1), a2 + hstep, voffA);
            PG8_WAIT_L(8); PG8_BAR; PG8_WAIT_L(0); PG8_MMA(0, 0, At, B0); PG8_BAR; PG8_SCHED;
            PG8_LDB(B1, 1, 1); PG8_STAGE(PG8_SB(1, 0), b3, voffB);
            PG8_BAR; PG8_WAIT_L(0); PG8_MMA(0, 1, At, B1); PG8_BAR;
            PG8_LDA(At, 1, 1); PG8_STAGE(PG8_SA(1, 0), a3, voffA);
            PG8_BAR; PG8_WAIT_L(0); PG8_MMA(1, 0, At, B0); PG8_BAR; PG8_SCHED;
            PG8_STAGE(PG8_SB(1, 1), b3 + hstep, voffB);
            PG8_WAIT_V(6); PG8_BAR; PG8_MMA(1, 1, At, B1); PG8_BAR;
            }
        }
        if constexpr (ALIGN_EPI) { if (wr == 0) PG8_BAR; }
        if constexpr (!Epi::AFTER_DRAIN) { E(acc, cur, wr, wc, fr, fq); S.done(cur); }
        if (!has_next) break;
#pragma unroll
        for (int a = 0; a < 2; ++a)
#pragma unroll
            for (int b = 0; b < 2; ++b)
#pragma unroll
                for (int m = 0; m < 4; ++m)
#pragma unroll
                    for (int n = 0; n < 2; ++n) acc[a][b][m][n] = (f32x4){0.f, 0.f, 0.f, 0.f};
        cur = nxt; cA = nA; cB = nB; ++ui;
        if constexpr (ALIGN_EPI) { if (wr == 1) PG8_BAR; }
    }
    PG8_WAIT_V(0);
    if constexpr (!ALIGN_EPI) { if (wr == 0) PG8_BAR; }
    PG8_BAR;
    if constexpr (Epi::AFTER_DRAIN) { E.fused(acc, cur, wr, wc, fr, fq, lds, wid, lane); S.done(cur); }
#undef PG8_SA
#undef PG8_SB
#undef PG8_STAGE
#undef PG8_LDA
#undef PG8_LDB
#undef PG8_MMA
#undef PG8_WAIT_V
#undef PG8_WAIT_L
#undef PG8_BAR
#undef PG8_SCHED
}
}

#ifndef PG8_SP2
#define PG8_SP2 true
#endif
#ifndef PG8_ALIGN
#define PG8_ALIGN true
#endif
constexpr int BATCH = 8, SEQ = 2048, DM = 1024, MROWS = BATCH * SEQ, DEPTH = 2;
constexpr int D_RNN = 512, NHEAD = 8, HDIM = 64, D_INR = 2760, ZP = 2816, TOPK = 256;
constexpr int C_XR = 0, C_GR = 512, C_Q = 1024, C_K = 1536, C_V = 1600, C_GA = 1664, C_QI = 2176, C_KI = 2688, C_WI = 2752;
constexpr float EPS = 1e-6f;
constexpr float QSCALE = 0.125f * 1.4426950408889634f;
constexpr size_t MiB = 1u << 20;
constexpr size_t WS_CTL = 0, CTL_ZERO_BYTES = 1 * MiB;
constexpr size_t WS_MOD = 1 * MiB;
constexpr size_t WS_BIAS = 1 * MiB + 256 * 1024;
constexpr size_t WS_SSQ = 2 * MiB;
constexpr size_t WS_WTIN = 3 * MiB;
constexpr size_t WS_WTOUT = 14 * MiB;
constexpr size_t WS_A = 32 * MiB;
constexpr size_t WS_Z = 64 * MiB;
constexpr size_t WS_Y = 152 * MiB;
constexpr size_t WS_X1 = 184 * MiB;
constexpr size_t WS_END = 216 * MiB;
constexpr int LDS_BYTES = 163840;
constexpr int MISC_OFF = 131072 + 8192;
constexpr int NPHASE = 8;
constexpr int CW_BAR = 4096, CW_PANEL = 16384;

#define LAS __attribute__((address_space(3)))
typedef unsigned short bf16;
typedef float f32x4 __attribute__((ext_vector_type(4)));
typedef unsigned u32x4 __attribute__((ext_vector_type(4)));
typedef unsigned u32x2 __attribute__((ext_vector_type(2)));
__device__ __forceinline__ float bf2f(bf16 v) { return __uint_as_float(((unsigned)v) << 16); }
__device__ __forceinline__ unsigned f2bf(float f) { unsigned u = __float_as_uint(f); return (u + 0x7fffu + ((u >> 16) & 1u)) >> 16; }
__device__ __forceinline__ unsigned pk2(float lo, float hi) { return f2bf(lo) | (f2bf(hi) << 16); }
__device__ __forceinline__ float wave_sum(float v) {
#pragma unroll
    for (int o = 1; o < 64; o <<= 1) v += __shfl_xor(v, o);
    return v;
}
__device__ __forceinline__ float wave_max(float v) {
#pragma unroll
    for (int o = 1; o < 64; o <<= 1) v = fmaxf(v, __shfl_xor(v, o));
    return v;
}
__device__ __forceinline__ int wave_sum_i(int v) {
#pragma unroll
    for (int o = 1; o < 64; o <<= 1) v += __shfl_xor(v, o);
    return v;
}
__device__ __forceinline__ float siluf(float v) { return v / (1.f + expf(-v)); }
__device__ __forceinline__ float sigmf(float v) { return 1.f / (1.f + expf(-v)); }

struct P {
    const float *x, *c, *norm_g, *ada_w, *ada_b, *w_in, *conv_w, *conv_b, *lru_wx, *lru_bx, *lru_wa, *lru_ba, *lru_a, *w_out, *final_g;
    float* out;
    float *mod, *bias, *ssq;
    bf16 *wt_in, *wt_out, *A, *Z, *Y, *X1;
    unsigned* ctl;
};

#ifndef EPI_ZD
#define EPI_ZD 2
#endif
struct EpiZ {
    static constexpr bool PERM = true, AFTER_DRAIN = false;
    bf16* Zp; const float* ssq; const float* bias;
    __device__ __forceinline__ void operator()(const pg8::f32x4 (&acc)[2][2][4][2], const pg8::Unit& u, int wr, int wc, int fr, int fq) const {
        const int row0 = u.pm * 256 + wr * 64 + fr, col0 = u.pn * 256 + wc * 32 + 8 * fq, b = u.pm >> 3;
        const float cs = (u.pn == 4 || u.pn == 5) ? QSCALE : 1.0f;
        f32x4 bv[2][2];
#pragma unroll
        for (int bj = 0; bj < 2; ++bj)
#pragma unroll
            for (int n = 0; n < 2; ++n) bv[bj][n] = *(const f32x4*)(bias + b * ZP + col0 + bj * 128 + 4 * n);
        f32x4 qq[EPI_ZD];
#pragma unroll
        for (int gi = 0; gi < EPI_ZD; ++gi) qq[gi] = *(const f32x4*)(ssq + (size_t)(row0 + (gi >> 2) * 128 + (gi & 3) * 16) * 4);
#pragma unroll
        for (int ai = 0; ai < 2; ++ai)
#pragma unroll
            for (int m = 0; m < 4; ++m) {
                const int r = row0 + ai * 128 + m * 16, gi = ai * 4 + m;
                const f32x4 q = qq[gi % EPI_ZD];
                if (gi + EPI_ZD < 8) qq[gi % EPI_ZD] = *(const f32x4*)(ssq + (size_t)(row0 + ((gi + EPI_ZD) >> 2) * 128 + ((gi + EPI_ZD) & 3) * 16) * 4);
                const float rstd = __builtin_amdgcn_rsqf(((q.x + q.y) + (q.z + q.w)) * (1.0f / 1024.0f) + EPS);
                bf16* rowp = Zp + (size_t)r * ZP + col0;
#pragma unroll
                for (int bj = 0; bj < 2; ++bj) {
                    const f32x4 v0 = (acc[ai][bj][m][0] * rstd + bv[bj][0]) * cs, v1 = (acc[ai][bj][m][1] * rstd + bv[bj][1]) * cs;
                    u32x4 w; w.x = pk2(v0[0], v0[1]); w.y = pk2(v0[2], v0[3]); w.z = pk2(v1[0], v1[1]); w.w = pk2(v1[2], v1[3]);
                    *(u32x4*)(rowp + bj * 128) = w;
                }
            }
    }
};
#ifndef EPI_XD
#define EPI_XD 4
#endif
struct EpiX {
    static constexpr bool PERM = true, AFTER_DRAIN = true;
    const float* xres; bf16* xout; bf16* Anext; const float* gate; const float* ng; const float* nscale; float* ssq;
    __device__ __forceinline__ void fused(pg8::f32x4 (&acc)[2][2][4][2], const pg8::Unit& u, int wr, int wc, int fr, int fq, LAS unsigned char* lds, int wid, int lane) const {
        const int b = u.pm >> 3, col0 = u.pn * 256 + wc * 32 + 8 * fq;
        LAS float* Pp = (LAS float*)lds;
        f32x4 gv[2][2], gs[2][2];
#pragma unroll
        for (int bj = 0; bj < 2; ++bj)
#pragma unroll
            for (int n = 0; n < 2; ++n) {
                gv[bj][n] = *(const f32x4*)(gate + b * 3072 + col0 + bj * 128 + 4 * n);
                if (Anext) { const f32x4 g = *(const f32x4*)(ng + col0 + bj * 128 + 4 * n), s = *(const f32x4*)(nscale + b * 3072 + col0 + bj * 128 + 4 * n); gs[bj][n] = g * (s + 1.0f); }
                else gs[bj][n] = (f32x4){0.f, 0.f, 0.f, 0.f};
            }
        f32x4 xq[EPI_XD][2][2];
#define EPIX_LOAD(gi) do { const size_t r_ = (size_t)u.pm * 256 + ((gi) >> 2) * 128 + wr * 64 + ((gi) & 3) * 16 + fr; \
        _Pragma("unroll") for (int bj = 0; bj < 2; ++bj) _Pragma("unroll") for (int n = 0; n < 2; ++n) xq[(gi) % EPI_XD][bj][n] = *(const f32x4*)(xres + r_ * DM + col0 + bj * 128 + 4 * n); } while (0)
#pragma unroll
        for (int gi = 0; gi < EPI_XD; ++gi) EPIX_LOAD(gi);
#pragma unroll
        for (int ai = 0; ai < 2; ++ai)
#pragma unroll
            for (int m = 0; m < 4; ++m) {
                const int rl = ai * 128 + wr * 64 + m * 16 + fr; const size_t r = (size_t)u.pm * 256 + rl;
                float s = 0.f;
                f32x4 xc[2][2];
#pragma unroll
                for (int bj = 0; bj < 2; ++bj)
#pragma unroll
                    for (int n = 0; n < 2; ++n) xc[bj][n] = xq[(ai * 4 + m) % EPI_XD][bj][n];
                if (ai * 4 + m + EPI_XD < 8) EPIX_LOAD(ai * 4 + m + EPI_XD);
#pragma unroll
                for (int bj = 0; bj < 2; ++bj) {
                    f32x4 x1[2];
#pragma unroll
                    for (int n = 0; n < 2; ++n) {
                        const f32x4 xr = xc[bj][n];
                        x1[n] = xr + gv[bj][n] * acc[ai][bj][m][n];
                        s += (x1[n][0] * x1[n][0] + x1[n][1] * x1[n][1]) + (x1[n][2] * x1[n][2] + x1[n][3] * x1[n][3]);
                    }
                    { u32x4 xw; xw.x = pk2(x1[0][0], x1[0][1]); xw.y = pk2(x1[0][2], x1[0][3]); xw.z = pk2(x1[1][0], x1[1][1]); xw.w = pk2(x1[1][2], x1[1][3]);
                      *(u32x4*)(xout + r * DM + col0 + bj * 128) = xw; }
                    if (Anext) { const f32x4 a0 = x1[0] * gs[bj][0], a1 = x1[1] * gs[bj][1];
                        u32x4 w; w.x = pk2(a0[0], a0[1]); w.y = pk2(a0[2], a0[3]); w.z = pk2(a1[0], a1[1]); w.w = pk2(a1[2], a1[3]);
                        *(u32x4*)(Anext + r * DM + col0 + bj * 128) = w; }
                }
                s += __shfl_xor(s, 16); s += __shfl_xor(s, 32);
                if (fq == 0) Pp[rl * 4 + wc] = s;
            }
        __syncthreads();
        const int tid = wid * 64 + lane;
        if (tid < 256) ssq[((size_t)u.pm * 256 + tid) * 4 + u.pn] = (Pp[tid * 4 + 0] + Pp[tid * 4 + 1]) + (Pp[tid * 4 + 2] + Pp[tid * 4 + 3]);
        __syncthreads();
    }
};

struct EpiXF {
    static constexpr bool PERM = true, AFTER_DRAIN = true;
    const bf16* xres; float* out; const float* gate; const float* fg; float* ssq; unsigned* cnt;
    __device__ __forceinline__ void fused(pg8::f32x4 (&acc)[2][2][4][2], const pg8::Unit& u, int wr, int wc, int fr, int fq, LAS unsigned char* lds, int wid, int lane) const {
        const int b = u.pm >> 3, col0 = u.pn * 256 + wc * 32 + 8 * fq, tid = wid * 64 + lane;
        LAS float* Pp = (LAS float*)lds;
        LAS float* Sr = (LAS float*)(lds + 4096);
        {
            f32x4 gv[2][2];
#pragma unroll
            for (int bj = 0; bj < 2; ++bj)
#pragma unroll
                for (int n = 0; n < 2; ++n) gv[bj][n] = *(const f32x4*)(gate + b * 3072 + col0 + bj * 128 + 4 * n);
#pragma unroll
            for (int ai = 0; ai < 2; ++ai)
#pragma unroll
                for (int m = 0; m < 4; ++m) {
                    const int rl = ai * 128 + wr * 64 + m * 16 + fr; const size_t r = (size_t)u.pm * 256 + rl;
                    float s = 0.f;
#pragma unroll
                    for (int bj = 0; bj < 2; ++bj) {
                        const u32x4 xw = *(const u32x4*)(xres + r * DM + col0 + bj * 128);
#pragma unroll
                        for (int n = 0; n < 2; ++n) {
                            const unsigned w0 = n ? xw.z : xw.x, w1 = n ? xw.w : xw.y;
                            const f32x4 xr = {__uint_as_float(w0 << 16), __uint_as_float(w0 & 0xffff0000u), __uint_as_float(w1 << 16), __uint_as_float(w1 & 0xffff0000u)};
                            const f32x4 x1 = xr + gv[bj][n] * acc[ai][bj][m][n];
                            acc[ai][bj][m][n] = x1;
                            s += (x1[0] * x1[0] + x1[1] * x1[1]) + (x1[2] * x1[2] + x1[3] * x1[3]);
                        }
                    }
                    s += __shfl_xor(s, 16); s += __shfl_xor(s, 32);
                    if (fq == 0) Pp[rl * 4 + wc] = s;
                }
        }
        __syncthreads();
        if (tid < 256) { const float tot = (Pp[tid * 4 + 0] + Pp[tid * 4 + 1]) + (Pp[tid * 4 + 2] + Pp[tid * 4 + 3]);
            __hip_atomic_store(ssq + ((size_t)u.pm * 256 + tid) * 4 + u.pn, tot, __ATOMIC_RELAXED, __HIP_MEMORY_SCOPE_AGENT); }
        asm volatile("s_waitcnt vmcnt(0)" ::: "memory");
        __syncthreads();
        if (tid == 0) {
            unsigned* c = cnt + 64 * u.pm;
            __hip_atomic_fetch_add(c, 1u, __ATOMIC_RELAXED, __HIP_MEMORY_SCOPE_AGENT);
            unsigned spins = 0u;
            while (__hip_atomic_load(c, __ATOMIC_RELAXED, __HIP_MEMORY_SCOPE_AGENT) < 4u) { __builtin_amdgcn_s_sleep(2); if (++spins > (1u << 22)) break; }
            __builtin_amdgcn_fence(__ATOMIC_ACQUIRE, "agent");
            asm volatile("s_waitcnt vmcnt(0)" ::: "memory");
        }
        __syncthreads();
        if (tid < 256) { const float* sp = ssq + ((size_t)u.pm * 256 + tid) * 4;
            const float q0 = __hip_atomic_load(sp + 0, __ATOMIC_RELAXED, __HIP_MEMORY_SCOPE_AGENT), q1 = __hip_atomic_load(sp + 1, __ATOMIC_RELAXED, __HIP_MEMORY_SCOPE_AGENT);
            const float q2 = __hip_atomic_load(sp + 2, __ATOMIC_RELAXED, __HIP_MEMORY_SCOPE_AGENT), q3 = __hip_atomic_load(sp + 3, __ATOMIC_RELAXED, __HIP_MEMORY_SCOPE_AGENT);
            Sr[tid] = 1.0f / sqrtf(((q0 + q1) + (q2 + q3)) * (1.0f / 1024.0f) + EPS); }
        __syncthreads();
        f32x4 fgv[2][2];
#pragma unroll
        for (int bj = 0; bj < 2; ++bj)
#pragma unroll
            for (int n = 0; n < 2; ++n) fgv[bj][n] = *(const f32x4*)(fg + col0 + bj * 128 + 4 * n);
#pragma unroll
        for (int ai = 0; ai < 2; ++ai)
#pragma unroll
            for (int m = 0; m < 4; ++m) {
                const int rl = ai * 128 + wr * 64 + m * 16 + fr; const size_t r = (size_t)u.pm * 256 + rl; const float rstd = Sr[rl];
#pragma unroll
                for (int bj = 0; bj < 2; ++bj)
#pragma unroll
                    for (int n = 0; n < 2; ++n) *(f32x4*)(out + r * DM + col0 + bj * 128 + 4 * n) = acc[ai][bj][m][n] * rstd * fgv[bj][n];
            }
        __syncthreads();
    }
};

#ifndef PRO_KC
#define PRO_KC 64
#endif
#ifndef TRQ
#define TRQ 4
#endif
__device__ __forceinline__ void ph0_prologue(const P& p, LAS unsigned char* lds) {
    const int tid = threadIdx.x, lane = tid & 63, wave = tid >> 6, G = gridDim.x, wg = blockIdx.x;
    LAS float* fl = (LAS float*)lds;
    for (int u = wg; u < 96; u += G) {
        const int l = u / 48, j = (u % 48) * 64 + lane;
        { float cv[16];
#pragma unroll
          for (int i = 0; i < 16; ++i) cv[i] = p.c[tid + 512 * i];
#pragma unroll
          for (int i = 0; i < 16; ++i) fl[tid + 512 * i] = siluf(cv[i]); }
        __syncthreads();
        float acc[8];
#pragma unroll
        for (int b = 0; b < 8; ++b) acc[b] = 0.f;
        const float* w = p.ada_w + ((size_t)l * 1024 + wave * 128) * 3072 + j;
#pragma unroll 1
        for (int k0 = 0; k0 < 128; k0 += PRO_KC) { float wv[PRO_KC];
#pragma unroll
          for (int k = 0; k < PRO_KC; ++k) wv[k] = w[(size_t)(k0 + k) * 3072];
#pragma unroll
          for (int k = 0; k < PRO_KC; ++k) {
#pragma unroll
            for (int b = 0; b < 8; ++b) acc[b] += fl[b * 1024 + wave * 128 + k0 + k] * wv[k]; } }
#pragma unroll
        for (int b = 0; b < 8; ++b) fl[8192 + (wave * 8 + b) * 64 + lane] = acc[b];
        __syncthreads();
        { const int b = wave; float s = p.ada_b[l * 3072 + j];
#pragma unroll
          for (int w8 = 0; w8 < 8; ++w8) s += fl[8192 + (w8 * 8 + b) * 64 + lane];
          p.mod[(l * 8 + b) * 3072 + j] = s; }
        __syncthreads();
    }
    const int GT = (G > 96) ? G - 96 : G, wt = (G > 96) ? wg - 96 : wg;
    if (wt >= 0)
#pragma unroll 1
    for (int u0 = wt; u0 < 1920; u0 += TRQ * GT) {
        float v[TRQ][8]; bf16* dst[TRQ]; bool act[TRQ];
#pragma unroll
        for (int q = 0; q < TRQ; ++q) {
            const int u = u0 + q * GT; act[q] = u < 1920; dst[q] = nullptr;
#pragma unroll
            for (int j = 0; j < 8; ++j) v[q][j] = 0.f;
            if (act[q]) {
                const float* W; bf16* WT; int N, kt, nt;
                if (u < 1408) { const int l = u / 704, r = u % 704; kt = r / 44; nt = r % 44; W = p.w_in + (size_t)l * 1024 * D_INR; N = D_INR; WT = p.wt_in + (size_t)l * ZP * 1024; }
                else { int r = u - 1408; const int l = r / 256; r %= 256; kt = r / 16; nt = r % 16; W = p.w_out + (size_t)l * 1024 * 1024; N = 1024; WT = p.wt_out + (size_t)l * 1024 * 1024; }
                const int n = nt * 64 + lane, k0 = kt * 64 + wave * 8;
                if (n < N) {
#pragma unroll
                    for (int j = 0; j < 8; ++j) v[q][j] = W[(size_t)(k0 + j) * N + n];
                }
                dst[q] = WT + (size_t)n * 1024 + k0;
            }
        }
#pragma unroll
        for (int q = 0; q < TRQ; ++q) if (act[q]) { u32x4 o; o.x = pk2(v[q][0], v[q][1]); o.y = pk2(v[q][2], v[q][3]); o.z = pk2(v[q][4], v[q][5]); o.w = pk2(v[q][6], v[q][7]); *(u32x4*)dst[q] = o; }
    }
}
__device__ __forceinline__ void ph1_prologue(const P& p, LAS unsigned char* lds) {
    const int tid = threadIdx.x, lane = tid & 63, wave = tid >> 6, G = gridDim.x, wg = blockIdx.x;
    LAS float* fl = (LAS float*)lds;
    for (int u = wg; u < 88; u += G) {
        const int l = u / 44, n = (u % 44) * 64 + lane;
        { float mv[16];
#pragma unroll
          for (int i = 0; i < 16; ++i) { const int e = tid + 512 * i; mv[i] = p.mod[(l * 8 + (e >> 10)) * 3072 + (e & 1023)]; }
#pragma unroll
          for (int i = 0; i < 16; ++i) fl[tid + 512 * i] = mv[i]; }
        __syncthreads();
        float acc[8];
#pragma unroll
        for (int b = 0; b < 8; ++b) acc[b] = 0.f;
        if (n < D_INR) { const float* w = p.w_in + ((size_t)l * 1024 + wave * 128) * D_INR + n;
#pragma unroll 1
            for (int k0 = 0; k0 < 128; k0 += PRO_KC) { float wv[PRO_KC];
#pragma unroll
              for (int k = 0; k < PRO_KC; ++k) wv[k] = w[(size_t)(k0 + k) * D_INR];
#pragma unroll
              for (int k = 0; k < PRO_KC; ++k) {
#pragma unroll
                for (int b = 0; b < 8; ++b) acc[b] += fl[b * 1024 + wave * 128 + k0 + k] * wv[k]; } } }
#pragma unroll
        for (int b = 0; b < 8; ++b) fl[8192 + (wave * 8 + b) * 64 + lane] = acc[b];
        __syncthreads();
        { const int b = wave; float s = 0.f;
#pragma unroll
          for (int w8 = 0; w8 < 8; ++w8) s += fl[8192 + (w8 * 8 + b) * 64 + lane];
          p.bias[(l * 8 + b) * ZP + n] = s; }
        __syncthreads();
    }
    {
        const int r0 = wg * 8 + wave, rstep = G * 8;
        f32x4 gq[4], xv[2][2][4], sv[2][2][4];
#pragma unroll
        for (int j = 0; j < 4; ++j) gq[j] = *(const f32x4*)(p.norm_g + (lane + 64 * j) * 4);
#define A0_LOAD(slot, pr) do { _Pragma("unroll") for (int h_ = 0; h_ < 2; ++h_) _Pragma("unroll") for (int j = 0; j < 4; ++j) { const int k_ = (lane + 64 * j) * 4, r_ = r0 + rstep * (2 * (pr) + h_); \
            xv[slot][h_][j] = *(const f32x4*)(p.x + (size_t)r_ * DM + k_); sv[slot][h_][j] = *(const f32x4*)(p.mod + (size_t)(r_ >> 11) * 3072 + 1024 + k_); } } while (0)
        A0_LOAD(0, 0);
#pragma unroll
        for (int pr = 0; pr < 4; ++pr) {
            if (pr + 1 < 4) A0_LOAD((pr + 1) & 1, pr + 1);
#pragma unroll
            for (int h = 0; h < 2; ++h) {
                const int r = r0 + rstep * (2 * pr + h); float s1 = 0.f;
#pragma unroll
                for (int j = 0; j < 4; ++j) { const int k = (lane + 64 * j) * 4; const f32x4 v = xv[pr & 1][h][j];
                    s1 += (v[0] * v[0] + v[1] * v[1]) + (v[2] * v[2] + v[3] * v[3]);
                    const f32x4 o1 = v * gq[j] * (sv[pr & 1][h][j] + 1.0f);
                    u32x2 w1; w1.x = pk2(o1[0], o1[1]); w1.y = pk2(o1[2], o1[3]);
                    *(u32x2*)(p.A + (size_t)r * DM + k) = w1; }
                s1 = wave_sum(s1);
                if (lane == 0) *(f32x4*)(p.ssq + (size_t)r * 4) = (f32x4){s1, 0.f, 0.f, 0.f};
            }
        }
#undef A0_LOAD
    }
}
__device__ __forceinline__ void ph_final(const P& p) {
    const int tid = threadIdx.x, lane = tid & 63, wave = tid >> 6, G = gridDim.x, wg = blockIdx.x;
    for (int r = wg * 8 + wave; r < MROWS; r += G * 8) {
        const f32x4 q = *(const f32x4*)(p.ssq + (size_t)r * 4);
        const float rstd = 1.0f / sqrtf(((q.x + q.y) + (q.z + q.w)) * (1.0f / 1024.0f) + EPS);
#pragma unroll
        for (int j = 0; j < 4; ++j) { const int k = (lane + 64 * j) * 4;
            const f32x4 v = *(const f32x4*)(p.out + (size_t)r * DM + k), g = *(const f32x4*)(p.final_g + k);
            *(f32x4*)(p.out + (size_t)r * DM + k) = v * rstd * g; }
    }
}
#define XB_TMO      128
#define XB_XCNT(j)  (256  + 64 * (j))
#define XB_XSUB(j)  (1280 + 64 * (j))
#define XB_XGEN(j)  (2304 + 64 * (j))
#define XB_TOP      3328
#define XB_TOPGEN   3392
#define XCD_BAR_WORDS 3456
#define XB_SPIN_CAP (1u << 18)

__device__ __forceinline__ unsigned xb_ld(unsigned* p)              { return __hip_atomic_load(p, __ATOMIC_RELAXED, __HIP_MEMORY_SCOPE_AGENT); }
__device__ __forceinline__ unsigned xb_add(unsigned* p, unsigned v) { return __hip_atomic_fetch_add(p, v, __ATOMIC_RELAXED, __HIP_MEMORY_SCOPE_AGENT); }
__device__ __forceinline__ unsigned xb_xcc_id() { return (unsigned)__builtin_amdgcn_s_getreg((3 << 11) | 20) & 0xFu; }
#define XB_SPIN(cond, bar) do { unsigned _sp = 0; while (cond) { __builtin_amdgcn_s_sleep(1); \
    if ((++_sp & 255u) == 0u) { if (xb_ld(&(bar)[XB_TMO])) break; if (_sp > XB_SPIN_CAP) { atomicAdd(&(bar)[XB_TMO], 1u); break; } } } } while (0)

struct XcdBarrier {
    unsigned* bar; unsigned x;
    volatile LAS unsigned* st;
};

__device__ __forceinline__ XcdBarrier xcd_barrier_post(unsigned* bar, volatile LAS unsigned* st) {
    XcdBarrier b; b.bar = bar; b.x = xb_xcc_id(); b.st = st;
    if (threadIdx.x == 0) (void)xb_add(&bar[XB_XCNT(b.x)], 1u);
    return b;
}
__device__ __forceinline__ void xcd_barrier_complete(unsigned* bar, unsigned x, unsigned& nloc, unsigned& nx) {
    const unsigned G = gridDim.x * gridDim.y * gridDim.z;
    unsigned sum, cnt, mine, sp = 0u;
    for (;;) {
        sum = 0u; cnt = 0u; mine = 0u;
#pragma unroll
        for (unsigned j = 0; j < 16; ++j) { const unsigned c = xb_ld(&bar[XB_XCNT(j)]); sum += c; cnt += (c > 0u) ? 1u : 0u; mine = (j == x) ? c : mine; }
        if (sum == G) break;
        __builtin_amdgcn_s_sleep(1);
        if ((++sp & 255u) == 0u) { if (xb_ld(&bar[XB_TMO])) break; if (sp > XB_SPIN_CAP) { atomicAdd(&bar[XB_TMO], 1u); break; } }
    }
    nloc = mine > 0u ? mine : 1u; nx = cnt > 0u ? cnt : 1u;
}

__device__ __forceinline__ void xcd_barrier(const XcdBarrier& b) {
    asm volatile("s_waitcnt vmcnt(0)" ::: "memory");
    __syncthreads();
    if (threadIdx.x == 0) {
        unsigned* bar = b.bar;
        __builtin_amdgcn_s_waitcnt(0);
        unsigned nloc = b.st[0], nx = b.st[1];
        if (nloc == 0u) { xcd_barrier_complete(bar, b.x, nloc, nx); b.st[0] = nloc; b.st[1] = nx; }
        const unsigned old = xb_add(&bar[XB_XSUB(b.x)], 1u);
        const unsigned gen = old / nloc;
        if (old + 1u == (gen + 1u) * nloc) {
            __builtin_amdgcn_fence(__ATOMIC_RELEASE, "agent");
            asm volatile("s_waitcnt vmcnt(0)" ::: "memory");
            const unsigned og = xb_add(&bar[XB_TOP], 1u);
            const unsigned tg = og / nx;
            if (og + 1u == (tg + 1u) * nx) xb_add(&bar[XB_TOPGEN], 1u);
            else XB_SPIN(xb_ld(&bar[XB_TOPGEN]) == tg, bar);
            __builtin_amdgcn_fence(__ATOMIC_ACQUIRE, "agent");
            xb_add(&bar[XB_XGEN(b.x)], 1u);
            asm volatile("s_waitcnt vmcnt(0)" ::: "memory");
        } else {
            XB_SPIN(xb_ld(&bar[XB_XGEN(b.x)]) == gen, bar);
            __builtin_amdgcn_fence(__ATOMIC_ACQUIRE, "agent");
            asm volatile("s_waitcnt vmcnt(0)" ::: "memory");
        }
    }
    __syncthreads();
}
__device__ __forceinline__ unsigned score_ukey(float s) { const unsigned u = __float_as_uint(s + 0.0f); return (u & 0x80000000u) ? ~u : (u | 0x80000000u); }
__device__ __forceinline__ void topk_threshold(const unsigned (&k)[32], unsigned& thr, unsigned& need) {
    unsigned prefix = 0u; bool exact = false;
    for (int bit = 31; bit >= 0; --bit) {
        const unsigned cand = prefix | (1u << bit);
        int c = 0;
#pragma unroll
        for (int i = 0; i < 32; ++i) c += (k[i] >= cand) ? 1 : 0;
        c = wave_sum_i(c);
        if (c >= TOPK) prefix = cand;
        if (c == TOPK) { exact = true; break; }
    }
    thr = prefix;
    if (exact) { need = 0xffffffffu; }
    else { int c = 0;
#pragma unroll
        for (int i = 0; i < 32; ++i) c += (k[i] > prefix) ? 1 : 0;
        c = wave_sum_i(c); need = (unsigned)(TOPK - c); }
}
#ifndef PROBE_VALU
#define PROBE_VALU 0
#endif
#ifndef RP_T3
#define RP_T3 1
#endif
#ifndef RP_T1
#define RP_T1 1
#endif
#ifndef RP_T2
#define RP_T2 1
#endif
#ifndef RP_I
#define RP_I 1
#endif
#ifndef RP_T
#define RP_T 1
#endif
#ifndef RP_V
#define RP_V 1
#endif
typedef short bf16x8v __attribute__((ext_vector_type(8)));
typedef short s16x4v __attribute__((ext_vector_type(4)));
constexpr int BMS = 65;
constexpr int SCP = 2052;
constexpr int DSA_BM_OFF = 16 * SCP * 4;
constexpr int DSA_RING_OFF = 0;
constexpr int DSA_QIB_OFF = 147456;
constexpr int DSA_WIB_OFF = 135680;
constexpr int DSA_MLUT_OFF = 143616;
__device__ __forceinline__ void glds16(const void* gsrc, unsigned lds_dst) { unsigned keep;
    asm volatile("s_mov_b32 %0, m0\n\ts_mov_b32 m0, %2\n\ts_nop 0\n\tglobal_load_lds_dwordx4 %1, off\n\ts_mov_b32 m0, %0" : "=&s"(keep) : "v"(gsrc), "s"(lds_dst) : "memory"); }
template <int I> __device__ __forceinline__ unsigned mbit_t(int mw) { unsigned r; asm("v_bfe_i32 %0, %1, %2, 1" : "=v"(r) : "v"(mw), "i"(I)); return r; }
#define mbit(mw, i) mbit_t<(i)>(mw)
__device__ __forceinline__ float relu_i(float x) { return __int_as_float(max(__float_as_int(x), 0)); }
__device__ __forceinline__ int imax3(float a, float b, float c) { return max(max(__float_as_int(a), __float_as_int(b)), __float_as_int(c)); }
__device__ __forceinline__ s16x4v lds_tr16(LAS const unsigned char* p) { return __builtin_bit_cast(s16x4v, __builtin_amdgcn_ds_read_tr16_b64_v4i16((LAS s16x4v*)p)); }
__device__ __forceinline__ unsigned cvtpk(float lo, float hi) { typedef float f2 __attribute__((ext_vector_type(2))); typedef __bf16 b2 __attribute__((ext_vector_type(2))); f2 v = {lo, hi}; b2 r = __builtin_convertvector(v, b2); return __builtin_bit_cast(unsigned, r); }


template <int L> __device__ __forceinline__ void wr2lanes(int& w, unsigned lo, unsigned hi) {
    asm volatile("s_nop 1\n\tv_writelane_b32 %0, %1, %3\n\tv_writelane_b32 %0, %2, %4" : "+v"(w) : "s"(lo), "s"(hi), "i"(L), "i"(L + 1));
}
__device__ __forceinline__ int wave_sum_dpp(int v) {
    v += __builtin_amdgcn_update_dpp(0, v, 0xB1, 0xf, 0xf, true);
    v += __builtin_amdgcn_update_dpp(0, v, 0x4E, 0xf, 0xf, true);
    v += __builtin_amdgcn_update_dpp(0, v, 0x141, 0xf, 0xf, true);
    v += __builtin_amdgcn_update_dpp(0, v, 0x140, 0xf, 0xf, true);
    return __builtin_amdgcn_readlane(v, 0) + __builtin_amdgcn_readlane(v, 16) + __builtin_amdgcn_readlane(v, 32) + __builtin_amdgcn_readlane(v, 48);
}
__device__ __forceinline__ unsigned wave_max_dpp(unsigned v) {
    v = max(v, (unsigned)__builtin_amdgcn_update_dpp(0, (int)v, 0xB1, 0xf, 0xf, true));
    v = max(v, (unsigned)__builtin_amdgcn_update_dpp(0, (int)v, 0x4E, 0xf, 0xf, true));
    v = max(v, (unsigned)__builtin_amdgcn_update_dpp(0, (int)v, 0x141, 0xf, 0xf, true));
    v = max(v, (unsigned)__builtin_amdgcn_update_dpp(0, (int)v, 0x140, 0xf, 0xf, true));
    return max(max((unsigned)__builtin_amdgcn_readlane((int)v, 0), (unsigned)__builtin_amdgcn_readlane((int)v, 16)), max((unsigned)__builtin_amdgcn_readlane((int)v, 32), (unsigned)__builtin_amdgcn_readlane((int)v, 48)));
}
__device__ __forceinline__ int cnt8(int acc, unsigned cand, unsigned k0, unsigned k1, unsigned k2, unsigned k3, unsigned k4, unsigned k5, unsigned k6, unsigned k7) {
    unsigned long long m0, m1, m2, m3, m4, m5, m6, m7;
    asm volatile("v_cmp_le_u32_e64 %1, %9, %10\n\tv_cmp_le_u32_e64 %2, %9, %11\n\tv_cmp_le_u32_e64 %3, %9, %12\n\tv_cmp_le_u32_e64 %4, %9, %13\n\t"
                 "v_cmp_le_u32_e64 %5, %9, %14\n\tv_cmp_le_u32_e64 %6, %9, %15\n\tv_cmp_le_u32_e64 %7, %9, %16\n\tv_cmp_le_u32_e64 %8, %9, %17\n\t"
                 "v_addc_co_u32_e64 %0, %1, 0, %0, %1\n\tv_addc_co_u32_e64 %0, %2, 0, %0, %2\n\tv_addc_co_u32_e64 %0, %3, 0, %0, %3\n\tv_addc_co_u32_e64 %0, %4, 0, %0, %4\n\t"
                 "v_addc_co_u32_e64 %0, %5, 0, %0, %5\n\tv_addc_co_u32_e64 %0, %6, 0, %0, %6\n\tv_addc_co_u32_e64 %0, %7, 0, %0, %7\n\tv_addc_co_u32_e64 %0, %8, 0, %0, %8"
                 : "+v"(acc), "=&s"(m0), "=&s"(m1), "=&s"(m2), "=&s"(m3), "=&s"(m4), "=&s"(m5), "=&s"(m6), "=&s"(m7)
                 : "s"(cand), "v"(k0), "v"(k1), "v"(k2), "v"(k3), "v"(k4), "v"(k5), "v"(k6), "v"(k7));
    return acc;
}
__device__ __forceinline__ int count_ge(const unsigned (&k)[32], unsigned cand_, int nb) {
    const unsigned cand = (unsigned)__builtin_amdgcn_readfirstlane((int)cand_);
    int c = 0;
    c = cnt8(c, cand, k[0], k[1], k[2], k[3], k[4], k[5], k[6], k[7]);
    if (nb > 1) c = cnt8(c, cand, k[8], k[9], k[10], k[11], k[12], k[13], k[14], k[15]);
    if (nb > 2) c = cnt8(c, cand, k[16], k[17], k[18], k[19], k[20], k[21], k[22], k[23]);
    if (nb > 3) c = cnt8(c, cand, k[24], k[25], k[26], k[27], k[28], k[29], k[30], k[31]);
    return wave_sum_dpp(c);
}
__device__ __forceinline__ int wave_scan_dpp(int v) {
    v += __builtin_amdgcn_update_dpp(0, v, 0x111, 0xf, 0xf, false);
    v += __builtin_amdgcn_update_dpp(0, v, 0x112, 0xf, 0xf, false);
    v += __builtin_amdgcn_update_dpp(0, v, 0x114, 0xf, 0xf, false);
    v += __builtin_amdgcn_update_dpp(0, v, 0x118, 0xf, 0xf, false);
    v += __builtin_amdgcn_update_dpp(0, v, 0x142, 0xa, 0xf, false);
    v += __builtin_amdgcn_update_dpp(0, v, 0x143, 0xc, 0xf, false);
    return v;
}
#ifndef HIST_WAVES
#define HIST_WAVES 4
#endif
struct TopkState { unsigned prefix; int bit; bool done; unsigned need; int nb; LAS unsigned* hist; int crej; };
__device__ __forceinline__ void topk_hist(const unsigned (&k)[32], TopkState& st, int c_above) {
    const int lane = threadIdx.x & 63;
    const unsigned T = (unsigned)__builtin_amdgcn_readfirstlane((int)st.prefix);
    LAS unsigned* hist = st.hist;
    *(LAS u32x4*)(hist + 4 * lane) = (u32x4){0u, 0u, 0u, 0u};
    asm volatile("" ::: "memory");
    const unsigned hb_ = (unsigned)(uintptr_t)hist; const unsigned one = 1u;
#define HF8(i0) { unsigned t0_; unsigned long long ex_; \
        asm volatile("s_mov_b64 %1, exec\n\t" \
            "v_subrev_u32_e32 %0, %2, %5\n\tv_lshrrev_b32_e32 %0, 15, %0\n\tv_cmpx_gt_u32_e32 vcc, 0x100, %0\n\tv_lshl_add_u32 %0, %0, 2, %3\n\tds_add_u32 %0, %4\n\ts_mov_b64 exec, %1\n\t" \
            "v_subrev_u32_e32 %0, %2, %6\n\tv_lshrrev_b32_e32 %0, 15, %0\n\tv_cmpx_gt_u32_e32 vcc, 0x100, %0\n\tv_lshl_add_u32 %0, %0, 2, %3\n\tds_add_u32 %0, %4\n\ts_mov_b64 exec, %1\n\t" \
            "v_subrev_u32_e32 %0, %2, %7\n\tv_lshrrev_b32_e32 %0, 15, %0\n\tv_cmpx_gt_u32_e32 vcc, 0x100, %0\n\tv_lshl_add_u32 %0, %0, 2, %3\n\tds_add_u32 %0, %4\n\ts_mov_b64 exec, %1\n\t" \
            "v_subrev_u32_e32 %0, %2, %8\n\tv_lshrrev_b32_e32 %0, 15, %0\n\tv_cmpx_gt_u32_e32 vcc, 0x100, %0\n\tv_lshl_add_u32 %0, %0, 2, %3\n\tds_add_u32 %0, %4\n\ts_mov_b64 exec, %1\n\t" \
            "v_subrev_u32_e32 %0, %2, %9\n\tv_lshrrev_b32_e32 %0, 15, %0\n\tv_cmpx_gt_u32_e32 vcc, 0x100, %0\n\tv_lshl_add_u32 %0, %0, 2, %3\n\tds_add_u32 %0, %4\n\ts_mov_b64 exec, %1\n\t" \
            "v_subrev_u32_e32 %0, %2, %10\n\tv_lshrrev_b32_e32 %0, 15, %0\n\tv_cmpx_gt_u32_e32 vcc, 0x100, %0\n\tv_lshl_add_u32 %0, %0, 2, %3\n\tds_add_u32 %0, %4\n\ts_mov_b64 exec, %1\n\t" \
            "v_subrev_u32_e32 %0, %2, %11\n\tv_lshrrev_b32_e32 %0, 15, %0\n\tv_cmpx_gt_u32_e32 vcc, 0x100, %0\n\tv_lshl_add_u32 %0, %0, 2, %3\n\tds_add_u32 %0, %4\n\ts_mov_b64 exec, %1\n\t" \
            "v_subrev_u32_e32 %0, %2, %12\n\tv_lshrrev_b32_e32 %0, 15, %0\n\tv_cmpx_gt_u32_e32 vcc, 0x100, %0\n\tv_lshl_add_u32 %0, %0, 2, %3\n\tds_add_u32 %0, %4\n\ts_mov_b64 exec, %1" \
            : "=&v"(t0_), "=&s"(ex_) : "s"(T), "s"(hb_), "v"(one), "v"(k[i0]), "v"(k[i0 + 1]), "v"(k[i0 + 2]), "v"(k[i0 + 3]), "v"(k[i0 + 4]), "v"(k[i0 + 5]), "v"(k[i0 + 6]), "v"(k[i0 + 7]) : "vcc", "memory"); }
    HF8(0)
    if (st.nb > 1) HF8(8)
    if (st.nb > 2) HF8(16)
    if (st.nb > 3) HF8(24)
#undef HF8
    asm volatile("" ::: "memory");
    const u32x4 w = *(LAS const u32x4*)(hist + 4 * (63 - lane));
    const int t = (int)((w.x + w.y) + (w.z + w.w));
    const int P = wave_scan_dpp(t);
    const int k1 = TOPK - c_above;
    const unsigned long long bal = __ballot(P >= k1);
    const int Ls = __builtin_ctzll(bal);
    int c = __builtin_amdgcn_readlane(P, Ls) - __builtin_amdgcn_readlane(t, Ls);
    const int h3 = __builtin_amdgcn_readlane((int)w.w, Ls), h2 = __builtin_amdgcn_readlane((int)w.z, Ls), h1 = __builtin_amdgcn_readlane((int)w.y, Ls), h0 = __builtin_amdgcn_readlane((int)w.x, Ls);
    int bsel = 3, hb = h3;
    if (c + h3 < k1) { c += h3; bsel = 2; hb = h2; if (c + h2 < k1) { c += h2; bsel = 1; hb = h1; if (c + h1 < k1) { c += h1; bsel = 0; hb = h0; } } }
    const unsigned bin = (unsigned)(4 * (63 - Ls) + bsel);
    st.prefix = T | (bin << 15); st.bit = 14;
    if (c + hb == k1) { st.done = true; st.need = 0xffffffffu; }
}
__device__ __forceinline__ void topk_init(const unsigned (&k)[32], TopkState& st) {
    unsigned mx = 0u;
#pragma unroll
    for (int i = 0; i < 32; ++i) mx = max(mx, k[i]);
    mx = wave_max_dpp(mx);
    st.prefix = 0u; st.bit = 31; st.done = false; st.need = 0u; st.crej = 0;
    unsigned E = mx >> 23;
    int cprev = 0;
#pragma unroll 1
    for (int j = 0; j < 4; ++j) {
        if (E < (unsigned)j + 1u) break;
        const unsigned T = (E - (unsigned)j) << 23;
        const int c = count_ge(k, T, st.nb);
        if (c >= TOPK) { st.prefix = T; st.bit = 22; if (c == TOPK) { st.done = true; st.need = 0xffffffffu; }
#ifndef NO_TOPK_HIST
#ifdef PROBE_HIST2
            else if (st.hist) { TopkState sv = st; topk_hist(k, st, cprev); asm volatile("" :: "s"(st.prefix) : "memory"); st = sv; topk_hist(k, st, cprev); }
#else
            else if (st.hist) topk_hist(k, st, cprev);
#endif
#endif
            break; }
        cprev = c;
    }
}
__device__ __forceinline__ void topk_step(const unsigned (&k)[32], TopkState& st) {
    if (st.done) return;
    if (st.bit < 0) { int c = 0;
#pragma unroll
        for (int i = 0; i < 32; ++i) c += (k[i] > st.prefix) ? 1 : 0;
        c = wave_sum_dpp(c); st.need = (unsigned)(TOPK - c); st.done = true; return; }
    const unsigned cand = st.prefix | (1u << st.bit);
    const int c = count_ge(k, cand, st.nb);
    if (c >= TOPK) st.prefix = cand; else st.crej = c;
    if (c == TOPK) { st.done = true; st.need = 0xffffffffu; }
    --st.bit;
#ifndef NO_TOPK_HIST
    if (st.bit == 22 && !st.done && st.hist) topk_hist(k, st, st.crej);
#endif
}

__device__ __forceinline__ void dsa_prefetch_qi(const bf16* zb, int qt, LAS unsigned char* lds, int wave, int lane) {
    const unsigned lds_base = (unsigned)(uintptr_t)lds;
#pragma unroll
    for (int i = 0; i < 2; ++i) { const int row = 2 * wave + i;
        glds16(zb + (size_t)(qt * 16 + row) * ZP + C_QI + ((lane ^ row) * 8), (unsigned)__builtin_amdgcn_readfirstlane(lds_base + DSA_QIB_OFF + row * 1024)); }
    if (wave == 0) glds16(zb + (size_t)(qt * 16 + (lane & 15)) * ZP + C_WI, (unsigned)__builtin_amdgcn_readfirstlane(lds_base + DSA_WIB_OFF));
}

__device__ __forceinline__ void dsa_prefetch_ki(const bf16* zb, int qt, bf16x8v (&pk)[4], int wave, int lane) {
    const int r16 = lane & 15, g = lane >> 4;
    if (wave <= qt) { const bf16* krow = zb + (size_t)(wave * 16 + r16) * ZP + C_KI; pk[0] = *(const bf16x8v*)(krow + 8 * g); pk[1] = *(const bf16x8v*)(krow + 32 + 8 * g); }
    if (wave + 8 <= qt) { const bf16* krow = zb + (size_t)((wave + 8) * 16 + r16) * ZP + C_KI; pk[2] = *(const bf16x8v*)(krow + 8 * g); pk[3] = *(const bf16x8v*)(krow + 32 + 8 * g); }
}

__device__ __forceinline__ void dsa_unit(const P& p, int b, int qt, int qt_next, bf16x8v (&pk)[4], LAS unsigned char* lds) {
    const int tid = threadIdx.x, lane = tid & 63, wave = __builtin_amdgcn_readfirstlane(tid >> 6), r16 = lane & 15, g = lane >> 4;
    const int q0 = qt * 16; const bf16* zb = p.Z + (size_t)b * SEQ * ZP;
    LAS float* SC = (LAS float*)lds; LAS unsigned* BM = (LAS unsigned*)(lds + DSA_BM_OFF);
    const bool dense_all = (qt < TOPK / 16);
    const bf16* qrow = zb + (size_t)(q0 + r16) * ZP;
    const bf16x8v bq0 = *(const bf16x8v*)(qrow + C_Q + wave * 64 + 8 * g), bq1 = *(const bf16x8v*)(qrow + C_Q + wave * 64 + 32 + 8 * g);
    u32x2 gwv[4];
#pragma unroll
    for (int dt = 0; dt < 4; ++dt) gwv[dt] = *(const u32x2*)(qrow + C_GA + wave * 64 + dt * 16 + 4 * g);
    const int nsteps = (((q0 + 16 + 31) >> 5) + 1) & ~1, nmega = (nsteps + 7) >> 3;
    const int kkey = lane >> 3, vkey = lane >> 1, vhalf = lane & 1;
    const unsigned lds_base = (unsigned)(uintptr_t)lds;
#define DSA_STAGE(mm) do { const int st_ = (mm) * 8 + wave; if (st_ < nsteps) { \
        const bf16* kb_ = zb + (size_t)st_ * 32 * ZP; const unsigned ldsb_ = lds_base + (unsigned)(((mm) & 1) * 65536 + wave * 4096); \
        _Pragma("unroll") for (int c_ = 0; c_ < 4; ++c_) { const int key_ = 8 * c_ + kkey, ch_ = (lane & 7) ^ ((key_ & 15) >> 1); \
            glds16(kb_ + (size_t)key_ * ZP + C_K + ch_ * 8, (unsigned)__builtin_amdgcn_readfirstlane(ldsb_ + c_ * 1024)); } \
        _Pragma("unroll") for (int c_ = 0; c_ < 4; ++c_) \
            glds16(kb_ + (size_t)vkey * ZP + C_V + c_ * 16 + vhalf * 8, (unsigned)__builtin_amdgcn_readfirstlane(ldsb_ + 32768 + c_ * 1024)); } } while (0)
    if (!dense_all) {
        for (int rpI = 0; rpI < RP_I; ++rpI) {
        bf16x8v bq[8][2]; float wv[8];
#pragma unroll
        for (int h = 0; h < 8; ++h) { bq[h][0] = *(LAS const bf16x8v*)(lds + DSA_QIB_OFF + r16 * 1024 + (((8 * h + g) ^ r16) * 16)); bq[h][1] = *(LAS const bf16x8v*)(lds + DSA_QIB_OFF + r16 * 1024 + (((8 * h + 4 + g) ^ r16) * 16));
            wv[h] = bf2f(*(LAS const bf16*)(lds + DSA_WIB_OFF + r16 * 16 + h * 2)) * 0.35355339059327373f * 0.125f; }
        bf16x8v ra0 = pk[0], ra1 = pk[1], rb0 = pk[2], rb1 = pk[3], rc0 = pk[0], rc1 = pk[1];
#define IDX_LOAD(d0, d1, ktl) do { const int ktl_ = (ktl) <= qt ? (ktl) : qt;        \
            const bf16* krow_ = zb + (size_t)(ktl_ * 16 + r16) * ZP + C_KI; d0 = *(const bf16x8v*)(krow_ + 8 * g); d1 = *(const bf16x8v*)(krow_ + 32 + 8 * g); } while (0)
#define IDX_STEP(c0, c1) do { \
            f32x4 sc = {0.f, 0.f, 0.f, 0.f}; \
            _Pragma("unroll") for (int h = 0; h < 8; ++h) { \
                f32x4 acc = {0.f, 0.f, 0.f, 0.f}; \
                acc = __builtin_amdgcn_mfma_f32_16x16x32_bf16(c0, bq[h][0], acc, 0, 0, 0); \
                acc = __builtin_amdgcn_mfma_f32_16x16x32_bf16(c1, bq[h][1], acc, 0, 0, 0); \
                _Pragma("unroll") for (int i = 0; i < 4; ++i) sc[i] += relu_i(acc[i]) * wv[h]; \
            } \
            if (__builtin_amdgcn_readfirstlane(kt) == qt) {                  \
                _Pragma("unroll") for (int i = 0; i < 4; ++i) sc[i] = (4 * g + i > r16) ? -INFINITY : sc[i]; \
            } \
            *(LAS f32x4*)(SC + r16 * SCP + kt * 16 + 4 * g) = sc; } while (0)
        int kt = wave;
        const int nst = (qt - wave + 8) >> 3;
        const int ntrip = (nst * 11) >> 5, rem = nst - 3 * ntrip;
#pragma unroll 1
        for (int it = ntrip; it > 0; --it) {
            IDX_LOAD(rc0, rc1, kt + 16); __builtin_amdgcn_sched_barrier(0); IDX_STEP(ra0, ra1); __builtin_amdgcn_sched_barrier(0); kt += 8;
            IDX_LOAD(ra0, ra1, kt + 16); __builtin_amdgcn_sched_barrier(0); IDX_STEP(rb0, rb1); __builtin_amdgcn_sched_barrier(0); kt += 8;
            IDX_LOAD(rb0, rb1, kt + 16); __builtin_amdgcn_sched_barrier(0); IDX_STEP(rc0, rc1); __builtin_amdgcn_sched_barrier(0); kt += 8;
        }
        if (rem >= 1) { IDX_STEP(ra0, ra1); kt += 8; if (rem >= 2) { IDX_STEP(rb0, rb1); } }
#undef IDX_LOAD
#undef IDX_STEP
        __syncthreads();
        }
#pragma unroll 1
        for (int rpT = 0; rpT < RP_T; ++rpT) {
            const int ra = 2 * wave, rb = 2 * wave + 1, ta = q0 + ra, tb = q0 + rb;
            unsigned ka[32], kb[32];
#pragma unroll
            for (int i = 0; i < 32; ++i) { const int key = lane + 64 * i; ka[i] = (key <= ta) ? score_ukey(SC[ra * SCP + key]) : 0u; kb[i] = (key <= tb) ? score_ukey(SC[rb * SCP + key]) : 0u; }
#if RP_T1 > 1
            asm volatile("" :: "v"(ka[0]), "v"(kb[31]) : "memory");
#pragma unroll
            for (int i = 0; i < 32; ++i) { const int key = lane + 64 * i; ka[i] = (key <= ta) ? score_ukey(SC[ra * SCP + key]) : 0u; kb[i] = (key <= tb) ? score_ukey(SC[rb * SCP + key]) : 0u; }
            asm volatile("" ::: "memory");
#endif
            asm volatile("s_waitcnt lgkmcnt(0)" ::: "memory");
            __syncthreads();
            DSA_STAGE(0);
            TopkState sa, sb; sa.nb = (ta >> 9) + 1; sb.nb = (tb >> 9) + 1;
            sa.hist = (wave < HIST_WAVES) ? (LAS unsigned*)(lds + 65536 + ra * 1280) : (LAS unsigned*)nullptr; sb.hist = (wave < HIST_WAVES) ? (LAS unsigned*)(lds + 65536 + rb * 1280) : (LAS unsigned*)nullptr;
            topk_init(ka, sa); topk_init(kb, sb);
#pragma unroll 1
            while (!(sa.done && sb.done)) { topk_step(ka, sa); topk_step(kb, sb); }
#if RP_T2 > 1
            asm volatile("" :: "v"(sa.prefix), "v"(sb.prefix));
            topk_init(ka, sa); topk_init(kb, sb);
#pragma unroll 1
            while (!(sa.done && sb.done)) { topk_step(ka, sa); topk_step(kb, sb); }
#endif
            if (sa.need == 0xffffffffu && sb.need == 0xffffffffu) {
                const unsigned ta_ = (unsigned)__builtin_amdgcn_readfirstlane((int)sa.prefix), tb_ = (unsigned)__builtin_amdgcn_readfirstlane((int)sb.prefix);
                int wa = 0, wb = 0;
#define WR2(i) { const unsigned long long ma = __ballot(ka[i] >= ta_), mb = __ballot(kb[i] >= tb_); wr2lanes<2 * (i)>(wa, (unsigned)ma, (unsigned)(ma >> 32)); wr2lanes<2 * (i)>(wb, (unsigned)mb, (unsigned)(mb >> 32)); }
                WR2(0) WR2(1) WR2(2) WR2(3) WR2(4) WR2(5) WR2(6) WR2(7) WR2(8) WR2(9) WR2(10) WR2(11) WR2(12) WR2(13) WR2(14) WR2(15)
                WR2(16) WR2(17) WR2(18) WR2(19) WR2(20) WR2(21) WR2(22) WR2(23) WR2(24) WR2(25) WR2(26) WR2(27) WR2(28) WR2(29) WR2(30) WR2(31)
#undef WR2
                BM[ra * BMS + lane] = (unsigned)wa; BM[rb * BMS + lane] = (unsigned)wb;
#if RP_T3 > 1
                asm volatile("" : "+v"(wa), "+v"(wb) :: "memory");
#define WR2(i) { const unsigned long long ma = __ballot(ka[i] >= ta_), mb = __ballot(kb[i] >= tb_); wr2lanes<2 * (i)>(wa, (unsigned)ma, (unsigned)(ma >> 32)); wr2lanes<2 * (i)>(wb, (unsigned)mb, (unsigned)(mb >> 32)); }
                WR2(0) WR2(1) WR2(2) WR2(3) WR2(4) WR2(5) WR2(6) WR2(7) WR2(8) WR2(9) WR2(10) WR2(11) WR2(12) WR2(13) WR2(14) WR2(15)
                WR2(16) WR2(17) WR2(18) WR2(19) WR2(20) WR2(21) WR2(22) WR2(23) WR2(24) WR2(25) WR2(26) WR2(27) WR2(28) WR2(29) WR2(30) WR2(31)
#undef WR2
                BM[ra * BMS + lane] = (unsigned)wa; BM[rb * BMS + lane] = (unsigned)wb;
#endif
            } else {
            unsigned eqa = 0u, eqb = 0u;
#pragma unroll 1
            for (int i = 0; i < 32; ++i) {
                unsigned kai = ka[0], kbi = kb[0];
#pragma unroll
                for (int j = 1; j < 32; ++j) { kai = (i == j) ? ka[j] : kai; kbi = (i == j) ? kb[j] : kbi; }
                { const bool eq = (kai == sa.prefix); const unsigned long long em = __ballot(eq);
                  const unsigned erank = eqa + __builtin_amdgcn_mbcnt_hi((unsigned)(em >> 32), __builtin_amdgcn_mbcnt_lo((unsigned)em, 0u));
                  const unsigned long long smk = __ballot((kai > sa.prefix) || (eq && erank < sa.need));
                  if (lane == 0) { BM[ra * BMS + 2 * i] = (unsigned)smk; BM[ra * BMS + 2 * i + 1] = (unsigned)(smk >> 32); }
                  eqa += (unsigned)__popcll(em); }
                { const bool eq = (kbi == sb.prefix); const unsigned long long em = __ballot(eq);
                  const unsigned erank = eqb + __builtin_amdgcn_mbcnt_hi((unsigned)(em >> 32), __builtin_amdgcn_mbcnt_lo((unsigned)em, 0u));
                  const unsigned long long smk = __ballot((kbi > sb.prefix) || (eq && erank < sb.need));
                  if (lane == 0) { BM[rb * BMS + 2 * i] = (unsigned)smk; BM[rb * BMS + 2 * i + 1] = (unsigned)(smk >> 32); }
                  eqb += (unsigned)__popcll(em); }
            }
            }
        }
    } else {
        for (int i = tid; i < 1024; i += 512) { const int row = i >> 6, w = i & 63, t = q0 + row, lo = 32 * w;
            BM[row * BMS + w] = (t >= lo + 31) ? 0xffffffffu : ((t < lo) ? 0u : ((2u << (t - lo)) - 1u)); }
        DSA_STAGE(0);
    }
    __syncthreads();
    const int h = wave;
#pragma unroll 1
    for (int rpV = 0; rpV < RP_V; ++rpV) {
    asm volatile("s_waitcnt vmcnt(0)" ::: "memory");
    asm volatile("" :: "v"(bq0), "v"(bq1), "v"(gwv[0]), "v"(gwv[1]), "v"(gwv[2]), "v"(gwv[3]));
    __syncthreads();
    if (qt_next >= TOPK / 16) { dsa_prefetch_qi(zb, qt_next, lds, wave, lane); dsa_prefetch_ki(zb, qt_next, pk, wave, lane); }
    f32x4 o[4], lacc = {0.f, 0.f, 0.f, 0.f}, negm = {0.f, 0.f, 0.f, 0.f};
#pragma unroll
    for (int dt = 0; dt < 4; ++dt) o[dt] = (f32x4){0.f, 0.f, 0.f, 0.f};
    float m_run = 0.f;
    const int kofs0 = r16 * 128 + ((g ^ (r16 >> 1)) & 7) * 16, kofs1 = r16 * 128 + (((4 + g) ^ (r16 >> 1)) & 7) * 16;
    const int vofs = 32768 + (4 * g + ((lane & 15) >> 2)) * 32 + (lane & 3) * 8;
    bf16x8v ones = {0x3f80, 0x3f80, 0x3f80, 0x3f80, 0x3f80, 0x3f80, 0x3f80, 0x3f80};
    asm volatile("" : "+v"(ones));
    LAS const unsigned char* mlut = lds + DSA_MLUT_OFF;
    constexpr float THR = 8.0f;
    bool first = true;
#pragma unroll 1
    for (int mm = 0; mm < nmega; ++mm) {
        if (mm + 1 < nmega) DSA_STAGE(mm + 1);
        LAS unsigned char* slotb = lds + (mm & 1) * 65536;
        const int nsub = (nsteps - mm * 8) < 8 ? (nsteps - mm * 8) : 8;
#pragma unroll 1
        for (int u = 0; u < nsub; u += 2) {
            LAS unsigned char* slot = slotb + u * 4096;
            const int mwA = (int)(BM[r16 * BMS + mm * 8 + u] >> (4 * g)), mwB = (int)(BM[r16 * BMS + mm * 8 + u + 1] >> (4 * g));
            f32x4 s0, s1, s2, s3;
            { const bf16x8v ka0 = *(LAS const bf16x8v*)(slot + kofs0), ka1 = *(LAS const bf16x8v*)(slot + kofs1);
              const bf16x8v kb0 = *(LAS const bf16x8v*)(slot + 2048 + kofs0), kb1 = *(LAS const bf16x8v*)(slot + 2048 + kofs1);
              const bf16x8v kc0 = *(LAS const bf16x8v*)(slot + 4096 + kofs0), kc1 = *(LAS const bf16x8v*)(slot + 4096 + kofs1);
              const bf16x8v kd0 = *(LAS const bf16x8v*)(slot + 6144 + kofs0), kd1 = *(LAS const bf16x8v*)(slot + 6144 + kofs1);
              s0 = __builtin_amdgcn_mfma_f32_16x16x32_bf16(ka0, bq0, negm, 0, 0, 0); s1 = __builtin_amdgcn_mfma_f32_16x16x32_bf16(kb0, bq0, negm, 0, 0, 0);
              s2 = __builtin_amdgcn_mfma_f32_16x16x32_bf16(kc0, bq0, negm, 0, 0, 0); s3 = __builtin_amdgcn_mfma_f32_16x16x32_bf16(kd0, bq0, negm, 0, 0, 0);
              s0 = __builtin_amdgcn_mfma_f32_16x16x32_bf16(ka1, bq1, s0, 0, 0, 0); s1 = __builtin_amdgcn_mfma_f32_16x16x32_bf16(kb1, bq1, s1, 0, 0, 0);
              s2 = __builtin_amdgcn_mfma_f32_16x16x32_bf16(kc1, bq1, s2, 0, 0, 0); s3 = __builtin_amdgcn_mfma_f32_16x16x32_bf16(kd1, bq1, s3, 0, 0, 0); }
            const int lmi = max(max(max(imax3(s0[0], s0[1], s0[2]), imax3(s0[3], s1[0], s1[1])), max(imax3(s1[2], s1[3], s2[0]), imax3(s2[1], s2[2], s2[3]))), max(imax3(s3[0], s3[1], s3[2]), __float_as_int(s3[3])));
            if (first || __any(lmi > 0x41000000)) {
                float lmx = fmaxf(fmaxf(fmaxf(fmaxf(s0[0], s0[1]), fmaxf(s0[2], s0[3])), fmaxf(fmaxf(s1[0], s1[1]), fmaxf(s1[2], s1[3]))), fmaxf(fmaxf(fmaxf(s2[0], s2[1]), fmaxf(s2[2], s2[3])), fmaxf(fmaxf(s3[0], s3[1]), fmaxf(s3[2], s3[3]))));
                { const auto r1 = __builtin_amdgcn_permlane16_swap(__float_as_uint(lmx), __float_as_uint(lmx), false, false); lmx = fmaxf(__uint_as_float(r1[0]), __uint_as_float(r1[1])); }
                { const auto r2 = __builtin_amdgcn_permlane32_swap(__float_as_uint(lmx), __float_as_uint(lmx), false, false); lmx = fmaxf(__uint_as_float(r2[0]), __uint_as_float(r2[1])); }
                const float dl = first ? lmx : fmaxf(lmx, 0.f);
                m_run += dl; const float f = first ? 1.0f : __builtin_amdgcn_exp2f(-dl);
#pragma unroll
                for (int i = 0; i < 4; ++i) { s0[i] -= dl; s1[i] -= dl; s2[i] -= dl; s3[i] -= dl; negm[i] = -m_run; }
                lacc = lacc * f;
#pragma unroll
                for (int dt = 0; dt < 4; ++dt) o[dt] = o[dt] * f;
                first = false;
            }
            const u32x2 mk0 = *(LAS const u32x2*)(mlut + ((mwA & 15) << 3)), mk1 = *(LAS const u32x2*)(mlut + (((mwA >> 16) & 15) << 3));
            const u32x2 mk2 = *(LAS const u32x2*)(mlut + ((mwB & 15) << 3)), mk3 = *(LAS const u32x2*)(mlut + (((mwB >> 16) & 15) << 3));
            u32x4 pwA, pwB;
            pwA.x = cvtpk(__builtin_amdgcn_exp2f(s0[0]), __builtin_amdgcn_exp2f(s0[1])) & mk0.x; pwA.y = cvtpk(__builtin_amdgcn_exp2f(s0[2]), __builtin_amdgcn_exp2f(s0[3])) & mk0.y;
            pwA.z = cvtpk(__builtin_amdgcn_exp2f(s1[0]), __builtin_amdgcn_exp2f(s1[1])) & mk1.x; pwA.w = cvtpk(__builtin_amdgcn_exp2f(s1[2]), __builtin_amdgcn_exp2f(s1[3])) & mk1.y;
            pwB.x = cvtpk(__builtin_amdgcn_exp2f(s2[0]), __builtin_amdgcn_exp2f(s2[1])) & mk2.x; pwB.y = cvtpk(__builtin_amdgcn_exp2f(s2[2]), __builtin_amdgcn_exp2f(s2[3])) & mk2.y;
            pwB.z = cvtpk(__builtin_amdgcn_exp2f(s3[0]), __builtin_amdgcn_exp2f(s3[1])) & mk3.x; pwB.w = cvtpk(__builtin_amdgcn_exp2f(s3[2]), __builtin_amdgcn_exp2f(s3[3])) & mk3.y;
            const bf16x8v pfA = __builtin_bit_cast(bf16x8v, pwA), pfB = __builtin_bit_cast(bf16x8v, pwB);
            lacc = __builtin_amdgcn_mfma_f32_16x16x32_bf16(ones, pfA, lacc, 0, 0, 0);
            lacc = __builtin_amdgcn_mfma_f32_16x16x32_bf16(ones, pfB, lacc, 0, 0, 0);
#pragma unroll
            for (int dt = 0; dt < 4; ++dt) {
                const s16x4v lo = lds_tr16(slot + vofs + dt * 1024), hi = lds_tr16(slot + vofs + dt * 1024 + 512);
                const s16x4v lo2 = lds_tr16(slot + 4096 + vofs + dt * 1024), hi2 = lds_tr16(slot + 4096 + vofs + dt * 1024 + 512);
                const bf16x8v vf = {lo[0], lo[1], lo[2], lo[3], hi[0], hi[1], hi[2], hi[3]};
                const bf16x8v vf2 = {lo2[0], lo2[1], lo2[2], lo2[3], hi2[0], hi2[1], hi2[2], hi2[3]};
                o[dt] = __builtin_amdgcn_mfma_f32_16x16x32_bf16(vf, pfA, o[dt], 0, 0, 0);
                o[dt] = __builtin_amdgcn_mfma_f32_16x16x32_bf16(vf2, pfB, o[dt], 0, 0, 0);
            }
        }
        asm volatile("s_waitcnt vmcnt(0) lgkmcnt(0)" ::: "memory");
        __syncthreads();
    }
#undef DSA_STAGE
    const float inv = 1.0f / lacc[0];
    bf16* yrow = p.Y + ((size_t)b * SEQ + q0 + r16) * DM + 512 + h * 64;
#pragma unroll
    for (int dt = 0; dt < 4; ++dt) {
        const u32x2 gw = gwv[dt];
        const float g0 = __uint_as_float(gw.x << 16), g1 = __uint_as_float(gw.x & 0xffff0000u), g2 = __uint_as_float(gw.y << 16), g3 = __uint_as_float(gw.y & 0xffff0000u);
        u32x2 w; w.x = pk2(o[dt][0] * inv * siluf(g0), o[dt][1] * inv * siluf(g1)); w.y = pk2(o[dt][2] * inv * siluf(g2), o[dt][3] * inv * siluf(g3));
        *(u32x2*)(yrow + dt * 16 + 4 * g) = w;
    }
    __syncthreads();
    }
}
__device__ __forceinline__ int dsa_qt_of(int j, int i) { return (i == 0) ? 127 - j : (i == 1) ? 64 + j : (i == 2) ? 63 - j : j; }
__device__ __forceinline__ void dsa_phase_pre(const P& p, LAS unsigned char* lds, bf16x8v (&pk)[4]) {
    const int G = gridDim.x, wg = blockIdx.x, lane = threadIdx.x & 63, wave = __builtin_amdgcn_readfirstlane(threadIdx.x >> 6);
    const int b = (G == 256) ? (wg & 7) : (wg >> 7), qt = (G == 256) ? dsa_qt_of(wg >> 3, 0) : 127 - (wg & 127);
#pragma unroll
    for (int i = 0; i < 4; ++i) pk[i] = (bf16x8v){0, 0, 0, 0, 0, 0, 0, 0};
    if (wg < 1024 && qt >= TOPK / 16) { dsa_prefetch_qi(p.Z + (size_t)b * SEQ * ZP, qt, lds, wave, lane); dsa_prefetch_ki(p.Z + (size_t)b * SEQ * ZP, qt, pk, wave, lane); }
}
__device__ __forceinline__ void dsa_phase(const P& p, LAS unsigned char* lds, bf16x8v (&pk)[4]) {
    const int G = gridDim.x, wg = blockIdx.x;
    if (G == 256) {
        const int b = wg & 7, j = wg >> 3;
#pragma unroll 1
        for (int i = 0; i < 4; ++i) dsa_unit(p, b, dsa_qt_of(j, i), (i < 3) ? dsa_qt_of(j, i + 1) : -1, pk, lds);
    }
}
constexpr int LRU_WS_OFF = 139264;
constexpr int LRU_XB = 264 * 128;
constexpr int LRU_GB = 256 * 32;
constexpr int LRU_BUF = LRU_XB + LRU_GB;
__device__ __forceinline__ float fast_sigm(float x) { return __builtin_amdgcn_rcpf(1.0f + __expf(-x)); }
__device__ __forceinline__ void lru_unit(const P& p, int l, int b, int blk, int q4, LAS unsigned char* lds) {
    const int tid = threadIdx.x, lane = tid & 63, wave = __builtin_amdgcn_readfirstlane(tid >> 6), r16 = lane & 15, g = lane >> 4;
    const bf16* zb = p.Z + (size_t)b * SEQ * ZP;
    const int cA = blk * 64, dloc = q4 * 16 + r16, dg = blk * 64 + dloc;
    const unsigned lds_base = (unsigned)(uintptr_t)lds;
#define LRU_STAGE(r) do { const unsigned bb_ = lds_base + (unsigned)(((r) & 1) * LRU_BUF); \
        _Pragma("unroll") for (int i_ = 0; i_ < 5; ++i_) { const int pc_ = wave + 8 * i_; if (pc_ < 33) { const int rho_ = pc_ * 8 + (lane >> 3); int t_ = (r) * 256 - 3 + rho_; t_ = t_ < 0 ? 0 : (t_ > SEQ - 1 ? SEQ - 1 : t_); \
            const int ch_ = (lane & 7) ^ ((rho_ >> 1) & 7); glds16(zb + (size_t)t_ * ZP + C_XR + cA + ch_ * 8, (unsigned)__builtin_amdgcn_readfirstlane(bb_ + pc_ * 1024)); } } \
        { const int row_ = wave * 32 + (lane >> 1); glds16(zb + (size_t)((r) * 256 + row_) * ZP + C_GR + dg - r16 + (lane & 1) * 8, (unsigned)__builtin_amdgcn_readfirstlane(bb_ + LRU_XB + wave * 1024)); } } while (0)
    LRU_STAGE(0);
    float cwA[2][4][8], cbA[2][8];
#pragma unroll
    for (int s = 0; s < 2; ++s)
#pragma unroll
        for (int j = 0; j < 8; ++j) { const int c = cA + 32 * s + 8 * g + j; cbA[s][j] = p.conv_b[l * 512 + c];
#pragma unroll
            for (int k = 0; k < 4; ++k) cwA[s][k][j] = p.conv_w[(l * 4 + k) * 512 + c]; }
    bf16x8v bxf[2], baf[2];
#pragma unroll
    for (int s = 0; s < 2; ++s) { u32x4 wx, wa; unsigned tx[8], ta[8];
#pragma unroll
        for (int j = 0; j < 8; ++j) { const size_t idx = (((size_t)l * 8 + blk) * 64 + 32 * s + 8 * g + j) * 64 + dloc; tx[j] = f2bf(p.lru_wx[idx]); ta[j] = f2bf(p.lru_wa[idx]); }
        wx.x = tx[0] | (tx[1] << 16); wx.y = tx[2] | (tx[3] << 16); wx.z = tx[4] | (tx[5] << 16); wx.w = tx[6] | (tx[7] << 16);
        wa.x = ta[0] | (ta[1] << 16); wa.y = ta[2] | (ta[3] << 16); wa.z = ta[4] | (ta[5] << 16); wa.w = ta[6] | (ta[7] << 16);
        bxf[s] = __builtin_bit_cast(bf16x8v, wx); baf[s] = __builtin_bit_cast(bf16x8v, wa); }
    const float cw0 = p.conv_w[(l * 4 + 0) * 512 + dg], cw1 = p.conv_w[(l * 4 + 1) * 512 + dg], cw2 = p.conv_w[(l * 4 + 2) * 512 + dg], cw3 = p.conv_w[(l * 4 + 3) * 512 + dg];
    const float cb = p.conv_b[l * 512 + dg], bxv = p.lru_bx[l * 512 + dg], bav = p.lru_ba[l * 512 + dg];
    const float sp8 = -8.0f * log1pf(expf(-p.lru_a[l * 512 + dg]));
    asm volatile("" :: "v"(cwA[0][0][0]), "v"(cwA[1][3][7]), "v"(cbA[1][7]), "v"(bxf[0]), "v"(bxf[1]), "v"(baf[0]), "v"(baf[1]), "v"(cw0), "v"(cw1), "v"(cw2), "v"(cw3), "v"(cb), "v"(bxv), "v"(bav), "v"(sp8));
    LAS float* WS = (LAS float*)(lds + LRU_WS_OFF);
    float hrun = 0.f;
    asm volatile("s_waitcnt vmcnt(0)" ::: "memory");
#pragma unroll 1
    for (int round = 0; round < 8; ++round) {
        asm volatile("s_waitcnt vmcnt(8)" ::: "memory");
        __syncthreads();
        if (round + 1 < 8) LRU_STAGE(round + 1);
        LAS const unsigned char* xb = lds + (round & 1) * LRU_BUF; LAS const unsigned char* gb = xb + LRU_XB;
        const int tw = round * 256 + wave * 32;
        float hl[2][4], pl[2][4], gr4[2][4], PT[2], HT[2], PE[2], HE[2];
#pragma unroll
        for (int tau = 0; tau < 2; ++tau) {
            const int t0 = tw + 16 * tau, rho0 = wave * 32 + 16 * tau;
            bf16x8v af[2];
#pragma unroll
            for (int s = 0; s < 2; ++s) {
                float xc[8];
#pragma unroll
                for (int j = 0; j < 8; ++j) xc[j] = cbA[s][j];
#pragma unroll
                for (int k = 0; k < 4; ++k) { const int rho = rho0 + r16 + k; u32x4 w = *(LAS const u32x4*)(xb + rho * 128 + (((4 * s + g) ^ (rho >> 1)) & 7) * 16);
                    if (t0 + r16 - 3 + k < 0) w = (u32x4){0u, 0u, 0u, 0u};
                    xc[0] += cwA[s][k][0] * __uint_as_float(w.x << 16); xc[1] += cwA[s][k][1] * __uint_as_float(w.x & 0xffff0000u);
                    xc[2] += cwA[s][k][2] * __uint_as_float(w.y << 16); xc[3] += cwA[s][k][3] * __uint_as_float(w.y & 0xffff0000u);
                    xc[4] += cwA[s][k][4] * __uint_as_float(w.z << 16); xc[5] += cwA[s][k][5] * __uint_as_float(w.z & 0xffff0000u);
                    xc[6] += cwA[s][k][6] * __uint_as_float(w.w << 16); xc[7] += cwA[s][k][7] * __uint_as_float(w.w & 0xffff0000u); }
                u32x4 pw; pw.x = cvtpk(xc[0], xc[1]); pw.y = cvtpk(xc[2], xc[3]); pw.z = cvtpk(xc[4], xc[5]); pw.w = cvtpk(xc[6], xc[7]);
                af[s] = __builtin_bit_cast(bf16x8v, pw);
            }
            f32x4 gx = {0.f, 0.f, 0.f, 0.f}, ga = {0.f, 0.f, 0.f, 0.f};
            gx = __builtin_amdgcn_mfma_f32_16x16x32_bf16(af[0], bxf[0], gx, 0, 0, 0); gx = __builtin_amdgcn_mfma_f32_16x16x32_bf16(af[1], bxf[1], gx, 0, 0, 0);
            ga = __builtin_amdgcn_mfma_f32_16x16x32_bf16(af[0], baf[0], ga, 0, 0, 0); ga = __builtin_amdgcn_mfma_f32_16x16x32_bf16(af[1], baf[1], ga, 0, 0, 0);
            float xo[7];
#pragma unroll
            for (int m = 0; m < 7; ++m) { const int rho = rho0 + 4 * g + m;
                const unsigned short v = *(LAS const unsigned short*)(xb + rho * 128 + (((dloc >> 3) ^ (rho >> 1)) & 7) * 16 + (dloc & 7) * 2);
                xo[m] = (t0 + 4 * g - 3 + m >= 0) ? bf2f(v) : 0.f; }
            float Pr = 1.f, Hr = 0.f;
#pragma unroll
            for (int i = 0; i < 4; ++i) {
                const float xcv = cb + cw0 * xo[i] + cw1 * xo[i + 1] + cw2 * xo[i + 2] + cw3 * xo[i + 3];
                const float sx = fast_sigm(gx[i] + bxv), sa = fast_sigm(ga[i] + bav);
                const float la = sp8 * sa, a = __expf(la), y2 = 2.0f * la;
                const float ser = -y2 * (1.0f + y2 * (0.5f + y2 * (0.16666667f + y2 * (0.041666668f + y2 * (0.0083333338f + y2 * 0.0013888889f)))));
                const float em = (y2 > -0.25f) ? ser : (1.0f - __expf(y2));
                const float u = __builtin_amdgcn_sqrtf(em) * sx * xcv;
                Hr = a * Hr + u; Pr *= a; hl[tau][i] = Hr; pl[tau][i] = Pr;
                gr4[tau][i] = bf2f(*(LAS const unsigned short*)(gb + (rho0 + 4 * g + i) * 32 + r16 * 2));
            }
            float Pi = Pr, Hi = Hr;
            { const float Pl = __shfl_up(Pi, 16), Hl = __shfl_up(Hi, 16); if (g >= 1) { Hi = Pi * Hl + Hi; Pi = Pl * Pi; } }
            { const float Pl = __shfl_up(Pi, 32), Hl = __shfl_up(Hi, 32); if (g >= 2) { Hi = Pi * Hl + Hi; Pi = Pl * Pi; } }
            float Pe = __shfl_up(Pi, 16), He = __shfl_up(Hi, 16); if (g == 0) { Pe = 1.f; He = 0.f; }
            PT[tau] = __shfl(Pi, 48 + r16); HT[tau] = __shfl(Hi, 48 + r16); PE[tau] = Pe; HE[tau] = He;
        }
        HE[1] = PE[1] * HT[0] + HE[1]; PE[1] = PT[0] * PE[1];
        const float Pw = PT[0] * PT[1], Hw = PT[1] * HT[0] + HT[1];
        LAS float* wsr = WS + (round & 1) * 256;
        if (g == 0) { wsr[(wave * 16 + r16) * 2 + 0] = Pw; wsr[(wave * 16 + r16) * 2 + 1] = Hw; }
        asm volatile("s_waitcnt lgkmcnt(0)" ::: "memory");
        __builtin_amdgcn_s_barrier();
        asm volatile("" ::: "memory");
        float hc = hrun, hall = hrun;
#pragma unroll
        for (int w2 = 0; w2 < 8; ++w2) { if (w2 == wave) hc = hall; hall = wsr[(w2 * 16 + r16) * 2 + 0] * hall + wsr[(w2 * 16 + r16) * 2 + 1]; }
        hrun = hall;
#pragma unroll
        for (int tau = 0; tau < 2; ++tau) {
            const float hin = PE[tau] * hc + HE[tau];
            bf16* yp = p.Y + ((size_t)b * SEQ + tw + 16 * tau + 4 * g) * DM + dg;
#pragma unroll
            for (int i = 0; i < 4; ++i) { const float h = hl[tau][i] + pl[tau][i] * hin, gr = gr4[tau][i]; yp[(size_t)i * DM] = (bf16)f2bf(h * gr * fast_sigm(gr)); }
        }
    }
#undef LRU_STAGE
    __syncthreads();
}
__device__ __forceinline__ void lru_phase(const P& p, int l, LAS unsigned char* lds) {
    const int G = gridDim.x, wg = blockIdx.x;
#pragma unroll 1
    for (int u = wg; u < 256; u += G) lru_unit(p, l, (u >> 3) & 7, u & 7, u >> 6, lds);
}
#ifndef DSA_PHASE
#define DSA_PHASE dsa_phase
#endif
#ifndef LRU_PHASE
#define LRU_PHASE lru_phase
#endif
#ifndef RP_A
#define RP_A 1
#endif
#ifndef RP_L
#define RP_L 1
#endif
#ifndef RP_D
#define RP_D 1
#endif
#ifndef RP_C
#define RP_C 1
#endif
#ifndef RP_0
#define RP_0 1
#endif
template <int OFF> __device__ __forceinline__ unsigned long long karg_u64() {
    unsigned long long v; const unsigned long long kp = (unsigned long long)__builtin_amdgcn_kernarg_segment_ptr();
    asm volatile("s_load_dwordx2 %0, %1, %2\n\ts_waitcnt lgkmcnt(0)" : "=s"(v) : "s"(kp), "i"(OFF) : "memory");
    return v;
}
struct Args { const float* in[15]; float* out; unsigned char* ws; int ph_lo, ph_hi; };
__global__ void __launch_bounds__(512, 2) mega(Args a) {
    extern __shared__ __attribute__((aligned(16))) unsigned char lds_raw[];
    LAS unsigned char* lds = (LAS unsigned char*)lds_raw;
#define KARG(T, off) ((T)(__attribute__((address_space(1))) void*)karg_u64<(off)>())
#define LOADP() P p; { unsigned char* ws_ = KARG(unsigned char*, 128); \
        p.x = KARG(const float*, 0); p.c = KARG(const float*, 8); p.norm_g = KARG(const float*, 16); p.ada_w = KARG(const float*, 24); p.ada_b = KARG(const float*, 32); p.w_in = KARG(const float*, 40); \
        p.conv_w = KARG(const float*, 48); p.conv_b = KARG(const float*, 56); p.lru_wx = KARG(const float*, 64); p.lru_bx = KARG(const float*, 72); p.lru_wa = KARG(const float*, 80); p.lru_ba = KARG(const float*, 88); \
        p.lru_a = KARG(const float*, 96); p.w_out = KARG(const float*, 104); p.final_g = KARG(const float*, 112); p.out = KARG(float*, 120); \
        p.ctl = (unsigned*)(ws_ + WS_CTL); p.mod = (float*)(ws_ + WS_MOD); p.bias = (float*)(ws_ + WS_BIAS); p.ssq = (float*)(ws_ + WS_SSQ); \
        p.wt_in = (bf16*)(ws_ + WS_WTIN); p.wt_out = (bf16*)(ws_ + WS_WTOUT); p.A = (bf16*)(ws_ + WS_A); p.Z = (bf16*)(ws_ + WS_Z); p.Y = (bf16*)(ws_ + WS_Y); p.X1 = (bf16*)(ws_ + WS_X1); }
    unsigned* const ctl0 = (unsigned*)((unsigned char*)a.ws + WS_CTL);
    const int lo = a.ph_lo, hi = a.ph_hi;
    volatile LAS unsigned* MISC = (volatile LAS unsigned*)(lds + MISC_OFF + 4096);
    if (threadIdx.x < 4) MISC[threadIdx.x] = 0u;
    if (threadIdx.x < 16) { const unsigned t = threadIdx.x; u32x2 m; m.x = ((t & 1u) ? 0xffffu : 0u) | ((t & 2u) ? 0xffff0000u : 0u); m.y = ((t & 4u) ? 0xffffu : 0u) | ((t & 8u) ? 0xffff0000u : 0u);
        *(LAS u32x2*)(lds + DSA_MLUT_OFF + t * 8) = m; }
    __syncthreads();
    XcdBarrier bar; bar.bar = ctl0 + CW_BAR; bar.x = 0; bar.st = MISC;
    if (hi - lo > 1) bar = xcd_barrier_post(ctl0 + CW_BAR, MISC);
#define IN(k) (lo <= (k) && (k) < hi)
#ifndef N_CG_SEAMS
#define N_CG_SEAMS 0
#endif
#define SEAM(k) do { if (IN(k) && IN((k) + 1)) { if ((k) < N_CG_SEAMS) cg::this_grid().sync(); else xcd_barrier(bar); } } while (0)
    if (IN(0)) { LOADP(); ph0_prologue(p, lds); if (RP_0 > 1) { __syncthreads(); ph0_prologue(p, lds); } }
    SEAM(0);
    if (IN(1)) { LOADP(); ph1_prologue(p, lds); if (RP_0 > 1) { __syncthreads(); ph1_prologue(p, lds); } }
    SEAM(1);
#define LAYER(l, base) \
    if (IN(base)) { LOADP(); \
        pg8::Gemm g{p.A, p.wt_in + (size_t)(l) * ZP * 1024, MROWS, ZP, DM}; pg8::StaticOrder S; S.init(MROWS, ZP, (int)gridDim.x, (int)blockIdx.x); \
        EpiZ E{p.Z, p.ssq, p.bias + (size_t)(l) * 8 * ZP}; \
        pg8::gemm_phase<EpiZ, pg8::StaticOrder, PG8_ALIGN, PG8_SP2>(lds, g, S, E); if (RP_A > 1) { __syncthreads(); pg8::gemm_phase<EpiZ, pg8::StaticOrder, PG8_ALIGN, PG8_SP2>(lds, g, S, E); } \
    } \
    SEAM(base); \
    if (IN((base) + 1)) { LOADP(); bf16x8v pk0[4]; dsa_phase_pre(p, lds, pk0); LRU_PHASE(p, (l), lds); __syncthreads(); DSA_PHASE(p, lds, pk0); } \
    SEAM((base) + 1); \
    if (IN((base) + 2)) { LOADP(); \
        pg8::Gemm g{p.Y, p.wt_out + (size_t)(l) * 1024 * 1024, MROWS, DM, DM}; pg8::StaticOrder S; S.init(MROWS, DM, (int)gridDim.x, (int)blockIdx.x); \
        if constexpr ((l) == DEPTH - 1) { \
            EpiXF E{p.X1, p.out, p.mod + (size_t)(l) * 8 * 3072 + 2048, p.final_g, p.ssq, p.ctl + CW_PANEL}; \
            pg8::gemm_phase<EpiXF, pg8::StaticOrder, false, PG8_SP2>(lds, g, S, E); \
        } else { \
            EpiX E{p.x, p.X1, p.A, p.mod + (size_t)(l) * 8 * 3072 + 2048, p.norm_g + (size_t)((l) + 1) * 1024, p.mod + (size_t)((l) + 1) * 8 * 3072 + 1024, p.ssq}; \
            pg8::gemm_phase<EpiX, pg8::StaticOrder, false, PG8_SP2>(lds, g, S, E); if (RP_C > 1 && (l) == 0) { __syncthreads(); pg8::gemm_phase<EpiX, pg8::StaticOrder, false, PG8_SP2>(lds, g, S, E); } \
        } \
    } \
    if ((base) + 3 < NPHASE) SEAM((base) + 2);
    LAYER(0, 2)
    LAYER(1, 5)
}
#ifndef MK_N_LAUNCHES
#define MK_N_LAUNCHES 1
#endif
extern "C" void kernel_launch(void* const* d_in, const int* in_sizes, int n_in, void* d_out, int out_size, void* d_ws, size_t ws_size, hipStream_t stream) {
    static int grid = 0;
    if (grid == 0) {
        if (n_in != 15 || out_size != MROWS * DM || ws_size < WS_END) { fprintf(stderr, "kernel_launch: unexpected problem (n_in %d out %d ws %zu)\n", n_in, out_size, ws_size); grid = -1; return; }
        int dev = 0, cus = 0, per_cu = 0;
        hipGetDevice(&dev); hipDeviceGetAttribute(&cus, hipDeviceAttributeMultiprocessorCount, dev);
        if (hipFuncSetAttribute((const void*)mega, hipFuncAttributeMaxDynamicSharedMemorySize, LDS_BYTES) != hipSuccess) { fprintf(stderr, "kernel_launch: hipFuncSetAttribute failed\n"); grid = -1; return; }
        if (hipOccupancyMaxActiveBlocksPerMultiprocessor(&per_cu, (const void*)mega, 512, LDS_BYTES) != hipSuccess || per_cu < 1) { fprintf(stderr, "kernel_launch: occupancy query failed (%d)\n", per_cu); per_cu = 1; }
        (void)hipGetLastError();
        grid = cus * per_cu;
        if (grid != 256) fprintf(stderr, "kernel_launch: grid %d (cus %d x %d) != 256: the fused out-projection epilogue needs exactly 256 workgroups\n", grid, cus, per_cu);
    }
    if (grid < 0) return;
    hipMemsetAsync((char*)d_ws + WS_CTL, 0, CTL_ZERO_BYTES, stream);
    Args a{};
    for (int i = 0; i < 15; ++i) a.in[i] = (const float*)d_in[i];
    a.out = (float*)d_out; a.ws = (unsigned char*)d_ws;
#if MK_N_LAUNCHES == 1
    a.ph_lo = 0; a.ph_hi = NPHASE;
    void* args[] = {&a};
    hipError_t e = hipLaunchCooperativeKernel((const void*)mega, dim3(grid), dim3(512), args, LDS_BYTES, stream);
    if (e != hipSuccess) fprintf(stderr, "cooperative launch failed: %s (grid %d)\n", hipGetErrorString(e), grid);
#else
    for (int ph = 0; ph < NPHASE; ++ph) { a.ph_lo = ph; a.ph_hi = ph + 1; hipLaunchKernelGGL(mega, dim3(grid), dim3(512), LDS_BYTES, stream, a); }
#endif
}
```

```cpp
#include <hip/hip_runtime.h>
#include <hip/hip_cooperative_groups.h>
#include <cstdio>
#include <cstdint>
#include <cmath>
namespace cg = cooperative_groups;
#define EPI_XD 3
#define EPI_ZD 8
#define HIST_WAVES 8
#define PRO_KC 64
#define HISTA_FALLBACK 1
#define WALK_MAX 4
namespace pg8 {
#define PG8_LAS __attribute__((address_space(3)))
typedef unsigned short bf16_t;
typedef short bf16x8 __attribute__((ext_vector_type(8)));
typedef float f32x4 __attribute__((ext_vector_type(4)));
typedef unsigned u32x4 __attribute__((ext_vector_type(4)));
constexpr int BM = 256, BK = 64, HALF = 128, HTB = HALF * BK * 2  , STAGE_BYTES = 8 * HTB, NXCD = 8, WGM = 8;

__host__ __device__ __forceinline__ int lds_byte(int r, int c) { const int st = (r >> 4) * 2 + (c >> 5), rr = r & 15, cc = c & 31, ob = rr * 64 + cc * 2; return st * 1024 + (ob ^ (((ob >> 9) & 1) << 5)); }
__host__ __device__ __forceinline__ void stage_rc(int b, int& R, int& C) { const int st = b / 1024, sb = b % 1024, swz = sb ^ (((sb >> 9) & 1) << 5); R = (st >> 1) * 16 + swz / 64; C = (st & 1) * 32 + (swz % 64) / 2; }
__host__ __device__ __forceinline__ int perm32(int rho) { const int n = rho >> 4, i = rho & 15; return 8 * (i >> 2) + 4 * n + (i & 3); }

struct Unit { int pm, pn; };
struct Gemm { const bf16_t* A; const bf16_t* Bt; int M, N, K; };

struct StaticOrder {
    int nM, nN, nwg, G, c;
    __host__ __device__ void init(int M, int N, int G_, int c_) { nM = M / BM; nN = N / BM; nwg = nM * nN; G = G_; c = c_; }
    __host__ __device__ bool next(int i, Unit& u) const {
        const long L = (long)i * G + c; if (L >= nwg) return false;
        int wgid = (int)L; { const int q = nwg / NXCD, r = nwg % NXCD, xcd = wgid % NXCD, off = wgid / NXCD; wgid = (xcd < r ? xcd * (q + 1) : r * (q + 1) + (xcd - r) * q) + off; }
        const int nig = WGM * nN, gid = wgid / nig, fm = gid * WGM, gsz = (nM - fm) < WGM ? (nM - fm) : WGM;
        u.pm = fm + ((wgid % nig) % gsz); u.pn = (wgid % nig) / gsz; return true;
    }
    __device__ __forceinline__ void a_ready(const Unit&) const {}
    __device__ __forceinline__ void done(const Unit&) const {}
};

__device__ __forceinline__ unsigned cvt_pk_bf16(float lo, float hi) { unsigned r; asm volatile("v_cvt_pk_bf16_f32 %0, %1, %2" : "=v"(r) : "v"(lo), "v"(hi)); return r; }
typedef float f32x2 __attribute__((ext_vector_type(2)));
template <class Epi, class Sched, bool ALIGN_EPI = false, bool SP2 = false>
__device__ __forceinline__ void gemm_phase(PG8_LAS unsigned char* lds, const Gemm g, const Sched& S, const Epi& E) {
    const int tid = threadIdx.x, wid = __builtin_amdgcn_readfirstlane(tid >> 6), lane = tid & 63, wr = wid >> 2, wc = wid & 3, fr = lane & 15, fq = lane >> 4;
    const int K = g.K, nt = K / BK;
    unsigned voffA[2], voffB[2];
#pragma unroll
    for (int i = 0; i < 2; ++i) { int R, C; stage_rc(tid * 16 + i * 8192, R, C); const int Rb = Epi::PERM ? ((R & ~31) + perm32(R & 31)) : R;
        voffA[i] = (unsigned)(R * K + C) * 2u; voffB[i] = (unsigned)(Rb * K + C) * 2u; }
    const size_t kstep = (size_t)(BK * 2);
    const size_t hstep = (size_t)HALF * K * 2;
    const size_t tstep = 2 * hstep;
    const unsigned ldsw = (unsigned)wid * 1024u;
    const int aoff = lds_byte(wr * 64 + fr, fq * 8), boff = lds_byte(wc * 32 + fr, fq * 8);
#define PG8_SA(b, h) (((b) * 2 + (h)) * HTB)
#define PG8_SB(b, h) ((4 + (b) * 2 + (h)) * HTB)
#define PG8_STAGE(bufoff, gbase, voff) do { _Pragma("unroll") for (int _i = 0; _i < 2; ++_i) \
        __builtin_amdgcn_global_load_lds((const unsigned*)((const char*)(gbase) + (voff)[_i]), (PG8_LAS unsigned*)(lds + (bufoff) + ldsw + _i * 8192), 16, 0, 0); } while (0)
#define PG8_LDA(dst, b, h) do { _Pragma("unroll") for (int m = 0; m < 4; ++m) _Pragma("unroll") for (int k = 0; k < 2; ++k) dst[m][k] = *(const PG8_LAS bf16x8*)(lds + PG8_SA(b, h) + aoff + m * 2048 + k * 1024); } while (0)
#define PG8_LDB(dst, b, h) do { _Pragma("unroll") for (int n = 0; n < 2; ++n) _Pragma("unroll") for (int k = 0; k < 2; ++k) dst[n][k] = *(const PG8_LAS bf16x8*)(lds + PG8_SB(b, h) + boff + n * 2048 + k * 1024); } while (0)
#define PG8_MMA(ai, bj, At, Bt) do { __builtin_amdgcn_s_setprio(1); _Pragma("unroll") for (int m = 0; m < 4; ++m) _Pragma("unroll") for (int n = 0; n < 2; ++n) _Pragma("unroll") for (int k = 0; k < 2; ++k) \
        acc[ai][bj][m][n] = __builtin_amdgcn_mfma_f32_16x16x32_bf16(Bt[n][k], At[m][k], acc[ai][bj][m][n], 0, 0, 0); __builtin_amdgcn_s_setprio(0); } while (0)
#define PG8_WAIT_V(n) asm volatile("s_waitcnt vmcnt(" #n ")" ::: "memory")
#define PG8_WAIT_L(n) asm volatile("s_waitcnt lgkmcnt(" #n ")" ::: "memory")
#define PG8_BAR __builtin_amdgcn_s_barrier()
#define PG8_SCHED __builtin_amdgcn_sched_barrier(0)
    Unit cur, nxt; int ui = 0;
    if (!S.next(0, cur)) return;
    f32x4 acc[2][2][4][2];
#pragma unroll
    for (int a = 0; a < 2; ++a)
#pragma unroll
        for (int b = 0; b < 2; ++b)
#pragma unroll
            for (int m = 0; m < 4; ++m)
#pragma unroll
                for (int n = 0; n < 2; ++n) acc[a][b][m][n] = (f32x4){0.f, 0.f, 0.f, 0.f};
    bf16x8 At[4][2], B0[2][2], B1[2][2];
    const char* cA = (const char*)g.A + (size_t)cur.pm * tstep; const char* cB = (const char*)g.Bt + (size_t)cur.pn * tstep;
    S.a_ready(cur);
    if constexpr (SP2) {
        PG8_STAGE(PG8_SB(0, 0), cB, voffB); PG8_STAGE(PG8_SB(0, 1), cB + hstep, voffB); PG8_STAGE(PG8_SA(0, 0), cA, voffA); PG8_STAGE(PG8_SA(0, 1), cA + hstep, voffA);
        if (wr == 1) PG8_BAR;
        PG8_WAIT_V(2); PG8_BAR;
        PG8_STAGE(PG8_SB(1, 0), cB + kstep, voffB); PG8_STAGE(PG8_SA(1, 0), cA + kstep, voffA); PG8_STAGE(PG8_SB(1, 1), cB + hstep + kstep, voffB);
        PG8_WAIT_V(6); PG8_BAR;
    } else {
        PG8_STAGE(PG8_SB(0, 0), cB, voffB); PG8_STAGE(PG8_SA(0, 0), cA, voffA); PG8_STAGE(PG8_SB(0, 1), cB + hstep, voffB); PG8_STAGE(PG8_SA(0, 1), cA + hstep, voffA);
        if (wr == 1) PG8_BAR;
        PG8_WAIT_V(4); PG8_BAR;
        PG8_STAGE(PG8_SB(1, 0), cB + kstep, voffB); PG8_STAGE(PG8_SA(1, 0), cA + kstep, voffA); PG8_STAGE(PG8_SB(1, 1), cB + hstep + kstep, voffB);
        PG8_WAIT_V(6); PG8_BAR;
    }
    for (;;) {
        const bool has_next = S.next(ui + 1, nxt);
        const char* nA = has_next ? (const char*)g.A + (size_t)nxt.pm * tstep : cA; const char* nB = has_next ? (const char*)g.Bt + (size_t)nxt.pn * tstep : cB;
        for (int t = 0; t < nt; t += 2) {
            const bool last = (t == nt - 2);
            const char* a1 = cA + (size_t)(t + 1) * kstep;
            const char* a2 = last ? nA : cA + (size_t)(t + 2) * kstep; const char* b2 = last ? nB : cB + (size_t)(t + 2) * kstep;
            const char* a3 = a2 + kstep; const char* b3 = b2 + kstep;
            if (last && has_next) S.a_ready(nxt);
            if constexpr (SP2) {
            PG8_LDB(B0, 0, 0); PG8_LDB(B1, 0, 1); PG8_SCHED; PG8_LDA(At, 0, 0); PG8_STAGE(PG8_SA(1, 1), a1 + hstep, voffA);
            PG8_WAIT_V(8); PG8_WAIT_L(0); PG8_BAR; PG8_MMA(0, 0, At, B0); PG8_MMA(0, 1, At, B1); PG8_BAR; PG8_SCHED;
            PG8_LDA(At, 0, 1); PG8_STAGE(PG8_SB(0, 0), b2, voffB); PG8_STAGE(PG8_SB(0, 1), b2 + hstep, voffB); PG8_STAGE(PG8_SA(0, 0), a2, voffA);
            PG8_WAIT_V(8); PG8_WAIT_L(0); PG8_BAR; PG8_MMA(1, 0, At, B0); PG8_MMA(1, 1, At, B1); PG8_BAR; PG8_SCHED;
            PG8_LDB(B0, 1, 0); PG8_LDB(B1, 1, 1); PG8_SCHED; PG8_LDA(At, 1, 0); PG8_STAGE(PG8_SA(0, 1), a2 + hstep, voffA);
            PG8_WAIT_V(8); PG8_WAIT_L(0); PG8_BAR; PG8_MMA(0, 0, At, B0); PG8_MMA(0, 1, At, B1); PG8_BAR; PG8_SCHED;
            PG8_LDA(At, 1, 1); PG8_STAGE(PG8_SB(1, 0), b3, voffB); PG8_STAGE(PG8_SB(1, 1), b3 + hstep, voffB); PG8_STAGE(PG8_SA(1, 0), a3, voffA);
            PG8_WAIT_V(8); PG8_WAIT_L(0); PG8_BAR; PG8_MMA(1, 0, At, B0); PG8_MMA(1, 1, At, B1); PG8_BAR; PG8_SCHED;
            } else {
            PG8_LDB(B0, 0, 0); PG8_SCHED; PG8_LDA(At, 0, 0); PG8_STAGE(PG8_SA(1, 1), a1 + hstep, voffA);
            PG8_WAIT_L(8); PG8_BAR; PG8_WAIT_L(0); PG8_MMA(0, 0, At, B0); PG8_BAR; PG8_SCHED;
            PG8_LDB(B1, 0, 1); PG8_STAGE(PG8_SB(0, 0), b2, voffB);
            PG8_BAR; PG8_WAIT_L(0); PG8_MMA(0, 1, At, B1); PG8_BAR;
            PG8_LDA(At, 0, 1); PG8_STAGE(PG8_SA(0, 0), a2, voffA);
            PG8_BAR; PG8_WAIT_L(0); PG8_MMA(1, 0, At, B0); PG8_BAR; PG8_SCHED;
            PG8_STAGE(PG8_SB(0, 1), b2 + hstep, voffB);
            PG8_WAIT_V(6); PG8_BAR; PG8_MMA(1, 1, At, B1); PG8_BAR;
            PG8_LDB(B0, 1, 0); PG8_SCHED; PG8_LDA(At, 1, 0); PG8_STAGE(PG8_SA(0, 1), a2 + hstep, voffA);
            PG8_WAIT_L(8); PG8_BAR; PG8_WAIT_L(0); PG8_MMA(0, 0, At, B0); PG8_BAR; PG8_SCHED;
            PG8_LDB(B1, 1, 1); PG8_STAGE(PG8_SB(1, 0), b3, voffB);
            PG8_BAR; PG8_WAIT_L(0); PG8_MMA(0, 1, At, B1); PG8_BAR;
            PG8_LDA(At, 1, 1); PG8_STAGE(PG8_SA(1, 0), a3, voffA);
            PG8_BAR; PG8_WAIT_L(0); PG8_MMA(1, 0, At, B0); PG8_BAR; PG8_SCHED;
            PG8_STAGE(PG8_SB(1, 1), b3 + hstep, voffB);
            PG8_WAIT_V(6); PG8_BAR; PG8_MMA(1, 1, At, B1); PG8_BAR;
            }
        }
        if constexpr (ALIGN_EPI) { if (wr == 0) PG8_BAR; }
        if constexpr (!Epi::AFTER_DRAIN) { E(acc, cur, wr, wc, fr, fq); S.done(cur); }
        if (!has_next) break;
#pragma unroll
        for (int a = 0; a < 2; ++a)
#pragma unroll
            for (int b = 0; b < 2; ++b)
#pragma unroll
                for (int m = 0; m < 4; ++m)
#pragma unroll
                    for (int n = 0; n < 2; ++n) acc[a][b][m][n] = (f32x4){0.f, 0.f, 0.f, 0.f};
        cur = nxt; cA = nA; cB = nB; ++ui;
        if constexpr (ALIGN_EPI) { if (wr == 1) PG8_BAR; }
    }
    PG8_WAIT_V(0);
    if constexpr (!ALIGN_EPI) { if (wr == 0) PG8_BAR; }
    PG8_BAR;
    if constexpr (Epi::AFTER_DRAIN) { E.fused(acc, cur, wr, wc, fr, fq, lds, wid, lane); S.done(cur); }
#undef PG8_SA
#undef PG8_SB
#undef PG8_STAGE
#undef PG8_LDA
#undef PG8_LDB
#undef PG8_MMA
#undef PG8_WAIT_V
#undef PG8_WAIT_L
#undef PG8_BAR
#undef PG8_SCHED
}
}

#ifndef PG8_SP2
#define PG8_SP2 true
#endif
#ifndef PG8_ALIGN
#define PG8_ALIGN true
#endif
constexpr int BATCH = 8, SEQ = 2048, DM = 1024, MROWS = BATCH * SEQ, DEPTH = 2;
constexpr int D_RNN = 512, NHEAD = 8, HDIM = 64, D_INR = 2760, ZP = 2816, TOPK = 256;
constexpr int C_XR = 0, C_GR = 512, C_Q = 1024, C_K = 1536, C_V = 1600, C_GA = 1664, C_QI = 2176, C_KI = 2688, C_WI = 2752;
constexpr float EPS = 1e-6f;
constexpr float QSCALE = 0.125f * 1.4426950408889634f;
constexpr size_t MiB = 1u << 20;
constexpr size_t WS_CTL = 0, CTL_ZERO_BYTES = 1 * MiB;
constexpr size_t WS_MOD = 1 * MiB;
constexpr size_t WS_BIAS = 1 * MiB + 256 * 1024;
constexpr size_t WS_SSQ = 2 * MiB;
constexpr size_t WS_WTIN = 3 * MiB;
constexpr size_t WS_WTOUT = 14 * MiB;
constexpr size_t WS_A = 32 * MiB;
constexpr size_t WS_Z = 64 * MiB;
constexpr size_t WS_Y = 152 * MiB;
constexpr size_t WS_X1 = 184 * MiB;
constexpr size_t WS_END = 216 * MiB;
constexpr int LDS_BYTES = 163840;
constexpr int MISC_OFF = 131072 + 8192;
constexpr int NPHASE = 8;
constexpr int CW_BAR = 4096, CW_PANEL = 16384;

#define LAS __attribute__((address_space(3)))
typedef unsigned short bf16;
typedef float f32x4 __attribute__((ext_vector_type(4)));
typedef unsigned u32x4 __attribute__((ext_vector_type(4)));
typedef unsigned u32x2 __attribute__((ext_vector_type(2)));
__device__ __forceinline__ float bf2f(bf16 v) { return __uint_as_float(((unsigned)v) << 16); }
__device__ __forceinline__ unsigned f2bf(float f) { unsigned u = __float_as_uint(f); return (u + 0x7fffu + ((u >> 16) & 1u)) >> 16; }
__device__ __forceinline__ unsigned pk2(float lo, float hi) { return f2bf(lo) | (f2bf(hi) << 16); }
__device__ __forceinline__ float wave_sum(float v) {
#pragma unroll
    for (int o = 1; o < 64; o <<= 1) v += __shfl_xor(v, o);
    return v;
}
__device__ __forceinline__ float wave_max(float v) {
#pragma unroll
    for (int o = 1; o < 64; o <<= 1) v = fmaxf(v, __shfl_xor(v, o));
    return v;
}
__device__ __forceinline__ int wave_sum_i(int v) {
#pragma unroll
    for (int o = 1; o < 64; o <<= 1) v += __shfl_xor(v, o);
    return v;
}
__device__ __forceinline__ float siluf(float v) { return v / (1.f + expf(-v)); }
__device__ __forceinline__ float sigmf(float v) { return 1.f / (1.f + expf(-v)); }

struct P {
    const float *x, *c, *norm_g, *ada_w, *ada_b, *w_in, *conv_w, *conv_b, *lru_wx, *lru_bx, *lru_wa, *lru_ba, *lru_a, *w_out, *final_g;
    float* out;
    float *mod, *bias, *ssq;
    bf16 *wt_in, *wt_out, *A, *Z, *Y, *X1;
    unsigned* ctl;
};

#ifndef EPI_ZD
#define EPI_ZD 2
#endif
struct EpiZ {
    static constexpr bool PERM = true, AFTER_DRAIN = false;
    bf16* Zp; const float* ssq; const float* bias;
    __device__ __forceinline__ void operator()(const pg8::f32x4 (&acc)[2][2][4][2], const pg8::Unit& u, int wr, int wc, int fr, int fq) const {
        const int row0 = u.pm * 256 + wr * 64 + fr, col0 = u.pn * 256 + wc * 32 + 8 * fq, b = u.pm >> 3;
        const float cs = (u.pn == 4 || u.pn == 5) ? QSCALE : 1.0f;
        f32x4 bv[2][2];
#pragma unroll
        for (int bj = 0; bj < 2; ++bj)
#pragma unroll
            for (int n = 0; n < 2; ++n) bv[bj][n] = *(const f32x4*)(bias + b * ZP + col0 + bj * 128 + 4 * n);
        f32x4 qq[EPI_ZD];
#pragma unroll
        for (int gi = 0; gi < EPI_ZD; ++gi) qq[gi] = *(const f32x4*)(ssq + (size_t)(row0 + (gi >> 2) * 128 + (gi & 3) * 16) * 4);
#pragma unroll
        for (int ai = 0; ai < 2; ++ai)
#pragma unroll
            for (int m = 0; m < 4; ++m) {
                const int r = row0 + ai * 128 + m * 16, gi = ai * 4 + m;
                const f32x4 q = qq[gi % EPI_ZD];
                if (gi + EPI_ZD < 8) qq[gi % EPI_ZD] = *(const f32x4*)(ssq + (size_t)(row0 + ((gi + EPI_ZD) >> 2) * 128 + ((gi + EPI_ZD) & 3) * 16) * 4);
                const float rstd = __builtin_amdgcn_rsqf(((q.x + q.y) + (q.z + q.w)) * (1.0f / 1024.0f) + EPS);
                bf16* rowp = Zp + (size_t)r * ZP + col0;
#pragma unroll
                for (int bj = 0; bj < 2; ++bj) {
                    const f32x4 v0 = (acc[ai][bj][m][0] * rstd + bv[bj][0]) * cs, v1 = (acc[ai][bj][m][1] * rstd + bv[bj][1]) * cs;
                    u32x4 w; w.x = pk2(v0[0], v0[1]); w.y = pk2(v0[2], v0[3]); w.z = pk2(v1[0], v1[1]); w.w = pk2(v1[2], v1[3]);
                    *(u32x4*)(rowp + bj * 128) = w;
                }
            }
    }
};
#ifndef EPI_XD
#define EPI_XD 4
#endif
struct EpiX {
    static constexpr bool PERM = true, AFTER_DRAIN = true;
    const float* xres; bf16* xout; bf16* Anext; const float* gate; const float* ng; const float* nscale; float* ssq;
    __device__ __forceinline__ void fused(pg8::f32x4 (&acc)[2][2][4][2], const pg8::Unit& u, int wr, int wc, int fr, int fq, LAS unsigned char* lds, int wid, int lane) const {
        const int b = u.pm >> 3, col0 = u.pn * 256 + wc * 32 + 8 * fq;
        LAS float* Pp = (LAS float*)lds;
        f32x4 gv[2][2], gs[2][2];
#pragma unroll
        for (int bj = 0; bj < 2; ++bj)
#pragma unroll
            for (int n = 0; n < 2; ++n) {
                gv[bj][n] = *(const f32x4*)(gate + b * 3072 + col0 + bj * 128 + 4 * n);
                if (Anext) { const f32x4 g = *(const f32x4*)(ng + col0 + bj * 128 + 4 * n), s = *(const f32x4*)(nscale + b * 3072 + col0 + bj * 128 + 4 * n); gs[bj][n] = g * (s + 1.0f); }
                else gs[bj][n] = (f32x4){0.f, 0.f, 0.f, 0.f};
            }
        f32x4 xq[EPI_XD][2][2];
#define EPIX_LOAD(gi) do { const size_t r_ = (size_t)u.pm * 256 + ((gi) >> 2) * 128 + wr * 64 + ((gi) & 3) * 16 + fr; \
        _Pragma("unroll") for (int bj = 0; bj < 2; ++bj) _Pragma("unroll") for (int n = 0; n < 2; ++n) xq[(gi) % EPI_XD][bj][n] = *(const f32x4*)(xres + r_ * DM + col0 + bj * 128 + 4 * n); } while (0)
#pragma unroll
        for (int gi = 0; gi < EPI_XD; ++gi) EPIX_LOAD(gi);
#pragma unroll
        for (int ai = 0; ai < 2; ++ai)
#pragma unroll
            for (int m = 0; m < 4; ++m) {
                const int rl = ai * 128 + wr * 64 + m * 16 + fr; const size_t r = (size_t)u.pm * 256 + rl;
                float s = 0.f;
                f32x4 xc[2][2];
#pragma unroll
                for (int bj = 0; bj < 2; ++bj)
#pragma unroll
                    for (int n = 0; n < 2; ++n) xc[bj][n] = xq[(ai * 4 + m) % EPI_XD][bj][n];
                if (ai * 4 + m + EPI_XD < 8) EPIX_LOAD(ai * 4 + m + EPI_XD);
#pragma unroll
                for (int bj = 0; bj < 2; ++bj) {
                    f32x4 x1[2];
#pragma unroll
                    for (int n = 0; n < 2; ++n) {
                        const f32x4 xr = xc[bj][n];
                        x1[n] = xr + gv[bj][n] * acc[ai][bj][m][n];
                        s += (x1[n][0] * x1[n][0] + x1[n][1] * x1[n][1]) + (x1[n][2] * x1[n][2] + x1[n][3] * x1[n][3]);
                    }
                    { u32x4 xw; xw.x = pk2(x1[0][0], x1[0][1]); xw.y = pk2(x1[0][2], x1[0][3]); xw.z = pk2(x1[1][0], x1[1][1]); xw.w = pk2(x1[1][2], x1[1][3]);
                      *(u32x4*)(xout + r * DM + col0 + bj * 128) = xw; }
                    if (Anext) { const f32x4 a0 = x1[0] * gs[bj][0], a1 = x1[1] * gs[bj][1];
                        u32x4 w; w.x = pk2(a0[0], a0[1]); w.y = pk2(a0[2], a0[3]); w.z = pk2(a1[0], a1[1]); w.w = pk2(a1[2], a1[3]);
                        *(u32x4*)(Anext + r * DM + col0 + bj * 128) = w; }
                }
                s += __shfl_xor(s, 16); s += __shfl_xor(s, 32);
                if (fq == 0) Pp[rl * 4 + wc] = s;
            }
        __syncthreads();
        const int tid = wid * 64 + lane;
        if (tid < 256) ssq[((size_t)u.pm * 256 + tid) * 4 + u.pn] = (Pp[tid * 4 + 0] + Pp[tid * 4 + 1]) + (Pp[tid * 4 + 2] + Pp[tid * 4 + 3]);
        __syncthreads();
    }
};

struct EpiXF {
    static constexpr bool PERM = true, AFTER_DRAIN = true;
    const bf16* xres; float* out; const float* gate; const float* fg; float* ssq; unsigned* cnt;
    __device__ __forceinline__ void fused(pg8::f32x4 (&acc)[2][2][4][2], const pg8::Unit& u, int wr, int wc, int fr, int fq, LAS unsigned char* lds, int wid, int lane) const {
        const int b = u.pm >> 3, col0 = u.pn * 256 + wc * 32 + 8 * fq, tid = wid * 64 + lane;
        LAS float* Pp = (LAS float*)lds;
        LAS float* Sr = (LAS float*)(lds + 4096);
        {
            f32x4 gv[2][2];
#pragma unroll
            for (int bj = 0; bj < 2; ++bj)
#pragma unroll
                for (int n = 0; n < 2; ++n) gv[bj][n] = *(const f32x4*)(gate + b * 3072 + col0 + bj * 128 + 4 * n);
#pragma unroll
            for (int ai = 0; ai < 2; ++ai)
#pragma unroll
                for (int m = 0; m < 4; ++m) {
                    const int rl = ai * 128 + wr * 64 + m * 16 + fr; const size_t r = (size_t)u.pm * 256 + rl;
                    float s = 0.f;
#pragma unroll
                    for (int bj = 0; bj < 2; ++bj) {
                        const u32x4 xw = *(const u32x4*)(xres + r * DM + col0 + bj * 128);
#pragma unroll
                        for (int n = 0; n < 2; ++n) {
                            const unsigned w0 = n ? xw.z : xw.x, w1 = n ? xw.w : xw.y;
                            const f32x4 xr = {__uint_as_float(w0 << 16), __uint_as_float(w0 & 0xffff0000u), __uint_as_float(w1 << 16), __uint_as_float(w1 & 0xffff0000u)};
                            const f32x4 x1 = xr + gv[bj][n] * acc[ai][bj][m][n];
                            acc[ai][bj][m][n] = x1;
                            s += (x1[0] * x1[0] + x1[1] * x1[1]) + (x1[2] * x1[2] + x1[3] * x1[3]);
                        }
                    }
                    s += __shfl_xor(s, 16); s += __shfl_xor(s, 32);
                    if (fq == 0) Pp[rl * 4 + wc] = s;
                }
        }
        __syncthreads();
        if (tid < 256) { const float tot = (Pp[tid * 4 + 0] + Pp[tid * 4 + 1]) + (Pp[tid * 4 + 2] + Pp[tid * 4 + 3]);
            __hip_atomic_store(ssq + ((size_t)u.pm * 256 + tid) * 4 + u.pn, tot, __ATOMIC_RELAXED, __HIP_MEMORY_SCOPE_AGENT); }
        asm volatile("s_waitcnt vmcnt(0)" ::: "memory");
        __syncthreads();
        if (tid == 0) {
            unsigned* c = cnt + 64 * u.pm;
            __hip_atomic_fetch_add(c, 1u, __ATOMIC_RELAXED, __HIP_MEMORY_SCOPE_AGENT);
            unsigned spins = 0u;
            while (__hip_atomic_load(c, __ATOMIC_RELAXED, __HIP_MEMORY_SCOPE_AGENT) < 4u) { __builtin_amdgcn_s_sleep(2); if (++spins > (1u << 22)) break; }
            __builtin_amdgcn_fence(__ATOMIC_ACQUIRE, "agent");
            asm volatile("s_waitcnt vmcnt(0)" ::: "memory");
        }
        __syncthreads();
        if (tid < 256) { const float* sp = ssq + ((size_t)u.pm * 256 + tid) * 4;
            const float q0 = __hip_atomic_load(sp + 0, __ATOMIC_RELAXED, __HIP_MEMORY_SCOPE_AGENT), q1 = __hip_atomic_load(sp + 1, __ATOMIC_RELAXED, __HIP_MEMORY_SCOPE_AGENT);
            const float q2 = __hip_atomic_load(sp + 2, __ATOMIC_RELAXED, __HIP_MEMORY_SCOPE_AGENT), q3 = __hip_atomic_load(sp + 3, __ATOMIC_RELAXED, __HIP_MEMORY_SCOPE_AGENT);
            Sr[tid] = 1.0f / sqrtf(((q0 + q1) + (q2 + q3)) * (1.0f / 1024.0f) + EPS); }
        __syncthreads();
        f32x4 fgv[2][2];
#pragma unroll
        for (int bj = 0; bj < 2; ++bj)
#pragma unroll
            for (int n = 0; n < 2; ++n) fgv[bj][n] = *(const f32x4*)(fg + col0 + bj * 128 + 4 * n);
#pragma unroll
        for (int ai = 0; ai < 2; ++ai)
#pragma unroll
            for (int m = 0; m < 4; ++m) {
                const int rl = ai * 128 + wr * 64 + m * 16 + fr; const size_t r = (size_t)u.pm * 256 + rl; const float rstd = Sr[rl];
#pragma unroll
                for (int bj = 0; bj < 2; ++bj)
#pragma unroll
                    for (int n = 0; n < 2; ++n) *(f32x4*)(out + r * DM + col0 + bj * 128 + 4 * n) = acc[ai][bj][m][n] * rstd * fgv[bj][n];
            }
        __syncthreads();
    }
};

#ifndef PRO_KC
#define PRO_KC 64
#endif
#ifndef TRQ
#define TRQ 4
#endif
__device__ __forceinline__ void ph0_prologue(const P& p, LAS unsigned char* lds) {
    const int tid = threadIdx.x, lane = tid & 63, wave = tid >> 6, G = gridDim.x, wg = blockIdx.x;
    LAS float* fl = (LAS float*)lds;
    for (int u = wg; u < 96; u += G) {
        const int l = u / 48, j = (u % 48) * 64 + lane;
        { float cv[16];
#pragma unroll
          for (int i = 0; i < 16; ++i) cv[i] = p.c[tid + 512 * i];
#pragma unroll
          for (int i = 0; i < 16; ++i) fl[tid + 512 * i] = siluf(cv[i]); }
        __syncthreads();
        float acc[8];
#pragma unroll
        for (int b = 0; b < 8; ++b) acc[b] = 0.f;
        const float* w = p.ada_w + ((size_t)l * 1024 + wave * 128) * 3072 + j;
#pragma unroll 1
        for (int k0 = 0; k0 < 128; k0 += PRO_KC) { float wv[PRO_KC];
#pragma unroll
          for (int k = 0; k < PRO_KC; ++k) wv[k] = w[(size_t)(k0 + k) * 3072];
#pragma unroll
          for (int k = 0; k < PRO_KC; ++k) {
#pragma unroll
            for (int b = 0; b < 8; ++b) acc[b] += fl[b * 1024 + wave * 128 + k0 + k] * wv[k]; } }
#pragma unroll
        for (int b = 0; b < 8; ++b) fl[8192 + (wave * 8 + b) * 64 + lane] = acc[b];
        __syncthreads();
        { const int b = wave; float s = p.ada_b[l * 3072 + j];
#pragma unroll
          for (int w8 = 0; w8 < 8; ++w8) s += fl[8192 + (w8 * 8 + b) * 64 + lane];
          p.mod[(l * 8 + b) * 3072 + j] = s; }
        __syncthreads();
    }
    const int GT = (G > 96) ? G - 96 : G, wt = (G > 96) ? wg - 96 : wg;
    if (wt >= 0)
#pragma unroll 1
    for (int u0 = wt; u0 < 1920; u0 += TRQ * GT) {
        float v[TRQ][8]; bf16* dst[TRQ]; bool act[TRQ];
#pragma unroll
        for (int q = 0; q < TRQ; ++q) {
            const int u = u0 + q * GT; act[q] = u < 1920; dst[q] = nullptr;
#pragma unroll
            for (int j = 0; j < 8; ++j) v[q][j] = 0.f;
            if (act[q]) {
                const float* W; bf16* WT; int N, kt, nt;
                if (u < 1408) { const int l = u / 704, r = u % 704; kt = r / 44; nt = r % 44; W = p.w_in + (size_t)l * 1024 * D_INR; N = D_INR; WT = p.wt_in + (size_t)l * ZP * 1024; }
                else { int r = u - 1408; const int l = r / 256; r %= 256; kt = r / 16; nt = r % 16; W = p.w_out + (size_t)l * 1024 * 1024; N = 1024; WT = p.wt_out + (size_t)l * 1024 * 1024; }
                const int n = nt * 64 + lane, k0 = kt * 64 + wave * 8;
                if (n < N) {
#pragma unroll
                    for (int j = 0; j < 8; ++j) v[q][j] = W[(size_t)(k0 + j) * N + n];
                }
                dst[q] = WT + (size_t)n * 1024 + k0;
            }
        }
#pragma unroll
        for (int q = 0; q < TRQ; ++q) if (act[q]) { u32x4 o; o.x = pk2(v[q][0], v[q][1]); o.y = pk2(v[q][2], v[q][3]); o.z = pk2(v[q][4], v[q][5]); o.w = pk2(v[q][6], v[q][7]); *(u32x4*)dst[q] = o; }
    }
}
__device__ __forceinline__ void ph1_prologue(const P& p, LAS unsigned char* lds) {
    const int tid = threadIdx.x, lane = tid & 63, wave = tid >> 6, G = gridDim.x, wg = blockIdx.x;
    LAS float* fl = (LAS float*)lds;
    for (int u = wg; u < 88; u += G) {
        const int l = u / 44, n = (u % 44) * 64 + lane;
        { float mv[16];
#pragma unroll
          for (int i = 0; i < 16; ++i) { const int e = tid + 512 * i; mv[i] = p.mod[(l * 8 + (e >> 10)) * 3072 + (e & 1023)]; }
#pragma unroll
          for (int i = 0; i < 16; ++i) fl[tid + 512 * i] = mv[i]; }
        __syncthreads();
        float acc[8];
#pragma unroll
        for (int b = 0; b < 8; ++b) acc[b] = 0.f;
        if (n < D_INR) { const float* w = p.w_in + ((size_t)l * 1024 + wave * 128) * D_INR + n;
#pragma unroll 1
            for (int k0 = 0; k0 < 128; k0 += PRO_KC) { float wv[PRO_KC];
#pragma unroll
              for (int k = 0; k < PRO_KC; ++k) wv[k] = w[(size_t)(k0 + k) * D_INR];
#pragma unroll
              for (int k = 0; k < PRO_KC; ++k) {
#pragma unroll
                for (int b = 0; b < 8; ++b) acc[b] += fl[b * 1024 + wave * 128 + k0 + k] * wv[k]; } } }
#pragma unroll
        for (int b = 0; b < 8; ++b) fl[8192 + (wave * 8 + b) * 64 + lane] = acc[b];
        __syncthreads();
        { const int b = wave; float s = 0.f;
#pragma unroll
          for (int w8 = 0; w8 < 8; ++w8) s += fl[8192 + (w8 * 8 + b) * 64 + lane];
          p.bias[(l * 8 + b) * ZP + n] = s; }
        __syncthreads();
    }
    {
        const int r0 = wg * 8 + wave, rstep = G * 8;
        f32x4 gq[4], xv[2][2][4], sv[2][2][4];
#pragma unroll
        for (int j = 0; j < 4; ++j) gq[j] = *(const f32x4*)(p.norm_g + (lane + 64 * j) * 4);
#define A0_LOAD(slot, pr) do { _Pragma("unroll") for (int h_ = 0; h_ < 2; ++h_) _Pragma("unroll") for (int j = 0; j < 4; ++j) { const int k_ = (lane + 64 * j) * 4, r_ = r0 + rstep * (2 * (pr) + h_); \
            xv[slot][h_][j] = *(const f32x4*)(p.x + (size_t)r_ * DM + k_); sv[slot][h_][j] = *(const f32x4*)(p.mod + (size_t)(r_ >> 11) * 3072 + 1024 + k_); } } while (0)
        A0_LOAD(0, 0);
#pragma unroll
        for (int pr = 0; pr < 4; ++pr) {
            if (pr + 1 < 4) A0_LOAD((pr + 1) & 1, pr + 1);
#pragma unroll
            for (int h = 0; h < 2; ++h) {
                const int r = r0 + rstep * (2 * pr + h); float s1 = 0.f;
#pragma unroll
                for (int j = 0; j < 4; ++j) { const int k = (lane + 64 * j) * 4; const f32x4 v = xv[pr & 1][h][j];
                    s1 += (v[0] * v[0] + v[1] * v[1]) + (v[2] * v[2] + v[3] * v[3]);
                    const f32x4 o1 = v * gq[j] * (sv[pr & 1][h][j] + 1.0f);
                    u32x2 w1; w1.x = pk2(o1[0], o1[1]); w1.y = pk2(o1[2], o1[3]);
                    *(u32x2*)(p.A + (size_t)r * DM + k) = w1; }
                s1 = wave_sum(s1);
                if (lane == 0) *(f32x4*)(p.ssq + (size_t)r * 4) = (f32x4){s1, 0.f, 0.f, 0.f};
            }
        }
#undef A0_LOAD
    }
}
__device__ __forceinline__ void ph_final(const P& p) {
    const int tid = threadIdx.x, lane = tid & 63, wave = tid >> 6, G = gridDim.x, wg = blockIdx.x;
    for (int r = wg * 8 + wave; r < MROWS; r += G * 8) {
        const f32x4 q = *(const f32x4*)(p.ssq + (size_t)r * 4);
        const float rstd = 1.0f / sqrtf(((q.x + q.y) + (q.z + q.w)) * (1.0f / 1024.0f) + EPS);
#pragma unroll
        for (int j = 0; j < 4; ++j) { const int k = (lane + 64 * j) * 4;
            const f32x4 v = *(const f32x4*)(p.out + (size_t)r * DM + k), g = *(const f32x4*)(p.final_g + k);
            *(f32x4*)(p.out + (size_t)r * DM + k) = v * rstd * g; }
    }
}
#define XB_TMO      128
#define XB_XCNT(j)  (256  + 64 * (j))
#define XB_XSUB(j)  (1280 + 64 * (j))
#define XB_XGEN(j)  (2304 + 64 * (j))
#define XB_TOP      3328
#define XB_TOPGEN   3392
#define XCD_BAR_WORDS 3456
#define XB_SPIN_CAP (1u << 18)

__device__ __forceinline__ unsigned xb_ld(unsigned* p)              { return __hip_atomic_load(p, __ATOMIC_RELAXED, __HIP_MEMORY_SCOPE_AGENT); }
__device__ __forceinline__ unsigned xb_add(unsigned* p, unsigned v) { return __hip_atomic_fetch_add(p, v, __ATOMIC_RELAXED, __HIP_MEMORY_SCOPE_AGENT); }
__device__ __forceinline__ unsigned xb_xcc_id() { return (unsigned)__builtin_amdgcn_s_getreg((3 << 11) | 20) & 0xFu; }
#define XB_SPIN(cond, bar) do { unsigned _sp = 0; while (cond) { __builtin_amdgcn_s_sleep(1); \
    if ((++_sp & 255u) == 0u) { if (xb_ld(&(bar)[XB_TMO])) break; if (_sp > XB_SPIN_CAP) { atomicAdd(&(bar)[XB_TMO], 1u); break; } } } } while (0)

struct XcdBarrier {
    unsigned* bar; unsigned x;
    volatile LAS unsigned* st;
};

__device__ __forceinline__ XcdBarrier xcd_barrier_post(unsigned* bar, volatile LAS unsigned* st) {
    XcdBarrier b; b.bar = bar; b.x = xb_xcc_id(); b.st = st;
    if (threadIdx.x == 0) (void)xb_add(&bar[XB_XCNT(b.x)], 1u);
    return b;
}
__device__ __forceinline__ void xcd_barrier_complete(unsigned* bar, unsigned x, unsigned& nloc, unsigned& nx) {
    const unsigned G = gridDim.x * gridDim.y * gridDim.z;
    unsigned sum, cnt, mine, sp = 0u;
    for (;;) {
        sum = 0u; cnt = 0u; mine = 0u;
#pragma unroll
        for (unsigned j = 0; j < 16; ++j) { const unsigned c = xb_ld(&bar[XB_XCNT(j)]); sum += c; cnt += (c > 0u) ? 1u : 0u; mine = (j == x) ? c : mine; }
        if (sum == G) break;
        __builtin_amdgcn_s_sleep(1);
        if ((++sp & 255u) == 0u) { if (xb_ld(&bar[XB_TMO])) break; if (sp > XB_SPIN_CAP) { atomicAdd(&bar[XB_TMO], 1u); break; } }
    }
    nloc = mine > 0u ? mine : 1u; nx = cnt > 0u ? cnt : 1u;
}

__device__ __forceinline__ void xcd_barrier(const XcdBarrier& b) {
    asm volatile("s_waitcnt vmcnt(0)" ::: "memory");
    __syncthreads();
    if (threadIdx.x == 0) {
        unsigned* bar = b.bar;
        __builtin_amdgcn_s_waitcnt(0);
        unsigned nloc = b.st[0], nx = b.st[1];
        if (nloc == 0u) { xcd_barrier_complete(bar, b.x, nloc, nx); b.st[0] = nloc; b.st[1] = nx; }
        const unsigned old = xb_add(&bar[XB_XSUB(b.x)], 1u);
        const unsigned gen = old / nloc;
        if (old + 1u == (gen + 1u) * nloc) {
            __builtin_amdgcn_fence(__ATOMIC_RELEASE, "agent");
            asm volatile("s_waitcnt vmcnt(0)" ::: "memory");
            const unsigned og = xb_add(&bar[XB_TOP], 1u);
            const unsigned tg = og / nx;
            if (og + 1u == (tg + 1u) * nx) xb_add(&bar[XB_TOPGEN], 1u);
            else XB_SPIN(xb_ld(&bar[XB_TOPGEN]) == tg, bar);
            __builtin_amdgcn_fence(__ATOMIC_ACQUIRE, "agent");
            xb_add(&bar[XB_XGEN(b.x)], 1u);
            asm volatile("s_waitcnt vmcnt(0)" ::: "memory");
        } else {
            XB_SPIN(xb_ld(&bar[XB_XGEN(b.x)]) == gen, bar);
            __builtin_amdgcn_fence(__ATOMIC_ACQUIRE, "agent");
            asm volatile("s_waitcnt vmcnt(0)" ::: "memory");
        }
    }
    __syncthreads();
}
__device__ __forceinline__ unsigned score_ukey(float s) { const unsigned u = __float_as_uint(s + 0.0f); return (u & 0x80000000u) ? ~u : (u | 0x80000000u); }
__device__ __forceinline__ void topk_threshold(const unsigned (&k)[32], unsigned& thr, unsigned& need) {
    unsigned prefix = 0u; bool exact = false;
    for (int bit = 31; bit >= 0; --bit) {
        const unsigned cand = prefix | (1u << bit);
        int c = 0;
#pragma unroll
        for (int i = 0; i < 32; ++i) c += (k[i] >= cand) ? 1 : 0;
        c = wave_sum_i(c);
        if (c >= TOPK) prefix = cand;
        if (c == TOPK) { exact = true; break; }
    }
    thr = prefix;
    if (exact) { need = 0xffffffffu; }
    else { int c = 0;
#pragma unroll
        for (int i = 0; i < 32; ++i) c += (k[i] > prefix) ? 1 : 0;
        c = wave_sum_i(c); need = (unsigned)(TOPK - c); }
}
#ifndef PROBE_VALU
#define PROBE_VALU 0
#endif
#ifndef RP_T3
#define RP_T3 1
#endif
#ifndef RP_T1
#define RP_T1 1
#endif
#ifndef RP_T2
#define RP_T2 1
#endif
#ifndef RP_I
#define RP_I 1
#endif
#ifndef RP_T
#define RP_T 1
#endif
#ifndef RP_V
#define RP_V 1
#endif
typedef short bf16x8v __attribute__((ext_vector_type(8)));
typedef short s16x4v __attribute__((ext_vector_type(4)));
constexpr int BMS = 65;
constexpr int SCP = 2052;
constexpr int DSA_BM_OFF = 16 * SCP * 4;
constexpr int DSA_RING_OFF = 0;
constexpr int DSA_QIB_OFF = 147456;
constexpr int DSA_WIB_OFF = 135680;
constexpr int DSA_MLUT_OFF = 143616;
__device__ __forceinline__ void glds16(const void* gsrc, unsigned lds_dst) { unsigned keep;
    asm volatile("s_mov_b32 %0, m0\n\ts_mov_b32 m0, %2\n\ts_nop 0\n\tglobal_load_lds_dwordx4 %1, off\n\ts_mov_b32 m0, %0" : "=&s"(keep) : "v"(gsrc), "s"(lds_dst) : "memory"); }
template <int I> __device__ __forceinline__ unsigned mbit_t(int mw) { unsigned r; asm("v_bfe_i32 %0, %1, %2, 1" : "=v"(r) : "v"(mw), "i"(I)); return r; }
#define mbit(mw, i) mbit_t<(i)>(mw)
__device__ __forceinline__ float relu_i(float x) { return __int_as_float(max(__float_as_int(x), 0)); }
__device__ __forceinline__ int imax3(float a, float b, float c) { return max(max(__float_as_int(a), __float_as_int(b)), __float_as_int(c)); }
__device__ __forceinline__ s16x4v lds_tr16(LAS const unsigned char* p) { return __builtin_bit_cast(s16x4v, __builtin_amdgcn_ds_read_tr16_b64_v4i16((LAS s16x4v*)p)); }
__device__ __forceinline__ unsigned cvtpk(float lo, float hi) { typedef float f2 __attribute__((ext_vector_type(2))); typedef __bf16 b2 __attribute__((ext_vector_type(2))); f2 v = {lo, hi}; b2 r = __builtin_convertvector(v, b2); return __builtin_bit_cast(unsigned, r); }


template <int L> __device__ __forceinline__ void wr2lanes(int& w, unsigned lo, unsigned hi) {
    asm volatile("s_nop 1\n\tv_writelane_b32 %0, %1, %3\n\tv_writelane_b32 %0, %2, %4" : "+v"(w) : "s"(lo), "s"(hi), "i"(L), "i"(L + 1));
}
__device__ __forceinline__ int wave_sum_dpp(int v) {
    v += __builtin_amdgcn_update_dpp(0, v, 0xB1, 0xf, 0xf, true);
    v += __builtin_amdgcn_update_dpp(0, v, 0x4E, 0xf, 0xf, true);
    v += __builtin_amdgcn_update_dpp(0, v, 0x141, 0xf, 0xf, true);
    v += __builtin_amdgcn_update_dpp(0, v, 0x140, 0xf, 0xf, true);
    return __builtin_amdgcn_readlane(v, 0) + __builtin_amdgcn_readlane(v, 16) + __builtin_amdgcn_readlane(v, 32) + __builtin_amdgcn_readlane(v, 48);
}
__device__ __forceinline__ unsigned wave_max_dpp(unsigned v) {
    v = max(v, (unsigned)__builtin_amdgcn_update_dpp(0, (int)v, 0xB1, 0xf, 0xf, true));
    v = max(v, (unsigned)__builtin_amdgcn_update_dpp(0, (int)v, 0x4E, 0xf, 0xf, true));
    v = max(v, (unsigned)__builtin_amdgcn_update_dpp(0, (int)v, 0x141, 0xf, 0xf, true));
    v = max(v, (unsigned)__builtin_amdgcn_update_dpp(0, (int)v, 0x140, 0xf, 0xf, true));
    return max(max((unsigned)__builtin_amdgcn_readlane((int)v, 0), (unsigned)__builtin_amdgcn_readlane((int)v, 16)), max((unsigned)__builtin_amdgcn_readlane((int)v, 32), (unsigned)__builtin_amdgcn_readlane((int)v, 48)));
}
__device__ __forceinline__ int cnt8(int acc, unsigned cand, unsigned k0, unsigned k1, unsigned k2, unsigned k3, unsigned k4, unsigned k5, unsigned k6, unsigned k7) {
    unsigned long long m0, m1, m2, m3, m4, m5, m6, m7;
    asm volatile("v_cmp_le_u32_e64 %1, %9, %10\n\tv_cmp_le_u32_e64 %2, %9, %11\n\tv_cmp_le_u32_e64 %3, %9, %12\n\tv_cmp_le_u32_e64 %4, %9, %13\n\t"
                 "v_cmp_le_u32_e64 %5, %9, %14\n\tv_cmp_le_u32_e64 %6, %9, %15\n\tv_cmp_le_u32_e64 %7, %9, %16\n\tv_cmp_le_u32_e64 %8, %9, %17\n\t"
                 "v_addc_co_u32_e64 %0, %1, 0, %0, %1\n\tv_addc_co_u32_e64 %0, %2, 0, %0, %2\n\tv_addc_co_u32_e64 %0, %3, 0, %0, %3\n\tv_addc_co_u32_e64 %0, %4, 0, %0, %4\n\t"
                 "v_addc_co_u32_e64 %0, %5, 0, %0, %5\n\tv_addc_co_u32_e64 %0, %6, 0, %0, %6\n\tv_addc_co_u32_e64 %0, %7, 0, %0, %7\n\tv_addc_co_u32_e64 %0, %8, 0, %0, %8"
                 : "+v"(acc), "=&s"(m0), "=&s"(m1), "=&s"(m2), "=&s"(m3), "=&s"(m4), "=&s"(m5), "=&s"(m6), "=&s"(m7)
                 : "s"(cand), "v"(k0), "v"(k1), "v"(k2), "v"(k3), "v"(k4), "v"(k5), "v"(k6), "v"(k7));
    return acc;
}
__device__ __forceinline__ int count_ge(const unsigned (&k)[32], unsigned cand_, int nb) {
    const unsigned cand = (unsigned)__builtin_amdgcn_readfirstlane((int)cand_);
    int c = 0;
    c = cnt8(c, cand, k[0], k[1], k[2], k[3], k[4], k[5], k[6], k[7]);
    if (nb > 1) c = cnt8(c, cand, k[8], k[9], k[10], k[11], k[12], k[13], k[14], k[15]);
    if (nb > 2) c = cnt8(c, cand, k[16], k[17], k[18], k[19], k[20], k[21], k[22], k[23]);
    if (nb > 3) c = cnt8(c, cand, k[24], k[25], k[26], k[27], k[28], k[29], k[30], k[31]);
    return wave_sum_dpp(c);
}
__device__ __forceinline__ int wave_scan_dpp(int v) {
    v += __builtin_amdgcn_update_dpp(0, v, 0x111, 0xf, 0xf, false);
    v += __builtin_amdgcn_update_dpp(0, v, 0x112, 0xf, 0xf, false);
    v += __builtin_amdgcn_update_dpp(0, v, 0x114, 0xf, 0xf, false);
    v += __builtin_amdgcn_update_dpp(0, v, 0x118, 0xf, 0xf, false);
    v += __builtin_amdgcn_update_dpp(0, v, 0x142, 0xa, 0xf, false);
    v += __builtin_amdgcn_update_dpp(0, v, 0x143, 0xc, 0xf, false);
    return v;
}
#ifndef WALK_MAX
#define WALK_MAX 4
#endif
#ifndef HIST_WAVES
#define HIST_WAVES 4
#endif
struct TopkState { unsigned prefix; int bit; bool done; unsigned need; int nb; LAS unsigned* hist; int crej; };
__device__ __forceinline__ void topk_hist(const unsigned (&k)[32], TopkState& st, int c_above) {
    const int lane = threadIdx.x & 63;
    const unsigned T = (unsigned)__builtin_amdgcn_readfirstlane((int)st.prefix);
    LAS unsigned* hist = st.hist;
    *(LAS u32x4*)(hist + 4 * lane) = (u32x4){0u, 0u, 0u, 0u};
    asm volatile("" ::: "memory");
    const unsigned hb_ = (unsigned)(uintptr_t)hist; const unsigned one = 1u;
#define HF8(i0) { unsigned t0_; unsigned long long ex_; \
        asm volatile("s_mov_b64 %1, exec\n\t" \
            "v_subrev_u32_e32 %0, %2, %5\n\tv_lshrrev_b32_e32 %0, 15, %0\n\tv_cmpx_gt_u32_e32 vcc, 0x100, %0\n\tv_lshl_add_u32 %0, %0, 2, %3\n\tds_add_u32 %0, %4\n\ts_mov_b64 exec, %1\n\t" \
            "v_subrev_u32_e32 %0, %2, %6\n\tv_lshrrev_b32_e32 %0, 15, %0\n\tv_cmpx_gt_u32_e32 vcc, 0x100, %0\n\tv_lshl_add_u32 %0, %0, 2, %3\n\tds_add_u32 %0, %4\n\ts_mov_b64 exec, %1\n\t" \
            "v_subrev_u32_e32 %0, %2, %7\n\tv_lshrrev_b32_e32 %0, 15, %0\n\tv_cmpx_gt_u32_e32 vcc, 0x100, %0\n\tv_lshl_add_u32 %0, %0, 2, %3\n\tds_add_u32 %0, %4\n\ts_mov_b64 exec, %1\n\t" \
            "v_subrev_u32_e32 %0, %2, %8\n\tv_lshrrev_b32_e32 %0, 15, %0\n\tv_cmpx_gt_u32_e32 vcc, 0x100, %0\n\tv_lshl_add_u32 %0, %0, 2, %3\n\tds_add_u32 %0, %4\n\ts_mov_b64 exec, %1\n\t" \
            "v_subrev_u32_e32 %0, %2, %9\n\tv_lshrrev_b32_e32 %0, 15, %0\n\tv_cmpx_gt_u32_e32 vcc, 0x100, %0\n\tv_lshl_add_u32 %0, %0, 2, %3\n\tds_add_u32 %0, %4\n\ts_mov_b64 exec, %1\n\t" \
            "v_subrev_u32_e32 %0, %2, %10\n\tv_lshrrev_b32_e32 %0, 15, %0\n\tv_cmpx_gt_u32_e32 vcc, 0x100, %0\n\tv_lshl_add_u32 %0, %0, 2, %3\n\tds_add_u32 %0, %4\n\ts_mov_b64 exec, %1\n\t" \
            "v_subrev_u32_e32 %0, %2, %11\n\tv_lshrrev_b32_e32 %0, 15, %0\n\tv_cmpx_gt_u32_e32 vcc, 0x100, %0\n\tv_lshl_add_u32 %0, %0, 2, %3\n\tds_add_u32 %0, %4\n\ts_mov_b64 exec, %1\n\t" \
            "v_subrev_u32_e32 %0, %2, %12\n\tv_lshrrev_b32_e32 %0, 15, %0\n\tv_cmpx_gt_u32_e32 vcc, 0x100, %0\n\tv_lshl_add_u32 %0, %0, 2, %3\n\tds_add_u32 %0, %4\n\ts_mov_b64 exec, %1" \
            : "=&v"(t0_), "=&s"(ex_) : "s"(T), "s"(hb_), "v"(one), "v"(k[i0]), "v"(k[i0 + 1]), "v"(k[i0 + 2]), "v"(k[i0 + 3]), "v"(k[i0 + 4]), "v"(k[i0 + 5]), "v"(k[i0 + 6]), "v"(k[i0 + 7]) : "vcc", "memory"); }
    HF8(0)
    if (st.nb > 1) HF8(8)
    if (st.nb > 2) HF8(16)
    if (st.nb > 3) HF8(24)
#undef HF8
    asm volatile("" ::: "memory");
    const u32x4 w = *(LAS const u32x4*)(hist + 4 * (63 - lane));
    const int t = (int)((w.x + w.y) + (w.z + w.w));
    const int P = wave_scan_dpp(t);
    const int k1 = TOPK - c_above;
    const unsigned long long bal = __ballot(P >= k1);
    const int Ls = __builtin_ctzll(bal);
    int c = __builtin_amdgcn_readlane(P, Ls) - __builtin_amdgcn_readlane(t, Ls);
    const int h3 = __builtin_amdgcn_readlane((int)w.w, Ls), h2 = __builtin_amdgcn_readlane((int)w.z, Ls), h1 = __builtin_amdgcn_readlane((int)w.y, Ls), h0 = __builtin_amdgcn_readlane((int)w.x, Ls);
    int bsel = 3, hb = h3;
    if (c + h3 < k1) { c += h3; bsel = 2; hb = h2; if (c + h2 < k1) { c += h2; bsel = 1; hb = h1; if (c + h1 < k1) { c += h1; bsel = 0; hb = h0; } } }
    const unsigned bin = (unsigned)(4 * (63 - Ls) + bsel);
    st.prefix = T | (bin << 15); st.bit = 14;
    if (c + hb == k1) { st.done = true; st.need = 0xffffffffu; }
}
__device__ __forceinline__ void topk_histA(const unsigned (&k)[32], TopkState& st) {
    const int lane = threadIdx.x & 63;
    LAS unsigned* hist = st.hist;
    *(LAS u32x4*)(hist + 8 * lane) = (u32x4){0u, 0u, 0u, 0u}; *(LAS u32x4*)(hist + 8 * lane + 4) = (u32x4){0u, 0u, 0u, 0u};
    asm volatile("" ::: "memory");
#define HA(i) __hip_atomic_fetch_add(hist + (k[i] >> 23), 1u, __ATOMIC_RELAXED, __HIP_MEMORY_SCOPE_WORKGROUP);
    HA(0) HA(1) HA(2) HA(3) HA(4) HA(5) HA(6) HA(7)
    if (st.nb > 1) { HA(8) HA(9) HA(10) HA(11) HA(12) HA(13) HA(14) HA(15) }
    if (st.nb > 2) { HA(16) HA(17) HA(18) HA(19) HA(20) HA(21) HA(22) HA(23) }
    if (st.nb > 3) { HA(24) HA(25) HA(26) HA(27) HA(28) HA(29) HA(30) HA(31) }
#undef HA
    asm volatile("" ::: "memory");
    const u32x4 w0 = *(LAS const u32x4*)(hist + 8 * (63 - lane)), w1 = *(LAS const u32x4*)(hist + 8 * (63 - lane) + 4);
    const int t = (int)(((w0.x + w0.y) + (w0.z + w0.w)) + ((w1.x + w1.y) + (w1.z + w1.w)));
    const int P = wave_scan_dpp(t);
    const unsigned long long bal = __ballot(P >= TOPK);
    const int Ls = __builtin_ctzll(bal);
    int c = __builtin_amdgcn_readlane(P, Ls) - __builtin_amdgcn_readlane(t, Ls);
    int bsel = 7, hb = 0; bool found = false;
#define WALK(j, word) if (!found) { const int h_ = __builtin_amdgcn_readlane((int)(word), Ls); if (c + h_ >= TOPK) { bsel = (j); hb = h_; found = true; } else c += h_; }
    WALK(7, w1.w) WALK(6, w1.z) WALK(5, w1.y) WALK(4, w1.x) WALK(3, w0.w) WALK(2, w0.z) WALK(1, w0.y) WALK(0, w0.x)
#undef WALK
    const unsigned bucket = (unsigned)(8 * (63 - Ls) + bsel);
    st.prefix = bucket << 23; st.bit = 22; st.crej = c;
    if (c + hb == TOPK) { st.done = true; st.need = 0xffffffffu; }
}
__device__ __forceinline__ void topk_init(const unsigned (&k)[32], TopkState& st) {
    unsigned mx = 0u;
#pragma unroll
    for (int i = 0; i < 32; ++i) mx = max(mx, k[i]);
    mx = wave_max_dpp(mx);
    st.prefix = 0u; st.bit = 31; st.done = false; st.need = 0u; st.crej = 0;
    unsigned E = mx >> 23;
    int cprev = 0;
#pragma unroll 1
    for (int j = 0; j < WALK_MAX; ++j) {
        if (E < (unsigned)j + 1u) break;
        const unsigned T = (E - (unsigned)j) << 23;
        const int c = count_ge(k, T, st.nb);
        if (c >= TOPK) { st.prefix = T; st.bit = 22; if (c == TOPK) { st.done = true; st.need = 0xffffffffu; }
#ifndef NO_TOPK_HIST
#ifdef PROBE_HIST2
            else if (st.hist) { TopkState sv = st; topk_hist(k, st, cprev); asm volatile("" :: "s"(st.prefix) : "memory"); st = sv; topk_hist(k, st, cprev); }
#else
            else if (st.hist) topk_hist(k, st, cprev);
#endif
#endif
            break; }
        cprev = c;
    }
#ifdef HISTA_FALLBACK
    if (st.bit == 31 && st.hist) { topk_histA(k, st); if (!st.done) topk_hist(k, st, st.crej); }
#endif
}
__device__ __forceinline__ void topk_step(const unsigned (&k)[32], TopkState& st) {
    if (st.done) return;
    if (st.bit < 0) { int c = 0;
#pragma unroll
        for (int i = 0; i < 32; ++i) c += (k[i] > st.prefix) ? 1 : 0;
        c = wave_sum_dpp(c); st.need = (unsigned)(TOPK - c); st.done = true; return; }
    const unsigned cand = st.prefix | (1u << st.bit);
    const int c = count_ge(k, cand, st.nb);
    if (c >= TOPK) st.prefix = cand; else st.crej = c;
    if (c == TOPK) { st.done = true; st.need = 0xffffffffu; }
    --st.bit;
#ifndef NO_TOPK_HIST
    if (st.bit == 22 && !st.done && st.hist) topk_hist(k, st, st.crej);
#endif
}

__device__ __forceinline__ void dsa_prefetch_qi(const bf16* zb, int qt, LAS unsigned char* lds, int wave, int lane) {
    const unsigned lds_base = (unsigned)(uintptr_t)lds;
#pragma unroll
    for (int i = 0; i < 2; ++i) { const int row = 2 * wave + i;
        glds16(zb + (size_t)(qt * 16 + row) * ZP + C_QI + ((lane ^ row) * 8), (unsigned)__builtin_amdgcn_readfirstlane(lds_base + DSA_QIB_OFF + row * 1024)); }
    if (wave == 0) glds16(zb + (size_t)(qt * 16 + (lane & 15)) * ZP + C_WI, (unsigned)__builtin_amdgcn_readfirstlane(lds_base + DSA_WIB_OFF));
}

__device__ __forceinline__ void dsa_prefetch_ki(const bf16* zb, int qt, bf16x8v (&pk)[4], int wave, int lane) {
    const int r16 = lane & 15, g = lane >> 4;
    if (wave <= qt) { const bf16* krow = zb + (size_t)(wave * 16 + r16) * ZP + C_KI; pk[0] = *(const bf16x8v*)(krow + 8 * g); pk[1] = *(const bf16x8v*)(krow + 32 + 8 * g); }
    if (wave + 8 <= qt) { const bf16* krow = zb + (size_t)((wave + 8) * 16 + r16) * ZP + C_KI; pk[2] = *(const bf16x8v*)(krow + 8 * g); pk[3] = *(const bf16x8v*)(krow + 32 + 8 * g); }
}

__device__ __forceinline__ void dsa_unit(const P& p, int b, int qt, int qt_next, bf16x8v (&pk)[4], LAS unsigned char* lds) {
    const int tid = threadIdx.x, lane = tid & 63, wave = __builtin_amdgcn_readfirstlane(tid >> 6), r16 = lane & 15, g = lane >> 4;
    const int q0 = qt * 16; const bf16* zb = p.Z + (size_t)b * SEQ * ZP;
    LAS float* SC = (LAS float*)lds; LAS unsigned* BM = (LAS unsigned*)(lds + DSA_BM_OFF);
    const bool dense_all = (qt < TOPK / 16);
    const bf16* qrow = zb + (size_t)(q0 + r16) * ZP;
    const bf16x8v bq0 = *(const bf16x8v*)(qrow + C_Q + wave * 64 + 8 * g), bq1 = *(const bf16x8v*)(qrow + C_Q + wave * 64 + 32 + 8 * g);
    u32x2 gwv[4];
#pragma unroll
    for (int dt = 0; dt < 4; ++dt) gwv[dt] = *(const u32x2*)(qrow + C_GA + wave * 64 + dt * 16 + 4 * g);
    const int nsteps = (((q0 + 16 + 31) >> 5) + 1) & ~1, nmega = (nsteps + 7) >> 3;
    const int kkey = lane >> 3, vkey = lane >> 1, vhalf = lane & 1;
    const unsigned lds_base = (unsigned)(uintptr_t)lds;
#define DSA_STAGE(mm) do { const int st_ = (mm) * 8 + wave; if (st_ < nsteps) { \
        const bf16* kb_ = zb + (size_t)st_ * 32 * ZP; const unsigned ldsb_ = lds_base + (unsigned)(((mm) & 1) * 65536 + wave * 4096); \
        _Pragma("unroll") for (int c_ = 0; c_ < 4; ++c_) { const int key_ = 8 * c_ + kkey, ch_ = (lane & 7) ^ ((key_ & 15) >> 1); \
            glds16(kb_ + (size_t)key_ * ZP + C_K + ch_ * 8, (unsigned)__builtin_amdgcn_readfirstlane(ldsb_ + c_ * 1024)); } \
        _Pragma("unroll") for (int c_ = 0; c_ < 4; ++c_) \
            glds16(kb_ + (size_t)vkey * ZP + C_V + c_ * 16 + vhalf * 8, (unsigned)__builtin_amdgcn_readfirstlane(ldsb_ + 32768 + c_ * 1024)); } } while (0)
    if (!dense_all) {
        for (int rpI = 0; rpI < RP_I; ++rpI) {
        bf16x8v bq[8][2]; float wv[8];
#pragma unroll
        for (int h = 0; h < 8; ++h) { bq[h][0] = *(LAS const bf16x8v*)(lds + DSA_QIB_OFF + r16 * 1024 + (((8 * h + g) ^ r16) * 16)); bq[h][1] = *(LAS const bf16x8v*)(lds + DSA_QIB_OFF + r16 * 1024 + (((8 * h + 4 + g) ^ r16) * 16));
            wv[h] = bf2f(*(LAS const bf16*)(lds + DSA_WIB_OFF + r16 * 16 + h * 2)) * 0.35355339059327373f * 0.125f; }
        bf16x8v ra0 = pk[0], ra1 = pk[1], rb0 = pk[2], rb1 = pk[3], rc0 = pk[0], rc1 = pk[1];
#define IDX_LOAD(d0, d1, ktl) do { const int ktl_ = (ktl) <= qt ? (ktl) : qt;        \
            const bf16* krow_ = zb + (size_t)(ktl_ * 16 + r16) * ZP + C_KI; d0 = *(const bf16x8v*)(krow_ + 8 * g); d1 = *(const bf16x8v*)(krow_ + 32 + 8 * g); } while (0)
#define IDX_STEP(c0, c1) do { \
            f32x4 sc = {0.f, 0.f, 0.f, 0.f}; \
            _Pragma("unroll") for (int h = 0; h < 8; ++h) { \
                f32x4 acc = {0.f, 0.f, 0.f, 0.f}; \
                acc = __builtin_amdgcn_mfma_f32_16x16x32_bf16(c0, bq[h][0], acc, 0, 0, 0); \
                acc = __builtin_amdgcn_mfma_f32_16x16x32_bf16(c1, bq[h][1], acc, 0, 0, 0); \
                _Pragma("unroll") for (int i = 0; i < 4; ++i) sc[i] += relu_i(acc[i]) * wv[h]; \
            } \
            if (__builtin_amdgcn_readfirstlane(kt) == qt) {                  \
                _Pragma("unroll") for (int i = 0; i < 4; ++i) sc[i] = (4 * g + i > r16) ? -INFINITY : sc[i]; \
            } \
            *(LAS f32x4*)(SC + r16 * SCP + kt * 16 + 4 * g) = sc; } while (0)
        int kt = wave;
        const int nst = (qt - wave + 8) >> 3;
        const int ntrip = (nst * 11) >> 5, rem = nst - 3 * ntrip;
#pragma unroll 1
        for (int it = ntrip; it > 0; --it) {
            IDX_LOAD(rc0, rc1, kt + 16); __builtin_amdgcn_sched_barrier(0); IDX_STEP(ra0, ra1); __builtin_amdgcn_sched_barrier(0); kt += 8;
            IDX_LOAD(ra0, ra1, kt + 16); __builtin_amdgcn_sched_barrier(0); IDX_STEP(rb0, rb1); __builtin_amdgcn_sched_barrier(0); kt += 8;
            IDX_LOAD(rb0, rb1, kt + 16); __builtin_amdgcn_sched_barrier(0); IDX_STEP(rc0, rc1); __builtin_amdgcn_sched_barrier(0); kt += 8;
        }
        if (rem >= 1) { IDX_STEP(ra0, ra1); kt += 8; if (rem >= 2) { IDX_STEP(rb0, rb1); } }
#undef IDX_LOAD
#undef IDX_STEP
        __syncthreads();
        }
#pragma unroll 1
        for (int rpT = 0; rpT < RP_T; ++rpT) {
            const int ra = 2 * wave, rb = 2 * wave + 1, ta = q0 + ra, tb = q0 + rb;
            unsigned ka[32], kb[32];
#pragma unroll
            for (int i = 0; i < 32; ++i) { const int key = lane + 64 * i; ka[i] = (key <= ta) ? score_ukey(SC[ra * SCP + key]) : 0u; kb[i] = (key <= tb) ? score_ukey(SC[rb * SCP + key]) : 0u; }
#if RP_T1 > 1
            asm volatile("" :: "v"(ka[0]), "v"(kb[31]) : "memory");
#pragma unroll
            for (int i = 0; i < 32; ++i) { const int key = lane + 64 * i; ka[i] = (key <= ta) ? score_ukey(SC[ra * SCP + key]) : 0u; kb[i] = (key <= tb) ? score_ukey(SC[rb * SCP + key]) : 0u; }
            asm volatile("" ::: "memory");
#endif
            asm volatile("s_waitcnt lgkmcnt(0)" ::: "memory");
            __syncthreads();
            DSA_STAGE(0);
            TopkState sa, sb; sa.nb = (ta >> 9) + 1; sb.nb = (tb >> 9) + 1;
            sa.hist = (wave < HIST_WAVES) ? (LAS unsigned*)(lds + 65536 + ra * 2048) : (LAS unsigned*)nullptr; sb.hist = (wave < HIST_WAVES) ? (LAS unsigned*)(lds + 65536 + rb * 2048) : (LAS unsigned*)nullptr;
            topk_init(ka, sa); topk_init(kb, sb);
#pragma unroll 1
            while (!(sa.done && sb.done)) { topk_step(ka, sa); topk_step(kb, sb); }
#if RP_T2 > 1
            asm volatile("" :: "v"(sa.prefix), "v"(sb.prefix));
            topk_init(ka, sa); topk_init(kb, sb);
#pragma unroll 1
            while (!(sa.done && sb.done)) { topk_step(ka, sa); topk_step(kb, sb); }
#endif
            if (sa.need == 0xffffffffu && sb.need == 0xffffffffu) {
                const unsigned ta_ = (unsigned)__builtin_amdgcn_readfirstlane((int)sa.prefix), tb_ = (unsigned)__builtin_amdgcn_readfirstlane((int)sb.prefix);
                int wa = 0, wb = 0;
#define WR2(i) { const unsigned long long ma = __ballot(ka[i] >= ta_), mb = __ballot(kb[i] >= tb_); wr2lanes<2 * (i)>(wa, (unsigned)ma, (unsigned)(ma >> 32)); wr2lanes<2 * (i)>(wb, (unsigned)mb, (unsigned)(mb >> 32)); }
                WR2(0) WR2(1) WR2(2) WR2(3) WR2(4) WR2(5) WR2(6) WR2(7) WR2(8) WR2(9) WR2(10) WR2(11) WR2(12) WR2(13) WR2(14) WR2(15)
                WR2(16) WR2(17) WR2(18) WR2(19) WR2(20) WR2(21) WR2(22) WR2(23) WR2(24) WR2(25) WR2(26) WR2(27) WR2(28) WR2(29) WR2(30) WR2(31)
#undef WR2
                BM[ra * BMS + lane] = (unsigned)wa; BM[rb * BMS + lane] = (unsigned)wb;
#if RP_T3 > 1
                asm volatile("" : "+v"(wa), "+v"(wb) :: "memory");
#define WR2(i) { const unsigned long long ma = __ballot(ka[i] >= ta_), mb = __ballot(kb[i] >= tb_); wr2lanes<2 * (i)>(wa, (unsigned)ma, (unsigned)(ma >> 32)); wr2lanes<2 * (i)>(wb, (unsigned)mb, (unsigned)(mb >> 32)); }
                WR2(0) WR2(1) WR2(2) WR2(3) WR2(4) WR2(5) WR2(6) WR2(7) WR2(8) WR2(9) WR2(10) WR2(11) WR2(12) WR2(13) WR2(14) WR2(15)
                WR2(16) WR2(17) WR2(18) WR2(19) WR2(20) WR2(21) WR2(22) WR2(23) WR2(24) WR2(25) WR2(26) WR2(27) WR2(28) WR2(29) WR2(30) WR2(31)
#undef WR2
                BM[ra * BMS + lane] = (unsigned)wa; BM[rb * BMS + lane] = (unsigned)wb;
#endif
            } else {
            unsigned eqa = 0u, eqb = 0u;
#pragma unroll 1
            for (int i = 0; i < 32; ++i) {
                unsigned kai = ka[0], kbi = kb[0];
#pragma unroll
                for (int j = 1; j < 32; ++j) { kai = (i == j) ? ka[j] : kai; kbi = (i == j) ? kb[j] : kbi; }
                { const bool eq = (kai == sa.prefix); const unsigned long long em = __ballot(eq);
                  const unsigned erank = eqa + __builtin_amdgcn_mbcnt_hi((unsigned)(em >> 32), __builtin_amdgcn_mbcnt_lo((unsigned)em, 0u));
                  const unsigned long long smk = __ballot((kai > sa.prefix) || (eq && erank < sa.need));
                  if (lane == 0) { BM[ra * BMS + 2 * i] = (unsigned)smk; BM[ra * BMS + 2 * i + 1] = (unsigned)(smk >> 32); }
                  eqa += (unsigned)__popcll(em); }
                { const bool eq = (kbi == sb.prefix); const unsigned long long em = __ballot(eq);
                  const unsigned erank = eqb + __builtin_amdgcn_mbcnt_hi((unsigned)(em >> 32), __builtin_amdgcn_mbcnt_lo((unsigned)em, 0u));
                  const unsigned long long smk = __ballot((kbi > sb.prefix) || (eq && erank < sb.need));
                  if (lane == 0) { BM[rb * BMS + 2 * i] = (unsigned)smk; BM[rb * BMS + 2 * i + 1] = (unsigned)(smk >> 32); }
                  eqb += (unsigned)__popcll(em); }
            }
            }
        }
    } else {
        for (int i = tid; i < 1024; i += 512) { const int row = i >> 6, w = i & 63, t = q0 + row, lo = 32 * w;
            BM[row * BMS + w] = (t >= lo + 31) ? 0xffffffffu : ((t < lo) ? 0u : ((2u << (t - lo)) - 1u)); }
        DSA_STAGE(0);
    }
    __syncthreads();
    const int h = wave;
#pragma unroll 1
    for (int rpV = 0; rpV < RP_V; ++rpV) {
    asm volatile("s_waitcnt vmcnt(0)" ::: "memory");
    asm volatile("" :: "v"(bq0), "v"(bq1), "v"(gwv[0]), "v"(gwv[1]), "v"(gwv[2]), "v"(gwv[3]));
    __syncthreads();
    if (qt_next >= TOPK / 16) { dsa_prefetch_qi(zb, qt_next, lds, wave, lane); dsa_prefetch_ki(zb, qt_next, pk, wave, lane); }
    f32x4 o[4], lacc = {0.f, 0.f, 0.f, 0.f}, negm = {0.f, 0.f, 0.f, 0.f};
#pragma unroll
    for (int dt = 0; dt < 4; ++dt) o[dt] = (f32x4){0.f, 0.f, 0.f, 0.f};
    float m_run = 0.f;
    const int kofs0 = r16 * 128 + ((g ^ (r16 >> 1)) & 7) * 16, kofs1 = r16 * 128 + (((4 + g) ^ (r16 >> 1)) & 7) * 16;
    const int vofs = 32768 + (4 * g + ((lane & 15) >> 2)) * 32 + (lane & 3) * 8;
    bf16x8v ones = {0x3f80, 0x3f80, 0x3f80, 0x3f80, 0x3f80, 0x3f80, 0x3f80, 0x3f80};
    asm volatile("" : "+v"(ones));
    LAS const unsigned char* mlut = lds + DSA_MLUT_OFF;
    constexpr float THR = 8.0f;
    bool first = true;
#pragma unroll 1
    for (int mm = 0; mm < nmega; ++mm) {
        if (mm + 1 < nmega) DSA_STAGE(mm + 1);
        LAS unsigned char* slotb = lds + (mm & 1) * 65536;
        const int nsub = (nsteps - mm * 8) < 8 ? (nsteps - mm * 8) : 8;
#pragma unroll 1
        for (int u = 0; u < nsub; u += 2) {
            LAS unsigned char* slot = slotb + u * 4096;
            const int mwA = (int)(BM[r16 * BMS + mm * 8 + u] >> (4 * g)), mwB = (int)(BM[r16 * BMS + mm * 8 + u + 1] >> (4 * g));
            f32x4 s0, s1, s2, s3;
            { const bf16x8v ka0 = *(LAS const bf16x8v*)(slot + kofs0), ka1 = *(LAS const bf16x8v*)(slot + kofs1);
              const bf16x8v kb0 = *(LAS const bf16x8v*)(slot + 2048 + kofs0), kb1 = *(LAS const bf16x8v*)(slot + 2048 + kofs1);
              const bf16x8v kc0 = *(LAS const bf16x8v*)(slot + 4096 + kofs0), kc1 = *(LAS const bf16x8v*)(slot + 4096 + kofs1);
              const bf16x8v kd0 = *(LAS const bf16x8v*)(slot + 6144 + kofs0), kd1 = *(LAS const bf16x8v*)(slot + 6144 + kofs1);
              s0 = __builtin_amdgcn_mfma_f32_16x16x32_bf16(ka0, bq0, negm, 0, 0, 0); s1 = __builtin_amdgcn_mfma_f32_16x16x32_bf16(kb0, bq0, negm, 0, 0, 0);
              s2 = __builtin_amdgcn_mfma_f32_16x16x32_bf16(kc0, bq0, negm, 0, 0, 0); s3 = __builtin_amdgcn_mfma_f32_16x16x32_bf16(kd0, bq0, negm, 0, 0, 0);
              s0 = __builtin_amdgcn_mfma_f32_16x16x32_bf16(ka1, bq1, s0, 0, 0, 0); s1 = __builtin_amdgcn_mfma_f32_16x16x32_bf16(kb1, bq1, s1, 0, 0, 0);
              s2 = __builtin_amdgcn_mfma_f32_16x16x32_bf16(kc1, bq1, s2, 0, 0, 0); s3 = __builtin_amdgcn_mfma_f32_16x16x32_bf16(kd1, bq1, s3, 0, 0, 0); }
            const int lmi = max(max(max(imax3(s0[0], s0[1], s0[2]), imax3(s0[3], s1[0], s1[1])), max(imax3(s1[2], s1[3], s2[0]), imax3(s2[1], s2[2], s2[3]))), max(imax3(s3[0], s3[1], s3[2]), __float_as_int(s3[3])));
            if (first || __any(lmi > 0x41000000)) {
                float lmx = fmaxf(fmaxf(fmaxf(fmaxf(s0[0], s0[1]), fmaxf(s0[2], s0[3])), fmaxf(fmaxf(s1[0], s1[1]), fmaxf(s1[2], s1[3]))), fmaxf(fmaxf(fmaxf(s2[0], s2[1]), fmaxf(s2[2], s2[3])), fmaxf(fmaxf(s3[0], s3[1]), fmaxf(s3[2], s3[3]))));
                { const auto r1 = __builtin_amdgcn_permlane16_swap(__float_as_uint(lmx), __float_as_uint(lmx), false, false); lmx = fmaxf(__uint_as_float(r1[0]), __uint_as_float(r1[1])); }
                { const auto r2 = __builtin_amdgcn_permlane32_swap(__float_as_uint(lmx), __float_as_uint(lmx), false, false); lmx = fmaxf(__uint_as_float(r2[0]), __uint_as_float(r2[1])); }
                const float dl = first ? lmx : fmaxf(lmx, 0.f);
                m_run += dl; const float f = first ? 1.0f : __builtin_amdgcn_exp2f(-dl);
#pragma unroll
                for (int i = 0; i < 4; ++i) { s0[i] -= dl; s1[i] -= dl; s2[i] -= dl; s3[i] -= dl; negm[i] = -m_run; }
                lacc = lacc * f;
#pragma unroll
                for (int dt = 0; dt < 4; ++dt) o[dt] = o[dt] * f;
                first = false;
            }
            const u32x2 mk0 = *(LAS const u32x2*)(mlut + ((mwA & 15) << 3)), mk1 = *(LAS const u32x2*)(mlut + (((mwA >> 16) & 15) << 3));
            const u32x2 mk2 = *(LAS const u32x2*)(mlut + ((mwB & 15) << 3)), mk3 = *(LAS const u32x2*)(mlut + (((mwB >> 16) & 15) << 3));
            u32x4 pwA, pwB;
            pwA.x = cvtpk(__builtin_amdgcn_exp2f(s0[0]), __builtin_amdgcn_exp2f(s0[1])) & mk0.x; pwA.y = cvtpk(__builtin_amdgcn_exp2f(s0[2]), __builtin_amdgcn_exp2f(s0[3])) & mk0.y;
            pwA.z = cvtpk(__builtin_amdgcn_exp2f(s1[0]), __builtin_amdgcn_exp2f(s1[1])) & mk1.x; pwA.w = cvtpk(__builtin_amdgcn_exp2f(s1[2]), __builtin_amdgcn_exp2f(s1[3])) & mk1.y;
            pwB.x = cvtpk(__builtin_amdgcn_exp2f(s2[0]), __builtin_amdgcn_exp2f(s2[1])) & mk2.x; pwB.y = cvtpk(__builtin_amdgcn_exp2f(s2[2]), __builtin_amdgcn_exp2f(s2[3])) & mk2.y;
            pwB.z = cvtpk(__builtin_amdgcn_exp2f(s3[0]), __builtin_amdgcn_exp2f(s3[1])) & mk3.x; pwB.w = cvtpk(__builtin_amdgcn_exp2f(s3[2]), __builtin_amdgcn_exp2f(s3[3])) & mk3.y;
            const bf16x8v pfA = __builtin_bit_cast(bf16x8v, pwA), pfB = __builtin_bit_cast(bf16x8v, pwB);
            lacc = __builtin_amdgcn_mfma_f32_16x16x32_bf16(ones, pfA, lacc, 0, 0, 0);
            lacc = __builtin_amdgcn_mfma_f32_16x16x32_bf16(ones, pfB, lacc, 0, 0, 0);
#pragma unroll
            for (int dt = 0; dt < 4; ++dt) {
                const s16x4v lo = lds_tr16(slot + vofs + dt * 1024), hi = lds_tr16(slot + vofs + dt * 1024 + 512);
                const s16x4v lo2 = lds_tr16(slot + 4096 + vofs + dt * 1024), hi2 = lds_tr16(slot + 4096 + vofs + dt * 1024 + 512);
                const bf16x8v vf = {lo[0], lo[1], lo[2], lo[3], hi[0], hi[1], hi[2], hi[3]};
                const bf16x8v vf2 = {lo2[0], lo2[1], lo2[2], lo2[3], hi2[0], hi2[1], hi2[2], hi2[3]};
                o[dt] = __builtin_amdgcn_mfma_f32_16x16x32_bf16(vf, pfA, o[dt], 0, 0, 0);
                o[dt] = __builtin_amdgcn_mfma_f32_16x16x32_bf16(vf2, pfB, o[dt], 0, 0, 0);
            }
        }
        asm volatile("s_waitcnt vmcnt(0) lgkmcnt(0)" ::: "memory");
        __syncthreads();
    }
#undef DSA_STAGE
    const float inv = 1.0f / lacc[0];
    bf16* yrow = p.Y + ((size_t)b * SEQ + q0 + r16) * DM + 512 + h * 64;
#pragma unroll
    for (int dt = 0; dt < 4; ++dt) {
        const u32x2 gw = gwv[dt];
        const float g0 = __uint_as_float(gw.x << 16), g1 = __uint_as_float(gw.x & 0xffff0000u), g2 = __uint_as_float(gw.y << 16), g3 = __uint_as_float(gw.y & 0xffff0000u);
        u32x2 w; w.x = pk2(o[dt][0] * inv * siluf(g0), o[dt][1] * inv * siluf(g1)); w.y = pk2(o[dt][2] * inv * siluf(g2), o[dt][3] * inv * siluf(g3));
        *(u32x2*)(yrow + dt * 16 + 4 * g) = w;
    }
    __syncthreads();
    }
}
__device__ __forceinline__ int dsa_qt_of(int j, int i) { return (i == 0) ? 127 - j : (i == 1) ? 64 + j : (i == 2) ? 63 - j : j; }
__device__ __forceinline__ void dsa_phase_pre(const P& p, LAS unsigned char* lds, bf16x8v (&pk)[4]) {
    const int G = gridDim.x, wg = blockIdx.x, lane = threadIdx.x & 63, wave = __builtin_amdgcn_readfirstlane(threadIdx.x >> 6);
    const int b = (G == 256) ? (wg & 7) : (wg >> 7), qt = (G == 256) ? dsa_qt_of(wg >> 3, 0) : 127 - (wg & 127);
#pragma unroll
    for (int i = 0; i < 4; ++i) pk[i] = (bf16x8v){0, 0, 0, 0, 0, 0, 0, 0};
    if (wg < 1024 && qt >= TOPK / 16) { dsa_prefetch_qi(p.Z + (size_t)b * SEQ * ZP, qt, lds, wave, lane); dsa_prefetch_ki(p.Z + (size_t)b * SEQ * ZP, qt, pk, wave, lane); }
}
__device__ __forceinline__ void dsa_phase(const P& p, LAS unsigned char* lds, bf16x8v (&pk)[4]) {
    const int G = gridDim.x, wg = blockIdx.x;
    if (G == 256) {
        const int b = wg & 7, j = wg >> 3;
#pragma unroll 1
        for (int i = 0; i < 4; ++i) dsa_unit(p, b, dsa_qt_of(j, i), (i < 3) ? dsa_qt_of(j, i + 1) : -1, pk, lds);
    }
}
constexpr int LRU_WS_OFF = 139264;
constexpr int LRU_XB = 264 * 128;
constexpr int LRU_GB = 256 * 32;
constexpr int LRU_BUF = LRU_XB + LRU_GB;
__device__ __forceinline__ float fast_sigm(float x) { return __builtin_amdgcn_rcpf(1.0f + __expf(-x)); }
__device__ __forceinline__ void lru_unit(const P& p, int l, int b, int blk, int q4, LAS unsigned char* lds) {
    const int tid = threadIdx.x, lane = tid & 63, wave = __builtin_amdgcn_readfirstlane(tid >> 6), r16 = lane & 15, g = lane >> 4;
    const bf16* zb = p.Z + (size_t)b * SEQ * ZP;
    const int cA = blk * 64, dloc = q4 * 16 + r16, dg = blk * 64 + dloc;
    const unsigned lds_base = (unsigned)(uintptr_t)lds;
#define LRU_STAGE(r) do { const unsigned bb_ = lds_base + (unsigned)(((r) & 1) * LRU_BUF); \
        _Pragma("unroll") for (int i_ = 0; i_ < 5; ++i_) { const int pc_ = wave + 8 * i_; if (pc_ < 33) { const int rho_ = pc_ * 8 + (lane >> 3); int t_ = (r) * 256 - 3 + rho_; t_ = t_ < 0 ? 0 : (t_ > SEQ - 1 ? SEQ - 1 : t_); \
            const int ch_ = (lane & 7) ^ ((rho_ >> 1) & 7); glds16(zb + (size_t)t_ * ZP + C_XR + cA + ch_ * 8, (unsigned)__builtin_amdgcn_readfirstlane(bb_ + pc_ * 1024)); } } \
        { const int row_ = wave * 32 + (lane >> 1); glds16(zb + (size_t)((r) * 256 + row_) * ZP + C_GR + dg - r16 + (lane & 1) * 8, (unsigned)__builtin_amdgcn_readfirstlane(bb_ + LRU_XB + wave * 1024)); } } while (0)
    LRU_STAGE(0);
    float cwA[2][4][8], cbA[2][8];
#pragma unroll
    for (int s = 0; s < 2; ++s)
#pragma unroll
        for (int j = 0; j < 8; ++j) { const int c = cA + 32 * s + 8 * g + j; cbA[s][j] = p.conv_b[l * 512 + c];
#pragma unroll
            for (int k = 0; k < 4; ++k) cwA[s][k][j] = p.conv_w[(l * 4 + k) * 512 + c]; }
    bf16x8v bxf[2], baf[2];
#pragma unroll
    for (int s = 0; s < 2; ++s) { u32x4 wx, wa; unsigned tx[8], ta[8];
#pragma unroll
        for (int j = 0; j < 8; ++j) { const size_t idx = (((size_t)l * 8 + blk) * 64 + 32 * s + 8 * g + j) * 64 + dloc; tx[j] = f2bf(p.lru_wx[idx]); ta[j] = f2bf(p.lru_wa[idx]); }
        wx.x = tx[0] | (tx[1] << 16); wx.y = tx[2] | (tx[3] << 16); wx.z = tx[4] | (tx[5] << 16); wx.w = tx[6] | (tx[7] << 16);
        wa.x = ta[0] | (ta[1] << 16); wa.y = ta[2] | (ta[3] << 16); wa.z = ta[4] | (ta[5] << 16); wa.w = ta[6] | (ta[7] << 16);
        bxf[s] = __builtin_bit_cast(bf16x8v, wx); baf[s] = __builtin_bit_cast(bf16x8v, wa); }
    const float cw0 = p.conv_w[(l * 4 + 0) * 512 + dg], cw1 = p.conv_w[(l * 4 + 1) * 512 + dg], cw2 = p.conv_w[(l * 4 + 2) * 512 + dg], cw3 = p.conv_w[(l * 4 + 3) * 512 + dg];
    const float cb = p.conv_b[l * 512 + dg], bxv = p.lru_bx[l * 512 + dg], bav = p.lru_ba[l * 512 + dg];
    const float sp8 = -8.0f * log1pf(expf(-p.lru_a[l * 512 + dg]));
    asm volatile("" :: "v"(cwA[0][0][0]), "v"(cwA[1][3][7]), "v"(cbA[1][7]), "v"(bxf[0]), "v"(bxf[1]), "v"(baf[0]), "v"(baf[1]), "v"(cw0), "v"(cw1), "v"(cw2), "v"(cw3), "v"(cb), "v"(bxv), "v"(bav), "v"(sp8));
    LAS float* WS = (LAS float*)(lds + LRU_WS_OFF);
    float hrun = 0.f;
    asm volatile("s_waitcnt vmcnt(0)" ::: "memory");
#pragma unroll 1
    for (int round = 0; round < 8; ++round) {
        asm volatile("s_waitcnt vmcnt(8)" ::: "memory");
        __syncthreads();
        if (round + 1 < 8) LRU_STAGE(round + 1);
        LAS const unsigned char* xb = lds + (round & 1) * LRU_BUF; LAS const unsigned char* gb = xb + LRU_XB;
        const int tw = round * 256 + wave * 32;
        float hl[2][4], pl[2][4], gr4[2][4], PT[2], HT[2], PE[2], HE[2];
#pragma unroll
        for (int tau = 0; tau < 2; ++tau) {
            const int t0 = tw + 16 * tau, rho0 = wave * 32 + 16 * tau;
            bf16x8v af[2];
#pragma unroll
            for (int s = 0; s < 2; ++s) {
                float xc[8];
#pragma unroll
                for (int j = 0; j < 8; ++j) xc[j] = cbA[s][j];
#pragma unroll
                for (int k = 0; k < 4; ++k) { const int rho = rho0 + r16 + k; u32x4 w = *(LAS const u32x4*)(xb + rho * 128 + (((4 * s + g) ^ (rho >> 1)) & 7) * 16);
                    if (t0 + r16 - 3 + k < 0) w = (u32x4){0u, 0u, 0u, 0u};
                    xc[0] += cwA[s][k][0] * __uint_as_float(w.x << 16); xc[1] += cwA[s][k][1] * __uint_as_float(w.x & 0xffff0000u);
                    xc[2] += cwA[s][k][2] * __uint_as_float(w.y << 16); xc[3] += cwA[s][k][3] * __uint_as_float(w.y & 0xffff0000u);
                    xc[4] += cwA[s][k][4] * __uint_as_float(w.z << 16); xc[5] += cwA[s][k][5] * __uint_as_float(w.z & 0xffff0000u);
                    xc[6] += cwA[s][k][6] * __uint_as_float(w.w << 16); xc[7] += cwA[s][k][7] * __uint_as_float(w.w & 0xffff0000u); }
                u32x4 pw; pw.x = cvtpk(xc[0], xc[1]); pw.y = cvtpk(xc[2], xc[3]); pw.z = cvtpk(xc[4], xc[5]); pw.w = cvtpk(xc[6], xc[7]);
                af[s] = __builtin_bit_cast(bf16x8v, pw);
            }
            f32x4 gx = {0.f, 0.f, 0.f, 0.f}, ga = {0.f, 0.f, 0.f, 0.f};
            gx = __builtin_amdgcn_mfma_f32_16x16x32_bf16(af[0], bxf[0], gx, 0, 0, 0); gx = __builtin_amdgcn_mfma_f32_16x16x32_bf16(af[1], bxf[1], gx, 0, 0, 0);
            ga = __builtin_amdgcn_mfma_f32_16x16x32_bf16(af[0], baf[0], ga, 0, 0, 0); ga = __builtin_amdgcn_mfma_f32_16x16x32_bf16(af[1], baf[1], ga, 0, 0, 0);
            float xo[7];
#pragma unroll
            for (int m = 0; m < 7; ++m) { const int rho = rho0 + 4 * g + m;
                const unsigned short v = *(LAS const unsigned short*)(xb + rho * 128 + (((dloc >> 3) ^ (rho >> 1)) & 7) * 16 + (dloc & 7) * 2);
                xo[m] = (t0 + 4 * g - 3 + m >= 0) ? bf2f(v) : 0.f; }
            float Pr = 1.f, Hr = 0.f;
#pragma unroll
            for (int i = 0; i < 4; ++i) {
                const float xcv = cb + cw0 * xo[i] + cw1 * xo[i + 1] + cw2 * xo[i + 2] + cw3 * xo[i + 3];
                const float sx = fast_sigm(gx[i] + bxv), sa = fast_sigm(ga[i] + bav);
                const float la = sp8 * sa, a = __expf(la), y2 = 2.0f * la;
                const float ser = -y2 * (1.0f + y2 * (0.5f + y2 * (0.16666667f + y2 * (0.041666668f + y2 * (0.0083333338f + y2 * 0.0013888889f)))));
                const float em = (y2 > -0.25f) ? ser : (1.0f - __expf(y2));
                const float u = __builtin_amdgcn_sqrtf(em) * sx * xcv;
                Hr = a * Hr + u; Pr *= a; hl[tau][i] = Hr; pl[tau][i] = Pr;
                gr4[tau][i] = bf2f(*(LAS const unsigned short*)(gb + (rho0 + 4 * g + i) * 32 + r16 * 2));
            }
            float Pi = Pr, Hi = Hr;
            { const float Pl = __shfl_up(Pi, 16), Hl = __shfl_up(Hi, 16); if (g >= 1) { Hi = Pi * Hl + Hi; Pi = Pl * Pi; } }
            { const float Pl = __shfl_up(Pi, 32), Hl = __shfl_up(Hi, 32); if (g >= 2) { Hi = Pi * Hl + Hi; Pi = Pl * Pi; } }
            float Pe = __shfl_up(Pi, 16), He = __shfl_up(Hi, 16); if (g == 0) { Pe = 1.f; He = 0.f; }
            PT[tau] = __shfl(Pi, 48 + r16); HT[tau] = __shfl(Hi, 48 + r16); PE[tau] = Pe; HE[tau] = He;
        }
        HE[1] = PE[1] * HT[0] + HE[1]; PE[1] = PT[0] * PE[1];
        const float Pw = PT[0] * PT[1], Hw = PT[1] * HT[0] + HT[1];
        LAS float* wsr = WS + (round & 1) * 256;
        if (g == 0) { wsr[(wave * 16 + r16) * 2 + 0] = Pw; wsr[(wave * 16 + r16) * 2 + 1] = Hw; }
        asm volatile("s_waitcnt lgkmcnt(0)" ::: "memory");
        __builtin_amdgcn_s_barrier();
        asm volatile("" ::: "memory");
        float hc = hrun, hall = hrun;
#pragma unroll
        for (int w2 = 0; w2 < 8; ++w2) { if (w2 == wave) hc = hall; hall = wsr[(w2 * 16 + r16) * 2 + 0] * hall + wsr[(w2 * 16 + r16) * 2 + 1]; }
        hrun = hall;
#pragma unroll
        for (int tau = 0; tau < 2; ++tau) {
            const float hin = PE[tau] * hc + HE[tau];
            bf16* yp = p.Y + ((size_t)b * SEQ + tw + 16 * tau + 4 * g) * DM + dg;
#pragma unroll
            for (int i = 0; i < 4; ++i) { const float h = hl[tau][i] + pl[tau][i] * hin, gr = gr4[tau][i]; yp[(size_t)i * DM] = (bf16)f2bf(h * gr * fast_sigm(gr)); }
        }
    }
#undef LRU_STAGE
    __syncthreads();
}
__device__ __forceinline__ void lru_phase(const P& p, int l, LAS unsigned char* lds) {
    const int G = gridDim.x, wg = blockIdx.x;
#pragma unroll 1
    for (int u = wg; u < 256; u += G) lru_unit(p, l, (u >> 3) & 7, u & 7, u >> 6, lds);
}
#ifndef DSA_PHASE
#define DSA_PHASE dsa_phase
#endif
#ifndef LRU_PHASE
#define LRU_PHASE lru_phase
#endif
#ifndef RP_A
#define RP_A 1
#endif
#ifndef RP_L
#define RP_L 1
#endif
#ifndef RP_D
#define RP_D 1
#endif
#ifndef RP_C
#define RP_C 1
#endif
#ifndef RP_0
#define RP_0 1
#endif
template <int OFF> __device__ __forceinline__ unsigned long long karg_u64() {
    unsigned long long v; const unsigned long long kp = (unsigned long long)__builtin_amdgcn_kernarg_segment_ptr();
    asm volatile("s_load_dwordx2 %0, %1, %2\n\ts_waitcnt lgkmcnt(0)" : "=s"(v) : "s"(kp), "i"(OFF) : "memory");
    return v;
}
struct Args { const float* in[15]; float* out; unsigned char* ws; int ph_lo, ph_hi; };
__global__ void __launch_bounds__(512, 2) mega(Args a) {
    extern __shared__ __attribute__((aligned(16))) unsigned char lds_raw[];
    LAS unsigned char* lds = (LAS unsigned char*)lds_raw;
#define KARG(T, off) ((T)(__attribute__((address_space(1))) void*)karg_u64<(off)>())
#define LOADP() P p; { unsigned char* ws_ = KARG(unsigned char*, 128); \
        p.x = KARG(const float*, 0); p.c = KARG(const float*, 8); p.norm_g = KARG(const float*, 16); p.ada_w = KARG(const float*, 24); p.ada_b = KARG(const float*, 32); p.w_in = KARG(const float*, 40); \
        p.conv_w = KARG(const float*, 48); p.conv_b = KARG(const float*, 56); p.lru_wx = KARG(const float*, 64); p.lru_bx = KARG(const float*, 72); p.lru_wa = KARG(const float*, 80); p.lru_ba = KARG(const float*, 88); \
        p.lru_a = KARG(const float*, 96); p.w_out = KARG(const float*, 104); p.final_g = KARG(const float*, 112); p.out = KARG(float*, 120); \
        p.ctl = (unsigned*)(ws_ + WS_CTL); p.mod = (float*)(ws_ + WS_MOD); p.bias = (float*)(ws_ + WS_BIAS); p.ssq = (float*)(ws_ + WS_SSQ); \
        p.wt_in = (bf16*)(ws_ + WS_WTIN); p.wt_out = (bf16*)(ws_ + WS_WTOUT); p.A = (bf16*)(ws_ + WS_A); p.Z = (bf16*)(ws_ + WS_Z); p.Y = (bf16*)(ws_ + WS_Y); p.X1 = (bf16*)(ws_ + WS_X1); }
    unsigned* const ctl0 = (unsigned*)((unsigned char*)a.ws + WS_CTL);
    const int lo = a.ph_lo, hi = a.ph_hi;
    volatile LAS unsigned* MISC = (volatile LAS unsigned*)(lds + MISC_OFF + 4096);
    if (threadIdx.x < 4) MISC[threadIdx.x] = 0u;
    if (threadIdx.x < 16) { const unsigned t = threadIdx.x; u32x2 m; m.x = ((t & 1u) ? 0xffffu : 0u) | ((t & 2u) ? 0xffff0000u : 0u); m.y = ((t & 4u) ? 0xffffu : 0u) | ((t & 8u) ? 0xffff0000u : 0u);
        *(LAS u32x2*)(lds + DSA_MLUT_OFF + t * 8) = m; }
    __syncthreads();
    XcdBarrier bar; bar.bar = ctl0 + CW_BAR; bar.x = 0; bar.st = MISC;
    if (hi - lo > 1) bar = xcd_barrier_post(ctl0 + CW_BAR, MISC);
#define IN(k) (lo <= (k) && (k) < hi)
#ifndef N_CG_SEAMS
#define N_CG_SEAMS 0
#endif
#define SEAM(k) do { if (IN(k) && IN((k) + 1)) { if ((k) < N_CG_SEAMS) cg::this_grid().sync(); else xcd_barrier(bar); } } while (0)
    if (IN(0)) { LOADP(); ph0_prologue(p, lds); if (RP_0 > 1) { __syncthreads(); ph0_prologue(p, lds); } }
    SEAM(0);
    if (IN(1)) { LOADP(); ph1_prologue(p, lds); if (RP_0 > 1) { __syncthreads(); ph1_prologue(p, lds); } }
    SEAM(1);
#define LAYER(l, base) \
    if (IN(base)) { LOADP(); \
        pg8::Gemm g{p.A, p.wt_in + (size_t)(l) * ZP * 1024, MROWS, ZP, DM}; pg8::StaticOrder S; S.init(MROWS, ZP, (int)gridDim.x, (int)blockIdx.x); \
        EpiZ E{p.Z, p.ssq, p.bias + (size_t)(l) * 8 * ZP}; \
        pg8::gemm_phase<EpiZ, pg8::StaticOrder, PG8_ALIGN, PG8_SP2>(lds, g, S, E); if (RP_A > 1) { __syncthreads(); pg8::gemm_phase<EpiZ, pg8::StaticOrder, PG8_ALIGN, PG8_SP2>(lds, g, S, E); } \
    } \
    SEAM(base); \
    if (IN((base) + 1)) { LOADP(); bf16x8v pk0[4]; dsa_phase_pre(p, lds, pk0); LRU_PHASE(p, (l), lds); __syncthreads(); DSA_PHASE(p, lds, pk0); } \
    SEAM((base) + 1); \
    if (IN((base) + 2)) { LOADP(); \
        pg8::Gemm g{p.Y, p.wt_out + (size_t)(l) * 1024 * 1024, MROWS, DM, DM}; pg8::StaticOrder S; S.init(MROWS, DM, (int)gridDim.x, (int)blockIdx.x); \
        if constexpr ((l) == DEPTH - 1) { \
            EpiXF E{p.X1, p.out, p.mod + (size_t)(l) * 8 * 3072 + 2048, p.final_g, p.ssq, p.ctl + CW_PANEL}; \
            pg8::gemm_phase<EpiXF, pg8::StaticOrder, false, PG8_SP2>(lds, g, S, E); \
        } else { \
            EpiX E{p.x, p.X1, p.A, p.mod + (size_t)(l) * 8 * 3072 + 2048, p.norm_g + (size_t)((l) + 1) * 1024, p.mod + (size_t)((l) + 1) * 8 * 3072 + 1024, p.ssq}; \
            pg8::gemm_phase<EpiX, pg8::StaticOrder, false, PG8_SP2>(lds, g, S, E); if (RP_C > 1 && (l) == 0) { __syncthreads(); pg8::gemm_phase<EpiX, pg8::StaticOrder, false, PG8_SP2>(lds, g, S, E); } \
        } \
    } \
    if ((base) + 3 < NPHASE) SEAM((base) + 2);
    LAYER(0, 2)
    LAYER(1, 5)
}
#ifndef MK_N_LAUNCHES
#define MK_N_LAUNCHES 1
#endif
extern "C" void kernel_launch(void* const* d_in, const int* in_sizes, int n_in, void* d_out, int out_size, void* d_ws, size_t ws_size, hipStream_t stream) {
    static int grid = 0;
    if (grid == 0) {
        if (n_in != 15 || out_size != MROWS * DM || ws_size < WS_END) { fprintf(stderr, "kernel_launch: unexpected problem (n_in %d out %d ws %zu)\n", n_in, out_size, ws_size); grid = -1; return; }
        int dev = 0, cus = 0, per_cu = 0;
        hipGetDevice(&dev); hipDeviceGetAttribute(&cus, hipDeviceAttributeMultiprocessorCount, dev);
        if (hipFuncSetAttribute((const void*)mega, hipFuncAttributeMaxDynamicSharedMemorySize, LDS_BYTES) != hipSuccess) { fprintf(stderr, "kernel_launch: hipFuncSetAttribute failed\n"); grid = -1; return; }
        if (hipOccupancyMaxActiveBlocksPerMultiprocessor(&per_cu, (const void*)mega, 512, LDS_BYTES) != hipSuccess || per_cu < 1) { fprintf(stderr, "kernel_launch: occupancy query failed (%d)\n", per_cu); per_cu = 1; }
        (void)hipGetLastError();
        grid = cus * per_cu;
        if (grid != 256) fprintf(stderr, "kernel_launch: grid %d (cus %d x %d) != 256: the fused out-projection epilogue needs exactly 256 workgroups\n", grid, cus, per_cu);
    }
    if (grid < 0) return;
    hipMemsetAsync((char*)d_ws + WS_CTL, 0, CTL_ZERO_BYTES, stream);
    Args a{};
    for (int i = 0; i < 15; ++i) a.in[i] = (const float*)d_in[i];
    a.out = (float*)d_out; a.ws = (unsigned char*)d_ws;
#if MK_N_LAUNCHES == 1
    a.ph_lo = 0; a.ph_hi = NPHASE;
    void* args[] = {&a};
    hipError_t e = hipLaunchCooperativeKernel((const void*)mega, dim3(grid), dim3(512), args, LDS_BYTES, stream);
    if (e != hipSuccess) fprintf(stderr, "cooperative launch failed: %s (grid %d)\n", hipGetErrorString(e), grid);
#else
    for (int ph = 0; ph < NPHASE; ++ph) { a.ph_lo = ph; a.ph_hi = ph + 1; hipLaunchKernelGGL(mega, dim3(grid), dim3(512), LDS_BYTES, stream, a); }
#endif
}
```

```cpp
#include <hip/hip_runtime.h>
#include <hip/hip_cooperative_groups.h>
#include <cstdio>
#include <cstdint>
#include <cmath>
namespace cg = cooperative_groups;
#define EPI_XD 3
#define EPI_ZD 8
#define HIST_WAVES 8
#define PRO_KC 64
#define HISTA_FALLBACK 1
#define WALK_MAX 4
#define XB_FLAT_RELEASE 1
namespace pg8 {
#define PG8_LAS __attribute__((address_space(3)))
typedef unsigned short bf16_t;
typedef short bf16x8 __attribute__((ext_vector_type(8)));
typedef float f32x4 __attribute__((ext_vector_type(4)));
typedef unsigned u32x4 __attribute__((ext_vector_type(4)));
constexpr int BM = 256, BK = 64, HALF = 128, HTB = HALF * BK * 2  , STAGE_BYTES = 8 * HTB, NXCD = 8, WGM = 8;

__host__ __device__ __forceinline__ int lds_byte(int r, int c) { const int st = (r >> 4) * 2 + (c >> 5), rr = r & 15, cc = c & 31, ob = rr * 64 + cc * 2; return st * 1024 + (ob ^ (((ob >> 9) & 1) << 5)); }
__host__ __device__ __forceinline__ void stage_rc(int b, int& R, int& C) { const int st = b / 1024, sb = b % 1024, swz = sb ^ (((sb >> 9) & 1) << 5); R = (st >> 1) * 16 + swz / 64; C = (st & 1) * 32 + (swz % 64) / 2; }
__host__ __device__ __forceinline__ int perm32(int rho) { const int n = rho >> 4, i = rho & 15; return 8 * (i >> 2) + 4 * n + (i & 3); }

struct Unit { int pm, pn; };
struct Gemm { const bf16_t* A; const bf16_t* Bt; int M, N, K; };

struct StaticOrder {
    int nM, nN, nwg, G, c;
    __host__ __device__ void init(int M, int N, int G_, int c_) { nM = M / BM; nN = N / BM; nwg = nM * nN; G = G_; c = c_; }
    __host__ __device__ bool next(int i, Unit& u) const {
        const long L = (long)i * G + c; if (L >= nwg) return false;
        int wgid = (int)L; { const int q = nwg / NXCD, r = nwg % NXCD, xcd = wgid % NXCD, off = wgid / NXCD; wgid = (xcd < r ? xcd * (q + 1) : r * (q + 1) + (xcd - r) * q) + off; }
        const int nig = WGM * nN, gid = wgid / nig, fm = gid * WGM, gsz = (nM - fm) < WGM ? (nM - fm) : WGM;
        u.pm = fm + ((wgid % nig) % gsz); u.pn = (wgid % nig) / gsz; return true;
    }
    __device__ __forceinline__ void a_ready(const Unit&) const {}
    __device__ __forceinline__ void done(const Unit&) const {}
};

__device__ __forceinline__ unsigned cvt_pk_bf16(float lo, float hi) { unsigned r; asm volatile("v_cvt_pk_bf16_f32 %0, %1, %2" : "=v"(r) : "v"(lo), "v"(hi)); return r; }
typedef float f32x2 __attribute__((ext_vector_type(2)));
template <class Epi, class Sched, bool ALIGN_EPI = false, bool SP2 = false>
__device__ __forceinline__ void gemm_phase(PG8_LAS unsigned char* lds, const Gemm g, const Sched& S, const Epi& E) {
    const int tid = threadIdx.x, wid = __builtin_amdgcn_readfirstlane(tid >> 6), lane = tid & 63, wr = wid >> 2, wc = wid & 3, fr = lane & 15, fq = lane >> 4;
    const int K = g.K, nt = K / BK;
    unsigned voffA[2], voffB[2];
#pragma unroll
    for (int i = 0; i < 2; ++i) { int R, C; stage_rc(tid * 16 + i * 8192, R, C); const int Rb = Epi::PERM ? ((R & ~31) + perm32(R & 31)) : R;
        voffA[i] = (unsigned)(R * K + C) * 2u; voffB[i] = (unsigned)(Rb * K + C) * 2u; }
    const size_t kstep = (size_t)(BK * 2);
    const size_t hstep = (size_t)HALF * K * 2;
    const size_t tstep = 2 * hstep;
    const unsigned ldsw = (unsigned)wid * 1024u;
    const int aoff = lds_byte(wr * 64 + fr, fq * 8), boff = lds_byte(wc * 32 + fr, fq * 8);
#define PG8_SA(b, h) (((b) * 2 + (h)) * HTB)
#define PG8_SB(b, h) ((4 + (b) * 2 + (h)) * HTB)
#define PG8_STAGE(bufoff, gbase, voff) do { _Pragma("unroll") for (int _i = 0; _i < 2; ++_i) \
        __builtin_amdgcn_global_load_lds((const unsigned*)((const char*)(gbase) + (voff)[_i]), (PG8_LAS unsigned*)(lds + (bufoff) + ldsw + _i * 8192), 16, 0, 0); } while (0)
#define PG8_LDA(dst, b, h) do { _Pragma("unroll") for (int m = 0; m < 4; ++m) _Pragma("unroll") for (int k = 0; k < 2; ++k) dst[m][k] = *(const PG8_LAS bf16x8*)(lds + PG8_SA(b, h) + aoff + m * 2048 + k * 1024); } while (0)
#define PG8_LDB(dst, b, h) do { _Pragma("unroll") for (int n = 0; n < 2; ++n) _Pragma("unroll") for (int k = 0; k < 2; ++k) dst[n][k] = *(const PG8_LAS bf16x8*)(lds + PG8_SB(b, h) + boff + n * 2048 + k * 1024); } while (0)
#define PG8_MMA(ai, bj, At, Bt) do { __builtin_amdgcn_s_setprio(1); _Pragma("unroll") for (int m = 0; m < 4; ++m) _Pragma("unroll") for (int n = 0; n < 2; ++n) _Pragma("unroll") for (int k = 0; k < 2; ++k) \
        acc[ai][bj][m][n] = __builtin_amdgcn_mfma_f32_16x16x32_bf16(Bt[n][k], At[m][k], acc[ai][bj][m][n], 0, 0, 0); __builtin_amdgcn_s_setprio(0); } while (0)
#define PG8_WAIT_V(n) asm volatile("s_waitcnt vmcnt(" #n ")" ::: "memory")
#define PG8_WAIT_L(n) asm volatile("s_waitcnt lgkmcnt(" #n ")" ::: "memory")
#define PG8_BAR __builtin_amdgcn_s_barrier()
#define PG8_SCHED __builtin_amdgcn_sched_barrier(0)
    Unit cur, nxt; int ui = 0;
    if (!S.next(0, cur)) return;
    f32x4 acc[2][2][4][2];
#pragma unroll
    for (int a = 0; a < 2; ++a)
#pragma unroll
        for (int b = 0; b < 2; ++b)
#pragma unroll
            for (int m = 0; m < 4; ++m)
#pragma unroll
                for (int n = 0; n < 2; ++n) acc[a][b][m][n] = (f32x4){0.f, 0.f, 0.f, 0.f};
    bf16x8 At[4][2], B0[2][2], B1[2][2];
    const char* cA = (const char*)g.A + (size_t)cur.pm * tstep; const char* cB = (const char*)g.Bt + (size_t)cur.pn * tstep;
    S.a_ready(cur);
    if constexpr (SP2) {
        PG8_STAGE(PG8_SB(0, 0), cB, voffB); PG8_STAGE(PG8_SB(0, 1), cB + hstep, voffB); PG8_STAGE(PG8_SA(0, 0), cA, voffA); PG8_STAGE(PG8_SA(0, 1), cA + hstep, voffA);
        if (wr == 1) PG8_BAR;
        PG8_WAIT_V(2); PG8_BAR;
        PG8_STAGE(PG8_SB(1, 0), cB + kstep, voffB); PG8_STAGE(PG8_SA(1, 0), cA + kstep, voffA); PG8_STAGE(PG8_SB(1, 1), cB + hstep + kstep, voffB);
        PG8_WAIT_V(6); PG8_BAR;
    } else {
        PG8_STAGE(PG8_SB(0, 0), cB, voffB); PG8_STAGE(PG8_SA(0, 0), cA, voffA); PG8_STAGE(PG8_SB(0, 1), cB + hstep, voffB); PG8_STAGE(PG8_SA(0, 1), cA + hstep, voffA);
        if (wr == 1) PG8_BAR;
        PG8_WAIT_V(4); PG8_BAR;
        PG8_STAGE(PG8_SB(1, 0), cB + kstep, voffB); PG8_STAGE(PG8_SA(1, 0), cA + kstep, voffA); PG8_STAGE(PG8_SB(1, 1), cB + hstep + kstep, voffB);
        PG8_WAIT_V(6); PG8_BAR;
    }
    for (;;) {
        const bool has_next = S.next(ui + 1, nxt);
        const char* nA = has_next ? (const char*)g.A + (size_t)nxt.pm * tstep : cA; const char* nB = has_next ? (const char*)g.Bt + (size_t)nxt.pn * tstep : cB;
        for (int t = 0; t < nt; t += 2) {
            const bool last = (t == nt - 2);
            const char* a1 = cA + (size_t)(t + 1) * kstep;
            const char* a2 = last ? nA : cA + (size_t)(t + 2) * kstep; const char* b2 = last ? nB : cB + (size_t)(t + 2) * kstep;
            const char* a3 = a2 + kstep; const char* b3 = b2 + kstep;
            if (last && has_next) S.a_ready(nxt);
            if constexpr (SP2) {
            PG8_LDB(B0, 0, 0); PG8_LDB(B1, 0, 1); PG8_SCHED; PG8_LDA(At, 0, 0); PG8_STAGE(PG8_SA(1, 1), a1 + hstep, voffA);
            PG8_WAIT_V(8); PG8_WAIT_L(0); PG8_BAR; PG8_MMA(0, 0, At, B0); PG8_MMA(0, 1, At, B1); PG8_BAR; PG8_SCHED;
            PG8_LDA(At, 0, 1); PG8_STAGE(PG8_SB(0, 0), b2, voffB); PG8_STAGE(PG8_SB(0, 1), b2 + hstep, voffB); PG8_STAGE(PG8_SA(0, 0), a2, voffA);
            PG8_WAIT_V(8); PG8_WAIT_L(0); PG8_BAR; PG8_MMA(1, 0, At, B0); PG8_MMA(1, 1, At, B1); PG8_BAR; PG8_SCHED;
            PG8_LDB(B0, 1, 0); PG8_LDB(B1, 1, 1); PG8_SCHED; PG8_LDA(At, 1, 0); PG8_STAGE(PG8_SA(0, 1), a2 + hstep, voffA);
            PG8_WAIT_V(8); PG8_WAIT_L(0); PG8_BAR; PG8_MMA(0, 0, At, B0); PG8_MMA(0, 1, At, B1); PG8_BAR; PG8_SCHED;
            PG8_LDA(At, 1, 1); PG8_STAGE(PG8_SB(1, 0), b3, voffB); PG8_STAGE(PG8_SB(1, 1), b3 + hstep, voffB); PG8_STAGE(PG8_SA(1, 0), a3, voffA);
            PG8_WAIT_V(8); PG8_WAIT_L(0); PG8_BAR; PG8_MMA(1, 0, At, B0); PG8_MMA(1, 1, At, B1); PG8_BAR; PG8_SCHED;
            } else {
            PG8_LDB(B0, 0, 0); PG8_SCHED; PG8_LDA(At, 0, 0); PG8_STAGE(PG8_SA(1, 1), a1 + hstep, voffA);
            PG8_WAIT_L(8); PG8_BAR; PG8_WAIT_L(0); PG8_MMA(0, 0, At, B0); PG8_BAR; PG8_SCHED;
            PG8_LDB(B1, 0, 1); PG8_STAGE(PG8_SB(0, 0), b2, voffB);
            PG8_BAR; PG8_WAIT_L(0); PG8_MMA(0, 1, At, B1); PG8_BAR;
            PG8_LDA(At, 0, 1); PG8_STAGE(PG8_SA(0, 0), a2, voffA);
            PG8_BAR; PG8_WAIT_L(0); PG8_MMA(1, 0, At, B0); PG8_BAR; PG8_SCHED;
            PG8_STAGE(PG8_SB(0, 1), b2 + hstep, voffB);
            PG8_WAIT_V(6); PG8_BAR; PG8_MMA(1, 1, At, B1); PG8_BAR;
            PG8_LDB(B0, 1, 0); PG8_SCHED; PG8_LDA(At, 1, 0); PG8_STAGE(PG8_SA(0, 1), a2 + hstep, voffA);
            PG8_WAIT_L(8); PG8_BAR; PG8_WAIT_L(0); PG8_MMA(0, 0, At, B0); PG8_BAR; PG8_SCHED;
            PG8_LDB(B1, 1, 1); PG8_STAGE(PG8_SB(1, 0), b3, voffB);
            PG8_BAR; PG8_WAIT_L(0); PG8_MMA(0, 1, At, B1); PG8_BAR;
            PG8_LDA(At, 1, 1); PG8_STAGE(PG8_SA(1, 0), a3, voffA);
            PG8_BAR; PG8_WAIT_L(0); PG8_MMA(1, 0, At, B0); PG8_BAR; PG8_SCHED;
            PG8_STAGE(PG8_SB(1, 1), b3 + hstep, voffB);
            PG8_WAIT_V(6); PG8_BAR; PG8_MMA(1, 1, At, B1); PG8_BAR;
            }
        }
        if constexpr (ALIGN_EPI) { if (wr == 0) PG8_BAR; }
        if constexpr (!Epi::AFTER_DRAIN) { E(acc, cur, wr, wc, fr, fq); S.done(cur); }
        if (!has_next) break;
#pragma unroll
        for (int a = 0; a < 2; ++a)
#pragma unroll
            for (int b = 0; b < 2; ++b)
#pragma unroll
                for (int m = 0; m < 4; ++m)
#pragma unroll
                    for (int n = 0; n < 2; ++n) acc[a][b][m][n] = (f32x4){0.f, 0.f, 0.f, 0.f};
        cur = nxt; cA = nA; cB = nB; ++ui;
        if constexpr (ALIGN_EPI) { if (wr == 1) PG8_BAR; }
    }
    PG8_WAIT_V(0);
    if constexpr (!ALIGN_EPI) { if (wr == 0) PG8_BAR; }
    PG8_BAR;
    if constexpr (Epi::AFTER_DRAIN) { E.fused(acc, cur, wr, wc, fr, fq, lds, wid, lane); S.done(cur); }
#undef PG8_SA
#undef PG8_SB
#undef PG8_STAGE
#undef PG8_LDA
#undef PG8_LDB
#undef PG8_MMA
#undef PG8_WAIT_V
#undef PG8_WAIT_L
#undef PG8_BAR
#undef PG8_SCHED
}
}

#ifndef PG8_SP2
#define PG8_SP2 true
#endif
#ifndef PG8_ALIGN
#define PG8_ALIGN true
#endif
constexpr int BATCH = 8, SEQ = 2048, DM = 1024, MROWS = BATCH * SEQ, DEPTH = 2;
constexpr int D_RNN = 512, NHEAD = 8, HDIM = 64, D_INR = 2760, ZP = 2816, TOPK = 256;
constexpr int C_XR = 0, C_GR = 512, C_Q = 1024, C_K = 1536, C_V = 1600, C_GA = 1664, C_QI = 2176, C_KI = 2688, C_WI = 2752;
constexpr float EPS = 1e-6f;
constexpr float QSCALE = 0.125f * 1.4426950408889634f;
constexpr size_t MiB = 1u << 20;
constexpr size_t WS_CTL = 0, CTL_ZERO_BYTES = 1 * MiB;
constexpr size_t WS_MOD = 1 * MiB;
constexpr size_t WS_BIAS = 1 * MiB + 256 * 1024;
constexpr size_t WS_SSQ = 2 * MiB;
constexpr size_t WS_WTIN = 3 * MiB;
constexpr size_t WS_WTOUT = 14 * MiB;
constexpr size_t WS_A = 32 * MiB;
constexpr size_t WS_Z = 64 * MiB;
constexpr size_t WS_Y = 152 * MiB;
constexpr size_t WS_X1 = 184 * MiB;
constexpr size_t WS_END = 216 * MiB;
constexpr int LDS_BYTES = 163840;
constexpr int MISC_OFF = 131072 + 8192;
constexpr int NPHASE = 8;
constexpr int CW_BAR = 4096, CW_PANEL = 16384;

#define LAS __attribute__((address_space(3)))
typedef unsigned short bf16;
typedef float f32x4 __attribute__((ext_vector_type(4)));
typedef unsigned u32x4 __attribute__((ext_vector_type(4)));
typedef unsigned u32x2 __attribute__((ext_vector_type(2)));
__device__ __forceinline__ float bf2f(bf16 v) { return __uint_as_float(((unsigned)v) << 16); }
__device__ __forceinline__ unsigned f2bf(float f) { unsigned u = __float_as_uint(f); return (u + 0x7fffu + ((u >> 16) & 1u)) >> 16; }
__device__ __forceinline__ unsigned pk2(float lo, float hi) { return f2bf(lo) | (f2bf(hi) << 16); }
__device__ __forceinline__ float wave_sum(float v) {
#pragma unroll
    for (int o = 1; o < 64; o <<= 1) v += __shfl_xor(v, o);
    return v;
}
__device__ __forceinline__ float wave_max(float v) {
#pragma unroll
    for (int o = 1; o < 64; o <<= 1) v = fmaxf(v, __shfl_xor(v, o));
    return v;
}
__device__ __forceinline__ int wave_sum_i(int v) {
#pragma unroll
    for (int o = 1; o < 64; o <<= 1) v += __shfl_xor(v, o);
    return v;
}
__device__ __forceinline__ float siluf(float v) { return v / (1.f + expf(-v)); }
__device__ __forceinline__ float sigmf(float v) { return 1.f / (1.f + expf(-v)); }

struct P {
    const float *x, *c, *norm_g, *ada_w, *ada_b, *w_in, *conv_w, *conv_b, *lru_wx, *lru_bx, *lru_wa, *lru_ba, *lru_a, *w_out, *final_g;
    float* out;
    float *mod, *bias, *ssq;
    bf16 *wt_in, *wt_out, *A, *Z, *Y, *X1;
    unsigned* ctl;
};

#ifndef EPI_ZD
#define EPI_ZD 2
#endif
struct EpiZ {
    static constexpr bool PERM = true, AFTER_DRAIN = false;
    bf16* Zp; const float* ssq; const float* bias;
    __device__ __forceinline__ void operator()(const pg8::f32x4 (&acc)[2][2][4][2], const pg8::Unit& u, int wr, int wc, int fr, int fq) const {
        const int row0 = u.pm * 256 + wr * 64 + fr, col0 = u.pn * 256 + wc * 32 + 8 * fq, b = u.pm >> 3;
        const float cs = (u.pn == 4 || u.pn == 5) ? QSCALE : 1.0f;
        f32x4 bv[2][2];
#pragma unroll
        for (int bj = 0; bj < 2; ++bj)
#pragma unroll
            for (int n = 0; n < 2; ++n) bv[bj][n] = *(const f32x4*)(bias + b * ZP + col0 + bj * 128 + 4 * n);
        f32x4 qq[EPI_ZD];
#pragma unroll
        for (int gi = 0; gi < EPI_ZD; ++gi) qq[gi] = *(const f32x4*)(ssq + (size_t)(row0 + (gi >> 2) * 128 + (gi & 3) * 16) * 4);
#pragma unroll
        for (int ai = 0; ai < 2; ++ai)
#pragma unroll
            for (int m = 0; m < 4; ++m) {
                const int r = row0 + ai * 128 + m * 16, gi = ai * 4 + m;
                const f32x4 q = qq[gi % EPI_ZD];
                if (gi + EPI_ZD < 8) qq[gi % EPI_ZD] = *(const f32x4*)(ssq + (size_t)(row0 + ((gi + EPI_ZD) >> 2) * 128 + ((gi + EPI_ZD) & 3) * 16) * 4);
                const float rstd = __builtin_amdgcn_rsqf(((q.x + q.y) + (q.z + q.w)) * (1.0f / 1024.0f) + EPS);
                bf16* rowp = Zp + (size_t)r * ZP + col0;
#pragma unroll
                for (int bj = 0; bj < 2; ++bj) {
                    const f32x4 v0 = (acc[ai][bj][m][0] * rstd + bv[bj][0]) * cs, v1 = (acc[ai][bj][m][1] * rstd + bv[bj][1]) * cs;
                    u32x4 w; w.x = pk2(v0[0], v0[1]); w.y = pk2(v0[2], v0[3]); w.z = pk2(v1[0], v1[1]); w.w = pk2(v1[2], v1[3]);
                    *(u32x4*)(rowp + bj * 128) = w;
                }
            }
    }
};
#ifndef EPI_XD
#define EPI_XD 4
#endif
struct EpiX {
    static constexpr bool PERM = true, AFTER_DRAIN = true;
    const float* xres; bf16* xout; bf16* Anext; const float* gate; const float* ng; const float* nscale; float* ssq;
    __device__ __forceinline__ void fused(pg8::f32x4 (&acc)[2][2][4][2], const pg8::Unit& u, int wr, int wc, int fr, int fq, LAS unsigned char* lds, int wid, int lane) const {
        const int b = u.pm >> 3, col0 = u.pn * 256 + wc * 32 + 8 * fq;
        LAS float* Pp = (LAS float*)lds;
        f32x4 gv[2][2], gs[2][2];
#pragma unroll
        for (int bj = 0; bj < 2; ++bj)
#pragma unroll
            for (int n = 0; n < 2; ++n) {
                gv[bj][n] = *(const f32x4*)(gate + b * 3072 + col0 + bj * 128 + 4 * n);
                if (Anext) { const f32x4 g = *(const f32x4*)(ng + col0 + bj * 128 + 4 * n), s = *(const f32x4*)(nscale + b * 3072 + col0 + bj * 128 + 4 * n); gs[bj][n] = g * (s + 1.0f); }
                else gs[bj][n] = (f32x4){0.f, 0.f, 0.f, 0.f};
            }
        f32x4 xq[EPI_XD][2][2];
#define EPIX_LOAD(gi) do { const size_t r_ = (size_t)u.pm * 256 + ((gi) >> 2) * 128 + wr * 64 + ((gi) & 3) * 16 + fr; \
        _Pragma("unroll") for (int bj = 0; bj < 2; ++bj) _Pragma("unroll") for (int n = 0; n < 2; ++n) xq[(gi) % EPI_XD][bj][n] = *(const f32x4*)(xres + r_ * DM + col0 + bj * 128 + 4 * n); } while (0)
#pragma unroll
        for (int gi = 0; gi < EPI_XD; ++gi) EPIX_LOAD(gi);
#pragma unroll
        for (int ai = 0; ai < 2; ++ai)
#pragma unroll
            for (int m = 0; m < 4; ++m) {
                const int rl = ai * 128 + wr * 64 + m * 16 + fr; const size_t r = (size_t)u.pm * 256 + rl;
                float s = 0.f;
                f32x4 xc[2][2];
#pragma unroll
                for (int bj = 0; bj < 2; ++bj)
#pragma unroll
                    for (int n = 0; n < 2; ++n) xc[bj][n] = xq[(ai * 4 + m) % EPI_XD][bj][n];
                if (ai * 4 + m + EPI_XD < 8) EPIX_LOAD(ai * 4 + m + EPI_XD);
#pragma unroll
                for (int bj = 0; bj < 2; ++bj) {
                    f32x4 x1[2];
#pragma unroll
                    for (int n = 0; n < 2; ++n) {
                        const f32x4 xr = xc[bj][n];
                        x1[n] = xr + gv[bj][n] * acc[ai][bj][m][n];
                        s += (x1[n][0] * x1[n][0] + x1[n][1] * x1[n][1]) + (x1[n][2] * x1[n][2] + x1[n][3] * x1[n][3]);
                    }
                    { u32x4 xw; xw.x = pk2(x1[0][0], x1[0][1]); xw.y = pk2(x1[0][2], x1[0][3]); xw.z = pk2(x1[1][0], x1[1][1]); xw.w = pk2(x1[1][2], x1[1][3]);
                      *(u32x4*)(xout + r * DM + col0 + bj * 128) = xw; }
                    if (Anext) { const f32x4 a0 = x1[0] * gs[bj][0], a1 = x1[1] * gs[bj][1];
                        u32x4 w; w.x = pk2(a0[0], a0[1]); w.y = pk2(a0[2], a0[3]); w.z = pk2(a1[0], a1[1]); w.w = pk2(a1[2], a1[3]);
                        *(u32x4*)(Anext + r * DM + col0 + bj * 128) = w; }
                }
                s += __shfl_xor(s, 16); s += __shfl_xor(s, 32);
                if (fq == 0) Pp[rl * 4 + wc] = s;
            }
        __syncthreads();
        const int tid = wid * 64 + lane;
        if (tid < 256) ssq[((size_t)u.pm * 256 + tid) * 4 + u.pn] = (Pp[tid * 4 + 0] + Pp[tid * 4 + 1]) + (Pp[tid * 4 + 2] + Pp[tid * 4 + 3]);
        __syncthreads();
    }
};

struct EpiXF {
    static constexpr bool PERM = true, AFTER_DRAIN = true;
    const bf16* xres; float* out; const float* gate; const float* fg; float* ssq; unsigned* cnt;
    __device__ __forceinline__ void fused(pg8::f32x4 (&acc)[2][2][4][2], const pg8::Unit& u, int wr, int wc, int fr, int fq, LAS unsigned char* lds, int wid, int lane) const {
        const int b = u.pm >> 3, col0 = u.pn * 256 + wc * 32 + 8 * fq, tid = wid * 64 + lane;
        LAS float* Pp = (LAS float*)lds;
        LAS float* Sr = (LAS float*)(lds + 4096);
        {
            f32x4 gv[2][2];
#pragma unroll
            for (int bj = 0; bj < 2; ++bj)
#pragma unroll
                for (int n = 0; n < 2; ++n) gv[bj][n] = *(const f32x4*)(gate + b * 3072 + col0 + bj * 128 + 4 * n);
#pragma unroll
            for (int ai = 0; ai < 2; ++ai)
#pragma unroll
                for (int m = 0; m < 4; ++m) {
                    const int rl = ai * 128 + wr * 64 + m * 16 + fr; const size_t r = (size_t)u.pm * 256 + rl;
                    float s = 0.f;
#pragma unroll
                    for (int bj = 0; bj < 2; ++bj) {
                        const u32x4 xw = *(const u32x4*)(xres + r * DM + col0 + bj * 128);
#pragma unroll
                        for (int n = 0; n < 2; ++n) {
                            const unsigned w0 = n ? xw.z : xw.x, w1 = n ? xw.w : xw.y;
                            const f32x4 xr = {__uint_as_float(w0 << 16), __uint_as_float(w0 & 0xffff0000u), __uint_as_float(w1 << 16), __uint_as_float(w1 & 0xffff0000u)};
                            const f32x4 x1 = xr + gv[bj][n] * acc[ai][bj][m][n];
                            acc[ai][bj][m][n] = x1;
                            s += (x1[0] * x1[0] + x1[1] * x1[1]) + (x1[2] * x1[2] + x1[3] * x1[3]);
                        }
                    }
                    s += __shfl_xor(s, 16); s += __shfl_xor(s, 32);
                    if (fq == 0) Pp[rl * 4 + wc] = s;
                }
        }
        __syncthreads();
        if (tid < 256) { const float tot = (Pp[tid * 4 + 0] + Pp[tid * 4 + 1]) + (Pp[tid * 4 + 2] + Pp[tid * 4 + 3]);
            __hip_atomic_store(ssq + ((size_t)u.pm * 256 + tid) * 4 + u.pn, tot, __ATOMIC_RELAXED, __HIP_MEMORY_SCOPE_AGENT); }
        asm volatile("s_waitcnt vmcnt(0)" ::: "memory");
        __syncthreads();
        if (tid == 0) {
            unsigned* c = cnt + 64 * u.pm;
            __hip_atomic_fetch_add(c, 1u, __ATOMIC_RELAXED, __HIP_MEMORY_SCOPE_AGENT);
            unsigned spins = 0u;
            while (__hip_atomic_load(c, __ATOMIC_RELAXED, __HIP_MEMORY_SCOPE_AGENT) < 4u) { __builtin_amdgcn_s_sleep(2); if (++spins > (1u << 22)) break; }
            __builtin_amdgcn_fence(__ATOMIC_ACQUIRE, "agent");
            asm volatile("s_waitcnt vmcnt(0)" ::: "memory");
        }
        __syncthreads();
        if (tid < 256) { const float* sp = ssq + ((size_t)u.pm * 256 + tid) * 4;
            const float q0 = __hip_atomic_load(sp + 0, __ATOMIC_RELAXED, __HIP_MEMORY_SCOPE_AGENT), q1 = __hip_atomic_load(sp + 1, __ATOMIC_RELAXED, __HIP_MEMORY_SCOPE_AGENT);
            const float q2 = __hip_atomic_load(sp + 2, __ATOMIC_RELAXED, __HIP_MEMORY_SCOPE_AGENT), q3 = __hip_atomic_load(sp + 3, __ATOMIC_RELAXED, __HIP_MEMORY_SCOPE_AGENT);
            Sr[tid] = 1.0f / sqrtf(((q0 + q1) + (q2 + q3)) * (1.0f / 1024.0f) + EPS); }
        __syncthreads();
        f32x4 fgv[2][2];
#pragma unroll
        for (int bj = 0; bj < 2; ++bj)
#pragma unroll
            for (int n = 0; n < 2; ++n) fgv[bj][n] = *(const f32x4*)(fg + col0 + bj * 128 + 4 * n);
#pragma unroll
        for (int ai = 0; ai < 2; ++ai)
#pragma unroll
            for (int m = 0; m < 4; ++m) {
                const int rl = ai * 128 + wr * 64 + m * 16 + fr; const size_t r = (size_t)u.pm * 256 + rl; const float rstd = Sr[rl];
#pragma unroll
                for (int bj = 0; bj < 2; ++bj)
#pragma unroll
                    for (int n = 0; n < 2; ++n) *(f32x4*)(out + r * DM + col0 + bj * 128 + 4 * n) = acc[ai][bj][m][n] * rstd * fgv[bj][n];
            }
        __syncthreads();
    }
};

#ifndef PRO_KC
#define PRO_KC 64
#endif
#ifndef TRQ
#define TRQ 4
#endif
__device__ __forceinline__ void ph0_prologue(const P& p, LAS unsigned char* lds) {
    const int tid = threadIdx.x, lane = tid & 63, wave = tid >> 6, G = gridDim.x, wg = blockIdx.x;
    LAS float* fl = (LAS float*)lds;
    for (int u = wg; u < 96; u += G) {
        const int l = u / 48, j = (u % 48) * 64 + lane;
        { float cv[16];
#pragma unroll
          for (int i = 0; i < 16; ++i) cv[i] = p.c[tid + 512 * i];
#pragma unroll
          for (int i = 0; i < 16; ++i) fl[tid + 512 * i] = siluf(cv[i]); }
        __syncthreads();
        float acc[8];
#pragma unroll
        for (int b = 0; b < 8; ++b) acc[b] = 0.f;
        const float* w = p.ada_w + ((size_t)l * 1024 + wave * 128) * 3072 + j;
#pragma unroll 1
        for (int k0 = 0; k0 < 128; k0 += PRO_KC) { float wv[PRO_KC];
#pragma unroll
          for (int k = 0; k < PRO_KC; ++k) wv[k] = w[(size_t)(k0 + k) * 3072];
#pragma unroll
          for (int k = 0; k < PRO_KC; ++k) {
#pragma unroll
            for (int b = 0; b < 8; ++b) acc[b] += fl[b * 1024 + wave * 128 + k0 + k] * wv[k]; } }
#pragma unroll
        for (int b = 0; b < 8; ++b) fl[8192 + (wave * 8 + b) * 64 + lane] = acc[b];
        __syncthreads();
        { const int b = wave; float s = p.ada_b[l * 3072 + j];
#pragma unroll
          for (int w8 = 0; w8 < 8; ++w8) s += fl[8192 + (w8 * 8 + b) * 64 + lane];
          p.mod[(l * 8 + b) * 3072 + j] = s; }
        __syncthreads();
    }
    const int GT = (G > 96) ? G - 96 : G, wt = (G > 96) ? wg - 96 : wg;
    if (wt >= 0)
#pragma unroll 1
    for (int u0 = wt; u0 < 1920; u0 += TRQ * GT) {
        float v[TRQ][8]; bf16* dst[TRQ]; bool act[TRQ];
#pragma unroll
        for (int q = 0; q < TRQ; ++q) {
            const int u = u0 + q * GT; act[q] = u < 1920; dst[q] = nullptr;
#pragma unroll
            for (int j = 0; j < 8; ++j) v[q][j] = 0.f;
            if (act[q]) {
                const float* W; bf16* WT; int N, kt, nt;
                if (u < 1408) { const int l = u / 704, r = u % 704; kt = r / 44; nt = r % 44; W = p.w_in + (size_t)l * 1024 * D_INR; N = D_INR; WT = p.wt_in + (size_t)l * ZP * 1024; }
                else { int r = u - 1408; const int l = r / 256; r %= 256; kt = r / 16; nt = r % 16; W = p.w_out + (size_t)l * 1024 * 1024; N = 1024; WT = p.wt_out + (size_t)l * 1024 * 1024; }
                const int n = nt * 64 + lane, k0 = kt * 64 + wave * 8;
                if (n < N) {
#pragma unroll
                    for (int j = 0; j < 8; ++j) v[q][j] = W[(size_t)(k0 + j) * N + n];
                }
                dst[q] = WT + (size_t)n * 1024 + k0;
            }
        }
#pragma unroll
        for (int q = 0; q < TRQ; ++q) if (act[q]) { u32x4 o; o.x = pk2(v[q][0], v[q][1]); o.y = pk2(v[q][2], v[q][3]); o.z = pk2(v[q][4], v[q][5]); o.w = pk2(v[q][6], v[q][7]); *(u32x4*)dst[q] = o; }
    }
}
__device__ __forceinline__ void ph1_prologue(const P& p, LAS unsigned char* lds) {
    const int tid = threadIdx.x, lane = tid & 63, wave = tid >> 6, G = gridDim.x, wg = blockIdx.x;
    LAS float* fl = (LAS float*)lds;
    for (int u = wg; u < 88; u += G) {
        const int l = u / 44, n = (u % 44) * 64 + lane;
        { float mv[16];
#pragma unroll
          for (int i = 0; i < 16; ++i) { const int e = tid + 512 * i; mv[i] = p.mod[(l * 8 + (e >> 10)) * 3072 + (e & 1023)]; }
#pragma unroll
          for (int i = 0; i < 16; ++i) fl[tid + 512 * i] = mv[i]; }
        __syncthreads();
        float acc[8];
#pragma unroll
        for (int b = 0; b < 8; ++b) acc[b] = 0.f;
        if (n < D_INR) { const float* w = p.w_in + ((size_t)l * 1024 + wave * 128) * D_INR + n;
#pragma unroll 1
            for (int k0 = 0; k0 < 128; k0 += PRO_KC) { float wv[PRO_KC];
#pragma unroll
              for (int k = 0; k < PRO_KC; ++k) wv[k] = w[(size_t)(k0 + k) * D_INR];
#pragma unroll
              for (int k = 0; k < PRO_KC; ++k) {
#pragma unroll
                for (int b = 0; b < 8; ++b) acc[b] += fl[b * 1024 + wave * 128 + k0 + k] * wv[k]; } } }
#pragma unroll
        for (int b = 0; b < 8; ++b) fl[8192 + (wave * 8 + b) * 64 + lane] = acc[b];
        __syncthreads();
        { const int b = wave; float s = 0.f;
#pragma unroll
          for (int w8 = 0; w8 < 8; ++w8) s += fl[8192 + (w8 * 8 + b) * 64 + lane];
          p.bias[(l * 8 + b) * ZP + n] = s; }
        __syncthreads();
    }
    {
        const int r0 = wg * 8 + wave, rstep = G * 8;
        f32x4 gq[4], xv[2][2][4], sv[2][2][4];
#pragma unroll
        for (int j = 0; j < 4; ++j) gq[j] = *(const f32x4*)(p.norm_g + (lane + 64 * j) * 4);
#define A0_LOAD(slot, pr) do { _Pragma("unroll") for (int h_ = 0; h_ < 2; ++h_) _Pragma("unroll") for (int j = 0; j < 4; ++j) { const int k_ = (lane + 64 * j) * 4, r_ = r0 + rstep * (2 * (pr) + h_); \
            xv[slot][h_][j] = *(const f32x4*)(p.x + (size_t)r_ * DM + k_); sv[slot][h_][j] = *(const f32x4*)(p.mod + (size_t)(r_ >> 11) * 3072 + 1024 + k_); } } while (0)
        A0_LOAD(0, 0);
#pragma unroll
        for (int pr = 0; pr < 4; ++pr) {
            if (pr + 1 < 4) A0_LOAD((pr + 1) & 1, pr + 1);
#pragma unroll
            for (int h = 0; h < 2; ++h) {
                const int r = r0 + rstep * (2 * pr + h); float s1 = 0.f;
#pragma unroll
                for (int j = 0; j < 4; ++j) { const int k = (lane + 64 * j) * 4; const f32x4 v = xv[pr & 1][h][j];
                    s1 += (v[0] * v[0] + v[1] * v[1]) + (v[2] * v[2] + v[3] * v[3]);
                    const f32x4 o1 = v * gq[j] * (sv[pr & 1][h][j] + 1.0f);
                    u32x2 w1; w1.x = pk2(o1[0], o1[1]); w1.y = pk2(o1[2], o1[3]);
                    *(u32x2*)(p.A + (size_t)r * DM + k) = w1; }
                s1 = wave_sum(s1);
                if (lane == 0) *(f32x4*)(p.ssq + (size_t)r * 4) = (f32x4){s1, 0.f, 0.f, 0.f};
            }
        }
#undef A0_LOAD
    }
}
__device__ __forceinline__ void ph_final(const P& p) {
    const int tid = threadIdx.x, lane = tid & 63, wave = tid >> 6, G = gridDim.x, wg = blockIdx.x;
    for (int r = wg * 8 + wave; r < MROWS; r += G * 8) {
        const f32x4 q = *(const f32x4*)(p.ssq + (size_t)r * 4);
        const float rstd = 1.0f / sqrtf(((q.x + q.y) + (q.z + q.w)) * (1.0f / 1024.0f) + EPS);
#pragma unroll
        for (int j = 0; j < 4; ++j) { const int k = (lane + 64 * j) * 4;
            const f32x4 v = *(const f32x4*)(p.out + (size_t)r * DM + k), g = *(const f32x4*)(p.final_g + k);
            *(f32x4*)(p.out + (size_t)r * DM + k) = v * rstd * g; }
    }
}
#define XB_TMO      128
#define XB_XCNT(j)  (256  + 64 * (j))
#define XB_XSUB(j)  (1280 + 64 * (j))
#define XB_XGEN(j)  (2304 + 64 * (j))
#define XB_TOP      3328
#define XB_TOPGEN   3392
#define XCD_BAR_WORDS 3456
#define XB_SPIN_CAP (1u << 18)

__device__ __forceinline__ unsigned xb_ld(unsigned* p)              { return __hip_atomic_load(p, __ATOMIC_RELAXED, __HIP_MEMORY_SCOPE_AGENT); }
__device__ __forceinline__ unsigned xb_add(unsigned* p, unsigned v) { return __hip_atomic_fetch_add(p, v, __ATOMIC_RELAXED, __HIP_MEMORY_SCOPE_AGENT); }
__device__ __forceinline__ unsigned xb_xcc_id() { return (unsigned)__builtin_amdgcn_s_getreg((3 << 11) | 20) & 0xFu; }
#define XB_SPIN(cond, bar) do { unsigned _sp = 0; while (cond) { __builtin_amdgcn_s_sleep(1); \
    if ((++_sp & 255u) == 0u) { if (xb_ld(&(bar)[XB_TMO])) break; if (_sp > XB_SPIN_CAP) { atomicAdd(&(bar)[XB_TMO], 1u); break; } } } } while (0)

struct XcdBarrier {
    unsigned* bar; unsigned x;
    volatile LAS unsigned* st;
};

__device__ __forceinline__ XcdBarrier xcd_barrier_post(unsigned* bar, volatile LAS unsigned* st) {
    XcdBarrier b; b.bar = bar; b.x = xb_xcc_id(); b.st = st;
    if (threadIdx.x == 0) (void)xb_add(&bar[XB_XCNT(b.x)], 1u);
    return b;
}
__device__ __forceinline__ void xcd_barrier_complete(unsigned* bar, unsigned x, unsigned& nloc, unsigned& nx) {
    const unsigned G = gridDim.x * gridDim.y * gridDim.z;
    unsigned sum, cnt, mine, sp = 0u;
    for (;;) {
        sum = 0u; cnt = 0u; mine = 0u;
#pragma unroll
        for (unsigned j = 0; j < 16; ++j) { const unsigned c = xb_ld(&bar[XB_XCNT(j)]); sum += c; cnt += (c > 0u) ? 1u : 0u; mine = (j == x) ? c : mine; }
        if (sum == G) break;
        __builtin_amdgcn_s_sleep(1);
        if ((++sp & 255u) == 0u) { if (xb_ld(&bar[XB_TMO])) break; if (sp > XB_SPIN_CAP) { atomicAdd(&bar[XB_TMO], 1u); break; } }
    }
    nloc = mine > 0u ? mine : 1u; nx = cnt > 0u ? cnt : 1u;
}

__device__ __forceinline__ void xcd_barrier(const XcdBarrier& b) {
    asm volatile("s_waitcnt vmcnt(0)" ::: "memory");
    __syncthreads();
    if (threadIdx.x == 0) {
        unsigned* bar = b.bar;
        __builtin_amdgcn_s_waitcnt(0);
        unsigned nloc = b.st[0], nx = b.st[1];
        if (nloc == 0u) { xcd_barrier_complete(bar, b.x, nloc, nx); b.st[0] = nloc; b.st[1] = nx; }
        const unsigned old = xb_add(&bar[XB_XSUB(b.x)], 1u);
        const unsigned gen = old / nloc;
        if (old + 1u == (gen + 1u) * nloc) {
            __builtin_amdgcn_fence(__ATOMIC_RELEASE, "agent");
            asm volatile("s_waitcnt vmcnt(0)" ::: "memory");
            const unsigned og = xb_add(&bar[XB_TOP], 1u);
            const unsigned tg = og / nx;
            if (og + 1u == (tg + 1u) * nx) xb_add(&bar[XB_TOPGEN], 1u);
            else XB_SPIN(xb_ld(&bar[XB_TOPGEN]) == tg, bar);
            __builtin_amdgcn_fence(__ATOMIC_ACQUIRE, "agent");
            xb_add(&bar[XB_XGEN(b.x)], 1u);
            asm volatile("s_waitcnt vmcnt(0)" ::: "memory");
        } else {
#ifdef XB_FLAT_RELEASE
            XB_SPIN(xb_ld(&bar[XB_TOPGEN]) == gen, bar);
#else
            XB_SPIN(xb_ld(&bar[XB_XGEN(b.x)]) == gen, bar);
#endif
            __builtin_amdgcn_fence(__ATOMIC_ACQUIRE, "agent");
            asm volatile("s_waitcnt vmcnt(0)" ::: "memory");
        }
    }
    __syncthreads();
}
__device__ __forceinline__ unsigned score_ukey(float s) { const unsigned u = __float_as_uint(s + 0.0f); return (u & 0x80000000u) ? ~u : (u | 0x80000000u); }
__device__ __forceinline__ void topk_threshold(const unsigned (&k)[32], unsigned& thr, unsigned& need) {
    unsigned prefix = 0u; bool exact = false;
    for (int bit = 31; bit >= 0; --bit) {
        const unsigned cand = prefix | (1u << bit);
        int c = 0;
#pragma unroll
        for (int i = 0; i < 32; ++i) c += (k[i] >= cand) ? 1 : 0;
        c = wave_sum_i(c);
        if (c >= TOPK) prefix = cand;
        if (c == TOPK) { exact = true; break; }
    }
    thr = prefix;
    if (exact) { need = 0xffffffffu; }
    else { int c = 0;
#pragma unroll
        for (int i = 0; i < 32; ++i) c += (k[i] > prefix) ? 1 : 0;
        c = wave_sum_i(c); need = (unsigned)(TOPK - c); }
}
#ifndef PROBE_VALU
#define PROBE_VALU 0
#endif
#ifndef RP_T3
#define RP_T3 1
#endif
#ifndef RP_T1
#define RP_T1 1
#endif
#ifndef RP_T2
#define RP_T2 1
#endif
#ifndef RP_I
#define RP_I 1
#endif
#ifndef RP_T
#define RP_T 1
#endif
#ifndef RP_V
#define RP_V 1
#endif
typedef short bf16x8v __attribute__((ext_vector_type(8)));
typedef short s16x4v __attribute__((ext_vector_type(4)));
constexpr int BMS = 65;
constexpr int SCP = 2052;
constexpr int DSA_BM_OFF = 16 * SCP * 4;
constexpr int DSA_RING_OFF = 0;
constexpr int DSA_QIB_OFF = 147456;
constexpr int DSA_WIB_OFF = 135680;
constexpr int DSA_MLUT_OFF = 143616;
__device__ __forceinline__ void glds16(const void* gsrc, unsigned lds_dst) { unsigned keep;
    asm volatile("s_mov_b32 %0, m0\n\ts_mov_b32 m0, %2\n\ts_nop 0\n\tglobal_load_lds_dwordx4 %1, off\n\ts_mov_b32 m0, %0" : "=&s"(keep) : "v"(gsrc), "s"(lds_dst) : "memory"); }
template <int I> __device__ __forceinline__ unsigned mbit_t(int mw) { unsigned r; asm("v_bfe_i32 %0, %1, %2, 1" : "=v"(r) : "v"(mw), "i"(I)); return r; }
#define mbit(mw, i) mbit_t<(i)>(mw)
__device__ __forceinline__ float relu_i(float x) { return __int_as_float(max(__float_as_int(x), 0)); }
__device__ __forceinline__ int imax3(float a, float b, float c) { return max(max(__float_as_int(a), __float_as_int(b)), __float_as_int(c)); }
__device__ __forceinline__ s16x4v lds_tr16(LAS const unsigned char* p) { return __builtin_bit_cast(s16x4v, __builtin_amdgcn_ds_read_tr16_b64_v4i16((LAS s16x4v*)p)); }
__device__ __forceinline__ unsigned cvtpk(float lo, float hi) { typedef float f2 __attribute__((ext_vector_type(2))); typedef __bf16 b2 __attribute__((ext_vector_type(2))); f2 v = {lo, hi}; b2 r = __builtin_convertvector(v, b2); return __builtin_bit_cast(unsigned, r); }


template <int L> __device__ __forceinline__ void wr2lanes(int& w, unsigned lo, unsigned hi) {
    asm volatile("s_nop 1\n\tv_writelane_b32 %0, %1, %3\n\tv_writelane_b32 %0, %2, %4" : "+v"(w) : "s"(lo), "s"(hi), "i"(L), "i"(L + 1));
}
__device__ __forceinline__ int wave_sum_dpp(int v) {
    v += __builtin_amdgcn_update_dpp(0, v, 0xB1, 0xf, 0xf, true);
    v += __builtin_amdgcn_update_dpp(0, v, 0x4E, 0xf, 0xf, true);
    v += __builtin_amdgcn_update_dpp(0, v, 0x141, 0xf, 0xf, true);
    v += __builtin_amdgcn_update_dpp(0, v, 0x140, 0xf, 0xf, true);
    return __builtin_amdgcn_readlane(v, 0) + __builtin_amdgcn_readlane(v, 16) + __builtin_amdgcn_readlane(v, 32) + __builtin_amdgcn_readlane(v, 48);
}
__device__ __forceinline__ unsigned wave_max_dpp(unsigned v) {
    v = max(v, (unsigned)__builtin_amdgcn_update_dpp(0, (int)v, 0xB1, 0xf, 0xf, true));
    v = max(v, (unsigned)__builtin_amdgcn_update_dpp(0, (int)v, 0x4E, 0xf, 0xf, true));
    v = max(v, (unsigned)__builtin_amdgcn_update_dpp(0, (int)v, 0x141, 0xf, 0xf, true));
    v = max(v, (unsigned)__builtin_amdgcn_update_dpp(0, (int)v, 0x140, 0xf, 0xf, true));
    return max(max((unsigned)__builtin_amdgcn_readlane((int)v, 0), (unsigned)__builtin_amdgcn_readlane((int)v, 16)), max((unsigned)__builtin_amdgcn_readlane((int)v, 32), (unsigned)__builtin_amdgcn_readlane((int)v, 48)));
}
__device__ __forceinline__ int cnt8(int acc, unsigned cand, unsigned k0, unsigned k1, unsigned k2, unsigned k3, unsigned k4, unsigned k5, unsigned k6, unsigned k7) {
    unsigned long long m0, m1, m2, m3, m4, m5, m6, m7;
    asm volatile("v_cmp_le_u32_e64 %1, %9, %10\n\tv_cmp_le_u32_e64 %2, %9, %11\n\tv_cmp_le_u32_e64 %3, %9, %12\n\tv_cmp_le_u32_e64 %4, %9, %13\n\t"
                 "v_cmp_le_u32_e64 %5, %9, %14\n\tv_cmp_le_u32_e64 %6, %9, %15\n\tv_cmp_le_u32_e64 %7, %9, %16\n\tv_cmp_le_u32_e64 %8, %9, %17\n\t"
                 "v_addc_co_u32_e64 %0, %1, 0, %0, %1\n\tv_addc_co_u32_e64 %0, %2, 0, %0, %2\n\tv_addc_co_u32_e64 %0, %3, 0, %0, %3\n\tv_addc_co_u32_e64 %0, %4, 0, %0, %4\n\t"
                 "v_addc_co_u32_e64 %0, %5, 0, %0, %5\n\tv_addc_co_u32_e64 %0, %6, 0, %0, %6\n\tv_addc_co_u32_e64 %0, %7, 0, %0, %7\n\tv_addc_co_u32_e64 %0, %8, 0, %0, %8"
                 : "+v"(acc), "=&s"(m0), "=&s"(m1), "=&s"(m2), "=&s"(m3), "=&s"(m4), "=&s"(m5), "=&s"(m6), "=&s"(m7)
                 : "s"(cand), "v"(k0), "v"(k1), "v"(k2), "v"(k3), "v"(k4), "v"(k5), "v"(k6), "v"(k7));
    return acc;
}
__device__ __forceinline__ int count_ge(const unsigned (&k)[32], unsigned cand_, int nb) {
    const unsigned cand = (unsigned)__builtin_amdgcn_readfirstlane((int)cand_);
    int c = 0;
    c = cnt8(c, cand, k[0], k[1], k[2], k[3], k[4], k[5], k[6], k[7]);
    if (nb > 1) c = cnt8(c, cand, k[8], k[9], k[10], k[11], k[12], k[13], k[14], k[15]);
    if (nb > 2) c = cnt8(c, cand, k[16], k[17], k[18], k[19], k[20], k[21], k[22], k[23]);
    if (nb > 3) c = cnt8(c, cand, k[24], k[25], k[26], k[27], k[28], k[29], k[30], k[31]);
    return wave_sum_dpp(c);
}
__device__ __forceinline__ int wave_scan_dpp(int v) {
    v += __builtin_amdgcn_update_dpp(0, v, 0x111, 0xf, 0xf, false);
    v += __builtin_amdgcn_update_dpp(0, v, 0x112, 0xf, 0xf, false);
    v += __builtin_amdgcn_update_dpp(0, v, 0x114, 0xf, 0xf, false);
    v += __builtin_amdgcn_update_dpp(0, v, 0x118, 0xf, 0xf, false);
    v += __builtin_amdgcn_update_dpp(0, v, 0x142, 0xa, 0xf, false);
    v += __builtin_amdgcn_update_dpp(0, v, 0x143, 0xc, 0xf, false);
    return v;
}
#ifndef WALK_MAX
#define WALK_MAX 4
#endif
#ifndef HIST_WAVES
#define HIST_WAVES 4
#endif
struct TopkState { unsigned prefix; int bit; bool done; unsigned need; int nb; LAS unsigned* hist; int crej; };
__device__ __forceinline__ void topk_hist(const unsigned (&k)[32], TopkState& st, int c_above) {
    const int lane = threadIdx.x & 63;
    const unsigned T = (unsigned)__builtin_amdgcn_readfirstlane((int)st.prefix);
    LAS unsigned* hist = st.hist;
    *(LAS u32x4*)(hist + 4 * lane) = (u32x4){0u, 0u, 0u, 0u};
    asm volatile("" ::: "memory");
    const unsigned hb_ = (unsigned)(uintptr_t)hist; const unsigned one = 1u;
#define HF8(i0) { unsigned t0_; unsigned long long ex_; \
        asm volatile("s_mov_b64 %1, exec\n\t" \
            "v_subrev_u32_e32 %0, %2, %5\n\tv_lshrrev_b32_e32 %0, 15, %0\n\tv_cmpx_gt_u32_e32 vcc, 0x100, %0\n\tv_lshl_add_u32 %0, %0, 2, %3\n\tds_add_u32 %0, %4\n\ts_mov_b64 exec, %1\n\t" \
            "v_subrev_u32_e32 %0, %2, %6\n\tv_lshrrev_b32_e32 %0, 15, %0\n\tv_cmpx_gt_u32_e32 vcc, 0x100, %0\n\tv_lshl_add_u32 %0, %0, 2, %3\n\tds_add_u32 %0, %4\n\ts_mov_b64 exec, %1\n\t" \
            "v_subrev_u32_e32 %0, %2, %7\n\tv_lshrrev_b32_e32 %0, 15, %0\n\tv_cmpx_gt_u32_e32 vcc, 0x100, %0\n\tv_lshl_add_u32 %0, %0, 2, %3\n\tds_add_u32 %0, %4\n\ts_mov_b64 exec, %1\n\t" \
            "v_subrev_u32_e32 %0, %2, %8\n\tv_lshrrev_b32_e32 %0, 15, %0\n\tv_cmpx_gt_u32_e32 vcc, 0x100, %0\n\tv_lshl_add_u32 %0, %0, 2, %3\n\tds_add_u32 %0, %4\n\ts_mov_b64 exec, %1\n\t" \
            "v_subrev_u32_e32 %0, %2, %9\n\tv_lshrrev_b32_e32 %0, 15, %0\n\tv_cmpx_gt_u32_e32 vcc, 0x100, %0\n\tv_lshl_add_u32 %0, %0, 2, %3\n\tds_add_u32 %0, %4\n\ts_mov_b64 exec, %1\n\t" \
            "v_subrev_u32_e32 %0, %2, %10\n\tv_lshrrev_b32_e32 %0, 15, %0\n\tv_cmpx_gt_u32_e32 vcc, 0x100, %0\n\tv_lshl_add_u32 %0, %0, 2, %3\n\tds_add_u32 %0, %4\n\ts_mov_b64 exec, %1\n\t" \
            "v_subrev_u32_e32 %0, %2, %11\n\tv_lshrrev_b32_e32 %0, 15, %0\n\tv_cmpx_gt_u32_e32 vcc, 0x100, %0\n\tv_lshl_add_u32 %0, %0, 2, %3\n\tds_add_u32 %0, %4\n\ts_mov_b64 exec, %1\n\t" \
            "v_subrev_u32_e32 %0, %2, %12\n\tv_lshrrev_b32_e32 %0, 15, %0\n\tv_cmpx_gt_u32_e32 vcc, 0x100, %0\n\tv_lshl_add_u32 %0, %0, 2, %3\n\tds_add_u32 %0, %4\n\ts_mov_b64 exec, %1" \
            : "=&v"(t0_), "=&s"(ex_) : "s"(T), "s"(hb_), "v"(one), "v"(k[i0]), "v"(k[i0 + 1]), "v"(k[i0 + 2]), "v"(k[i0 + 3]), "v"(k[i0 + 4]), "v"(k[i0 + 5]), "v"(k[i0 + 6]), "v"(k[i0 + 7]) : "vcc", "memory"); }
    HF8(0)
    if (st.nb > 1) HF8(8)
    if (st.nb > 2) HF8(16)
    if (st.nb > 3) HF8(24)
#undef HF8
    asm volatile("" ::: "memory");
    const u32x4 w = *(LAS const u32x4*)(hist + 4 * (63 - lane));
    const int t = (int)((w.x + w.y) + (w.z + w.w));
    const int P = wave_scan_dpp(t);
    const int k1 = TOPK - c_above;
    const unsigned long long bal = __ballot(P >= k1);
    const int Ls = __builtin_ctzll(bal);
    int c = __builtin_amdgcn_readlane(P, Ls) - __builtin_amdgcn_readlane(t, Ls);
    const int h3 = __builtin_amdgcn_readlane((int)w.w, Ls), h2 = __builtin_amdgcn_readlane((int)w.z, Ls), h1 = __builtin_amdgcn_readlane((int)w.y, Ls), h0 = __builtin_amdgcn_readlane((int)w.x, Ls);
    int bsel = 3, hb = h3;
    if (c + h3 < k1) { c += h3; bsel = 2; hb = h2; if (c + h2 < k1) { c += h2; bsel = 1; hb = h1; if (c + h1 < k1) { c += h1; bsel = 0; hb = h0; } } }
    const unsigned bin = (unsigned)(4 * (63 - Ls) + bsel);
    st.prefix = T | (bin << 15); st.bit = 14;
    if (c + hb == k1) { st.done = true; st.need = 0xffffffffu; }
}
__device__ __forceinline__ void topk_histA(const unsigned (&k)[32], TopkState& st) {
    const int lane = threadIdx.x & 63;
    LAS unsigned* hist = st.hist;
    *(LAS u32x4*)(hist + 8 * lane) = (u32x4){0u, 0u, 0u, 0u}; *(LAS u32x4*)(hist + 8 * lane + 4) = (u32x4){0u, 0u, 0u, 0u};
    asm volatile("" ::: "memory");
#define HA(i) __hip_atomic_fetch_add(hist + (k[i] >> 23), 1u, __ATOMIC_RELAXED, __HIP_MEMORY_SCOPE_WORKGROUP);
    HA(0) HA(1) HA(2) HA(3) HA(4) HA(5) HA(6) HA(7)
    if (st.nb > 1) { HA(8) HA(9) HA(10) HA(11) HA(12) HA(13) HA(14) HA(15) }
    if (st.nb > 2) { HA(16) HA(17) HA(18) HA(19) HA(20) HA(21) HA(22) HA(23) }
    if (st.nb > 3) { HA(24) HA(25) HA(26) HA(27) HA(28) HA(29) HA(30) HA(31) }
#undef HA
    asm volatile("" ::: "memory");
    const u32x4 w0 = *(LAS const u32x4*)(hist + 8 * (63 - lane)), w1 = *(LAS const u32x4*)(hist + 8 * (63 - lane) + 4);
    const int t = (int)(((w0.x + w0.y) + (w0.z + w0.w)) + ((w1.x + w1.y) + (w1.z + w1.w)));
    const int P = wave_scan_dpp(t);
    const unsigned long long bal = __ballot(P >= TOPK);
    const int Ls = __builtin_ctzll(bal);
    int c = __builtin_amdgcn_readlane(P, Ls) - __builtin_amdgcn_readlane(t, Ls);
    int bsel = 7, hb = 0; bool found = false;
#define WALK(j, word) if (!found) { const int h_ = __builtin_amdgcn_readlane((int)(word), Ls); if (c + h_ >= TOPK) { bsel = (j); hb = h_; found = true; } else c += h_; }
    WALK(7, w1.w) WALK(6, w1.z) WALK(5, w1.y) WALK(4, w1.x) WALK(3, w0.w) WALK(2, w0.z) WALK(1, w0.y) WALK(0, w0.x)
#undef WALK
    const unsigned bucket = (unsigned)(8 * (63 - Ls) + bsel);
    st.prefix = bucket << 23; st.bit = 22; st.crej = c;
    if (c + hb == TOPK) { st.done = true; st.need = 0xffffffffu; }
}
__device__ __forceinline__ void topk_init(const unsigned (&k)[32], TopkState& st) {
    unsigned mx = 0u;
#pragma unroll
    for (int i = 0; i < 32; ++i) mx = max(mx, k[i]);
    mx = wave_max_dpp(mx);
    st.prefix = 0u; st.bit = 31; st.done = false; st.need = 0u; st.crej = 0;
    unsigned E = mx >> 23;
    int cprev = 0;
#pragma unroll 1
    for (int j = 0; j < WALK_MAX; ++j) {
        if (E < (unsigned)j + 1u) break;
        const unsigned T = (E - (unsigned)j) << 23;
        const int c = count_ge(k, T, st.nb);
        if (c >= TOPK) { st.prefix = T; st.bit = 22; if (c == TOPK) { st.done = true; st.need = 0xffffffffu; }
#ifndef NO_TOPK_HIST
#ifdef PROBE_HIST2
            else if (st.hist) { TopkState sv = st; topk_hist(k, st, cprev); asm volatile("" :: "s"(st.prefix) : "memory"); st = sv; topk_hist(k, st, cprev); }
#else
            else if (st.hist) topk_hist(k, st, cprev);
#endif
#endif
            break; }
        cprev = c;
    }
#ifdef HISTA_FALLBACK
    if (st.bit == 31 && st.hist) { topk_histA(k, st); if (!st.done) topk_hist(k, st, st.crej); }
#endif
}
__device__ __forceinline__ void topk_step(const unsigned (&k)[32], TopkState& st) {
    if (st.done) return;
    if (st.bit < 0) { int c = 0;
#pragma unroll
        for (int i = 0; i < 32; ++i) c += (k[i] > st.prefix) ? 1 : 0;
        c = wave_sum_dpp(c); st.need = (unsigned)(TOPK - c); st.done = true; return; }
    const unsigned cand = st.prefix | (1u << st.bit);
    const int c = count_ge(k, cand, st.nb);
    if (c >= TOPK) st.prefix = cand; else st.crej = c;
    if (c == TOPK) { st.done = true; st.need = 0xffffffffu; }
    --st.bit;
#ifndef NO_TOPK_HIST
    if (st.bit == 22 && !st.done && st.hist) topk_hist(k, st, st.crej);
#endif
}

__device__ __forceinline__ void dsa_prefetch_qi(const bf16* zb, int qt, LAS unsigned char* lds, int wave, int lane) {
    const unsigned lds_base = (unsigned)(uintptr_t)lds;
#pragma unroll
    for (int i = 0; i < 2; ++i) { const int row = 2 * wave + i;
        glds16(zb + (size_t)(qt * 16 + row) * ZP + C_QI + ((lane ^ row) * 8), (unsigned)__builtin_amdgcn_readfirstlane(lds_base + DSA_QIB_OFF + row * 1024)); }
    if (wave == 0) glds16(zb + (size_t)(qt * 16 + (lane & 15)) * ZP + C_WI, (unsigned)__builtin_amdgcn_readfirstlane(lds_base + DSA_WIB_OFF));
}

__device__ __forceinline__ void dsa_prefetch_ki(const bf16* zb, int qt, bf16x8v (&pk)[4], int wave, int lane) {
    const int r16 = lane & 15, g = lane >> 4;
    if (wave <= qt) { const bf16* krow = zb + (size_t)(wave * 16 + r16) * ZP + C_KI; pk[0] = *(const bf16x8v*)(krow + 8 * g); pk[1] = *(const bf16x8v*)(krow + 32 + 8 * g); }
    if (wave + 8 <= qt) { const bf16* krow = zb + (size_t)((wave + 8) * 16 + r16) * ZP + C_KI; pk[2] = *(const bf16x8v*)(krow + 8 * g); pk[3] = *(const bf16x8v*)(krow + 32 + 8 * g); }
}

__device__ __forceinline__ void dsa_unit(const P& p, int b, int qt, int qt_next, bf16x8v (&pk)[4], LAS unsigned char* lds) {
    const int tid = threadIdx.x, lane = tid & 63, wave = __builtin_amdgcn_readfirstlane(tid >> 6), r16 = lane & 15, g = lane >> 4;
    const int q0 = qt * 16; const bf16* zb = p.Z + (size_t)b * SEQ * ZP;
    LAS float* SC = (LAS float*)lds; LAS unsigned* BM = (LAS unsigned*)(lds + DSA_BM_OFF);
    const bool dense_all = (qt < TOPK / 16);
    const bf16* qrow = zb + (size_t)(q0 + r16) * ZP;
    const bf16x8v bq0 = *(const bf16x8v*)(qrow + C_Q + wave * 64 + 8 * g), bq1 = *(const bf16x8v*)(qrow + C_Q + wave * 64 + 32 + 8 * g);
    u32x2 gwv[4];
#pragma unroll
    for (int dt = 0; dt < 4; ++dt) gwv[dt] = *(const u32x2*)(qrow + C_GA + wave * 64 + dt * 16 + 4 * g);
    const int nsteps = (((q0 + 16 + 31) >> 5) + 1) & ~1, nmega = (nsteps + 7) >> 3;
    const int kkey = lane >> 3, vkey = lane >> 1, vhalf = lane & 1;
    const unsigned lds_base = (unsigned)(uintptr_t)lds;
#define DSA_STAGE(mm) do { const int st_ = (mm) * 8 + wave; if (st_ < nsteps) { \
        const bf16* kb_ = zb + (size_t)st_ * 32 * ZP; const unsigned ldsb_ = lds_base + (unsigned)(((mm) & 1) * 65536 + wave * 4096); \
        _Pragma("unroll") for (int c_ = 0; c_ < 4; ++c_) { const int key_ = 8 * c_ + kkey, ch_ = (lane & 7) ^ ((key_ & 15) >> 1); \
            glds16(kb_ + (size_t)key_ * ZP + C_K + ch_ * 8, (unsigned)__builtin_amdgcn_readfirstlane(ldsb_ + c_ * 1024)); } \
        _Pragma("unroll") for (int c_ = 0; c_ < 4; ++c_) \
            glds16(kb_ + (size_t)vkey * ZP + C_V + c_ * 16 + vhalf * 8, (unsigned)__builtin_amdgcn_readfirstlane(ldsb_ + 32768 + c_ * 1024)); } } while (0)
    if (!dense_all) {
        for (int rpI = 0; rpI < RP_I; ++rpI) {
        bf16x8v bq[8][2]; float wv[8];
#pragma unroll
        for (int h = 0; h < 8; ++h) { bq[h][0] = *(LAS const bf16x8v*)(lds + DSA_QIB_OFF + r16 * 1024 + (((8 * h + g) ^ r16) * 16)); bq[h][1] = *(LAS const bf16x8v*)(lds + DSA_QIB_OFF + r16 * 1024 + (((8 * h + 4 + g) ^ r16) * 16));
            wv[h] = bf2f(*(LAS const bf16*)(lds + DSA_WIB_OFF + r16 * 16 + h * 2)) * 0.35355339059327373f * 0.125f; }
        bf16x8v ra0 = pk[0], ra1 = pk[1], rb0 = pk[2], rb1 = pk[3], rc0 = pk[0], rc1 = pk[1];
#define IDX_LOAD(d0, d1, ktl) do { const int ktl_ = (ktl) <= qt ? (ktl) : qt;        \
            const bf16* krow_ = zb + (size_t)(ktl_ * 16 + r16) * ZP + C_KI; d0 = *(const bf16x8v*)(krow_ + 8 * g); d1 = *(const bf16x8v*)(krow_ + 32 + 8 * g); } while (0)
#define IDX_STEP(c0, c1) do { \
            f32x4 sc = {0.f, 0.f, 0.f, 0.f}; \
            _Pragma("unroll") for (int h = 0; h < 8; ++h) { \
                f32x4 acc = {0.f, 0.f, 0.f, 0.f}; \
                acc = __builtin_amdgcn_mfma_f32_16x16x32_bf16(c0, bq[h][0], acc, 0, 0, 0); \
                acc = __builtin_amdgcn_mfma_f32_16x16x32_bf16(c1, bq[h][1], acc, 0, 0, 0); \
                _Pragma("unroll") for (int i = 0; i < 4; ++i) sc[i] += relu_i(acc[i]) * wv[h]; \
            } \
            if (__builtin_amdgcn_readfirstlane(kt) == qt) {                  \
                _Pragma("unroll") for (int i = 0; i < 4; ++i) sc[i] = (4 * g + i > r16) ? -INFINITY : sc[i]; \
            } \
            *(LAS f32x4*)(SC + r16 * SCP + kt * 16 + 4 * g) = sc; } while (0)
        int kt = wave;
        const int nst = (qt - wave + 8) >> 3;
        const int ntrip = (nst * 11) >> 5, rem = nst - 3 * ntrip;
#pragma unroll 1
        for (int it = ntrip; it > 0; --it) {
            IDX_LOAD(rc0, rc1, kt + 16); __builtin_amdgcn_sched_barrier(0); IDX_STEP(ra0, ra1); __builtin_amdgcn_sched_barrier(0); kt += 8;
            IDX_LOAD(ra0, ra1, kt + 16); __builtin_amdgcn_sched_barrier(0); IDX_STEP(rb0, rb1); __builtin_amdgcn_sched_barrier(0); kt += 8;
            IDX_LOAD(rb0, rb1, kt + 16); __builtin_amdgcn_sched_barrier(0); IDX_STEP(rc0, rc1); __builtin_amdgcn_sched_barrier(0); kt += 8;
        }
        if (rem >= 1) { IDX_STEP(ra0, ra1); kt += 8; if (rem >= 2) { IDX_STEP(rb0, rb1); } }
#undef IDX_LOAD
#undef IDX_STEP
        __syncthreads();
        }
#pragma unroll 1
        for (int rpT = 0; rpT < RP_T; ++rpT) {
            const int ra = 2 * wave, rb = 2 * wave + 1, ta = q0 + ra, tb = q0 + rb;
            unsigned ka[32], kb[32];
#pragma unroll
            for (int i = 0; i < 32; ++i) { const int key = lane + 64 * i; ka[i] = (key <= ta) ? score_ukey(SC[ra * SCP + key]) : 0u; kb[i] = (key <= tb) ? score_ukey(SC[rb * SCP + key]) : 0u; }
#if RP_T1 > 1
            asm volatile("" :: "v"(ka[0]), "v"(kb[31]) : "memory");
#pragma unroll
            for (int i = 0; i < 32; ++i) { const int key = lane + 64 * i; ka[i] = (key <= ta) ? score_ukey(SC[ra * SCP + key]) : 0u; kb[i] = (key <= tb) ? score_ukey(SC[rb * SCP + key]) : 0u; }
            asm volatile("" ::: "memory");
#endif
            asm volatile("s_waitcnt lgkmcnt(0)" ::: "memory");
            __syncthreads();
            DSA_STAGE(0);
            TopkState sa, sb; sa.nb = (ta >> 9) + 1; sb.nb = (tb >> 9) + 1;
            sa.hist = (wave < HIST_WAVES) ? (LAS unsigned*)(lds + 65536 + ra * 2048) : (LAS unsigned*)nullptr; sb.hist = (wave < HIST_WAVES) ? (LAS unsigned*)(lds + 65536 + rb * 2048) : (LAS unsigned*)nullptr;
            topk_init(ka, sa); topk_init(kb, sb);
#pragma unroll 1
            while (!(sa.done && sb.done)) { topk_step(ka, sa); topk_step(kb, sb); }
#if RP_T2 > 1
            asm volatile("" :: "v"(sa.prefix), "v"(sb.prefix));
            topk_init(ka, sa); topk_init(kb, sb);
#pragma unroll 1
            while (!(sa.done && sb.done)) { topk_step(ka, sa); topk_step(kb, sb); }
#endif
            if (sa.need == 0xffffffffu && sb.need == 0xffffffffu) {
                const unsigned ta_ = (unsigned)__builtin_amdgcn_readfirstlane((int)sa.prefix), tb_ = (unsigned)__builtin_amdgcn_readfirstlane((int)sb.prefix);
                int wa = 0, wb = 0;
#define WR2(i) { const unsigned long long ma = __ballot(ka[i] >= ta_), mb = __ballot(kb[i] >= tb_); wr2lanes<2 * (i)>(wa, (unsigned)ma, (unsigned)(ma >> 32)); wr2lanes<2 * (i)>(wb, (unsigned)mb, (unsigned)(mb >> 32)); }
                WR2(0) WR2(1) WR2(2) WR2(3) WR2(4) WR2(5) WR2(6) WR2(7) WR2(8) WR2(9) WR2(10) WR2(11) WR2(12) WR2(13) WR2(14) WR2(15)
                WR2(16) WR2(17) WR2(18) WR2(19) WR2(20) WR2(21) WR2(22) WR2(23) WR2(24) WR2(25) WR2(26) WR2(27) WR2(28) WR2(29) WR2(30) WR2(31)
#undef WR2
                BM[ra * BMS + lane] = (unsigned)wa; BM[rb * BMS + lane] = (unsigned)wb;
#if RP_T3 > 1
                asm volatile("" : "+v"(wa), "+v"(wb) :: "memory");
#define WR2(i) { const unsigned long long ma = __ballot(ka[i] >= ta_), mb = __ballot(kb[i] >= tb_); wr2lanes<2 * (i)>(wa, (unsigned)ma, (unsigned)(ma >> 32)); wr2lanes<2 * (i)>(wb, (unsigned)mb, (unsigned)(mb >> 32)); }
                WR2(0) WR2(1) WR2(2) WR2(3) WR2(4) WR2(5) WR2(6) WR2(7) WR2(8) WR2(9) WR2(10) WR2(11) WR2(12) WR2(13) WR2(14) WR2(15)
                WR2(16) WR2(17) WR2(18) WR2(19) WR2(20) WR2(21) WR2(22) WR2(23) WR2(24) WR2(25) WR2(26) WR2(27) WR2(28) WR2(29) WR2(30) WR2(31)
#undef WR2
                BM[ra * BMS + lane] = (unsigned)wa; BM[rb * BMS + lane] = (unsigned)wb;
#endif
            } else {
            unsigned eqa = 0u, eqb = 0u;
#pragma unroll 1
            for (int i = 0; i < 32; ++i) {
                unsigned kai = ka[0], kbi = kb[0];
#pragma unroll
                for (int j = 1; j < 32; ++j) { kai = (i == j) ? ka[j] : kai; kbi = (i == j) ? kb[j] : kbi; }
                { const bool eq = (kai == sa.prefix); const unsigned long long em = __ballot(eq);
                  const unsigned erank = eqa + __builtin_amdgcn_mbcnt_hi((unsigned)(em >> 32), __builtin_amdgcn_mbcnt_lo((unsigned)em, 0u));
                  const unsigned long long smk = __ballot((kai > sa.prefix) || (eq && erank < sa.need));
                  if (lane == 0) { BM[ra * BMS + 2 * i] = (unsigned)smk; BM[ra * BMS + 2 * i + 1] = (unsigned)(smk >> 32); }
                  eqa += (unsigned)__popcll(em); }
                { const bool eq = (kbi == sb.prefix); const unsigned long long em = __ballot(eq);
                  const unsigned erank = eqb + __builtin_amdgcn_mbcnt_hi((unsigned)(em >> 32), __builtin_amdgcn_mbcnt_lo((unsigned)em, 0u));
                  const unsigned long long smk = __ballot((kbi > sb.prefix) || (eq && erank < sb.need));
                  if (lane == 0) { BM[rb * BMS + 2 * i] = (unsigned)smk; BM[rb * BMS + 2 * i + 1] = (unsigned)(smk >> 32); }
                  eqb += (unsigned)__popcll(em); }
            }
            }
        }
    } else {
        for (int i = tid; i < 1024; i += 512) { const int row = i >> 6, w = i & 63, t = q0 + row, lo = 32 * w;
            BM[row * BMS + w] = (t >= lo + 31) ? 0xffffffffu : ((t < lo) ? 0u : ((2u << (t - lo)) - 1u)); }
        DSA_STAGE(0);
    }
    __syncthreads();
    const int h = wave;
#pragma unroll 1
    for (int rpV = 0; rpV < RP_V; ++rpV) {
    asm volatile("s_waitcnt vmcnt(0)" ::: "memory");
    asm volatile("" :: "v"(bq0), "v"(bq1), "v"(gwv[0]), "v"(gwv[1]), "v"(gwv[2]), "v"(gwv[3]));
    __syncthreads();
    if (qt_next >= TOPK / 16) { dsa_prefetch_qi(zb, qt_next, lds, wave, lane); dsa_prefetch_ki(zb, qt_next, pk, wave, lane); }
    f32x4 o[4], lacc = {0.f, 0.f, 0.f, 0.f}, negm = {0.f, 0.f, 0.f, 0.f};
#pragma unroll
    for (int dt = 0; dt < 4; ++dt) o[dt] = (f32x4){0.f, 0.f, 0.f, 0.f};
    float m_run = 0.f;
    const int kofs0 = r16 * 128 + ((g ^ (r16 >> 1)) & 7) * 16, kofs1 = r16 * 128 + (((4 + g) ^ (r16 >> 1)) & 7) * 16;
    const int vofs = 32768 + (4 * g + ((lane & 15) >> 2)) * 32 + (lane & 3) * 8;
    bf16x8v ones = {0x3f80, 0x3f80, 0x3f80, 0x3f80, 0x3f80, 0x3f80, 0x3f80, 0x3f80};
    asm volatile("" : "+v"(ones));
    LAS const unsigned char* mlut = lds + DSA_MLUT_OFF;
    constexpr float THR = 8.0f;
    bool first = true;
#pragma unroll 1
    for (int mm = 0; mm < nmega; ++mm) {
        if (mm + 1 < nmega) DSA_STAGE(mm + 1);
        LAS unsigned char* slotb = lds + (mm & 1) * 65536;
        const int nsub = (nsteps - mm * 8) < 8 ? (nsteps - mm * 8) : 8;
#pragma unroll 1
        for (int u = 0; u < nsub; u += 2) {
            LAS unsigned char* slot = slotb + u * 4096;
            const int mwA = (int)(BM[r16 * BMS + mm * 8 + u] >> (4 * g)), mwB = (int)(BM[r16 * BMS + mm * 8 + u + 1] >> (4 * g));
            f32x4 s0, s1, s2, s3;
            { const bf16x8v ka0 = *(LAS const bf16x8v*)(slot + kofs0), ka1 = *(LAS const bf16x8v*)(slot + kofs1);
              const bf16x8v kb0 = *(LAS const bf16x8v*)(slot + 2048 + kofs0), kb1 = *(LAS const bf16x8v*)(slot + 2048 + kofs1);
              const bf16x8v kc0 = *(LAS const bf16x8v*)(slot + 4096 + kofs0), kc1 = *(LAS const bf16x8v*)(slot + 4096 + kofs1);
              const bf16x8v kd0 = *(LAS const bf16x8v*)(slot + 6144 + kofs0), kd1 = *(LAS const bf16x8v*)(slot + 6144 + kofs1);
              s0 = __builtin_amdgcn_mfma_f32_16x16x32_bf16(ka0, bq0, negm, 0, 0, 0); s1 = __builtin_amdgcn_mfma_f32_16x16x32_bf16(kb0, bq0, negm, 0, 0, 0);
              s2 = __builtin_amdgcn_mfma_f32_16x16x32_bf16(kc0, bq0, negm, 0, 0, 0); s3 = __builtin_amdgcn_mfma_f32_16x16x32_bf16(kd0, bq0, negm, 0, 0, 0);
              s0 = __builtin_amdgcn_mfma_f32_16x16x32_bf16(ka1, bq1, s0, 0, 0, 0); s1 = __builtin_amdgcn_mfma_f32_16x16x32_bf16(kb1, bq1, s1, 0, 0, 0);
              s2 = __builtin_amdgcn_mfma_f32_16x16x32_bf16(kc1, bq1, s2, 0, 0, 0); s3 = __builtin_amdgcn_mfma_f32_16x16x32_bf16(kd1, bq1, s3, 0, 0, 0); }
            const int lmi = max(max(max(imax3(s0[0], s0[1], s0[2]), imax3(s0[3], s1[0], s1[1])), max(imax3(s1[2], s1[3], s2[0]), imax3(s2[1], s2[2], s2[3]))), max(imax3(s3[0], s3[1], s3[2]), __float_as_int(s3[3])));
            if (first || __any(lmi > 0x41000000)) {
                float lmx = fmaxf(fmaxf(fmaxf(fmaxf(s0[0], s0[1]), fmaxf(s0[2], s0[3])), fmaxf(fmaxf(s1[0], s1[1]), fmaxf(s1[2], s1[3]))), fmaxf(fmaxf(fmaxf(s2[0], s2[1]), fmaxf(s2[2], s2[3])), fmaxf(fmaxf(s3[0], s3[1]), fmaxf(s3[2], s3[3]))));
                { const auto r1 = __builtin_amdgcn_permlane16_swap(__float_as_uint(lmx), __float_as_uint(lmx), false, false); lmx = fmaxf(__uint_as_float(r1[0]), __uint_as_float(r1[1])); }
                { const auto r2 = __builtin_amdgcn_permlane32_swap(__float_as_uint(lmx), __float_as_uint(lmx), false, false); lmx = fmaxf(__uint_as_float(r2[0]), __uint_as_float(r2[1])); }
                const float dl = first ? lmx : fmaxf(lmx, 0.f);
                m_run += dl; const float f = first ? 1.0f : __builtin_amdgcn_exp2f(-dl);
#pragma unroll
                for (int i = 0; i < 4; ++i) { s0[i] -= dl; s1[i] -= dl; s2[i] -= dl; s3[i] -= dl; negm[i] = -m_run; }
                lacc = lacc * f;
#pragma unroll
                for (int dt = 0; dt < 4; ++dt) o[dt] = o[dt] * f;
                first = false;
            }
            const u32x2 mk0 = *(LAS const u32x2*)(mlut + ((mwA & 15) << 3)), mk1 = *(LAS const u32x2*)(mlut + (((mwA >> 16) & 15) << 3));
            const u32x2 mk2 = *(LAS const u32x2*)(mlut + ((mwB & 15) << 3)), mk3 = *(LAS const u32x2*)(mlut + (((mwB >> 16) & 15) << 3));
            u32x4 pwA, pwB;
            pwA.x = cvtpk(__builtin_amdgcn_exp2f(s0[0]), __builtin_amdgcn_exp2f(s0[1])) & mk0.x; pwA.y = cvtpk(__builtin_amdgcn_exp2f(s0[2]), __builtin_amdgcn_exp2f(s0[3])) & mk0.y;
            pwA.z = cvtpk(__builtin_amdgcn_exp2f(s1[0]), __builtin_amdgcn_exp2f(s1[1])) & mk1.x; pwA.w = cvtpk(__builtin_amdgcn_exp2f(s1[2]), __builtin_amdgcn_exp2f(s1[3])) & mk1.y;
            pwB.x = cvtpk(__builtin_amdgcn_exp2f(s2[0]), __builtin_amdgcn_exp2f(s2[1])) & mk2.x; pwB.y = cvtpk(__builtin_amdgcn_exp2f(s2[2]), __builtin_amdgcn_exp2f(s2[3])) & mk2.y;
            pwB.z = cvtpk(__builtin_amdgcn_exp2f(s3[0]), __builtin_amdgcn_exp2f(s3[1])) & mk3.x; pwB.w = cvtpk(__builtin_amdgcn_exp2f(s3[2]), __builtin_amdgcn_exp2f(s3[3])) & mk3.y;
            const bf16x8v pfA = __builtin_bit_cast(bf16x8v, pwA), pfB = __builtin_bit_cast(bf16x8v, pwB);
            lacc = __builtin_amdgcn_mfma_f32_16x16x32_bf16(ones, pfA, lacc, 0, 0, 0);
            lacc = __builtin_amdgcn_mfma_f32_16x16x32_bf16(ones, pfB, lacc, 0, 0, 0);
#pragma unroll
            for (int dt = 0; dt < 4; ++dt) {
                const s16x4v lo = lds_tr16(slot + vofs + dt * 1024), hi = lds_tr16(slot + vofs + dt * 1024 + 512);
                const s16x4v lo2 = lds_tr16(slot + 4096 + vofs + dt * 1024), hi2 = lds_tr16(slot + 4096 + vofs + dt * 1024 + 512);
                const bf16x8v vf = {lo[0], lo[1], lo[2], lo[3], hi[0], hi[1], hi[2], hi[3]};
                const bf16x8v vf2 = {lo2[0], lo2[1], lo2[2], lo2[3], hi2[0], hi2[1], hi2[2], hi2[3]};
                o[dt] = __builtin_amdgcn_mfma_f32_16x16x32_bf16(vf, pfA, o[dt], 0, 0, 0);
                o[dt] = __builtin_amdgcn_mfma_f32_16x16x32_bf16(vf2, pfB, o[dt], 0, 0, 0);
            }
        }
        asm volatile("s_waitcnt vmcnt(0) lgkmcnt(0)" ::: "memory");
        __syncthreads();
    }
#undef DSA_STAGE
    const float inv = 1.0f / lacc[0];
    bf16* yrow = p.Y + ((size_t)b * SEQ + q0 + r16) * DM + 512 + h * 64;
#pragma unroll
    for (int dt = 0; dt < 4; ++dt) {
        const u32x2 gw = gwv[dt];
        const float g0 = __uint_as_float(gw.x << 16), g1 = __uint_as_float(gw.x & 0xffff0000u), g2 = __uint_as_float(gw.y << 16), g3 = __uint_as_float(gw.y & 0xffff0000u);
        u32x2 w; w.x = pk2(o[dt][0] * inv * siluf(g0), o[dt][1] * inv * siluf(g1)); w.y = pk2(o[dt][2] * inv * siluf(g2), o[dt][3] * inv * siluf(g3));
        *(u32x2*)(yrow + dt * 16 + 4 * g) = w;
    }
    __syncthreads();
    }
}
__device__ __forceinline__ int dsa_qt_of(int j, int i) { return (i == 0) ? 127 - j : (i == 1) ? 64 + j : (i == 2) ? 63 - j : j; }
__device__ __forceinline__ void dsa_phase_pre(const P& p, LAS unsigned char* lds, bf16x8v (&pk)[4]) {
    const int G = gridDim.x, wg = blockIdx.x, lane = threadIdx.x & 63, wave = __builtin_amdgcn_readfirstlane(threadIdx.x >> 6);
    const int b = (G == 256) ? (wg & 7) : (wg >> 7), qt = (G == 256) ? dsa_qt_of(wg >> 3, 0) : 127 - (wg & 127);
#pragma unroll
    for (int i = 0; i < 4; ++i) pk[i] = (bf16x8v){0, 0, 0, 0, 0, 0, 0, 0};
    if (wg < 1024 && qt >= TOPK / 16) { dsa_prefetch_qi(p.Z + (size_t)b * SEQ * ZP, qt, lds, wave, lane); dsa_prefetch_ki(p.Z + (size_t)b * SEQ * ZP, qt, pk, wave, lane); }
}
__device__ __forceinline__ void dsa_phase(const P& p, LAS unsigned char* lds, bf16x8v (&pk)[4]) {
    const int G = gridDim.x, wg = blockIdx.x;
    if (G == 256) {
        const int b = wg & 7, j = wg >> 3;
#pragma unroll 1
        for (int i = 0; i < 4; ++i) dsa_unit(p, b, dsa_qt_of(j, i), (i < 3) ? dsa_qt_of(j, i + 1) : -1, pk, lds);
    }
}
constexpr int LRU_WS_OFF = 139264;
constexpr int LRU_XB = 264 * 128;
constexpr int LRU_GB = 256 * 32;
constexpr int LRU_BUF = LRU_XB + LRU_GB;
__device__ __forceinline__ float fast_sigm(float x) { return __builtin_amdgcn_rcpf(1.0f + __expf(-x)); }
__device__ __forceinline__ void lru_unit(const P& p, int l, int b, int blk, int q4, LAS unsigned char* lds) {
    const int tid = threadIdx.x, lane = tid & 63, wave = __builtin_amdgcn_readfirstlane(tid >> 6), r16 = lane & 15, g = lane >> 4;
    const bf16* zb = p.Z + (size_t)b * SEQ * ZP;
    const int cA = blk * 64, dloc = q4 * 16 + r16, dg = blk * 64 + dloc;
    const unsigned lds_base = (unsigned)(uintptr_t)lds;
#define LRU_STAGE(r) do { const unsigned bb_ = lds_base + (unsigned)(((r) & 1) * LRU_BUF); \
        _Pragma("unroll") for (int i_ = 0; i_ < 5; ++i_) { const int pc_ = wave + 8 * i_; if (pc_ < 33) { const int rho_ = pc_ * 8 + (lane >> 3); int t_ = (r) * 256 - 3 + rho_; t_ = t_ < 0 ? 0 : (t_ > SEQ - 1 ? SEQ - 1 : t_); \
            const int ch_ = (lane & 7) ^ ((rho_ >> 1) & 7); glds16(zb + (size_t)t_ * ZP + C_XR + cA + ch_ * 8, (unsigned)__builtin_amdgcn_readfirstlane(bb_ + pc_ * 1024)); } } \
        { const int row_ = wave * 32 + (lane >> 1); glds16(zb + (size_t)((r) * 256 + row_) * ZP + C_GR + dg - r16 + (lane & 1) * 8, (unsigned)__builtin_amdgcn_readfirstlane(bb_ + LRU_XB + wave * 1024)); } } while (0)
    LRU_STAGE(0);
    float cwA[2][4][8], cbA[2][8];
#pragma unroll
    for (int s = 0; s < 2; ++s)
#pragma unroll
        for (int j = 0; j < 8; ++j) { const int c = cA + 32 * s + 8 * g + j; cbA[s][j] = p.conv_b[l * 512 + c];
#pragma unroll
            for (int k = 0; k < 4; ++k) cwA[s][k][j] = p.conv_w[(l * 4 + k) * 512 + c]; }
    bf16x8v bxf[2], baf[2];
#pragma unroll
    for (int s = 0; s < 2; ++s) { u32x4 wx, wa; unsigned tx[8], ta[8];
#pragma unroll
        for (int j = 0; j < 8; ++j) { const size_t idx = (((size_t)l * 8 + blk) * 64 + 32 * s + 8 * g + j) * 64 + dloc; tx[j] = f2bf(p.lru_wx[idx]); ta[j] = f2bf(p.lru_wa[idx]); }
        wx.x = tx[0] | (tx[1] << 16); wx.y = tx[2] | (tx[3] << 16); wx.z = tx[4] | (tx[5] << 16); wx.w = tx[6] | (tx[7] << 16);
        wa.x = ta[0] | (ta[1] << 16); wa.y = ta[2] | (ta[3] << 16); wa.z = ta[4] | (ta[5] << 16); wa.w = ta[6] | (ta[7] << 16);
        bxf[s] = __builtin_bit_cast(bf16x8v, wx); baf[s] = __builtin_bit_cast(bf16x8v, wa); }
    const float cw0 = p.conv_w[(l * 4 + 0) * 512 + dg], cw1 = p.conv_w[(l * 4 + 1) * 512 + dg], cw2 = p.conv_w[(l * 4 + 2) * 512 + dg], cw3 = p.conv_w[(l * 4 + 3) * 512 + dg];
    const float cb = p.conv_b[l * 512 + dg], bxv = p.lru_bx[l * 512 + dg], bav = p.lru_ba[l * 512 + dg];
    const float sp8 = -8.0f * log1pf(expf(-p.lru_a[l * 512 + dg]));
    asm volatile("" :: "v"(cwA[0][0][0]), "v"(cwA[1][3][7]), "v"(cbA[1][7]), "v"(bxf[0]), "v"(bxf[1]), "v"(baf[0]), "v"(baf[1]), "v"(cw0), "v"(cw1), "v"(cw2), "v"(cw3), "v"(cb), "v"(bxv), "v"(bav), "v"(sp8));
    LAS float* WS = (LAS float*)(lds + LRU_WS_OFF);
    float hrun = 0.f;
    asm volatile("s_waitcnt vmcnt(0)" ::: "memory");
#pragma unroll 1
    for (int round = 0; round < 8; ++round) {
        asm volatile("s_waitcnt vmcnt(8)" ::: "memory");
        __syncthreads();
        if (round + 1 < 8) LRU_STAGE(round + 1);
        LAS const unsigned char* xb = lds + (round & 1) * LRU_BUF; LAS const unsigned char* gb = xb + LRU_XB;
        const int tw = round * 256 + wave * 32;
        float hl[2][4], pl[2][4], gr4[2][4], PT[2], HT[2], PE[2], HE[2];
#pragma unroll
        for (int tau = 0; tau < 2; ++tau) {
            const int t0 = tw + 16 * tau, rho0 = wave * 32 + 16 * tau;
            bf16x8v af[2];
#pragma unroll
            for (int s = 0; s < 2; ++s) {
                float xc[8];
#pragma unroll
                for (int j = 0; j < 8; ++j) xc[j] = cbA[s][j];
#pragma unroll
                for (int k = 0; k < 4; ++k) { const int rho = rho0 + r16 + k; u32x4 w = *(LAS const u32x4*)(xb + rho * 128 + (((4 * s + g) ^ (rho >> 1)) & 7) * 16);
                    if (t0 + r16 - 3 + k < 0) w = (u32x4){0u, 0u, 0u, 0u};
                    xc[0] += cwA[s][k][0] * __uint_as_float(w.x << 16); xc[1] += cwA[s][k][1] * __uint_as_float(w.x & 0xffff0000u);
                    xc[2] += cwA[s][k][2] * __uint_as_float(w.y << 16); xc[3] += cwA[s][k][3] * __uint_as_float(w.y & 0xffff0000u);
                    xc[4] += cwA[s][k][4] * __uint_as_float(w.z << 16); xc[5] += cwA[s][k][5] * __uint_as_float(w.z & 0xffff0000u);
                    xc[6] += cwA[s][k][6] * __uint_as_float(w.w << 16); xc[7] += cwA[s][k][7] * __uint_as_float(w.w & 0xffff0000u); }
                u32x4 pw; pw.x = cvtpk(xc[0], xc[1]); pw.y = cvtpk(xc[2], xc[3]); pw.z = cvtpk(xc[4], xc[5]); pw.w = cvtpk(xc[6], xc[7]);
                af[s] = __builtin_bit_cast(bf16x8v, pw);
            }
            f32x4 gx = {0.f, 0.f, 0.f, 0.f}, ga = {0.f, 0.f, 0.f, 0.f};
            gx = __builtin_amdgcn_mfma_f32_16x16x32_bf16(af[0], bxf[0], gx, 0, 0, 0); gx = __builtin_amdgcn_mfma_f32_16x16x32_bf16(af[1], bxf[1], gx, 0, 0, 0);
            ga = __builtin_amdgcn_mfma_f32_16x16x32_bf16(af[0], baf[0], ga, 0, 0, 0); ga = __builtin_amdgcn_mfma_f32_16x16x32_bf16(af[1], baf[1], ga, 0, 0, 0);
            float xo[7];
#pragma unroll
            for (int m = 0; m < 7; ++m) { const int rho = rho0 + 4 * g + m;
                const unsigned short v = *(LAS const unsigned short*)(xb + rho * 128 + (((dloc >> 3) ^ (rho >> 1)) & 7) * 16 + (dloc & 7) * 2);
                xo[m] = (t0 + 4 * g - 3 + m >= 0) ? bf2f(v) : 0.f; }
            float Pr = 1.f, Hr = 0.f;
#pragma unroll
            for (int i = 0; i < 4; ++i) {
                const float xcv = cb + cw0 * xo[i] + cw1 * xo[i + 1] + cw2 * xo[i + 2] + cw3 * xo[i + 3];
                const float sx = fast_sigm(gx[i] + bxv), sa = fast_sigm(ga[i] + bav);
                const float la = sp8 * sa, a = __expf(la), y2 = 2.0f * la;
                const float ser = -y2 * (1.0f + y2 * (0.5f + y2 * (0.16666667f + y2 * (0.041666668f + y2 * (0.0083333338f + y2 * 0.0013888889f)))));
                const float em = (y2 > -0.25f) ? ser : (1.0f - __expf(y2));
                const float u = __builtin_amdgcn_sqrtf(em) * sx * xcv;
                Hr = a * Hr + u; Pr *= a; hl[tau][i] = Hr; pl[tau][i] = Pr;
                gr4[tau][i] = bf2f(*(LAS const unsigned short*)(gb + (rho0 + 4 * g + i) * 32 + r16 * 2));
            }
            float Pi = Pr, Hi = Hr;
            { const float Pl = __shfl_up(Pi, 16), Hl = __shfl_up(Hi, 16); if (g >= 1) { Hi = Pi * Hl + Hi; Pi = Pl * Pi; } }
            { const float Pl = __shfl_up(Pi, 32), Hl = __shfl_up(Hi, 32); if (g >= 2) { Hi = Pi * Hl + Hi; Pi = Pl * Pi; } }
            float Pe = __shfl_up(Pi, 16), He = __shfl_up(Hi, 16); if (g == 0) { Pe = 1.f; He = 0.f; }
            PT[tau] = __shfl(Pi, 48 + r16); HT[tau] = __shfl(Hi, 48 + r16); PE[tau] = Pe; HE[tau] = He;
        }
        HE[1] = PE[1] * HT[0] + HE[1]; PE[1] = PT[0] * PE[1];
        const float Pw = PT[0] * PT[1], Hw = PT[1] * HT[0] + HT[1];
        LAS float* wsr = WS + (round & 1) * 256;
        if (g == 0) { wsr[(wave * 16 + r16) * 2 + 0] = Pw; wsr[(wave * 16 + r16) * 2 + 1] = Hw; }
        asm volatile("s_waitcnt lgkmcnt(0)" ::: "memory");
        __builtin_amdgcn_s_barrier();
        asm volatile("" ::: "memory");
        float hc = hrun, hall = hrun;
#pragma unroll
        for (int w2 = 0; w2 < 8; ++w2) { if (w2 == wave) hc = hall; hall = wsr[(w2 * 16 + r16) * 2 + 0] * hall + wsr[(w2 * 16 + r16) * 2 + 1]; }
        hrun = hall;
#pragma unroll
        for (int tau = 0; tau < 2; ++tau) {
            const float hin = PE[tau] * hc + HE[tau];
            bf16* yp = p.Y + ((size_t)b * SEQ + tw + 16 * tau + 4 * g) * DM + dg;
#pragma unroll
            for (int i = 0; i < 4; ++i) { const float h = hl[tau][i] + pl[tau][i] * hin, gr = gr4[tau][i]; yp[(size_t)i * DM] = (bf16)f2bf(h * gr * fast_sigm(gr)); }
        }
    }
#undef LRU_STAGE
    __syncthreads();
}
__device__ __forceinline__ void lru_phase(const P& p, int l, LAS unsigned char* lds) {
    const int G = gridDim.x, wg = blockIdx.x;
#pragma unroll 1
    for (int u = wg; u < 256; u += G) lru_unit(p, l, (u >> 3) & 7, u & 7, u >> 6, lds);
}
#ifndef DSA_PHASE
#define DSA_PHASE dsa_phase
#endif
#ifndef LRU_PHASE
#define LRU_PHASE lru_phase
#endif
#ifndef RP_A
#define RP_A 1
#endif
#ifndef RP_L
#define RP_L 1
#endif
#ifndef RP_D
#define RP_D 1
#endif
#ifndef RP_C
#define RP_C 1
#endif
#ifndef RP_0
#define RP_0 1
#endif
template <int OFF> __device__ __forceinline__ unsigned long long karg_u64() {
    unsigned long long v; const unsigned long long kp = (unsigned long long)__builtin_amdgcn_kernarg_segment_ptr();
    asm volatile("s_load_dwordx2 %0, %1, %2\n\ts_waitcnt lgkmcnt(0)" : "=s"(v) : "s"(kp), "i"(OFF) : "memory");
    return v;
}
struct Args { const float* in[15]; float* out; unsigned char* ws; int ph_lo, ph_hi; };
__global__ void __launch_bounds__(512, 2) mega(Args a) {
    extern __shared__ __attribute__((aligned(16))) unsigned char lds_raw[];
    LAS unsigned char* lds = (LAS unsigned char*)lds_raw;
#define KARG(T, off) ((T)(__attribute__((address_space(1))) void*)karg_u64<(off)>())
#define LOADP() P p; { unsigned char* ws_ = KARG(unsigned char*, 128); \
        p.x = KARG(const float*, 0); p.c = KARG(const float*, 8); p.norm_g = KARG(const float*, 16); p.ada_w = KARG(const float*, 24); p.ada_b = KARG(const float*, 32); p.w_in = KARG(const float*, 40); \
        p.conv_w = KARG(const float*, 48); p.conv_b = KARG(const float*, 56); p.lru_wx = KARG(const float*, 64); p.lru_bx = KARG(const float*, 72); p.lru_wa = KARG(const float*, 80); p.lru_ba = KARG(const float*, 88); \
        p.lru_a = KARG(const float*, 96); p.w_out = KARG(const float*, 104); p.final_g = KARG(const float*, 112); p.out = KARG(float*, 120); \
        p.ctl = (unsigned*)(ws_ + WS_CTL); p.mod = (float*)(ws_ + WS_MOD); p.bias = (float*)(ws_ + WS_BIAS); p.ssq = (float*)(ws_ + WS_SSQ); \
        p.wt_in = (bf16*)(ws_ + WS_WTIN); p.wt_out = (bf16*)(ws_ + WS_WTOUT); p.A = (bf16*)(ws_ + WS_A); p.Z = (bf16*)(ws_ + WS_Z); p.Y = (bf16*)(ws_ + WS_Y); p.X1 = (bf16*)(ws_ + WS_X1); }
    unsigned* const ctl0 = (unsigned*)((unsigned char*)a.ws + WS_CTL);
    const int lo = a.ph_lo, hi = a.ph_hi;
    volatile LAS unsigned* MISC = (volatile LAS unsigned*)(lds + MISC_OFF + 4096);
    if (threadIdx.x < 4) MISC[threadIdx.x] = 0u;
    if (threadIdx.x < 16) { const unsigned t = threadIdx.x; u32x2 m; m.x = ((t & 1u) ? 0xffffu : 0u) | ((t & 2u) ? 0xffff0000u : 0u); m.y = ((t & 4u) ? 0xffffu : 0u) | ((t & 8u) ? 0xffff0000u : 0u);
        *(LAS u32x2*)(lds + DSA_MLUT_OFF + t * 8) = m; }
    __syncthreads();
    XcdBarrier bar; bar.bar = ctl0 + CW_BAR; bar.x = 0; bar.st = MISC;
    if (hi - lo > 1) bar = xcd_barrier_post(ctl0 + CW_BAR, MISC);
#define IN(k) (lo <= (k) && (k) < hi)
#ifndef N_CG_SEAMS
#define N_CG_SEAMS 0
#endif
#define SEAM(k) do { if (IN(k) && IN((k) + 1)) { if ((k) < N_CG_SEAMS) cg::this_grid().sync(); else xcd_barrier(bar); } } while (0)
    if (IN(0)) { LOADP(); ph0_prologue(p, lds); if (RP_0 > 1) { __syncthreads(); ph0_prologue(p, lds); } }
    SEAM(0);
    if (IN(1)) { LOADP(); ph1_prologue(p, lds); if (RP_0 > 1) { __syncthreads(); ph1_prologue(p, lds); } }
    SEAM(1);
#ifdef PROBE_BAR
#define SEAM_X(b) do { SEAM(b); SEAM(b); SEAM(b); SEAM(b); } while (0)
#else
#define SEAM_X(b) do { } while (0)
#endif
#define LAYER(l, base) \
    if (IN(base)) { LOADP(); \
        pg8::Gemm g{p.A, p.wt_in + (size_t)(l) * ZP * 1024, MROWS, ZP, DM}; pg8::StaticOrder S; S.init(MROWS, ZP, (int)gridDim.x, (int)blockIdx.x); \
        EpiZ E{p.Z, p.ssq, p.bias + (size_t)(l) * 8 * ZP}; \
        pg8::gemm_phase<EpiZ, pg8::StaticOrder, PG8_ALIGN, PG8_SP2>(lds, g, S, E); if (RP_A > 1) { __syncthreads(); pg8::gemm_phase<EpiZ, pg8::StaticOrder, PG8_ALIGN, PG8_SP2>(lds, g, S, E); } \
    } \
    SEAM(base); SEAM_X(base); \
    if (IN((base) + 1)) { LOADP(); bf16x8v pk0[4]; dsa_phase_pre(p, lds, pk0); LRU_PHASE(p, (l), lds); __syncthreads(); DSA_PHASE(p, lds, pk0); } \
    SEAM((base) + 1); \
    if (IN((base) + 2)) { LOADP(); \
        pg8::Gemm g{p.Y, p.wt_out + (size_t)(l) * 1024 * 1024, MROWS, DM, DM}; pg8::StaticOrder S; S.init(MROWS, DM, (int)gridDim.x, (int)blockIdx.x); \
        if constexpr ((l) == DEPTH - 1) { \
            EpiXF E{p.X1, p.out, p.mod + (size_t)(l) * 8 * 3072 + 2048, p.final_g, p.ssq, p.ctl + CW_PANEL}; \
            pg8::gemm_phase<EpiXF, pg8::StaticOrder, false, PG8_SP2>(lds, g, S, E); \
        } else { \
            EpiX E{p.x, p.X1, p.A, p.mod + (size_t)(l) * 8 * 3072 + 2048, p.norm_g + (size_t)((l) + 1) * 1024, p.mod + (size_t)((l) + 1) * 8 * 3072 + 1024, p.ssq}; \
            pg8::gemm_phase<EpiX, pg8::StaticOrder, false, PG8_SP2>(lds, g, S, E); if (RP_C > 1 && (l) == 0) { __syncthreads(); pg8::gemm_phase<EpiX, pg8::StaticOrder, false, PG8_SP2>(lds, g, S, E); } \
        } \
    } \
    if ((base) + 3 < NPHASE) SEAM((base) + 2);
    LAYER(0, 2)
    LAYER(1, 5)
}
#ifndef MK_N_LAUNCHES
#define MK_N_LAUNCHES 1
#endif
extern "C" void kernel_launch(void* const* d_in, const int* in_sizes, int n_in, void* d_out, int out_size, void* d_ws, size_t ws_size, hipStream_t stream) {
    static int grid = 0;
    if (grid == 0) {
        if (n_in != 15 || out_size != MROWS * DM || ws_size < WS_END) { fprintf(stderr, "kernel_launch: unexpected problem (n_in %d out %d ws %zu)\n", n_in, out_size, ws_size); grid = -1; return; }
        int dev = 0, cus = 0, per_cu = 0;
        hipGetDevice(&dev); hipDeviceGetAttribute(&cus, hipDeviceAttributeMultiprocessorCount, dev);
        if (hipFuncSetAttribute((const void*)mega, hipFuncAttributeMaxDynamicSharedMemorySize, LDS_BYTES) != hipSuccess) { fprintf(stderr, "kernel_launch: hipFuncSetAttribute failed\n"); grid = -1; return; }
        if (hipOccupancyMaxActiveBlocksPerMultiprocessor(&per_cu, (const void*)mega, 512, LDS_BYTES) != hipSuccess || per_cu < 1) { fprintf(stderr, "kernel_launch: occupancy query failed (%d)\n", per_cu); per_cu = 1; }
        (void)hipGetLastError();
        grid = cus * per_cu;
        if (grid != 256) fprintf(stderr, "kernel_launch: grid %d (cus %d x %d) != 256: the fused out-projection epilogue needs exactly 256 workgroups\n", grid, cus, per_cu);
    }
    if (grid < 0) return;
    hipMemsetAsync((char*)d_ws + WS_CTL, 0, CTL_ZERO_BYTES, stream);
    Args a{};
    for (int i = 0; i < 15; ++i) a.in[i] = (const float*)d_in[i];
    a.out = (float*)d_out; a.ws = (unsigned char*)d_ws;
#if MK_N_LAUNCHES == 1
    a.ph_lo = 0; a.ph_hi = NPHASE;
    void* args[] = {&a};
    hipError_t e = hipLaunchCooperativeKernel((const void*)mega, dim3(grid), dim3(512), args, LDS_BYTES, stream);
    if (e != hipSuccess) fprintf(stderr, "cooperative launch failed: %s (grid %d)\n", hipGetErrorString(e), grid);
#else
    for (int ph = 0; ph < NPHASE; ++ph) { a.ph_lo = ph; a.ph_hi = ph + 1; hipLaunchKernelGGL(mega, dim3(grid), dim3(512), LDS_BYTES, stream, a); }
#endif
}
```

```cpp
#include <hip/hip_runtime.h>
#include <hip/hip_cooperative_groups.h>
#include <cstdio>
#include <cstdint>
#include <cmath>
namespace cg = cooperative_groups;
#define EPI_XD 4
#define EPI_ZD 8
#define HIST_WAVES 8
#define PRO_KC 64
#define HISTA_FALLBACK 1
#define WALK_MAX 4
#define XB_FLAT_RELEASE 1
namespace pg8 {
#define PG8_LAS __attribute__((address_space(3)))
typedef unsigned short bf16_t;
typedef short bf16x8 __attribute__((ext_vector_type(8)));
typedef float f32x4 __attribute__((ext_vector_type(4)));
typedef unsigned u32x4 __attribute__((ext_vector_type(4)));
constexpr int BM = 256, BK = 64, HALF = 128, HTB = HALF * BK * 2  , STAGE_BYTES = 8 * HTB, NXCD = 8, WGM = 8;

__host__ __device__ __forceinline__ int lds_byte(int r, int c) { const int st = (r >> 4) * 2 + (c >> 5), rr = r & 15, cc = c & 31, ob = rr * 64 + cc * 2; return st * 1024 + (ob ^ (((ob >> 9) & 1) << 5)); }
__host__ __device__ __forceinline__ void stage_rc(int b, int& R, int& C) { const int st = b / 1024, sb = b % 1024, swz = sb ^ (((sb >> 9) & 1) << 5); R = (st >> 1) * 16 + swz / 64; C = (st & 1) * 32 + (swz % 64) / 2; }
__host__ __device__ __forceinline__ int perm32(int rho) { const int n = rho >> 4, i = rho & 15; return 8 * (i >> 2) + 4 * n + (i & 3); }

struct Unit { int pm, pn; };
struct Gemm { const bf16_t* A; const bf16_t* Bt; int M, N, K; };

struct StaticOrder {
    int nM, nN, nwg, G, c;
    __host__ __device__ void init(int M, int N, int G_, int c_) { nM = M / BM; nN = N / BM; nwg = nM * nN; G = G_; c = c_; }
    __host__ __device__ bool next(int i, Unit& u) const {
        const long L = (long)i * G + c; if (L >= nwg) return false;
        int wgid = (int)L; { const int q = nwg / NXCD, r = nwg % NXCD, xcd = wgid % NXCD, off = wgid / NXCD; wgid = (xcd < r ? xcd * (q + 1) : r * (q + 1) + (xcd - r) * q) + off; }
        const int nig = WGM * nN, gid = wgid / nig, fm = gid * WGM, gsz = (nM - fm) < WGM ? (nM - fm) : WGM;
        u.pm = fm + ((wgid % nig) % gsz); u.pn = (wgid % nig) / gsz; return true;
    }
    __device__ __forceinline__ void a_ready(const Unit&) const {}
    __device__ __forceinline__ void done(const Unit&) const {}
};

__device__ __forceinline__ unsigned cvt_pk_bf16(float lo, float hi) { unsigned r; asm volatile("v_cvt_pk_bf16_f32 %0, %1, %2" : "=v"(r) : "v"(lo), "v"(hi)); return r; }
typedef float f32x2 __attribute__((ext_vector_type(2)));
template <class Epi, class Sched, bool ALIGN_EPI = false, bool SP2 = false>
__device__ __forceinline__ void gemm_phase(PG8_LAS unsigned char* lds, const Gemm g, const Sched& S, const Epi& E) {
    const int tid = threadIdx.x, wid = __builtin_amdgcn_readfirstlane(tid >> 6), lane = tid & 63, wr = wid >> 2, wc = wid & 3, fr = lane & 15, fq = lane >> 4;
    const int K = g.K, nt = K / BK;
    unsigned voffA[2], voffB[2];
#pragma unroll
    for (int i = 0; i < 2; ++i) { int R, C; stage_rc(tid * 16 + i * 8192, R, C); const int Rb = Epi::PERM ? ((R & ~31) + perm32(R & 31)) : R;
        voffA[i] = (unsigned)(R * K + C) * 2u; voffB[i] = (unsigned)(Rb * K + C) * 2u; }
    const size_t kstep = (size_t)(BK * 2);
    const size_t hstep = (size_t)HALF * K * 2;
    const size_t tstep = 2 * hstep;
    const unsigned ldsw = (unsigned)wid * 1024u;
    const int aoff = lds_byte(wr * 64 + fr, fq * 8), boff = lds_byte(wc * 32 + fr, fq * 8);
#define PG8_SA(b, h) (((b) * 2 + (h)) * HTB)
#define PG8_SB(b, h) ((4 + (b) * 2 + (h)) * HTB)
#define PG8_STAGE(bufoff, gbase, voff) do { _Pragma("unroll") for (int _i = 0; _i < 2; ++_i) \
        __builtin_amdgcn_global_load_lds((const unsigned*)((const char*)(gbase) + (voff)[_i]), (PG8_LAS unsigned*)(lds + (bufoff) + ldsw + _i * 8192), 16, 0, 0); } while (0)
#define PG8_LDA(dst, b, h) do { _Pragma("unroll") for (int m = 0; m < 4; ++m) _Pragma("unroll") for (int k = 0; k < 2; ++k) dst[m][k] = *(const PG8_LAS bf16x8*)(lds + PG8_SA(b, h) + aoff + m * 2048 + k * 1024); } while (0)
#define PG8_LDB(dst, b, h) do { _Pragma("unroll") for (int n = 0; n < 2; ++n) _Pragma("unroll") for (int k = 0; k < 2; ++k) dst[n][k] = *(const PG8_LAS bf16x8*)(lds + PG8_SB(b, h) + boff + n * 2048 + k * 1024); } while (0)
#define PG8_MMA(ai, bj, At, Bt) do { __builtin_amdgcn_s_setprio(1); _Pragma("unroll") for (int m = 0; m < 4; ++m) _Pragma("unroll") for (int n = 0; n < 2; ++n) _Pragma("unroll") for (int k = 0; k < 2; ++k) \
        acc[ai][bj][m][n] = __builtin_amdgcn_mfma_f32_16x16x32_bf16(Bt[n][k], At[m][k], acc[ai][bj][m][n], 0, 0, 0); __builtin_amdgcn_s_setprio(0); } while (0)
#define PG8_WAIT_V(n) asm volatile("s_waitcnt vmcnt(" #n ")" ::: "memory")
#define PG8_WAIT_L(n) asm volatile("s_waitcnt lgkmcnt(" #n ")" ::: "memory")
#define PG8_BAR __builtin_amdgcn_s_barrier()
#define PG8_SCHED __builtin_amdgcn_sched_barrier(0)
    Unit cur, nxt; int ui = 0;
    if (!S.next(0, cur)) return;
    f32x4 acc[2][2][4][2];
#pragma unroll
    for (int a = 0; a < 2; ++a)
#pragma unroll
        for (int b = 0; b < 2; ++b)
#pragma unroll
            for (int m = 0; m < 4; ++m)
#pragma unroll
                for (int n = 0; n < 2; ++n) acc[a][b][m][n] = (f32x4){0.f, 0.f, 0.f, 0.f};
    bf16x8 At[4][2], B0[2][2], B1[2][2];
    const char* cA = (const char*)g.A + (size_t)cur.pm * tstep; const char* cB = (const char*)g.Bt + (size_t)cur.pn * tstep;
    S.a_ready(cur);
    if constexpr (SP2) {
        PG8_STAGE(PG8_SB(0, 0), cB, voffB); PG8_STAGE(PG8_SB(0, 1), cB + hstep, voffB); PG8_STAGE(PG8_SA(0, 0), cA, voffA); PG8_STAGE(PG8_SA(0, 1), cA + hstep, voffA);
        if (wr == 1) PG8_BAR;
        PG8_WAIT_V(2); PG8_BAR;
        PG8_STAGE(PG8_SB(1, 0), cB + kstep, voffB); PG8_STAGE(PG8_SA(1, 0), cA + kstep, voffA); PG8_STAGE(PG8_SB(1, 1), cB + hstep + kstep, voffB);
        PG8_WAIT_V(6); PG8_BAR;
    } else {
        PG8_STAGE(PG8_SB(0, 0), cB, voffB); PG8_STAGE(PG8_SA(0, 0), cA, voffA); PG8_STAGE(PG8_SB(0, 1), cB + hstep, voffB); PG8_STAGE(PG8_SA(0, 1), cA + hstep, voffA);
        if (wr == 1) PG8_BAR;
        PG8_WAIT_V(4); PG8_BAR;
        PG8_STAGE(PG8_SB(1, 0), cB + kstep, voffB); PG8_STAGE(PG8_SA(1, 0), cA + kstep, voffA); PG8_STAGE(PG8_SB(1, 1), cB + hstep + kstep, voffB);
        PG8_WAIT_V(6); PG8_BAR;
    }
    for (;;) {
        const bool has_next = S.next(ui + 1, nxt);
        const char* nA = has_next ? (const char*)g.A + (size_t)nxt.pm * tstep : cA; const char* nB = has_next ? (const char*)g.Bt + (size_t)nxt.pn * tstep : cB;
        for (int t = 0; t < nt; t += 2) {
            const bool last = (t == nt - 2);
            const char* a1 = cA + (size_t)(t + 1) * kstep;
            const char* a2 = last ? nA : cA + (size_t)(t + 2) * kstep; const char* b2 = last ? nB : cB + (size_t)(t + 2) * kstep;
            const char* a3 = a2 + kstep; const char* b3 = b2 + kstep;
            if (last && has_next) S.a_ready(nxt);
            if constexpr (SP2) {
            PG8_LDB(B0, 0, 0); PG8_LDB(B1, 0, 1); PG8_SCHED; PG8_LDA(At, 0, 0); PG8_STAGE(PG8_SA(1, 1), a1 + hstep, voffA);
            PG8_WAIT_V(8); PG8_WAIT_L(0); PG8_BAR; PG8_MMA(0, 0, At, B0); PG8_MMA(0, 1, At, B1); PG8_BAR; PG8_SCHED;
            PG8_LDA(At, 0, 1); PG8_STAGE(PG8_SB(0, 0), b2, voffB); PG8_STAGE(PG8_SB(0, 1), b2 + hstep, voffB); PG8_STAGE(PG8_SA(0, 0), a2, voffA);
            PG8_WAIT_V(8); PG8_WAIT_L(0); PG8_BAR; PG8_MMA(1, 0, At, B0); PG8_MMA(1, 1, At, B1); PG8_BAR; PG8_SCHED;
            PG8_LDB(B0, 1, 0); PG8_LDB(B1, 1, 1); PG8_SCHED; PG8_LDA(At, 1, 0); PG8_STAGE(PG8_SA(0, 1), a2 + hstep, voffA);
            PG8_WAIT_V(8); PG8_WAIT_L(0); PG8_BAR; PG8_MMA(0, 0, At, B0); PG8_MMA(0, 1, At, B1); PG8_BAR; PG8_SCHED;
            PG8_LDA(At, 1, 1); PG8_STAGE(PG8_SB(1, 0), b3, voffB); PG8_STAGE(PG8_SB(1, 1), b3 + hstep, voffB); PG8_STAGE(PG8_SA(1, 0), a3, voffA);
            PG8_WAIT_V(8); PG8_WAIT_L(0); PG8_BAR; PG8_MMA(1, 0, At, B0); PG8_MMA(1, 1, At, B1); PG8_BAR; PG8_SCHED;
            } else {
            PG8_LDB(B0, 0, 0); PG8_SCHED; PG8_LDA(At, 0, 0); PG8_STAGE(PG8_SA(1, 1), a1 + hstep, voffA);
            PG8_WAIT_L(8); PG8_BAR; PG8_WAIT_L(0); PG8_MMA(0, 0, At, B0); PG8_BAR; PG8_SCHED;
            PG8_LDB(B1, 0, 1); PG8_STAGE(PG8_SB(0, 0), b2, voffB);
            PG8_BAR; PG8_WAIT_L(0); PG8_MMA(0, 1, At, B1); PG8_BAR;
            PG8_LDA(At, 0, 1); PG8_STAGE(PG8_SA(0, 0), a2, voffA);
            PG8_BAR; PG8_WAIT_L(0); PG8_MMA(1, 0, At, B0); PG8_BAR; PG8_SCHED;
            PG8_STAGE(PG8_SB(0, 1), b2 + hstep, voffB);
            PG8_WAIT_V(6); PG8_BAR; PG8_MMA(1, 1, At, B1); PG8_BAR;
            PG8_LDB(B0, 1, 0); PG8_SCHED; PG8_LDA(At, 1, 0); PG8_STAGE(PG8_SA(0, 1), a2 + hstep, voffA);
            PG8_WAIT_L(8); PG8_BAR; PG8_WAIT_L(0); PG8_MMA(0, 0, At, B0); PG8_BAR; PG8_SCHED;
            PG8_LDB(B1, 1, 1); PG8_STAGE(PG8_SB(1, 0), b3, voffB);
            PG8_BAR; PG8_WAIT_L(0); PG8_MMA(0, 1, At, B1); PG8_BAR;
            PG8_LDA(At, 1, 1); PG8_STAGE(PG8_SA(1, 0), a3, voffA);
            PG8_BAR; PG8_WAIT_L(0); PG8_MMA(1, 0, At, B0); PG8_BAR; PG8_SCHED;
            PG8_STAGE(PG8_SB(1, 1), b3 + hstep, voffB);
            PG8_WAIT_V(6); PG8_BAR; PG8_MMA(1, 1, At, B1); PG8_BAR;
            }
        }
        if constexpr (ALIGN_EPI) { if (wr == 0) PG8_BAR; }
        if constexpr (!Epi::AFTER_DRAIN) { E(acc, cur, wr, wc, fr, fq); S.done(cur); }
        if (!has_next) break;
#pragma unroll
        for (int a = 0; a < 2; ++a)
#pragma unroll
            for (int b = 0; b < 2; ++b)
#pragma unroll
                for (int m = 0; m < 4; ++m)
#pragma unroll
                    for (int n = 0; n < 2; ++n) acc[a][b][m][n] = (f32x4){0.f, 0.f, 0.f, 0.f};
        cur = nxt; cA = nA; cB = nB; ++ui;
        if constexpr (ALIGN_EPI) { if (wr == 1) PG8_BAR; }
    }
    PG8_WAIT_V(0);
    if constexpr (!ALIGN_EPI) { if (wr == 0) PG8_BAR; }
    PG8_BAR;
    if constexpr (Epi::AFTER_DRAIN) { E.fused(acc, cur, wr, wc, fr, fq, lds, wid, lane); S.done(cur); }
#undef PG8_SA
#undef PG8_SB
#undef PG8_STAGE
#undef PG8_LDA
#undef PG8_LDB
#undef PG8_MMA
#undef PG8_WAIT_V
#undef PG8_WAIT_L
#undef PG8_BAR
#undef PG8_SCHED
}
}

#ifndef PG8_SP2
#define PG8_SP2 true
#endif
#ifndef PG8_ALIGN
#define PG8_ALIGN true
#endif
constexpr int BATCH = 8, SEQ = 2048, DM = 1024, MROWS = BATCH * SEQ, DEPTH = 2;
constexpr int D_RNN = 512, NHEAD = 8, HDIM = 64, D_INR = 2760, ZP = 2816, TOPK = 256;
constexpr int C_XR = 0, C_GR = 512, C_Q = 1024, C_K = 1536, C_V = 1600, C_GA = 1664, C_QI = 2176, C_KI = 2688, C_WI = 2752;
constexpr float EPS = 1e-6f;
constexpr float QSCALE = 0.125f * 1.4426950408889634f;
constexpr size_t MiB = 1u << 20;
constexpr size_t WS_CTL = 0, CTL_ZERO_BYTES = 1 * MiB;
constexpr size_t WS_MOD = 1 * MiB;
constexpr size_t WS_BIAS = 1 * MiB + 256 * 1024;
constexpr size_t WS_SSQ = 2 * MiB;
constexpr size_t WS_WTIN = 3 * MiB;
constexpr size_t WS_WTOUT = 14 * MiB;
constexpr size_t WS_A = 32 * MiB;
constexpr size_t WS_Z = 64 * MiB;
constexpr size_t WS_Y = 152 * MiB;
constexpr size_t WS_X1 = 184 * MiB;
constexpr size_t WS_END = 216 * MiB;
constexpr int LDS_BYTES = 163840;
constexpr int MISC_OFF = 131072 + 8192;
constexpr int NPHASE = 8;
constexpr int CW_BAR = 4096, CW_PANEL = 16384;

#define LAS __attribute__((address_space(3)))
typedef unsigned short bf16;
typedef float f32x4 __attribute__((ext_vector_type(4)));
typedef unsigned u32x4 __attribute__((ext_vector_type(4)));
typedef unsigned u32x2 __attribute__((ext_vector_type(2)));
__device__ __forceinline__ float bf2f(bf16 v) { return __uint_as_float(((unsigned)v) << 16); }
__device__ __forceinline__ unsigned f2bf(float f) { unsigned u = __float_as_uint(f); return (u + 0x7fffu + ((u >> 16) & 1u)) >> 16; }
__device__ __forceinline__ unsigned pk2(float lo, float hi) { return f2bf(lo) | (f2bf(hi) << 16); }
__device__ __forceinline__ float wave_sum(float v) {
#pragma unroll
    for (int o = 1; o < 64; o <<= 1) v += __shfl_xor(v, o);
    return v;
}
__device__ __forceinline__ float wave_max(float v) {
#pragma unroll
    for (int o = 1; o < 64; o <<= 1) v = fmaxf(v, __shfl_xor(v, o));
    return v;
}
__device__ __forceinline__ int wave_sum_i(int v) {
#pragma unroll
    for (int o = 1; o < 64; o <<= 1) v += __shfl_xor(v, o);
    return v;
}
__device__ __forceinline__ float siluf(float v) { return v / (1.f + expf(-v)); }
__device__ __forceinline__ float sigmf(float v) { return 1.f / (1.f + expf(-v)); }

#ifdef USE_NT
#define NT_STORE(ptr, val) __builtin_nontemporal_store((val), (ptr))
#else
#define NT_STORE(ptr, val) (*(ptr) = (val))
#endif
struct P {
    const float *x, *c, *norm_g, *ada_w, *ada_b, *w_in, *conv_w, *conv_b, *lru_wx, *lru_bx, *lru_wa, *lru_ba, *lru_a, *w_out, *final_g;
    float* out;
    float *mod, *bias, *ssq;
    bf16 *wt_in, *wt_out, *A, *Z, *Y, *X1;
    unsigned* ctl;
};

#ifndef EPI_ZD
#define EPI_ZD 2
#endif
struct EpiZ {
    static constexpr bool PERM = true, AFTER_DRAIN = false;
    bf16* Zp; const float* ssq; const float* bias;
    __device__ __forceinline__ void operator()(const pg8::f32x4 (&acc)[2][2][4][2], const pg8::Unit& u, int wr, int wc, int fr, int fq) const {
        const int row0 = u.pm * 256 + wr * 64 + fr, col0 = u.pn * 256 + wc * 32 + 8 * fq, b = u.pm >> 3;
        const float cs = (u.pn == 4 || u.pn == 5) ? QSCALE : 1.0f;
        f32x4 bv[2][2];
#pragma unroll
        for (int bj = 0; bj < 2; ++bj)
#pragma unroll
            for (int n = 0; n < 2; ++n) bv[bj][n] = *(const f32x4*)(bias + b * ZP + col0 + bj * 128 + 4 * n);
        f32x4 qq[EPI_ZD];
#pragma unroll
        for (int gi = 0; gi < EPI_ZD; ++gi) qq[gi] = *(const f32x4*)(ssq + (size_t)(row0 + (gi >> 2) * 128 + (gi & 3) * 16) * 4);
#pragma unroll
        for (int ai = 0; ai < 2; ++ai)
#pragma unroll
            for (int m = 0; m < 4; ++m) {
                const int r = row0 + ai * 128 + m * 16, gi = ai * 4 + m;
                const f32x4 q = qq[gi % EPI_ZD];
                if (gi + EPI_ZD < 8) qq[gi % EPI_ZD] = *(const f32x4*)(ssq + (size_t)(row0 + ((gi + EPI_ZD) >> 2) * 128 + ((gi + EPI_ZD) & 3) * 16) * 4);
                const float rstd = __builtin_amdgcn_rsqf(((q.x + q.y) + (q.z + q.w)) * (1.0f / 1024.0f) + EPS);
                bf16* rowp = Zp + (size_t)r * ZP + col0;
#pragma unroll
                for (int bj = 0; bj < 2; ++bj) {
                    const f32x4 v0 = (acc[ai][bj][m][0] * rstd + bv[bj][0]) * cs, v1 = (acc[ai][bj][m][1] * rstd + bv[bj][1]) * cs;
                    u32x4 w; w.x = pk2(v0[0], v0[1]); w.y = pk2(v0[2], v0[3]); w.z = pk2(v1[0], v1[1]); w.w = pk2(v1[2], v1[3]);
                    NT_STORE((u32x4*)(rowp + bj * 128), w);
                }
            }
    }
};
#ifndef EPI_XD
#define EPI_XD 4
#endif
struct EpiX {
    static constexpr bool PERM = true, AFTER_DRAIN = true;
    const float* xres; bf16* xout; bf16* Anext; const float* gate; const float* ng; const float* nscale; float* ssq;
    __device__ __forceinline__ void fused(pg8::f32x4 (&acc)[2][2][4][2], const pg8::Unit& u, int wr, int wc, int fr, int fq, LAS unsigned char* lds, int wid, int lane) const {
        const int b = u.pm >> 3, col0 = u.pn * 256 + wc * 32 + 8 * fq;
        LAS float* Pp = (LAS float*)lds;
        f32x4 gv[2][2], gs[2][2];
#pragma unroll
        for (int bj = 0; bj < 2; ++bj)
#pragma unroll
            for (int n = 0; n < 2; ++n) {
                gv[bj][n] = *(const f32x4*)(gate + b * 3072 + col0 + bj * 128 + 4 * n);
                if (Anext) { const f32x4 g = *(const f32x4*)(ng + col0 + bj * 128 + 4 * n), s = *(const f32x4*)(nscale + b * 3072 + col0 + bj * 128 + 4 * n); gs[bj][n] = g * (s + 1.0f); }
                else gs[bj][n] = (f32x4){0.f, 0.f, 0.f, 0.f};
            }
        f32x4 xq[EPI_XD][2][2];
#define EPIX_LOAD(gi) do { const size_t r_ = (size_t)u.pm * 256 + ((gi) >> 2) * 128 + wr * 64 + ((gi) & 3) * 16 + fr; \
        _Pragma("unroll") for (int bj = 0; bj < 2; ++bj) _Pragma("unroll") for (int n = 0; n < 2; ++n) xq[(gi) % EPI_XD][bj][n] = *(const f32x4*)(xres + r_ * DM + col0 + bj * 128 + 4 * n); } while (0)
#pragma unroll
        for (int gi = 0; gi < EPI_XD; ++gi) EPIX_LOAD(gi);
#pragma unroll
        for (int ai = 0; ai < 2; ++ai)
#pragma unroll
            for (int m = 0; m < 4; ++m) {
                const int rl = ai * 128 + wr * 64 + m * 16 + fr; const size_t r = (size_t)u.pm * 256 + rl;
                float s = 0.f;
                f32x4 xc[2][2];
#pragma unroll
                for (int bj = 0; bj < 2; ++bj)
#pragma unroll
                    for (int n = 0; n < 2; ++n) xc[bj][n] = xq[(ai * 4 + m) % EPI_XD][bj][n];
                if (ai * 4 + m + EPI_XD < 8) EPIX_LOAD(ai * 4 + m + EPI_XD);
#pragma unroll
                for (int bj = 0; bj < 2; ++bj) {
                    f32x4 x1[2];
#pragma unroll
                    for (int n = 0; n < 2; ++n) {
                        const f32x4 xr = xc[bj][n];
                        x1[n] = xr + gv[bj][n] * acc[ai][bj][m][n];
                        s += (x1[n][0] * x1[n][0] + x1[n][1] * x1[n][1]) + (x1[n][2] * x1[n][2] + x1[n][3] * x1[n][3]);
                    }
                    { u32x4 xw; xw.x = pk2(x1[0][0], x1[0][1]); xw.y = pk2(x1[0][2], x1[0][3]); xw.z = pk2(x1[1][0], x1[1][1]); xw.w = pk2(x1[1][2], x1[1][3]);
                      NT_STORE((u32x4*)(xout + r * DM + col0 + bj * 128), xw); }
                    if (Anext) { const f32x4 a0 = x1[0] * gs[bj][0], a1 = x1[1] * gs[bj][1];
                        u32x4 w; w.x = pk2(a0[0], a0[1]); w.y = pk2(a0[2], a0[3]); w.z = pk2(a1[0], a1[1]); w.w = pk2(a1[2], a1[3]);
                        NT_STORE((u32x4*)(Anext + r * DM + col0 + bj * 128), w); }
                }
                s += __shfl_xor(s, 16); s += __shfl_xor(s, 32);
                if (fq == 0) Pp[rl * 4 + wc] = s;
            }
        __syncthreads();
        const int tid = wid * 64 + lane;
        if (tid < 256) ssq[((size_t)u.pm * 256 + tid) * 4 + u.pn] = (Pp[tid * 4 + 0] + Pp[tid * 4 + 1]) + (Pp[tid * 4 + 2] + Pp[tid * 4 + 3]);
        __syncthreads();
    }
};

struct EpiXF {
    static constexpr bool PERM = true, AFTER_DRAIN = true;
    const bf16* xres; float* out; const float* gate; const float* fg; float* ssq; unsigned* cnt;
    __device__ __forceinline__ void fused(pg8::f32x4 (&acc)[2][2][4][2], const pg8::Unit& u, int wr, int wc, int fr, int fq, LAS unsigned char* lds, int wid, int lane) const {
        const int b = u.pm >> 3, col0 = u.pn * 256 + wc * 32 + 8 * fq, tid = wid * 64 + lane;
        LAS float* Pp = (LAS float*)lds;
        LAS float* Sr = (LAS float*)(lds + 4096);
        {
            f32x4 gv[2][2];
#pragma unroll
            for (int bj = 0; bj < 2; ++bj)
#pragma unroll
                for (int n = 0; n < 2; ++n) gv[bj][n] = *(const f32x4*)(gate + b * 3072 + col0 + bj * 128 + 4 * n);
#pragma unroll
            for (int ai = 0; ai < 2; ++ai)
#pragma unroll
                for (int m = 0; m < 4; ++m) {
                    const int rl = ai * 128 + wr * 64 + m * 16 + fr; const size_t r = (size_t)u.pm * 256 + rl;
                    float s = 0.f;
#pragma unroll
                    for (int bj = 0; bj < 2; ++bj) {
                        const u32x4 xw = *(const u32x4*)(xres + r * DM + col0 + bj * 128);
#pragma unroll
                        for (int n = 0; n < 2; ++n) {
                            const unsigned w0 = n ? xw.z : xw.x, w1 = n ? xw.w : xw.y;
                            const f32x4 xr = {__uint_as_float(w0 << 16), __uint_as_float(w0 & 0xffff0000u), __uint_as_float(w1 << 16), __uint_as_float(w1 & 0xffff0000u)};
                            const f32x4 x1 = xr + gv[bj][n] * acc[ai][bj][m][n];
                            acc[ai][bj][m][n] = x1;
                            s += (x1[0] * x1[0] + x1[1] * x1[1]) + (x1[2] * x1[2] + x1[3] * x1[3]);
                        }
                    }
                    s += __shfl_xor(s, 16); s += __shfl_xor(s, 32);
                    if (fq == 0) Pp[rl * 4 + wc] = s;
                }
        }
        __syncthreads();
        if (tid < 256) { const float tot = (Pp[tid * 4 + 0] + Pp[tid * 4 + 1]) + (Pp[tid * 4 + 2] + Pp[tid * 4 + 3]);
            __hip_atomic_store(ssq + ((size_t)u.pm * 256 + tid) * 4 + u.pn, tot, __ATOMIC_RELAXED, __HIP_MEMORY_SCOPE_AGENT); }
        asm volatile("s_waitcnt vmcnt(0)" ::: "memory");
        __syncthreads();
        if (tid == 0) {
            unsigned* c = cnt + 64 * u.pm;
            __hip_atomic_fetch_add(c, 1u, __ATOMIC_RELAXED, __HIP_MEMORY_SCOPE_AGENT);
            unsigned spins = 0u;
            while (__hip_atomic_load(c, __ATOMIC_RELAXED, __HIP_MEMORY_SCOPE_AGENT) < 4u) { __builtin_amdgcn_s_sleep(2); if (++spins > (1u << 22)) break; }
            __builtin_amdgcn_fence(__ATOMIC_ACQUIRE, "agent");
            asm volatile("s_waitcnt vmcnt(0)" ::: "memory");
        }
        __syncthreads();
        if (tid < 256) { const float* sp = ssq + ((size_t)u.pm * 256 + tid) * 4;
            const float q0 = __hip_atomic_load(sp + 0, __ATOMIC_RELAXED, __HIP_MEMORY_SCOPE_AGENT), q1 = __hip_atomic_load(sp + 1, __ATOMIC_RELAXED, __HIP_MEMORY_SCOPE_AGENT);
            const float q2 = __hip_atomic_load(sp + 2, __ATOMIC_RELAXED, __HIP_MEMORY_SCOPE_AGENT), q3 = __hip_atomic_load(sp + 3, __ATOMIC_RELAXED, __HIP_MEMORY_SCOPE_AGENT);
            Sr[tid] = 1.0f / sqrtf(((q0 + q1) + (q2 + q3)) * (1.0f / 1024.0f) + EPS); }
        __syncthreads();
        f32x4 fgv[2][2];
#pragma unroll
        for (int bj = 0; bj < 2; ++bj)
#pragma unroll
            for (int n = 0; n < 2; ++n) fgv[bj][n] = *(const f32x4*)(fg + col0 + bj * 128 + 4 * n);
#pragma unroll
        for (int ai = 0; ai < 2; ++ai)
#pragma unroll
            for (int m = 0; m < 4; ++m) {
                const int rl = ai * 128 + wr * 64 + m * 16 + fr; const size_t r = (size_t)u.pm * 256 + rl; const float rstd = Sr[rl];
#pragma unroll
                for (int bj = 0; bj < 2; ++bj)
#pragma unroll
                    for (int n = 0; n < 2; ++n) NT_STORE((f32x4*)(out + r * DM + col0 + bj * 128 + 4 * n), acc[ai][bj][m][n] * rstd * fgv[bj][n]);
            }
        __syncthreads();
    }
};

#ifndef PRO_KC
#define PRO_KC 64
#endif
#ifndef TRQ
#define TRQ 4
#endif
__device__ __forceinline__ void ph0_prologue(const P& p, LAS unsigned char* lds) {
    const int tid = threadIdx.x, lane = tid & 63, wave = tid >> 6, G = gridDim.x, wg = blockIdx.x;
    LAS float* fl = (LAS float*)lds;
    for (int u = wg; u < 96; u += G) {
        const int l = u / 48, j = (u % 48) * 64 + lane;
        { float cv[16];
#pragma unroll
          for (int i = 0; i < 16; ++i) cv[i] = p.c[tid + 512 * i];
#pragma unroll
          for (int i = 0; i < 16; ++i) fl[tid + 512 * i] = siluf(cv[i]); }
        __syncthreads();
        float acc[8];
#pragma unroll
        for (int b = 0; b < 8; ++b) acc[b] = 0.f;
        const float* w = p.ada_w + ((size_t)l * 1024 + wave * 128) * 3072 + j;
#pragma unroll 1
        for (int k0 = 0; k0 < 128; k0 += PRO_KC) { float wv[PRO_KC];
#pragma unroll
          for (int k = 0; k < PRO_KC; ++k) wv[k] = w[(size_t)(k0 + k) * 3072];
#pragma unroll
          for (int k = 0; k < PRO_KC; ++k) {
#pragma unroll
            for (int b = 0; b < 8; ++b) acc[b] += fl[b * 1024 + wave * 128 + k0 + k] * wv[k]; } }
#pragma unroll
        for (int b = 0; b < 8; ++b) fl[8192 + (wave * 8 + b) * 64 + lane] = acc[b];
        __syncthreads();
        { const int b = wave; float s = p.ada_b[l * 3072 + j];
#pragma unroll
          for (int w8 = 0; w8 < 8; ++w8) s += fl[8192 + (w8 * 8 + b) * 64 + lane];
          p.mod[(l * 8 + b) * 3072 + j] = s; }
        __syncthreads();
    }
    const int GT = (G > 96) ? G - 96 : G, wt = (G > 96) ? wg - 96 : wg;
    if (wt >= 0)
#pragma unroll 1
    for (int u0 = wt; u0 < 1920; u0 += TRQ * GT) {
        float v[TRQ][8]; bf16* dst[TRQ]; bool act[TRQ];
#pragma unroll
        for (int q = 0; q < TRQ; ++q) {
            const int u = u0 + q * GT; act[q] = u < 1920; dst[q] = nullptr;
#pragma unroll
            for (int j = 0; j < 8; ++j) v[q][j] = 0.f;
            if (act[q]) {
                const float* W; bf16* WT; int N, kt, nt;
                if (u < 1408) { const int l = u / 704, r = u % 704; kt = r / 44; nt = r % 44; W = p.w_in + (size_t)l * 1024 * D_INR; N = D_INR; WT = p.wt_in + (size_t)l * ZP * 1024; }
                else { int r = u - 1408; const int l = r / 256; r %= 256; kt = r / 16; nt = r % 16; W = p.w_out + (size_t)l * 1024 * 1024; N = 1024; WT = p.wt_out + (size_t)l * 1024 * 1024; }
                const int n = nt * 64 + lane, k0 = kt * 64 + wave * 8;
                if (n < N) {
#pragma unroll
                    for (int j = 0; j < 8; ++j) v[q][j] = W[(size_t)(k0 + j) * N + n];
                }
                dst[q] = WT + (size_t)n * 1024 + k0;
            }
        }
#pragma unroll
        for (int q = 0; q < TRQ; ++q) if (act[q]) { u32x4 o; o.x = pk2(v[q][0], v[q][1]); o.y = pk2(v[q][2], v[q][3]); o.z = pk2(v[q][4], v[q][5]); o.w = pk2(v[q][6], v[q][7]); *(u32x4*)dst[q] = o; }
    }
}
__device__ __forceinline__ void ph1_prologue(const P& p, LAS unsigned char* lds) {
    const int tid = threadIdx.x, lane = tid & 63, wave = tid >> 6, G = gridDim.x, wg = blockIdx.x;
    LAS float* fl = (LAS float*)lds;
    for (int u = wg; u < 88; u += G) {
        const int l = u / 44, n = (u % 44) * 64 + lane;
        { float mv[16];
#pragma unroll
          for (int i = 0; i < 16; ++i) { const int e = tid + 512 * i; mv[i] = p.mod[(l * 8 + (e >> 10)) * 3072 + (e & 1023)]; }
#pragma unroll
          for (int i = 0; i < 16; ++i) fl[tid + 512 * i] = mv[i]; }
        __syncthreads();
        float acc[8];
#pragma unroll
        for (int b = 0; b < 8; ++b) acc[b] = 0.f;
        if (n < D_INR) { const float* w = p.w_in + ((size_t)l * 1024 + wave * 128) * D_INR + n;
#pragma unroll 1
            for (int k0 = 0; k0 < 128; k0 += PRO_KC) { float wv[PRO_KC];
#pragma unroll
              for (int k = 0; k < PRO_KC; ++k) wv[k] = w[(size_t)(k0 + k) * D_INR];
#pragma unroll
              for (int k = 0; k < PRO_KC; ++k) {
#pragma unroll
                for (int b = 0; b < 8; ++b) acc[b] += fl[b * 1024 + wave * 128 + k0 + k] * wv[k]; } } }
#pragma unroll
        for (int b = 0; b < 8; ++b) fl[8192 + (wave * 8 + b) * 64 + lane] = acc[b];
        __syncthreads();
        { const int b = wave; float s = 0.f;
#pragma unroll
          for (int w8 = 0; w8 < 8; ++w8) s += fl[8192 + (w8 * 8 + b) * 64 + lane];
          p.bias[(l * 8 + b) * ZP + n] = s; }
        __syncthreads();
    }
    {
        const int r0 = wg * 8 + wave, rstep = G * 8;
        f32x4 gq[4], xv[2][2][4], sv[2][2][4];
#pragma unroll
        for (int j = 0; j < 4; ++j) gq[j] = *(const f32x4*)(p.norm_g + (lane + 64 * j) * 4);
#define A0_LOAD(slot, pr) do { _Pragma("unroll") for (int h_ = 0; h_ < 2; ++h_) _Pragma("unroll") for (int j = 0; j < 4; ++j) { const int k_ = (lane + 64 * j) * 4, r_ = r0 + rstep * (2 * (pr) + h_); \
            xv[slot][h_][j] = *(const f32x4*)(p.x + (size_t)r_ * DM + k_); sv[slot][h_][j] = *(const f32x4*)(p.mod + (size_t)(r_ >> 11) * 3072 + 1024 + k_); } } while (0)
        A0_LOAD(0, 0);
#pragma unroll
        for (int pr = 0; pr < 4; ++pr) {
            if (pr + 1 < 4) A0_LOAD((pr + 1) & 1, pr + 1);
#pragma unroll
            for (int h = 0; h < 2; ++h) {
                const int r = r0 + rstep * (2 * pr + h); float s1 = 0.f;
#pragma unroll
                for (int j = 0; j < 4; ++j) { const int k = (lane + 64 * j) * 4; const f32x4 v = xv[pr & 1][h][j];
                    s1 += (v[0] * v[0] + v[1] * v[1]) + (v[2] * v[2] + v[3] * v[3]);
                    const f32x4 o1 = v * gq[j] * (sv[pr & 1][h][j] + 1.0f);
                    u32x2 w1; w1.x = pk2(o1[0], o1[1]); w1.y = pk2(o1[2], o1[3]);
                    *(u32x2*)(p.A + (size_t)r * DM + k) = w1; }
                s1 = wave_sum(s1);
                if (lane == 0) *(f32x4*)(p.ssq + (size_t)r * 4) = (f32x4){s1, 0.f, 0.f, 0.f};
            }
        }
#undef A0_LOAD
    }
}
__device__ __forceinline__ void ph_final(const P& p) {
    const int tid = threadIdx.x, lane = tid & 63, wave = tid >> 6, G = gridDim.x, wg = blockIdx.x;
    for (int r = wg * 8 + wave; r < MROWS; r += G * 8) {
        const f32x4 q = *(const f32x4*)(p.ssq + (size_t)r * 4);
        const float rstd = 1.0f / sqrtf(((q.x + q.y) + (q.z + q.w)) * (1.0f / 1024.0f) + EPS);
#pragma unroll
        for (int j = 0; j < 4; ++j) { const int k = (lane + 64 * j) * 4;
            const f32x4 v = *(const f32x4*)(p.out + (size_t)r * DM + k), g = *(const f32x4*)(p.final_g + k);
            *(f32x4*)(p.out + (size_t)r * DM + k) = v * rstd * g; }
    }
}
#define XB_TMO      128
#define XB_XCNT(j)  (256  + 64 * (j))
#define XB_XSUB(j)  (1280 + 64 * (j))
#define XB_XGEN(j)  (2304 + 64 * (j))
#define XB_TOP      3328
#define XB_TOPGEN   3392
#define XCD_BAR_WORDS 3456
#define XB_SPIN_CAP (1u << 18)

__device__ __forceinline__ unsigned xb_ld(unsigned* p)              { return __hip_atomic_load(p, __ATOMIC_RELAXED, __HIP_MEMORY_SCOPE_AGENT); }
__device__ __forceinline__ unsigned xb_add(unsigned* p, unsigned v) { return __hip_atomic_fetch_add(p, v, __ATOMIC_RELAXED, __HIP_MEMORY_SCOPE_AGENT); }
__device__ __forceinline__ unsigned xb_xcc_id() { return (unsigned)__builtin_amdgcn_s_getreg((3 << 11) | 20) & 0xFu; }
#define XB_SPIN(cond, bar) do { unsigned _sp = 0; while (cond) { __builtin_amdgcn_s_sleep(1); \
    if ((++_sp & 255u) == 0u) { if (xb_ld(&(bar)[XB_TMO])) break; if (_sp > XB_SPIN_CAP) { atomicAdd(&(bar)[XB_TMO], 1u); break; } } } } while (0)

struct XcdBarrier {
    unsigned* bar; unsigned x;
    volatile LAS unsigned* st;
};

__device__ __forceinline__ XcdBarrier xcd_barrier_post(unsigned* bar, volatile LAS unsigned* st) {
    XcdBarrier b; b.bar = bar; b.x = xb_xcc_id(); b.st = st;
    if (threadIdx.x == 0) (void)xb_add(&bar[XB_XCNT(b.x)], 1u);
    return b;
}
__device__ __forceinline__ void xcd_barrier_complete(unsigned* bar, unsigned x, unsigned& nloc, unsigned& nx) {
    const unsigned G = gridDim.x * gridDim.y * gridDim.z;
    unsigned sum, cnt, mine, sp = 0u;
    for (;;) {
        sum = 0u; cnt = 0u; mine = 0u;
#pragma unroll
        for (unsigned j = 0; j < 16; ++j) { const unsigned c = xb_ld(&bar[XB_XCNT(j)]); sum += c; cnt += (c > 0u) ? 1u : 0u; mine = (j == x) ? c : mine; }
        if (sum == G) break;
        __builtin_amdgcn_s_sleep(1);
        if ((++sp & 255u) == 0u) { if (xb_ld(&bar[XB_TMO])) break; if (sp > XB_SPIN_CAP) { atomicAdd(&bar[XB_TMO], 1u); break; } }
    }
    nloc = mine > 0u ? mine : 1u; nx = cnt > 0u ? cnt : 1u;
}

__device__ __forceinline__ void xcd_barrier(const XcdBarrier& b) {
    asm volatile("s_waitcnt vmcnt(0)" ::: "memory");
    __syncthreads();
    if (threadIdx.x == 0) {
        unsigned* bar = b.bar;
        __builtin_amdgcn_s_waitcnt(0);
        unsigned nloc = b.st[0], nx = b.st[1];
        if (nloc == 0u) { xcd_barrier_complete(bar, b.x, nloc, nx); b.st[0] = nloc; b.st[1] = nx; }
        const unsigned old = xb_add(&bar[XB_XSUB(b.x)], 1u);
        const unsigned gen = old / nloc;
        if (old + 1u == (gen + 1u) * nloc) {
            __builtin_amdgcn_fence(__ATOMIC_RELEASE, "agent");
            asm volatile("s_waitcnt vmcnt(0)" ::: "memory");
            const unsigned og = xb_add(&bar[XB_TOP], 1u);
            const unsigned tg = og / nx;
            if (og + 1u == (tg + 1u) * nx) xb_add(&bar[XB_TOPGEN], 1u);
            else XB_SPIN(xb_ld(&bar[XB_TOPGEN]) == tg, bar);
            __builtin_amdgcn_fence(__ATOMIC_ACQUIRE, "agent");
            xb_add(&bar[XB_XGEN(b.x)], 1u);
            asm volatile("s_waitcnt vmcnt(0)" ::: "memory");
        } else {
#ifdef XB_FLAT_RELEASE
            XB_SPIN(xb_ld(&bar[XB_TOPGEN]) == gen, bar);
#else
            XB_SPIN(xb_ld(&bar[XB_XGEN(b.x)]) == gen, bar);
#endif
            __builtin_amdgcn_fence(__ATOMIC_ACQUIRE, "agent");
            asm volatile("s_waitcnt vmcnt(0)" ::: "memory");
        }
    }
    __syncthreads();
}
__device__ __forceinline__ unsigned score_ukey(float s) { const unsigned u = __float_as_uint(s + 0.0f); return (u & 0x80000000u) ? ~u : (u | 0x80000000u); }
__device__ __forceinline__ void topk_threshold(const unsigned (&k)[32], unsigned& thr, unsigned& need) {
    unsigned prefix = 0u; bool exact = false;
    for (int bit = 31; bit >= 0; --bit) {
        const unsigned cand = prefix | (1u << bit);
        int c = 0;
#pragma unroll
        for (int i = 0; i < 32; ++i) c += (k[i] >= cand) ? 1 : 0;
        c = wave_sum_i(c);
        if (c >= TOPK) prefix = cand;
        if (c == TOPK) { exact = true; break; }
    }
    thr = prefix;
    if (exact) { need = 0xffffffffu; }
    else { int c = 0;
#pragma unroll
        for (int i = 0; i < 32; ++i) c += (k[i] > prefix) ? 1 : 0;
        c = wave_sum_i(c); need = (unsigned)(TOPK - c); }
}
#ifndef PROBE_VALU
#define PROBE_VALU 0
#endif
#ifndef RP_T3
#define RP_T3 1
#endif
#ifndef RP_T1
#define RP_T1 1
#endif
#ifndef RP_T2
#define RP_T2 1
#endif
#ifndef RP_I
#define RP_I 1
#endif
#ifndef RP_T
#define RP_T 1
#endif
#ifndef RP_V
#define RP_V 1
#endif
typedef short bf16x8v __attribute__((ext_vector_type(8)));
typedef short s16x4v __attribute__((ext_vector_type(4)));
constexpr int BMS = 65;
constexpr int SCP = 2052;
constexpr int DSA_BM_OFF = 16 * SCP * 4;
constexpr int DSA_RING_OFF = 0;
constexpr int DSA_QIB_OFF = 147456;
constexpr int DSA_WIB_OFF = 135680;
constexpr int DSA_MLUT_OFF = 143616;
__device__ __forceinline__ void glds16(const void* gsrc, unsigned lds_dst) { unsigned keep;
    asm volatile("s_mov_b32 %0, m0\n\ts_mov_b32 m0, %2\n\ts_nop 0\n\tglobal_load_lds_dwordx4 %1, off\n\ts_mov_b32 m0, %0" : "=&s"(keep) : "v"(gsrc), "s"(lds_dst) : "memory"); }
template <int I> __device__ __forceinline__ unsigned mbit_t(int mw) { unsigned r; asm("v_bfe_i32 %0, %1, %2, 1" : "=v"(r) : "v"(mw), "i"(I)); return r; }
#define mbit(mw, i) mbit_t<(i)>(mw)
__device__ __forceinline__ float relu_i(float x) { return __int_as_float(max(__float_as_int(x), 0)); }
__device__ __forceinline__ int imax3(float a, float b, float c) { return max(max(__float_as_int(a), __float_as_int(b)), __float_as_int(c)); }
__device__ __forceinline__ s16x4v lds_tr16(LAS const unsigned char* p) { return __builtin_bit_cast(s16x4v, __builtin_amdgcn_ds_read_tr16_b64_v4i16((LAS s16x4v*)p)); }
__device__ __forceinline__ unsigned cvtpk(float lo, float hi) { typedef float f2 __attribute__((ext_vector_type(2))); typedef __bf16 b2 __attribute__((ext_vector_type(2))); f2 v = {lo, hi}; b2 r = __builtin_convertvector(v, b2); return __builtin_bit_cast(unsigned, r); }


template <int L> __device__ __forceinline__ void wr2lanes(int& w, unsigned lo, unsigned hi) {
    asm volatile("s_nop 1\n\tv_writelane_b32 %0, %1, %3\n\tv_writelane_b32 %0, %2, %4" : "+v"(w) : "s"(lo), "s"(hi), "i"(L), "i"(L + 1));
}
__device__ __forceinline__ int wave_sum_dpp(int v) {
    v += __builtin_amdgcn_update_dpp(0, v, 0xB1, 0xf, 0xf, true);
    v += __builtin_amdgcn_update_dpp(0, v, 0x4E, 0xf, 0xf, true);
    v += __builtin_amdgcn_update_dpp(0, v, 0x141, 0xf, 0xf, true);
    v += __builtin_amdgcn_update_dpp(0, v, 0x140, 0xf, 0xf, true);
    return __builtin_amdgcn_readlane(v, 0) + __builtin_amdgcn_readlane(v, 16) + __builtin_amdgcn_readlane(v, 32) + __builtin_amdgcn_readlane(v, 48);
}
__device__ __forceinline__ unsigned wave_max_dpp(unsigned v) {
    v = max(v, (unsigned)__builtin_amdgcn_update_dpp(0, (int)v, 0xB1, 0xf, 0xf, true));
    v = max(v, (unsigned)__builtin_amdgcn_update_dpp(0, (int)v, 0x4E, 0xf, 0xf, true));
    v = max(v, (unsigned)__builtin_amdgcn_update_dpp(0, (int)v, 0x141, 0xf, 0xf, true));
    v = max(v, (unsigned)__builtin_amdgcn_update_dpp(0, (int)v, 0x140, 0xf, 0xf, true));
    return max(max((unsigned)__builtin_amdgcn_readlane((int)v, 0), (unsigned)__builtin_amdgcn_readlane((int)v, 16)), max((unsigned)__builtin_amdgcn_readlane((int)v, 32), (unsigned)__builtin_amdgcn_readlane((int)v, 48)));
}
__device__ __forceinline__ int cnt8(int acc, unsigned cand, unsigned k0, unsigned k1, unsigned k2, unsigned k3, unsigned k4, unsigned k5, unsigned k6, unsigned k7) {
    unsigned long long m0, m1, m2, m3, m4, m5, m6, m7;
    asm volatile("v_cmp_le_u32_e64 %1, %9, %10\n\tv_cmp_le_u32_e64 %2, %9, %11\n\tv_cmp_le_u32_e64 %3, %9, %12\n\tv_cmp_le_u32_e64 %4, %9, %13\n\t"
                 "v_cmp_le_u32_e64 %5, %9, %14\n\tv_cmp_le_u32_e64 %6, %9, %15\n\tv_cmp_le_u32_e64 %7, %9, %16\n\tv_cmp_le_u32_e64 %8, %9, %17\n\t"
                 "v_addc_co_u32_e64 %0, %1, 0, %0, %1\n\tv_addc_co_u32_e64 %0, %2, 0, %0, %2\n\tv_addc_co_u32_e64 %0, %3, 0, %0, %3\n\tv_addc_co_u32_e64 %0, %4, 0, %0, %4\n\t"
                 "v_addc_co_u32_e64 %0, %5, 0, %0, %5\n\tv_addc_co_u32_e64 %0, %6, 0, %0, %6\n\tv_addc_co_u32_e64 %0, %7, 0, %0, %7\n\tv_addc_co_u32_e64 %0, %8, 0, %0, %8"
                 : "+v"(acc), "=&s"(m0), "=&s"(m1), "=&s"(m2), "=&s"(m3), "=&s"(m4), "=&s"(m5), "=&s"(m6), "=&s"(m7)
                 : "s"(cand), "v"(k0), "v"(k1), "v"(k2), "v"(k3), "v"(k4), "v"(k5), "v"(k6), "v"(k7));
    return acc;
}
__device__ __forceinline__ int count_ge(const unsigned (&k)[32], unsigned cand_, int nb) {
    const unsigned cand = (unsigned)__builtin_amdgcn_readfirstlane((int)cand_);
    int c = 0;
    c = cnt8(c, cand, k[0], k[1], k[2], k[3], k[4], k[5], k[6], k[7]);
    if (nb > 1) c = cnt8(c, cand, k[8], k[9], k[10], k[11], k[12], k[13], k[14], k[15]);
    if (nb > 2) c = cnt8(c, cand, k[16], k[17], k[18], k[19], k[20], k[21], k[22], k[23]);
    if (nb > 3) c = cnt8(c, cand, k[24], k[25], k[26], k[27], k[28], k[29], k[30], k[31]);
    return wave_sum_dpp(c);
}
__device__ __forceinline__ int wave_scan_dpp(int v) {
    v += __builtin_amdgcn_update_dpp(0, v, 0x111, 0xf, 0xf, false);
    v += __builtin_amdgcn_update_dpp(0, v, 0x112, 0xf, 0xf, false);
    v += __builtin_amdgcn_update_dpp(0, v, 0x114, 0xf, 0xf, false);
    v += __builtin_amdgcn_update_dpp(0, v, 0x118, 0xf, 0xf, false);
    v += __builtin_amdgcn_update_dpp(0, v, 0x142, 0xa, 0xf, false);
    v += __builtin_amdgcn_update_dpp(0, v, 0x143, 0xc, 0xf, false);
    return v;
}
#ifndef WALK_MAX
#define WALK_MAX 4
#endif
#ifndef HIST_WAVES
#define HIST_WAVES 4
#endif
struct TopkState { unsigned prefix; int bit; bool done; unsigned need; int nb; LAS unsigned* hist; int crej; };
__device__ __forceinline__ void topk_hist(const unsigned (&k)[32], TopkState& st, int c_above) {
    const int lane = threadIdx.x & 63;
    const unsigned T = (unsigned)__builtin_amdgcn_readfirstlane((int)st.prefix);
    LAS unsigned* hist = st.hist;
    *(LAS u32x4*)(hist + 4 * lane) = (u32x4){0u, 0u, 0u, 0u};
    asm volatile("" ::: "memory");
    const unsigned hb_ = (unsigned)(uintptr_t)hist; const unsigned one = 1u;
#define HF8(i0) { unsigned t0_; unsigned long long ex_; \
        asm volatile("s_mov_b64 %1, exec\n\t" \
            "v_subrev_u32_e32 %0, %2, %5\n\tv_lshrrev_b32_e32 %0, 15, %0\n\tv_cmpx_gt_u32_e32 vcc, 0x100, %0\n\tv_lshl_add_u32 %0, %0, 2, %3\n\tds_add_u32 %0, %4\n\ts_mov_b64 exec, %1\n\t" \
            "v_subrev_u32_e32 %0, %2, %6\n\tv_lshrrev_b32_e32 %0, 15, %0\n\tv_cmpx_gt_u32_e32 vcc, 0x100, %0\n\tv_lshl_add_u32 %0, %0, 2, %3\n\tds_add_u32 %0, %4\n\ts_mov_b64 exec, %1\n\t" \
            "v_subrev_u32_e32 %0, %2, %7\n\tv_lshrrev_b32_e32 %0, 15, %0\n\tv_cmpx_gt_u32_e32 vcc, 0x100, %0\n\tv_lshl_add_u32 %0, %0, 2, %3\n\tds_add_u32 %0, %4\n\ts_mov_b64 exec, %1\n\t" \
            "v_subrev_u32_e32 %0, %2, %8\n\tv_lshrrev_b32_e32 %0, 15, %0\n\tv_cmpx_gt_u32_e32 vcc, 0x100, %0\n\tv_lshl_add_u32 %0, %0, 2, %3\n\tds_add_u32 %0, %4\n\ts_mov_b64 exec, %1\n\t" \
            "v_subrev_u32_e32 %0, %2, %9\n\tv_lshrrev_b32_e32 %0, 15, %0\n\tv_cmpx_gt_u32_e32 vcc, 0x100, %0\n\tv_lshl_add_u32 %0, %0, 2, %3\n\tds_add_u32 %0, %4\n\ts_mov_b64 exec, %1\n\t" \
            "v_subrev_u32_e32 %0, %2, %10\n\tv_lshrrev_b32_e32 %0, 15, %0\n\tv_cmpx_gt_u32_e32 vcc, 0x100, %0\n\tv_lshl_add_u32 %0, %0, 2, %3\n\tds_add_u32 %0, %4\n\ts_mov_b64 exec, %1\n\t" \
            "v_subrev_u32_e32 %0, %2, %11\n\tv_lshrrev_b32_e32 %0, 15, %0\n\tv_cmpx_gt_u32_e32 vcc, 0x100, %0\n\tv_lshl_add_u32 %0, %0, 2, %3\n\tds_add_u32 %0, %4\n\ts_mov_b64 exec, %1\n\t" \
            "v_subrev_u32_e32 %0, %2, %12\n\tv_lshrrev_b32_e32 %0, 15, %0\n\tv_cmpx_gt_u32_e32 vcc, 0x100, %0\n\tv_lshl_add_u32 %0, %0, 2, %3\n\tds_add_u32 %0, %4\n\ts_mov_b64 exec, %1" \
            : "=&v"(t0_), "=&s"(ex_) : "s"(T), "s"(hb_), "v"(one), "v"(k[i0]), "v"(k[i0 + 1]), "v"(k[i0 + 2]), "v"(k[i0 + 3]), "v"(k[i0 + 4]), "v"(k[i0 + 5]), "v"(k[i0 + 6]), "v"(k[i0 + 7]) : "vcc", "memory"); }
    HF8(0)
    if (st.nb > 1) HF8(8)
    if (st.nb > 2) HF8(16)
    if (st.nb > 3) HF8(24)
#undef HF8
    asm volatile("" ::: "memory");
    const u32x4 w = *(LAS const u32x4*)(hist + 4 * (63 - lane));
    const int t = (int)((w.x + w.y) + (w.z + w.w));
    const int P = wave_scan_dpp(t);
    const int k1 = TOPK - c_above;
    const unsigned long long bal = __ballot(P >= k1);
    const int Ls = __builtin_ctzll(bal);
    int c = __builtin_amdgcn_readlane(P, Ls) - __builtin_amdgcn_readlane(t, Ls);
    const int h3 = __builtin_amdgcn_readlane((int)w.w, Ls), h2 = __builtin_amdgcn_readlane((int)w.z, Ls), h1 = __builtin_amdgcn_readlane((int)w.y, Ls), h0 = __builtin_amdgcn_readlane((int)w.x, Ls);
    int bsel = 3, hb = h3;
    if (c + h3 < k1) { c += h3; bsel = 2; hb = h2; if (c + h2 < k1) { c += h2; bsel = 1; hb = h1; if (c + h1 < k1) { c += h1; bsel = 0; hb = h0; } } }
    const unsigned bin = (unsigned)(4 * (63 - Ls) + bsel);
    st.prefix = T | (bin << 15); st.bit = 14;
    if (c + hb == k1) { st.done = true; st.need = 0xffffffffu; }
}
__device__ __forceinline__ void topk_histA(const unsigned (&k)[32], TopkState& st) {
    const int lane = threadIdx.x & 63;
    LAS unsigned* hist = st.hist;
    *(LAS u32x4*)(hist + 8 * lane) = (u32x4){0u, 0u, 0u, 0u}; *(LAS u32x4*)(hist + 8 * lane + 4) = (u32x4){0u, 0u, 0u, 0u};
    asm volatile("" ::: "memory");
#define HA(i) __hip_atomic_fetch_add(hist + (k[i] >> 23), 1u, __ATOMIC_RELAXED, __HIP_MEMORY_SCOPE_WORKGROUP);
    HA(0) HA(1) HA(2) HA(3) HA(4) HA(5) HA(6) HA(7)
    if (st.nb > 1) { HA(8) HA(9) HA(10) HA(11) HA(12) HA(13) HA(14) HA(15) }
    if (st.nb > 2) { HA(16) HA(17) HA(18) HA(19) HA(20) HA(21) HA(22) HA(23) }
    if (st.nb > 3) { HA(24) HA(25) HA(26) HA(27) HA(28) HA(29) HA(30) HA(31) }
#undef HA
    asm volatile("" ::: "memory");
    const u32x4 w0 = *(LAS const u32x4*)(hist + 8 * (63 - lane)), w1 = *(LAS const u32x4*)(hist + 8 * (63 - lane) + 4);
    const int t = (int)(((w0.x + w0.y) + (w0.z + w0.w)) + ((w1.x + w1.y) + (w1.z + w1.w)));
    const int P = wave_scan_dpp(t);
    const unsigned long long bal = __ballot(P >= TOPK);
    const int Ls = __builtin_ctzll(bal);
    int c = __builtin_amdgcn_readlane(P, Ls) - __builtin_amdgcn_readlane(t, Ls);
    int bsel = 7, hb = 0; bool found = false;
#define WALK(j, word) if (!found) { const int h_ = __builtin_amdgcn_readlane((int)(word), Ls); if (c + h_ >= TOPK) { bsel = (j); hb = h_; found = true; } else c += h_; }
    WALK(7, w1.w) WALK(6, w1.z) WALK(5, w1.y) WALK(4, w1.x) WALK(3, w0.w) WALK(2, w0.z) WALK(1, w0.y) WALK(0, w0.x)
#undef WALK
    const unsigned bucket = (unsigned)(8 * (63 - Ls) + bsel);
    st.prefix = bucket << 23; st.bit = 22; st.crej = c;
    if (c + hb == TOPK) { st.done = true; st.need = 0xffffffffu; }
}
__device__ __forceinline__ void topk_init(const unsigned (&k)[32], TopkState& st) {
    unsigned mx = 0u;
#pragma unroll
    for (int i = 0; i < 32; ++i) mx = max(mx, k[i]);
    mx = wave_max_dpp(mx);
    st.prefix = 0u; st.bit = 31; st.done = false; st.need = 0u; st.crej = 0;
    unsigned E = mx >> 23;
    int cprev = 0;
#pragma unroll 1
    for (int j = 0; j < WALK_MAX; ++j) {
        if (E < (unsigned)j + 1u) break;
        const unsigned T = (E - (unsigned)j) << 23;
        const int c = count_ge(k, T, st.nb);
        if (c >= TOPK) { st.prefix = T; st.bit = 22; if (c == TOPK) { st.done = true; st.need = 0xffffffffu; }
#ifndef NO_TOPK_HIST
#ifdef PROBE_HIST2
            else if (st.hist) { TopkState sv = st; topk_hist(k, st, cprev); asm volatile("" :: "s"(st.prefix) : "memory"); st = sv; topk_hist(k, st, cprev); }
#else
            else if (st.hist) topk_hist(k, st, cprev);
#endif
#endif
            break; }
        cprev = c;
    }
#ifdef HISTA_FALLBACK
    if (st.bit == 31 && st.hist) { topk_histA(k, st); if (!st.done) topk_hist(k, st, st.crej); }
#endif
}
__device__ __forceinline__ void topk_step(const unsigned (&k)[32], TopkState& st) {
    if (st.done) return;
    if (st.bit < 0) { int c = 0;
#pragma unroll
        for (int i = 0; i < 32; ++i) c += (k[i] > st.prefix) ? 1 : 0;
        c = wave_sum_dpp(c); st.need = (unsigned)(TOPK - c); st.done = true; return; }
    const unsigned cand = st.prefix | (1u << st.bit);
    const int c = count_ge(k, cand, st.nb);
    if (c >= TOPK) st.prefix = cand; else st.crej = c;
    if (c == TOPK) { st.done = true; st.need = 0xffffffffu; }
    --st.bit;
#ifndef NO_TOPK_HIST
    if (st.bit == 22 && !st.done && st.hist) topk_hist(k, st, st.crej);
#endif
}

__device__ __forceinline__ void dsa_prefetch_qi(const bf16* zb, int qt, LAS unsigned char* lds, int wave, int lane) {
    const unsigned lds_base = (unsigned)(uintptr_t)lds;
#pragma unroll
    for (int i = 0; i < 2; ++i) { const int row = 2 * wave + i;
        glds16(zb + (size_t)(qt * 16 + row) * ZP + C_QI + ((lane ^ row) * 8), (unsigned)__builtin_amdgcn_readfirstlane(lds_base + DSA_QIB_OFF + row * 1024)); }
    if (wave == 0) glds16(zb + (size_t)(qt * 16 + (lane & 15)) * ZP + C_WI, (unsigned)__builtin_amdgcn_readfirstlane(lds_base + DSA_WIB_OFF));
}

__device__ __forceinline__ void dsa_prefetch_ki(const bf16* zb, int qt, bf16x8v (&pk)[4], int wave, int lane) {
    const int r16 = lane & 15, g = lane >> 4;
    if (wave <= qt) { const bf16* krow = zb + (size_t)(wave * 16 + r16) * ZP + C_KI; pk[0] = *(const bf16x8v*)(krow + 8 * g); pk[1] = *(const bf16x8v*)(krow + 32 + 8 * g); }
    if (wave + 8 <= qt) { const bf16* krow = zb + (size_t)((wave + 8) * 16 + r16) * ZP + C_KI; pk[2] = *(const bf16x8v*)(krow + 8 * g); pk[3] = *(const bf16x8v*)(krow + 32 + 8 * g); }
}

__device__ __forceinline__ void dsa_unit(const P& p, int b, int qt, int qt_next, bf16x8v (&pk)[4], LAS unsigned char* lds) {
    const int tid = threadIdx.x, lane = tid & 63, wave = __builtin_amdgcn_readfirstlane(tid >> 6), r16 = lane & 15, g = lane >> 4;
    const int q0 = qt * 16; const bf16* zb = p.Z + (size_t)b * SEQ * ZP;
    LAS float* SC = (LAS float*)lds; LAS unsigned* BM = (LAS unsigned*)(lds + DSA_BM_OFF);
    const bool dense_all = (qt < TOPK / 16);
    const bf16* qrow = zb + (size_t)(q0 + r16) * ZP;
    const bf16x8v bq0 = *(const bf16x8v*)(qrow + C_Q + wave * 64 + 8 * g), bq1 = *(const bf16x8v*)(qrow + C_Q + wave * 64 + 32 + 8 * g);
    u32x2 gwv[4];
#pragma unroll
    for (int dt = 0; dt < 4; ++dt) gwv[dt] = *(const u32x2*)(qrow + C_GA + wave * 64 + dt * 16 + 4 * g);
    const int nsteps = (((q0 + 16 + 31) >> 5) + 1) & ~1, nmega = (nsteps + 7) >> 3;
    const int kkey = lane >> 3, vkey = lane >> 1, vhalf = lane & 1;
    const unsigned lds_base = (unsigned)(uintptr_t)lds;
#define DSA_STAGE(mm) do { const int st_ = (mm) * 8 + wave; if (st_ < nsteps) { \
        const bf16* kb_ = zb + (size_t)st_ * 32 * ZP; const unsigned ldsb_ = lds_base + (unsigned)(((mm) & 1) * 65536 + wave * 4096); \
        _Pragma("unroll") for (int c_ = 0; c_ < 4; ++c_) { const int key_ = 8 * c_ + kkey, ch_ = (lane & 7) ^ ((key_ & 15) >> 1); \
            glds16(kb_ + (size_t)key_ * ZP + C_K + ch_ * 8, (unsigned)__builtin_amdgcn_readfirstlane(ldsb_ + c_ * 1024)); } \
        _Pragma("unroll") for (int c_ = 0; c_ < 4; ++c_) \
            glds16(kb_ + (size_t)vkey * ZP + C_V + c_ * 16 + vhalf * 8, (unsigned)__builtin_amdgcn_readfirstlane(ldsb_ + 32768 + c_ * 1024)); } } while (0)
    if (!dense_all) {
        for (int rpI = 0; rpI < RP_I; ++rpI) {
        bf16x8v bq[8][2]; float wv[8];
#pragma unroll
        for (int h = 0; h < 8; ++h) { bq[h][0] = *(LAS const bf16x8v*)(lds + DSA_QIB_OFF + r16 * 1024 + (((8 * h + g) ^ r16) * 16)); bq[h][1] = *(LAS const bf16x8v*)(lds + DSA_QIB_OFF + r16 * 1024 + (((8 * h + 4 + g) ^ r16) * 16));
            wv[h] = bf2f(*(LAS const bf16*)(lds + DSA_WIB_OFF + r16 * 16 + h * 2)) * 0.35355339059327373f * 0.125f; }
        bf16x8v ra0 = pk[0], ra1 = pk[1], rb0 = pk[2], rb1 = pk[3], rc0 = pk[0], rc1 = pk[1];
#define IDX_LOAD(d0, d1, ktl) do { const int ktl_ = (ktl) <= qt ? (ktl) : qt;        \
            const bf16* krow_ = zb + (size_t)(ktl_ * 16 + r16) * ZP + C_KI; d0 = *(const bf16x8v*)(krow_ + 8 * g); d1 = *(const bf16x8v*)(krow_ + 32 + 8 * g); } while (0)
#define IDX_STEP(c0, c1) do { \
            f32x4 sc = {0.f, 0.f, 0.f, 0.f}; \
            _Pragma("unroll") for (int h = 0; h < 8; ++h) { \
                f32x4 acc = {0.f, 0.f, 0.f, 0.f}; \
                acc = __builtin_amdgcn_mfma_f32_16x16x32_bf16(c0, bq[h][0], acc, 0, 0, 0); \
                acc = __builtin_amdgcn_mfma_f32_16x16x32_bf16(c1, bq[h][1], acc, 0, 0, 0); \
                _Pragma("unroll") for (int i = 0; i < 4; ++i) sc[i] += relu_i(acc[i]) * wv[h]; \
            } \
            if (__builtin_amdgcn_readfirstlane(kt) == qt) {                  \
                _Pragma("unroll") for (int i = 0; i < 4; ++i) sc[i] = (4 * g + i > r16) ? -INFINITY : sc[i]; \
            } \
            *(LAS f32x4*)(SC + r16 * SCP + kt * 16 + 4 * g) = sc; } while (0)
        int kt = wave;
        const int nst = (qt - wave + 8) >> 3;
        const int ntrip = (nst * 11) >> 5, rem = nst - 3 * ntrip;
#pragma unroll 1
        for (int it = ntrip; it > 0; --it) {
            IDX_LOAD(rc0, rc1, kt + 16); __builtin_amdgcn_sched_barrier(0); IDX_STEP(ra0, ra1); __builtin_amdgcn_sched_barrier(0); kt += 8;
            IDX_LOAD(ra0, ra1, kt + 16); __builtin_amdgcn_sched_barrier(0); IDX_STEP(rb0, rb1); __builtin_amdgcn_sched_barrier(0); kt += 8;
            IDX_LOAD(rb0, rb1, kt + 16); __builtin_amdgcn_sched_barrier(0); IDX_STEP(rc0, rc1); __builtin_amdgcn_sched_barrier(0); kt += 8;
        }
        if (rem >= 1) { IDX_STEP(ra0, ra1); kt += 8; if (rem >= 2) { IDX_STEP(rb0, rb1); } }
#undef IDX_LOAD
#undef IDX_STEP
        __syncthreads();
        }
#pragma unroll 1
        for (int rpT = 0; rpT < RP_T; ++rpT) {
            const int ra = 2 * wave, rb = 2 * wave + 1, ta = q0 + ra, tb = q0 + rb;
            unsigned ka[32], kb[32];
#pragma unroll
            for (int i = 0; i < 32; ++i) { const int key = lane + 64 * i; ka[i] = (key <= ta) ? score_ukey(SC[ra * SCP + key]) : 0u; kb[i] = (key <= tb) ? score_ukey(SC[rb * SCP + key]) : 0u; }
#if RP_T1 > 1
            asm volatile("" :: "v"(ka[0]), "v"(kb[31]) : "memory");
#pragma unroll
            for (int i = 0; i < 32; ++i) { const int key = lane + 64 * i; ka[i] = (key <= ta) ? score_ukey(SC[ra * SCP + key]) : 0u; kb[i] = (key <= tb) ? score_ukey(SC[rb * SCP + key]) : 0u; }
            asm volatile("" ::: "memory");
#endif
            asm volatile("s_waitcnt lgkmcnt(0)" ::: "memory");
            __syncthreads();
            DSA_STAGE(0);
            TopkState sa, sb; sa.nb = (ta >> 9) + 1; sb.nb = (tb >> 9) + 1;
            sa.hist = (wave < HIST_WAVES) ? (LAS unsigned*)(lds + 65536 + ra * 2048) : (LAS unsigned*)nullptr; sb.hist = (wave < HIST_WAVES) ? (LAS unsigned*)(lds + 65536 + rb * 2048) : (LAS unsigned*)nullptr;
            topk_init(ka, sa); topk_init(kb, sb);
#pragma unroll 1
            while (!(sa.done && sb.done)) { topk_step(ka, sa); topk_step(kb, sb); }
#if RP_T2 > 1
            asm volatile("" :: "v"(sa.prefix), "v"(sb.prefix));
            topk_init(ka, sa); topk_init(kb, sb);
#pragma unroll 1
            while (!(sa.done && sb.done)) { topk_step(ka, sa); topk_step(kb, sb); }
#endif
            if (sa.need == 0xffffffffu && sb.need == 0xffffffffu) {
                const unsigned ta_ = (unsigned)__builtin_amdgcn_readfirstlane((int)sa.prefix), tb_ = (unsigned)__builtin_amdgcn_readfirstlane((int)sb.prefix);
                int wa = 0, wb = 0;
#define WR2(i) { const unsigned long long ma = __ballot(ka[i] >= ta_), mb = __ballot(kb[i] >= tb_); wr2lanes<2 * (i)>(wa, (unsigned)ma, (unsigned)(ma >> 32)); wr2lanes<2 * (i)>(wb, (unsigned)mb, (unsigned)(mb >> 32)); }
                WR2(0) WR2(1) WR2(2) WR2(3) WR2(4) WR2(5) WR2(6) WR2(7) WR2(8) WR2(9) WR2(10) WR2(11) WR2(12) WR2(13) WR2(14) WR2(15)
                WR2(16) WR2(17) WR2(18) WR2(19) WR2(20) WR2(21) WR2(22) WR2(23) WR2(24) WR2(25) WR2(26) WR2(27) WR2(28) WR2(29) WR2(30) WR2(31)
#undef WR2
                BM[ra * BMS + lane] = (unsigned)wa; BM[rb * BMS + lane] = (unsigned)wb;
#if RP_T3 > 1
                asm volatile("" : "+v"(wa), "+v"(wb) :: "memory");
#define WR2(i) { const unsigned long long ma = __ballot(ka[i] >= ta_), mb = __ballot(kb[i] >= tb_); wr2lanes<2 * (i)>(wa, (unsigned)ma, (unsigned)(ma >> 32)); wr2lanes<2 * (i)>(wb, (unsigned)mb, (unsigned)(mb >> 32)); }
                WR2(0) WR2(1) WR2(2) WR2(3) WR2(4) WR2(5) WR2(6) WR2(7) WR2(8) WR2(9) WR2(10) WR2(11) WR2(12) WR2(13) WR2(14) WR2(15)
                WR2(16) WR2(17) WR2(18) WR2(19) WR2(20) WR2(21) WR2(22) WR2(23) WR2(24) WR2(25) WR2(26) WR2(27) WR2(28) WR2(29) WR2(30) WR2(31)
#undef WR2
                BM[ra * BMS + lane] = (unsigned)wa; BM[rb * BMS + lane] = (unsigned)wb;
#endif
            } else {
            unsigned eqa = 0u, eqb = 0u;
#pragma unroll 1
            for (int i = 0; i < 32; ++i) {
                unsigned kai = ka[0], kbi = kb[0];
#pragma unroll
                for (int j = 1; j < 32; ++j) { kai = (i == j) ? ka[j] : kai; kbi = (i == j) ? kb[j] : kbi; }
                { const bool eq = (kai == sa.prefix); const unsigned long long em = __ballot(eq);
                  const unsigned erank = eqa + __builtin_amdgcn_mbcnt_hi((unsigned)(em >> 32), __builtin_amdgcn_mbcnt_lo((unsigned)em, 0u));
                  const unsigned long long smk = __ballot((kai > sa.prefix) || (eq && erank < sa.need));
                  if (lane == 0) { BM[ra * BMS + 2 * i] = (unsigned)smk; BM[ra * BMS + 2 * i + 1] = (unsigned)(smk >> 32); }
                  eqa += (unsigned)__popcll(em); }
                { const bool eq = (kbi == sb.prefix); const unsigned long long em = __ballot(eq);
                  const unsigned erank = eqb + __builtin_amdgcn_mbcnt_hi((unsigned)(em >> 32), __builtin_amdgcn_mbcnt_lo((unsigned)em, 0u));
                  const unsigned long long smk = __ballot((kbi > sb.prefix) || (eq && erank < sb.need));
                  if (lane == 0) { BM[rb * BMS + 2 * i] = (unsigned)smk; BM[rb * BMS + 2 * i + 1] = (unsigned)(smk >> 32); }
                  eqb += (unsigned)__popcll(em); }
            }
            }
        }
    } else {
        for (int i = tid; i < 1024; i += 512) { const int row = i >> 6, w = i & 63, t = q0 + row, lo = 32 * w;
            BM[row * BMS + w] = (t >= lo + 31) ? 0xffffffffu : ((t < lo) ? 0u : ((2u << (t - lo)) - 1u)); }
        DSA_STAGE(0);
    }
    __syncthreads();
    const int h = wave;
#pragma unroll 1
    for (int rpV = 0; rpV < RP_V; ++rpV) {
    asm volatile("s_waitcnt vmcnt(0)" ::: "memory");
    asm volatile("" :: "v"(bq0), "v"(bq1), "v"(gwv[0]), "v"(gwv[1]), "v"(gwv[2]), "v"(gwv[3]));
    __syncthreads();
    if (qt_next >= TOPK / 16) { dsa_prefetch_qi(zb, qt_next, lds, wave, lane); dsa_prefetch_ki(zb, qt_next, pk, wave, lane); }
    f32x4 o[4], lacc = {0.f, 0.f, 0.f, 0.f}, negm = {0.f, 0.f, 0.f, 0.f};
#pragma unroll
    for (int dt = 0; dt < 4; ++dt) o[dt] = (f32x4){0.f, 0.f, 0.f, 0.f};
    float m_run = 0.f;
    const int kofs0 = r16 * 128 + ((g ^ (r16 >> 1)) & 7) * 16, kofs1 = r16 * 128 + (((4 + g) ^ (r16 >> 1)) & 7) * 16;
    const int vofs = 32768 + (4 * g + ((lane & 15) >> 2)) * 32 + (lane & 3) * 8;
    bf16x8v ones = {0x3f80, 0x3f80, 0x3f80, 0x3f80, 0x3f80, 0x3f80, 0x3f80, 0x3f80};
    asm volatile("" : "+v"(ones));
    LAS const unsigned char* mlut = lds + DSA_MLUT_OFF;
    constexpr float THR = 8.0f;
    bool first = true;
#pragma unroll 1
    for (int mm = 0; mm < nmega; ++mm) {
        if (mm + 1 < nmega) DSA_STAGE(mm + 1);
        LAS unsigned char* slotb = lds + (mm & 1) * 65536;
        const int nsub = (nsteps - mm * 8) < 8 ? (nsteps - mm * 8) : 8;
#pragma unroll 1
        for (int u = 0; u < nsub; u += 2) {
            LAS unsigned char* slot = slotb + u * 4096;
            const int mwA = (int)(BM[r16 * BMS + mm * 8 + u] >> (4 * g)), mwB = (int)(BM[r16 * BMS + mm * 8 + u + 1] >> (4 * g));
            f32x4 s0, s1, s2, s3;
            { const bf16x8v ka0 = *(LAS const bf16x8v*)(slot + kofs0), ka1 = *(LAS const bf16x8v*)(slot + kofs1);
              const bf16x8v kb0 = *(LAS const bf16x8v*)(slot + 2048 + kofs0), kb1 = *(LAS const bf16x8v*)(slot + 2048 + kofs1);
              const bf16x8v kc0 = *(LAS const bf16x8v*)(slot + 4096 + kofs0), kc1 = *(LAS const bf16x8v*)(slot + 4096 + kofs1);
              const bf16x8v kd0 = *(LAS const bf16x8v*)(slot + 6144 + kofs0), kd1 = *(LAS const bf16x8v*)(slot + 6144 + kofs1);
              s0 = __builtin_amdgcn_mfma_f32_16x16x32_bf16(ka0, bq0, negm, 0, 0, 0); s1 = __builtin_amdgcn_mfma_f32_16x16x32_bf16(kb0, bq0, negm, 0, 0, 0);
              s2 = __builtin_amdgcn_mfma_f32_16x16x32_bf16(kc0, bq0, negm, 0, 0, 0); s3 = __builtin_amdgcn_mfma_f32_16x16x32_bf16(kd0, bq0, negm, 0, 0, 0);
              s0 = __builtin_amdgcn_mfma_f32_16x16x32_bf16(ka1, bq1, s0, 0, 0, 0); s1 = __builtin_amdgcn_mfma_f32_16x16x32_bf16(kb1, bq1, s1, 0, 0, 0);
              s2 = __builtin_amdgcn_mfma_f32_16x16x32_bf16(kc1, bq1, s2, 0, 0, 0); s3 = __builtin_amdgcn_mfma_f32_16x16x32_bf16(kd1, bq1, s3, 0, 0, 0); }
            const int lmi = max(max(max(imax3(s0[0], s0[1], s0[2]), imax3(s0[3], s1[0], s1[1])), max(imax3(s1[2], s1[3], s2[0]), imax3(s2[1], s2[2], s2[3]))), max(imax3(s3[0], s3[1], s3[2]), __float_as_int(s3[3])));
            if (first || __any(lmi > 0x41000000)) {
                float lmx = fmaxf(fmaxf(fmaxf(fmaxf(s0[0], s0[1]), fmaxf(s0[2], s0[3])), fmaxf(fmaxf(s1[0], s1[1]), fmaxf(s1[2], s1[3]))), fmaxf(fmaxf(fmaxf(s2[0], s2[1]), fmaxf(s2[2], s2[3])), fmaxf(fmaxf(s3[0], s3[1]), fmaxf(s3[2], s3[3]))));
                { const auto r1 = __builtin_amdgcn_permlane16_swap(__float_as_uint(lmx), __float_as_uint(lmx), false, false); lmx = fmaxf(__uint_as_float(r1[0]), __uint_as_float(r1[1])); }
                { const auto r2 = __builtin_amdgcn_permlane32_swap(__float_as_uint(lmx), __float_as_uint(lmx), false, false); lmx = fmaxf(__uint_as_float(r2[0]), __uint_as_float(r2[1])); }
                const float dl = first ? lmx : fmaxf(lmx, 0.f);
                m_run += dl; const float f = first ? 1.0f : __builtin_amdgcn_exp2f(-dl);
#pragma unroll
                for (int i = 0; i < 4; ++i) { s0[i] -= dl; s1[i] -= dl; s2[i] -= dl; s3[i] -= dl; negm[i] = -m_run; }
                lacc = lacc * f;
#pragma unroll
                for (int dt = 0; dt < 4; ++dt) o[dt] = o[dt] * f;
                first = false;
            }
            const u32x2 mk0 = *(LAS const u32x2*)(mlut + ((mwA & 15) << 3)), mk1 = *(LAS const u32x2*)(mlut + (((mwA >> 16) & 15) << 3));
            const u32x2 mk2 = *(LAS const u32x2*)(mlut + ((mwB & 15) << 3)), mk3 = *(LAS const u32x2*)(mlut + (((mwB >> 16) & 15) << 3));
            u32x4 pwA, pwB;
            pwA.x = cvtpk(__builtin_amdgcn_exp2f(s0[0]), __builtin_amdgcn_exp2f(s0[1])) & mk0.x; pwA.y = cvtpk(__builtin_amdgcn_exp2f(s0[2]), __builtin_amdgcn_exp2f(s0[3])) & mk0.y;
            pwA.z = cvtpk(__builtin_amdgcn_exp2f(s1[0]), __builtin_amdgcn_exp2f(s1[1])) & mk1.x; pwA.w = cvtpk(__builtin_amdgcn_exp2f(s1[2]), __builtin_amdgcn_exp2f(s1[3])) & mk1.y;
            pwB.x = cvtpk(__builtin_amdgcn_exp2f(s2[0]), __builtin_amdgcn_exp2f(s2[1])) & mk2.x; pwB.y = cvtpk(__builtin_amdgcn_exp2f(s2[2]), __builtin_amdgcn_exp2f(s2[3])) & mk2.y;
            pwB.z = cvtpk(__builtin_amdgcn_exp2f(s3[0]), __builtin_amdgcn_exp2f(s3[1])) & mk3.x; pwB.w = cvtpk(__builtin_amdgcn_exp2f(s3[2]), __builtin_amdgcn_exp2f(s3[3])) & mk3.y;
            const bf16x8v pfA = __builtin_bit_cast(bf16x8v, pwA), pfB = __builtin_bit_cast(bf16x8v, pwB);
            lacc = __builtin_amdgcn_mfma_f32_16x16x32_bf16(ones, pfA, lacc, 0, 0, 0);
            lacc = __builtin_amdgcn_mfma_f32_16x16x32_bf16(ones, pfB, lacc, 0, 0, 0);
#pragma unroll
            for (int dt = 0; dt < 4; ++dt) {
                const s16x4v lo = lds_tr16(slot + vofs + dt * 1024), hi = lds_tr16(slot + vofs + dt * 1024 + 512);
                const s16x4v lo2 = lds_tr16(slot + 4096 + vofs + dt * 1024), hi2 = lds_tr16(slot + 4096 + vofs + dt * 1024 + 512);
                const bf16x8v vf = {lo[0], lo[1], lo[2], lo[3], hi[0], hi[1], hi[2], hi[3]};
                const bf16x8v vf2 = {lo2[0], lo2[1], lo2[2], lo2[3], hi2[0], hi2[1], hi2[2], hi2[3]};
                o[dt] = __builtin_amdgcn_mfma_f32_16x16x32_bf16(vf, pfA, o[dt], 0, 0, 0);
                o[dt] = __builtin_amdgcn_mfma_f32_16x16x32_bf16(vf2, pfB, o[dt], 0, 0, 0);
            }
        }
        asm volatile("s_waitcnt vmcnt(0) lgkmcnt(0)" ::: "memory");
        __syncthreads();
    }
#undef DSA_STAGE
    const float inv = 1.0f / lacc[0];
    bf16* yrow = p.Y + ((size_t)b * SEQ + q0 + r16) * DM + 512 + h * 64;
#pragma unroll
    for (int dt = 0; dt < 4; ++dt) {
        const u32x2 gw = gwv[dt];
        const float g0 = __uint_as_float(gw.x << 16), g1 = __uint_as_float(gw.x & 0xffff0000u), g2 = __uint_as_float(gw.y << 16), g3 = __uint_as_float(gw.y & 0xffff0000u);
        u32x2 w; w.x = pk2(o[dt][0] * inv * siluf(g0), o[dt][1] * inv * siluf(g1)); w.y = pk2(o[dt][2] * inv * siluf(g2), o[dt][3] * inv * siluf(g3));
        *(u32x2*)(yrow + dt * 16 + 4 * g) = w;
    }
    __syncthreads();
    }
}
__device__ __forceinline__ int dsa_qt_of(int j, int i) { return (i == 0) ? 127 - j : (i == 1) ? 64 + j : (i == 2) ? 63 - j : j; }
__device__ __forceinline__ void dsa_phase_pre(const P& p, LAS unsigned char* lds, bf16x8v (&pk)[4]) {
    const int G = gridDim.x, wg = blockIdx.x, lane = threadIdx.x & 63, wave = __builtin_amdgcn_readfirstlane(threadIdx.x >> 6);
    const int b = (G == 256) ? (wg & 7) : (wg >> 7), qt = (G == 256) ? dsa_qt_of(wg >> 3, 0) : 127 - (wg & 127);
#pragma unroll
    for (int i = 0; i < 4; ++i) pk[i] = (bf16x8v){0, 0, 0, 0, 0, 0, 0, 0};
    if (wg < 1024 && qt >= TOPK / 16) { dsa_prefetch_qi(p.Z + (size_t)b * SEQ * ZP, qt, lds, wave, lane); dsa_prefetch_ki(p.Z + (size_t)b * SEQ * ZP, qt, pk, wave, lane); }
}
__device__ __forceinline__ void dsa_phase(const P& p, LAS unsigned char* lds, bf16x8v (&pk)[4]) {
    const int G = gridDim.x, wg = blockIdx.x;
    if (G == 256) {
        const int b = wg & 7, j = wg >> 3;
#pragma unroll 1
        for (int i = 0; i < 4; ++i) dsa_unit(p, b, dsa_qt_of(j, i), (i < 3) ? dsa_qt_of(j, i + 1) : -1, pk, lds);
    }
}
constexpr int LRU_WS_OFF = 139264;
constexpr int LRU_XB = 264 * 128;
constexpr int LRU_GB = 256 * 32;
constexpr int LRU_BUF = LRU_XB + LRU_GB;
__device__ __forceinline__ float fast_sigm(float x) { return __builtin_amdgcn_rcpf(1.0f + __expf(-x)); }
__device__ __forceinline__ void lru_unit(const P& p, int l, int b, int blk, int q4, LAS unsigned char* lds) {
    const int tid = threadIdx.x, lane = tid & 63, wave = __builtin_amdgcn_readfirstlane(tid >> 6), r16 = lane & 15, g = lane >> 4;
    const bf16* zb = p.Z + (size_t)b * SEQ * ZP;
    const int cA = blk * 64, dloc = q4 * 16 + r16, dg = blk * 64 + dloc;
    const unsigned lds_base = (unsigned)(uintptr_t)lds;
#define LRU_STAGE(r) do { const unsigned bb_ = lds_base + (unsigned)(((r) & 1) * LRU_BUF); \
        _Pragma("unroll") for (int i_ = 0; i_ < 5; ++i_) { const int pc_ = wave + 8 * i_; if (pc_ < 33) { const int rho_ = pc_ * 8 + (lane >> 3); int t_ = (r) * 256 - 3 + rho_; t_ = t_ < 0 ? 0 : (t_ > SEQ - 1 ? SEQ - 1 : t_); \
            const int ch_ = (lane & 7) ^ ((rho_ >> 1) & 7); glds16(zb + (size_t)t_ * ZP + C_XR + cA + ch_ * 8, (unsigned)__builtin_amdgcn_readfirstlane(bb_ + pc_ * 1024)); } } \
        { const int row_ = wave * 32 + (lane >> 1); glds16(zb + (size_t)((r) * 256 + row_) * ZP + C_GR + dg - r16 + (lane & 1) * 8, (unsigned)__builtin_amdgcn_readfirstlane(bb_ + LRU_XB + wave * 1024)); } } while (0)
    LRU_STAGE(0);
    float cwA[2][4][8], cbA[2][8];
#pragma unroll
    for (int s = 0; s < 2; ++s)
#pragma unroll
        for (int j = 0; j < 8; ++j) { const int c = cA + 32 * s + 8 * g + j; cbA[s][j] = p.conv_b[l * 512 + c];
#pragma unroll
            for (int k = 0; k < 4; ++k) cwA[s][k][j] = p.conv_w[(l * 4 + k) * 512 + c]; }
    bf16x8v bxf[2], baf[2];
#pragma unroll
    for (int s = 0; s < 2; ++s) { u32x4 wx, wa; unsigned tx[8], ta[8];
#pragma unroll
        for (int j = 0; j < 8; ++j) { const size_t idx = (((size_t)l * 8 + blk) * 64 + 32 * s + 8 * g + j) * 64 + dloc; tx[j] = f2bf(p.lru_wx[idx]); ta[j] = f2bf(p.lru_wa[idx]); }
        wx.x = tx[0] | (tx[1] << 16); wx.y = tx[2] | (tx[3] << 16); wx.z = tx[4] | (tx[5] << 16); wx.w = tx[6] | (tx[7] << 16);
        wa.x = ta[0] | (ta[1] << 16); wa.y = ta[2] | (ta[3] << 16); wa.z = ta[4] | (ta[5] << 16); wa.w = ta[6] | (ta[7] << 16);
        bxf[s] = __builtin_bit_cast(bf16x8v, wx); baf[s] = __builtin_bit_cast(bf16x8v, wa); }
    const float cw0 = p.conv_w[(l * 4 + 0) * 512 + dg], cw1 = p.conv_w[(l * 4 + 1) * 512 + dg], cw2 = p.conv_w[(l * 4 + 2) * 512 + dg], cw3 = p.conv_w[(l * 4 + 3) * 512 + dg];
    const float cb = p.conv_b[l * 512 + dg], bxv = p.lru_bx[l * 512 + dg], bav = p.lru_ba[l * 512 + dg];
    const float sp8 = -8.0f * log1pf(expf(-p.lru_a[l * 512 + dg]));
    asm volatile("" :: "v"(cwA[0][0][0]), "v"(cwA[1][3][7]), "v"(cbA[1][7]), "v"(bxf[0]), "v"(bxf[1]), "v"(baf[0]), "v"(baf[1]), "v"(cw0), "v"(cw1), "v"(cw2), "v"(cw3), "v"(cb), "v"(bxv), "v"(bav), "v"(sp8));
    LAS float* WS = (LAS float*)(lds + LRU_WS_OFF);
    float hrun = 0.f;
    asm volatile("s_waitcnt vmcnt(0)" ::: "memory");
#pragma unroll 1
    for (int round = 0; round < 8; ++round) {
        asm volatile("s_waitcnt vmcnt(8)" ::: "memory");
        __syncthreads();
        if (round + 1 < 8) LRU_STAGE(round + 1);
        LAS const unsigned char* xb = lds + (round & 1) * LRU_BUF; LAS const unsigned char* gb = xb + LRU_XB;
        const int tw = round * 256 + wave * 32;
        float hl[2][4], pl[2][4], gr4[2][4], PT[2], HT[2], PE[2], HE[2];
#pragma unroll
        for (int tau = 0; tau < 2; ++tau) {
            const int t0 = tw + 16 * tau, rho0 = wave * 32 + 16 * tau;
            bf16x8v af[2];
#pragma unroll
            for (int s = 0; s < 2; ++s) {
                float xc[8];
#pragma unroll
                for (int j = 0; j < 8; ++j) xc[j] = cbA[s][j];
#pragma unroll
                for (int k = 0; k < 4; ++k) { const int rho = rho0 + r16 + k; u32x4 w = *(LAS const u32x4*)(xb + rho * 128 + (((4 * s + g) ^ (rho >> 1)) & 7) * 16);
                    if (t0 + r16 - 3 + k < 0) w = (u32x4){0u, 0u, 0u, 0u};
                    xc[0] += cwA[s][k][0] * __uint_as_float(w.x << 16); xc[1] += cwA[s][k][1] * __uint_as_float(w.x & 0xffff0000u);
                    xc[2] += cwA[s][k][2] * __uint_as_float(w.y << 16); xc[3] += cwA[s][k][3] * __uint_as_float(w.y & 0xffff0000u);
                    xc[4] += cwA[s][k][4] * __uint_as_float(w.z << 16); xc[5] += cwA[s][k][5] * __uint_as_float(w.z & 0xffff0000u);
                    xc[6] += cwA[s][k][6] * __uint_as_float(w.w << 16); xc[7] += cwA[s][k][7] * __uint_as_float(w.w & 0xffff0000u); }
                u32x4 pw; pw.x = cvtpk(xc[0], xc[1]); pw.y = cvtpk(xc[2], xc[3]); pw.z = cvtpk(xc[4], xc[5]); pw.w = cvtpk(xc[6], xc[7]);
                af[s] = __builtin_bit_cast(bf16x8v, pw);
            }
            f32x4 gx = {0.f, 0.f, 0.f, 0.f}, ga = {0.f, 0.f, 0.f, 0.f};
            gx = __builtin_amdgcn_mfma_f32_16x16x32_bf16(af[0], bxf[0], gx, 0, 0, 0); gx = __builtin_amdgcn_mfma_f32_16x16x32_bf16(af[1], bxf[1], gx, 0, 0, 0);
            ga = __builtin_amdgcn_mfma_f32_16x16x32_bf16(af[0], baf[0], ga, 0, 0, 0); ga = __builtin_amdgcn_mfma_f32_16x16x32_bf16(af[1], baf[1], ga, 0, 0, 0);
            float xo[7];
#pragma unroll
            for (int m = 0; m < 7; ++m) { const int rho = rho0 + 4 * g + m;
                const unsigned short v = *(LAS const unsigned short*)(xb + rho * 128 + (((dloc >> 3) ^ (rho >> 1)) & 7) * 16 + (dloc & 7) * 2);
                xo[m] = (t0 + 4 * g - 3 + m >= 0) ? bf2f(v) : 0.f; }
            float Pr = 1.f, Hr = 0.f;
#pragma unroll
            for (int i = 0; i < 4; ++i) {
                const float xcv = cb + cw0 * xo[i] + cw1 * xo[i + 1] + cw2 * xo[i + 2] + cw3 * xo[i + 3];
                const float sx = fast_sigm(gx[i] + bxv), sa = fast_sigm(ga[i] + bav);
                const float la = sp8 * sa, a = __expf(la), y2 = 2.0f * la;
                const float ser = -y2 * (1.0f + y2 * (0.5f + y2 * (0.16666667f + y2 * (0.041666668f + y2 * (0.0083333338f + y2 * 0.0013888889f)))));
                const float em = (y2 > -0.25f) ? ser : (1.0f - __expf(y2));
                const float u = __builtin_amdgcn_sqrtf(em) * sx * xcv;
                Hr = a * Hr + u; Pr *= a; hl[tau][i] = Hr; pl[tau][i] = Pr;
                gr4[tau][i] = bf2f(*(LAS const unsigned short*)(gb + (rho0 + 4 * g + i) * 32 + r16 * 2));
            }
            float Pi = Pr, Hi = Hr;
            { const float Pl = __shfl_up(Pi, 16), Hl = __shfl_up(Hi, 16); if (g >= 1) { Hi = Pi * Hl + Hi; Pi = Pl * Pi; } }
            { const float Pl = __shfl_up(Pi, 32), Hl = __shfl_up(Hi, 32); if (g >= 2) { Hi = Pi * Hl + Hi; Pi = Pl * Pi; } }
            float Pe = __shfl_up(Pi, 16), He = __shfl_up(Hi, 16); if (g == 0) { Pe = 1.f; He = 0.f; }
            PT[tau] = __shfl(Pi, 48 + r16); HT[tau] = __shfl(Hi, 48 + r16); PE[tau] = Pe; HE[tau] = He;
        }
        HE[1] = PE[1] * HT[0] + HE[1]; PE[1] = PT[0] * PE[1];
        const float Pw = PT[0] * PT[1], Hw = PT[1] * HT[0] + HT[1];
        LAS float* wsr = WS + (round & 1) * 256;
        if (g == 0) { wsr[(wave * 16 + r16) * 2 + 0] = Pw; wsr[(wave * 16 + r16) * 2 + 1] = Hw; }
        asm volatile("s_waitcnt lgkmcnt(0)" ::: "memory");
        __builtin_amdgcn_s_barrier();
        asm volatile("" ::: "memory");
        float hc = hrun, hall = hrun;
#pragma unroll
        for (int w2 = 0; w2 < 8; ++w2) { if (w2 == wave) hc = hall; hall = wsr[(w2 * 16 + r16) * 2 + 0] * hall + wsr[(w2 * 16 + r16) * 2 + 1]; }
        hrun = hall;
#pragma unroll
        for (int tau = 0; tau < 2; ++tau) {
            const float hin = PE[tau] * hc + HE[tau];
            bf16* yp = p.Y + ((size_t)b * SEQ + tw + 16 * tau + 4 * g) * DM + dg;
#pragma unroll
            for (int i = 0; i < 4; ++i) { const float h = hl[tau][i] + pl[tau][i] * hin, gr = gr4[tau][i]; yp[(size_t)i * DM] = (bf16)f2bf(h * gr * fast_sigm(gr)); }
        }
    }
#undef LRU_STAGE
    __syncthreads();
}
__device__ __forceinline__ void lru_phase(const P& p, int l, LAS unsigned char* lds) {
    const int G = gridDim.x, wg = blockIdx.x;
#pragma unroll 1
    for (int u = wg; u < 256; u += G) lru_unit(p, l, (u >> 3) & 7, u & 7, u >> 6, lds);
}
#ifndef DSA_PHASE
#define DSA_PHASE dsa_phase
#endif
#ifndef LRU_PHASE
#define LRU_PHASE lru_phase
#endif
#ifndef RP_A
#define RP_A 1
#endif
#ifndef RP_L
#define RP_L 1
#endif
#ifndef RP_D
#define RP_D 1
#endif
#ifndef RP_C
#define RP_C 1
#endif
#ifndef RP_0
#define RP_0 1
#endif
template <int OFF> __device__ __forceinline__ unsigned long long karg_u64() {
    unsigned long long v; const unsigned long long kp = (unsigned long long)__builtin_amdgcn_kernarg_segment_ptr();
    asm volatile("s_load_dwordx2 %0, %1, %2\n\ts_waitcnt lgkmcnt(0)" : "=s"(v) : "s"(kp), "i"(OFF) : "memory");
    return v;
}
struct Args { const float* in[15]; float* out; unsigned char* ws; int ph_lo, ph_hi; };
__global__ void __launch_bounds__(512, 2) mega(Args a) {
    extern __shared__ __attribute__((aligned(16))) unsigned char lds_raw[];
    LAS unsigned char* lds = (LAS unsigned char*)lds_raw;
#define KARG(T, off) ((T)(__attribute__((address_space(1))) void*)karg_u64<(off)>())
#define LOADP() P p; { unsigned char* ws_ = KARG(unsigned char*, 128); \
        p.x = KARG(const float*, 0); p.c = KARG(const float*, 8); p.norm_g = KARG(const float*, 16); p.ada_w = KARG(const float*, 24); p.ada_b = KARG(const float*, 32); p.w_in = KARG(const float*, 40); \
        p.conv_w = KARG(const float*, 48); p.conv_b = KARG(const float*, 56); p.lru_wx = KARG(const float*, 64); p.lru_bx = KARG(const float*, 72); p.lru_wa = KARG(const float*, 80); p.lru_ba = KARG(const float*, 88); \
        p.lru_a = KARG(const float*, 96); p.w_out = KARG(const float*, 104); p.final_g = KARG(const float*, 112); p.out = KARG(float*, 120); \
        p.ctl = (unsigned*)(ws_ + WS_CTL); p.mod = (float*)(ws_ + WS_MOD); p.bias = (float*)(ws_ + WS_BIAS); p.ssq = (float*)(ws_ + WS_SSQ); \
        p.wt_in = (bf16*)(ws_ + WS_WTIN); p.wt_out = (bf16*)(ws_ + WS_WTOUT); p.A = (bf16*)(ws_ + WS_A); p.Z = (bf16*)(ws_ + WS_Z); p.Y = (bf16*)(ws_ + WS_Y); p.X1 = (bf16*)(ws_ + WS_X1); }
    unsigned* const ctl0 = (unsigned*)((unsigned char*)a.ws + WS_CTL);
    const int lo = a.ph_lo, hi = a.ph_hi;
    volatile LAS unsigned* MISC = (volatile LAS unsigned*)(lds + MISC_OFF + 4096);
    if (threadIdx.x < 4) MISC[threadIdx.x] = 0u;
    if (threadIdx.x < 16) { const unsigned t = threadIdx.x; u32x2 m; m.x = ((t & 1u) ? 0xffffu : 0u) | ((t & 2u) ? 0xffff0000u : 0u); m.y = ((t & 4u) ? 0xffffu : 0u) | ((t & 8u) ? 0xffff0000u : 0u);
        *(LAS u32x2*)(lds + DSA_MLUT_OFF + t * 8) = m; }
    __syncthreads();
    XcdBarrier bar; bar.bar = ctl0 + CW_BAR; bar.x = 0; bar.st = MISC;
    if (hi - lo > 1) bar = xcd_barrier_post(ctl0 + CW_BAR, MISC);
#define IN(k) (lo <= (k) && (k) < hi)
#ifndef N_CG_SEAMS
#define N_CG_SEAMS 0
#endif
#define SEAM(k) do { if (IN(k) && IN((k) + 1)) { if ((k) < N_CG_SEAMS) cg::this_grid().sync(); else xcd_barrier(bar); } } while (0)
    if (IN(0)) { LOADP(); ph0_prologue(p, lds); if (RP_0 > 1) { __syncthreads(); ph0_prologue(p, lds); } }
    SEAM(0);
    if (IN(1)) { LOADP(); ph1_prologue(p, lds); if (RP_0 > 1) { __syncthreads(); ph1_prologue(p, lds); } }
    SEAM(1);
#ifdef PROBE_BAR
#define SEAM_X(b) do { SEAM(b); SEAM(b); SEAM(b); SEAM(b); } while (0)
#else
#define SEAM_X(b) do { } while (0)
#endif
#define LAYER(l, base) \
    if (IN(base)) { LOADP(); \
        pg8::Gemm g{p.A, p.wt_in + (size_t)(l) * ZP * 1024, MROWS, ZP, DM}; pg8::StaticOrder S; S.init(MROWS, ZP, (int)gridDim.x, (int)blockIdx.x); \
        EpiZ E{p.Z, p.ssq, p.bias + (size_t)(l) * 8 * ZP}; \
        pg8::gemm_phase<EpiZ, pg8::StaticOrder, PG8_ALIGN, PG8_SP2>(lds, g, S, E); if (RP_A > 1) { __syncthreads(); pg8::gemm_phase<EpiZ, pg8::StaticOrder, PG8_ALIGN, PG8_SP2>(lds, g, S, E); } \
    } \
    SEAM(base); SEAM_X(base); \
    if (IN((base) + 1)) { LOADP(); bf16x8v pk0[4]; dsa_phase_pre(p, lds, pk0); LRU_PHASE(p, (l), lds); __syncthreads(); DSA_PHASE(p, lds, pk0); } \
    SEAM((base) + 1); \
    if (IN((base) + 2)) { LOADP(); \
        pg8::Gemm g{p.Y, p.wt_out + (size_t)(l) * 1024 * 1024, MROWS, DM, DM}; pg8::StaticOrder S; S.init(MROWS, DM, (int)gridDim.x, (int)blockIdx.x); \
        if constexpr ((l) == DEPTH - 1) { \
            EpiXF E{p.X1, p.out, p.mod + (size_t)(l) * 8 * 3072 + 2048, p.final_g, p.ssq, p.ctl + CW_PANEL}; \
            pg8::gemm_phase<EpiXF, pg8::StaticOrder, false, PG8_SP2>(lds, g, S, E); \
        } else { \
            EpiX E{p.x, p.X1, p.A, p.mod + (size_t)(l) * 8 * 3072 + 2048, p.norm_g + (size_t)((l) + 1) * 1024, p.mod + (size_t)((l) + 1) * 8 * 3072 + 1024, p.ssq}; \
            pg8::gemm_phase<EpiX, pg8::StaticOrder, false, PG8_SP2>(lds, g, S, E); if (RP_C > 1 && (l) == 0) { __syncthreads(); pg8::gemm_phase<EpiX, pg8::StaticOrder, false, PG8_SP2>(lds, g, S, E); } \
        } \
    } \
    if ((base) + 3 < NPHASE) SEAM((base) + 2);
    LAYER(0, 2)
    LAYER(1, 5)
}
#ifndef MK_N_LAUNCHES
#define MK_N_LAUNCHES 1
#endif
extern "C" void kernel_launch(void* const* d_in, const int* in_sizes, int n_in, void* d_out, int out_size, void* d_ws, size_t ws_size, hipStream_t stream) {
    static int grid = 0;
    if (grid == 0) {
        if (n_in != 15 || out_size != MROWS * DM || ws_size < WS_END) { fprintf(stderr, "kernel_launch: unexpected problem (n_in %d out %d ws %zu)\n", n_in, out_size, ws_size); grid = -1; return; }
        int dev = 0, cus = 0, per_cu = 0;
        hipGetDevice(&dev); hipDeviceGetAttribute(&cus, hipDeviceAttributeMultiprocessorCount, dev);
        if (hipFuncSetAttribute((const void*)mega, hipFuncAttributeMaxDynamicSharedMemorySize, LDS_BYTES) != hipSuccess) { fprintf(stderr, "kernel_launch: hipFuncSetAttribute failed\n"); grid = -1; return; }
        if (hipOccupancyMaxActiveBlocksPerMultiprocessor(&per_cu, (const void*)mega, 512, LDS_BYTES) != hipSuccess || per_cu < 1) { fprintf(stderr, "kernel_launch: occupancy query failed (%d)\n", per_cu); per_cu = 1; }
        (void)hipGetLastError();
        grid = cus * per_cu;
        if (grid != 256) fprintf(stderr, "kernel_launch: grid %d (cus %d x %d) != 256: the fused out-projection epilogue needs exactly 256 workgroups\n", grid, cus, per_cu);
    }
    if (grid < 0) return;
    hipMemsetAsync((char*)d_ws + WS_CTL, 0, CTL_ZERO_BYTES, stream);
    Args a{};
    for (int i = 0; i < 15; ++i) a.in[i] = (const float*)d_in[i];
    a.out = (float*)d_out; a.ws = (unsigned char*)d_ws;
#if MK_N_LAUNCHES == 1
    a.ph_lo = 0; a.ph_hi = NPHASE;
    void* args[] = {&a};
    hipError_t e = hipLaunchCooperativeKernel((const void*)mega, dim3(grid), dim3(512), args, LDS_BYTES, stream);
    if (e != hipSuccess) fprintf(stderr, "cooperative launch failed: %s (grid %d)\n", hipGetErrorString(e), grid);
#else
    for (int ph = 0; ph < NPHASE; ++ph) { a.ph_lo = ph; a.ph_hi = ph + 1; hipLaunchKernelGGL(mega, dim3(grid), dim3(512), LDS_BYTES, stream, a); }
#endif
}
```

```cpp
#include <hip/hip_runtime.h>
#include <hip/hip_cooperative_groups.h>
#include <cstdio>
#include <cstdint>
#include <cmath>
namespace cg = cooperative_groups;
#define EPI_XD 4
#define EPI_ZD 8
#define HIST_WAVES 8
#define PRO_KC 64
#define HISTA_FALLBACK 1
#define WALK_MAX 4
#define XB_FLAT_RELEASE 1

namespace pg8 {
#define PG8_LAS __attribute__((address_space(3)))
typedef unsigned short bf16_t;
typedef short bf16x8 __attribute__((ext_vector_type(8)));
typedef float f32x4 __attribute__((ext_vector_type(4)));
typedef unsigned u32x4 __attribute__((ext_vector_type(4)));
constexpr int BM = 256, BK = 64, HALF = 128, HTB = HALF * BK * 2  , STAGE_BYTES = 8 * HTB, NXCD = 8, WGM = 8;

__host__ __device__ __forceinline__ int lds_byte(int r, int c) { const int st = (r >> 4) * 2 + (c >> 5), rr = r & 15, cc = c & 31, ob = rr * 64 + cc * 2; return st * 1024 + (ob ^ (((ob >> 9) & 1) << 5)); }
__host__ __device__ __forceinline__ void stage_rc(int b, int& R, int& C) { const int st = b / 1024, sb = b % 1024, swz = sb ^ (((sb >> 9) & 1) << 5); R = (st >> 1) * 16 + swz / 64; C = (st & 1) * 32 + (swz % 64) / 2; }
__host__ __device__ __forceinline__ int perm32(int rho) { const int n = rho >> 4, i = rho & 15; return 8 * (i >> 2) + 4 * n + (i & 3); }

struct Unit { int pm, pn; };
struct Gemm { const bf16_t* A; const bf16_t* Bt; int M, N, K; };

struct StaticOrder {
    int nM, nN, nwg, G, c;
    __host__ __device__ void init(int M, int N, int G_, int c_) { nM = M / BM; nN = N / BM; nwg = nM * nN; G = G_; c = c_; }
    __host__ __device__ bool next(int i, Unit& u) const {
        const long L = (long)i * G + c; if (L >= nwg) return false;
        int wgid = (int)L; { const int q = nwg / NXCD, r = nwg % NXCD, xcd = wgid % NXCD, off = wgid / NXCD; wgid = (xcd < r ? xcd * (q + 1) : r * (q + 1) + (xcd - r) * q) + off; }
        const int nig = WGM * nN, gid = wgid / nig, fm = gid * WGM, gsz = (nM - fm) < WGM ? (nM - fm) : WGM;
        u.pm = fm + ((wgid % nig) % gsz); u.pn = (wgid % nig) / gsz; return true;
    }
    __device__ __forceinline__ void a_ready(const Unit&) const {}
    __device__ __forceinline__ void done(const Unit&) const {}
};

__device__ __forceinline__ unsigned cvt_pk_bf16(float lo, float hi) { unsigned r; asm volatile("v_cvt_pk_bf16_f32 %0, %1, %2" : "=v"(r) : "v"(lo), "v"(hi)); return r; }
typedef float f32x2 __attribute__((ext_vector_type(2)));
template <class Epi, class Sched, bool ALIGN_EPI = false, bool SP2 = false>
__device__ __forceinline__ void gemm_phase(PG8_LAS unsigned char* lds, const Gemm g, const Sched& S, const Epi& E) {
    const int tid = threadIdx.x, wid = __builtin_amdgcn_readfirstlane(tid >> 6), lane = tid & 63, wr = wid >> 2, wc = wid & 3, fr = lane & 15, fq = lane >> 4;
    const int K = g.K, nt = K / BK;
    unsigned voffA[2], voffB[2];
#pragma unroll
    for (int i = 0; i < 2; ++i) { int R, C; stage_rc(tid * 16 + i * 8192, R, C); const int Rb = Epi::PERM ? ((R & ~31) + perm32(R & 31)) : R;
        voffA[i] = (unsigned)(R * K + C) * 2u; voffB[i] = (unsigned)(Rb * K + C) * 2u; }
    const size_t kstep = (size_t)(BK * 2);
    const size_t hstep = (size_t)HALF * K * 2;
    const size_t tstep = 2 * hstep;
    const unsigned ldsw = (unsigned)wid * 1024u;
    const int aoff = lds_byte(wr * 64 + fr, fq * 8), boff = lds_byte(wc * 32 + fr, fq * 8);
#define PG8_SA(b, h) (((b) * 2 + (h)) * HTB)
#define PG8_SB(b, h) ((4 + (b) * 2 + (h)) * HTB)
#define PG8_STAGE(bufoff, gbase, voff) do { _Pragma("unroll") for (int _i = 0; _i < 2; ++_i) \
        __builtin_amdgcn_global_load_lds((const unsigned*)((const char*)(gbase) + (voff)[_i]), (PG8_LAS unsigned*)(lds + (bufoff) + ldsw + _i * 8192), 16, 0, 0); } while (0)
#define PG8_LDA(dst, b, h) do { _Pragma("unroll") for (int m = 0; m < 4; ++m) _Pragma("unroll") for (int k = 0; k < 2; ++k) dst[m][k] = *(const PG8_LAS bf16x8*)(lds + PG8_SA(b, h) + aoff + m * 2048 + k * 1024); } while (0)
#define PG8_LDB(dst, b, h) do { _Pragma("unroll") for (int n = 0; n < 2; ++n) _Pragma("unroll") for (int k = 0; k < 2; ++k) dst[n][k] = *(const PG8_LAS bf16x8*)(lds + PG8_SB(b, h) + boff + n * 2048 + k * 1024); } while (0)
#define PG8_MMA(ai, bj, At, Bt) do { __builtin_amdgcn_s_setprio(1); _Pragma("unroll") for (int m = 0; m < 4; ++m) _Pragma("unroll") for (int n = 0; n < 2; ++n) _Pragma("unroll") for (int k = 0; k < 2; ++k) \
        acc[ai][bj][m][n] = __builtin_amdgcn_mfma_f32_16x16x32_bf16(Bt[n][k], At[m][k], acc[ai][bj][m][n], 0, 0, 0); __builtin_amdgcn_s_setprio(0); } while (0)
#define PG8_WAIT_V(n) asm volatile("s_waitcnt vmcnt(" #n ")" ::: "memory")
#define PG8_WAIT_L(n) asm volatile("s_waitcnt lgkmcnt(" #n ")" ::: "memory")
#define PG8_BAR __builtin_amdgcn_s_barrier()
#define PG8_SCHED __builtin_amdgcn_sched_barrier(0)
    Unit cur, nxt; int ui = 0;
    if (!S.next(0, cur)) return;
    f32x4 acc[2][2][4][2];
#pragma unroll
    for (int a = 0; a < 2; ++a)
#pragma unroll
        for (int b = 0; b < 2; ++b)
#pragma unroll
            for (int m = 0; m < 4; ++m)
#pragma unroll
                for (int n = 0; n < 2; ++n) acc[a][b][m][n] = (f32x4){0.f, 0.f, 0.f, 0.f};
    bf16x8 At[4][2], B0[2][2], B1[2][2];
    const char* cA = (const char*)g.A + (size_t)cur.pm * tstep; const char* cB = (const char*)g.Bt + (size_t)cur.pn * tstep;
    S.a_ready(cur);
    if constexpr (SP2) {
        PG8_STAGE(PG8_SB(0, 0), cB, voffB); PG8_STAGE(PG8_SB(0, 1), cB + hstep, voffB); PG8_STAGE(PG8_SA(0, 0), cA, voffA); PG8_STAGE(PG8_SA(0, 1), cA + hstep, voffA);
        if (wr == 1) PG8_BAR;
        PG8_WAIT_V(2); PG8_BAR;
        PG8_STAGE(PG8_SB(1, 0), cB + kstep, voffB); PG8_STAGE(PG8_SA(1, 0), cA + kstep, voffA); PG8_STAGE(PG8_SB(1, 1), cB + hstep + kstep, voffB);
        PG8_WAIT_V(6); PG8_BAR;
    } else {
        PG8_STAGE(PG8_SB(0, 0), cB, voffB); PG8_STAGE(PG8_SA(0, 0), cA, voffA); PG8_STAGE(PG8_SB(0, 1), cB + hstep, voffB); PG8_STAGE(PG8_SA(0, 1), cA + hstep, voffA);
        if (wr == 1) PG8_BAR;
        PG8_WAIT_V(4); PG8_BAR;
        PG8_STAGE(PG8_SB(1, 0), cB + kstep, voffB); PG8_STAGE(PG8_SA(1, 0), cA + kstep, voffA); PG8_STAGE(PG8_SB(1, 1), cB + hstep + kstep, voffB);
        PG8_WAIT_V(6); PG8_BAR;
    }
    for (;;) {
        const bool has_next = S.next(ui + 1, nxt);
        const char* nA = has_next ? (const char*)g.A + (size_t)nxt.pm * tstep : cA; const char* nB = has_next ? (const char*)g.Bt + (size_t)nxt.pn * tstep : cB;
        for (int t = 0; t < nt; t += 2) {
            const bool last = (t == nt - 2);
            const char* a1 = cA + (size_t)(t + 1) * kstep;
            const char* a2 = last ? nA : cA + (size_t)(t + 2) * kstep; const char* b2 = last ? nB : cB + (size_t)(t + 2) * kstep;
            const char* a3 = a2 + kstep; const char* b3 = b2 + kstep;
            if (last && has_next) S.a_ready(nxt);
            if constexpr (SP2) {
            PG8_LDB(B0, 0, 0); PG8_LDB(B1, 0, 1); PG8_SCHED; PG8_LDA(At, 0, 0); PG8_STAGE(PG8_SA(1, 1), a1 + hstep, voffA);
            PG8_WAIT_V(8); PG8_WAIT_L(0); PG8_BAR; PG8_MMA(0, 0, At, B0); PG8_MMA(0, 1, At, B1); PG8_BAR; PG8_SCHED;
            PG8_LDA(At, 0, 1); PG8_STAGE(PG8_SB(0, 0), b2, voffB); PG8_STAGE(PG8_SB(0, 1), b2 + hstep, voffB); PG8_STAGE(PG8_SA(0, 0), a2, voffA);
            PG8_WAIT_V(8); PG8_WAIT_L(0); PG8_BAR; PG8_MMA(1, 0, At, B0); PG8_MMA(1, 1, At, B1); PG8_BAR; PG8_SCHED;
            PG8_LDB(B0, 1, 0); PG8_LDB(B1, 1, 1); PG8_SCHED; PG8_LDA(At, 1, 0); PG8_STAGE(PG8_SA(0, 1), a2 + hstep, voffA);
            PG8_WAIT_V(8); PG8_WAIT_L(0); PG8_BAR; PG8_MMA(0, 0, At, B0); PG8_MMA(0, 1, At, B1); PG8_BAR; PG8_SCHED;
            PG8_LDA(At, 1, 1); PG8_STAGE(PG8_SB(1, 0), b3, voffB); PG8_STAGE(PG8_SB(1, 1), b3 + hstep, voffB); PG8_STAGE(PG8_SA(1, 0), a3, voffA);
            PG8_WAIT_V(8); PG8_WAIT_L(0); PG8_BAR; PG8_MMA(1, 0, At, B0); PG8_MMA(1, 1, At, B1); PG8_BAR; PG8_SCHED;
            } else {
            PG8_LDB(B0, 0, 0); PG8_SCHED; PG8_LDA(At, 0, 0); PG8_STAGE(PG8_SA(1, 1), a1 + hstep, voffA);
            PG8_WAIT_L(8); PG8_BAR; PG8_WAIT_L(0); PG8_MMA(0, 0, At, B0); PG8_BAR; PG8_SCHED;
            PG8_LDB(B1, 0, 1); PG8_STAGE(PG8_SB(0, 0), b2, voffB);
            PG8_BAR; PG8_WAIT_L(0); PG8_MMA(0, 1, At, B1); PG8_BAR;
            PG8_LDA(At, 0, 1); PG8_STAGE(PG8_SA(0, 0), a2, voffA);
            PG8_BAR; PG8_WAIT_L(0); PG8_MMA(1, 0, At, B0); PG8_BAR; PG8_SCHED;
            PG8_STAGE(PG8_SB(0, 1), b2 + hstep, voffB);
            PG8_WAIT_V(6); PG8_BAR; PG8_MMA(1, 1, At, B1); PG8_BAR;
            PG8_LDB(B0, 1, 0); PG8_SCHED; PG8_LDA(At, 1, 0); PG8_STAGE(PG8_SA(0, 1), a2 + hstep, voffA);
            PG8_WAIT_L(8); PG8_BAR; PG8_WAIT_L(0); PG8_MMA(0, 0, At, B0); PG8_BAR; PG8_SCHED;
            PG8_LDB(B1, 1, 1); PG8_STAGE(PG8_SB(1, 0), b3, voffB);
            PG8_BAR; PG8_WAIT_L(0); PG8_MMA(0, 1, At, B1); PG8_BAR;
            PG8_LDA(At, 1, 1); PG8_STAGE(PG8_SA(1, 0), a3, voffA);
            PG8_BAR; PG8_WAIT_L(0); PG8_MMA(1, 0, At, B0); PG8_BAR; PG8_SCHED;
            PG8_STAGE(PG8_SB(1, 1), b3 + hstep, voffB);
            PG8_WAIT_V(6); PG8_BAR; PG8_MMA(1, 1, At, B1); PG8_BAR;
            }
        }
        if constexpr (ALIGN_EPI) { if (wr == 0) PG8_BAR; }
        if constexpr (!Epi::AFTER_DRAIN) { E(acc, cur, wr, wc, fr, fq); S.done(cur); }
        if (!has_next) break;
#pragma unroll
        for (int a = 0; a < 2; ++a)
#pragma unroll
            for (int b = 0; b < 2; ++b)
#pragma unroll
                for (int m = 0; m < 4; ++m)
#pragma unroll
                    for (int n = 0; n < 2; ++n) acc[a][b][m][n] = (f32x4){0.f, 0.f, 0.f, 0.f};
        cur = nxt; cA = nA; cB = nB; ++ui;
        if constexpr (ALIGN_EPI) { if (wr == 1) PG8_BAR; }
    }
    PG8_WAIT_V(0);
    if constexpr (!ALIGN_EPI) { if (wr == 0) PG8_BAR; }
    PG8_BAR;
    if constexpr (Epi::AFTER_DRAIN) { E.fused(acc, cur, wr, wc, fr, fq, lds, wid, lane); S.done(cur); }
#undef PG8_SA
#undef PG8_SB
#undef PG8_STAGE
#undef PG8_LDA
#undef PG8_LDB
#undef PG8_MMA
#undef PG8_WAIT_V
#undef PG8_WAIT_L
#undef PG8_BAR
#undef PG8_SCHED
}
}

#ifndef PG8_SP2
#define PG8_SP2 true
#endif
#ifndef PG8_ALIGN
#define PG8_ALIGN true
#endif
constexpr int BATCH = 8, SEQ = 2048, DM = 1024, MROWS = BATCH * SEQ, DEPTH = 2;
constexpr int D_RNN = 512, NHEAD = 8, HDIM = 64, D_INR = 2760, ZP = 2816, TOPK = 256;
constexpr int C_XR = 0, C_GR = 512, C_Q = 1024, C_K = 1536, C_V = 1600, C_GA = 1664, C_QI = 2176, C_KI = 2688, C_WI = 2752;
constexpr float EPS = 1e-6f;
constexpr float QSCALE = 0.125f * 1.4426950408889634f;
constexpr size_t MiB = 1u << 20;
constexpr size_t WS_CTL = 0, CTL_ZERO_BYTES = 1 * MiB;
constexpr size_t WS_MOD = 1 * MiB;
constexpr size_t WS_BIAS = 1 * MiB + 256 * 1024;
constexpr size_t WS_SSQ = 2 * MiB;
constexpr size_t WS_WTIN = 3 * MiB;
constexpr size_t WS_WTOUT = 14 * MiB;
constexpr size_t WS_A = 32 * MiB;
constexpr size_t WS_Z = 64 * MiB;
constexpr size_t WS_Y = 152 * MiB;
constexpr size_t WS_X1 = 184 * MiB;
constexpr size_t WS_END = 216 * MiB;
constexpr int LDS_BYTES = 163840;
constexpr int MISC_OFF = 131072 + 8192;
constexpr int NPHASE = 8;
constexpr int CW_BAR = 4096, CW_PANEL = 16384;

#define LAS __attribute__((address_space(3)))
typedef unsigned short bf16;
typedef float f32x4 __attribute__((ext_vector_type(4)));
typedef unsigned u32x4 __attribute__((ext_vector_type(4)));
typedef unsigned u32x2 __attribute__((ext_vector_type(2)));
__device__ __forceinline__ float bf2f(bf16 v) { return __uint_as_float(((unsigned)v) << 16); }
__device__ __forceinline__ unsigned f2bf(float f) { unsigned u = __float_as_uint(f); return (u + 0x7fffu + ((u >> 16) & 1u)) >> 16; }
__device__ __forceinline__ unsigned pk2(float lo, float hi) { return f2bf(lo) | (f2bf(hi) << 16); }
__device__ __forceinline__ float wave_sum(float v) {
#pragma unroll
    for (int o = 1; o < 64; o <<= 1) v += __shfl_xor(v, o);
    return v;
}
__device__ __forceinline__ float wave_max(float v) {
#pragma unroll
    for (int o = 1; o < 64; o <<= 1) v = fmaxf(v, __shfl_xor(v, o));
    return v;
}
__device__ __forceinline__ int wave_sum_i(int v) {
#pragma unroll
    for (int o = 1; o < 64; o <<= 1) v += __shfl_xor(v, o);
    return v;
}
__device__ __forceinline__ float siluf(float v) { return v / (1.f + expf(-v)); }
__device__ __forceinline__ float sigmf(float v) { return 1.f / (1.f + expf(-v)); }

#ifdef USE_NT
#define NT_STORE(ptr, val) __builtin_nontemporal_store((val), (ptr))
#else
#define NT_STORE(ptr, val) (*(ptr) = (val))
#endif
struct P {
    const float *x, *c, *norm_g, *ada_w, *ada_b, *w_in, *conv_w, *conv_b, *lru_wx, *lru_bx, *lru_wa, *lru_ba, *lru_a, *w_out, *final_g;
    float* out;
    float *mod, *bias, *ssq;
    bf16 *wt_in, *wt_out, *A, *Z, *Y, *X1;
    unsigned* ctl;
};

#ifndef EPI_ZD
#define EPI_ZD 2
#endif
struct EpiZ {
    static constexpr bool PERM = true, AFTER_DRAIN = false;
    bf16* Zp; const float* ssq; const float* bias;
    __device__ __forceinline__ void operator()(const pg8::f32x4 (&acc)[2][2][4][2], const pg8::Unit& u, int wr, int wc, int fr, int fq) const {
        const int row0 = u.pm * 256 + wr * 64 + fr, col0 = u.pn * 256 + wc * 32 + 8 * fq, b = u.pm >> 3;
        const float cs = (u.pn == 4 || u.pn == 5) ? QSCALE : 1.0f;
        f32x4 bv[2][2];
#pragma unroll
        for (int bj = 0; bj < 2; ++bj)
#pragma unroll
            for (int n = 0; n < 2; ++n) bv[bj][n] = *(const f32x4*)(bias + b * ZP + col0 + bj * 128 + 4 * n);
        f32x4 qq[EPI_ZD];
#pragma unroll
        for (int gi = 0; gi < EPI_ZD; ++gi) qq[gi] = *(const f32x4*)(ssq + (size_t)(row0 + (gi >> 2) * 128 + (gi & 3) * 16) * 4);
#pragma unroll
        for (int ai = 0; ai < 2; ++ai)
#pragma unroll
            for (int m = 0; m < 4; ++m) {
                const int r = row0 + ai * 128 + m * 16, gi = ai * 4 + m;
                const f32x4 q = qq[gi % EPI_ZD];
                if (gi + EPI_ZD < 8) qq[gi % EPI_ZD] = *(const f32x4*)(ssq + (size_t)(row0 + ((gi + EPI_ZD) >> 2) * 128 + ((gi + EPI_ZD) & 3) * 16) * 4);
                const float rstd = __builtin_amdgcn_rsqf(((q.x + q.y) + (q.z + q.w)) * (1.0f / 1024.0f) + EPS);
                bf16* rowp = Zp + (size_t)r * ZP + col0;
#pragma unroll
                for (int bj = 0; bj < 2; ++bj) {
                    const f32x4 v0 = (acc[ai][bj][m][0] * rstd + bv[bj][0]) * cs, v1 = (acc[ai][bj][m][1] * rstd + bv[bj][1]) * cs;
                    u32x4 w; w.x = pk2(v0[0], v0[1]); w.y = pk2(v0[2], v0[3]); w.z = pk2(v1[0], v1[1]); w.w = pk2(v1[2], v1[3]);
                    NT_STORE((u32x4*)(rowp + bj * 128), w);
                }
            }
    }
};
#ifndef EPI_XD
#define EPI_XD 4
#endif
struct EpiX {
    static constexpr bool PERM = true, AFTER_DRAIN = true;
    const float* xres; bf16* xout; bf16* Anext; const float* gate; const float* ng; const float* nscale; float* ssq;
    __device__ __forceinline__ void fused(pg8::f32x4 (&acc)[2][2][4][2], const pg8::Unit& u, int wr, int wc, int fr, int fq, LAS unsigned char* lds, int wid, int lane) const {
        const int b = u.pm >> 3, col0 = u.pn * 256 + wc * 32 + 8 * fq;
        LAS float* Pp = (LAS float*)lds;
        f32x4 gv[2][2], gs[2][2];
#pragma unroll
        for (int bj = 0; bj < 2; ++bj)
#pragma unroll
            for (int n = 0; n < 2; ++n) {
                gv[bj][n] = *(const f32x4*)(gate + b * 3072 + col0 + bj * 128 + 4 * n);
                if (Anext) { const f32x4 g = *(const f32x4*)(ng + col0 + bj * 128 + 4 * n), s = *(const f32x4*)(nscale + b * 3072 + col0 + bj * 128 + 4 * n); gs[bj][n] = g * (s + 1.0f); }
                else gs[bj][n] = (f32x4){0.f, 0.f, 0.f, 0.f};
            }
        f32x4 xq[EPI_XD][2][2];
#define EPIX_LOAD(gi) do { const size_t r_ = (size_t)u.pm * 256 + ((gi) >> 2) * 128 + wr * 64 + ((gi) & 3) * 16 + fr; \
        _Pragma("unroll") for (int bj = 0; bj < 2; ++bj) _Pragma("unroll") for (int n = 0; n < 2; ++n) xq[(gi) % EPI_XD][bj][n] = *(const f32x4*)(xres + r_ * DM + col0 + bj * 128 + 4 * n); } while (0)
#pragma unroll
        for (int gi = 0; gi < EPI_XD; ++gi) EPIX_LOAD(gi);
#pragma unroll
        for (int ai = 0; ai < 2; ++ai)
#pragma unroll
            for (int m = 0; m < 4; ++m) {
                const int rl = ai * 128 + wr * 64 + m * 16 + fr; const size_t r = (size_t)u.pm * 256 + rl;
                float s = 0.f;
                f32x4 xc[2][2];
#pragma unroll
                for (int bj = 0; bj < 2; ++bj)
#pragma unroll
                    for (int n = 0; n < 2; ++n) xc[bj][n] = xq[(ai * 4 + m) % EPI_XD][bj][n];
                if (ai * 4 + m + EPI_XD < 8) EPIX_LOAD(ai * 4 + m + EPI_XD);
#pragma unroll
                for (int bj = 0; bj < 2; ++bj) {
                    f32x4 x1[2];
#pragma unroll
                    for (int n = 0; n < 2; ++n) {
                        const f32x4 xr = xc[bj][n];
                        x1[n] = xr + gv[bj][n] * acc[ai][bj][m][n];
                        s += (x1[n][0] * x1[n][0] + x1[n][1] * x1[n][1]) + (x1[n][2] * x1[n][2] + x1[n][3] * x1[n][3]);
                    }
                    { u32x4 xw; xw.x = pk2(x1[0][0], x1[0][1]); xw.y = pk2(x1[0][2], x1[0][3]); xw.z = pk2(x1[1][0], x1[1][1]); xw.w = pk2(x1[1][2], x1[1][3]);
                      NT_STORE((u32x4*)(xout + r * DM + col0 + bj * 128), xw); }
                    if (Anext) { const f32x4 a0 = x1[0] * gs[bj][0], a1 = x1[1] * gs[bj][1];
                        u32x4 w; w.x = pk2(a0[0], a0[1]); w.y = pk2(a0[2], a0[3]); w.z = pk2(a1[0], a1[1]); w.w = pk2(a1[2], a1[3]);
                        NT_STORE((u32x4*)(Anext + r * DM + col0 + bj * 128), w); }
                }
                s += __shfl_xor(s, 16); s += __shfl_xor(s, 32);
                if (fq == 0) Pp[rl * 4 + wc] = s;
            }
        __syncthreads();
        const int tid = wid * 64 + lane;
        if (tid < 256) ssq[((size_t)u.pm * 256 + tid) * 4 + u.pn] = (Pp[tid * 4 + 0] + Pp[tid * 4 + 1]) + (Pp[tid * 4 + 2] + Pp[tid * 4 + 3]);
        __syncthreads();
    }
};

struct EpiXF {
    static constexpr bool PERM = true, AFTER_DRAIN = true;
    const bf16* xres; float* out; const float* gate; const float* fg; float* ssq; unsigned* cnt;
    __device__ __forceinline__ void fused(pg8::f32x4 (&acc)[2][2][4][2], const pg8::Unit& u, int wr, int wc, int fr, int fq, LAS unsigned char* lds, int wid, int lane) const {
        const int b = u.pm >> 3, col0 = u.pn * 256 + wc * 32 + 8 * fq, tid = wid * 64 + lane;
        LAS float* Pp = (LAS float*)lds;
        LAS float* Sr = (LAS float*)(lds + 4096);
        {
            f32x4 gv[2][2];
#pragma unroll
            for (int bj = 0; bj < 2; ++bj)
#pragma unroll
                for (int n = 0; n < 2; ++n) gv[bj][n] = *(const f32x4*)(gate + b * 3072 + col0 + bj * 128 + 4 * n);
#pragma unroll
            for (int ai = 0; ai < 2; ++ai)
#pragma unroll
                for (int m = 0; m < 4; ++m) {
                    const int rl = ai * 128 + wr * 64 + m * 16 + fr; const size_t r = (size_t)u.pm * 256 + rl;
                    float s = 0.f;
#pragma unroll
                    for (int bj = 0; bj < 2; ++bj) {
                        const u32x4 xw = *(const u32x4*)(xres + r * DM + col0 + bj * 128);
#pragma unroll
                        for (int n = 0; n < 2; ++n) {
                            const unsigned w0 = n ? xw.z : xw.x, w1 = n ? xw.w : xw.y;
                            const f32x4 xr = {__uint_as_float(w0 << 16), __uint_as_float(w0 & 0xffff0000u), __uint_as_float(w1 << 16), __uint_as_float(w1 & 0xffff0000u)};
                            const f32x4 x1 = xr + gv[bj][n] * acc[ai][bj][m][n];
                            acc[ai][bj][m][n] = x1;
                            s += (x1[0] * x1[0] + x1[1] * x1[1]) + (x1[2] * x1[2] + x1[3] * x1[3]);
                        }
                    }
                    s += __shfl_xor(s, 16); s += __shfl_xor(s, 32);
                    if (fq == 0) Pp[rl * 4 + wc] = s;
                }
        }
        __syncthreads();
        if (tid < 256) { const float tot = (Pp[tid * 4 + 0] + Pp[tid * 4 + 1]) + (Pp[tid * 4 + 2] + Pp[tid * 4 + 3]);
            __hip_atomic_store(ssq + ((size_t)u.pm * 256 + tid) * 4 + u.pn, tot, __ATOMIC_RELAXED, __HIP_MEMORY_SCOPE_AGENT); }
        asm volatile("s_waitcnt vmcnt(0)" ::: "memory");
        __syncthreads();
        if (tid == 0) {
            unsigned* c = cnt + 64 * u.pm;
            __hip_atomic_fetch_add(c, 1u, __ATOMIC_RELAXED, __HIP_MEMORY_SCOPE_AGENT);
            unsigned spins = 0u;
            while (__hip_atomic_load(c, __ATOMIC_RELAXED, __HIP_MEMORY_SCOPE_AGENT) < 4u) { __builtin_amdgcn_s_sleep(2); if (++spins > (1u << 22)) break; }
            __builtin_amdgcn_fence(__ATOMIC_ACQUIRE, "agent");
            asm volatile("s_waitcnt vmcnt(0)" ::: "memory");
        }
        __syncthreads();
        if (tid < 256) { const float* sp = ssq + ((size_t)u.pm * 256 + tid) * 4;
            const float q0 = __hip_atomic_load(sp + 0, __ATOMIC_RELAXED, __HIP_MEMORY_SCOPE_AGENT), q1 = __hip_atomic_load(sp + 1, __ATOMIC_RELAXED, __HIP_MEMORY_SCOPE_AGENT);
            const float q2 = __hip_atomic_load(sp + 2, __ATOMIC_RELAXED, __HIP_MEMORY_SCOPE_AGENT), q3 = __hip_atomic_load(sp + 3, __ATOMIC_RELAXED, __HIP_MEMORY_SCOPE_AGENT);
            Sr[tid] = 1.0f / sqrtf(((q0 + q1) + (q2 + q3)) * (1.0f / 1024.0f) + EPS); }
        __syncthreads();
        f32x4 fgv[2][2];
#pragma unroll
        for (int bj = 0; bj < 2; ++bj)
#pragma unroll
            for (int n = 0; n < 2; ++n) fgv[bj][n] = *(const f32x4*)(fg + col0 + bj * 128 + 4 * n);
#pragma unroll
        for (int ai = 0; ai < 2; ++ai)
#pragma unroll
            for (int m = 0; m < 4; ++m) {
                const int rl = ai * 128 + wr * 64 + m * 16 + fr; const size_t r = (size_t)u.pm * 256 + rl; const float rstd = Sr[rl];
#pragma unroll
                for (int bj = 0; bj < 2; ++bj)
#pragma unroll
                    for (int n = 0; n < 2; ++n) NT_STORE((f32x4*)(out + r * DM + col0 + bj * 128 + 4 * n), acc[ai][bj][m][n] * rstd * fgv[bj][n]);
            }
        __syncthreads();
    }
};

#ifndef PRO_KC
#define PRO_KC 64
#endif
#ifndef TRQ
#define TRQ 4
#endif
__device__ __forceinline__ void ph0_prologue(const P& p, LAS unsigned char* lds) {
    const int tid = threadIdx.x, lane = tid & 63, wave = tid >> 6, G = gridDim.x, wg = blockIdx.x;
    LAS float* fl = (LAS float*)lds;
    for (int u = wg; u < 96; u += G) {
        const int l = u / 48, j = (u % 48) * 64 + lane;
        { float cv[16];
#pragma unroll
          for (int i = 0; i < 16; ++i) cv[i] = p.c[tid + 512 * i];
#pragma unroll
          for (int i = 0; i < 16; ++i) fl[tid + 512 * i] = siluf(cv[i]); }
        __syncthreads();
        float acc[8];
#pragma unroll
        for (int b = 0; b < 8; ++b) acc[b] = 0.f;
        const float* w = p.ada_w + ((size_t)l * 1024 + wave * 128) * 3072 + j;
#pragma unroll 1
        for (int k0 = 0; k0 < 128; k0 += PRO_KC) { float wv[PRO_KC];
#pragma unroll
          for (int k = 0; k < PRO_KC; ++k) wv[k] = w[(size_t)(k0 + k) * 3072];
#pragma unroll
          for (int k = 0; k < PRO_KC; ++k) {
#pragma unroll
            for (int b = 0; b < 8; ++b) acc[b] += fl[b * 1024 + wave * 128 + k0 + k] * wv[k]; } }
#pragma unroll
        for (int b = 0; b < 8; ++b) fl[8192 + (wave * 8 + b) * 64 + lane] = acc[b];
        __syncthreads();
        { const int b = wave; float s = p.ada_b[l * 3072 + j];
#pragma unroll
          for (int w8 = 0; w8 < 8; ++w8) s += fl[8192 + (w8 * 8 + b) * 64 + lane];
          p.mod[(l * 8 + b) * 3072 + j] = s; }
        __syncthreads();
    }
    const int GT = (G > 96) ? G - 96 : G, wt = (G > 96) ? wg - 96 : wg;
    if (wt >= 0)
#pragma unroll 1
    for (int u0 = wt; u0 < 1920; u0 += TRQ * GT) {
        float v[TRQ][8]; bf16* dst[TRQ]; bool act[TRQ];
#pragma unroll
        for (int q = 0; q < TRQ; ++q) {
            const int u = u0 + q * GT; act[q] = u < 1920; dst[q] = nullptr;
#pragma unroll
            for (int j = 0; j < 8; ++j) v[q][j] = 0.f;
            if (act[q]) {
                const float* W; bf16* WT; int N, kt, nt;
                if (u < 1408) { const int l = u / 704, r = u % 704; kt = r / 44; nt = r % 44; W = p.w_in + (size_t)l * 1024 * D_INR; N = D_INR; WT = p.wt_in + (size_t)l * ZP * 1024; }
                else { int r = u - 1408; const int l = r / 256; r %= 256; kt = r / 16; nt = r % 16; W = p.w_out + (size_t)l * 1024 * 1024; N = 1024; WT = p.wt_out + (size_t)l * 1024 * 1024; }
                const int n = nt * 64 + lane, k0 = kt * 64 + wave * 8;
                if (n < N) {
#pragma unroll
                    for (int j = 0; j < 8; ++j) v[q][j] = W[(size_t)(k0 + j) * N + n];
                }
                dst[q] = WT + (size_t)n * 1024 + k0;
            }
        }
#pragma unroll
        for (int q = 0; q < TRQ; ++q) if (act[q]) { u32x4 o; o.x = pk2(v[q][0], v[q][1]); o.y = pk2(v[q][2], v[q][3]); o.z = pk2(v[q][4], v[q][5]); o.w = pk2(v[q][6], v[q][7]); *(u32x4*)dst[q] = o; }
    }
}
__device__ __forceinline__ void ph1_prologue(const P& p, LAS unsigned char* lds) {
    const int tid = threadIdx.x, lane = tid & 63, wave = tid >> 6, G = gridDim.x, wg = blockIdx.x;
    LAS float* fl = (LAS float*)lds;
    for (int u = wg; u < 88; u += G) {
        const int l = u / 44, n = (u % 44) * 64 + lane;
        { float mv[16];
#pragma unroll
          for (int i = 0; i < 16; ++i) { const int e = tid + 512 * i; mv[i] = p.mod[(l * 8 + (e >> 10)) * 3072 + (e & 1023)]; }
#pragma unroll
          for (int i = 0; i < 16; ++i) fl[tid + 512 * i] = mv[i]; }
        __syncthreads();
        float acc[8];
#pragma unroll
        for (int b = 0; b < 8; ++b) acc[b] = 0.f;
        if (n < D_INR) { const float* w = p.w_in + ((size_t)l * 1024 + wave * 128) * D_INR + n;
#pragma unroll 1
            for (int k0 = 0; k0 < 128; k0 += PRO_KC) { float wv[PRO_KC];
#pragma unroll
              for (int k = 0; k < PRO_KC; ++k) wv[k] = w[(size_t)(k0 + k) * D_INR];
#pragma unroll
              for (int k = 0; k < PRO_KC; ++k) {
#pragma unroll
                for (int b = 0; b < 8; ++b) acc[b] += fl[b * 1024 + wave * 128 + k0 + k] * wv[k]; } } }
#pragma unroll
        for (int b = 0; b < 8; ++b) fl[8192 + (wave * 8 + b) * 64 + lane] = acc[b];
        __syncthreads();
        { const int b = wave; float s = 0.f;
#pragma unroll
          for (int w8 = 0; w8 < 8; ++w8) s += fl[8192 + (w8 * 8 + b) * 64 + lane];
          p.bias[(l * 8 + b) * ZP + n] = s; }
        __syncthreads();
    }
    {
        const int r0 = wg * 8 + wave, rstep = G * 8;
        f32x4 gq[4], xv[2][2][4], sv[2][2][4];
#pragma unroll
        for (int j = 0; j < 4; ++j) gq[j] = *(const f32x4*)(p.norm_g + (lane + 64 * j) * 4);
#define A0_LOAD(slot, pr) do { _Pragma("unroll") for (int h_ = 0; h_ < 2; ++h_) _Pragma("unroll") for (int j = 0; j < 4; ++j) { const int k_ = (lane + 64 * j) * 4, r_ = r0 + rstep * (2 * (pr) + h_); \
            xv[slot][h_][j] = *(const f32x4*)(p.x + (size_t)r_ * DM + k_); sv[slot][h_][j] = *(const f32x4*)(p.mod + (size_t)(r_ >> 11) * 3072 + 1024 + k_); } } while (0)
        A0_LOAD(0, 0);
#pragma unroll
        for (int pr = 0; pr < 4; ++pr) {
            if (pr + 1 < 4) A0_LOAD((pr + 1) & 1, pr + 1);
#pragma unroll
            for (int h = 0; h < 2; ++h) {
                const int r = r0 + rstep * (2 * pr + h); float s1 = 0.f;
#pragma unroll
                for (int j = 0; j < 4; ++j) { const int k = (lane + 64 * j) * 4; const f32x4 v = xv[pr & 1][h][j];
                    s1 += (v[0] * v[0] + v[1] * v[1]) + (v[2] * v[2] + v[3] * v[3]);
                    const f32x4 o1 = v * gq[j] * (sv[pr & 1][h][j] + 1.0f);
                    u32x2 w1; w1.x = pk2(o1[0], o1[1]); w1.y = pk2(o1[2], o1[3]);
                    *(u32x2*)(p.A + (size_t)r * DM + k) = w1; }
                s1 = wave_sum(s1);
                if (lane == 0) *(f32x4*)(p.ssq + (size_t)r * 4) = (f32x4){s1, 0.f, 0.f, 0.f};
            }
        }
#undef A0_LOAD
    }
}
__device__ __forceinline__ void ph_final(const P& p) {
    const int tid = threadIdx.x, lane = tid & 63, wave = tid >> 6, G = gridDim.x, wg = blockIdx.x;
    for (int r = wg * 8 + wave; r < MROWS; r += G * 8) {
        const f32x4 q = *(const f32x4*)(p.ssq + (size_t)r * 4);
        const float rstd = 1.0f / sqrtf(((q.x + q.y) + (q.z + q.w)) * (1.0f / 1024.0f) + EPS);
#pragma unroll
        for (int j = 0; j < 4; ++j) { const int k = (lane + 64 * j) * 4;
            const f32x4 v = *(const f32x4*)(p.out + (size_t)r * DM + k), g = *(const f32x4*)(p.final_g + k);
            *(f32x4*)(p.out + (size_t)r * DM + k) = v * rstd * g; }
    }
}
#define XB_TMO      128
#define XB_XCNT(j)  (256  + 64 * (j))
#define XB_XSUB(j)  (1280 + 64 * (j))
#define XB_XGEN(j)  (2304 + 64 * (j))
#define XB_TOP      3328
#define XB_TOPGEN   3392
#define XCD_BAR_WORDS 3456
#define XB_SPIN_CAP (1u << 18)

__device__ __forceinline__ unsigned xb_ld(unsigned* p)              { return __hip_atomic_load(p, __ATOMIC_RELAXED, __HIP_MEMORY_SCOPE_AGENT); }
__device__ __forceinline__ unsigned xb_add(unsigned* p, unsigned v) { return __hip_atomic_fetch_add(p, v, __ATOMIC_RELAXED, __HIP_MEMORY_SCOPE_AGENT); }
__device__ __forceinline__ unsigned xb_xcc_id() { return (unsigned)__builtin_amdgcn_s_getreg((3 << 11) | 20) & 0xFu; }
#define XB_SPIN(cond, bar) do { unsigned _sp = 0; while (cond) { __builtin_amdgcn_s_sleep(1); \
    if ((++_sp & 255u) == 0u) { if (xb_ld(&(bar)[XB_TMO])) break; if (_sp > XB_SPIN_CAP) { atomicAdd(&(bar)[XB_TMO], 1u); break; } } } } while (0)

struct XcdBarrier {
    unsigned* bar; unsigned x;
    volatile LAS unsigned* st;
};

__device__ __forceinline__ XcdBarrier xcd_barrier_post(unsigned* bar, volatile LAS unsigned* st) {
    XcdBarrier b; b.bar = bar; b.x = xb_xcc_id(); b.st = st;
    if (threadIdx.x == 0) (void)xb_add(&bar[XB_XCNT(b.x)], 1u);
    return b;
}
__device__ __forceinline__ void xcd_barrier_complete(unsigned* bar, unsigned x, unsigned& nloc, unsigned& nx) {
    const unsigned G = gridDim.x * gridDim.y * gridDim.z;
    unsigned sum, cnt, mine, sp = 0u;
    for (;;) {
        sum = 0u; cnt = 0u; mine = 0u;
#pragma unroll
        for (unsigned j = 0; j < 16; ++j) { const unsigned c = xb_ld(&bar[XB_XCNT(j)]); sum += c; cnt += (c > 0u) ? 1u : 0u; mine = (j == x) ? c : mine; }
        if (sum == G) break;
        __builtin_amdgcn_s_sleep(1);
        if ((++sp & 255u) == 0u) { if (xb_ld(&bar[XB_TMO])) break; if (sp > XB_SPIN_CAP) { atomicAdd(&bar[XB_TMO], 1u); break; } }
    }
    nloc = mine > 0u ? mine : 1u; nx = cnt > 0u ? cnt : 1u;
}

__device__ __forceinline__ void xcd_barrier(const XcdBarrier& b) {
    asm volatile("s_waitcnt vmcnt(0)" ::: "memory");
    __syncthreads();
    if (threadIdx.x == 0) {
        unsigned* bar = b.bar;
        __builtin_amdgcn_s_waitcnt(0);
        unsigned nloc = b.st[0], nx = b.st[1];
        if (nloc == 0u) { xcd_barrier_complete(bar, b.x, nloc, nx); b.st[0] = nloc; b.st[1] = nx; }
        const unsigned old = xb_add(&bar[XB_XSUB(b.x)], 1u);
        const unsigned gen = old / nloc;
        if (old + 1u == (gen + 1u) * nloc) {
            __builtin_amdgcn_fence(__ATOMIC_RELEASE, "agent");
            asm volatile("s_waitcnt vmcnt(0)" ::: "memory");
            const unsigned og = xb_add(&bar[XB_TOP], 1u);
            const unsigned tg = og / nx;
            if (og + 1u == (tg + 1u) * nx) xb_add(&bar[XB_TOPGEN], 1u);
            else XB_SPIN(xb_ld(&bar[XB_TOPGEN]) == tg, bar);
            __builtin_amdgcn_fence(__ATOMIC_ACQUIRE, "agent");
            xb_add(&bar[XB_XGEN(b.x)], 1u);
            asm volatile("s_waitcnt vmcnt(0)" ::: "memory");
        } else {
#ifdef XB_FLAT_RELEASE
            XB_SPIN(xb_ld(&bar[XB_TOPGEN]) == gen, bar);
#else
            XB_SPIN(xb_ld(&bar[XB_XGEN(b.x)]) == gen, bar);
#endif
            __builtin_amdgcn_fence(__ATOMIC_ACQUIRE, "agent");
            asm volatile("s_waitcnt vmcnt(0)" ::: "memory");
        }
    }
    __syncthreads();
}
__device__ __forceinline__ unsigned score_ukey(float s) { const unsigned u = __float_as_uint(s + 0.0f); return (u & 0x80000000u) ? ~u : (u | 0x80000000u); }
__device__ __forceinline__ void topk_threshold(const unsigned (&k)[32], unsigned& thr, unsigned& need) {
    unsigned prefix = 0u; bool exact = false;
    for (int bit = 31; bit >= 0; --bit) {
        const unsigned cand = prefix | (1u << bit);
        int c = 0;
#pragma unroll
        for (int i = 0; i < 32; ++i) c += (k[i] >= cand) ? 1 : 0;
        c = wave_sum_i(c);
        if (c >= TOPK) prefix = cand;
        if (c == TOPK) { exact = true; break; }
    }
    thr = prefix;
    if (exact) { need = 0xffffffffu; }
    else { int c = 0;
#pragma unroll
        for (int i = 0; i < 32; ++i) c += (k[i] > prefix) ? 1 : 0;
        c = wave_sum_i(c); need = (unsigned)(TOPK - c); }
}
#ifndef PROBE_VALU
#define PROBE_VALU 0
#endif
#ifndef RP_T3
#define RP_T3 1
#endif
#ifndef RP_T1
#define RP_T1 1
#endif
#ifndef RP_T2
#define RP_T2 1
#endif
#ifndef RP_I
#define RP_I 1
#endif
#ifndef RP_T
#define RP_T 1
#endif
#ifndef RP_V
#define RP_V 1
#endif
typedef short bf16x8v __attribute__((ext_vector_type(8)));
typedef short s16x4v __attribute__((ext_vector_type(4)));
constexpr int BMS = 65;
constexpr int SCP = 2052;
constexpr int DSA_BM_OFF = 16 * SCP * 4;
constexpr int DSA_RING_OFF = 0;
constexpr int DSA_QIB_OFF = 147456;
constexpr int DSA_WIB_OFF = 135680;
constexpr int DSA_MLUT_OFF = 143616;
__device__ __forceinline__ void glds16(const void* gsrc, unsigned lds_dst) { unsigned keep;
    asm volatile("s_mov_b32 %0, m0\n\ts_mov_b32 m0, %2\n\ts_nop 0\n\tglobal_load_lds_dwordx4 %1, off\n\ts_mov_b32 m0, %0" : "=&s"(keep) : "v"(gsrc), "s"(lds_dst) : "memory"); }
template <int I> __device__ __forceinline__ unsigned mbit_t(int mw) { unsigned r; asm("v_bfe_i32 %0, %1, %2, 1" : "=v"(r) : "v"(mw), "i"(I)); return r; }
#define mbit(mw, i) mbit_t<(i)>(mw)
__device__ __forceinline__ float relu_i(float x) { return __int_as_float(max(__float_as_int(x), 0)); }
#ifndef NO_FMAC_S
__device__ __forceinline__ float fmac_s(float a, float b, float c) { asm("v_fmac_f32_e32 %0, %1, %2" : "+v"(c) : "v"(a), "v"(b)); return c; }
#else
__device__ __forceinline__ float fmac_s(float a, float b, float c) { return a * b + c; }
#endif
__device__ __forceinline__ int imax3(float a, float b, float c) { return max(max(__float_as_int(a), __float_as_int(b)), __float_as_int(c)); }
__device__ __forceinline__ s16x4v lds_tr16(LAS const unsigned char* p) { return __builtin_bit_cast(s16x4v, __builtin_amdgcn_ds_read_tr16_b64_v4i16((LAS s16x4v*)p)); }
__device__ __forceinline__ unsigned cvtpk(float lo, float hi) { typedef float f2 __attribute__((ext_vector_type(2))); typedef __bf16 b2 __attribute__((ext_vector_type(2))); f2 v = {lo, hi}; b2 r = __builtin_convertvector(v, b2); return __builtin_bit_cast(unsigned, r); }


template <int L> __device__ __forceinline__ void wr2lanes(int& w, unsigned lo, unsigned hi) {
    asm volatile("s_nop 1\n\tv_writelane_b32 %0, %1, %3\n\tv_writelane_b32 %0, %2, %4" : "+v"(w) : "s"(lo), "s"(hi), "i"(L), "i"(L + 1));
}
__device__ __forceinline__ int wave_sum_dpp(int v) {
    v += __builtin_amdgcn_update_dpp(0, v, 0xB1, 0xf, 0xf, true);
    v += __builtin_amdgcn_update_dpp(0, v, 0x4E, 0xf, 0xf, true);
    v += __builtin_amdgcn_update_dpp(0, v, 0x141, 0xf, 0xf, true);
    v += __builtin_amdgcn_update_dpp(0, v, 0x140, 0xf, 0xf, true);
    return __builtin_amdgcn_readlane(v, 0) + __builtin_amdgcn_readlane(v, 16) + __builtin_amdgcn_readlane(v, 32) + __builtin_amdgcn_readlane(v, 48);
}
__device__ __forceinline__ unsigned wave_max_dpp(unsigned v) {
    v = max(v, (unsigned)__builtin_amdgcn_update_dpp(0, (int)v, 0xB1, 0xf, 0xf, true));
    v = max(v, (unsigned)__builtin_amdgcn_update_dpp(0, (int)v, 0x4E, 0xf, 0xf, true));
    v = max(v, (unsigned)__builtin_amdgcn_update_dpp(0, (int)v, 0x141, 0xf, 0xf, true));
    v = max(v, (unsigned)__builtin_amdgcn_update_dpp(0, (int)v, 0x140, 0xf, 0xf, true));
    return max(max((unsigned)__builtin_amdgcn_readlane((int)v, 0), (unsigned)__builtin_amdgcn_readlane((int)v, 16)), max((unsigned)__builtin_amdgcn_readlane((int)v, 32), (unsigned)__builtin_amdgcn_readlane((int)v, 48)));
}
__device__ __forceinline__ void cnt8(int& a0, int& a1, int& a2, int& a3, unsigned cand, unsigned k0, unsigned k1, unsigned k2, unsigned k3, unsigned k4, unsigned k5, unsigned k6, unsigned k7) {
    unsigned long long m0, m1, m2, m3, m4, m5, m6, m7;
    asm volatile("v_cmp_le_u32_e64 %4, %12, %13\n\tv_cmp_le_u32_e64 %5, %12, %14\n\tv_cmp_le_u32_e64 %6, %12, %15\n\tv_cmp_le_u32_e64 %7, %12, %16\n\t"
                 "v_cmp_le_u32_e64 %8, %12, %17\n\tv_cmp_le_u32_e64 %9, %12, %18\n\tv_cmp_le_u32_e64 %10, %12, %19\n\tv_cmp_le_u32_e64 %11, %12, %20\n\t"
                 "v_addc_co_u32_e64 %0, %4, 0, %0, %4\n\tv_addc_co_u32_e64 %1, %5, 0, %1, %5\n\tv_addc_co_u32_e64 %2, %6, 0, %2, %6\n\tv_addc_co_u32_e64 %3, %7, 0, %3, %7\n\t"
                 "v_addc_co_u32_e64 %0, %8, 0, %0, %8\n\tv_addc_co_u32_e64 %1, %9, 0, %1, %9\n\tv_addc_co_u32_e64 %2, %10, 0, %2, %10\n\tv_addc_co_u32_e64 %3, %11, 0, %3, %11"
                 : "+v"(a0), "+v"(a1), "+v"(a2), "+v"(a3), "=&s"(m0), "=&s"(m1), "=&s"(m2), "=&s"(m3), "=&s"(m4), "=&s"(m5), "=&s"(m6), "=&s"(m7)
                 : "s"(cand), "v"(k0), "v"(k1), "v"(k2), "v"(k3), "v"(k4), "v"(k5), "v"(k6), "v"(k7));
}
__device__ __forceinline__ int count_ge(const unsigned (&k)[32], unsigned cand_, int nb) {
    const unsigned cand = (unsigned)__builtin_amdgcn_readfirstlane((int)cand_);
    int a0 = 0, a1 = 0, a2 = 0, a3 = 0;
    cnt8(a0, a1, a2, a3, cand, k[0], k[1], k[2], k[3], k[4], k[5], k[6], k[7]);
    if (nb > 1) cnt8(a0, a1, a2, a3, cand, k[8], k[9], k[10], k[11], k[12], k[13], k[14], k[15]);
    if (nb > 2) cnt8(a0, a1, a2, a3, cand, k[16], k[17], k[18], k[19], k[20], k[21], k[22], k[23]);
    if (nb > 3) cnt8(a0, a1, a2, a3, cand, k[24], k[25], k[26], k[27], k[28], k[29], k[30], k[31]);
    return wave_sum_dpp((a0 + a1) + (a2 + a3));
}
__device__ __forceinline__ int wave_scan_dpp(int v) {
    v += __builtin_amdgcn_update_dpp(0, v, 0x111, 0xf, 0xf, false);
    v += __builtin_amdgcn_update_dpp(0, v, 0x112, 0xf, 0xf, false);
    v += __builtin_amdgcn_update_dpp(0, v, 0x114, 0xf, 0xf, false);
    v += __builtin_amdgcn_update_dpp(0, v, 0x118, 0xf, 0xf, false);
    v += __builtin_amdgcn_update_dpp(0, v, 0x142, 0xa, 0xf, false);
    v += __builtin_amdgcn_update_dpp(0, v, 0x143, 0xc, 0xf, false);
    return v;
}
#ifndef WALK_MAX
#define WALK_MAX 4
#endif
#ifndef HIST_WAVES
#define HIST_WAVES 4
#endif
struct TopkState { unsigned prefix; int bit; bool done; unsigned need; int nb; LAS unsigned* hist; int crej; };
__device__ __forceinline__ void topk_hist(const unsigned (&k)[32], TopkState& st, int c_above) {
    const int lane = threadIdx.x & 63;
    const unsigned T = (unsigned)__builtin_amdgcn_readfirstlane((int)st.prefix);
    LAS unsigned* hist = st.hist;
    *(LAS u32x4*)(hist + 4 * lane) = (u32x4){0u, 0u, 0u, 0u};
    asm volatile("" ::: "memory");
    const unsigned hb_ = (unsigned)(uintptr_t)hist; const unsigned one = 1u;
#define HF8(i0) { unsigned t0_; unsigned long long ex_; \
        asm volatile("s_mov_b64 %1, exec\n\t" \
            "v_subrev_u32_e32 %0, %2, %5\n\tv_lshrrev_b32_e32 %0, 15, %0\n\tv_cmpx_gt_u32_e32 vcc, 0x100, %0\n\tv_lshl_add_u32 %0, %0, 2, %3\n\tds_add_u32 %0, %4\n\ts_mov_b64 exec, %1\n\t" \
            "v_subrev_u32_e32 %0, %2, %6\n\tv_lshrrev_b32_e32 %0, 15, %0\n\tv_cmpx_gt_u32_e32 vcc, 0x100, %0\n\tv_lshl_add_u32 %0, %0, 2, %3\n\tds_add_u32 %0, %4\n\ts_mov_b64 exec, %1\n\t" \
            "v_subrev_u32_e32 %0, %2, %7\n\tv_lshrrev_b32_e32 %0, 15, %0\n\tv_cmpx_gt_u32_e32 vcc, 0x100, %0\n\tv_lshl_add_u32 %0, %0, 2, %3\n\tds_add_u32 %0, %4\n\ts_mov_b64 exec, %1\n\t" \
            "v_subrev_u32_e32 %0, %2, %8\n\tv_lshrrev_b32_e32 %0, 15, %0\n\tv_cmpx_gt_u32_e32 vcc, 0x100, %0\n\tv_lshl_add_u32 %0, %0, 2, %3\n\tds_add_u32 %0, %4\n\ts_mov_b64 exec, %1\n\t" \
            "v_subrev_u32_e32 %0, %2, %9\n\tv_lshrrev_b32_e32 %0, 15, %0\n\tv_cmpx_gt_u32_e32 vcc, 0x100, %0\n\tv_lshl_add_u32 %0, %0, 2, %3\n\tds_add_u32 %0, %4\n\ts_mov_b64 exec, %1\n\t" \
            "v_subrev_u32_e32 %0, %2, %10\n\tv_lshrrev_b32_e32 %0, 15, %0\n\tv_cmpx_gt_u32_e32 vcc, 0x100, %0\n\tv_lshl_add_u32 %0, %0, 2, %3\n\tds_add_u32 %0, %4\n\ts_mov_b64 exec, %1\n\t" \
            "v_subrev_u32_e32 %0, %2, %11\n\tv_lshrrev_b32_e32 %0, 15, %0\n\tv_cmpx_gt_u32_e32 vcc, 0x100, %0\n\tv_lshl_add_u32 %0, %0, 2, %3\n\tds_add_u32 %0, %4\n\ts_mov_b64 exec, %1\n\t" \
            "v_subrev_u32_e32 %0, %2, %12\n\tv_lshrrev_b32_e32 %0, 15, %0\n\tv_cmpx_gt_u32_e32 vcc, 0x100, %0\n\tv_lshl_add_u32 %0, %0, 2, %3\n\tds_add_u32 %0, %4\n\ts_mov_b64 exec, %1" \
            : "=&v"(t0_), "=&s"(ex_) : "s"(T), "s"(hb_), "v"(one), "v"(k[i0]), "v"(k[i0 + 1]), "v"(k[i0 + 2]), "v"(k[i0 + 3]), "v"(k[i0 + 4]), "v"(k[i0 + 5]), "v"(k[i0 + 6]), "v"(k[i0 + 7]) : "vcc", "memory"); }
    HF8(0)
    if (st.nb > 1) HF8(8)
    if (st.nb > 2) HF8(16)
    if (st.nb > 3) HF8(24)
#undef HF8
    asm volatile("" ::: "memory");
    const u32x4 w = *(LAS const u32x4*)(hist + 4 * (63 - lane));
    const int t = (int)((w.x + w.y) + (w.z + w.w));
    const int P = wave_scan_dpp(t);
    const int k1 = TOPK - c_above;
    const unsigned long long bal = __ballot(P >= k1);
    const int Ls = __builtin_ctzll(bal);
    int c = __builtin_amdgcn_readlane(P, Ls) - __builtin_amdgcn_readlane(t, Ls);
    const int h3 = __builtin_amdgcn_readlane((int)w.w, Ls), h2 = __builtin_amdgcn_readlane((int)w.z, Ls), h1 = __builtin_amdgcn_readlane((int)w.y, Ls), h0 = __builtin_amdgcn_readlane((int)w.x, Ls);
    int bsel = 3, hb = h3;
    if (c + h3 < k1) { c += h3; bsel = 2; hb = h2; if (c + h2 < k1) { c += h2; bsel = 1; hb = h1; if (c + h1 < k1) { c += h1; bsel = 0; hb = h0; } } }
    const unsigned bin = (unsigned)(4 * (63 - Ls) + bsel);
    st.prefix = T | (bin << 15); st.bit = 14;
    if (c + hb == k1) { st.done = true; st.need = 0xffffffffu; }
}
__device__ __forceinline__ bool topk_histE(const unsigned (&k)[32], TopkState& st, unsigned Etop_, int k1, int cbase) {
    const int lane = threadIdx.x & 63;
    const unsigned Etop = (unsigned)__builtin_amdgcn_readfirstlane((int)Etop_);
    LAS unsigned* hist = st.hist;
    *(LAS u32x4*)(hist + 8 * lane) = (u32x4){0u, 0u, 0u, 0u}; *(LAS u32x4*)(hist + 8 * lane + 4) = (u32x4){0u, 0u, 0u, 0u};
    asm volatile("" ::: "memory");
    const unsigned hb_ = (unsigned)(uintptr_t)hist, one = 1u, l7 = (unsigned)lane & 7u;
#define HE1(K) "v_lshrrev_b32_e32 %0, 23, " K "\n\tv_sub_u32_e32 %0, %2, %0\n\tv_cmpx_gt_u32_e32 vcc, 64, %0\n\tv_lshl_or_b32 %0, %0, 3, %5\n\tv_lshl_add_u32 %0, %0, 2, %3\n\tds_add_u32 %0, %4\n\ts_mov_b64 exec, %1\n\t"
#define HE8(i0) { unsigned t0_; unsigned long long ex_; \
        asm volatile("s_mov_b64 %1, exec\n\t" HE1("%6") HE1("%7") HE1("%8") HE1("%9") HE1("%10") HE1("%11") HE1("%12") HE1("%13") "s_nop 0" \
            : "=&v"(t0_), "=&s"(ex_) : "s"(Etop), "s"(hb_), "v"(one), "v"(l7), "v"(k[i0]), "v"(k[i0 + 1]), "v"(k[i0 + 2]), "v"(k[i0 + 3]), "v"(k[i0 + 4]), "v"(k[i0 + 5]), "v"(k[i0 + 6]), "v"(k[i0 + 7]) : "vcc", "memory"); }
    HE8(0)
    if (st.nb > 1) HE8(8)
    if (st.nb > 2) HE8(16)
    if (st.nb > 3) HE8(24)
#undef HE8
#undef HE1
    asm volatile("" ::: "memory");
    const u32x4 w0 = *(LAS const u32x4*)(hist + 8 * lane), w1 = *(LAS const u32x4*)(hist + 8 * lane + 4);
    const int t = (int)(((w0.x + w0.y) + (w0.z + w0.w)) + ((w1.x + w1.y) + (w1.z + w1.w)));
    const int P = wave_scan_dpp(t);
    const unsigned long long bal = __ballot(P >= k1);
    if (bal == 0ull) return false;
    const int Ls = __builtin_ctzll(bal);
    const int S = __builtin_amdgcn_readlane(P, Ls), cab = S - __builtin_amdgcn_readlane(t, Ls);
    st.prefix = (Etop - (unsigned)Ls) << 23; st.bit = 22; st.crej = cbase + cab;
    if (S == k1) { st.done = true; st.need = 0xffffffffu; }
    return true;
}
__device__ __forceinline__ void topk_init(const unsigned (&k)[32], TopkState& st) {
    unsigned mx = 0u;
#pragma unroll
    for (int i = 0; i < 32; ++i) mx = max(mx, k[i]);
    mx = wave_max_dpp(mx);
    st.prefix = 0u; st.bit = 31; st.done = false; st.need = 0u; st.crej = 0;
    const unsigned E = mx >> 23;
    bool ok = false;
    if (E >= 320u) ok = topk_histE(k, st, E, TOPK, 0);
    if (!ok) {
        const int npos = (E >= 256u) ? count_ge(k, 0x80000000u, st.nb) : 0;
        if (npos < TOPK) {
            unsigned mn = 0u;
#pragma unroll
            for (int i = 0; i < 32; ++i) mn = max(mn, k[i] & ~(unsigned)((int)k[i] >> 31));
            mn = wave_max_dpp(mn);
            const unsigned En = mn >> 23;
            if (En >= 64u) ok = topk_histE(k, st, En, TOPK - npos, npos);
        }
    }
    if (ok && !st.done) topk_hist(k, st, st.crej);
}
__device__ __forceinline__ void topk_step(const unsigned (&k)[32], TopkState& st) {
    if (st.done) return;
    if (st.bit < 0) { int c = 0;
#pragma unroll
        for (int i = 0; i < 32; ++i) c += (k[i] > st.prefix) ? 1 : 0;
        c = wave_sum_dpp(c); st.need = (unsigned)(TOPK - c); st.done = true; return; }
    const unsigned cand = st.prefix | (1u << st.bit);
    const int c = count_ge(k, cand, st.nb);
    if (c >= TOPK) st.prefix = cand; else st.crej = c;
    if (c == TOPK) { st.done = true; st.need = 0xffffffffu; }
    --st.bit;
#ifndef NO_TOPK_HIST
    if (st.bit == 22 && !st.done && st.hist) topk_hist(k, st, st.crej);
#endif
}

__device__ __forceinline__ void dsa_prefetch_qi(const bf16* zb, int qt, LAS unsigned char* lds, int wave, int lane) {
    const unsigned lds_base = (unsigned)(uintptr_t)lds;
#pragma unroll
    for (int i = 0; i < 2; ++i) { const int row = 2 * wave + i;
        glds16(zb + (size_t)(qt * 16 + row) * ZP + C_QI + ((lane ^ row) * 8), (unsigned)__builtin_amdgcn_readfirstlane(lds_base + DSA_QIB_OFF + row * 1024)); }
    if (wave == 0) glds16(zb + (size_t)(qt * 16 + (lane & 15)) * ZP + C_WI, (unsigned)__builtin_amdgcn_readfirstlane(lds_base + DSA_WIB_OFF));
}

__device__ __forceinline__ void dsa_prefetch_ki(const bf16* zb, int qt, bf16x8v (&pk)[4], int wave, int lane) {
    const int r16 = lane & 15, g = lane >> 4;
    if (wave <= qt) { const bf16* krow = zb + (size_t)(wave * 16 + r16) * ZP + C_KI; pk[0] = *(const bf16x8v*)(krow + 8 * g); pk[1] = *(const bf16x8v*)(krow + 32 + 8 * g); }
    if (wave + 8 <= qt) { const bf16* krow = zb + (size_t)((wave + 8) * 16 + r16) * ZP + C_KI; pk[2] = *(const bf16x8v*)(krow + 8 * g); pk[3] = *(const bf16x8v*)(krow + 32 + 8 * g); }
}

__device__ __forceinline__ void dsa_unit(const P& p, int b, int qt, int qt_next, bf16x8v (&pk)[4], LAS unsigned char* lds) {
    const int tid = threadIdx.x, lane = tid & 63, wave = __builtin_amdgcn_readfirstlane(tid >> 6), r16 = lane & 15, g = lane >> 4;
    const int q0 = qt * 16; const bf16* zb = p.Z + (size_t)b * SEQ * ZP;
    LAS float* SC = (LAS float*)lds; LAS unsigned* BM = (LAS unsigned*)(lds + DSA_BM_OFF);
    const bool dense_all = (qt < TOPK / 16);
    const bf16* qrow = zb + (size_t)(q0 + r16) * ZP;
    const bf16x8v bq0 = *(const bf16x8v*)(qrow + C_Q + wave * 64 + 8 * g), bq1 = *(const bf16x8v*)(qrow + C_Q + wave * 64 + 32 + 8 * g);
    u32x2 gwv[4];
#pragma unroll
    for (int dt = 0; dt < 4; ++dt) gwv[dt] = *(const u32x2*)(qrow + C_GA + wave * 64 + dt * 16 + 4 * g);
    const int nsteps = (((q0 + 16 + 31) >> 5) + 1) & ~1, nmega = (nsteps + 7) >> 3;
    const int kkey = lane >> 3, vkey = lane >> 1, vhalf = lane & 1;
    const unsigned lds_base = (unsigned)(uintptr_t)lds;
#define DSA_STAGE(mm) do { const int st_ = (mm) * 8 + wave; if (st_ < nsteps) { \
        const bf16* kb_ = zb + (size_t)st_ * 32 * ZP; const unsigned ldsb_ = lds_base + (unsigned)(((mm) & 1) * 65536 + wave * 4096); \
        _Pragma("unroll") for (int c_ = 0; c_ < 4; ++c_) { const int key_ = 8 * c_ + kkey, ch_ = (lane & 7) ^ ((key_ & 15) >> 1); \
            glds16(kb_ + (size_t)key_ * ZP + C_K + ch_ * 8, (unsigned)__builtin_amdgcn_readfirstlane(ldsb_ + c_ * 1024)); } \
        _Pragma("unroll") for (int c_ = 0; c_ < 4; ++c_) \
            glds16(kb_ + (size_t)vkey * ZP + C_V + c_ * 16 + vhalf * 8, (unsigned)__builtin_amdgcn_readfirstlane(ldsb_ + 32768 + c_ * 1024)); } } while (0)
    if (!dense_all) {
        for (int rpI = 0; rpI < RP_I; ++rpI) {
        bf16x8v bq[8][2]; float wv[8];
#pragma unroll
        for (int h = 0; h < 8; ++h) { bq[h][0] = *(LAS const bf16x8v*)(lds + DSA_QIB_OFF + r16 * 1024 + (((8 * h + g) ^ r16) * 16)); bq[h][1] = *(LAS const bf16x8v*)(lds + DSA_QIB_OFF + r16 * 1024 + (((8 * h + 4 + g) ^ r16) * 16));
            wv[h] = bf2f(*(LAS const bf16*)(lds + DSA_WIB_OFF + r16 * 16 + h * 2)) * 0.35355339059327373f * 0.125f; }
        bf16x8v ra0 = pk[0], ra1 = pk[1], rb0 = pk[2], rb1 = pk[3], rc0 = pk[0], rc1 = pk[1];
#define IDX_LOAD(d0, d1, ktl) do { const int ktl_ = (ktl) <= qt ? (ktl) : qt;        \
            const bf16* krow_ = zb + (size_t)(ktl_ * 16 + r16) * ZP + C_KI; d0 = *(const bf16x8v*)(krow_ + 8 * g); d1 = *(const bf16x8v*)(krow_ + 32 + 8 * g); } while (0)
#define IDX_STEP(c0, c1) do { \
            f32x4 sc = {0.f, 0.f, 0.f, 0.f}; \
            _Pragma("unroll") for (int h = 0; h < 8; ++h) { \
                f32x4 acc = {0.f, 0.f, 0.f, 0.f}; \
                acc = __builtin_amdgcn_mfma_f32_16x16x32_bf16(c0, bq[h][0], acc, 0, 0, 0); \
                acc = __builtin_amdgcn_mfma_f32_16x16x32_bf16(c1, bq[h][1], acc, 0, 0, 0); \
                _Pragma("unroll") for (int i = 0; i < 4; ++i) sc[i] = fmac_s(relu_i(acc[i]), wv[h], sc[i]); \
            } \
            if (__builtin_amdgcn_readfirstlane(kt) == qt) {                  \
                _Pragma("unroll") for (int i = 0; i < 4; ++i) sc[i] = (4 * g + i > r16) ? -INFINITY : sc[i]; \
            } \
            *(LAS f32x4*)(SC + r16 * SCP + kt * 16 + 4 * g) = sc; } while (0)
        int kt = wave;
        const int nst = (qt - wave + 8) >> 3;
        const int ntrip = (nst * 11) >> 5, rem = nst - 3 * ntrip;
#pragma unroll 1
        for (int it = ntrip; it > 0; --it) {
            IDX_LOAD(rc0, rc1, kt + 16); __builtin_amdgcn_sched_barrier(0); IDX_STEP(ra0, ra1); __builtin_amdgcn_sched_barrier(0); kt += 8;
            IDX_LOAD(ra0, ra1, kt + 16); __builtin_amdgcn_sched_barrier(0); IDX_STEP(rb0, rb1); __builtin_amdgcn_sched_barrier(0); kt += 8;
            IDX_LOAD(rb0, rb1, kt + 16); __builtin_amdgcn_sched_barrier(0); IDX_STEP(rc0, rc1); __builtin_amdgcn_sched_barrier(0); kt += 8;
        }
        if (rem >= 1) { IDX_STEP(ra0, ra1); kt += 8; if (rem >= 2) { IDX_STEP(rb0, rb1); } }
#undef IDX_LOAD
#undef IDX_STEP
        __syncthreads();
        }
#pragma unroll 1
        for (int rpT = 0; rpT < RP_T; ++rpT) {
            const int ra = 2 * wave, rb = 2 * wave + 1, ta = q0 + ra, tb = q0 + rb;
            unsigned ka[32], kb[32];
#ifdef KLG
#pragma unroll
            for (int i0 = 0; i0 < 32; i0 += KLG) {
                float fa[KLG], fb[KLG];
#pragma unroll
                for (int j = 0; j < KLG; ++j) { fa[j] = SC[ra * SCP + lane + 64 * (i0 + j)]; fb[j] = SC[rb * SCP + lane + 64 * (i0 + j)]; }
#pragma unroll
                for (int j = 0; j < KLG; ++j) { const int key = lane + 64 * (i0 + j); ka[i0 + j] = (key <= ta) ? score_ukey(fa[j]) : 0u; kb[i0 + j] = (key <= tb) ? score_ukey(fb[j]) : 0u; }
            }
#else
#pragma unroll
            for (int i = 0; i < 32; ++i) { const int key = lane + 64 * i; ka[i] = (key <= ta) ? score_ukey(SC[ra * SCP + key]) : 0u; kb[i] = (key <= tb) ? score_ukey(SC[rb * SCP + key]) : 0u; }
#endif
#if RP_T1 > 1
            asm volatile("" :: "v"(ka[0]), "v"(kb[31]) : "memory");
#pragma unroll
            for (int i = 0; i < 32; ++i) { const int key = lane + 64 * i; ka[i] = (key <= ta) ? score_ukey(SC[ra * SCP + key]) : 0u; kb[i] = (key <= tb) ? score_ukey(SC[rb * SCP + key]) : 0u; }
            asm volatile("" ::: "memory");
#endif
            asm volatile("s_waitcnt lgkmcnt(0)" ::: "memory");
            __syncthreads();
            DSA_STAGE(0);
            TopkState sa, sb; sa.nb = (ta >> 9) + 1; sb.nb = (tb >> 9) + 1;
            sa.hist = (wave < HIST_WAVES) ? (LAS unsigned*)(lds + 65536 + ra * 2048) : (LAS unsigned*)nullptr; sb.hist = (wave < HIST_WAVES) ? (LAS unsigned*)(lds + 65536 + rb * 2048) : (LAS unsigned*)nullptr;
            topk_init(ka, sa); topk_init(kb, sb);
#pragma unroll 1
            while (!(sa.done && sb.done)) { topk_step(ka, sa); topk_step(kb, sb); }
#if RP_T2 > 1
            asm volatile("" :: "v"(sa.prefix), "v"(sb.prefix));
            topk_init(ka, sa); topk_init(kb, sb);
#pragma unroll 1
            while (!(sa.done && sb.done)) { topk_step(ka, sa); topk_step(kb, sb); }
#endif
            if (sa.need == 0xffffffffu && sb.need == 0xffffffffu) {
                const unsigned ta_ = (unsigned)__builtin_amdgcn_readfirstlane((int)sa.prefix), tb_ = (unsigned)__builtin_amdgcn_readfirstlane((int)sb.prefix);
                int wa = 0, wb = 0;
#define WR2(i) { const unsigned long long ma = __ballot(ka[i] >= ta_), mb = __ballot(kb[i] >= tb_); wr2lanes<2 * (i)>(wa, (unsigned)ma, (unsigned)(ma >> 32)); wr2lanes<2 * (i)>(wb, (unsigned)mb, (unsigned)(mb >> 32)); }
                WR2(0) WR2(1) WR2(2) WR2(3) WR2(4) WR2(5) WR2(6) WR2(7) WR2(8) WR2(9) WR2(10) WR2(11) WR2(12) WR2(13) WR2(14) WR2(15)
                WR2(16) WR2(17) WR2(18) WR2(19) WR2(20) WR2(21) WR2(22) WR2(23) WR2(24) WR2(25) WR2(26) WR2(27) WR2(28) WR2(29) WR2(30) WR2(31)
#undef WR2
                BM[ra * BMS + lane] = (unsigned)wa; BM[rb * BMS + lane] = (unsigned)wb;
#if RP_T3 > 1
                asm volatile("" : "+v"(wa), "+v"(wb) :: "memory");
#define WR2(i) { const unsigned long long ma = __ballot(ka[i] >= ta_), mb = __ballot(kb[i] >= tb_); wr2lanes<2 * (i)>(wa, (unsigned)ma, (unsigned)(ma >> 32)); wr2lanes<2 * (i)>(wb, (unsigned)mb, (unsigned)(mb >> 32)); }
                WR2(0) WR2(1) WR2(2) WR2(3) WR2(4) WR2(5) WR2(6) WR2(7) WR2(8) WR2(9) WR2(10) WR2(11) WR2(12) WR2(13) WR2(14) WR2(15)
                WR2(16) WR2(17) WR2(18) WR2(19) WR2(20) WR2(21) WR2(22) WR2(23) WR2(24) WR2(25) WR2(26) WR2(27) WR2(28) WR2(29) WR2(30) WR2(31)
#undef WR2
                BM[ra * BMS + lane] = (unsigned)wa; BM[rb * BMS + lane] = (unsigned)wb;
#endif
            } else {
            unsigned eqa = 0u, eqb = 0u;
#pragma unroll 1
            for (int i = 0; i < 32; ++i) {
                unsigned kai = ka[0], kbi = kb[0];
#pragma unroll
                for (int j = 1; j < 32; ++j) { kai = (i == j) ? ka[j] : kai; kbi = (i == j) ? kb[j] : kbi; }
                { const bool eq = (kai == sa.prefix); const unsigned long long em = __ballot(eq);
                  const unsigned erank = eqa + __builtin_amdgcn_mbcnt_hi((unsigned)(em >> 32), __builtin_amdgcn_mbcnt_lo((unsigned)em, 0u));
                  const unsigned long long smk = __ballot((kai > sa.prefix) || (eq && erank < sa.need));
                  if (lane == 0) { BM[ra * BMS + 2 * i] = (unsigned)smk; BM[ra * BMS + 2 * i + 1] = (unsigned)(smk >> 32); }
                  eqa += (unsigned)__popcll(em); }
                { const bool eq = (kbi == sb.prefix); const unsigned long long em = __ballot(eq);
                  const unsigned erank = eqb + __builtin_amdgcn_mbcnt_hi((unsigned)(em >> 32), __builtin_amdgcn_mbcnt_lo((unsigned)em, 0u));
                  const unsigned long long smk = __ballot((kbi > sb.prefix) || (eq && erank < sb.need));
                  if (lane == 0) { BM[rb * BMS + 2 * i] = (unsigned)smk; BM[rb * BMS + 2 * i + 1] = (unsigned)(smk >> 32); }
                  eqb += (unsigned)__popcll(em); }
            }
            }
        }
    } else {
        for (int i = tid; i < 1024; i += 512) { const int row = i >> 6, w = i & 63, t = q0 + row, lo = 32 * w;
            BM[row * BMS + w] = (t >= lo + 31) ? 0xffffffffu : ((t < lo) ? 0u : ((2u << (t - lo)) - 1u)); }
        DSA_STAGE(0);
    }
    __syncthreads();
    const int h = wave;
#pragma unroll 1
    for (int rpV = 0; rpV < RP_V; ++rpV) {
    asm volatile("s_waitcnt vmcnt(0)" ::: "memory");
    asm volatile("" :: "v"(bq0), "v"(bq1), "v"(gwv[0]), "v"(gwv[1]), "v"(gwv[2]), "v"(gwv[3]));
    __syncthreads();
    if (qt_next >= TOPK / 16) { dsa_prefetch_qi(zb, qt_next, lds, wave, lane); dsa_prefetch_ki(zb, qt_next, pk, wave, lane); }
    f32x4 o[4], lacc = {0.f, 0.f, 0.f, 0.f}, negm = {0.f, 0.f, 0.f, 0.f};
#pragma unroll
    for (int dt = 0; dt < 4; ++dt) o[dt] = (f32x4){0.f, 0.f, 0.f, 0.f};
    float m_run = 0.f;
    const int kofs0 = r16 * 128 + ((g ^ (r16 >> 1)) & 7) * 16, kofs1 = r16 * 128 + (((4 + g) ^ (r16 >> 1)) & 7) * 16;
    const int vofs = 32768 + (4 * g + ((lane & 15) >> 2)) * 32 + (lane & 3) * 8;
    bf16x8v ones = {0x3f80, 0x3f80, 0x3f80, 0x3f80, 0x3f80, 0x3f80, 0x3f80, 0x3f80};
    asm volatile("" : "+v"(ones));
    LAS const unsigned char* mlut = lds + DSA_MLUT_OFF;
    constexpr float THR = 8.0f;
    bool first = true;
#pragma unroll 1
    for (int mm = 0; mm < nmega; ++mm) {
        if (mm + 1 < nmega) DSA_STAGE(mm + 1);
        LAS unsigned char* slotb = lds + (mm & 1) * 65536;
        const int nsub = (nsteps - mm * 8) < 8 ? (nsteps - mm * 8) : 8;
#pragma unroll 1
        for (int u = 0; u < nsub; u += 2) {
            LAS unsigned char* slot = slotb + u * 4096;
            const int mwA = (int)(BM[r16 * BMS + mm * 8 + u] >> (4 * g)), mwB = (int)(BM[r16 * BMS + mm * 8 + u + 1] >> (4 * g));
            f32x4 s0, s1, s2, s3;
            { const bf16x8v ka0 = *(LAS const bf16x8v*)(slot + kofs0), ka1 = *(LAS const bf16x8v*)(slot + kofs1);
              const bf16x8v kb0 = *(LAS const bf16x8v*)(slot + 2048 + kofs0), kb1 = *(LAS const bf16x8v*)(slot + 2048 + kofs1);
              const bf16x8v kc0 = *(LAS const bf16x8v*)(slot + 4096 + kofs0), kc1 = *(LAS const bf16x8v*)(slot + 4096 + kofs1);
              const bf16x8v kd0 = *(LAS const bf16x8v*)(slot + 6144 + kofs0), kd1 = *(LAS const bf16x8v*)(slot + 6144 + kofs1);
              s0 = __builtin_amdgcn_mfma_f32_16x16x32_bf16(ka0, bq0, negm, 0, 0, 0); s1 = __builtin_amdgcn_mfma_f32_16x16x32_bf16(kb0, bq0, negm, 0, 0, 0);
              s2 = __builtin_amdgcn_mfma_f32_16x16x32_bf16(kc0, bq0, negm, 0, 0, 0); s3 = __builtin_amdgcn_mfma_f32_16x16x32_bf16(kd0, bq0, negm, 0, 0, 0);
              s0 = __builtin_amdgcn_mfma_f32_16x16x32_bf16(ka1, bq1, s0, 0, 0, 0); s1 = __builtin_amdgcn_mfma_f32_16x16x32_bf16(kb1, bq1, s1, 0, 0, 0);
              s2 = __builtin_amdgcn_mfma_f32_16x16x32_bf16(kc1, bq1, s2, 0, 0, 0); s3 = __builtin_amdgcn_mfma_f32_16x16x32_bf16(kd1, bq1, s3, 0, 0, 0); }
            const int lmi = max(max(max(imax3(s0[0], s0[1], s0[2]), imax3(s0[3], s1[0], s1[1])), max(imax3(s1[2], s1[3], s2[0]), imax3(s2[1], s2[2], s2[3]))), max(imax3(s3[0], s3[1], s3[2]), __float_as_int(s3[3])));
            if (first || __any(lmi > 0x41000000)) {
                float lmx = fmaxf(fmaxf(fmaxf(fmaxf(s0[0], s0[1]), fmaxf(s0[2], s0[3])), fmaxf(fmaxf(s1[0], s1[1]), fmaxf(s1[2], s1[3]))), fmaxf(fmaxf(fmaxf(s2[0], s2[1]), fmaxf(s2[2], s2[3])), fmaxf(fmaxf(s3[0], s3[1]), fmaxf(s3[2], s3[3]))));
                { const auto r1 = __builtin_amdgcn_permlane16_swap(__float_as_uint(lmx), __float_as_uint(lmx), false, false); lmx = fmaxf(__uint_as_float(r1[0]), __uint_as_float(r1[1])); }
                { const auto r2 = __builtin_amdgcn_permlane32_swap(__float_as_uint(lmx), __float_as_uint(lmx), false, false); lmx = fmaxf(__uint_as_float(r2[0]), __uint_as_float(r2[1])); }
                const float dl = first ? lmx : fmaxf(lmx, 0.f);
                m_run += dl; const float f = first ? 1.0f : __builtin_amdgcn_exp2f(-dl);
#pragma unroll
                for (int i = 0; i < 4; ++i) { s0[i] -= dl; s1[i] -= dl; s2[i] -= dl; s3[i] -= dl; negm[i] = -m_run; }
                lacc = lacc * f;
#pragma unroll
                for (int dt = 0; dt < 4; ++dt) o[dt] = o[dt] * f;
                first = false;
            }
            const u32x2 mk0 = *(LAS const u32x2*)(mlut + ((mwA & 15) << 3)), mk1 = *(LAS const u32x2*)(mlut + (((mwA >> 16) & 15) << 3));
            const u32x2 mk2 = *(LAS const u32x2*)(mlut + ((mwB & 15) << 3)), mk3 = *(LAS const u32x2*)(mlut + (((mwB >> 16) & 15) << 3));
            u32x4 pwA, pwB;
            pwA.x = cvtpk(__builtin_amdgcn_exp2f(s0[0]), __builtin_amdgcn_exp2f(s0[1])) & mk0.x; pwA.y = cvtpk(__builtin_amdgcn_exp2f(s0[2]), __builtin_amdgcn_exp2f(s0[3])) & mk0.y;
            pwA.z = cvtpk(__builtin_amdgcn_exp2f(s1[0]), __builtin_amdgcn_exp2f(s1[1])) & mk1.x; pwA.w = cvtpk(__builtin_amdgcn_exp2f(s1[2]), __builtin_amdgcn_exp2f(s1[3])) & mk1.y;
            pwB.x = cvtpk(__builtin_amdgcn_exp2f(s2[0]), __builtin_amdgcn_exp2f(s2[1])) & mk2.x; pwB.y = cvtpk(__builtin_amdgcn_exp2f(s2[2]), __builtin_amdgcn_exp2f(s2[3])) & mk2.y;
            pwB.z = cvtpk(__builtin_amdgcn_exp2f(s3[0]), __builtin_amdgcn_exp2f(s3[1])) & mk3.x; pwB.w = cvtpk(__builtin_amdgcn_exp2f(s3[2]), __builtin_amdgcn_exp2f(s3[3])) & mk3.y;
            const bf16x8v pfA = __builtin_bit_cast(bf16x8v, pwA), pfB = __builtin_bit_cast(bf16x8v, pwB);
            lacc = __builtin_amdgcn_mfma_f32_16x16x32_bf16(ones, pfA, lacc, 0, 0, 0);
            lacc = __builtin_amdgcn_mfma_f32_16x16x32_bf16(ones, pfB, lacc, 0, 0, 0);
#pragma unroll
            for (int dt = 0; dt < 4; ++dt) {
                const s16x4v lo = lds_tr16(slot + vofs + dt * 1024), hi = lds_tr16(slot + vofs + dt * 1024 + 512);
                const s16x4v lo2 = lds_tr16(slot + 4096 + vofs + dt * 1024), hi2 = lds_tr16(slot + 4096 + vofs + dt * 1024 + 512);
                const bf16x8v vf = {lo[0], lo[1], lo[2], lo[3], hi[0], hi[1], hi[2], hi[3]};
                const bf16x8v vf2 = {lo2[0], lo2[1], lo2[2], lo2[3], hi2[0], hi2[1], hi2[2], hi2[3]};
                o[dt] = __builtin_amdgcn_mfma_f32_16x16x32_bf16(vf, pfA, o[dt], 0, 0, 0);
                o[dt] = __builtin_amdgcn_mfma_f32_16x16x32_bf16(vf2, pfB, o[dt], 0, 0, 0);
            }
        }
        asm volatile("s_waitcnt vmcnt(0) lgkmcnt(0)" ::: "memory");
        __syncthreads();
    }
#undef DSA_STAGE
    const float inv = 1.0f / lacc[0];
    bf16* yrow = p.Y + ((size_t)b * SEQ + q0 + r16) * DM + 512 + h * 64;
#pragma unroll
    for (int dt = 0; dt < 4; ++dt) {
        const u32x2 gw = gwv[dt];
        const float g0 = __uint_as_float(gw.x << 16), g1 = __uint_as_float(gw.x & 0xffff0000u), g2 = __uint_as_float(gw.y << 16), g3 = __uint_as_float(gw.y & 0xffff0000u);
        u32x2 w; w.x = pk2(o[dt][0] * inv * siluf(g0), o[dt][1] * inv * siluf(g1)); w.y = pk2(o[dt][2] * inv * siluf(g2), o[dt][3] * inv * siluf(g3));
        *(u32x2*)(yrow + dt * 16 + 4 * g) = w;
    }
    __syncthreads();
    }
}
__device__ __forceinline__ int dsa_qt_of(int j, int i) { return (i == 0) ? 127 - j : (i == 1) ? 64 + j : (i == 2) ? 63 - j : j; }
__device__ __forceinline__ void dsa_phase_pre(const P& p, LAS unsigned char* lds, bf16x8v (&pk)[4]) {
    const int G = gridDim.x, wg = blockIdx.x, lane = threadIdx.x & 63, wave = __builtin_amdgcn_readfirstlane(threadIdx.x >> 6);
    const int b = (G == 256) ? (wg & 7) : (wg >> 7), qt = (G == 256) ? dsa_qt_of(wg >> 3, 0) : 127 - (wg & 127);
#pragma unroll
    for (int i = 0; i < 4; ++i) pk[i] = (bf16x8v){0, 0, 0, 0, 0, 0, 0, 0};
    if (wg < 1024 && qt >= TOPK / 16) { dsa_prefetch_qi(p.Z + (size_t)b * SEQ * ZP, qt, lds, wave, lane); dsa_prefetch_ki(p.Z + (size_t)b * SEQ * ZP, qt, pk, wave, lane); }
}
__device__ __forceinline__ void dsa_phase(const P& p, LAS unsigned char* lds, bf16x8v (&pk)[4]) {
    const int G = gridDim.x, wg = blockIdx.x;
    if (G == 256) {
        const int b = wg & 7, j = wg >> 3;
#pragma unroll 1
        for (int i = 0; i < 4; ++i) dsa_unit(p, b, dsa_qt_of(j, i), (i < 3) ? dsa_qt_of(j, i + 1) : -1, pk, lds);
    }
}
constexpr int LRU_WS_OFF = 139264;
constexpr int LRU_XB = 264 * 128;
constexpr int LRU_GB = 256 * 32;
constexpr int LRU_BUF = LRU_XB + LRU_GB;
__device__ __forceinline__ float fast_sigm(float x) { return __builtin_amdgcn_rcpf(1.0f + __expf(-x)); }
__device__ __forceinline__ void lru_unit(const P& p, int l, int b, int blk, int q4, LAS unsigned char* lds) {
    const int tid = threadIdx.x, lane = tid & 63, wave = __builtin_amdgcn_readfirstlane(tid >> 6), r16 = lane & 15, g = lane >> 4;
    const bf16* zb = p.Z + (size_t)b * SEQ * ZP;
    const int cA = blk * 64, dloc = q4 * 16 + r16, dg = blk * 64 + dloc;
    const unsigned lds_base = (unsigned)(uintptr_t)lds;
#define LRU_STAGE(r) do { const unsigned bb_ = lds_base + (unsigned)(((r) & 1) * LRU_BUF); \
        _Pragma("unroll") for (int i_ = 0; i_ < 5; ++i_) { const int pc_ = wave + 8 * i_; if (pc_ < 33) { const int rho_ = pc_ * 8 + (lane >> 3); int t_ = (r) * 256 - 3 + rho_; t_ = t_ < 0 ? 0 : (t_ > SEQ - 1 ? SEQ - 1 : t_); \
            const int ch_ = (lane & 7) ^ ((rho_ >> 1) & 7); glds16(zb + (size_t)t_ * ZP + C_XR + cA + ch_ * 8, (unsigned)__builtin_amdgcn_readfirstlane(bb_ + pc_ * 1024)); } } \
        { const int row_ = wave * 32 + (lane >> 1); glds16(zb + (size_t)((r) * 256 + row_) * ZP + C_GR + dg - r16 + (lane & 1) * 8, (unsigned)__builtin_amdgcn_readfirstlane(bb_ + LRU_XB + wave * 1024)); } } while (0)
    LRU_STAGE(0);
    float cwA[2][4][8], cbA[2][8];
#pragma unroll
    for (int s = 0; s < 2; ++s)
#pragma unroll
        for (int j = 0; j < 8; ++j) { const int c = cA + 32 * s + 8 * g + j; cbA[s][j] = p.conv_b[l * 512 + c];
#pragma unroll
            for (int k = 0; k < 4; ++k) cwA[s][k][j] = p.conv_w[(l * 4 + k) * 512 + c]; }
    bf16x8v bxf[2], baf[2];
#pragma unroll
    for (int s = 0; s < 2; ++s) { u32x4 wx, wa; unsigned tx[8], ta[8];
#pragma unroll
        for (int j = 0; j < 8; ++j) { const size_t idx = (((size_t)l * 8 + blk) * 64 + 32 * s + 8 * g + j) * 64 + dloc; tx[j] = f2bf(p.lru_wx[idx]); ta[j] = f2bf(p.lru_wa[idx]); }
        wx.x = tx[0] | (tx[1] << 16); wx.y = tx[2] | (tx[3] << 16); wx.z = tx[4] | (tx[5] << 16); wx.w = tx[6] | (tx[7] << 16);
        wa.x = ta[0] | (ta[1] << 16); wa.y = ta[2] | (ta[3] << 16); wa.z = ta[4] | (ta[5] << 16); wa.w = ta[6] | (ta[7] << 16);
        bxf[s] = __builtin_bit_cast(bf16x8v, wx); baf[s] = __builtin_bit_cast(bf16x8v, wa); }
    const float cw0 = p.conv_w[(l * 4 + 0) * 512 + dg], cw1 = p.conv_w[(l * 4 + 1) * 512 + dg], cw2 = p.conv_w[(l * 4 + 2) * 512 + dg], cw3 = p.conv_w[(l * 4 + 3) * 512 + dg];
    const float cb = p.conv_b[l * 512 + dg], bxv = p.lru_bx[l * 512 + dg], bav = p.lru_ba[l * 512 + dg];
    const float sp8 = -8.0f * log1pf(expf(-p.lru_a[l * 512 + dg]));
    asm volatile("" :: "v"(cwA[0][0][0]), "v"(cwA[1][3][7]), "v"(cbA[1][7]), "v"(bxf[0]), "v"(bxf[1]), "v"(baf[0]), "v"(baf[1]), "v"(cw0), "v"(cw1), "v"(cw2), "v"(cw3), "v"(cb), "v"(bxv), "v"(bav), "v"(sp8));
    LAS float* WS = (LAS float*)(lds + LRU_WS_OFF);
    float hrun = 0.f;
    asm volatile("s_waitcnt vmcnt(0)" ::: "memory");
#pragma unroll 1
    for (int round = 0; round < 8; ++round) {
        asm volatile("s_waitcnt vmcnt(8)" ::: "memory");
        __syncthreads();
        if (round + 1 < 8) LRU_STAGE(round + 1);
        LAS const unsigned char* xb = lds + (round & 1) * LRU_BUF; LAS const unsigned char* gb = xb + LRU_XB;
        const int tw = round * 256 + wave * 32;
        float hl[2][4], pl[2][4], gr4[2][4], PT[2], HT[2], PE[2], HE[2];
#pragma unroll
        for (int tau = 0; tau < 2; ++tau) {
            const int t0 = tw + 16 * tau, rho0 = wave * 32 + 16 * tau;
            bf16x8v af[2];
#pragma unroll
            for (int s = 0; s < 2; ++s) {
                float xc[8];
#pragma unroll
                for (int j = 0; j < 8; ++j) xc[j] = cbA[s][j];
#pragma unroll
                for (int k = 0; k < 4; ++k) { const int rho = rho0 + r16 + k; u32x4 w = *(LAS const u32x4*)(xb + rho * 128 + (((4 * s + g) ^ (rho >> 1)) & 7) * 16);
                    if (t0 + r16 - 3 + k < 0) w = (u32x4){0u, 0u, 0u, 0u};
                    xc[0] += cwA[s][k][0] * __uint_as_float(w.x << 16); xc[1] += cwA[s][k][1] * __uint_as_float(w.x & 0xffff0000u);
                    xc[2] += cwA[s][k][2] * __uint_as_float(w.y << 16); xc[3] += cwA[s][k][3] * __uint_as_float(w.y & 0xffff0000u);
                    xc[4] += cwA[s][k][4] * __uint_as_float(w.z << 16); xc[5] += cwA[s][k][5] * __uint_as_float(w.z & 0xffff0000u);
                    xc[6] += cwA[s][k][6] * __uint_as_float(w.w << 16); xc[7] += cwA[s][k][7] * __uint_as_float(w.w & 0xffff0000u); }
                u32x4 pw; pw.x = cvtpk(xc[0], xc[1]); pw.y = cvtpk(xc[2], xc[3]); pw.z = cvtpk(xc[4], xc[5]); pw.w = cvtpk(xc[6], xc[7]);
                af[s] = __builtin_bit_cast(bf16x8v, pw);
            }
            f32x4 gx = {0.f, 0.f, 0.f, 0.f}, ga = {0.f, 0.f, 0.f, 0.f};
            gx = __builtin_amdgcn_mfma_f32_16x16x32_bf16(af[0], bxf[0], gx, 0, 0, 0); gx = __builtin_amdgcn_mfma_f32_16x16x32_bf16(af[1], bxf[1], gx, 0, 0, 0);
            ga = __builtin_amdgcn_mfma_f32_16x16x32_bf16(af[0], baf[0], ga, 0, 0, 0); ga = __builtin_amdgcn_mfma_f32_16x16x32_bf16(af[1], baf[1], ga, 0, 0, 0);
            float xo[7];
#pragma unroll
            for (int m = 0; m < 7; ++m) { const int rho = rho0 + 4 * g + m;
                const unsigned short v = *(LAS const unsigned short*)(xb + rho * 128 + (((dloc >> 3) ^ (rho >> 1)) & 7) * 16 + (dloc & 7) * 2);
                xo[m] = (t0 + 4 * g - 3 + m >= 0) ? bf2f(v) : 0.f; }
            float Pr = 1.f, Hr = 0.f;
#pragma unroll
            for (int i = 0; i < 4; ++i) {
                const float xcv = cb + cw0 * xo[i] + cw1 * xo[i + 1] + cw2 * xo[i + 2] + cw3 * xo[i + 3];
                const float sx = fast_sigm(gx[i] + bxv), sa = fast_sigm(ga[i] + bav);
                const float la = sp8 * sa, a = __expf(la), y2 = 2.0f * la;
                const float ser = -y2 * (1.0f + y2 * (0.5f + y2 * (0.16666667f + y2 * (0.041666668f + y2 * (0.0083333338f + y2 * 0.0013888889f)))));
                const float em = (y2 > -0.25f) ? ser : (1.0f - __expf(y2));
                const float u = __builtin_amdgcn_sqrtf(em) * sx * xcv;
                Hr = a * Hr + u; Pr *= a; hl[tau][i] = Hr; pl[tau][i] = Pr;
                gr4[tau][i] = bf2f(*(LAS const unsigned short*)(gb + (rho0 + 4 * g + i) * 32 + r16 * 2));
            }
            float Pi = Pr, Hi = Hr;
            { const float Pl = __shfl_up(Pi, 16), Hl = __shfl_up(Hi, 16); if (g >= 1) { Hi = Pi * Hl + Hi; Pi = Pl * Pi; } }
            { const float Pl = __shfl_up(Pi, 32), Hl = __shfl_up(Hi, 32); if (g >= 2) { Hi = Pi * Hl + Hi; Pi = Pl * Pi; } }
            float Pe = __shfl_up(Pi, 16), He = __shfl_up(Hi, 16); if (g == 0) { Pe = 1.f; He = 0.f; }
            PT[tau] = __shfl(Pi, 48 + r16); HT[tau] = __shfl(Hi, 48 + r16); PE[tau] = Pe; HE[tau] = He;
        }
        HE[1] = PE[1] * HT[0] + HE[1]; PE[1] = PT[0] * PE[1];
        const float Pw = PT[0] * PT[1], Hw = PT[1] * HT[0] + HT[1];
        LAS float* wsr = WS + (round & 1) * 256;
        if (g == 0) { wsr[(wave * 16 + r16) * 2 + 0] = Pw; wsr[(wave * 16 + r16) * 2 + 1] = Hw; }
        asm volatile("s_waitcnt lgkmcnt(0)" ::: "memory");
        __builtin_amdgcn_s_barrier();
        asm volatile("" ::: "memory");
        float hc = hrun, hall = hrun;
#pragma unroll
        for (int w2 = 0; w2 < 8; ++w2) { if (w2 == wave) hc = hall; hall = wsr[(w2 * 16 + r16) * 2 + 0] * hall + wsr[(w2 * 16 + r16) * 2 + 1]; }
        hrun = hall;
#pragma unroll
        for (int tau = 0; tau < 2; ++tau) {
            const float hin = PE[tau] * hc + HE[tau];
            bf16* yp = p.Y + ((size_t)b * SEQ + tw + 16 * tau + 4 * g) * DM + dg;
#pragma unroll
            for (int i = 0; i < 4; ++i) { const float h = hl[tau][i] + pl[tau][i] * hin, gr = gr4[tau][i]; yp[(size_t)i * DM] = (bf16)f2bf(h * gr * fast_sigm(gr)); }
        }
    }
#undef LRU_STAGE
    __syncthreads();
}
__device__ __forceinline__ void lru_phase(const P& p, int l, LAS unsigned char* lds) {
    const int G = gridDim.x, wg = blockIdx.x;
#pragma unroll 1
    for (int u = wg; u < 256; u += G) lru_unit(p, l, (u >> 3) & 7, u & 7, u >> 6, lds);
}
#ifndef DSA_PHASE
#define DSA_PHASE dsa_phase
#endif
#ifndef LRU_PHASE
#define LRU_PHASE lru_phase
#endif
#ifndef RP_A
#define RP_A 1
#endif
#ifndef RP_L
#define RP_L 1
#endif
#ifndef RP_D
#define RP_D 1
#endif
#ifndef RP_C
#define RP_C 1
#endif
#ifndef RP_0
#define RP_0 1
#endif
template <int OFF> __device__ __forceinline__ unsigned long long karg_u64() {
    unsigned long long v; const unsigned long long kp = (unsigned long long)__builtin_amdgcn_kernarg_segment_ptr();
    asm volatile("s_load_dwordx2 %0, %1, %2\n\ts_waitcnt lgkmcnt(0)" : "=s"(v) : "s"(kp), "i"(OFF) : "memory");
    return v;
}
struct Args { const float* in[15]; float* out; unsigned char* ws; int ph_lo, ph_hi; };
__global__ void __launch_bounds__(512, 2) mega(Args a) {
    extern __shared__ __attribute__((aligned(16))) unsigned char lds_raw[];
    LAS unsigned char* lds = (LAS unsigned char*)lds_raw;
#define KARG(T, off) ((T)(__attribute__((address_space(1))) void*)karg_u64<(off)>())
#define LOADP() P p; { unsigned char* ws_ = KARG(unsigned char*, 128); \
        p.x = KARG(const float*, 0); p.c = KARG(const float*, 8); p.norm_g = KARG(const float*, 16); p.ada_w = KARG(const float*, 24); p.ada_b = KARG(const float*, 32); p.w_in = KARG(const float*, 40); \
        p.conv_w = KARG(const float*, 48); p.conv_b = KARG(const float*, 56); p.lru_wx = KARG(const float*, 64); p.lru_bx = KARG(const float*, 72); p.lru_wa = KARG(const float*, 80); p.lru_ba = KARG(const float*, 88); \
        p.lru_a = KARG(const float*, 96); p.w_out = KARG(const float*, 104); p.final_g = KARG(const float*, 112); p.out = KARG(float*, 120); \
        p.ctl = (unsigned*)(ws_ + WS_CTL); p.mod = (float*)(ws_ + WS_MOD); p.bias = (float*)(ws_ + WS_BIAS); p.ssq = (float*)(ws_ + WS_SSQ); \
        p.wt_in = (bf16*)(ws_ + WS_WTIN); p.wt_out = (bf16*)(ws_ + WS_WTOUT); p.A = (bf16*)(ws_ + WS_A); p.Z = (bf16*)(ws_ + WS_Z); p.Y = (bf16*)(ws_ + WS_Y); p.X1 = (bf16*)(ws_ + WS_X1); }
    unsigned* const ctl0 = (unsigned*)((unsigned char*)a.ws + WS_CTL);
    const int lo = a.ph_lo, hi = a.ph_hi;
    volatile LAS unsigned* MISC = (volatile LAS unsigned*)(lds + MISC_OFF + 4096);
    if (threadIdx.x < 4) MISC[threadIdx.x] = 0u;
    if (threadIdx.x < 16) { const unsigned t = threadIdx.x; u32x2 m; m.x = ((t & 1u) ? 0xffffu : 0u) | ((t & 2u) ? 0xffff0000u : 0u); m.y = ((t & 4u) ? 0xffffu : 0u) | ((t & 8u) ? 0xffff0000u : 0u);
        *(LAS u32x2*)(lds + DSA_MLUT_OFF + t * 8) = m; }
    __syncthreads();
    XcdBarrier bar; bar.bar = ctl0 + CW_BAR; bar.x = 0; bar.st = MISC;
    if (hi - lo > 1) bar = xcd_barrier_post(ctl0 + CW_BAR, MISC);
#define IN(k) (lo <= (k) && (k) < hi)
#ifndef N_CG_SEAMS
#define N_CG_SEAMS 0
#endif
#define SEAM(k) do { if (IN(k) && IN((k) + 1)) { if ((k) < N_CG_SEAMS) cg::this_grid().sync(); else xcd_barrier(bar); } } while (0)
    if (IN(0)) { LOADP(); ph0_prologue(p, lds); if (RP_0 > 1) { __syncthreads(); ph0_prologue(p, lds); } }
    SEAM(0);
    if (IN(1)) { LOADP(); ph1_prologue(p, lds); if (RP_0 > 1) { __syncthreads(); ph1_prologue(p, lds); } }
    SEAM(1);
#ifdef PROBE_BAR
#define SEAM_X(b) do { SEAM(b); SEAM(b); SEAM(b); SEAM(b); } while (0)
#else
#define SEAM_X(b) do { } while (0)
#endif
#define LAYER(l, base) \
    if (IN(base)) { LOADP(); \
        pg8::Gemm g{p.A, p.wt_in + (size_t)(l) * ZP * 1024, MROWS, ZP, DM}; pg8::StaticOrder S; S.init(MROWS, ZP, (int)gridDim.x, (int)blockIdx.x); \
        EpiZ E{p.Z, p.ssq, p.bias + (size_t)(l) * 8 * ZP}; \
        pg8::gemm_phase<EpiZ, pg8::StaticOrder, PG8_ALIGN, PG8_SP2>(lds, g, S, E); if (RP_A > 1) { __syncthreads(); pg8::gemm_phase<EpiZ, pg8::StaticOrder, PG8_ALIGN, PG8_SP2>(lds, g, S, E); } \
    } \
    SEAM(base); SEAM_X(base); \
    if (IN((base) + 1)) { LOADP(); bf16x8v pk0[4]; dsa_phase_pre(p, lds, pk0); LRU_PHASE(p, (l), lds); __syncthreads(); DSA_PHASE(p, lds, pk0); } \
    SEAM((base) + 1); \
    if (IN((base) + 2)) { LOADP(); \
        pg8::Gemm g{p.Y, p.wt_out + (size_t)(l) * 1024 * 1024, MROWS, DM, DM}; pg8::StaticOrder S; S.init(MROWS, DM, (int)gridDim.x, (int)blockIdx.x); \
        if constexpr ((l) == DEPTH - 1) { \
            EpiXF E{p.X1, p.out, p.mod + (size_t)(l) * 8 * 3072 + 2048, p.final_g, p.ssq, p.ctl + CW_PANEL}; \
            pg8::gemm_phase<EpiXF, pg8::StaticOrder, false, PG8_SP2>(lds, g, S, E); \
        } else { \
            EpiX E{p.x, p.X1, p.A, p.mod + (size_t)(l) * 8 * 3072 + 2048, p.norm_g + (size_t)((l) + 1) * 1024, p.mod + (size_t)((l) + 1) * 8 * 3072 + 1024, p.ssq}; \
            pg8::gemm_phase<EpiX, pg8::StaticOrder, false, PG8_SP2>(lds, g, S, E); if (RP_C > 1 && (l) == 0) { __syncthreads(); pg8::gemm_phase<EpiX, pg8::StaticOrder, false, PG8_SP2>(lds, g, S, E); } \
        } \
    } \
    if ((base) + 3 < NPHASE) SEAM((base) + 2);
    LAYER(0, 2)
    LAYER(1, 5)
}
#ifndef MK_N_LAUNCHES
#define MK_N_LAUNCHES 1
#endif
extern "C" void kernel_launch(void* const* d_in, const int* in_sizes, int n_in, void* d_out, int out_size, void* d_ws, size_t ws_size, hipStream_t stream) {
    static int grid = 0;
    if (grid == 0) {
        if (n_in != 15 || out_size != MROWS * DM || ws_size < WS_END) { fprintf(stderr, "kernel_launch: unexpected problem (n_in %d out %d ws %zu)\n", n_in, out_size, ws_size); grid = -1; return; }
        int dev = 0, cus = 0, per_cu = 0;
        hipGetDevice(&dev); hipDeviceGetAttribute(&cus, hipDeviceAttributeMultiprocessorCount, dev);
        if (hipFuncSetAttribute((const void*)mega, hipFuncAttributeMaxDynamicSharedMemorySize, LDS_BYTES) != hipSuccess) { fprintf(stderr, "kernel_launch: hipFuncSetAttribute failed\n"); grid = -1; return; }
        if (hipOccupancyMaxActiveBlocksPerMultiprocessor(&per_cu, (const void*)mega, 512, LDS_BYTES) != hipSuccess || per_cu < 1) { fprintf(stderr, "kernel_launch: occupancy query failed (%d)\n", per_cu); per_cu = 1; }
        (void)hipGetLastError();
        grid = cus * per_cu;
        if (grid != 256) fprintf(stderr, "kernel_launch: grid %d (cus %d x %d) != 256: the fused out-projection epilogue needs exactly 256 workgroups\n", grid, cus, per_cu);
    }
    if (grid < 0) return;
    hipMemsetAsync((char*)d_ws + WS_CTL, 0, CTL_ZERO_BYTES, stream);
    Args a{};
    for (int i = 0; i < 15; ++i) a.in[i] = (const float*)d_in[i];
    a.out = (float*)d_out; a.ws = (unsigned char*)d_ws;
#if MK_N_LAUNCHES == 1
    a.ph_lo = 0; a.ph_hi = NPHASE;
    void* args[] = {&a};
    hipError_t e = hipLaunchCooperativeKernel((const void*)mega, dim3(grid), dim3(512), args, LDS_BYTES, stream);
    if (e != hipSuccess) fprintf(stderr, "cooperative launch failed: %s (grid %d)\n", hipGetErrorString(e), grid);
#else
    for (int ph = 0; ph < NPHASE; ++ph) { a.ph_lo = ph; a.ph_hi = ph + 1; hipLaunchKernelGGL(mega, dim3(grid), dim3(512), LDS_BYTES, stream, a); }
#endif
}
```

```cpp
#include <hip/hip_runtime.h>
#include <hip/hip_cooperative_groups.h>
#include <cstdio>
#include <cstdint>
#include <cmath>
namespace cg = cooperative_groups;
#define EPI_XD 4
#define EPI_ZD 8
#define HIST_WAVES 8
#define PRO_KC 64
#define HISTA_FALLBACK 1
#define WALK_MAX 4
#define XB_FLAT_RELEASE 1

namespace pg8 {
#define PG8_LAS __attribute__((address_space(3)))
typedef unsigned short bf16_t;
typedef short bf16x8 __attribute__((ext_vector_type(8)));
typedef float f32x4 __attribute__((ext_vector_type(4)));
typedef unsigned u32x4 __attribute__((ext_vector_type(4)));
constexpr int BM = 256, BK = 64, HALF = 128, HTB = HALF * BK * 2  , STAGE_BYTES = 8 * HTB, NXCD = 8, WGM = 8;

__host__ __device__ __forceinline__ int lds_byte(int r, int c) { const int st = (r >> 4) * 2 + (c >> 5), rr = r & 15, cc = c & 31, ob = rr * 64 + cc * 2; return st * 1024 + (ob ^ (((ob >> 9) & 1) << 5)); }
__host__ __device__ __forceinline__ void stage_rc(int b, int& R, int& C) { const int st = b / 1024, sb = b % 1024, swz = sb ^ (((sb >> 9) & 1) << 5); R = (st >> 1) * 16 + swz / 64; C = (st & 1) * 32 + (swz % 64) / 2; }
__host__ __device__ __forceinline__ int perm32(int rho) { const int n = rho >> 4, i = rho & 15; return 8 * (i >> 2) + 4 * n + (i & 3); }

struct Unit { int pm, pn; };
struct Gemm { const bf16_t* A; const bf16_t* Bt; int M, N, K; };

struct StaticOrder {
    int nM, nN, nwg, G, c;
    __host__ __device__ void init(int M, int N, int G_, int c_) { nM = M / BM; nN = N / BM; nwg = nM * nN; G = G_; c = c_; }
    __host__ __device__ bool next(int i, Unit& u) const {
        const long L = (long)i * G + c; if (L >= nwg) return false;
        int wgid = (int)L; { const int q = nwg / NXCD, r = nwg % NXCD, xcd = wgid % NXCD, off = wgid / NXCD; wgid = (xcd < r ? xcd * (q + 1) : r * (q + 1) + (xcd - r) * q) + off; }
        const int nig = WGM * nN, gid = wgid / nig, fm = gid * WGM, gsz = (nM - fm) < WGM ? (nM - fm) : WGM;
        u.pm = fm + ((wgid % nig) % gsz); u.pn = (wgid % nig) / gsz; return true;
    }
    __device__ __forceinline__ void a_ready(const Unit&) const {}
    __device__ __forceinline__ void done(const Unit&) const {}
};

__device__ __forceinline__ unsigned cvt_pk_bf16(float lo, float hi) { unsigned r; asm volatile("v_cvt_pk_bf16_f32 %0, %1, %2" : "=v"(r) : "v"(lo), "v"(hi)); return r; }
typedef float f32x2 __attribute__((ext_vector_type(2)));
template <class Epi, class Sched, bool ALIGN_EPI = false, bool SP2 = false>
__device__ __forceinline__ void gemm_phase(PG8_LAS unsigned char* lds, const Gemm g, const Sched& S, const Epi& E) {
    const int tid = threadIdx.x, wid = __builtin_amdgcn_readfirstlane(tid >> 6), lane = tid & 63, wr = wid >> 2, wc = wid & 3, fr = lane & 15, fq = lane >> 4;
    const int K = g.K, nt = K / BK;
    unsigned voffA[2], voffB[2];
#pragma unroll
    for (int i = 0; i < 2; ++i) { int R, C; stage_rc(tid * 16 + i * 8192, R, C); const int Rb = Epi::PERM ? ((R & ~31) + perm32(R & 31)) : R;
        voffA[i] = (unsigned)(R * K + C) * 2u; voffB[i] = (unsigned)(Rb * K + C) * 2u; }
    const size_t kstep = (size_t)(BK * 2);
    const size_t hstep = (size_t)HALF * K * 2;
    const size_t tstep = 2 * hstep;
    const unsigned ldsw = (unsigned)wid * 1024u;
    const int aoff = lds_byte(wr * 64 + fr, fq * 8), boff = lds_byte(wc * 32 + fr, fq * 8);
#define PG8_SA(b, h) (((b) * 2 + (h)) * HTB)
#define PG8_SB(b, h) ((4 + (b) * 2 + (h)) * HTB)
#define PG8_STAGE(bufoff, gbase, voff) do { _Pragma("unroll") for (int _i = 0; _i < 2; ++_i) \
        __builtin_amdgcn_global_load_lds((const unsigned*)((const char*)(gbase) + (voff)[_i]), (PG8_LAS unsigned*)(lds + (bufoff) + ldsw + _i * 8192), 16, 0, 0); } while (0)
#define PG8_LDA(dst, b, h) do { _Pragma("unroll") for (int m = 0; m < 4; ++m) _Pragma("unroll") for (int k = 0; k < 2; ++k) dst[m][k] = *(const PG8_LAS bf16x8*)(lds + PG8_SA(b, h) + aoff + m * 2048 + k * 1024); } while (0)
#define PG8_LDB(dst, b, h) do { _Pragma("unroll") for (int n = 0; n < 2; ++n) _Pragma("unroll") for (int k = 0; k < 2; ++k) dst[n][k] = *(const PG8_LAS bf16x8*)(lds + PG8_SB(b, h) + boff + n * 2048 + k * 1024); } while (0)
#define PG8_MMA(ai, bj, At, Bt) do { __builtin_amdgcn_s_setprio(1); _Pragma("unroll") for (int m = 0; m < 4; ++m) _Pragma("unroll") for (int n = 0; n < 2; ++n) _Pragma("unroll") for (int k = 0; k < 2; ++k) \
        acc[ai][bj][m][n] = __builtin_amdgcn_mfma_f32_16x16x32_bf16(Bt[n][k], At[m][k], acc[ai][bj][m][n], 0, 0, 0); __builtin_amdgcn_s_setprio(0); } while (0)
#define PG8_WAIT_V(n) asm volatile("s_waitcnt vmcnt(" #n ")" ::: "memory")
#define PG8_WAIT_L(n) asm volatile("s_waitcnt lgkmcnt(" #n ")" ::: "memory")
#define PG8_BAR __builtin_amdgcn_s_barrier()
#define PG8_SCHED __builtin_amdgcn_sched_barrier(0)
    Unit cur, nxt; int ui = 0;
    if (!S.next(0, cur)) return;
    f32x4 acc[2][2][4][2];
#pragma unroll
    for (int a = 0; a < 2; ++a)
#pragma unroll
        for (int b = 0; b < 2; ++b)
#pragma unroll
            for (int m = 0; m < 4; ++m)
#pragma unroll
                for (int n = 0; n < 2; ++n) acc[a][b][m][n] = (f32x4){0.f, 0.f, 0.f, 0.f};
    bf16x8 At[4][2], B0[2][2], B1[2][2];
    const char* cA = (const char*)g.A + (size_t)cur.pm * tstep; const char* cB = (const char*)g.Bt + (size_t)cur.pn * tstep;
    S.a_ready(cur);
    if constexpr (SP2) {
        PG8_STAGE(PG8_SB(0, 0), cB, voffB); PG8_STAGE(PG8_SB(0, 1), cB + hstep, voffB); PG8_STAGE(PG8_SA(0, 0), cA, voffA); PG8_STAGE(PG8_SA(0, 1), cA + hstep, voffA);
        if (wr == 1) PG8_BAR;
        PG8_WAIT_V(2); PG8_BAR;
        PG8_STAGE(PG8_SB(1, 0), cB + kstep, voffB); PG8_STAGE(PG8_SA(1, 0), cA + kstep, voffA); PG8_STAGE(PG8_SB(1, 1), cB + hstep + kstep, voffB);
        PG8_WAIT_V(6); PG8_BAR;
    } else {
        PG8_STAGE(PG8_SB(0, 0), cB, voffB); PG8_STAGE(PG8_SA(0, 0), cA, voffA); PG8_STAGE(PG8_SB(0, 1), cB + hstep, voffB); PG8_STAGE(PG8_SA(0, 1), cA + hstep, voffA);
        if (wr == 1) PG8_BAR;
        PG8_WAIT_V(4); PG8_BAR;
        PG8_STAGE(PG8_SB(1, 0), cB + kstep, voffB); PG8_STAGE(PG8_SA(1, 0), cA + kstep, voffA); PG8_STAGE(PG8_SB(1, 1), cB + hstep + kstep, voffB);
        PG8_WAIT_V(6); PG8_BAR;
    }
    for (;;) {
        const bool has_next = S.next(ui + 1, nxt);
        const char* nA = has_next ? (const char*)g.A + (size_t)nxt.pm * tstep : cA; const char* nB = has_next ? (const char*)g.Bt + (size_t)nxt.pn * tstep : cB;
        for (int t = 0; t < nt; t += 2) {
            const bool last = (t == nt - 2);
            const char* a1 = cA + (size_t)(t + 1) * kstep;
            const char* a2 = last ? nA : cA + (size_t)(t + 2) * kstep; const char* b2 = last ? nB : cB + (size_t)(t + 2) * kstep;
            const char* a3 = a2 + kstep; const char* b3 = b2 + kstep;
            if (last && has_next) S.a_ready(nxt);
            if constexpr (SP2) {
            PG8_LDB(B0, 0, 0); PG8_LDB(B1, 0, 1); PG8_SCHED; PG8_LDA(At, 0, 0); PG8_STAGE(PG8_SA(1, 1), a1 + hstep, voffA);
            PG8_WAIT_V(8); PG8_WAIT_L(0); PG8_BAR; PG8_MMA(0, 0, At, B0); PG8_MMA(0, 1, At, B1); PG8_BAR; PG8_SCHED;
            PG8_LDA(At, 0, 1); PG8_STAGE(PG8_SB(0, 0), b2, voffB); PG8_STAGE(PG8_SB(0, 1), b2 + hstep, voffB); PG8_STAGE(PG8_SA(0, 0), a2, voffA);
            PG8_WAIT_V(8); PG8_WAIT_L(0); PG8_BAR; PG8_MMA(1, 0, At, B0); PG8_MMA(1, 1, At, B1); PG8_BAR; PG8_SCHED;
            PG8_LDB(B0, 1, 0); PG8_LDB(B1, 1, 1); PG8_SCHED; PG8_LDA(At, 1, 0); PG8_STAGE(PG8_SA(0, 1), a2 + hstep, voffA);
            PG8_WAIT_V(8); PG8_WAIT_L(0); PG8_BAR; PG8_MMA(0, 0, At, B0); PG8_MMA(0, 1, At, B1); PG8_BAR; PG8_SCHED;
            PG8_LDA(At, 1, 1); PG8_STAGE(PG8_SB(1, 0), b3, voffB); PG8_STAGE(PG8_SB(1, 1), b3 + hstep, voffB); PG8_STAGE(PG8_SA(1, 0), a3, voffA);
            PG8_WAIT_V(8); PG8_WAIT_L(0); PG8_BAR; PG8_MMA(1, 0, At, B0); PG8_MMA(1, 1, At, B1); PG8_BAR; PG8_SCHED;
            } else {
            PG8_LDB(B0, 0, 0); PG8_SCHED; PG8_LDA(At, 0, 0); PG8_STAGE(PG8_SA(1, 1), a1 + hstep, voffA);
            PG8_WAIT_L(8); PG8_BAR; PG8_WAIT_L(0); PG8_MMA(0, 0, At, B0); PG8_BAR; PG8_SCHED;
            PG8_LDB(B1, 0, 1); PG8_STAGE(PG8_SB(0, 0), b2, voffB);
            PG8_BAR; PG8_WAIT_L(0); PG8_MMA(0, 1, At, B1); PG8_BAR;
            PG8_LDA(At, 0, 1); PG8_STAGE(PG8_SA(0, 0), a2, voffA);
            PG8_BAR; PG8_WAIT_L(0); PG8_MMA(1, 0, At, B0); PG8_BAR; PG8_SCHED;
            PG8_STAGE(PG8_SB(0, 1), b2 + hstep, voffB);
            PG8_WAIT_V(6); PG8_BAR; PG8_MMA(1, 1, At, B1); PG8_BAR;
            PG8_LDB(B0, 1, 0); PG8_SCHED; PG8_LDA(At, 1, 0); PG8_STAGE(PG8_SA(0, 1), a2 + hstep, voffA);
            PG8_WAIT_L(8); PG8_BAR; PG8_WAIT_L(0); PG8_MMA(0, 0, At, B0); PG8_BAR; PG8_SCHED;
            PG8_LDB(B1, 1, 1); PG8_STAGE(PG8_SB(1, 0), b3, voffB);
            PG8_BAR; PG8_WAIT_L(0); PG8_MMA(0, 1, At, B1); PG8_BAR;
            PG8_LDA(At, 1, 1); PG8_STAGE(PG8_SA(1, 0), a3, voffA);
            PG8_BAR; PG8_WAIT_L(0); PG8_MMA(1, 0, At, B0); PG8_BAR; PG8_SCHED;
            PG8_STAGE(PG8_SB(1, 1), b3 + hstep, voffB);
            PG8_WAIT_V(6); PG8_BAR; PG8_MMA(1, 1, At, B1); PG8_BAR;
            }
        }
        if constexpr (ALIGN_EPI) { if (wr == 0) PG8_BAR; }
        if constexpr (!Epi::AFTER_DRAIN) { E(acc, cur, wr, wc, fr, fq); S.done(cur); }
        if (!has_next) break;
#pragma unroll
        for (int a = 0; a < 2; ++a)
#pragma unroll
            for (int b = 0; b < 2; ++b)
#pragma unroll
                for (int m = 0; m < 4; ++m)
#pragma unroll
                    for (int n = 0; n < 2; ++n) acc[a][b][m][n] = (f32x4){0.f, 0.f, 0.f, 0.f};
        cur = nxt; cA = nA; cB = nB; ++ui;
        if constexpr (ALIGN_EPI) { if (wr == 1) PG8_BAR; }
    }
    PG8_WAIT_V(0);
    if constexpr (!ALIGN_EPI) { if (wr == 0) PG8_BAR; }
    PG8_BAR;
    if constexpr (Epi::AFTER_DRAIN) { E.fused(acc, cur, wr, wc, fr, fq, lds, wid, lane); S.done(cur); }
#undef PG8_SA
#undef PG8_SB
#undef PG8_STAGE
#undef PG8_LDA
#undef PG8_LDB
#undef PG8_MMA
#undef PG8_WAIT_V
#undef PG8_WAIT_L
#undef PG8_BAR
#undef PG8_SCHED
}
}

#ifndef PG8_SP2
#define PG8_SP2 true
#endif
#ifndef PG8_ALIGN
#define PG8_ALIGN true
#endif
constexpr int BATCH = 8, SEQ = 2048, DM = 1024, MROWS = BATCH * SEQ, DEPTH = 2;
constexpr int D_RNN = 512, NHEAD = 8, HDIM = 64, D_INR = 2760, ZP = 2816, TOPK = 256;
constexpr int C_XR = 0, C_GR = 512, C_Q = 1024, C_K = 1536, C_V = 1600, C_GA = 1664, C_QI = 2176, C_KI = 2688, C_WI = 2752;
constexpr float EPS = 1e-6f;
constexpr float QSCALE = 0.125f * 1.4426950408889634f;
constexpr size_t MiB = 1u << 20;
constexpr size_t WS_CTL = 0, CTL_ZERO_BYTES = 1 * MiB;
constexpr size_t WS_MOD = 1 * MiB;
constexpr size_t WS_BIAS = 1 * MiB + 256 * 1024;
constexpr size_t WS_SSQ = 2 * MiB;
constexpr size_t WS_WTIN = 3 * MiB;
constexpr size_t WS_WTOUT = 14 * MiB;
constexpr size_t WS_A = 32 * MiB;
constexpr size_t WS_Z = 64 * MiB;
constexpr size_t WS_Y = 152 * MiB;
constexpr size_t WS_X1 = 184 * MiB;
constexpr size_t WS_END = 216 * MiB;
constexpr int LDS_BYTES = 163840;
constexpr int MISC_OFF = 131072 + 8192;
constexpr int NPHASE = 8;
constexpr int CW_BAR = 4096, CW_PANEL = 16384;

#define LAS __attribute__((address_space(3)))
typedef unsigned short bf16;
typedef float f32x4 __attribute__((ext_vector_type(4)));
typedef unsigned u32x4 __attribute__((ext_vector_type(4)));
typedef unsigned u32x2 __attribute__((ext_vector_type(2)));
__device__ __forceinline__ float bf2f(bf16 v) { return __uint_as_float(((unsigned)v) << 16); }
__device__ __forceinline__ unsigned f2bf(float f) { unsigned u = __float_as_uint(f); return (u + 0x7fffu + ((u >> 16) & 1u)) >> 16; }
__device__ __forceinline__ unsigned pk2(float lo, float hi) { return f2bf(lo) | (f2bf(hi) << 16); }
__device__ __forceinline__ float wave_sum(float v) {
#pragma unroll
    for (int o = 1; o < 64; o <<= 1) v += __shfl_xor(v, o);
    return v;
}
__device__ __forceinline__ float wave_max(float v) {
#pragma unroll
    for (int o = 1; o < 64; o <<= 1) v = fmaxf(v, __shfl_xor(v, o));
    return v;
}
__device__ __forceinline__ int wave_sum_i(int v) {
#pragma unroll
    for (int o = 1; o < 64; o <<= 1) v += __shfl_xor(v, o);
    return v;
}
__device__ __forceinline__ float siluf(float v) { return v / (1.f + expf(-v)); }
__device__ __forceinline__ float sigmf(float v) { return 1.f / (1.f + expf(-v)); }

#ifdef USE_NT
#define NT_STORE(ptr, val) __builtin_nontemporal_store((val), (ptr))
#else
#define NT_STORE(ptr, val) (*(ptr) = (val))
#endif
struct P {
    const float *x, *c, *norm_g, *ada_w, *ada_b, *w_in, *conv_w, *conv_b, *lru_wx, *lru_bx, *lru_wa, *lru_ba, *lru_a, *w_out, *final_g;
    float* out;
    float *mod, *bias, *ssq;
    bf16 *wt_in, *wt_out, *A, *Z, *Y, *X1;
    unsigned* ctl;
};

#ifndef EPI_ZD
#define EPI_ZD 2
#endif
struct EpiZ {
    static constexpr bool PERM = true, AFTER_DRAIN = false;
    bf16* Zp; const float* ssq; const float* bias;
    __device__ __forceinline__ void operator()(const pg8::f32x4 (&acc)[2][2][4][2], const pg8::Unit& u, int wr, int wc, int fr, int fq) const {
        const int row0 = u.pm * 256 + wr * 64 + fr, col0 = u.pn * 256 + wc * 32 + 8 * fq, b = u.pm >> 3;
        const float cs = (u.pn == 4 || u.pn == 5) ? QSCALE : 1.0f;
        f32x4 bv[2][2];
#pragma unroll
        for (int bj = 0; bj < 2; ++bj)
#pragma unroll
            for (int n = 0; n < 2; ++n) bv[bj][n] = *(const f32x4*)(bias + b * ZP + col0 + bj * 128 + 4 * n);
        f32x4 qq[EPI_ZD];
#pragma unroll
        for (int gi = 0; gi < EPI_ZD; ++gi) qq[gi] = *(const f32x4*)(ssq + (size_t)(row0 + (gi >> 2) * 128 + (gi & 3) * 16) * 4);
#pragma unroll
        for (int ai = 0; ai < 2; ++ai)
#pragma unroll
            for (int m = 0; m < 4; ++m) {
                const int r = row0 + ai * 128 + m * 16, gi = ai * 4 + m;
                const f32x4 q = qq[gi % EPI_ZD];
                if (gi + EPI_ZD < 8) qq[gi % EPI_ZD] = *(const f32x4*)(ssq + (size_t)(row0 + ((gi + EPI_ZD) >> 2) * 128 + ((gi + EPI_ZD) & 3) * 16) * 4);
                const float rstd = __builtin_amdgcn_rsqf(((q.x + q.y) + (q.z + q.w)) * (1.0f / 1024.0f) + EPS);
                bf16* rowp = Zp + (size_t)r * ZP + col0;
#pragma unroll
                for (int bj = 0; bj < 2; ++bj) {
                    const f32x4 v0 = (acc[ai][bj][m][0] * rstd + bv[bj][0]) * cs, v1 = (acc[ai][bj][m][1] * rstd + bv[bj][1]) * cs;
                    u32x4 w; w.x = pk2(v0[0], v0[1]); w.y = pk2(v0[2], v0[3]); w.z = pk2(v1[0], v1[1]); w.w = pk2(v1[2], v1[3]);
                    NT_STORE((u32x4*)(rowp + bj * 128), w);
                }
            }
    }
};
#ifndef EPI_XD
#define EPI_XD 4
#endif
struct EpiX {
    static constexpr bool PERM = true, AFTER_DRAIN = true;
    const float* xres; bf16* xout; bf16* Anext; const float* gate; const float* ng; const float* nscale; float* ssq;
    __device__ __forceinline__ void fused(pg8::f32x4 (&acc)[2][2][4][2], const pg8::Unit& u, int wr, int wc, int fr, int fq, LAS unsigned char* lds, int wid, int lane) const {
        const int b = u.pm >> 3, col0 = u.pn * 256 + wc * 32 + 8 * fq;
        LAS float* Pp = (LAS float*)lds;
        f32x4 gv[2][2], gs[2][2];
#pragma unroll
        for (int bj = 0; bj < 2; ++bj)
#pragma unroll
            for (int n = 0; n < 2; ++n) {
                gv[bj][n] = *(const f32x4*)(gate + b * 3072 + col0 + bj * 128 + 4 * n);
                if (Anext) { const f32x4 g = *(const f32x4*)(ng + col0 + bj * 128 + 4 * n), s = *(const f32x4*)(nscale + b * 3072 + col0 + bj * 128 + 4 * n); gs[bj][n] = g * (s + 1.0f); }
                else gs[bj][n] = (f32x4){0.f, 0.f, 0.f, 0.f};
            }
        f32x4 xq[EPI_XD][2][2];
#define EPIX_LOAD(gi) do { const size_t r_ = (size_t)u.pm * 256 + ((gi) >> 2) * 128 + wr * 64 + ((gi) & 3) * 16 + fr; \
        _Pragma("unroll") for (int bj = 0; bj < 2; ++bj) _Pragma("unroll") for (int n = 0; n < 2; ++n) xq[(gi) % EPI_XD][bj][n] = *(const f32x4*)(xres + r_ * DM + col0 + bj * 128 + 4 * n); } while (0)
#pragma unroll
        for (int gi = 0; gi < EPI_XD; ++gi) EPIX_LOAD(gi);
#pragma unroll
        for (int ai = 0; ai < 2; ++ai)
#pragma unroll
            for (int m = 0; m < 4; ++m) {
                const int rl = ai * 128 + wr * 64 + m * 16 + fr; const size_t r = (size_t)u.pm * 256 + rl;
                float s = 0.f;
                f32x4 xc[2][2];
#pragma unroll
                for (int bj = 0; bj < 2; ++bj)
#pragma unroll
                    for (int n = 0; n < 2; ++n) xc[bj][n] = xq[(ai * 4 + m) % EPI_XD][bj][n];
                if (ai * 4 + m + EPI_XD < 8) EPIX_LOAD(ai * 4 + m + EPI_XD);
#pragma unroll
                for (int bj = 0; bj < 2; ++bj) {
                    f32x4 x1[2];
#pragma unroll
                    for (int n = 0; n < 2; ++n) {
                        const f32x4 xr = xc[bj][n];
                        x1[n] = xr + gv[bj][n] * acc[ai][bj][m][n];
                        s += (x1[n][0] * x1[n][0] + x1[n][1] * x1[n][1]) + (x1[n][2] * x1[n][2] + x1[n][3] * x1[n][3]);
                    }
                    { u32x4 xw; xw.x = pk2(x1[0][0], x1[0][1]); xw.y = pk2(x1[0][2], x1[0][3]); xw.z = pk2(x1[1][0], x1[1][1]); xw.w = pk2(x1[1][2], x1[1][3]);
                      NT_STORE((u32x4*)(xout + r * DM + col0 + bj * 128), xw); }
                    if (Anext) { const f32x4 a0 = x1[0] * gs[bj][0], a1 = x1[1] * gs[bj][1];
                        u32x4 w; w.x = pk2(a0[0], a0[1]); w.y = pk2(a0[2], a0[3]); w.z = pk2(a1[0], a1[1]); w.w = pk2(a1[2], a1[3]);
                        NT_STORE((u32x4*)(Anext + r * DM + col0 + bj * 128), w); }
                }
                s += __shfl_xor(s, 16); s += __shfl_xor(s, 32);
                if (fq == 0) Pp[rl * 4 + wc] = s;
            }
        __syncthreads();
        const int tid = wid * 64 + lane;
        if (tid < 256) ssq[((size_t)u.pm * 256 + tid) * 4 + u.pn] = (Pp[tid * 4 + 0] + Pp[tid * 4 + 1]) + (Pp[tid * 4 + 2] + Pp[tid * 4 + 3]);
        __syncthreads();
    }
};

struct EpiXF {
    static constexpr bool PERM = true, AFTER_DRAIN = true;
    const bf16* xres; float* out; const float* gate; const float* fg; float* ssq; unsigned* cnt;
    __device__ __forceinline__ void fused(pg8::f32x4 (&acc)[2][2][4][2], const pg8::Unit& u, int wr, int wc, int fr, int fq, LAS unsigned char* lds, int wid, int lane) const {
        const int b = u.pm >> 3, col0 = u.pn * 256 + wc * 32 + 8 * fq, tid = wid * 64 + lane;
        LAS float* Pp = (LAS float*)lds;
        LAS float* Sr = (LAS float*)(lds + 4096);
        {
            f32x4 gv[2][2];
#pragma unroll
            for (int bj = 0; bj < 2; ++bj)
#pragma unroll
                for (int n = 0; n < 2; ++n) gv[bj][n] = *(const f32x4*)(gate + b * 3072 + col0 + bj * 128 + 4 * n);
#pragma unroll
            for (int ai = 0; ai < 2; ++ai)
#pragma unroll
                for (int m = 0; m < 4; ++m) {
                    const int rl = ai * 128 + wr * 64 + m * 16 + fr; const size_t r = (size_t)u.pm * 256 + rl;
                    float s = 0.f;
#pragma unroll
                    for (int bj = 0; bj < 2; ++bj) {
                        const u32x4 xw = *(const u32x4*)(xres + r * DM + col0 + bj * 128);
#pragma unroll
                        for (int n = 0; n < 2; ++n) {
                            const unsigned w0 = n ? xw.z : xw.x, w1 = n ? xw.w : xw.y;
                            const f32x4 xr = {__uint_as_float(w0 << 16), __uint_as_float(w0 & 0xffff0000u), __uint_as_float(w1 << 16), __uint_as_float(w1 & 0xffff0000u)};
                            const f32x4 x1 = xr + gv[bj][n] * acc[ai][bj][m][n];
                            acc[ai][bj][m][n] = x1;
                            s += (x1[0] * x1[0] + x1[1] * x1[1]) + (x1[2] * x1[2] + x1[3] * x1[3]);
                        }
                    }
                    s += __shfl_xor(s, 16); s += __shfl_xor(s, 32);
                    if (fq == 0) Pp[rl * 4 + wc] = s;
                }
        }
        __syncthreads();
        if (tid < 256) { const float tot = (Pp[tid * 4 + 0] + Pp[tid * 4 + 1]) + (Pp[tid * 4 + 2] + Pp[tid * 4 + 3]);
            __hip_atomic_store(ssq + ((size_t)u.pm * 256 + tid) * 4 + u.pn, tot, __ATOMIC_RELAXED, __HIP_MEMORY_SCOPE_AGENT); }
        asm volatile("s_waitcnt vmcnt(0)" ::: "memory");
        __syncthreads();
        if (tid == 0) {
            unsigned* c = cnt + 64 * u.pm;
            __hip_atomic_fetch_add(c, 1u, __ATOMIC_RELAXED, __HIP_MEMORY_SCOPE_AGENT);
            unsigned spins = 0u;
            while (__hip_atomic_load(c, __ATOMIC_RELAXED, __HIP_MEMORY_SCOPE_AGENT) < 4u) { __builtin_amdgcn_s_sleep(2); if (++spins > (1u << 22)) break; }
            __builtin_amdgcn_fence(__ATOMIC_ACQUIRE, "agent");
            asm volatile("s_waitcnt vmcnt(0)" ::: "memory");
        }
        __syncthreads();
        if (tid < 256) { const float* sp = ssq + ((size_t)u.pm * 256 + tid) * 4;
            const float q0 = __hip_atomic_load(sp + 0, __ATOMIC_RELAXED, __HIP_MEMORY_SCOPE_AGENT), q1 = __hip_atomic_load(sp + 1, __ATOMIC_RELAXED, __HIP_MEMORY_SCOPE_AGENT);
            const float q2 = __hip_atomic_load(sp + 2, __ATOMIC_RELAXED, __HIP_MEMORY_SCOPE_AGENT), q3 = __hip_atomic_load(sp + 3, __ATOMIC_RELAXED, __HIP_MEMORY_SCOPE_AGENT);
            Sr[tid] = 1.0f / sqrtf(((q0 + q1) + (q2 + q3)) * (1.0f / 1024.0f) + EPS); }
        __syncthreads();
        f32x4 fgv[2][2];
#pragma unroll
        for (int bj = 0; bj < 2; ++bj)
#pragma unroll
            for (int n = 0; n < 2; ++n) fgv[bj][n] = *(const f32x4*)(fg + col0 + bj * 128 + 4 * n);
#pragma unroll
        for (int ai = 0; ai < 2; ++ai)
#pragma unroll
            for (int m = 0; m < 4; ++m) {
                const int rl = ai * 128 + wr * 64 + m * 16 + fr; const size_t r = (size_t)u.pm * 256 + rl; const float rstd = Sr[rl];
#pragma unroll
                for (int bj = 0; bj < 2; ++bj)
#pragma unroll
                    for (int n = 0; n < 2; ++n) NT_STORE((f32x4*)(out + r * DM + col0 + bj * 128 + 4 * n), acc[ai][bj][m][n] * rstd * fgv[bj][n]);
            }
        __syncthreads();
    }
};

#ifndef PRO_KC
#define PRO_KC 64
#endif
#ifndef TRQ
#define TRQ 4
#endif
__device__ __forceinline__ void ph0_prologue(const P& p, LAS unsigned char* lds) {
    const int tid = threadIdx.x, lane = tid & 63, wave = tid >> 6, G = gridDim.x, wg = blockIdx.x;
    LAS float* fl = (LAS float*)lds;
    for (int u = wg; u < 96; u += G) {
        const int l = u / 48, j = (u % 48) * 64 + lane;
        { float cv[16];
#pragma unroll
          for (int i = 0; i < 16; ++i) cv[i] = p.c[tid + 512 * i];
#pragma unroll
          for (int i = 0; i < 16; ++i) fl[tid + 512 * i] = siluf(cv[i]); }
        __syncthreads();
        float acc[8];
#pragma unroll
        for (int b = 0; b < 8; ++b) acc[b] = 0.f;
        const float* w = p.ada_w + ((size_t)l * 1024 + wave * 128) * 3072 + j;
#pragma unroll 1
        for (int k0 = 0; k0 < 128; k0 += PRO_KC) { float wv[PRO_KC];
#pragma unroll
          for (int k = 0; k < PRO_KC; ++k) wv[k] = w[(size_t)(k0 + k) * 3072];
#pragma unroll
          for (int k = 0; k < PRO_KC; ++k) {
#pragma unroll
            for (int b = 0; b < 8; ++b) acc[b] += fl[b * 1024 + wave * 128 + k0 + k] * wv[k]; } }
#pragma unroll
        for (int b = 0; b < 8; ++b) fl[8192 + (wave * 8 + b) * 64 + lane] = acc[b];
        __syncthreads();
        { const int b = wave; float s = p.ada_b[l * 3072 + j];
#pragma unroll
          for (int w8 = 0; w8 < 8; ++w8) s += fl[8192 + (w8 * 8 + b) * 64 + lane];
          p.mod[(l * 8 + b) * 3072 + j] = s; }
        __syncthreads();
    }
    const int GT = (G > 96) ? G - 96 : G, wt = (G > 96) ? wg - 96 : wg;
    if (wt >= 0)
#pragma unroll 1
    for (int u0 = wt; u0 < 1920; u0 += TRQ * GT) {
        float v[TRQ][8]; bf16* dst[TRQ]; bool act[TRQ];
#pragma unroll
        for (int q = 0; q < TRQ; ++q) {
            const int u = u0 + q * GT; act[q] = u < 1920; dst[q] = nullptr;
#pragma unroll
            for (int j = 0; j < 8; ++j) v[q][j] = 0.f;
            if (act[q]) {
                const float* W; bf16* WT; int N, kt, nt;
                if (u < 1408) { const int l = u / 704, r = u % 704; kt = r / 44; nt = r % 44; W = p.w_in + (size_t)l * 1024 * D_INR; N = D_INR; WT = p.wt_in + (size_t)l * ZP * 1024; }
                else { int r = u - 1408; const int l = r / 256; r %= 256; kt = r / 16; nt = r % 16; W = p.w_out + (size_t)l * 1024 * 1024; N = 1024; WT = p.wt_out + (size_t)l * 1024 * 1024; }
                const int n = nt * 64 + lane, k0 = kt * 64 + wave * 8;
                if (n < N) {
#pragma unroll
                    for (int j = 0; j < 8; ++j) v[q][j] = W[(size_t)(k0 + j) * N + n];
                }
                dst[q] = WT + (size_t)n * 1024 + k0;
            }
        }
#pragma unroll
        for (int q = 0; q < TRQ; ++q) if (act[q]) { u32x4 o; o.x = pk2(v[q][0], v[q][1]); o.y = pk2(v[q][2], v[q][3]); o.z = pk2(v[q][4], v[q][5]); o.w = pk2(v[q][6], v[q][7]); *(u32x4*)dst[q] = o; }
    }
}
__device__ __forceinline__ void ph1_prologue(const P& p, LAS unsigned char* lds) {
    const int tid = threadIdx.x, lane = tid & 63, wave = tid >> 6, G = gridDim.x, wg = blockIdx.x;
    LAS float* fl = (LAS float*)lds;
    for (int u = wg; u < 88; u += G) {
        const int l = u / 44, n = (u % 44) * 64 + lane;
        { float mv[16];
#pragma unroll
          for (int i = 0; i < 16; ++i) { const int e = tid + 512 * i; mv[i] = p.mod[(l * 8 + (e >> 10)) * 3072 + (e & 1023)]; }
#pragma unroll
          for (int i = 0; i < 16; ++i) fl[tid + 512 * i] = mv[i]; }
        __syncthreads();
        float acc[8];
#pragma unroll
        for (int b = 0; b < 8; ++b) acc[b] = 0.f;
        if (n < D_INR) { const float* w = p.w_in + ((size_t)l * 1024 + wave * 128) * D_INR + n;
#pragma unroll 1
            for (int k0 = 0; k0 < 128; k0 += PRO_KC) { float wv[PRO_KC];
#pragma unroll
              for (int k = 0; k < PRO_KC; ++k) wv[k] = w[(size_t)(k0 + k) * D_INR];
#pragma unroll
              for (int k = 0; k < PRO_KC; ++k) {
#pragma unroll
                for (int b = 0; b < 8; ++b) acc[b] += fl[b * 1024 + wave * 128 + k0 + k] * wv[k]; } } }
#pragma unroll
        for (int b = 0; b < 8; ++b) fl[8192 + (wave * 8 + b) * 64 + lane] = acc[b];
        __syncthreads();
        { const int b = wave; float s = 0.f;
#pragma unroll
          for (int w8 = 0; w8 < 8; ++w8) s += fl[8192 + (w8 * 8 + b) * 64 + lane];
          p.bias[(l * 8 + b) * ZP + n] = s; }
        __syncthreads();
    }
    {
        const int r0 = wg * 8 + wave, rstep = G * 8;
        f32x4 gq[4], xv[2][2][4], sv[2][2][4];
#pragma unroll
        for (int j = 0; j < 4; ++j) gq[j] = *(const f32x4*)(p.norm_g + (lane + 64 * j) * 4);
#define A0_LOAD(slot, pr) do { _Pragma("unroll") for (int h_ = 0; h_ < 2; ++h_) _Pragma("unroll") for (int j = 0; j < 4; ++j) { const int k_ = (lane + 64 * j) * 4, r_ = r0 + rstep * (2 * (pr) + h_); \
            xv[slot][h_][j] = *(const f32x4*)(p.x + (size_t)r_ * DM + k_); sv[slot][h_][j] = *(const f32x4*)(p.mod + (size_t)(r_ >> 11) * 3072 + 1024 + k_); } } while (0)
        A0_LOAD(0, 0);
#pragma unroll
        for (int pr = 0; pr < 4; ++pr) {
            if (pr + 1 < 4) A0_LOAD((pr + 1) & 1, pr + 1);
#pragma unroll
            for (int h = 0; h < 2; ++h) {
                const int r = r0 + rstep * (2 * pr + h); float s1 = 0.f;
#pragma unroll
                for (int j = 0; j < 4; ++j) { const int k = (lane + 64 * j) * 4; const f32x4 v = xv[pr & 1][h][j];
                    s1 += (v[0] * v[0] + v[1] * v[1]) + (v[2] * v[2] + v[3] * v[3]);
                    const f32x4 o1 = v * gq[j] * (sv[pr & 1][h][j] + 1.0f);
                    u32x2 w1; w1.x = pk2(o1[0], o1[1]); w1.y = pk2(o1[2], o1[3]);
                    *(u32x2*)(p.A + (size_t)r * DM + k) = w1; }
                s1 = wave_sum(s1);
                if (lane == 0) *(f32x4*)(p.ssq + (size_t)r * 4) = (f32x4){s1, 0.f, 0.f, 0.f};
            }
        }
#undef A0_LOAD
    }
}
__device__ __forceinline__ void ph_final(const P& p) {
    const int tid = threadIdx.x, lane = tid & 63, wave = tid >> 6, G = gridDim.x, wg = blockIdx.x;
    for (int r = wg * 8 + wave; r < MROWS; r += G * 8) {
        const f32x4 q = *(const f32x4*)(p.ssq + (size_t)r * 4);
        const float rstd = 1.0f / sqrtf(((q.x + q.y) + (q.z + q.w)) * (1.0f / 1024.0f) + EPS);
#pragma unroll
        for (int j = 0; j < 4; ++j) { const int k = (lane + 64 * j) * 4;
            const f32x4 v = *(const f32x4*)(p.out + (size_t)r * DM + k), g = *(const f32x4*)(p.final_g + k);
            *(f32x4*)(p.out + (size_t)r * DM + k) = v * rstd * g; }
    }
}
#define XB_TMO      128
#define XB_XCNT(j)  (256  + 64 * (j))
#define XB_XSUB(j)  (1280 + 64 * (j))
#define XB_XGEN(j)  (2304 + 64 * (j))
#define XB_TOP      3328
#define XB_TOPGEN   3392
#define XCD_BAR_WORDS 3456
#define XB_SPIN_CAP (1u << 18)

__device__ __forceinline__ unsigned xb_ld(unsigned* p)              { return __hip_atomic_load(p, __ATOMIC_RELAXED, __HIP_MEMORY_SCOPE_AGENT); }
__device__ __forceinline__ unsigned xb_add(unsigned* p, unsigned v) { return __hip_atomic_fetch_add(p, v, __ATOMIC_RELAXED, __HIP_MEMORY_SCOPE_AGENT); }
__device__ __forceinline__ unsigned xb_xcc_id() { return (unsigned)__builtin_amdgcn_s_getreg((3 << 11) | 20) & 0xFu; }
#define XB_SPIN(cond, bar) do { unsigned _sp = 0; while (cond) { __builtin_amdgcn_s_sleep(1); \
    if ((++_sp & 255u) == 0u) { if (xb_ld(&(bar)[XB_TMO])) break; if (_sp > XB_SPIN_CAP) { atomicAdd(&(bar)[XB_TMO], 1u); break; } } } } while (0)

struct XcdBarrier {
    unsigned* bar; unsigned x;
    volatile LAS unsigned* st;
};

__device__ __forceinline__ XcdBarrier xcd_barrier_post(unsigned* bar, volatile LAS unsigned* st) {
    XcdBarrier b; b.bar = bar; b.x = xb_xcc_id(); b.st = st;
    if (threadIdx.x == 0) (void)xb_add(&bar[XB_XCNT(b.x)], 1u);
    return b;
}
__device__ __forceinline__ void xcd_barrier_complete(unsigned* bar, unsigned x, unsigned& nloc, unsigned& nx) {
    const unsigned G = gridDim.x * gridDim.y * gridDim.z;
    unsigned sum, cnt, mine, sp = 0u;
    for (;;) {
        sum = 0u; cnt = 0u; mine = 0u;
#pragma unroll
        for (unsigned j = 0; j < 16; ++j) { const unsigned c = xb_ld(&bar[XB_XCNT(j)]); sum += c; cnt += (c > 0u) ? 1u : 0u; mine = (j == x) ? c : mine; }
        if (sum == G) break;
        __builtin_amdgcn_s_sleep(1);
        if ((++sp & 255u) == 0u) { if (xb_ld(&bar[XB_TMO])) break; if (sp > XB_SPIN_CAP) { atomicAdd(&bar[XB_TMO], 1u); break; } }
    }
    nloc = mine > 0u ? mine : 1u; nx = cnt > 0u ? cnt : 1u;
}

__device__ __forceinline__ void xcd_barrier(const XcdBarrier& b) {
    asm volatile("s_waitcnt vmcnt(0)" ::: "memory");
    __syncthreads();
    if (threadIdx.x == 0) {
        unsigned* bar = b.bar;
        __builtin_amdgcn_s_waitcnt(0);
        unsigned nloc = b.st[0], nx = b.st[1];
        if (nloc == 0u) { xcd_barrier_complete(bar, b.x, nloc, nx); b.st[0] = nloc; b.st[1] = nx; }
        const unsigned old = xb_add(&bar[XB_XSUB(b.x)], 1u);
        const unsigned gen = old / nloc;
        if (old + 1u == (gen + 1u) * nloc) {
            __builtin_amdgcn_fence(__ATOMIC_RELEASE, "agent");
            asm volatile("s_waitcnt vmcnt(0)" ::: "memory");
            const unsigned og = xb_add(&bar[XB_TOP], 1u);
            const unsigned tg = og / nx;
            if (og + 1u == (tg + 1u) * nx) xb_add(&bar[XB_TOPGEN], 1u);
            else XB_SPIN(xb_ld(&bar[XB_TOPGEN]) == tg, bar);
            __builtin_amdgcn_fence(__ATOMIC_ACQUIRE, "agent");
            xb_add(&bar[XB_XGEN(b.x)], 1u);
            asm volatile("s_waitcnt vmcnt(0)" ::: "memory");
        } else {
#ifdef XB_FLAT_RELEASE
            XB_SPIN(xb_ld(&bar[XB_TOPGEN]) == gen, bar);
#else
            XB_SPIN(xb_ld(&bar[XB_XGEN(b.x)]) == gen, bar);
#endif
            __builtin_amdgcn_fence(__ATOMIC_ACQUIRE, "agent");
            asm volatile("s_waitcnt vmcnt(0)" ::: "memory");
        }
    }
    __syncthreads();
}
__device__ __forceinline__ unsigned score_ukey(float s) { const unsigned u = __float_as_uint(s + 0.0f); return (u & 0x80000000u) ? ~u : (u | 0x80000000u); }
__device__ __forceinline__ void topk_threshold(const unsigned (&k)[32], unsigned& thr, unsigned& need) {
    unsigned prefix = 0u; bool exact = false;
    for (int bit = 31; bit >= 0; --bit) {
        const unsigned cand = prefix | (1u << bit);
        int c = 0;
#pragma unroll
        for (int i = 0; i < 32; ++i) c += (k[i] >= cand) ? 1 : 0;
        c = wave_sum_i(c);
        if (c >= TOPK) prefix = cand;
        if (c == TOPK) { exact = true; break; }
    }
    thr = prefix;
    if (exact) { need = 0xffffffffu; }
    else { int c = 0;
#pragma unroll
        for (int i = 0; i < 32; ++i) c += (k[i] > prefix) ? 1 : 0;
        c = wave_sum_i(c); need = (unsigned)(TOPK - c); }
}
#ifndef PROBE_VALU
#define PROBE_VALU 0
#endif
#ifndef RP_T3
#define RP_T3 1
#endif
#ifndef RP_T1
#define RP_T1 1
#endif
#ifndef RP_T2
#define RP_T2 1
#endif
#ifndef RP_I
#define RP_I 1
#endif
#ifndef RP_T
#define RP_T 1
#endif
#ifndef RP_V
#define RP_V 1
#endif
typedef short bf16x8v __attribute__((ext_vector_type(8)));
typedef short s16x4v __attribute__((ext_vector_type(4)));
constexpr int BMS = 65;
constexpr int SCP = 2052;
constexpr int DSA_BM_OFF = 16 * SCP * 4;
constexpr int DSA_RING_OFF = 0;
constexpr int DSA_QIB_OFF = 147456;
constexpr int DSA_WIB_OFF = 135680;
constexpr int DSA_MLUT_OFF = 143616;
__device__ __forceinline__ void glds16(const void* gsrc, unsigned lds_dst) { unsigned keep;
    asm volatile("s_mov_b32 %0, m0\n\ts_mov_b32 m0, %2\n\ts_nop 0\n\tglobal_load_lds_dwordx4 %1, off\n\ts_mov_b32 m0, %0" : "=&s"(keep) : "v"(gsrc), "s"(lds_dst) : "memory"); }
template <int I> __device__ __forceinline__ unsigned mbit_t(int mw) { unsigned r; asm("v_bfe_i32 %0, %1, %2, 1" : "=v"(r) : "v"(mw), "i"(I)); return r; }
#define mbit(mw, i) mbit_t<(i)>(mw)
__device__ __forceinline__ float relu_i(float x) { return __int_as_float(max(__float_as_int(x), 0)); }
#ifndef NO_FMAC_S
__device__ __forceinline__ float fmac_s(float a, float b, float c) { asm("v_fmac_f32_e32 %0, %1, %2" : "+v"(c) : "v"(a), "v"(b)); return c; }
#else
__device__ __forceinline__ float fmac_s(float a, float b, float c) { return a * b + c; }
#endif
__device__ __forceinline__ int imax3(float a, float b, float c) { return max(max(__float_as_int(a), __float_as_int(b)), __float_as_int(c)); }
__device__ __forceinline__ s16x4v lds_tr16(LAS const unsigned char* p) { return __builtin_bit_cast(s16x4v, __builtin_amdgcn_ds_read_tr16_b64_v4i16((LAS s16x4v*)p)); }
__device__ __forceinline__ unsigned cvtpk(float lo, float hi) { typedef float f2 __attribute__((ext_vector_type(2))); typedef __bf16 b2 __attribute__((ext_vector_type(2))); f2 v = {lo, hi}; b2 r = __builtin_convertvector(v, b2); return __builtin_bit_cast(unsigned, r); }


template <int L> __device__ __forceinline__ void wr2lanes(int& w, unsigned lo, unsigned hi) {
    asm volatile("s_nop 1\n\tv_writelane_b32 %0, %1, %3\n\tv_writelane_b32 %0, %2, %4" : "+v"(w) : "s"(lo), "s"(hi), "i"(L), "i"(L + 1));
}
__device__ __forceinline__ int wave_sum_dpp(int v) {
    v += __builtin_amdgcn_update_dpp(0, v, 0xB1, 0xf, 0xf, true);
    v += __builtin_amdgcn_update_dpp(0, v, 0x4E, 0xf, 0xf, true);
    v += __builtin_amdgcn_update_dpp(0, v, 0x141, 0xf, 0xf, true);
    v += __builtin_amdgcn_update_dpp(0, v, 0x140, 0xf, 0xf, true);
    return __builtin_amdgcn_readlane(v, 0) + __builtin_amdgcn_readlane(v, 16) + __builtin_amdgcn_readlane(v, 32) + __builtin_amdgcn_readlane(v, 48);
}
__device__ __forceinline__ unsigned wave_max_dpp(unsigned v) {
    v = max(v, (unsigned)__builtin_amdgcn_update_dpp(0, (int)v, 0xB1, 0xf, 0xf, true));
    v = max(v, (unsigned)__builtin_amdgcn_update_dpp(0, (int)v, 0x4E, 0xf, 0xf, true));
    v = max(v, (unsigned)__builtin_amdgcn_update_dpp(0, (int)v, 0x141, 0xf, 0xf, true));
    v = max(v, (unsigned)__builtin_amdgcn_update_dpp(0, (int)v, 0x140, 0xf, 0xf, true));
    return max(max((unsigned)__builtin_amdgcn_readlane((int)v, 0), (unsigned)__builtin_amdgcn_readlane((int)v, 16)), max((unsigned)__builtin_amdgcn_readlane((int)v, 32), (unsigned)__builtin_amdgcn_readlane((int)v, 48)));
}
__device__ __forceinline__ void cnt8(int& a0, int& a1, int& a2, int& a3, unsigned cand, unsigned k0, unsigned k1, unsigned k2, unsigned k3, unsigned k4, unsigned k5, unsigned k6, unsigned k7) {
    unsigned long long m0, m1, m2, m3, m4, m5, m6, m7;
    asm volatile("v_cmp_le_u32_e64 %4, %12, %13\n\tv_cmp_le_u32_e64 %5, %12, %14\n\tv_cmp_le_u32_e64 %6, %12, %15\n\tv_cmp_le_u32_e64 %7, %12, %16\n\t"
                 "v_cmp_le_u32_e64 %8, %12, %17\n\tv_cmp_le_u32_e64 %9, %12, %18\n\tv_cmp_le_u32_e64 %10, %12, %19\n\tv_cmp_le_u32_e64 %11, %12, %20\n\t"
                 "v_addc_co_u32_e64 %0, %4, 0, %0, %4\n\tv_addc_co_u32_e64 %1, %5, 0, %1, %5\n\tv_addc_co_u32_e64 %2, %6, 0, %2, %6\n\tv_addc_co_u32_e64 %3, %7, 0, %3, %7\n\t"
                 "v_addc_co_u32_e64 %0, %8, 0, %0, %8\n\tv_addc_co_u32_e64 %1, %9, 0, %1, %9\n\tv_addc_co_u32_e64 %2, %10, 0, %2, %10\n\tv_addc_co_u32_e64 %3, %11, 0, %3, %11"
                 : "+v"(a0), "+v"(a1), "+v"(a2), "+v"(a3), "=&s"(m0), "=&s"(m1), "=&s"(m2), "=&s"(m3), "=&s"(m4), "=&s"(m5), "=&s"(m6), "=&s"(m7)
                 : "s"(cand), "v"(k0), "v"(k1), "v"(k2), "v"(k3), "v"(k4), "v"(k5), "v"(k6), "v"(k7));
}
__device__ __forceinline__ int count_ge(const unsigned (&k)[32], unsigned cand_, int nb) {
    const unsigned cand = (unsigned)__builtin_amdgcn_readfirstlane((int)cand_);
    int a0 = 0, a1 = 0, a2 = 0, a3 = 0;
    cnt8(a0, a1, a2, a3, cand, k[0], k[1], k[2], k[3], k[4], k[5], k[6], k[7]);
    if (nb > 1) cnt8(a0, a1, a2, a3, cand, k[8], k[9], k[10], k[11], k[12], k[13], k[14], k[15]);
    if (nb > 2) cnt8(a0, a1, a2, a3, cand, k[16], k[17], k[18], k[19], k[20], k[21], k[22], k[23]);
    if (nb > 3) cnt8(a0, a1, a2, a3, cand, k[24], k[25], k[26], k[27], k[28], k[29], k[30], k[31]);
    return wave_sum_dpp((a0 + a1) + (a2 + a3));
}
__device__ __forceinline__ int wave_scan_dpp(int v) {
    v += __builtin_amdgcn_update_dpp(0, v, 0x111, 0xf, 0xf, false);
    v += __builtin_amdgcn_update_dpp(0, v, 0x112, 0xf, 0xf, false);
    v += __builtin_amdgcn_update_dpp(0, v, 0x114, 0xf, 0xf, false);
    v += __builtin_amdgcn_update_dpp(0, v, 0x118, 0xf, 0xf, false);
    v += __builtin_amdgcn_update_dpp(0, v, 0x142, 0xa, 0xf, false);
    v += __builtin_amdgcn_update_dpp(0, v, 0x143, 0xc, 0xf, false);
    return v;
}
#ifndef WALK_MAX
#define WALK_MAX 4
#endif
#ifndef HIST_WAVES
#define HIST_WAVES 4
#endif
struct TopkState { unsigned prefix; int bit; bool done; unsigned need; int nb; LAS unsigned* hist; int crej; };
#ifndef HB_BITS
#define HB_BITS 8
#endif
__device__ __forceinline__ void topk_hist(const unsigned (&k)[32], TopkState& st, int c_above) {
    constexpr int NBIN = 1 << HB_BITS, BPL = NBIN / 64, SH = 23 - HB_BITS;
    const int lane = threadIdx.x & 63;
    const unsigned T = (unsigned)__builtin_amdgcn_readfirstlane((int)st.prefix);
    LAS unsigned* hist = st.hist;
#pragma unroll
    for (int q = 0; q < BPL / 4; ++q) *(LAS u32x4*)(hist + BPL * lane + 4 * q) = (u32x4){0u, 0u, 0u, 0u};
    asm volatile("" ::: "memory");
    const unsigned hb_ = (unsigned)(uintptr_t)hist; const unsigned one = 1u;
#define HF1(K) "v_subrev_u32_e32 %0, %2, " K "\n\tv_lshrrev_b32_e32 %0, %13, %0\n\tv_cmpx_gt_u32_e32 vcc, %14, %0\n\tv_lshl_add_u32 %0, %0, 2, %3\n\tds_add_u32 %0, %4\n\ts_mov_b64 exec, %1\n\t"
#define HF8(i0) { unsigned t0_; unsigned long long ex_; \
        asm volatile("s_mov_b64 %1, exec\n\t" HF1("%5") HF1("%6") HF1("%7") HF1("%8") HF1("%9") HF1("%10") HF1("%11") HF1("%12") "s_nop 0" \
            : "=&v"(t0_), "=&s"(ex_) : "s"(T), "s"(hb_), "v"(one), "v"(k[i0]), "v"(k[i0 + 1]), "v"(k[i0 + 2]), "v"(k[i0 + 3]), "v"(k[i0 + 4]), "v"(k[i0 + 5]), "v"(k[i0 + 6]), "v"(k[i0 + 7]), "i"(SH), "i"(NBIN) : "vcc", "memory"); }
    HF8(0)
    if (st.nb > 1) HF8(8)
    if (st.nb > 2) HF8(16)
    if (st.nb > 3) HF8(24)
#undef HF8
#undef HF1
    asm volatile("" ::: "memory");
    u32x4 w[BPL / 4]; int t = 0;
#pragma unroll
    for (int q = 0; q < BPL / 4; ++q) { w[q] = *(LAS const u32x4*)(hist + BPL * (63 - lane) + 4 * q); t += (int)((w[q].x + w[q].y) + (w[q].z + w[q].w)); }
    const int P = wave_scan_dpp(t);
    const int k1 = TOPK - c_above;
    const unsigned long long bal = __ballot(P >= k1);
    const int Ls = __builtin_ctzll(bal);
    int c = __builtin_amdgcn_readlane(P, Ls) - __builtin_amdgcn_readlane(t, Ls);
    int bsel = 0, hb = 0; bool found = false;
#pragma unroll
    for (int j = BPL - 1; j >= 0; --j) {
        if (!found) { const int h_ = __builtin_amdgcn_readlane((int)w[j >> 2][j & 3], Ls); if (c + h_ >= k1) { bsel = j; hb = h_; found = true; } else c += h_; }
    }
    const unsigned bin = (unsigned)(BPL * (63 - Ls) + bsel);
    st.prefix = T | (bin << SH); st.bit = SH - 1;
    if (c + hb == k1) { st.done = true; st.need = 0xffffffffu; }
#ifndef NO_TOPK_GATHER
    else if (hb <= 64) {
        const unsigned Pf = (unsigned)__builtin_amdgcn_readfirstlane((int)st.prefix);
        const int k2 = k1 - c;
        LAS unsigned* list = hist;
        int base = 0;
#define GT1(i) { const bool p_ = (k[i] - Pf) < (1u << SH); const unsigned long long m_ = __ballot(p_); \
            if (m_ != 0ull) { const int r_ = base + (int)__builtin_amdgcn_mbcnt_hi((unsigned)(m_ >> 32), __builtin_amdgcn_mbcnt_lo((unsigned)m_, 0u)); if (p_) list[r_] = k[i]; base += __popcll(m_); } }
#define GT4(i0) { const unsigned dm_ = min(min(k[i0] - Pf, k[i0 + 1] - Pf), min(k[i0 + 2] - Pf, k[i0 + 3] - Pf)); \
            if (__ballot(dm_ < (1u << SH)) != 0ull) { GT1(i0) GT1(i0 + 1) GT1(i0 + 2) GT1(i0 + 3) } }
        GT4(0) GT4(4)
        if (st.nb > 1) { GT4(8) GT4(12) }
        if (st.nb > 2) { GT4(16) GT4(20) }
        if (st.nb > 3) { GT4(24) GT4(28) }
#undef GT4
#undef GT1
        asm volatile("" ::: "memory");
        const unsigned v = (lane < hb) ? list[lane] : 0u;
        int g = 0, ge = 0;
#pragma unroll 1
        for (int j = 0; j < hb; ++j) { const unsigned s_ = (unsigned)__builtin_amdgcn_readlane((int)v, j); g += (s_ > v) ? 1 : 0; ge += (s_ >= v) ? 1 : 0; }
        const unsigned long long hit = __ballot(lane < hb && g < k2 && ge >= k2);
        if (hit != 0ull) {
            const int Lh = __builtin_ctzll(hit);
            const int gs = __builtin_amdgcn_readlane(g, Lh), ges = __builtin_amdgcn_readlane(ge, Lh);
            st.prefix = (unsigned)__builtin_amdgcn_readlane((int)v, Lh); st.done = true;
            st.need = (ges - gs == k2 - gs) ? 0xffffffffu : (unsigned)(k2 - gs);
        }
    }
#endif
}
__device__ __forceinline__ bool topk_histE(const unsigned (&k)[32], TopkState& st, unsigned Etop_, int k1, int cbase) {
    const int lane = threadIdx.x & 63;
    const unsigned Etop = (unsigned)__builtin_amdgcn_readfirstlane((int)Etop_);
    LAS unsigned* hist = st.hist;
    *(LAS u32x4*)(hist + 8 * lane) = (u32x4){0u, 0u, 0u, 0u}; *(LAS u32x4*)(hist + 8 * lane + 4) = (u32x4){0u, 0u, 0u, 0u};
    asm volatile("" ::: "memory");
    const unsigned hb_ = (unsigned)(uintptr_t)hist, one = 1u, l7 = (unsigned)lane & 7u;
#define HE1(K) "v_lshrrev_b32_e32 %0, 23, " K "\n\tv_sub_u32_e32 %0, %2, %0\n\tv_cmpx_gt_u32_e32 vcc, 64, %0\n\tv_lshl_or_b32 %0, %0, 3, %5\n\tv_lshl_add_u32 %0, %0, 2, %3\n\tds_add_u32 %0, %4\n\ts_mov_b64 exec, %1\n\t"
#define HE8(i0) { unsigned t0_; unsigned long long ex_; \
        asm volatile("s_mov_b64 %1, exec\n\t" HE1("%6") HE1("%7") HE1("%8") HE1("%9") HE1("%10") HE1("%11") HE1("%12") HE1("%13") "s_nop 0" \
            : "=&v"(t0_), "=&s"(ex_) : "s"(Etop), "s"(hb_), "v"(one), "v"(l7), "v"(k[i0]), "v"(k[i0 + 1]), "v"(k[i0 + 2]), "v"(k[i0 + 3]), "v"(k[i0 + 4]), "v"(k[i0 + 5]), "v"(k[i0 + 6]), "v"(k[i0 + 7]) : "vcc", "memory"); }
    HE8(0)
    if (st.nb > 1) HE8(8)
    if (st.nb > 2) HE8(16)
    if (st.nb > 3) HE8(24)
#undef HE8
#undef HE1
    asm volatile("" ::: "memory");
    const u32x4 w0 = *(LAS const u32x4*)(hist + 8 * lane), w1 = *(LAS const u32x4*)(hist + 8 * lane + 4);
    const int t = (int)(((w0.x + w0.y) + (w0.z + w0.w)) + ((w1.x + w1.y) + (w1.z + w1.w)));
    const int P = wave_scan_dpp(t);
    const unsigned long long bal = __ballot(P >= k1);
    if (bal == 0ull) return false;
    const int Ls = __builtin_ctzll(bal);
    const int S = __builtin_amdgcn_readlane(P, Ls), cab = S - __builtin_amdgcn_readlane(t, Ls);
    st.prefix = (Etop - (unsigned)Ls) << 23; st.bit = 22; st.crej = cbase + cab;
    if (S == k1) { st.done = true; st.need = 0xffffffffu; }
    return true;
}
__device__ __forceinline__ void topk_init(const unsigned (&k)[32], TopkState& st) {
    unsigned mx = 0u;
#pragma unroll
    for (int i = 0; i < 32; ++i) mx = max(mx, k[i]);
    mx = wave_max_dpp(mx);
    st.prefix = 0u; st.bit = 31; st.done = false; st.need = 0u; st.crej = 0;
    const unsigned E = mx >> 23;
    bool ok = false;
    if (E >= 320u) ok = topk_histE(k, st, E, TOPK, 0);
    if (!ok) {
        const int npos = (E >= 256u) ? count_ge(k, 0x80000000u, st.nb) : 0;
        if (npos < TOPK) {
            unsigned mn = 0u;
#pragma unroll
            for (int i = 0; i < 32; ++i) mn = max(mn, k[i] & ~(unsigned)((int)k[i] >> 31));
            mn = wave_max_dpp(mn);
            const unsigned En = mn >> 23;
            if (En >= 64u) ok = topk_histE(k, st, En, TOPK - npos, npos);
        }
    }
    if (ok && !st.done) topk_hist(k, st, st.crej);
}
__device__ __forceinline__ void topk_step(const unsigned (&k)[32], TopkState& st) {
    if (st.done) return;
    if (st.bit < 0) { int c = 0;
#pragma unroll
        for (int i = 0; i < 32; ++i) c += (k[i] > st.prefix) ? 1 : 0;
        c = wave_sum_dpp(c); st.need = (unsigned)(TOPK - c); st.done = true; return; }
    const unsigned cand = st.prefix | (1u << st.bit);
    const int c = count_ge(k, cand, st.nb);
    if (c >= TOPK) st.prefix = cand; else st.crej = c;
    if (c == TOPK) { st.done = true; st.need = 0xffffffffu; }
    --st.bit;
#ifndef NO_TOPK_HIST
    if (st.bit == 22 && !st.done && st.hist) topk_hist(k, st, st.crej);
#endif
}

__device__ __forceinline__ void dsa_prefetch_qi(const bf16* zb, int qt, LAS unsigned char* lds, int wave, int lane) {
    const unsigned lds_base = (unsigned)(uintptr_t)lds;
#pragma unroll
    for (int i = 0; i < 2; ++i) { const int row = 2 * wave + i;
        glds16(zb + (size_t)(qt * 16 + row) * ZP + C_QI + ((lane ^ row) * 8), (unsigned)__builtin_amdgcn_readfirstlane(lds_base + DSA_QIB_OFF + row * 1024)); }
    if (wave == 0) glds16(zb + (size_t)(qt * 16 + (lane & 15)) * ZP + C_WI, (unsigned)__builtin_amdgcn_readfirstlane(lds_base + DSA_WIB_OFF));
}

__device__ __forceinline__ void dsa_prefetch_ki(const bf16* zb, int qt, bf16x8v (&pk)[4], int wave, int lane) {
    const int r16 = lane & 15, g = lane >> 4;
    if (wave <= qt) { const bf16* krow = zb + (size_t)(wave * 16 + r16) * ZP + C_KI; pk[0] = *(const bf16x8v*)(krow + 8 * g); pk[1] = *(const bf16x8v*)(krow + 32 + 8 * g); }
    if (wave + 8 <= qt) { const bf16* krow = zb + (size_t)((wave + 8) * 16 + r16) * ZP + C_KI; pk[2] = *(const bf16x8v*)(krow + 8 * g); pk[3] = *(const bf16x8v*)(krow + 32 + 8 * g); }
}

__device__ __forceinline__ void dsa_unit(const P& p, int b, int qt, int qt_next, bf16x8v (&pk)[4], LAS unsigned char* lds) {
    const int tid = threadIdx.x, lane = tid & 63, wave = __builtin_amdgcn_readfirstlane(tid >> 6), r16 = lane & 15, g = lane >> 4;
    const int q0 = qt * 16; const bf16* zb = p.Z + (size_t)b * SEQ * ZP;
    LAS float* SC = (LAS float*)lds; LAS unsigned* BM = (LAS unsigned*)(lds + DSA_BM_OFF);
    const bool dense_all = (qt < TOPK / 16);
    const bf16* qrow = zb + (size_t)(q0 + r16) * ZP;
    const bf16x8v bq0 = *(const bf16x8v*)(qrow + C_Q + wave * 64 + 8 * g), bq1 = *(const bf16x8v*)(qrow + C_Q + wave * 64 + 32 + 8 * g);
    u32x2 gwv[4];
#pragma unroll
    for (int dt = 0; dt < 4; ++dt) gwv[dt] = *(const u32x2*)(qrow + C_GA + wave * 64 + dt * 16 + 4 * g);
    const int nsteps = (((q0 + 16 + 31) >> 5) + 1) & ~1, nmega = (nsteps + 7) >> 3;
    const int kkey = lane >> 3, vkey = lane >> 1, vhalf = lane & 1;
    const unsigned lds_base = (unsigned)(uintptr_t)lds;
#define DSA_STAGE(mm) do { const int st_ = (mm) * 8 + wave; if (st_ < nsteps) { \
        const bf16* kb_ = zb + (size_t)st_ * 32 * ZP; const unsigned ldsb_ = lds_base + (unsigned)(((mm) & 1) * 65536 + wave * 4096); \
        _Pragma("unroll") for (int c_ = 0; c_ < 4; ++c_) { const int key_ = 8 * c_ + kkey, ch_ = (lane & 7) ^ ((key_ & 15) >> 1); \
            glds16(kb_ + (size_t)key_ * ZP + C_K + ch_ * 8, (unsigned)__builtin_amdgcn_readfirstlane(ldsb_ + c_ * 1024)); } \
        _Pragma("unroll") for (int c_ = 0; c_ < 4; ++c_) \
            glds16(kb_ + (size_t)vkey * ZP + C_V + c_ * 16 + vhalf * 8, (unsigned)__builtin_amdgcn_readfirstlane(ldsb_ + 32768 + c_ * 1024)); } } while (0)
    if (!dense_all) {
        for (int rpI = 0; rpI < RP_I; ++rpI) {
        bf16x8v bq[8][2]; float wv[8];
#pragma unroll
        for (int h = 0; h < 8; ++h) { bq[h][0] = *(LAS const bf16x8v*)(lds + DSA_QIB_OFF + r16 * 1024 + (((8 * h + g) ^ r16) * 16)); bq[h][1] = *(LAS const bf16x8v*)(lds + DSA_QIB_OFF + r16 * 1024 + (((8 * h + 4 + g) ^ r16) * 16));
            wv[h] = bf2f(*(LAS const bf16*)(lds + DSA_WIB_OFF + r16 * 16 + h * 2)) * 0.35355339059327373f * 0.125f; }
        bf16x8v ra0 = pk[0], ra1 = pk[1], rb0 = pk[2], rb1 = pk[3], rc0 = pk[0], rc1 = pk[1];
#define IDX_LOAD(d0, d1, ktl) do { const int ktl_ = (ktl) <= qt ? (ktl) : qt;        \
            const bf16* krow_ = zb + (size_t)(ktl_ * 16 + r16) * ZP + C_KI; d0 = *(const bf16x8v*)(krow_ + 8 * g); d1 = *(const bf16x8v*)(krow_ + 32 + 8 * g); } while (0)
#define IDX_STEP(c0, c1) do { \
            f32x4 sc = {0.f, 0.f, 0.f, 0.f}; \
            _Pragma("unroll") for (int h = 0; h < 8; ++h) { \
                f32x4 acc = {0.f, 0.f, 0.f, 0.f}; \
                acc = __builtin_amdgcn_mfma_f32_16x16x32_bf16(c0, bq[h][0], acc, 0, 0, 0); \
                acc = __builtin_amdgcn_mfma_f32_16x16x32_bf16(c1, bq[h][1], acc, 0, 0, 0); \
                _Pragma("unroll") for (int i = 0; i < 4; ++i) sc[i] = fmac_s(relu_i(acc[i]), wv[h], sc[i]); \
            } \
            if (__builtin_amdgcn_readfirstlane(kt) == qt) {                  \
                _Pragma("unroll") for (int i = 0; i < 4; ++i) sc[i] = (4 * g + i > r16) ? -INFINITY : sc[i]; \
            } \
            *(LAS f32x4*)(SC + r16 * SCP + kt * 16 + 4 * g) = sc; } while (0)
        int kt = wave;
        const int nst = (qt - wave + 8) >> 3;
        const int ntrip = (nst * 11) >> 5, rem = nst - 3 * ntrip;
#pragma unroll 1
        for (int it = ntrip; it > 0; --it) {
            IDX_LOAD(rc0, rc1, kt + 16); __builtin_amdgcn_sched_barrier(0); IDX_STEP(ra0, ra1); __builtin_amdgcn_sched_barrier(0); kt += 8;
            IDX_LOAD(ra0, ra1, kt + 16); __builtin_amdgcn_sched_barrier(0); IDX_STEP(rb0, rb1); __builtin_amdgcn_sched_barrier(0); kt += 8;
            IDX_LOAD(rb0, rb1, kt + 16); __builtin_amdgcn_sched_barrier(0); IDX_STEP(rc0, rc1); __builtin_amdgcn_sched_barrier(0); kt += 8;
        }
        if (rem >= 1) { IDX_STEP(ra0, ra1); kt += 8; if (rem >= 2) { IDX_STEP(rb0, rb1); } }
#undef IDX_LOAD
#undef IDX_STEP
        __syncthreads();
        }
#pragma unroll 1
        for (int rpT = 0; rpT < RP_T; ++rpT) {
            const int ra = 2 * wave, rb = 2 * wave + 1, ta = q0 + ra, tb = q0 + rb;
            unsigned ka[32], kb[32];
#ifdef KLG
#pragma unroll
            for (int i0 = 0; i0 < 32; i0 += KLG) {
                float fa[KLG], fb[KLG];
#pragma unroll
                for (int j = 0; j < KLG; ++j) { fa[j] = SC[ra * SCP + lane + 64 * (i0 + j)]; fb[j] = SC[rb * SCP + lane + 64 * (i0 + j)]; }
#pragma unroll
                for (int j = 0; j < KLG; ++j) { const int key = lane + 64 * (i0 + j); ka[i0 + j] = (key <= ta) ? score_ukey(fa[j]) : 0u; kb[i0 + j] = (key <= tb) ? score_ukey(fb[j]) : 0u; }
            }
#else
#pragma unroll
            for (int i = 0; i < 32; ++i) { const int key = lane + 64 * i; ka[i] = (key <= ta) ? score_ukey(SC[ra * SCP + key]) : 0u; kb[i] = (key <= tb) ? score_ukey(SC[rb * SCP + key]) : 0u; }
#endif
#if RP_T1 > 1
            asm volatile("" :: "v"(ka[0]), "v"(kb[31]) : "memory");
#pragma unroll
            for (int i = 0; i < 32; ++i) { const int key = lane + 64 * i; ka[i] = (key <= ta) ? score_ukey(SC[ra * SCP + key]) : 0u; kb[i] = (key <= tb) ? score_ukey(SC[rb * SCP + key]) : 0u; }
            asm volatile("" ::: "memory");
#endif
            asm volatile("s_waitcnt lgkmcnt(0)" ::: "memory");
            __syncthreads();
            DSA_STAGE(0);
            TopkState sa, sb; sa.nb = (ta >> 9) + 1; sb.nb = (tb >> 9) + 1;
            sa.hist = (wave < HIST_WAVES) ? (LAS unsigned*)(lds + 65536 + ra * 4096) : (LAS unsigned*)nullptr; sb.hist = (wave < HIST_WAVES) ? (LAS unsigned*)(lds + 65536 + rb * 4096) : (LAS unsigned*)nullptr;
            topk_init(ka, sa); topk_init(kb, sb);
#pragma unroll 1
            while (!(sa.done && sb.done)) { topk_step(ka, sa); topk_step(kb, sb); }
#if RP_T2 > 1
            asm volatile("" :: "v"(sa.prefix), "v"(sb.prefix));
            topk_init(ka, sa); topk_init(kb, sb);
#pragma unroll 1
            while (!(sa.done && sb.done)) { topk_step(ka, sa); topk_step(kb, sb); }
#endif
            if (sa.need == 0xffffffffu && sb.need == 0xffffffffu) {
                const unsigned ta_ = (unsigned)__builtin_amdgcn_readfirstlane((int)sa.prefix), tb_ = (unsigned)__builtin_amdgcn_readfirstlane((int)sb.prefix);
                int wa = 0, wb = 0;
#define WR2(i) { const unsigned long long ma = __ballot(ka[i] >= ta_), mb = __ballot(kb[i] >= tb_); wr2lanes<2 * (i)>(wa, (unsigned)ma, (unsigned)(ma >> 32)); wr2lanes<2 * (i)>(wb, (unsigned)mb, (unsigned)(mb >> 32)); }
                WR2(0) WR2(1) WR2(2) WR2(3) WR2(4) WR2(5) WR2(6) WR2(7) WR2(8) WR2(9) WR2(10) WR2(11) WR2(12) WR2(13) WR2(14) WR2(15)
                WR2(16) WR2(17) WR2(18) WR2(19) WR2(20) WR2(21) WR2(22) WR2(23) WR2(24) WR2(25) WR2(26) WR2(27) WR2(28) WR2(29) WR2(30) WR2(31)
#undef WR2
                BM[ra * BMS + lane] = (unsigned)wa; BM[rb * BMS + lane] = (unsigned)wb;
#if RP_T3 > 1
                asm volatile("" : "+v"(wa), "+v"(wb) :: "memory");
#define WR2(i) { const unsigned long long ma = __ballot(ka[i] >= ta_), mb = __ballot(kb[i] >= tb_); wr2lanes<2 * (i)>(wa, (unsigned)ma, (unsigned)(ma >> 32)); wr2lanes<2 * (i)>(wb, (unsigned)mb, (unsigned)(mb >> 32)); }
                WR2(0) WR2(1) WR2(2) WR2(3) WR2(4) WR2(5) WR2(6) WR2(7) WR2(8) WR2(9) WR2(10) WR2(11) WR2(12) WR2(13) WR2(14) WR2(15)
                WR2(16) WR2(17) WR2(18) WR2(19) WR2(20) WR2(21) WR2(22) WR2(23) WR2(24) WR2(25) WR2(26) WR2(27) WR2(28) WR2(29) WR2(30) WR2(31)
#undef WR2
                BM[ra * BMS + lane] = (unsigned)wa; BM[rb * BMS + lane] = (unsigned)wb;
#endif
            } else {
            unsigned eqa = 0u, eqb = 0u;
#pragma unroll 1
            for (int i = 0; i < 32; ++i) {
                unsigned kai = ka[0], kbi = kb[0];
#pragma unroll
                for (int j = 1; j < 32; ++j) { kai = (i == j) ? ka[j] : kai; kbi = (i == j) ? kb[j] : kbi; }
                { const bool eq = (kai == sa.prefix); const unsigned long long em = __ballot(eq);
                  const unsigned erank = eqa + __builtin_amdgcn_mbcnt_hi((unsigned)(em >> 32), __builtin_amdgcn_mbcnt_lo((unsigned)em, 0u));
                  const unsigned long long smk = __ballot((kai > sa.prefix) || (eq && erank < sa.need));
                  if (lane == 0) { BM[ra * BMS + 2 * i] = (unsigned)smk; BM[ra * BMS + 2 * i + 1] = (unsigned)(smk >> 32); }
                  eqa += (unsigned)__popcll(em); }
                { const bool eq = (kbi == sb.prefix); const unsigned long long em = __ballot(eq);
                  const unsigned erank = eqb + __builtin_amdgcn_mbcnt_hi((unsigned)(em >> 32), __builtin_amdgcn_mbcnt_lo((unsigned)em, 0u));
                  const unsigned long long smk = __ballot((kbi > sb.prefix) || (eq && erank < sb.need));
                  if (lane == 0) { BM[rb * BMS + 2 * i] = (unsigned)smk; BM[rb * BMS + 2 * i + 1] = (unsigned)(smk >> 32); }
                  eqb += (unsigned)__popcll(em); }
            }
            }
        }
    } else {
        for (int i = tid; i < 1024; i += 512) { const int row = i >> 6, w = i & 63, t = q0 + row, lo = 32 * w;
            BM[row * BMS + w] = (t >= lo + 31) ? 0xffffffffu : ((t < lo) ? 0u : ((2u << (t - lo)) - 1u)); }
        DSA_STAGE(0);
    }
    __syncthreads();
    const int h = wave;
#pragma unroll 1
    for (int rpV = 0; rpV < RP_V; ++rpV) {
    asm volatile("s_waitcnt vmcnt(0)" ::: "memory");
    asm volatile("" :: "v"(bq0), "v"(bq1), "v"(gwv[0]), "v"(gwv[1]), "v"(gwv[2]), "v"(gwv[3]));
    __syncthreads();
    if (qt_next >= TOPK / 16) { dsa_prefetch_qi(zb, qt_next, lds, wave, lane); dsa_prefetch_ki(zb, qt_next, pk, wave, lane); }
    f32x4 o[4], lacc = {0.f, 0.f, 0.f, 0.f}, negm = {0.f, 0.f, 0.f, 0.f};
#pragma unroll
    for (int dt = 0; dt < 4; ++dt) o[dt] = (f32x4){0.f, 0.f, 0.f, 0.f};
    float m_run = 0.f;
    const int kofs0 = r16 * 128 + ((g ^ (r16 >> 1)) & 7) * 16, kofs1 = r16 * 128 + (((4 + g) ^ (r16 >> 1)) & 7) * 16;
    const int vofs = 32768 + (4 * g + ((lane & 15) >> 2)) * 32 + (lane & 3) * 8;
    bf16x8v ones = {0x3f80, 0x3f80, 0x3f80, 0x3f80, 0x3f80, 0x3f80, 0x3f80, 0x3f80};
    asm volatile("" : "+v"(ones));
    LAS const unsigned char* mlut = lds + DSA_MLUT_OFF;
    constexpr float THR = 8.0f;
    bool first = true;
#pragma unroll 1
    for (int mm = 0; mm < nmega; ++mm) {
        if (mm + 1 < nmega) DSA_STAGE(mm + 1);
        LAS unsigned char* slotb = lds + (mm & 1) * 65536;
        const int nsub = (nsteps - mm * 8) < 8 ? (nsteps - mm * 8) : 8;
#pragma unroll 1
        for (int u = 0; u < nsub; u += 2) {
            LAS unsigned char* slot = slotb + u * 4096;
            const int mwA = (int)(BM[r16 * BMS + mm * 8 + u] >> (4 * g)), mwB = (int)(BM[r16 * BMS + mm * 8 + u + 1] >> (4 * g));
            f32x4 s0, s1, s2, s3;
            { const bf16x8v ka0 = *(LAS const bf16x8v*)(slot + kofs0), ka1 = *(LAS const bf16x8v*)(slot + kofs1);
              const bf16x8v kb0 = *(LAS const bf16x8v*)(slot + 2048 + kofs0), kb1 = *(LAS const bf16x8v*)(slot + 2048 + kofs1);
              const bf16x8v kc0 = *(LAS const bf16x8v*)(slot + 4096 + kofs0), kc1 = *(LAS const bf16x8v*)(slot + 4096 + kofs1);
              const bf16x8v kd0 = *(LAS const bf16x8v*)(slot + 6144 + kofs0), kd1 = *(LAS const bf16x8v*)(slot + 6144 + kofs1);
              s0 = __builtin_amdgcn_mfma_f32_16x16x32_bf16(ka0, bq0, negm, 0, 0, 0); s1 = __builtin_amdgcn_mfma_f32_16x16x32_bf16(kb0, bq0, negm, 0, 0, 0);
              s2 = __builtin_amdgcn_mfma_f32_16x16x32_bf16(kc0, bq0, negm, 0, 0, 0); s3 = __builtin_amdgcn_mfma_f32_16x16x32_bf16(kd0, bq0, negm, 0, 0, 0);
              s0 = __builtin_amdgcn_mfma_f32_16x16x32_bf16(ka1, bq1, s0, 0, 0, 0); s1 = __builtin_amdgcn_mfma_f32_16x16x32_bf16(kb1, bq1, s1, 0, 0, 0);
              s2 = __builtin_amdgcn_mfma_f32_16x16x32_bf16(kc1, bq1, s2, 0, 0, 0); s3 = __builtin_amdgcn_mfma_f32_16x16x32_bf16(kd1, bq1, s3, 0, 0, 0); }
            const int lmi = max(max(max(imax3(s0[0], s0[1], s0[2]), imax3(s0[3], s1[0], s1[1])), max(imax3(s1[2], s1[3], s2[0]), imax3(s2[1], s2[2], s2[3]))), max(imax3(s3[0], s3[1], s3[2]), __float_as_int(s3[3])));
            if (first || __any(lmi > 0x41000000)) {
                float lmx = fmaxf(fmaxf(fmaxf(fmaxf(s0[0], s0[1]), fmaxf(s0[2], s0[3])), fmaxf(fmaxf(s1[0], s1[1]), fmaxf(s1[2], s1[3]))), fmaxf(fmaxf(fmaxf(s2[0], s2[1]), fmaxf(s2[2], s2[3])), fmaxf(fmaxf(s3[0], s3[1]), fmaxf(s3[2], s3[3]))));
                { const auto r1 = __builtin_amdgcn_permlane16_swap(__float_as_uint(lmx), __float_as_uint(lmx), false, false); lmx = fmaxf(__uint_as_float(r1[0]), __uint_as_float(r1[1])); }
                { const auto r2 = __builtin_amdgcn_permlane32_swap(__float_as_uint(lmx), __float_as_uint(lmx), false, false); lmx = fmaxf(__uint_as_float(r2[0]), __uint_as_float(r2[1])); }
                const float dl = first ? lmx : fmaxf(lmx, 0.f);
                m_run += dl; const float f = first ? 1.0f : __builtin_amdgcn_exp2f(-dl);
#pragma unroll
                for (int i = 0; i < 4; ++i) { s0[i] -= dl; s1[i] -= dl; s2[i] -= dl; s3[i] -= dl; negm[i] = -m_run; }
                lacc = lacc * f;
#pragma unroll
                for (int dt = 0; dt < 4; ++dt) o[dt] = o[dt] * f;
                first = false;
            }
            const u32x2 mk0 = *(LAS const u32x2*)(mlut + ((mwA & 15) << 3)), mk1 = *(LAS const u32x2*)(mlut + (((mwA >> 16) & 15) << 3));
            const u32x2 mk2 = *(LAS const u32x2*)(mlut + ((mwB & 15) << 3)), mk3 = *(LAS const u32x2*)(mlut + (((mwB >> 16) & 15) << 3));
            u32x4 pwA, pwB;
            pwA.x = cvtpk(__builtin_amdgcn_exp2f(s0[0]), __builtin_amdgcn_exp2f(s0[1])) & mk0.x; pwA.y = cvtpk(__builtin_amdgcn_exp2f(s0[2]), __builtin_amdgcn_exp2f(s0[3])) & mk0.y;
            pwA.z = cvtpk(__builtin_amdgcn_exp2f(s1[0]), __builtin_amdgcn_exp2f(s1[1])) & mk1.x; pwA.w = cvtpk(__builtin_amdgcn_exp2f(s1[2]), __builtin_amdgcn_exp2f(s1[3])) & mk1.y;
            pwB.x = cvtpk(__builtin_amdgcn_exp2f(s2[0]), __builtin_amdgcn_exp2f(s2[1])) & mk2.x; pwB.y = cvtpk(__builtin_amdgcn_exp2f(s2[2]), __builtin_amdgcn_exp2f(s2[3])) & mk2.y;
            pwB.z = cvtpk(__builtin_amdgcn_exp2f(s3[0]), __builtin_amdgcn_exp2f(s3[1])) & mk3.x; pwB.w = cvtpk(__builtin_amdgcn_exp2f(s3[2]), __builtin_amdgcn_exp2f(s3[3])) & mk3.y;
            const bf16x8v pfA = __builtin_bit_cast(bf16x8v, pwA), pfB = __builtin_bit_cast(bf16x8v, pwB);
            lacc = __builtin_amdgcn_mfma_f32_16x16x32_bf16(ones, pfA, lacc, 0, 0, 0);
            lacc = __builtin_amdgcn_mfma_f32_16x16x32_bf16(ones, pfB, lacc, 0, 0, 0);
#pragma unroll
            for (int dt = 0; dt < 4; ++dt) {
                const s16x4v lo = lds_tr16(slot + vofs + dt * 1024), hi = lds_tr16(slot + vofs + dt * 1024 + 512);
                const s16x4v lo2 = lds_tr16(slot + 4096 + vofs + dt * 1024), hi2 = lds_tr16(slot + 4096 + vofs + dt * 1024 + 512);
                const bf16x8v vf = {lo[0], lo[1], lo[2], lo[3], hi[0], hi[1], hi[2], hi[3]};
                const bf16x8v vf2 = {lo2[0], lo2[1], lo2[2], lo2[3], hi2[0], hi2[1], hi2[2], hi2[3]};
                o[dt] = __builtin_amdgcn_mfma_f32_16x16x32_bf16(vf, pfA, o[dt], 0, 0, 0);
                o[dt] = __builtin_amdgcn_mfma_f32_16x16x32_bf16(vf2, pfB, o[dt], 0, 0, 0);
            }
        }
        asm volatile("s_waitcnt vmcnt(0) lgkmcnt(0)" ::: "memory");
        __syncthreads();
    }
#undef DSA_STAGE
    const float inv = 1.0f / lacc[0];
    bf16* yrow = p.Y + ((size_t)b * SEQ + q0 + r16) * DM + 512 + h * 64;
#pragma unroll
    for (int dt = 0; dt < 4; ++dt) {
        const u32x2 gw = gwv[dt];
        const float g0 = __uint_as_float(gw.x << 16), g1 = __uint_as_float(gw.x & 0xffff0000u), g2 = __uint_as_float(gw.y << 16), g3 = __uint_as_float(gw.y & 0xffff0000u);
        u32x2 w; w.x = pk2(o[dt][0] * inv * siluf(g0), o[dt][1] * inv * siluf(g1)); w.y = pk2(o[dt][2] * inv * siluf(g2), o[dt][3] * inv * siluf(g3));
        *(u32x2*)(yrow + dt * 16 + 4 * g) = w;
    }
    __syncthreads();
    }
}
__device__ __forceinline__ int dsa_qt_of(int j, int i) { return (i == 0) ? 127 - j : (i == 1) ? 64 + j : (i == 2) ? 63 - j : j; }
__device__ __forceinline__ void dsa_phase_pre(const P& p, LAS unsigned char* lds, bf16x8v (&pk)[4]) {
    const int G = gridDim.x, wg = blockIdx.x, lane = threadIdx.x & 63, wave = __builtin_amdgcn_readfirstlane(threadIdx.x >> 6);
    const int b = (G == 256) ? (wg & 7) : (wg >> 7), qt = (G == 256) ? dsa_qt_of(wg >> 3, 0) : 127 - (wg & 127);
#pragma unroll
    for (int i = 0; i < 4; ++i) pk[i] = (bf16x8v){0, 0, 0, 0, 0, 0, 0, 0};
    if (wg < 1024 && qt >= TOPK / 16) { dsa_prefetch_qi(p.Z + (size_t)b * SEQ * ZP, qt, lds, wave, lane); dsa_prefetch_ki(p.Z + (size_t)b * SEQ * ZP, qt, pk, wave, lane); }
}
__device__ __forceinline__ void dsa_phase(const P& p, LAS unsigned char* lds, bf16x8v (&pk)[4]) {
    const int G = gridDim.x, wg = blockIdx.x;
    if (G == 256) {
        const int b = wg & 7, j = wg >> 3;
#pragma unroll 1
        for (int i = 0; i < 4; ++i) dsa_unit(p, b, dsa_qt_of(j, i), (i < 3) ? dsa_qt_of(j, i + 1) : -1, pk, lds);
    }
}
constexpr int LRU_WS_OFF = 139264;
constexpr int LRU_XB = 264 * 128;
constexpr int LRU_GB = 256 * 32;
constexpr int LRU_BUF = LRU_XB + LRU_GB;
__device__ __forceinline__ float fast_sigm(float x) { return __builtin_amdgcn_rcpf(1.0f + __expf(-x)); }
__device__ __forceinline__ void lru_unit(const P& p, int l, int b, int blk, int q4, LAS unsigned char* lds) {
    const int tid = threadIdx.x, lane = tid & 63, wave = __builtin_amdgcn_readfirstlane(tid >> 6), r16 = lane & 15, g = lane >> 4;
    const bf16* zb = p.Z + (size_t)b * SEQ * ZP;
    const int cA = blk * 64, dloc = q4 * 16 + r16, dg = blk * 64 + dloc;
    const unsigned lds_base = (unsigned)(uintptr_t)lds;
#define LRU_STAGE(r) do { const unsigned bb_ = lds_base + (unsigned)(((r) & 1) * LRU_BUF); \
        _Pragma("unroll") for (int i_ = 0; i_ < 5; ++i_) { const int pc_ = wave + 8 * i_; if (pc_ < 33) { const int rho_ = pc_ * 8 + (lane >> 3); int t_ = (r) * 256 - 3 + rho_; t_ = t_ < 0 ? 0 : (t_ > SEQ - 1 ? SEQ - 1 : t_); \
            const int ch_ = (lane & 7) ^ ((rho_ >> 1) & 7); glds16(zb + (size_t)t_ * ZP + C_XR + cA + ch_ * 8, (unsigned)__builtin_amdgcn_readfirstlane(bb_ + pc_ * 1024)); } } \
        { const int row_ = wave * 32 + (lane >> 1); glds16(zb + (size_t)((r) * 256 + row_) * ZP + C_GR + dg - r16 + (lane & 1) * 8, (unsigned)__builtin_amdgcn_readfirstlane(bb_ + LRU_XB + wave * 1024)); } } while (0)
    LRU_STAGE(0);
    float cwA[2][4][8], cbA[2][8];
#pragma unroll
    for (int s = 0; s < 2; ++s)
#pragma unroll
        for (int j = 0; j < 8; ++j) { const int c = cA + 32 * s + 8 * g + j; cbA[s][j] = p.conv_b[l * 512 + c];
#pragma unroll
            for (int k = 0; k < 4; ++k) cwA[s][k][j] = p.conv_w[(l * 4 + k) * 512 + c]; }
    bf16x8v bxf[2], baf[2];
#pragma unroll
    for (int s = 0; s < 2; ++s) { u32x4 wx, wa; unsigned tx[8], ta[8];
#pragma unroll
        for (int j = 0; j < 8; ++j) { const size_t idx = (((size_t)l * 8 + blk) * 64 + 32 * s + 8 * g + j) * 64 + dloc; tx[j] = f2bf(p.lru_wx[idx]); ta[j] = f2bf(p.lru_wa[idx]); }
        wx.x = tx[0] | (tx[1] << 16); wx.y = tx[2] | (tx[3] << 16); wx.z = tx[4] | (tx[5] << 16); wx.w = tx[6] | (tx[7] << 16);
        wa.x = ta[0] | (ta[1] << 16); wa.y = ta[2] | (ta[3] << 16); wa.z = ta[4] | (ta[5] << 16); wa.w = ta[6] | (ta[7] << 16);
        bxf[s] = __builtin_bit_cast(bf16x8v, wx); baf[s] = __builtin_bit_cast(bf16x8v, wa); }
    const float cw0 = p.conv_w[(l * 4 + 0) * 512 + dg], cw1 = p.conv_w[(l * 4 + 1) * 512 + dg], cw2 = p.conv_w[(l * 4 + 2) * 512 + dg], cw3 = p.conv_w[(l * 4 + 3) * 512 + dg];
    const float cb = p.conv_b[l * 512 + dg], bxv = p.lru_bx[l * 512 + dg], bav = p.lru_ba[l * 512 + dg];
    const float sp8 = -8.0f * log1pf(expf(-p.lru_a[l * 512 + dg]));
    asm volatile("" :: "v"(cwA[0][0][0]), "v"(cwA[1][3][7]), "v"(cbA[1][7]), "v"(bxf[0]), "v"(bxf[1]), "v"(baf[0]), "v"(baf[1]), "v"(cw0), "v"(cw1), "v"(cw2), "v"(cw3), "v"(cb), "v"(bxv), "v"(bav), "v"(sp8));
    LAS float* WS = (LAS float*)(lds + LRU_WS_OFF);
    float hrun = 0.f;
    asm volatile("s_waitcnt vmcnt(0)" ::: "memory");
#pragma unroll 1
    for (int round = 0; round < 8; ++round) {
        asm volatile("s_waitcnt vmcnt(8)" ::: "memory");
        __syncthreads();
        if (round + 1 < 8) LRU_STAGE(round + 1);
        LAS const unsigned char* xb = lds + (round & 1) * LRU_BUF; LAS const unsigned char* gb = xb + LRU_XB;
        const int tw = round * 256 + wave * 32;
        float hl[2][4], pl[2][4], gr4[2][4], PT[2], HT[2], PE[2], HE[2];
#pragma unroll
        for (int tau = 0; tau < 2; ++tau) {
            const int t0 = tw + 16 * tau, rho0 = wave * 32 + 16 * tau;
            bf16x8v af[2];
#pragma unroll
            for (int s = 0; s < 2; ++s) {
                float xc[8];
#pragma unroll
                for (int j = 0; j < 8; ++j) xc[j] = cbA[s][j];
#pragma unroll
                for (int k = 0; k < 4; ++k) { const int rho = rho0 + r16 + k; u32x4 w = *(LAS const u32x4*)(xb + rho * 128 + (((4 * s + g) ^ (rho >> 1)) & 7) * 16);
                    if (t0 + r16 - 3 + k < 0) w = (u32x4){0u, 0u, 0u, 0u};
                    xc[0] += cwA[s][k][0] * __uint_as_float(w.x << 16); xc[1] += cwA[s][k][1] * __uint_as_float(w.x & 0xffff0000u);
                    xc[2] += cwA[s][k][2] * __uint_as_float(w.y << 16); xc[3] += cwA[s][k][3] * __uint_as_float(w.y & 0xffff0000u);
                    xc[4] += cwA[s][k][4] * __uint_as_float(w.z << 16); xc[5] += cwA[s][k][5] * __uint_as_float(w.z & 0xffff0000u);
                    xc[6] += cwA[s][k][6] * __uint_as_float(w.w << 16); xc[7] += cwA[s][k][7] * __uint_as_float(w.w & 0xffff0000u); }
                u32x4 pw; pw.x = cvtpk(xc[0], xc[1]); pw.y = cvtpk(xc[2], xc[3]); pw.z = cvtpk(xc[4], xc[5]); pw.w = cvtpk(xc[6], xc[7]);
                af[s] = __builtin_bit_cast(bf16x8v, pw);
            }
            f32x4 gx = {0.f, 0.f, 0.f, 0.f}, ga = {0.f, 0.f, 0.f, 0.f};
            gx = __builtin_amdgcn_mfma_f32_16x16x32_bf16(af[0], bxf[0], gx, 0, 0, 0); gx = __builtin_amdgcn_mfma_f32_16x16x32_bf16(af[1], bxf[1], gx, 0, 0, 0);
            ga = __builtin_amdgcn_mfma_f32_16x16x32_bf16(af[0], baf[0], ga, 0, 0, 0); ga = __builtin_amdgcn_mfma_f32_16x16x32_bf16(af[1], baf[1], ga, 0, 0, 0);
            float xo[7];
#pragma unroll
            for (int m = 0; m < 7; ++m) { const int rho = rho0 + 4 * g + m;
                const unsigned short v = *(LAS const unsigned short*)(xb + rho * 128 + (((dloc >> 3) ^ (rho >> 1)) & 7) * 16 + (dloc & 7) * 2);
                xo[m] = (t0 + 4 * g - 3 + m >= 0) ? bf2f(v) : 0.f; }
            float Pr = 1.f, Hr = 0.f;
#pragma unroll
            for (int i = 0; i < 4; ++i) {
                const float xcv = cb + cw0 * xo[i] + cw1 * xo[i + 1] + cw2 * xo[i + 2] + cw3 * xo[i + 3];
                const float sx = fast_sigm(gx[i] + bxv), sa = fast_sigm(ga[i] + bav);
                const float la = sp8 * sa, a = __expf(la), y2 = 2.0f * la;
                const float ser = -y2 * (1.0f + y2 * (0.5f + y2 * (0.16666667f + y2 * (0.041666668f + y2 * (0.0083333338f + y2 * 0.0013888889f)))));
                const float em = (y2 > -0.25f) ? ser : (1.0f - __expf(y2));
                const float u = __builtin_amdgcn_sqrtf(em) * sx * xcv;
                Hr = a * Hr + u; Pr *= a; hl[tau][i] = Hr; pl[tau][i] = Pr;
                gr4[tau][i] = bf2f(*(LAS const unsigned short*)(gb + (rho0 + 4 * g + i) * 32 + r16 * 2));
            }
            float Pi = Pr, Hi = Hr;
            { const float Pl = __shfl_up(Pi, 16), Hl = __shfl_up(Hi, 16); if (g >= 1) { Hi = Pi * Hl + Hi; Pi = Pl * Pi; } }
            { const float Pl = __shfl_up(Pi, 32), Hl = __shfl_up(Hi, 32); if (g >= 2) { Hi = Pi * Hl + Hi; Pi = Pl * Pi; } }
            float Pe = __shfl_up(Pi, 16), He = __shfl_up(Hi, 16); if (g == 0) { Pe = 1.f; He = 0.f; }
            PT[tau] = __shfl(Pi, 48 + r16); HT[tau] = __shfl(Hi, 48 + r16); PE[tau] = Pe; HE[tau] = He;
        }
        HE[1] = PE[1] * HT[0] + HE[1]; PE[1] = PT[0] * PE[1];
        const float Pw = PT[0] * PT[1], Hw = PT[1] * HT[0] + HT[1];
        LAS float* wsr = WS + (round & 1) * 256;
        if (g == 0) { wsr[(wave * 16 + r16) * 2 + 0] = Pw; wsr[(wave * 16 + r16) * 2 + 1] = Hw; }
        asm volatile("s_waitcnt lgkmcnt(0)" ::: "memory");
        __builtin_amdgcn_s_barrier();
        asm volatile("" ::: "memory");
        float hc = hrun, hall = hrun;
#pragma unroll
        for (int w2 = 0; w2 < 8; ++w2) { if (w2 == wave) hc = hall; hall = wsr[(w2 * 16 + r16) * 2 + 0] * hall + wsr[(w2 * 16 + r16) * 2 + 1]; }
        hrun = hall;
#pragma unroll
        for (int tau = 0; tau < 2; ++tau) {
            const float hin = PE[tau] * hc + HE[tau];
            bf16* yp = p.Y + ((size_t)b * SEQ + tw + 16 * tau + 4 * g) * DM + dg;
#pragma unroll
            for (int i = 0; i < 4; ++i) { const float h = hl[tau][i] + pl[tau][i] * hin, gr = gr4[tau][i]; yp[(size_t)i * DM] = (bf16)f2bf(h * gr * fast_sigm(gr)); }
        }
    }
#undef LRU_STAGE
    __syncthreads();
}
__device__ __forceinline__ void lru_phase(const P& p, int l, LAS unsigned char* lds) {
    const int G = gridDim.x, wg = blockIdx.x;
#pragma unroll 1
    for (int u = wg; u < 256; u += G) lru_unit(p, l, (u >> 3) & 7, u & 7, u >> 6, lds);
}
#ifndef DSA_PHASE
#define DSA_PHASE dsa_phase
#endif
#ifndef LRU_PHASE
#define LRU_PHASE lru_phase
#endif
#ifndef RP_A
#define RP_A 1
#endif
#ifndef RP_L
#define RP_L 1
#endif
#ifndef RP_D
#define RP_D 1
#endif
#ifndef RP_C
#define RP_C 1
#endif
#ifndef RP_0
#define RP_0 1
#endif
template <int OFF> __device__ __forceinline__ unsigned long long karg_u64() {
    unsigned long long v; const unsigned long long kp = (unsigned long long)__builtin_amdgcn_kernarg_segment_ptr();
    asm volatile("s_load_dwordx2 %0, %1, %2\n\ts_waitcnt lgkmcnt(0)" : "=s"(v) : "s"(kp), "i"(OFF) : "memory");
    return v;
}
struct Args { const float* in[15]; float* out; unsigned char* ws; int ph_lo, ph_hi; };
__global__ void __launch_bounds__(512, 2) mega(Args a) {
    extern __shared__ __attribute__((aligned(16))) unsigned char lds_raw[];
    LAS unsigned char* lds = (LAS unsigned char*)lds_raw;
#define KARG(T, off) ((T)(__attribute__((address_space(1))) void*)karg_u64<(off)>())
#define LOADP() P p; { unsigned char* ws_ = KARG(unsigned char*, 128); \
        p.x = KARG(const float*, 0); p.c = KARG(const float*, 8); p.norm_g = KARG(const float*, 16); p.ada_w = KARG(const float*, 24); p.ada_b = KARG(const float*, 32); p.w_in = KARG(const float*, 40); \
        p.conv_w = KARG(const float*, 48); p.conv_b = KARG(const float*, 56); p.lru_wx = KARG(const float*, 64); p.lru_bx = KARG(const float*, 72); p.lru_wa = KARG(const float*, 80); p.lru_ba = KARG(const float*, 88); \
        p.lru_a = KARG(const float*, 96); p.w_out = KARG(const float*, 104); p.final_g = KARG(const float*, 112); p.out = KARG(float*, 120); \
        p.ctl = (unsigned*)(ws_ + WS_CTL); p.mod = (float*)(ws_ + WS_MOD); p.bias = (float*)(ws_ + WS_BIAS); p.ssq = (float*)(ws_ + WS_SSQ); \
        p.wt_in = (bf16*)(ws_ + WS_WTIN); p.wt_out = (bf16*)(ws_ + WS_WTOUT); p.A = (bf16*)(ws_ + WS_A); p.Z = (bf16*)(ws_ + WS_Z); p.Y = (bf16*)(ws_ + WS_Y); p.X1 = (bf16*)(ws_ + WS_X1); }
    unsigned* const ctl0 = (unsigned*)((unsigned char*)a.ws + WS_CTL);
    const int lo = a.ph_lo, hi = a.ph_hi;
    volatile LAS unsigned* MISC = (volatile LAS unsigned*)(lds + MISC_OFF + 4096);
    if (threadIdx.x < 4) MISC[threadIdx.x] = 0u;
    if (threadIdx.x < 16) { const unsigned t = threadIdx.x; u32x2 m; m.x = ((t & 1u) ? 0xffffu : 0u) | ((t & 2u) ? 0xffff0000u : 0u); m.y = ((t & 4u) ? 0xffffu : 0u) | ((t & 8u) ? 0xffff0000u : 0u);
        *(LAS u32x2*)(lds + DSA_MLUT_OFF + t * 8) = m; }
    __syncthreads();
    XcdBarrier bar; bar.bar = ctl0 + CW_BAR; bar.x = 0; bar.st = MISC;
    if (hi - lo > 1) bar = xcd_barrier_post(ctl0 + CW_BAR, MISC);
#define IN(k) (lo <= (k) && (k) < hi)
#ifndef N_CG_SEAMS
#define N_CG_SEAMS 0
#endif
#define SEAM(k) do { if (IN(k) && IN((k) + 1)) { if ((k) < N_CG_SEAMS) cg::this_grid().sync(); else xcd_barrier(bar); } } while (0)
    if (IN(0)) { LOADP(); ph0_prologue(p, lds); if (RP_0 > 1) { __syncthreads(); ph0_prologue(p, lds); } }
    SEAM(0);
    if (IN(1)) { LOADP(); ph1_prologue(p, lds); if (RP_0 > 1) { __syncthreads(); ph1_prologue(p, lds); } }
    SEAM(1);
#ifdef PROBE_BAR
#define SEAM_X(b) do { SEAM(b); SEAM(b); SEAM(b); SEAM(b); } while (0)
#else
#define SEAM_X(b) do { } while (0)
#endif
#define LAYER(l, base) \
    if (IN(base)) { LOADP(); \
        pg8::Gemm g{p.A, p.wt_in + (size_t)(l) * ZP * 1024, MROWS, ZP, DM}; pg8::StaticOrder S; S.init(MROWS, ZP, (int)gridDim.x, (int)blockIdx.x); \
        EpiZ E{p.Z, p.ssq, p.bias + (size_t)(l) * 8 * ZP}; \
        pg8::gemm_phase<EpiZ, pg8::StaticOrder, PG8_ALIGN, PG8_SP2>(lds, g, S, E); if (RP_A > 1) { __syncthreads(); pg8::gemm_phase<EpiZ, pg8::StaticOrder, PG8_ALIGN, PG8_SP2>(lds, g, S, E); } \
    } \
    SEAM(base); SEAM_X(base); \
    if (IN((base) + 1)) { LOADP(); bf16x8v pk0[4]; dsa_phase_pre(p, lds, pk0); LRU_PHASE(p, (l), lds); __syncthreads(); DSA_PHASE(p, lds, pk0); } \
    SEAM((base) + 1); \
    if (IN((base) + 2)) { LOADP(); \
        pg8::Gemm g{p.Y, p.wt_out + (size_t)(l) * 1024 * 1024, MROWS, DM, DM}; pg8::StaticOrder S; S.init(MROWS, DM, (int)gridDim.x, (int)blockIdx.x); \
        if constexpr ((l) == DEPTH - 1) { \
            EpiXF E{p.X1, p.out, p.mod + (size_t)(l) * 8 * 3072 + 2048, p.final_g, p.ssq, p.ctl + CW_PANEL}; \
            pg8::gemm_phase<EpiXF, pg8::StaticOrder, false, PG8_SP2>(lds, g, S, E); \
        } else { \
            EpiX E{p.x, p.X1, p.A, p.mod + (size_t)(l) * 8 * 3072 + 2048, p.norm_g + (size_t)((l) + 1) * 1024, p.mod + (size_t)((l) + 1) * 8 * 3072 + 1024, p.ssq}; \
            pg8::gemm_phase<EpiX, pg8::StaticOrder, false, PG8_SP2>(lds, g, S, E); if (RP_C > 1 && (l) == 0) { __syncthreads(); pg8::gemm_phase<EpiX, pg8::StaticOrder, false, PG8_SP2>(lds, g, S, E); } \
        } \
    } \
    if ((base) + 3 < NPHASE) SEAM((base) + 2);
    LAYER(0, 2)
    LAYER(1, 5)
}
#ifndef MK_N_LAUNCHES
#define MK_N_LAUNCHES 1
#endif
extern "C" void kernel_launch(void* const* d_in, const int* in_sizes, int n_in, void* d_out, int out_size, void* d_ws, size_t ws_size, hipStream_t stream) {
    static int grid = 0;
    if (grid == 0) {
        if (n_in != 15 || out_size != MROWS * DM || ws_size < WS_END) { fprintf(stderr, "kernel_launch: unexpected problem (n_in %d out %d ws %zu)\n", n_in, out_size, ws_size); grid = -1; return; }
        int dev = 0, cus = 0, per_cu = 0;
        hipGetDevice(&dev); hipDeviceGetAttribute(&cus, hipDeviceAttributeMultiprocessorCount, dev);
        if (hipFuncSetAttribute((const void*)mega, hipFuncAttributeMaxDynamicSharedMemorySize, LDS_BYTES) != hipSuccess) { fprintf(stderr, "kernel_launch: hipFuncSetAttribute failed\n"); grid = -1; return; }
        if (hipOccupancyMaxActiveBlocksPerMultiprocessor(&per_cu, (const void*)mega, 512, LDS_BYTES) != hipSuccess || per_cu < 1) { fprintf(stderr, "kernel_launch: occupancy query failed (%d)\n", per_cu); per_cu = 1; }
        (void)hipGetLastError();
        grid = cus * per_cu;
        if (grid != 256) fprintf(stderr, "kernel_launch: grid %d (cus %d x %d) != 256: the fused out-projection epilogue needs exactly 256 workgroups\n", grid, cus, per_cu);
    }
    if (grid < 0) return;
    hipMemsetAsync((char*)d_ws + WS_CTL, 0, CTL_ZERO_BYTES, stream);
    Args a{};
    for (int i = 0; i < 15; ++i) a.in[i] = (const float*)d_in[i];
    a.out = (float*)d_out; a.ws = (unsigned char*)d_ws;
#if MK_N_LAUNCHES == 1
    a.ph_lo = 0; a.ph_hi = NPHASE;
    void* args[] = {&a};
    hipError_t e = hipLaunchCooperativeKernel((const void*)mega, dim3(grid), dim3(512), args, LDS_BYTES, stream);
    if (e != hipSuccess) fprintf(stderr, "cooperative launch failed: %s (grid %d)\n", hipGetErrorString(e), grid);
#else
    for (int ph = 0; ph < NPHASE; ++ph) { a.ph_lo = ph; a.ph_hi = ph + 1; hipLaunchKernelGGL(mega, dim3(grid), dim3(512), LDS_BYTES, stream, a); }
#endif
}
```

```cpp
#include <hip/hip_runtime.h>
#include <hip/hip_cooperative_groups.h>
#include <cstdio>
#include <cstdint>
#include <cmath>
namespace cg = cooperative_groups;
#define EPI_XD 4
#define EPI_ZD 8
#define HIST_WAVES 8
#define PRO_KC 64
#define HISTA_FALLBACK 1
#define WALK_MAX 4
#define XB_FLAT_RELEASE 1
#define DSA_DYNQ 1
namespace pg8 {
#define PG8_LAS __attribute__((address_space(3)))
typedef unsigned short bf16_t;
typedef short bf16x8 __attribute__((ext_vector_type(8)));
typedef float f32x4 __attribute__((ext_vector_type(4)));
typedef unsigned u32x4 __attribute__((ext_vector_type(4)));
constexpr int BM = 256, BK = 64, HALF = 128, HTB = HALF * BK * 2  , STAGE_BYTES = 8 * HTB, NXCD = 8, WGM = 8;

__host__ __device__ __forceinline__ int lds_byte(int r, int c) { const int st = (r >> 4) * 2 + (c >> 5), rr = r & 15, cc = c & 31, ob = rr * 64 + cc * 2; return st * 1024 + (ob ^ (((ob >> 9) & 1) << 5)); }
__host__ __device__ __forceinline__ void stage_rc(int b, int& R, int& C) { const int st = b / 1024, sb = b % 1024, swz = sb ^ (((sb >> 9) & 1) << 5); R = (st >> 1) * 16 + swz / 64; C = (st & 1) * 32 + (swz % 64) / 2; }
__host__ __device__ __forceinline__ int perm32(int rho) { const int n = rho >> 4, i = rho & 15; return 8 * (i >> 2) + 4 * n + (i & 3); }

struct Unit { int pm, pn; };
struct Gemm { const bf16_t* A; const bf16_t* Bt; int M, N, K; };

struct StaticOrder {
    int nM, nN, nwg, G, c;
    __host__ __device__ void init(int M, int N, int G_, int c_) { nM = M / BM; nN = N / BM; nwg = nM * nN; G = G_; c = c_; }
    __host__ __device__ bool next(int i, Unit& u) const {
        const long L = (long)i * G + c; if (L >= nwg) return false;
        int wgid = (int)L; { const int q = nwg / NXCD, r = nwg % NXCD, xcd = wgid % NXCD, off = wgid / NXCD; wgid = (xcd < r ? xcd * (q + 1) : r * (q + 1) + (xcd - r) * q) + off; }
        const int nig = WGM * nN, gid = wgid / nig, fm = gid * WGM, gsz = (nM - fm) < WGM ? (nM - fm) : WGM;
        u.pm = fm + ((wgid % nig) % gsz); u.pn = (wgid % nig) / gsz; return true;
    }
    __device__ __forceinline__ void a_ready(const Unit&) const {}
    __device__ __forceinline__ void done(const Unit&) const {}
};

__device__ __forceinline__ unsigned cvt_pk_bf16(float lo, float hi) { unsigned r; asm volatile("v_cvt_pk_bf16_f32 %0, %1, %2" : "=v"(r) : "v"(lo), "v"(hi)); return r; }
typedef float f32x2 __attribute__((ext_vector_type(2)));
template <class Epi, class Sched, bool ALIGN_EPI = false, bool SP2 = false>
__device__ __forceinline__ void gemm_phase(PG8_LAS unsigned char* lds, const Gemm g, const Sched& S, const Epi& E) {
    const int tid = threadIdx.x, wid = __builtin_amdgcn_readfirstlane(tid >> 6), lane = tid & 63, wr = wid >> 2, wc = wid & 3, fr = lane & 15, fq = lane >> 4;
    const int K = g.K, nt = K / BK;
    unsigned voffA[2], voffB[2];
#pragma unroll
    for (int i = 0; i < 2; ++i) { int R, C; stage_rc(tid * 16 + i * 8192, R, C); const int Rb = Epi::PERM ? ((R & ~31) + perm32(R & 31)) : R;
        voffA[i] = (unsigned)(R * K + C) * 2u; voffB[i] = (unsigned)(Rb * K + C) * 2u; }
    const size_t kstep = (size_t)(BK * 2);
    const size_t hstep = (size_t)HALF * K * 2;
    const size_t tstep = 2 * hstep;
    const unsigned ldsw = (unsigned)wid * 1024u;
    const int aoff = lds_byte(wr * 64 + fr, fq * 8), boff = lds_byte(wc * 32 + fr, fq * 8);
#define PG8_SA(b, h) (((b) * 2 + (h)) * HTB)
#define PG8_SB(b, h) ((4 + (b) * 2 + (h)) * HTB)
#define PG8_STAGE(bufoff, gbase, voff) do { _Pragma("unroll") for (int _i = 0; _i < 2; ++_i) \
        __builtin_amdgcn_global_load_lds((const unsigned*)((const char*)(gbase) + (voff)[_i]), (PG8_LAS unsigned*)(lds + (bufoff) + ldsw + _i * 8192), 16, 0, 0); } while (0)
#define PG8_LDA(dst, b, h) do { _Pragma("unroll") for (int m = 0; m < 4; ++m) _Pragma("unroll") for (int k = 0; k < 2; ++k) dst[m][k] = *(const PG8_LAS bf16x8*)(lds + PG8_SA(b, h) + aoff + m * 2048 + k * 1024); } while (0)
#define PG8_LDB(dst, b, h) do { _Pragma("unroll") for (int n = 0; n < 2; ++n) _Pragma("unroll") for (int k = 0; k < 2; ++k) dst[n][k] = *(const PG8_LAS bf16x8*)(lds + PG8_SB(b, h) + boff + n * 2048 + k * 1024); } while (0)
#define PG8_MMA(ai, bj, At, Bt) do { __builtin_amdgcn_s_setprio(1); _Pragma("unroll") for (int m = 0; m < 4; ++m) _Pragma("unroll") for (int n = 0; n < 2; ++n) _Pragma("unroll") for (int k = 0; k < 2; ++k) \
        acc[ai][bj][m][n] = __builtin_amdgcn_mfma_f32_16x16x32_bf16(Bt[n][k], At[m][k], acc[ai][bj][m][n], 0, 0, 0); __builtin_amdgcn_s_setprio(0); } while (0)
#define PG8_WAIT_V(n) asm volatile("s_waitcnt vmcnt(" #n ")" ::: "memory")
#define PG8_WAIT_L(n) asm volatile("s_waitcnt lgkmcnt(" #n ")" ::: "memory")
#define PG8_BAR __builtin_amdgcn_s_barrier()
#define PG8_SCHED __builtin_amdgcn_sched_barrier(0)
    Unit cur, nxt; int ui = 0;
    if (!S.next(0, cur)) return;
    f32x4 acc[2][2][4][2];
#pragma unroll
    for (int a = 0; a < 2; ++a)
#pragma unroll
        for (int b = 0; b < 2; ++b)
#pragma unroll
            for (int m = 0; m < 4; ++m)
#pragma unroll
                for (int n = 0; n < 2; ++n) acc[a][b][m][n] = (f32x4){0.f, 0.f, 0.f, 0.f};
    bf16x8 At[4][2], B0[2][2], B1[2][2];
    const char* cA = (const char*)g.A + (size_t)cur.pm * tstep; const char* cB = (const char*)g.Bt + (size_t)cur.pn * tstep;
    S.a_ready(cur);
    if constexpr (SP2) {
        PG8_STAGE(PG8_SB(0, 0), cB, voffB); PG8_STAGE(PG8_SB(0, 1), cB + hstep, voffB); PG8_STAGE(PG8_SA(0, 0), cA, voffA); PG8_STAGE(PG8_SA(0, 1), cA + hstep, voffA);
        if (wr == 1) PG8_BAR;
        PG8_WAIT_V(2); PG8_BAR;
        PG8_STAGE(PG8_SB(1, 0), cB + kstep, voffB); PG8_STAGE(PG8_SA(1, 0), cA + kstep, voffA); PG8_STAGE(PG8_SB(1, 1), cB + hstep + kstep, voffB);
        PG8_WAIT_V(6); PG8_BAR;
    } else {
        PG8_STAGE(PG8_SB(0, 0), cB, voffB); PG8_STAGE(PG8_SA(0, 0), cA, voffA); PG8_STAGE(PG8_SB(0, 1), cB + hstep, voffB); PG8_STAGE(PG8_SA(0, 1), cA + hstep, voffA);
        if (wr == 1) PG8_BAR;
        PG8_WAIT_V(4); PG8_BAR;
        PG8_STAGE(PG8_SB(1, 0), cB + kstep, voffB); PG8_STAGE(PG8_SA(1, 0), cA + kstep, voffA); PG8_STAGE(PG8_SB(1, 1), cB + hstep + kstep, voffB);
        PG8_WAIT_V(6); PG8_BAR;
    }
    for (;;) {
        const bool has_next = S.next(ui + 1, nxt);
        const char* nA = has_next ? (const char*)g.A + (size_t)nxt.pm * tstep : cA; const char* nB = has_next ? (const char*)g.Bt + (size_t)nxt.pn * tstep : cB;
        for (int t = 0; t < nt; t += 2) {
            const bool last = (t == nt - 2);
            const char* a1 = cA + (size_t)(t + 1) * kstep;
            const char* a2 = last ? nA : cA + (size_t)(t + 2) * kstep; const char* b2 = last ? nB : cB + (size_t)(t + 2) * kstep;
            const char* a3 = a2 + kstep; const char* b3 = b2 + kstep;
            if (last && has_next) S.a_ready(nxt);
            if constexpr (SP2) {
            PG8_LDB(B0, 0, 0); PG8_LDB(B1, 0, 1); PG8_SCHED; PG8_LDA(At, 0, 0); PG8_STAGE(PG8_SA(1, 1), a1 + hstep, voffA);
            PG8_WAIT_V(8); PG8_WAIT_L(0); PG8_BAR; PG8_MMA(0, 0, At, B0); PG8_MMA(0, 1, At, B1); PG8_BAR; PG8_SCHED;
            PG8_LDA(At, 0, 1); PG8_STAGE(PG8_SB(0, 0), b2, voffB); PG8_STAGE(PG8_SB(0, 1), b2 + hstep, voffB); PG8_STAGE(PG8_SA(0, 0), a2, voffA);
            PG8_WAIT_V(8); PG8_WAIT_L(0); PG8_BAR; PG8_MMA(1, 0, At, B0); PG8_MMA(1, 1, At, B1); PG8_BAR; PG8_SCHED;
            PG8_LDB(B0, 1, 0); PG8_LDB(B1, 1, 1); PG8_SCHED; PG8_LDA(At, 1, 0); PG8_STAGE(PG8_SA(0, 1), a2 + hstep, voffA);
            PG8_WAIT_V(8); PG8_WAIT_L(0); PG8_BAR; PG8_MMA(0, 0, At, B0); PG8_MMA(0, 1, At, B1); PG8_BAR; PG8_SCHED;
            PG8_LDA(At, 1, 1); PG8_STAGE(PG8_SB(1, 0), b3, voffB); PG8_STAGE(PG8_SB(1, 1), b3 + hstep, voffB); PG8_STAGE(PG8_SA(1, 0), a3, voffA);
            PG8_WAIT_V(8); PG8_WAIT_L(0); PG8_BAR; PG8_MMA(1, 0, At, B0); PG8_MMA(1, 1, At, B1); PG8_BAR; PG8_SCHED;
            } else {
            PG8_LDB(B0, 0, 0); PG8_SCHED; PG8_LDA(At, 0, 0); PG8_STAGE(PG8_SA(1, 1), a1 + hstep, voffA);
            PG8_WAIT_L(8); PG8_BAR; PG8_WAIT_L(0); PG8_MMA(0, 0, At, B0); PG8_BAR; PG8_SCHED;
            PG8_LDB(B1, 0, 1); PG8_STAGE(PG8_SB(0, 0), b2, voffB);
            PG8_BAR; PG8_WAIT_L(0); PG8_MMA(0, 1, At, B1); PG8_BAR;
            PG8_LDA(At, 0, 1); PG8_STAGE(PG8_SA(0, 0), a2, voffA);
            PG8_BAR; PG8_WAIT_L(0); PG8_MMA(1, 0, At, B0); PG8_BAR; PG8_SCHED;
            PG8_STAGE(PG8_SB(0, 1), b2 + hstep, voffB);
            PG8_WAIT_V(6); PG8_BAR; PG8_MMA(1, 1, At, B1); PG8_BAR;
            PG8_LDB(B0, 1, 0); PG8_SCHED; PG8_LDA(At, 1, 0); PG8_STAGE(PG8_SA(0, 1), a2 + hstep, voffA);
            PG8_WAIT_L(8); PG8_BAR; PG8_WAIT_L(0); PG8_MMA(0, 0, At, B0); PG8_BAR; PG8_SCHED;
            PG8_LDB(B1, 1, 1); PG8_STAGE(PG8_SB(1, 0), b3, voffB);
            PG8_BAR; PG8_WAIT_L(0); PG8_MMA(0, 1, At, B1); PG8_BAR;
            PG8_LDA(At, 1, 1); PG8_STAGE(PG8_SA(1, 0), a3, voffA);
            PG8_BAR; PG8_WAIT_L(0); PG8_MMA(1, 0, At, B0); PG8_BAR; PG8_SCHED;
            PG8_STAGE(PG8_SB(1, 1), b3 + hstep, voffB);
            PG8_WAIT_V(6); PG8_BAR; PG8_MMA(1, 1, At, B1); PG8_BAR;
            }
        }
        if constexpr (ALIGN_EPI) { if (wr == 0) PG8_BAR; }
        if constexpr (!Epi::AFTER_DRAIN) { E(acc, cur, wr, wc, fr, fq); S.done(cur); }
        if (!has_next) break;
#pragma unroll
        for (int a = 0; a < 2; ++a)
#pragma unroll
            for (int b = 0; b < 2; ++b)
#pragma unroll
                for (int m = 0; m < 4; ++m)
#pragma unroll
                    for (int n = 0; n < 2; ++n) acc[a][b][m][n] = (f32x4){0.f, 0.f, 0.f, 0.f};
        cur = nxt; cA = nA; cB = nB; ++ui;
        if constexpr (ALIGN_EPI) { if (wr == 1) PG8_BAR; }
    }
    PG8_WAIT_V(0);
    if constexpr (!ALIGN_EPI) { if (wr == 0) PG8_BAR; }
    PG8_BAR;
    if constexpr (Epi::AFTER_DRAIN) { E.fused(acc, cur, wr, wc, fr, fq, lds, wid, lane); S.done(cur); }
#undef PG8_SA
#undef PG8_SB
#undef PG8_STAGE
#undef PG8_LDA
#undef PG8_LDB
#undef PG8_MMA
#undef PG8_WAIT_V
#undef PG8_WAIT_L
#undef PG8_BAR
#undef PG8_SCHED
}
}

#ifndef PG8_SP2
#define PG8_SP2 true
#endif
#ifndef PG8_ALIGN
#define PG8_ALIGN true
#endif
constexpr int BATCH = 8, SEQ = 2048, DM = 1024, MROWS = BATCH * SEQ, DEPTH = 2;
constexpr int D_RNN = 512, NHEAD = 8, HDIM = 64, D_INR = 2760, ZP = 2816, TOPK = 256;
constexpr int C_XR = 0, C_GR = 512, C_Q = 1024, C_K = 1536, C_V = 1600, C_GA = 1664, C_QI = 2176, C_KI = 2688, C_WI = 2752;
constexpr float EPS = 1e-6f;
constexpr float QSCALE = 0.125f * 1.4426950408889634f;
constexpr size_t MiB = 1u << 20;
constexpr size_t WS_CTL = 0, CTL_ZERO_BYTES = 1 * MiB;
constexpr size_t WS_MOD = 1 * MiB;
constexpr size_t WS_BIAS = 1 * MiB + 256 * 1024;
constexpr size_t WS_SSQ = 2 * MiB;
constexpr size_t WS_WTIN = 3 * MiB;
constexpr size_t WS_WTOUT = 14 * MiB;
constexpr size_t WS_A = 32 * MiB;
constexpr size_t WS_Z = 64 * MiB;
constexpr size_t WS_Y = 152 * MiB;
constexpr size_t WS_X1 = 184 * MiB;
constexpr size_t WS_END = 216 * MiB;
constexpr int LDS_BYTES = 163840;
constexpr int MISC_OFF = 131072 + 8192;
constexpr int NPHASE = 8;
constexpr int CW_BAR = 4096, CW_PANEL = 16384;

#define LAS __attribute__((address_space(3)))
typedef unsigned short bf16;
typedef float f32x4 __attribute__((ext_vector_type(4)));
typedef unsigned u32x4 __attribute__((ext_vector_type(4)));
typedef unsigned u32x2 __attribute__((ext_vector_type(2)));
__device__ __forceinline__ float bf2f(bf16 v) { return __uint_as_float(((unsigned)v) << 16); }
__device__ __forceinline__ unsigned f2bf(float f) { unsigned u = __float_as_uint(f); return (u + 0x7fffu + ((u >> 16) & 1u)) >> 16; }
__device__ __forceinline__ unsigned pk2(float lo, float hi) { return f2bf(lo) | (f2bf(hi) << 16); }
__device__ __forceinline__ float wave_sum(float v) {
#pragma unroll
    for (int o = 1; o < 64; o <<= 1) v += __shfl_xor(v, o);
    return v;
}
__device__ __forceinline__ float wave_max(float v) {
#pragma unroll
    for (int o = 1; o < 64; o <<= 1) v = fmaxf(v, __shfl_xor(v, o));
    return v;
}
__device__ __forceinline__ int wave_sum_i(int v) {
#pragma unroll
    for (int o = 1; o < 64; o <<= 1) v += __shfl_xor(v, o);
    return v;
}
__device__ __forceinline__ float siluf(float v) { return v / (1.f + expf(-v)); }
__device__ __forceinline__ float sigmf(float v) { return 1.f / (1.f + expf(-v)); }

#ifdef USE_NT
#define NT_STORE(ptr, val) __builtin_nontemporal_store((val), (ptr))
#else
#define NT_STORE(ptr, val) (*(ptr) = (val))
#endif
struct P {
    const float *x, *c, *norm_g, *ada_w, *ada_b, *w_in, *conv_w, *conv_b, *lru_wx, *lru_bx, *lru_wa, *lru_ba, *lru_a, *w_out, *final_g;
    float* out;
    float *mod, *bias, *ssq;
    bf16 *wt_in, *wt_out, *A, *Z, *Y, *X1;
    unsigned* ctl;
};

#ifndef EPI_ZD
#define EPI_ZD 2
#endif
struct EpiZ {
    static constexpr bool PERM = true, AFTER_DRAIN = false;
    bf16* Zp; const float* ssq; const float* bias;
    __device__ __forceinline__ void operator()(const pg8::f32x4 (&acc)[2][2][4][2], const pg8::Unit& u, int wr, int wc, int fr, int fq) const {
        const int row0 = u.pm * 256 + wr * 64 + fr, col0 = u.pn * 256 + wc * 32 + 8 * fq, b = u.pm >> 3;
        const float cs = (u.pn == 4 || u.pn == 5) ? QSCALE : 1.0f;
        f32x4 bv[2][2];
#pragma unroll
        for (int bj = 0; bj < 2; ++bj)
#pragma unroll
            for (int n = 0; n < 2; ++n) bv[bj][n] = *(const f32x4*)(bias + b * ZP + col0 + bj * 128 + 4 * n);
        f32x4 qq[EPI_ZD];
#pragma unroll
        for (int gi = 0; gi < EPI_ZD; ++gi) qq[gi] = *(const f32x4*)(ssq + (size_t)(row0 + (gi >> 2) * 128 + (gi & 3) * 16) * 4);
#pragma unroll
        for (int ai = 0; ai < 2; ++ai)
#pragma unroll
            for (int m = 0; m < 4; ++m) {
                const int r = row0 + ai * 128 + m * 16, gi = ai * 4 + m;
                const f32x4 q = qq[gi % EPI_ZD];
                if (gi + EPI_ZD < 8) qq[gi % EPI_ZD] = *(const f32x4*)(ssq + (size_t)(row0 + ((gi + EPI_ZD) >> 2) * 128 + ((gi + EPI_ZD) & 3) * 16) * 4);
                const float rstd = __builtin_amdgcn_rsqf(((q.x + q.y) + (q.z + q.w)) * (1.0f / 1024.0f) + EPS);
                bf16* rowp = Zp + (size_t)r * ZP + col0;
#pragma unroll
                for (int bj = 0; bj < 2; ++bj) {
                    const f32x4 v0 = (acc[ai][bj][m][0] * rstd + bv[bj][0]) * cs, v1 = (acc[ai][bj][m][1] * rstd + bv[bj][1]) * cs;
                    u32x4 w; w.x = pk2(v0[0], v0[1]); w.y = pk2(v0[2], v0[3]); w.z = pk2(v1[0], v1[1]); w.w = pk2(v1[2], v1[3]);
                    NT_STORE((u32x4*)(rowp + bj * 128), w);
                }
            }
    }
};
#ifndef EPI_XD
#define EPI_XD 4
#endif
struct EpiX {
    static constexpr bool PERM = true, AFTER_DRAIN = true;
    const float* xres; bf16* xout; bf16* Anext; const float* gate; const float* ng; const float* nscale; float* ssq;
    __device__ __forceinline__ void fused(pg8::f32x4 (&acc)[2][2][4][2], const pg8::Unit& u, int wr, int wc, int fr, int fq, LAS unsigned char* lds, int wid, int lane) const {
        const int b = u.pm >> 3, col0 = u.pn * 256 + wc * 32 + 8 * fq;
        LAS float* Pp = (LAS float*)lds;
        f32x4 gv[2][2], gs[2][2];
#pragma unroll
        for (int bj = 0; bj < 2; ++bj)
#pragma unroll
            for (int n = 0; n < 2; ++n) {
                gv[bj][n] = *(const f32x4*)(gate + b * 3072 + col0 + bj * 128 + 4 * n);
                if (Anext) { const f32x4 g = *(const f32x4*)(ng + col0 + bj * 128 + 4 * n), s = *(const f32x4*)(nscale + b * 3072 + col0 + bj * 128 + 4 * n); gs[bj][n] = g * (s + 1.0f); }
                else gs[bj][n] = (f32x4){0.f, 0.f, 0.f, 0.f};
            }
        f32x4 xq[EPI_XD][2][2];
#define EPIX_LOAD(gi) do { const size_t r_ = (size_t)u.pm * 256 + ((gi) >> 2) * 128 + wr * 64 + ((gi) & 3) * 16 + fr; \
        _Pragma("unroll") for (int bj = 0; bj < 2; ++bj) _Pragma("unroll") for (int n = 0; n < 2; ++n) xq[(gi) % EPI_XD][bj][n] = *(const f32x4*)(xres + r_ * DM + col0 + bj * 128 + 4 * n); } while (0)
#pragma unroll
        for (int gi = 0; gi < EPI_XD; ++gi) EPIX_LOAD(gi);
#pragma unroll
        for (int ai = 0; ai < 2; ++ai)
#pragma unroll
            for (int m = 0; m < 4; ++m) {
                const int rl = ai * 128 + wr * 64 + m * 16 + fr; const size_t r = (size_t)u.pm * 256 + rl;
                float s = 0.f;
                f32x4 xc[2][2];
#pragma unroll
                for (int bj = 0; bj < 2; ++bj)
#pragma unroll
                    for (int n = 0; n < 2; ++n) xc[bj][n] = xq[(ai * 4 + m) % EPI_XD][bj][n];
                if (ai * 4 + m + EPI_XD < 8) EPIX_LOAD(ai * 4 + m + EPI_XD);
#pragma unroll
                for (int bj = 0; bj < 2; ++bj) {
                    f32x4 x1[2];
#pragma unroll
                    for (int n = 0; n < 2; ++n) {
                        const f32x4 xr = xc[bj][n];
                        x1[n] = xr + gv[bj][n] * acc[ai][bj][m][n];
                        s += (x1[n][0] * x1[n][0] + x1[n][1] * x1[n][1]) + (x1[n][2] * x1[n][2] + x1[n][3] * x1[n][3]);
                    }
                    { u32x4 xw; xw.x = pk2(x1[0][0], x1[0][1]); xw.y = pk2(x1[0][2], x1[0][3]); xw.z = pk2(x1[1][0], x1[1][1]); xw.w = pk2(x1[1][2], x1[1][3]);
                      NT_STORE((u32x4*)(xout + r * DM + col0 + bj * 128), xw); }
                    if (Anext) { const f32x4 a0 = x1[0] * gs[bj][0], a1 = x1[1] * gs[bj][1];
                        u32x4 w; w.x = pk2(a0[0], a0[1]); w.y = pk2(a0[2], a0[3]); w.z = pk2(a1[0], a1[1]); w.w = pk2(a1[2], a1[3]);
                        NT_STORE((u32x4*)(Anext + r * DM + col0 + bj * 128), w); }
                }
                s += __shfl_xor(s, 16); s += __shfl_xor(s, 32);
                if (fq == 0) Pp[rl * 4 + wc] = s;
            }
        __syncthreads();
        const int tid = wid * 64 + lane;
        if (tid < 256) ssq[((size_t)u.pm * 256 + tid) * 4 + u.pn] = (Pp[tid * 4 + 0] + Pp[tid * 4 + 1]) + (Pp[tid * 4 + 2] + Pp[tid * 4 + 3]);
        __syncthreads();
    }
};

struct EpiXF {
    static constexpr bool PERM = true, AFTER_DRAIN = true;
    const bf16* xres; float* out; const float* gate; const float* fg; float* ssq; unsigned* cnt;
    __device__ __forceinline__ void fused(pg8::f32x4 (&acc)[2][2][4][2], const pg8::Unit& u, int wr, int wc, int fr, int fq, LAS unsigned char* lds, int wid, int lane) const {
        const int b = u.pm >> 3, col0 = u.pn * 256 + wc * 32 + 8 * fq, tid = wid * 64 + lane;
        LAS float* Pp = (LAS float*)lds;
        LAS float* Sr = (LAS float*)(lds + 4096);
        {
            f32x4 gv[2][2];
#pragma unroll
            for (int bj = 0; bj < 2; ++bj)
#pragma unroll
                for (int n = 0; n < 2; ++n) gv[bj][n] = *(const f32x4*)(gate + b * 3072 + col0 + bj * 128 + 4 * n);
#pragma unroll
            for (int ai = 0; ai < 2; ++ai)
#pragma unroll
                for (int m = 0; m < 4; ++m) {
                    const int rl = ai * 128 + wr * 64 + m * 16 + fr; const size_t r = (size_t)u.pm * 256 + rl;
                    float s = 0.f;
#pragma unroll
                    for (int bj = 0; bj < 2; ++bj) {
                        const u32x4 xw = *(const u32x4*)(xres + r * DM + col0 + bj * 128);
#pragma unroll
                        for (int n = 0; n < 2; ++n) {
                            const unsigned w0 = n ? xw.z : xw.x, w1 = n ? xw.w : xw.y;
                            const f32x4 xr = {__uint_as_float(w0 << 16), __uint_as_float(w0 & 0xffff0000u), __uint_as_float(w1 << 16), __uint_as_float(w1 & 0xffff0000u)};
                            const f32x4 x1 = xr + gv[bj][n] * acc[ai][bj][m][n];
                            acc[ai][bj][m][n] = x1;
                            s += (x1[0] * x1[0] + x1[1] * x1[1]) + (x1[2] * x1[2] + x1[3] * x1[3]);
                        }
                    }
                    s += __shfl_xor(s, 16); s += __shfl_xor(s, 32);
                    if (fq == 0) Pp[rl * 4 + wc] = s;
                }
        }
        __syncthreads();
        if (tid < 256) { const float tot = (Pp[tid * 4 + 0] + Pp[tid * 4 + 1]) + (Pp[tid * 4 + 2] + Pp[tid * 4 + 3]);
            __hip_atomic_store(ssq + ((size_t)u.pm * 256 + tid) * 4 + u.pn, tot, __ATOMIC_RELAXED, __HIP_MEMORY_SCOPE_AGENT); }
        asm volatile("s_waitcnt vmcnt(0)" ::: "memory");
        __syncthreads();
        if (tid == 0) {
            unsigned* c = cnt + 64 * u.pm;
            __hip_atomic_fetch_add(c, 1u, __ATOMIC_RELAXED, __HIP_MEMORY_SCOPE_AGENT);
            unsigned spins = 0u;
            while (__hip_atomic_load(c, __ATOMIC_RELAXED, __HIP_MEMORY_SCOPE_AGENT) < 4u) { __builtin_amdgcn_s_sleep(2); if (++spins > (1u << 22)) break; }
            __builtin_amdgcn_fence(__ATOMIC_ACQUIRE, "agent");
            asm volatile("s_waitcnt vmcnt(0)" ::: "memory");
        }
        __syncthreads();
        if (tid < 256) { const float* sp = ssq + ((size_t)u.pm * 256 + tid) * 4;
            const float q0 = __hip_atomic_load(sp + 0, __ATOMIC_RELAXED, __HIP_MEMORY_SCOPE_AGENT), q1 = __hip_atomic_load(sp + 1, __ATOMIC_RELAXED, __HIP_MEMORY_SCOPE_AGENT);
            const float q2 = __hip_atomic_load(sp + 2, __ATOMIC_RELAXED, __HIP_MEMORY_SCOPE_AGENT), q3 = __hip_atomic_load(sp + 3, __ATOMIC_RELAXED, __HIP_MEMORY_SCOPE_AGENT);
            Sr[tid] = 1.0f / sqrtf(((q0 + q1) + (q2 + q3)) * (1.0f / 1024.0f) + EPS); }
        __syncthreads();
        f32x4 fgv[2][2];
#pragma unroll
        for (int bj = 0; bj < 2; ++bj)
#pragma unroll
            for (int n = 0; n < 2; ++n) fgv[bj][n] = *(const f32x4*)(fg + col0 + bj * 128 + 4 * n);
#pragma unroll
        for (int ai = 0; ai < 2; ++ai)
#pragma unroll
            for (int m = 0; m < 4; ++m) {
                const int rl = ai * 128 + wr * 64 + m * 16 + fr; const size_t r = (size_t)u.pm * 256 + rl; const float rstd = Sr[rl];
#pragma unroll
                for (int bj = 0; bj < 2; ++bj)
#pragma unroll
                    for (int n = 0; n < 2; ++n) NT_STORE((f32x4*)(out + r * DM + col0 + bj * 128 + 4 * n), acc[ai][bj][m][n] * rstd * fgv[bj][n]);
            }
        __syncthreads();
    }
};

#ifndef PRO_KC
#define PRO_KC 64
#endif
#ifndef TRQ
#define TRQ 4
#endif
__device__ __forceinline__ void ph0_prologue(const P& p, LAS unsigned char* lds) {
    const int tid = threadIdx.x, lane = tid & 63, wave = tid >> 6, G = gridDim.x, wg = blockIdx.x;
    LAS float* fl = (LAS float*)lds;
    for (int u = wg; u < 96; u += G) {
        const int l = u / 48, j = (u % 48) * 64 + lane;
        { float cv[16];
#pragma unroll
          for (int i = 0; i < 16; ++i) cv[i] = p.c[tid + 512 * i];
#pragma unroll
          for (int i = 0; i < 16; ++i) fl[tid + 512 * i] = siluf(cv[i]); }
        __syncthreads();
        float acc[8];
#pragma unroll
        for (int b = 0; b < 8; ++b) acc[b] = 0.f;
        const float* w = p.ada_w + ((size_t)l * 1024 + wave * 128) * 3072 + j;
#pragma unroll 1
        for (int k0 = 0; k0 < 128; k0 += PRO_KC) { float wv[PRO_KC];
#pragma unroll
          for (int k = 0; k < PRO_KC; ++k) wv[k] = w[(size_t)(k0 + k) * 3072];
#pragma unroll
          for (int k = 0; k < PRO_KC; ++k) {
#pragma unroll
            for (int b = 0; b < 8; ++b) acc[b] += fl[b * 1024 + wave * 128 + k0 + k] * wv[k]; } }
#pragma unroll
        for (int b = 0; b < 8; ++b) fl[8192 + (wave * 8 + b) * 64 + lane] = acc[b];
        __syncthreads();
        { const int b = wave; float s = p.ada_b[l * 3072 + j];
#pragma unroll
          for (int w8 = 0; w8 < 8; ++w8) s += fl[8192 + (w8 * 8 + b) * 64 + lane];
          p.mod[(l * 8 + b) * 3072 + j] = s; }
        __syncthreads();
    }
    const int GT = (G > 96) ? G - 96 : G, wt = (G > 96) ? wg - 96 : wg;
    if (wt >= 0)
#pragma unroll 1
    for (int u0 = wt; u0 < 1920; u0 += TRQ * GT) {
        float v[TRQ][8]; bf16* dst[TRQ]; bool act[TRQ];
#pragma unroll
        for (int q = 0; q < TRQ; ++q) {
            const int u = u0 + q * GT; act[q] = u < 1920; dst[q] = nullptr;
#pragma unroll
            for (int j = 0; j < 8; ++j) v[q][j] = 0.f;
            if (act[q]) {
                const float* W; bf16* WT; int N, kt, nt;
                if (u < 1408) { const int l = u / 704, r = u % 704; kt = r / 44; nt = r % 44; W = p.w_in + (size_t)l * 1024 * D_INR; N = D_INR; WT = p.wt_in + (size_t)l * ZP * 1024; }
                else { int r = u - 1408; const int l = r / 256; r %= 256; kt = r / 16; nt = r % 16; W = p.w_out + (size_t)l * 1024 * 1024; N = 1024; WT = p.wt_out + (size_t)l * 1024 * 1024; }
                const int n = nt * 64 + lane, k0 = kt * 64 + wave * 8;
                if (n < N) {
#pragma unroll
                    for (int j = 0; j < 8; ++j) v[q][j] = W[(size_t)(k0 + j) * N + n];
                }
                dst[q] = WT + (size_t)n * 1024 + k0;
            }
        }
#pragma unroll
        for (int q = 0; q < TRQ; ++q) if (act[q]) { u32x4 o; o.x = pk2(v[q][0], v[q][1]); o.y = pk2(v[q][2], v[q][3]); o.z = pk2(v[q][4], v[q][5]); o.w = pk2(v[q][6], v[q][7]); *(u32x4*)dst[q] = o; }
    }
}
__device__ __forceinline__ void ph1_prologue(const P& p, LAS unsigned char* lds) {
    const int tid = threadIdx.x, lane = tid & 63, wave = tid >> 6, G = gridDim.x, wg = blockIdx.x;
    LAS float* fl = (LAS float*)lds;
    for (int u = wg; u < 88; u += G) {
        const int l = u / 44, n = (u % 44) * 64 + lane;
        { float mv[16];
#pragma unroll
          for (int i = 0; i < 16; ++i) { const int e = tid + 512 * i; mv[i] = p.mod[(l * 8 + (e >> 10)) * 3072 + (e & 1023)]; }
#pragma unroll
          for (int i = 0; i < 16; ++i) fl[tid + 512 * i] = mv[i]; }
        __syncthreads();
        float acc[8];
#pragma unroll
        for (int b = 0; b < 8; ++b) acc[b] = 0.f;
        if (n < D_INR) { const float* w = p.w_in + ((size_t)l * 1024 + wave * 128) * D_INR + n;
#pragma unroll 1
            for (int k0 = 0; k0 < 128; k0 += PRO_KC) { float wv[PRO_KC];
#pragma unroll
              for (int k = 0; k < PRO_KC; ++k) wv[k] = w[(size_t)(k0 + k) * D_INR];
#pragma unroll
              for (int k = 0; k < PRO_KC; ++k) {
#pragma unroll
                for (int b = 0; b < 8; ++b) acc[b] += fl[b * 1024 + wave * 128 + k0 + k] * wv[k]; } } }
#pragma unroll
        for (int b = 0; b < 8; ++b) fl[8192 + (wave * 8 + b) * 64 + lane] = acc[b];
        __syncthreads();
        { const int b = wave; float s = 0.f;
#pragma unroll
          for (int w8 = 0; w8 < 8; ++w8) s += fl[8192 + (w8 * 8 + b) * 64 + lane];
          p.bias[(l * 8 + b) * ZP + n] = s; }
        __syncthreads();
    }
    {
        const int r0 = wg * 8 + wave, rstep = G * 8;
        f32x4 gq[4], xv[2][2][4], sv[2][2][4];
#pragma unroll
        for (int j = 0; j < 4; ++j) gq[j] = *(const f32x4*)(p.norm_g + (lane + 64 * j) * 4);
#define A0_LOAD(slot, pr) do { _Pragma("unroll") for (int h_ = 0; h_ < 2; ++h_) _Pragma("unroll") for (int j = 0; j < 4; ++j) { const int k_ = (lane + 64 * j) * 4, r_ = r0 + rstep * (2 * (pr) + h_); \
            xv[slot][h_][j] = *(const f32x4*)(p.x + (size_t)r_ * DM + k_); sv[slot][h_][j] = *(const f32x4*)(p.mod + (size_t)(r_ >> 11) * 3072 + 1024 + k_); } } while (0)
        A0_LOAD(0, 0);
#pragma unroll
        for (int pr = 0; pr < 4; ++pr) {
            if (pr + 1 < 4) A0_LOAD((pr + 1) & 1, pr + 1);
#pragma unroll
            for (int h = 0; h < 2; ++h) {
                const int r = r0 + rstep * (2 * pr + h); float s1 = 0.f;
#pragma unroll
                for (int j = 0; j < 4; ++j) { const int k = (lane + 64 * j) * 4; const f32x4 v = xv[pr & 1][h][j];
                    s1 += (v[0] * v[0] + v[1] * v[1]) + (v[2] * v[2] + v[3] * v[3]);
                    const f32x4 o1 = v * gq[j] * (sv[pr & 1][h][j] + 1.0f);
                    u32x2 w1; w1.x = pk2(o1[0], o1[1]); w1.y = pk2(o1[2], o1[3]);
                    *(u32x2*)(p.A + (size_t)r * DM + k) = w1; }
                s1 = wave_sum(s1);
                if (lane == 0) *(f32x4*)(p.ssq + (size_t)r * 4) = (f32x4){s1, 0.f, 0.f, 0.f};
            }
        }
#undef A0_LOAD
    }
}
__device__ __forceinline__ void ph_final(const P& p) {
    const int tid = threadIdx.x, lane = tid & 63, wave = tid >> 6, G = gridDim.x, wg = blockIdx.x;
    for (int r = wg * 8 + wave; r < MROWS; r += G * 8) {
        const f32x4 q = *(const f32x4*)(p.ssq + (size_t)r * 4);
        const float rstd = 1.0f / sqrtf(((q.x + q.y) + (q.z + q.w)) * (1.0f / 1024.0f) + EPS);
#pragma unroll
        for (int j = 0; j < 4; ++j) { const int k = (lane + 64 * j) * 4;
            const f32x4 v = *(const f32x4*)(p.out + (size_t)r * DM + k), g = *(const f32x4*)(p.final_g + k);
            *(f32x4*)(p.out + (size_t)r * DM + k) = v * rstd * g; }
    }
}
#define XB_TMO      128
#define XB_XCNT(j)  (256  + 64 * (j))
#define XB_XSUB(j)  (1280 + 64 * (j))
#define XB_XGEN(j)  (2304 + 64 * (j))
#define XB_TOP      3328
#define XB_TOPGEN   3392
#define XCD_BAR_WORDS 3456
#define XB_SPIN_CAP (1u << 18)

__device__ __forceinline__ unsigned xb_ld(unsigned* p)              { return __hip_atomic_load(p, __ATOMIC_RELAXED, __HIP_MEMORY_SCOPE_AGENT); }
__device__ __forceinline__ unsigned xb_add(unsigned* p, unsigned v) { return __hip_atomic_fetch_add(p, v, __ATOMIC_RELAXED, __HIP_MEMORY_SCOPE_AGENT); }
__device__ __forceinline__ unsigned xb_xcc_id() { return (unsigned)__builtin_amdgcn_s_getreg((3 << 11) | 20) & 0xFu; }
#define XB_SPIN(cond, bar) do { unsigned _sp = 0; while (cond) { __builtin_amdgcn_s_sleep(1); \
    if ((++_sp & 255u) == 0u) { if (xb_ld(&(bar)[XB_TMO])) break; if (_sp > XB_SPIN_CAP) { atomicAdd(&(bar)[XB_TMO], 1u); break; } } } } while (0)

struct XcdBarrier {
    unsigned* bar; unsigned x;
    volatile LAS unsigned* st;
};

__device__ __forceinline__ XcdBarrier xcd_barrier_post(unsigned* bar, volatile LAS unsigned* st) {
    XcdBarrier b; b.bar = bar; b.x = xb_xcc_id(); b.st = st;
    if (threadIdx.x == 0) (void)xb_add(&bar[XB_XCNT(b.x)], 1u);
    return b;
}
__device__ __forceinline__ void xcd_barrier_complete(unsigned* bar, unsigned x, unsigned& nloc, unsigned& nx) {
    const unsigned G = gridDim.x * gridDim.y * gridDim.z;
    unsigned sum, cnt, mine, sp = 0u;
    for (;;) {
        sum = 0u; cnt = 0u; mine = 0u;
#pragma unroll
        for (unsigned j = 0; j < 16; ++j) { const unsigned c = xb_ld(&bar[XB_XCNT(j)]); sum += c; cnt += (c > 0u) ? 1u : 0u; mine = (j == x) ? c : mine; }
        if (sum == G) break;
        __builtin_amdgcn_s_sleep(1);
        if ((++sp & 255u) == 0u) { if (xb_ld(&bar[XB_TMO])) break; if (sp > XB_SPIN_CAP) { atomicAdd(&bar[XB_TMO], 1u); break; } }
    }
    nloc = mine > 0u ? mine : 1u; nx = cnt > 0u ? cnt : 1u;
}

__device__ __forceinline__ void xcd_barrier(const XcdBarrier& b) {
    asm volatile("s_waitcnt vmcnt(0)" ::: "memory");
    __syncthreads();
    if (threadIdx.x == 0) {
        unsigned* bar = b.bar;
        __builtin_amdgcn_s_waitcnt(0);
        unsigned nloc = b.st[0], nx = b.st[1];
        if (nloc == 0u) { xcd_barrier_complete(bar, b.x, nloc, nx); b.st[0] = nloc; b.st[1] = nx; }
#ifdef XB_EARLY_WB
        __builtin_amdgcn_fence(__ATOMIC_RELEASE, "agent");
        asm volatile("s_waitcnt vmcnt(0)" ::: "memory");
#endif
        const unsigned old = xb_add(&bar[XB_XSUB(b.x)], 1u);
        const unsigned gen = old / nloc;
        if (old + 1u == (gen + 1u) * nloc) {
#ifndef XB_EARLY_WB
            __builtin_amdgcn_fence(__ATOMIC_RELEASE, "agent");
#endif
            asm volatile("s_waitcnt vmcnt(0)" ::: "memory");
            const unsigned og = xb_add(&bar[XB_TOP], 1u);
            const unsigned tg = og / nx;
            if (og + 1u == (tg + 1u) * nx) xb_add(&bar[XB_TOPGEN], 1u);
            else XB_SPIN(xb_ld(&bar[XB_TOPGEN]) == tg, bar);
            __builtin_amdgcn_fence(__ATOMIC_ACQUIRE, "agent");
            xb_add(&bar[XB_XGEN(b.x)], 1u);
            asm volatile("s_waitcnt vmcnt(0)" ::: "memory");
        } else {
#ifdef XB_FLAT_RELEASE
            XB_SPIN(xb_ld(&bar[XB_TOPGEN]) == gen, bar);
#else
            XB_SPIN(xb_ld(&bar[XB_XGEN(b.x)]) == gen, bar);
#endif
            __builtin_amdgcn_fence(__ATOMIC_ACQUIRE, "agent");
            asm volatile("s_waitcnt vmcnt(0)" ::: "memory");
        }
    }
    __syncthreads();
}
__device__ __forceinline__ unsigned score_ukey(float s) { const unsigned u = __float_as_uint(s + 0.0f); return (u & 0x80000000u) ? ~u : (u | 0x80000000u); }
__device__ __forceinline__ void topk_threshold(const unsigned (&k)[32], unsigned& thr, unsigned& need) {
    unsigned prefix = 0u; bool exact = false;
    for (int bit = 31; bit >= 0; --bit) {
        const unsigned cand = prefix | (1u << bit);
        int c = 0;
#pragma unroll
        for (int i = 0; i < 32; ++i) c += (k[i] >= cand) ? 1 : 0;
        c = wave_sum_i(c);
        if (c >= TOPK) prefix = cand;
        if (c == TOPK) { exact = true; break; }
    }
    thr = prefix;
    if (exact) { need = 0xffffffffu; }
    else { int c = 0;
#pragma unroll
        for (int i = 0; i < 32; ++i) c += (k[i] > prefix) ? 1 : 0;
        c = wave_sum_i(c); need = (unsigned)(TOPK - c); }
}
#ifndef PROBE_VALU
#define PROBE_VALU 0
#endif
#ifndef RP_T3
#define RP_T3 1
#endif
#ifndef RP_T1
#define RP_T1 1
#endif
#ifndef RP_T2
#define RP_T2 1
#endif
#ifndef RP_I
#define RP_I 1
#endif
#ifndef RP_T
#define RP_T 1
#endif
#ifndef RP_V
#define RP_V 1
#endif
typedef short bf16x8v __attribute__((ext_vector_type(8)));
typedef short s16x4v __attribute__((ext_vector_type(4)));
constexpr int BMS = 65;
constexpr int SCP = 2052;
constexpr int DSA_BM_OFF = 16 * SCP * 4;
constexpr int DSA_RING_OFF = 0;
constexpr int DSA_QIB_OFF = 147456;
constexpr int DSA_WIB_OFF = 135680;
constexpr int DSA_MLUT_OFF = 143616;
__device__ __forceinline__ void glds16(const void* gsrc, unsigned lds_dst) { unsigned keep;
    asm volatile("s_mov_b32 %0, m0\n\ts_mov_b32 m0, %2\n\ts_nop 0\n\tglobal_load_lds_dwordx4 %1, off\n\ts_mov_b32 m0, %0" : "=&s"(keep) : "v"(gsrc), "s"(lds_dst) : "memory"); }
template <int I> __device__ __forceinline__ unsigned mbit_t(int mw) { unsigned r; asm("v_bfe_i32 %0, %1, %2, 1" : "=v"(r) : "v"(mw), "i"(I)); return r; }
#define mbit(mw, i) mbit_t<(i)>(mw)
#ifdef ATT_SETPRIO
#define ATT_PRIO(p) __builtin_amdgcn_s_setprio(p)
#else
#define ATT_PRIO(p)
#endif
__device__ __forceinline__ float relu_i(float x) { return __int_as_float(max(__float_as_int(x), 0)); }
#ifndef NO_FMAC_S
__device__ __forceinline__ float fmac_s(float a, float b, float c) { asm("v_fmac_f32_e32 %0, %1, %2" : "+v"(c) : "v"(a), "v"(b)); return c; }
#else
__device__ __forceinline__ float fmac_s(float a, float b, float c) { return a * b + c; }
#endif
__device__ __forceinline__ int imax3(float a, float b, float c) { return max(max(__float_as_int(a), __float_as_int(b)), __float_as_int(c)); }
__device__ __forceinline__ s16x4v lds_tr16(LAS const unsigned char* p) { return __builtin_bit_cast(s16x4v, __builtin_amdgcn_ds_read_tr16_b64_v4i16((LAS s16x4v*)p)); }
__device__ __forceinline__ unsigned cvtpk(float lo, float hi) { typedef float f2 __attribute__((ext_vector_type(2))); typedef __bf16 b2 __attribute__((ext_vector_type(2))); f2 v = {lo, hi}; b2 r = __builtin_convertvector(v, b2); return __builtin_bit_cast(unsigned, r); }


template <int L> __device__ __forceinline__ void wr2lanes(int& w, unsigned lo, unsigned hi) {
    asm volatile("s_nop 1\n\tv_writelane_b32 %0, %1, %3\n\tv_writelane_b32 %0, %2, %4" : "+v"(w) : "s"(lo), "s"(hi), "i"(L), "i"(L + 1));
}
__device__ __forceinline__ int wave_sum_dpp(int v) {
    v += __builtin_amdgcn_update_dpp(0, v, 0xB1, 0xf, 0xf, true);
    v += __builtin_amdgcn_update_dpp(0, v, 0x4E, 0xf, 0xf, true);
    v += __builtin_amdgcn_update_dpp(0, v, 0x141, 0xf, 0xf, true);
    v += __builtin_amdgcn_update_dpp(0, v, 0x140, 0xf, 0xf, true);
    return __builtin_amdgcn_readlane(v, 0) + __builtin_amdgcn_readlane(v, 16) + __builtin_amdgcn_readlane(v, 32) + __builtin_amdgcn_readlane(v, 48);
}
__device__ __forceinline__ unsigned wave_max_dpp(unsigned v) {
    v = max(v, (unsigned)__builtin_amdgcn_update_dpp(0, (int)v, 0xB1, 0xf, 0xf, true));
    v = max(v, (unsigned)__builtin_amdgcn_update_dpp(0, (int)v, 0x4E, 0xf, 0xf, true));
    v = max(v, (unsigned)__builtin_amdgcn_update_dpp(0, (int)v, 0x141, 0xf, 0xf, true));
    v = max(v, (unsigned)__builtin_amdgcn_update_dpp(0, (int)v, 0x140, 0xf, 0xf, true));
    return max(max((unsigned)__builtin_amdgcn_readlane((int)v, 0), (unsigned)__builtin_amdgcn_readlane((int)v, 16)), max((unsigned)__builtin_amdgcn_readlane((int)v, 32), (unsigned)__builtin_amdgcn_readlane((int)v, 48)));
}
__device__ __forceinline__ void cnt8(int& a0, int& a1, int& a2, int& a3, unsigned cand, unsigned k0, unsigned k1, unsigned k2, unsigned k3, unsigned k4, unsigned k5, unsigned k6, unsigned k7) {
    unsigned long long m0, m1, m2, m3, m4, m5, m6, m7;
    asm volatile("v_cmp_le_u32_e64 %4, %12, %13\n\tv_cmp_le_u32_e64 %5, %12, %14\n\tv_cmp_le_u32_e64 %6, %12, %15\n\tv_cmp_le_u32_e64 %7, %12, %16\n\t"
                 "v_cmp_le_u32_e64 %8, %12, %17\n\tv_cmp_le_u32_e64 %9, %12, %18\n\tv_cmp_le_u32_e64 %10, %12, %19\n\tv_cmp_le_u32_e64 %11, %12, %20\n\t"
                 "v_addc_co_u32_e64 %0, %4, 0, %0, %4\n\tv_addc_co_u32_e64 %1, %5, 0, %1, %5\n\tv_addc_co_u32_e64 %2, %6, 0, %2, %6\n\tv_addc_co_u32_e64 %3, %7, 0, %3, %7\n\t"
                 "v_addc_co_u32_e64 %0, %8, 0, %0, %8\n\tv_addc_co_u32_e64 %1, %9, 0, %1, %9\n\tv_addc_co_u32_e64 %2, %10, 0, %2, %10\n\tv_addc_co_u32_e64 %3, %11, 0, %3, %11"
                 : "+v"(a0), "+v"(a1), "+v"(a2), "+v"(a3), "=&s"(m0), "=&s"(m1), "=&s"(m2), "=&s"(m3), "=&s"(m4), "=&s"(m5), "=&s"(m6), "=&s"(m7)
                 : "s"(cand), "v"(k0), "v"(k1), "v"(k2), "v"(k3), "v"(k4), "v"(k5), "v"(k6), "v"(k7));
}
__device__ __forceinline__ int count_ge(const unsigned (&k)[32], unsigned cand_, int nb) {
    const unsigned cand = (unsigned)__builtin_amdgcn_readfirstlane((int)cand_);
    int a0 = 0, a1 = 0, a2 = 0, a3 = 0;
    cnt8(a0, a1, a2, a3, cand, k[0], k[1], k[2], k[3], k[4], k[5], k[6], k[7]);
    if (nb > 1) cnt8(a0, a1, a2, a3, cand, k[8], k[9], k[10], k[11], k[12], k[13], k[14], k[15]);
    if (nb > 2) cnt8(a0, a1, a2, a3, cand, k[16], k[17], k[18], k[19], k[20], k[21], k[22], k[23]);
    if (nb > 3) cnt8(a0, a1, a2, a3, cand, k[24], k[25], k[26], k[27], k[28], k[29], k[30], k[31]);
    return wave_sum_dpp((a0 + a1) + (a2 + a3));
}
__device__ __forceinline__ int wave_scan_dpp(int v) {
    v += __builtin_amdgcn_update_dpp(0, v, 0x111, 0xf, 0xf, false);
    v += __builtin_amdgcn_update_dpp(0, v, 0x112, 0xf, 0xf, false);
    v += __builtin_amdgcn_update_dpp(0, v, 0x114, 0xf, 0xf, false);
    v += __builtin_amdgcn_update_dpp(0, v, 0x118, 0xf, 0xf, false);
    v += __builtin_amdgcn_update_dpp(0, v, 0x142, 0xa, 0xf, false);
    v += __builtin_amdgcn_update_dpp(0, v, 0x143, 0xc, 0xf, false);
    return v;
}
#ifndef WALK_MAX
#define WALK_MAX 4
#endif
#ifndef HIST_WAVES
#define HIST_WAVES 4
#endif
struct TopkState { unsigned prefix; int bit; bool done; unsigned need; int nb; LAS unsigned* hist; int crej; };
#ifndef HB_BITS
#define HB_BITS 8
#endif
__device__ __forceinline__ void topk_hist(const unsigned (&k)[32], TopkState& st, int c_above) {
    constexpr int NBIN = 1 << HB_BITS, BPL = NBIN / 64, SH = 23 - HB_BITS;
    const int lane = threadIdx.x & 63;
    const unsigned T = (unsigned)__builtin_amdgcn_readfirstlane((int)st.prefix);
    LAS unsigned* hist = st.hist;
#pragma unroll
    for (int q = 0; q < BPL / 4; ++q) *(LAS u32x4*)(hist + BPL * lane + 4 * q) = (u32x4){0u, 0u, 0u, 0u};
    asm volatile("" ::: "memory");
    const unsigned hb_ = (unsigned)(uintptr_t)hist; const unsigned one = 1u;
#define HF1(K) "v_subrev_u32_e32 %0, %2, " K "\n\tv_lshrrev_b32_e32 %0, %13, %0\n\tv_cmpx_gt_u32_e32 vcc, %14, %0\n\tv_lshl_add_u32 %0, %0, 2, %3\n\tds_add_u32 %0, %4\n\ts_mov_b64 exec, %1\n\t"
#define HF8(i0) { unsigned t0_; unsigned long long ex_; \
        asm volatile("s_mov_b64 %1, exec\n\t" HF1("%5") HF1("%6") HF1("%7") HF1("%8") HF1("%9") HF1("%10") HF1("%11") HF1("%12") "s_nop 0" \
            : "=&v"(t0_), "=&s"(ex_) : "s"(T), "s"(hb_), "v"(one), "v"(k[i0]), "v"(k[i0 + 1]), "v"(k[i0 + 2]), "v"(k[i0 + 3]), "v"(k[i0 + 4]), "v"(k[i0 + 5]), "v"(k[i0 + 6]), "v"(k[i0 + 7]), "i"(SH), "i"(NBIN) : "vcc", "memory"); }
    HF8(0)
    if (st.nb > 1) HF8(8)
    if (st.nb > 2) HF8(16)
    if (st.nb > 3) HF8(24)
#undef HF8
#undef HF1
    asm volatile("" ::: "memory");
    u32x4 w[BPL / 4]; int t = 0;
#pragma unroll
    for (int q = 0; q < BPL / 4; ++q) { w[q] = *(LAS const u32x4*)(hist + BPL * (63 - lane) + 4 * q); t += (int)((w[q].x + w[q].y) + (w[q].z + w[q].w)); }
    const int P = wave_scan_dpp(t);
    const int k1 = TOPK - c_above;
    const unsigned long long bal = __ballot(P >= k1);
    const int Ls = __builtin_ctzll(bal);
    int c = __builtin_amdgcn_readlane(P, Ls) - __builtin_amdgcn_readlane(t, Ls);
    int bsel = 0, hb = 0; bool found = false;
#pragma unroll
    for (int j = BPL - 1; j >= 0; --j) {
        if (!found) { const int h_ = __builtin_amdgcn_readlane((int)w[j >> 2][j & 3], Ls); if (c + h_ >= k1) { bsel = j; hb = h_; found = true; } else c += h_; }
    }
    const unsigned bin = (unsigned)(BPL * (63 - Ls) + bsel);
    st.prefix = T | (bin << SH); st.bit = SH - 1;
    if (c + hb == k1) { st.done = true; st.need = 0xffffffffu; }
#ifndef NO_TOPK_GATHER
    else if (hb <= 64) {
        const unsigned Pf = (unsigned)__builtin_amdgcn_readfirstlane((int)st.prefix);
        const int k2 = k1 - c;
        LAS unsigned* list = hist;
        int base = 0;
#define GT1(i) { const bool p_ = (k[i] - Pf) < (1u << SH); const unsigned long long m_ = __ballot(p_); \
            if (m_ != 0ull) { const int r_ = base + (int)__builtin_amdgcn_mbcnt_hi((unsigned)(m_ >> 32), __builtin_amdgcn_mbcnt_lo((unsigned)m_, 0u)); if (p_) list[r_] = k[i]; base += __popcll(m_); } }
#define GT4(i0) { const unsigned dm_ = min(min(k[i0] - Pf, k[i0 + 1] - Pf), min(k[i0 + 2] - Pf, k[i0 + 3] - Pf)); \
            if (__ballot(dm_ < (1u << SH)) != 0ull) { GT1(i0) GT1(i0 + 1) GT1(i0 + 2) GT1(i0 + 3) } }
        GT4(0) GT4(4)
        if (st.nb > 1) { GT4(8) GT4(12) }
        if (st.nb > 2) { GT4(16) GT4(20) }
        if (st.nb > 3) { GT4(24) GT4(28) }
#undef GT4
#undef GT1
        asm volatile("" ::: "memory");
        const unsigned v = (lane < hb) ? list[lane] : 0u;
        int g = 0, ge = 0;
#pragma unroll 1
        for (int j = 0; j < hb; ++j) { const unsigned s_ = (unsigned)__builtin_amdgcn_readlane((int)v, j); g += (s_ > v) ? 1 : 0; ge += (s_ >= v) ? 1 : 0; }
        const unsigned long long hit = __ballot(lane < hb && g < k2 && ge >= k2);
        if (hit != 0ull) {
            const int Lh = __builtin_ctzll(hit);
            const int gs = __builtin_amdgcn_readlane(g, Lh), ges = __builtin_amdgcn_readlane(ge, Lh);
            st.prefix = (unsigned)__builtin_amdgcn_readlane((int)v, Lh); st.done = true;
            st.need = (ges - gs == k2 - gs) ? 0xffffffffu : (unsigned)(k2 - gs);
        }
    }
#endif
}
__device__ __forceinline__ bool topk_histE(const unsigned (&k)[32], TopkState& st, unsigned Etop_, int k1, int cbase) {
    const int lane = threadIdx.x & 63;
    const unsigned Etop = (unsigned)__builtin_amdgcn_readfirstlane((int)Etop_);
    LAS unsigned* hist = st.hist;
    *(LAS u32x4*)(hist + 8 * lane) = (u32x4){0u, 0u, 0u, 0u}; *(LAS u32x4*)(hist + 8 * lane + 4) = (u32x4){0u, 0u, 0u, 0u};
    asm volatile("" ::: "memory");
    const unsigned hb_ = (unsigned)(uintptr_t)hist, one = 1u, l7 = (unsigned)lane & 7u;
#define HE1(K) "v_lshrrev_b32_e32 %0, 23, " K "\n\tv_sub_u32_e32 %0, %2, %0\n\tv_cmpx_gt_u32_e32 vcc, 64, %0\n\tv_lshl_or_b32 %0, %0, 3, %5\n\tv_lshl_add_u32 %0, %0, 2, %3\n\tds_add_u32 %0, %4\n\ts_mov_b64 exec, %1\n\t"
#define HE8(i0) { unsigned t0_; unsigned long long ex_; \
        asm volatile("s_mov_b64 %1, exec\n\t" HE1("%6") HE1("%7") HE1("%8") HE1("%9") HE1("%10") HE1("%11") HE1("%12") HE1("%13") "s_nop 0" \
            : "=&v"(t0_), "=&s"(ex_) : "s"(Etop), "s"(hb_), "v"(one), "v"(l7), "v"(k[i0]), "v"(k[i0 + 1]), "v"(k[i0 + 2]), "v"(k[i0 + 3]), "v"(k[i0 + 4]), "v"(k[i0 + 5]), "v"(k[i0 + 6]), "v"(k[i0 + 7]) : "vcc", "memory"); }
    HE8(0)
    if (st.nb > 1) HE8(8)
    if (st.nb > 2) HE8(16)
    if (st.nb > 3) HE8(24)
#undef HE8
#undef HE1
    asm volatile("" ::: "memory");
    const u32x4 w0 = *(LAS const u32x4*)(hist + 8 * lane), w1 = *(LAS const u32x4*)(hist + 8 * lane + 4);
    const int t = (int)(((w0.x + w0.y) + (w0.z + w0.w)) + ((w1.x + w1.y) + (w1.z + w1.w)));
    const int P = wave_scan_dpp(t);
    const unsigned long long bal = __ballot(P >= k1);
    if (bal == 0ull) return false;
    const int Ls = __builtin_ctzll(bal);
    const int S = __builtin_amdgcn_readlane(P, Ls), cab = S - __builtin_amdgcn_readlane(t, Ls);
    st.prefix = (Etop - (unsigned)Ls) << 23; st.bit = 22; st.crej = cbase + cab;
    if (S == k1) { st.done = true; st.need = 0xffffffffu; }
    return true;
}
__device__ __forceinline__ void topk_init(const unsigned (&k)[32], TopkState& st) {
    unsigned mx = 0u;
#pragma unroll
    for (int i = 0; i < 32; ++i) mx = max(mx, k[i]);
    mx = wave_max_dpp(mx);
    st.prefix = 0u; st.bit = 31; st.done = false; st.need = 0u; st.crej = 0;
    const unsigned E = mx >> 23;
    bool ok = false;
    if (E >= 320u) ok = topk_histE(k, st, E, TOPK, 0);
    if (!ok) {
        const int npos = (E >= 256u) ? count_ge(k, 0x80000000u, st.nb) : 0;
        if (npos < TOPK) {
            unsigned mn = 0u;
#pragma unroll
            for (int i = 0; i < 32; ++i) mn = max(mn, k[i] & ~(unsigned)((int)k[i] >> 31));
            mn = wave_max_dpp(mn);
            const unsigned En = mn >> 23;
            if (En >= 64u) ok = topk_histE(k, st, En, TOPK - npos, npos);
        }
    }
    if (ok && !st.done) topk_hist(k, st, st.crej);
}
__device__ __forceinline__ void topk_step(const unsigned (&k)[32], TopkState& st) {
    if (st.done) return;
    if (st.bit < 0) { int c = 0;
#pragma unroll
        for (int i = 0; i < 32; ++i) c += (k[i] > st.prefix) ? 1 : 0;
        c = wave_sum_dpp(c); st.need = (unsigned)(TOPK - c); st.done = true; return; }
    const unsigned cand = st.prefix | (1u << st.bit);
    const int c = count_ge(k, cand, st.nb);
    if (c >= TOPK) st.prefix = cand; else st.crej = c;
    if (c == TOPK) { st.done = true; st.need = 0xffffffffu; }
    --st.bit;
#ifndef NO_TOPK_HIST
    if (st.bit == 22 && !st.done && st.hist) topk_hist(k, st, st.crej);
#endif
}

__device__ __forceinline__ void dsa_prefetch_qi(const bf16* zb, int qt, LAS unsigned char* lds, int wave, int lane) {
    const unsigned lds_base = (unsigned)(uintptr_t)lds;
#pragma unroll
    for (int i = 0; i < 2; ++i) { const int row = 2 * wave + i;
        glds16(zb + (size_t)(qt * 16 + row) * ZP + C_QI + ((lane ^ row) * 8), (unsigned)__builtin_amdgcn_readfirstlane(lds_base + DSA_QIB_OFF + row * 1024)); }
    if (wave == 0) glds16(zb + (size_t)(qt * 16 + (lane & 15)) * ZP + C_WI, (unsigned)__builtin_amdgcn_readfirstlane(lds_base + DSA_WIB_OFF));
}

__device__ __forceinline__ void dsa_prefetch_ki(const bf16* zb, int qt, bf16x8v (&pk)[4], int wave, int lane) {
    const int r16 = lane & 15, g = lane >> 4;
    if (wave <= qt) { const bf16* krow = zb + (size_t)(wave * 16 + r16) * ZP + C_KI; pk[0] = *(const bf16x8v*)(krow + 8 * g); pk[1] = *(const bf16x8v*)(krow + 32 + 8 * g); }
    if (wave + 8 <= qt) { const bf16* krow = zb + (size_t)((wave + 8) * 16 + r16) * ZP + C_KI; pk[2] = *(const bf16x8v*)(krow + 8 * g); pk[3] = *(const bf16x8v*)(krow + 32 + 8 * g); }
}

#ifdef DSA_DYNQ
constexpr int DSA_NEXT_OFF = 143360 + 32;
constexpr int CW_QUEUE = 24576;
__device__ __forceinline__ void dsa_unit(const P& p, int b, int qt, int& qt_next, unsigned* queue, bf16x8v (&pk)[4], LAS unsigned char* lds) {
    unsigned nraw_ = 0u;
    if (threadIdx.x == 0) nraw_ = __hip_atomic_fetch_add(queue, 1u, __ATOMIC_RELAXED, __HIP_MEMORY_SCOPE_AGENT);
#else
__device__ __forceinline__ void dsa_unit(const P& p, int b, int qt, int qt_next, bf16x8v (&pk)[4], LAS unsigned char* lds) {
#endif
    const int tid = threadIdx.x, lane = tid & 63, wave = __builtin_amdgcn_readfirstlane(tid >> 6), r16 = lane & 15, g = lane >> 4;
    const int q0 = qt * 16; const bf16* zb = p.Z + (size_t)b * SEQ * ZP;
    LAS float* SC = (LAS float*)lds; LAS unsigned* BM = (LAS unsigned*)(lds + DSA_BM_OFF);
    const bool dense_all = (qt < TOPK / 16);
    const bf16* qrow = zb + (size_t)(q0 + r16) * ZP;
    const bf16x8v bq0 = *(const bf16x8v*)(qrow + C_Q + wave * 64 + 8 * g), bq1 = *(const bf16x8v*)(qrow + C_Q + wave * 64 + 32 + 8 * g);
    u32x2 gwv[4];
#pragma unroll
    for (int dt = 0; dt < 4; ++dt) gwv[dt] = *(const u32x2*)(qrow + C_GA + wave * 64 + dt * 16 + 4 * g);
    const int nsteps = (((q0 + 16 + 31) >> 5) + 1) & ~1, nmega = (nsteps + 7) >> 3;
    const int kkey = lane >> 3, vkey = lane >> 1, vhalf = lane & 1;
    const unsigned lds_base = (unsigned)(uintptr_t)lds;
#define DSA_STAGE(mm) do { const int st_ = (mm) * 8 + wave; if (st_ < nsteps) { \
        const bf16* kb_ = zb + (size_t)st_ * 32 * ZP; const unsigned ldsb_ = lds_base + (unsigned)(((mm) & 1) * 65536 + wave * 4096); \
        _Pragma("unroll") for (int c_ = 0; c_ < 4; ++c_) { const int key_ = 8 * c_ + kkey, ch_ = (lane & 7) ^ ((key_ & 15) >> 1); \
            glds16(kb_ + (size_t)key_ * ZP + C_K + ch_ * 8, (unsigned)__builtin_amdgcn_readfirstlane(ldsb_ + c_ * 1024)); } \
        _Pragma("unroll") for (int c_ = 0; c_ < 4; ++c_) \
            glds16(kb_ + (size_t)vkey * ZP + C_V + c_ * 16 + vhalf * 8, (unsigned)__builtin_amdgcn_readfirstlane(ldsb_ + 32768 + c_ * 1024)); } } while (0)
    if (!dense_all) {
        for (int rpI = 0; rpI < RP_I; ++rpI) {
        bf16x8v bq[8][2]; float wv[8];
#pragma unroll
        for (int h = 0; h < 8; ++h) { bq[h][0] = *(LAS const bf16x8v*)(lds + DSA_QIB_OFF + r16 * 1024 + (((8 * h + g) ^ r16) * 16)); bq[h][1] = *(LAS const bf16x8v*)(lds + DSA_QIB_OFF + r16 * 1024 + (((8 * h + 4 + g) ^ r16) * 16));
            wv[h] = bf2f(*(LAS const bf16*)(lds + DSA_WIB_OFF + r16 * 16 + h * 2)) * 0.35355339059327373f * 0.125f; }
        bf16x8v ra0 = pk[0], ra1 = pk[1], rb0 = pk[2], rb1 = pk[3], rc0 = pk[0], rc1 = pk[1];
#if defined(PROBE_IDX_MFMA)
        f32x4 dacc = {0.f, 0.f, 0.f, 0.f};
#define PROBE_XMFMA(c0, c1, h) dacc = __builtin_amdgcn_mfma_f32_16x16x32_bf16(c0, bq[h][0], dacc, 0, 0, 0); dacc = __builtin_amdgcn_mfma_f32_16x16x32_bf16(c1, bq[h][1], dacc, 0, 0, 0);
#else
#define PROBE_XMFMA(c0, c1, h)
#endif
#if defined(PROBE_IDX_VALU)
        unsigned dv0 = 1u, dv1 = 2u, dv2 = 3u, dv3 = 4u;
#define PROBE_XVALU() asm volatile("v_add_u32_e32 %0, 1, %0\n\tv_add_u32_e32 %1, 1, %1\n\tv_add_u32_e32 %2, 1, %2\n\tv_add_u32_e32 %3, 1, %3\n\tv_add_u32_e32 %0, 1, %0\n\tv_add_u32_e32 %1, 1, %1\n\tv_add_u32_e32 %2, 1, %2\n\tv_add_u32_e32 %3, 1, %3" : "+v"(dv0), "+v"(dv1), "+v"(dv2), "+v"(dv3));
#else
#define PROBE_XVALU()
#endif
#define IDX_LOAD(d0, d1, ktl) do { const int ktl_ = (ktl) <= qt ? (ktl) : qt;        \
            const bf16* krow_ = zb + (size_t)(ktl_ * 16 + r16) * ZP + C_KI; d0 = *(const bf16x8v*)(krow_ + 8 * g); d1 = *(const bf16x8v*)(krow_ + 32 + 8 * g); } while (0)
#define IDX_STEP(c0, c1) do { \
            f32x4 sc = {0.f, 0.f, 0.f, 0.f}; \
            _Pragma("unroll") for (int h = 0; h < 8; ++h) { \
                f32x4 acc = {0.f, 0.f, 0.f, 0.f}; \
                acc = __builtin_amdgcn_mfma_f32_16x16x32_bf16(c0, bq[h][0], acc, 0, 0, 0); \
                acc = __builtin_amdgcn_mfma_f32_16x16x32_bf16(c1, bq[h][1], acc, 0, 0, 0); \
                PROBE_XMFMA(c0, c1, h) \
                _Pragma("unroll") for (int i = 0; i < 4; ++i) sc[i] = fmac_s(relu_i(acc[i]), wv[h], sc[i]); \
                PROBE_XVALU() \
            } \
            if (__builtin_amdgcn_readfirstlane(kt) == qt) {                  \
                _Pragma("unroll") for (int i = 0; i < 4; ++i) sc[i] = (4 * g + i > r16) ? -INFINITY : sc[i]; \
            } \
            *(LAS f32x4*)(SC + r16 * SCP + kt * 16 + 4 * g) = sc; } while (0)
        int kt = wave;
        const int nst = (qt - wave + 8) >> 3;
#ifdef IDX_PAIR
#define IDX_PAIR_STEP(c0, c1, e0, e1) do { \
            f32x4 sc = {0.f, 0.f, 0.f, 0.f}, sd = {0.f, 0.f, 0.f, 0.f}; \
            _Pragma("unroll") for (int h = 0; h < 8; ++h) { \
                f32x4 acc = {0.f, 0.f, 0.f, 0.f}, acd = {0.f, 0.f, 0.f, 0.f}; \
                acc = __builtin_amdgcn_mfma_f32_16x16x32_bf16(c0, bq[h][0], acc, 0, 0, 0); acd = __builtin_amdgcn_mfma_f32_16x16x32_bf16(e0, bq[h][0], acd, 0, 0, 0); \
                acc = __builtin_amdgcn_mfma_f32_16x16x32_bf16(c1, bq[h][1], acc, 0, 0, 0); acd = __builtin_amdgcn_mfma_f32_16x16x32_bf16(e1, bq[h][1], acd, 0, 0, 0); \
                _Pragma("unroll") for (int i = 0; i < 4; ++i) { sc[i] = fmac_s(relu_i(acc[i]), wv[h], sc[i]); sd[i] = fmac_s(relu_i(acd[i]), wv[h], sd[i]); } \
            } \
            if (__builtin_amdgcn_readfirstlane(kt) + 8 >= qt) {               \
                _Pragma("unroll") for (int i = 0; i < 4; ++i) { sc[i] = (kt == qt && 4 * g + i > r16) ? -INFINITY : sc[i]; sd[i] = (kt + 8 == qt && 4 * g + i > r16) ? -INFINITY : sd[i]; } \
            } \
            *(LAS f32x4*)(SC + r16 * SCP + kt * 16 + 4 * g) = sc; *(LAS f32x4*)(SC + r16 * SCP + (kt + 8) * 16 + 4 * g) = sd; } while (0)
        bf16x8v rd0 = pk[0], rd1 = pk[1];
        IDX_LOAD(rc0, rc1, kt + 16); IDX_LOAD(rd0, rd1, kt + 24);
        const int ntrip = nst >> 2, rem = nst & 3;
#pragma unroll 1
        for (int it = ntrip; it > 0; --it) {
            IDX_PAIR_STEP(ra0, ra1, rb0, rb1); __builtin_amdgcn_sched_barrier(0); IDX_LOAD(ra0, ra1, kt + 32); IDX_LOAD(rb0, rb1, kt + 40); __builtin_amdgcn_sched_barrier(0); kt += 16;
            IDX_PAIR_STEP(rc0, rc1, rd0, rd1); __builtin_amdgcn_sched_barrier(0); IDX_LOAD(rc0, rc1, kt + 32); IDX_LOAD(rd0, rd1, kt + 40); __builtin_amdgcn_sched_barrier(0); kt += 16;
        }
        if (rem >= 2) { IDX_PAIR_STEP(ra0, ra1, rb0, rb1); kt += 16; if (rem == 3) { IDX_STEP(rc0, rc1); } }
        else if (rem == 1) { IDX_STEP(ra0, ra1); }
#undef IDX_PAIR_STEP
#else
        const int ntrip = (nst * 11) >> 5, rem = nst - 3 * ntrip;
#pragma unroll 1
        for (int it = ntrip; it > 0; --it) {
            IDX_LOAD(rc0, rc1, kt + 16); __builtin_amdgcn_sched_barrier(0); IDX_STEP(ra0, ra1); __builtin_amdgcn_sched_barrier(0); kt += 8;
            IDX_LOAD(ra0, ra1, kt + 16); __builtin_amdgcn_sched_barrier(0); IDX_STEP(rb0, rb1); __builtin_amdgcn_sched_barrier(0); kt += 8;
            IDX_LOAD(rb0, rb1, kt + 16); __builtin_amdgcn_sched_barrier(0); IDX_STEP(rc0, rc1); __builtin_amdgcn_sched_barrier(0); kt += 8;
        }
        if (rem >= 1) { IDX_STEP(ra0, ra1); kt += 8; if (rem >= 2) { IDX_STEP(rb0, rb1); } }
#endif
#if defined(PROBE_IDX_MFMA)
        asm volatile("s_nop 7\n\ts_nop 7" :: "v"(dacc));
#endif
#undef IDX_LOAD
#undef IDX_STEP
        __syncthreads();
        }
#pragma unroll 1
        for (int rpT = 0; rpT < RP_T; ++rpT) {
            const int ra = 2 * wave, rb = 2 * wave + 1, ta = q0 + ra, tb = q0 + rb;
            unsigned ka[32], kb[32];
#ifdef KLG
#pragma unroll
            for (int i0 = 0; i0 < 32; i0 += KLG) {
                float fa[KLG], fb[KLG];
#pragma unroll
                for (int j = 0; j < KLG; ++j) { fa[j] = SC[ra * SCP + lane + 64 * (i0 + j)]; fb[j] = SC[rb * SCP + lane + 64 * (i0 + j)]; }
#pragma unroll
                for (int j = 0; j < KLG; ++j) { const int key = lane + 64 * (i0 + j); ka[i0 + j] = (key <= ta) ? score_ukey(fa[j]) : 0u; kb[i0 + j] = (key <= tb) ? score_ukey(fb[j]) : 0u; }
            }
#else
#pragma unroll
            for (int i = 0; i < 32; ++i) { const int key = lane + 64 * i; ka[i] = (key <= ta) ? score_ukey(SC[ra * SCP + key]) : 0u; kb[i] = (key <= tb) ? score_ukey(SC[rb * SCP + key]) : 0u; }
#endif
#if RP_T1 > 1
            asm volatile("" :: "v"(ka[0]), "v"(kb[31]) : "memory");
#pragma unroll
            for (int i = 0; i < 32; ++i) { const int key = lane + 64 * i; ka[i] = (key <= ta) ? score_ukey(SC[ra * SCP + key]) : 0u; kb[i] = (key <= tb) ? score_ukey(SC[rb * SCP + key]) : 0u; }
            asm volatile("" ::: "memory");
#endif
            asm volatile("s_waitcnt lgkmcnt(0)" ::: "memory");
            __syncthreads();
            DSA_STAGE(0);
            TopkState sa, sb; sa.nb = (ta >> 9) + 1; sb.nb = (tb >> 9) + 1;
            sa.hist = (wave < HIST_WAVES) ? (LAS unsigned*)(lds + 65536 + ra * 4096) : (LAS unsigned*)nullptr; sb.hist = (wave < HIST_WAVES) ? (LAS unsigned*)(lds + 65536 + rb * 4096) : (LAS unsigned*)nullptr;
            topk_init(ka, sa); topk_init(kb, sb);
#pragma unroll 1
            while (!(sa.done && sb.done)) { topk_step(ka, sa); topk_step(kb, sb); }
#if RP_T2 > 1
            asm volatile("" :: "v"(sa.prefix), "v"(sb.prefix));
            topk_init(ka, sa); topk_init(kb, sb);
#pragma unroll 1
            while (!(sa.done && sb.done)) { topk_step(ka, sa); topk_step(kb, sb); }
#endif
            if (sa.need == 0xffffffffu && sb.need == 0xffffffffu) {
                const unsigned ta_ = (unsigned)__builtin_amdgcn_readfirstlane((int)sa.prefix), tb_ = (unsigned)__builtin_amdgcn_readfirstlane((int)sb.prefix);
                int wa = 0, wb = 0;
#define WR2(i) { const unsigned long long ma = __ballot(ka[i] >= ta_), mb = __ballot(kb[i] >= tb_); wr2lanes<2 * (i)>(wa, (unsigned)ma, (unsigned)(ma >> 32)); wr2lanes<2 * (i)>(wb, (unsigned)mb, (unsigned)(mb >> 32)); }
                WR2(0) WR2(1) WR2(2) WR2(3) WR2(4) WR2(5) WR2(6) WR2(7) WR2(8) WR2(9) WR2(10) WR2(11) WR2(12) WR2(13) WR2(14) WR2(15)
                WR2(16) WR2(17) WR2(18) WR2(19) WR2(20) WR2(21) WR2(22) WR2(23) WR2(24) WR2(25) WR2(26) WR2(27) WR2(28) WR2(29) WR2(30) WR2(31)
#undef WR2
                BM[ra * BMS + lane] = (unsigned)wa; BM[rb * BMS + lane] = (unsigned)wb;
#if RP_T3 > 1
                asm volatile("" : "+v"(wa), "+v"(wb) :: "memory");
#define WR2(i) { const unsigned long long ma = __ballot(ka[i] >= ta_), mb = __ballot(kb[i] >= tb_); wr2lanes<2 * (i)>(wa, (unsigned)ma, (unsigned)(ma >> 32)); wr2lanes<2 * (i)>(wb, (unsigned)mb, (unsigned)(mb >> 32)); }
                WR2(0) WR2(1) WR2(2) WR2(3) WR2(4) WR2(5) WR2(6) WR2(7) WR2(8) WR2(9) WR2(10) WR2(11) WR2(12) WR2(13) WR2(14) WR2(15)
                WR2(16) WR2(17) WR2(18) WR2(19) WR2(20) WR2(21) WR2(22) WR2(23) WR2(24) WR2(25) WR2(26) WR2(27) WR2(28) WR2(29) WR2(30) WR2(31)
#undef WR2
                BM[ra * BMS + lane] = (unsigned)wa; BM[rb * BMS + lane] = (unsigned)wb;
#endif
            } else {
            unsigned eqa = 0u, eqb = 0u;
#pragma unroll 1
            for (int i = 0; i < 32; ++i) {
                unsigned kai = ka[0], kbi = kb[0];
#pragma unroll
                for (int j = 1; j < 32; ++j) { kai = (i == j) ? ka[j] : kai; kbi = (i == j) ? kb[j] : kbi; }
                { const bool eq = (kai == sa.prefix); const unsigned long long em = __ballot(eq);
                  const unsigned erank = eqa + __builtin_amdgcn_mbcnt_hi((unsigned)(em >> 32), __builtin_amdgcn_mbcnt_lo((unsigned)em, 0u));
                  const unsigned long long smk = __ballot((kai > sa.prefix) || (eq && erank < sa.need));
                  if (lane == 0) { BM[ra * BMS + 2 * i] = (unsigned)smk; BM[ra * BMS + 2 * i + 1] = (unsigned)(smk >> 32); }
                  eqa += (unsigned)__popcll(em); }
                { const bool eq = (kbi == sb.prefix); const unsigned long long em = __ballot(eq);
                  const unsigned erank = eqb + __builtin_amdgcn_mbcnt_hi((unsigned)(em >> 32), __builtin_amdgcn_mbcnt_lo((unsigned)em, 0u));
                  const unsigned long long smk = __ballot((kbi > sb.prefix) || (eq && erank < sb.need));
                  if (lane == 0) { BM[rb * BMS + 2 * i] = (unsigned)smk; BM[rb * BMS + 2 * i + 1] = (unsigned)(smk >> 32); }
                  eqb += (unsigned)__popcll(em); }
            }
            }
        }
    } else {
        for (int i = tid; i < 1024; i += 512) { const int row = i >> 6, w = i & 63, t = q0 + row, lo = 32 * w;
            BM[row * BMS + w] = (t >= lo + 31) ? 0xffffffffu : ((t < lo) ? 0u : ((2u << (t - lo)) - 1u)); }
        DSA_STAGE(0);
    }
    __syncthreads();
    const int h = wave;
#pragma unroll 1
    for (int rpV = 0; rpV < RP_V; ++rpV) {
    asm volatile("s_waitcnt vmcnt(0)" ::: "memory");
#ifdef DSA_DYNQ
    if (threadIdx.x == 0) *(volatile LAS unsigned*)(lds + DSA_NEXT_OFF) = nraw_;
#endif
    asm volatile("" :: "v"(bq0), "v"(bq1), "v"(gwv[0]), "v"(gwv[1]), "v"(gwv[2]), "v"(gwv[3]));
    __syncthreads();
#ifdef DSA_DYNQ
    { const unsigned nidx_ = *(volatile LAS unsigned*)(lds + DSA_NEXT_OFF); qt_next = (nidx_ <= 95u) ? 95 - (int)nidx_ : -1; qt_next = __builtin_amdgcn_readfirstlane(qt_next); }
#endif
    if (qt_next >= TOPK / 16) { dsa_prefetch_qi(zb, qt_next, lds, wave, lane); dsa_prefetch_ki(zb, qt_next, pk, wave, lane); }
    f32x4 o[4], lacc = {0.f, 0.f, 0.f, 0.f}, negm = {0.f, 0.f, 0.f, 0.f};
#pragma unroll
    for (int dt = 0; dt < 4; ++dt) o[dt] = (f32x4){0.f, 0.f, 0.f, 0.f};
    float m_run = 0.f;
    const int kofs0 = r16 * 128 + ((g ^ (r16 >> 1)) & 7) * 16, kofs1 = r16 * 128 + (((4 + g) ^ (r16 >> 1)) & 7) * 16;
    const int vofs = 32768 + (4 * g + ((lane & 15) >> 2)) * 32 + (lane & 3) * 8;
    bf16x8v ones = {0x3f80, 0x3f80, 0x3f80, 0x3f80, 0x3f80, 0x3f80, 0x3f80, 0x3f80};
    asm volatile("" : "+v"(ones));
    LAS const unsigned char* mlut = lds + DSA_MLUT_OFF;
    constexpr float THR = 8.0f;
    bool first = true;
#pragma unroll 1
    for (int mm = 0; mm < nmega; ++mm) {
        if (mm + 1 < nmega) DSA_STAGE(mm + 1);
        LAS unsigned char* slotb = lds + (mm & 1) * 65536;
        const int nsub = (nsteps - mm * 8) < 8 ? (nsteps - mm * 8) : 8;
#pragma unroll 1
        for (int u = 0; u < nsub; u += 2) {
            LAS unsigned char* slot = slotb + u * 4096;
            const int mwA = (int)(BM[r16 * BMS + mm * 8 + u] >> (4 * g)), mwB = (int)(BM[r16 * BMS + mm * 8 + u + 1] >> (4 * g));
            f32x4 s0, s1, s2, s3;
            { const bf16x8v ka0 = *(LAS const bf16x8v*)(slot + kofs0), ka1 = *(LAS const bf16x8v*)(slot + kofs1);
              const bf16x8v kb0 = *(LAS const bf16x8v*)(slot + 2048 + kofs0), kb1 = *(LAS const bf16x8v*)(slot + 2048 + kofs1);
              const bf16x8v kc0 = *(LAS const bf16x8v*)(slot + 4096 + kofs0), kc1 = *(LAS const bf16x8v*)(slot + 4096 + kofs1);
              const bf16x8v kd0 = *(LAS const bf16x8v*)(slot + 6144 + kofs0), kd1 = *(LAS const bf16x8v*)(slot + 6144 + kofs1);
              ATT_PRIO(1);
              s0 = __builtin_amdgcn_mfma_f32_16x16x32_bf16(ka0, bq0, negm, 0, 0, 0); s1 = __builtin_amdgcn_mfma_f32_16x16x32_bf16(kb0, bq0, negm, 0, 0, 0);
              s2 = __builtin_amdgcn_mfma_f32_16x16x32_bf16(kc0, bq0, negm, 0, 0, 0); s3 = __builtin_amdgcn_mfma_f32_16x16x32_bf16(kd0, bq0, negm, 0, 0, 0);
              s0 = __builtin_amdgcn_mfma_f32_16x16x32_bf16(ka1, bq1, s0, 0, 0, 0); s1 = __builtin_amdgcn_mfma_f32_16x16x32_bf16(kb1, bq1, s1, 0, 0, 0);
              s2 = __builtin_amdgcn_mfma_f32_16x16x32_bf16(kc1, bq1, s2, 0, 0, 0); s3 = __builtin_amdgcn_mfma_f32_16x16x32_bf16(kd1, bq1, s3, 0, 0, 0); ATT_PRIO(0); }
            const int lmi = max(max(max(imax3(s0[0], s0[1], s0[2]), imax3(s0[3], s1[0], s1[1])), max(imax3(s1[2], s1[3], s2[0]), imax3(s2[1], s2[2], s2[3]))), max(imax3(s3[0], s3[1], s3[2]), __float_as_int(s3[3])));
            if (first || __any(lmi > 0x41000000)) {
                float lmx = fmaxf(fmaxf(fmaxf(fmaxf(s0[0], s0[1]), fmaxf(s0[2], s0[3])), fmaxf(fmaxf(s1[0], s1[1]), fmaxf(s1[2], s1[3]))), fmaxf(fmaxf(fmaxf(s2[0], s2[1]), fmaxf(s2[2], s2[3])), fmaxf(fmaxf(s3[0], s3[1]), fmaxf(s3[2], s3[3]))));
                { const auto r1 = __builtin_amdgcn_permlane16_swap(__float_as_uint(lmx), __float_as_uint(lmx), false, false); lmx = fmaxf(__uint_as_float(r1[0]), __uint_as_float(r1[1])); }
                { const auto r2 = __builtin_amdgcn_permlane32_swap(__float_as_uint(lmx), __float_as_uint(lmx), false, false); lmx = fmaxf(__uint_as_float(r2[0]), __uint_as_float(r2[1])); }
                const float dl = first ? lmx : fmaxf(lmx, 0.f);
                m_run += dl; const float f = first ? 1.0f : __builtin_amdgcn_exp2f(-dl);
#pragma unroll
                for (int i = 0; i < 4; ++i) { s0[i] -= dl; s1[i] -= dl; s2[i] -= dl; s3[i] -= dl; negm[i] = -m_run; }
                lacc = lacc * f;
#pragma unroll
                for (int dt = 0; dt < 4; ++dt) o[dt] = o[dt] * f;
                first = false;
            }
            const u32x2 mk0 = *(LAS const u32x2*)(mlut + ((mwA & 15) << 3)), mk1 = *(LAS const u32x2*)(mlut + (((mwA >> 16) & 15) << 3));
            const u32x2 mk2 = *(LAS const u32x2*)(mlut + ((mwB & 15) << 3)), mk3 = *(LAS const u32x2*)(mlut + (((mwB >> 16) & 15) << 3));
            u32x4 pwA, pwB;
            pwA.x = cvtpk(__builtin_amdgcn_exp2f(s0[0]), __builtin_amdgcn_exp2f(s0[1])) & mk0.x; pwA.y = cvtpk(__builtin_amdgcn_exp2f(s0[2]), __builtin_amdgcn_exp2f(s0[3])) & mk0.y;
            pwA.z = cvtpk(__builtin_amdgcn_exp2f(s1[0]), __builtin_amdgcn_exp2f(s1[1])) & mk1.x; pwA.w = cvtpk(__builtin_amdgcn_exp2f(s1[2]), __builtin_amdgcn_exp2f(s1[3])) & mk1.y;
            pwB.x = cvtpk(__builtin_amdgcn_exp2f(s2[0]), __builtin_amdgcn_exp2f(s2[1])) & mk2.x; pwB.y = cvtpk(__builtin_amdgcn_exp2f(s2[2]), __builtin_amdgcn_exp2f(s2[3])) & mk2.y;
            pwB.z = cvtpk(__builtin_amdgcn_exp2f(s3[0]), __builtin_amdgcn_exp2f(s3[1])) & mk3.x; pwB.w = cvtpk(__builtin_amdgcn_exp2f(s3[2]), __builtin_amdgcn_exp2f(s3[3])) & mk3.y;
            const bf16x8v pfA = __builtin_bit_cast(bf16x8v, pwA), pfB = __builtin_bit_cast(bf16x8v, pwB);
            ATT_PRIO(1);
            lacc = __builtin_amdgcn_mfma_f32_16x16x32_bf16(ones, pfA, lacc, 0, 0, 0);
            lacc = __builtin_amdgcn_mfma_f32_16x16x32_bf16(ones, pfB, lacc, 0, 0, 0);
#pragma unroll
            for (int dt = 0; dt < 4; ++dt) {
                const s16x4v lo = lds_tr16(slot + vofs + dt * 1024), hi = lds_tr16(slot + vofs + dt * 1024 + 512);
                const s16x4v lo2 = lds_tr16(slot + 4096 + vofs + dt * 1024), hi2 = lds_tr16(slot + 4096 + vofs + dt * 1024 + 512);
                const bf16x8v vf = {lo[0], lo[1], lo[2], lo[3], hi[0], hi[1], hi[2], hi[3]};
                const bf16x8v vf2 = {lo2[0], lo2[1], lo2[2], lo2[3], hi2[0], hi2[1], hi2[2], hi2[3]};
                o[dt] = __builtin_amdgcn_mfma_f32_16x16x32_bf16(vf, pfA, o[dt], 0, 0, 0);
                o[dt] = __builtin_amdgcn_mfma_f32_16x16x32_bf16(vf2, pfB, o[dt], 0, 0, 0);
            }
            ATT_PRIO(0);
        }
        asm volatile("s_waitcnt vmcnt(0) lgkmcnt(0)" ::: "memory");
        __syncthreads();
    }
#undef DSA_STAGE
    const float inv = 1.0f / lacc[0];
    bf16* yrow = p.Y + ((size_t)b * SEQ + q0 + r16) * DM + 512 + h * 64;
#pragma unroll
    for (int dt = 0; dt < 4; ++dt) {
        const u32x2 gw = gwv[dt];
        const float g0 = __uint_as_float(gw.x << 16), g1 = __uint_as_float(gw.x & 0xffff0000u), g2 = __uint_as_float(gw.y << 16), g3 = __uint_as_float(gw.y & 0xffff0000u);
        u32x2 w; w.x = pk2(o[dt][0] * inv * siluf(g0), o[dt][1] * inv * siluf(g1)); w.y = pk2(o[dt][2] * inv * siluf(g2), o[dt][3] * inv * siluf(g3));
        *(u32x2*)(yrow + dt * 16 + 4 * g) = w;
    }
    __syncthreads();
    }
}
#ifdef QT_TABLE
__device__ const unsigned char DSA_QT_TAB[32][4] = { {127, 66, 63, 2}, {126, 67, 62, 3}, {125, 68, 61, 4}, {124, 74, 60, 0}, {123, 69, 58, 8}, {122, 70, 57, 9}, {121, 71, 55, 11}, {120, 76, 56, 7}, {119, 65, 59, 15}, {118, 73, 54, 14}, {117, 83, 53, 6}, {116, 91, 51, 1}, {115, 82, 52, 10}, {114, 85, 48, 12}, {113, 84, 49, 13}, {112, 72, 46, 19}, {111, 75, 47, 16}, {110, 94, 50, 5}, {109, 78, 45, 17}, {108, 77, 44, 20}, {107, 79, 43, 21}, {106, 64, 42, 37}, {105, 81, 41, 23}, {104, 87, 40, 18}, {103, 86, 36, 24}, {102, 88, 38, 22}, {101, 80, 39, 30}, {100, 92, 32, 26}, {99, 90, 35, 25}, {98, 89, 34, 29}, {97, 93, 33, 27}, {96, 95, 31, 28} };
__device__ __forceinline__ int dsa_qt_of(int j, int i) { return (int)DSA_QT_TAB[j][i]; }
#else
__device__ __forceinline__ int dsa_qt_of(int j, int i) { return (i == 0) ? 127 - j : (i == 1) ? 64 + j : (i == 2) ? 63 - j : j; }
#endif
__device__ __forceinline__ void dsa_phase_pre(const P& p, LAS unsigned char* lds, bf16x8v (&pk)[4]) {
    const int G = gridDim.x, wg = blockIdx.x, lane = threadIdx.x & 63, wave = __builtin_amdgcn_readfirstlane(threadIdx.x >> 6);
    const int b = (G == 256) ? (wg & 7) : (wg >> 7), qt = (G == 256) ? dsa_qt_of(wg >> 3, 0) : 127 - (wg & 127);
#pragma unroll
    for (int i = 0; i < 4; ++i) pk[i] = (bf16x8v){0, 0, 0, 0, 0, 0, 0, 0};
    if (wg < 1024 && qt >= TOPK / 16) { dsa_prefetch_qi(p.Z + (size_t)b * SEQ * ZP, qt, lds, wave, lane); dsa_prefetch_ki(p.Z + (size_t)b * SEQ * ZP, qt, pk, wave, lane); }
}
__device__ __forceinline__ void dsa_phase(const P& p, LAS unsigned char* lds, bf16x8v (&pk)[4], int l) {
    const int G = gridDim.x, wg = blockIdx.x;
    if (G == 256) {
        const int b = wg & 7, j = wg >> 3;
#ifdef DSA_DYNQ
        unsigned* queue = p.ctl + CW_QUEUE + (l * 8 + b) * 64;
        int qt = 127 - j;
#pragma unroll 1
        while (qt >= 0) { int qn = -1; dsa_unit(p, b, qt, qn, queue, pk, lds); qt = qn; }
#else
#pragma unroll 1
        for (int i = 0; i < 4; ++i) dsa_unit(p, b, dsa_qt_of(j, i), (i < 3) ? dsa_qt_of(j, i + 1) : -1, pk, lds);
#endif
    }
}
constexpr int LRU_WS_OFF = 139264;
constexpr int LRU_XB = 264 * 128;
constexpr int LRU_GB = 256 * 32;
constexpr int LRU_BUF = LRU_XB + LRU_GB;
__device__ __forceinline__ float fast_sigm(float x) { return __builtin_amdgcn_rcpf(1.0f + __expf(-x)); }
__device__ __forceinline__ void lru_unit(const P& p, int l, int b, int blk, int q4, LAS unsigned char* lds) {
    const int tid = threadIdx.x, lane = tid & 63, wave = __builtin_amdgcn_readfirstlane(tid >> 6), r16 = lane & 15, g = lane >> 4;
    const bf16* zb = p.Z + (size_t)b * SEQ * ZP;
    const int cA = blk * 64, dloc = q4 * 16 + r16, dg = blk * 64 + dloc;
    const unsigned lds_base = (unsigned)(uintptr_t)lds;
#define LRU_STAGE(r) do { const unsigned bb_ = lds_base + (unsigned)(((r) & 1) * LRU_BUF); \
        _Pragma("unroll") for (int i_ = 0; i_ < 5; ++i_) { const int pc_ = wave + 8 * i_; if (pc_ < 33) { const int rho_ = pc_ * 8 + (lane >> 3); int t_ = (r) * 256 - 3 + rho_; t_ = t_ < 0 ? 0 : (t_ > SEQ - 1 ? SEQ - 1 : t_); \
            const int ch_ = (lane & 7) ^ ((rho_ >> 1) & 7); glds16(zb + (size_t)t_ * ZP + C_XR + cA + ch_ * 8, (unsigned)__builtin_amdgcn_readfirstlane(bb_ + pc_ * 1024)); } } \
        { const int row_ = wave * 32 + (lane >> 1); glds16(zb + (size_t)((r) * 256 + row_) * ZP + C_GR + dg - r16 + (lane & 1) * 8, (unsigned)__builtin_amdgcn_readfirstlane(bb_ + LRU_XB + wave * 1024)); } } while (0)
    LRU_STAGE(0);
    float cwA[2][4][8], cbA[2][8];
#pragma unroll
    for (int s = 0; s < 2; ++s)
#pragma unroll
        for (int j = 0; j < 8; ++j) { const int c = cA + 32 * s + 8 * g + j; cbA[s][j] = p.conv_b[l * 512 + c];
#pragma unroll
            for (int k = 0; k < 4; ++k) cwA[s][k][j] = p.conv_w[(l * 4 + k) * 512 + c]; }
    bf16x8v bxf[2], baf[2];
#pragma unroll
    for (int s = 0; s < 2; ++s) { u32x4 wx, wa; unsigned tx[8], ta[8];
#pragma unroll
        for (int j = 0; j < 8; ++j) { const size_t idx = (((size_t)l * 8 + blk) * 64 + 32 * s + 8 * g + j) * 64 + dloc; tx[j] = f2bf(p.lru_wx[idx]); ta[j] = f2bf(p.lru_wa[idx]); }
        wx.x = tx[0] | (tx[1] << 16); wx.y = tx[2] | (tx[3] << 16); wx.z = tx[4] | (tx[5] << 16); wx.w = tx[6] | (tx[7] << 16);
        wa.x = ta[0] | (ta[1] << 16); wa.y = ta[2] | (ta[3] << 16); wa.z = ta[4] | (ta[5] << 16); wa.w = ta[6] | (ta[7] << 16);
        bxf[s] = __builtin_bit_cast(bf16x8v, wx); baf[s] = __builtin_bit_cast(bf16x8v, wa); }
    const float cw0 = p.conv_w[(l * 4 + 0) * 512 + dg], cw1 = p.conv_w[(l * 4 + 1) * 512 + dg], cw2 = p.conv_w[(l * 4 + 2) * 512 + dg], cw3 = p.conv_w[(l * 4 + 3) * 512 + dg];
    const float cb = p.conv_b[l * 512 + dg], bxv = p.lru_bx[l * 512 + dg], bav = p.lru_ba[l * 512 + dg];
    const float sp8 = -8.0f * log1pf(expf(-p.lru_a[l * 512 + dg]));
    asm volatile("" :: "v"(cwA[0][0][0]), "v"(cwA[1][3][7]), "v"(cbA[1][7]), "v"(bxf[0]), "v"(bxf[1]), "v"(baf[0]), "v"(baf[1]), "v"(cw0), "v"(cw1), "v"(cw2), "v"(cw3), "v"(cb), "v"(bxv), "v"(bav), "v"(sp8));
    LAS float* WS = (LAS float*)(lds + LRU_WS_OFF);
    float hrun = 0.f;
    asm volatile("s_waitcnt vmcnt(0)" ::: "memory");
#pragma unroll 1
    for (int round = 0; round < 8; ++round) {
        asm volatile("s_waitcnt vmcnt(8)" ::: "memory");
        __syncthreads();
        if (round + 1 < 8) LRU_STAGE(round + 1);
        LAS const unsigned char* xb = lds + (round & 1) * LRU_BUF; LAS const unsigned char* gb = xb + LRU_XB;
        const int tw = round * 256 + wave * 32;
        float hl[2][4], pl[2][4], gr4[2][4], PT[2], HT[2], PE[2], HE[2];
#pragma unroll
        for (int tau = 0; tau < 2; ++tau) {
            const int t0 = tw + 16 * tau, rho0 = wave * 32 + 16 * tau;
            bf16x8v af[2];
#pragma unroll
            for (int s = 0; s < 2; ++s) {
                float xc[8];
#pragma unroll
                for (int j = 0; j < 8; ++j) xc[j] = cbA[s][j];
#pragma unroll
                for (int k = 0; k < 4; ++k) { const int rho = rho0 + r16 + k; u32x4 w = *(LAS const u32x4*)(xb + rho * 128 + (((4 * s + g) ^ (rho >> 1)) & 7) * 16);
                    if (t0 + r16 - 3 + k < 0) w = (u32x4){0u, 0u, 0u, 0u};
                    xc[0] += cwA[s][k][0] * __uint_as_float(w.x << 16); xc[1] += cwA[s][k][1] * __uint_as_float(w.x & 0xffff0000u);
                    xc[2] += cwA[s][k][2] * __uint_as_float(w.y << 16); xc[3] += cwA[s][k][3] * __uint_as_float(w.y & 0xffff0000u);
                    xc[4] += cwA[s][k][4] * __uint_as_float(w.z << 16); xc[5] += cwA[s][k][5] * __uint_as_float(w.z & 0xffff0000u);
                    xc[6] += cwA[s][k][6] * __uint_as_float(w.w << 16); xc[7] += cwA[s][k][7] * __uint_as_float(w.w & 0xffff0000u); }
                u32x4 pw; pw.x = cvtpk(xc[0], xc[1]); pw.y = cvtpk(xc[2], xc[3]); pw.z = cvtpk(xc[4], xc[5]); pw.w = cvtpk(xc[6], xc[7]);
                af[s] = __builtin_bit_cast(bf16x8v, pw);
            }
            f32x4 gx = {0.f, 0.f, 0.f, 0.f}, ga = {0.f, 0.f, 0.f, 0.f};
            gx = __builtin_amdgcn_mfma_f32_16x16x32_bf16(af[0], bxf[0], gx, 0, 0, 0); gx = __builtin_amdgcn_mfma_f32_16x16x32_bf16(af[1], bxf[1], gx, 0, 0, 0);
            ga = __builtin_amdgcn_mfma_f32_16x16x32_bf16(af[0], baf[0], ga, 0, 0, 0); ga = __builtin_amdgcn_mfma_f32_16x16x32_bf16(af[1], baf[1], ga, 0, 0, 0);
            float xo[7];
#pragma unroll
            for (int m = 0; m < 7; ++m) { const int rho = rho0 + 4 * g + m;
                const unsigned short v = *(LAS const unsigned short*)(xb + rho * 128 + (((dloc >> 3) ^ (rho >> 1)) & 7) * 16 + (dloc & 7) * 2);
                xo[m] = (t0 + 4 * g - 3 + m >= 0) ? bf2f(v) : 0.f; }
            float Pr = 1.f, Hr = 0.f;
#pragma unroll
            for (int i = 0; i < 4; ++i) {
                const float xcv = cb + cw0 * xo[i] + cw1 * xo[i + 1] + cw2 * xo[i + 2] + cw3 * xo[i + 3];
                const float sx = fast_sigm(gx[i] + bxv), sa = fast_sigm(ga[i] + bav);
                const float la = sp8 * sa, a = __expf(la), y2 = 2.0f * la;
#ifdef LRU_EM_SERIES
                const float ser = -y2 * (1.0f + y2 * (0.5f + y2 * (0.16666667f + y2 * (0.041666668f + y2 * (0.0083333338f + y2 * 0.0013888889f)))));
                const float em = (y2 > -0.25f) ? ser : (1.0f - __expf(y2));
#else
                const float em = 1.0f - a * a;
#endif
                const float u = __builtin_amdgcn_sqrtf(em) * sx * xcv;
                Hr = a * Hr + u; Pr *= a; hl[tau][i] = Hr; pl[tau][i] = Pr;
                gr4[tau][i] = bf2f(*(LAS const unsigned short*)(gb + (rho0 + 4 * g + i) * 32 + r16 * 2));
            }
            float Pi = Pr, Hi = Hr;
            { const float Pl = __shfl_up(Pi, 16), Hl = __shfl_up(Hi, 16); if (g >= 1) { Hi = Pi * Hl + Hi; Pi = Pl * Pi; } }
            { const float Pl = __shfl_up(Pi, 32), Hl = __shfl_up(Hi, 32); if (g >= 2) { Hi = Pi * Hl + Hi; Pi = Pl * Pi; } }
            float Pe = __shfl_up(Pi, 16), He = __shfl_up(Hi, 16); if (g == 0) { Pe = 1.f; He = 0.f; }
            PT[tau] = __shfl(Pi, 48 + r16); HT[tau] = __shfl(Hi, 48 + r16); PE[tau] = Pe; HE[tau] = He;
        }
#ifdef PROBE_LRU_VALU
        { unsigned d0 = 1u, d1 = 2u, d2 = 3u, d3 = 4u;
#pragma unroll
          for (int q = 0; q < 16; ++q) asm volatile("v_add_u32_e32 %0, 1, %0\n\tv_add_u32_e32 %1, 1, %1\n\tv_add_u32_e32 %2, 1, %2\n\tv_add_u32_e32 %3, 1, %3" : "+v"(d0), "+v"(d1), "+v"(d2), "+v"(d3)); }
#endif
        HE[1] = PE[1] * HT[0] + HE[1]; PE[1] = PT[0] * PE[1];
        const float Pw = PT[0] * PT[1], Hw = PT[1] * HT[0] + HT[1];
        LAS float* wsr = WS + (round & 1) * 256;
        if (g == 0) { wsr[(wave * 16 + r16) * 2 + 0] = Pw; wsr[(wave * 16 + r16) * 2 + 1] = Hw; }
        asm volatile("s_waitcnt lgkmcnt(0)" ::: "memory");
        __builtin_amdgcn_s_barrier();
        asm volatile("" ::: "memory");
        float hc = hrun, hall = hrun;
#pragma unroll
        for (int w2 = 0; w2 < 8; ++w2) { if (w2 == wave) hc = hall; hall = wsr[(w2 * 16 + r16) * 2 + 0] * hall + wsr[(w2 * 16 + r16) * 2 + 1]; }
        hrun = hall;
#pragma unroll
        for (int tau = 0; tau < 2; ++tau) {
            const float hin = PE[tau] * hc + HE[tau];
            bf16* yp = p.Y + ((size_t)b * SEQ + tw + 16 * tau + 4 * g) * DM + dg;
#pragma unroll
            for (int i = 0; i < 4; ++i) { const float h = hl[tau][i] + pl[tau][i] * hin, gr = gr4[tau][i]; yp[(size_t)i * DM] = (bf16)f2bf(h * gr * fast_sigm(gr)); }
        }
    }
#undef LRU_STAGE
    __syncthreads();
}
__device__ __forceinline__ void lru_phase(const P& p, int l, LAS unsigned char* lds) {
    const int G = gridDim.x, wg = blockIdx.x;
#pragma unroll 1
    for (int u = wg; u < 256; u += G) lru_unit(p, l, (u >> 3) & 7, u & 7, u >> 6, lds);
}
#ifndef DSA_PHASE
#define DSA_PHASE dsa_phase
#endif
#ifndef LRU_PHASE
#define LRU_PHASE lru_phase
#endif
#ifndef RP_A
#define RP_A 1
#endif
#ifndef RP_L
#define RP_L 1
#endif
#ifndef RP_D
#define RP_D 1
#endif
#ifndef RP_C
#define RP_C 1
#endif
#ifndef RP_0
#define RP_0 1
#endif
template <int OFF> __device__ __forceinline__ unsigned long long karg_u64() {
    unsigned long long v; const unsigned long long kp = (unsigned long long)__builtin_amdgcn_kernarg_segment_ptr();
    asm volatile("s_load_dwordx2 %0, %1, %2\n\ts_waitcnt lgkmcnt(0)" : "=s"(v) : "s"(kp), "i"(OFF) : "memory");
    return v;
}
struct Args { const float* in[15]; float* out; unsigned char* ws; int ph_lo, ph_hi; };
__global__ void __launch_bounds__(512, 2) mega(Args a) {
    extern __shared__ __attribute__((aligned(16))) unsigned char lds_raw[];
    LAS unsigned char* lds = (LAS unsigned char*)lds_raw;
#define KARG(T, off) ((T)(__attribute__((address_space(1))) void*)karg_u64<(off)>())
#define LOADP() P p; { unsigned char* ws_ = KARG(unsigned char*, 128); \
        p.x = KARG(const float*, 0); p.c = KARG(const float*, 8); p.norm_g = KARG(const float*, 16); p.ada_w = KARG(const float*, 24); p.ada_b = KARG(const float*, 32); p.w_in = KARG(const float*, 40); \
        p.conv_w = KARG(const float*, 48); p.conv_b = KARG(const float*, 56); p.lru_wx = KARG(const float*, 64); p.lru_bx = KARG(const float*, 72); p.lru_wa = KARG(const float*, 80); p.lru_ba = KARG(const float*, 88); \
        p.lru_a = KARG(const float*, 96); p.w_out = KARG(const float*, 104); p.final_g = KARG(const float*, 112); p.out = KARG(float*, 120); \
        p.ctl = (unsigned*)(ws_ + WS_CTL); p.mod = (float*)(ws_ + WS_MOD); p.bias = (float*)(ws_ + WS_BIAS); p.ssq = (float*)(ws_ + WS_SSQ); \
        p.wt_in = (bf16*)(ws_ + WS_WTIN); p.wt_out = (bf16*)(ws_ + WS_WTOUT); p.A = (bf16*)(ws_ + WS_A); p.Z = (bf16*)(ws_ + WS_Z); p.Y = (bf16*)(ws_ + WS_Y); p.X1 = (bf16*)(ws_ + WS_X1); }
    unsigned* const ctl0 = (unsigned*)((unsigned char*)a.ws + WS_CTL);
    const int lo = a.ph_lo, hi = a.ph_hi;
    volatile LAS unsigned* MISC = (volatile LAS unsigned*)(lds + MISC_OFF + 4096);
    if (threadIdx.x < 4) MISC[threadIdx.x] = 0u;
    if (threadIdx.x < 16) { const unsigned t = threadIdx.x; u32x2 m; m.x = ((t & 1u) ? 0xffffu : 0u) | ((t & 2u) ? 0xffff0000u : 0u); m.y = ((t & 4u) ? 0xffffu : 0u) | ((t & 8u) ? 0xffff0000u : 0u);
        *(LAS u32x2*)(lds + DSA_MLUT_OFF + t * 8) = m; }
    __syncthreads();
    XcdBarrier bar; bar.bar = ctl0 + CW_BAR; bar.x = 0; bar.st = MISC;
    if (hi - lo > 1) bar = xcd_barrier_post(ctl0 + CW_BAR, MISC);
#define IN(k) (lo <= (k) && (k) < hi)
#ifndef N_CG_SEAMS
#define N_CG_SEAMS 0
#endif
#define SEAM(k) do { if (IN(k) && IN((k) + 1)) { if ((k) < N_CG_SEAMS) cg::this_grid().sync(); else xcd_barrier(bar); } } while (0)
    if (IN(0)) { LOADP(); ph0_prologue(p, lds); if (RP_0 > 1) { __syncthreads(); ph0_prologue(p, lds); } }
    SEAM(0);
    if (IN(1)) { LOADP(); ph1_prologue(p, lds); if (RP_0 > 1) { __syncthreads(); ph1_prologue(p, lds); } }
    SEAM(1);
#ifdef PROBE_BAR
#define SEAM_X(b) do { SEAM(b); SEAM(b); SEAM(b); SEAM(b); } while (0)
#else
#define SEAM_X(b) do { } while (0)
#endif
#define LAYER(l, base) \
    if (IN(base)) { LOADP(); \
        pg8::Gemm g{p.A, p.wt_in + (size_t)(l) * ZP * 1024, MROWS, ZP, DM}; pg8::StaticOrder S; S.init(MROWS, ZP, (int)gridDim.x, (int)blockIdx.x); \
        EpiZ E{p.Z, p.ssq, p.bias + (size_t)(l) * 8 * ZP}; \
        pg8::gemm_phase<EpiZ, pg8::StaticOrder, PG8_ALIGN, PG8_SP2>(lds, g, S, E); if (RP_A > 1) { __syncthreads(); pg8::gemm_phase<EpiZ, pg8::StaticOrder, PG8_ALIGN, PG8_SP2>(lds, g, S, E); } \
    } \
    SEAM(base); SEAM_X(base); \
    if (IN((base) + 1)) { LOADP(); bf16x8v pk0[4]; dsa_phase_pre(p, lds, pk0); LRU_PHASE(p, (l), lds); __syncthreads(); DSA_PHASE(p, lds, pk0, (l)); } \
    SEAM((base) + 1); \
    if (IN((base) + 2)) { LOADP(); \
        pg8::Gemm g{p.Y, p.wt_out + (size_t)(l) * 1024 * 1024, MROWS, DM, DM}; pg8::StaticOrder S; S.init(MROWS, DM, (int)gridDim.x, (int)blockIdx.x); \
        if constexpr ((l) == DEPTH - 1) { \
            EpiXF E{p.X1, p.out, p.mod + (size_t)(l) * 8 * 3072 + 2048, p.final_g, p.ssq, p.ctl + CW_PANEL}; \
            pg8::gemm_phase<EpiXF, pg8::StaticOrder, false, PG8_SP2>(lds, g, S, E); \
        } else { \
            EpiX E{p.x, p.X1, p.A, p.mod + (size_t)(l) * 8 * 3072 + 2048, p.norm_g + (size_t)((l) + 1) * 1024, p.mod + (size_t)((l) + 1) * 8 * 3072 + 1024, p.ssq}; \
            pg8::gemm_phase<EpiX, pg8::StaticOrder, false, PG8_SP2>(lds, g, S, E); if (RP_C > 1 && (l) == 0) { __syncthreads(); pg8::gemm_phase<EpiX, pg8::StaticOrder, false, PG8_SP2>(lds, g, S, E); } \
        } \
    } \
    if ((base) + 3 < NPHASE) SEAM((base) + 2);
    LAYER(0, 2)
    LAYER(1, 5)
}
#ifndef MK_N_LAUNCHES
#define MK_N_LAUNCHES 1
#endif
extern "C" void kernel_launch(void* const* d_in, const int* in_sizes, int n_in, void* d_out, int out_size, void* d_ws, size_t ws_size, hipStream_t stream) {
    static int grid = 0;
    if (grid == 0) {
        if (n_in != 15 || out_size != MROWS * DM || ws_size < WS_END) { fprintf(stderr, "kernel_launch: unexpected problem (n_in %d out %d ws %zu)\n", n_in, out_size, ws_size); grid = -1; return; }
        int dev = 0, cus = 0, per_cu = 0;
        hipGetDevice(&dev); hipDeviceGetAttribute(&cus, hipDeviceAttributeMultiprocessorCount, dev);
        if (hipFuncSetAttribute((const void*)mega, hipFuncAttributeMaxDynamicSharedMemorySize, LDS_BYTES) != hipSuccess) { fprintf(stderr, "kernel_launch: hipFuncSetAttribute failed\n"); grid = -1; return; }
        if (hipOccupancyMaxActiveBlocksPerMultiprocessor(&per_cu, (const void*)mega, 512, LDS_BYTES) != hipSuccess || per_cu < 1) { fprintf(stderr, "kernel_launch: occupancy query failed (%d)\n", per_cu); per_cu = 1; }
        (void)hipGetLastError();
        grid = cus * per_cu;
        if (grid != 256) fprintf(stderr, "kernel_launch: grid %d (cus %d x %d) != 256: the fused out-projection epilogue needs exactly 256 workgroups\n", grid, cus, per_cu);
    }
    if (grid < 0) return;
    hipMemsetAsync((char*)d_ws + WS_CTL, 0, CTL_ZERO_BYTES, stream);
    Args a{};
    for (int i = 0; i < 15; ++i) a.in[i] = (const float*)d_in[i];
    a.out = (float*)d_out; a.ws = (unsigned char*)d_ws;
#if MK_N_LAUNCHES == 1
    a.ph_lo = 0; a.ph_hi = NPHASE;
    void* args[] = {&a};
    hipError_t e = hipLaunchCooperativeKernel((const void*)mega, dim3(grid), dim3(512), args, LDS_BYTES, stream);
    if (e != hipSuccess) fprintf(stderr, "cooperative launch failed: %s (grid %d)\n", hipGetErrorString(e), grid);
#else
    for (int ph = 0; ph < NPHASE; ++ph) { a.ph_lo = ph; a.ph_hi = ph + 1; hipLaunchKernelGGL(mega, dim3(grid), dim3(512), LDS_BYTES, stream, a); }
#endif
}
```

```cpp
#include <hip/hip_runtime.h>
#include <hip/hip_cooperative_groups.h>
#include <cstdio>
#include <cstdint>
#include <cmath>
namespace cg = cooperative_groups;
#define EPI_XD 4
#define EPI_ZD 8
#define HIST_WAVES 8
#define PRO_KC 64
#define HISTA_FALLBACK 1
#define WALK_MAX 4
#define XB_FLAT_RELEASE 1
#define DSA_DYNQ 1
#define XB_LOCAL 1
namespace pg8 {
#define PG8_LAS __attribute__((address_space(3)))
typedef unsigned short bf16_t;
typedef short bf16x8 __attribute__((ext_vector_type(8)));
typedef float f32x4 __attribute__((ext_vector_type(4)));
typedef unsigned u32x4 __attribute__((ext_vector_type(4)));
constexpr int BM = 256, BK = 64, HALF = 128, HTB = HALF * BK * 2  , STAGE_BYTES = 8 * HTB, NXCD = 8, WGM = 8;

__host__ __device__ __forceinline__ int lds_byte(int r, int c) { const int st = (r >> 4) * 2 + (c >> 5), rr = r & 15, cc = c & 31, ob = rr * 64 + cc * 2; return st * 1024 + (ob ^ (((ob >> 9) & 1) << 5)); }
__host__ __device__ __forceinline__ void stage_rc(int b, int& R, int& C) { const int st = b / 1024, sb = b % 1024, swz = sb ^ (((sb >> 9) & 1) << 5); R = (st >> 1) * 16 + swz / 64; C = (st & 1) * 32 + (swz % 64) / 2; }
__host__ __device__ __forceinline__ int perm32(int rho) { const int n = rho >> 4, i = rho & 15; return 8 * (i >> 2) + 4 * n + (i & 3); }

struct Unit { int pm, pn; };
struct Gemm { const bf16_t* A; const bf16_t* Bt; int M, N, K; };

struct StaticOrder {
    int nM, nN, nwg, G, c;
    __host__ __device__ void init(int M, int N, int G_, int c_) { nM = M / BM; nN = N / BM; nwg = nM * nN; G = G_; c = c_; }
    __host__ __device__ bool next(int i, Unit& u) const {
        const long L = (long)i * G + c; if (L >= nwg) return false;
        int wgid = (int)L; { const int q = nwg / NXCD, r = nwg % NXCD, xcd = wgid % NXCD, off = wgid / NXCD; wgid = (xcd < r ? xcd * (q + 1) : r * (q + 1) + (xcd - r) * q) + off; }
        const int nig = WGM * nN, gid = wgid / nig, fm = gid * WGM, gsz = (nM - fm) < WGM ? (nM - fm) : WGM;
        u.pm = fm + ((wgid % nig) % gsz); u.pn = (wgid % nig) / gsz; return true;
    }
    __device__ __forceinline__ void a_ready(const Unit&) const {}
    __device__ __forceinline__ void done(const Unit&) const {}
};

__device__ __forceinline__ unsigned cvt_pk_bf16(float lo, float hi) { unsigned r; asm volatile("v_cvt_pk_bf16_f32 %0, %1, %2" : "=v"(r) : "v"(lo), "v"(hi)); return r; }
typedef float f32x2 __attribute__((ext_vector_type(2)));
template <class Epi, class Sched, bool ALIGN_EPI = false, bool SP2 = false>
__device__ __forceinline__ void gemm_phase(PG8_LAS unsigned char* lds, const Gemm g, const Sched& S, const Epi& E) {
    const int tid = threadIdx.x, wid = __builtin_amdgcn_readfirstlane(tid >> 6), lane = tid & 63, wr = wid >> 2, wc = wid & 3, fr = lane & 15, fq = lane >> 4;
    const int K = g.K, nt = K / BK;
    unsigned voffA[2], voffB[2];
#pragma unroll
    for (int i = 0; i < 2; ++i) { int R, C; stage_rc(tid * 16 + i * 8192, R, C); const int Rb = Epi::PERM ? ((R & ~31) + perm32(R & 31)) : R;
        voffA[i] = (unsigned)(R * K + C) * 2u; voffB[i] = (unsigned)(Rb * K + C) * 2u; }
    const size_t kstep = (size_t)(BK * 2);
    const size_t hstep = (size_t)HALF * K * 2;
    const size_t tstep = 2 * hstep;
    const unsigned ldsw = (unsigned)wid * 1024u;
    const int aoff = lds_byte(wr * 64 + fr, fq * 8), boff = lds_byte(wc * 32 + fr, fq * 8);
#define PG8_SA(b, h) (((b) * 2 + (h)) * HTB)
#define PG8_SB(b, h) ((4 + (b) * 2 + (h)) * HTB)
#define PG8_STAGE(bufoff, gbase, voff) do { _Pragma("unroll") for (int _i = 0; _i < 2; ++_i) \
        __builtin_amdgcn_global_load_lds((const unsigned*)((const char*)(gbase) + (voff)[_i]), (PG8_LAS unsigned*)(lds + (bufoff) + ldsw + _i * 8192), 16, 0, 0); } while (0)
#define PG8_LDA(dst, b, h) do { _Pragma("unroll") for (int m = 0; m < 4; ++m) _Pragma("unroll") for (int k = 0; k < 2; ++k) dst[m][k] = *(const PG8_LAS bf16x8*)(lds + PG8_SA(b, h) + aoff + m * 2048 + k * 1024); } while (0)
#define PG8_LDB(dst, b, h) do { _Pragma("unroll") for (int n = 0; n < 2; ++n) _Pragma("unroll") for (int k = 0; k < 2; ++k) dst[n][k] = *(const PG8_LAS bf16x8*)(lds + PG8_SB(b, h) + boff + n * 2048 + k * 1024); } while (0)
#define PG8_MMA(ai, bj, At, Bt) do { __builtin_amdgcn_s_setprio(1); _Pragma("unroll") for (int m = 0; m < 4; ++m) _Pragma("unroll") for (int n = 0; n < 2; ++n) _Pragma("unroll") for (int k = 0; k < 2; ++k) \
        acc[ai][bj][m][n] = __builtin_amdgcn_mfma_f32_16x16x32_bf16(Bt[n][k], At[m][k], acc[ai][bj][m][n], 0, 0, 0); __builtin_amdgcn_s_setprio(0); } while (0)
#define PG8_WAIT_V(n) asm volatile("s_waitcnt vmcnt(" #n ")" ::: "memory")
#define PG8_WAIT_L(n) asm volatile("s_waitcnt lgkmcnt(" #n ")" ::: "memory")
#define PG8_BAR __builtin_amdgcn_s_barrier()
#define PG8_SCHED __builtin_amdgcn_sched_barrier(0)
    Unit cur, nxt; int ui = 0;
    if (!S.next(0, cur)) return;
    f32x4 acc[2][2][4][2];
#pragma unroll
    for (int a = 0; a < 2; ++a)
#pragma unroll
        for (int b = 0; b < 2; ++b)
#pragma unroll
            for (int m = 0; m < 4; ++m)
#pragma unroll
                for (int n = 0; n < 2; ++n) acc[a][b][m][n] = (f32x4){0.f, 0.f, 0.f, 0.f};
    bf16x8 At[4][2], B0[2][2], B1[2][2];
    const char* cA = (const char*)g.A + (size_t)cur.pm * tstep; const char* cB = (const char*)g.Bt + (size_t)cur.pn * tstep;
    S.a_ready(cur);
    if constexpr (SP2) {
        PG8_STAGE(PG8_SB(0, 0), cB, voffB); PG8_STAGE(PG8_SB(0, 1), cB + hstep, voffB); PG8_STAGE(PG8_SA(0, 0), cA, voffA); PG8_STAGE(PG8_SA(0, 1), cA + hstep, voffA);
        if (wr == 1) PG8_BAR;
        PG8_WAIT_V(2); PG8_BAR;
        PG8_STAGE(PG8_SB(1, 0), cB + kstep, voffB); PG8_STAGE(PG8_SA(1, 0), cA + kstep, voffA); PG8_STAGE(PG8_SB(1, 1), cB + hstep + kstep, voffB);
        PG8_WAIT_V(6); PG8_BAR;
    } else {
        PG8_STAGE(PG8_SB(0, 0), cB, voffB); PG8_STAGE(PG8_SA(0, 0), cA, voffA); PG8_STAGE(PG8_SB(0, 1), cB + hstep, voffB); PG8_STAGE(PG8_SA(0, 1), cA + hstep, voffA);
        if (wr == 1) PG8_BAR;
        PG8_WAIT_V(4); PG8_BAR;
        PG8_STAGE(PG8_SB(1, 0), cB + kstep, voffB); PG8_STAGE(PG8_SA(1, 0), cA + kstep, voffA); PG8_STAGE(PG8_SB(1, 1), cB + hstep + kstep, voffB);
        PG8_WAIT_V(6); PG8_BAR;
    }
    for (;;) {
        const bool has_next = S.next(ui + 1, nxt);
        const char* nA = has_next ? (const char*)g.A + (size_t)nxt.pm * tstep : cA; const char* nB = has_next ? (const char*)g.Bt + (size_t)nxt.pn * tstep : cB;
        for (int t = 0; t < nt; t += 2) {
            const bool last = (t == nt - 2);
            const char* a1 = cA + (size_t)(t + 1) * kstep;
            const char* a2 = last ? nA : cA + (size_t)(t + 2) * kstep; const char* b2 = last ? nB : cB + (size_t)(t + 2) * kstep;
            const char* a3 = a2 + kstep; const char* b3 = b2 + kstep;
            if (last && has_next) S.a_ready(nxt);
            if constexpr (SP2) {
            PG8_LDB(B0, 0, 0); PG8_LDB(B1, 0, 1); PG8_SCHED; PG8_LDA(At, 0, 0); PG8_STAGE(PG8_SA(1, 1), a1 + hstep, voffA);
            PG8_WAIT_V(8); PG8_WAIT_L(0); PG8_BAR; PG8_MMA(0, 0, At, B0); PG8_MMA(0, 1, At, B1); PG8_BAR; PG8_SCHED;
            PG8_LDA(At, 0, 1); PG8_STAGE(PG8_SB(0, 0), b2, voffB); PG8_STAGE(PG8_SB(0, 1), b2 + hstep, voffB); PG8_STAGE(PG8_SA(0, 0), a2, voffA);
            PG8_WAIT_V(8); PG8_WAIT_L(0); PG8_BAR; PG8_MMA(1, 0, At, B0); PG8_MMA(1, 1, At, B1); PG8_BAR; PG8_SCHED;
            PG8_LDB(B0, 1, 0); PG8_LDB(B1, 1, 1); PG8_SCHED; PG8_LDA(At, 1, 0); PG8_STAGE(PG8_SA(0, 1), a2 + hstep, voffA);
            PG8_WAIT_V(8); PG8_WAIT_L(0); PG8_BAR; PG8_MMA(0, 0, At, B0); PG8_MMA(0, 1, At, B1); PG8_BAR; PG8_SCHED;
            PG8_LDA(At, 1, 1); PG8_STAGE(PG8_SB(1, 0), b3, voffB); PG8_STAGE(PG8_SB(1, 1), b3 + hstep, voffB); PG8_STAGE(PG8_SA(1, 0), a3, voffA);
            PG8_WAIT_V(8); PG8_WAIT_L(0); PG8_BAR; PG8_MMA(1, 0, At, B0); PG8_MMA(1, 1, At, B1); PG8_BAR; PG8_SCHED;
            } else {
            PG8_LDB(B0, 0, 0); PG8_SCHED; PG8_LDA(At, 0, 0); PG8_STAGE(PG8_SA(1, 1), a1 + hstep, voffA);
            PG8_WAIT_L(8); PG8_BAR; PG8_WAIT_L(0); PG8_MMA(0, 0, At, B0); PG8_BAR; PG8_SCHED;
            PG8_LDB(B1, 0, 1); PG8_STAGE(PG8_SB(0, 0), b2, voffB);
            PG8_BAR; PG8_WAIT_L(0); PG8_MMA(0, 1, At, B1); PG8_BAR;
            PG8_LDA(At, 0, 1); PG8_STAGE(PG8_SA(0, 0), a2, voffA);
            PG8_BAR; PG8_WAIT_L(0); PG8_MMA(1, 0, At, B0); PG8_BAR; PG8_SCHED;
            PG8_STAGE(PG8_SB(0, 1), b2 + hstep, voffB);
            PG8_WAIT_V(6); PG8_BAR; PG8_MMA(1, 1, At, B1); PG8_BAR;
            PG8_LDB(B0, 1, 0); PG8_SCHED; PG8_LDA(At, 1, 0); PG8_STAGE(PG8_SA(0, 1), a2 + hstep, voffA);
            PG8_WAIT_L(8); PG8_BAR; PG8_WAIT_L(0); PG8_MMA(0, 0, At, B0); PG8_BAR; PG8_SCHED;
            PG8_LDB(B1, 1, 1); PG8_STAGE(PG8_SB(1, 0), b3, voffB);
            PG8_BAR; PG8_WAIT_L(0); PG8_MMA(0, 1, At, B1); PG8_BAR;
            PG8_LDA(At, 1, 1); PG8_STAGE(PG8_SA(1, 0), a3, voffA);
            PG8_BAR; PG8_WAIT_L(0); PG8_MMA(1, 0, At, B0); PG8_BAR; PG8_SCHED;
            PG8_STAGE(PG8_SB(1, 1), b3 + hstep, voffB);
            PG8_WAIT_V(6); PG8_BAR; PG8_MMA(1, 1, At, B1); PG8_BAR;
            }
        }
        if constexpr (ALIGN_EPI) { if (wr == 0) PG8_BAR; }
        if constexpr (!Epi::AFTER_DRAIN) { E(acc, cur, wr, wc, fr, fq); S.done(cur); }
        if (!has_next) break;
#pragma unroll
        for (int a = 0; a < 2; ++a)
#pragma unroll
            for (int b = 0; b < 2; ++b)
#pragma unroll
                for (int m = 0; m < 4; ++m)
#pragma unroll
                    for (int n = 0; n < 2; ++n) acc[a][b][m][n] = (f32x4){0.f, 0.f, 0.f, 0.f};
        cur = nxt; cA = nA; cB = nB; ++ui;
        if constexpr (ALIGN_EPI) { if (wr == 1) PG8_BAR; }
    }
    PG8_WAIT_V(0);
    if constexpr (!ALIGN_EPI) { if (wr == 0) PG8_BAR; }
    PG8_BAR;
    if constexpr (Epi::AFTER_DRAIN) { E.fused(acc, cur, wr, wc, fr, fq, lds, wid, lane); S.done(cur); }
#undef PG8_SA
#undef PG8_SB
#undef PG8_STAGE
#undef PG8_LDA
#undef PG8_LDB
#undef PG8_MMA
#undef PG8_WAIT_V
#undef PG8_WAIT_L
#undef PG8_BAR
#undef PG8_SCHED
}
}

#ifndef PG8_SP2
#define PG8_SP2 true
#endif
#ifndef PG8_ALIGN
#define PG8_ALIGN true
#endif
constexpr int BATCH = 8, SEQ = 2048, DM = 1024, MROWS = BATCH * SEQ, DEPTH = 2;
constexpr int D_RNN = 512, NHEAD = 8, HDIM = 64, D_INR = 2760, ZP = 2816, TOPK = 256;
constexpr int C_XR = 0, C_GR = 512, C_Q = 1024, C_K = 1536, C_V = 1600, C_GA = 1664, C_QI = 2176, C_KI = 2688, C_WI = 2752;
constexpr float EPS = 1e-6f;
constexpr float QSCALE = 0.125f * 1.4426950408889634f;
constexpr size_t MiB = 1u << 20;
constexpr size_t WS_CTL = 0, CTL_ZERO_BYTES = 1 * MiB;
constexpr size_t WS_MOD = 1 * MiB;
constexpr size_t WS_BIAS = 1 * MiB + 256 * 1024;
constexpr size_t WS_SSQ = 2 * MiB;
constexpr size_t WS_WTIN = 3 * MiB;
constexpr size_t WS_WTOUT = 14 * MiB;
constexpr size_t WS_A = 32 * MiB;
constexpr size_t WS_Z = 64 * MiB;
constexpr size_t WS_Y = 152 * MiB;
constexpr size_t WS_X1 = 184 * MiB;
constexpr size_t WS_END = 216 * MiB;
constexpr int LDS_BYTES = 163840;
constexpr int MISC_OFF = 131072 + 8192;
constexpr int NPHASE = 8;
constexpr int CW_BAR = 4096, CW_PANEL = 16384;

#define LAS __attribute__((address_space(3)))
typedef unsigned short bf16;
typedef float f32x4 __attribute__((ext_vector_type(4)));
typedef unsigned u32x4 __attribute__((ext_vector_type(4)));
typedef unsigned u32x2 __attribute__((ext_vector_type(2)));
__device__ __forceinline__ float bf2f(bf16 v) { return __uint_as_float(((unsigned)v) << 16); }
__device__ __forceinline__ unsigned f2bf(float f) { unsigned u = __float_as_uint(f); return (u + 0x7fffu + ((u >> 16) & 1u)) >> 16; }
__device__ __forceinline__ unsigned pk2(float lo, float hi) { return f2bf(lo) | (f2bf(hi) << 16); }
__device__ __forceinline__ float wave_sum(float v) {
#pragma unroll
    for (int o = 1; o < 64; o <<= 1) v += __shfl_xor(v, o);
    return v;
}
__device__ __forceinline__ float wave_max(float v) {
#pragma unroll
    for (int o = 1; o < 64; o <<= 1) v = fmaxf(v, __shfl_xor(v, o));
    return v;
}
__device__ __forceinline__ int wave_sum_i(int v) {
#pragma unroll
    for (int o = 1; o < 64; o <<= 1) v += __shfl_xor(v, o);
    return v;
}
__device__ __forceinline__ float siluf(float v) { return v / (1.f + expf(-v)); }
__device__ __forceinline__ float sigmf(float v) { return 1.f / (1.f + expf(-v)); }

#ifdef USE_NT
#define NT_STORE(ptr, val) __builtin_nontemporal_store((val), (ptr))
#else
#define NT_STORE(ptr, val) (*(ptr) = (val))
#endif
struct P {
    const float *x, *c, *norm_g, *ada_w, *ada_b, *w_in, *conv_w, *conv_b, *lru_wx, *lru_bx, *lru_wa, *lru_ba, *lru_a, *w_out, *final_g;
    float* out;
    float *mod, *bias, *ssq;
    bf16 *wt_in, *wt_out, *A, *Z, *Y, *X1;
    unsigned* ctl;
};

#ifndef EPI_ZD
#define EPI_ZD 2
#endif
struct EpiZ {
    static constexpr bool PERM = true, AFTER_DRAIN = false;
    bf16* Zp; const float* ssq; const float* bias;
    __device__ __forceinline__ void operator()(const pg8::f32x4 (&acc)[2][2][4][2], const pg8::Unit& u, int wr, int wc, int fr, int fq) const {
        const int row0 = u.pm * 256 + wr * 64 + fr, col0 = u.pn * 256 + wc * 32 + 8 * fq, b = u.pm >> 3;
        const float cs = (u.pn == 4 || u.pn == 5) ? QSCALE : 1.0f;
        f32x4 bv[2][2];
#pragma unroll
        for (int bj = 0; bj < 2; ++bj)
#pragma unroll
            for (int n = 0; n < 2; ++n) bv[bj][n] = *(const f32x4*)(bias + b * ZP + col0 + bj * 128 + 4 * n);
        f32x4 qq[EPI_ZD];
#pragma unroll
        for (int gi = 0; gi < EPI_ZD; ++gi) qq[gi] = *(const f32x4*)(ssq + (size_t)(row0 + (gi >> 2) * 128 + (gi & 3) * 16) * 4);
#pragma unroll
        for (int ai = 0; ai < 2; ++ai)
#pragma unroll
            for (int m = 0; m < 4; ++m) {
                const int r = row0 + ai * 128 + m * 16, gi = ai * 4 + m;
                const f32x4 q = qq[gi % EPI_ZD];
                if (gi + EPI_ZD < 8) qq[gi % EPI_ZD] = *(const f32x4*)(ssq + (size_t)(row0 + ((gi + EPI_ZD) >> 2) * 128 + ((gi + EPI_ZD) & 3) * 16) * 4);
                const float rstd = __builtin_amdgcn_rsqf(((q.x + q.y) + (q.z + q.w)) * (1.0f / 1024.0f) + EPS);
                bf16* rowp = Zp + (size_t)r * ZP + col0;
#pragma unroll
                for (int bj = 0; bj < 2; ++bj) {
                    const f32x4 v0 = (acc[ai][bj][m][0] * rstd + bv[bj][0]) * cs, v1 = (acc[ai][bj][m][1] * rstd + bv[bj][1]) * cs;
                    u32x4 w; w.x = pk2(v0[0], v0[1]); w.y = pk2(v0[2], v0[3]); w.z = pk2(v1[0], v1[1]); w.w = pk2(v1[2], v1[3]);
                    NT_STORE((u32x4*)(rowp + bj * 128), w);
                }
            }
    }
};
#ifndef EPI_XD
#define EPI_XD 4
#endif
struct EpiX {
    static constexpr bool PERM = true, AFTER_DRAIN = true;
    const float* xres; bf16* xout; bf16* Anext; const float* gate; const float* ng; const float* nscale; float* ssq;
    __device__ __forceinline__ void fused(pg8::f32x4 (&acc)[2][2][4][2], const pg8::Unit& u, int wr, int wc, int fr, int fq, LAS unsigned char* lds, int wid, int lane) const {
        const int b = u.pm >> 3, col0 = u.pn * 256 + wc * 32 + 8 * fq;
        LAS float* Pp = (LAS float*)lds;
        f32x4 gv[2][2], gs[2][2];
#pragma unroll
        for (int bj = 0; bj < 2; ++bj)
#pragma unroll
            for (int n = 0; n < 2; ++n) {
                gv[bj][n] = *(const f32x4*)(gate + b * 3072 + col0 + bj * 128 + 4 * n);
                if (Anext) { const f32x4 g = *(const f32x4*)(ng + col0 + bj * 128 + 4 * n), s = *(const f32x4*)(nscale + b * 3072 + col0 + bj * 128 + 4 * n); gs[bj][n] = g * (s + 1.0f); }
                else gs[bj][n] = (f32x4){0.f, 0.f, 0.f, 0.f};
            }
        f32x4 xq[EPI_XD][2][2];
#define EPIX_LOAD(gi) do { const size_t r_ = (size_t)u.pm * 256 + ((gi) >> 2) * 128 + wr * 64 + ((gi) & 3) * 16 + fr; \
        _Pragma("unroll") for (int bj = 0; bj < 2; ++bj) _Pragma("unroll") for (int n = 0; n < 2; ++n) xq[(gi) % EPI_XD][bj][n] = *(const f32x4*)(xres + r_ * DM + col0 + bj * 128 + 4 * n); } while (0)
#pragma unroll
        for (int gi = 0; gi < EPI_XD; ++gi) EPIX_LOAD(gi);
#pragma unroll
        for (int ai = 0; ai < 2; ++ai)
#pragma unroll
            for (int m = 0; m < 4; ++m) {
                const int rl = ai * 128 + wr * 64 + m * 16 + fr; const size_t r = (size_t)u.pm * 256 + rl;
                float s = 0.f;
                f32x4 xc[2][2];
#pragma unroll
                for (int bj = 0; bj < 2; ++bj)
#pragma unroll
                    for (int n = 0; n < 2; ++n) xc[bj][n] = xq[(ai * 4 + m) % EPI_XD][bj][n];
                if (ai * 4 + m + EPI_XD < 8) EPIX_LOAD(ai * 4 + m + EPI_XD);
#pragma unroll
                for (int bj = 0; bj < 2; ++bj) {
                    f32x4 x1[2];
#pragma unroll
                    for (int n = 0; n < 2; ++n) {
                        const f32x4 xr = xc[bj][n];
                        x1[n] = xr + gv[bj][n] * acc[ai][bj][m][n];
                        s += (x1[n][0] * x1[n][0] + x1[n][1] * x1[n][1]) + (x1[n][2] * x1[n][2] + x1[n][3] * x1[n][3]);
                    }
                    { u32x4 xw; xw.x = pk2(x1[0][0], x1[0][1]); xw.y = pk2(x1[0][2], x1[0][3]); xw.z = pk2(x1[1][0], x1[1][1]); xw.w = pk2(x1[1][2], x1[1][3]);
                      NT_STORE((u32x4*)(xout + r * DM + col0 + bj * 128), xw); }
                    if (Anext) { const f32x4 a0 = x1[0] * gs[bj][0], a1 = x1[1] * gs[bj][1];
                        u32x4 w; w.x = pk2(a0[0], a0[1]); w.y = pk2(a0[2], a0[3]); w.z = pk2(a1[0], a1[1]); w.w = pk2(a1[2], a1[3]);
                        NT_STORE((u32x4*)(Anext + r * DM + col0 + bj * 128), w); }
                }
                s += __shfl_xor(s, 16); s += __shfl_xor(s, 32);
                if (fq == 0) Pp[rl * 4 + wc] = s;
            }
        __syncthreads();
        const int tid = wid * 64 + lane;
        if (tid < 256) ssq[((size_t)u.pm * 256 + tid) * 4 + u.pn] = (Pp[tid * 4 + 0] + Pp[tid * 4 + 1]) + (Pp[tid * 4 + 2] + Pp[tid * 4 + 3]);
        __syncthreads();
    }
};

struct EpiXF {
    static constexpr bool PERM = true, AFTER_DRAIN = true;
    const bf16* xres; float* out; const float* gate; const float* fg; float* ssq; unsigned* cnt;
    __device__ __forceinline__ void fused(pg8::f32x4 (&acc)[2][2][4][2], const pg8::Unit& u, int wr, int wc, int fr, int fq, LAS unsigned char* lds, int wid, int lane) const {
        const int b = u.pm >> 3, col0 = u.pn * 256 + wc * 32 + 8 * fq, tid = wid * 64 + lane;
        LAS float* Pp = (LAS float*)lds;
        LAS float* Sr = (LAS float*)(lds + 4096);
        {
            f32x4 gv[2][2];
#pragma unroll
            for (int bj = 0; bj < 2; ++bj)
#pragma unroll
                for (int n = 0; n < 2; ++n) gv[bj][n] = *(const f32x4*)(gate + b * 3072 + col0 + bj * 128 + 4 * n);
#pragma unroll
            for (int ai = 0; ai < 2; ++ai)
#pragma unroll
                for (int m = 0; m < 4; ++m) {
                    const int rl = ai * 128 + wr * 64 + m * 16 + fr; const size_t r = (size_t)u.pm * 256 + rl;
                    float s = 0.f;
#pragma unroll
                    for (int bj = 0; bj < 2; ++bj) {
                        const u32x4 xw = *(const u32x4*)(xres + r * DM + col0 + bj * 128);
#pragma unroll
                        for (int n = 0; n < 2; ++n) {
                            const unsigned w0 = n ? xw.z : xw.x, w1 = n ? xw.w : xw.y;
                            const f32x4 xr = {__uint_as_float(w0 << 16), __uint_as_float(w0 & 0xffff0000u), __uint_as_float(w1 << 16), __uint_as_float(w1 & 0xffff0000u)};
                            const f32x4 x1 = xr + gv[bj][n] * acc[ai][bj][m][n];
                            acc[ai][bj][m][n] = x1;
                            s += (x1[0] * x1[0] + x1[1] * x1[1]) + (x1[2] * x1[2] + x1[3] * x1[3]);
                        }
                    }
                    s += __shfl_xor(s, 16); s += __shfl_xor(s, 32);
                    if (fq == 0) Pp[rl * 4 + wc] = s;
                }
        }
        __syncthreads();
        if (tid < 256) { const float tot = (Pp[tid * 4 + 0] + Pp[tid * 4 + 1]) + (Pp[tid * 4 + 2] + Pp[tid * 4 + 3]);
            __hip_atomic_store(ssq + ((size_t)u.pm * 256 + tid) * 4 + u.pn, tot, __ATOMIC_RELAXED, __HIP_MEMORY_SCOPE_AGENT); }
        asm volatile("s_waitcnt vmcnt(0)" ::: "memory");
        __syncthreads();
        if (tid == 0) {
            unsigned* c = cnt + 64 * u.pm;
            __hip_atomic_fetch_add(c, 1u, __ATOMIC_RELAXED, __HIP_MEMORY_SCOPE_AGENT);
            unsigned spins = 0u;
            while (__hip_atomic_load(c, __ATOMIC_RELAXED, __HIP_MEMORY_SCOPE_AGENT) < 4u) { __builtin_amdgcn_s_sleep(2); if (++spins > (1u << 22)) break; }
            __builtin_amdgcn_fence(__ATOMIC_ACQUIRE, "agent");
            asm volatile("s_waitcnt vmcnt(0)" ::: "memory");
        }
        __syncthreads();
        if (tid < 256) { const float* sp = ssq + ((size_t)u.pm * 256 + tid) * 4;
            const float q0 = __hip_atomic_load(sp + 0, __ATOMIC_RELAXED, __HIP_MEMORY_SCOPE_AGENT), q1 = __hip_atomic_load(sp + 1, __ATOMIC_RELAXED, __HIP_MEMORY_SCOPE_AGENT);
            const float q2 = __hip_atomic_load(sp + 2, __ATOMIC_RELAXED, __HIP_MEMORY_SCOPE_AGENT), q3 = __hip_atomic_load(sp + 3, __ATOMIC_RELAXED, __HIP_MEMORY_SCOPE_AGENT);
            Sr[tid] = 1.0f / sqrtf(((q0 + q1) + (q2 + q3)) * (1.0f / 1024.0f) + EPS); }
        __syncthreads();
        f32x4 fgv[2][2];
#pragma unroll
        for (int bj = 0; bj < 2; ++bj)
#pragma unroll
            for (int n = 0; n < 2; ++n) fgv[bj][n] = *(const f32x4*)(fg + col0 + bj * 128 + 4 * n);
#pragma unroll
        for (int ai = 0; ai < 2; ++ai)
#pragma unroll
            for (int m = 0; m < 4; ++m) {
                const int rl = ai * 128 + wr * 64 + m * 16 + fr; const size_t r = (size_t)u.pm * 256 + rl; const float rstd = Sr[rl];
#pragma unroll
                for (int bj = 0; bj < 2; ++bj)
#pragma unroll
                    for (int n = 0; n < 2; ++n) NT_STORE((f32x4*)(out + r * DM + col0 + bj * 128 + 4 * n), acc[ai][bj][m][n] * rstd * fgv[bj][n]);
            }
        __syncthreads();
    }
};

#ifndef PRO_KC
#define PRO_KC 64
#endif
#ifndef TRQ
#define TRQ 4
#endif
__device__ __forceinline__ void ph0_prologue(const P& p, LAS unsigned char* lds) {
    const int tid = threadIdx.x, lane = tid & 63, wave = tid >> 6, G = gridDim.x, wg = blockIdx.x;
    LAS float* fl = (LAS float*)lds;
    for (int u = wg; u < 96; u += G) {
        const int l = u / 48, j = (u % 48) * 64 + lane;
        { float cv[16];
#pragma unroll
          for (int i = 0; i < 16; ++i) cv[i] = p.c[tid + 512 * i];
#pragma unroll
          for (int i = 0; i < 16; ++i) fl[tid + 512 * i] = siluf(cv[i]); }
        __syncthreads();
        float acc[8];
#pragma unroll
        for (int b = 0; b < 8; ++b) acc[b] = 0.f;
        const float* w = p.ada_w + ((size_t)l * 1024 + wave * 128) * 3072 + j;
#pragma unroll 1
        for (int k0 = 0; k0 < 128; k0 += PRO_KC) { float wv[PRO_KC];
#pragma unroll
          for (int k = 0; k < PRO_KC; ++k) wv[k] = w[(size_t)(k0 + k) * 3072];
#pragma unroll
          for (int k = 0; k < PRO_KC; ++k) {
#pragma unroll
            for (int b = 0; b < 8; ++b) acc[b] += fl[b * 1024 + wave * 128 + k0 + k] * wv[k]; } }
#pragma unroll
        for (int b = 0; b < 8; ++b) fl[8192 + (wave * 8 + b) * 64 + lane] = acc[b];
        __syncthreads();
        { const int b = wave; float s = p.ada_b[l * 3072 + j];
#pragma unroll
          for (int w8 = 0; w8 < 8; ++w8) s += fl[8192 + (w8 * 8 + b) * 64 + lane];
          p.mod[(l * 8 + b) * 3072 + j] = s; }
        __syncthreads();
    }
    const int GT = (G > 96) ? G - 96 : G, wt = (G > 96) ? wg - 96 : wg;
    if (wt >= 0)
#pragma unroll 1
    for (int u0 = wt; u0 < 1920; u0 += TRQ * GT) {
        float v[TRQ][8]; bf16* dst[TRQ]; bool act[TRQ];
#pragma unroll
        for (int q = 0; q < TRQ; ++q) {
            const int u = u0 + q * GT; act[q] = u < 1920; dst[q] = nullptr;
#pragma unroll
            for (int j = 0; j < 8; ++j) v[q][j] = 0.f;
            if (act[q]) {
                const float* W; bf16* WT; int N, kt, nt;
                if (u < 1408) { const int l = u / 704, r = u % 704; kt = r / 44; nt = r % 44; W = p.w_in + (size_t)l * 1024 * D_INR; N = D_INR; WT = p.wt_in + (size_t)l * ZP * 1024; }
                else { int r = u - 1408; const int l = r / 256; r %= 256; kt = r / 16; nt = r % 16; W = p.w_out + (size_t)l * 1024 * 1024; N = 1024; WT = p.wt_out + (size_t)l * 1024 * 1024; }
                const int n = nt * 64 + lane, k0 = kt * 64 + wave * 8;
                if (n < N) {
#pragma unroll
                    for (int j = 0; j < 8; ++j) v[q][j] = W[(size_t)(k0 + j) * N + n];
                }
                dst[q] = WT + (size_t)n * 1024 + k0;
            }
        }
#pragma unroll
        for (int q = 0; q < TRQ; ++q) if (act[q]) { u32x4 o; o.x = pk2(v[q][0], v[q][1]); o.y = pk2(v[q][2], v[q][3]); o.z = pk2(v[q][4], v[q][5]); o.w = pk2(v[q][6], v[q][7]); *(u32x4*)dst[q] = o; }
    }
}
__device__ __forceinline__ void ph1_prologue(const P& p, LAS unsigned char* lds) {
    const int tid = threadIdx.x, lane = tid & 63, wave = tid >> 6, G = gridDim.x, wg = blockIdx.x;
    LAS float* fl = (LAS float*)lds;
    for (int u = wg; u < 88; u += G) {
        const int l = u / 44, n = (u % 44) * 64 + lane;
        { float mv[16];
#pragma unroll
          for (int i = 0; i < 16; ++i) { const int e = tid + 512 * i; mv[i] = p.mod[(l * 8 + (e >> 10)) * 3072 + (e & 1023)]; }
#pragma unroll
          for (int i = 0; i < 16; ++i) fl[tid + 512 * i] = mv[i]; }
        __syncthreads();
        float acc[8];
#pragma unroll
        for (int b = 0; b < 8; ++b) acc[b] = 0.f;
        if (n < D_INR) { const float* w = p.w_in + ((size_t)l * 1024 + wave * 128) * D_INR + n;
#pragma unroll 1
            for (int k0 = 0; k0 < 128; k0 += PRO_KC) { float wv[PRO_KC];
#pragma unroll
              for (int k = 0; k < PRO_KC; ++k) wv[k] = w[(size_t)(k0 + k) * D_INR];
#pragma unroll
              for (int k = 0; k < PRO_KC; ++k) {
#pragma unroll
                for (int b = 0; b < 8; ++b) acc[b] += fl[b * 1024 + wave * 128 + k0 + k] * wv[k]; } } }
#pragma unroll
        for (int b = 0; b < 8; ++b) fl[8192 + (wave * 8 + b) * 64 + lane] = acc[b];
        __syncthreads();
        { const int b = wave; float s = 0.f;
#pragma unroll
          for (int w8 = 0; w8 < 8; ++w8) s += fl[8192 + (w8 * 8 + b) * 64 + lane];
          p.bias[(l * 8 + b) * ZP + n] = s; }
        __syncthreads();
    }
#ifdef A0_REBAL
    {
        const bool bw = wg < 88;
        const int uw = bw ? wg * 8 + wave : (wg - 88) * 8 + wave;
        const int qbase = bw ? uw : 1408 + uw, qstr = bw ? 704 : 1344, nq = bw ? 2 : (5 + (uw < 64 ? 1 : 0));
        f32x4 gq[4], xv[2][2][4], sv[2][2][4];
#pragma unroll
        for (int j = 0; j < 4; ++j) gq[j] = *(const f32x4*)(p.norm_g + (lane + 64 * j) * 4);
#define A0_LOAD(slot, qi) do { const int q_ = qbase + qstr * ((qi) < nq ? (qi) : nq - 1); _Pragma("unroll") for (int h_ = 0; h_ < 2; ++h_) _Pragma("unroll") for (int j = 0; j < 4; ++j) { \
            const int k_ = (lane + 64 * j) * 4, r_ = (q_ & 2047) + 2048 * (2 * (q_ >> 11) + h_); \
            xv[slot][h_][j] = *(const f32x4*)(p.x + (size_t)r_ * DM + k_); sv[slot][h_][j] = *(const f32x4*)(p.mod + (size_t)(r_ >> 11) * 3072 + 1024 + k_); } } while (0)
#define A0_PROC(slot, qi) do { const int q_ = qbase + qstr * (qi); _Pragma("unroll") for (int h = 0; h < 2; ++h) { \
            const int r = (q_ & 2047) + 2048 * (2 * (q_ >> 11) + h); float s1 = 0.f; \
            _Pragma("unroll") for (int j = 0; j < 4; ++j) { const int k = (lane + 64 * j) * 4; const f32x4 v = xv[slot][h][j]; \
                s1 += (v[0] * v[0] + v[1] * v[1]) + (v[2] * v[2] + v[3] * v[3]); \
                const f32x4 o1 = v * gq[j] * (sv[slot][h][j] + 1.0f); \
                u32x2 w1; w1.x = pk2(o1[0], o1[1]); w1.y = pk2(o1[2], o1[3]); \
                *(u32x2*)(p.A + (size_t)r * DM + k) = w1; } \
            s1 = wave_sum(s1); \
            if (lane == 0) *(f32x4*)(p.ssq + (size_t)r * 4) = (f32x4){s1, 0.f, 0.f, 0.f}; } } while (0)
        A0_LOAD(0, 0);
#pragma unroll 1
        for (int i = 0; i < nq; i += 2) {
            A0_LOAD(1, i + 1);
            A0_PROC(0, i);
            A0_LOAD(0, i + 2);
            if (i + 1 < nq) A0_PROC(1, i + 1);
        }
#undef A0_LOAD
#undef A0_PROC
    }
#else
    {
        const int r0 = wg * 8 + wave, rstep = G * 8;
        f32x4 gq[4], xv[2][2][4], sv[2][2][4];
#pragma unroll
        for (int j = 0; j < 4; ++j) gq[j] = *(const f32x4*)(p.norm_g + (lane + 64 * j) * 4);
#define A0_LOAD(slot, pr) do { _Pragma("unroll") for (int h_ = 0; h_ < 2; ++h_) _Pragma("unroll") for (int j = 0; j < 4; ++j) { const int k_ = (lane + 64 * j) * 4, r_ = r0 + rstep * (2 * (pr) + h_); \
            xv[slot][h_][j] = *(const f32x4*)(p.x + (size_t)r_ * DM + k_); sv[slot][h_][j] = *(const f32x4*)(p.mod + (size_t)(r_ >> 11) * 3072 + 1024 + k_); } } while (0)
        A0_LOAD(0, 0);
#pragma unroll
        for (int pr = 0; pr < 4; ++pr) {
            if (pr + 1 < 4) A0_LOAD((pr + 1) & 1, pr + 1);
#pragma unroll
            for (int h = 0; h < 2; ++h) {
                const int r = r0 + rstep * (2 * pr + h); float s1 = 0.f;
#pragma unroll
                for (int j = 0; j < 4; ++j) { const int k = (lane + 64 * j) * 4; const f32x4 v = xv[pr & 1][h][j];
                    s1 += (v[0] * v[0] + v[1] * v[1]) + (v[2] * v[2] + v[3] * v[3]);
                    const f32x4 o1 = v * gq[j] * (sv[pr & 1][h][j] + 1.0f);
                    u32x2 w1; w1.x = pk2(o1[0], o1[1]); w1.y = pk2(o1[2], o1[3]);
                    *(u32x2*)(p.A + (size_t)r * DM + k) = w1; }
                s1 = wave_sum(s1);
                if (lane == 0) *(f32x4*)(p.ssq + (size_t)r * 4) = (f32x4){s1, 0.f, 0.f, 0.f};
            }
        }
#undef A0_LOAD
    }
#endif
}
__device__ __forceinline__ void ph_final(const P& p) {
    const int tid = threadIdx.x, lane = tid & 63, wave = tid >> 6, G = gridDim.x, wg = blockIdx.x;
    for (int r = wg * 8 + wave; r < MROWS; r += G * 8) {
        const f32x4 q = *(const f32x4*)(p.ssq + (size_t)r * 4);
        const float rstd = 1.0f / sqrtf(((q.x + q.y) + (q.z + q.w)) * (1.0f / 1024.0f) + EPS);
#pragma unroll
        for (int j = 0; j < 4; ++j) { const int k = (lane + 64 * j) * 4;
            const f32x4 v = *(const f32x4*)(p.out + (size_t)r * DM + k), g = *(const f32x4*)(p.final_g + k);
            *(f32x4*)(p.out + (size_t)r * DM + k) = v * rstd * g; }
    }
}
#define XB_TMO      128
#define XB_XCNT(j)  (256  + 64 * (j))
#define XB_XSUB(j)  (1280 + 64 * (j))
#define XB_XGEN(j)  (2304 + 64 * (j))
#define XB_TOP      3328
#define XB_TOPGEN   3392
#define XB_MAPMAX(r) (3456 + 64 * (r))
#define XB_MAPINV(r) (3968 + 64 * (r))
#define XCD_BAR_WORDS 4480
#define XB_SPIN_CAP (1u << 18)

__device__ __forceinline__ unsigned xb_ld(unsigned* p)              { return __hip_atomic_load(p, __ATOMIC_RELAXED, __HIP_MEMORY_SCOPE_AGENT); }
__device__ __forceinline__ unsigned xb_add(unsigned* p, unsigned v) { return __hip_atomic_fetch_add(p, v, __ATOMIC_RELAXED, __HIP_MEMORY_SCOPE_AGENT); }
__device__ __forceinline__ unsigned xb_xcc_id() { return (unsigned)__builtin_amdgcn_s_getreg((3 << 11) | 20) & 0xFu; }
#define XB_SPIN(cond, bar) do { unsigned _sp = 0; while (cond) { __builtin_amdgcn_s_sleep(1); \
    if ((++_sp & 255u) == 0u) { if (xb_ld(&(bar)[XB_TMO])) break; if (_sp > XB_SPIN_CAP) { atomicAdd(&(bar)[XB_TMO], 1u); break; } } } } while (0)

struct XcdBarrier {
    unsigned* bar; unsigned x;
    volatile LAS unsigned* st;
};

__device__ __forceinline__ XcdBarrier xcd_barrier_post(unsigned* bar, volatile LAS unsigned* st) {
    XcdBarrier b; b.bar = bar; b.x = xb_xcc_id(); b.st = st;
    if (threadIdx.x == 0) { (void)xb_add(&bar[XB_XCNT(b.x)], 1u);
#ifdef XB_LOCAL
        const unsigned r = blockIdx.x & 7u;
        __hip_atomic_fetch_max(&bar[XB_MAPMAX(r)], b.x + 1u, __ATOMIC_RELAXED, __HIP_MEMORY_SCOPE_AGENT);
        __hip_atomic_fetch_max(&bar[XB_MAPINV(r)], 16u - b.x, __ATOMIC_RELAXED, __HIP_MEMORY_SCOPE_AGENT);
#endif
    }
    return b;
}
__device__ __forceinline__ void xcd_barrier_complete(unsigned* bar, unsigned x, unsigned& nloc, unsigned& nx) {
    const unsigned G = gridDim.x * gridDim.y * gridDim.z;
    unsigned sum, cnt, mine, sp = 0u;
    for (;;) {
        sum = 0u; cnt = 0u; mine = 0u;
#pragma unroll
        for (unsigned j = 0; j < 16; ++j) { const unsigned c = xb_ld(&bar[XB_XCNT(j)]); sum += c; cnt += (c > 0u) ? 1u : 0u; mine = (j == x) ? c : mine; }
        if (sum == G) break;
        __builtin_amdgcn_s_sleep(1);
        if ((++sp & 255u) == 0u) { if (xb_ld(&bar[XB_TMO])) break; if (sp > XB_SPIN_CAP) { atomicAdd(&bar[XB_TMO], 1u); break; } }
    }
    nloc = mine > 0u ? mine : 1u; nx = cnt > 0u ? cnt : 1u;
}

__device__ __forceinline__ void xcd_barrier(const XcdBarrier& b) {
    asm volatile("s_waitcnt vmcnt(0)" ::: "memory");
    __syncthreads();
    if (threadIdx.x == 0) {
        unsigned* bar = b.bar;
        __builtin_amdgcn_s_waitcnt(0);
        unsigned nloc = b.st[0], nx = b.st[1];
        if (nloc == 0u) { xcd_barrier_complete(bar, b.x, nloc, nx); b.st[0] = nloc; b.st[1] = nx; }
#ifdef XB_EARLY_WB
        __builtin_amdgcn_fence(__ATOMIC_RELEASE, "agent");
        asm volatile("s_waitcnt vmcnt(0)" ::: "memory");
#endif
        const unsigned old = xb_add(&bar[XB_XSUB(b.x)], 1u);
        const unsigned gen = old / nloc;
        if (old + 1u == (gen + 1u) * nloc) {
#ifndef XB_EARLY_WB
            __builtin_amdgcn_fence(__ATOMIC_RELEASE, "agent");
#endif
            asm volatile("s_waitcnt vmcnt(0)" ::: "memory");
            const unsigned og = xb_add(&bar[XB_TOP], 1u);
            const unsigned tg = og / nx;
            if (og + 1u == (tg + 1u) * nx) xb_add(&bar[XB_TOPGEN], 1u);
            else XB_SPIN(xb_ld(&bar[XB_TOPGEN]) == tg, bar);
            __builtin_amdgcn_fence(__ATOMIC_ACQUIRE, "agent");
            xb_add(&bar[XB_XGEN(b.x)], 1u);
            asm volatile("s_waitcnt vmcnt(0)" ::: "memory");
        } else {
#ifdef XB_FLAT_RELEASE
            XB_SPIN(xb_ld(&bar[XB_TOPGEN]) == gen, bar);
#else
            XB_SPIN(xb_ld(&bar[XB_XGEN(b.x)]) == gen, bar);
#endif
            __builtin_amdgcn_fence(__ATOMIC_ACQUIRE, "agent");
            asm volatile("s_waitcnt vmcnt(0)" ::: "memory");
        }
    }
    __syncthreads();
}

#ifdef XB_LOCAL
__device__ __forceinline__ void xcd_barrier_local(const XcdBarrier& b) {
    const unsigned v0 = b.st[2];
    __syncthreads();
    if (v0 == 0u) {
        if (threadIdx.x == 0) {
            bool ok = true;
#pragma unroll
            for (unsigned r = 0; r < 8; ++r) ok = ok && (xb_ld(&b.bar[XB_MAPMAX(r)]) + xb_ld(&b.bar[XB_MAPINV(r)]) == 17u);
            b.st[2] = ok ? 1u : 2u;
        }
        __syncthreads();
    }
    if (b.st[2] != 1u) { xcd_barrier(b); return; }
    asm volatile("s_waitcnt vmcnt(0)" ::: "memory");
    __syncthreads();
    if (threadIdx.x == 0) {
        unsigned* bar = b.bar;
        __builtin_amdgcn_s_waitcnt(0);
        const unsigned nloc = b.st[0];
        const unsigned old = xb_add(&bar[XB_XSUB(b.x)], 1u);
        const unsigned gen = old / nloc;
        if (old + 1u == (gen + 1u) * nloc) xb_add(&bar[XB_XGEN(b.x)], 1u);
        else XB_SPIN(xb_ld(&bar[XB_XGEN(b.x)]) == gen, bar);
        __builtin_amdgcn_fence(__ATOMIC_ACQUIRE, "agent");
        asm volatile("s_waitcnt vmcnt(0)" ::: "memory");
    }
    __syncthreads();
}
#endif
__device__ __forceinline__ unsigned score_ukey(float s) { const unsigned u = __float_as_uint(s + 0.0f); return (u & 0x80000000u) ? ~u : (u | 0x80000000u); }
__device__ __forceinline__ void topk_threshold(const unsigned (&k)[32], unsigned& thr, unsigned& need) {
    unsigned prefix = 0u; bool exact = false;
    for (int bit = 31; bit >= 0; --bit) {
        const unsigned cand = prefix | (1u << bit);
        int c = 0;
#pragma unroll
        for (int i = 0; i < 32; ++i) c += (k[i] >= cand) ? 1 : 0;
        c = wave_sum_i(c);
        if (c >= TOPK) prefix = cand;
        if (c == TOPK) { exact = true; break; }
    }
    thr = prefix;
    if (exact) { need = 0xffffffffu; }
    else { int c = 0;
#pragma unroll
        for (int i = 0; i < 32; ++i) c += (k[i] > prefix) ? 1 : 0;
        c = wave_sum_i(c); need = (unsigned)(TOPK - c); }
}
#ifndef PROBE_VALU
#define PROBE_VALU 0
#endif
#ifndef RP_T3
#define RP_T3 1
#endif
#ifndef RP_T1
#define RP_T1 1
#endif
#ifndef RP_T2
#define RP_T2 1
#endif
#ifndef RP_I
#define RP_I 1
#endif
#ifndef RP_T
#define RP_T 1
#endif
#ifndef RP_V
#define RP_V 1
#endif
typedef short bf16x8v __attribute__((ext_vector_type(8)));
typedef short s16x4v __attribute__((ext_vector_type(4)));
constexpr int BMS = 65;
constexpr int SCP = 2052;
constexpr int DSA_BM_OFF = 16 * SCP * 4;
constexpr int DSA_RING_OFF = 0;
constexpr int DSA_QIB_OFF = 147456;
constexpr int DSA_WIB_OFF = 135680;
constexpr int DSA_MLUT_OFF = 143616;
__device__ __forceinline__ void glds16(const void* gsrc, unsigned lds_dst) { unsigned keep;
    asm volatile("s_mov_b32 %0, m0\n\ts_mov_b32 m0, %2\n\ts_nop 0\n\tglobal_load_lds_dwordx4 %1, off\n\ts_mov_b32 m0, %0" : "=&s"(keep) : "v"(gsrc), "s"(lds_dst) : "memory"); }
template <int I> __device__ __forceinline__ unsigned mbit_t(int mw) { unsigned r; asm("v_bfe_i32 %0, %1, %2, 1" : "=v"(r) : "v"(mw), "i"(I)); return r; }
#define mbit(mw, i) mbit_t<(i)>(mw)
#ifdef IDX_SADDR
#define IDX_DIAG_BR asm volatile("" ::: "memory")
#else
#define IDX_DIAG_BR
#endif
#ifdef ATT_SETPRIO
#define ATT_PRIO(p) __builtin_amdgcn_s_setprio(p)
#else
#define ATT_PRIO(p)
#endif
__device__ __forceinline__ float relu_i(float x) { return __int_as_float(max(__float_as_int(x), 0)); }
#ifndef NO_FMAC_S
__device__ __forceinline__ float fmac_s(float a, float b, float c) { asm("v_fmac_f32_e32 %0, %1, %2" : "+v"(c) : "v"(a), "v"(b)); return c; }
#else
__device__ __forceinline__ float fmac_s(float a, float b, float c) { return a * b + c; }
#endif
__device__ __forceinline__ int imax3(float a, float b, float c) { return max(max(__float_as_int(a), __float_as_int(b)), __float_as_int(c)); }
__device__ __forceinline__ s16x4v lds_tr16(LAS const unsigned char* p) { return __builtin_bit_cast(s16x4v, __builtin_amdgcn_ds_read_tr16_b64_v4i16((LAS s16x4v*)p)); }
__device__ __forceinline__ unsigned cvtpk(float lo, float hi) { typedef float f2 __attribute__((ext_vector_type(2))); typedef __bf16 b2 __attribute__((ext_vector_type(2))); f2 v = {lo, hi}; b2 r = __builtin_convertvector(v, b2); return __builtin_bit_cast(unsigned, r); }


template <int L> __device__ __forceinline__ void wr2lanes(int& w, unsigned lo, unsigned hi) {
    asm volatile("s_nop 1\n\tv_writelane_b32 %0, %1, %3\n\tv_writelane_b32 %0, %2, %4" : "+v"(w) : "s"(lo), "s"(hi), "i"(L), "i"(L + 1));
}
__device__ __forceinline__ int wave_sum_dpp(int v) {
    v += __builtin_amdgcn_update_dpp(0, v, 0xB1, 0xf, 0xf, true);
    v += __builtin_amdgcn_update_dpp(0, v, 0x4E, 0xf, 0xf, true);
    v += __builtin_amdgcn_update_dpp(0, v, 0x141, 0xf, 0xf, true);
    v += __builtin_amdgcn_update_dpp(0, v, 0x140, 0xf, 0xf, true);
    return __builtin_amdgcn_readlane(v, 0) + __builtin_amdgcn_readlane(v, 16) + __builtin_amdgcn_readlane(v, 32) + __builtin_amdgcn_readlane(v, 48);
}
__device__ __forceinline__ unsigned wave_max_dpp(unsigned v) {
    v = max(v, (unsigned)__builtin_amdgcn_update_dpp(0, (int)v, 0xB1, 0xf, 0xf, true));
    v = max(v, (unsigned)__builtin_amdgcn_update_dpp(0, (int)v, 0x4E, 0xf, 0xf, true));
    v = max(v, (unsigned)__builtin_amdgcn_update_dpp(0, (int)v, 0x141, 0xf, 0xf, true));
    v = max(v, (unsigned)__builtin_amdgcn_update_dpp(0, (int)v, 0x140, 0xf, 0xf, true));
    return max(max((unsigned)__builtin_amdgcn_readlane((int)v, 0), (unsigned)__builtin_amdgcn_readlane((int)v, 16)), max((unsigned)__builtin_amdgcn_readlane((int)v, 32), (unsigned)__builtin_amdgcn_readlane((int)v, 48)));
}
__device__ __forceinline__ void cnt8(int& a0, int& a1, int& a2, int& a3, unsigned cand, unsigned k0, unsigned k1, unsigned k2, unsigned k3, unsigned k4, unsigned k5, unsigned k6, unsigned k7) {
    unsigned long long m0, m1, m2, m3, m4, m5, m6, m7;
    asm volatile("v_cmp_le_u32_e64 %4, %12, %13\n\tv_cmp_le_u32_e64 %5, %12, %14\n\tv_cmp_le_u32_e64 %6, %12, %15\n\tv_cmp_le_u32_e64 %7, %12, %16\n\t"
                 "v_cmp_le_u32_e64 %8, %12, %17\n\tv_cmp_le_u32_e64 %9, %12, %18\n\tv_cmp_le_u32_e64 %10, %12, %19\n\tv_cmp_le_u32_e64 %11, %12, %20\n\t"
                 "v_addc_co_u32_e64 %0, %4, 0, %0, %4\n\tv_addc_co_u32_e64 %1, %5, 0, %1, %5\n\tv_addc_co_u32_e64 %2, %6, 0, %2, %6\n\tv_addc_co_u32_e64 %3, %7, 0, %3, %7\n\t"
                 "v_addc_co_u32_e64 %0, %8, 0, %0, %8\n\tv_addc_co_u32_e64 %1, %9, 0, %1, %9\n\tv_addc_co_u32_e64 %2, %10, 0, %2, %10\n\tv_addc_co_u32_e64 %3, %11, 0, %3, %11"
                 : "+v"(a0), "+v"(a1), "+v"(a2), "+v"(a3), "=&s"(m0), "=&s"(m1), "=&s"(m2), "=&s"(m3), "=&s"(m4), "=&s"(m5), "=&s"(m6), "=&s"(m7)
                 : "s"(cand), "v"(k0), "v"(k1), "v"(k2), "v"(k3), "v"(k4), "v"(k5), "v"(k6), "v"(k7));
}
__device__ __forceinline__ int count_ge(const unsigned (&k)[32], unsigned cand_, int nb) {
    const unsigned cand = (unsigned)__builtin_amdgcn_readfirstlane((int)cand_);
    int a0 = 0, a1 = 0, a2 = 0, a3 = 0;
    cnt8(a0, a1, a2, a3, cand, k[0], k[1], k[2], k[3], k[4], k[5], k[6], k[7]);
    if (nb > 1) cnt8(a0, a1, a2, a3, cand, k[8], k[9], k[10], k[11], k[12], k[13], k[14], k[15]);
    if (nb > 2) cnt8(a0, a1, a2, a3, cand, k[16], k[17], k[18], k[19], k[20], k[21], k[22], k[23]);
    if (nb > 3) cnt8(a0, a1, a2, a3, cand, k[24], k[25], k[26], k[27], k[28], k[29], k[30], k[31]);
    return wave_sum_dpp((a0 + a1) + (a2 + a3));
}
__device__ __forceinline__ int wave_scan_dpp(int v) {
    v += __builtin_amdgcn_update_dpp(0, v, 0x111, 0xf, 0xf, false);
    v += __builtin_amdgcn_update_dpp(0, v, 0x112, 0xf, 0xf, false);
    v += __builtin_amdgcn_update_dpp(0, v, 0x114, 0xf, 0xf, false);
    v += __builtin_amdgcn_update_dpp(0, v, 0x118, 0xf, 0xf, false);
    v += __builtin_amdgcn_update_dpp(0, v, 0x142, 0xa, 0xf, false);
    v += __builtin_amdgcn_update_dpp(0, v, 0x143, 0xc, 0xf, false);
    return v;
}
#ifndef WALK_MAX
#define WALK_MAX 4
#endif
#ifndef HIST_WAVES
#define HIST_WAVES 4
#endif
struct TopkState { unsigned prefix; int bit; bool done; unsigned need; int nb; LAS unsigned* hist; int crej; };
#ifndef HB_BITS
#define HB_BITS 8
#endif
__device__ __forceinline__ void topk_hist(const unsigned (&k)[32], TopkState& st, int c_above) {
    constexpr int NBIN = 1 << HB_BITS, BPL = NBIN / 64, SH = 23 - HB_BITS;
    const int lane = threadIdx.x & 63;
    const unsigned T = (unsigned)__builtin_amdgcn_readfirstlane((int)st.prefix);
    LAS unsigned* hist = st.hist;
#pragma unroll
    for (int q = 0; q < BPL / 4; ++q) *(LAS u32x4*)(hist + BPL * lane + 4 * q) = (u32x4){0u, 0u, 0u, 0u};
    asm volatile("" ::: "memory");
    const unsigned hb_ = (unsigned)(uintptr_t)hist; const unsigned one = 1u;
#define HF1(K) "v_subrev_u32_e32 %0, %2, " K "\n\tv_lshrrev_b32_e32 %0, %13, %0\n\tv_cmpx_gt_u32_e32 vcc, %14, %0\n\tv_lshl_add_u32 %0, %0, 2, %3\n\tds_add_u32 %0, %4\n\ts_mov_b64 exec, %1\n\t"
#define HF8(i0) { unsigned t0_; unsigned long long ex_; \
        asm volatile("s_mov_b64 %1, exec\n\t" HF1("%5") HF1("%6") HF1("%7") HF1("%8") HF1("%9") HF1("%10") HF1("%11") HF1("%12") "s_nop 0" \
            : "=&v"(t0_), "=&s"(ex_) : "s"(T), "s"(hb_), "v"(one), "v"(k[i0]), "v"(k[i0 + 1]), "v"(k[i0 + 2]), "v"(k[i0 + 3]), "v"(k[i0 + 4]), "v"(k[i0 + 5]), "v"(k[i0 + 6]), "v"(k[i0 + 7]), "i"(SH), "i"(NBIN) : "vcc", "memory"); }
    HF8(0)
    if (st.nb > 1) HF8(8)
    if (st.nb > 2) HF8(16)
    if (st.nb > 3) HF8(24)
#undef HF8
#undef HF1
    asm volatile("" ::: "memory");
    u32x4 w[BPL / 4]; int t = 0;
#pragma unroll
    for (int q = 0; q < BPL / 4; ++q) { w[q] = *(LAS const u32x4*)(hist + BPL * (63 - lane) + 4 * q); t += (int)((w[q].x + w[q].y) + (w[q].z + w[q].w)); }
    const int P = wave_scan_dpp(t);
    const int k1 = TOPK - c_above;
    const unsigned long long bal = __ballot(P >= k1);
    const int Ls = __builtin_ctzll(bal);
    int c = __builtin_amdgcn_readlane(P, Ls) - __builtin_amdgcn_readlane(t, Ls);
    int bsel = 0, hb = 0; bool found = false;
#pragma unroll
    for (int j = BPL - 1; j >= 0; --j) {
        if (!found) { const int h_ = __builtin_amdgcn_readlane((int)w[j >> 2][j & 3], Ls); if (c + h_ >= k1) { bsel = j; hb = h_; found = true; } else c += h_; }
    }
    const unsigned bin = (unsigned)(BPL * (63 - Ls) + bsel);
    st.prefix = T | (bin << SH); st.bit = SH - 1;
    if (c + hb == k1) { st.done = true; st.need = 0xffffffffu; }
#ifndef NO_TOPK_GATHER
    else if (hb <= 64) {
        const unsigned Pf = (unsigned)__builtin_amdgcn_readfirstlane((int)st.prefix);
        const int k2 = k1 - c;
        LAS unsigned* list = hist;
        int base = 0;
#define GT1(i) { const bool p_ = (k[i] - Pf) < (1u << SH); const unsigned long long m_ = __ballot(p_); \
            if (m_ != 0ull) { const int r_ = base + (int)__builtin_amdgcn_mbcnt_hi((unsigned)(m_ >> 32), __builtin_amdgcn_mbcnt_lo((unsigned)m_, 0u)); if (p_) list[r_] = k[i]; base += __popcll(m_); } }
#define GT4(i0) { const unsigned dm_ = min(min(k[i0] - Pf, k[i0 + 1] - Pf), min(k[i0 + 2] - Pf, k[i0 + 3] - Pf)); \
            if (__ballot(dm_ < (1u << SH)) != 0ull) { GT1(i0) GT1(i0 + 1) GT1(i0 + 2) GT1(i0 + 3) } }
        GT4(0) GT4(4)
        if (st.nb > 1) { GT4(8) GT4(12) }
        if (st.nb > 2) { GT4(16) GT4(20) }
        if (st.nb > 3) { GT4(24) GT4(28) }
#undef GT4
#undef GT1
        asm volatile("" ::: "memory");
        const unsigned v = (lane < hb) ? list[lane] : 0u;
        int g = 0, ge = 0;
#pragma unroll 1
        for (int j = 0; j < hb; ++j) { const unsigned s_ = (unsigned)__builtin_amdgcn_readlane((int)v, j); g += (s_ > v) ? 1 : 0; ge += (s_ >= v) ? 1 : 0; }
        const unsigned long long hit = __ballot(lane < hb && g < k2 && ge >= k2);
        if (hit != 0ull) {
            const int Lh = __builtin_ctzll(hit);
            const int gs = __builtin_amdgcn_readlane(g, Lh), ges = __builtin_amdgcn_readlane(ge, Lh);
            st.prefix = (unsigned)__builtin_amdgcn_readlane((int)v, Lh); st.done = true;
            st.need = (ges - gs == k2 - gs) ? 0xffffffffu : (unsigned)(k2 - gs);
        }
    }
#endif
}
__device__ __forceinline__ bool topk_histE(const unsigned (&k)[32], TopkState& st, unsigned Etop_, int k1, int cbase) {
    const int lane = threadIdx.x & 63;
    const unsigned Etop = (unsigned)__builtin_amdgcn_readfirstlane((int)Etop_);
    LAS unsigned* hist = st.hist;
    *(LAS u32x4*)(hist + 8 * lane) = (u32x4){0u, 0u, 0u, 0u}; *(LAS u32x4*)(hist + 8 * lane + 4) = (u32x4){0u, 0u, 0u, 0u};
    asm volatile("" ::: "memory");
    const unsigned hb_ = (unsigned)(uintptr_t)hist, one = 1u, l7 = (unsigned)lane & 7u;
#define HE1(K) "v_lshrrev_b32_e32 %0, 23, " K "\n\tv_sub_u32_e32 %0, %2, %0\n\tv_cmpx_gt_u32_e32 vcc, 64, %0\n\tv_lshl_or_b32 %0, %0, 3, %5\n\tv_lshl_add_u32 %0, %0, 2, %3\n\tds_add_u32 %0, %4\n\ts_mov_b64 exec, %1\n\t"
#define HE8(i0) { unsigned t0_; unsigned long long ex_; \
        asm volatile("s_mov_b64 %1, exec\n\t" HE1("%6") HE1("%7") HE1("%8") HE1("%9") HE1("%10") HE1("%11") HE1("%12") HE1("%13") "s_nop 0" \
            : "=&v"(t0_), "=&s"(ex_) : "s"(Etop), "s"(hb_), "v"(one), "v"(l7), "v"(k[i0]), "v"(k[i0 + 1]), "v"(k[i0 + 2]), "v"(k[i0 + 3]), "v"(k[i0 + 4]), "v"(k[i0 + 5]), "v"(k[i0 + 6]), "v"(k[i0 + 7]) : "vcc", "memory"); }
    HE8(0)
    if (st.nb > 1) HE8(8)
    if (st.nb > 2) HE8(16)
    if (st.nb > 3) HE8(24)
#undef HE8
#undef HE1
    asm volatile("" ::: "memory");
    const u32x4 w0 = *(LAS const u32x4*)(hist + 8 * lane), w1 = *(LAS const u32x4*)(hist + 8 * lane + 4);
    const int t = (int)(((w0.x + w0.y) + (w0.z + w0.w)) + ((w1.x + w1.y) + (w1.z + w1.w)));
    const int P = wave_scan_dpp(t);
    const unsigned long long bal = __ballot(P >= k1);
    if (bal == 0ull) return false;
    const int Ls = __builtin_ctzll(bal);
    const int S = __builtin_amdgcn_readlane(P, Ls), cab = S - __builtin_amdgcn_readlane(t, Ls);
    st.prefix = (Etop - (unsigned)Ls) << 23; st.bit = 22; st.crej = cbase + cab;
    if (S == k1) { st.done = true; st.need = 0xffffffffu; }
    return true;
}
__device__ __forceinline__ void topk_init(const unsigned (&k)[32], TopkState& st) {
    unsigned mx = 0u;
#pragma unroll
    for (int i = 0; i < 32; ++i) mx = max(mx, k[i]);
    mx = wave_max_dpp(mx);
    st.prefix = 0u; st.bit = 31; st.done = false; st.need = 0u; st.crej = 0;
    const unsigned E = mx >> 23;
    bool ok = false;
    if (E >= 320u) ok = topk_histE(k, st, E, TOPK, 0);
    if (!ok) {
        const int npos = (E >= 256u) ? count_ge(k, 0x80000000u, st.nb) : 0;
        if (npos < TOPK) {
            unsigned mn = 0u;
#pragma unroll
            for (int i = 0; i < 32; ++i) mn = max(mn, k[i] & ~(unsigned)((int)k[i] >> 31));
            mn = wave_max_dpp(mn);
            const unsigned En = mn >> 23;
            if (En >= 64u) ok = topk_histE(k, st, En, TOPK - npos, npos);
        }
    }
    if (ok && !st.done) topk_hist(k, st, st.crej);
}
__device__ __forceinline__ void topk_step(const unsigned (&k)[32], TopkState& st) {
    if (st.done) return;
    if (st.bit < 0) { int c = 0;
#pragma unroll
        for (int i = 0; i < 32; ++i) c += (k[i] > st.prefix) ? 1 : 0;
        c = wave_sum_dpp(c); st.need = (unsigned)(TOPK - c); st.done = true; return; }
    const unsigned cand = st.prefix | (1u << st.bit);
    const int c = count_ge(k, cand, st.nb);
    if (c >= TOPK) st.prefix = cand; else st.crej = c;
    if (c == TOPK) { st.done = true; st.need = 0xffffffffu; }
    --st.bit;
#ifndef NO_TOPK_HIST
    if (st.bit == 22 && !st.done && st.hist) topk_hist(k, st, st.crej);
#endif
}

__device__ __forceinline__ void dsa_prefetch_qi(const bf16* zb, int qt, LAS unsigned char* lds, int wave, int lane) {
    const unsigned lds_base = (unsigned)(uintptr_t)lds;
#pragma unroll
    for (int i = 0; i < 2; ++i) { const int row = 2 * wave + i;
        glds16(zb + (size_t)(qt * 16 + row) * ZP + C_QI + ((lane ^ row) * 8), (unsigned)__builtin_amdgcn_readfirstlane(lds_base + DSA_QIB_OFF + row * 1024)); }
    if (wave == 0) glds16(zb + (size_t)(qt * 16 + (lane & 15)) * ZP + C_WI, (unsigned)__builtin_amdgcn_readfirstlane(lds_base + DSA_WIB_OFF));
}

__device__ __forceinline__ void dsa_prefetch_ki(const bf16* zb, int qt, bf16x8v (&pk)[4], int wave, int lane) {
    const int r16 = lane & 15, g = lane >> 4;
    if (wave <= qt) { const bf16* krow = zb + (size_t)(wave * 16 + r16) * ZP + C_KI; pk[0] = *(const bf16x8v*)(krow + 8 * g); pk[1] = *(const bf16x8v*)(krow + 32 + 8 * g); }
    if (wave + 8 <= qt) { const bf16* krow = zb + (size_t)((wave + 8) * 16 + r16) * ZP + C_KI; pk[2] = *(const bf16x8v*)(krow + 8 * g); pk[3] = *(const bf16x8v*)(krow + 32 + 8 * g); }
}

#ifdef DSA_DYNQ
constexpr int DSA_NEXT_OFF = 143360 + 32;
constexpr int CW_QUEUE = 24576;
__device__ __forceinline__ void dsa_unit(const P& p, int b, int qt, int& qt_next, unsigned* queue, bf16x8v (&pk)[4], LAS unsigned char* lds) {
    unsigned nraw_ = 0u;
    if (threadIdx.x == 0) nraw_ = __hip_atomic_fetch_add(queue, 1u, __ATOMIC_RELAXED, __HIP_MEMORY_SCOPE_AGENT);
#else
__device__ __forceinline__ void dsa_unit(const P& p, int b, int qt, int qt_next, bf16x8v (&pk)[4], LAS unsigned char* lds) {
#endif
    const int tid = threadIdx.x, lane = tid & 63, wave = __builtin_amdgcn_readfirstlane(tid >> 6), r16 = lane & 15, g = lane >> 4;
    const int q0 = qt * 16; const bf16* zb = p.Z + (size_t)b * SEQ * ZP;
    LAS float* SC = (LAS float*)lds; LAS unsigned* BM = (LAS unsigned*)(lds + DSA_BM_OFF);
    const bool dense_all = (qt < TOPK / 16);
    const bf16* qrow = zb + (size_t)(q0 + r16) * ZP;
    const bf16x8v bq0 = *(const bf16x8v*)(qrow + C_Q + wave * 64 + 8 * g), bq1 = *(const bf16x8v*)(qrow + C_Q + wave * 64 + 32 + 8 * g);
    u32x2 gwv[4];
#pragma unroll
    for (int dt = 0; dt < 4; ++dt) gwv[dt] = *(const u32x2*)(qrow + C_GA + wave * 64 + dt * 16 + 4 * g);
    const int nsteps = (((q0 + 16 + 31) >> 5) + 1) & ~1, nmega = (nsteps + 7) >> 3;
    const int kkey = lane >> 3, vkey = lane >> 1, vhalf = lane & 1;
    const unsigned lds_base = (unsigned)(uintptr_t)lds;
#define DSA_STAGE(mm) do { const int st_ = (mm) * 8 + wave; if (st_ < nsteps) { \
        const bf16* kb_ = zb + (size_t)st_ * 32 * ZP; const unsigned ldsb_ = lds_base + (unsigned)(((mm) & 1) * 65536 + wave * 4096); \
        _Pragma("unroll") for (int c_ = 0; c_ < 4; ++c_) { const int key_ = 8 * c_ + kkey, ch_ = (lane & 7) ^ ((key_ & 15) >> 1); \
            glds16(kb_ + (size_t)key_ * ZP + C_K + ch_ * 8, (unsigned)__builtin_amdgcn_readfirstlane(ldsb_ + c_ * 1024)); } \
        _Pragma("unroll") for (int c_ = 0; c_ < 4; ++c_) \
            glds16(kb_ + (size_t)vkey * ZP + C_V + c_ * 16 + vhalf * 8, (unsigned)__builtin_amdgcn_readfirstlane(ldsb_ + 32768 + c_ * 1024)); } } while (0)
    if (!dense_all) {
        for (int rpI = 0; rpI < RP_I; ++rpI) {
        bf16x8v bq[8][2]; float wv[8];
#pragma unroll
        for (int h = 0; h < 8; ++h) { bq[h][0] = *(LAS const bf16x8v*)(lds + DSA_QIB_OFF + r16 * 1024 + (((8 * h + g) ^ r16) * 16)); bq[h][1] = *(LAS const bf16x8v*)(lds + DSA_QIB_OFF + r16 * 1024 + (((8 * h + 4 + g) ^ r16) * 16));
            wv[h] = bf2f(*(LAS const bf16*)(lds + DSA_WIB_OFF + r16 * 16 + h * 2)) * 0.35355339059327373f * 0.125f; }
        bf16x8v ra0 = pk[0], ra1 = pk[1], rb0 = pk[2], rb1 = pk[3], rc0 = pk[0], rc1 = pk[1];
#if defined(PROBE_IDX_MFMA)
        f32x4 dacc = {0.f, 0.f, 0.f, 0.f};
#define PROBE_XMFMA(c0, c1, h) dacc = __builtin_amdgcn_mfma_f32_16x16x32_bf16(c0, bq[h][0], dacc, 0, 0, 0); dacc = __builtin_amdgcn_mfma_f32_16x16x32_bf16(c1, bq[h][1], dacc, 0, 0, 0);
#else
#define PROBE_XMFMA(c0, c1, h)
#endif
#if defined(PROBE_IDX_VALU)
        unsigned dv0 = 1u, dv1 = 2u, dv2 = 3u, dv3 = 4u;
#define PROBE_XVALU() asm volatile("v_add_u32_e32 %0, 1, %0\n\tv_add_u32_e32 %1, 1, %1\n\tv_add_u32_e32 %2, 1, %2\n\tv_add_u32_e32 %3, 1, %3\n\tv_add_u32_e32 %0, 1, %0\n\tv_add_u32_e32 %1, 1, %1\n\tv_add_u32_e32 %2, 1, %2\n\tv_add_u32_e32 %3, 1, %3" : "+v"(dv0), "+v"(dv1), "+v"(dv2), "+v"(dv3));
#else
#define PROBE_XVALU()
#endif
#ifdef IDX_SADDR
        const unsigned kioff_ = (unsigned)((r16 * ZP + C_KI + 8 * g) * 2);
#define IDX_LOAD(d0, d1, ktl) do { const int ktl_ = (ktl) <= qt ? (ktl) : qt;        \
            const unsigned off_ = kioff_ + (unsigned)ktl_ * (unsigned)(16 * ZP * 2); d0 = *(const bf16x8v*)((const char*)zb + off_); d1 = *(const bf16x8v*)((const char*)zb + off_ + 64u); } while (0)
#else
#define IDX_LOAD(d0, d1, ktl) do { const int ktl_ = (ktl) <= qt ? (ktl) : qt;        \
            const bf16* krow_ = zb + (size_t)(ktl_ * 16 + r16) * ZP + C_KI; d0 = *(const bf16x8v*)(krow_ + 8 * g); d1 = *(const bf16x8v*)(krow_ + 32 + 8 * g); } while (0)
#endif
#define IDX_STEP(c0, c1) do { \
            f32x4 sc = {0.f, 0.f, 0.f, 0.f}; \
            _Pragma("unroll") for (int h = 0; h < 8; ++h) { \
                f32x4 acc = {0.f, 0.f, 0.f, 0.f}; \
                acc = __builtin_amdgcn_mfma_f32_16x16x32_bf16(c0, bq[h][0], acc, 0, 0, 0); \
                acc = __builtin_amdgcn_mfma_f32_16x16x32_bf16(c1, bq[h][1], acc, 0, 0, 0); \
                PROBE_XMFMA(c0, c1, h) \
                _Pragma("unroll") for (int i = 0; i < 4; ++i) sc[i] = fmac_s(relu_i(acc[i]), wv[h], sc[i]); \
                PROBE_XVALU() \
            } \
            if (__builtin_amdgcn_readfirstlane(kt) == qt) {                  \
                IDX_DIAG_BR; \
                _Pragma("unroll") for (int i = 0; i < 4; ++i) sc[i] = (4 * g + i > r16) ? -INFINITY : sc[i]; \
            } \
            *(LAS f32x4*)(SC + r16 * SCP + kt * 16 + 4 * g) = sc; } while (0)
        int kt = wave;
        const int nst = (qt - wave + 8) >> 3;
#ifdef IDX_PAIR
#define IDX_PAIR_STEP(c0, c1, e0, e1) do { \
            f32x4 sc = {0.f, 0.f, 0.f, 0.f}, sd = {0.f, 0.f, 0.f, 0.f}; \
            _Pragma("unroll") for (int h = 0; h < 8; ++h) { \
                f32x4 acc = {0.f, 0.f, 0.f, 0.f}, acd = {0.f, 0.f, 0.f, 0.f}; \
                acc = __builtin_amdgcn_mfma_f32_16x16x32_bf16(c0, bq[h][0], acc, 0, 0, 0); acd = __builtin_amdgcn_mfma_f32_16x16x32_bf16(e0, bq[h][0], acd, 0, 0, 0); \
                acc = __builtin_amdgcn_mfma_f32_16x16x32_bf16(c1, bq[h][1], acc, 0, 0, 0); acd = __builtin_amdgcn_mfma_f32_16x16x32_bf16(e1, bq[h][1], acd, 0, 0, 0); \
                _Pragma("unroll") for (int i = 0; i < 4; ++i) { sc[i] = fmac_s(relu_i(acc[i]), wv[h], sc[i]); sd[i] = fmac_s(relu_i(acd[i]), wv[h], sd[i]); } \
            } \
            if (__builtin_amdgcn_readfirstlane(kt) + 8 >= qt) {               \
                _Pragma("unroll") for (int i = 0; i < 4; ++i) { sc[i] = (kt == qt && 4 * g + i > r16) ? -INFINITY : sc[i]; sd[i] = (kt + 8 == qt && 4 * g + i > r16) ? -INFINITY : sd[i]; } \
            } \
            *(LAS f32x4*)(SC + r16 * SCP + kt * 16 + 4 * g) = sc; *(LAS f32x4*)(SC + r16 * SCP + (kt + 8) * 16 + 4 * g) = sd; } while (0)
        bf16x8v rd0 = pk[0], rd1 = pk[1];
        IDX_LOAD(rc0, rc1, kt + 16); IDX_LOAD(rd0, rd1, kt + 24);
        const int ntrip = nst >> 2, rem = nst & 3;
#pragma unroll 1
        for (int it = ntrip; it > 0; --it) {
            IDX_PAIR_STEP(ra0, ra1, rb0, rb1); __builtin_amdgcn_sched_barrier(0); IDX_LOAD(ra0, ra1, kt + 32); IDX_LOAD(rb0, rb1, kt + 40); __builtin_amdgcn_sched_barrier(0); kt += 16;
            IDX_PAIR_STEP(rc0, rc1, rd0, rd1); __builtin_amdgcn_sched_barrier(0); IDX_LOAD(rc0, rc1, kt + 32); IDX_LOAD(rd0, rd1, kt + 40); __builtin_amdgcn_sched_barrier(0); kt += 16;
        }
        if (rem >= 2) { IDX_PAIR_STEP(ra0, ra1, rb0, rb1); kt += 16; if (rem == 3) { IDX_STEP(rc0, rc1); } }
        else if (rem == 1) { IDX_STEP(ra0, ra1); }
#undef IDX_PAIR_STEP
#else
        const int ntrip = (nst * 11) >> 5, rem = nst - 3 * ntrip;
#pragma unroll 1
        for (int it = ntrip; it > 0; --it) {
            IDX_LOAD(rc0, rc1, kt + 16); __builtin_amdgcn_sched_barrier(0); IDX_STEP(ra0, ra1); __builtin_amdgcn_sched_barrier(0); kt += 8;
            IDX_LOAD(ra0, ra1, kt + 16); __builtin_amdgcn_sched_barrier(0); IDX_STEP(rb0, rb1); __builtin_amdgcn_sched_barrier(0); kt += 8;
            IDX_LOAD(rb0, rb1, kt + 16); __builtin_amdgcn_sched_barrier(0); IDX_STEP(rc0, rc1); __builtin_amdgcn_sched_barrier(0); kt += 8;
        }
        if (rem >= 1) { IDX_STEP(ra0, ra1); kt += 8; if (rem >= 2) { IDX_STEP(rb0, rb1); } }
#endif
#if defined(PROBE_IDX_MFMA)
        asm volatile("s_nop 7\n\ts_nop 7" :: "v"(dacc));
#endif
#undef IDX_LOAD
#undef IDX_STEP
        __syncthreads();
        }
#pragma unroll 1
        for (int rpT = 0; rpT < RP_T; ++rpT) {
            const int ra = 2 * wave, rb = 2 * wave + 1, ta = q0 + ra, tb = q0 + rb;
            unsigned ka[32], kb[32];
#ifdef KLG
#pragma unroll
            for (int i0 = 0; i0 < 32; i0 += KLG) {
                float fa[KLG], fb[KLG];
#pragma unroll
                for (int j = 0; j < KLG; ++j) { fa[j] = SC[ra * SCP + lane + 64 * (i0 + j)]; fb[j] = SC[rb * SCP + lane + 64 * (i0 + j)]; }
#pragma unroll
                for (int j = 0; j < KLG; ++j) { const int key = lane + 64 * (i0 + j); ka[i0 + j] = (key <= ta) ? score_ukey(fa[j]) : 0u; kb[i0 + j] = (key <= tb) ? score_ukey(fb[j]) : 0u; }
            }
#else
#pragma unroll
            for (int i = 0; i < 32; ++i) { const int key = lane + 64 * i; ka[i] = (key <= ta) ? score_ukey(SC[ra * SCP + key]) : 0u; kb[i] = (key <= tb) ? score_ukey(SC[rb * SCP + key]) : 0u; }
#endif
#if RP_T1 > 1
            asm volatile("" :: "v"(ka[0]), "v"(kb[31]) : "memory");
#pragma unroll
            for (int i = 0; i < 32; ++i) { const int key = lane + 64 * i; ka[i] = (key <= ta) ? score_ukey(SC[ra * SCP + key]) : 0u; kb[i] = (key <= tb) ? score_ukey(SC[rb * SCP + key]) : 0u; }
            asm volatile("" ::: "memory");
#endif
            asm volatile("s_waitcnt lgkmcnt(0)" ::: "memory");
            __syncthreads();
            DSA_STAGE(0);
            TopkState sa, sb; sa.nb = (ta >> 9) + 1; sb.nb = (tb >> 9) + 1;
            sa.hist = (wave < HIST_WAVES) ? (LAS unsigned*)(lds + 65536 + ra * 4096) : (LAS unsigned*)nullptr; sb.hist = (wave < HIST_WAVES) ? (LAS unsigned*)(lds + 65536 + rb * 4096) : (LAS unsigned*)nullptr;
            topk_init(ka, sa); topk_init(kb, sb);
#pragma unroll 1
            while (!(sa.done && sb.done)) { topk_step(ka, sa); topk_step(kb, sb); }
#if RP_T2 > 1
            asm volatile("" :: "v"(sa.prefix), "v"(sb.prefix));
            topk_init(ka, sa); topk_init(kb, sb);
#pragma unroll 1
            while (!(sa.done && sb.done)) { topk_step(ka, sa); topk_step(kb, sb); }
#endif
            if (sa.need == 0xffffffffu && sb.need == 0xffffffffu) {
                const unsigned ta_ = (unsigned)__builtin_amdgcn_readfirstlane((int)sa.prefix), tb_ = (unsigned)__builtin_amdgcn_readfirstlane((int)sb.prefix);
                int wa = 0, wb = 0;
#define WR2(i) { const unsigned long long ma = __ballot(ka[i] >= ta_), mb = __ballot(kb[i] >= tb_); wr2lanes<2 * (i)>(wa, (unsigned)ma, (unsigned)(ma >> 32)); wr2lanes<2 * (i)>(wb, (unsigned)mb, (unsigned)(mb >> 32)); }
                WR2(0) WR2(1) WR2(2) WR2(3) WR2(4) WR2(5) WR2(6) WR2(7) WR2(8) WR2(9) WR2(10) WR2(11) WR2(12) WR2(13) WR2(14) WR2(15)
                WR2(16) WR2(17) WR2(18) WR2(19) WR2(20) WR2(21) WR2(22) WR2(23) WR2(24) WR2(25) WR2(26) WR2(27) WR2(28) WR2(29) WR2(30) WR2(31)
#undef WR2
                BM[ra * BMS + lane] = (unsigned)wa; BM[rb * BMS + lane] = (unsigned)wb;
#if RP_T3 > 1
                asm volatile("" : "+v"(wa), "+v"(wb) :: "memory");
#define WR2(i) { const unsigned long long ma = __ballot(ka[i] >= ta_), mb = __ballot(kb[i] >= tb_); wr2lanes<2 * (i)>(wa, (unsigned)ma, (unsigned)(ma >> 32)); wr2lanes<2 * (i)>(wb, (unsigned)mb, (unsigned)(mb >> 32)); }
                WR2(0) WR2(1) WR2(2) WR2(3) WR2(4) WR2(5) WR2(6) WR2(7) WR2(8) WR2(9) WR2(10) WR2(11) WR2(12) WR2(13) WR2(14) WR2(15)
                WR2(16) WR2(17) WR2(18) WR2(19) WR2(20) WR2(21) WR2(22) WR2(23) WR2(24) WR2(25) WR2(26) WR2(27) WR2(28) WR2(29) WR2(30) WR2(31)
#undef WR2
                BM[ra * BMS + lane] = (unsigned)wa; BM[rb * BMS + lane] = (unsigned)wb;
#endif
            } else {
            unsigned eqa = 0u, eqb = 0u;
#pragma unroll 1
            for (int i = 0; i < 32; ++i) {
                unsigned kai = ka[0], kbi = kb[0];
#pragma unroll
                for (int j = 1; j < 32; ++j) { kai = (i == j) ? ka[j] : kai; kbi = (i == j) ? kb[j] : kbi; }
                { const bool eq = (kai == sa.prefix); const unsigned long long em = __ballot(eq);
                  const unsigned erank = eqa + __builtin_amdgcn_mbcnt_hi((unsigned)(em >> 32), __builtin_amdgcn_mbcnt_lo((unsigned)em, 0u));
                  const unsigned long long smk = __ballot((kai > sa.prefix) || (eq && erank < sa.need));
                  if (lane == 0) { BM[ra * BMS + 2 * i] = (unsigned)smk; BM[ra * BMS + 2 * i + 1] = (unsigned)(smk >> 32); }
                  eqa += (unsigned)__popcll(em); }
                { const bool eq = (kbi == sb.prefix); const unsigned long long em = __ballot(eq);
                  const unsigned erank = eqb + __builtin_amdgcn_mbcnt_hi((unsigned)(em >> 32), __builtin_amdgcn_mbcnt_lo((unsigned)em, 0u));
                  const unsigned long long smk = __ballot((kbi > sb.prefix) || (eq && erank < sb.need));
                  if (lane == 0) { BM[rb * BMS + 2 * i] = (unsigned)smk; BM[rb * BMS + 2 * i + 1] = (unsigned)(smk >> 32); }
                  eqb += (unsigned)__popcll(em); }
            }
            }
        }
    } else {
        for (int i = tid; i < 1024; i += 512) { const int row = i >> 6, w = i & 63, t = q0 + row, lo = 32 * w;
            BM[row * BMS + w] = (t >= lo + 31) ? 0xffffffffu : ((t < lo) ? 0u : ((2u << (t - lo)) - 1u)); }
        DSA_STAGE(0);
    }
    __syncthreads();
    const int h = wave;
#pragma unroll 1
    for (int rpV = 0; rpV < RP_V; ++rpV) {
    asm volatile("s_waitcnt vmcnt(0)" ::: "memory");
#ifdef DSA_DYNQ
    if (threadIdx.x == 0) *(volatile LAS unsigned*)(lds + DSA_NEXT_OFF) = nraw_;
#endif
    asm volatile("" :: "v"(bq0), "v"(bq1), "v"(gwv[0]), "v"(gwv[1]), "v"(gwv[2]), "v"(gwv[3]));
    __syncthreads();
#ifdef DSA_DYNQ
    { const unsigned nidx_ = *(volatile LAS unsigned*)(lds + DSA_NEXT_OFF); qt_next = (nidx_ <= 95u) ? 95 - (int)nidx_ : -1; qt_next = __builtin_amdgcn_readfirstlane(qt_next); }
#endif
    if (qt_next >= TOPK / 16) { dsa_prefetch_qi(zb, qt_next, lds, wave, lane); dsa_prefetch_ki(zb, qt_next, pk, wave, lane); }
    f32x4 o[4], lacc = {0.f, 0.f, 0.f, 0.f}, negm = {0.f, 0.f, 0.f, 0.f};
#pragma unroll
    for (int dt = 0; dt < 4; ++dt) o[dt] = (f32x4){0.f, 0.f, 0.f, 0.f};
    float m_run = 0.f;
    const int kofs0 = r16 * 128 + ((g ^ (r16 >> 1)) & 7) * 16, kofs1 = r16 * 128 + (((4 + g) ^ (r16 >> 1)) & 7) * 16;
    const int vofs = 32768 + (4 * g + ((lane & 15) >> 2)) * 32 + (lane & 3) * 8;
    bf16x8v ones = {0x3f80, 0x3f80, 0x3f80, 0x3f80, 0x3f80, 0x3f80, 0x3f80, 0x3f80};
    asm volatile("" : "+v"(ones));
    LAS const unsigned char* mlut = lds + DSA_MLUT_OFF;
    constexpr float THR = 8.0f;
    bool first = true;
#pragma unroll 1
    for (int mm = 0; mm < nmega; ++mm) {
        if (mm + 1 < nmega) DSA_STAGE(mm + 1);
        LAS unsigned char* slotb = lds + (mm & 1) * 65536;
        const int nsub = (nsteps - mm * 8) < 8 ? (nsteps - mm * 8) : 8;
#pragma unroll 1
        for (int u = 0; u < nsub; u += 2) {
            LAS unsigned char* slot = slotb + u * 4096;
            const int mwA = (int)(BM[r16 * BMS + mm * 8 + u] >> (4 * g)), mwB = (int)(BM[r16 * BMS + mm * 8 + u + 1] >> (4 * g));
            f32x4 s0, s1, s2, s3;
            { const bf16x8v ka0 = *(LAS const bf16x8v*)(slot + kofs0), ka1 = *(LAS const bf16x8v*)(slot + kofs1);
              const bf16x8v kb0 = *(LAS const bf16x8v*)(slot + 2048 + kofs0), kb1 = *(LAS const bf16x8v*)(slot + 2048 + kofs1);
              const bf16x8v kc0 = *(LAS const bf16x8v*)(slot + 4096 + kofs0), kc1 = *(LAS const bf16x8v*)(slot + 4096 + kofs1);
              const bf16x8v kd0 = *(LAS const bf16x8v*)(slot + 6144 + kofs0), kd1 = *(LAS const bf16x8v*)(slot + 6144 + kofs1);
              ATT_PRIO(1);
              s0 = __builtin_amdgcn_mfma_f32_16x16x32_bf16(ka0, bq0, negm, 0, 0, 0); s1 = __builtin_amdgcn_mfma_f32_16x16x32_bf16(kb0, bq0, negm, 0, 0, 0);
              s2 = __builtin_amdgcn_mfma_f32_16x16x32_bf16(kc0, bq0, negm, 0, 0, 0); s3 = __builtin_amdgcn_mfma_f32_16x16x32_bf16(kd0, bq0, negm, 0, 0, 0);
              s0 = __builtin_amdgcn_mfma_f32_16x16x32_bf16(ka1, bq1, s0, 0, 0, 0); s1 = __builtin_amdgcn_mfma_f32_16x16x32_bf16(kb1, bq1, s1, 0, 0, 0);
              s2 = __builtin_amdgcn_mfma_f32_16x16x32_bf16(kc1, bq1, s2, 0, 0, 0); s3 = __builtin_amdgcn_mfma_f32_16x16x32_bf16(kd1, bq1, s3, 0, 0, 0); ATT_PRIO(0); }
            const int lmi = max(max(max(imax3(s0[0], s0[1], s0[2]), imax3(s0[3], s1[0], s1[1])), max(imax3(s1[2], s1[3], s2[0]), imax3(s2[1], s2[2], s2[3]))), max(imax3(s3[0], s3[1], s3[2]), __float_as_int(s3[3])));
            if (first || __any(lmi > 0x41000000)) {
                float lmx = fmaxf(fmaxf(fmaxf(fmaxf(s0[0], s0[1]), fmaxf(s0[2], s0[3])), fmaxf(fmaxf(s1[0], s1[1]), fmaxf(s1[2], s1[3]))), fmaxf(fmaxf(fmaxf(s2[0], s2[1]), fmaxf(s2[2], s2[3])), fmaxf(fmaxf(s3[0], s3[1]), fmaxf(s3[2], s3[3]))));
                { const auto r1 = __builtin_amdgcn_permlane16_swap(__float_as_uint(lmx), __float_as_uint(lmx), false, false); lmx = fmaxf(__uint_as_float(r1[0]), __uint_as_float(r1[1])); }
                { const auto r2 = __builtin_amdgcn_permlane32_swap(__float_as_uint(lmx), __float_as_uint(lmx), false, false); lmx = fmaxf(__uint_as_float(r2[0]), __uint_as_float(r2[1])); }
                const float dl = first ? lmx : fmaxf(lmx, 0.f);
                m_run += dl; const float f = first ? 1.0f : __builtin_amdgcn_exp2f(-dl);
#pragma unroll
                for (int i = 0; i < 4; ++i) { s0[i] -= dl; s1[i] -= dl; s2[i] -= dl; s3[i] -= dl; negm[i] = -m_run; }
                lacc = lacc * f;
#pragma unroll
                for (int dt = 0; dt < 4; ++dt) o[dt] = o[dt] * f;
                first = false;
            }
            const u32x2 mk0 = *(LAS const u32x2*)(mlut + ((mwA & 15) << 3)), mk1 = *(LAS const u32x2*)(mlut + (((mwA >> 16) & 15) << 3));
            const u32x2 mk2 = *(LAS const u32x2*)(mlut + ((mwB & 15) << 3)), mk3 = *(LAS const u32x2*)(mlut + (((mwB >> 16) & 15) << 3));
            u32x4 pwA, pwB;
            pwA.x = cvtpk(__builtin_amdgcn_exp2f(s0[0]), __builtin_amdgcn_exp2f(s0[1])) & mk0.x; pwA.y = cvtpk(__builtin_amdgcn_exp2f(s0[2]), __builtin_amdgcn_exp2f(s0[3])) & mk0.y;
            pwA.z = cvtpk(__builtin_amdgcn_exp2f(s1[0]), __builtin_amdgcn_exp2f(s1[1])) & mk1.x; pwA.w = cvtpk(__builtin_amdgcn_exp2f(s1[2]), __builtin_amdgcn_exp2f(s1[3])) & mk1.y;
            pwB.x = cvtpk(__builtin_amdgcn_exp2f(s2[0]), __builtin_amdgcn_exp2f(s2[1])) & mk2.x; pwB.y = cvtpk(__builtin_amdgcn_exp2f(s2[2]), __builtin_amdgcn_exp2f(s2[3])) & mk2.y;
            pwB.z = cvtpk(__builtin_amdgcn_exp2f(s3[0]), __builtin_amdgcn_exp2f(s3[1])) & mk3.x; pwB.w = cvtpk(__builtin_amdgcn_exp2f(s3[2]), __builtin_amdgcn_exp2f(s3[3])) & mk3.y;
            const bf16x8v pfA = __builtin_bit_cast(bf16x8v, pwA), pfB = __builtin_bit_cast(bf16x8v, pwB);
            ATT_PRIO(1);
            lacc = __builtin_amdgcn_mfma_f32_16x16x32_bf16(ones, pfA, lacc, 0, 0, 0);
            lacc = __builtin_amdgcn_mfma_f32_16x16x32_bf16(ones, pfB, lacc, 0, 0, 0);
#pragma unroll
            for (int dt = 0; dt < 4; ++dt) {
                const s16x4v lo = lds_tr16(slot + vofs + dt * 1024), hi = lds_tr16(slot + vofs + dt * 1024 + 512);
                const s16x4v lo2 = lds_tr16(slot + 4096 + vofs + dt * 1024), hi2 = lds_tr16(slot + 4096 + vofs + dt * 1024 + 512);
                const bf16x8v vf = {lo[0], lo[1], lo[2], lo[3], hi[0], hi[1], hi[2], hi[3]};
                const bf16x8v vf2 = {lo2[0], lo2[1], lo2[2], lo2[3], hi2[0], hi2[1], hi2[2], hi2[3]};
                o[dt] = __builtin_amdgcn_mfma_f32_16x16x32_bf16(vf, pfA, o[dt], 0, 0, 0);
                o[dt] = __builtin_amdgcn_mfma_f32_16x16x32_bf16(vf2, pfB, o[dt], 0, 0, 0);
            }
            ATT_PRIO(0);
        }
        asm volatile("s_waitcnt vmcnt(0) lgkmcnt(0)" ::: "memory");
        __syncthreads();
    }
#undef DSA_STAGE
    const float inv = 1.0f / lacc[0];
    bf16* yrow = p.Y + ((size_t)b * SEQ + q0 + r16) * DM + 512 + h * 64;
#pragma unroll
    for (int dt = 0; dt < 4; ++dt) {
        const u32x2 gw = gwv[dt];
        const float g0 = __uint_as_float(gw.x << 16), g1 = __uint_as_float(gw.x & 0xffff0000u), g2 = __uint_as_float(gw.y << 16), g3 = __uint_as_float(gw.y & 0xffff0000u);
        u32x2 w; w.x = pk2(o[dt][0] * inv * siluf(g0), o[dt][1] * inv * siluf(g1)); w.y = pk2(o[dt][2] * inv * siluf(g2), o[dt][3] * inv * siluf(g3));
        *(u32x2*)(yrow + dt * 16 + 4 * g) = w;
    }
    __syncthreads();
    }
}
#ifdef QT_TABLE
__device__ const unsigned char DSA_QT_TAB[32][4] = { {127, 66, 63, 2}, {126, 67, 62, 3}, {125, 68, 61, 4}, {124, 74, 60, 0}, {123, 69, 58, 8}, {122, 70, 57, 9}, {121, 71, 55, 11}, {120, 76, 56, 7}, {119, 65, 59, 15}, {118, 73, 54, 14}, {117, 83, 53, 6}, {116, 91, 51, 1}, {115, 82, 52, 10}, {114, 85, 48, 12}, {113, 84, 49, 13}, {112, 72, 46, 19}, {111, 75, 47, 16}, {110, 94, 50, 5}, {109, 78, 45, 17}, {108, 77, 44, 20}, {107, 79, 43, 21}, {106, 64, 42, 37}, {105, 81, 41, 23}, {104, 87, 40, 18}, {103, 86, 36, 24}, {102, 88, 38, 22}, {101, 80, 39, 30}, {100, 92, 32, 26}, {99, 90, 35, 25}, {98, 89, 34, 29}, {97, 93, 33, 27}, {96, 95, 31, 28} };
__device__ __forceinline__ int dsa_qt_of(int j, int i) { return (int)DSA_QT_TAB[j][i]; }
#else
__device__ __forceinline__ int dsa_qt_of(int j, int i) { return (i == 0) ? 127 - j : (i == 1) ? 64 + j : (i == 2) ? 63 - j : j; }
#endif
__device__ __forceinline__ void dsa_phase_pre(const P& p, LAS unsigned char* lds, bf16x8v (&pk)[4]) {
    const int G = gridDim.x, wg = blockIdx.x, lane = threadIdx.x & 63, wave = __builtin_amdgcn_readfirstlane(threadIdx.x >> 6);
    const int b = (G == 256) ? (wg & 7) : (wg >> 7), qt = (G == 256) ? dsa_qt_of(wg >> 3, 0) : 127 - (wg & 127);
#pragma unroll
    for (int i = 0; i < 4; ++i) pk[i] = (bf16x8v){0, 0, 0, 0, 0, 0, 0, 0};
    if (wg < 1024 && qt >= TOPK / 16) { dsa_prefetch_qi(p.Z + (size_t)b * SEQ * ZP, qt, lds, wave, lane); dsa_prefetch_ki(p.Z + (size_t)b * SEQ * ZP, qt, pk, wave, lane); }
}
__device__ __forceinline__ void dsa_phase(const P& p, LAS unsigned char* lds, bf16x8v (&pk)[4], int l) {
    const int G = gridDim.x, wg = blockIdx.x;
    if (G == 256) {
        const int b = wg & 7, j = wg >> 3;
#ifdef DSA_DYNQ
        unsigned* queue = p.ctl + CW_QUEUE + (l * 8 + b) * 64;
        int qt = 127 - j;
#pragma unroll 1
        while (qt >= 0) { int qn = -1; dsa_unit(p, b, qt, qn, queue, pk, lds); qt = qn; }
#else
#pragma unroll 1
        for (int i = 0; i < 4; ++i) dsa_unit(p, b, dsa_qt_of(j, i), (i < 3) ? dsa_qt_of(j, i + 1) : -1, pk, lds);
#endif
    }
}
constexpr int LRU_WS_OFF = 139264;
constexpr int LRU_XB = 264 * 128;
constexpr int LRU_GB = 256 * 32;
constexpr int LRU_BUF = LRU_XB + LRU_GB;
__device__ __forceinline__ float fast_sigm(float x) { return __builtin_amdgcn_rcpf(1.0f + __expf(-x)); }
__device__ __forceinline__ void lru_unit(const P& p, int l, int b, int blk, int q4, LAS unsigned char* lds) {
    const int tid = threadIdx.x, lane = tid & 63, wave = __builtin_amdgcn_readfirstlane(tid >> 6), r16 = lane & 15, g = lane >> 4;
    const bf16* zb = p.Z + (size_t)b * SEQ * ZP;
    const int cA = blk * 64, dloc = q4 * 16 + r16, dg = blk * 64 + dloc;
    const unsigned lds_base = (unsigned)(uintptr_t)lds;
#define LRU_STAGE(r) do { const unsigned bb_ = lds_base + (unsigned)(((r) & 1) * LRU_BUF); \
        _Pragma("unroll") for (int i_ = 0; i_ < 5; ++i_) { const int pc_ = wave + 8 * i_; if (pc_ < 33) { const int rho_ = pc_ * 8 + (lane >> 3); int t_ = (r) * 256 - 3 + rho_; t_ = t_ < 0 ? 0 : (t_ > SEQ - 1 ? SEQ - 1 : t_); \
            const int ch_ = (lane & 7) ^ ((rho_ >> 1) & 7); glds16(zb + (size_t)t_ * ZP + C_XR + cA + ch_ * 8, (unsigned)__builtin_amdgcn_readfirstlane(bb_ + pc_ * 1024)); } } \
        { const int row_ = wave * 32 + (lane >> 1); glds16(zb + (size_t)((r) * 256 + row_) * ZP + C_GR + dg - r16 + (lane & 1) * 8, (unsigned)__builtin_amdgcn_readfirstlane(bb_ + LRU_XB + wave * 1024)); } } while (0)
    LRU_STAGE(0);
    float cwA[2][4][8], cbA[2][8];
#pragma unroll
    for (int s = 0; s < 2; ++s)
#pragma unroll
        for (int j = 0; j < 8; ++j) { const int c = cA + 32 * s + 8 * g + j; cbA[s][j] = p.conv_b[l * 512 + c];
#pragma unroll
            for (int k = 0; k < 4; ++k) cwA[s][k][j] = p.conv_w[(l * 4 + k) * 512 + c]; }
    bf16x8v bxf[2], baf[2];
#pragma unroll
    for (int s = 0; s < 2; ++s) { u32x4 wx, wa; unsigned tx[8], ta[8];
#pragma unroll
        for (int j = 0; j < 8; ++j) { const size_t idx = (((size_t)l * 8 + blk) * 64 + 32 * s + 8 * g + j) * 64 + dloc; tx[j] = f2bf(p.lru_wx[idx]); ta[j] = f2bf(p.lru_wa[idx]); }
        wx.x = tx[0] | (tx[1] << 16); wx.y = tx[2] | (tx[3] << 16); wx.z = tx[4] | (tx[5] << 16); wx.w = tx[6] | (tx[7] << 16);
        wa.x = ta[0] | (ta[1] << 16); wa.y = ta[2] | (ta[3] << 16); wa.z = ta[4] | (ta[5] << 16); wa.w = ta[6] | (ta[7] << 16);
        bxf[s] = __builtin_bit_cast(bf16x8v, wx); baf[s] = __builtin_bit_cast(bf16x8v, wa); }
    const float cw0 = p.conv_w[(l * 4 + 0) * 512 + dg], cw1 = p.conv_w[(l * 4 + 1) * 512 + dg], cw2 = p.conv_w[(l * 4 + 2) * 512 + dg], cw3 = p.conv_w[(l * 4 + 3) * 512 + dg];
    const float cb = p.conv_b[l * 512 + dg], bxv = p.lru_bx[l * 512 + dg], bav = p.lru_ba[l * 512 + dg];
    const float sp8 = -8.0f * log1pf(expf(-p.lru_a[l * 512 + dg]));
    asm volatile("" :: "v"(cwA[0][0][0]), "v"(cwA[1][3][7]), "v"(cbA[1][7]), "v"(bxf[0]), "v"(bxf[1]), "v"(baf[0]), "v"(baf[1]), "v"(cw0), "v"(cw1), "v"(cw2), "v"(cw3), "v"(cb), "v"(bxv), "v"(bav), "v"(sp8));
    LAS float* WS = (LAS float*)(lds + LRU_WS_OFF);
    float hrun = 0.f;
    asm volatile("s_waitcnt vmcnt(0)" ::: "memory");
#pragma unroll 1
    for (int round = 0; round < 8; ++round) {
        asm volatile("s_waitcnt vmcnt(8)" ::: "memory");
        __syncthreads();
        if (round + 1 < 8) LRU_STAGE(round + 1);
        LAS const unsigned char* xb = lds + (round & 1) * LRU_BUF; LAS const unsigned char* gb = xb + LRU_XB;
        const int tw = round * 256 + wave * 32;
        float hl[2][4], pl[2][4], gr4[2][4], PT[2], HT[2], PE[2], HE[2];
#pragma unroll
        for (int tau = 0; tau < 2; ++tau) {
            const int t0 = tw + 16 * tau, rho0 = wave * 32 + 16 * tau;
            bf16x8v af[2];
#pragma unroll
            for (int s = 0; s < 2; ++s) {
                float xc[8];
#pragma unroll
                for (int j = 0; j < 8; ++j) xc[j] = cbA[s][j];
#pragma unroll
                for (int k = 0; k < 4; ++k) { const int rho = rho0 + r16 + k; u32x4 w = *(LAS const u32x4*)(xb + rho * 128 + (((4 * s + g) ^ (rho >> 1)) & 7) * 16);
                    if (t0 + r16 - 3 + k < 0) w = (u32x4){0u, 0u, 0u, 0u};
                    xc[0] += cwA[s][k][0] * __uint_as_float(w.x << 16); xc[1] += cwA[s][k][1] * __uint_as_float(w.x & 0xffff0000u);
                    xc[2] += cwA[s][k][2] * __uint_as_float(w.y << 16); xc[3] += cwA[s][k][3] * __uint_as_float(w.y & 0xffff0000u);
                    xc[4] += cwA[s][k][4] * __uint_as_float(w.z << 16); xc[5] += cwA[s][k][5] * __uint_as_float(w.z & 0xffff0000u);
                    xc[6] += cwA[s][k][6] * __uint_as_float(w.w << 16); xc[7] += cwA[s][k][7] * __uint_as_float(w.w & 0xffff0000u); }
                u32x4 pw; pw.x = cvtpk(xc[0], xc[1]); pw.y = cvtpk(xc[2], xc[3]); pw.z = cvtpk(xc[4], xc[5]); pw.w = cvtpk(xc[6], xc[7]);
                af[s] = __builtin_bit_cast(bf16x8v, pw);
            }
            f32x4 gx = {0.f, 0.f, 0.f, 0.f}, ga = {0.f, 0.f, 0.f, 0.f};
            gx = __builtin_amdgcn_mfma_f32_16x16x32_bf16(af[0], bxf[0], gx, 0, 0, 0); gx = __builtin_amdgcn_mfma_f32_16x16x32_bf16(af[1], bxf[1], gx, 0, 0, 0);
            ga = __builtin_amdgcn_mfma_f32_16x16x32_bf16(af[0], baf[0], ga, 0, 0, 0); ga = __builtin_amdgcn_mfma_f32_16x16x32_bf16(af[1], baf[1], ga, 0, 0, 0);
            float xo[7];
#pragma unroll
            for (int m = 0; m < 7; ++m) { const int rho = rho0 + 4 * g + m;
                const unsigned short v = *(LAS const unsigned short*)(xb + rho * 128 + (((dloc >> 3) ^ (rho >> 1)) & 7) * 16 + (dloc & 7) * 2);
                xo[m] = (t0 + 4 * g - 3 + m >= 0) ? bf2f(v) : 0.f; }
            float Pr = 1.f, Hr = 0.f;
#pragma unroll
            for (int i = 0; i < 4; ++i) {
                const float xcv = cb + cw0 * xo[i] + cw1 * xo[i + 1] + cw2 * xo[i + 2] + cw3 * xo[i + 3];
                const float sx = fast_sigm(gx[i] + bxv), sa = fast_sigm(ga[i] + bav);
                const float la = sp8 * sa, a = __expf(la), y2 = 2.0f * la;
#ifdef LRU_EM_SERIES
                const float ser = -y2 * (1.0f + y2 * (0.5f + y2 * (0.16666667f + y2 * (0.041666668f + y2 * (0.0083333338f + y2 * 0.0013888889f)))));
                const float em = (y2 > -0.25f) ? ser : (1.0f - __expf(y2));
#else
                const float em = 1.0f - a * a;
#endif
                const float u = __builtin_amdgcn_sqrtf(em) * sx * xcv;
                Hr = a * Hr + u; Pr *= a; hl[tau][i] = Hr; pl[tau][i] = Pr;
                gr4[tau][i] = bf2f(*(LAS const unsigned short*)(gb + (rho0 + 4 * g + i) * 32 + r16 * 2));
            }
            float Pi = Pr, Hi = Hr;
            { const float Pl = __shfl_up(Pi, 16), Hl = __shfl_up(Hi, 16); if (g >= 1) { Hi = Pi * Hl + Hi; Pi = Pl * Pi; } }
            { const float Pl = __shfl_up(Pi, 32), Hl = __shfl_up(Hi, 32); if (g >= 2) { Hi = Pi * Hl + Hi; Pi = Pl * Pi; } }
            float Pe = __shfl_up(Pi, 16), He = __shfl_up(Hi, 16); if (g == 0) { Pe = 1.f; He = 0.f; }
            PT[tau] = __shfl(Pi, 48 + r16); HT[tau] = __shfl(Hi, 48 + r16); PE[tau] = Pe; HE[tau] = He;
        }
#ifdef PROBE_LRU_VALU
        { unsigned d0 = 1u, d1 = 2u, d2 = 3u, d3 = 4u;
#pragma unroll
          for (int q = 0; q < 16; ++q) asm volatile("v_add_u32_e32 %0, 1, %0\n\tv_add_u32_e32 %1, 1, %1\n\tv_add_u32_e32 %2, 1, %2\n\tv_add_u32_e32 %3, 1, %3" : "+v"(d0), "+v"(d1), "+v"(d2), "+v"(d3)); }
#endif
        HE[1] = PE[1] * HT[0] + HE[1]; PE[1] = PT[0] * PE[1];
        const float Pw = PT[0] * PT[1], Hw = PT[1] * HT[0] + HT[1];
        LAS float* wsr = WS + (round & 1) * 256;
        if (g == 0) { wsr[(wave * 16 + r16) * 2 + 0] = Pw; wsr[(wave * 16 + r16) * 2 + 1] = Hw; }
        asm volatile("s_waitcnt lgkmcnt(0)" ::: "memory");
        __builtin_amdgcn_s_barrier();
        asm volatile("" ::: "memory");
        float hc = hrun, hall = hrun;
#pragma unroll
        for (int w2 = 0; w2 < 8; ++w2) { if (w2 == wave) hc = hall; hall = wsr[(w2 * 16 + r16) * 2 + 0] * hall + wsr[(w2 * 16 + r16) * 2 + 1]; }
        hrun = hall;
#pragma unroll
        for (int tau = 0; tau < 2; ++tau) {
            const float hin = PE[tau] * hc + HE[tau];
            bf16* yp = p.Y + ((size_t)b * SEQ + tw + 16 * tau + 4 * g) * DM + dg;
#pragma unroll
            for (int i = 0; i < 4; ++i) { const float h = hl[tau][i] + pl[tau][i] * hin, gr = gr4[tau][i]; yp[(size_t)i * DM] = (bf16)f2bf(h * gr * fast_sigm(gr)); }
        }
    }
#undef LRU_STAGE
    __syncthreads();
}
__device__ __forceinline__ void lru_phase(const P& p, int l, LAS unsigned char* lds) {
    const int G = gridDim.x, wg = blockIdx.x;
#pragma unroll 1
#ifdef XB_LOCAL
    for (int u = wg; u < 256; u += G) lru_unit(p, l, u & 7, (u >> 3) & 7, u >> 6, lds);
#else
    for (int u = wg; u < 256; u += G) lru_unit(p, l, (u >> 3) & 7, u & 7, u >> 6, lds);
#endif
}
#ifndef DSA_PHASE
#define DSA_PHASE dsa_phase
#endif
#ifndef LRU_PHASE
#define LRU_PHASE lru_phase
#endif
#ifndef RP_A
#define RP_A 1
#endif
#ifndef RP_L
#define RP_L 1
#endif
#ifndef RP_D
#define RP_D 1
#endif
#ifndef RP_C
#define RP_C 1
#endif
#ifndef RP_0
#define RP_0 1
#endif
template <int OFF> __device__ __forceinline__ unsigned long long karg_u64() {
    unsigned long long v; const unsigned long long kp = (unsigned long long)__builtin_amdgcn_kernarg_segment_ptr();
    asm volatile("s_load_dwordx2 %0, %1, %2\n\ts_waitcnt lgkmcnt(0)" : "=s"(v) : "s"(kp), "i"(OFF) : "memory");
    return v;
}
struct Args { const float* in[15]; float* out; unsigned char* ws; int ph_lo, ph_hi; };
__global__ void __launch_bounds__(512, 2) mega(Args a) {
    extern __shared__ __attribute__((aligned(16))) unsigned char lds_raw[];
    LAS unsigned char* lds = (LAS unsigned char*)lds_raw;
#define KARG(T, off) ((T)(__attribute__((address_space(1))) void*)karg_u64<(off)>())
#define LOADP() P p; { unsigned char* ws_ = KARG(unsigned char*, 128); \
        p.x = KARG(const float*, 0); p.c = KARG(const float*, 8); p.norm_g = KARG(const float*, 16); p.ada_w = KARG(const float*, 24); p.ada_b = KARG(const float*, 32); p.w_in = KARG(const float*, 40); \
        p.conv_w = KARG(const float*, 48); p.conv_b = KARG(const float*, 56); p.lru_wx = KARG(const float*, 64); p.lru_bx = KARG(const float*, 72); p.lru_wa = KARG(const float*, 80); p.lru_ba = KARG(const float*, 88); \
        p.lru_a = KARG(const float*, 96); p.w_out = KARG(const float*, 104); p.final_g = KARG(const float*, 112); p.out = KARG(float*, 120); \
        p.ctl = (unsigned*)(ws_ + WS_CTL); p.mod = (float*)(ws_ + WS_MOD); p.bias = (float*)(ws_ + WS_BIAS); p.ssq = (float*)(ws_ + WS_SSQ); \
        p.wt_in = (bf16*)(ws_ + WS_WTIN); p.wt_out = (bf16*)(ws_ + WS_WTOUT); p.A = (bf16*)(ws_ + WS_A); p.Z = (bf16*)(ws_ + WS_Z); p.Y = (bf16*)(ws_ + WS_Y); p.X1 = (bf16*)(ws_ + WS_X1); }
    unsigned* const ctl0 = (unsigned*)((unsigned char*)a.ws + WS_CTL);
    const int lo = a.ph_lo, hi = a.ph_hi;
    volatile LAS unsigned* MISC = (volatile LAS unsigned*)(lds + MISC_OFF + 4096);
    if (threadIdx.x < 4) MISC[threadIdx.x] = 0u;
    if (threadIdx.x < 16) { const unsigned t = threadIdx.x; u32x2 m; m.x = ((t & 1u) ? 0xffffu : 0u) | ((t & 2u) ? 0xffff0000u : 0u); m.y = ((t & 4u) ? 0xffffu : 0u) | ((t & 8u) ? 0xffff0000u : 0u);
        *(LAS u32x2*)(lds + DSA_MLUT_OFF + t * 8) = m; }
    __syncthreads();
    XcdBarrier bar; bar.bar = ctl0 + CW_BAR; bar.x = 0; bar.st = MISC;
    if (hi - lo > 1) bar = xcd_barrier_post(ctl0 + CW_BAR, MISC);
#define IN(k) (lo <= (k) && (k) < hi)
#ifndef N_CG_SEAMS
#define N_CG_SEAMS 0
#endif
#ifdef XB_LOCAL
#define SEAM(k) do { if (IN(k) && IN((k) + 1)) { if ((k) < N_CG_SEAMS) cg::this_grid().sync(); else if ((k) >= 2 && lo == 0) xcd_barrier_local(bar); else xcd_barrier(bar); } } while (0)
#else
#define SEAM(k) do { if (IN(k) && IN((k) + 1)) { if ((k) < N_CG_SEAMS) cg::this_grid().sync(); else xcd_barrier(bar); } } while (0)
#endif
    if (IN(0)) { LOADP(); ph0_prologue(p, lds); if (RP_0 > 1) { __syncthreads(); ph0_prologue(p, lds); } }
    SEAM(0);
    if (IN(1)) { LOADP(); ph1_prologue(p, lds); if (RP_0 > 1) { __syncthreads(); ph1_prologue(p, lds); } }
    SEAM(1);
#ifdef PROBE_BAR
#define SEAM_X(b) do { SEAM(b); SEAM(b); SEAM(b); SEAM(b); } while (0)
#else
#define SEAM_X(b) do { } while (0)
#endif
#define LAYER(l, base) \
    if (IN(base)) { LOADP(); \
        pg8::Gemm g{p.A, p.wt_in + (size_t)(l) * ZP * 1024, MROWS, ZP, DM}; pg8::StaticOrder S; S.init(MROWS, ZP, (int)gridDim.x, (int)blockIdx.x); \
        EpiZ E{p.Z, p.ssq, p.bias + (size_t)(l) * 8 * ZP}; \
        pg8::gemm_phase<EpiZ, pg8::StaticOrder, PG8_ALIGN, PG8_SP2>(lds, g, S, E); if (RP_A > 1) { __syncthreads(); pg8::gemm_phase<EpiZ, pg8::StaticOrder, PG8_ALIGN, PG8_SP2>(lds, g, S, E); } \
    } \
    SEAM(base); SEAM_X(base); \
    if (IN((base) + 1)) { LOADP(); bf16x8v pk0[4]; dsa_phase_pre(p, lds, pk0); LRU_PHASE(p, (l), lds); __syncthreads(); DSA_PHASE(p, lds, pk0, (l)); } \
    SEAM((base) + 1); \
    if (IN((base) + 2)) { LOADP(); \
        pg8::Gemm g{p.Y, p.wt_out + (size_t)(l) * 1024 * 1024, MROWS, DM, DM}; pg8::StaticOrder S; S.init(MROWS, DM, (int)gridDim.x, (int)blockIdx.x); \
        if constexpr ((l) == DEPTH - 1) { \
            EpiXF E{p.X1, p.out, p.mod + (size_t)(l) * 8 * 3072 + 2048, p.final_g, p.ssq, p.ctl + CW_PANEL}; \
            pg8::gemm_phase<EpiXF, pg8::StaticOrder, false, PG8_SP2>(lds, g, S, E); \
        } else { \
            EpiX E{p.x, p.X1, p.A, p.mod + (size_t)(l) * 8 * 3072 + 2048, p.norm_g + (size_t)((l) + 1) * 1024, p.mod + (size_t)((l) + 1) * 8 * 3072 + 1024, p.ssq}; \
            pg8::gemm_phase<EpiX, pg8::StaticOrder, false, PG8_SP2>(lds, g, S, E); if (RP_C > 1 && (l) == 0) { __syncthreads(); pg8::gemm_phase<EpiX, pg8::StaticOrder, false, PG8_SP2>(lds, g, S, E); } \
        } \
    } \
    if ((base) + 3 < NPHASE) SEAM((base) + 2);
    LAYER(0, 2)
    LAYER(1, 5)
}
#ifndef MK_N_LAUNCHES
#define MK_N_LAUNCHES 1
#endif
extern "C" void kernel_launch(void* const* d_in, const int* in_sizes, int n_in, void* d_out, int out_size, void* d_ws, size_t ws_size, hipStream_t stream) {
    static int grid = 0;
    if (grid == 0) {
        if (n_in != 15 || out_size != MROWS * DM || ws_size < WS_END) { fprintf(stderr, "kernel_launch: unexpected problem (n_in %d out %d ws %zu)\n", n_in, out_size, ws_size); grid = -1; return; }
        int dev = 0, cus = 0, per_cu = 0;
        hipGetDevice(&dev); hipDeviceGetAttribute(&cus, hipDeviceAttributeMultiprocessorCount, dev);
        if (hipFuncSetAttribute((const void*)mega, hipFuncAttributeMaxDynamicSharedMemorySize, LDS_BYTES) != hipSuccess) { fprintf(stderr, "kernel_launch: hipFuncSetAttribute failed\n"); grid = -1; return; }
        if (hipOccupancyMaxActiveBlocksPerMultiprocessor(&per_cu, (const void*)mega, 512, LDS_BYTES) != hipSuccess || per_cu < 1) { fprintf(stderr, "kernel_launch: occupancy query failed (%d)\n", per_cu); per_cu = 1; }
        (void)hipGetLastError();
        grid = cus * per_cu;
        if (grid != 256) fprintf(stderr, "kernel_launch: grid %d (cus %d x %d) != 256: the fused out-projection epilogue needs exactly 256 workgroups\n", grid, cus, per_cu);
    }
    if (grid < 0) return;
    hipMemsetAsync((char*)d_ws + WS_CTL, 0, CTL_ZERO_BYTES, stream);
    Args a{};
    for (int i = 0; i < 15; ++i) a.in[i] = (const float*)d_in[i];
    a.out = (float*)d_out; a.ws = (unsigned char*)d_ws;
#if MK_N_LAUNCHES == 1
    a.ph_lo = 0; a.ph_hi = NPHASE;
    void* args[] = {&a};
    hipError_t e = hipLaunchCooperativeKernel((const void*)mega, dim3(grid), dim3(512), args, LDS_BYTES, stream);
    if (e != hipSuccess) fprintf(stderr, "cooperative launch failed: %s (grid %d)\n", hipGetErrorString(e), grid);
#else
    for (int ph = 0; ph < NPHASE; ++ph) { a.ph_lo = ph; a.ph_hi = ph + 1; hipLaunchKernelGGL(mega, dim3(grid), dim3(512), LDS_BYTES, stream, a); }
#endif
}
```
